# Optimizing an MI355X kernel written in HIP

```python
import math
import jax, jax.numpy as jnp
from jax import lax
import numpy as np

D_MODEL = 1024
BATCH = 4
SEQ = 4096
DEPTH = 2

ATTN_HEADS = D_MODEL // 64
ATTN_HEAD_DIM = 64
ROT_DIM = ATTN_HEAD_DIM // 4
ROPE_THETA = 500000.0
MOBA_BLOCK = 256
MOBA_TOP_K = 3
MOBA_Q_CHUNK = 32
MLSTM_HEADS = 4
MLSTM_DV = D_MODEL // MLSTM_HEADS
MLSTM_DQK = MLSTM_DV // 2
MLSTM_CHUNK = 64
MLSTM_PROJ = 2 * MLSTM_HEADS * MLSTM_DQK + 2 * MLSTM_HEADS * MLSTM_DV + 2 * MLSTM_HEADS
MOE_EXPERTS = 32
MOE_TOP_K = 4
MOE_D_FF = D_MODEL
SWIGLU_LIMIT = 7.0
SWIGLU_ALPHA = 1.702
MOE_ROW_BLOCK = 256
N_MIXERS = 2
N_ATTN = (DEPTH + 1) // 2
N_MLSTM = DEPTH // 2
DEEPNORM_ALPHA = (2 * DEPTH) ** 0.25
DEEPNORM_BETA = (8 * DEPTH) ** -0.25
LN_EPS = 1e-5

kernel_name = 'moba_mlstm_interleaved_moe_deepnorm'


def layer_norm(x, g, b):
    xf = x.astype(jnp.float32)
    mu = jnp.mean(xf, axis=-1, keepdims=True)
    var = jnp.mean(jnp.square(xf - mu), axis=-1, keepdims=True)
    y = (xf - mu) * lax.rsqrt(var + LN_EPS)
    return (y * g.astype(jnp.float32) + b.astype(jnp.float32)).astype(x.dtype)


def partial_rope(x, positions):
    inv_freq = ROPE_THETA ** (-jnp.arange(0, ROT_DIM, 2, dtype=jnp.float32) / ROT_DIM)
    ang = positions.astype(jnp.float32)[:, None, :, None] * inv_freq
    cos, sin = jnp.cos(ang), jnp.sin(ang)
    xr = x[..., :ROT_DIM].astype(jnp.float32)
    x1, x2 = xr[..., :ROT_DIM // 2], xr[..., ROT_DIM // 2:]
    rot = jnp.concatenate([x1 * cos - x2 * sin, x2 * cos + x1 * sin], axis=-1)
    return jnp.concatenate([rot.astype(x.dtype), x[..., ROT_DIM:]], axis=-1)


def moba_attention(q, k, v):
    Bb, H, S, Dh = q.shape
    nb = S // MOBA_BLOCK
    kk = min(MOBA_TOP_K, nb)
    nq = S // MOBA_Q_CHUNK
    k_blk = k.reshape(Bb, H, nb, MOBA_BLOCK, Dh)
    v_blk = v.reshape(Bb, H, nb, MOBA_BLOCK, Dh)
    k_mean = jnp.mean(k_blk.astype(jnp.float32), axis=3)
    gate = jnp.einsum('bhsd,bhnd->bhsn', q.astype(jnp.float32), k_mean)
    q_blk = jnp.arange(S) // MOBA_BLOCK
    fully_past = jnp.arange(nb)[None, :] < q_blk[:, None]
    gate = jnp.where(fully_past, gate, -jnp.inf)
    _, sel = lax.top_k(gate, kk)
    valid = sel < q_blk[:, None]
    to_chunks = lambda a: jnp.moveaxis(a.reshape(Bb, H, nq, MOBA_Q_CHUNK, *a.shape[3:]), 2, 0)
    gather = jax.vmap(jax.vmap(lambda blocks, idx: blocks[idx]))
    scale = Dh ** -0.5

    def chunk(args):
        c, q_c, sel_c, valid_c = args
        q_start = c * MOBA_Q_CHUNK
        own = q_start // MOBA_BLOCK
        k_sel = gather(k_blk, sel_c)
        v_sel = gather(v_blk, sel_c)
        k_own = lax.dynamic_index_in_dim(k_blk, own, axis=2, keepdims=False)
        v_own = lax.dynamic_index_in_dim(v_blk, own, axis=2, keepdims=False)
        s_sel = (jnp.einsum('bhqd,bhqjkd->bhqjk', q_c, k_sel) * scale).astype(jnp.float32)
        s_sel = jnp.where(valid_c[..., None], s_sel, -jnp.inf).reshape(Bb, H, MOBA_Q_CHUNK, kk * MOBA_BLOCK)
        s_own = (jnp.einsum('bhqd,bhkd->bhqk', q_c, k_own) * scale).astype(jnp.float32)
        q_pos = q_start + jnp.arange(MOBA_Q_CHUNK)
        k_pos = own * MOBA_BLOCK + jnp.arange(MOBA_BLOCK)
        s_own = jnp.where(k_pos[None, :] <= q_pos[:, None], s_own, -jnp.inf)
        p = jax.nn.softmax(jnp.concatenate([s_sel, s_own], axis=-1), axis=-1).astype(v.dtype)
        p_sel = p[..., :kk * MOBA_BLOCK].reshape(Bb, H, MOBA_Q_CHUNK, kk, MOBA_BLOCK)
        p_own = p[..., kk * MOBA_BLOCK:]
        return (jnp.einsum('bhqjk,bhqjkd->bhqd', p_sel, v_sel)
                + jnp.einsum('bhqk,bhkd->bhqd', p_own, v_own))

    out = lax.map(chunk, (jnp.arange(nq), to_chunks(q), to_chunks(sel), to_chunks(valid)))
    return jnp.moveaxis(out, 0, 2).reshape(Bb, H, S, Dh)


def moba_layer(x, positions, w_qkv, w_o):
    Bb, S, _ = x.shape
    hd = ATTN_HEADS * ATTN_HEAD_DIM
    qkv = x @ w_qkv
    split = lambda a: a.reshape(Bb, S, ATTN_HEADS, ATTN_HEAD_DIM).transpose(0, 2, 1, 3)
    q, k, v = split(qkv[..., :hd]), split(qkv[..., hd:2 * hd]), split(qkv[..., 2 * hd:])
    q, k = partial_rope(q, positions), partial_rope(k, positions)
    s_pad = -(-S // MOBA_BLOCK) * MOBA_BLOCK
    pad = ((0, 0), (0, 0), (0, s_pad - S), (0, 0))
    o = moba_attention(jnp.pad(q, pad), jnp.pad(k, pad), jnp.pad(v, pad))[:, :, :S]
    return o.transpose(0, 2, 1, 3).reshape(Bb, S, hd) @ w_o


def mlstm_chunkwise(q, k, v, i_pre, f_pre):
    Bb, H, S, Dqk = q.shape
    Dv = v.shape[-1]
    nc = S // MLSTM_CHUNK
    f32 = jnp.float32
    to_chunks = lambda a: jnp.moveaxis(a.astype(f32).reshape(Bb, H, nc, MLSTM_CHUNK, *a.shape[3:]), 2, 0)
    log_f = jax.nn.log_sigmoid(f_pre.astype(f32))
    causal = jnp.tril(jnp.ones((MLSTM_CHUNK, MLSTM_CHUNK), dtype=bool))

    def step(carry, xs):
        C, n, m = carry
        q_c, k_c, v_c, i_c, lf_c = xs
        b = jnp.cumsum(lf_c, axis=-1)
        D = jnp.where(causal, b[..., :, None] - b[..., None, :] + i_c[..., None, :], -jnp.inf)
        g = b + m[..., None]
        m_t = jnp.maximum(g, jnp.max(D, axis=-1))
        w_inter = jnp.exp(g - m_t)
        A = jnp.exp(D - m_t[..., None]) * jnp.einsum('bhtd,bhsd->bhts', q_c, k_c)
        num = (w_inter[..., None] * jnp.einsum('bhtd,bhde->bhte', q_c, C)
               + jnp.einsum('bhts,bhse->bhte', A, v_c))
        den = w_inter * jnp.einsum('bhtd,bhd->bht', q_c, n) + jnp.sum(A, axis=-1)
        h = num / jnp.maximum(jnp.abs(den), jnp.exp(-m_t))[..., None]
        m_new = m_t[..., -1]
        decay = jnp.exp(b[..., -1] + m - m_new)
        w_s = jnp.exp(b[..., -1:] - b + i_c - m_new[..., None])
        C_new = decay[..., None, None] * C + jnp.einsum('bhs,bhsd,bhse->bhde', w_s, k_c, v_c)
        n_new = decay[..., None] * n + jnp.einsum('bhs,bhsd->bhd', w_s, k_c)
        return (C_new, n_new, m_new), h

    init = (jnp.zeros((Bb, H, Dqk, Dv), f32), jnp.zeros((Bb, H, Dqk), f32), jnp.zeros((Bb, H), f32))
    _, hs = lax.scan(step, init, (to_chunks(q), to_chunks(k), to_chunks(v), to_chunks(i_pre), to_chunks(log_f)))
    return jnp.moveaxis(hs, 0, 2).reshape(Bb, H, S, Dv)


def mlstm_layer(x, w_in, b_gates, norm_g, w_out):
    Bb, S, _ = x.shape
    qk_w = MLSTM_HEADS * MLSTM_DQK
    v_w = MLSTM_HEADS * MLSTM_DV
    proj = x @ w_in
    heads = lambda a, d: a.reshape(Bb, S, MLSTM_HEADS, d).transpose(0, 2, 1, 3)
    q = heads(proj[..., :qk_w], MLSTM_DQK)
    k = heads(proj[..., qk_w:2 * qk_w], MLSTM_DQK) * (MLSTM_DQK ** -0.5)
    v = heads(proj[..., 2 * qk_w:2 * qk_w + v_w], MLSTM_DV)
    o_pre = proj[..., 2 * qk_w + v_w:2 * qk_w + 2 * v_w]
    gates = (proj[..., 2 * qk_w + 2 * v_w:] + b_gates).transpose(0, 2, 1)
    h = mlstm_chunkwise(q, k, v, gates[:, :MLSTM_HEADS], gates[:, MLSTM_HEADS:])
    mu = jnp.mean(h, axis=-1, keepdims=True)
    var = jnp.mean(jnp.square(h - mu), axis=-1, keepdims=True)
    h = (h - mu) * lax.rsqrt(var + LN_EPS) * norm_g.astype(jnp.float32).reshape(MLSTM_HEADS, 1, MLSTM_DV)
    h = h.transpose(0, 2, 1, 3).reshape(Bb, S, v_w).astype(x.dtype)
    return (jax.nn.sigmoid(o_pre) * h) @ w_out


def clamped_swiglu(h):
    x_glu = jnp.minimum(h[..., ::2], SWIGLU_LIMIT)
    x_lin = jnp.clip(h[..., 1::2], -SWIGLU_LIMIT, SWIGLU_LIMIT)
    return x_glu * jax.nn.sigmoid(SWIGLU_ALPHA * x_glu) * (x_lin + 1.0)


def moe_ffn(x, router_w, router_b, w_gate_up, b_gate_up, w_down, b_down):
    Bb, S, D = x.shape
    xt = x.reshape(-1, D)
    T = xt.shape[0]
    n_assign = T * MOE_TOP_K
    logits = (xt @ router_w + router_b).astype(jnp.float32)
    top_logits, top_e = lax.top_k(logits, MOE_TOP_K)
    gates = jax.nn.softmax(top_logits, axis=-1)
    flat_e = top_e.reshape(-1)
    order = jnp.argsort(flat_e)
    sorted_e = flat_e[order]
    counts = jnp.bincount(flat_e, length=MOE_EXPERTS)
    padded = (counts + MOE_ROW_BLOCK - 1) // MOE_ROW_BLOCK * MOE_ROW_BLOCK
    pad_end = jnp.cumsum(padded)
    pad_start = pad_end - padded
    start = jnp.cumsum(counts) - counts
    dest_sorted = pad_start[sorted_e] + jnp.arange(n_assign, dtype=jnp.int32) - start[sorted_e]
    dest = jnp.zeros((n_assign,), jnp.int32).at[order].set(dest_sorted.astype(jnp.int32))
    n_blocks = -(-(n_assign + MOE_EXPERTS * (MOE_ROW_BLOCK - 1)) // MOE_ROW_BLOCK)
    n_rows = n_blocks * MOE_ROW_BLOCK
    row_token = jnp.zeros((n_rows,), jnp.int32).at[dest].set(jnp.arange(n_assign, dtype=jnp.int32) // MOE_TOP_K)
    block_e = jnp.minimum(jnp.searchsorted(pad_end, jnp.arange(n_blocks) * MOE_ROW_BLOCK, side='right'),
                          MOE_EXPERTS - 1)
    x_rows = xt[row_token].reshape(n_blocks, MOE_ROW_BLOCK, D)

    def expert_block(args):
        xb, e = args
        h = xb @ w_gate_up[e] + b_gate_up[e]
        return clamped_swiglu(h) @ w_down[e] + b_down[e]

    y_rows = lax.map(expert_block, (x_rows, block_e)).reshape(n_rows, D)
    y = y_rows[dest].reshape(T, MOE_TOP_K, D)
    out = jnp.einsum('tkd,tk->td', y, gates.astype(y.dtype))
    return out.reshape(Bb, S, D)


def _normal(key, shape, scale):
    return jax.random.normal(key, shape, jnp.float32) * scale


def setup_inputs(seed: int = 0) -> dict:
    key = jax.random.key(seed)
    ks = jax.random.split(key, 20)
    hd = ATTN_HEADS * ATTN_HEAD_DIM
    v_w = MLSTM_HEADS * MLSTM_DV
    x = _normal(ks[0], (BATCH, SEQ, D_MODEL), 1.0)
    positions = jnp.broadcast_to(jnp.arange(SEQ, dtype=jnp.int32), (BATCH, SEQ))
    attn_w_qkv = _normal(ks[1], (N_ATTN, D_MODEL, 3 * hd), D_MODEL ** -0.5)
    attn_w_o = _normal(ks[2], (N_ATTN, hd, D_MODEL), hd ** -0.5 * DEEPNORM_BETA)
    mlstm_w_in = _normal(ks[3], (N_MLSTM, D_MODEL, MLSTM_PROJ), D_MODEL ** -0.5)
    mlstm_b_gates = jnp.concatenate([
        _normal(ks[4], (N_MLSTM, MLSTM_HEADS), 0.1),
        3.0 + _normal(ks[5], (N_MLSTM, MLSTM_HEADS), 0.1)], axis=-1)
    mlstm_norm_g = 1.0 + _normal(ks[6], (N_MLSTM, v_w), 0.02)
    mlstm_w_out = _normal(ks[7], (N_MLSTM, v_w, D_MODEL), v_w ** -0.5 * DEEPNORM_BETA)
    ln_mix_g = 1.0 + _normal(ks[8], (DEPTH, D_MODEL), 0.02)
    ln_mix_b = _normal(ks[9], (DEPTH, D_MODEL), 0.02)
    ln_ffn_g = 1.0 + _normal(ks[10], (DEPTH, D_MODEL), 0.02)
    ln_ffn_b = _normal(ks[11], (DEPTH, D_MODEL), 0.02)
    router_w = _normal(ks[12], (DEPTH, D_MODEL, MOE_EXPERTS), D_MODEL ** -0.5)
    router_b = _normal(ks[13], (DEPTH, MOE_EXPERTS), 0.01)
    w_gate_up = _normal(ks[14], (DEPTH, MOE_EXPERTS, D_MODEL, 2 * MOE_D_FF), D_MODEL ** -0.5)
    b_gate_up = _normal(ks[15], (DEPTH, MOE_EXPERTS, 2 * MOE_D_FF), 0.01)
    w_down = _normal(ks[16], (DEPTH, MOE_EXPERTS, MOE_D_FF, D_MODEL), MOE_D_FF ** -0.5 * DEEPNORM_BETA)
    b_down = _normal(ks[17], (DEPTH, MOE_EXPERTS, D_MODEL), 0.01)
    return {'x': x, 'positions': positions,
            'attn_w_qkv': attn_w_qkv, 'attn_w_o': attn_w_o,
            'mlstm_w_in': mlstm_w_in, 'mlstm_b_gates': mlstm_b_gates,
            'mlstm_norm_g': mlstm_norm_g, 'mlstm_w_out': mlstm_w_out,
            'ln_mix_g': ln_mix_g, 'ln_mix_b': ln_mix_b, 'ln_ffn_g': ln_ffn_g, 'ln_ffn_b': ln_ffn_b,
            'router_w': router_w, 'router_b': router_b,
            'w_gate_up': w_gate_up, 'b_gate_up': b_gate_up, 'w_down': w_down, 'b_down': b_down}


def reference(x, positions, attn_w_qkv, attn_w_o, mlstm_w_in, mlstm_b_gates, mlstm_norm_g, mlstm_w_out,
              ln_mix_g, ln_mix_b, ln_ffn_g, ln_ffn_b, router_w, router_b,
              w_gate_up, b_gate_up, w_down, b_down):
    for layer in range(DEPTH):
        slot = layer // N_MIXERS
        if layer % N_MIXERS == 0:
            y = moba_layer(x, positions, attn_w_qkv[slot], attn_w_o[slot])
        else:
            y = mlstm_layer(x, mlstm_w_in[slot], mlstm_b_gates[slot], mlstm_norm_g[slot], mlstm_w_out[slot])
        x = layer_norm(DEEPNORM_ALPHA * x + y, ln_mix_g[layer], ln_mix_b[layer])
        f = moe_ffn(x, router_w[layer], router_b[layer], w_gate_up[layer], b_gate_up[layer],
                    w_down[layer], b_down[layer])
        x = layer_norm(DEEPNORM_ALPHA * x + f, ln_ffn_g[layer], ln_ffn_b[layer])
    return x
```

```cpp
#include <hip/hip_runtime.h>
#include <hip/hip_bf16.h>
#include <cstdio>
#include <cstdint>
#include <cmath>

#define LAS __attribute__((address_space(3)))
#define GAS __attribute__((address_space(1)))
typedef unsigned short bf16_t;
typedef short bf16x8 __attribute__((ext_vector_type(8)));
typedef float f32x4 __attribute__((ext_vector_type(4)));
typedef float f32x2 __attribute__((ext_vector_type(2)));
typedef unsigned u32x4 __attribute__((ext_vector_type(4)));
typedef unsigned u32x2 __attribute__((ext_vector_type(2)));
typedef int i32x4 __attribute__((ext_vector_type(4)));
typedef int i32x8 __attribute__((ext_vector_type(8)));

typedef __bf16 bf16x2_t __attribute__((ext_vector_type(2)));
__device__ __forceinline__ unsigned cvt_pk_bf16(float lo, float hi) { const f32x2 v = {lo, hi}; const bf16x2_t b = __builtin_convertvector(v, bf16x2_t); return __builtin_bit_cast(unsigned, b); }
__device__ __forceinline__ float bf2f(unsigned short b) { return __uint_as_float(((unsigned)b) << 16); }
__device__ __forceinline__ float bflo(unsigned w) { return __uint_as_float(w << 16); }
__device__ __forceinline__ float bfhi(unsigned w) { return __uint_as_float(w & 0xffff0000u); }

__device__ __forceinline__ void glds16s(const void* sbase, unsigned voff, unsigned lds_dst) { unsigned keep;
    asm volatile("s_nop 4\n\ts_mov_b32 %0, m0\n\ts_mov_b32 m0, %3\n\ts_nop 0\n\tglobal_load_lds_dwordx4 %1, %2\n\ts_mov_b32 m0, %0" : "=&s"(keep) : "v"(voff), "s"(sbase), "s"(lds_dst) : "memory"); }
__device__ __forceinline__ void glds4s(const void* sbase, unsigned voff, unsigned lds_dst) { unsigned keep;
    asm volatile("s_nop 4\n\ts_mov_b32 %0, m0\n\ts_mov_b32 m0, %3\n\ts_nop 0\n\tglobal_load_lds_dword %1, %2\n\ts_mov_b32 m0, %0" : "=&s"(keep) : "v"(voff), "s"(sbase), "s"(lds_dst) : "memory"); }
__device__ __forceinline__ const char* uni_ptr(const char* p) { const unsigned long long v = (unsigned long long)p; const unsigned lo = __builtin_amdgcn_readfirstlane((unsigned)v), hi = __builtin_amdgcn_readfirstlane((unsigned)(v >> 32)); return (const char*)(((unsigned long long)hi << 32) | lo); }
namespace pg8 {
constexpr int BM = 256, BK = 64, HALF = 128, HTB = HALF * BK * 2, STAGE_BYTES = 8 * HTB, NXCD = 8, WGM = 8;
__host__ __device__ __forceinline__ int lds_byte(int r, int c) { const int st = (r >> 4) * 2 + (c >> 5), rr = r & 15, cc = c & 31, ob = rr * 64 + cc * 2; return st * 1024 + (ob ^ (((ob >> 9) & 1) << 5)); }
__host__ __device__ __forceinline__ void stage_rc(int b, int& R, int& C) { const int st = b / 1024, sb = b % 1024, swz = sb ^ (((sb >> 9) & 1) << 5); R = (st >> 1) * 16 + swz / 64; C = (st & 1) * 32 + (swz % 64) / 2; }
__host__ __device__ __forceinline__ int perm32(int rho) { const int n = rho >> 4, i = rho & 15; return 8 * (i >> 2) + 4 * n + (i & 3); }

struct Unit { int pm, pn; const char* A; const char* B; const LAS unsigned short* tl; int x0, x1, x2; };
struct Gemm { int K, lda, ldb; const char* Abase; };

__device__ __forceinline__ bool tile_order(int i, int G, int c, int nM, int nN, int& pm, int& pn) {
    const int nwg = nM * nN; const long L = (long)i * G + c; if (L >= nwg) return false;
    int wgid = (int)L; { const int q = nwg / NXCD, r = nwg % NXCD, xcd = wgid % NXCD, off = wgid / NXCD; wgid = (xcd < r ? xcd * (q + 1) : r * (q + 1) + (xcd - r) * q) + off; }
    const int nig = WGM * nN, gid = wgid / nig, fm = gid * WGM, gsz = (nM - fm) < WGM ? (nM - fm) : WGM;
    pm = fm + ((wgid % nig) % gsz); pn = (wgid % nig) / gsz; return true;
}

template <class Epi, class Sched, bool ALIGN_EPI, bool GATHER, bool FP8 = false, bool HALFSEL = false>
__device__ __forceinline__ void gemm_phase(LAS unsigned char* lds, const Gemm g, const Sched& S, const Epi& E) {
    const int tid = threadIdx.x, wid = __builtin_amdgcn_readfirstlane(tid >> 6), lane = tid & 63, wr = wid >> 2, wc = wid & 3, fr = lane & 15, fq = lane >> 4;
    const int K = g.K, nt = K / BK;
    int RA[2]; unsigned cA2[2], voffB[2];
#pragma unroll
    for (int i = 0; i < 2; ++i) { int R, C; stage_rc(tid * 16 + i * 8192, R, C); const int Rb = Epi::PERM ? ((R & ~31) + perm32(R & 31)) : R;
        RA[i] = R; cA2[i] = (unsigned)C * 2u; voffB[i] = (unsigned)(Rb * g.ldb + C) * 2u; }
    const size_t kstep = (size_t)(BK * 2);
    const unsigned hstepA = (unsigned)HALF * (unsigned)g.lda * 2u; const size_t hstepB = (size_t)HALF * g.ldb * 2;
    const unsigned ldsb = (unsigned)__builtin_amdgcn_readfirstlane((unsigned)(unsigned long long)lds + (unsigned)wid * 1024u);
    const int aoff = lds_byte(wr * 64 + fr, fq * 8), boff = lds_byte(wc * 32 + fr, fq * 8);
    const int aoff2 = aoff + 1024, boff2 = boff + 1024;
#define PG8_SA(b, h) (((b) * 2 + (h)) * HTB)
#define PG8_SB(b, h) ((4 + (b) * 2 + (h)) * HTB)
#define PG8_STAGE(bufoff, gbase, voff) do { _Pragma("unroll") for (int _i = 0; _i < 2; ++_i) glds16s((gbase), (voff)[_i], ldsb + (unsigned)(bufoff) + _i * 8192u); } while (0)
#define PG8_STAGE_A(bufoff, gbase, AO, h) do { _Pragma("unroll") for (int _i = 0; _i < 2; ++_i) glds16s((gbase), (AO)[h][_i], ldsb + (unsigned)(bufoff) + _i * 8192u); } while (0)
#define PG8_LD8(base_, o1_, o2_) __builtin_shufflevector(*(const LAS i32x4*)(lds + (base_) + (o1_)), *(const LAS i32x4*)(lds + (base_) + (o2_)), 0, 1, 2, 3, 4, 5, 6, 7)
#define PG8_LDA(dst, b, h) do { if constexpr (FP8) { _Pragma("unroll") for (int m = 0; m < 4; ++m) dst##8[m] = PG8_LD8(PG8_SA(b, h) + m * 2048, aoff, aoff2); } \
        else { _Pragma("unroll") for (int m = 0; m < 4; ++m) _Pragma("unroll") for (int k = 0; k < 2; ++k) dst[m][k] = *(const LAS bf16x8*)(lds + PG8_SA(b, h) + aoff + m * 2048 + k * 1024); } } while (0)
#define PG8_LDB(dst, b, h) do { if constexpr (FP8) { _Pragma("unroll") for (int n = 0; n < 2; ++n) dst##8[n] = PG8_LD8(PG8_SB(b, h) + n * 2048, boff, boff2); } \
        else { _Pragma("unroll") for (int n = 0; n < 2; ++n) _Pragma("unroll") for (int k = 0; k < 2; ++k) dst[n][k] = *(const LAS bf16x8*)(lds + PG8_SB(b, h) + boff + n * 2048 + k * 1024); } } while (0)
#define PG8_MMA(ai, bj, At, Bt) do { __builtin_amdgcn_s_setprio(1); _Pragma("unroll") for (int m = 0; m < 4; ++m) _Pragma("unroll") for (int n = 0; n < 2; ++n) { \
        if constexpr (FP8) asm volatile("v_mfma_f32_16x16x128_f8f6f4 %0, %1, %2, %0" : "+v"(acc[ai][bj][m][n]) : "v"(Bt##8[n]), "v"(At##8[m])); \
        else { _Pragma("unroll") for (int k = 0; k < 2; ++k) acc[ai][bj][m][n] = __builtin_amdgcn_mfma_f32_16x16x32_bf16(Bt[n][k], At[m][k], acc[ai][bj][m][n], 0, 0, 0); } } \
        __builtin_amdgcn_s_setprio(0); } while (0)
#define PG8_WAIT_V(n) asm volatile("s_waitcnt vmcnt(" #n ")" ::: "memory")
#define PG8_WAIT_L(n) asm volatile("s_waitcnt lgkmcnt(" #n ")" ::: "memory")
#define PG8_BAR __builtin_amdgcn_s_barrier()
#define PG8_SCHED __builtin_amdgcn_sched_barrier(0)
#define PG8_AOFF(AO, U) do { _Pragma("unroll") for (int _h = 0; _h < 2; ++_h) _Pragma("unroll") for (int _i = 0; _i < 2; ++_i) { \
        if constexpr (GATHER) AO[_h][_i] = (unsigned)(U).tl[RA[_i] + _h * HALF] * (unsigned)(g.lda * 2) + cA2[_i]; \
        else AO[_h][_i] = (unsigned)RA[_i] * (unsigned)(g.lda * 2) + cA2[_i] + (unsigned)_h * hstepA; } } while (0)
    Unit cur, nxt; int ui = 0;
    if (!S.next(0, cur)) return;
    f32x4 acc[2][2][4][2];
#pragma unroll
    for (int a = 0; a < 2; ++a)
#pragma unroll
        for (int b = 0; b < 2; ++b)
#pragma unroll
            for (int m = 0; m < 4; ++m)
#pragma unroll
                for (int n = 0; n < 2; ++n) acc[a][b][m][n] = (f32x4){0.f, 0.f, 0.f, 0.f};
    bf16x8 At[4][2], B0[2][2], B1[2][2]; i32x8 At8[4], B08[2], B18[2];
    E.prep(cur, 0, wid, lane);
    unsigned aoC[2][2], aoN[2][2];
    PG8_AOFF(aoC, cur);
    const char* cA = uni_ptr(GATHER ? g.Abase : cur.A); const char* cB = uni_ptr(cur.B);
    PG8_STAGE(PG8_SB(0, 0), cB, voffB); PG8_STAGE(PG8_SB(0, 1), cB + hstepB, voffB); PG8_STAGE_A(PG8_SA(0, 0), cA, aoC, 0); PG8_STAGE_A(PG8_SA(0, 1), cA, aoC, 1);
    if (wr == 1) PG8_BAR;
    PG8_WAIT_V(2); PG8_BAR;
    PG8_STAGE(PG8_SB(1, 0), cB + kstep, voffB); PG8_STAGE_A(PG8_SA(1, 0), cA + kstep, aoC, 0); PG8_STAGE(PG8_SB(1, 1), cB + hstepB + kstep, voffB);
    PG8_WAIT_V(6); PG8_BAR;
    for (;;) {
        const bool has_next = S.next(ui + 1, nxt);
        if (has_next) E.prep(nxt, ui + 1, wid, lane);
        if constexpr (GATHER) { if (has_next) PG8_AOFF(aoN, nxt); else { _Pragma("unroll") for (int _h = 0; _h < 2; ++_h) _Pragma("unroll") for (int _i = 0; _i < 2; ++_i) aoN[_h][_i] = aoC[_h][_i]; } }
        const char* nA = uni_ptr(GATHER ? g.Abase : (has_next ? nxt.A : cA)); const char* nB = uni_ptr(has_next ? nxt.B : cB);
        const bool dh0 = cur.x2 != 2, dh1 = cur.x2 != 1;
#pragma nounroll
        for (int t = 0; t < nt; t += 2) {
            const bool last = (t == nt - 2);
            const char* a1 = cA + (size_t)(t + 1) * kstep;
            const char* a2 = last ? nA : cA + (size_t)(t + 2) * kstep; const char* b2 = last ? nB : cB + (size_t)(t + 2) * kstep;
            const char* a3 = a2 + kstep; const char* b3 = b2 + kstep;
            unsigned aoS[2][2];
#pragma unroll
            for (int _h = 0; _h < 2; ++_h)
#pragma unroll
                for (int _i = 0; _i < 2; ++_i) aoS[_h][_i] = (GATHER && last) ? aoN[_h][_i] : aoC[_h][_i];
            PG8_LDB(B0, 0, 0); PG8_LDB(B1, 0, 1); PG8_SCHED; PG8_LDA(At, 0, 0); PG8_STAGE_A(PG8_SA(1, 1), a1, aoC, 1);
            PG8_WAIT_V(8); PG8_WAIT_L(0); PG8_BAR; if (!HALFSEL || dh0) PG8_MMA(0, 0, At, B0); if (!HALFSEL || dh1) PG8_MMA(0, 1, At, B1); PG8_BAR; PG8_SCHED;
            PG8_LDA(At, 0, 1); PG8_STAGE(PG8_SB(0, 0), b2, voffB); PG8_STAGE(PG8_SB(0, 1), b2 + hstepB, voffB); PG8_STAGE_A(PG8_SA(0, 0), a2, aoS, 0);
            PG8_WAIT_V(8); PG8_WAIT_L(0); PG8_BAR; if (!HALFSEL || dh0) PG8_MMA(1, 0, At, B0); if (!HALFSEL || dh1) PG8_MMA(1, 1, At, B1); PG8_BAR; PG8_SCHED;
            PG8_LDB(B0, 1, 0); PG8_LDB(B1, 1, 1); PG8_SCHED; PG8_LDA(At, 1, 0); PG8_STAGE_A(PG8_SA(0, 1), a2, aoS, 1);
            PG8_WAIT_V(8); PG8_WAIT_L(0); PG8_BAR; if (!HALFSEL || dh0) PG8_MMA(0, 0, At, B0); if (!HALFSEL || dh1) PG8_MMA(0, 1, At, B1); PG8_BAR; PG8_SCHED;
            PG8_LDA(At, 1, 1); PG8_STAGE(PG8_SB(1, 0), b3, voffB); PG8_STAGE(PG8_SB(1, 1), b3 + hstepB, voffB); PG8_STAGE_A(PG8_SA(1, 0), a3, aoS, 0);
            PG8_WAIT_V(8); PG8_WAIT_L(0); PG8_BAR; if (!HALFSEL || dh0) PG8_MMA(1, 0, At, B0); if (!HALFSEL || dh1) PG8_MMA(1, 1, At, B1); PG8_BAR; PG8_SCHED;
        }
        if constexpr (FP8) asm volatile("s_nop 15\n\ts_nop 15" ::: "memory");
        if constexpr (ALIGN_EPI) { if (wr == 0) PG8_BAR; }
        E(acc, cur, wr, wc, fr, fq);
        if (!has_next) break;
#pragma unroll
        for (int a = 0; a < 2; ++a)
#pragma unroll
            for (int b = 0; b < 2; ++b)
#pragma unroll
                for (int m = 0; m < 4; ++m)
#pragma unroll
                    for (int n = 0; n < 2; ++n) acc[a][b][m][n] = (f32x4){0.f, 0.f, 0.f, 0.f};
        if constexpr (FP8) asm volatile("s_nop 7" ::: "memory");
        cur = nxt; cA = nA; cB = nB; ++ui;
        if constexpr (GATHER) {
#pragma unroll
            for (int _h = 0; _h < 2; ++_h)
#pragma unroll
                for (int _i = 0; _i < 2; ++_i) aoC[_h][_i] = aoN[_h][_i]; }
        if constexpr (ALIGN_EPI) { if (wr == 1) PG8_BAR; }
    }
    PG8_WAIT_V(0);
    if constexpr (!ALIGN_EPI) { if (wr == 0) PG8_BAR; }
    PG8_BAR;
#undef PG8_SA
#undef PG8_SB
#undef PG8_STAGE
#undef PG8_STAGE_A
#undef PG8_LDA
#undef PG8_LD8
#undef PG8_LDB
#undef PG8_MMA
#undef PG8_WAIT_V
#undef PG8_WAIT_L
#undef PG8_BAR
#undef PG8_SCHED
#undef PG8_AOFF
}
}
#include <hip/hip_bf16.h>
namespace attn_body {
using bf16=__hip_bfloat16;
using bf16x8=__attribute__((ext_vector_type(8)))short;
using s16x4=__attribute__((ext_vector_type(4)))short;
using f32x16=__attribute__((ext_vector_type(16)))float;
using u32x4=__attribute__((ext_vector_type(4)))unsigned;
constexpr int BATCH=4,NHEAD=16,SEQ=4096,D=64,DM=NHEAD*D;
constexpr int NW=8,QBLK=32,QB=QBLK*NW,KVBLK=64,NQB=SEQ/QB;
constexpr int ATTN_PITCH=DM, ATTN_UNIT_ROWS=QB;
__device__ __forceinline__ int crow(int r,int hi){return (r&3)+8*(r>>2)+4*hi;}
#define SBAR() __builtin_amdgcn_sched_barrier(0)
__device__ __forceinline__ void cmask(f32x16&p0,f32x16&p1,int jb,int qrel,int hi){
  const float NEG=-INFINITY; int d=qrel-64*jb-4*hi; asm volatile("":"+v"(d));
  #pragma unroll
  for(int r=0;r<16;++r){const int c=(r&3)+8*(r>>2); if(c>d)p0[r]=NEG; if(c+32>d)p1[r]=NEG;}
}

constexpr int NSLOT=3, SLOTB=8192;
constexpr int LDS_GT=98304;
constexpr int LDS_K=0, LDS_V=NSLOT*SLOTB, LDS_WS=2*NSLOT*SLOTB, LDS_OST=LDS_WS+NW*64*4, LDS_BYTES=LDS_OST+NW*4096;
constexpr float C2=0.125f*1.4426950408889634f;
__device__ __forceinline__ void glds16(const void*gsrc,unsigned lds_dst){unsigned keep;
  asm volatile("s_mov_b32 %0, m0\n\ts_mov_b32 m0, %2\n\ts_nop 0\n\tglobal_load_lds_dwordx4 %1, off\n\ts_mov_b32 m0, %0":"=&s"(keep):"v"(gsrc),"s"(lds_dst):"memory");}
__device__ __forceinline__ void glds16s(const void*sbase,unsigned voff,unsigned lds_dst){unsigned keep;
  asm volatile("s_nop 4\n\ts_mov_b32 %0, m0\n\ts_mov_b32 m0, %3\n\ts_nop 0\n\tglobal_load_lds_dwordx4 %1, %2\n\ts_mov_b32 m0, %0":"=&s"(keep):"v"(voff),"s"(sbase),"s"(lds_dst):"memory");}
__device__ __forceinline__ unsigned lane_now(){unsigned l;asm volatile("v_mbcnt_lo_u32_b32 %0, -1, 0\n\tv_mbcnt_hi_u32_b32 %0, -1, %0":"=v"(l));return l;}
__device__ __forceinline__ float max3f(float a,float b,float c){float r;asm("v_max3_f32 %0, %1, %2, %3":"=v"(r):"v"(a),"v"(b),"v"(c));return r;}
__device__ __forceinline__ float max2f(float a,float b){float r;asm("v_max_f32_e32 %0, %1, %2":"=v"(r):"v"(a),"v"(b));return r;}
__device__ __forceinline__ float fadd_s(float a,float b){float r;asm("v_add_f32_e32 %0, %1, %2":"=v"(r):"v"(a),"v"(b));return r;}
__device__ __forceinline__ float fsub_s(float a,float b){float r;asm("v_sub_f32_e32 %0, %1, %2":"=v"(r):"v"(a),"v"(b));return r;}
typedef float f32x2_t __attribute__((ext_vector_type(2))); typedef __bf16 bf16x2_t __attribute__((ext_vector_type(2)));
__device__ __forceinline__ unsigned cvtpk_s(float lo,float hi){f32x2_t v={lo,hi};bf16x2_t b=__builtin_convertvector(v,bf16x2_t);return __builtin_bit_cast(unsigned,b);}
#define WAIT_BAR(N) asm volatile("s_waitcnt vmcnt(" #N ") lgkmcnt(0)\n\ts_barrier":::"memory")

__device__ __forceinline__ void qkt(f32x16&p0,f32x16&p1,const char*Kslot,const bf16x8*qr,int r32,int hi){
  const char*kb=Kslot+hi*1024+r32*16;
  #pragma unroll
  for(int d0=0;d0<4;++d0){
    const bf16x8 b0=*reinterpret_cast<const bf16x8*>(kb+d0*2048);
    const bf16x8 b1=*reinterpret_cast<const bf16x8*>(kb+d0*2048+512);
    if(d0==0){p0=__builtin_amdgcn_mfma_f32_32x32x16_bf16(b0,qr[0],(f32x16){0.f,0.f,0.f,0.f,0.f,0.f,0.f,0.f,0.f,0.f,0.f,0.f,0.f,0.f,0.f,0.f},0,0,0);p1=__builtin_amdgcn_mfma_f32_32x32x16_bf16(b1,qr[0],(f32x16){0.f,0.f,0.f,0.f,0.f,0.f,0.f,0.f,0.f,0.f,0.f,0.f,0.f,0.f,0.f,0.f},0,0,0);}
    else{p0=__builtin_amdgcn_mfma_f32_32x32x16_bf16(b0,qr[d0],p0,0,0,0);p1=__builtin_amdgcn_mfma_f32_32x32x16_bf16(b1,qr[d0],p1,0,0,0);}}
}
typedef __attribute__((address_space(3))) const char* lds_cptr;
typedef short v4i16_t __attribute__((ext_vector_type(4)));
__device__ __forceinline__ void kload8(bf16x8*kf,lds_cptr kp){
  kf[0]=*(const __attribute__((address_space(3))) bf16x8*)(kp);      kf[1]=*(const __attribute__((address_space(3))) bf16x8*)(kp+512);
  kf[2]=*(const __attribute__((address_space(3))) bf16x8*)(kp+2048); kf[3]=*(const __attribute__((address_space(3))) bf16x8*)(kp+2560);
  kf[4]=*(const __attribute__((address_space(3))) bf16x8*)(kp+4096); kf[5]=*(const __attribute__((address_space(3))) bf16x8*)(kp+4608);
  kf[6]=*(const __attribute__((address_space(3))) bf16x8*)(kp+6144); kf[7]=*(const __attribute__((address_space(3))) bf16x8*)(kp+6656);
}
__device__ __forceinline__ void kload2(bf16x8*kf,lds_cptr kp,int j){ kf[2*j]=*(const __attribute__((address_space(3))) bf16x8*)(kp+j*2048); kf[2*j+1]=*(const __attribute__((address_space(3))) bf16x8*)(kp+j*2048+512); }
__device__ __forceinline__ s16x4 vtr(lds_cptr p){ return __builtin_bit_cast(s16x4,__builtin_amdgcn_ds_read_tr16_b64_v4i16((__attribute__((address_space(3))) v4i16_t*)p)); }
__device__ __forceinline__ float rowmax(const f32x16&p0,const f32x16&p1){
  float a=max3f(p0[0],p0[1],p1[0]),b=max3f(p0[2],p0[3],p1[1]);a=max3f(a,p1[2],p1[3]);
  #pragma unroll
  for(int r=4;r<16;r+=4){a=max3f(a,p0[r],p0[r+1]);b=max3f(b,p0[r+2],p0[r+3]);a=max3f(a,p1[r],p1[r+1]);b=max3f(b,p1[r+2],p1[r+3]);}
  const float m=max2f(a,b);
  auto rr=__builtin_amdgcn_permlane32_swap(__float_as_uint(m),__float_as_uint(m),false,false);
  return max2f(__uint_as_float(rr[0]),__uint_as_float(rr[1]));
}
__device__ __forceinline__ void pv(f32x16*o,int vb,bf16x8 pa0,bf16x8 pa1,bf16x8 pa2,bf16x8 pa3){
  #pragma unroll
  for(int d0=0;d0<2;++d0){s16x4 lo[4],hi[4];
    #pragma unroll
    for(int ks=0;ks<4;++ks){
      asm volatile("ds_read_b64_tr_b16 %0,%1 offset:%c2":"=&v"(lo[ks]):"v"(vb),"i"(d0*4096+ks*1024):"memory");
      asm volatile("ds_read_b64_tr_b16 %0,%1 offset:%c2":"=&v"(hi[ks]):"v"(vb),"i"(d0*4096+ks*1024+512):"memory");}
    asm volatile("s_waitcnt lgkmcnt(0)":::"memory");SBAR();
    #define PK(k) (bf16x8){lo[k][0],lo[k][1],lo[k][2],lo[k][3],hi[k][0],hi[k][1],hi[k][2],hi[k][3]}
    o[d0]=__builtin_amdgcn_mfma_f32_32x32x16_bf16(pa0,PK(0),o[d0],0,0,0);
    o[d0]=__builtin_amdgcn_mfma_f32_32x32x16_bf16(pa1,PK(1),o[d0],0,0,0);
    o[d0]=__builtin_amdgcn_mfma_f32_32x32x16_bf16(pa2,PK(2),o[d0],0,0,0);
    o[d0]=__builtin_amdgcn_mfma_f32_32x32x16_bf16(pa3,PK(3),o[d0],0,0,0);
    #undef PK
  }
}

#ifndef ATTN_STORE16
#define ATTN_STORE16(p,v) (*(u32x4*)(p)=(v))
#endif
template<int THRL> __device__ __forceinline__ void attn_unit(int b,int h,int qb,const bf16*Q,const bf16*__restrict__ K,const bf16*__restrict__ V,bf16*O,const float*ksum,char*shm){
  const int tid=threadIdx.x,lane=tid&63,r32=lane&31,hi=lane>>5; const int wid=__builtin_amdgcn_readfirstlane(tid>>6);
  const long rowbase=(long)b*SEQ; const int q0=qb*QB;
  const bf16*Qw=Q+(rowbase+q0+wid*QBLK)*DM+h*D;
  const bf16*Kh=K+rowbase*DM+h*D,*Vh=V+rowbase*DM+h*D;
  const unsigned lds0=(unsigned)(uintptr_t)shm;
  float*wsf=(float*)(shm+LDS_WS)+wid*64;
  const unsigned kdst=lds0+LDS_K+wid*1024, vdst=lds0+LDS_V+wid*1024;
  #define PHYS(t) (((t)<4)?(4*qb+(t)):((t)-4))
  #define DMA_K(t,slot) glds16s((const char*)Kh+(size_t)PHYS(t)*(KVBLK*DM*2)+wid*16,lane_now()*(unsigned)(DM*2),(unsigned)__builtin_amdgcn_readfirstlane(kdst+(slot)))
  #define DMA_V(t,slot) glds16s((const char*)Vh+(size_t)PHYS(t)*(KVBLK*DM*2)+(size_t)(16*(wid&3))*(DM*2)+(wid>>2)*64,({const unsigned l_=lane_now(); (l_>>2)*(unsigned)(DM*2)+(l_&3u)*16u;}),(unsigned)__builtin_amdgcn_readfirstlane(vdst+(slot)))
  const int vb0=(int)(lds0+LDS_V)+((lane>>4)&1)*32+(lane&3)*8+(4*hi+((lane&15)>>2))*64;
  const char*Kbase=shm+LDS_K; bf16x8 kf[8];
  const lds_cptr shm3=(lds_cptr)shm; const lds_cptr kp0=shm3+LDS_K+hi*1024+r32*16; const lds_cptr vp0=shm3+LDS_V+((lane>>4)&1)*32+(lane&3)*8+(4*hi+((lane&15)>>2))*64;
  const int NT=(q0+QB)/KVBLK;
  DMA_K(0,0);DMA_V(0,0);DMA_K(1,SLOTB);
  { float*gt=(float*)(shm+LDS_GT);
    #pragma unroll
    for(int k=0;k<2;++k){ const int j=2*wid+k; if(j<qb) gt[j*64+lane]=ksum[(long)(b*16+j)*DM+h*D+lane]; } }
  bf16x8 qr[4];
  #pragma unroll
  for(int d0=0;d0<4;++d0)qr[d0]=*reinterpret_cast<const bf16x8*>(&Qw[(long)r32*DM+d0*16+hi*8]);

  unsigned sel=0u;
  float mhat=0.f,l_reg=0.f;f32x16 o[2];o[0]=f32x16{};o[1]=f32x16{};
  bf16x8 kone=(bf16x8){0,0,0,0,0,0,0,0}, qm=(bf16x8){0,0,0,0,0,0,0,0}; if(hi==0) kone[0]=(short)0x3F80;
  #define SETQM() do{ const unsigned short mb_=(unsigned short)(cvtpk_s(-mhat,0.f)&0xffffu); qm[0]=(hi==0)?(short)mb_:(short)0; asm volatile("":"+v"(qm)); }while(0)
  const int qrel=wid*QBLK+r32;
  #define CMASK(P0,P1,t) do{ const int t_=(t); if(t_<4){ const int l_=(int)lane_now(); cmask(P0,P1,t_,wid*QBLK+(l_&31),l_>>5); } else if(!((sel>>(((t_-4)>>2)&15))&1u)){ _Pragma("unroll") for(int r=0;r<16;++r){P0[r]=-INFINITY;P1[r]=-INFINITY;} } }while(0)
  bool resc=false;
  #define START(P0,P1) do{ const float rm=rowmax(P0,P1); resc=false; \
    { const float dl=__uint_as_float(cvtpk_s(rm,0.f)<<16); mhat=fadd_s(mhat,dl);          \
      _Pragma("unroll") for(int r=0;r<16;++r){P0[r]=fsub_s(P0[r],dl);P1[r]=fsub_s(P1[r],dl);} \
      SETQM(); } \
    _Pragma("unroll") for(int r=0;r<16;++r)P0[r]=__builtin_amdgcn_exp2f(P0[r]); }while(0)
  #define RESC() do{ if(resc){ asm volatile("s_waitcnt lgkmcnt(0)":::"memory"); \
      _Pragma("unroll") for(int d_=0;d_<2;++d_) _Pragma("unroll") for(int r=0;r<16;++r)o[d_][r]*=wsf[crow(r,(int)(lane_now()>>5))]; } }while(0)
  f32x16 pA0,pA1,pB0,pB1;
  int sl_prev=0,sl_cur=0,sl_next=SLOTB;
  #define ROT() do{sl_prev=sl_cur;sl_cur=sl_next;sl_next=(sl_next==(NSLOT-1)*SLOTB)?0:sl_next+SLOTB;}while(0)
  DMA_K(2,2*SLOTB);
  WAIT_BAR(3);
  { float qf[32];
    #pragma unroll
    for(int d0=0;d0<4;++d0){
      #pragma unroll
      for(int i=0;i<8;++i) qf[d0*8+i]=__uint_as_float(((unsigned)(unsigned short)qr[d0][i])<<16); }
    const float*gt=(const float*)(shm+LDS_GT)+hi*8; float g[15];
    #pragma unroll
    for(int j=0;j<15;++j){ g[j]=-INFINITY;
      if(j<qb){ const float*kp=gt+j*64; float a=0.f;
        #pragma unroll
        for(int d0=0;d0<4;++d0){ const float4 k0=*reinterpret_cast<const float4*>(kp+d0*16), k1=*reinterpret_cast<const float4*>(kp+d0*16+4);
          a+=qf[d0*8+0]*k0.x; a+=qf[d0*8+1]*k0.y; a+=qf[d0*8+2]*k0.z; a+=qf[d0*8+3]*k0.w; a+=qf[d0*8+4]*k1.x; a+=qf[d0*8+5]*k1.y; a+=qf[d0*8+6]*k1.z; a+=qf[d0*8+7]*k1.w; }
        g[j]=a+__shfl_xor(a,32); } }
    #pragma unroll
    for(int kk=0;kk<3;++kk){ float best=-INFINITY; int bj=-1;
      #pragma unroll
      for(int j=0;j<15;++j){ const bool c=(j<qb)&&!((sel>>j)&1u)&&(g[j]>best); best=c?g[j]:best; bj=c?j:bj; }
      if(bj>=0) sel|=(1u<<bj); } }
  qkt(pA0,pA1,Kbase,qr,r32,hi);asm volatile("s_nop 15\n\ts_nop 7":"+v"(pA0),"+v"(pA1));CMASK(pA0,pA1,0);
  START(pA0,pA1);
  _Pragma("unroll") for(int r=0;r<16;++r)pA1[r]=__builtin_amdgcn_exp2f(pA1[r]);
  WAIT_BAR(0);
  DMA_K(3,0);DMA_V(1,SLOTB);
  ROT();
  kload8(kf,kp0+sl_cur);
  WAIT_BAR(2);
  s16x4 vlo[8],vhi[8]; u32x4 pw0,pw1,pw2,pw3;
  #define PKW(P,B) cvtpk_s(P[B],P[B+1])
  #define PAF(k) __builtin_bit_cast(bf16x8,pw##k)
  #define VFR(i) (bf16x8){vlo[i][0],vlo[i][1],vlo[i][2],vlo[i][3],vhi[i][0],vhi[i][1],vhi[i][2],vhi[i][3]}
  #define PIN(x) asm volatile("":"+v"(x))
  #define MX3(a,b,c) __builtin_fmaxf(__builtin_fmaxf((a),(b)),(c))
  #define GAPA(MF,A0,A1,A2,A3,W0,W1,PW) do{ MF; sacc+=A0; sacc+=A1; sacc+=A2; sacc+=A3; PIN(sacc); W0; W1; PIN(PW); SBAR(); }while(0)
  #define EX(v) __builtin_amdgcn_exp2f(v)
  #define GAPB(MF,X,B) do{ MF; X[B]=EX(X[B]); X[B+1]=EX(X[B+1]); X[B+2]=EX(X[B+2]); X[B+3]=EX(X[B+3]); PIN(X); SBAR(); }while(0)
  #define VRD(i) do{ vlo[i]=vtr(vp_+(((i)>>2)*4096+((i)&3)*1024)); vhi[i]=vtr(vp_+(((i)>>2)*4096+((i)&3)*1024+512)); }while(0)
  #define KRD(G,j) do{ if(G){ kload2(kf,kp0+sl_next,j); SBAR(); } }while(0)
  #define STEP(C0,C1,P0,P1,t,GK,GV,GL) do{ SBAR(); \
    const lds_cptr vp_=vp0+sl_prev; \
    C0=__builtin_amdgcn_mfma_f32_32x32x16_bf16(kone,qm,(f32x16){0.f,0.f,0.f,0.f,0.f,0.f,0.f,0.f,0.f,0.f,0.f,0.f,0.f,0.f,0.f,0.f},0,0,0); C1=__builtin_amdgcn_mfma_f32_32x32x16_bf16(kone,qm,(f32x16){0.f,0.f,0.f,0.f,0.f,0.f,0.f,0.f,0.f,0.f,0.f,0.f,0.f,0.f,0.f,0.f},0,0,0); SBAR(); \
    VRD(0); SBAR(); float sacc=(P0[0]+P0[1]); \
    GAPA(C0=__builtin_amdgcn_mfma_f32_32x32x16_bf16(kf[0],qr[0],C0,0,0,0), P0[2],P0[3],P0[4],P0[5],     pw0[0]=PKW(P0,0), pw0[1]=PKW(P0,2), pw0); \
    VRD(4); SBAR(); GAPA(C1=__builtin_amdgcn_mfma_f32_32x32x16_bf16(kf[1],qr[0],C1,0,0,0), P0[6],P0[7],P0[8],P0[9],     pw0[2]=PKW(P0,4), pw0[3]=PKW(P0,6), pw0); \
    VRD(1); SBAR(); GAPA(C0=__builtin_amdgcn_mfma_f32_32x32x16_bf16(kf[2],qr[1],C0,0,0,0),   P0[10],P0[11],P0[12],P0[13], pw1[0]=PKW(P0,8), pw1[1]=PKW(P0,10), pw1); \
    VRD(5); SBAR(); GAPA(C1=__builtin_amdgcn_mfma_f32_32x32x16_bf16(kf[3],qr[1],C1,0,0,0),   P0[14],P0[15],P1[0],P1[1],   pw1[2]=PKW(P0,12),pw1[3]=PKW(P0,14), pw1); \
    VRD(2); SBAR(); GAPA(C0=__builtin_amdgcn_mfma_f32_32x32x16_bf16(kf[4],qr[2],C0,0,0,0),   P1[2],P1[3],P1[4],P1[5],     pw2[0]=PKW(P1,0), pw2[1]=PKW(P1,2), pw2); \
    VRD(6); SBAR(); GAPA(C1=__builtin_amdgcn_mfma_f32_32x32x16_bf16(kf[5],qr[2],C1,0,0,0),   P1[6],P1[7],P1[8],P1[9],     pw2[2]=PKW(P1,4), pw2[3]=PKW(P1,6), pw2); \
    VRD(3); SBAR(); GAPA(C0=__builtin_amdgcn_mfma_f32_32x32x16_bf16(kf[6],qr[3],C0,0,0,0),   P1[10],P1[11],P1[12],P1[13], pw3[0]=PKW(P1,8), pw3[1]=PKW(P1,10), pw3); \
    VRD(7); SBAR(); GAPA(C1=__builtin_amdgcn_mfma_f32_32x32x16_bf16(kf[7],qr[3],C1,0,0,0),   P1[14],P1[15],0.f,0.f,       pw3[2]=PKW(P1,12),pw3[3]=PKW(P1,14), pw3); \
    l_reg+=sacc; \
    if(GK){DMA_K((t)+3,sl_cur);} if(GV){DMA_V((t)+1,sl_next);} \
    CMASK(C0,C1,t); \
    { float a=MX3(C0[0],C0[1],C1[0]),b=MX3(C0[2],C0[3],C1[1]); a=MX3(a,C1[2],C1[3]); \
      _Pragma("unroll") for(int r=4;r<16;r+=4){a=MX3(a,C0[r],C0[r+1]);b=MX3(b,C0[r+2],C0[r+3]);a=MX3(a,C1[r],C1[r+1]);b=MX3(b,C1[r+2],C1[r+3]);} \
      float rm=__builtin_fmaxf(a,b); { auto rr=__builtin_amdgcn_permlane32_swap(__float_as_uint(rm),__float_as_uint(rm),false,false); rm=__builtin_fmaxf(__uint_as_float(rr[0]),__uint_as_float(rr[1])); } \
      resc=false; \
      if(__builtin_expect(__any(rm>(float)THRL),0)){ const float mn_=__uint_as_float(cvtpk_s(mhat+__builtin_fmaxf(rm,0.f),0.f)<<16); const float dl=mn_-mhat; mhat=mn_; \
        _Pragma("unroll") for(int r=0;r<16;++r){C0[r]-=dl;C1[r]-=dl;} \
        SETQM(); \
        const float f=__builtin_amdgcn_exp2f(-dl); l_reg*=f; { const int l_=(int)lane_now(); if((l_>>5)==0)wsf[l_&31]=f; } resc=true; } } \
    SBAR(); \
    GAPB(o[0]=__builtin_amdgcn_mfma_f32_32x32x16_bf16(PAF(0),VFR(0),o[0],0,0,0), C0,0); \
    GAPB(o[1]=__builtin_amdgcn_mfma_f32_32x32x16_bf16(PAF(0),VFR(4),o[1],0,0,0), C0,4); \
    KRD(GL,0); GAPB(o[0]=__builtin_amdgcn_mfma_f32_32x32x16_bf16(PAF(1),VFR(1),o[0],0,0,0), C0,8); \
    KRD(GL,1); GAPB(o[1]=__builtin_amdgcn_mfma_f32_32x32x16_bf16(PAF(1),VFR(5),o[1],0,0,0), C0,12); \
    KRD(GL,2); GAPB(o[0]=__builtin_amdgcn_mfma_f32_32x32x16_bf16(PAF(2),VFR(2),o[0],0,0,0), C1,0); \
    KRD(GL,3); GAPB(o[1]=__builtin_amdgcn_mfma_f32_32x32x16_bf16(PAF(2),VFR(6),o[1],0,0,0), C1,4); \
    GAPB(o[0]=__builtin_amdgcn_mfma_f32_32x32x16_bf16(PAF(3),VFR(3),o[0],0,0,0), C1,8); \
    GAPB(o[1]=__builtin_amdgcn_mfma_f32_32x32x16_bf16(PAF(3),VFR(7),o[1],0,0,0), C1,12); \
    }while(0)
  int t=1;
  #undef CMASK
  #define CMASK(P0,P1,t) do{ const int t_=(t); if(t_<4){ const int l_=(int)lane_now(); cmask(P0,P1,t_,wid*QBLK+(l_&31),l_>>5); } else if(!((sel>>(((t_-4)>>2)&15))&1u)){ _Pragma("unroll") for(int r=0;r<16;++r){P0[r]=-INFINITY;P1[r]=-INFINITY;} } }while(0)
  for(;t+5<NT;t+=2){
    STEP(pB0,pB1,pA0,pA1,t,true,true,true);     WAIT_BAR(2); RESC(); ROT();
    STEP(pA0,pA1,pB0,pB1,t+1,true,true,true);   WAIT_BAR(2); RESC(); ROT();
  }
  #undef CMASK
  #define CMASK(P0,P1,t) do{ const int t_=(t); if(t_<4){ const int l_=(int)lane_now(); cmask(P0,P1,t_,wid*QBLK+(l_&31),l_>>5); } else if(!((sel>>(((t_-4)>>2)&15))&1u)){ _Pragma("unroll") for(int r=0;r<16;++r){P0[r]=-INFINITY;P1[r]=-INFINITY;} } }while(0)
  #define ENDW(tt) do{ if((tt)+3<NT){WAIT_BAR(2);} else if((tt)+2<NT){WAIT_BAR(1);} else {WAIT_BAR(0);} }while(0)
  for(;t+1<NT;t+=2){
    STEP(pB0,pB1,pA0,pA1,t,(t+3<NT),(t+1<NT),(t+1<NT));       ENDW(t);   RESC(); ROT();
    STEP(pA0,pA1,pB0,pB1,t+1,(t+4<NT),(t+2<NT),(t+2<NT));     ENDW(t+1); RESC(); ROT();
  }
  STEP(pB0,pB1,pA0,pA1,NT-1,false,false,false); RESC();
  { float sacc=pB0[0]+pB0[1]; _Pragma("unroll") for(int r=2;r<16;++r)sacc+=pB0[r]; _Pragma("unroll") for(int r=0;r<16;++r)sacc+=pB1[r]; l_reg+=sacc;
    pw0=(u32x4){PKW(pB0,0),PKW(pB0,2),PKW(pB0,4),PKW(pB0,6)};pw1=(u32x4){PKW(pB0,8),PKW(pB0,10),PKW(pB0,12),PKW(pB0,14)};pw2=(u32x4){PKW(pB1,0),PKW(pB1,2),PKW(pB1,4),PKW(pB1,6)};pw3=(u32x4){PKW(pB1,8),PKW(pB1,10),PKW(pB1,12),PKW(pB1,14)};
    SBAR(); pv(o,vb0+sl_cur,PAF(0),PAF(1),PAF(2),PAF(3)); }
  #undef PKW
  #undef PAF
  #undef VFR
  #undef PIN
  #undef MX3
  #undef GAPA
  #undef GAPB
  #undef EX
  #undef VRD
  #undef KRD
  #undef STEP
  #undef ENDW
  {auto rr=__builtin_amdgcn_permlane32_swap(__float_as_uint(l_reg),__float_as_uint(l_reg),false,false);l_reg=__uint_as_float(rr[0])+__uint_as_float(rr[1]);}
  if(hi==0)wsf[32+r32]=l_reg;asm volatile("s_waitcnt lgkmcnt(0)":::"memory");
  float rli[16];
  #pragma unroll
  for(int r=0;r<16;++r)rli[r]=__builtin_amdgcn_rcpf(wsf[32+crow(r,hi)]);
  bf16*Ow=O+(rowbase+q0+wid*QBLK)*DM+h*D;
  { bf16*stg=(bf16*)(shm+LDS_OST)+wid*2048;
    #pragma unroll
    for(int r=0;r<16;++r){const int orow=crow(r,hi);
      #pragma unroll
      for(int d0=0;d0<2;++d0)stg[orow*64+d0*32+r32]=__float2bfloat16(o[d0][r]*rli[r]);}
    asm volatile("s_waitcnt lgkmcnt(0)":::"memory");
    #pragma unroll
    for(int i=0;i<4;++i){const int row=i*8+(lane>>3),ch=lane&7; const u32x4 v=*(const u32x4*)(stg+row*64+ch*8); ATTN_STORE16(Ow+(long)row*DM+ch*8,v);} }
  asm volatile("s_waitcnt lgkmcnt(0)\n\ts_barrier":::"memory");
  #undef DMA_K
  #undef PHYS
  #undef DMA_V
  #undef CMASK
  #undef START
  #undef SETQM
  #undef RESC
  #undef ROT
}
constexpr int ATTN_LDS_BYTES=LDS_BYTES;
struct AttnTensors { const bf16* Q; const bf16* K; const bf16* V; bf16* O; const float* ksum; };
struct AttnUnit { int bh; int qb; };
struct StaticOrder {
  int vcu, G;
  __device__ __forceinline__ explicit StaticOrder(int grid,int block):vcu((grid%8==0)?((block%8)*(grid/8)+block/8):block),G(grid){}
  __device__ __forceinline__ bool next(int i,AttnUnit&u)const{ const int L=i*G+vcu; if(L>=1024)return false; const int w=L&255, rnd=L>>8, s=w&3; u.bh=w>>2; u.qb=(rnd==0)?s:(rnd==1)?7-s:(rnd==2)?8+s:15-s; return true; }
  __device__ __forceinline__ void a_ready(const AttnUnit&)const{}
  __device__ __forceinline__ void done(const AttnUnit&)const{}
};
struct SnakeOrder {
  int v, G;
  __device__ __forceinline__ bool next(int i,AttnUnit&u)const{ const int idx=i*G+((i&1)?(G-1-v):v); if(idx>=1024)return false; u.qb=15-(idx>>6); u.bh=idx&63; return true; }
  __device__ __forceinline__ void a_ready(const AttnUnit&)const{}
  __device__ __forceinline__ void done(const AttnUnit&)const{}
};
template<class Sched,int THRL=8> __device__ __forceinline__ void attn_phase(char*lds,const AttnTensors&T,const Sched&S){
  AttnUnit u;
  for(int i=0;S.next(i,u);++i){ S.a_ready(u); attn_unit<THRL>(u.bh/NHEAD,u.bh%NHEAD,u.qb,T.Q,T.K,T.V,T.O,T.ksum,lds); S.done(u); }
}
#undef SBAR
#undef WAIT_BAR
}
constexpr int NWAVES = 8, NTHR = 512;
constexpr int NTOK = 16384, DM = 1024, SEQ = 4096, NBATCH = 4, NEXP = 32;
constexpr float ALPHA = 1.4142135623730951f;
constexpr float LN_EPS = 1e-5f;
constexpr float RSQRT_DQK = 0.08838834764831845f;
constexpr int NPHASE = 19;
constexpr float FP8_SA = 4.0f, FP8_SWGU = 64.0f, FP8_SWD = 128.0f;
#ifndef DBG_ATTN_MUL
#define DBG_ATTN_MUL 1.0f
#endif
#ifndef DBG_MLSTM_MUL
#define DBG_MLSTM_MUL 1.0f
#endif
#ifndef DBG_MOE_MUL
#define DBG_MOE_MUL 1.0f
#endif
#ifndef DBG_P14_A
#define DBG_P14_A WS_HN
#endif
#ifndef NCONV
#define NCONV 64
#endif
#ifndef MK_ONE_LAUNCH
#define MK_ONE_LAUNCH 1
#endif

constexpr size_t MiB = 1u << 20, KiB = 1024;
constexpr size_t WS_CTL = 0, CTL_ZERO_BYTES = 1 * MiB;
constexpr int CW_TMO = 0, CW_BAR = 4096, CW_CNT = 8192, CW_AQ = 16384;
constexpr size_t WS_KSUM = 256 * KiB, WS_DEN = 512 * KiB;
constexpr size_t WS_WQKV = 2 * MiB, WS_WO = 8 * MiB, WS_WINA = 10 * MiB, WS_WINB = 14 * MiB, WS_WOUT = 17 * MiB;
constexpr size_t WS_WG = 19 * MiB, WS_RWT = 20 * MiB, WS_ROPE = 21 * MiB;
constexpr size_t WS_TOKE = 22 * MiB, WS_TOKP = 22 * MiB + 256 * KiB, WS_TOKG = 22 * MiB + 512 * KiB;
constexpr size_t WS_GI = 23 * MiB, WS_LF = 23 * MiB + 256 * KiB, WS_RF = 23 * MiB + 512 * KiB, WS_CF = 23 * MiB + 768 * KiB;
constexpr size_t WS_DEC = 24 * MiB, WS_NU = 24 * MiB + 256 * KiB, WS_NPREV = 24 * MiB + 512 * KiB;
constexpr size_t WS_ROWTOK = 25 * MiB;
constexpr size_t WS_XB = 32 * MiB, WS_Q = 64 * MiB, WS_K = 96 * MiB, WS_V = 128 * MiB;
constexpr size_t WS_R0 = 160 * MiB, WS_R1 = 224 * MiB, WS_R2 = 288 * MiB;
constexpr size_t WS_H = 352 * MiB, WS_Y = 496 * MiB;
constexpr size_t WS_WGU = 640 * MiB, WS_WD = 896 * MiB, WS_END = 1024 * MiB;
constexpr size_t WS_AE = 352 * MiB, WS_BE = 416 * MiB, WS_KN = 464 * MiB, WS_KT = 496 * MiB, WS_UT = 512 * MiB, WS_OS = 544 * MiB, WS_HN = 576 * MiB;

constexpr int RING_OFF = 0, RING_BYTES = 131072;
constexpr int LX = RING_BYTES;
constexpr int LX_MISC = LX;
constexpr int LX_TILEE = LX + 128;
constexpr int LX_TBASE = LX + 1280;
constexpr int LX_LCNT = LX + 1536, LX_GBASE = LX + 1664;
constexpr int LX_REC = LX + 1792;
constexpr int LX_TOKL = LX + 4096;
constexpr int LX_LNX = LX + 4096;
constexpr int LX_BIAS = LX + 12288;
constexpr int LDS_BYTES = 147456;
constexpr int TOKL_ROUNDS = 10;

#define RLX_AGENT __ATOMIC_RELAXED, __HIP_MEMORY_SCOPE_AGENT
#define LDS_WAIT() asm volatile("s_waitcnt lgkmcnt(0)" ::: "memory")
#define VM_WAIT() asm volatile("s_waitcnt vmcnt(0)" ::: "memory")
#define XB_TMO      128
#define XB_XCNT(j)  (256  + 64 * (j))
#define XB_XSUB(j)  (1280 + 64 * (j))
#define XB_XGEN(j)  (2304 + 64 * (j))
#define XB_TOP      3328
#define XB_TOPGEN   3392
#define XCD_BAR_WORDS 3456
#define XB_SPIN_CAP (1u << 18)

__device__ __forceinline__ unsigned xb_ld(unsigned* p)              { return __hip_atomic_load(p, __ATOMIC_RELAXED, __HIP_MEMORY_SCOPE_AGENT); }
__device__ __forceinline__ unsigned xb_add(unsigned* p, unsigned v) { return __hip_atomic_fetch_add(p, v, __ATOMIC_RELAXED, __HIP_MEMORY_SCOPE_AGENT); }
__device__ __forceinline__ unsigned xb_xcc_id() { return (unsigned)__builtin_amdgcn_s_getreg((3 << 11) | 20) & 0xFu; }
#define XB_SPIN(cond, bar) do { unsigned _sp = 0; while (cond) { __builtin_amdgcn_s_sleep(1); \
    if ((++_sp & 255u) == 0u) { if (xb_ld(&(bar)[XB_TMO])) break; if (_sp > XB_SPIN_CAP) { atomicAdd(&(bar)[XB_TMO], 1u); break; } } } } while (0)

struct XcdBarrier {
    unsigned* bar; unsigned x;
    volatile LAS unsigned* st;
};

__device__ __forceinline__ XcdBarrier xcd_barrier_post(unsigned* bar, volatile LAS unsigned* st) {
    XcdBarrier b; b.bar = bar; b.x = xb_xcc_id(); b.st = st;
    if (threadIdx.x == 0) (void)xb_add(&bar[XB_XCNT(b.x)], 1u);
    return b;
}
__device__ __forceinline__ void xcd_barrier_complete(unsigned* bar, unsigned x, unsigned& nloc, unsigned& nx) {
    const unsigned G = gridDim.x * gridDim.y * gridDim.z;
    unsigned sum, cnt, mine, sp = 0u;
    for (;;) {
        sum = 0u; cnt = 0u; mine = 0u;
#pragma unroll
        for (unsigned j = 0; j < 16; ++j) { const unsigned c = xb_ld(&bar[XB_XCNT(j)]); sum += c; cnt += (c > 0u) ? 1u : 0u; mine = (j == x) ? c : mine; }
        if (sum == G) break;
        __builtin_amdgcn_s_sleep(1);
        if ((++sp & 255u) == 0u) { if (xb_ld(&bar[XB_TMO])) break; if (sp > XB_SPIN_CAP) { atomicAdd(&bar[XB_TMO], 1u); break; } }
    }
    nloc = mine > 0u ? mine : 1u; nx = cnt > 0u ? cnt : 1u;
}

__device__ __forceinline__ void xcd_barrier(const XcdBarrier& b) {
    asm volatile("s_waitcnt vmcnt(0)" ::: "memory");
    __syncthreads();
    if (threadIdx.x == 0) {
        unsigned* bar = b.bar;
        __builtin_amdgcn_s_waitcnt(0);
        unsigned nloc = b.st[0], nx = b.st[1];
        if (nloc == 0u) { xcd_barrier_complete(bar, b.x, nloc, nx); b.st[0] = nloc; b.st[1] = nx; }
        const unsigned old = xb_add(&bar[XB_XSUB(b.x)], 1u);
        const unsigned gen = old / nloc;
        if (old + 1u == (gen + 1u) * nloc) {
            __builtin_amdgcn_fence(__ATOMIC_RELEASE, "agent");
            asm volatile("s_waitcnt vmcnt(0)" ::: "memory");
            const unsigned og = xb_add(&bar[XB_TOP], 1u);
            const unsigned tg = og / nx;
            if (og + 1u == (tg + 1u) * nx) xb_add(&bar[XB_TOPGEN], 1u);
            else XB_SPIN(xb_ld(&bar[XB_TOPGEN]) == tg, bar);
            __builtin_amdgcn_fence(__ATOMIC_ACQUIRE, "agent");
            xb_add(&bar[XB_XGEN(b.x)], 1u);
            asm volatile("s_waitcnt vmcnt(0)" ::: "memory");
        } else {
            XB_SPIN(xb_ld(&bar[XB_XGEN(b.x)]) == gen, bar);
            __builtin_amdgcn_fence(__ATOMIC_ACQUIRE, "agent");
            asm volatile("s_waitcnt vmcnt(0)" ::: "memory");
        }
    }
    __syncthreads();
}
using pg8::Unit; using pg8::Gemm;
typedef f32x4 (&AccRef)[2][2][4][2];

__device__ __forceinline__ bool moe_unit(int i, int G, int c, int nT, int nN, int& pm, int& pn, int& half) {
    const int U = nT * nN, R = U / G, rem = U - R * G; half = 0;
    if (i < R) return pg8::tile_order(i, G, c, nT, nN, pm, pn);
    if (i > R || rem == 0) return false;
    if (2 * rem <= G) { if (c >= 2 * rem) return false; half = 1 + (c & 1); return pg8::tile_order(0, U, R * G + (c >> 1), nT, nN, pm, pn); }
    return pg8::tile_order(i, G, c, nT, nN, pm, pn);
}
struct DenseSched {
    int nM, nN, G, c; const char* A; const char* B; size_t tstepA, tstepB; bool split = false;
    __device__ __forceinline__ bool next(int i, Unit& u) const {
        int half = 0;
        if (split) { if (!moe_unit(i, G, c, nM, nN, u.pm, u.pn, half)) return false; }
        else if (!pg8::tile_order(i, G, c, nM, nN, u.pm, u.pn)) return false;
        u.A = A + (size_t)u.pm * tstepA; u.B = B + (size_t)u.pn * tstepB; u.tl = nullptr; u.x0 = u.x1 = 0; u.x2 = half; return true; }
};
struct MoeSched {
    int nT, nN, G, c; const LAS int* tile_e; const LAS int* tbase; const LAS unsigned short* tokl;
    const char* A; const char* B; size_t tstepA, estepB, tstepB;
    __device__ __forceinline__ bool next(int i, Unit& u) const {
        int half; if (!moe_unit(i, G, c, nT, nN, u.pm, u.pn, half)) return false;
        const int e = tile_e[u.pm];
        u.x0 = e; u.x1 = u.pm * 256; u.x2 = half;
        u.A = A + (size_t)u.pm * tstepA; u.B = B + (size_t)e * estepB + (size_t)u.pn * tstepB;
        u.tl = tokl ? tokl + (i < TOKL_ROUNDS ? i : TOKL_ROUNDS - 1) * 256 : nullptr; return true; }
};
struct MuSched {
    int G, c, mode; const char* A; const char* B;
    __device__ __forceinline__ bool next(int i, Unit& u) const {
        const int mu = i * G + c; if (mu >= 256) return false;
        const int b = mu >> 6, hh = (mu >> 4) & 3, ch = mu & 15; const size_t tok0 = (size_t)b * SEQ + (size_t)ch * 256;
        u.pm = mu; u.pn = 0; u.x0 = mu; u.x1 = u.x2 = 0; u.tl = nullptr;
        if (mode == 0) { u.A = A + (size_t)mu * 256 * 384 * 2; u.B = B + ((size_t)(hh * 128) * NTOK + tok0) * 2; }
        else if (mode == 1) { u.A = A + ((size_t)mu * 256 * 512 + 256) * 2; u.B = B + (tok0 * 1024 + (size_t)hh * 256) * 2; }
        else { u.A = A + (size_t)mu * 256 * 512 * 2; u.B = B + (size_t)mu * 256 * 384 * 2; }
        return true; }
};

constexpr float C2 = 0.125f * 1.4426950408889634f;

struct EpiQKV {
    static constexpr bool PERM = true;
    __device__ __forceinline__ void prep(const Unit&, int, int, int) const {}
    bf16_t* Q; bf16_t* K; bf16_t* V; const float* rope; float* ksum;
    __device__ __forceinline__ void operator()(AccRef acc, const Unit& u, int wr, int wc, int fr, int fq) const {
        asm volatile("" : "+v"(fr), "+v"(fq));
        const int part = u.pn >> 2, colt = (u.pn & 3) * 256;
        bf16_t* base = Q + (size_t)part * ((WS_K - WS_Q) / 2);
        const bool rot = (part < 2) && ((wc & 1) == 0);
        const float sgn = (fq == 0) ? -1.f : 1.f;
        float ks[2][8];
#pragma unroll
        for (int bj = 0; bj < 2; ++bj)
#pragma unroll
            for (int j = 0; j < 8; ++j) ks[bj][j] = 0.f;
#pragma unroll
        for (int ai = 0; ai < 2; ++ai)
#pragma unroll
            for (int m = 0; m < 4; ++m) {
                const int row = u.pm * 256 + ai * 128 + wr * 64 + m * 16 + fr;
                f32x4 cs0 = {1.f, 1.f, 1.f, 1.f}, cs1 = cs0, sn0 = {0.f, 0.f, 0.f, 0.f}, sn1 = sn0;
                if (rot) { const f32x4* rp = (const f32x4*)(rope + (size_t)row * 16); cs0 = rp[0]; cs1 = rp[1]; sn0 = rp[2]; sn1 = rp[3]; }
#pragma unroll
                for (int bj = 0; bj < 2; ++bj) {
                    f32x4 v0 = acc[ai][bj][m][0], v1 = acc[ai][bj][m][1];
                    if (rot) {
                        f32x4 p0, p1;
#pragma unroll
                        for (int j = 0; j < 4; ++j) { p0[j] = __shfl_xor(v0[j], 16); p1[j] = __shfl_xor(v1[j], 16); }
                        if (fq < 2) { v0 = v0 * cs0 + p0 * sn0 * sgn; v1 = v1 * cs1 + p1 * sn1 * sgn; }
                    }
                    if (part == 0) { v0 = v0 * C2; v1 = v1 * C2; }
                    if (part == 1) {
#pragma unroll
                        for (int j = 0; j < 4; ++j) { ks[bj][j] += v0[j]; ks[bj][4 + j] += v1[j]; } }
                    u32x4 w; w.x = cvt_pk_bf16(v0[0], v0[1]); w.y = cvt_pk_bf16(v0[2], v0[3]); w.z = cvt_pk_bf16(v1[0], v1[1]); w.w = cvt_pk_bf16(v1[2], v1[3]);
                    *(u32x4*)(base + (size_t)row * DM + colt + bj * 128 + wc * 32 + fq * 8) = w;
                }
            }
        if (part == 1) {
#pragma unroll
            for (int bj = 0; bj < 2; ++bj)
#pragma unroll
                for (int j = 0; j < 8; ++j) { float s = ks[bj][j]; s += __shfl_xor(s, 1); s += __shfl_xor(s, 2); s += __shfl_xor(s, 4); s += __shfl_xor(s, 8);
                    if (fr == 0) atomicAdd(ksum + (size_t)u.pm * DM + colt + bj * 128 + wc * 32 + fq * 8 + j, s); }
        }
    }
};

struct EpiZ {
    static constexpr bool PERM = false;
    __device__ __forceinline__ void prep(const Unit&, int, int, int) const {}
    const float* xin; float* z; float ymul;
    __device__ __forceinline__ void operator()(AccRef acc, const Unit& u, int wr, int wc, int fr, int fq) const {
        asm volatile("" : "+v"(fr), "+v"(fq));
#pragma unroll
        for (int ai = 0; ai < 2; ++ai) {
            const size_t off0 = (size_t)(u.pm * 256 + ai * 128 + wr * 64 + fr) * DM + u.pn * 256 + wc * 32 + fq * 4;
            f32x4 xr[4][2][2];
#pragma unroll
            for (int m = 0; m < 4; ++m)
#pragma unroll
                for (int bj = 0; bj < 2; ++bj)
#pragma unroll
                    for (int n = 0; n < 2; ++n) xr[m][bj][n] = *(const f32x4*)(xin + off0 + (size_t)m * 16 * DM + bj * 128 + n * 16);
#pragma unroll
            for (int m = 0; m < 4; ++m)
#pragma unroll
                for (int bj = 0; bj < 2; ++bj)
#pragma unroll
                    for (int n = 0; n < 2; ++n) *(f32x4*)(z + off0 + (size_t)m * 16 * DM + bj * 128 + n * 16) = xr[m][bj][n] * ALPHA + acc[ai][bj][m][n] * ymul;
            asm volatile("" ::: "memory");
        }
    }
};

__device__ __forceinline__ float swiglu1(float glu, float lin) {
    const float g = fminf(glu, 7.0f), l = fminf(fmaxf(lin, -7.0f), 7.0f);
    const float sg = __builtin_amdgcn_rcpf(1.0f + __builtin_amdgcn_exp2f(-1.702f * 1.4426950408889634f * g));
    return g * sg * (l + 1.0f);
}
struct EpiGU {
    static constexpr bool PERM = true;
    __device__ __forceinline__ void prep(const Unit& u, int ui, int wid, int lane) const { if (wid < 4) glds4s(uni_ptr((const char*)(bias + (size_t)u.x0 * 2048 + u.pn * 256 + wid * 64)), (unsigned)lane * 4u, (unsigned)__builtin_amdgcn_readfirstlane((unsigned)(unsigned long long)bl + (unsigned)(((ui & 1) * 256 + wid * 64) * 4))); }
    const float* bias; unsigned char* H; LAS float* bl; mutable int ucnt;
    __device__ __forceinline__ void operator()(AccRef acc, const Unit& u, int wr, int wc, int fr, int fq) const {
        asm volatile("" : "+v"(fr), "+v"(fq));
        const int c0 = u.pn * 256 + wc * 32 + fq * 8; const LAS float* bp = bl + (ucnt & 1) * 256 + wc * 32 + fq * 8; ++ucnt; constexpr float SC = 1.0f / (FP8_SA * FP8_SWGU);
        f32x4 b[2][2];
#pragma unroll
        for (int bj = 0; bj < 2; ++bj) { b[bj][0] = *(const LAS f32x4*)(bp + bj * 128); b[bj][1] = *(const LAS f32x4*)(bp + bj * 128 + 4); }
#pragma unroll
        for (int ai = 0; ai < 2; ++ai)
#pragma unroll
            for (int m = 0; m < 4; ++m) {
                unsigned char* rowp = H + (size_t)(u.x1 + ai * 128 + wr * 64 + m * 16 + fr) * DM + (c0 >> 1);
#pragma unroll
                for (int bj = 0; bj < 2; ++bj) { if (u.x2 == 2 - bj) continue;
                    const f32x4 v0 = acc[ai][bj][m][0] * SC + b[bj][0], v1 = acc[ai][bj][m][1] * SC + b[bj][1];
                    int w = __builtin_amdgcn_cvt_pk_fp8_f32(swiglu1(v0[0], v0[1]) * FP8_SA, swiglu1(v0[2], v0[3]) * FP8_SA, 0, false);
                    w = __builtin_amdgcn_cvt_pk_fp8_f32(swiglu1(v1[0], v1[1]) * FP8_SA, swiglu1(v1[2], v1[3]) * FP8_SA, w, true);
                    *(int*)(rowp + bj * 64) = w; }
            }
    }
};
struct EpiDN {
    static constexpr bool PERM = true;
    __device__ __forceinline__ void prep(const Unit& u, int ui, int wid, int lane) const { if (wid < 4) glds4s(uni_ptr((const char*)(bias + (size_t)u.x0 * 1024 + u.pn * 256 + wid * 64)), (unsigned)lane * 4u, (unsigned)__builtin_amdgcn_readfirstlane((unsigned)(unsigned long long)bl + (unsigned)(((ui & 1) * 256 + wid * 64) * 4))); }
    const float* bias; bf16_t* Y; LAS float* bl; mutable int ucnt;
    __device__ __forceinline__ void operator()(AccRef acc, const Unit& u, int wr, int wc, int fr, int fq) const {
        asm volatile("" : "+v"(fr), "+v"(fq));
        const int c0 = u.pn * 256 + wc * 32 + fq * 8; const LAS float* bp = bl + (ucnt & 1) * 256 + wc * 32 + fq * 8; ++ucnt; constexpr float SC = 1.0f / (FP8_SA * FP8_SWD);
        f32x4 b[2][2];
#pragma unroll
        for (int bj = 0; bj < 2; ++bj) { b[bj][0] = *(const LAS f32x4*)(bp + bj * 128); b[bj][1] = *(const LAS f32x4*)(bp + bj * 128 + 4); }
#pragma unroll
        for (int ai = 0; ai < 2; ++ai)
#pragma unroll
            for (int m = 0; m < 4; ++m) {
                bf16_t* rowp = Y + (size_t)(u.x1 + ai * 128 + wr * 64 + m * 16 + fr) * DM + c0;
#pragma unroll
                for (int bj = 0; bj < 2; ++bj) { if (u.x2 == 2 - bj) continue;
                    const f32x4 v0 = acc[ai][bj][m][0] * SC + b[bj][0], v1 = acc[ai][bj][m][1] * SC + b[bj][1];
                    u32x4 w; w.x = cvt_pk_bf16(v0[0], v0[1]); w.y = cvt_pk_bf16(v0[2], v0[3]); w.z = cvt_pk_bf16(v1[0], v1[1]); w.w = cvt_pk_bf16(v1[2], v1[3]);
                    *(u32x4*)(rowp + bj * 128) = w; }
            }
    }
};

struct EpiINA {
    static constexpr bool PERM = true;
    __device__ __forceinline__ void prep(const Unit&, int, int, int) const {}
    const float* rf; const float* cf; bf16_t* AE; bf16_t* KN; bf16_t* OS;
    __device__ __forceinline__ void operator()(AccRef acc, const Unit& u, int wr, int wc, int fr, int fq) const {
        asm volatile("" : "+v"(fr), "+v"(fq));
        const int b = u.pm >> 4, ch = u.pm & 15, d0 = wc * 32 + fq * 8; const u32x4 zero = {0u, 0u, 0u, 0u};
        if (u.pn < 4) {
            const bool isq = u.pn < 2; const float* fac = isq ? rf : cf; const float fs = isq ? 1.0f : RSQRT_DQK; const int h0 = (u.pn & 1) * 2;
            float sf[2][4][2];
#pragma unroll
            for (int ai = 0; ai < 2; ++ai)
#pragma unroll
                for (int m = 0; m < 4; ++m)
#pragma unroll
                    for (int bj = 0; bj < 2; ++bj) sf[ai][m][bj] = fac[(size_t)(h0 + bj) * NTOK + (size_t)u.pm * 256 + ai * 128 + wr * 64 + m * 16 + fr];
#pragma unroll
            for (int ai = 0; ai < 2; ++ai)
#pragma unroll
                for (int m = 0; m < 4; ++m) {
                    const int t = ai * 128 + wr * 64 + m * 16 + fr; const size_t token = (size_t)u.pm * 256 + t;
#pragma unroll
                    for (int bj = 0; bj < 2; ++bj) { const int hh = h0 + bj; const float s = sf[ai][m][bj] * fs;
                        const f32x4 v0 = acc[ai][bj][m][0] * s, v1 = acc[ai][bj][m][1] * s;
                        const size_t oq = ((size_t)(((b * 4 + hh) * 16 + ch) * 256 + t)) * 512 + 256 + d0, ok = token * 1024 + hh * 256 + d0;
                        bf16_t* dst = isq ? (AE + oq) : (KN + ok);
                        u32x4 w; w.x = cvt_pk_bf16(v0[0], v0[1]); w.y = cvt_pk_bf16(v0[2], v0[3]); w.z = cvt_pk_bf16(v1[0], v1[1]); w.w = cvt_pk_bf16(v1[2], v1[3]);
                        *(u32x4*)dst = w; *(u32x4*)(dst + 128) = zero; }
                }
        } else {
#pragma unroll
            for (int ai = 0; ai < 2; ++ai)
#pragma unroll
                for (int m = 0; m < 4; ++m) {
                    const int t = ai * 128 + wr * 64 + m * 16 + fr; const size_t token = (size_t)u.pm * 256 + t;
#pragma unroll
                    for (int bj = 0; bj < 2; ++bj) { f32x4 v0 = acc[ai][bj][m][0], v1 = acc[ai][bj][m][1];
#pragma unroll
                        for (int j = 0; j < 4; ++j) { v0[j] = __builtin_amdgcn_rcpf(1.0f + __builtin_amdgcn_exp2f(-1.4426950408889634f * v0[j])); v1[j] = __builtin_amdgcn_rcpf(1.0f + __builtin_amdgcn_exp2f(-1.4426950408889634f * v1[j])); }
                        u32x4 w; w.x = cvt_pk_bf16(v0[0], v0[1]); w.y = cvt_pk_bf16(v0[2], v0[3]); w.z = cvt_pk_bf16(v1[0], v1[1]); w.w = cvt_pk_bf16(v1[2], v1[3]);
                        *(u32x4*)(OS + token * 1024 + (u.pn - 4) * 256 + bj * 128 + d0) = w; }
                }
        }
    }
};
struct EpiINB {
    static constexpr bool PERM = true;
    __device__ __forceinline__ void prep(const Unit&, int, int, int) const {}
    const float* cf; bf16_t* KT; bf16_t* BE;
    __device__ __forceinline__ void operator()(AccRef acc, const Unit& u, int wr, int wc, int fr, int fq) const {
        asm volatile("" : "+v"(fr), "+v"(fq));
        const int b = u.pn >> 4, ch = u.pn & 15;
        f32x4 cv[2][2][2];
#pragma unroll
        for (int ai = 0; ai < 2; ++ai)
#pragma unroll
            for (int bj = 0; bj < 2; ++bj) { const size_t tok0 = (size_t)u.pn * 256 + bj * 128 + wc * 32 + fq * 8;
                if (u.pm < 2) { const int hh = u.pm * 2 + ai; cv[ai][bj][0] = *(const f32x4*)(cf + (size_t)hh * NTOK + tok0) * RSQRT_DQK; cv[ai][bj][1] = *(const f32x4*)(cf + (size_t)hh * NTOK + tok0 + 4) * RSQRT_DQK; }
                else { cv[ai][bj][0] = (f32x4){1.f, 1.f, 1.f, 1.f}; cv[ai][bj][1] = cv[ai][bj][0]; } }
#pragma unroll
        for (int ai = 0; ai < 2; ++ai)
#pragma unroll
            for (int m = 0; m < 4; ++m) {
                const int R = u.pm * 256 + ai * 128 + wr * 64 + m * 16 + fr;
#pragma unroll
                for (int bj = 0; bj < 2; ++bj) { if (u.x2 == 2 - bj) continue;
                    const f32x4 v0 = acc[ai][bj][m][0] * cv[ai][bj][0], v1 = acc[ai][bj][m][1] * cv[ai][bj][1]; const int s0 = bj * 128 + wc * 32 + fq * 8; const size_t tok0 = (size_t)u.pn * 256 + s0; bf16_t* dst;
                    if (u.pm < 2) dst = KT + (size_t)R * NTOK + tok0;
                    else { const int eg = R - 512, hh = eg >> 8, e = eg & 255; dst = BE + ((size_t)(((b * 4 + hh) * 16 + ch) * 256 + e)) * 384 + s0; }
                    u32x4 w; w.x = cvt_pk_bf16(v0[0], v0[1]); w.y = cvt_pk_bf16(v0[2], v0[3]); w.z = cvt_pk_bf16(v1[0], v1[1]); w.w = cvt_pk_bf16(v1[2], v1[3]);
                    *(u32x4*)dst = w;
                }
            }
    }
};
struct EpiM1 {
    static constexpr bool PERM = false;
    __device__ __forceinline__ void prep(const Unit&, int, int, int) const {}
    float* UT;
    __device__ __forceinline__ void operator()(AccRef acc, const Unit& u, int wr, int wc, int fr, int fq) const {
        asm volatile("" : "+v"(fr), "+v"(fq));
#pragma unroll
        for (int ai = 0; ai < 2; ++ai)
#pragma unroll
            for (int m = 0; m < 4; ++m) { float* rowp = UT + ((size_t)u.x0 * 256 + ai * 128 + wr * 64 + m * 16 + fr) * 128 + wc * 32 + fq * 4;
#pragma unroll
                for (int n = 0; n < 2; ++n) *(f32x4*)(rowp + n * 16) = acc[ai][0][m][n]; }
    }
};
struct EpiM2A {
    static constexpr bool PERM = true;
    __device__ __forceinline__ void prep(const Unit&, int, int, int) const {}
    bf16_t* AE; const float* nprev; float* den;
    __device__ __forceinline__ void operator()(AccRef acc, const Unit& u, int wr, int wc, int fr, int fq) const {
        asm volatile("" : "+v"(fr), "+v"(fq));
        const int mu = u.x0, dd = wc * 32 + fq * 8;
        const f32x4 n0 = *(const f32x4*)(nprev + (size_t)mu * 128 + dd), n1 = *(const f32x4*)(nprev + (size_t)mu * 128 + dd + 4);
        u32x4 qv8[2][4];
#pragma unroll
        for (int ai = 0; ai < 2; ++ai)
#pragma unroll
            for (int m = 0; m < 4; ++m) qv8[ai][m] = *(const u32x4*)(AE + ((size_t)mu * 256 + ai * 128 + wr * 64 + m * 16 + fr) * 512 + 256 + dd);
#pragma unroll
        for (int ai = 0; ai < 2; ++ai)
#pragma unroll
            for (int m = 0; m < 4; ++m) {
                const int t = ai * 128 + wr * 64 + m * 16 + fr; bf16_t* rowp = AE + ((size_t)mu * 256 + t) * 512;
                const u32x4 qv = qv8[ai][m];
                float part = bflo(qv.x) * n0[0] + bfhi(qv.x) * n0[1] + bflo(qv.y) * n0[2] + bfhi(qv.y) * n0[3] + bflo(qv.z) * n1[0] + bfhi(qv.z) * n1[1] + bflo(qv.w) * n1[2] + bfhi(qv.w) * n1[3];
#pragma unroll
                for (int bj = 0; bj < 2; ++bj) { const int s0 = bj * 128 + wc * 32 + fq * 8; f32x4 v0 = acc[ai][bj][m][0], v1 = acc[ai][bj][m][1];
                    int dts = t - s0; asm volatile("" : "+v"(dts));
#pragma unroll
                    for (int j = 0; j < 4; ++j) { v0[j] = (j <= dts) ? v0[j] : 0.f; v1[j] = (4 + j <= dts) ? v1[j] : 0.f; part += v0[j] + v1[j]; }
                    u32x4 w; w.x = cvt_pk_bf16(v0[0], v0[1]); w.y = cvt_pk_bf16(v0[2], v0[3]); w.z = cvt_pk_bf16(v1[0], v1[1]); w.w = cvt_pk_bf16(v1[2], v1[3]);
                    *(u32x4*)(rowp + s0) = w; }
                part += __shfl_xor(part, 16); part += __shfl_xor(part, 32);
                if (fq == 0) atomicAdd(den + (size_t)mu * 256 + (wr * 64 + fr) + (ai * 128 + m * 16), part);
            }
    }
};
struct EpiM2B {
    static constexpr bool PERM = true;
    __device__ __forceinline__ void prep(const Unit&, int, int, int) const {}
    const float* den; const float* normg; const bf16_t* OS; bf16_t* HN; LAS float* lnx;
    __device__ __forceinline__ void operator()(AccRef acc, const Unit& u, int wr, int wc, int fr, int fq) const {
        asm volatile("" : "+v"(fr), "+v"(fq));
        const int mu = u.x0, b = mu >> 6, hh = (mu >> 4) & 3, ch = mu & 15;
        float dnv[2][4];
#pragma unroll
        for (int ai = 0; ai < 2; ++ai)
#pragma unroll
            for (int m = 0; m < 4; ++m) dnv[ai][m] = den[(size_t)mu * 256 + ai * 128 + wr * 64 + m * 16 + fr];
#pragma unroll
        for (int ai = 0; ai < 2; ++ai)
#pragma unroll
            for (int m = 0; m < 4; ++m) {
                const int t = ai * 128 + wr * 64 + m * 16 + fr; const float dn = dnv[ai][m];
#ifdef DBG_DEN1
                const float inv = 1.0f;
#else
                const float inv = 1.0f / fmaxf(fabsf(dn), 1.0f);
#endif
                float s1 = 0.f, s2 = 0.f;
#pragma unroll
                for (int bj = 0; bj < 2; ++bj)
#pragma unroll
                    for (int n = 0; n < 2; ++n) { f32x4 h = acc[ai][bj][m][n] * inv; acc[ai][bj][m][n] = h; s1 += (h[0] + h[1]) + (h[2] + h[3]); s2 += (h[0] * h[0] + h[1] * h[1]) + (h[2] * h[2] + h[3] * h[3]); }
                s1 += __shfl_xor(s1, 16); s1 += __shfl_xor(s1, 32); s2 += __shfl_xor(s2, 16); s2 += __shfl_xor(s2, 32);
                if (fq == 0) { lnx[(t * 4 + wc) * 2] = s1; lnx[(t * 4 + wc) * 2 + 1] = s2; }
            }
        const int e0 = wc * 32 + fq * 8;
        f32x4 gg[2][2];
#pragma unroll
        for (int bj = 0; bj < 2; ++bj) { gg[bj][0] = *(const f32x4*)(normg + hh * 256 + bj * 128 + e0); gg[bj][1] = *(const f32x4*)(normg + hh * 256 + bj * 128 + e0 + 4); }
        asm volatile("s_waitcnt lgkmcnt(0)" ::: "memory"); __builtin_amdgcn_s_barrier(); asm volatile("" ::: "memory");
#pragma unroll
        for (int ai = 0; ai < 2; ++ai) {
            u32x4 ovv[4][2];
#pragma unroll
            for (int m = 0; m < 4; ++m)
#pragma unroll
                for (int bj = 0; bj < 2; ++bj) ovv[m][bj] = *(const u32x4*)(OS + (((size_t)(b * 16 + ch)) * 256 + ai * 128 + wr * 64 + m * 16 + fr) * 1024 + hh * 256 + bj * 128 + e0);
#pragma unroll
            for (int m = 0; m < 4; ++m) {
                const int t = ai * 128 + wr * 64 + m * 16 + fr; const size_t token = ((size_t)(b * 16 + ch)) * 256 + t;
                const LAS f32x4* lp = (const LAS f32x4*)(lnx + t * 8); const f32x4 a = lp[0], c = lp[1];
                const float mean = (a[0] + a[2] + c[0] + c[2]) * (1.0f / 256.0f); const float ex2 = (a[1] + a[3] + c[1] + c[3]) * (1.0f / 256.0f);
                const float rstd = 1.0f / sqrtf(fmaxf(ex2 - mean * mean, 0.f) + LN_EPS);
#pragma unroll
                for (int bj = 0; bj < 2; ++bj) { const int e = bj * 128 + e0; const size_t off = token * 1024 + hh * 256 + e; const u32x4 ov = ovv[m][bj];
#ifdef DBG_HN_OS
                    f32x4 v0 = {1.f, 1.f, 1.f, 1.f}, v1 = v0;
#elif defined(DBG_HN_RAW)
                    f32x4 v0 = acc[ai][bj][m][0], v1 = acc[ai][bj][m][1];
#else
                    f32x4 v0 = (acc[ai][bj][m][0] - mean) * rstd * gg[bj][0], v1 = (acc[ai][bj][m][1] - mean) * rstd * gg[bj][1];
#endif
#ifndef DBG_HN_ONE
                    v0[0] *= bflo(ov.x); v0[1] *= bfhi(ov.x); v0[2] *= bflo(ov.y); v0[3] *= bfhi(ov.y); v1[0] *= bflo(ov.z); v1[1] *= bfhi(ov.z); v1[2] *= bflo(ov.w); v1[3] *= bfhi(ov.w);
#endif
                    u32x4 w; w.x = cvt_pk_bf16(v0[0], v0[1]); w.y = cvt_pk_bf16(v0[2], v0[3]); w.z = cvt_pk_bf16(v1[0], v1[1]); w.w = cvt_pk_bf16(v1[2], v1[3]);
                    *(u32x4*)(HN + off) = w; }
            }
            asm volatile("" ::: "memory");
        }
        asm volatile("s_waitcnt lgkmcnt(0)" ::: "memory"); __builtin_amdgcn_s_barrier(); asm volatile("" ::: "memory");
    }
};
struct Frame {
    LAS unsigned char* lds;
    unsigned* ctl;
    unsigned char* ws;
    int tid, lane, wave, vcu, G;
};
__device__ __forceinline__ float wave_sum(float v) {
#pragma unroll
    for (int o = 1; o < 64; o <<= 1) v += __shfl_xor(v, o);
    return v;
}

__device__ __forceinline__ void tr_block(const float* src, size_t pitch, bf16_t* dst, size_t kd, int kb, int nb, LAS unsigned* scr, int lane) {
    const float* s0 = src + (size_t)(64 * kb) * pitch + 64 * nb + 4 * (lane & 15);
#pragma unroll
    for (int i = 0; i < 8; ++i) {
        const int kp = 4 * i + (lane >> 4);
        const f32x4 a = __builtin_nontemporal_load((const f32x4*)(s0 + (size_t)(2 * kp) * pitch)), b = __builtin_nontemporal_load((const f32x4*)(s0 + (size_t)(2 * kp + 1) * pitch));
#pragma unroll
        for (int j = 0; j < 4; ++j) scr[(4 * (lane & 15) + j) * 33 + kp] = cvt_pk_bf16(a[j], b[j]);
    }
    LDS_WAIT(); asm volatile("" ::: "memory");
    u32x4 o[8];
#pragma unroll
    for (int c = 0; c < 8; ++c) { const int rr = 8 * c + (lane >> 3), q4 = 4 * (lane & 7); o[c].x = scr[rr * 33 + q4]; o[c].y = scr[rr * 33 + q4 + 1]; o[c].z = scr[rr * 33 + q4 + 2]; o[c].w = scr[rr * 33 + q4 + 3]; }
    bf16_t* d = dst + (size_t)(64 * nb + (lane >> 3)) * kd + 64 * kb + 8 * (lane & 7);
#pragma unroll
    for (int c = 0; c < 8; ++c) *(u32x4*)(d + (size_t)(8 * c) * kd) = o[c];
    LDS_WAIT(); asm volatile("" ::: "memory");
}
__device__ __forceinline__ void tr_block8(const float* src, size_t pitch, unsigned char* dst, size_t kd, int kb, int nb, float scale, LAS unsigned* scr, int lane) {
    const float* s0 = src + (size_t)(128 * kb) * pitch + 64 * nb + 4 * (lane & 15);
#pragma unroll
    for (int i = 0; i < 8; ++i) {
        const int kq = 4 * i + (lane >> 4);
        const f32x4 r0 = __builtin_nontemporal_load((const f32x4*)(s0 + (size_t)(4 * kq) * pitch)) * scale, r1 = __builtin_nontemporal_load((const f32x4*)(s0 + (size_t)(4 * kq + 1) * pitch)) * scale,
                    r2 = __builtin_nontemporal_load((const f32x4*)(s0 + (size_t)(4 * kq + 2) * pitch)) * scale, r3 = __builtin_nontemporal_load((const f32x4*)(s0 + (size_t)(4 * kq + 3) * pitch)) * scale;
#pragma unroll
        for (int j = 0; j < 4; ++j) { int w = __builtin_amdgcn_cvt_pk_fp8_f32(r0[j], r1[j], 0, false); w = __builtin_amdgcn_cvt_pk_fp8_f32(r2[j], r3[j], w, true); scr[(4 * (lane & 15) + j) * 33 + kq] = (unsigned)w; }
    }
    LDS_WAIT(); asm volatile("" ::: "memory");
    u32x4 o[8];
#pragma unroll
    for (int c = 0; c < 8; ++c) { const int rr = 8 * c + (lane >> 3), q4 = 4 * (lane & 7); o[c].x = scr[rr * 33 + q4]; o[c].y = scr[rr * 33 + q4 + 1]; o[c].z = scr[rr * 33 + q4 + 2]; o[c].w = scr[rr * 33 + q4 + 3]; }
    unsigned char* d = dst + (size_t)(64 * nb + (lane >> 3)) * kd + 128 * kb + 16 * (lane & 7);
#pragma unroll
    for (int c = 0; c < 8; ++c) *(u32x4*)(d + (size_t)(8 * c) * kd) = o[c];
    LDS_WAIT(); asm volatile("" ::: "memory");
}
constexpr int CONV_ITEMS = 24576;
struct ConvItem { const float* s0; size_t pitch; unsigned char* d; float scale; };
__device__ __forceinline__ ConvItem conv_desc(const float* wgu, const float* wd, unsigned char* ws, int v, int lane) {
    const int layer = v >= 12288; int r = v - layer * 12288; ConvItem it;
    if (r < 8192) { const int mat = layer * 32 + (r >> 8); r &= 255; const int kb = r >> 5, nb = r & 31; it.pitch = 2048; it.scale = FP8_SWGU;
        it.s0 = wgu + (size_t)mat * 1024 * 2048 + (size_t)(128 * kb) * 2048 + 64 * nb + 4 * (lane & 15); it.d = ws + WS_WGU + (size_t)mat * 2048 * 1024 + (size_t)(64 * nb + (lane >> 3)) * 1024 + 128 * kb + 16 * (lane & 7); }
    else { r -= 8192; const int mat = layer * 32 + (r >> 7); r &= 127; const int kb = r >> 4, nb = r & 15; it.pitch = 1024; it.scale = FP8_SWD;
        it.s0 = wd + (size_t)mat * 1024 * 1024 + (size_t)(128 * kb) * 1024 + 64 * nb + 4 * (lane & 15); it.d = ws + WS_WD + (size_t)mat * 1024 * 1024 + (size_t)(64 * nb + (lane >> 3)) * 1024 + 128 * kb + 16 * (lane & 7); }
    return it;
}
__device__ __forceinline__ void conv_items(Frame& F, const float* wgu, const float* wd, int v_lo, int v_hi, int cw, int ncw) {
    LAS unsigned* scr = (LAS unsigned*)(F.lds + RING_OFF + F.wave * 8448); unsigned char* ws = F.ws; const int lane = F.lane;
    int v = v_lo + cw; if (v >= v_hi) return;
    ConvItem cur = conv_desc(wgu, wd, ws, v, lane);
    f32x4 r[8][4];
#pragma unroll
    for (int i = 0; i < 8; ++i) { const int kq = 4 * i + (lane >> 4);
#pragma unroll
        for (int q = 0; q < 4; ++q) r[i][q] = __builtin_nontemporal_load((const f32x4*)(cur.s0 + (size_t)(4 * kq + q) * cur.pitch)); }
    for (;;) {
        const int vn = v + ncw; const bool has = vn < v_hi; ConvItem nx = cur; if (has) nx = conv_desc(wgu, wd, ws, vn, lane);
#pragma unroll
        for (int i = 0; i < 8; ++i) { const int kq = 4 * i + (lane >> 4);
#pragma unroll
            for (int j = 0; j < 4; ++j) { int w = __builtin_amdgcn_cvt_pk_fp8_f32(r[i][0][j] * cur.scale, r[i][1][j] * cur.scale, 0, false); w = __builtin_amdgcn_cvt_pk_fp8_f32(r[i][2][j] * cur.scale, r[i][3][j] * cur.scale, w, true); scr[(4 * (lane & 15) + j) * 33 + kq] = (unsigned)w; }
            if (has) {
#pragma unroll
                for (int q = 0; q < 4; ++q) r[i][q] = __builtin_nontemporal_load((const f32x4*)(nx.s0 + (size_t)(4 * kq + q) * nx.pitch)); } }
        LDS_WAIT(); asm volatile("" ::: "memory");
        u32x4 o[8];
#pragma unroll
        for (int c = 0; c < 8; ++c) { const int rr = 8 * c + (lane >> 3), q4 = 4 * (lane & 7); o[c].x = scr[rr * 33 + q4]; o[c].y = scr[rr * 33 + q4 + 1]; o[c].z = scr[rr * 33 + q4 + 2]; o[c].w = scr[rr * 33 + q4 + 3]; }
#pragma unroll
        for (int c = 0; c < 8; ++c) *(u32x4*)(cur.d + (size_t)(8 * c) * 1024) = o[c];
        LDS_WAIT(); asm volatile("" ::: "memory");
        if (!has) break;
        v = vn; cur = nx;
    }
}
struct P0In { const float *x, *wqkv, *wo, *win, *wout, *rw, *wgu, *wd; const int* pos; };
__device__ __forceinline__ void p0_prologue(Frame& F, const P0In& I) {
    LAS unsigned* scr = (LAS unsigned*)(F.lds + RING_OFF + F.wave * 8448);
    const int gw = F.vcu * NWAVES + F.wave, NGW = F.G * NWAVES;
    unsigned char* ws = F.ws;
    constexpr int KB = 16;
    constexpr int I_QKV = KB * 48, I_WO = KB * 16, I_INA1 = KB * 16, I_INA2 = KB * 16, I_INB = KB * 24, I_WOUT = KB * 16;
    constexpr int I_SMALL = I_QKV + I_WO + I_INA1 + I_INA2 + I_INB + I_WOUT;
    constexpr int NITEMS = I_SMALL;
    for (int it = gw; it < NITEMS; it += NGW) {
        int r = it; const float* src; size_t pitch; bf16_t* dst; int nbl;
        if (r < I_QKV) { src = I.wqkv; pitch = 3072; dst = (bf16_t*)(ws + WS_WQKV); nbl = 48; }
        else if ((r -= I_QKV) < I_WO) { src = I.wo; pitch = 1024; dst = (bf16_t*)(ws + WS_WO); nbl = 16; }
        else if ((r -= I_WO) < I_INA1) { src = I.win; pitch = 3080; dst = (bf16_t*)(ws + WS_WINA); nbl = 16; }
        else if ((r -= I_INA1) < I_INA2) { src = I.win + 2048; pitch = 3080; dst = (bf16_t*)(ws + WS_WINA) + (size_t)1024 * 1024; nbl = 16; }
        else if ((r -= I_INA2) < I_INB) { src = I.win + 512; pitch = 3080; dst = (bf16_t*)(ws + WS_WINB); nbl = 24; }
        else { r -= I_INB; src = I.wout; pitch = 1024; dst = (bf16_t*)(ws + WS_WOUT); nbl = 16; }
        tr_block(src, pitch, dst, 1024, r / nbl, r % nbl, scr, F.lane);
    }
    if (NCONV == 0) conv_items(F, I.wgu, I.wd, 0, CONV_ITEMS, gw, NGW);
    const int gt = F.vcu * NTHR + F.tid, NGT = F.G * NTHR;
    for (int i = gt; i < NTOK * DM / 8; i += NGT) { const f32x4 a = ((const f32x4*)I.x)[2 * i], b = ((const f32x4*)I.x)[2 * i + 1];
        u32x4 w; w.x = cvt_pk_bf16(a[0], a[1]); w.y = cvt_pk_bf16(a[2], a[3]); w.z = cvt_pk_bf16(b[0], b[1]); w.w = cvt_pk_bf16(b[2], b[3]); ((u32x4*)(ws + WS_XB))[i] = w; }
    for (int i = gt; i < NTOK * 8; i += NGT) { const int tok = i >> 3, f = i & 7; const float inv = powf(500000.0f, -(float)f * 0.125f); const float ang = (float)I.pos[tok] * inv;
        float sn, cs; sincosf(ang, &sn, &cs); float* rp = (float*)(ws + WS_ROPE) + (size_t)tok * 16; rp[f] = cs; rp[8 + f] = sn; }
    for (int i = gt; i < 2 * 32 * 1024; i += NGT) { const int l = i >> 15, e = (i >> 10) & 31, k = i & 1023; ((float*)(ws + WS_RWT))[i] = I.rw[((size_t)l * 1024 + k) * 32 + e]; }
    for (int i = gt; i < 8 * 1024; i += NGT) { const int gidx = i >> 10, k = i & 1023; ((float*)(ws + WS_WG))[i] = I.win[(size_t)k * 3080 + 3072 + gidx]; }
}

__device__ __forceinline__ void phase_ln_router(Frame& F, const float* __restrict__ z, float* __restrict__ x1, const float* lng, const float* lnb, const float* rbias, int layer, int cset) {
    unsigned char* ws = F.ws;
    LAS f32x4* rwv = (LAS f32x4*)(F.lds + RING_OFF);
    LAS int* lcnt = (LAS int*)(F.lds + LX_LCNT); LAS int* gbase = (LAS int*)(F.lds + LX_GBASE); LAS int* rec = (LAS int*)(F.lds + LX_REC);
    LAS float* lgb = (LAS float*)(F.lds + LX_LNX);
    { const f32x4* src = (const f32x4*)((const float*)(ws + WS_RWT) + (size_t)layer * 32768);
      for (int i = F.tid; i < 8192; i += NTHR) { const int e = i >> 8, c = i & 255; rwv[e * 256 + (c ^ (e & 15))] = src[i]; } }
    int* toke = (int*)(ws + WS_TOKE); int* tokp = (int*)(ws + WS_TOKP); float* tokg = (float*)(ws + WS_TOKG);
    unsigned short* rowtok = (unsigned short*)(ws + WS_ROWTOK); unsigned char* xb8 = (unsigned char*)(ws + WS_XB);
    unsigned* cntg = F.ctl + CW_CNT + cset * 2048;
    const int lane = F.lane;
    for (int grp = F.vcu; grp < NTOK / 64; grp += F.G) {
        if (F.tid < 32) lcnt[F.tid] = 0;
        for (int i = F.tid; i < 1024; i += NTHR) { lgb[i] = lng[i]; lgb[1024 + i] = lnb[i]; }
        __syncthreads();
#pragma unroll 2
        for (int tk = 0; tk < 8; tk += 2) {
            const int token0 = grp * 64 + F.wave * 8 + tk;
            f32x4 v[2][4]; float s[2] = {0.f, 0.f};
#pragma unroll
            for (int u = 0; u < 2; ++u)
#pragma unroll
                for (int j = 0; j < 4; ++j) { v[u][j] = *(const f32x4*)(z + (size_t)(token0 + u) * DM + 4 * lane + 256 * j); s[u] += (v[u][j][0] + v[u][j][1]) + (v[u][j][2] + v[u][j][3]); }
#pragma unroll
            for (int o = 1; o < 64; o <<= 1) { const float a0 = __shfl_xor(s[0], o), a1 = __shfl_xor(s[1], o); s[0] += a0; s[1] += a1; }
            float s2[2] = {0.f, 0.f};
#pragma unroll
            for (int u = 0; u < 2; ++u) { const float mean = s[u] * (1.0f / DM);
#pragma unroll
                for (int j = 0; j < 4; ++j) { v[u][j] = v[u][j] - mean; s2[u] += (v[u][j][0] * v[u][j][0] + v[u][j][1] * v[u][j][1]) + (v[u][j][2] * v[u][j][2] + v[u][j][3] * v[u][j][3]); } }
#pragma unroll
            for (int o = 1; o < 64; o <<= 1) { const float a0 = __shfl_xor(s2[0], o), a1 = __shfl_xor(s2[1], o); s2[0] += a0; s2[1] += a1; }
#pragma unroll
            for (int u = 0; u < 2; ++u) { const float rstd = 1.0f / sqrtf(s2[u] * (1.0f / DM) + LN_EPS); const int token = token0 + u;
#pragma unroll
                for (int j = 0; j < 4; ++j) { const f32x4 gvj = *(const LAS f32x4*)(lgb + 4 * lane + 256 * j), bvj = *(const LAS f32x4*)(lgb + 1024 + 4 * lane + 256 * j);
                    const f32x4 y = v[u][j] * rstd * gvj + bvj; *(f32x4*)(x1 + (size_t)token * DM + 4 * lane + 256 * j) = y;
                    int w8 = __builtin_amdgcn_cvt_pk_fp8_f32(y[0] * FP8_SA, y[1] * FP8_SA, 0, false); w8 = __builtin_amdgcn_cvt_pk_fp8_f32(y[2] * FP8_SA, y[3] * FP8_SA, w8, true);
                    *(int*)(xb8 + (size_t)token * DM + 4 * lane + 256 * j) = w8; } }
        }
        VM_WAIT(); __syncthreads();
        const int tg = F.wave & 3, kh = F.wave >> 2, e0 = lane & 15, kq = lane >> 4;
        f32x4 acc0 = {0.f, 0.f, 0.f, 0.f}, acc1 = acc0;
        { const float* arow = x1 + (size_t)(grp * 64 + tg * 16 + e0) * DM + kh * 512 + 4 * kq;
#pragma unroll 4
          for (int blk = 0; blk < 32; ++blk) {
              const f32x4 a4 = *(const f32x4*)(arow + blk * 16); const int c = ((kh * 512 + blk * 16) >> 2) + kq;
              const f32x4 b0 = rwv[e0 * 256 + (c ^ e0)], b1 = rwv[(16 + e0) * 256 + (c ^ e0)];
#pragma unroll
              for (int j = 0; j < 4; ++j) { acc0 = __builtin_amdgcn_mfma_f32_16x16x4f32(a4[j], b0[j], acc0, 0, 0, 0); acc1 = __builtin_amdgcn_mfma_f32_16x16x4f32(a4[j], b1[j], acc1, 0, 0, 0); } } }
        __syncthreads();
        if (kh == 1) { ((LAS f32x4*)lgb)[(tg * 2 + 0) * 64 + lane] = acc0; ((LAS f32x4*)lgb)[(tg * 2 + 1) * 64 + lane] = acc1; }
        __syncthreads();
        if (kh == 0) {
            acc0 = acc0 + ((LAS f32x4*)lgb)[(tg * 2 + 0) * 64 + lane]; acc1 = acc1 + ((LAS f32x4*)lgb)[(tg * 2 + 1) * 64 + lane];
            const float rb0 = rbias[e0], rb1 = rbias[16 + e0];
#pragma unroll
            for (int r = 0; r < 4; ++r) {
                float l0 = acc0[r] + rb0, l1 = acc1[r] + rb1; float tv[4]; int te[4];
#pragma unroll
                for (int k = 0; k < 4; ++k) { float bvv = (l1 > l0) ? l1 : l0; int be = (l1 > l0) ? 16 + e0 : e0;
#pragma unroll
                    for (int o = 1; o < 16; o <<= 1) { const float ov = __shfl_xor(bvv, o); const int oe = __shfl_xor(be, o); const bool take = (ov > bvv) || (ov == bvv && oe < be); bvv = take ? ov : bvv; be = take ? oe : be; }
                    tv[k] = bvv; te[k] = be; if (be == e0) l0 = -INFINITY; if (be == 16 + e0) l1 = -INFINITY; }
                const float w0 = 1.0f, w1 = __expf(tv[1] - tv[0]), w2 = __expf(tv[2] - tv[0]), w3 = __expf(tv[3] - tv[0]); const float wi = 1.0f / (w0 + w1 + w2 + w3);
                if (e0 < 4) {
                    const int tl = tg * 16 + 4 * kq + r, token = grp * 64 + tl;
                    const int ek = (e0 == 0) ? te[0] : (e0 == 1) ? te[1] : (e0 == 2) ? te[2] : te[3];
                    const float wk = (e0 == 0) ? w0 : (e0 == 1) ? w1 : (e0 == 2) ? w2 : w3;
                    const int li = atomicAdd((int*)(lcnt + ek), 1); rec[tl * 8 + e0] = ek; rec[tl * 8 + 4 + e0] = li;
                    toke[token * 4 + e0] = ek; tokg[token * 4 + e0] = wk * wi;
                }
            }
        }
        __syncthreads();
        if (F.tid < 32) gbase[F.tid] = (int)__hip_atomic_fetch_add(cntg + F.tid * 64, (unsigned)lcnt[F.tid], RLX_AGENT);
        __syncthreads();
        if (F.tid < 256) { const int tl = F.tid >> 2, k = F.tid & 3; const int token = grp * 64 + tl; const int e = rec[tl * 8 + k]; const int pos = gbase[e] + rec[tl * 8 + 4 + k];
            tokp[token * 4 + k] = pos; rowtok[(size_t)e * NTOK + pos] = (unsigned short)token; }
        __syncthreads();
    }
}

__device__ __forceinline__ int moe_tables(Frame& F, int layer) {
    LAS int* tile_e = (LAS int*)(F.lds + LX_TILEE); LAS int* tbase = (LAS int*)(F.lds + LX_TBASE);
    if (F.tid < 64) {
        const int e = F.lane & 31; const int c = (int)__hip_atomic_load(F.ctl + CW_CNT + layer * 2048 + e * 64, RLX_AGENT); const int nt = (F.lane < 32) ? ((c + 255) >> 8) : 0;
        int inc = nt;
#pragma unroll
        for (int o = 1; o < 32; o <<= 1) { const int up = __shfl_up(inc, o); if (F.lane >= o) inc += up; }
        const int t0 = inc - nt;
        if (F.lane < 32) { tbase[e] = t0; for (int i = 0; i < nt; ++i) tile_e[t0 + i] = e; }
        if (F.lane == 31) tbase[32] = inc;
    }
    __syncthreads();
    return tbase[32];
}

template <bool NEXT_MLSTM>
__device__ __forceinline__ void phase_combine(Frame& F, const float* __restrict__ x1, float* __restrict__ out, const float* lng, const float* lnb, const float* bgates, int layer) {
    unsigned char* ws = F.ws;
    (void)moe_tables(F, layer);
    const LAS int* tbase = (const LAS int*)(F.lds + LX_TBASE);
    const int* toke = (const int*)(ws + WS_TOKE); const int* tokp = (const int*)(ws + WS_TOKP); const float* tokg = (const float*)(ws + WS_TOKG);
    const bf16_t* Y = (const bf16_t*)(ws + WS_Y); bf16_t* xb = (bf16_t*)(ws + WS_XB);
    LAS float* wg = (LAS float*)(F.lds + RING_OFF);
    if constexpr (NEXT_MLSTM) { const f32x4* src = (const f32x4*)(ws + WS_WG); for (int i = F.tid; i < 2048; i += NTHR) ((LAS f32x4*)wg)[i] = src[i]; __syncthreads(); }
    const int lane = F.lane; const int gw = F.vcu * NWAVES + F.wave, NGW = F.G * NWAVES;
    f32x4 gv[4], bv[4];
#pragma unroll
    for (int j = 0; j < 4; ++j) { gv[j] = *(const f32x4*)(lng + 4 * lane + 256 * j); bv[j] = *(const f32x4*)(lnb + 4 * lane + 256 * j); }
    constexpr int NTK = NEXT_MLSTM ? 1 : 2;
    for (int token0 = gw; token0 < NTOK; token0 += NTK * NGW) {
        f32x4 vv[NTK][4];
#pragma unroll
        for (int u = 0; u < NTK; ++u) { const int token = token0 + u * NGW; if (token < NTOK) {
#pragma unroll
            for (int j = 0; j < 4; ++j) vv[u][j] = *(const f32x4*)(x1 + (size_t)token * DM + 4 * lane + 256 * j) * ALPHA;
#pragma unroll
            for (int k = 0; k < 4; ++k) { const int e = toke[token * 4 + k]; const size_t row = (size_t)tbase[e] * 256 + tokp[token * 4 + k]; const float gt = tokg[token * 4 + k] * DBG_MOE_MUL;
#pragma unroll
                for (int j = 0; j < 4; ++j) { const u32x2 y = *(const u32x2*)(Y + row * DM + 4 * lane + 256 * j); vv[u][j][0] += gt * bflo(y.x); vv[u][j][1] += gt * bfhi(y.x); vv[u][j][2] += gt * bflo(y.y); vv[u][j][3] += gt * bfhi(y.y); } } } }
#pragma unroll
        for (int u = 0; u < NTK; ++u) { const int token = token0 + u * NGW; if (token < NTOK) {
        f32x4 v[4];
#pragma unroll
        for (int j = 0; j < 4; ++j) v[j] = vv[u][j];
        float s = 0.f;
#pragma unroll
        for (int j = 0; j < 4; ++j) s += (v[j][0] + v[j][1]) + (v[j][2] + v[j][3]);
        const float mean = wave_sum(s) * (1.0f / DM); float s2 = 0.f;
#pragma unroll
        for (int j = 0; j < 4; ++j) { v[j] = v[j] - mean; s2 += (v[j][0] * v[j][0] + v[j][1] * v[j][1]) + (v[j][2] * v[j][2] + v[j][3] * v[j][3]); }
        const float rstd = 1.0f / sqrtf(wave_sum(s2) * (1.0f / DM) + LN_EPS);
#pragma unroll
        for (int j = 0; j < 4; ++j) { v[j] = v[j] * rstd * gv[j] + bv[j]; *(f32x4*)(out + (size_t)token * DM + 4 * lane + 256 * j) = v[j]; }
        if constexpr (NEXT_MLSTM) {
#pragma unroll
            for (int j = 0; j < 4; ++j) { u32x2 w; w.x = cvt_pk_bf16(v[j][0], v[j][1]); w.y = cvt_pk_bf16(v[j][2], v[j][3]); *(u32x2*)(xb + (size_t)token * DM + 4 * lane + 256 * j) = w; }
            float gp[8];
#pragma unroll
            for (int gi = 0; gi < 8; ++gi) { float a = 0.f;
#pragma unroll
                for (int j = 0; j < 4; ++j) { const f32x4 w = *(const LAS f32x4*)(wg + gi * 1024 + 4 * lane + 256 * j); a += (v[j][0] * w[0] + v[j][1] * w[1]) + (v[j][2] * w[2] + v[j][3] * w[3]); }
                gp[gi] = a; }
#pragma unroll
            for (int o = 1; o < 64; o <<= 1) {
#pragma unroll
                for (int gi = 0; gi < 8; ++gi) gp[gi] += __shfl_xor(gp[gi], o); }
#pragma unroll
            for (int gi = 0; gi < 8; ++gi) gp[gi] += bgates[gi];
            if (lane == 0) {
#pragma unroll
                for (int hh = 0; hh < 4; ++hh) { ((float*)(ws + WS_GI))[(size_t)hh * NTOK + token] = gp[hh];
                    const float f = gp[4 + hh]; const float lf = (f >= 0.f) ? -log1pf(__expf(-f)) : (f - log1pf(__expf(f)));
                    ((float*)(ws + WS_LF))[(size_t)hh * NTOK + token] = lf; } }
        }
        } }
    }
}

__device__ __forceinline__ void phase_gate_scan(Frame& F) {
    unsigned char* ws = F.ws; const int lane = F.lane; const int gw = F.vcu * NWAVES + F.wave, NGW = F.G * NWAVES;
    for (int mu = gw; mu < 256; mu += NGW) {
        const int b = mu >> 6, hh = (mu >> 4) & 3, ch = mu & 15; const size_t base = (size_t)hh * NTOK + (size_t)b * SEQ + ch * 256 + 4 * lane;
        const f32x4 lf = *(const f32x4*)((const float*)(ws + WS_LF) + base), gi = *(const f32x4*)((const float*)(ws + WS_GI) + base);
        f32x4 c; c[0] = lf[0]; c[1] = c[0] + lf[1]; c[2] = c[1] + lf[2]; c[3] = c[2] + lf[3];
        float tot = c[3];
#pragma unroll
        for (int o = 1; o < 64; o <<= 1) { const float up = __shfl_up(tot, o); if (lane >= o) tot += up; }
        const float excl = tot - c[3];
        f32x4 rf, cf;
#pragma unroll
        for (int j = 0; j < 4; ++j) { const float bt = excl + c[j]; rf[j] = __expf(bt); cf[j] = __expf(gi[j] - bt); }
        *(f32x4*)((float*)(ws + WS_RF) + base) = rf; *(f32x4*)((float*)(ws + WS_CF) + base) = cf;
        if (lane == 63) ((float*)(ws + WS_DEC))[mu] = __expf(tot);
    }
}
__device__ __forceinline__ void phase_nu(Frame& F) {
    unsigned char* ws = F.ws; const int lane = F.lane; const int gw = F.vcu * NWAVES + F.wave, NGW = F.G * NWAVES;
    const bf16_t* KT = (const bf16_t*)(ws + WS_KT); float* NU = (float*)(ws + WS_NU);
    for (int r0 = gw * 16; r0 < 256 * 128; r0 += NGW * 16) {
        const int mu = r0 >> 7, d0 = r0 & 127, b = mu >> 6, hh = (mu >> 4) & 3, ch = mu & 15;
        const bf16_t* base = KT + (size_t)(hh * 128 + d0) * NTOK + (size_t)b * SEQ + ch * 256 + 4 * lane;
        u32x2 kv[16];
#pragma unroll
        for (int i = 0; i < 16; ++i) kv[i] = *(const u32x2*)(base + (size_t)i * NTOK);
        float s[16];
#pragma unroll
        for (int i = 0; i < 16; ++i) s[i] = (bflo(kv[i].x) + bfhi(kv[i].x)) + (bflo(kv[i].y) + bfhi(kv[i].y));
#pragma unroll
        for (int o = 1; o < 64; o <<= 1) {
#pragma unroll
            for (int i = 0; i < 16; ++i) s[i] += __shfl_xor(s[i], o); }
        float mine = s[0];
#pragma unroll
        for (int i = 1; i < 16; ++i) mine = (lane == i) ? s[i] : mine;
        if (lane < 16) NU[r0 + lane] = mine;
    }
}
__device__ __forceinline__ void phase_state_scan(Frame& F) {
    unsigned char* ws = F.ws; const int gt = F.vcu * NTHR + F.tid, NGT = F.G * NTHR;
    const float* UT = (const float*)(ws + WS_UT); const float* DEC = (const float*)(ws + WS_DEC); bf16_t* BE = (bf16_t*)(ws + WS_BE);
    for (int i = gt; i < 16 * 256 * 32; i += NGT) { const int bh = i >> 13, e = (i >> 5) & 255, dg = i & 31;
        f32x4 U[16]; float dc[16];
#pragma unroll
        for (int ch = 0; ch < 16; ++ch) { const size_t mu = (size_t)bh * 16 + ch; U[ch] = *(const f32x4*)(UT + (mu * 256 + e) * 128 + 4 * dg); dc[ch] = DEC[mu]; }
        f32x4 C = {0.f, 0.f, 0.f, 0.f};
#pragma unroll
        for (int ch = 0; ch < 16; ++ch) { const size_t mu = (size_t)bh * 16 + ch;
            u32x2 w; w.x = cvt_pk_bf16(C[0], C[1]); w.y = cvt_pk_bf16(C[2], C[3]);
#ifdef DBG_NO_INTER
            w.x = 0u; w.y = 0u;
#endif
            *(u32x2*)(BE + (mu * 256 + e) * 384 + 256 + 4 * dg) = w;
            C = (C + U[ch]) * dc[ch]; } }
    const float* NU = (const float*)(ws + WS_NU); float* NP = (float*)(ws + WS_NPREV);
    for (int i = gt; i < 16 * 128; i += NGT) { const int bh = i >> 7, d = i & 127; float n = 0.f;
        for (int ch = 0; ch < 16; ++ch) { const int mu = bh * 16 + ch; NP[mu * 128 + d] = n; n = (n + NU[mu * 128 + d]) * DEC[mu];
#ifdef DBG_NO_INTER
            n = 0.f;
#endif
        } }
}
struct Args { const float* in[18]; float* out; unsigned char* ws; int ph_lo, ph_hi; };
__global__ void __launch_bounds__(NTHR, 2) mk_fwd(Args args) {
    extern __shared__ __attribute__((aligned(16))) unsigned char lds[];
    Frame F;
    const char __attribute__((address_space(4)))* kargp = (const char __attribute__((address_space(4)))*)__builtin_amdgcn_kernarg_segment_ptr();
#define AIN(i) ({ const char __attribute__((address_space(4)))* k_ = kargp; asm volatile("" : "+s"(k_)); *(const float* const __attribute__((address_space(4)))*)(k_ + 8 * (i)); })
    unsigned char* const ws0 = (unsigned char*)AIN(19);
    F.lds = (LAS unsigned char*)lds; F.ws = ws0; F.ctl = (unsigned*)(ws0 + WS_CTL);
    F.tid = threadIdx.x; F.lane = F.tid & 63; F.wave = __builtin_amdgcn_readfirstlane(F.tid >> 6);
    F.G = gridDim.x; { const int bx = blockIdx.x; F.vcu = (F.G % 8 == 0) ? (bx % 8) * (F.G / 8) + bx / 8 : bx; }
    for (int u = F.tid; u < (LDS_BYTES - LX) / 4; u += NTHR) ((LAS unsigned*)(F.lds + LX))[u] = 0u;
    __syncthreads();
    int lo, hi; { const char __attribute__((address_space(4)))* k_ = kargp; lo = *(const int __attribute__((address_space(4)))*)(k_ + 160); hi = *(const int __attribute__((address_space(4)))*)(k_ + 164); }
    XcdBarrier bar; bar.bar = (unsigned*)(F.ctl + CW_BAR); bar.x = 0; bar.st = nullptr;
    if (hi - lo > 1) bar = xcd_barrier_post((unsigned*)(F.ctl + CW_BAR), (volatile LAS unsigned*)(F.lds + LX_MISC) + 8);
#ifndef PHASE_MASK
#define PHASE_MASK 0x7FFFF
#endif
#define IN(k) ((((PHASE_MASK) >> (k)) & 1) && lo <= (k) && (k) < hi)
#ifndef REPEAT_MASK
#define REPEAT_MASK 0
#endif
#define PH(k) if (IN(k))
#define SEAM(k) do { if (IN(k) && IN((k) + 1)) xcd_barrier(bar); } while (0)
    unsigned char* ws = ws0;
#define x_in AIN(0)
#define ln_mix_g AIN(8)
#define ln_mix_b AIN(9)
#define ln_ffn_g AIN(10)
#define ln_ffn_b AIN(11)
#define router_b AIN(13)
#define b_gu AIN(15)
#define b_dn AIN(17)
    bf16_t* XB = (bf16_t*)(ws + WS_XB); bf16_t* QB_ = (bf16_t*)(ws + WS_Q); bf16_t* KB_ = (bf16_t*)(ws + WS_K); bf16_t* VB_ = (bf16_t*)(ws + WS_V);
    float* R0 = (float*)(ws + WS_R0); float* R1 = (float*)(ws + WS_R1); float* R2 = (float*)(ws + WS_R2);
    bf16_t* HB = (bf16_t*)(ws + WS_H); bf16_t* YB = (bf16_t*)(ws + WS_Y);
    LAS unsigned char* ring = F.lds + RING_OFF;
    const int cG = (int)blockIdx.x;
    const bool isConv = (NCONV > 0) && ((int)blockIdx.x >= F.G - NCONV);
    const int Gc = F.G - NCONV, cwv = ((int)blockIdx.x - Gc) * NWAVES + F.wave, ncw = NCONV * NWAVES;
#define CONV_SLICE(a, b) conv_items(F, AIN(14), AIN(16), (int)((long)CONV_ITEMS * (a) / 1000), (int)((long)CONV_ITEMS * (b) / 1000), cwv, ncw)

    PH(0) { P0In I{x_in, AIN(2), AIN(3), AIN(4), AIN(7), AIN(12), AIN(14), AIN(16), (const int*)AIN(1)}; p0_prologue(F, I); }
    SEAM(0);
    PH(1) { { Gemm g{1024, 1024, 1024, nullptr}; DenseSched S{64, 12, F.G, cG, (const char*)XB, (const char*)(ws + WS_WQKV), (size_t)256 * 1024 * 2, (size_t)256 * 1024 * 2};
        EpiQKV E{QB_, KB_, VB_, (const float*)(ws + WS_ROPE), (float*)(ws + WS_KSUM)};
        pg8::gemm_phase<EpiQKV, DenseSched, true, false>(ring, g, S, E); } }
    SEAM(1);
    PH(2) { if (isConv) CONV_SLICE(0, 1000); else {
        const attn_body::AttnTensors AT{(const attn_body::bf16*)QB_, (const attn_body::bf16*)KB_, (const attn_body::bf16*)VB_, (attn_body::bf16*)QB_, (const float*)(ws + WS_KSUM)};
        if (NCONV == 0) { const attn_body::StaticOrder S((int)F.G, (int)blockIdx.x); attn_body::attn_phase<attn_body::StaticOrder>((char*)lds + RING_OFF, AT, S); }
        else { const attn_body::SnakeOrder S{cG, Gc}; attn_body::attn_phase<attn_body::SnakeOrder>((char*)lds + RING_OFF, AT, S); } } }
    SEAM(2);
    PH(3) { { Gemm g{1024, 1024, 1024, nullptr}; DenseSched S{64, 4, F.G, cG, (const char*)QB_, (const char*)(ws + WS_WO), (size_t)256 * 1024 * 2, (size_t)256 * 1024 * 2};
        EpiZ E{x_in, R0, DBG_ATTN_MUL}; pg8::gemm_phase<EpiZ, DenseSched, true, false>(ring, g, S, E); } }
    SEAM(3);
    PH(4) phase_ln_router(F, R0, R1, ln_mix_g, ln_mix_b, router_b, 0, 0);
    SEAM(4);
    PH(5) { const int nT = moe_tables(F, 0); LAS unsigned short* tokl = (LAS unsigned short*)(F.lds + LX_TOKL);
        { const unsigned short* rowtok = (const unsigned short*)(ws + WS_ROWTOK); const LAS int* tile_e = (const LAS int*)(F.lds + LX_TILEE); const LAS int* tbase = (const LAS int*)(F.lds + LX_TBASE);
          for (int i = 0; i < TOKL_ROUNDS; ++i) { int pm, pn, hf; if (!moe_unit(i, F.G, cG, nT, 8, pm, pn, hf)) break;
              if (F.tid < 256) { const int e = tile_e[pm]; const int r = (pm - tbase[e]) * 256 + F.tid; const int c = (int)__hip_atomic_load(F.ctl + CW_CNT + 0 * 2048 + e * 64, RLX_AGENT);
                  tokl[i * 256 + F.tid] = (r < c) ? rowtok[(size_t)e * NTOK + r] : (unsigned short)0; } }
          __syncthreads(); }
        Gemm g{512, 512, 512, (const char*)XB};
        MoeSched S{nT, 8, F.G, cG, (const LAS int*)(F.lds + LX_TILEE), (const LAS int*)(F.lds + LX_TBASE), tokl, nullptr, (const char*)(ws + WS_WGU) + (size_t)0 * 32 * 2048 * 1024, 0, (size_t)2048 * 1024, (size_t)256 * 1024};
        EpiGU E{b_gu + (size_t)0 * 32 * 2048, (unsigned char*)HB, (LAS float*)(F.lds + LX_BIAS), 0}; pg8::gemm_phase<EpiGU, MoeSched, true, true, true, true>(ring, g, S, E); }
    SEAM(5);
    PH(6) { const int nT = moe_tables(F, 0); Gemm g{512, 512, 512, nullptr};
        MoeSched S{nT, 4, F.G, cG, (const LAS int*)(F.lds + LX_TILEE), (const LAS int*)(F.lds + LX_TBASE), nullptr, (const char*)HB, (const char*)(ws + WS_WD) + (size_t)0 * 32 * 1024 * 1024, (size_t)256 * 1024, (size_t)1024 * 1024, (size_t)256 * 1024};
        EpiDN E{b_dn + (size_t)0 * 32 * 1024, YB, (LAS float*)(F.lds + LX_BIAS), 0}; pg8::gemm_phase<EpiDN, MoeSched, true, false, true, true>(ring, g, S, E); }
    SEAM(6);
    PH(7) phase_combine<true>(F, R1, R2, ln_ffn_g, ln_ffn_b, AIN(5), 0);
    SEAM(7);
    PH(8) phase_gate_scan(F);
    SEAM(8);
    PH(9) {
        { Gemm g{1024, 1024, 1024, nullptr}; DenseSched S{64, 8, F.G, cG, (const char*)XB, (const char*)(ws + WS_WINA), (size_t)256 * 1024 * 2, (size_t)256 * 1024 * 2};
          EpiINA E{(const float*)(ws + WS_RF), (const float*)(ws + WS_CF), (bf16_t*)(ws + WS_AE), (bf16_t*)(ws + WS_KN), (bf16_t*)(ws + WS_OS)};
          pg8::gemm_phase<EpiINA, DenseSched, true, false>(ring, g, S, E); }
        { Gemm g{1024, 1024, 1024, nullptr}; DenseSched S{6, 64, F.G, cG, (const char*)(ws + WS_WINB), (const char*)XB, (size_t)256 * 1024 * 2, (size_t)256 * 1024 * 2, true};
          EpiINB E{(const float*)(ws + WS_CF), (bf16_t*)(ws + WS_KT), (bf16_t*)(ws + WS_BE)};
          pg8::gemm_phase<EpiINB, DenseSched, true, false, false, true>(ring, g, S, E); }
    }
    SEAM(9);
    PH(10) { Gemm g{256, 384, NTOK, nullptr}; MuSched S{F.G, cG, 0, (const char*)(ws + WS_BE), (const char*)(ws + WS_KT)};
        EpiM1 E{(float*)(ws + WS_UT)}; pg8::gemm_phase<EpiM1, MuSched, true, false>(ring, g, S, E);
        phase_nu(F); }
    SEAM(10);
    PH(11) phase_state_scan(F);
    SEAM(11);
    PH(12) { Gemm g{256, 512, 1024, nullptr}; MuSched S{F.G, cG, 1, (const char*)(ws + WS_AE), (const char*)(ws + WS_KN)};
        EpiM2A E{(bf16_t*)(ws + WS_AE), (const float*)(ws + WS_NPREV), (float*)(ws + WS_DEN)}; pg8::gemm_phase<EpiM2A, MuSched, true, false>(ring, g, S, E); }
    SEAM(12);
    PH(13) { Gemm g{384, 512, 384, nullptr}; MuSched S{F.G, cG, 2, (const char*)(ws + WS_AE), (const char*)(ws + WS_BE)};
        EpiM2B E{(const float*)(ws + WS_DEN), AIN(6), (const bf16_t*)(ws + WS_OS), (bf16_t*)(ws + WS_HN), (LAS float*)(F.lds + LX_LNX)};
        pg8::gemm_phase<EpiM2B, MuSched, true, false>(ring, g, S, E); }
    SEAM(13);
    PH(14) { Gemm g{1024, 1024, 1024, nullptr}; DenseSched S{64, 4, F.G, cG, (const char*)(ws + DBG_P14_A), (const char*)(ws + WS_WOUT), (size_t)256 * 1024 * 2, (size_t)256 * 1024 * 2};
        EpiZ E{R2, R0, DBG_MLSTM_MUL}; pg8::gemm_phase<EpiZ, DenseSched, true, false>(ring, g, S, E); }
    SEAM(14);
    PH(15) phase_ln_router(F, R0, R1, ln_mix_g + 1024, ln_mix_b + 1024, router_b + 32, 1, 1);
    SEAM(15);
    PH(16) { const int nT = moe_tables(F, 1); LAS unsigned short* tokl = (LAS unsigned short*)(F.lds + LX_TOKL);
        { const unsigned short* rowtok = (const unsigned short*)(ws + WS_ROWTOK); const LAS int* tile_e = (const LAS int*)(F.lds + LX_TILEE); const LAS int* tbase = (const LAS int*)(F.lds + LX_TBASE);
          for (int i = 0; i < TOKL_ROUNDS; ++i) { int pm, pn, hf; if (!moe_unit(i, F.G, cG, nT, 8, pm, pn, hf)) break;
              if (F.tid < 256) { const int e = tile_e[pm]; const int r = (pm - tbase[e]) * 256 + F.tid; const int c = (int)__hip_atomic_load(F.ctl + CW_CNT + 1 * 2048 + e * 64, RLX_AGENT);
                  tokl[i * 256 + F.tid] = (r < c) ? rowtok[(size_t)e * NTOK + r] : (unsigned short)0; } }
          __syncthreads(); }
        Gemm g{512, 512, 512, (const char*)XB};
        MoeSched S{nT, 8, F.G, cG, (const LAS int*)(F.lds + LX_TILEE), (const LAS int*)(F.lds + LX_TBASE), tokl, nullptr, (const char*)(ws + WS_WGU) + (size_t)1 * 32 * 2048 * 1024, 0, (size_t)2048 * 1024, (size_t)256 * 1024};
        EpiGU E{b_gu + (size_t)1 * 32 * 2048, (unsigned char*)HB, (LAS float*)(F.lds + LX_BIAS), 0}; pg8::gemm_phase<EpiGU, MoeSched, true, true, true, true>(ring, g, S, E); }
    SEAM(16);
    PH(17) { const int nT = moe_tables(F, 1); Gemm g{512, 512, 512, nullptr};
        MoeSched S{nT, 4, F.G, cG, (const LAS int*)(F.lds + LX_TILEE), (const LAS int*)(F.lds + LX_TBASE), nullptr, (const char*)HB, (const char*)(ws + WS_WD) + (size_t)1 * 32 * 1024 * 1024, (size_t)256 * 1024, (size_t)1024 * 1024, (size_t)256 * 1024};
        EpiDN E{b_dn + (size_t)1 * 32 * 1024, YB, (LAS float*)(F.lds + LX_BIAS), 0}; pg8::gemm_phase<EpiDN, MoeSched, true, false, true, true>(ring, g, S, E); }
    SEAM(17);
    PH(18) phase_combine<false>(F, R1, (float*)AIN(18), ln_ffn_g + 1024, ln_ffn_b + 1024, nullptr, 1);
#undef IN
#undef CONV_SLICE
#undef AIN
#undef x_in
#undef ln_mix_g
#undef ln_mix_b
#undef ln_ffn_g
#undef ln_ffn_b
#undef router_b
#undef b_gu
#undef b_dn
#undef SEAM
}

extern "C" void kernel_launch(void* const* d_in, const int* in_sizes, int n_in, void* d_out, int out_size, void* d_ws, size_t ws_size, hipStream_t stream) {
    static int grid = 0;
    if (grid == 0) {
        if (n_in != 18 || out_size != NTOK * DM || ws_size < WS_END) { fprintf(stderr, "kernel_launch: unexpected problem shape (n_in %d, out %d, ws %zu)\n", n_in, out_size, ws_size); grid = -1; return; }
        int dev = 0, cus = 0, per_cu = 0;
        if (hipGetDevice(&dev) != hipSuccess || hipDeviceGetAttribute(&cus, hipDeviceAttributeMultiprocessorCount, dev) != hipSuccess) { grid = -1; return; }
        if (hipFuncSetAttribute((const void*)mk_fwd, hipFuncAttributeMaxDynamicSharedMemorySize, LDS_BYTES) != hipSuccess) { fprintf(stderr, "kernel_launch: hipFuncSetAttribute failed\n"); grid = -1; return; }
        if (hipOccupancyMaxActiveBlocksPerMultiprocessor(&per_cu, (const void*)mk_fwd, NTHR, LDS_BYTES) != hipSuccess || per_cu < 1) fprintf(stderr, "kernel_launch: occupancy query reports %d\n", per_cu);
        (void)hipGetLastError();
        grid = cus;
        if (grid > 256) grid = 256;
        if (grid < 240) { fprintf(stderr, "kernel_launch: %d CUs: this build needs 240..256\n", cus); grid = -1; return; }
    }
    if (grid < 0) return;
    if (hipMemsetAsync((char*)d_ws + WS_CTL, 0, CTL_ZERO_BYTES, stream) != hipSuccess) return;
    Args a{};
    for (int i = 0; i < 18; ++i) a.in[i] = (const float*)d_in[i];
    a.out = (float*)d_out; a.ws = (unsigned char*)d_ws;
#if MK_ONE_LAUNCH
    a.ph_lo = 0; a.ph_hi = NPHASE;
    hipLaunchKernelGGL(mk_fwd, dim3(grid), dim3(NTHR), LDS_BYTES, stream, a);
#else
    for (int p = 0; p < NPHASE; ++p) { a.ph_lo = p; a.ph_hi = p + 1; hipLaunchKernelGGL(mk_fwd, dim3(grid), dim3(NTHR), LDS_BYTES, stream, a); }
#endif
}
```

```cpp
#include <hip/hip_runtime.h>
#include <hip/hip_bf16.h>
#include <cstdio>
#include <cstdint>
#include <cmath>

#define LAS __attribute__((address_space(3)))
#define GAS __attribute__((address_space(1)))
typedef unsigned short bf16_t;
typedef short bf16x8 __attribute__((ext_vector_type(8)));
typedef float f32x4 __attribute__((ext_vector_type(4)));
typedef float f32x2 __attribute__((ext_vector_type(2)));
typedef unsigned u32x4 __attribute__((ext_vector_type(4)));
typedef unsigned u32x2 __attribute__((ext_vector_type(2)));
typedef int i32x4 __attribute__((ext_vector_type(4)));
typedef int i32x8 __attribute__((ext_vector_type(8)));

typedef __bf16 bf16x2_t __attribute__((ext_vector_type(2)));
__device__ __forceinline__ unsigned cvt_pk_bf16(float lo, float hi) { const f32x2 v = {lo, hi}; const bf16x2_t b = __builtin_convertvector(v, bf16x2_t); return __builtin_bit_cast(unsigned, b); }
__device__ __forceinline__ float bf2f(unsigned short b) { return __uint_as_float(((unsigned)b) << 16); }
__device__ __forceinline__ float bflo(unsigned w) { return __uint_as_float(w << 16); }
__device__ __forceinline__ float bfhi(unsigned w) { return __uint_as_float(w & 0xffff0000u); }

__device__ __forceinline__ void glds16s(const void* sbase, unsigned voff, unsigned lds_dst) { unsigned keep;
    asm volatile("s_nop 4\n\ts_mov_b32 %0, m0\n\ts_mov_b32 m0, %3\n\ts_nop 0\n\tglobal_load_lds_dwordx4 %1, %2\n\ts_mov_b32 m0, %0" : "=&s"(keep) : "v"(voff), "s"(sbase), "s"(lds_dst) : "memory"); }
__device__ __forceinline__ void glds4s(const void* sbase, unsigned voff, unsigned lds_dst) { unsigned keep;
    asm volatile("s_nop 4\n\ts_mov_b32 %0, m0\n\ts_mov_b32 m0, %3\n\ts_nop 0\n\tglobal_load_lds_dword %1, %2\n\ts_mov_b32 m0, %0" : "=&s"(keep) : "v"(voff), "s"(sbase), "s"(lds_dst) : "memory"); }
__device__ __forceinline__ const char* uni_ptr(const char* p) { const unsigned long long v = (unsigned long long)p; const unsigned lo = __builtin_amdgcn_readfirstlane((unsigned)v), hi = __builtin_amdgcn_readfirstlane((unsigned)(v >> 32)); return (const char*)(((unsigned long long)hi << 32) | lo); }
namespace pg8 {
constexpr int BM = 256, BK = 64, HALF = 128, HTB = HALF * BK * 2, STAGE_BYTES = 8 * HTB, NXCD = 8, WGM = 8;
__host__ __device__ __forceinline__ int lds_byte(int r, int c) { const int st = (r >> 4) * 2 + (c >> 5), rr = r & 15, cc = c & 31, ob = rr * 64 + cc * 2; return st * 1024 + (ob ^ (((ob >> 9) & 1) << 5)); }
__host__ __device__ __forceinline__ void stage_rc(int b, int& R, int& C) { const int st = b / 1024, sb = b % 1024, swz = sb ^ (((sb >> 9) & 1) << 5); R = (st >> 1) * 16 + swz / 64; C = (st & 1) * 32 + (swz % 64) / 2; }
__host__ __device__ __forceinline__ int perm32(int rho) { const int n = rho >> 4, i = rho & 15; return 8 * (i >> 2) + 4 * n + (i & 3); }

struct Unit { int pm, pn; const char* A; const char* B; const LAS unsigned short* tl; int x0, x1, x2; };
struct Gemm { int K, lda, ldb; const char* Abase; };

__device__ __forceinline__ bool tile_order(int i, int G, int c, int nM, int nN, int& pm, int& pn) {
    const int nwg = nM * nN; const long L = (long)i * G + c; if (L >= nwg) return false;
    int wgid = (int)L; { const int q = nwg / NXCD, r = nwg % NXCD, xcd = wgid % NXCD, off = wgid / NXCD; wgid = (xcd < r ? xcd * (q + 1) : r * (q + 1) + (xcd - r) * q) + off; }
    const int nig = WGM * nN, gid = wgid / nig, fm = gid * WGM, gsz = (nM - fm) < WGM ? (nM - fm) : WGM;
    pm = fm + ((wgid % nig) % gsz); pn = (wgid % nig) / gsz; return true;
}

template <class Epi, class Sched, bool ALIGN_EPI, bool GATHER, bool FP8 = false, bool HALFSEL = false>
__device__ __forceinline__ void gemm_phase(LAS unsigned char* lds, const Gemm g, const Sched& S, const Epi& E) {
    const int tid = threadIdx.x, wid = __builtin_amdgcn_readfirstlane(tid >> 6), lane = tid & 63, wr = wid >> 2, wc = wid & 3, fr = lane & 15, fq = lane >> 4;
    const int K = g.K, nt = K / BK;
    int RA[2]; unsigned cA2[2], voffB[2];
#pragma unroll
    for (int i = 0; i < 2; ++i) { int R, C; stage_rc(tid * 16 + i * 8192, R, C); const int Rb = Epi::PERM ? ((R & ~31) + perm32(R & 31)) : R;
        RA[i] = R; cA2[i] = (unsigned)C * 2u; voffB[i] = (unsigned)(Rb * g.ldb + C) * 2u; }
    const size_t kstep = (size_t)(BK * 2);
    const unsigned hstepA = (unsigned)HALF * (unsigned)g.lda * 2u; const size_t hstepB = (size_t)HALF * g.ldb * 2;
    const unsigned ldsb = (unsigned)__builtin_amdgcn_readfirstlane((unsigned)(unsigned long long)lds + (unsigned)wid * 1024u);
    const int aoff = lds_byte(wr * 64 + fr, fq * 8), boff = lds_byte(wc * 32 + fr, fq * 8);
    const int aoff2 = aoff + 1024, boff2 = boff + 1024;
#define PG8_SA(b, h) (((b) * 2 + (h)) * HTB)
#define PG8_SB(b, h) ((4 + (b) * 2 + (h)) * HTB)
#define PG8_STAGE(bufoff, gbase, voff) do { _Pragma("unroll") for (int _i = 0; _i < 2; ++_i) glds16s((gbase), (voff)[_i], ldsb + (unsigned)(bufoff) + _i * 8192u); } while (0)
#define PG8_STAGE_A(bufoff, gbase, AO, h) do { _Pragma("unroll") for (int _i = 0; _i < 2; ++_i) glds16s((gbase), (AO)[h][_i], ldsb + (unsigned)(bufoff) + _i * 8192u); } while (0)
#define PG8_LD8(base_, o1_, o2_) __builtin_shufflevector(*(const LAS i32x4*)(lds + (base_) + (o1_)), *(const LAS i32x4*)(lds + (base_) + (o2_)), 0, 1, 2, 3, 4, 5, 6, 7)
#define PG8_LDA(dst, b, h) do { if constexpr (FP8) { _Pragma("unroll") for (int m = 0; m < 4; ++m) dst##8[m] = PG8_LD8(PG8_SA(b, h) + m * 2048, aoff, aoff2); } \
        else { _Pragma("unroll") for (int m = 0; m < 4; ++m) _Pragma("unroll") for (int k = 0; k < 2; ++k) dst[m][k] = *(const LAS bf16x8*)(lds + PG8_SA(b, h) + aoff + m * 2048 + k * 1024); } } while (0)
#define PG8_LDB(dst, b, h) do { if constexpr (FP8) { _Pragma("unroll") for (int n = 0; n < 2; ++n) dst##8[n] = PG8_LD8(PG8_SB(b, h) + n * 2048, boff, boff2); } \
        else { _Pragma("unroll") for (int n = 0; n < 2; ++n) _Pragma("unroll") for (int k = 0; k < 2; ++k) dst[n][k] = *(const LAS bf16x8*)(lds + PG8_SB(b, h) + boff + n * 2048 + k * 1024); } } while (0)
#define PG8_MMA(ai, bj, At, Bt) do { __builtin_amdgcn_s_setprio(1); _Pragma("unroll") for (int m = 0; m < 4; ++m) _Pragma("unroll") for (int n = 0; n < 2; ++n) { \
        if constexpr (FP8) asm volatile("v_mfma_f32_16x16x128_f8f6f4 %0, %1, %2, %0" : "+v"(acc[ai][bj][m][n]) : "v"(Bt##8[n]), "v"(At##8[m])); \
        else { _Pragma("unroll") for (int k = 0; k < 2; ++k) acc[ai][bj][m][n] = __builtin_amdgcn_mfma_f32_16x16x32_bf16(Bt[n][k], At[m][k], acc[ai][bj][m][n], 0, 0, 0); } } \
        __builtin_amdgcn_s_setprio(0); } while (0)
#define PG8_WAIT_V(n) asm volatile("s_waitcnt vmcnt(" #n ")" ::: "memory")
#define PG8_WAIT_L(n) asm volatile("s_waitcnt lgkmcnt(" #n ")" ::: "memory")
#define PG8_BAR __builtin_amdgcn_s_barrier()
#define PG8_SCHED __builtin_amdgcn_sched_barrier(0)
#define PG8_AOFF(AO, U) do { _Pragma("unroll") for (int _h = 0; _h < 2; ++_h) _Pragma("unroll") for (int _i = 0; _i < 2; ++_i) { \
        if constexpr (GATHER) AO[_h][_i] = (unsigned)(U).tl[RA[_i] + _h * HALF] * (unsigned)(g.lda * 2) + cA2[_i]; \
        else AO[_h][_i] = (unsigned)RA[_i] * (unsigned)(g.lda * 2) + cA2[_i] + (unsigned)_h * hstepA; } } while (0)
    Unit cur, nxt; int ui = 0;
    if (!S.next(0, cur)) return;
    f32x4 acc[2][2][4][2];
#pragma unroll
    for (int a = 0; a < 2; ++a)
#pragma unroll
        for (int b = 0; b < 2; ++b)
#pragma unroll
            for (int m = 0; m < 4; ++m)
#pragma unroll
                for (int n = 0; n < 2; ++n) acc[a][b][m][n] = (f32x4){0.f, 0.f, 0.f, 0.f};
    bf16x8 At[4][2], B0[2][2], B1[2][2]; i32x8 At8[4], B08[2], B18[2];
    E.prep(cur, 0, wid, lane);
    unsigned aoC[2][2], aoN[2][2];
    PG8_AOFF(aoC, cur);
    const char* cA = uni_ptr(GATHER ? g.Abase : cur.A); const char* cB = uni_ptr(cur.B);
    PG8_STAGE(PG8_SB(0, 0), cB, voffB); PG8_STAGE(PG8_SB(0, 1), cB + hstepB, voffB); PG8_STAGE_A(PG8_SA(0, 0), cA, aoC, 0); PG8_STAGE_A(PG8_SA(0, 1), cA, aoC, 1);
    if (wr == 1) PG8_BAR;
    PG8_WAIT_V(2); PG8_BAR;
    PG8_STAGE(PG8_SB(1, 0), cB + kstep, voffB); PG8_STAGE_A(PG8_SA(1, 0), cA + kstep, aoC, 0); PG8_STAGE(PG8_SB(1, 1), cB + hstepB + kstep, voffB);
    PG8_WAIT_V(6); PG8_BAR;
    for (;;) {
        const bool has_next = S.next(ui + 1, nxt);
        if (has_next) E.prep(nxt, ui + 1, wid, lane);
        if constexpr (GATHER) { if (has_next) PG8_AOFF(aoN, nxt); else { _Pragma("unroll") for (int _h = 0; _h < 2; ++_h) _Pragma("unroll") for (int _i = 0; _i < 2; ++_i) aoN[_h][_i] = aoC[_h][_i]; } }
        const char* nA = uni_ptr(GATHER ? g.Abase : (has_next ? nxt.A : cA)); const char* nB = uni_ptr(has_next ? nxt.B : cB);
        const bool dh0 = cur.x2 != 2, dh1 = cur.x2 != 1;
#pragma nounroll
        for (int t = 0; t < nt; t += 2) {
            const bool last = (t == nt - 2);
            const char* a1 = cA + (size_t)(t + 1) * kstep;
            const char* a2 = last ? nA : cA + (size_t)(t + 2) * kstep; const char* b2 = last ? nB : cB + (size_t)(t + 2) * kstep;
            const char* a3 = a2 + kstep; const char* b3 = b2 + kstep;
            unsigned aoS[2][2];
#pragma unroll
            for (int _h = 0; _h < 2; ++_h)
#pragma unroll
                for (int _i = 0; _i < 2; ++_i) aoS[_h][_i] = (GATHER && last) ? aoN[_h][_i] : aoC[_h][_i];
            PG8_LDB(B0, 0, 0); PG8_LDB(B1, 0, 1); PG8_SCHED; PG8_LDA(At, 0, 0); PG8_STAGE_A(PG8_SA(1, 1), a1, aoC, 1);
            PG8_WAIT_V(8); PG8_WAIT_L(0); PG8_BAR; if (!HALFSEL || dh0) PG8_MMA(0, 0, At, B0); if (!HALFSEL || dh1) PG8_MMA(0, 1, At, B1); PG8_BAR; PG8_SCHED;
            PG8_LDA(At, 0, 1); PG8_STAGE(PG8_SB(0, 0), b2, voffB); PG8_STAGE(PG8_SB(0, 1), b2 + hstepB, voffB); PG8_STAGE_A(PG8_SA(0, 0), a2, aoS, 0);
            PG8_WAIT_V(8); PG8_WAIT_L(0); PG8_BAR; if (!HALFSEL || dh0) PG8_MMA(1, 0, At, B0); if (!HALFSEL || dh1) PG8_MMA(1, 1, At, B1); PG8_BAR; PG8_SCHED;
            PG8_LDB(B0, 1, 0); PG8_LDB(B1, 1, 1); PG8_SCHED; PG8_LDA(At, 1, 0); PG8_STAGE_A(PG8_SA(0, 1), a2, aoS, 1);
            PG8_WAIT_V(8); PG8_WAIT_L(0); PG8_BAR; if (!HALFSEL || dh0) PG8_MMA(0, 0, At, B0); if (!HALFSEL || dh1) PG8_MMA(0, 1, At, B1); PG8_BAR; PG8_SCHED;
            PG8_LDA(At, 1, 1); PG8_STAGE(PG8_SB(1, 0), b3, voffB); PG8_STAGE(PG8_SB(1, 1), b3 + hstepB, voffB); PG8_STAGE_A(PG8_SA(1, 0), a3, aoS, 0);
            PG8_WAIT_V(8); PG8_WAIT_L(0); PG8_BAR; if (!HALFSEL || dh0) PG8_MMA(1, 0, At, B0); if (!HALFSEL || dh1) PG8_MMA(1, 1, At, B1); PG8_BAR; PG8_SCHED;
        }
        if constexpr (FP8) asm volatile("s_nop 15\n\ts_nop 15" ::: "memory");
        if constexpr (ALIGN_EPI) { if (wr == 0) PG8_BAR; }
        E(acc, cur, wr, wc, fr, fq);
        if (!has_next) break;
#pragma unroll
        for (int a = 0; a < 2; ++a)
#pragma unroll
            for (int b = 0; b < 2; ++b)
#pragma unroll
                for (int m = 0; m < 4; ++m)
#pragma unroll
                    for (int n = 0; n < 2; ++n) acc[a][b][m][n] = (f32x4){0.f, 0.f, 0.f, 0.f};
        if constexpr (FP8) asm volatile("s_nop 7" ::: "memory");
        cur = nxt; cA = nA; cB = nB; ++ui;
        if constexpr (GATHER) {
#pragma unroll
            for (int _h = 0; _h < 2; ++_h)
#pragma unroll
                for (int _i = 0; _i < 2; ++_i) aoC[_h][_i] = aoN[_h][_i]; }
        if constexpr (ALIGN_EPI) { if (wr == 1) PG8_BAR; }
    }
    PG8_WAIT_V(0);
    if constexpr (!ALIGN_EPI) { if (wr == 0) PG8_BAR; }
    PG8_BAR;
#undef PG8_SA
#undef PG8_SB
#undef PG8_STAGE
#undef PG8_STAGE_A
#undef PG8_LDA
#undef PG8_LD8
#undef PG8_LDB
#undef PG8_MMA
#undef PG8_WAIT_V
#undef PG8_WAIT_L
#undef PG8_BAR
#undef PG8_SCHED
#undef PG8_AOFF
}
}
#include <hip/hip_bf16.h>
namespace attn_body {
using bf16=__hip_bfloat16;
using bf16x8=__attribute__((ext_vector_type(8)))short;
using s16x4=__attribute__((ext_vector_type(4)))short;
using f32x16=__attribute__((ext_vector_type(16)))float;
using u32x4=__attribute__((ext_vector_type(4)))unsigned;
constexpr int BATCH=4,NHEAD=16,SEQ=4096,D=64,DM=NHEAD*D;
constexpr int NW=8,QBLK=32,QB=QBLK*NW,KVBLK=64,NQB=SEQ/QB;
constexpr int ATTN_PITCH=DM, ATTN_UNIT_ROWS=QB;
__device__ __forceinline__ int crow(int r,int hi){return (r&3)+8*(r>>2)+4*hi;}
#define SBAR() __builtin_amdgcn_sched_barrier(0)
__device__ __forceinline__ void cmask(f32x16&p0,f32x16&p1,int jb,int qrel,int hi){
  const float NEG=-INFINITY; int d=qrel-64*jb-4*hi; asm volatile("":"+v"(d));
  #pragma unroll
  for(int r=0;r<16;++r){const int c=(r&3)+8*(r>>2); if(c>d)p0[r]=NEG; if(c+32>d)p1[r]=NEG;}
}

constexpr int NSLOT=3, SLOTB=8192;
constexpr int LDS_GT=98304;
constexpr int LDS_K=0, LDS_V=NSLOT*SLOTB, LDS_WS=2*NSLOT*SLOTB, LDS_OST=LDS_WS+NW*64*4, LDS_BYTES=LDS_OST+NW*4096;
constexpr float C2=0.125f*1.4426950408889634f;
__device__ __forceinline__ void glds16(const void*gsrc,unsigned lds_dst){unsigned keep;
  asm volatile("s_mov_b32 %0, m0\n\ts_mov_b32 m0, %2\n\ts_nop 0\n\tglobal_load_lds_dwordx4 %1, off\n\ts_mov_b32 m0, %0":"=&s"(keep):"v"(gsrc),"s"(lds_dst):"memory");}
__device__ __forceinline__ void glds16s(const void*sbase,unsigned voff,unsigned lds_dst){unsigned keep;
  asm volatile("s_nop 4\n\ts_mov_b32 %0, m0\n\ts_mov_b32 m0, %3\n\ts_nop 0\n\tglobal_load_lds_dwordx4 %1, %2\n\ts_mov_b32 m0, %0":"=&s"(keep):"v"(voff),"s"(sbase),"s"(lds_dst):"memory");}
__device__ __forceinline__ unsigned lane_now(){unsigned l;asm volatile("v_mbcnt_lo_u32_b32 %0, -1, 0\n\tv_mbcnt_hi_u32_b32 %0, -1, %0":"=v"(l));return l;}
__device__ __forceinline__ float max3f(float a,float b,float c){float r;asm("v_max3_f32 %0, %1, %2, %3":"=v"(r):"v"(a),"v"(b),"v"(c));return r;}
__device__ __forceinline__ float max2f(float a,float b){float r;asm("v_max_f32_e32 %0, %1, %2":"=v"(r):"v"(a),"v"(b));return r;}
__device__ __forceinline__ float fadd_s(float a,float b){float r;asm("v_add_f32_e32 %0, %1, %2":"=v"(r):"v"(a),"v"(b));return r;}
__device__ __forceinline__ float fsub_s(float a,float b){float r;asm("v_sub_f32_e32 %0, %1, %2":"=v"(r):"v"(a),"v"(b));return r;}
typedef float f32x2_t __attribute__((ext_vector_type(2))); typedef __bf16 bf16x2_t __attribute__((ext_vector_type(2)));
__device__ __forceinline__ unsigned cvtpk_s(float lo,float hi){f32x2_t v={lo,hi};bf16x2_t b=__builtin_convertvector(v,bf16x2_t);return __builtin_bit_cast(unsigned,b);}
#define WAIT_BAR(N) asm volatile("s_waitcnt vmcnt(" #N ") lgkmcnt(0)\n\ts_barrier":::"memory")

__device__ __forceinline__ void qkt(f32x16&p0,f32x16&p1,const char*Kslot,const bf16x8*qr,int r32,int hi){
  const char*kb=Kslot+hi*1024+r32*16;
  #pragma unroll
  for(int d0=0;d0<4;++d0){
    const bf16x8 b0=*reinterpret_cast<const bf16x8*>(kb+d0*2048);
    const bf16x8 b1=*reinterpret_cast<const bf16x8*>(kb+d0*2048+512);
    if(d0==0){p0=__builtin_amdgcn_mfma_f32_32x32x16_bf16(b0,qr[0],(f32x16){0.f,0.f,0.f,0.f,0.f,0.f,0.f,0.f,0.f,0.f,0.f,0.f,0.f,0.f,0.f,0.f},0,0,0);p1=__builtin_amdgcn_mfma_f32_32x32x16_bf16(b1,qr[0],(f32x16){0.f,0.f,0.f,0.f,0.f,0.f,0.f,0.f,0.f,0.f,0.f,0.f,0.f,0.f,0.f,0.f},0,0,0);}
    else{p0=__builtin_amdgcn_mfma_f32_32x32x16_bf16(b0,qr[d0],p0,0,0,0);p1=__builtin_amdgcn_mfma_f32_32x32x16_bf16(b1,qr[d0],p1,0,0,0);}}
}
typedef __attribute__((address_space(3))) const char* lds_cptr;
typedef short v4i16_t __attribute__((ext_vector_type(4)));
__device__ __forceinline__ void kload8(bf16x8*kf,lds_cptr kp){
  kf[0]=*(const __attribute__((address_space(3))) bf16x8*)(kp);      kf[1]=*(const __attribute__((address_space(3))) bf16x8*)(kp+512);
  kf[2]=*(const __attribute__((address_space(3))) bf16x8*)(kp+2048); kf[3]=*(const __attribute__((address_space(3))) bf16x8*)(kp+2560);
  kf[4]=*(const __attribute__((address_space(3))) bf16x8*)(kp+4096); kf[5]=*(const __attribute__((address_space(3))) bf16x8*)(kp+4608);
  kf[6]=*(const __attribute__((address_space(3))) bf16x8*)(kp+6144); kf[7]=*(const __attribute__((address_space(3))) bf16x8*)(kp+6656);
}
__device__ __forceinline__ void kload2(bf16x8*kf,lds_cptr kp,int j){ kf[2*j]=*(const __attribute__((address_space(3))) bf16x8*)(kp+j*2048); kf[2*j+1]=*(const __attribute__((address_space(3))) bf16x8*)(kp+j*2048+512); }
__device__ __forceinline__ s16x4 vtr(lds_cptr p){ return __builtin_bit_cast(s16x4,__builtin_amdgcn_ds_read_tr16_b64_v4i16((__attribute__((address_space(3))) v4i16_t*)p)); }
__device__ __forceinline__ float rowmax(const f32x16&p0,const f32x16&p1){
  float a=max3f(p0[0],p0[1],p1[0]),b=max3f(p0[2],p0[3],p1[1]);a=max3f(a,p1[2],p1[3]);
  #pragma unroll
  for(int r=4;r<16;r+=4){a=max3f(a,p0[r],p0[r+1]);b=max3f(b,p0[r+2],p0[r+3]);a=max3f(a,p1[r],p1[r+1]);b=max3f(b,p1[r+2],p1[r+3]);}
  const float m=max2f(a,b);
  auto rr=__builtin_amdgcn_permlane32_swap(__float_as_uint(m),__float_as_uint(m),false,false);
  return max2f(__uint_as_float(rr[0]),__uint_as_float(rr[1]));
}
__device__ __forceinline__ void pv(f32x16*o,int vb,bf16x8 pa0,bf16x8 pa1,bf16x8 pa2,bf16x8 pa3){
  #pragma unroll
  for(int d0=0;d0<2;++d0){s16x4 lo[4],hi[4];
    #pragma unroll
    for(int ks=0;ks<4;++ks){
      asm volatile("ds_read_b64_tr_b16 %0,%1 offset:%c2":"=&v"(lo[ks]):"v"(vb),"i"(d0*4096+ks*1024):"memory");
      asm volatile("ds_read_b64_tr_b16 %0,%1 offset:%c2":"=&v"(hi[ks]):"v"(vb),"i"(d0*4096+ks*1024+512):"memory");}
    asm volatile("s_waitcnt lgkmcnt(0)":::"memory");SBAR();
    #define PK(k) (bf16x8){lo[k][0],lo[k][1],lo[k][2],lo[k][3],hi[k][0],hi[k][1],hi[k][2],hi[k][3]}
    o[d0]=__builtin_amdgcn_mfma_f32_32x32x16_bf16(pa0,PK(0),o[d0],0,0,0);
    o[d0]=__builtin_amdgcn_mfma_f32_32x32x16_bf16(pa1,PK(1),o[d0],0,0,0);
    o[d0]=__builtin_amdgcn_mfma_f32_32x32x16_bf16(pa2,PK(2),o[d0],0,0,0);
    o[d0]=__builtin_amdgcn_mfma_f32_32x32x16_bf16(pa3,PK(3),o[d0],0,0,0);
    #undef PK
  }
}

#ifndef ATTN_STORE16
#define ATTN_STORE16(p,v) (*(u32x4*)(p)=(v))
#endif
template<int THRL> __device__ __forceinline__ void attn_unit(int b,int h,int qb,const bf16*Q,const bf16*__restrict__ K,const bf16*__restrict__ V,bf16*O,const float*ksum,char*shm){
  const int tid=threadIdx.x,lane=tid&63,r32=lane&31,hi=lane>>5; const int wid=__builtin_amdgcn_readfirstlane(tid>>6);
  const long rowbase=(long)b*SEQ; const int q0=qb*QB;
  const bf16*Qw=Q+(rowbase+q0+wid*QBLK)*DM+h*D;
  const bf16*Kh=K+rowbase*DM+h*D,*Vh=V+rowbase*DM+h*D;
  const unsigned lds0=(unsigned)(uintptr_t)shm;
  float*wsf=(float*)(shm+LDS_WS)+wid*64;
  const unsigned kdst=lds0+LDS_K+wid*1024, vdst=lds0+LDS_V+wid*1024;
  #define PHYS(t) (((t)<4)?(4*qb+(t)):((t)-4))
  #define DMA_K(t,slot) glds16s((const char*)Kh+(size_t)PHYS(t)*(KVBLK*DM*2)+wid*16,lane_now()*(unsigned)(DM*2),(unsigned)__builtin_amdgcn_readfirstlane(kdst+(slot)))
  #define DMA_V(t,slot) glds16s((const char*)Vh+(size_t)PHYS(t)*(KVBLK*DM*2)+(size_t)(16*(wid&3))*(DM*2)+(wid>>2)*64,({const unsigned l_=lane_now(); (l_>>2)*(unsigned)(DM*2)+(l_&3u)*16u;}),(unsigned)__builtin_amdgcn_readfirstlane(vdst+(slot)))
  const int vb0=(int)(lds0+LDS_V)+((lane>>4)&1)*32+(lane&3)*8+(4*hi+((lane&15)>>2))*64;
  const char*Kbase=shm+LDS_K; bf16x8 kf[8];
  const lds_cptr shm3=(lds_cptr)shm; const lds_cptr kp0=shm3+LDS_K+hi*1024+r32*16; const lds_cptr vp0=shm3+LDS_V+((lane>>4)&1)*32+(lane&3)*8+(4*hi+((lane&15)>>2))*64;
  const int NT=(q0+QB)/KVBLK;
  DMA_K(0,0);DMA_V(0,0);DMA_K(1,SLOTB);
  { float*gt=(float*)(shm+LDS_GT);
    #pragma unroll
    for(int k=0;k<2;++k){ const int j=2*wid+k; if(j<qb) gt[j*64+lane]=ksum[(long)(b*16+j)*DM+h*D+lane]; } }
  bf16x8 qr[4];
  #pragma unroll
  for(int d0=0;d0<4;++d0)qr[d0]=*reinterpret_cast<const bf16x8*>(&Qw[(long)r32*DM+d0*16+hi*8]);

  unsigned sel=0u;
  float mhat=0.f,l_reg=0.f;f32x16 o[2];o[0]=f32x16{};o[1]=f32x16{};
  bf16x8 kone=(bf16x8){0,0,0,0,0,0,0,0}, qm=(bf16x8){0,0,0,0,0,0,0,0}; if(hi==0) kone[0]=(short)0x3F80;
  #define SETQM() do{ const unsigned short mb_=(unsigned short)(cvtpk_s(-mhat,0.f)&0xffffu); qm[0]=(hi==0)?(short)mb_:(short)0; asm volatile("":"+v"(qm)); }while(0)
  const int qrel=wid*QBLK+r32;
  #define CMASK(P0,P1,t) do{ const int t_=(t); if(t_<4){ const int l_=(int)lane_now(); cmask(P0,P1,t_,wid*QBLK+(l_&31),l_>>5); } else if(!((sel>>(((t_-4)>>2)&15))&1u)){ _Pragma("unroll") for(int r=0;r<16;++r){P0[r]=-INFINITY;P1[r]=-INFINITY;} } }while(0)
  bool resc=false;
  #define START(P0,P1) do{ const float rm=rowmax(P0,P1); resc=false; \
    { const float dl=__uint_as_float(cvtpk_s(rm,0.f)<<16); mhat=fadd_s(mhat,dl);          \
      _Pragma("unroll") for(int r=0;r<16;++r){P0[r]=fsub_s(P0[r],dl);P1[r]=fsub_s(P1[r],dl);} \
      SETQM(); } \
    _Pragma("unroll") for(int r=0;r<16;++r)P0[r]=__builtin_amdgcn_exp2f(P0[r]); }while(0)
  #define RESC() do{ if(resc){ asm volatile("s_waitcnt lgkmcnt(0)":::"memory"); \
      _Pragma("unroll") for(int d_=0;d_<2;++d_) _Pragma("unroll") for(int r=0;r<16;++r)o[d_][r]*=wsf[crow(r,(int)(lane_now()>>5))]; } }while(0)
  f32x16 pA0,pA1,pB0,pB1;
  int sl_prev=0,sl_cur=0,sl_next=SLOTB;
  #define ROT() do{sl_prev=sl_cur;sl_cur=sl_next;sl_next=(sl_next==(NSLOT-1)*SLOTB)?0:sl_next+SLOTB;}while(0)
  DMA_K(2,2*SLOTB);
  WAIT_BAR(3);
  { float qf[32];
    #pragma unroll
    for(int d0=0;d0<4;++d0){
      #pragma unroll
      for(int i=0;i<8;++i) qf[d0*8+i]=__uint_as_float(((unsigned)(unsigned short)qr[d0][i])<<16); }
    const float*gt=(const float*)(shm+LDS_GT)+hi*8; float g[15];
    #pragma unroll
    for(int j=0;j<15;++j){ g[j]=-INFINITY;
      if(j<qb){ const float*kp=gt+j*64; float a=0.f;
        #pragma unroll
        for(int d0=0;d0<4;++d0){ const float4 k0=*reinterpret_cast<const float4*>(kp+d0*16), k1=*reinterpret_cast<const float4*>(kp+d0*16+4);
          a+=qf[d0*8+0]*k0.x; a+=qf[d0*8+1]*k0.y; a+=qf[d0*8+2]*k0.z; a+=qf[d0*8+3]*k0.w; a+=qf[d0*8+4]*k1.x; a+=qf[d0*8+5]*k1.y; a+=qf[d0*8+6]*k1.z; a+=qf[d0*8+7]*k1.w; }
        g[j]=a+__shfl_xor(a,32); } }
    #pragma unroll
    for(int kk=0;kk<3;++kk){ float best=-INFINITY; int bj=-1;
      #pragma unroll
      for(int j=0;j<15;++j){ const bool c=(j<qb)&&!((sel>>j)&1u)&&(g[j]>best); best=c?g[j]:best; bj=c?j:bj; }
      if(bj>=0) sel|=(1u<<bj); } }
  qkt(pA0,pA1,Kbase,qr,r32,hi);asm volatile("s_nop 15\n\ts_nop 7":"+v"(pA0),"+v"(pA1));CMASK(pA0,pA1,0);
  START(pA0,pA1);
  _Pragma("unroll") for(int r=0;r<16;++r)pA1[r]=__builtin_amdgcn_exp2f(pA1[r]);
  WAIT_BAR(0);
  DMA_K(3,0);DMA_V(1,SLOTB);
  ROT();
  kload8(kf,kp0+sl_cur);
  WAIT_BAR(2);
  s16x4 vlo[8],vhi[8]; u32x4 pw0,pw1,pw2,pw3;
  #define PKW(P,B) cvtpk_s(P[B],P[B+1])
  #define PAF(k) __builtin_bit_cast(bf16x8,pw##k)
  #define VFR(i) (bf16x8){vlo[i][0],vlo[i][1],vlo[i][2],vlo[i][3],vhi[i][0],vhi[i][1],vhi[i][2],vhi[i][3]}
  #define PIN(x) asm volatile("":"+v"(x))
  #define MX3(a,b,c) __builtin_fmaxf(__builtin_fmaxf((a),(b)),(c))
  #define GAPA(MF,A0,A1,A2,A3,W0,W1,PW) do{ MF; sacc+=A0; sacc+=A1; sacc+=A2; sacc+=A3; PIN(sacc); W0; W1; PIN(PW); SBAR(); }while(0)
  #define EX(v) __builtin_amdgcn_exp2f(v)
  #define GAPB(MF,X,B) do{ MF; X[B]=EX(X[B]); X[B+1]=EX(X[B+1]); X[B+2]=EX(X[B+2]); X[B+3]=EX(X[B+3]); PIN(X); SBAR(); }while(0)
  #define VRD(i) do{ vlo[i]=vtr(vp_+(((i)>>2)*4096+((i)&3)*1024)); vhi[i]=vtr(vp_+(((i)>>2)*4096+((i)&3)*1024+512)); }while(0)
  #define KRD(G,j) do{ if(G){ kload2(kf,kp0+sl_next,j); SBAR(); } }while(0)
  #define STEP(C0,C1,P0,P1,t,GK,GV,GL) do{ SBAR(); \
    const lds_cptr vp_=vp0+sl_prev; \
    C0=__builtin_amdgcn_mfma_f32_32x32x16_bf16(kone,qm,(f32x16){0.f,0.f,0.f,0.f,0.f,0.f,0.f,0.f,0.f,0.f,0.f,0.f,0.f,0.f,0.f,0.f},0,0,0); C1=__builtin_amdgcn_mfma_f32_32x32x16_bf16(kone,qm,(f32x16){0.f,0.f,0.f,0.f,0.f,0.f,0.f,0.f,0.f,0.f,0.f,0.f,0.f,0.f,0.f,0.f},0,0,0); SBAR(); \
    VRD(0); SBAR(); float sacc=(P0[0]+P0[1]); \
    GAPA(C0=__builtin_amdgcn_mfma_f32_32x32x16_bf16(kf[0],qr[0],C0,0,0,0), P0[2],P0[3],P0[4],P0[5],     pw0[0]=PKW(P0,0), pw0[1]=PKW(P0,2), pw0); \
    VRD(4); SBAR(); GAPA(C1=__builtin_amdgcn_mfma_f32_32x32x16_bf16(kf[1],qr[0],C1,0,0,0), P0[6],P0[7],P0[8],P0[9],     pw0[2]=PKW(P0,4), pw0[3]=PKW(P0,6), pw0); \
    VRD(1); SBAR(); GAPA(C0=__builtin_amdgcn_mfma_f32_32x32x16_bf16(kf[2],qr[1],C0,0,0,0),   P0[10],P0[11],P0[12],P0[13], pw1[0]=PKW(P0,8), pw1[1]=PKW(P0,10), pw1); \
    VRD(5); SBAR(); GAPA(C1=__builtin_amdgcn_mfma_f32_32x32x16_bf16(kf[3],qr[1],C1,0,0,0),   P0[14],P0[15],P1[0],P1[1],   pw1[2]=PKW(P0,12),pw1[3]=PKW(P0,14), pw1); \
    VRD(2); SBAR(); GAPA(C0=__builtin_amdgcn_mfma_f32_32x32x16_bf16(kf[4],qr[2],C0,0,0,0),   P1[2],P1[3],P1[4],P1[5],     pw2[0]=PKW(P1,0), pw2[1]=PKW(P1,2), pw2); \
    VRD(6); SBAR(); GAPA(C1=__builtin_amdgcn_mfma_f32_32x32x16_bf16(kf[5],qr[2],C1,0,0,0),   P1[6],P1[7],P1[8],P1[9],     pw2[2]=PKW(P1,4), pw2[3]=PKW(P1,6), pw2); \
    VRD(3); SBAR(); GAPA(C0=__builtin_amdgcn_mfma_f32_32x32x16_bf16(kf[6],qr[3],C0,0,0,0),   P1[10],P1[11],P1[12],P1[13], pw3[0]=PKW(P1,8), pw3[1]=PKW(P1,10), pw3); \
    VRD(7); SBAR(); GAPA(C1=__builtin_amdgcn_mfma_f32_32x32x16_bf16(kf[7],qr[3],C1,0,0,0),   P1[14],P1[15],0.f,0.f,       pw3[2]=PKW(P1,12),pw3[3]=PKW(P1,14), pw3); \
    l_reg+=sacc; \
    if(GK){DMA_K((t)+3,sl_cur);} if(GV){DMA_V((t)+1,sl_next);} \
    CMASK(C0,C1,t); \
    { float a=MX3(C0[0],C0[1],C1[0]),b=MX3(C0[2],C0[3],C1[1]); a=MX3(a,C1[2],C1[3]); \
      _Pragma("unroll") for(int r=4;r<16;r+=4){a=MX3(a,C0[r],C0[r+1]);b=MX3(b,C0[r+2],C0[r+3]);a=MX3(a,C1[r],C1[r+1]);b=MX3(b,C1[r+2],C1[r+3]);} \
      float rm=__builtin_fmaxf(a,b); { auto rr=__builtin_amdgcn_permlane32_swap(__float_as_uint(rm),__float_as_uint(rm),false,false); rm=__builtin_fmaxf(__uint_as_float(rr[0]),__uint_as_float(rr[1])); } \
      resc=false; \
      if(__builtin_expect(__any(rm>(float)THRL),0)){ const float mn_=__uint_as_float(cvtpk_s(mhat+__builtin_fmaxf(rm,0.f),0.f)<<16); const float dl=mn_-mhat; mhat=mn_; \
        _Pragma("unroll") for(int r=0;r<16;++r){C0[r]-=dl;C1[r]-=dl;} \
        SETQM(); \
        const float f=__builtin_amdgcn_exp2f(-dl); l_reg*=f; { const int l_=(int)lane_now(); if((l_>>5)==0)wsf[l_&31]=f; } resc=true; } } \
    SBAR(); \
    GAPB(o[0]=__builtin_amdgcn_mfma_f32_32x32x16_bf16(PAF(0),VFR(0),o[0],0,0,0), C0,0); \
    GAPB(o[1]=__builtin_amdgcn_mfma_f32_32x32x16_bf16(PAF(0),VFR(4),o[1],0,0,0), C0,4); \
    KRD(GL,0); GAPB(o[0]=__builtin_amdgcn_mfma_f32_32x32x16_bf16(PAF(1),VFR(1),o[0],0,0,0), C0,8); \
    KRD(GL,1); GAPB(o[1]=__builtin_amdgcn_mfma_f32_32x32x16_bf16(PAF(1),VFR(5),o[1],0,0,0), C0,12); \
    KRD(GL,2); GAPB(o[0]=__builtin_amdgcn_mfma_f32_32x32x16_bf16(PAF(2),VFR(2),o[0],0,0,0), C1,0); \
    KRD(GL,3); GAPB(o[1]=__builtin_amdgcn_mfma_f32_32x32x16_bf16(PAF(2),VFR(6),o[1],0,0,0), C1,4); \
    GAPB(o[0]=__builtin_amdgcn_mfma_f32_32x32x16_bf16(PAF(3),VFR(3),o[0],0,0,0), C1,8); \
    GAPB(o[1]=__builtin_amdgcn_mfma_f32_32x32x16_bf16(PAF(3),VFR(7),o[1],0,0,0), C1,12); \
    }while(0)
  int t=1;
  #undef CMASK
  #define CMASK(P0,P1,t) do{ const int t_=(t); if(t_<4){ const int l_=(int)lane_now(); cmask(P0,P1,t_,wid*QBLK+(l_&31),l_>>5); } else if(!((sel>>(((t_-4)>>2)&15))&1u)){ _Pragma("unroll") for(int r=0;r<16;++r){P0[r]=-INFINITY;P1[r]=-INFINITY;} } }while(0)
  for(;t+5<NT;t+=2){
    STEP(pB0,pB1,pA0,pA1,t,true,true,true);     WAIT_BAR(2); RESC(); ROT();
    STEP(pA0,pA1,pB0,pB1,t+1,true,true,true);   WAIT_BAR(2); RESC(); ROT();
  }
  #undef CMASK
  #define CMASK(P0,P1,t) do{ const int t_=(t); if(t_<4){ const int l_=(int)lane_now(); cmask(P0,P1,t_,wid*QBLK+(l_&31),l_>>5); } else if(!((sel>>(((t_-4)>>2)&15))&1u)){ _Pragma("unroll") for(int r=0;r<16;++r){P0[r]=-INFINITY;P1[r]=-INFINITY;} } }while(0)
  #define ENDW(tt) do{ if((tt)+3<NT){WAIT_BAR(2);} else if((tt)+2<NT){WAIT_BAR(1);} else {WAIT_BAR(0);} }while(0)
  for(;t+1<NT;t+=2){
    STEP(pB0,pB1,pA0,pA1,t,(t+3<NT),(t+1<NT),(t+1<NT));       ENDW(t);   RESC(); ROT();
    STEP(pA0,pA1,pB0,pB1,t+1,(t+4<NT),(t+2<NT),(t+2<NT));     ENDW(t+1); RESC(); ROT();
  }
  STEP(pB0,pB1,pA0,pA1,NT-1,false,false,false); RESC();
  { float sacc=pB0[0]+pB0[1]; _Pragma("unroll") for(int r=2;r<16;++r)sacc+=pB0[r]; _Pragma("unroll") for(int r=0;r<16;++r)sacc+=pB1[r]; l_reg+=sacc;
    pw0=(u32x4){PKW(pB0,0),PKW(pB0,2),PKW(pB0,4),PKW(pB0,6)};pw1=(u32x4){PKW(pB0,8),PKW(pB0,10),PKW(pB0,12),PKW(pB0,14)};pw2=(u32x4){PKW(pB1,0),PKW(pB1,2),PKW(pB1,4),PKW(pB1,6)};pw3=(u32x4){PKW(pB1,8),PKW(pB1,10),PKW(pB1,12),PKW(pB1,14)};
    SBAR(); pv(o,vb0+sl_cur,PAF(0),PAF(1),PAF(2),PAF(3)); }
  #undef PKW
  #undef PAF
  #undef VFR
  #undef PIN
  #undef MX3
  #undef GAPA
  #undef GAPB
  #undef EX
  #undef VRD
  #undef KRD
  #undef STEP
  #undef ENDW
  {auto rr=__builtin_amdgcn_permlane32_swap(__float_as_uint(l_reg),__float_as_uint(l_reg),false,false);l_reg=__uint_as_float(rr[0])+__uint_as_float(rr[1]);}
  if(hi==0)wsf[32+r32]=l_reg;asm volatile("s_waitcnt lgkmcnt(0)":::"memory");
  float rli[16];
  #pragma unroll
  for(int r=0;r<16;++r)rli[r]=__builtin_amdgcn_rcpf(wsf[32+crow(r,hi)]);
  bf16*Ow=O+(rowbase+q0+wid*QBLK)*DM+h*D;
  { bf16*stg=(bf16*)(shm+LDS_OST)+wid*2048;
    #pragma unroll
    for(int r=0;r<16;++r){const int orow=crow(r,hi);
      #pragma unroll
      for(int d0=0;d0<2;++d0)stg[orow*64+d0*32+r32]=__float2bfloat16(o[d0][r]*rli[r]);}
    asm volatile("s_waitcnt lgkmcnt(0)":::"memory");
    #pragma unroll
    for(int i=0;i<4;++i){const int row=i*8+(lane>>3),ch=lane&7; const u32x4 v=*(const u32x4*)(stg+row*64+ch*8); ATTN_STORE16(Ow+(long)row*DM+ch*8,v);} }
  asm volatile("s_waitcnt lgkmcnt(0)\n\ts_barrier":::"memory");
  #undef DMA_K
  #undef PHYS
  #undef DMA_V
  #undef CMASK
  #undef START
  #undef SETQM
  #undef RESC
  #undef ROT
}
constexpr int ATTN_LDS_BYTES=LDS_BYTES;
struct AttnTensors { const bf16* Q; const bf16* K; const bf16* V; bf16* O; const float* ksum; };
struct AttnUnit { int bh; int qb; };
struct StaticOrder {
  int vcu, G;
  __device__ __forceinline__ explicit StaticOrder(int grid,int block):vcu((grid%8==0)?((block%8)*(grid/8)+block/8):block),G(grid){}
  __device__ __forceinline__ bool next(int i,AttnUnit&u)const{ const int L=i*G+vcu; if(L>=1024)return false; const int w=L&255, rnd=L>>8, s=w&3; u.bh=w>>2; u.qb=(rnd==0)?s:(rnd==1)?7-s:(rnd==2)?8+s:15-s; return true; }
  __device__ __forceinline__ void a_ready(const AttnUnit&)const{}
  __device__ __forceinline__ void done(const AttnUnit&)const{}
};
struct SnakeOrder {
  int v, G;
  __device__ __forceinline__ bool next(int i,AttnUnit&u)const{ const int idx=i*G+((i&1)?(G-1-v):v); if(idx>=1024)return false; u.qb=15-(idx>>6); u.bh=idx&63; return true; }
  __device__ __forceinline__ void a_ready(const AttnUnit&)const{}
  __device__ __forceinline__ void done(const AttnUnit&)const{}
};
template<class Sched,int THRL=8> __device__ __forceinline__ void attn_phase(char*lds,const AttnTensors&T,const Sched&S){
  AttnUnit u;
  for(int i=0;S.next(i,u);++i){ S.a_ready(u); attn_unit<THRL>(u.bh/NHEAD,u.bh%NHEAD,u.qb,T.Q,T.K,T.V,T.O,T.ksum,lds); S.done(u); }
}
#undef SBAR
#undef WAIT_BAR
}
constexpr int NWAVES = 8, NTHR = 512;
constexpr int NTOK = 16384, DM = 1024, SEQ = 4096, NBATCH = 4, NEXP = 32;
constexpr float ALPHA = 1.4142135623730951f;
constexpr float LN_EPS = 1e-5f;
constexpr float RSQRT_DQK = 0.08838834764831845f;
constexpr int NPHASE = 19;
constexpr float FP8_SA = 4.0f, FP8_SWGU = 64.0f, FP8_SWD = 128.0f;
#ifndef DBG_ATTN_MUL
#define DBG_ATTN_MUL 1.0f
#endif
#ifndef DBG_MLSTM_MUL
#define DBG_MLSTM_MUL 1.0f
#endif
#ifndef DBG_MOE_MUL
#define DBG_MOE_MUL 1.0f
#endif
#ifndef DBG_P14_A
#define DBG_P14_A WS_HN
#endif
#ifndef NCONV
#define NCONV 72
#endif
#ifndef MK_ONE_LAUNCH
#define MK_ONE_LAUNCH 1
#endif

constexpr size_t MiB = 1u << 20, KiB = 1024;
constexpr size_t WS_CTL = 0, CTL_ZERO_BYTES = 1 * MiB;
constexpr int CW_TMO = 0, CW_BAR = 4096, CW_CNT = 8192, CW_AQ = 16384;
constexpr size_t WS_KSUM = 256 * KiB, WS_DEN = 512 * KiB;
constexpr size_t WS_WQKV = 2 * MiB, WS_WO = 8 * MiB, WS_WINA = 10 * MiB, WS_WINB = 14 * MiB, WS_WOUT = 17 * MiB;
constexpr size_t WS_WG = 19 * MiB, WS_RWT = 20 * MiB, WS_ROPE = 21 * MiB;
constexpr size_t WS_TOKE = 22 * MiB, WS_TOKP = 22 * MiB + 256 * KiB, WS_TOKG = 22 * MiB + 512 * KiB;
constexpr size_t WS_GI = 23 * MiB, WS_LF = 23 * MiB + 256 * KiB, WS_RF = 23 * MiB + 512 * KiB, WS_CF = 23 * MiB + 768 * KiB;
constexpr size_t WS_DEC = 24 * MiB, WS_NU = 24 * MiB + 256 * KiB, WS_NPREV = 24 * MiB + 512 * KiB;
constexpr size_t WS_ROWTOK = 25 * MiB;
constexpr size_t WS_XB = 32 * MiB, WS_Q = 64 * MiB, WS_K = 96 * MiB, WS_V = 128 * MiB;
constexpr size_t WS_R0 = 160 * MiB, WS_R1 = 224 * MiB, WS_R2 = 288 * MiB;
constexpr size_t WS_H = 352 * MiB, WS_Y = 496 * MiB;
constexpr size_t WS_WGU = 640 * MiB, WS_WD = 896 * MiB, WS_END = 1024 * MiB;
constexpr size_t WS_AE = 352 * MiB, WS_BE = 416 * MiB, WS_KN = 464 * MiB, WS_KT = 496 * MiB, WS_UT = 512 * MiB, WS_OS = 544 * MiB, WS_HN = 576 * MiB;

constexpr int RING_OFF = 0, RING_BYTES = 131072;
constexpr int LX = RING_BYTES;
constexpr int LX_MISC = LX;
constexpr int LX_TILEE = LX + 128;
constexpr int LX_TBASE = LX + 1280;
constexpr int LX_LCNT = LX + 1536, LX_GBASE = LX + 1664;
constexpr int LX_REC = LX + 1792;
constexpr int LX_TOKL = LX + 4096;
constexpr int LX_LNX = LX + 4096;
constexpr int LX_BIAS = LX + 12288;
constexpr int LDS_BYTES = 147456;
constexpr int TOKL_ROUNDS = 10;

#define RLX_AGENT __ATOMIC_RELAXED, __HIP_MEMORY_SCOPE_AGENT
#define LDS_WAIT() asm volatile("s_waitcnt lgkmcnt(0)" ::: "memory")
#define VM_WAIT() asm volatile("s_waitcnt vmcnt(0)" ::: "memory")
#define XB_TMO      128
#define XB_XCNT(j)  (256  + 64 * (j))
#define XB_XSUB(j)  (1280 + 64 * (j))
#define XB_XGEN(j)  (2304 + 64 * (j))
#define XB_TOP      3328
#define XB_TOPGEN   3392
#define XCD_BAR_WORDS 3456
#define XB_SPIN_CAP (1u << 18)

__device__ __forceinline__ unsigned xb_ld(unsigned* p)              { return __hip_atomic_load(p, __ATOMIC_RELAXED, __HIP_MEMORY_SCOPE_AGENT); }
__device__ __forceinline__ unsigned xb_add(unsigned* p, unsigned v) { return __hip_atomic_fetch_add(p, v, __ATOMIC_RELAXED, __HIP_MEMORY_SCOPE_AGENT); }
__device__ __forceinline__ unsigned xb_xcc_id() { return (unsigned)__builtin_amdgcn_s_getreg((3 << 11) | 20) & 0xFu; }
#define XB_SPIN(cond, bar) do { unsigned _sp = 0; while (cond) { __builtin_amdgcn_s_sleep(1); \
    if ((++_sp & 255u) == 0u) { if (xb_ld(&(bar)[XB_TMO])) break; if (_sp > XB_SPIN_CAP) { atomicAdd(&(bar)[XB_TMO], 1u); break; } } } } while (0)

struct XcdBarrier {
    unsigned* bar; unsigned x;
    volatile LAS unsigned* st;
};

__device__ __forceinline__ XcdBarrier xcd_barrier_post(unsigned* bar, volatile LAS unsigned* st) {
    XcdBarrier b; b.bar = bar; b.x = xb_xcc_id(); b.st = st;
    if (threadIdx.x == 0) (void)xb_add(&bar[XB_XCNT(b.x)], 1u);
    return b;
}
__device__ __forceinline__ void xcd_barrier_complete(unsigned* bar, unsigned x, unsigned& nloc, unsigned& nx) {
    const unsigned G = gridDim.x * gridDim.y * gridDim.z;
    unsigned sum, cnt, mine, sp = 0u;
    for (;;) {
        sum = 0u; cnt = 0u; mine = 0u;
#pragma unroll
        for (unsigned j = 0; j < 16; ++j) { const unsigned c = xb_ld(&bar[XB_XCNT(j)]); sum += c; cnt += (c > 0u) ? 1u : 0u; mine = (j == x) ? c : mine; }
        if (sum == G) break;
        __builtin_amdgcn_s_sleep(1);
        if ((++sp & 255u) == 0u) { if (xb_ld(&bar[XB_TMO])) break; if (sp > XB_SPIN_CAP) { atomicAdd(&bar[XB_TMO], 1u); break; } }
    }
    nloc = mine > 0u ? mine : 1u; nx = cnt > 0u ? cnt : 1u;
}

__device__ __forceinline__ void xcd_barrier(const XcdBarrier& b) {
    asm volatile("s_waitcnt vmcnt(0)" ::: "memory");
    __syncthreads();
    if (threadIdx.x == 0) {
        unsigned* bar = b.bar;
        __builtin_amdgcn_s_waitcnt(0);
        unsigned nloc = b.st[0], nx = b.st[1];
        if (nloc == 0u) { xcd_barrier_complete(bar, b.x, nloc, nx); b.st[0] = nloc; b.st[1] = nx; }
        const unsigned old = xb_add(&bar[XB_XSUB(b.x)], 1u);
        const unsigned gen = old / nloc;
        if (old + 1u == (gen + 1u) * nloc) {
            __builtin_amdgcn_fence(__ATOMIC_RELEASE, "agent");
            asm volatile("s_waitcnt vmcnt(0)" ::: "memory");
            const unsigned og = xb_add(&bar[XB_TOP], 1u);
            const unsigned tg = og / nx;
            if (og + 1u == (tg + 1u) * nx) xb_add(&bar[XB_TOPGEN], 1u);
            else XB_SPIN(xb_ld(&bar[XB_TOPGEN]) == tg, bar);
            __builtin_amdgcn_fence(__ATOMIC_ACQUIRE, "agent");
            xb_add(&bar[XB_XGEN(b.x)], 1u);
            asm volatile("s_waitcnt vmcnt(0)" ::: "memory");
        } else {
            XB_SPIN(xb_ld(&bar[XB_XGEN(b.x)]) == gen, bar);
            __builtin_amdgcn_fence(__ATOMIC_ACQUIRE, "agent");
            asm volatile("s_waitcnt vmcnt(0)" ::: "memory");
        }
    }
    __syncthreads();
}
using pg8::Unit; using pg8::Gemm;
typedef f32x4 (&AccRef)[2][2][4][2];

__device__ __forceinline__ bool moe_unit(int i, int G, int c, int nT, int nN, int& pm, int& pn, int& half) {
    const int U = nT * nN, R = U / G, rem = U - R * G; half = 0;
    if (i < R) return pg8::tile_order(i, G, c, nT, nN, pm, pn);
    if (i > R || rem == 0) return false;
    if (2 * rem <= G) { if (c >= 2 * rem) return false; half = 1 + (c & 1); return pg8::tile_order(0, U, R * G + (c >> 1), nT, nN, pm, pn); }
    return pg8::tile_order(i, G, c, nT, nN, pm, pn);
}
struct DenseSched {
    int nM, nN, G, c; const char* A; const char* B; size_t tstepA, tstepB; bool split = false;
    __device__ __forceinline__ bool next(int i, Unit& u) const {
        int half = 0;
        if (split) { if (!moe_unit(i, G, c, nM, nN, u.pm, u.pn, half)) return false; }
        else if (!pg8::tile_order(i, G, c, nM, nN, u.pm, u.pn)) return false;
        u.A = A + (size_t)u.pm * tstepA; u.B = B + (size_t)u.pn * tstepB; u.tl = nullptr; u.x0 = u.x1 = 0; u.x2 = half; return true; }
};
struct MoeSched {
    int nT, nN, G, c; const LAS int* tile_e; const LAS int* tbase; const LAS unsigned short* tokl;
    const char* A; const char* B; size_t tstepA, estepB, tstepB;
    __device__ __forceinline__ bool next(int i, Unit& u) const {
        int half; if (!moe_unit(i, G, c, nT, nN, u.pm, u.pn, half)) return false;
        const int e = tile_e[u.pm];
        u.x0 = e; u.x1 = u.pm * 256; u.x2 = half;
        u.A = A + (size_t)u.pm * tstepA; u.B = B + (size_t)e * estepB + (size_t)u.pn * tstepB;
        u.tl = tokl ? tokl + (i < TOKL_ROUNDS ? i : TOKL_ROUNDS - 1) * 256 : nullptr; return true; }
};
struct MuSched {
    int G, c, mode; const char* A; const char* B;
    __device__ __forceinline__ bool next(int i, Unit& u) const {
        const int mu = i * G + c; if (mu >= 256) return false;
        const int b = mu >> 6, hh = (mu >> 4) & 3, ch = mu & 15; const size_t tok0 = (size_t)b * SEQ + (size_t)ch * 256;
        u.pm = mu; u.pn = 0; u.x0 = mu; u.x1 = u.x2 = 0; u.tl = nullptr;
        if (mode == 0) { u.A = A + (size_t)mu * 256 * 384 * 2; u.B = B + ((size_t)(hh * 128) * NTOK + tok0) * 2; }
        else if (mode == 1) { u.A = A + ((size_t)mu * 256 * 512 + 256) * 2; u.B = B + (tok0 * 1024 + (size_t)hh * 256) * 2; }
        else { u.A = A + (size_t)mu * 256 * 512 * 2; u.B = B + (size_t)mu * 256 * 384 * 2; }
        return true; }
};

constexpr float C2 = 0.125f * 1.4426950408889634f;

struct EpiQKV {
    static constexpr bool PERM = true;
    __device__ __forceinline__ void prep(const Unit&, int, int, int) const {}
    bf16_t* Q; bf16_t* K; bf16_t* V; const float* rope; float* ksum;
    __device__ __forceinline__ void operator()(AccRef acc, const Unit& u, int wr, int wc, int fr, int fq) const {
        asm volatile("" : "+v"(fr), "+v"(fq));
        const int part = u.pn >> 2, colt = (u.pn & 3) * 256;
        bf16_t* base = Q + (size_t)part * ((WS_K - WS_Q) / 2);
        const bool rot = (part < 2) && ((wc & 1) == 0);
        const float sgn = (fq == 0) ? -1.f : 1.f;
        float ks[2][8];
#pragma unroll
        for (int bj = 0; bj < 2; ++bj)
#pragma unroll
            for (int j = 0; j < 8; ++j) ks[bj][j] = 0.f;
#pragma unroll
        for (int ai = 0; ai < 2; ++ai)
#pragma unroll
            for (int m = 0; m < 4; ++m) {
                const int row = u.pm * 256 + ai * 128 + wr * 64 + m * 16 + fr;
                f32x4 cs0 = {1.f, 1.f, 1.f, 1.f}, cs1 = cs0, sn0 = {0.f, 0.f, 0.f, 0.f}, sn1 = sn0;
                if (rot) { const f32x4* rp = (const f32x4*)(rope + (size_t)row * 16); cs0 = rp[0]; cs1 = rp[1]; sn0 = rp[2]; sn1 = rp[3]; }
#pragma unroll
                for (int bj = 0; bj < 2; ++bj) {
                    f32x4 v0 = acc[ai][bj][m][0], v1 = acc[ai][bj][m][1];
                    if (rot) {
                        f32x4 p0, p1;
#pragma unroll
                        for (int j = 0; j < 4; ++j) { p0[j] = __shfl_xor(v0[j], 16); p1[j] = __shfl_xor(v1[j], 16); }
                        if (fq < 2) { v0 = v0 * cs0 + p0 * sn0 * sgn; v1 = v1 * cs1 + p1 * sn1 * sgn; }
                    }
                    if (part == 0) { v0 = v0 * C2; v1 = v1 * C2; }
                    if (part == 1) {
#pragma unroll
                        for (int j = 0; j < 4; ++j) { ks[bj][j] += v0[j]; ks[bj][4 + j] += v1[j]; } }
                    u32x4 w; w.x = cvt_pk_bf16(v0[0], v0[1]); w.y = cvt_pk_bf16(v0[2], v0[3]); w.z = cvt_pk_bf16(v1[0], v1[1]); w.w = cvt_pk_bf16(v1[2], v1[3]);
                    *(u32x4*)(base + (size_t)row * DM + colt + bj * 128 + wc * 32 + fq * 8) = w;
                }
            }
        if (part == 1) {
#pragma unroll
            for (int bj = 0; bj < 2; ++bj)
#pragma unroll
                for (int j = 0; j < 8; ++j) { float s = ks[bj][j]; s += __shfl_xor(s, 1); s += __shfl_xor(s, 2); s += __shfl_xor(s, 4); s += __shfl_xor(s, 8);
                    if (fr == 0) atomicAdd(ksum + (size_t)u.pm * DM + colt + bj * 128 + wc * 32 + fq * 8 + j, s); }
        }
    }
};

struct EpiZ {
    static constexpr bool PERM = false;
    __device__ __forceinline__ void prep(const Unit&, int, int, int) const {}
    const float* xin; float* z; float ymul;
    __device__ __forceinline__ void operator()(AccRef acc, const Unit& u, int wr, int wc, int fr, int fq) const {
        asm volatile("" : "+v"(fr), "+v"(fq));
#pragma unroll
        for (int ai = 0; ai < 2; ++ai) {
            const size_t off0 = (size_t)(u.pm * 256 + ai * 128 + wr * 64 + fr) * DM + u.pn * 256 + wc * 32 + fq * 4;
            f32x4 xr[4][2][2];
#pragma unroll
            for (int m = 0; m < 4; ++m)
#pragma unroll
                for (int bj = 0; bj < 2; ++bj)
#pragma unroll
                    for (int n = 0; n < 2; ++n) xr[m][bj][n] = *(const f32x4*)(xin + off0 + (size_t)m * 16 * DM + bj * 128 + n * 16);
#pragma unroll
            for (int m = 0; m < 4; ++m)
#pragma unroll
                for (int bj = 0; bj < 2; ++bj)
#pragma unroll
                    for (int n = 0; n < 2; ++n) *(f32x4*)(z + off0 + (size_t)m * 16 * DM + bj * 128 + n * 16) = xr[m][bj][n] * ALPHA + acc[ai][bj][m][n] * ymul;
            asm volatile("" ::: "memory");
        }
    }
};

__device__ __forceinline__ float swiglu1(float glu, float lin) {
    const float g = fminf(glu, 7.0f), l = fminf(fmaxf(lin, -7.0f), 7.0f);
    const float sg = __builtin_amdgcn_rcpf(1.0f + __builtin_amdgcn_exp2f(-1.702f * 1.4426950408889634f * g));
    return g * sg * (l + 1.0f);
}
struct EpiGU {
    static constexpr bool PERM = true;
    __device__ __forceinline__ void prep(const Unit& u, int ui, int wid, int lane) const { if (wid < 4) glds4s(uni_ptr((const char*)(bias + (size_t)u.x0 * 2048 + u.pn * 256 + wid * 64)), (unsigned)lane * 4u, (unsigned)__builtin_amdgcn_readfirstlane((unsigned)(unsigned long long)bl + (unsigned)(((ui & 1) * 256 + wid * 64) * 4))); }
    const float* bias; unsigned char* H; LAS float* bl; mutable int ucnt;
    __device__ __forceinline__ void operator()(AccRef acc, const Unit& u, int wr, int wc, int fr, int fq) const {
        asm volatile("" : "+v"(fr), "+v"(fq));
        const int c0 = u.pn * 256 + wc * 32 + fq * 8; const LAS float* bp = bl + (ucnt & 1) * 256 + wc * 32 + fq * 8; ++ucnt; constexpr float SC = 1.0f / (FP8_SA * FP8_SWGU);
        f32x4 b[2][2];
#pragma unroll
        for (int bj = 0; bj < 2; ++bj) { b[bj][0] = *(const LAS f32x4*)(bp + bj * 128); b[bj][1] = *(const LAS f32x4*)(bp + bj * 128 + 4); }
#pragma unroll
        for (int ai = 0; ai < 2; ++ai)
#pragma unroll
            for (int m = 0; m < 4; ++m) {
                unsigned char* rowp = H + (size_t)(u.x1 + ai * 128 + wr * 64 + m * 16 + fr) * DM + (c0 >> 1);
#pragma unroll
                for (int bj = 0; bj < 2; ++bj) { if (u.x2 == 2 - bj) continue;
                    const f32x4 v0 = acc[ai][bj][m][0] * SC + b[bj][0], v1 = acc[ai][bj][m][1] * SC + b[bj][1];
                    int w = __builtin_amdgcn_cvt_pk_fp8_f32(swiglu1(v0[0], v0[1]) * FP8_SA, swiglu1(v0[2], v0[3]) * FP8_SA, 0, false);
                    w = __builtin_amdgcn_cvt_pk_fp8_f32(swiglu1(v1[0], v1[1]) * FP8_SA, swiglu1(v1[2], v1[3]) * FP8_SA, w, true);
                    *(int*)(rowp + bj * 64) = w; }
            }
    }
};
struct EpiDN {
    static constexpr bool PERM = true;
    __device__ __forceinline__ void prep(const Unit& u, int ui, int wid, int lane) const { if (wid < 4) glds4s(uni_ptr((const char*)(bias + (size_t)u.x0 * 1024 + u.pn * 256 + wid * 64)), (unsigned)lane * 4u, (unsigned)__builtin_amdgcn_readfirstlane((unsigned)(unsigned long long)bl + (unsigned)(((ui & 1) * 256 + wid * 64) * 4))); }
    const float* bias; bf16_t* Y; LAS float* bl; mutable int ucnt;
    __device__ __forceinline__ void operator()(AccRef acc, const Unit& u, int wr, int wc, int fr, int fq) const {
        asm volatile("" : "+v"(fr), "+v"(fq));
        const int c0 = u.pn * 256 + wc * 32 + fq * 8; const LAS float* bp = bl + (ucnt & 1) * 256 + wc * 32 + fq * 8; ++ucnt; constexpr float SC = 1.0f / (FP8_SA * FP8_SWD);
        f32x4 b[2][2];
#pragma unroll
        for (int bj = 0; bj < 2; ++bj) { b[bj][0] = *(const LAS f32x4*)(bp + bj * 128); b[bj][1] = *(const LAS f32x4*)(bp + bj * 128 + 4); }
#pragma unroll
        for (int ai = 0; ai < 2; ++ai)
#pragma unroll
            for (int m = 0; m < 4; ++m) {
                bf16_t* rowp = Y + (size_t)(u.x1 + ai * 128 + wr * 64 + m * 16 + fr) * DM + c0;
#pragma unroll
                for (int bj = 0; bj < 2; ++bj) { if (u.x2 == 2 - bj) continue;
                    const f32x4 v0 = acc[ai][bj][m][0] * SC + b[bj][0], v1 = acc[ai][bj][m][1] * SC + b[bj][1];
                    u32x4 w; w.x = cvt_pk_bf16(v0[0], v0[1]); w.y = cvt_pk_bf16(v0[2], v0[3]); w.z = cvt_pk_bf16(v1[0], v1[1]); w.w = cvt_pk_bf16(v1[2], v1[3]);
                    *(u32x4*)(rowp + bj * 128) = w; }
            }
    }
};

struct EpiINA {
    static constexpr bool PERM = true;
    __device__ __forceinline__ void prep(const Unit&, int, int, int) const {}
    const float* rf; const float* cf; bf16_t* AE; bf16_t* KN; bf16_t* OS;
    __device__ __forceinline__ void operator()(AccRef acc, const Unit& u, int wr, int wc, int fr, int fq) const {
        asm volatile("" : "+v"(fr), "+v"(fq));
        const int b = u.pm >> 4, ch = u.pm & 15, d0 = wc * 32 + fq * 8; const u32x4 zero = {0u, 0u, 0u, 0u};
        if (u.pn < 4) {
            const bool isq = u.pn < 2; const float* fac = isq ? rf : cf; const float fs = isq ? 1.0f : RSQRT_DQK; const int h0 = (u.pn & 1) * 2;
            float sf[2][4][2];
#pragma unroll
            for (int ai = 0; ai < 2; ++ai)
#pragma unroll
                for (int m = 0; m < 4; ++m)
#pragma unroll
                    for (int bj = 0; bj < 2; ++bj) sf[ai][m][bj] = fac[(size_t)(h0 + bj) * NTOK + (size_t)u.pm * 256 + ai * 128 + wr * 64 + m * 16 + fr];
#pragma unroll
            for (int ai = 0; ai < 2; ++ai)
#pragma unroll
                for (int m = 0; m < 4; ++m) {
                    const int t = ai * 128 + wr * 64 + m * 16 + fr; const size_t token = (size_t)u.pm * 256 + t;
#pragma unroll
                    for (int bj = 0; bj < 2; ++bj) { const int hh = h0 + bj; const float s = sf[ai][m][bj] * fs;
                        const f32x4 v0 = acc[ai][bj][m][0] * s, v1 = acc[ai][bj][m][1] * s;
                        const size_t oq = ((size_t)(((b * 4 + hh) * 16 + ch) * 256 + t)) * 512 + 256 + d0, ok = token * 1024 + hh * 256 + d0;
                        bf16_t* dst = isq ? (AE + oq) : (KN + ok);
                        u32x4 w; w.x = cvt_pk_bf16(v0[0], v0[1]); w.y = cvt_pk_bf16(v0[2], v0[3]); w.z = cvt_pk_bf16(v1[0], v1[1]); w.w = cvt_pk_bf16(v1[2], v1[3]);
                        *(u32x4*)dst = w; *(u32x4*)(dst + 128) = zero; }
                }
        } else {
#pragma unroll
            for (int ai = 0; ai < 2; ++ai)
#pragma unroll
                for (int m = 0; m < 4; ++m) {
                    const int t = ai * 128 + wr * 64 + m * 16 + fr; const size_t token = (size_t)u.pm * 256 + t;
#pragma unroll
                    for (int bj = 0; bj < 2; ++bj) { f32x4 v0 = acc[ai][bj][m][0], v1 = acc[ai][bj][m][1];
#pragma unroll
                        for (int j = 0; j < 4; ++j) { v0[j] = __builtin_amdgcn_rcpf(1.0f + __builtin_amdgcn_exp2f(-1.4426950408889634f * v0[j])); v1[j] = __builtin_amdgcn_rcpf(1.0f + __builtin_amdgcn_exp2f(-1.4426950408889634f * v1[j])); }
                        u32x4 w; w.x = cvt_pk_bf16(v0[0], v0[1]); w.y = cvt_pk_bf16(v0[2], v0[3]); w.z = cvt_pk_bf16(v1[0], v1[1]); w.w = cvt_pk_bf16(v1[2], v1[3]);
                        *(u32x4*)(OS + token * 1024 + (u.pn - 4) * 256 + bj * 128 + d0) = w; }
                }
        }
    }
};
struct EpiINB {
    static constexpr bool PERM = true;
    __device__ __forceinline__ void prep(const Unit&, int, int, int) const {}
    const float* cf; bf16_t* KT; bf16_t* BE;
    __device__ __forceinline__ void operator()(AccRef acc, const Unit& u, int wr, int wc, int fr, int fq) const {
        asm volatile("" : "+v"(fr), "+v"(fq));
        const int b = u.pn >> 4, ch = u.pn & 15;
        f32x4 cv[2][2][2];
#pragma unroll
        for (int ai = 0; ai < 2; ++ai)
#pragma unroll
            for (int bj = 0; bj < 2; ++bj) { const size_t tok0 = (size_t)u.pn * 256 + bj * 128 + wc * 32 + fq * 8;
                if (u.pm < 2) { const int hh = u.pm * 2 + ai; cv[ai][bj][0] = *(const f32x4*)(cf + (size_t)hh * NTOK + tok0) * RSQRT_DQK; cv[ai][bj][1] = *(const f32x4*)(cf + (size_t)hh * NTOK + tok0 + 4) * RSQRT_DQK; }
                else { cv[ai][bj][0] = (f32x4){1.f, 1.f, 1.f, 1.f}; cv[ai][bj][1] = cv[ai][bj][0]; } }
#pragma unroll
        for (int ai = 0; ai < 2; ++ai)
#pragma unroll
            for (int m = 0; m < 4; ++m) {
                const int R = u.pm * 256 + ai * 128 + wr * 64 + m * 16 + fr;
#pragma unroll
                for (int bj = 0; bj < 2; ++bj) { if (u.x2 == 2 - bj) continue;
                    const f32x4 v0 = acc[ai][bj][m][0] * cv[ai][bj][0], v1 = acc[ai][bj][m][1] * cv[ai][bj][1]; const int s0 = bj * 128 + wc * 32 + fq * 8; const size_t tok0 = (size_t)u.pn * 256 + s0; bf16_t* dst;
                    if (u.pm < 2) dst = KT + (size_t)R * NTOK + tok0;
                    else { const int eg = R - 512, hh = eg >> 8, e = eg & 255; dst = BE + ((size_t)(((b * 4 + hh) * 16 + ch) * 256 + e)) * 384 + s0; }
                    u32x4 w; w.x = cvt_pk_bf16(v0[0], v0[1]); w.y = cvt_pk_bf16(v0[2], v0[3]); w.z = cvt_pk_bf16(v1[0], v1[1]); w.w = cvt_pk_bf16(v1[2], v1[3]);
                    *(u32x4*)dst = w;
                }
            }
    }
};
struct EpiM1 {
    static constexpr bool PERM = false;
    __device__ __forceinline__ void prep(const Unit&, int, int, int) const {}
    float* UT;
    __device__ __forceinline__ void operator()(AccRef acc, const Unit& u, int wr, int wc, int fr, int fq) const {
        asm volatile("" : "+v"(fr), "+v"(fq));
#pragma unroll
        for (int ai = 0; ai < 2; ++ai)
#pragma unroll
            for (int m = 0; m < 4; ++m) { float* rowp = UT + ((size_t)u.x0 * 256 + ai * 128 + wr * 64 + m * 16 + fr) * 128 + wc * 32 + fq * 4;
#pragma unroll
                for (int n = 0; n < 2; ++n) *(f32x4*)(rowp + n * 16) = acc[ai][0][m][n]; }
    }
};
struct EpiM2A {
    static constexpr bool PERM = true;
    __device__ __forceinline__ void prep(const Unit&, int, int, int) const {}
    bf16_t* AE; const float* nprev; float* den;
    __device__ __forceinline__ void operator()(AccRef acc, const Unit& u, int wr, int wc, int fr, int fq) const {
        asm volatile("" : "+v"(fr), "+v"(fq));
        const int mu = u.x0, dd = wc * 32 + fq * 8;
        const f32x4 n0 = *(const f32x4*)(nprev + (size_t)mu * 128 + dd), n1 = *(const f32x4*)(nprev + (size_t)mu * 128 + dd + 4);
        u32x4 qv8[2][4];
#pragma unroll
        for (int ai = 0; ai < 2; ++ai)
#pragma unroll
            for (int m = 0; m < 4; ++m) qv8[ai][m] = *(const u32x4*)(AE + ((size_t)mu * 256 + ai * 128 + wr * 64 + m * 16 + fr) * 512 + 256 + dd);
#pragma unroll
        for (int ai = 0; ai < 2; ++ai)
#pragma unroll
            for (int m = 0; m < 4; ++m) {
                const int t = ai * 128 + wr * 64 + m * 16 + fr; bf16_t* rowp = AE + ((size_t)mu * 256 + t) * 512;
                const u32x4 qv = qv8[ai][m];
                float part = bflo(qv.x) * n0[0] + bfhi(qv.x) * n0[1] + bflo(qv.y) * n0[2] + bfhi(qv.y) * n0[3] + bflo(qv.z) * n1[0] + bfhi(qv.z) * n1[1] + bflo(qv.w) * n1[2] + bfhi(qv.w) * n1[3];
#pragma unroll
                for (int bj = 0; bj < 2; ++bj) { const int s0 = bj * 128 + wc * 32 + fq * 8; f32x4 v0 = acc[ai][bj][m][0], v1 = acc[ai][bj][m][1];
                    int dts = t - s0; asm volatile("" : "+v"(dts));
#pragma unroll
                    for (int j = 0; j < 4; ++j) { v0[j] = (j <= dts) ? v0[j] : 0.f; v1[j] = (4 + j <= dts) ? v1[j] : 0.f; part += v0[j] + v1[j]; }
                    u32x4 w; w.x = cvt_pk_bf16(v0[0], v0[1]); w.y = cvt_pk_bf16(v0[2], v0[3]); w.z = cvt_pk_bf16(v1[0], v1[1]); w.w = cvt_pk_bf16(v1[2], v1[3]);
                    *(u32x4*)(rowp + s0) = w; }
                part += __shfl_xor(part, 16); part += __shfl_xor(part, 32);
                if (fq == 0) atomicAdd(den + (size_t)mu * 256 + (wr * 64 + fr) + (ai * 128 + m * 16), part);
            }
    }
};
struct EpiM2B {
    static constexpr bool PERM = true;
    __device__ __forceinline__ void prep(const Unit&, int, int, int) const {}
    const float* den; const float* normg; const bf16_t* OS; bf16_t* HN; LAS float* lnx;
    __device__ __forceinline__ void operator()(AccRef acc, const Unit& u, int wr, int wc, int fr, int fq) const {
        asm volatile("" : "+v"(fr), "+v"(fq));
        const int mu = u.x0, b = mu >> 6, hh = (mu >> 4) & 3, ch = mu & 15;
        float dnv[2][4];
#pragma unroll
        for (int ai = 0; ai < 2; ++ai)
#pragma unroll
            for (int m = 0; m < 4; ++m) dnv[ai][m] = den[(size_t)mu * 256 + ai * 128 + wr * 64 + m * 16 + fr];
#pragma unroll
        for (int ai = 0; ai < 2; ++ai)
#pragma unroll
            for (int m = 0; m < 4; ++m) {
                const int t = ai * 128 + wr * 64 + m * 16 + fr; const float dn = dnv[ai][m];
#ifdef DBG_DEN1
                const float inv = 1.0f;
#else
                const float inv = 1.0f / fmaxf(fabsf(dn), 1.0f);
#endif
                float s1 = 0.f, s2 = 0.f;
#pragma unroll
                for (int bj = 0; bj < 2; ++bj)
#pragma unroll
                    for (int n = 0; n < 2; ++n) { f32x4 h = acc[ai][bj][m][n] * inv; acc[ai][bj][m][n] = h; s1 += (h[0] + h[1]) + (h[2] + h[3]); s2 += (h[0] * h[0] + h[1] * h[1]) + (h[2] * h[2] + h[3] * h[3]); }
                s1 += __shfl_xor(s1, 16); s1 += __shfl_xor(s1, 32); s2 += __shfl_xor(s2, 16); s2 += __shfl_xor(s2, 32);
                if (fq == 0) { lnx[(t * 4 + wc) * 2] = s1; lnx[(t * 4 + wc) * 2 + 1] = s2; }
            }
        const int e0 = wc * 32 + fq * 8;
        f32x4 gg[2][2];
#pragma unroll
        for (int bj = 0; bj < 2; ++bj) { gg[bj][0] = *(const f32x4*)(normg + hh * 256 + bj * 128 + e0); gg[bj][1] = *(const f32x4*)(normg + hh * 256 + bj * 128 + e0 + 4); }
        asm volatile("s_waitcnt lgkmcnt(0)" ::: "memory"); __builtin_amdgcn_s_barrier(); asm volatile("" ::: "memory");
#pragma unroll
        for (int ai = 0; ai < 2; ++ai) {
            u32x4 ovv[4][2];
#pragma unroll
            for (int m = 0; m < 4; ++m)
#pragma unroll
                for (int bj = 0; bj < 2; ++bj) ovv[m][bj] = *(const u32x4*)(OS + (((size_t)(b * 16 + ch)) * 256 + ai * 128 + wr * 64 + m * 16 + fr) * 1024 + hh * 256 + bj * 128 + e0);
#pragma unroll
            for (int m = 0; m < 4; ++m) {
                const int t = ai * 128 + wr * 64 + m * 16 + fr; const size_t token = ((size_t)(b * 16 + ch)) * 256 + t;
                const LAS f32x4* lp = (const LAS f32x4*)(lnx + t * 8); const f32x4 a = lp[0], c = lp[1];
                const float mean = (a[0] + a[2] + c[0] + c[2]) * (1.0f / 256.0f); const float ex2 = (a[1] + a[3] + c[1] + c[3]) * (1.0f / 256.0f);
                const float rstd = 1.0f / sqrtf(fmaxf(ex2 - mean * mean, 0.f) + LN_EPS);
#pragma unroll
                for (int bj = 0; bj < 2; ++bj) { const int e = bj * 128 + e0; const size_t off = token * 1024 + hh * 256 + e; const u32x4 ov = ovv[m][bj];
#ifdef DBG_HN_OS
                    f32x4 v0 = {1.f, 1.f, 1.f, 1.f}, v1 = v0;
#elif defined(DBG_HN_RAW)
                    f32x4 v0 = acc[ai][bj][m][0], v1 = acc[ai][bj][m][1];
#else
                    f32x4 v0 = (acc[ai][bj][m][0] - mean) * rstd * gg[bj][0], v1 = (acc[ai][bj][m][1] - mean) * rstd * gg[bj][1];
#endif
#ifndef DBG_HN_ONE
                    v0[0] *= bflo(ov.x); v0[1] *= bfhi(ov.x); v0[2] *= bflo(ov.y); v0[3] *= bfhi(ov.y); v1[0] *= bflo(ov.z); v1[1] *= bfhi(ov.z); v1[2] *= bflo(ov.w); v1[3] *= bfhi(ov.w);
#endif
                    u32x4 w; w.x = cvt_pk_bf16(v0[0], v0[1]); w.y = cvt_pk_bf16(v0[2], v0[3]); w.z = cvt_pk_bf16(v1[0], v1[1]); w.w = cvt_pk_bf16(v1[2], v1[3]);
                    *(u32x4*)(HN + off) = w; }
            }
            asm volatile("" ::: "memory");
        }
        asm volatile("s_waitcnt lgkmcnt(0)" ::: "memory"); __builtin_amdgcn_s_barrier(); asm volatile("" ::: "memory");
    }
};
struct Frame {
    LAS unsigned char* lds;
    unsigned* ctl;
    unsigned char* ws;
    int tid, lane, wave, vcu, G;
};
__device__ __forceinline__ float wave_sum(float v) {
#pragma unroll
    for (int o = 1; o < 64; o <<= 1) v += __shfl_xor(v, o);
    return v;
}

__device__ __forceinline__ void tr_block(const float* src, size_t pitch, bf16_t* dst, size_t kd, int kb, int nb, LAS unsigned* scr, int lane) {
    const float* s0 = src + (size_t)(64 * kb) * pitch + 64 * nb + 4 * (lane & 15);
#pragma unroll
    for (int i = 0; i < 8; ++i) {
        const int kp = 4 * i + (lane >> 4);
        const f32x4 a = __builtin_nontemporal_load((const f32x4*)(s0 + (size_t)(2 * kp) * pitch)), b = __builtin_nontemporal_load((const f32x4*)(s0 + (size_t)(2 * kp + 1) * pitch));
#pragma unroll
        for (int j = 0; j < 4; ++j) scr[(4 * (lane & 15) + j) * 33 + kp] = cvt_pk_bf16(a[j], b[j]);
    }
    LDS_WAIT(); asm volatile("" ::: "memory");
    u32x4 o[8];
#pragma unroll
    for (int c = 0; c < 8; ++c) { const int rr = 8 * c + (lane >> 3), q4 = 4 * (lane & 7); o[c].x = scr[rr * 33 + q4]; o[c].y = scr[rr * 33 + q4 + 1]; o[c].z = scr[rr * 33 + q4 + 2]; o[c].w = scr[rr * 33 + q4 + 3]; }
    bf16_t* d = dst + (size_t)(64 * nb + (lane >> 3)) * kd + 64 * kb + 8 * (lane & 7);
#pragma unroll
    for (int c = 0; c < 8; ++c) *(u32x4*)(d + (size_t)(8 * c) * kd) = o[c];
    LDS_WAIT(); asm volatile("" ::: "memory");
}
__device__ __forceinline__ void tr_block8(const float* src, size_t pitch, unsigned char* dst, size_t kd, int kb, int nb, float scale, LAS unsigned* scr, int lane) {
    const float* s0 = src + (size_t)(128 * kb) * pitch + 64 * nb + 4 * (lane & 15);
#pragma unroll
    for (int i = 0; i < 8; ++i) {
        const int kq = 4 * i + (lane >> 4);
        const f32x4 r0 = __builtin_nontemporal_load((const f32x4*)(s0 + (size_t)(4 * kq) * pitch)) * scale, r1 = __builtin_nontemporal_load((const f32x4*)(s0 + (size_t)(4 * kq + 1) * pitch)) * scale,
                    r2 = __builtin_nontemporal_load((const f32x4*)(s0 + (size_t)(4 * kq + 2) * pitch)) * scale, r3 = __builtin_nontemporal_load((const f32x4*)(s0 + (size_t)(4 * kq + 3) * pitch)) * scale;
#pragma unroll
        for (int j = 0; j < 4; ++j) { int w = __builtin_amdgcn_cvt_pk_fp8_f32(r0[j], r1[j], 0, false); w = __builtin_amdgcn_cvt_pk_fp8_f32(r2[j], r3[j], w, true); scr[(4 * (lane & 15) + j) * 33 + kq] = (unsigned)w; }
    }
    LDS_WAIT(); asm volatile("" ::: "memory");
    u32x4 o[8];
#pragma unroll
    for (int c = 0; c < 8; ++c) { const int rr = 8 * c + (lane >> 3), q4 = 4 * (lane & 7); o[c].x = scr[rr * 33 + q4]; o[c].y = scr[rr * 33 + q4 + 1]; o[c].z = scr[rr * 33 + q4 + 2]; o[c].w = scr[rr * 33 + q4 + 3]; }
    unsigned char* d = dst + (size_t)(64 * nb + (lane >> 3)) * kd + 128 * kb + 16 * (lane & 7);
#pragma unroll
    for (int c = 0; c < 8; ++c) *(u32x4*)(d + (size_t)(8 * c) * kd) = o[c];
    LDS_WAIT(); asm volatile("" ::: "memory");
}
constexpr int CONV_ITEMS = 24576;
struct ConvItem { const float* s0; size_t pitch; unsigned char* d; float scale; };
__device__ __forceinline__ ConvItem conv_desc(const float* wgu, const float* wd, unsigned char* ws, int v, int lane) {
    const int layer = v >= 12288; int r = v - layer * 12288; ConvItem it;
    if (r < 8192) { const int mat = layer * 32 + (r >> 8); r &= 255; const int kb = r >> 5, nb = r & 31; it.pitch = 2048; it.scale = FP8_SWGU;
        it.s0 = wgu + (size_t)mat * 1024 * 2048 + (size_t)(128 * kb) * 2048 + 64 * nb + 4 * (lane & 15); it.d = ws + WS_WGU + (size_t)mat * 2048 * 1024 + (size_t)(64 * nb + (lane >> 3)) * 1024 + 128 * kb + 16 * (lane & 7); }
    else { r -= 8192; const int mat = layer * 32 + (r >> 7); r &= 127; const int kb = r >> 4, nb = r & 15; it.pitch = 1024; it.scale = FP8_SWD;
        it.s0 = wd + (size_t)mat * 1024 * 1024 + (size_t)(128 * kb) * 1024 + 64 * nb + 4 * (lane & 15); it.d = ws + WS_WD + (size_t)mat * 1024 * 1024 + (size_t)(64 * nb + (lane >> 3)) * 1024 + 128 * kb + 16 * (lane & 7); }
    return it;
}
__device__ __forceinline__ void conv_items(Frame& F, const float* wgu, const float* wd, int v_lo, int v_hi, int cw, int ncw) {
    LAS unsigned* scr = (LAS unsigned*)(F.lds + RING_OFF + F.wave * 8448); unsigned char* ws = F.ws; const int lane = F.lane;
    int v = v_lo + cw; if (v >= v_hi) return;
    ConvItem cur = conv_desc(wgu, wd, ws, v, lane);
    f32x4 r[8][4];
#pragma unroll
    for (int i = 0; i < 8; ++i) { const int kq = 4 * i + (lane >> 4);
#pragma unroll
        for (int q = 0; q < 4; ++q) r[i][q] = __builtin_nontemporal_load((const f32x4*)(cur.s0 + (size_t)(4 * kq + q) * cur.pitch)); }
    for (;;) {
        const int vn = v + ncw; const bool has = vn < v_hi; ConvItem nx = cur; if (has) nx = conv_desc(wgu, wd, ws, vn, lane);
#pragma unroll
        for (int i = 0; i < 8; ++i) { const int kq = 4 * i + (lane >> 4);
#pragma unroll
            for (int j = 0; j < 4; ++j) { int w = __builtin_amdgcn_cvt_pk_fp8_f32(r[i][0][j] * cur.scale, r[i][1][j] * cur.scale, 0, false); w = __builtin_amdgcn_cvt_pk_fp8_f32(r[i][2][j] * cur.scale, r[i][3][j] * cur.scale, w, true); scr[(4 * (lane & 15) + j) * 33 + kq] = (unsigned)w; }
            if (has) {
#pragma unroll
                for (int q = 0; q < 4; ++q) r[i][q] = __builtin_nontemporal_load((const f32x4*)(nx.s0 + (size_t)(4 * kq + q) * nx.pitch)); } }
        LDS_WAIT(); asm volatile("" ::: "memory");
        u32x4 o[8];
#pragma unroll
        for (int c = 0; c < 8; ++c) { const int rr = 8 * c + (lane >> 3), q4 = 4 * (lane & 7); o[c].x = scr[rr * 33 + q4]; o[c].y = scr[rr * 33 + q4 + 1]; o[c].z = scr[rr * 33 + q4 + 2]; o[c].w = scr[rr * 33 + q4 + 3]; }
#pragma unroll
        for (int c = 0; c < 8; ++c) *(u32x4*)(cur.d + (size_t)(8 * c) * 1024) = o[c];
        LDS_WAIT(); asm volatile("" ::: "memory");
        if (!has) break;
        v = vn; cur = nx;
    }
}
struct P0In { const float *x, *wqkv, *wo, *win, *wout, *rw, *wgu, *wd; const int* pos; };
__device__ __forceinline__ void p0_prologue(Frame& F, const P0In& I) {
    LAS unsigned* scr = (LAS unsigned*)(F.lds + RING_OFF + F.wave * 8448);
    const int gw = F.vcu * NWAVES + F.wave, NGW = F.G * NWAVES;
    unsigned char* ws = F.ws;
    constexpr int KB = 16;
    constexpr int I_QKV = KB * 48, I_WO = KB * 16, I_INA1 = KB * 16, I_INA2 = KB * 16, I_INB = KB * 24, I_WOUT = KB * 16;
    constexpr int I_SMALL = I_QKV + I_WO + I_INA1 + I_INA2 + I_INB + I_WOUT;
    constexpr int NITEMS = I_SMALL;
    for (int it = gw; it < NITEMS; it += NGW) {
        int r = it; const float* src; size_t pitch; bf16_t* dst; int nbl;
        if (r < I_QKV) { src = I.wqkv; pitch = 3072; dst = (bf16_t*)(ws + WS_WQKV); nbl = 48; }
        else if ((r -= I_QKV) < I_WO) { src = I.wo; pitch = 1024; dst = (bf16_t*)(ws + WS_WO); nbl = 16; }
        else if ((r -= I_WO) < I_INA1) { src = I.win; pitch = 3080; dst = (bf16_t*)(ws + WS_WINA); nbl = 16; }
        else if ((r -= I_INA1) < I_INA2) { src = I.win + 2048; pitch = 3080; dst = (bf16_t*)(ws + WS_WINA) + (size_t)1024 * 1024; nbl = 16; }
        else if ((r -= I_INA2) < I_INB) { src = I.win + 512; pitch = 3080; dst = (bf16_t*)(ws + WS_WINB); nbl = 24; }
        else { r -= I_INB; src = I.wout; pitch = 1024; dst = (bf16_t*)(ws + WS_WOUT); nbl = 16; }
        tr_block(src, pitch, dst, 1024, r / nbl, r % nbl, scr, F.lane);
    }
    if (NCONV == 0) conv_items(F, I.wgu, I.wd, 0, CONV_ITEMS, gw, NGW);
    const int gt = F.vcu * NTHR + F.tid, NGT = F.G * NTHR;
    for (int i = gt; i < NTOK * DM / 8; i += NGT) { const f32x4 a = ((const f32x4*)I.x)[2 * i], b = ((const f32x4*)I.x)[2 * i + 1];
        u32x4 w; w.x = cvt_pk_bf16(a[0], a[1]); w.y = cvt_pk_bf16(a[2], a[3]); w.z = cvt_pk_bf16(b[0], b[1]); w.w = cvt_pk_bf16(b[2], b[3]); ((u32x4*)(ws + WS_XB))[i] = w; }
    for (int i = gt; i < NTOK * 8; i += NGT) { const int tok = i >> 3, f = i & 7; const float inv = powf(500000.0f, -(float)f * 0.125f); const float ang = (float)I.pos[tok] * inv;
        float sn, cs; sincosf(ang, &sn, &cs); float* rp = (float*)(ws + WS_ROPE) + (size_t)tok * 16; rp[f] = cs; rp[8 + f] = sn; }
    for (int i = gt; i < 2 * 32 * 1024; i += NGT) { const int l = i >> 15, e = (i >> 10) & 31, k = i & 1023; ((float*)(ws + WS_RWT))[i] = I.rw[((size_t)l * 1024 + k) * 32 + e]; }
    for (int i = gt; i < 8 * 1024; i += NGT) { const int gidx = i >> 10, k = i & 1023; ((float*)(ws + WS_WG))[i] = I.win[(size_t)k * 3080 + 3072 + gidx]; }
}

__device__ __forceinline__ void phase_ln_router(Frame& F, const float* __restrict__ z, float* __restrict__ x1, const float* lng, const float* lnb, const float* rbias, int layer, int cset) {
    unsigned char* ws = F.ws;
    LAS f32x4* rwv = (LAS f32x4*)(F.lds + RING_OFF);
    LAS int* lcnt = (LAS int*)(F.lds + LX_LCNT); LAS int* gbase = (LAS int*)(F.lds + LX_GBASE); LAS int* rec = (LAS int*)(F.lds + LX_REC);
    LAS float* lgb = (LAS float*)(F.lds + LX_LNX);
    { const f32x4* src = (const f32x4*)((const float*)(ws + WS_RWT) + (size_t)layer * 32768);
      for (int i = F.tid; i < 8192; i += NTHR) { const int e = i >> 8, c = i & 255; rwv[e * 256 + (c ^ (e & 15))] = src[i]; } }
    int* toke = (int*)(ws + WS_TOKE); int* tokp = (int*)(ws + WS_TOKP); float* tokg = (float*)(ws + WS_TOKG);
    unsigned short* rowtok = (unsigned short*)(ws + WS_ROWTOK); unsigned char* xb8 = (unsigned char*)(ws + WS_XB);
    unsigned* cntg = F.ctl + CW_CNT + cset * 2048;
    const int lane = F.lane;
    for (int grp = F.vcu; grp < NTOK / 64; grp += F.G) {
        if (F.tid < 32) lcnt[F.tid] = 0;
        for (int i = F.tid; i < 1024; i += NTHR) { lgb[i] = lng[i]; lgb[1024 + i] = lnb[i]; }
        __syncthreads();
#pragma unroll 2
        for (int tk = 0; tk < 8; tk += 2) {
            const int token0 = grp * 64 + F.wave * 8 + tk;
            f32x4 v[2][4]; float s[2] = {0.f, 0.f};
#pragma unroll
            for (int u = 0; u < 2; ++u)
#pragma unroll
                for (int j = 0; j < 4; ++j) { v[u][j] = *(const f32x4*)(z + (size_t)(token0 + u) * DM + 4 * lane + 256 * j); s[u] += (v[u][j][0] + v[u][j][1]) + (v[u][j][2] + v[u][j][3]); }
#pragma unroll
            for (int o = 1; o < 64; o <<= 1) { const float a0 = __shfl_xor(s[0], o), a1 = __shfl_xor(s[1], o); s[0] += a0; s[1] += a1; }
            float s2[2] = {0.f, 0.f};
#pragma unroll
            for (int u = 0; u < 2; ++u) { const float mean = s[u] * (1.0f / DM);
#pragma unroll
                for (int j = 0; j < 4; ++j) { v[u][j] = v[u][j] - mean; s2[u] += (v[u][j][0] * v[u][j][0] + v[u][j][1] * v[u][j][1]) + (v[u][j][2] * v[u][j][2] + v[u][j][3] * v[u][j][3]); } }
#pragma unroll
            for (int o = 1; o < 64; o <<= 1) { const float a0 = __shfl_xor(s2[0], o), a1 = __shfl_xor(s2[1], o); s2[0] += a0; s2[1] += a1; }
#pragma unroll
            for (int u = 0; u < 2; ++u) { const float rstd = 1.0f / sqrtf(s2[u] * (1.0f / DM) + LN_EPS); const int token = token0 + u;
#pragma unroll
                for (int j = 0; j < 4; ++j) { const f32x4 gvj = *(const LAS f32x4*)(lgb + 4 * lane + 256 * j), bvj = *(const LAS f32x4*)(lgb + 1024 + 4 * lane + 256 * j);
                    const f32x4 y = v[u][j] * rstd * gvj + bvj; *(f32x4*)(x1 + (size_t)token * DM + 4 * lane + 256 * j) = y;
                    int w8 = __builtin_amdgcn_cvt_pk_fp8_f32(y[0] * FP8_SA, y[1] * FP8_SA, 0, false); w8 = __builtin_amdgcn_cvt_pk_fp8_f32(y[2] * FP8_SA, y[3] * FP8_SA, w8, true);
                    *(int*)(xb8 + (size_t)token * DM + 4 * lane + 256 * j) = w8; } }
        }
        VM_WAIT(); __syncthreads();
        const int tg = F.wave & 3, kh = F.wave >> 2, e0 = lane & 15, kq = lane >> 4;
        f32x4 acc0 = {0.f, 0.f, 0.f, 0.f}, acc1 = acc0;
        { const float* arow = x1 + (size_t)(grp * 64 + tg * 16 + e0) * DM + kh * 512 + 4 * kq;
#pragma unroll 4
          for (int blk = 0; blk < 32; ++blk) {
              const f32x4 a4 = *(const f32x4*)(arow + blk * 16); const int c = ((kh * 512 + blk * 16) >> 2) + kq;
              const f32x4 b0 = rwv[e0 * 256 + (c ^ e0)], b1 = rwv[(16 + e0) * 256 + (c ^ e0)];
#pragma unroll
              for (int j = 0; j < 4; ++j) { acc0 = __builtin_amdgcn_mfma_f32_16x16x4f32(a4[j], b0[j], acc0, 0, 0, 0); acc1 = __builtin_amdgcn_mfma_f32_16x16x4f32(a4[j], b1[j], acc1, 0, 0, 0); } } }
        __syncthreads();
        if (kh == 1) { ((LAS f32x4*)lgb)[(tg * 2 + 0) * 64 + lane] = acc0; ((LAS f32x4*)lgb)[(tg * 2 + 1) * 64 + lane] = acc1; }
        __syncthreads();
        if (kh == 0) {
            acc0 = acc0 + ((LAS f32x4*)lgb)[(tg * 2 + 0) * 64 + lane]; acc1 = acc1 + ((LAS f32x4*)lgb)[(tg * 2 + 1) * 64 + lane];
            const float rb0 = rbias[e0], rb1 = rbias[16 + e0];
#pragma unroll
            for (int r = 0; r < 4; ++r) {
                float l0 = acc0[r] + rb0, l1 = acc1[r] + rb1; float tv[4]; int te[4];
#pragma unroll
                for (int k = 0; k < 4; ++k) { float bvv = (l1 > l0) ? l1 : l0; int be = (l1 > l0) ? 16 + e0 : e0;
#pragma unroll
                    for (int o = 1; o < 16; o <<= 1) { const float ov = __shfl_xor(bvv, o); const int oe = __shfl_xor(be, o); const bool take = (ov > bvv) || (ov == bvv && oe < be); bvv = take ? ov : bvv; be = take ? oe : be; }
                    tv[k] = bvv; te[k] = be; if (be == e0) l0 = -INFINITY; if (be == 16 + e0) l1 = -INFINITY; }
                const float w0 = 1.0f, w1 = __expf(tv[1] - tv[0]), w2 = __expf(tv[2] - tv[0]), w3 = __expf(tv[3] - tv[0]); const float wi = 1.0f / (w0 + w1 + w2 + w3);
                if (e0 < 4) {
                    const int tl = tg * 16 + 4 * kq + r, token = grp * 64 + tl;
                    const int ek = (e0 == 0) ? te[0] : (e0 == 1) ? te[1] : (e0 == 2) ? te[2] : te[3];
                    const float wk = (e0 == 0) ? w0 : (e0 == 1) ? w1 : (e0 == 2) ? w2 : w3;
                    const int li = atomicAdd((int*)(lcnt + ek), 1); rec[tl * 8 + e0] = ek; rec[tl * 8 + 4 + e0] = li;
                    toke[token * 4 + e0] = ek; tokg[token * 4 + e0] = wk * wi;
                }
            }
        }
        __syncthreads();
        if (F.tid < 32) gbase[F.tid] = (int)__hip_atomic_fetch_add(cntg + F.tid * 64, (unsigned)lcnt[F.tid], RLX_AGENT);
        __syncthreads();
        if (F.tid < 256) { const int tl = F.tid >> 2, k = F.tid & 3; const int token = grp * 64 + tl; const int e = rec[tl * 8 + k]; const int pos = gbase[e] + rec[tl * 8 + 4 + k];
            tokp[token * 4 + k] = pos; rowtok[(size_t)e * NTOK + pos] = (unsigned short)token; }
        __syncthreads();
    }
}

__device__ __forceinline__ int moe_tables(Frame& F, int layer) {
    LAS int* tile_e = (LAS int*)(F.lds + LX_TILEE); LAS int* tbase = (LAS int*)(F.lds + LX_TBASE);
    if (F.tid < 64) {
        const int e = F.lane & 31; const int c = (int)__hip_atomic_load(F.ctl + CW_CNT + layer * 2048 + e * 64, RLX_AGENT); const int nt = (F.lane < 32) ? ((c + 255) >> 8) : 0;
        int inc = nt;
#pragma unroll
        for (int o = 1; o < 32; o <<= 1) { const int up = __shfl_up(inc, o); if (F.lane >= o) inc += up; }
        const int t0 = inc - nt;
        if (F.lane < 32) { tbase[e] = t0; for (int i = 0; i < nt; ++i) tile_e[t0 + i] = e; }
        if (F.lane == 31) tbase[32] = inc;
    }
    __syncthreads();
    return tbase[32];
}

template <bool NEXT_MLSTM>
__device__ __forceinline__ void phase_combine(Frame& F, const float* __restrict__ x1, float* __restrict__ out, const float* lng, const float* lnb, const float* bgates, int layer) {
    unsigned char* ws = F.ws;
    (void)moe_tables(F, layer);
    const LAS int* tbase = (const LAS int*)(F.lds + LX_TBASE);
    const int* toke = (const int*)(ws + WS_TOKE); const int* tokp = (const int*)(ws + WS_TOKP); const float* tokg = (const float*)(ws + WS_TOKG);
    const bf16_t* Y = (const bf16_t*)(ws + WS_Y); bf16_t* xb = (bf16_t*)(ws + WS_XB);
    LAS float* wg = (LAS float*)(F.lds + RING_OFF);
    if constexpr (NEXT_MLSTM) { const f32x4* src = (const f32x4*)(ws + WS_WG); for (int i = F.tid; i < 2048; i += NTHR) ((LAS f32x4*)wg)[i] = src[i]; __syncthreads(); }
    const int lane = F.lane; const int gw = F.vcu * NWAVES + F.wave, NGW = F.G * NWAVES;
    f32x4 gv[4], bv[4];
#pragma unroll
    for (int j = 0; j < 4; ++j) { gv[j] = *(const f32x4*)(lng + 4 * lane + 256 * j); bv[j] = *(const f32x4*)(lnb + 4 * lane + 256 * j); }
    constexpr int NTK = NEXT_MLSTM ? 1 : 2;
    for (int token0 = gw; token0 < NTOK; token0 += NTK * NGW) {
        f32x4 vv[NTK][4];
#pragma unroll
        for (int u = 0; u < NTK; ++u) { const int token = token0 + u * NGW; if (token < NTOK) {
#pragma unroll
            for (int j = 0; j < 4; ++j) vv[u][j] = *(const f32x4*)(x1 + (size_t)token * DM + 4 * lane + 256 * j) * ALPHA;
#pragma unroll
            for (int k = 0; k < 4; ++k) { const int e = toke[token * 4 + k]; const size_t row = (size_t)tbase[e] * 256 + tokp[token * 4 + k]; const float gt = tokg[token * 4 + k] * DBG_MOE_MUL;
#pragma unroll
                for (int j = 0; j < 4; ++j) { const u32x2 y = *(const u32x2*)(Y + row * DM + 4 * lane + 256 * j); vv[u][j][0] += gt * bflo(y.x); vv[u][j][1] += gt * bfhi(y.x); vv[u][j][2] += gt * bflo(y.y); vv[u][j][3] += gt * bfhi(y.y); } } } }
#pragma unroll
        for (int u = 0; u < NTK; ++u) { const int token = token0 + u * NGW; if (token < NTOK) {
        f32x4 v[4];
#pragma unroll
        for (int j = 0; j < 4; ++j) v[j] = vv[u][j];
        float s = 0.f;
#pragma unroll
        for (int j = 0; j < 4; ++j) s += (v[j][0] + v[j][1]) + (v[j][2] + v[j][3]);
        const float mean = wave_sum(s) * (1.0f / DM); float s2 = 0.f;
#pragma unroll
        for (int j = 0; j < 4; ++j) { v[j] = v[j] - mean; s2 += (v[j][0] * v[j][0] + v[j][1] * v[j][1]) + (v[j][2] * v[j][2] + v[j][3] * v[j][3]); }
        const float rstd = 1.0f / sqrtf(wave_sum(s2) * (1.0f / DM) + LN_EPS);
#pragma unroll
        for (int j = 0; j < 4; ++j) { v[j] = v[j] * rstd * gv[j] + bv[j]; *(f32x4*)(out + (size_t)token * DM + 4 * lane + 256 * j) = v[j]; }
        if constexpr (NEXT_MLSTM) {
#pragma unroll
            for (int j = 0; j < 4; ++j) { u32x2 w; w.x = cvt_pk_bf16(v[j][0], v[j][1]); w.y = cvt_pk_bf16(v[j][2], v[j][3]); *(u32x2*)(xb + (size_t)token * DM + 4 * lane + 256 * j) = w; }
            float gp[8];
#pragma unroll
            for (int gi = 0; gi < 8; ++gi) { float a = 0.f;
#pragma unroll
                for (int j = 0; j < 4; ++j) { const f32x4 w = *(const LAS f32x4*)(wg + gi * 1024 + 4 * lane + 256 * j); a += (v[j][0] * w[0] + v[j][1] * w[1]) + (v[j][2] * w[2] + v[j][3] * w[3]); }
                gp[gi] = a; }
#pragma unroll
            for (int o = 1; o < 64; o <<= 1) {
#pragma unroll
                for (int gi = 0; gi < 8; ++gi) gp[gi] += __shfl_xor(gp[gi], o); }
#pragma unroll
            for (int gi = 0; gi < 8; ++gi) gp[gi] += bgates[gi];
            if (lane == 0) {
#pragma unroll
                for (int hh = 0; hh < 4; ++hh) { ((float*)(ws + WS_GI))[(size_t)hh * NTOK + token] = gp[hh];
                    const float f = gp[4 + hh]; const float lf = (f >= 0.f) ? -log1pf(__expf(-f)) : (f - log1pf(__expf(f)));
                    ((float*)(ws + WS_LF))[(size_t)hh * NTOK + token] = lf; } }
        }
        } }
    }
}

__device__ __forceinline__ void phase_gate_scan(Frame& F) {
    unsigned char* ws = F.ws; const int lane = F.lane; const int gw = F.vcu * NWAVES + F.wave, NGW = F.G * NWAVES;
    for (int mu = gw; mu < 256; mu += NGW) {
        const int b = mu >> 6, hh = (mu >> 4) & 3, ch = mu & 15; const size_t base = (size_t)hh * NTOK + (size_t)b * SEQ + ch * 256 + 4 * lane;
        const f32x4 lf = *(const f32x4*)((const float*)(ws + WS_LF) + base), gi = *(const f32x4*)((const float*)(ws + WS_GI) + base);
        f32x4 c; c[0] = lf[0]; c[1] = c[0] + lf[1]; c[2] = c[1] + lf[2]; c[3] = c[2] + lf[3];
        float tot = c[3];
#pragma unroll
        for (int o = 1; o < 64; o <<= 1) { const float up = __shfl_up(tot, o); if (lane >= o) tot += up; }
        const float excl = tot - c[3];
        f32x4 rf, cf;
#pragma unroll
        for (int j = 0; j < 4; ++j) { const float bt = excl + c[j]; rf[j] = __expf(bt); cf[j] = __expf(gi[j] - bt); }
        *(f32x4*)((float*)(ws + WS_RF) + base) = rf; *(f32x4*)((float*)(ws + WS_CF) + base) = cf;
        if (lane == 63) ((float*)(ws + WS_DEC))[mu] = __expf(tot);
    }
}
__device__ __forceinline__ void phase_nu(Frame& F) {
    unsigned char* ws = F.ws; const int lane = F.lane; const int gw = F.vcu * NWAVES + F.wave, NGW = F.G * NWAVES;
    const bf16_t* KT = (const bf16_t*)(ws + WS_KT); float* NU = (float*)(ws + WS_NU);
    for (int r0 = gw * 16; r0 < 256 * 128; r0 += NGW * 16) {
        const int mu = r0 >> 7, d0 = r0 & 127, b = mu >> 6, hh = (mu >> 4) & 3, ch = mu & 15;
        const bf16_t* base = KT + (size_t)(hh * 128 + d0) * NTOK + (size_t)b * SEQ + ch * 256 + 4 * lane;
        u32x2 kv[16];
#pragma unroll
        for (int i = 0; i < 16; ++i) kv[i] = *(const u32x2*)(base + (size_t)i * NTOK);
        float s[16];
#pragma unroll
        for (int i = 0; i < 16; ++i) s[i] = (bflo(kv[i].x) + bfhi(kv[i].x)) + (bflo(kv[i].y) + bfhi(kv[i].y));
#pragma unroll
        for (int o = 1; o < 64; o <<= 1) {
#pragma unroll
            for (int i = 0; i < 16; ++i) s[i] += __shfl_xor(s[i], o); }
        float mine = s[0];
#pragma unroll
        for (int i = 1; i < 16; ++i) mine = (lane == i) ? s[i] : mine;
        if (lane < 16) NU[r0 + lane] = mine;
    }
}
__device__ __forceinline__ void phase_state_scan(Frame& F) {
    unsigned char* ws = F.ws; const int gt = F.vcu * NTHR + F.tid, NGT = F.G * NTHR;
    const float* UT = (const float*)(ws + WS_UT); const float* DEC = (const float*)(ws + WS_DEC); bf16_t* BE = (bf16_t*)(ws + WS_BE);
    for (int i = gt; i < 16 * 256 * 32; i += NGT) { const int bh = i >> 13, e = (i >> 5) & 255, dg = i & 31;
        f32x4 U[16]; float dc[16];
#pragma unroll
        for (int ch = 0; ch < 16; ++ch) { const size_t mu = (size_t)bh * 16 + ch; U[ch] = *(const f32x4*)(UT + (mu * 256 + e) * 128 + 4 * dg); dc[ch] = DEC[mu]; }
        f32x4 C = {0.f, 0.f, 0.f, 0.f};
#pragma unroll
        for (int ch = 0; ch < 16; ++ch) { const size_t mu = (size_t)bh * 16 + ch;
            u32x2 w; w.x = cvt_pk_bf16(C[0], C[1]); w.y = cvt_pk_bf16(C[2], C[3]);
#ifdef DBG_NO_INTER
            w.x = 0u; w.y = 0u;
#endif
            *(u32x2*)(BE + (mu * 256 + e) * 384 + 256 + 4 * dg) = w;
            C = (C + U[ch]) * dc[ch]; } }
    const float* NU = (const float*)(ws + WS_NU); float* NP = (float*)(ws + WS_NPREV);
    for (int i = gt; i < 16 * 128; i += NGT) { const int bh = i >> 7, d = i & 127; float n = 0.f;
        for (int ch = 0; ch < 16; ++ch) { const int mu = bh * 16 + ch; NP[mu * 128 + d] = n; n = (n + NU[mu * 128 + d]) * DEC[mu];
#ifdef DBG_NO_INTER
            n = 0.f;
#endif
        } }
}
struct Args { const float* in[18]; float* out; unsigned char* ws; int ph_lo, ph_hi; };
__global__ void __launch_bounds__(NTHR, 2) mk_fwd(Args args) {
    extern __shared__ __attribute__((aligned(16))) unsigned char lds[];
    Frame F;
    const char __attribute__((address_space(4)))* kargp = (const char __attribute__((address_space(4)))*)__builtin_amdgcn_kernarg_segment_ptr();
#define AIN(i) ({ const char __attribute__((address_space(4)))* k_ = kargp; asm volatile("" : "+s"(k_)); *(const float* const __attribute__((address_space(4)))*)(k_ + 8 * (i)); })
    unsigned char* const ws0 = (unsigned char*)AIN(19);
    F.lds = (LAS unsigned char*)lds; F.ws = ws0; F.ctl = (unsigned*)(ws0 + WS_CTL);
    F.tid = threadIdx.x; F.lane = F.tid & 63; F.wave = __builtin_amdgcn_readfirstlane(F.tid >> 6);
    F.G = gridDim.x; { const int bx = blockIdx.x; F.vcu = (F.G % 8 == 0) ? (bx % 8) * (F.G / 8) + bx / 8 : bx; }
    for (int u = F.tid; u < (LDS_BYTES - LX) / 4; u += NTHR) ((LAS unsigned*)(F.lds + LX))[u] = 0u;
    __syncthreads();
    int lo, hi; { const char __attribute__((address_space(4)))* k_ = kargp; lo = *(const int __attribute__((address_space(4)))*)(k_ + 160); hi = *(const int __attribute__((address_space(4)))*)(k_ + 164); }
    XcdBarrier bar; bar.bar = (unsigned*)(F.ctl + CW_BAR); bar.x = 0; bar.st = nullptr;
    if (hi - lo > 1) bar = xcd_barrier_post((unsigned*)(F.ctl + CW_BAR), (volatile LAS unsigned*)(F.lds + LX_MISC) + 8);
#ifndef PHASE_MASK
#define PHASE_MASK 0x7FFFF
#endif
#define IN(k) ((((PHASE_MASK) >> (k)) & 1) && lo <= (k) && (k) < hi)
#ifndef REPEAT_MASK
#define REPEAT_MASK 0
#endif
#define PH(k) if (IN(k))
#define SEAM(k) do { if (IN(k) && IN((k) + 1)) xcd_barrier(bar); } while (0)
    unsigned char* ws = ws0;
#define x_in AIN(0)
#define ln_mix_g AIN(8)
#define ln_mix_b AIN(9)
#define ln_ffn_g AIN(10)
#define ln_ffn_b AIN(11)
#define router_b AIN(13)
#define b_gu AIN(15)
#define b_dn AIN(17)
    bf16_t* XB = (bf16_t*)(ws + WS_XB); bf16_t* QB_ = (bf16_t*)(ws + WS_Q); bf16_t* KB_ = (bf16_t*)(ws + WS_K); bf16_t* VB_ = (bf16_t*)(ws + WS_V);
    float* R0 = (float*)(ws + WS_R0); float* R1 = (float*)(ws + WS_R1); float* R2 = (float*)(ws + WS_R2);
    bf16_t* HB = (bf16_t*)(ws + WS_H); bf16_t* YB = (bf16_t*)(ws + WS_Y);
    LAS unsigned char* ring = F.lds + RING_OFF;
    const int cG = (int)blockIdx.x;
    const bool isConv = (NCONV > 0) && ((int)blockIdx.x >= F.G - NCONV);
    const int Gc = F.G - NCONV, cwv = ((int)blockIdx.x - Gc) * NWAVES + F.wave, ncw = NCONV * NWAVES;
#define CONV_SLICE(a, b) conv_items(F, AIN(14), AIN(16), (int)((long)CONV_ITEMS * (a) / 1000), (int)((long)CONV_ITEMS * (b) / 1000), cwv, ncw)

    PH(0) { P0In I{x_in, AIN(2), AIN(3), AIN(4), AIN(7), AIN(12), AIN(14), AIN(16), (const int*)AIN(1)}; p0_prologue(F, I); }
    SEAM(0);
    PH(1) { { Gemm g{1024, 1024, 1024, nullptr}; DenseSched S{64, 12, F.G, cG, (const char*)XB, (const char*)(ws + WS_WQKV), (size_t)256 * 1024 * 2, (size_t)256 * 1024 * 2};
        EpiQKV E{QB_, KB_, VB_, (const float*)(ws + WS_ROPE), (float*)(ws + WS_KSUM)};
        pg8::gemm_phase<EpiQKV, DenseSched, true, false>(ring, g, S, E); } }
    SEAM(1);
    PH(2) { if (isConv) CONV_SLICE(0, 1000); else {
        const attn_body::AttnTensors AT{(const attn_body::bf16*)QB_, (const attn_body::bf16*)KB_, (const attn_body::bf16*)VB_, (attn_body::bf16*)QB_, (const float*)(ws + WS_KSUM)};
        if (NCONV == 0) { const attn_body::StaticOrder S((int)F.G, (int)blockIdx.x); attn_body::attn_phase<attn_body::StaticOrder>((char*)lds + RING_OFF, AT, S); }
        else { const attn_body::SnakeOrder S{cG, Gc}; attn_body::attn_phase<attn_body::SnakeOrder>((char*)lds + RING_OFF, AT, S); } } }
    SEAM(2);
    PH(3) { { Gemm g{1024, 1024, 1024, nullptr}; DenseSched S{64, 4, F.G, cG, (const char*)QB_, (const char*)(ws + WS_WO), (size_t)256 * 1024 * 2, (size_t)256 * 1024 * 2};
        EpiZ E{x_in, R0, DBG_ATTN_MUL}; pg8::gemm_phase<EpiZ, DenseSched, true, false>(ring, g, S, E); } }
    SEAM(3);
    PH(4) phase_ln_router(F, R0, R1, ln_mix_g, ln_mix_b, router_b, 0, 0);
    SEAM(4);
    PH(5) { const int nT = moe_tables(F, 0); LAS unsigned short* tokl = (LAS unsigned short*)(F.lds + LX_TOKL);
        { const unsigned short* rowtok = (const unsigned short*)(ws + WS_ROWTOK); const LAS int* tile_e = (const LAS int*)(F.lds + LX_TILEE); const LAS int* tbase = (const LAS int*)(F.lds + LX_TBASE);
          for (int i = 0; i < TOKL_ROUNDS; ++i) { int pm, pn, hf; if (!moe_unit(i, F.G, cG, nT, 8, pm, pn, hf)) break;
              if (F.tid < 256) { const int e = tile_e[pm]; const int r = (pm - tbase[e]) * 256 + F.tid; const int c = (int)__hip_atomic_load(F.ctl + CW_CNT + 0 * 2048 + e * 64, RLX_AGENT);
                  tokl[i * 256 + F.tid] = (r < c) ? rowtok[(size_t)e * NTOK + r] : (unsigned short)0; } }
          __syncthreads(); }
        Gemm g{512, 512, 512, (const char*)XB};
        MoeSched S{nT, 8, F.G, cG, (const LAS int*)(F.lds + LX_TILEE), (const LAS int*)(F.lds + LX_TBASE), tokl, nullptr, (const char*)(ws + WS_WGU) + (size_t)0 * 32 * 2048 * 1024, 0, (size_t)2048 * 1024, (size_t)256 * 1024};
        EpiGU E{b_gu + (size_t)0 * 32 * 2048, (unsigned char*)HB, (LAS float*)(F.lds + LX_BIAS), 0}; pg8::gemm_phase<EpiGU, MoeSched, true, true, true, true>(ring, g, S, E); }
    SEAM(5);
    PH(6) { const int nT = moe_tables(F, 0); Gemm g{512, 512, 512, nullptr};
        MoeSched S{nT, 4, F.G, cG, (const LAS int*)(F.lds + LX_TILEE), (const LAS int*)(F.lds + LX_TBASE), nullptr, (const char*)HB, (const char*)(ws + WS_WD) + (size_t)0 * 32 * 1024 * 1024, (size_t)256 * 1024, (size_t)1024 * 1024, (size_t)256 * 1024};
        EpiDN E{b_dn + (size_t)0 * 32 * 1024, YB, (LAS float*)(F.lds + LX_BIAS), 0}; pg8::gemm_phase<EpiDN, MoeSched, true, false, true, true>(ring, g, S, E); }
    SEAM(6);
    PH(7) phase_combine<true>(F, R1, R2, ln_ffn_g, ln_ffn_b, AIN(5), 0);
    SEAM(7);
    PH(8) phase_gate_scan(F);
    SEAM(8);
    PH(9) {
        { Gemm g{1024, 1024, 1024, nullptr}; DenseSched S{64, 8, F.G, cG, (const char*)XB, (const char*)(ws + WS_WINA), (size_t)256 * 1024 * 2, (size_t)256 * 1024 * 2};
          EpiINA E{(const float*)(ws + WS_RF), (const float*)(ws + WS_CF), (bf16_t*)(ws + WS_AE), (bf16_t*)(ws + WS_KN), (bf16_t*)(ws + WS_OS)};
          pg8::gemm_phase<EpiINA, DenseSched, true, false>(ring, g, S, E); }
        { Gemm g{1024, 1024, 1024, nullptr}; DenseSched S{6, 64, F.G, cG, (const char*)(ws + WS_WINB), (const char*)XB, (size_t)256 * 1024 * 2, (size_t)256 * 1024 * 2, true};
          EpiINB E{(const float*)(ws + WS_CF), (bf16_t*)(ws + WS_KT), (bf16_t*)(ws + WS_BE)};
          pg8::gemm_phase<EpiINB, DenseSched, true, false, false, true>(ring, g, S, E); }
    }
    SEAM(9);
    PH(10) { Gemm g{256, 384, NTOK, nullptr}; MuSched S{F.G, cG, 0, (const char*)(ws + WS_BE), (const char*)(ws + WS_KT)};
        EpiM1 E{(float*)(ws + WS_UT)}; pg8::gemm_phase<EpiM1, MuSched, true, false>(ring, g, S, E);
        phase_nu(F); }
    SEAM(10);
    PH(11) phase_state_scan(F);
    SEAM(11);
    PH(12) { Gemm g{256, 512, 1024, nullptr}; MuSched S{F.G, cG, 1, (const char*)(ws + WS_AE), (const char*)(ws + WS_KN)};
        EpiM2A E{(bf16_t*)(ws + WS_AE), (const float*)(ws + WS_NPREV), (float*)(ws + WS_DEN)}; pg8::gemm_phase<EpiM2A, MuSched, true, false>(ring, g, S, E); }
    SEAM(12);
    PH(13) { Gemm g{384, 512, 384, nullptr}; MuSched S{F.G, cG, 2, (const char*)(ws + WS_AE), (const char*)(ws + WS_BE)};
        EpiM2B E{(const float*)(ws + WS_DEN), AIN(6), (const bf16_t*)(ws + WS_OS), (bf16_t*)(ws + WS_HN), (LAS float*)(F.lds + LX_LNX)};
        pg8::gemm_phase<EpiM2B, MuSched, true, false>(ring, g, S, E); }
    SEAM(13);
    PH(14) { Gemm g{1024, 1024, 1024, nullptr}; DenseSched S{64, 4, F.G, cG, (const char*)(ws + DBG_P14_A), (const char*)(ws + WS_WOUT), (size_t)256 * 1024 * 2, (size_t)256 * 1024 * 2};
        EpiZ E{R2, R0, DBG_MLSTM_MUL}; pg8::gemm_phase<EpiZ, DenseSched, true, false>(ring, g, S, E); }
    SEAM(14);
    PH(15) phase_ln_router(F, R0, R1, ln_mix_g + 1024, ln_mix_b + 1024, router_b + 32, 1, 1);
    SEAM(15);
    PH(16) { const int nT = moe_tables(F, 1); LAS unsigned short* tokl = (LAS unsigned short*)(F.lds + LX_TOKL);
        { const unsigned short* rowtok = (const unsigned short*)(ws + WS_ROWTOK); const LAS int* tile_e = (const LAS int*)(F.lds + LX_TILEE); const LAS int* tbase = (const LAS int*)(F.lds + LX_TBASE);
          for (int i = 0; i < TOKL_ROUNDS; ++i) { int pm, pn, hf; if (!moe_unit(i, F.G, cG, nT, 8, pm, pn, hf)) break;
              if (F.tid < 256) { const int e = tile_e[pm]; const int r = (pm - tbase[e]) * 256 + F.tid; const int c = (int)__hip_atomic_load(F.ctl + CW_CNT + 1 * 2048 + e * 64, RLX_AGENT);
                  tokl[i * 256 + F.tid] = (r < c) ? rowtok[(size_t)e * NTOK + r] : (unsigned short)0; } }
          __syncthreads(); }
        Gemm g{512, 512, 512, (const char*)XB};
        MoeSched S{nT, 8, F.G, cG, (const LAS int*)(F.lds + LX_TILEE), (const LAS int*)(F.lds + LX_TBASE), tokl, nullptr, (const char*)(ws + WS_WGU) + (size_t)1 * 32 * 2048 * 1024, 0, (size_t)2048 * 1024, (size_t)256 * 1024};
        EpiGU E{b_gu + (size_t)1 * 32 * 2048, (unsigned char*)HB, (LAS float*)(F.lds + LX_BIAS), 0}; pg8::gemm_phase<EpiGU, MoeSched, true, true, true, true>(ring, g, S, E); }
    SEAM(16);
    PH(17) { const int nT = moe_tables(F, 1); Gemm g{512, 512, 512, nullptr};
        MoeSched S{nT, 4, F.G, cG, (const LAS int*)(F.lds + LX_TILEE), (const LAS int*)(F.lds + LX_TBASE), nullptr, (const char*)HB, (const char*)(ws + WS_WD) + (size_t)1 * 32 * 1024 * 1024, (size_t)256 * 1024, (size_t)1024 * 1024, (size_t)256 * 1024};
        EpiDN E{b_dn + (size_t)1 * 32 * 1024, YB, (LAS float*)(F.lds + LX_BIAS), 0}; pg8::gemm_phase<EpiDN, MoeSched, true, false, true, true>(ring, g, S, E); }
    SEAM(17);
    PH(18) phase_combine<false>(F, R1, (float*)AIN(18), ln_ffn_g + 1024, ln_ffn_b + 1024, nullptr, 1);
#undef IN
#undef CONV_SLICE
#undef AIN
#undef x_in
#undef ln_mix_g
#undef ln_mix_b
#undef ln_ffn_g
#undef ln_ffn_b
#undef router_b
#undef b_gu
#undef b_dn
#undef SEAM
}

extern "C" void kernel_launch(void* const* d_in, const int* in_sizes, int n_in, void* d_out, int out_size, void* d_ws, size_t ws_size, hipStream_t stream) {
    static int grid = 0;
    if (grid == 0) {
        if (n_in != 18 || out_size != NTOK * DM || ws_size < WS_END) { fprintf(stderr, "kernel_launch: unexpected problem shape (n_in %d, out %d, ws %zu)\n", n_in, out_size, ws_size); grid = -1; return; }
        int dev = 0, cus = 0, per_cu = 0;
        if (hipGetDevice(&dev) != hipSuccess || hipDeviceGetAttribute(&cus, hipDeviceAttributeMultiprocessorCount, dev) != hipSuccess) { grid = -1; return; }
        if (hipFuncSetAttribute((const void*)mk_fwd, hipFuncAttributeMaxDynamicSharedMemorySize, LDS_BYTES) != hipSuccess) { fprintf(stderr, "kernel_launch: hipFuncSetAttribute failed\n"); grid = -1; return; }
        if (hipOccupancyMaxActiveBlocksPerMultiprocessor(&per_cu, (const void*)mk_fwd, NTHR, LDS_BYTES) != hipSuccess || per_cu < 1) fprintf(stderr, "kernel_launch: occupancy query reports %d\n", per_cu);
        (void)hipGetLastError();
        grid = cus;
        if (grid > 256) grid = 256;
        if (grid < 240) { fprintf(stderr, "kernel_launch: %d CUs: this build needs 240..256\n", cus); grid = -1; return; }
    }
    if (grid < 0) return;
    if (hipMemsetAsync((char*)d_ws + WS_CTL, 0, CTL_ZERO_BYTES, stream) != hipSuccess) return;
    Args a{};
    for (int i = 0; i < 18; ++i) a.in[i] = (const float*)d_in[i];
    a.out = (float*)d_out; a.ws = (unsigned char*)d_ws;
#if MK_ONE_LAUNCH
    a.ph_lo = 0; a.ph_hi = NPHASE;
    hipLaunchKernelGGL(mk_fwd, dim3(grid), dim3(NTHR), LDS_BYTES, stream, a);
#else
    for (int p = 0; p < NPHASE; ++p) { a.ph_lo = p; a.ph_hi = p + 1; hipLaunchKernelGGL(mk_fwd, dim3(grid), dim3(NTHR), LDS_BYTES, stream, a); }
#endif
}
```

```cpp
#include <hip/hip_runtime.h>
#include <hip/hip_bf16.h>
#include <cstdio>
#include <cstdint>
#include <cmath>

#define LAS __attribute__((address_space(3)))
#define GAS __attribute__((address_space(1)))
typedef unsigned short bf16_t;
typedef short bf16x8 __attribute__((ext_vector_type(8)));
typedef float f32x4 __attribute__((ext_vector_type(4)));
typedef float f32x2 __attribute__((ext_vector_type(2)));
typedef unsigned u32x4 __attribute__((ext_vector_type(4)));
typedef unsigned u32x2 __attribute__((ext_vector_type(2)));
typedef int i32x4 __attribute__((ext_vector_type(4)));
typedef int i32x8 __attribute__((ext_vector_type(8)));

typedef __bf16 bf16x2_t __attribute__((ext_vector_type(2)));
__device__ __forceinline__ unsigned cvt_pk_bf16(float lo, float hi) { const f32x2 v = {lo, hi}; const bf16x2_t b = __builtin_convertvector(v, bf16x2_t); return __builtin_bit_cast(unsigned, b); }
__device__ __forceinline__ float bf2f(unsigned short b) { return __uint_as_float(((unsigned)b) << 16); }
__device__ __forceinline__ float bflo(unsigned w) { return __uint_as_float(w << 16); }
__device__ __forceinline__ float bfhi(unsigned w) { return __uint_as_float(w & 0xffff0000u); }

__device__ __forceinline__ void glds16s(const void* sbase, unsigned voff, unsigned lds_dst) { unsigned keep;
    asm volatile("s_nop 4\n\ts_mov_b32 %0, m0\n\ts_mov_b32 m0, %3\n\ts_nop 0\n\tglobal_load_lds_dwordx4 %1, %2\n\ts_mov_b32 m0, %0" : "=&s"(keep) : "v"(voff), "s"(sbase), "s"(lds_dst) : "memory"); }
__device__ __forceinline__ void glds4s(const void* sbase, unsigned voff, unsigned lds_dst) { unsigned keep;
    asm volatile("s_nop 4\n\ts_mov_b32 %0, m0\n\ts_mov_b32 m0, %3\n\ts_nop 0\n\tglobal_load_lds_dword %1, %2\n\ts_mov_b32 m0, %0" : "=&s"(keep) : "v"(voff), "s"(sbase), "s"(lds_dst) : "memory"); }
__device__ __forceinline__ const char* uni_ptr(const char* p) { const unsigned long long v = (unsigned long long)p; const unsigned lo = __builtin_amdgcn_readfirstlane((unsigned)v), hi = __builtin_amdgcn_readfirstlane((unsigned)(v >> 32)); return (const char*)(((unsigned long long)hi << 32) | lo); }
namespace pg8 {
constexpr int BM = 256, BK = 64, HALF = 128, HTB = HALF * BK * 2, STAGE_BYTES = 8 * HTB, NXCD = 8, WGM = 8;
__host__ __device__ __forceinline__ int lds_byte(int r, int c) { const int st = (r >> 4) * 2 + (c >> 5), rr = r & 15, cc = c & 31, ob = rr * 64 + cc * 2; return st * 1024 + (ob ^ (((ob >> 9) & 1) << 5)); }
__host__ __device__ __forceinline__ void stage_rc(int b, int& R, int& C) { const int st = b / 1024, sb = b % 1024, swz = sb ^ (((sb >> 9) & 1) << 5); R = (st >> 1) * 16 + swz / 64; C = (st & 1) * 32 + (swz % 64) / 2; }
__host__ __device__ __forceinline__ int perm32(int rho) { const int n = rho >> 4, i = rho & 15; return 8 * (i >> 2) + 4 * n + (i & 3); }

struct Unit { int pm, pn; const char* A; const char* B; const LAS unsigned short* tl; int x0, x1, x2; };
struct Gemm { int K, lda, ldb; const char* Abase; };

__device__ __forceinline__ bool tile_order(int i, int G, int c, int nM, int nN, int& pm, int& pn) {
    const int nwg = nM * nN; const long L = (long)i * G + c; if (L >= nwg) return false;
    int wgid = (int)L; { const int q = nwg / NXCD, r = nwg % NXCD, xcd = wgid % NXCD, off = wgid / NXCD; wgid = (xcd < r ? xcd * (q + 1) : r * (q + 1) + (xcd - r) * q) + off; }
    const int nig = WGM * nN, gid = wgid / nig, fm = gid * WGM, gsz = (nM - fm) < WGM ? (nM - fm) : WGM;
    pm = fm + ((wgid % nig) % gsz); pn = (wgid % nig) / gsz; return true;
}

template <class Epi, class Sched, bool ALIGN_EPI, bool GATHER, bool FP8 = false, bool HALFSEL = false>
__device__ __forceinline__ void gemm_phase(LAS unsigned char* lds, const Gemm g, const Sched& S, const Epi& E) {
    const int tid = threadIdx.x, wid = __builtin_amdgcn_readfirstlane(tid >> 6), lane = tid & 63, wr = wid >> 2, wc = wid & 3, fr = lane & 15, fq = lane >> 4;
    const int K = g.K, nt = K / BK;
    int RA[2]; unsigned cA2[2], voffB[2];
#pragma unroll
    for (int i = 0; i < 2; ++i) { int R, C; stage_rc(tid * 16 + i * 8192, R, C); const int Rb = Epi::PERM ? ((R & ~31) + perm32(R & 31)) : R;
        RA[i] = R; cA2[i] = (unsigned)C * 2u; voffB[i] = (unsigned)(Rb * g.ldb + C) * 2u; }
    const size_t kstep = (size_t)(BK * 2);
    const unsigned hstepA = (unsigned)HALF * (unsigned)g.lda * 2u; const size_t hstepB = (size_t)HALF * g.ldb * 2;
    const unsigned ldsb = (unsigned)__builtin_amdgcn_readfirstlane((unsigned)(unsigned long long)lds + (unsigned)wid * 1024u);
    const int aoff = lds_byte(wr * 64 + fr, fq * 8), boff = lds_byte(wc * 32 + fr, fq * 8);
    const int aoff2 = aoff + 1024, boff2 = boff + 1024;
#define PG8_SA(b, h) (((b) * 2 + (h)) * HTB)
#define PG8_SB(b, h) ((4 + (b) * 2 + (h)) * HTB)
#define PG8_STAGE(bufoff, gbase, voff) do { _Pragma("unroll") for (int _i = 0; _i < 2; ++_i) glds16s((gbase), (voff)[_i], ldsb + (unsigned)(bufoff) + _i * 8192u); } while (0)
#define PG8_STAGE_A(bufoff, gbase, AO, h) do { _Pragma("unroll") for (int _i = 0; _i < 2; ++_i) glds16s((gbase), (AO)[h][_i], ldsb + (unsigned)(bufoff) + _i * 8192u); } while (0)
#define PG8_LD8(base_, o1_, o2_) __builtin_shufflevector(*(const LAS i32x4*)(lds + (base_) + (o1_)), *(const LAS i32x4*)(lds + (base_) + (o2_)), 0, 1, 2, 3, 4, 5, 6, 7)
#define PG8_LDA(dst, b, h) do { if constexpr (FP8) { _Pragma("unroll") for (int m = 0; m < 4; ++m) dst##8[m] = PG8_LD8(PG8_SA(b, h) + m * 2048, aoff, aoff2); } \
        else { _Pragma("unroll") for (int m = 0; m < 4; ++m) _Pragma("unroll") for (int k = 0; k < 2; ++k) dst[m][k] = *(const LAS bf16x8*)(lds + PG8_SA(b, h) + aoff + m * 2048 + k * 1024); } } while (0)
#define PG8_LDB(dst, b, h) do { if constexpr (FP8) { _Pragma("unroll") for (int n = 0; n < 2; ++n) dst##8[n] = PG8_LD8(PG8_SB(b, h) + n * 2048, boff, boff2); } \
        else { _Pragma("unroll") for (int n = 0; n < 2; ++n) _Pragma("unroll") for (int k = 0; k < 2; ++k) dst[n][k] = *(const LAS bf16x8*)(lds + PG8_SB(b, h) + boff + n * 2048 + k * 1024); } } while (0)
#define PG8_MMA(ai, bj, At, Bt) do { __builtin_amdgcn_s_setprio(1); _Pragma("unroll") for (int m = 0; m < 4; ++m) _Pragma("unroll") for (int n = 0; n < 2; ++n) { \
        if constexpr (FP8) asm volatile("v_mfma_f32_16x16x128_f8f6f4 %0, %1, %2, %0" : "+v"(acc[ai][bj][m][n]) : "v"(Bt##8[n]), "v"(At##8[m])); \
        else { _Pragma("unroll") for (int k = 0; k < 2; ++k) acc[ai][bj][m][n] = __builtin_amdgcn_mfma_f32_16x16x32_bf16(Bt[n][k], At[m][k], acc[ai][bj][m][n], 0, 0, 0); } } \
        __builtin_amdgcn_s_setprio(0); } while (0)
#define PG8_WAIT_V(n) asm volatile("s_waitcnt vmcnt(" #n ")" ::: "memory")
#define PG8_WAIT_L(n) asm volatile("s_waitcnt lgkmcnt(" #n ")" ::: "memory")
#define PG8_BAR __builtin_amdgcn_s_barrier()
#define PG8_SCHED __builtin_amdgcn_sched_barrier(0)
#define PG8_AOFF(AO, U) do { _Pragma("unroll") for (int _h = 0; _h < 2; ++_h) _Pragma("unroll") for (int _i = 0; _i < 2; ++_i) { \
        if constexpr (GATHER) AO[_h][_i] = (unsigned)(U).tl[RA[_i] + _h * HALF] * (unsigned)(g.lda * 2) + cA2[_i]; \
        else AO[_h][_i] = (unsigned)RA[_i] * (unsigned)(g.lda * 2) + cA2[_i] + (unsigned)_h * hstepA; } } while (0)
    Unit cur, nxt; int ui = 0;
    if (!S.next(0, cur)) return;
    f32x4 acc[2][2][4][2];
#pragma unroll
    for (int a = 0; a < 2; ++a)
#pragma unroll
        for (int b = 0; b < 2; ++b)
#pragma unroll
            for (int m = 0; m < 4; ++m)
#pragma unroll
                for (int n = 0; n < 2; ++n) acc[a][b][m][n] = (f32x4){0.f, 0.f, 0.f, 0.f};
    bf16x8 At[4][2], B0[2][2], B1[2][2]; i32x8 At8[4], B08[2], B18[2];
    E.prep(cur, 0, wid, lane);
    unsigned aoC[2][2], aoN[2][2];
    PG8_AOFF(aoC, cur);
    const char* cA = uni_ptr(GATHER ? g.Abase : cur.A); const char* cB = uni_ptr(cur.B);
    PG8_STAGE(PG8_SB(0, 0), cB, voffB); PG8_STAGE(PG8_SB(0, 1), cB + hstepB, voffB); PG8_STAGE_A(PG8_SA(0, 0), cA, aoC, 0); PG8_STAGE_A(PG8_SA(0, 1), cA, aoC, 1);
    if (wr == 1) PG8_BAR;
    PG8_WAIT_V(2); PG8_BAR;
    PG8_STAGE(PG8_SB(1, 0), cB + kstep, voffB); PG8_STAGE_A(PG8_SA(1, 0), cA + kstep, aoC, 0); PG8_STAGE(PG8_SB(1, 1), cB + hstepB + kstep, voffB);
    PG8_WAIT_V(6); PG8_BAR;
    for (;;) {
        const bool has_next = S.next(ui + 1, nxt);
        if (has_next) E.prep(nxt, ui + 1, wid, lane);
        if constexpr (GATHER) { if (has_next) PG8_AOFF(aoN, nxt); else { _Pragma("unroll") for (int _h = 0; _h < 2; ++_h) _Pragma("unroll") for (int _i = 0; _i < 2; ++_i) aoN[_h][_i] = aoC[_h][_i]; } }
        const char* nA = uni_ptr(GATHER ? g.Abase : (has_next ? nxt.A : cA)); const char* nB = uni_ptr(has_next ? nxt.B : cB);
        const bool dh0 = cur.x2 != 2, dh1 = cur.x2 != 1;
#pragma nounroll
        for (int t = 0; t < nt; t += 2) {
            const bool last = (t == nt - 2);
            const char* a1 = cA + (size_t)(t + 1) * kstep;
            const char* a2 = last ? nA : cA + (size_t)(t + 2) * kstep; const char* b2 = last ? nB : cB + (size_t)(t + 2) * kstep;
            const char* a3 = a2 + kstep; const char* b3 = b2 + kstep;
            unsigned aoS[2][2];
#pragma unroll
            for (int _h = 0; _h < 2; ++_h)
#pragma unroll
                for (int _i = 0; _i < 2; ++_i) aoS[_h][_i] = (GATHER && last) ? aoN[_h][_i] : aoC[_h][_i];
            PG8_LDB(B0, 0, 0); PG8_LDB(B1, 0, 1); PG8_SCHED; PG8_LDA(At, 0, 0); PG8_STAGE_A(PG8_SA(1, 1), a1, aoC, 1);
            PG8_WAIT_V(8); PG8_WAIT_L(0); PG8_BAR; if (!HALFSEL || dh0) PG8_MMA(0, 0, At, B0); if (!HALFSEL || dh1) PG8_MMA(0, 1, At, B1); PG8_BAR; PG8_SCHED;
            PG8_LDA(At, 0, 1); PG8_STAGE(PG8_SB(0, 0), b2, voffB); PG8_STAGE(PG8_SB(0, 1), b2 + hstepB, voffB); PG8_STAGE_A(PG8_SA(0, 0), a2, aoS, 0);
            PG8_WAIT_V(8); PG8_WAIT_L(0); PG8_BAR; if (!HALFSEL || dh0) PG8_MMA(1, 0, At, B0); if (!HALFSEL || dh1) PG8_MMA(1, 1, At, B1); PG8_BAR; PG8_SCHED;
            PG8_LDB(B0, 1, 0); PG8_LDB(B1, 1, 1); PG8_SCHED; PG8_LDA(At, 1, 0); PG8_STAGE_A(PG8_SA(0, 1), a2, aoS, 1);
            PG8_WAIT_V(8); PG8_WAIT_L(0); PG8_BAR; if (!HALFSEL || dh0) PG8_MMA(0, 0, At, B0); if (!HALFSEL || dh1) PG8_MMA(0, 1, At, B1); PG8_BAR; PG8_SCHED;
            PG8_LDA(At, 1, 1); PG8_STAGE(PG8_SB(1, 0), b3, voffB); PG8_STAGE(PG8_SB(1, 1), b3 + hstepB, voffB); PG8_STAGE_A(PG8_SA(1, 0), a3, aoS, 0);
            PG8_WAIT_V(8); PG8_WAIT_L(0); PG8_BAR; if (!HALFSEL || dh0) PG8_MMA(1, 0, At, B0); if (!HALFSEL || dh1) PG8_MMA(1, 1, At, B1); PG8_BAR; PG8_SCHED;
        }
        if constexpr (FP8) asm volatile("s_nop 15\n\ts_nop 15" ::: "memory");
        if constexpr (ALIGN_EPI) { if (wr == 0) PG8_BAR; }
        E(acc, cur, wr, wc, fr, fq);
        if (!has_next) break;
#pragma unroll
        for (int a = 0; a < 2; ++a)
#pragma unroll
            for (int b = 0; b < 2; ++b)
#pragma unroll
                for (int m = 0; m < 4; ++m)
#pragma unroll
                    for (int n = 0; n < 2; ++n) acc[a][b][m][n] = (f32x4){0.f, 0.f, 0.f, 0.f};
        if constexpr (FP8) asm volatile("s_nop 7" ::: "memory");
        cur = nxt; cA = nA; cB = nB; ++ui;
        if constexpr (GATHER) {
#pragma unroll
            for (int _h = 0; _h < 2; ++_h)
#pragma unroll
                for (int _i = 0; _i < 2; ++_i) aoC[_h][_i] = aoN[_h][_i]; }
        if constexpr (ALIGN_EPI) { if (wr == 1) PG8_BAR; }
    }
    PG8_WAIT_V(0);
    if constexpr (!ALIGN_EPI) { if (wr == 0) PG8_BAR; }
    PG8_BAR;
#undef PG8_SA
#undef PG8_SB
#undef PG8_STAGE
#undef PG8_STAGE_A
#undef PG8_LDA
#undef PG8_LD8
#undef PG8_LDB
#undef PG8_MMA
#undef PG8_WAIT_V
#undef PG8_WAIT_L
#undef PG8_BAR
#undef PG8_SCHED
#undef PG8_AOFF
}
}
#include <hip/hip_bf16.h>
namespace attn_body {
using bf16=__hip_bfloat16;
using bf16x8=__attribute__((ext_vector_type(8)))short;
using s16x4=__attribute__((ext_vector_type(4)))short;
using f32x16=__attribute__((ext_vector_type(16)))float;
using u32x4=__attribute__((ext_vector_type(4)))unsigned;
constexpr int BATCH=4,NHEAD=16,SEQ=4096,D=64,DM=NHEAD*D;
constexpr int NW=8,QBLK=32,QB=QBLK*NW,KVBLK=64,NQB=SEQ/QB;
constexpr int ATTN_PITCH=DM, ATTN_UNIT_ROWS=QB;
__device__ __forceinline__ int crow(int r,int hi){return (r&3)+8*(r>>2)+4*hi;}
#define SBAR() __builtin_amdgcn_sched_barrier(0)
__device__ __forceinline__ void cmask(f32x16&p0,f32x16&p1,int jb,int qrel,int hi){
  const float NEG=-INFINITY; int d=qrel-64*jb-4*hi; asm volatile("":"+v"(d));
  #pragma unroll
  for(int r=0;r<16;++r){const int c=(r&3)+8*(r>>2); if(c>d)p0[r]=NEG; if(c+32>d)p1[r]=NEG;}
}

constexpr int NSLOT=3, SLOTB=8192;
constexpr int LDS_GT=98304;
constexpr int LDS_K=0, LDS_V=NSLOT*SLOTB, LDS_WS=2*NSLOT*SLOTB, LDS_OST=LDS_WS+NW*64*4, LDS_BYTES=LDS_OST+NW*4096;
constexpr float C2=0.125f*1.4426950408889634f;
__device__ __forceinline__ void glds16(const void*gsrc,unsigned lds_dst){unsigned keep;
  asm volatile("s_mov_b32 %0, m0\n\ts_mov_b32 m0, %2\n\ts_nop 0\n\tglobal_load_lds_dwordx4 %1, off\n\ts_mov_b32 m0, %0":"=&s"(keep):"v"(gsrc),"s"(lds_dst):"memory");}
__device__ __forceinline__ void glds16s(const void*sbase,unsigned voff,unsigned lds_dst){unsigned keep;
  asm volatile("s_nop 4\n\ts_mov_b32 %0, m0\n\ts_mov_b32 m0, %3\n\ts_nop 0\n\tglobal_load_lds_dwordx4 %1, %2\n\ts_mov_b32 m0, %0":"=&s"(keep):"v"(voff),"s"(sbase),"s"(lds_dst):"memory");}
__device__ __forceinline__ unsigned lane_now(){unsigned l;asm volatile("v_mbcnt_lo_u32_b32 %0, -1, 0\n\tv_mbcnt_hi_u32_b32 %0, -1, %0":"=v"(l));return l;}
__device__ __forceinline__ float max3f(float a,float b,float c){float r;asm("v_max3_f32 %0, %1, %2, %3":"=v"(r):"v"(a),"v"(b),"v"(c));return r;}
__device__ __forceinline__ float max2f(float a,float b){float r;asm("v_max_f32_e32 %0, %1, %2":"=v"(r):"v"(a),"v"(b));return r;}
__device__ __forceinline__ float fadd_s(float a,float b){float r;asm("v_add_f32_e32 %0, %1, %2":"=v"(r):"v"(a),"v"(b));return r;}
__device__ __forceinline__ float fsub_s(float a,float b){float r;asm("v_sub_f32_e32 %0, %1, %2":"=v"(r):"v"(a),"v"(b));return r;}
typedef float f32x2_t __attribute__((ext_vector_type(2))); typedef __bf16 bf16x2_t __attribute__((ext_vector_type(2)));
__device__ __forceinline__ unsigned cvtpk_s(float lo,float hi){f32x2_t v={lo,hi};bf16x2_t b=__builtin_convertvector(v,bf16x2_t);return __builtin_bit_cast(unsigned,b);}
#define WAIT_BAR(N) asm volatile("s_waitcnt vmcnt(" #N ") lgkmcnt(0)\n\ts_barrier":::"memory")

__device__ __forceinline__ void qkt(f32x16&p0,f32x16&p1,const char*Kslot,const bf16x8*qr,int r32,int hi){
  const char*kb=Kslot+hi*1024+r32*16;
  #pragma unroll
  for(int d0=0;d0<4;++d0){
    const bf16x8 b0=*reinterpret_cast<const bf16x8*>(kb+d0*2048);
    const bf16x8 b1=*reinterpret_cast<const bf16x8*>(kb+d0*2048+512);
    if(d0==0){p0=__builtin_amdgcn_mfma_f32_32x32x16_bf16(b0,qr[0],(f32x16){0.f,0.f,0.f,0.f,0.f,0.f,0.f,0.f,0.f,0.f,0.f,0.f,0.f,0.f,0.f,0.f},0,0,0);p1=__builtin_amdgcn_mfma_f32_32x32x16_bf16(b1,qr[0],(f32x16){0.f,0.f,0.f,0.f,0.f,0.f,0.f,0.f,0.f,0.f,0.f,0.f,0.f,0.f,0.f,0.f},0,0,0);}
    else{p0=__builtin_amdgcn_mfma_f32_32x32x16_bf16(b0,qr[d0],p0,0,0,0);p1=__builtin_amdgcn_mfma_f32_32x32x16_bf16(b1,qr[d0],p1,0,0,0);}}
}
typedef __attribute__((address_space(3))) const char* lds_cptr;
typedef short v4i16_t __attribute__((ext_vector_type(4)));
__device__ __forceinline__ void kload8(bf16x8*kf,lds_cptr kp){
  kf[0]=*(const __attribute__((address_space(3))) bf16x8*)(kp);      kf[1]=*(const __attribute__((address_space(3))) bf16x8*)(kp+512);
  kf[2]=*(const __attribute__((address_space(3))) bf16x8*)(kp+2048); kf[3]=*(const __attribute__((address_space(3))) bf16x8*)(kp+2560);
  kf[4]=*(const __attribute__((address_space(3))) bf16x8*)(kp+4096); kf[5]=*(const __attribute__((address_space(3))) bf16x8*)(kp+4608);
  kf[6]=*(const __attribute__((address_space(3))) bf16x8*)(kp+6144); kf[7]=*(const __attribute__((address_space(3))) bf16x8*)(kp+6656);
}
__device__ __forceinline__ void kload2(bf16x8*kf,lds_cptr kp,int j){ kf[2*j]=*(const __attribute__((address_space(3))) bf16x8*)(kp+j*2048); kf[2*j+1]=*(const __attribute__((address_space(3))) bf16x8*)(kp+j*2048+512); }
__device__ __forceinline__ s16x4 vtr(lds_cptr p){ return __builtin_bit_cast(s16x4,__builtin_amdgcn_ds_read_tr16_b64_v4i16((__attribute__((address_space(3))) v4i16_t*)p)); }
__device__ __forceinline__ float rowmax(const f32x16&p0,const f32x16&p1){
  float a=max3f(p0[0],p0[1],p1[0]),b=max3f(p0[2],p0[3],p1[1]);a=max3f(a,p1[2],p1[3]);
  #pragma unroll
  for(int r=4;r<16;r+=4){a=max3f(a,p0[r],p0[r+1]);b=max3f(b,p0[r+2],p0[r+3]);a=max3f(a,p1[r],p1[r+1]);b=max3f(b,p1[r+2],p1[r+3]);}
  const float m=max2f(a,b);
  auto rr=__builtin_amdgcn_permlane32_swap(__float_as_uint(m),__float_as_uint(m),false,false);
  return max2f(__uint_as_float(rr[0]),__uint_as_float(rr[1]));
}
__device__ __forceinline__ void pv(f32x16*o,int vb,bf16x8 pa0,bf16x8 pa1,bf16x8 pa2,bf16x8 pa3){
  #pragma unroll
  for(int d0=0;d0<2;++d0){s16x4 lo[4],hi[4];
    #pragma unroll
    for(int ks=0;ks<4;++ks){
      asm volatile("ds_read_b64_tr_b16 %0,%1 offset:%c2":"=&v"(lo[ks]):"v"(vb),"i"(d0*4096+ks*1024):"memory");
      asm volatile("ds_read_b64_tr_b16 %0,%1 offset:%c2":"=&v"(hi[ks]):"v"(vb),"i"(d0*4096+ks*1024+512):"memory");}
    asm volatile("s_waitcnt lgkmcnt(0)":::"memory");SBAR();
    #define PK(k) (bf16x8){lo[k][0],lo[k][1],lo[k][2],lo[k][3],hi[k][0],hi[k][1],hi[k][2],hi[k][3]}
    o[d0]=__builtin_amdgcn_mfma_f32_32x32x16_bf16(pa0,PK(0),o[d0],0,0,0);
    o[d0]=__builtin_amdgcn_mfma_f32_32x32x16_bf16(pa1,PK(1),o[d0],0,0,0);
    o[d0]=__builtin_amdgcn_mfma_f32_32x32x16_bf16(pa2,PK(2),o[d0],0,0,0);
    o[d0]=__builtin_amdgcn_mfma_f32_32x32x16_bf16(pa3,PK(3),o[d0],0,0,0);
    #undef PK
  }
}

#ifndef ATTN_STORE16
#define ATTN_STORE16(p,v) (*(u32x4*)(p)=(v))
#endif
template<int THRL> __device__ __forceinline__ void attn_unit(int b,int h,int qb,const bf16*Q,const bf16*__restrict__ K,const bf16*__restrict__ V,bf16*O,const float*ksum,char*shm){
  const int tid=threadIdx.x,lane=tid&63,r32=lane&31,hi=lane>>5; const int wid=__builtin_amdgcn_readfirstlane(tid>>6);
  const long rowbase=(long)b*SEQ; const int q0=qb*QB;
  const bf16*Qw=Q+(rowbase+q0+wid*QBLK)*DM+h*D;
  const bf16*Kh=K+rowbase*DM+h*D,*Vh=V+rowbase*DM+h*D;
  const unsigned lds0=(unsigned)(uintptr_t)shm;
  float*wsf=(float*)(shm+LDS_WS)+wid*64;
  const unsigned kdst=lds0+LDS_K+wid*1024, vdst=lds0+LDS_V+wid*1024;
  #define PHYS(t) (((t)<4)?(4*qb+(t)):((t)-4))
  #define DMA_K(t,slot) glds16s((const char*)Kh+(size_t)PHYS(t)*(KVBLK*DM*2)+wid*16,lane_now()*(unsigned)(DM*2),(unsigned)__builtin_amdgcn_readfirstlane(kdst+(slot)))
  #define DMA_V(t,slot) glds16s((const char*)Vh+(size_t)PHYS(t)*(KVBLK*DM*2)+(size_t)(16*(wid&3))*(DM*2)+(wid>>2)*64,({const unsigned l_=lane_now(); (l_>>2)*(unsigned)(DM*2)+(l_&3u)*16u;}),(unsigned)__builtin_amdgcn_readfirstlane(vdst+(slot)))
  const int vb0=(int)(lds0+LDS_V)+((lane>>4)&1)*32+(lane&3)*8+(4*hi+((lane&15)>>2))*64;
  const char*Kbase=shm+LDS_K; bf16x8 kf[8];
  const lds_cptr shm3=(lds_cptr)shm; const lds_cptr kp0=shm3+LDS_K+hi*1024+r32*16; const lds_cptr vp0=shm3+LDS_V+((lane>>4)&1)*32+(lane&3)*8+(4*hi+((lane&15)>>2))*64;
  const int NT=(q0+QB)/KVBLK;
  DMA_K(0,0);DMA_V(0,0);DMA_K(1,SLOTB);
  { float*gt=(float*)(shm+LDS_GT);
    #pragma unroll
    for(int k=0;k<2;++k){ const int j=2*wid+k; if(j<qb) gt[j*64+lane]=ksum[(long)(b*16+j)*DM+h*D+lane]; } }
  bf16x8 qr[4];
  #pragma unroll
  for(int d0=0;d0<4;++d0)qr[d0]=*reinterpret_cast<const bf16x8*>(&Qw[(long)r32*DM+d0*16+hi*8]);

  unsigned sel=0u;
  float mhat=0.f,l_reg=0.f;f32x16 o[2];o[0]=f32x16{};o[1]=f32x16{};
  bf16x8 kone=(bf16x8){0,0,0,0,0,0,0,0}, qm=(bf16x8){0,0,0,0,0,0,0,0}; if(hi==0) kone[0]=(short)0x3F80;
  #define SETQM() do{ const unsigned short mb_=(unsigned short)(cvtpk_s(-mhat,0.f)&0xffffu); qm[0]=(hi==0)?(short)mb_:(short)0; asm volatile("":"+v"(qm)); }while(0)
  const int qrel=wid*QBLK+r32;
  #define CMASK(P0,P1,t) do{ const int t_=(t); if(t_<4){ const int l_=(int)lane_now(); cmask(P0,P1,t_,wid*QBLK+(l_&31),l_>>5); } else if(!((sel>>(((t_-4)>>2)&15))&1u)){ _Pragma("unroll") for(int r=0;r<16;++r){P0[r]=-INFINITY;P1[r]=-INFINITY;} } }while(0)
  bool resc=false;
  #define START(P0,P1) do{ const float rm=rowmax(P0,P1); resc=false; \
    { const float dl=__uint_as_float(cvtpk_s(rm,0.f)<<16); mhat=fadd_s(mhat,dl);          \
      _Pragma("unroll") for(int r=0;r<16;++r){P0[r]=fsub_s(P0[r],dl);P1[r]=fsub_s(P1[r],dl);} \
      SETQM(); } \
    _Pragma("unroll") for(int r=0;r<16;++r)P0[r]=__builtin_amdgcn_exp2f(P0[r]); }while(0)
  #define RESC() do{ if(resc){ asm volatile("s_waitcnt lgkmcnt(0)":::"memory"); \
      _Pragma("unroll") for(int d_=0;d_<2;++d_) _Pragma("unroll") for(int r=0;r<16;++r)o[d_][r]*=wsf[crow(r,(int)(lane_now()>>5))]; } }while(0)
  f32x16 pA0,pA1,pB0,pB1;
  int sl_prev=0,sl_cur=0,sl_next=SLOTB;
  #define ROT() do{sl_prev=sl_cur;sl_cur=sl_next;sl_next=(sl_next==(NSLOT-1)*SLOTB)?0:sl_next+SLOTB;}while(0)
  DMA_K(2,2*SLOTB);
  WAIT_BAR(3);
  { float qf[32];
    #pragma unroll
    for(int d0=0;d0<4;++d0){
      #pragma unroll
      for(int i=0;i<8;++i) qf[d0*8+i]=__uint_as_float(((unsigned)(unsigned short)qr[d0][i])<<16); }
    const float*gt=(const float*)(shm+LDS_GT)+hi*8; float g[15];
    #pragma unroll
    for(int j=0;j<15;++j){ g[j]=-INFINITY;
      if(j<qb){ const float*kp=gt+j*64; float a=0.f;
        #pragma unroll
        for(int d0=0;d0<4;++d0){ const float4 k0=*reinterpret_cast<const float4*>(kp+d0*16), k1=*reinterpret_cast<const float4*>(kp+d0*16+4);
          a+=qf[d0*8+0]*k0.x; a+=qf[d0*8+1]*k0.y; a+=qf[d0*8+2]*k0.z; a+=qf[d0*8+3]*k0.w; a+=qf[d0*8+4]*k1.x; a+=qf[d0*8+5]*k1.y; a+=qf[d0*8+6]*k1.z; a+=qf[d0*8+7]*k1.w; }
        g[j]=a+__shfl_xor(a,32); } }
    #pragma unroll
    for(int kk=0;kk<3;++kk){ float best=-INFINITY; int bj=-1;
      #pragma unroll
      for(int j=0;j<15;++j){ const bool c=(j<qb)&&!((sel>>j)&1u)&&(g[j]>best); best=c?g[j]:best; bj=c?j:bj; }
      if(bj>=0) sel|=(1u<<bj); } }
  qkt(pA0,pA1,Kbase,qr,r32,hi);asm volatile("s_nop 15\n\ts_nop 7":"+v"(pA0),"+v"(pA1));CMASK(pA0,pA1,0);
  START(pA0,pA1);
  _Pragma("unroll") for(int r=0;r<16;++r)pA1[r]=__builtin_amdgcn_exp2f(pA1[r]);
  WAIT_BAR(0);
  DMA_K(3,0);DMA_V(1,SLOTB);
  ROT();
  kload8(kf,kp0+sl_cur);
  WAIT_BAR(2);
  s16x4 vlo[8],vhi[8]; u32x4 pw0,pw1,pw2,pw3;
  #define PKW(P,B) cvtpk_s(P[B],P[B+1])
  #define PAF(k) __builtin_bit_cast(bf16x8,pw##k)
  #define VFR(i) (bf16x8){vlo[i][0],vlo[i][1],vlo[i][2],vlo[i][3],vhi[i][0],vhi[i][1],vhi[i][2],vhi[i][3]}
  #define PIN(x) asm volatile("":"+v"(x))
  #define MX3(a,b,c) __builtin_fmaxf(__builtin_fmaxf((a),(b)),(c))
  #define GAPA(MF,A0,A1,A2,A3,W0,W1,PW) do{ MF; sacc+=A0; sacc+=A1; sacc+=A2; sacc+=A3; PIN(sacc); W0; W1; PIN(PW); SBAR(); }while(0)
  #define EX(v) __builtin_amdgcn_exp2f(v)
  #define GAPB(MF,X,B) do{ MF; X[B]=EX(X[B]); X[B+1]=EX(X[B+1]); X[B+2]=EX(X[B+2]); X[B+3]=EX(X[B+3]); PIN(X); SBAR(); }while(0)
  #define VRD(i) do{ vlo[i]=vtr(vp_+(((i)>>2)*4096+((i)&3)*1024)); vhi[i]=vtr(vp_+(((i)>>2)*4096+((i)&3)*1024+512)); }while(0)
  #define KRD(G,j) do{ if(G){ kload2(kf,kp0+sl_next,j); SBAR(); } }while(0)
  #define STEP(C0,C1,P0,P1,t,GK,GV,GL) do{ SBAR(); \
    const lds_cptr vp_=vp0+sl_prev; \
    C0=__builtin_amdgcn_mfma_f32_32x32x16_bf16(kone,qm,(f32x16){0.f,0.f,0.f,0.f,0.f,0.f,0.f,0.f,0.f,0.f,0.f,0.f,0.f,0.f,0.f,0.f},0,0,0); C1=__builtin_amdgcn_mfma_f32_32x32x16_bf16(kone,qm,(f32x16){0.f,0.f,0.f,0.f,0.f,0.f,0.f,0.f,0.f,0.f,0.f,0.f,0.f,0.f,0.f,0.f},0,0,0); SBAR(); \
    VRD(0); SBAR(); float sacc=(P0[0]+P0[1]); \
    GAPA(C0=__builtin_amdgcn_mfma_f32_32x32x16_bf16(kf[0],qr[0],C0,0,0,0), P0[2],P0[3],P0[4],P0[5],     pw0[0]=PKW(P0,0), pw0[1]=PKW(P0,2), pw0); \
    VRD(4); SBAR(); GAPA(C1=__builtin_amdgcn_mfma_f32_32x32x16_bf16(kf[1],qr[0],C1,0,0,0), P0[6],P0[7],P0[8],P0[9],     pw0[2]=PKW(P0,4), pw0[3]=PKW(P0,6), pw0); \
    VRD(1); SBAR(); GAPA(C0=__builtin_amdgcn_mfma_f32_32x32x16_bf16(kf[2],qr[1],C0,0,0,0),   P0[10],P0[11],P0[12],P0[13], pw1[0]=PKW(P0,8), pw1[1]=PKW(P0,10), pw1); \
    VRD(5); SBAR(); GAPA(C1=__builtin_amdgcn_mfma_f32_32x32x16_bf16(kf[3],qr[1],C1,0,0,0),   P0[14],P0[15],P1[0],P1[1],   pw1[2]=PKW(P0,12),pw1[3]=PKW(P0,14), pw1); \
    VRD(2); SBAR(); GAPA(C0=__builtin_amdgcn_mfma_f32_32x32x16_bf16(kf[4],qr[2],C0,0,0,0),   P1[2],P1[3],P1[4],P1[5],     pw2[0]=PKW(P1,0), pw2[1]=PKW(P1,2), pw2); \
    VRD(6); SBAR(); GAPA(C1=__builtin_amdgcn_mfma_f32_32x32x16_bf16(kf[5],qr[2],C1,0,0,0),   P1[6],P1[7],P1[8],P1[9],     pw2[2]=PKW(P1,4), pw2[3]=PKW(P1,6), pw2); \
    VRD(3); SBAR(); GAPA(C0=__builtin_amdgcn_mfma_f32_32x32x16_bf16(kf[6],qr[3],C0,0,0,0),   P1[10],P1[11],P1[12],P1[13], pw3[0]=PKW(P1,8), pw3[1]=PKW(P1,10), pw3); \
    VRD(7); SBAR(); GAPA(C1=__builtin_amdgcn_mfma_f32_32x32x16_bf16(kf[7],qr[3],C1,0,0,0),   P1[14],P1[15],0.f,0.f,       pw3[2]=PKW(P1,12),pw3[3]=PKW(P1,14), pw3); \
    l_reg+=sacc; \
    if(GK){DMA_K((t)+3,sl_cur);} if(GV){DMA_V((t)+1,sl_next);} \
    CMASK(C0,C1,t); \
    { float a=MX3(C0[0],C0[1],C1[0]),b=MX3(C0[2],C0[3],C1[1]); a=MX3(a,C1[2],C1[3]); \
      _Pragma("unroll") for(int r=4;r<16;r+=4){a=MX3(a,C0[r],C0[r+1]);b=MX3(b,C0[r+2],C0[r+3]);a=MX3(a,C1[r],C1[r+1]);b=MX3(b,C1[r+2],C1[r+3]);} \
      float rm=__builtin_fmaxf(a,b); { auto rr=__builtin_amdgcn_permlane32_swap(__float_as_uint(rm),__float_as_uint(rm),false,false); rm=__builtin_fmaxf(__uint_as_float(rr[0]),__uint_as_float(rr[1])); } \
      resc=false; \
      if(__builtin_expect(__any(rm>(float)THRL),0)){ const float mn_=__uint_as_float(cvtpk_s(mhat+__builtin_fmaxf(rm,0.f),0.f)<<16); const float dl=mn_-mhat; mhat=mn_; \
        _Pragma("unroll") for(int r=0;r<16;++r){C0[r]-=dl;C1[r]-=dl;} \
        SETQM(); \
        const float f=__builtin_amdgcn_exp2f(-dl); l_reg*=f; { const int l_=(int)lane_now(); if((l_>>5)==0)wsf[l_&31]=f; } resc=true; } } \
    SBAR(); \
    GAPB(o[0]=__builtin_amdgcn_mfma_f32_32x32x16_bf16(PAF(0),VFR(0),o[0],0,0,0), C0,0); \
    GAPB(o[1]=__builtin_amdgcn_mfma_f32_32x32x16_bf16(PAF(0),VFR(4),o[1],0,0,0), C0,4); \
    KRD(GL,0); GAPB(o[0]=__builtin_amdgcn_mfma_f32_32x32x16_bf16(PAF(1),VFR(1),o[0],0,0,0), C0,8); \
    KRD(GL,1); GAPB(o[1]=__builtin_amdgcn_mfma_f32_32x32x16_bf16(PAF(1),VFR(5),o[1],0,0,0), C0,12); \
    KRD(GL,2); GAPB(o[0]=__builtin_amdgcn_mfma_f32_32x32x16_bf16(PAF(2),VFR(2),o[0],0,0,0), C1,0); \
    KRD(GL,3); GAPB(o[1]=__builtin_amdgcn_mfma_f32_32x32x16_bf16(PAF(2),VFR(6),o[1],0,0,0), C1,4); \
    GAPB(o[0]=__builtin_amdgcn_mfma_f32_32x32x16_bf16(PAF(3),VFR(3),o[0],0,0,0), C1,8); \
    GAPB(o[1]=__builtin_amdgcn_mfma_f32_32x32x16_bf16(PAF(3),VFR(7),o[1],0,0,0), C1,12); \
    }while(0)
  int t=1;
  #undef CMASK
  #define CMASK(P0,P1,t) do{ const int t_=(t); if(t_<4){ const int l_=(int)lane_now(); cmask(P0,P1,t_,wid*QBLK+(l_&31),l_>>5); } else if(!((sel>>(((t_-4)>>2)&15))&1u)){ _Pragma("unroll") for(int r=0;r<16;++r){P0[r]=-INFINITY;P1[r]=-INFINITY;} } }while(0)
  for(;t+5<NT;t+=2){
    STEP(pB0,pB1,pA0,pA1,t,true,true,true);     WAIT_BAR(2); RESC(); ROT();
    STEP(pA0,pA1,pB0,pB1,t+1,true,true,true);   WAIT_BAR(2); RESC(); ROT();
  }
  #undef CMASK
  #define CMASK(P0,P1,t) do{ const int t_=(t); if(t_<4){ const int l_=(int)lane_now(); cmask(P0,P1,t_,wid*QBLK+(l_&31),l_>>5); } else if(!((sel>>(((t_-4)>>2)&15))&1u)){ _Pragma("unroll") for(int r=0;r<16;++r){P0[r]=-INFINITY;P1[r]=-INFINITY;} } }while(0)
  #define ENDW(tt) do{ if((tt)+3<NT){WAIT_BAR(2);} else if((tt)+2<NT){WAIT_BAR(1);} else {WAIT_BAR(0);} }while(0)
  for(;t+1<NT;t+=2){
    STEP(pB0,pB1,pA0,pA1,t,(t+3<NT),(t+1<NT),(t+1<NT));       ENDW(t);   RESC(); ROT();
    STEP(pA0,pA1,pB0,pB1,t+1,(t+4<NT),(t+2<NT),(t+2<NT));     ENDW(t+1); RESC(); ROT();
  }
  STEP(pB0,pB1,pA0,pA1,NT-1,false,false,false); RESC();
  { float sacc=pB0[0]+pB0[1]; _Pragma("unroll") for(int r=2;r<16;++r)sacc+=pB0[r]; _Pragma("unroll") for(int r=0;r<16;++r)sacc+=pB1[r]; l_reg+=sacc;
    pw0=(u32x4){PKW(pB0,0),PKW(pB0,2),PKW(pB0,4),PKW(pB0,6)};pw1=(u32x4){PKW(pB0,8),PKW(pB0,10),PKW(pB0,12),PKW(pB0,14)};pw2=(u32x4){PKW(pB1,0),PKW(pB1,2),PKW(pB1,4),PKW(pB1,6)};pw3=(u32x4){PKW(pB1,8),PKW(pB1,10),PKW(pB1,12),PKW(pB1,14)};
    SBAR(); pv(o,vb0+sl_cur,PAF(0),PAF(1),PAF(2),PAF(3)); }
  #undef PKW
  #undef PAF
  #undef VFR
  #undef PIN
  #undef MX3
  #undef GAPA
  #undef GAPB
  #undef EX
  #undef VRD
  #undef KRD
  #undef STEP
  #undef ENDW
  {auto rr=__builtin_amdgcn_permlane32_swap(__float_as_uint(l_reg),__float_as_uint(l_reg),false,false);l_reg=__uint_as_float(rr[0])+__uint_as_float(rr[1]);}
  if(hi==0)wsf[32+r32]=l_reg;asm volatile("s_waitcnt lgkmcnt(0)":::"memory");
  float rli[16];
  #pragma unroll
  for(int r=0;r<16;++r)rli[r]=__builtin_amdgcn_rcpf(wsf[32+crow(r,hi)]);
  bf16*Ow=O+(rowbase+q0+wid*QBLK)*DM+h*D;
  { bf16*stg=(bf16*)(shm+LDS_OST)+wid*2048;
    #pragma unroll
    for(int r=0;r<16;++r){const int orow=crow(r,hi);
      #pragma unroll
      for(int d0=0;d0<2;++d0)stg[orow*64+d0*32+r32]=__float2bfloat16(o[d0][r]*rli[r]);}
    asm volatile("s_waitcnt lgkmcnt(0)":::"memory");
    #pragma unroll
    for(int i=0;i<4;++i){const int row=i*8+(lane>>3),ch=lane&7; const u32x4 v=*(const u32x4*)(stg+row*64+ch*8); ATTN_STORE16(Ow+(long)row*DM+ch*8,v);} }
  asm volatile("s_waitcnt lgkmcnt(0)\n\ts_barrier":::"memory");
  #undef DMA_K
  #undef PHYS
  #undef DMA_V
  #undef CMASK
  #undef START
  #undef SETQM
  #undef RESC
  #undef ROT
}
constexpr int ATTN_LDS_BYTES=LDS_BYTES;
struct AttnTensors { const bf16* Q; const bf16* K; const bf16* V; bf16* O; const float* ksum; };
struct AttnUnit { int bh; int qb; };
struct StaticOrder {
  int vcu, G;
  __device__ __forceinline__ explicit StaticOrder(int grid,int block):vcu((grid%8==0)?((block%8)*(grid/8)+block/8):block),G(grid){}
  __device__ __forceinline__ bool next(int i,AttnUnit&u)const{ const int L=i*G+vcu; if(L>=1024)return false; const int w=L&255, rnd=L>>8, s=w&3; u.bh=w>>2; u.qb=(rnd==0)?s:(rnd==1)?7-s:(rnd==2)?8+s:15-s; return true; }
  __device__ __forceinline__ void a_ready(const AttnUnit&)const{}
  __device__ __forceinline__ void done(const AttnUnit&)const{}
};
struct SnakeOrder {
  int v, G;
  __device__ __forceinline__ bool next(int i,AttnUnit&u)const{ const int idx=i*G+((i&1)?(G-1-v):v); if(idx>=1024)return false; u.qb=15-(idx>>6); u.bh=idx&63; return true; }
  __device__ __forceinline__ void a_ready(const AttnUnit&)const{}
  __device__ __forceinline__ void done(const AttnUnit&)const{}
};
template<class Sched,int THRL=8> __device__ __forceinline__ void attn_phase(char*lds,const AttnTensors&T,const Sched&S){
  AttnUnit u;
  for(int i=0;S.next(i,u);++i){ S.a_ready(u); attn_unit<THRL>(u.bh/NHEAD,u.bh%NHEAD,u.qb,T.Q,T.K,T.V,T.O,T.ksum,lds); S.done(u); }
}
#undef SBAR
#undef WAIT_BAR
}
constexpr int NWAVES = 8, NTHR = 512;
constexpr int NTOK = 16384, DM = 1024, SEQ = 4096, NBATCH = 4, NEXP = 32;
constexpr float ALPHA = 1.4142135623730951f;
constexpr float LN_EPS = 1e-5f;
constexpr float RSQRT_DQK = 0.08838834764831845f;
constexpr int NPHASE = 19;
constexpr float FP8_SA = 4.0f, FP8_SWGU = 64.0f, FP8_SWD = 128.0f;
#ifndef DBG_ATTN_MUL
#define DBG_ATTN_MUL 1.0f
#endif
#ifndef DBG_MLSTM_MUL
#define DBG_MLSTM_MUL 1.0f
#endif
#ifndef DBG_MOE_MUL
#define DBG_MOE_MUL 1.0f
#endif
#ifndef DBG_P14_A
#define DBG_P14_A WS_HN
#endif
#ifndef NCONV
#define NCONV 80
#endif
#ifndef MK_ONE_LAUNCH
#define MK_ONE_LAUNCH 1
#endif

constexpr size_t MiB = 1u << 20, KiB = 1024;
constexpr size_t WS_CTL = 0, CTL_ZERO_BYTES = 1 * MiB;
constexpr int CW_TMO = 0, CW_BAR = 4096, CW_CNT = 8192, CW_AQ = 16384;
constexpr size_t WS_KSUM = 256 * KiB, WS_DEN = 512 * KiB;
constexpr size_t WS_WQKV = 2 * MiB, WS_WO = 8 * MiB, WS_WINA = 10 * MiB, WS_WINB = 14 * MiB, WS_WOUT = 17 * MiB;
constexpr size_t WS_WG = 19 * MiB, WS_RWT = 20 * MiB, WS_ROPE = 21 * MiB;
constexpr size_t WS_TOKE = 22 * MiB, WS_TOKP = 22 * MiB + 256 * KiB, WS_TOKG = 22 * MiB + 512 * KiB;
constexpr size_t WS_GI = 23 * MiB, WS_LF = 23 * MiB + 256 * KiB, WS_RF = 23 * MiB + 512 * KiB, WS_CF = 23 * MiB + 768 * KiB;
constexpr size_t WS_DEC = 24 * MiB, WS_NU = 24 * MiB + 256 * KiB, WS_NPREV = 24 * MiB + 512 * KiB;
constexpr size_t WS_ROWTOK = 25 * MiB;
constexpr size_t WS_XB = 32 * MiB, WS_Q = 64 * MiB, WS_K = 96 * MiB, WS_V = 128 * MiB;
constexpr size_t WS_R0 = 160 * MiB, WS_R1 = 224 * MiB, WS_R2 = 288 * MiB;
constexpr size_t WS_H = 352 * MiB, WS_Y = 496 * MiB;
constexpr size_t WS_WGU = 640 * MiB, WS_WD = 896 * MiB, WS_END = 1024 * MiB;
constexpr size_t WS_AE = 352 * MiB, WS_BE = 416 * MiB, WS_KN = 464 * MiB, WS_KT = 496 * MiB, WS_UT = 512 * MiB, WS_OS = 544 * MiB, WS_HN = 576 * MiB;

constexpr int RING_OFF = 0, RING_BYTES = 131072;
constexpr int LX = RING_BYTES;
constexpr int LX_MISC = LX;
constexpr int LX_TILEE = LX + 128;
constexpr int LX_TBASE = LX + 1280;
constexpr int LX_LCNT = LX + 1536, LX_GBASE = LX + 1664;
constexpr int LX_REC = LX + 1792;
constexpr int LX_TOKL = LX + 4096;
constexpr int LX_LNX = LX + 4096;
constexpr int LX_BIAS = LX + 12288;
constexpr int LDS_BYTES = 147456;
constexpr int TOKL_ROUNDS = 10;

#define RLX_AGENT __ATOMIC_RELAXED, __HIP_MEMORY_SCOPE_AGENT
#define LDS_WAIT() asm volatile("s_waitcnt lgkmcnt(0)" ::: "memory")
#define VM_WAIT() asm volatile("s_waitcnt vmcnt(0)" ::: "memory")
#define XB_TMO      128
#define XB_XCNT(j)  (256  + 64 * (j))
#define XB_XSUB(j)  (1280 + 64 * (j))
#define XB_XGEN(j)  (2304 + 64 * (j))
#define XB_TOP      3328
#define XB_TOPGEN   3392
#define XCD_BAR_WORDS 3456
#define XB_SPIN_CAP (1u << 18)

__device__ __forceinline__ unsigned xb_ld(unsigned* p)              { return __hip_atomic_load(p, __ATOMIC_RELAXED, __HIP_MEMORY_SCOPE_AGENT); }
__device__ __forceinline__ unsigned xb_add(unsigned* p, unsigned v) { return __hip_atomic_fetch_add(p, v, __ATOMIC_RELAXED, __HIP_MEMORY_SCOPE_AGENT); }
__device__ __forceinline__ unsigned xb_xcc_id() { return (unsigned)__builtin_amdgcn_s_getreg((3 << 11) | 20) & 0xFu; }
#define XB_SPIN(cond, bar) do { unsigned _sp = 0; while (cond) { __builtin_amdgcn_s_sleep(1); \
    if ((++_sp & 255u) == 0u) { if (xb_ld(&(bar)[XB_TMO])) break; if (_sp > XB_SPIN_CAP) { atomicAdd(&(bar)[XB_TMO], 1u); break; } } } } while (0)

struct XcdBarrier {
    unsigned* bar; unsigned x;
    volatile LAS unsigned* st;
};

__device__ __forceinline__ XcdBarrier xcd_barrier_post(unsigned* bar, volatile LAS unsigned* st) {
    XcdBarrier b; b.bar = bar; b.x = xb_xcc_id(); b.st = st;
    if (threadIdx.x == 0) (void)xb_add(&bar[XB_XCNT(b.x)], 1u);
    return b;
}
__device__ __forceinline__ void xcd_barrier_complete(unsigned* bar, unsigned x, unsigned& nloc, unsigned& nx) {
    const unsigned G = gridDim.x * gridDim.y * gridDim.z;
    unsigned sum, cnt, mine, sp = 0u;
    for (;;) {
        sum = 0u; cnt = 0u; mine = 0u;
#pragma unroll
        for (unsigned j = 0; j < 16; ++j) { const unsigned c = xb_ld(&bar[XB_XCNT(j)]); sum += c; cnt += (c > 0u) ? 1u : 0u; mine = (j == x) ? c : mine; }
        if (sum == G) break;
        __builtin_amdgcn_s_sleep(1);
        if ((++sp & 255u) == 0u) { if (xb_ld(&bar[XB_TMO])) break; if (sp > XB_SPIN_CAP) { atomicAdd(&bar[XB_TMO], 1u); break; } }
    }
    nloc = mine > 0u ? mine : 1u; nx = cnt > 0u ? cnt : 1u;
}

__device__ __forceinline__ void xcd_barrier(const XcdBarrier& b) {
    asm volatile("s_waitcnt vmcnt(0)" ::: "memory");
    __syncthreads();
    if (threadIdx.x == 0) {
        unsigned* bar = b.bar;
        __builtin_amdgcn_s_waitcnt(0);
        unsigned nloc = b.st[0], nx = b.st[1];
        if (nloc == 0u) { xcd_barrier_complete(bar, b.x, nloc, nx); b.st[0] = nloc; b.st[1] = nx; }
        const unsigned old = xb_add(&bar[XB_XSUB(b.x)], 1u);
        const unsigned gen = old / nloc;
        if (old + 1u == (gen + 1u) * nloc) {
            __builtin_amdgcn_fence(__ATOMIC_RELEASE, "agent");
            asm volatile("s_waitcnt vmcnt(0)" ::: "memory");
            const unsigned og = xb_add(&bar[XB_TOP], 1u);
            const unsigned tg = og / nx;
            if (og + 1u == (tg + 1u) * nx) xb_add(&bar[XB_TOPGEN], 1u);
            else XB_SPIN(xb_ld(&bar[XB_TOPGEN]) == tg, bar);
            __builtin_amdgcn_fence(__ATOMIC_ACQUIRE, "agent");
            xb_add(&bar[XB_XGEN(b.x)], 1u);
            asm volatile("s_waitcnt vmcnt(0)" ::: "memory");
        } else {
            XB_SPIN(xb_ld(&bar[XB_XGEN(b.x)]) == gen, bar);
            __builtin_amdgcn_fence(__ATOMIC_ACQUIRE, "agent");
            asm volatile("s_waitcnt vmcnt(0)" ::: "memory");
        }
    }
    __syncthreads();
}
using pg8::Unit; using pg8::Gemm;
typedef f32x4 (&AccRef)[2][2][4][2];

__device__ __forceinline__ bool moe_unit(int i, int G, int c, int nT, int nN, int& pm, int& pn, int& half) {
    const int U = nT * nN, R = U / G, rem = U - R * G; half = 0;
    if (i < R) return pg8::tile_order(i, G, c, nT, nN, pm, pn);
    if (i > R || rem == 0) return false;
    if (2 * rem <= G) { if (c >= 2 * rem) return false; half = 1 + (c & 1); return pg8::tile_order(0, U, R * G + (c >> 1), nT, nN, pm, pn); }
    return pg8::tile_order(i, G, c, nT, nN, pm, pn);
}
struct DenseSched {
    int nM, nN, G, c; const char* A; const char* B; size_t tstepA, tstepB; bool split = false;
    __device__ __forceinline__ bool next(int i, Unit& u) const {
        int half = 0;
        if (split) { if (!moe_unit(i, G, c, nM, nN, u.pm, u.pn, half)) return false; }
        else if (!pg8::tile_order(i, G, c, nM, nN, u.pm, u.pn)) return false;
        u.A = A + (size_t)u.pm * tstepA; u.B = B + (size_t)u.pn * tstepB; u.tl = nullptr; u.x0 = u.x1 = 0; u.x2 = half; return true; }
};
struct MoeSched {
    int nT, nN, G, c; const LAS int* tile_e; const LAS int* tbase; const LAS unsigned short* tokl;
    const char* A; const char* B; size_t tstepA, estepB, tstepB;
    __device__ __forceinline__ bool next(int i, Unit& u) const {
        int half; if (!moe_unit(i, G, c, nT, nN, u.pm, u.pn, half)) return false;
        const int e = tile_e[u.pm];
        u.x0 = e; u.x1 = u.pm * 256; u.x2 = half;
        u.A = A + (size_t)u.pm * tstepA; u.B = B + (size_t)e * estepB + (size_t)u.pn * tstepB;
        u.tl = tokl ? tokl + (i < TOKL_ROUNDS ? i : TOKL_ROUNDS - 1) * 256 : nullptr; return true; }
};
struct MuSched {
    int G, c, mode; const char* A; const char* B;
    __device__ __forceinline__ bool next(int i, Unit& u) const {
        const int mu = i * G + c; if (mu >= 256) return false;
        const int b = mu >> 6, hh = (mu >> 4) & 3, ch = mu & 15; const size_t tok0 = (size_t)b * SEQ + (size_t)ch * 256;
        u.pm = mu; u.pn = 0; u.x0 = mu; u.x1 = u.x2 = 0; u.tl = nullptr;
        if (mode == 0) { u.A = A + (size_t)mu * 256 * 384 * 2; u.B = B + ((size_t)(hh * 128) * NTOK + tok0) * 2; }
        else if (mode == 1) { u.A = A + ((size_t)mu * 256 * 512 + 256) * 2; u.B = B + (tok0 * 1024 + (size_t)hh * 256) * 2; }
        else { u.A = A + (size_t)mu * 256 * 512 * 2; u.B = B + (size_t)mu * 256 * 384 * 2; }
        return true; }
};

constexpr float C2 = 0.125f * 1.4426950408889634f;

struct EpiQKV {
    static constexpr bool PERM = true;
    __device__ __forceinline__ void prep(const Unit&, int, int, int) const {}
    bf16_t* Q; bf16_t* K; bf16_t* V; const float* rope; float* ksum;
    __device__ __forceinline__ void operator()(AccRef acc, const Unit& u, int wr, int wc, int fr, int fq) const {
        asm volatile("" : "+v"(fr), "+v"(fq));
        const int part = u.pn >> 2, colt = (u.pn & 3) * 256;
        bf16_t* base = Q + (size_t)part * ((WS_K - WS_Q) / 2);
        const bool rot = (part < 2) && ((wc & 1) == 0);
        const float sgn = (fq == 0) ? -1.f : 1.f;
        float ks[2][8];
#pragma unroll
        for (int bj = 0; bj < 2; ++bj)
#pragma unroll
            for (int j = 0; j < 8; ++j) ks[bj][j] = 0.f;
#pragma unroll
        for (int ai = 0; ai < 2; ++ai)
#pragma unroll
            for (int m = 0; m < 4; ++m) {
                const int row = u.pm * 256 + ai * 128 + wr * 64 + m * 16 + fr;
                f32x4 cs0 = {1.f, 1.f, 1.f, 1.f}, cs1 = cs0, sn0 = {0.f, 0.f, 0.f, 0.f}, sn1 = sn0;
                if (rot) { const f32x4* rp = (const f32x4*)(rope + (size_t)row * 16); cs0 = rp[0]; cs1 = rp[1]; sn0 = rp[2]; sn1 = rp[3]; }
#pragma unroll
                for (int bj = 0; bj < 2; ++bj) {
                    f32x4 v0 = acc[ai][bj][m][0], v1 = acc[ai][bj][m][1];
                    if (rot) {
                        f32x4 p0, p1;
#pragma unroll
                        for (int j = 0; j < 4; ++j) { p0[j] = __shfl_xor(v0[j], 16); p1[j] = __shfl_xor(v1[j], 16); }
                        if (fq < 2) { v0 = v0 * cs0 + p0 * sn0 * sgn; v1 = v1 * cs1 + p1 * sn1 * sgn; }
                    }
                    if (part == 0) { v0 = v0 * C2; v1 = v1 * C2; }
                    if (part == 1) {
#pragma unroll
                        for (int j = 0; j < 4; ++j) { ks[bj][j] += v0[j]; ks[bj][4 + j] += v1[j]; } }
                    u32x4 w; w.x = cvt_pk_bf16(v0[0], v0[1]); w.y = cvt_pk_bf16(v0[2], v0[3]); w.z = cvt_pk_bf16(v1[0], v1[1]); w.w = cvt_pk_bf16(v1[2], v1[3]);
                    *(u32x4*)(base + (size_t)row * DM + colt + bj * 128 + wc * 32 + fq * 8) = w;
                }
            }
        if (part == 1) {
#pragma unroll
            for (int bj = 0; bj < 2; ++bj)
#pragma unroll
                for (int j = 0; j < 8; ++j) { float s = ks[bj][j]; s += __shfl_xor(s, 1); s += __shfl_xor(s, 2); s += __shfl_xor(s, 4); s += __shfl_xor(s, 8);
                    if (fr == 0) atomicAdd(ksum + (size_t)u.pm * DM + colt + bj * 128 + wc * 32 + fq * 8 + j, s); }
        }
    }
};

struct EpiZ {
    static constexpr bool PERM = false;
    __device__ __forceinline__ void prep(const Unit&, int, int, int) const {}
    const float* xin; float* z; float ymul;
    __device__ __forceinline__ void operator()(AccRef acc, const Unit& u, int wr, int wc, int fr, int fq) const {
        asm volatile("" : "+v"(fr), "+v"(fq));
#pragma unroll
        for (int ai = 0; ai < 2; ++ai) {
            const size_t off0 = (size_t)(u.pm * 256 + ai * 128 + wr * 64 + fr) * DM + u.pn * 256 + wc * 32 + fq * 4;
            f32x4 xr[4][2][2];
#pragma unroll
            for (int m = 0; m < 4; ++m)
#pragma unroll
                for (int bj = 0; bj < 2; ++bj)
#pragma unroll
                    for (int n = 0; n < 2; ++n) xr[m][bj][n] = *(const f32x4*)(xin + off0 + (size_t)m * 16 * DM + bj * 128 + n * 16);
#pragma unroll
            for (int m = 0; m < 4; ++m)
#pragma unroll
                for (int bj = 0; bj < 2; ++bj)
#pragma unroll
                    for (int n = 0; n < 2; ++n) *(f32x4*)(z + off0 + (size_t)m * 16 * DM + bj * 128 + n * 16) = xr[m][bj][n] * ALPHA + acc[ai][bj][m][n] * ymul;
            asm volatile("" ::: "memory");
        }
    }
};

__device__ __forceinline__ float swiglu1(float glu, float lin) {
    const float g = fminf(glu, 7.0f), l = fminf(fmaxf(lin, -7.0f), 7.0f);
    const float sg = __builtin_amdgcn_rcpf(1.0f + __builtin_amdgcn_exp2f(-1.702f * 1.4426950408889634f * g));
    return g * sg * (l + 1.0f);
}
struct EpiGU {
    static constexpr bool PERM = true;
    __device__ __forceinline__ void prep(const Unit& u, int ui, int wid, int lane) const { if (wid < 4) glds4s(uni_ptr((const char*)(bias + (size_t)u.x0 * 2048 + u.pn * 256 + wid * 64)), (unsigned)lane * 4u, (unsigned)__builtin_amdgcn_readfirstlane((unsigned)(unsigned long long)bl + (unsigned)(((ui & 1) * 256 + wid * 64) * 4))); }
    const float* bias; unsigned char* H; LAS float* bl; mutable int ucnt;
    __device__ __forceinline__ void operator()(AccRef acc, const Unit& u, int wr, int wc, int fr, int fq) const {
        asm volatile("" : "+v"(fr), "+v"(fq));
        const int c0 = u.pn * 256 + wc * 32 + fq * 8; const LAS float* bp = bl + (ucnt & 1) * 256 + wc * 32 + fq * 8; ++ucnt; constexpr float SC = 1.0f / (FP8_SA * FP8_SWGU);
        f32x4 b[2][2];
#pragma unroll
        for (int bj = 0; bj < 2; ++bj) { b[bj][0] = *(const LAS f32x4*)(bp + bj * 128); b[bj][1] = *(const LAS f32x4*)(bp + bj * 128 + 4); }
#pragma unroll
        for (int ai = 0; ai < 2; ++ai)
#pragma unroll
            for (int m = 0; m < 4; ++m) {
                unsigned char* rowp = H + (size_t)(u.x1 + ai * 128 + wr * 64 + m * 16 + fr) * DM + (c0 >> 1);
#pragma unroll
                for (int bj = 0; bj < 2; ++bj) { if (u.x2 == 2 - bj) continue;
                    const f32x4 v0 = acc[ai][bj][m][0] * SC + b[bj][0], v1 = acc[ai][bj][m][1] * SC + b[bj][1];
                    int w = __builtin_amdgcn_cvt_pk_fp8_f32(swiglu1(v0[0], v0[1]) * FP8_SA, swiglu1(v0[2], v0[3]) * FP8_SA, 0, false);
                    w = __builtin_amdgcn_cvt_pk_fp8_f32(swiglu1(v1[0], v1[1]) * FP8_SA, swiglu1(v1[2], v1[3]) * FP8_SA, w, true);
                    *(int*)(rowp + bj * 64) = w; }
            }
    }
};
struct EpiDN {
    static constexpr bool PERM = true;
    __device__ __forceinline__ void prep(const Unit& u, int ui, int wid, int lane) const { if (wid < 4) glds4s(uni_ptr((const char*)(bias + (size_t)u.x0 * 1024 + u.pn * 256 + wid * 64)), (unsigned)lane * 4u, (unsigned)__builtin_amdgcn_readfirstlane((unsigned)(unsigned long long)bl + (unsigned)(((ui & 1) * 256 + wid * 64) * 4))); }
    const float* bias; bf16_t* Y; LAS float* bl; mutable int ucnt;
    __device__ __forceinline__ void operator()(AccRef acc, const Unit& u, int wr, int wc, int fr, int fq) const {
        asm volatile("" : "+v"(fr), "+v"(fq));
        const int c0 = u.pn * 256 + wc * 32 + fq * 8; const LAS float* bp = bl + (ucnt & 1) * 256 + wc * 32 + fq * 8; ++ucnt; constexpr float SC = 1.0f / (FP8_SA * FP8_SWD);
        f32x4 b[2][2];
#pragma unroll
        for (int bj = 0; bj < 2; ++bj) { b[bj][0] = *(const LAS f32x4*)(bp + bj * 128); b[bj][1] = *(const LAS f32x4*)(bp + bj * 128 + 4); }
#pragma unroll
        for (int ai = 0; ai < 2; ++ai)
#pragma unroll
            for (int m = 0; m < 4; ++m) {
                bf16_t* rowp = Y + (size_t)(u.x1 + ai * 128 + wr * 64 + m * 16 + fr) * DM + c0;
#pragma unroll
                for (int bj = 0; bj < 2; ++bj) { if (u.x2 == 2 - bj) continue;
                    const f32x4 v0 = acc[ai][bj][m][0] * SC + b[bj][0], v1 = acc[ai][bj][m][1] * SC + b[bj][1];
                    u32x4 w; w.x = cvt_pk_bf16(v0[0], v0[1]); w.y = cvt_pk_bf16(v0[2], v0[3]); w.z = cvt_pk_bf16(v1[0], v1[1]); w.w = cvt_pk_bf16(v1[2], v1[3]);
                    *(u32x4*)(rowp + bj * 128) = w; }
            }
    }
};

struct EpiINA {
    static constexpr bool PERM = true;
    __device__ __forceinline__ void prep(const Unit&, int, int, int) const {}
    const float* rf; const float* cf; bf16_t* AE; bf16_t* KN; bf16_t* OS;
    __device__ __forceinline__ void operator()(AccRef acc, const Unit& u, int wr, int wc, int fr, int fq) const {
        asm volatile("" : "+v"(fr), "+v"(fq));
        const int b = u.pm >> 4, ch = u.pm & 15, d0 = wc * 32 + fq * 8; const u32x4 zero = {0u, 0u, 0u, 0u};
        if (u.pn < 4) {
            const bool isq = u.pn < 2; const float* fac = isq ? rf : cf; const float fs = isq ? 1.0f : RSQRT_DQK; const int h0 = (u.pn & 1) * 2;
            float sf[2][4][2];
#pragma unroll
            for (int ai = 0; ai < 2; ++ai)
#pragma unroll
                for (int m = 0; m < 4; ++m)
#pragma unroll
                    for (int bj = 0; bj < 2; ++bj) sf[ai][m][bj] = fac[(size_t)(h0 + bj) * NTOK + (size_t)u.pm * 256 + ai * 128 + wr * 64 + m * 16 + fr];
#pragma unroll
            for (int ai = 0; ai < 2; ++ai)
#pragma unroll
                for (int m = 0; m < 4; ++m) {
                    const int t = ai * 128 + wr * 64 + m * 16 + fr; const size_t token = (size_t)u.pm * 256 + t;
#pragma unroll
                    for (int bj = 0; bj < 2; ++bj) { const int hh = h0 + bj; const float s = sf[ai][m][bj] * fs;
                        const f32x4 v0 = acc[ai][bj][m][0] * s, v1 = acc[ai][bj][m][1] * s;
                        const size_t oq = ((size_t)(((b * 4 + hh) * 16 + ch) * 256 + t)) * 512 + 256 + d0, ok = token * 1024 + hh * 256 + d0;
                        bf16_t* dst = isq ? (AE + oq) : (KN + ok);
                        u32x4 w; w.x = cvt_pk_bf16(v0[0], v0[1]); w.y = cvt_pk_bf16(v0[2], v0[3]); w.z = cvt_pk_bf16(v1[0], v1[1]); w.w = cvt_pk_bf16(v1[2], v1[3]);
                        *(u32x4*)dst = w; *(u32x4*)(dst + 128) = zero; }
                }
        } else {
#pragma unroll
            for (int ai = 0; ai < 2; ++ai)
#pragma unroll
                for (int m = 0; m < 4; ++m) {
                    const int t = ai * 128 + wr * 64 + m * 16 + fr; const size_t token = (size_t)u.pm * 256 + t;
#pragma unroll
                    for (int bj = 0; bj < 2; ++bj) { f32x4 v0 = acc[ai][bj][m][0], v1 = acc[ai][bj][m][1];
#pragma unroll
                        for (int j = 0; j < 4; ++j) { v0[j] = __builtin_amdgcn_rcpf(1.0f + __builtin_amdgcn_exp2f(-1.4426950408889634f * v0[j])); v1[j] = __builtin_amdgcn_rcpf(1.0f + __builtin_amdgcn_exp2f(-1.4426950408889634f * v1[j])); }
                        u32x4 w; w.x = cvt_pk_bf16(v0[0], v0[1]); w.y = cvt_pk_bf16(v0[2], v0[3]); w.z = cvt_pk_bf16(v1[0], v1[1]); w.w = cvt_pk_bf16(v1[2], v1[3]);
                        *(u32x4*)(OS + token * 1024 + (u.pn - 4) * 256 + bj * 128 + d0) = w; }
                }
        }
    }
};
struct EpiINB {
    static constexpr bool PERM = true;
    __device__ __forceinline__ void prep(const Unit&, int, int, int) const {}
    const float* cf; bf16_t* KT; bf16_t* BE;
    __device__ __forceinline__ void operator()(AccRef acc, const Unit& u, int wr, int wc, int fr, int fq) const {
        asm volatile("" : "+v"(fr), "+v"(fq));
        const int b = u.pn >> 4, ch = u.pn & 15;
        f32x4 cv[2][2][2];
#pragma unroll
        for (int ai = 0; ai < 2; ++ai)
#pragma unroll
            for (int bj = 0; bj < 2; ++bj) { const size_t tok0 = (size_t)u.pn * 256 + bj * 128 + wc * 32 + fq * 8;
                if (u.pm < 2) { const int hh = u.pm * 2 + ai; cv[ai][bj][0] = *(const f32x4*)(cf + (size_t)hh * NTOK + tok0) * RSQRT_DQK; cv[ai][bj][1] = *(const f32x4*)(cf + (size_t)hh * NTOK + tok0 + 4) * RSQRT_DQK; }
                else { cv[ai][bj][0] = (f32x4){1.f, 1.f, 1.f, 1.f}; cv[ai][bj][1] = cv[ai][bj][0]; } }
#pragma unroll
        for (int ai = 0; ai < 2; ++ai)
#pragma unroll
            for (int m = 0; m < 4; ++m) {
                const int R = u.pm * 256 + ai * 128 + wr * 64 + m * 16 + fr;
#pragma unroll
                for (int bj = 0; bj < 2; ++bj) { if (u.x2 == 2 - bj) continue;
                    const f32x4 v0 = acc[ai][bj][m][0] * cv[ai][bj][0], v1 = acc[ai][bj][m][1] * cv[ai][bj][1]; const int s0 = bj * 128 + wc * 32 + fq * 8; const size_t tok0 = (size_t)u.pn * 256 + s0; bf16_t* dst;
                    if (u.pm < 2) dst = KT + (size_t)R * NTOK + tok0;
                    else { const int eg = R - 512, hh = eg >> 8, e = eg & 255; dst = BE + ((size_t)(((b * 4 + hh) * 16 + ch) * 256 + e)) * 384 + s0; }
                    u32x4 w; w.x = cvt_pk_bf16(v0[0], v0[1]); w.y = cvt_pk_bf16(v0[2], v0[3]); w.z = cvt_pk_bf16(v1[0], v1[1]); w.w = cvt_pk_bf16(v1[2], v1[3]);
                    *(u32x4*)dst = w;
                }
            }
    }
};
struct EpiM1 {
    static constexpr bool PERM = false;
    __device__ __forceinline__ void prep(const Unit&, int, int, int) const {}
    float* UT;
    __device__ __forceinline__ void operator()(AccRef acc, const Unit& u, int wr, int wc, int fr, int fq) const {
        asm volatile("" : "+v"(fr), "+v"(fq));
#pragma unroll
        for (int ai = 0; ai < 2; ++ai)
#pragma unroll
            for (int m = 0; m < 4; ++m) { float* rowp = UT + ((size_t)u.x0 * 256 + ai * 128 + wr * 64 + m * 16 + fr) * 128 + wc * 32 + fq * 4;
#pragma unroll
                for (int n = 0; n < 2; ++n) *(f32x4*)(rowp + n * 16) = acc[ai][0][m][n]; }
    }
};
struct EpiM2A {
    static constexpr bool PERM = true;
    __device__ __forceinline__ void prep(const Unit&, int, int, int) const {}
    bf16_t* AE; const float* nprev; float* den;
    __device__ __forceinline__ void operator()(AccRef acc, const Unit& u, int wr, int wc, int fr, int fq) const {
        asm volatile("" : "+v"(fr), "+v"(fq));
        const int mu = u.x0, dd = wc * 32 + fq * 8;
        const f32x4 n0 = *(const f32x4*)(nprev + (size_t)mu * 128 + dd), n1 = *(const f32x4*)(nprev + (size_t)mu * 128 + dd + 4);
        u32x4 qv8[2][4];
#pragma unroll
        for (int ai = 0; ai < 2; ++ai)
#pragma unroll
            for (int m = 0; m < 4; ++m) qv8[ai][m] = *(const u32x4*)(AE + ((size_t)mu * 256 + ai * 128 + wr * 64 + m * 16 + fr) * 512 + 256 + dd);
#pragma unroll
        for (int ai = 0; ai < 2; ++ai)
#pragma unroll
            for (int m = 0; m < 4; ++m) {
                const int t = ai * 128 + wr * 64 + m * 16 + fr; bf16_t* rowp = AE + ((size_t)mu * 256 + t) * 512;
                const u32x4 qv = qv8[ai][m];
                float part = bflo(qv.x) * n0[0] + bfhi(qv.x) * n0[1] + bflo(qv.y) * n0[2] + bfhi(qv.y) * n0[3] + bflo(qv.z) * n1[0] + bfhi(qv.z) * n1[1] + bflo(qv.w) * n1[2] + bfhi(qv.w) * n1[3];
#pragma unroll
                for (int bj = 0; bj < 2; ++bj) { const int s0 = bj * 128 + wc * 32 + fq * 8; f32x4 v0 = acc[ai][bj][m][0], v1 = acc[ai][bj][m][1];
                    int dts = t - s0; asm volatile("" : "+v"(dts));
#pragma unroll
                    for (int j = 0; j < 4; ++j) { v0[j] = (j <= dts) ? v0[j] : 0.f; v1[j] = (4 + j <= dts) ? v1[j] : 0.f; part += v0[j] + v1[j]; }
                    u32x4 w; w.x = cvt_pk_bf16(v0[0], v0[1]); w.y = cvt_pk_bf16(v0[2], v0[3]); w.z = cvt_pk_bf16(v1[0], v1[1]); w.w = cvt_pk_bf16(v1[2], v1[3]);
                    *(u32x4*)(rowp + s0) = w; }
                part += __shfl_xor(part, 16); part += __shfl_xor(part, 32);
                if (fq == 0) atomicAdd(den + (size_t)mu * 256 + (wr * 64 + fr) + (ai * 128 + m * 16), part);
            }
    }
};
struct EpiM2B {
    static constexpr bool PERM = true;
    __device__ __forceinline__ void prep(const Unit&, int, int, int) const {}
    const float* den; const float* normg; const bf16_t* OS; bf16_t* HN; LAS float* lnx;
    __device__ __forceinline__ void operator()(AccRef acc, const Unit& u, int wr, int wc, int fr, int fq) const {
        asm volatile("" : "+v"(fr), "+v"(fq));
        const int mu = u.x0, b = mu >> 6, hh = (mu >> 4) & 3, ch = mu & 15;
        float dnv[2][4];
#pragma unroll
        for (int ai = 0; ai < 2; ++ai)
#pragma unroll
            for (int m = 0; m < 4; ++m) dnv[ai][m] = den[(size_t)mu * 256 + ai * 128 + wr * 64 + m * 16 + fr];
#pragma unroll
        for (int ai = 0; ai < 2; ++ai)
#pragma unroll
            for (int m = 0; m < 4; ++m) {
                const int t = ai * 128 + wr * 64 + m * 16 + fr; const float dn = dnv[ai][m];
#ifdef DBG_DEN1
                const float inv = 1.0f;
#else
                const float inv = 1.0f / fmaxf(fabsf(dn), 1.0f);
#endif
                float s1 = 0.f, s2 = 0.f;
#pragma unroll
                for (int bj = 0; bj < 2; ++bj)
#pragma unroll
                    for (int n = 0; n < 2; ++n) { f32x4 h = acc[ai][bj][m][n] * inv; acc[ai][bj][m][n] = h; s1 += (h[0] + h[1]) + (h[2] + h[3]); s2 += (h[0] * h[0] + h[1] * h[1]) + (h[2] * h[2] + h[3] * h[3]); }
                s1 += __shfl_xor(s1, 16); s1 += __shfl_xor(s1, 32); s2 += __shfl_xor(s2, 16); s2 += __shfl_xor(s2, 32);
                if (fq == 0) { lnx[(t * 4 + wc) * 2] = s1; lnx[(t * 4 + wc) * 2 + 1] = s2; }
            }
        const int e0 = wc * 32 + fq * 8;
        f32x4 gg[2][2];
#pragma unroll
        for (int bj = 0; bj < 2; ++bj) { gg[bj][0] = *(const f32x4*)(normg + hh * 256 + bj * 128 + e0); gg[bj][1] = *(const f32x4*)(normg + hh * 256 + bj * 128 + e0 + 4); }
        asm volatile("s_waitcnt lgkmcnt(0)" ::: "memory"); __builtin_amdgcn_s_barrier(); asm volatile("" ::: "memory");
#pragma unroll
        for (int ai = 0; ai < 2; ++ai) {
            u32x4 ovv[4][2];
#pragma unroll
            for (int m = 0; m < 4; ++m)
#pragma unroll
                for (int bj = 0; bj < 2; ++bj) ovv[m][bj] = *(const u32x4*)(OS + (((size_t)(b * 16 + ch)) * 256 + ai * 128 + wr * 64 + m * 16 + fr) * 1024 + hh * 256 + bj * 128 + e0);
#pragma unroll
            for (int m = 0; m < 4; ++m) {
                const int t = ai * 128 + wr * 64 + m * 16 + fr; const size_t token = ((size_t)(b * 16 + ch)) * 256 + t;
                const LAS f32x4* lp = (const LAS f32x4*)(lnx + t * 8); const f32x4 a = lp[0], c = lp[1];
                const float mean = (a[0] + a[2] + c[0] + c[2]) * (1.0f / 256.0f); const float ex2 = (a[1] + a[3] + c[1] + c[3]) * (1.0f / 256.0f);
                const float rstd = 1.0f / sqrtf(fmaxf(ex2 - mean * mean, 0.f) + LN_EPS);
#pragma unroll
                for (int bj = 0; bj < 2; ++bj) { const int e = bj * 128 + e0; const size_t off = token * 1024 + hh * 256 + e; const u32x4 ov = ovv[m][bj];
#ifdef DBG_HN_OS
                    f32x4 v0 = {1.f, 1.f, 1.f, 1.f}, v1 = v0;
#elif defined(DBG_HN_RAW)
                    f32x4 v0 = acc[ai][bj][m][0], v1 = acc[ai][bj][m][1];
#else
                    f32x4 v0 = (acc[ai][bj][m][0] - mean) * rstd * gg[bj][0], v1 = (acc[ai][bj][m][1] - mean) * rstd * gg[bj][1];
#endif
#ifndef DBG_HN_ONE
                    v0[0] *= bflo(ov.x); v0[1] *= bfhi(ov.x); v0[2] *= bflo(ov.y); v0[3] *= bfhi(ov.y); v1[0] *= bflo(ov.z); v1[1] *= bfhi(ov.z); v1[2] *= bflo(ov.w); v1[3] *= bfhi(ov.w);
#endif
                    u32x4 w; w.x = cvt_pk_bf16(v0[0], v0[1]); w.y = cvt_pk_bf16(v0[2], v0[3]); w.z = cvt_pk_bf16(v1[0], v1[1]); w.w = cvt_pk_bf16(v1[2], v1[3]);
                    *(u32x4*)(HN + off) = w; }
            }
            asm volatile("" ::: "memory");
        }
        asm volatile("s_waitcnt lgkmcnt(0)" ::: "memory"); __builtin_amdgcn_s_barrier(); asm volatile("" ::: "memory");
    }
};
struct Frame {
    LAS unsigned char* lds;
    unsigned* ctl;
    unsigned char* ws;
    int tid, lane, wave, vcu, G;
};
__device__ __forceinline__ float wave_sum(float v) {
#pragma unroll
    for (int o = 1; o < 64; o <<= 1) v += __shfl_xor(v, o);
    return v;
}

__device__ __forceinline__ void tr_block(const float* src, size_t pitch, bf16_t* dst, size_t kd, int kb, int nb, LAS unsigned* scr, int lane) {
    const float* s0 = src + (size_t)(64 * kb) * pitch + 64 * nb + 4 * (lane & 15);
#pragma unroll
    for (int i = 0; i < 8; ++i) {
        const int kp = 4 * i + (lane >> 4);
        const f32x4 a = __builtin_nontemporal_load((const f32x4*)(s0 + (size_t)(2 * kp) * pitch)), b = __builtin_nontemporal_load((const f32x4*)(s0 + (size_t)(2 * kp + 1) * pitch));
#pragma unroll
        for (int j = 0; j < 4; ++j) scr[(4 * (lane & 15) + j) * 33 + kp] = cvt_pk_bf16(a[j], b[j]);
    }
    LDS_WAIT(); asm volatile("" ::: "memory");
    u32x4 o[8];
#pragma unroll
    for (int c = 0; c < 8; ++c) { const int rr = 8 * c + (lane >> 3), q4 = 4 * (lane & 7); o[c].x = scr[rr * 33 + q4]; o[c].y = scr[rr * 33 + q4 + 1]; o[c].z = scr[rr * 33 + q4 + 2]; o[c].w = scr[rr * 33 + q4 + 3]; }
    bf16_t* d = dst + (size_t)(64 * nb + (lane >> 3)) * kd + 64 * kb + 8 * (lane & 7);
#pragma unroll
    for (int c = 0; c < 8; ++c) *(u32x4*)(d + (size_t)(8 * c) * kd) = o[c];
    LDS_WAIT(); asm volatile("" ::: "memory");
}
__device__ __forceinline__ void tr_block8(const float* src, size_t pitch, unsigned char* dst, size_t kd, int kb, int nb, float scale, LAS unsigned* scr, int lane) {
    const float* s0 = src + (size_t)(128 * kb) * pitch + 64 * nb + 4 * (lane & 15);
#pragma unroll
    for (int i = 0; i < 8; ++i) {
        const int kq = 4 * i + (lane >> 4);
        const f32x4 r0 = __builtin_nontemporal_load((const f32x4*)(s0 + (size_t)(4 * kq) * pitch)) * scale, r1 = __builtin_nontemporal_load((const f32x4*)(s0 + (size_t)(4 * kq + 1) * pitch)) * scale,
                    r2 = __builtin_nontemporal_load((const f32x4*)(s0 + (size_t)(4 * kq + 2) * pitch)) * scale, r3 = __builtin_nontemporal_load((const f32x4*)(s0 + (size_t)(4 * kq + 3) * pitch)) * scale;
#pragma unroll
        for (int j = 0; j < 4; ++j) { int w = __builtin_amdgcn_cvt_pk_fp8_f32(r0[j], r1[j], 0, false); w = __builtin_amdgcn_cvt_pk_fp8_f32(r2[j], r3[j], w, true); scr[(4 * (lane & 15) + j) * 33 + kq] = (unsigned)w; }
    }
    LDS_WAIT(); asm volatile("" ::: "memory");
    u32x4 o[8];
#pragma unroll
    for (int c = 0; c < 8; ++c) { const int rr = 8 * c + (lane >> 3), q4 = 4 * (lane & 7); o[c].x = scr[rr * 33 + q4]; o[c].y = scr[rr * 33 + q4 + 1]; o[c].z = scr[rr * 33 + q4 + 2]; o[c].w = scr[rr * 33 + q4 + 3]; }
    unsigned char* d = dst + (size_t)(64 * nb + (lane >> 3)) * kd + 128 * kb + 16 * (lane & 7);
#pragma unroll
    for (int c = 0; c < 8; ++c) *(u32x4*)(d + (size_t)(8 * c) * kd) = o[c];
    LDS_WAIT(); asm volatile("" ::: "memory");
}
constexpr int CONV_ITEMS = 24576;
struct ConvItem { const float* s0; size_t pitch; unsigned char* d; float scale; };
__device__ __forceinline__ ConvItem conv_desc(const float* wgu, const float* wd, unsigned char* ws, int v, int lane) {
    const int layer = v >= 12288; int r = v - layer * 12288; ConvItem it;
    if (r < 8192) { const int mat = layer * 32 + (r >> 8); r &= 255; const int kb = r >> 5, nb = r & 31; it.pitch = 2048; it.scale = FP8_SWGU;
        it.s0 = wgu + (size_t)mat * 1024 * 2048 + (size_t)(128 * kb) * 2048 + 64 * nb + 4 * (lane & 15); it.d = ws + WS_WGU + (size_t)mat * 2048 * 1024 + (size_t)(64 * nb + (lane >> 3)) * 1024 + 128 * kb + 16 * (lane & 7); }
    else { r -= 8192; const int mat = layer * 32 + (r >> 7); r &= 127; const int kb = r >> 4, nb = r & 15; it.pitch = 1024; it.scale = FP8_SWD;
        it.s0 = wd + (size_t)mat * 1024 * 1024 + (size_t)(128 * kb) * 1024 + 64 * nb + 4 * (lane & 15); it.d = ws + WS_WD + (size_t)mat * 1024 * 1024 + (size_t)(64 * nb + (lane >> 3)) * 1024 + 128 * kb + 16 * (lane & 7); }
    return it;
}
__device__ __forceinline__ void conv_items(Frame& F, const float* wgu, const float* wd, int v_lo, int v_hi, int cw, int ncw) {
    LAS unsigned* scr = (LAS unsigned*)(F.lds + RING_OFF + F.wave * 8448); unsigned char* ws = F.ws; const int lane = F.lane;
    int v = v_lo + cw; if (v >= v_hi) return;
    ConvItem cur = conv_desc(wgu, wd, ws, v, lane);
    f32x4 r[8][4];
#pragma unroll
    for (int i = 0; i < 8; ++i) { const int kq = 4 * i + (lane >> 4);
#pragma unroll
        for (int q = 0; q < 4; ++q) r[i][q] = __builtin_nontemporal_load((const f32x4*)(cur.s0 + (size_t)(4 * kq + q) * cur.pitch)); }
    for (;;) {
        const int vn = v + ncw; const bool has = vn < v_hi; ConvItem nx = cur; if (has) nx = conv_desc(wgu, wd, ws, vn, lane);
#pragma unroll
        for (int i = 0; i < 8; ++i) { const int kq = 4 * i + (lane >> 4);
#pragma unroll
            for (int j = 0; j < 4; ++j) { int w = __builtin_amdgcn_cvt_pk_fp8_f32(r[i][0][j] * cur.scale, r[i][1][j] * cur.scale, 0, false); w = __builtin_amdgcn_cvt_pk_fp8_f32(r[i][2][j] * cur.scale, r[i][3][j] * cur.scale, w, true); scr[(4 * (lane & 15) + j) * 33 + kq] = (unsigned)w; }
            if (has) {
#pragma unroll
                for (int q = 0; q < 4; ++q) r[i][q] = __builtin_nontemporal_load((const f32x4*)(nx.s0 + (size_t)(4 * kq + q) * nx.pitch)); } }
        LDS_WAIT(); asm volatile("" ::: "memory");
        u32x4 o[8];
#pragma unroll
        for (int c = 0; c < 8; ++c) { const int rr = 8 * c + (lane >> 3), q4 = 4 * (lane & 7); o[c].x = scr[rr * 33 + q4]; o[c].y = scr[rr * 33 + q4 + 1]; o[c].z = scr[rr * 33 + q4 + 2]; o[c].w = scr[rr * 33 + q4 + 3]; }
#pragma unroll
        for (int c = 0; c < 8; ++c) *(u32x4*)(cur.d + (size_t)(8 * c) * 1024) = o[c];
        LDS_WAIT(); asm volatile("" ::: "memory");
        if (!has) break;
        v = vn; cur = nx;
    }
}
struct P0In { const float *x, *wqkv, *wo, *win, *wout, *rw, *wgu, *wd; const int* pos; };
__device__ __forceinline__ void p0_prologue(Frame& F, const P0In& I) {
    LAS unsigned* scr = (LAS unsigned*)(F.lds + RING_OFF + F.wave * 8448);
    const int gw = F.vcu * NWAVES + F.wave, NGW = F.G * NWAVES;
    unsigned char* ws = F.ws;
    constexpr int KB = 16;
    constexpr int I_QKV = KB * 48, I_WO = KB * 16, I_INA1 = KB * 16, I_INA2 = KB * 16, I_INB = KB * 24, I_WOUT = KB * 16;
    constexpr int I_SMALL = I_QKV + I_WO + I_INA1 + I_INA2 + I_INB + I_WOUT;
    constexpr int NITEMS = I_SMALL;
    for (int it = gw; it < NITEMS; it += NGW) {
        int r = it; const float* src; size_t pitch; bf16_t* dst; int nbl;
        if (r < I_QKV) { src = I.wqkv; pitch = 3072; dst = (bf16_t*)(ws + WS_WQKV); nbl = 48; }
        else if ((r -= I_QKV) < I_WO) { src = I.wo; pitch = 1024; dst = (bf16_t*)(ws + WS_WO); nbl = 16; }
        else if ((r -= I_WO) < I_INA1) { src = I.win; pitch = 3080; dst = (bf16_t*)(ws + WS_WINA); nbl = 16; }
        else if ((r -= I_INA1) < I_INA2) { src = I.win + 2048; pitch = 3080; dst = (bf16_t*)(ws + WS_WINA) + (size_t)1024 * 1024; nbl = 16; }
        else if ((r -= I_INA2) < I_INB) { src = I.win + 512; pitch = 3080; dst = (bf16_t*)(ws + WS_WINB); nbl = 24; }
        else { r -= I_INB; src = I.wout; pitch = 1024; dst = (bf16_t*)(ws + WS_WOUT); nbl = 16; }
        tr_block(src, pitch, dst, 1024, r / nbl, r % nbl, scr, F.lane);
    }
    if (NCONV == 0) conv_items(F, I.wgu, I.wd, 0, CONV_ITEMS, gw, NGW);
    const int gt = F.vcu * NTHR + F.tid, NGT = F.G * NTHR;
    for (int i = gt; i < NTOK * DM / 8; i += NGT) { const f32x4 a = ((const f32x4*)I.x)[2 * i], b = ((const f32x4*)I.x)[2 * i + 1];
        u32x4 w; w.x = cvt_pk_bf16(a[0], a[1]); w.y = cvt_pk_bf16(a[2], a[3]); w.z = cvt_pk_bf16(b[0], b[1]); w.w = cvt_pk_bf16(b[2], b[3]); ((u32x4*)(ws + WS_XB))[i] = w; }
    for (int i = gt; i < NTOK * 8; i += NGT) { const int tok = i >> 3, f = i & 7; const float inv = powf(500000.0f, -(float)f * 0.125f); const float ang = (float)I.pos[tok] * inv;
        float sn, cs; sincosf(ang, &sn, &cs); float* rp = (float*)(ws + WS_ROPE) + (size_t)tok * 16; rp[f] = cs; rp[8 + f] = sn; }
    for (int i = gt; i < 2 * 32 * 1024; i += NGT) { const int l = i >> 15, e = (i >> 10) & 31, k = i & 1023; ((float*)(ws + WS_RWT))[i] = I.rw[((size_t)l * 1024 + k) * 32 + e]; }
    for (int i = gt; i < 8 * 1024; i += NGT) { const int gidx = i >> 10, k = i & 1023; ((float*)(ws + WS_WG))[i] = I.win[(size_t)k * 3080 + 3072 + gidx]; }
}

__device__ __forceinline__ void phase_ln_router(Frame& F, const float* __restrict__ z, float* __restrict__ x1, const float* lng, const float* lnb, const float* rbias, int layer, int cset) {
    unsigned char* ws = F.ws;
    LAS f32x4* rwv = (LAS f32x4*)(F.lds + RING_OFF);
    LAS int* lcnt = (LAS int*)(F.lds + LX_LCNT); LAS int* gbase = (LAS int*)(F.lds + LX_GBASE); LAS int* rec = (LAS int*)(F.lds + LX_REC);
    LAS float* lgb = (LAS float*)(F.lds + LX_LNX);
    { const f32x4* src = (const f32x4*)((const float*)(ws + WS_RWT) + (size_t)layer * 32768);
      for (int i = F.tid; i < 8192; i += NTHR) { const int e = i >> 8, c = i & 255; rwv[e * 256 + (c ^ (e & 15))] = src[i]; } }
    int* toke = (int*)(ws + WS_TOKE); int* tokp = (int*)(ws + WS_TOKP); float* tokg = (float*)(ws + WS_TOKG);
    unsigned short* rowtok = (unsigned short*)(ws + WS_ROWTOK); unsigned char* xb8 = (unsigned char*)(ws + WS_XB);
    unsigned* cntg = F.ctl + CW_CNT + cset * 2048;
    const int lane = F.lane;
    for (int grp = F.vcu; grp < NTOK / 64; grp += F.G) {
        if (F.tid < 32) lcnt[F.tid] = 0;
        for (int i = F.tid; i < 1024; i += NTHR) { lgb[i] = lng[i]; lgb[1024 + i] = lnb[i]; }
        __syncthreads();
#pragma unroll 2
        for (int tk = 0; tk < 8; tk += 2) {
            const int token0 = grp * 64 + F.wave * 8 + tk;
            f32x4 v[2][4]; float s[2] = {0.f, 0.f};
#pragma unroll
            for (int u = 0; u < 2; ++u)
#pragma unroll
                for (int j = 0; j < 4; ++j) { v[u][j] = *(const f32x4*)(z + (size_t)(token0 + u) * DM + 4 * lane + 256 * j); s[u] += (v[u][j][0] + v[u][j][1]) + (v[u][j][2] + v[u][j][3]); }
#pragma unroll
            for (int o = 1; o < 64; o <<= 1) { const float a0 = __shfl_xor(s[0], o), a1 = __shfl_xor(s[1], o); s[0] += a0; s[1] += a1; }
            float s2[2] = {0.f, 0.f};
#pragma unroll
            for (int u = 0; u < 2; ++u) { const float mean = s[u] * (1.0f / DM);
#pragma unroll
                for (int j = 0; j < 4; ++j) { v[u][j] = v[u][j] - mean; s2[u] += (v[u][j][0] * v[u][j][0] + v[u][j][1] * v[u][j][1]) + (v[u][j][2] * v[u][j][2] + v[u][j][3] * v[u][j][3]); } }
#pragma unroll
            for (int o = 1; o < 64; o <<= 1) { const float a0 = __shfl_xor(s2[0], o), a1 = __shfl_xor(s2[1], o); s2[0] += a0; s2[1] += a1; }
#pragma unroll
            for (int u = 0; u < 2; ++u) { const float rstd = 1.0f / sqrtf(s2[u] * (1.0f / DM) + LN_EPS); const int token = token0 + u;
#pragma unroll
                for (int j = 0; j < 4; ++j) { const f32x4 gvj = *(const LAS f32x4*)(lgb + 4 * lane + 256 * j), bvj = *(const LAS f32x4*)(lgb + 1024 + 4 * lane + 256 * j);
                    const f32x4 y = v[u][j] * rstd * gvj + bvj; *(f32x4*)(x1 + (size_t)token * DM + 4 * lane + 256 * j) = y;
                    int w8 = __builtin_amdgcn_cvt_pk_fp8_f32(y[0] * FP8_SA, y[1] * FP8_SA, 0, false); w8 = __builtin_amdgcn_cvt_pk_fp8_f32(y[2] * FP8_SA, y[3] * FP8_SA, w8, true);
                    *(int*)(xb8 + (size_t)token * DM + 4 * lane + 256 * j) = w8; } }
        }
        VM_WAIT(); __syncthreads();
        const int tg = F.wave & 3, kh = F.wave >> 2, e0 = lane & 15, kq = lane >> 4;
        f32x4 acc0 = {0.f, 0.f, 0.f, 0.f}, acc1 = acc0;
        { const float* arow = x1 + (size_t)(grp * 64 + tg * 16 + e0) * DM + kh * 512 + 4 * kq;
#pragma unroll 4
          for (int blk = 0; blk < 32; ++blk) {
              const f32x4 a4 = *(const f32x4*)(arow + blk * 16); const int c = ((kh * 512 + blk * 16) >> 2) + kq;
              const f32x4 b0 = rwv[e0 * 256 + (c ^ e0)], b1 = rwv[(16 + e0) * 256 + (c ^ e0)];
#pragma unroll
              for (int j = 0; j < 4; ++j) { acc0 = __builtin_amdgcn_mfma_f32_16x16x4f32(a4[j], b0[j], acc0, 0, 0, 0); acc1 = __builtin_amdgcn_mfma_f32_16x16x4f32(a4[j], b1[j], acc1, 0, 0, 0); } } }
        __syncthreads();
        if (kh == 1) { ((LAS f32x4*)lgb)[(tg * 2 + 0) * 64 + lane] = acc0; ((LAS f32x4*)lgb)[(tg * 2 + 1) * 64 + lane] = acc1; }
        __syncthreads();
        if (kh == 0) {
            acc0 = acc0 + ((LAS f32x4*)lgb)[(tg * 2 + 0) * 64 + lane]; acc1 = acc1 + ((LAS f32x4*)lgb)[(tg * 2 + 1) * 64 + lane];
            const float rb0 = rbias[e0], rb1 = rbias[16 + e0];
#pragma unroll
            for (int r = 0; r < 4; ++r) {
                float l0 = acc0[r] + rb0, l1 = acc1[r] + rb1; float tv[4]; int te[4];
#pragma unroll
                for (int k = 0; k < 4; ++k) { float bvv = (l1 > l0) ? l1 : l0; int be = (l1 > l0) ? 16 + e0 : e0;
#pragma unroll
                    for (int o = 1; o < 16; o <<= 1) { const float ov = __shfl_xor(bvv, o); const int oe = __shfl_xor(be, o); const bool take = (ov > bvv) || (ov == bvv && oe < be); bvv = take ? ov : bvv; be = take ? oe : be; }
                    tv[k] = bvv; te[k] = be; if (be == e0) l0 = -INFINITY; if (be == 16 + e0) l1 = -INFINITY; }
                const float w0 = 1.0f, w1 = __expf(tv[1] - tv[0]), w2 = __expf(tv[2] - tv[0]), w3 = __expf(tv[3] - tv[0]); const float wi = 1.0f / (w0 + w1 + w2 + w3);
                if (e0 < 4) {
                    const int tl = tg * 16 + 4 * kq + r, token = grp * 64 + tl;
                    const int ek = (e0 == 0) ? te[0] : (e0 == 1) ? te[1] : (e0 == 2) ? te[2] : te[3];
                    const float wk = (e0 == 0) ? w0 : (e0 == 1) ? w1 : (e0 == 2) ? w2 : w3;
                    const int li = atomicAdd((int*)(lcnt + ek), 1); rec[tl * 8 + e0] = ek; rec[tl * 8 + 4 + e0] = li;
                    toke[token * 4 + e0] = ek; tokg[token * 4 + e0] = wk * wi;
                }
            }
        }
        __syncthreads();
        if (F.tid < 32) gbase[F.tid] = (int)__hip_atomic_fetch_add(cntg + F.tid * 64, (unsigned)lcnt[F.tid], RLX_AGENT);
        __syncthreads();
        if (F.tid < 256) { const int tl = F.tid >> 2, k = F.tid & 3; const int token = grp * 64 + tl; const int e = rec[tl * 8 + k]; const int pos = gbase[e] + rec[tl * 8 + 4 + k];
            tokp[token * 4 + k] = pos; rowtok[(size_t)e * NTOK + pos] = (unsigned short)token; }
        __syncthreads();
    }
}

__device__ __forceinline__ int moe_tables(Frame& F, int layer) {
    LAS int* tile_e = (LAS int*)(F.lds + LX_TILEE); LAS int* tbase = (LAS int*)(F.lds + LX_TBASE);
    if (F.tid < 64) {
        const int e = F.lane & 31; const int c = (int)__hip_atomic_load(F.ctl + CW_CNT + layer * 2048 + e * 64, RLX_AGENT); const int nt = (F.lane < 32) ? ((c + 255) >> 8) : 0;
        int inc = nt;
#pragma unroll
        for (int o = 1; o < 32; o <<= 1) { const int up = __shfl_up(inc, o); if (F.lane >= o) inc += up; }
        const int t0 = inc - nt;
        if (F.lane < 32) { tbase[e] = t0; for (int i = 0; i < nt; ++i) tile_e[t0 + i] = e; }
        if (F.lane == 31) tbase[32] = inc;
    }
    __syncthreads();
    return tbase[32];
}

template <bool NEXT_MLSTM>
__device__ __forceinline__ void phase_combine(Frame& F, const float* __restrict__ x1, float* __restrict__ out, const float* lng, const float* lnb, const float* bgates, int layer) {
    unsigned char* ws = F.ws;
    (void)moe_tables(F, layer);
    const LAS int* tbase = (const LAS int*)(F.lds + LX_TBASE);
    const int* toke = (const int*)(ws + WS_TOKE); const int* tokp = (const int*)(ws + WS_TOKP); const float* tokg = (const float*)(ws + WS_TOKG);
    const bf16_t* Y = (const bf16_t*)(ws + WS_Y); bf16_t* xb = (bf16_t*)(ws + WS_XB);
    LAS float* wg = (LAS float*)(F.lds + RING_OFF);
    if constexpr (NEXT_MLSTM) { const f32x4* src = (const f32x4*)(ws + WS_WG); for (int i = F.tid; i < 2048; i += NTHR) ((LAS f32x4*)wg)[i] = src[i]; __syncthreads(); }
    const int lane = F.lane; const int gw = F.vcu * NWAVES + F.wave, NGW = F.G * NWAVES;
    f32x4 gv[4], bv[4];
#pragma unroll
    for (int j = 0; j < 4; ++j) { gv[j] = *(const f32x4*)(lng + 4 * lane + 256 * j); bv[j] = *(const f32x4*)(lnb + 4 * lane + 256 * j); }
    constexpr int NTK = NEXT_MLSTM ? 1 : 2;
    for (int token0 = gw; token0 < NTOK; token0 += NTK * NGW) {
        f32x4 vv[NTK][4];
#pragma unroll
        for (int u = 0; u < NTK; ++u) { const int token = token0 + u * NGW; if (token < NTOK) {
#pragma unroll
            for (int j = 0; j < 4; ++j) vv[u][j] = *(const f32x4*)(x1 + (size_t)token * DM + 4 * lane + 256 * j) * ALPHA;
#pragma unroll
            for (int k = 0; k < 4; ++k) { const int e = toke[token * 4 + k]; const size_t row = (size_t)tbase[e] * 256 + tokp[token * 4 + k]; const float gt = tokg[token * 4 + k] * DBG_MOE_MUL;
#pragma unroll
                for (int j = 0; j < 4; ++j) { const u32x2 y = *(const u32x2*)(Y + row * DM + 4 * lane + 256 * j); vv[u][j][0] += gt * bflo(y.x); vv[u][j][1] += gt * bfhi(y.x); vv[u][j][2] += gt * bflo(y.y); vv[u][j][3] += gt * bfhi(y.y); } } } }
#pragma unroll
        for (int u = 0; u < NTK; ++u) { const int token = token0 + u * NGW; if (token < NTOK) {
        f32x4 v[4];
#pragma unroll
        for (int j = 0; j < 4; ++j) v[j] = vv[u][j];
        float s = 0.f;
#pragma unroll
        for (int j = 0; j < 4; ++j) s += (v[j][0] + v[j][1]) + (v[j][2] + v[j][3]);
        const float mean = wave_sum(s) * (1.0f / DM); float s2 = 0.f;
#pragma unroll
        for (int j = 0; j < 4; ++j) { v[j] = v[j] - mean; s2 += (v[j][0] * v[j][0] + v[j][1] * v[j][1]) + (v[j][2] * v[j][2] + v[j][3] * v[j][3]); }
        const float rstd = 1.0f / sqrtf(wave_sum(s2) * (1.0f / DM) + LN_EPS);
#pragma unroll
        for (int j = 0; j < 4; ++j) { v[j] = v[j] * rstd * gv[j] + bv[j]; *(f32x4*)(out + (size_t)token * DM + 4 * lane + 256 * j) = v[j]; }
        if constexpr (NEXT_MLSTM) {
#pragma unroll
            for (int j = 0; j < 4; ++j) { u32x2 w; w.x = cvt_pk_bf16(v[j][0], v[j][1]); w.y = cvt_pk_bf16(v[j][2], v[j][3]); *(u32x2*)(xb + (size_t)token * DM + 4 * lane + 256 * j) = w; }
            float gp[8];
#pragma unroll
            for (int gi = 0; gi < 8; ++gi) { float a = 0.f;
#pragma unroll
                for (int j = 0; j < 4; ++j) { const f32x4 w = *(const LAS f32x4*)(wg + gi * 1024 + 4 * lane + 256 * j); a += (v[j][0] * w[0] + v[j][1] * w[1]) + (v[j][2] * w[2] + v[j][3] * w[3]); }
                gp[gi] = a; }
#pragma unroll
            for (int o = 1; o < 64; o <<= 1) {
#pragma unroll
                for (int gi = 0; gi < 8; ++gi) gp[gi] += __shfl_xor(gp[gi], o); }
#pragma unroll
            for (int gi = 0; gi < 8; ++gi) gp[gi] += bgates[gi];
            if (lane == 0) {
#pragma unroll
                for (int hh = 0; hh < 4; ++hh) { ((float*)(ws + WS_GI))[(size_t)hh * NTOK + token] = gp[hh];
                    const float f = gp[4 + hh]; const float lf = (f >= 0.f) ? -log1pf(__expf(-f)) : (f - log1pf(__expf(f)));
                    ((float*)(ws + WS_LF))[(size_t)hh * NTOK + token] = lf; } }
        }
        } }
    }
}

__device__ __forceinline__ void phase_gate_scan(Frame& F) {
    unsigned char* ws = F.ws; const int lane = F.lane; const int gw = F.vcu * NWAVES + F.wave, NGW = F.G * NWAVES;
    for (int mu = gw; mu < 256; mu += NGW) {
        const int b = mu >> 6, hh = (mu >> 4) & 3, ch = mu & 15; const size_t base = (size_t)hh * NTOK + (size_t)b * SEQ + ch * 256 + 4 * lane;
        const f32x4 lf = *(const f32x4*)((const float*)(ws + WS_LF) + base), gi = *(const f32x4*)((const float*)(ws + WS_GI) + base);
        f32x4 c; c[0] = lf[0]; c[1] = c[0] + lf[1]; c[2] = c[1] + lf[2]; c[3] = c[2] + lf[3];
        float tot = c[3];
#pragma unroll
        for (int o = 1; o < 64; o <<= 1) { const float up = __shfl_up(tot, o); if (lane >= o) tot += up; }
        const float excl = tot - c[3];
        f32x4 rf, cf;
#pragma unroll
        for (int j = 0; j < 4; ++j) { const float bt = excl + c[j]; rf[j] = __expf(bt); cf[j] = __expf(gi[j] - bt); }
        *(f32x4*)((float*)(ws + WS_RF) + base) = rf; *(f32x4*)((float*)(ws + WS_CF) + base) = cf;
        if (lane == 63) ((float*)(ws + WS_DEC))[mu] = __expf(tot);
    }
}
__device__ __forceinline__ void phase_nu(Frame& F) {
    unsigned char* ws = F.ws; const int lane = F.lane; const int gw = F.vcu * NWAVES + F.wave, NGW = F.G * NWAVES;
    const bf16_t* KT = (const bf16_t*)(ws + WS_KT); float* NU = (float*)(ws + WS_NU);
    for (int r0 = gw * 16; r0 < 256 * 128; r0 += NGW * 16) {
        const int mu = r0 >> 7, d0 = r0 & 127, b = mu >> 6, hh = (mu >> 4) & 3, ch = mu & 15;
        const bf16_t* base = KT + (size_t)(hh * 128 + d0) * NTOK + (size_t)b * SEQ + ch * 256 + 4 * lane;
        u32x2 kv[16];
#pragma unroll
        for (int i = 0; i < 16; ++i) kv[i] = *(const u32x2*)(base + (size_t)i * NTOK);
        float s[16];
#pragma unroll
        for (int i = 0; i < 16; ++i) s[i] = (bflo(kv[i].x) + bfhi(kv[i].x)) + (bflo(kv[i].y) + bfhi(kv[i].y));
#pragma unroll
        for (int o = 1; o < 64; o <<= 1) {
#pragma unroll
            for (int i = 0; i < 16; ++i) s[i] += __shfl_xor(s[i], o); }
        float mine = s[0];
#pragma unroll
        for (int i = 1; i < 16; ++i) mine = (lane == i) ? s[i] : mine;
        if (lane < 16) NU[r0 + lane] = mine;
    }
}
__device__ __forceinline__ void phase_state_scan(Frame& F) {
    unsigned char* ws = F.ws; const int gt = F.vcu * NTHR + F.tid, NGT = F.G * NTHR;
    const float* UT = (const float*)(ws + WS_UT); const float* DEC = (const float*)(ws + WS_DEC); bf16_t* BE = (bf16_t*)(ws + WS_BE);
    for (int i = gt; i < 16 * 256 * 32; i += NGT) { const int bh = i >> 13, e = (i >> 5) & 255, dg = i & 31;
        f32x4 U[16]; float dc[16];
#pragma unroll
        for (int ch = 0; ch < 16; ++ch) { const size_t mu = (size_t)bh * 16 + ch; U[ch] = *(const f32x4*)(UT + (mu * 256 + e) * 128 + 4 * dg); dc[ch] = DEC[mu]; }
        f32x4 C = {0.f, 0.f, 0.f, 0.f};
#pragma unroll
        for (int ch = 0; ch < 16; ++ch) { const size_t mu = (size_t)bh * 16 + ch;
            u32x2 w; w.x = cvt_pk_bf16(C[0], C[1]); w.y = cvt_pk_bf16(C[2], C[3]);
#ifdef DBG_NO_INTER
            w.x = 0u; w.y = 0u;
#endif
            *(u32x2*)(BE + (mu * 256 + e) * 384 + 256 + 4 * dg) = w;
            C = (C + U[ch]) * dc[ch]; } }
    const float* NU = (const float*)(ws + WS_NU); float* NP = (float*)(ws + WS_NPREV);
    for (int i = gt; i < 16 * 128; i += NGT) { const int bh = i >> 7, d = i & 127; float n = 0.f;
        for (int ch = 0; ch < 16; ++ch) { const int mu = bh * 16 + ch; NP[mu * 128 + d] = n; n = (n + NU[mu * 128 + d]) * DEC[mu];
#ifdef DBG_NO_INTER
            n = 0.f;
#endif
        } }
}
struct Args { const float* in[18]; float* out; unsigned char* ws; int ph_lo, ph_hi; };
__global__ void __launch_bounds__(NTHR, 2) mk_fwd(Args args) {
    extern __shared__ __attribute__((aligned(16))) unsigned char lds[];
    Frame F;
    const char __attribute__((address_space(4)))* kargp = (const char __attribute__((address_space(4)))*)__builtin_amdgcn_kernarg_segment_ptr();
#define AIN(i) ({ const char __attribute__((address_space(4)))* k_ = kargp; asm volatile("" : "+s"(k_)); *(const float* const __attribute__((address_space(4)))*)(k_ + 8 * (i)); })
    unsigned char* const ws0 = (unsigned char*)AIN(19);
    F.lds = (LAS unsigned char*)lds; F.ws = ws0; F.ctl = (unsigned*)(ws0 + WS_CTL);
    F.tid = threadIdx.x; F.lane = F.tid & 63; F.wave = __builtin_amdgcn_readfirstlane(F.tid >> 6);
    F.G = gridDim.x; { const int bx = blockIdx.x; F.vcu = (F.G % 8 == 0) ? (bx % 8) * (F.G / 8) + bx / 8 : bx; }
    for (int u = F.tid; u < (LDS_BYTES - LX) / 4; u += NTHR) ((LAS unsigned*)(F.lds + LX))[u] = 0u;
    __syncthreads();
    int lo, hi; { const char __attribute__((address_space(4)))* k_ = kargp; lo = *(const int __attribute__((address_space(4)))*)(k_ + 160); hi = *(const int __attribute__((address_space(4)))*)(k_ + 164); }
    XcdBarrier bar; bar.bar = (unsigned*)(F.ctl + CW_BAR); bar.x = 0; bar.st = nullptr;
    if (hi - lo > 1) bar = xcd_barrier_post((unsigned*)(F.ctl + CW_BAR), (volatile LAS unsigned*)(F.lds + LX_MISC) + 8);
#ifndef PHASE_MASK
#define PHASE_MASK 0x7FFFF
#endif
#define IN(k) ((((PHASE_MASK) >> (k)) & 1) && lo <= (k) && (k) < hi)
#ifndef REPEAT_MASK
#define REPEAT_MASK 0
#endif
#define PH(k) if (IN(k))
#define SEAM(k) do { if (IN(k) && IN((k) + 1)) xcd_barrier(bar); } while (0)
    unsigned char* ws = ws0;
#define x_in AIN(0)
#define ln_mix_g AIN(8)
#define ln_mix_b AIN(9)
#define ln_ffn_g AIN(10)
#define ln_ffn_b AIN(11)
#define router_b AIN(13)
#define b_gu AIN(15)
#define b_dn AIN(17)
    bf16_t* XB = (bf16_t*)(ws + WS_XB); bf16_t* QB_ = (bf16_t*)(ws + WS_Q); bf16_t* KB_ = (bf16_t*)(ws + WS_K); bf16_t* VB_ = (bf16_t*)(ws + WS_V);
    float* R0 = (float*)(ws + WS_R0); float* R1 = (float*)(ws + WS_R1); float* R2 = (float*)(ws + WS_R2);
    bf16_t* HB = (bf16_t*)(ws + WS_H); bf16_t* YB = (bf16_t*)(ws + WS_Y);
    LAS unsigned char* ring = F.lds + RING_OFF;
    const int cG = (int)blockIdx.x;
    const bool isConv = (NCONV > 0) && ((int)blockIdx.x >= F.G - NCONV);
    const int Gc = F.G - NCONV, cwv = ((int)blockIdx.x - Gc) * NWAVES + F.wave, ncw = NCONV * NWAVES;
#define CONV_SLICE(a, b) conv_items(F, AIN(14), AIN(16), (int)((long)CONV_ITEMS * (a) / 1000), (int)((long)CONV_ITEMS * (b) / 1000), cwv, ncw)

    PH(0) { P0In I{x_in, AIN(2), AIN(3), AIN(4), AIN(7), AIN(12), AIN(14), AIN(16), (const int*)AIN(1)}; p0_prologue(F, I); }
    SEAM(0);
    PH(1) { { Gemm g{1024, 1024, 1024, nullptr}; DenseSched S{64, 12, F.G, cG, (const char*)XB, (const char*)(ws + WS_WQKV), (size_t)256 * 1024 * 2, (size_t)256 * 1024 * 2};
        EpiQKV E{QB_, KB_, VB_, (const float*)(ws + WS_ROPE), (float*)(ws + WS_KSUM)};
        pg8::gemm_phase<EpiQKV, DenseSched, true, false>(ring, g, S, E); } }
    SEAM(1);
    PH(2) { if (isConv) CONV_SLICE(0, 1000); else {
        const attn_body::AttnTensors AT{(const attn_body::bf16*)QB_, (const attn_body::bf16*)KB_, (const attn_body::bf16*)VB_, (attn_body::bf16*)QB_, (const float*)(ws + WS_KSUM)};
        if (NCONV == 0) { const attn_body::StaticOrder S((int)F.G, (int)blockIdx.x); attn_body::attn_phase<attn_body::StaticOrder>((char*)lds + RING_OFF, AT, S); }
        else { const attn_body::SnakeOrder S{cG, Gc}; attn_body::attn_phase<attn_body::SnakeOrder>((char*)lds + RING_OFF, AT, S); } } }
    SEAM(2);
    PH(3) { { Gemm g{1024, 1024, 1024, nullptr}; DenseSched S{64, 4, F.G, cG, (const char*)QB_, (const char*)(ws + WS_WO), (size_t)256 * 1024 * 2, (size_t)256 * 1024 * 2};
        EpiZ E{x_in, R0, DBG_ATTN_MUL}; pg8::gemm_phase<EpiZ, DenseSched, true, false>(ring, g, S, E); } }
    SEAM(3);
    PH(4) phase_ln_router(F, R0, R1, ln_mix_g, ln_mix_b, router_b, 0, 0);
    SEAM(4);
    PH(5) { const int nT = moe_tables(F, 0); LAS unsigned short* tokl = (LAS unsigned short*)(F.lds + LX_TOKL);
        { const unsigned short* rowtok = (const unsigned short*)(ws + WS_ROWTOK); const LAS int* tile_e = (const LAS int*)(F.lds + LX_TILEE); const LAS int* tbase = (const LAS int*)(F.lds + LX_TBASE);
          for (int i = 0; i < TOKL_ROUNDS; ++i) { int pm, pn, hf; if (!moe_unit(i, F.G, cG, nT, 8, pm, pn, hf)) break;
              if (F.tid < 256) { const int e = tile_e[pm]; const int r = (pm - tbase[e]) * 256 + F.tid; const int c = (int)__hip_atomic_load(F.ctl + CW_CNT + 0 * 2048 + e * 64, RLX_AGENT);
                  tokl[i * 256 + F.tid] = (r < c) ? rowtok[(size_t)e * NTOK + r] : (unsigned short)0; } }
          __syncthreads(); }
        Gemm g{512, 512, 512, (const char*)XB};
        MoeSched S{nT, 8, F.G, cG, (const LAS int*)(F.lds + LX_TILEE), (const LAS int*)(F.lds + LX_TBASE), tokl, nullptr, (const char*)(ws + WS_WGU) + (size_t)0 * 32 * 2048 * 1024, 0, (size_t)2048 * 1024, (size_t)256 * 1024};
        EpiGU E{b_gu + (size_t)0 * 32 * 2048, (unsigned char*)HB, (LAS float*)(F.lds + LX_BIAS), 0}; pg8::gemm_phase<EpiGU, MoeSched, true, true, true, true>(ring, g, S, E); }
    SEAM(5);
    PH(6) { const int nT = moe_tables(F, 0); Gemm g{512, 512, 512, nullptr};
        MoeSched S{nT, 4, F.G, cG, (const LAS int*)(F.lds + LX_TILEE), (const LAS int*)(F.lds + LX_TBASE), nullptr, (const char*)HB, (const char*)(ws + WS_WD) + (size_t)0 * 32 * 1024 * 1024, (size_t)256 * 1024, (size_t)1024 * 1024, (size_t)256 * 1024};
        EpiDN E{b_dn + (size_t)0 * 32 * 1024, YB, (LAS float*)(F.lds + LX_BIAS), 0}; pg8::gemm_phase<EpiDN, MoeSched, true, false, true, true>(ring, g, S, E); }
    SEAM(6);
    PH(7) phase_combine<true>(F, R1, R2, ln_ffn_g, ln_ffn_b, AIN(5), 0);
    SEAM(7);
    PH(8) phase_gate_scan(F);
    SEAM(8);
    PH(9) {
        { Gemm g{1024, 1024, 1024, nullptr}; DenseSched S{64, 8, F.G, cG, (const char*)XB, (const char*)(ws + WS_WINA), (size_t)256 * 1024 * 2, (size_t)256 * 1024 * 2};
          EpiINA E{(const float*)(ws + WS_RF), (const float*)(ws + WS_CF), (bf16_t*)(ws + WS_AE), (bf16_t*)(ws + WS_KN), (bf16_t*)(ws + WS_OS)};
          pg8::gemm_phase<EpiINA, DenseSched, true, false>(ring, g, S, E); }
        { Gemm g{1024, 1024, 1024, nullptr}; DenseSched S{6, 64, F.G, cG, (const char*)(ws + WS_WINB), (const char*)XB, (size_t)256 * 1024 * 2, (size_t)256 * 1024 * 2, true};
          EpiINB E{(const float*)(ws + WS_CF), (bf16_t*)(ws + WS_KT), (bf16_t*)(ws + WS_BE)};
          pg8::gemm_phase<EpiINB, DenseSched, true, false, false, true>(ring, g, S, E); }
    }
    SEAM(9);
    PH(10) { Gemm g{256, 384, NTOK, nullptr}; MuSched S{F.G, cG, 0, (const char*)(ws + WS_BE), (const char*)(ws + WS_KT)};
        EpiM1 E{(float*)(ws + WS_UT)}; pg8::gemm_phase<EpiM1, MuSched, true, false>(ring, g, S, E);
        phase_nu(F); }
    SEAM(10);
    PH(11) phase_state_scan(F);
    SEAM(11);
    PH(12) { Gemm g{256, 512, 1024, nullptr}; MuSched S{F.G, cG, 1, (const char*)(ws + WS_AE), (const char*)(ws + WS_KN)};
        EpiM2A E{(bf16_t*)(ws + WS_AE), (const float*)(ws + WS_NPREV), (float*)(ws + WS_DEN)}; pg8::gemm_phase<EpiM2A, MuSched, true, false>(ring, g, S, E); }
    SEAM(12);
    PH(13) { Gemm g{384, 512, 384, nullptr}; MuSched S{F.G, cG, 2, (const char*)(ws + WS_AE), (const char*)(ws + WS_BE)};
        EpiM2B E{(const float*)(ws + WS_DEN), AIN(6), (const bf16_t*)(ws + WS_OS), (bf16_t*)(ws + WS_HN), (LAS float*)(F.lds + LX_LNX)};
        pg8::gemm_phase<EpiM2B, MuSched, true, false>(ring, g, S, E); }
    SEAM(13);
    PH(14) { Gemm g{1024, 1024, 1024, nullptr}; DenseSched S{64, 4, F.G, cG, (const char*)(ws + DBG_P14_A), (const char*)(ws + WS_WOUT), (size_t)256 * 1024 * 2, (size_t)256 * 1024 * 2};
        EpiZ E{R2, R0, DBG_MLSTM_MUL}; pg8::gemm_phase<EpiZ, DenseSched, true, false>(ring, g, S, E); }
    SEAM(14);
    PH(15) phase_ln_router(F, R0, R1, ln_mix_g + 1024, ln_mix_b + 1024, router_b + 32, 1, 1);
    SEAM(15);
    PH(16) { const int nT = moe_tables(F, 1); LAS unsigned short* tokl = (LAS unsigned short*)(F.lds + LX_TOKL);
        { const unsigned short* rowtok = (const unsigned short*)(ws + WS_ROWTOK); const LAS int* tile_e = (const LAS int*)(F.lds + LX_TILEE); const LAS int* tbase = (const LAS int*)(F.lds + LX_TBASE);
          for (int i = 0; i < TOKL_ROUNDS; ++i) { int pm, pn, hf; if (!moe_unit(i, F.G, cG, nT, 8, pm, pn, hf)) break;
              if (F.tid < 256) { const int e = tile_e[pm]; const int r = (pm - tbase[e]) * 256 + F.tid; const int c = (int)__hip_atomic_load(F.ctl + CW_CNT + 1 * 2048 + e * 64, RLX_AGENT);
                  tokl[i * 256 + F.tid] = (r < c) ? rowtok[(size_t)e * NTOK + r] : (unsigned short)0; } }
          __syncthreads(); }
        Gemm g{512, 512, 512, (const char*)XB};
        MoeSched S{nT, 8, F.G, cG, (const LAS int*)(F.lds + LX_TILEE), (const LAS int*)(F.lds + LX_TBASE), tokl, nullptr, (const char*)(ws + WS_WGU) + (size_t)1 * 32 * 2048 * 1024, 0, (size_t)2048 * 1024, (size_t)256 * 1024};
        EpiGU E{b_gu + (size_t)1 * 32 * 2048, (unsigned char*)HB, (LAS float*)(F.lds + LX_BIAS), 0}; pg8::gemm_phase<EpiGU, MoeSched, true, true, true, true>(ring, g, S, E); }
    SEAM(16);
    PH(17) { const int nT = moe_tables(F, 1); Gemm g{512, 512, 512, nullptr};
        MoeSched S{nT, 4, F.G, cG, (const LAS int*)(F.lds + LX_TILEE), (const LAS int*)(F.lds + LX_TBASE), nullptr, (const char*)HB, (const char*)(ws + WS_WD) + (size_t)1 * 32 * 1024 * 1024, (size_t)256 * 1024, (size_t)1024 * 1024, (size_t)256 * 1024};
        EpiDN E{b_dn + (size_t)1 * 32 * 1024, YB, (LAS float*)(F.lds + LX_BIAS), 0}; pg8::gemm_phase<EpiDN, MoeSched, true, false, true, true>(ring, g, S, E); }
    SEAM(17);
    PH(18) phase_combine<false>(F, R1, (float*)AIN(18), ln_ffn_g + 1024, ln_ffn_b + 1024, nullptr, 1);
#undef IN
#undef CONV_SLICE
#undef AIN
#undef x_in
#undef ln_mix_g
#undef ln_mix_b
#undef ln_ffn_g
#undef ln_ffn_b
#undef router_b
#undef b_gu
#undef b_dn
#undef SEAM
}

extern "C" void kernel_launch(void* const* d_in, const int* in_sizes, int n_in, void* d_out, int out_size, void* d_ws, size_t ws_size, hipStream_t stream) {
    static int grid = 0;
    if (grid == 0) {
        if (n_in != 18 || out_size != NTOK * DM || ws_size < WS_END) { fprintf(stderr, "kernel_launch: unexpected problem shape (n_in %d, out %d, ws %zu)\n", n_in, out_size, ws_size); grid = -1; return; }
        int dev = 0, cus = 0, per_cu = 0;
        if (hipGetDevice(&dev) != hipSuccess || hipDeviceGetAttribute(&cus, hipDeviceAttributeMultiprocessorCount, dev) != hipSuccess) { grid = -1; return; }
        if (hipFuncSetAttribute((const void*)mk_fwd, hipFuncAttributeMaxDynamicSharedMemorySize, LDS_BYTES) != hipSuccess) { fprintf(stderr, "kernel_launch: hipFuncSetAttribute failed\n"); grid = -1; return; }
        if (hipOccupancyMaxActiveBlocksPerMultiprocessor(&per_cu, (const void*)mk_fwd, NTHR, LDS_BYTES) != hipSuccess || per_cu < 1) fprintf(stderr, "kernel_launch: occupancy query reports %d\n", per_cu);
        (void)hipGetLastError();
        grid = cus;
        if (grid > 256) grid = 256;
        if (grid < 240) { fprintf(stderr, "kernel_launch: %d CUs: this build needs 240..256\n", cus); grid = -1; return; }
    }
    if (grid < 0) return;
    if (hipMemsetAsync((char*)d_ws + WS_CTL, 0, CTL_ZERO_BYTES, stream) != hipSuccess) return;
    Args a{};
    for (int i = 0; i < 18; ++i) a.in[i] = (const float*)d_in[i];
    a.out = (float*)d_out; a.ws = (unsigned char*)d_ws;
#if MK_ONE_LAUNCH
    a.ph_lo = 0; a.ph_hi = NPHASE;
    hipLaunchKernelGGL(mk_fwd, dim3(grid), dim3(NTHR), LDS_BYTES, stream, a);
#else
    for (int p = 0; p < NPHASE; ++p) { a.ph_lo = p; a.ph_hi = p + 1; hipLaunchKernelGGL(mk_fwd, dim3(grid), dim3(NTHR), LDS_BYTES, stream, a); }
#endif
}
```

```cpp
#include <hip/hip_runtime.h>
#include <hip/hip_bf16.h>
#include <cstdio>
#include <cstdint>
#include <cmath>

#define LAS __attribute__((address_space(3)))
#define GAS __attribute__((address_space(1)))
typedef unsigned short bf16_t;
typedef short bf16x8 __attribute__((ext_vector_type(8)));
typedef float f32x4 __attribute__((ext_vector_type(4)));
typedef float f32x2 __attribute__((ext_vector_type(2)));
typedef unsigned u32x4 __attribute__((ext_vector_type(4)));
typedef unsigned u32x2 __attribute__((ext_vector_type(2)));
typedef int i32x4 __attribute__((ext_vector_type(4)));
typedef int i32x8 __attribute__((ext_vector_type(8)));

typedef __bf16 bf16x2_t __attribute__((ext_vector_type(2)));
__device__ __forceinline__ unsigned cvt_pk_bf16(float lo, float hi) { const f32x2 v = {lo, hi}; const bf16x2_t b = __builtin_convertvector(v, bf16x2_t); return __builtin_bit_cast(unsigned, b); }
__device__ __forceinline__ float bf2f(unsigned short b) { return __uint_as_float(((unsigned)b) << 16); }
__device__ __forceinline__ float bflo(unsigned w) { return __uint_as_float(w << 16); }
__device__ __forceinline__ float bfhi(unsigned w) { return __uint_as_float(w & 0xffff0000u); }

__device__ __forceinline__ void glds16s(const void* sbase, unsigned voff, unsigned lds_dst) { unsigned keep;
    asm volatile("s_nop 4\n\ts_mov_b32 %0, m0\n\ts_mov_b32 m0, %3\n\ts_nop 0\n\tglobal_load_lds_dwordx4 %1, %2\n\ts_mov_b32 m0, %0" : "=&s"(keep) : "v"(voff), "s"(sbase), "s"(lds_dst) : "memory"); }
__device__ __forceinline__ void glds4s(const void* sbase, unsigned voff, unsigned lds_dst) { unsigned keep;
    asm volatile("s_nop 4\n\ts_mov_b32 %0, m0\n\ts_mov_b32 m0, %3\n\ts_nop 0\n\tglobal_load_lds_dword %1, %2\n\ts_mov_b32 m0, %0" : "=&s"(keep) : "v"(voff), "s"(sbase), "s"(lds_dst) : "memory"); }
__device__ __forceinline__ const char* uni_ptr(const char* p) { const unsigned long long v = (unsigned long long)p; const unsigned lo = __builtin_amdgcn_readfirstlane((unsigned)v), hi = __builtin_amdgcn_readfirstlane((unsigned)(v >> 32)); return (const char*)(((unsigned long long)hi << 32) | lo); }
namespace pg8 {
constexpr int BM = 256, BK = 64, HALF = 128, HTB = HALF * BK * 2, STAGE_BYTES = 8 * HTB, NXCD = 8, WGM = 8;
__host__ __device__ __forceinline__ int lds_byte(int r, int c) { const int st = (r >> 4) * 2 + (c >> 5), rr = r & 15, cc = c & 31, ob = rr * 64 + cc * 2; return st * 1024 + (ob ^ (((ob >> 9) & 1) << 5)); }
__host__ __device__ __forceinline__ void stage_rc(int b, int& R, int& C) { const int st = b / 1024, sb = b % 1024, swz = sb ^ (((sb >> 9) & 1) << 5); R = (st >> 1) * 16 + swz / 64; C = (st & 1) * 32 + (swz % 64) / 2; }
__host__ __device__ __forceinline__ int perm32(int rho) { const int n = rho >> 4, i = rho & 15; return 8 * (i >> 2) + 4 * n + (i & 3); }

struct Unit { int pm, pn; const char* A; const char* B; const LAS unsigned short* tl; int x0, x1, x2; };
struct Gemm { int K, lda, ldb; const char* Abase; };

__device__ __forceinline__ bool tile_order(int i, int G, int c, int nM, int nN, int& pm, int& pn) {
    const int nwg = nM * nN; const long L = (long)i * G + c; if (L >= nwg) return false;
    int wgid = (int)L; { const int q = nwg / NXCD, r = nwg % NXCD, xcd = wgid % NXCD, off = wgid / NXCD; wgid = (xcd < r ? xcd * (q + 1) : r * (q + 1) + (xcd - r) * q) + off; }
    const int nig = WGM * nN, gid = wgid / nig, fm = gid * WGM, gsz = (nM - fm) < WGM ? (nM - fm) : WGM;
    pm = fm + ((wgid % nig) % gsz); pn = (wgid % nig) / gsz; return true;
}

template <class Epi, class Sched, bool ALIGN_EPI, bool GATHER, bool FP8 = false, bool HALFSEL = false>
__device__ __forceinline__ void gemm_phase(LAS unsigned char* lds, const Gemm g, const Sched& S, const Epi& E) {
    const int tid = threadIdx.x, wid = __builtin_amdgcn_readfirstlane(tid >> 6), lane = tid & 63, wr = wid >> 2, wc = wid & 3, fr = lane & 15, fq = lane >> 4;
    const int K = g.K, nt = K / BK;
    int RA[2]; unsigned cA2[2], voffB[2];
#pragma unroll
    for (int i = 0; i < 2; ++i) { int R, C; stage_rc(tid * 16 + i * 8192, R, C); const int Rb = Epi::PERM ? ((R & ~31) + perm32(R & 31)) : R;
        RA[i] = R; cA2[i] = (unsigned)C * 2u; voffB[i] = (unsigned)(Rb * g.ldb + C) * 2u; }
    const size_t kstep = (size_t)(BK * 2);
    const unsigned hstepA = (unsigned)HALF * (unsigned)g.lda * 2u; const size_t hstepB = (size_t)HALF * g.ldb * 2;
    const unsigned ldsb = (unsigned)__builtin_amdgcn_readfirstlane((unsigned)(unsigned long long)lds + (unsigned)wid * 1024u);
    const int aoff = lds_byte(wr * 64 + fr, fq * 8), boff = lds_byte(wc * 32 + fr, fq * 8);
    const int aoff2 = aoff + 1024, boff2 = boff + 1024;
#define PG8_SA(b, h) (((b) * 2 + (h)) * HTB)
#define PG8_SB(b, h) ((4 + (b) * 2 + (h)) * HTB)
#define PG8_STAGE(bufoff, gbase, voff) do { _Pragma("unroll") for (int _i = 0; _i < 2; ++_i) glds16s((gbase), (voff)[_i], ldsb + (unsigned)(bufoff) + _i * 8192u); } while (0)
#define PG8_STAGE_A(bufoff, gbase, AO, h) do { _Pragma("unroll") for (int _i = 0; _i < 2; ++_i) glds16s((gbase), (AO)[h][_i], ldsb + (unsigned)(bufoff) + _i * 8192u); } while (0)
#define PG8_LD8(base_, o1_, o2_) __builtin_shufflevector(*(const LAS i32x4*)(lds + (base_) + (o1_)), *(const LAS i32x4*)(lds + (base_) + (o2_)), 0, 1, 2, 3, 4, 5, 6, 7)
#define PG8_LDA(dst, b, h) do { if constexpr (FP8) { _Pragma("unroll") for (int m = 0; m < 4; ++m) dst##8[m] = PG8_LD8(PG8_SA(b, h) + m * 2048, aoff, aoff2); } \
        else { _Pragma("unroll") for (int m = 0; m < 4; ++m) _Pragma("unroll") for (int k = 0; k < 2; ++k) dst[m][k] = *(const LAS bf16x8*)(lds + PG8_SA(b, h) + aoff + m * 2048 + k * 1024); } } while (0)
#define PG8_LDB(dst, b, h) do { if constexpr (FP8) { _Pragma("unroll") for (int n = 0; n < 2; ++n) dst##8[n] = PG8_LD8(PG8_SB(b, h) + n * 2048, boff, boff2); } \
        else { _Pragma("unroll") for (int n = 0; n < 2; ++n) _Pragma("unroll") for (int k = 0; k < 2; ++k) dst[n][k] = *(const LAS bf16x8*)(lds + PG8_SB(b, h) + boff + n * 2048 + k * 1024); } } while (0)
#define PG8_MMA(ai, bj, At, Bt) do { __builtin_amdgcn_s_setprio(1); _Pragma("unroll") for (int m = 0; m < 4; ++m) _Pragma("unroll") for (int n = 0; n < 2; ++n) { \
        if constexpr (FP8) asm volatile("v_mfma_f32_16x16x128_f8f6f4 %0, %1, %2, %0" : "+v"(acc[ai][bj][m][n]) : "v"(Bt##8[n]), "v"(At##8[m])); \
        else { _Pragma("unroll") for (int k = 0; k < 2; ++k) acc[ai][bj][m][n] = __builtin_amdgcn_mfma_f32_16x16x32_bf16(Bt[n][k], At[m][k], acc[ai][bj][m][n], 0, 0, 0); } } \
        __builtin_amdgcn_s_setprio(0); } while (0)
#define PG8_WAIT_V(n) asm volatile("s_waitcnt vmcnt(" #n ")" ::: "memory")
#define PG8_WAIT_L(n) asm volatile("s_waitcnt lgkmcnt(" #n ")" ::: "memory")
#define PG8_BAR __builtin_amdgcn_s_barrier()
#define PG8_SCHED __builtin_amdgcn_sched_barrier(0)
#define PG8_AOFF(AO, U) do { _Pragma("unroll") for (int _h = 0; _h < 2; ++_h) _Pragma("unroll") for (int _i = 0; _i < 2; ++_i) { \
        if constexpr (GATHER) AO[_h][_i] = (unsigned)(U).tl[RA[_i] + _h * HALF] * (unsigned)(g.lda * 2) + cA2[_i]; \
        else AO[_h][_i] = (unsigned)RA[_i] * (unsigned)(g.lda * 2) + cA2[_i] + (unsigned)_h * hstepA; } } while (0)
    Unit cur, nxt; int ui = 0;
    if (!S.next(0, cur)) return;
    f32x4 acc[2][2][4][2];
#pragma unroll
    for (int a = 0; a < 2; ++a)
#pragma unroll
        for (int b = 0; b < 2; ++b)
#pragma unroll
            for (int m = 0; m < 4; ++m)
#pragma unroll
                for (int n = 0; n < 2; ++n) acc[a][b][m][n] = (f32x4){0.f, 0.f, 0.f, 0.f};
    bf16x8 At[4][2], B0[2][2], B1[2][2]; i32x8 At8[4], B08[2], B18[2];
    E.prep(cur, 0, wid, lane);
    unsigned aoC[2][2], aoN[2][2];
    PG8_AOFF(aoC, cur);
    const char* cA = uni_ptr(GATHER ? g.Abase : cur.A); const char* cB = uni_ptr(cur.B);
    PG8_STAGE(PG8_SB(0, 0), cB, voffB); PG8_STAGE(PG8_SB(0, 1), cB + hstepB, voffB); PG8_STAGE_A(PG8_SA(0, 0), cA, aoC, 0); PG8_STAGE_A(PG8_SA(0, 1), cA, aoC, 1);
    if (wr == 1) PG8_BAR;
    PG8_WAIT_V(2); PG8_BAR;
    PG8_STAGE(PG8_SB(1, 0), cB + kstep, voffB); PG8_STAGE_A(PG8_SA(1, 0), cA + kstep, aoC, 0); PG8_STAGE(PG8_SB(1, 1), cB + hstepB + kstep, voffB);
    PG8_WAIT_V(6); PG8_BAR;
    for (;;) {
        const bool has_next = S.next(ui + 1, nxt);
        if (has_next) E.prep(nxt, ui + 1, wid, lane);
        if constexpr (GATHER) { if (has_next) PG8_AOFF(aoN, nxt); else { _Pragma("unroll") for (int _h = 0; _h < 2; ++_h) _Pragma("unroll") for (int _i = 0; _i < 2; ++_i) aoN[_h][_i] = aoC[_h][_i]; } }
        const char* nA = uni_ptr(GATHER ? g.Abase : (has_next ? nxt.A : cA)); const char* nB = uni_ptr(has_next ? nxt.B : cB);
        const bool dh0 = cur.x2 != 2, dh1 = cur.x2 != 1;
#pragma nounroll
        for (int t = 0; t < nt; t += 2) {
            const bool last = (t == nt - 2);
            const char* a1 = cA + (size_t)(t + 1) * kstep;
            const char* a2 = last ? nA : cA + (size_t)(t + 2) * kstep; const char* b2 = last ? nB : cB + (size_t)(t + 2) * kstep;
            const char* a3 = a2 + kstep; const char* b3 = b2 + kstep;
            unsigned aoS[2][2];
#pragma unroll
            for (int _h = 0; _h < 2; ++_h)
#pragma unroll
                for (int _i = 0; _i < 2; ++_i) aoS[_h][_i] = (GATHER && last) ? aoN[_h][_i] : aoC[_h][_i];
            PG8_LDB(B0, 0, 0); PG8_LDB(B1, 0, 1); PG8_SCHED; PG8_LDA(At, 0, 0); PG8_STAGE_A(PG8_SA(1, 1), a1, aoC, 1);
            PG8_WAIT_V(8); PG8_WAIT_L(0); PG8_BAR; if (!HALFSEL || dh0) PG8_MMA(0, 0, At, B0); if (!HALFSEL || dh1) PG8_MMA(0, 1, At, B1); PG8_BAR; PG8_SCHED;
            PG8_LDA(At, 0, 1); PG8_STAGE(PG8_SB(0, 0), b2, voffB); PG8_STAGE(PG8_SB(0, 1), b2 + hstepB, voffB); PG8_STAGE_A(PG8_SA(0, 0), a2, aoS, 0);
            PG8_WAIT_V(8); PG8_WAIT_L(0); PG8_BAR; if (!HALFSEL || dh0) PG8_MMA(1, 0, At, B0); if (!HALFSEL || dh1) PG8_MMA(1, 1, At, B1); PG8_BAR; PG8_SCHED;
            PG8_LDB(B0, 1, 0); PG8_LDB(B1, 1, 1); PG8_SCHED; PG8_LDA(At, 1, 0); PG8_STAGE_A(PG8_SA(0, 1), a2, aoS, 1);
            PG8_WAIT_V(8); PG8_WAIT_L(0); PG8_BAR; if (!HALFSEL || dh0) PG8_MMA(0, 0, At, B0); if (!HALFSEL || dh1) PG8_MMA(0, 1, At, B1); PG8_BAR; PG8_SCHED;
            PG8_LDA(At, 1, 1); PG8_STAGE(PG8_SB(1, 0), b3, voffB); PG8_STAGE(PG8_SB(1, 1), b3 + hstepB, voffB); PG8_STAGE_A(PG8_SA(1, 0), a3, aoS, 0);
            PG8_WAIT_V(8); PG8_WAIT_L(0); PG8_BAR; if (!HALFSEL || dh0) PG8_MMA(1, 0, At, B0); if (!HALFSEL || dh1) PG8_MMA(1, 1, At, B1); PG8_BAR; PG8_SCHED;
        }
        if constexpr (FP8) asm volatile("s_nop 15\n\ts_nop 15" ::: "memory");
        if constexpr (ALIGN_EPI) { if (wr == 0) PG8_BAR; }
        E(acc, cur, wr, wc, fr, fq);
        if (!has_next) break;
#pragma unroll
        for (int a = 0; a < 2; ++a)
#pragma unroll
            for (int b = 0; b < 2; ++b)
#pragma unroll
                for (int m = 0; m < 4; ++m)
#pragma unroll
                    for (int n = 0; n < 2; ++n) acc[a][b][m][n] = (f32x4){0.f, 0.f, 0.f, 0.f};
        if constexpr (FP8) asm volatile("s_nop 7" ::: "memory");
        cur = nxt; cA = nA; cB = nB; ++ui;
        if constexpr (GATHER) {
#pragma unroll
            for (int _h = 0; _h < 2; ++_h)
#pragma unroll
                for (int _i = 0; _i < 2; ++_i) aoC[_h][_i] = aoN[_h][_i]; }
        if constexpr (ALIGN_EPI) { if (wr == 1) PG8_BAR; }
    }
    PG8_WAIT_V(0);
    if constexpr (!ALIGN_EPI) { if (wr == 0) PG8_BAR; }
    PG8_BAR;
#undef PG8_SA
#undef PG8_SB
#undef PG8_STAGE
#undef PG8_STAGE_A
#undef PG8_LDA
#undef PG8_LD8
#undef PG8_LDB
#undef PG8_MMA
#undef PG8_WAIT_V
#undef PG8_WAIT_L
#undef PG8_BAR
#undef PG8_SCHED
#undef PG8_AOFF
}
}
#include <hip/hip_bf16.h>
namespace attn_body {
using bf16=__hip_bfloat16;
using bf16x8=__attribute__((ext_vector_type(8)))short;
using s16x4=__attribute__((ext_vector_type(4)))short;
using f32x16=__attribute__((ext_vector_type(16)))float;
using u32x4=__attribute__((ext_vector_type(4)))unsigned;
constexpr int BATCH=4,NHEAD=16,SEQ=4096,D=64,DM=NHEAD*D;
constexpr int NW=8,QBLK=32,QB=QBLK*NW,KVBLK=64,NQB=SEQ/QB;
constexpr int ATTN_PITCH=DM, ATTN_UNIT_ROWS=QB;
__device__ __forceinline__ int crow(int r,int hi){return (r&3)+8*(r>>2)+4*hi;}
#define SBAR() __builtin_amdgcn_sched_barrier(0)
__device__ __forceinline__ void cmask(f32x16&p0,f32x16&p1,int jb,int qrel,int hi){
  const float NEG=-INFINITY; int d=qrel-64*jb-4*hi; asm volatile("":"+v"(d));
  #pragma unroll
  for(int r=0;r<16;++r){const int c=(r&3)+8*(r>>2); if(c>d)p0[r]=NEG; if(c+32>d)p1[r]=NEG;}
}

constexpr int NSLOT=3, SLOTB=8192;
constexpr int LDS_GT=98304;
constexpr int LDS_K=0, LDS_V=NSLOT*SLOTB, LDS_WS=2*NSLOT*SLOTB, LDS_OST=LDS_WS+NW*64*4, LDS_BYTES=LDS_OST+NW*4096;
constexpr float C2=0.125f*1.4426950408889634f;
__device__ __forceinline__ void glds16(const void*gsrc,unsigned lds_dst){unsigned keep;
  asm volatile("s_mov_b32 %0, m0\n\ts_mov_b32 m0, %2\n\ts_nop 0\n\tglobal_load_lds_dwordx4 %1, off\n\ts_mov_b32 m0, %0":"=&s"(keep):"v"(gsrc),"s"(lds_dst):"memory");}
__device__ __forceinline__ void glds16s(const void*sbase,unsigned voff,unsigned lds_dst){unsigned keep;
  asm volatile("s_nop 4\n\ts_mov_b32 %0, m0\n\ts_mov_b32 m0, %3\n\ts_nop 0\n\tglobal_load_lds_dwordx4 %1, %2\n\ts_mov_b32 m0, %0":"=&s"(keep):"v"(voff),"s"(sbase),"s"(lds_dst):"memory");}
__device__ __forceinline__ unsigned lane_now(){unsigned l;asm volatile("v_mbcnt_lo_u32_b32 %0, -1, 0\n\tv_mbcnt_hi_u32_b32 %0, -1, %0":"=v"(l));return l;}
__device__ __forceinline__ float max3f(float a,float b,float c){float r;asm("v_max3_f32 %0, %1, %2, %3":"=v"(r):"v"(a),"v"(b),"v"(c));return r;}
__device__ __forceinline__ float max2f(float a,float b){float r;asm("v_max_f32_e32 %0, %1, %2":"=v"(r):"v"(a),"v"(b));return r;}
__device__ __forceinline__ float fadd_s(float a,float b){float r;asm("v_add_f32_e32 %0, %1, %2":"=v"(r):"v"(a),"v"(b));return r;}
__device__ __forceinline__ float fsub_s(float a,float b){float r;asm("v_sub_f32_e32 %0, %1, %2":"=v"(r):"v"(a),"v"(b));return r;}
typedef float f32x2_t __attribute__((ext_vector_type(2))); typedef __bf16 bf16x2_t __attribute__((ext_vector_type(2)));
__device__ __forceinline__ unsigned cvtpk_s(float lo,float hi){f32x2_t v={lo,hi};bf16x2_t b=__builtin_convertvector(v,bf16x2_t);return __builtin_bit_cast(unsigned,b);}
#define WAIT_BAR(N) asm volatile("s_waitcnt vmcnt(" #N ") lgkmcnt(0)\n\ts_barrier":::"memory")

__device__ __forceinline__ void qkt(f32x16&p0,f32x16&p1,const char*Kslot,const bf16x8*qr,int r32,int hi){
  const char*kb=Kslot+hi*1024+r32*16;
  #pragma unroll
  for(int d0=0;d0<4;++d0){
    const bf16x8 b0=*reinterpret_cast<const bf16x8*>(kb+d0*2048);
    const bf16x8 b1=*reinterpret_cast<const bf16x8*>(kb+d0*2048+512);
    if(d0==0){p0=__builtin_amdgcn_mfma_f32_32x32x16_bf16(b0,qr[0],(f32x16){0.f,0.f,0.f,0.f,0.f,0.f,0.f,0.f,0.f,0.f,0.f,0.f,0.f,0.f,0.f,0.f},0,0,0);p1=__builtin_amdgcn_mfma_f32_32x32x16_bf16(b1,qr[0],(f32x16){0.f,0.f,0.f,0.f,0.f,0.f,0.f,0.f,0.f,0.f,0.f,0.f,0.f,0.f,0.f,0.f},0,0,0);}
    else{p0=__builtin_amdgcn_mfma_f32_32x32x16_bf16(b0,qr[d0],p0,0,0,0);p1=__builtin_amdgcn_mfma_f32_32x32x16_bf16(b1,qr[d0],p1,0,0,0);}}
}
typedef __attribute__((address_space(3))) const char* lds_cptr;
typedef short v4i16_t __attribute__((ext_vector_type(4)));
__device__ __forceinline__ void kload8(bf16x8*kf,lds_cptr kp){
  kf[0]=*(const __attribute__((address_space(3))) bf16x8*)(kp);      kf[1]=*(const __attribute__((address_space(3))) bf16x8*)(kp+512);
  kf[2]=*(const __attribute__((address_space(3))) bf16x8*)(kp+2048); kf[3]=*(const __attribute__((address_space(3))) bf16x8*)(kp+2560);
  kf[4]=*(const __attribute__((address_space(3))) bf16x8*)(kp+4096); kf[5]=*(const __attribute__((address_space(3))) bf16x8*)(kp+4608);
  kf[6]=*(const __attribute__((address_space(3))) bf16x8*)(kp+6144); kf[7]=*(const __attribute__((address_space(3))) bf16x8*)(kp+6656);
}
__device__ __forceinline__ void kload2(bf16x8*kf,lds_cptr kp,int j){ kf[2*j]=*(const __attribute__((address_space(3))) bf16x8*)(kp+j*2048); kf[2*j+1]=*(const __attribute__((address_space(3))) bf16x8*)(kp+j*2048+512); }
__device__ __forceinline__ s16x4 vtr(lds_cptr p){ return __builtin_bit_cast(s16x4,__builtin_amdgcn_ds_read_tr16_b64_v4i16((__attribute__((address_space(3))) v4i16_t*)p)); }
__device__ __forceinline__ float rowmax(const f32x16&p0,const f32x16&p1){
  float a=max3f(p0[0],p0[1],p1[0]),b=max3f(p0[2],p0[3],p1[1]);a=max3f(a,p1[2],p1[3]);
  #pragma unroll
  for(int r=4;r<16;r+=4){a=max3f(a,p0[r],p0[r+1]);b=max3f(b,p0[r+2],p0[r+3]);a=max3f(a,p1[r],p1[r+1]);b=max3f(b,p1[r+2],p1[r+3]);}
  const float m=max2f(a,b);
  auto rr=__builtin_amdgcn_permlane32_swap(__float_as_uint(m),__float_as_uint(m),false,false);
  return max2f(__uint_as_float(rr[0]),__uint_as_float(rr[1]));
}
__device__ __forceinline__ void pv(f32x16*o,int vb,bf16x8 pa0,bf16x8 pa1,bf16x8 pa2,bf16x8 pa3){
  #pragma unroll
  for(int d0=0;d0<2;++d0){s16x4 lo[4],hi[4];
    #pragma unroll
    for(int ks=0;ks<4;++ks){
      asm volatile("ds_read_b64_tr_b16 %0,%1 offset:%c2":"=&v"(lo[ks]):"v"(vb),"i"(d0*4096+ks*1024):"memory");
      asm volatile("ds_read_b64_tr_b16 %0,%1 offset:%c2":"=&v"(hi[ks]):"v"(vb),"i"(d0*4096+ks*1024+512):"memory");}
    asm volatile("s_waitcnt lgkmcnt(0)":::"memory");SBAR();
    #define PK(k) (bf16x8){lo[k][0],lo[k][1],lo[k][2],lo[k][3],hi[k][0],hi[k][1],hi[k][2],hi[k][3]}
    o[d0]=__builtin_amdgcn_mfma_f32_32x32x16_bf16(pa0,PK(0),o[d0],0,0,0);
    o[d0]=__builtin_amdgcn_mfma_f32_32x32x16_bf16(pa1,PK(1),o[d0],0,0,0);
    o[d0]=__builtin_amdgcn_mfma_f32_32x32x16_bf16(pa2,PK(2),o[d0],0,0,0);
    o[d0]=__builtin_amdgcn_mfma_f32_32x32x16_bf16(pa3,PK(3),o[d0],0,0,0);
    #undef PK
  }
}

#ifndef ATTN_STORE16
#define ATTN_STORE16(p,v) (*(u32x4*)(p)=(v))
#endif
template<int THRL> __device__ __forceinline__ void attn_unit(int b,int h,int qb,const bf16*Q,const bf16*__restrict__ K,const bf16*__restrict__ V,bf16*O,const float*ksum,char*shm){
  const int tid=threadIdx.x,lane=tid&63,r32=lane&31,hi=lane>>5; const int wid=__builtin_amdgcn_readfirstlane(tid>>6);
  const long rowbase=(long)b*SEQ; const int q0=qb*QB;
  const bf16*Qw=Q+(rowbase+q0+wid*QBLK)*DM+h*D;
  const bf16*Kh=K+rowbase*DM+h*D,*Vh=V+rowbase*DM+h*D;
  const unsigned lds0=(unsigned)(uintptr_t)shm;
  float*wsf=(float*)(shm+LDS_WS)+wid*64;
  const unsigned kdst=lds0+LDS_K+wid*1024, vdst=lds0+LDS_V+wid*1024;
  #define PHYS(t) (((t)<4)?(4*qb+(t)):((t)-4))
  #define DMA_K(t,slot) glds16s((const char*)Kh+(size_t)PHYS(t)*(KVBLK*DM*2)+wid*16,lane_now()*(unsigned)(DM*2),(unsigned)__builtin_amdgcn_readfirstlane(kdst+(slot)))
  #define DMA_V(t,slot) glds16s((const char*)Vh+(size_t)PHYS(t)*(KVBLK*DM*2)+(size_t)(16*(wid&3))*(DM*2)+(wid>>2)*64,({const unsigned l_=lane_now(); (l_>>2)*(unsigned)(DM*2)+(l_&3u)*16u;}),(unsigned)__builtin_amdgcn_readfirstlane(vdst+(slot)))
  const int vb0=(int)(lds0+LDS_V)+((lane>>4)&1)*32+(lane&3)*8+(4*hi+((lane&15)>>2))*64;
  const char*Kbase=shm+LDS_K; bf16x8 kf[8];
  const lds_cptr shm3=(lds_cptr)shm; const lds_cptr kp0=shm3+LDS_K+hi*1024+r32*16; const lds_cptr vp0=shm3+LDS_V+((lane>>4)&1)*32+(lane&3)*8+(4*hi+((lane&15)>>2))*64;
  const int NT=(q0+QB)/KVBLK;
  DMA_K(0,0);DMA_V(0,0);DMA_K(1,SLOTB);
  { float*gt=(float*)(shm+LDS_GT);
    #pragma unroll
    for(int k=0;k<2;++k){ const int j=2*wid+k; if(j<qb) gt[j*64+lane]=ksum[(long)(b*16+j)*DM+h*D+lane]; } }
  bf16x8 qr[4];
  #pragma unroll
  for(int d0=0;d0<4;++d0)qr[d0]=*reinterpret_cast<const bf16x8*>(&Qw[(long)r32*DM+d0*16+hi*8]);

  unsigned sel=0u;
  float mhat=0.f,l_reg=0.f;f32x16 o[2];o[0]=f32x16{};o[1]=f32x16{};
  bf16x8 kone=(bf16x8){0,0,0,0,0,0,0,0}, qm=(bf16x8){0,0,0,0,0,0,0,0}; if(hi==0) kone[0]=(short)0x3F80;
  #define SETQM() do{ const unsigned short mb_=(unsigned short)(cvtpk_s(-mhat,0.f)&0xffffu); qm[0]=(hi==0)?(short)mb_:(short)0; asm volatile("":"+v"(qm)); }while(0)
  const int qrel=wid*QBLK+r32;
  #define CMASK(P0,P1,t) do{ const int t_=(t); if(t_<4){ const int l_=(int)lane_now(); cmask(P0,P1,t_,wid*QBLK+(l_&31),l_>>5); } else if(!((sel>>(((t_-4)>>2)&15))&1u)){ _Pragma("unroll") for(int r=0;r<16;++r){P0[r]=-INFINITY;P1[r]=-INFINITY;} } }while(0)
  bool resc=false;
  #define START(P0,P1) do{ const float rm=rowmax(P0,P1); resc=false; \
    { const float dl=__uint_as_float(cvtpk_s(rm,0.f)<<16); mhat=fadd_s(mhat,dl);          \
      _Pragma("unroll") for(int r=0;r<16;++r){P0[r]=fsub_s(P0[r],dl);P1[r]=fsub_s(P1[r],dl);} \
      SETQM(); } \
    _Pragma("unroll") for(int r=0;r<16;++r)P0[r]=__builtin_amdgcn_exp2f(P0[r]); }while(0)
  #define RESC() do{ if(resc){ asm volatile("s_waitcnt lgkmcnt(0)":::"memory"); \
      _Pragma("unroll") for(int d_=0;d_<2;++d_) _Pragma("unroll") for(int r=0;r<16;++r)o[d_][r]*=wsf[crow(r,(int)(lane_now()>>5))]; } }while(0)
  f32x16 pA0,pA1,pB0,pB1;
  int sl_prev=0,sl_cur=0,sl_next=SLOTB;
  #define ROT() do{sl_prev=sl_cur;sl_cur=sl_next;sl_next=(sl_next==(NSLOT-1)*SLOTB)?0:sl_next+SLOTB;}while(0)
  DMA_K(2,2*SLOTB);
  WAIT_BAR(3);
  { float qf[32];
    #pragma unroll
    for(int d0=0;d0<4;++d0){
      #pragma unroll
      for(int i=0;i<8;++i) qf[d0*8+i]=__uint_as_float(((unsigned)(unsigned short)qr[d0][i])<<16); }
    const float*gt=(const float*)(shm+LDS_GT)+hi*8; float g[15];
    #pragma unroll
    for(int j=0;j<15;++j){ g[j]=-INFINITY;
      if(j<qb){ const float*kp=gt+j*64; float a=0.f;
        #pragma unroll
        for(int d0=0;d0<4;++d0){ const float4 k0=*reinterpret_cast<const float4*>(kp+d0*16), k1=*reinterpret_cast<const float4*>(kp+d0*16+4);
          a+=qf[d0*8+0]*k0.x; a+=qf[d0*8+1]*k0.y; a+=qf[d0*8+2]*k0.z; a+=qf[d0*8+3]*k0.w; a+=qf[d0*8+4]*k1.x; a+=qf[d0*8+5]*k1.y; a+=qf[d0*8+6]*k1.z; a+=qf[d0*8+7]*k1.w; }
        g[j]=a+__shfl_xor(a,32); } }
    #pragma unroll
    for(int kk=0;kk<3;++kk){ float best=-INFINITY; int bj=-1;
      #pragma unroll
      for(int j=0;j<15;++j){ const bool c=(j<qb)&&!((sel>>j)&1u)&&(g[j]>best); best=c?g[j]:best; bj=c?j:bj; }
      if(bj>=0) sel|=(1u<<bj); } }
  qkt(pA0,pA1,Kbase,qr,r32,hi);asm volatile("s_nop 15\n\ts_nop 7":"+v"(pA0),"+v"(pA1));CMASK(pA0,pA1,0);
  START(pA0,pA1);
  _Pragma("unroll") for(int r=0;r<16;++r)pA1[r]=__builtin_amdgcn_exp2f(pA1[r]);
  WAIT_BAR(0);
  DMA_K(3,0);DMA_V(1,SLOTB);
  ROT();
  kload8(kf,kp0+sl_cur);
  WAIT_BAR(2);
  s16x4 vlo[8],vhi[8]; u32x4 pw0,pw1,pw2,pw3;
  #define PKW(P,B) cvtpk_s(P[B],P[B+1])
  #define PAF(k) __builtin_bit_cast(bf16x8,pw##k)
  #define VFR(i) (bf16x8){vlo[i][0],vlo[i][1],vlo[i][2],vlo[i][3],vhi[i][0],vhi[i][1],vhi[i][2],vhi[i][3]}
  #define PIN(x) asm volatile("":"+v"(x))
  #define MX3(a,b,c) __builtin_fmaxf(__builtin_fmaxf((a),(b)),(c))
  #define GAPA(MF,A0,A1,A2,A3,W0,W1,PW) do{ MF; sacc+=A0; sacc+=A1; sacc+=A2; sacc+=A3; PIN(sacc); W0; W1; PIN(PW); SBAR(); }while(0)
  #define EX(v) __builtin_amdgcn_exp2f(v)
  #define GAPB(MF,X,B) do{ MF; X[B]=EX(X[B]); X[B+1]=EX(X[B+1]); X[B+2]=EX(X[B+2]); X[B+3]=EX(X[B+3]); PIN(X); SBAR(); }while(0)
  #define VRD(i) do{ vlo[i]=vtr(vp_+(((i)>>2)*4096+((i)&3)*1024)); vhi[i]=vtr(vp_+(((i)>>2)*4096+((i)&3)*1024+512)); }while(0)
  #define KRD(G,j) do{ if(G){ kload2(kf,kp0+sl_next,j); SBAR(); } }while(0)
  #define STEP(C0,C1,P0,P1,t,GK,GV,GL) do{ SBAR(); \
    const lds_cptr vp_=vp0+sl_prev; \
    C0=__builtin_amdgcn_mfma_f32_32x32x16_bf16(kone,qm,(f32x16){0.f,0.f,0.f,0.f,0.f,0.f,0.f,0.f,0.f,0.f,0.f,0.f,0.f,0.f,0.f,0.f},0,0,0); C1=__builtin_amdgcn_mfma_f32_32x32x16_bf16(kone,qm,(f32x16){0.f,0.f,0.f,0.f,0.f,0.f,0.f,0.f,0.f,0.f,0.f,0.f,0.f,0.f,0.f,0.f},0,0,0); SBAR(); \
    VRD(0); SBAR(); float sacc=(P0[0]+P0[1]); \
    GAPA(C0=__builtin_amdgcn_mfma_f32_32x32x16_bf16(kf[0],qr[0],C0,0,0,0), P0[2],P0[3],P0[4],P0[5],     pw0[0]=PKW(P0,0), pw0[1]=PKW(P0,2), pw0); \
    VRD(4); SBAR(); GAPA(C1=__builtin_amdgcn_mfma_f32_32x32x16_bf16(kf[1],qr[0],C1,0,0,0), P0[6],P0[7],P0[8],P0[9],     pw0[2]=PKW(P0,4), pw0[3]=PKW(P0,6), pw0); \
    VRD(1); SBAR(); GAPA(C0=__builtin_amdgcn_mfma_f32_32x32x16_bf16(kf[2],qr[1],C0,0,0,0),   P0[10],P0[11],P0[12],P0[13], pw1[0]=PKW(P0,8), pw1[1]=PKW(P0,10), pw1); \
    VRD(5); SBAR(); GAPA(C1=__builtin_amdgcn_mfma_f32_32x32x16_bf16(kf[3],qr[1],C1,0,0,0),   P0[14],P0[15],P1[0],P1[1],   pw1[2]=PKW(P0,12),pw1[3]=PKW(P0,14), pw1); \
    VRD(2); SBAR(); GAPA(C0=__builtin_amdgcn_mfma_f32_32x32x16_bf16(kf[4],qr[2],C0,0,0,0),   P1[2],P1[3],P1[4],P1[5],     pw2[0]=PKW(P1,0), pw2[1]=PKW(P1,2), pw2); \
    VRD(6); SBAR(); GAPA(C1=__builtin_amdgcn_mfma_f32_32x32x16_bf16(kf[5],qr[2],C1,0,0,0),   P1[6],P1[7],P1[8],P1[9],     pw2[2]=PKW(P1,4), pw2[3]=PKW(P1,6), pw2); \
    VRD(3); SBAR(); GAPA(C0=__builtin_amdgcn_mfma_f32_32x32x16_bf16(kf[6],qr[3],C0,0,0,0),   P1[10],P1[11],P1[12],P1[13], pw3[0]=PKW(P1,8), pw3[1]=PKW(P1,10), pw3); \
    VRD(7); SBAR(); GAPA(C1=__builtin_amdgcn_mfma_f32_32x32x16_bf16(kf[7],qr[3],C1,0,0,0),   P1[14],P1[15],0.f,0.f,       pw3[2]=PKW(P1,12),pw3[3]=PKW(P1,14), pw3); \
    l_reg+=sacc; \
    if(GK){DMA_K((t)+3,sl_cur);} if(GV){DMA_V((t)+1,sl_next);} \
    CMASK(C0,C1,t); \
    { float a=MX3(C0[0],C0[1],C1[0]),b=MX3(C0[2],C0[3],C1[1]); a=MX3(a,C1[2],C1[3]); \
      _Pragma("unroll") for(int r=4;r<16;r+=4){a=MX3(a,C0[r],C0[r+1]);b=MX3(b,C0[r+2],C0[r+3]);a=MX3(a,C1[r],C1[r+1]);b=MX3(b,C1[r+2],C1[r+3]);} \
      float rm=__builtin_fmaxf(a,b); { auto rr=__builtin_amdgcn_permlane32_swap(__float_as_uint(rm),__float_as_uint(rm),false,false); rm=__builtin_fmaxf(__uint_as_float(rr[0]),__uint_as_float(rr[1])); } \
      resc=false; \
      if(__builtin_expect(__any(rm>(float)THRL),0)){ const float mn_=__uint_as_float(cvtpk_s(mhat+__builtin_fmaxf(rm,0.f),0.f)<<16); const float dl=mn_-mhat; mhat=mn_; \
        _Pragma("unroll") for(int r=0;r<16;++r){C0[r]-=dl;C1[r]-=dl;} \
        SETQM(); \
        const float f=__builtin_amdgcn_exp2f(-dl); l_reg*=f; { const int l_=(int)lane_now(); if((l_>>5)==0)wsf[l_&31]=f; } resc=true; } } \
    SBAR(); \
    GAPB(o[0]=__builtin_amdgcn_mfma_f32_32x32x16_bf16(PAF(0),VFR(0),o[0],0,0,0), C0,0); \
    GAPB(o[1]=__builtin_amdgcn_mfma_f32_32x32x16_bf16(PAF(0),VFR(4),o[1],0,0,0), C0,4); \
    KRD(GL,0); GAPB(o[0]=__builtin_amdgcn_mfma_f32_32x32x16_bf16(PAF(1),VFR(1),o[0],0,0,0), C0,8); \
    KRD(GL,1); GAPB(o[1]=__builtin_amdgcn_mfma_f32_32x32x16_bf16(PAF(1),VFR(5),o[1],0,0,0), C0,12); \
    KRD(GL,2); GAPB(o[0]=__builtin_amdgcn_mfma_f32_32x32x16_bf16(PAF(2),VFR(2),o[0],0,0,0), C1,0); \
    KRD(GL,3); GAPB(o[1]=__builtin_amdgcn_mfma_f32_32x32x16_bf16(PAF(2),VFR(6),o[1],0,0,0), C1,4); \
    GAPB(o[0]=__builtin_amdgcn_mfma_f32_32x32x16_bf16(PAF(3),VFR(3),o[0],0,0,0), C1,8); \
    GAPB(o[1]=__builtin_amdgcn_mfma_f32_32x32x16_bf16(PAF(3),VFR(7),o[1],0,0,0), C1,12); \
    }while(0)
  int t=1;
  #undef CMASK
  #define CMASK(P0,P1,t) do{ const int t_=(t); if(t_<4){ const int l_=(int)lane_now(); cmask(P0,P1,t_,wid*QBLK+(l_&31),l_>>5); } else if(!((sel>>(((t_-4)>>2)&15))&1u)){ _Pragma("unroll") for(int r=0;r<16;++r){P0[r]=-INFINITY;P1[r]=-INFINITY;} } }while(0)
  for(;t+5<NT;t+=2){
    STEP(pB0,pB1,pA0,pA1,t,true,true,true);     WAIT_BAR(2); RESC(); ROT();
    STEP(pA0,pA1,pB0,pB1,t+1,true,true,true);   WAIT_BAR(2); RESC(); ROT();
  }
  #undef CMASK
  #define CMASK(P0,P1,t) do{ const int t_=(t); if(t_<4){ const int l_=(int)lane_now(); cmask(P0,P1,t_,wid*QBLK+(l_&31),l_>>5); } else if(!((sel>>(((t_-4)>>2)&15))&1u)){ _Pragma("unroll") for(int r=0;r<16;++r){P0[r]=-INFINITY;P1[r]=-INFINITY;} } }while(0)
  #define ENDW(tt) do{ if((tt)+3<NT){WAIT_BAR(2);} else if((tt)+2<NT){WAIT_BAR(1);} else {WAIT_BAR(0);} }while(0)
  for(;t+1<NT;t+=2){
    STEP(pB0,pB1,pA0,pA1,t,(t+3<NT),(t+1<NT),(t+1<NT));       ENDW(t);   RESC(); ROT();
    STEP(pA0,pA1,pB0,pB1,t+1,(t+4<NT),(t+2<NT),(t+2<NT));     ENDW(t+1); RESC(); ROT();
  }
  STEP(pB0,pB1,pA0,pA1,NT-1,false,false,false); RESC();
  { float sacc=pB0[0]+pB0[1]; _Pragma("unroll") for(int r=2;r<16;++r)sacc+=pB0[r]; _Pragma("unroll") for(int r=0;r<16;++r)sacc+=pB1[r]; l_reg+=sacc;
    pw0=(u32x4){PKW(pB0,0),PKW(pB0,2),PKW(pB0,4),PKW(pB0,6)};pw1=(u32x4){PKW(pB0,8),PKW(pB0,10),PKW(pB0,12),PKW(pB0,14)};pw2=(u32x4){PKW(pB1,0),PKW(pB1,2),PKW(pB1,4),PKW(pB1,6)};pw3=(u32x4){PKW(pB1,8),PKW(pB1,10),PKW(pB1,12),PKW(pB1,14)};
    SBAR(); pv(o,vb0+sl_cur,PAF(0),PAF(1),PAF(2),PAF(3)); }
  #undef PKW
  #undef PAF
  #undef VFR
  #undef PIN
  #undef MX3
  #undef GAPA
  #undef GAPB
  #undef EX
  #undef VRD
  #undef KRD
  #undef STEP
  #undef ENDW
  {auto rr=__builtin_amdgcn_permlane32_swap(__float_as_uint(l_reg),__float_as_uint(l_reg),false,false);l_reg=__uint_as_float(rr[0])+__uint_as_float(rr[1]);}
  if(hi==0)wsf[32+r32]=l_reg;asm volatile("s_waitcnt lgkmcnt(0)":::"memory");
  float rli[16];
  #pragma unroll
  for(int r=0;r<16;++r)rli[r]=__builtin_amdgcn_rcpf(wsf[32+crow(r,hi)]);
  bf16*Ow=O+(rowbase+q0+wid*QBLK)*DM+h*D;
  { bf16*stg=(bf16*)(shm+LDS_OST)+wid*2048;
    #pragma unroll
    for(int r=0;r<16;++r){const int orow=crow(r,hi);
      #pragma unroll
      for(int d0=0;d0<2;++d0)stg[orow*64+d0*32+r32]=__float2bfloat16(o[d0][r]*rli[r]);}
    asm volatile("s_waitcnt lgkmcnt(0)":::"memory");
    #pragma unroll
    for(int i=0;i<4;++i){const int row=i*8+(lane>>3),ch=lane&7; const u32x4 v=*(const u32x4*)(stg+row*64+ch*8); ATTN_STORE16(Ow+(long)row*DM+ch*8,v);} }
  asm volatile("s_waitcnt lgkmcnt(0)\n\ts_barrier":::"memory");
  #undef DMA_K
  #undef PHYS
  #undef DMA_V
  #undef CMASK
  #undef START
  #undef SETQM
  #undef RESC
  #undef ROT
}
constexpr int ATTN_LDS_BYTES=LDS_BYTES;
struct AttnTensors { const bf16* Q; const bf16* K; const bf16* V; bf16* O; const float* ksum; };
struct AttnUnit { int bh; int qb; };
struct StaticOrder {
  int vcu, G;
  __device__ __forceinline__ explicit StaticOrder(int grid,int block):vcu((grid%8==0)?((block%8)*(grid/8)+block/8):block),G(grid){}
  __device__ __forceinline__ bool next(int i,AttnUnit&u)const{ const int L=i*G+vcu; if(L>=1024)return false; const int w=L&255, rnd=L>>8, s=w&3; u.bh=w>>2; u.qb=(rnd==0)?s:(rnd==1)?7-s:(rnd==2)?8+s:15-s; return true; }
  __device__ __forceinline__ void a_ready(const AttnUnit&)const{}
  __device__ __forceinline__ void done(const AttnUnit&)const{}
};
struct SnakeOrder {
  int v, G;
  __device__ __forceinline__ bool next(int i,AttnUnit&u)const{ const int idx=i*G+((i&1)?(G-1-v):v); if(idx>=1024)return false; u.qb=15-(idx>>6); u.bh=idx&63; return true; }
  __device__ __forceinline__ void a_ready(const AttnUnit&)const{}
  __device__ __forceinline__ void done(const AttnUnit&)const{}
};
template<class Sched,int THRL=8> __device__ __forceinline__ void attn_phase(char*lds,const AttnTensors&T,const Sched&S){
  AttnUnit u;
  for(int i=0;S.next(i,u);++i){ S.a_ready(u); attn_unit<THRL>(u.bh/NHEAD,u.bh%NHEAD,u.qb,T.Q,T.K,T.V,T.O,T.ksum,lds); S.done(u); }
}
#undef SBAR
#undef WAIT_BAR
}
constexpr int NWAVES = 8, NTHR = 512;
constexpr int NTOK = 16384, DM = 1024, SEQ = 4096, NBATCH = 4, NEXP = 32;
constexpr float ALPHA = 1.4142135623730951f;
constexpr float LN_EPS = 1e-5f;
constexpr float RSQRT_DQK = 0.08838834764831845f;
constexpr int NPHASE = 19;
constexpr float FP8_SA = 4.0f, FP8_SWGU = 64.0f, FP8_SWD = 128.0f;
#ifndef DBG_ATTN_MUL
#define DBG_ATTN_MUL 1.0f
#endif
#ifndef DBG_MLSTM_MUL
#define DBG_MLSTM_MUL 1.0f
#endif
#ifndef DBG_MOE_MUL
#define DBG_MOE_MUL 1.0f
#endif
#ifndef DBG_P14_A
#define DBG_P14_A WS_HN
#endif
#ifndef NCONV
#define NCONV 80
#endif
#ifndef MK_ONE_LAUNCH
#define MK_ONE_LAUNCH 1
#endif

constexpr size_t MiB = 1u << 20, KiB = 1024;
constexpr size_t WS_CTL = 0, CTL_ZERO_BYTES = 1 * MiB;
constexpr int CW_TMO = 0, CW_BAR = 4096, CW_CNT = 8192, CW_AQ = 16384;
constexpr size_t WS_KSUM = 256 * KiB, WS_DEN = 512 * KiB;
constexpr size_t WS_WQKV = 2 * MiB, WS_WO = 8 * MiB, WS_WINA = 10 * MiB, WS_WINB = 14 * MiB, WS_WOUT = 17 * MiB;
constexpr size_t WS_WG = 19 * MiB, WS_RWT = 20 * MiB, WS_ROPE = 21 * MiB;
constexpr size_t WS_TOKE = 22 * MiB, WS_TOKP = 22 * MiB + 256 * KiB, WS_TOKG = 22 * MiB + 512 * KiB;
constexpr size_t WS_GI = 23 * MiB, WS_LF = 23 * MiB + 256 * KiB, WS_RF = 23 * MiB + 512 * KiB, WS_CF = 23 * MiB + 768 * KiB;
constexpr size_t WS_DEC = 24 * MiB, WS_NU = 24 * MiB + 256 * KiB, WS_NPREV = 24 * MiB + 512 * KiB;
constexpr size_t WS_ROWTOK = 25 * MiB;
constexpr size_t WS_XB = 32 * MiB, WS_Q = 64 * MiB, WS_K = 96 * MiB, WS_V = 128 * MiB;
constexpr size_t WS_R0 = 160 * MiB, WS_R1 = 224 * MiB, WS_R2 = 288 * MiB;
constexpr size_t WS_H = 352 * MiB, WS_Y = 496 * MiB;
constexpr size_t WS_WGU = 640 * MiB, WS_WD = 896 * MiB, WS_END = 1024 * MiB;
constexpr size_t WS_AE = 352 * MiB, WS_BE = 416 * MiB, WS_KN = 464 * MiB, WS_KT = 496 * MiB, WS_UT = 512 * MiB, WS_OS = 544 * MiB, WS_HN = 576 * MiB;

constexpr int RING_OFF = 0, RING_BYTES = 131072;
constexpr int LX = RING_BYTES;
constexpr int LX_MISC = LX;
constexpr int LX_TILEE = LX + 128;
constexpr int LX_TBASE = LX + 1280;
constexpr int LX_LCNT = LX + 1536, LX_GBASE = LX + 1664;
constexpr int LX_REC = LX + 1792;
constexpr int LX_TOKL = LX + 4096;
constexpr int LX_LNX = LX + 4096;
constexpr int LX_BIAS = LX + 12288;
constexpr int LDS_BYTES = 147456;
constexpr int TOKL_ROUNDS = 10;

#define RLX_AGENT __ATOMIC_RELAXED, __HIP_MEMORY_SCOPE_AGENT
#define LDS_WAIT() asm volatile("s_waitcnt lgkmcnt(0)" ::: "memory")
#define VM_WAIT() asm volatile("s_waitcnt vmcnt(0)" ::: "memory")
#define XB_TMO      128
#define XB_XCNT(j)  (256  + 64 * (j))
#define XB_XSUB(j)  (1280 + 64 * (j))
#define XB_XGEN(j)  (2304 + 64 * (j))
#define XB_TOP      3328
#define XB_TOPGEN   3392
#define XCD_BAR_WORDS 3456
#define XB_SPIN_CAP (1u << 18)

__device__ __forceinline__ unsigned xb_ld(unsigned* p)              { return __hip_atomic_load(p, __ATOMIC_RELAXED, __HIP_MEMORY_SCOPE_AGENT); }
__device__ __forceinline__ unsigned xb_add(unsigned* p, unsigned v) { return __hip_atomic_fetch_add(p, v, __ATOMIC_RELAXED, __HIP_MEMORY_SCOPE_AGENT); }
__device__ __forceinline__ unsigned xb_xcc_id() { return (unsigned)__builtin_amdgcn_s_getreg((3 << 11) | 20) & 0xFu; }
#define XB_SPIN(cond, bar) do { unsigned _sp = 0; while (cond) { __builtin_amdgcn_s_sleep(1); \
    if ((++_sp & 255u) == 0u) { if (xb_ld(&(bar)[XB_TMO])) break; if (_sp > XB_SPIN_CAP) { atomicAdd(&(bar)[XB_TMO], 1u); break; } } } } while (0)

struct XcdBarrier {
    unsigned* bar; unsigned x;
    volatile LAS unsigned* st;
};

__device__ __forceinline__ XcdBarrier xcd_barrier_post(unsigned* bar, volatile LAS unsigned* st) {
    XcdBarrier b; b.bar = bar; b.x = xb_xcc_id(); b.st = st;
    if (threadIdx.x == 0) (void)xb_add(&bar[XB_XCNT(b.x)], 1u);
    return b;
}
__device__ __forceinline__ void xcd_barrier_complete(unsigned* bar, unsigned x, unsigned& nloc, unsigned& nx) {
    const unsigned G = gridDim.x * gridDim.y * gridDim.z;
    unsigned sum, cnt, mine, sp = 0u;
    for (;;) {
        sum = 0u; cnt = 0u; mine = 0u;
#pragma unroll
        for (unsigned j = 0; j < 16; ++j) { const unsigned c = xb_ld(&bar[XB_XCNT(j)]); sum += c; cnt += (c > 0u) ? 1u : 0u; mine = (j == x) ? c : mine; }
        if (sum == G) break;
        __builtin_amdgcn_s_sleep(1);
        if ((++sp & 255u) == 0u) { if (xb_ld(&bar[XB_TMO])) break; if (sp > XB_SPIN_CAP) { atomicAdd(&bar[XB_TMO], 1u); break; } }
    }
    nloc = mine > 0u ? mine : 1u; nx = cnt > 0u ? cnt : 1u;
}

__device__ __forceinline__ void xcd_barrier(const XcdBarrier& b) {
    asm volatile("s_waitcnt vmcnt(0)" ::: "memory");
    __syncthreads();
    if (threadIdx.x == 0) {
        unsigned* bar = b.bar;
        __builtin_amdgcn_s_waitcnt(0);
        unsigned nloc = b.st[0], nx = b.st[1];
        if (nloc == 0u) { xcd_barrier_complete(bar, b.x, nloc, nx); b.st[0] = nloc; b.st[1] = nx; }
        const unsigned old = xb_add(&bar[XB_XSUB(b.x)], 1u);
        const unsigned gen = old / nloc;
        if (old + 1u == (gen + 1u) * nloc) {
            __builtin_amdgcn_fence(__ATOMIC_RELEASE, "agent");
            asm volatile("s_waitcnt vmcnt(0)" ::: "memory");
            const unsigned og = xb_add(&bar[XB_TOP], 1u);
            const unsigned tg = og / nx;
            if (og + 1u == (tg + 1u) * nx) xb_add(&bar[XB_TOPGEN], 1u);
            else XB_SPIN(xb_ld(&bar[XB_TOPGEN]) == tg, bar);
            __builtin_amdgcn_fence(__ATOMIC_ACQUIRE, "agent");
            xb_add(&bar[XB_XGEN(b.x)], 1u);
            asm volatile("s_waitcnt vmcnt(0)" ::: "memory");
        } else {
            XB_SPIN(xb_ld(&bar[XB_XGEN(b.x)]) == gen, bar);
            __builtin_amdgcn_fence(__ATOMIC_ACQUIRE, "agent");
            asm volatile("s_waitcnt vmcnt(0)" ::: "memory");
        }
    }
    __syncthreads();
}
using pg8::Unit; using pg8::Gemm;
typedef f32x4 (&AccRef)[2][2][4][2];

__device__ __forceinline__ bool moe_unit(int i, int G, int c, int nT, int nN, int& pm, int& pn, int& half) {
    const int U = nT * nN, R = U / G, rem = U - R * G; half = 0;
    if (i < R) return pg8::tile_order(i, G, c, nT, nN, pm, pn);
    if (i > R || rem == 0) return false;
    if (2 * rem <= G) { if (c >= 2 * rem) return false; half = 1 + (c & 1); return pg8::tile_order(0, U, R * G + (c >> 1), nT, nN, pm, pn); }
    return pg8::tile_order(i, G, c, nT, nN, pm, pn);
}
struct DenseSched {
    int nM, nN, G, c; const char* A; const char* B; size_t tstepA, tstepB; bool split = false;
    __device__ __forceinline__ bool next(int i, Unit& u) const {
        int half = 0;
        if (split) { if (!moe_unit(i, G, c, nM, nN, u.pm, u.pn, half)) return false; }
        else if (!pg8::tile_order(i, G, c, nM, nN, u.pm, u.pn)) return false;
        u.A = A + (size_t)u.pm * tstepA; u.B = B + (size_t)u.pn * tstepB; u.tl = nullptr; u.x0 = u.x1 = 0; u.x2 = half; return true; }
};
struct MoeSched {
    int nT, nN, G, c; const LAS int* tile_e; const LAS int* tbase; const LAS unsigned short* tokl;
    const char* A; const char* B; size_t tstepA, estepB, tstepB;
    __device__ __forceinline__ bool next(int i, Unit& u) const {
        int half; if (!moe_unit(i, G, c, nT, nN, u.pm, u.pn, half)) return false;
        const int e = tile_e[u.pm];
        u.x0 = e; u.x1 = u.pm * 256; u.x2 = half;
        u.A = A + (size_t)u.pm * tstepA; u.B = B + (size_t)e * estepB + (size_t)u.pn * tstepB;
        u.tl = tokl ? tokl + (i < TOKL_ROUNDS ? i : TOKL_ROUNDS - 1) * 256 : nullptr; return true; }
};
struct MuSched {
    int G, c, mode; const char* A; const char* B;
    __device__ __forceinline__ bool next(int i, Unit& u) const {
        const int mu = i * G + c; if (mu >= 256) return false;
        const int b = mu >> 6, hh = (mu >> 4) & 3, ch = mu & 15; const size_t tok0 = (size_t)b * SEQ + (size_t)ch * 256;
        u.pm = mu; u.pn = 0; u.x0 = mu; u.x1 = u.x2 = 0; u.tl = nullptr;
        if (mode == 0) { u.A = A + (size_t)mu * 256 * 384 * 2; u.B = B + ((size_t)(hh * 128) * NTOK + tok0) * 2; }
        else if (mode == 1) { u.A = A + ((size_t)mu * 256 * 512 + 256) * 2; u.B = B + (tok0 * 1024 + (size_t)hh * 256) * 2; }
        else { u.A = A + (size_t)mu * 256 * 512 * 2; u.B = B + (size_t)mu * 256 * 384 * 2; }
        return true; }
};

constexpr float C2 = 0.125f * 1.4426950408889634f;

struct EpiQKV {
    static constexpr bool PERM = true;
    __device__ __forceinline__ void prep(const Unit&, int, int, int) const {}
    bf16_t* Q; bf16_t* K; bf16_t* V; const float* rope; float* ksum;
    __device__ __forceinline__ void operator()(AccRef acc, const Unit& u, int wr, int wc, int fr, int fq) const {
        asm volatile("" : "+v"(fr), "+v"(fq));
        const int part = u.pn >> 2, colt = (u.pn & 3) * 256;
        bf16_t* base = Q + (size_t)part * ((WS_K - WS_Q) / 2);
        const bool rot = (part < 2) && ((wc & 1) == 0);
        const float sgn = (fq == 0) ? -1.f : 1.f;
        float ks[2][8];
#pragma unroll
        for (int bj = 0; bj < 2; ++bj)
#pragma unroll
            for (int j = 0; j < 8; ++j) ks[bj][j] = 0.f;
#pragma unroll
        for (int ai = 0; ai < 2; ++ai)
#pragma unroll
            for (int m = 0; m < 4; ++m) {
                const int row = u.pm * 256 + ai * 128 + wr * 64 + m * 16 + fr;
                f32x4 cs0 = {1.f, 1.f, 1.f, 1.f}, cs1 = cs0, sn0 = {0.f, 0.f, 0.f, 0.f}, sn1 = sn0;
                if (rot) { const f32x4* rp = (const f32x4*)(rope + (size_t)row * 16); cs0 = rp[0]; cs1 = rp[1]; sn0 = rp[2]; sn1 = rp[3]; }
#pragma unroll
                for (int bj = 0; bj < 2; ++bj) {
                    f32x4 v0 = acc[ai][bj][m][0], v1 = acc[ai][bj][m][1];
                    if (rot) {
                        f32x4 p0, p1;
#pragma unroll
                        for (int j = 0; j < 4; ++j) { p0[j] = __shfl_xor(v0[j], 16); p1[j] = __shfl_xor(v1[j], 16); }
                        if (fq < 2) { v0 = v0 * cs0 + p0 * sn0 * sgn; v1 = v1 * cs1 + p1 * sn1 * sgn; }
                    }
                    if (part == 0) { v0 = v0 * C2; v1 = v1 * C2; }
                    if (part == 1) {
#pragma unroll
                        for (int j = 0; j < 4; ++j) { ks[bj][j] += v0[j]; ks[bj][4 + j] += v1[j]; } }
                    u32x4 w; w.x = cvt_pk_bf16(v0[0], v0[1]); w.y = cvt_pk_bf16(v0[2], v0[3]); w.z = cvt_pk_bf16(v1[0], v1[1]); w.w = cvt_pk_bf16(v1[2], v1[3]);
                    *(u32x4*)(base + (size_t)row * DM + colt + bj * 128 + wc * 32 + fq * 8) = w;
                }
            }
        if (part == 1) {
#pragma unroll
            for (int bj = 0; bj < 2; ++bj)
#pragma unroll
                for (int j = 0; j < 8; ++j) { float s = ks[bj][j]; s += __shfl_xor(s, 1); s += __shfl_xor(s, 2); s += __shfl_xor(s, 4); s += __shfl_xor(s, 8);
                    if (fr == 0) atomicAdd(ksum + (size_t)u.pm * DM + colt + bj * 128 + wc * 32 + fq * 8 + j, s); }
        }
    }
};

struct EpiZ {
    static constexpr bool PERM = false;
    __device__ __forceinline__ void prep(const Unit&, int, int, int) const {}
    const float* xin; float* z; float ymul;
    __device__ __forceinline__ void operator()(AccRef acc, const Unit& u, int wr, int wc, int fr, int fq) const {
        asm volatile("" : "+v"(fr), "+v"(fq));
#pragma unroll
        for (int ai = 0; ai < 2; ++ai) {
            const size_t off0 = (size_t)(u.pm * 256 + ai * 128 + wr * 64 + fr) * DM + u.pn * 256 + wc * 32 + fq * 4;
            f32x4 xr[4][2][2];
#pragma unroll
            for (int m = 0; m < 4; ++m)
#pragma unroll
                for (int bj = 0; bj < 2; ++bj)
#pragma unroll
                    for (int n = 0; n < 2; ++n) xr[m][bj][n] = *(const f32x4*)(xin + off0 + (size_t)m * 16 * DM + bj * 128 + n * 16);
#pragma unroll
            for (int m = 0; m < 4; ++m)
#pragma unroll
                for (int bj = 0; bj < 2; ++bj)
#pragma unroll
                    for (int n = 0; n < 2; ++n) *(f32x4*)(z + off0 + (size_t)m * 16 * DM + bj * 128 + n * 16) = xr[m][bj][n] * ALPHA + acc[ai][bj][m][n] * ymul;
            asm volatile("" ::: "memory");
        }
    }
};

__device__ __forceinline__ float swiglu1(float glu, float lin) {
    const float g = fminf(glu, 7.0f), l = fminf(fmaxf(lin, -7.0f), 7.0f);
    const float sg = __builtin_amdgcn_rcpf(1.0f + __builtin_amdgcn_exp2f(-1.702f * 1.4426950408889634f * g));
    return g * sg * (l + 1.0f);
}
__device__ __forceinline__ f32x2 swiglu2(float glu0, float lin0, float glu1, float lin1) {
    const f32x2 g = {fminf(glu0, 7.0f), fminf(glu1, 7.0f)}, l = {fminf(fmaxf(lin0, -7.0f), 7.0f), fminf(fmaxf(lin1, -7.0f), 7.0f)};
    const f32x2 t = g * (f32x2){-1.702f * 1.4426950408889634f, -1.702f * 1.4426950408889634f};
    const f32x2 d = (f32x2){__builtin_amdgcn_exp2f(t[0]), __builtin_amdgcn_exp2f(t[1])} + (f32x2){1.0f, 1.0f};
    const f32x2 r = {__builtin_amdgcn_rcpf(d[0]), __builtin_amdgcn_rcpf(d[1])};
    const f32x2 lp = l * (f32x2){FP8_SA, FP8_SA} + (f32x2){FP8_SA, FP8_SA};
    return (g * lp) * r;
}
struct EpiGU {
    static constexpr bool PERM = true;
    __device__ __forceinline__ void prep(const Unit& u, int ui, int wid, int lane) const { if (wid < 4) glds4s(uni_ptr((const char*)(bias + (size_t)u.x0 * 2048 + u.pn * 256 + wid * 64)), (unsigned)lane * 4u, (unsigned)__builtin_amdgcn_readfirstlane((unsigned)(unsigned long long)bl + (unsigned)(((ui & 1) * 256 + wid * 64) * 4))); }
    const float* bias; unsigned char* H; LAS float* bl; mutable int ucnt;
    __device__ __forceinline__ void operator()(AccRef acc, const Unit& u, int wr, int wc, int fr, int fq) const {
        asm volatile("" : "+v"(fr), "+v"(fq));
        const int c0 = u.pn * 256 + wc * 32 + fq * 8; const LAS float* bp = bl + (ucnt & 1) * 256 + wc * 32 + fq * 8; ++ucnt; constexpr float SC = 1.0f / (FP8_SA * FP8_SWGU);
        f32x4 b[2][2];
#pragma unroll
        for (int bj = 0; bj < 2; ++bj) { b[bj][0] = *(const LAS f32x4*)(bp + bj * 128); b[bj][1] = *(const LAS f32x4*)(bp + bj * 128 + 4); }
#pragma unroll
        for (int ai = 0; ai < 2; ++ai)
#pragma unroll
            for (int m = 0; m < 4; ++m) {
                unsigned char* rowp = H + (size_t)(u.x1 + ai * 128 + wr * 64 + m * 16 + fr) * DM + (c0 >> 1);
#pragma unroll
                for (int bj = 0; bj < 2; ++bj) { if (u.x2 == 2 - bj) continue;
                    const f32x4 v0 = acc[ai][bj][m][0] * SC + b[bj][0], v1 = acc[ai][bj][m][1] * SC + b[bj][1];
                    const f32x2 h0 = swiglu2(v0[0], v0[1], v0[2], v0[3]), h1 = swiglu2(v1[0], v1[1], v1[2], v1[3]);
                    int w = __builtin_amdgcn_cvt_pk_fp8_f32(h0[0], h0[1], 0, false);
                    w = __builtin_amdgcn_cvt_pk_fp8_f32(h1[0], h1[1], w, true);
                    *(int*)(rowp + bj * 64) = w; }
            }
    }
};
struct EpiDN {
    static constexpr bool PERM = true;
    __device__ __forceinline__ void prep(const Unit& u, int ui, int wid, int lane) const { if (wid < 4) glds4s(uni_ptr((const char*)(bias + (size_t)u.x0 * 1024 + u.pn * 256 + wid * 64)), (unsigned)lane * 4u, (unsigned)__builtin_amdgcn_readfirstlane((unsigned)(unsigned long long)bl + (unsigned)(((ui & 1) * 256 + wid * 64) * 4))); }
    const float* bias; bf16_t* Y; LAS float* bl; mutable int ucnt;
    __device__ __forceinline__ void operator()(AccRef acc, const Unit& u, int wr, int wc, int fr, int fq) const {
        asm volatile("" : "+v"(fr), "+v"(fq));
        const int c0 = u.pn * 256 + wc * 32 + fq * 8; const LAS float* bp = bl + (ucnt & 1) * 256 + wc * 32 + fq * 8; ++ucnt; constexpr float SC = 1.0f / (FP8_SA * FP8_SWD);
        f32x4 b[2][2];
#pragma unroll
        for (int bj = 0; bj < 2; ++bj) { b[bj][0] = *(const LAS f32x4*)(bp + bj * 128); b[bj][1] = *(const LAS f32x4*)(bp + bj * 128 + 4); }
#pragma unroll
        for (int ai = 0; ai < 2; ++ai)
#pragma unroll
            for (int m = 0; m < 4; ++m) {
                bf16_t* rowp = Y + (size_t)(u.x1 + ai * 128 + wr * 64 + m * 16 + fr) * DM + c0;
#pragma unroll
                for (int bj = 0; bj < 2; ++bj) { if (u.x2 == 2 - bj) continue;
                    const f32x4 v0 = acc[ai][bj][m][0] * SC + b[bj][0], v1 = acc[ai][bj][m][1] * SC + b[bj][1];
                    u32x4 w; w.x = cvt_pk_bf16(v0[0], v0[1]); w.y = cvt_pk_bf16(v0[2], v0[3]); w.z = cvt_pk_bf16(v1[0], v1[1]); w.w = cvt_pk_bf16(v1[2], v1[3]);
                    *(u32x4*)(rowp + bj * 128) = w; }
            }
    }
};

struct EpiINA {
    static constexpr bool PERM = true;
    __device__ __forceinline__ void prep(const Unit&, int, int, int) const {}
    const float* rf; const float* cf; bf16_t* AE; bf16_t* KN; bf16_t* OS;
    __device__ __forceinline__ void operator()(AccRef acc, const Unit& u, int wr, int wc, int fr, int fq) const {
        asm volatile("" : "+v"(fr), "+v"(fq));
        const int b = u.pm >> 4, ch = u.pm & 15, d0 = wc * 32 + fq * 8; const u32x4 zero = {0u, 0u, 0u, 0u};
        if (u.pn < 4) {
            const bool isq = u.pn < 2; const float* fac = isq ? rf : cf; const float fs = isq ? 1.0f : RSQRT_DQK; const int h0 = (u.pn & 1) * 2;
            float sf[2][4][2];
#pragma unroll
            for (int ai = 0; ai < 2; ++ai)
#pragma unroll
                for (int m = 0; m < 4; ++m)
#pragma unroll
                    for (int bj = 0; bj < 2; ++bj) sf[ai][m][bj] = fac[(size_t)(h0 + bj) * NTOK + (size_t)u.pm * 256 + ai * 128 + wr * 64 + m * 16 + fr];
#pragma unroll
            for (int ai = 0; ai < 2; ++ai)
#pragma unroll
                for (int m = 0; m < 4; ++m) {
                    const int t = ai * 128 + wr * 64 + m * 16 + fr; const size_t token = (size_t)u.pm * 256 + t;
#pragma unroll
                    for (int bj = 0; bj < 2; ++bj) { const int hh = h0 + bj; const float s = sf[ai][m][bj] * fs;
                        const f32x4 v0 = acc[ai][bj][m][0] * s, v1 = acc[ai][bj][m][1] * s;
                        const size_t oq = ((size_t)(((b * 4 + hh) * 16 + ch) * 256 + t)) * 512 + 256 + d0, ok = token * 1024 + hh * 256 + d0;
                        bf16_t* dst = isq ? (AE + oq) : (KN + ok);
                        u32x4 w; w.x = cvt_pk_bf16(v0[0], v0[1]); w.y = cvt_pk_bf16(v0[2], v0[3]); w.z = cvt_pk_bf16(v1[0], v1[1]); w.w = cvt_pk_bf16(v1[2], v1[3]);
                        *(u32x4*)dst = w; *(u32x4*)(dst + 128) = zero; }
                }
        } else {
#pragma unroll
            for (int ai = 0; ai < 2; ++ai)
#pragma unroll
                for (int m = 0; m < 4; ++m) {
                    const int t = ai * 128 + wr * 64 + m * 16 + fr; const size_t token = (size_t)u.pm * 256 + t;
#pragma unroll
                    for (int bj = 0; bj < 2; ++bj) { f32x4 v0 = acc[ai][bj][m][0], v1 = acc[ai][bj][m][1];
#pragma unroll
                        for (int j = 0; j < 4; ++j) { v0[j] = __builtin_amdgcn_rcpf(1.0f + __builtin_amdgcn_exp2f(-1.4426950408889634f * v0[j])); v1[j] = __builtin_amdgcn_rcpf(1.0f + __builtin_amdgcn_exp2f(-1.4426950408889634f * v1[j])); }
                        u32x4 w; w.x = cvt_pk_bf16(v0[0], v0[1]); w.y = cvt_pk_bf16(v0[2], v0[3]); w.z = cvt_pk_bf16(v1[0], v1[1]); w.w = cvt_pk_bf16(v1[2], v1[3]);
                        *(u32x4*)(OS + token * 1024 + (u.pn - 4) * 256 + bj * 128 + d0) = w; }
                }
        }
    }
};
struct EpiINB {
    static constexpr bool PERM = true;
    __device__ __forceinline__ void prep(const Unit&, int, int, int) const {}
    const float* cf; bf16_t* KT; bf16_t* BE;
    __device__ __forceinline__ void operator()(AccRef acc, const Unit& u, int wr, int wc, int fr, int fq) const {
        asm volatile("" : "+v"(fr), "+v"(fq));
        const int b = u.pn >> 4, ch = u.pn & 15;
        f32x4 cv[2][2][2];
#pragma unroll
        for (int ai = 0; ai < 2; ++ai)
#pragma unroll
            for (int bj = 0; bj < 2; ++bj) { const size_t tok0 = (size_t)u.pn * 256 + bj * 128 + wc * 32 + fq * 8;
                if (u.pm < 2) { const int hh = u.pm * 2 + ai; cv[ai][bj][0] = *(const f32x4*)(cf + (size_t)hh * NTOK + tok0) * RSQRT_DQK; cv[ai][bj][1] = *(const f32x4*)(cf + (size_t)hh * NTOK + tok0 + 4) * RSQRT_DQK; }
                else { cv[ai][bj][0] = (f32x4){1.f, 1.f, 1.f, 1.f}; cv[ai][bj][1] = cv[ai][bj][0]; } }
#pragma unroll
        for (int ai = 0; ai < 2; ++ai)
#pragma unroll
            for (int m = 0; m < 4; ++m) {
                const int R = u.pm * 256 + ai * 128 + wr * 64 + m * 16 + fr;
#pragma unroll
                for (int bj = 0; bj < 2; ++bj) { if (u.x2 == 2 - bj) continue;
                    const f32x4 v0 = acc[ai][bj][m][0] * cv[ai][bj][0], v1 = acc[ai][bj][m][1] * cv[ai][bj][1]; const int s0 = bj * 128 + wc * 32 + fq * 8; const size_t tok0 = (size_t)u.pn * 256 + s0; bf16_t* dst;
                    if (u.pm < 2) dst = KT + (size_t)R * NTOK + tok0;
                    else { const int eg = R - 512, hh = eg >> 8, e = eg & 255; dst = BE + ((size_t)(((b * 4 + hh) * 16 + ch) * 256 + e)) * 384 + s0; }
                    u32x4 w; w.x = cvt_pk_bf16(v0[0], v0[1]); w.y = cvt_pk_bf16(v0[2], v0[3]); w.z = cvt_pk_bf16(v1[0], v1[1]); w.w = cvt_pk_bf16(v1[2], v1[3]);
                    *(u32x4*)dst = w;
                }
            }
    }
};
struct EpiM1 {
    static constexpr bool PERM = false;
    __device__ __forceinline__ void prep(const Unit&, int, int, int) const {}
    float* UT;
    __device__ __forceinline__ void operator()(AccRef acc, const Unit& u, int wr, int wc, int fr, int fq) const {
        asm volatile("" : "+v"(fr), "+v"(fq));
#pragma unroll
        for (int ai = 0; ai < 2; ++ai)
#pragma unroll
            for (int m = 0; m < 4; ++m) { float* rowp = UT + ((size_t)u.x0 * 256 + ai * 128 + wr * 64 + m * 16 + fr) * 128 + wc * 32 + fq * 4;
#pragma unroll
                for (int n = 0; n < 2; ++n) *(f32x4*)(rowp + n * 16) = acc[ai][0][m][n]; }
    }
};
struct EpiM2A {
    static constexpr bool PERM = true;
    __device__ __forceinline__ void prep(const Unit&, int, int, int) const {}
    bf16_t* AE; const float* nprev; float* den;
    __device__ __forceinline__ void operator()(AccRef acc, const Unit& u, int wr, int wc, int fr, int fq) const {
        asm volatile("" : "+v"(fr), "+v"(fq));
        const int mu = u.x0, dd = wc * 32 + fq * 8;
        const f32x4 n0 = *(const f32x4*)(nprev + (size_t)mu * 128 + dd), n1 = *(const f32x4*)(nprev + (size_t)mu * 128 + dd + 4);
        u32x4 qv8[2][4];
#pragma unroll
        for (int ai = 0; ai < 2; ++ai)
#pragma unroll
            for (int m = 0; m < 4; ++m) qv8[ai][m] = *(const u32x4*)(AE + ((size_t)mu * 256 + ai * 128 + wr * 64 + m * 16 + fr) * 512 + 256 + dd);
#pragma unroll
        for (int ai = 0; ai < 2; ++ai)
#pragma unroll
            for (int m = 0; m < 4; ++m) {
                const int t = ai * 128 + wr * 64 + m * 16 + fr; bf16_t* rowp = AE + ((size_t)mu * 256 + t) * 512;
                const u32x4 qv = qv8[ai][m];
                float part = bflo(qv.x) * n0[0] + bfhi(qv.x) * n0[1] + bflo(qv.y) * n0[2] + bfhi(qv.y) * n0[3] + bflo(qv.z) * n1[0] + bfhi(qv.z) * n1[1] + bflo(qv.w) * n1[2] + bfhi(qv.w) * n1[3];
#pragma unroll
                for (int bj = 0; bj < 2; ++bj) { const int s0 = bj * 128 + wc * 32 + fq * 8; f32x4 v0 = acc[ai][bj][m][0], v1 = acc[ai][bj][m][1];
                    int dts = t - s0; asm volatile("" : "+v"(dts));
#pragma unroll
                    for (int j = 0; j < 4; ++j) { v0[j] = (j <= dts) ? v0[j] : 0.f; v1[j] = (4 + j <= dts) ? v1[j] : 0.f; part += v0[j] + v1[j]; }
                    u32x4 w; w.x = cvt_pk_bf16(v0[0], v0[1]); w.y = cvt_pk_bf16(v0[2], v0[3]); w.z = cvt_pk_bf16(v1[0], v1[1]); w.w = cvt_pk_bf16(v1[2], v1[3]);
                    *(u32x4*)(rowp + s0) = w; }
                part += __shfl_xor(part, 16); part += __shfl_xor(part, 32);
                if (fq == 0) atomicAdd(den + (size_t)mu * 256 + (wr * 64 + fr) + (ai * 128 + m * 16), part);
            }
    }
};
struct EpiM2B {
    static constexpr bool PERM = true;
    __device__ __forceinline__ void prep(const Unit&, int, int, int) const {}
    const float* den; const float* normg; const bf16_t* OS; bf16_t* HN; LAS float* lnx;
    __device__ __forceinline__ void operator()(AccRef acc, const Unit& u, int wr, int wc, int fr, int fq) const {
        asm volatile("" : "+v"(fr), "+v"(fq));
        const int mu = u.x0, b = mu >> 6, hh = (mu >> 4) & 3, ch = mu & 15;
        float dnv[2][4];
#pragma unroll
        for (int ai = 0; ai < 2; ++ai)
#pragma unroll
            for (int m = 0; m < 4; ++m) dnv[ai][m] = den[(size_t)mu * 256 + ai * 128 + wr * 64 + m * 16 + fr];
#pragma unroll
        for (int ai = 0; ai < 2; ++ai)
#pragma unroll
            for (int m = 0; m < 4; ++m) {
                const int t = ai * 128 + wr * 64 + m * 16 + fr; const float dn = dnv[ai][m];
#ifdef DBG_DEN1
                const float inv = 1.0f;
#else
                const float inv = 1.0f / fmaxf(fabsf(dn), 1.0f);
#endif
                float s1 = 0.f, s2 = 0.f;
#pragma unroll
                for (int bj = 0; bj < 2; ++bj)
#pragma unroll
                    for (int n = 0; n < 2; ++n) { f32x4 h = acc[ai][bj][m][n] * inv; acc[ai][bj][m][n] = h; s1 += (h[0] + h[1]) + (h[2] + h[3]); s2 += (h[0] * h[0] + h[1] * h[1]) + (h[2] * h[2] + h[3] * h[3]); }
                s1 += __shfl_xor(s1, 16); s1 += __shfl_xor(s1, 32); s2 += __shfl_xor(s2, 16); s2 += __shfl_xor(s2, 32);
                if (fq == 0) { lnx[(t * 4 + wc) * 2] = s1; lnx[(t * 4 + wc) * 2 + 1] = s2; }
            }
        const int e0 = wc * 32 + fq * 8;
        f32x4 gg[2][2];
#pragma unroll
        for (int bj = 0; bj < 2; ++bj) { gg[bj][0] = *(const f32x4*)(normg + hh * 256 + bj * 128 + e0); gg[bj][1] = *(const f32x4*)(normg + hh * 256 + bj * 128 + e0 + 4); }
        asm volatile("s_waitcnt lgkmcnt(0)" ::: "memory"); __builtin_amdgcn_s_barrier(); asm volatile("" ::: "memory");
#pragma unroll
        for (int ai = 0; ai < 2; ++ai) {
            u32x4 ovv[4][2];
#pragma unroll
            for (int m = 0; m < 4; ++m)
#pragma unroll
                for (int bj = 0; bj < 2; ++bj) ovv[m][bj] = *(const u32x4*)(OS + (((size_t)(b * 16 + ch)) * 256 + ai * 128 + wr * 64 + m * 16 + fr) * 1024 + hh * 256 + bj * 128 + e0);
#pragma unroll
            for (int m = 0; m < 4; ++m) {
                const int t = ai * 128 + wr * 64 + m * 16 + fr; const size_t token = ((size_t)(b * 16 + ch)) * 256 + t;
                const LAS f32x4* lp = (const LAS f32x4*)(lnx + t * 8); const f32x4 a = lp[0], c = lp[1];
                const float mean = (a[0] + a[2] + c[0] + c[2]) * (1.0f / 256.0f); const float ex2 = (a[1] + a[3] + c[1] + c[3]) * (1.0f / 256.0f);
                const float rstd = 1.0f / sqrtf(fmaxf(ex2 - mean * mean, 0.f) + LN_EPS);
#pragma unroll
                for (int bj = 0; bj < 2; ++bj) { const int e = bj * 128 + e0; const size_t off = token * 1024 + hh * 256 + e; const u32x4 ov = ovv[m][bj];
#ifdef DBG_HN_OS
                    f32x4 v0 = {1.f, 1.f, 1.f, 1.f}, v1 = v0;
#elif defined(DBG_HN_RAW)
                    f32x4 v0 = acc[ai][bj][m][0], v1 = acc[ai][bj][m][1];
#else
                    f32x4 v0 = (acc[ai][bj][m][0] - mean) * rstd * gg[bj][0], v1 = (acc[ai][bj][m][1] - mean) * rstd * gg[bj][1];
#endif
#ifndef DBG_HN_ONE
                    v0[0] *= bflo(ov.x); v0[1] *= bfhi(ov.x); v0[2] *= bflo(ov.y); v0[3] *= bfhi(ov.y); v1[0] *= bflo(ov.z); v1[1] *= bfhi(ov.z); v1[2] *= bflo(ov.w); v1[3] *= bfhi(ov.w);
#endif
                    u32x4 w; w.x = cvt_pk_bf16(v0[0], v0[1]); w.y = cvt_pk_bf16(v0[2], v0[3]); w.z = cvt_pk_bf16(v1[0], v1[1]); w.w = cvt_pk_bf16(v1[2], v1[3]);
                    *(u32x4*)(HN + off) = w; }
            }
            asm volatile("" ::: "memory");
        }
        asm volatile("s_waitcnt lgkmcnt(0)" ::: "memory"); __builtin_amdgcn_s_barrier(); asm volatile("" ::: "memory");
    }
};
struct Frame {
    LAS unsigned char* lds;
    unsigned* ctl;
    unsigned char* ws;
    int tid, lane, wave, vcu, G;
};
__device__ __forceinline__ float wave_sum(float v) {
#pragma unroll
    for (int o = 1; o < 64; o <<= 1) v += __shfl_xor(v, o);
    return v;
}

__device__ __forceinline__ void tr_block(const float* src, size_t pitch, bf16_t* dst, size_t kd, int kb, int nb, LAS unsigned* scr, int lane) {
    const float* s0 = src + (size_t)(64 * kb) * pitch + 64 * nb + 4 * (lane & 15);
#pragma unroll
    for (int i = 0; i < 8; ++i) {
        const int kp = 4 * i + (lane >> 4);
        const f32x4 a = __builtin_nontemporal_load((const f32x4*)(s0 + (size_t)(2 * kp) * pitch)), b = __builtin_nontemporal_load((const f32x4*)(s0 + (size_t)(2 * kp + 1) * pitch));
#pragma unroll
        for (int j = 0; j < 4; ++j) scr[(4 * (lane & 15) + j) * 33 + kp] = cvt_pk_bf16(a[j], b[j]);
    }
    LDS_WAIT(); asm volatile("" ::: "memory");
    u32x4 o[8];
#pragma unroll
    for (int c = 0; c < 8; ++c) { const int rr = 8 * c + (lane >> 3), q4 = 4 * (lane & 7); o[c].x = scr[rr * 33 + q4]; o[c].y = scr[rr * 33 + q4 + 1]; o[c].z = scr[rr * 33 + q4 + 2]; o[c].w = scr[rr * 33 + q4 + 3]; }
    bf16_t* d = dst + (size_t)(64 * nb + (lane >> 3)) * kd + 64 * kb + 8 * (lane & 7);
#pragma unroll
    for (int c = 0; c < 8; ++c) *(u32x4*)(d + (size_t)(8 * c) * kd) = o[c];
    LDS_WAIT(); asm volatile("" ::: "memory");
}
__device__ __forceinline__ void tr_block8(const float* src, size_t pitch, unsigned char* dst, size_t kd, int kb, int nb, float scale, LAS unsigned* scr, int lane) {
    const float* s0 = src + (size_t)(128 * kb) * pitch + 64 * nb + 4 * (lane & 15);
#pragma unroll
    for (int i = 0; i < 8; ++i) {
        const int kq = 4 * i + (lane >> 4);
        const f32x4 r0 = __builtin_nontemporal_load((const f32x4*)(s0 + (size_t)(4 * kq) * pitch)) * scale, r1 = __builtin_nontemporal_load((const f32x4*)(s0 + (size_t)(4 * kq + 1) * pitch)) * scale,
                    r2 = __builtin_nontemporal_load((const f32x4*)(s0 + (size_t)(4 * kq + 2) * pitch)) * scale, r3 = __builtin_nontemporal_load((const f32x4*)(s0 + (size_t)(4 * kq + 3) * pitch)) * scale;
#pragma unroll
        for (int j = 0; j < 4; ++j) { int w = __builtin_amdgcn_cvt_pk_fp8_f32(r0[j], r1[j], 0, false); w = __builtin_amdgcn_cvt_pk_fp8_f32(r2[j], r3[j], w, true); scr[(4 * (lane & 15) + j) * 33 + kq] = (unsigned)w; }
    }
    LDS_WAIT(); asm volatile("" ::: "memory");
    u32x4 o[8];
#pragma unroll
    for (int c = 0; c < 8; ++c) { const int rr = 8 * c + (lane >> 3), q4 = 4 * (lane & 7); o[c].x = scr[rr * 33 + q4]; o[c].y = scr[rr * 33 + q4 + 1]; o[c].z = scr[rr * 33 + q4 + 2]; o[c].w = scr[rr * 33 + q4 + 3]; }
    unsigned char* d = dst + (size_t)(64 * nb + (lane >> 3)) * kd + 128 * kb + 16 * (lane & 7);
#pragma unroll
    for (int c = 0; c < 8; ++c) *(u32x4*)(d + (size_t)(8 * c) * kd) = o[c];
    LDS_WAIT(); asm volatile("" ::: "memory");
}
constexpr int CONV_ITEMS = 24576;
struct ConvItem { const float* s0; size_t pitch; unsigned char* d; float scale; };
__device__ __forceinline__ ConvItem conv_desc(const float* wgu, const float* wd, unsigned char* ws, int v, int lane) {
    const int layer = v >= 12288; int r = v - layer * 12288; ConvItem it;
    if (r < 8192) { const int mat = layer * 32 + (r >> 8); r &= 255; const int kb = r >> 5, nb = r & 31; it.pitch = 2048; it.scale = FP8_SWGU;
        it.s0 = wgu + (size_t)mat * 1024 * 2048 + (size_t)(128 * kb) * 2048 + 64 * nb + 4 * (lane & 15); it.d = ws + WS_WGU + (size_t)mat * 2048 * 1024 + (size_t)(64 * nb + (lane >> 3)) * 1024 + 128 * kb + 16 * (lane & 7); }
    else { r -= 8192; const int mat = layer * 32 + (r >> 7); r &= 127; const int kb = r >> 4, nb = r & 15; it.pitch = 1024; it.scale = FP8_SWD;
        it.s0 = wd + (size_t)mat * 1024 * 1024 + (size_t)(128 * kb) * 1024 + 64 * nb + 4 * (lane & 15); it.d = ws + WS_WD + (size_t)mat * 1024 * 1024 + (size_t)(64 * nb + (lane >> 3)) * 1024 + 128 * kb + 16 * (lane & 7); }
    return it;
}
__device__ __forceinline__ void conv_items(Frame& F, const float* wgu, const float* wd, int v_lo, int v_hi, int cw, int ncw) {
    LAS unsigned* scr = (LAS unsigned*)(F.lds + RING_OFF + F.wave * 8448); unsigned char* ws = F.ws; const int lane = F.lane;
    int v = v_lo + cw; if (v >= v_hi) return;
    ConvItem cur = conv_desc(wgu, wd, ws, v, lane);
    f32x4 r[8][4];
#pragma unroll
    for (int i = 0; i < 8; ++i) { const int kq = 4 * i + (lane >> 4);
#pragma unroll
        for (int q = 0; q < 4; ++q) r[i][q] = __builtin_nontemporal_load((const f32x4*)(cur.s0 + (size_t)(4 * kq + q) * cur.pitch)); }
    for (;;) {
        const int vn = v + ncw; const bool has = vn < v_hi; ConvItem nx = cur; if (has) nx = conv_desc(wgu, wd, ws, vn, lane);
#pragma unroll
        for (int i = 0; i < 8; ++i) { const int kq = 4 * i + (lane >> 4);
#pragma unroll
            for (int j = 0; j < 4; ++j) { int w = __builtin_amdgcn_cvt_pk_fp8_f32(r[i][0][j] * cur.scale, r[i][1][j] * cur.scale, 0, false); w = __builtin_amdgcn_cvt_pk_fp8_f32(r[i][2][j] * cur.scale, r[i][3][j] * cur.scale, w, true); scr[(4 * (lane & 15) + j) * 33 + kq] = (unsigned)w; }
            if (has) {
#pragma unroll
                for (int q = 0; q < 4; ++q) r[i][q] = __builtin_nontemporal_load((const f32x4*)(nx.s0 + (size_t)(4 * kq + q) * nx.pitch)); } }
        LDS_WAIT(); asm volatile("" ::: "memory");
        u32x4 o[8];
#pragma unroll
        for (int c = 0; c < 8; ++c) { const int rr = 8 * c + (lane >> 3), q4 = 4 * (lane & 7); o[c].x = scr[rr * 33 + q4]; o[c].y = scr[rr * 33 + q4 + 1]; o[c].z = scr[rr * 33 + q4 + 2]; o[c].w = scr[rr * 33 + q4 + 3]; }
#pragma unroll
        for (int c = 0; c < 8; ++c) *(u32x4*)(cur.d + (size_t)(8 * c) * 1024) = o[c];
        LDS_WAIT(); asm volatile("" ::: "memory");
        if (!has) break;
        v = vn; cur = nx;
    }
}
struct P0In { const float *x, *wqkv, *wo, *win, *wout, *rw, *wgu, *wd; const int* pos; };
__device__ __forceinline__ void p0_prologue(Frame& F, const P0In& I) {
    LAS unsigned* scr = (LAS unsigned*)(F.lds + RING_OFF + F.wave * 8448);
    const int gw = F.vcu * NWAVES + F.wave, NGW = F.G * NWAVES;
    unsigned char* ws = F.ws;
    constexpr int KB = 16;
    constexpr int I_QKV = KB * 48, I_WO = KB * 16, I_INA1 = KB * 16, I_INA2 = KB * 16, I_INB = KB * 24, I_WOUT = KB * 16;
    constexpr int I_SMALL = I_QKV + I_WO + I_INA1 + I_INA2 + I_INB + I_WOUT;
    constexpr int NITEMS = I_SMALL;
    for (int it = gw; it < NITEMS; it += NGW) {
        int r = it; const float* src; size_t pitch; bf16_t* dst; int nbl;
        if (r < I_QKV) { src = I.wqkv; pitch = 3072; dst = (bf16_t*)(ws + WS_WQKV); nbl = 48; }
        else if ((r -= I_QKV) < I_WO) { src = I.wo; pitch = 1024; dst = (bf16_t*)(ws + WS_WO); nbl = 16; }
        else if ((r -= I_WO) < I_INA1) { src = I.win; pitch = 3080; dst = (bf16_t*)(ws + WS_WINA); nbl = 16; }
        else if ((r -= I_INA1) < I_INA2) { src = I.win + 2048; pitch = 3080; dst = (bf16_t*)(ws + WS_WINA) + (size_t)1024 * 1024; nbl = 16; }
        else if ((r -= I_INA2) < I_INB) { src = I.win + 512; pitch = 3080; dst = (bf16_t*)(ws + WS_WINB); nbl = 24; }
        else { r -= I_INB; src = I.wout; pitch = 1024; dst = (bf16_t*)(ws + WS_WOUT); nbl = 16; }
        tr_block(src, pitch, dst, 1024, r / nbl, r % nbl, scr, F.lane);
    }
    if (NCONV == 0) conv_items(F, I.wgu, I.wd, 0, CONV_ITEMS, gw, NGW);
    const int gt = F.vcu * NTHR + F.tid, NGT = F.G * NTHR;
    for (int i = gt; i < NTOK * DM / 8; i += NGT) { const f32x4 a = ((const f32x4*)I.x)[2 * i], b = ((const f32x4*)I.x)[2 * i + 1];
        u32x4 w; w.x = cvt_pk_bf16(a[0], a[1]); w.y = cvt_pk_bf16(a[2], a[3]); w.z = cvt_pk_bf16(b[0], b[1]); w.w = cvt_pk_bf16(b[2], b[3]); ((u32x4*)(ws + WS_XB))[i] = w; }
    for (int i = gt; i < NTOK * 8; i += NGT) { const int tok = i >> 3, f = i & 7; const float inv = powf(500000.0f, -(float)f * 0.125f); const float ang = (float)I.pos[tok] * inv;
        float sn, cs; sincosf(ang, &sn, &cs); float* rp = (float*)(ws + WS_ROPE) + (size_t)tok * 16; rp[f] = cs; rp[8 + f] = sn; }
    for (int i = gt; i < 2 * 32 * 1024; i += NGT) { const int l = i >> 15, e = (i >> 10) & 31, k = i & 1023; ((float*)(ws + WS_RWT))[i] = I.rw[((size_t)l * 1024 + k) * 32 + e]; }
    for (int i = gt; i < 8 * 1024; i += NGT) { const int gidx = i >> 10, k = i & 1023; ((float*)(ws + WS_WG))[i] = I.win[(size_t)k * 3080 + 3072 + gidx]; }
}

__device__ __forceinline__ void phase_ln_router(Frame& F, const float* __restrict__ z, float* __restrict__ x1, const float* lng, const float* lnb, const float* rbias, int layer, int cset) {
    unsigned char* ws = F.ws;
    LAS f32x4* rwv = (LAS f32x4*)(F.lds + RING_OFF);
    LAS int* lcnt = (LAS int*)(F.lds + LX_LCNT); LAS int* gbase = (LAS int*)(F.lds + LX_GBASE); LAS int* rec = (LAS int*)(F.lds + LX_REC);
    LAS float* lgb = (LAS float*)(F.lds + LX_LNX);
    { const f32x4* src = (const f32x4*)((const float*)(ws + WS_RWT) + (size_t)layer * 32768);
      for (int i = F.tid; i < 8192; i += NTHR) { const int e = i >> 8, c = i & 255; rwv[e * 256 + (c ^ (e & 15))] = src[i]; } }
    int* toke = (int*)(ws + WS_TOKE); int* tokp = (int*)(ws + WS_TOKP); float* tokg = (float*)(ws + WS_TOKG);
    unsigned short* rowtok = (unsigned short*)(ws + WS_ROWTOK); unsigned char* xb8 = (unsigned char*)(ws + WS_XB);
    unsigned* cntg = F.ctl + CW_CNT + cset * 2048;
    const int lane = F.lane;
    for (int grp = F.vcu; grp < NTOK / 64; grp += F.G) {
        if (F.tid < 32) lcnt[F.tid] = 0;
        for (int i = F.tid; i < 1024; i += NTHR) { lgb[i] = lng[i]; lgb[1024 + i] = lnb[i]; }
        __syncthreads();
#pragma unroll 2
        for (int tk = 0; tk < 8; tk += 2) {
            const int token0 = grp * 64 + F.wave * 8 + tk;
            f32x4 v[2][4]; float s[2] = {0.f, 0.f};
#pragma unroll
            for (int u = 0; u < 2; ++u)
#pragma unroll
                for (int j = 0; j < 4; ++j) { v[u][j] = *(const f32x4*)(z + (size_t)(token0 + u) * DM + 4 * lane + 256 * j); s[u] += (v[u][j][0] + v[u][j][1]) + (v[u][j][2] + v[u][j][3]); }
#pragma unroll
            for (int o = 1; o < 64; o <<= 1) { const float a0 = __shfl_xor(s[0], o), a1 = __shfl_xor(s[1], o); s[0] += a0; s[1] += a1; }
            float s2[2] = {0.f, 0.f};
#pragma unroll
            for (int u = 0; u < 2; ++u) { const float mean = s[u] * (1.0f / DM);
#pragma unroll
                for (int j = 0; j < 4; ++j) { v[u][j] = v[u][j] - mean; s2[u] += (v[u][j][0] * v[u][j][0] + v[u][j][1] * v[u][j][1]) + (v[u][j][2] * v[u][j][2] + v[u][j][3] * v[u][j][3]); } }
#pragma unroll
            for (int o = 1; o < 64; o <<= 1) { const float a0 = __shfl_xor(s2[0], o), a1 = __shfl_xor(s2[1], o); s2[0] += a0; s2[1] += a1; }
#pragma unroll
            for (int u = 0; u < 2; ++u) { const float rstd = 1.0f / sqrtf(s2[u] * (1.0f / DM) + LN_EPS); const int token = token0 + u;
#pragma unroll
                for (int j = 0; j < 4; ++j) { const f32x4 gvj = *(const LAS f32x4*)(lgb + 4 * lane + 256 * j), bvj = *(const LAS f32x4*)(lgb + 1024 + 4 * lane + 256 * j);
                    const f32x4 y = v[u][j] * rstd * gvj + bvj; *(f32x4*)(x1 + (size_t)token * DM + 4 * lane + 256 * j) = y;
                    int w8 = __builtin_amdgcn_cvt_pk_fp8_f32(y[0] * FP8_SA, y[1] * FP8_SA, 0, false); w8 = __builtin_amdgcn_cvt_pk_fp8_f32(y[2] * FP8_SA, y[3] * FP8_SA, w8, true);
                    *(int*)(xb8 + (size_t)token * DM + 4 * lane + 256 * j) = w8; } }
        }
        VM_WAIT(); __syncthreads();
        const int tg = F.wave & 3, kh = F.wave >> 2, e0 = lane & 15, kq = lane >> 4;
        f32x4 acc0 = {0.f, 0.f, 0.f, 0.f}, acc1 = acc0;
        { const float* arow = x1 + (size_t)(grp * 64 + tg * 16 + e0) * DM + kh * 512 + 4 * kq;
#pragma unroll 4
          for (int blk = 0; blk < 32; ++blk) {
              const f32x4 a4 = *(const f32x4*)(arow + blk * 16); const int c = ((kh * 512 + blk * 16) >> 2) + kq;
              const f32x4 b0 = rwv[e0 * 256 + (c ^ e0)], b1 = rwv[(16 + e0) * 256 + (c ^ e0)];
#pragma unroll
              for (int j = 0; j < 4; ++j) { acc0 = __builtin_amdgcn_mfma_f32_16x16x4f32(a4[j], b0[j], acc0, 0, 0, 0); acc1 = __builtin_amdgcn_mfma_f32_16x16x4f32(a4[j], b1[j], acc1, 0, 0, 0); } } }
        __syncthreads();
        if (kh == 1) { ((LAS f32x4*)lgb)[(tg * 2 + 0) * 64 + lane] = acc0; ((LAS f32x4*)lgb)[(tg * 2 + 1) * 64 + lane] = acc1; }
        __syncthreads();
        if (kh == 0) {
            acc0 = acc0 + ((LAS f32x4*)lgb)[(tg * 2 + 0) * 64 + lane]; acc1 = acc1 + ((LAS f32x4*)lgb)[(tg * 2 + 1) * 64 + lane];
            const float rb0 = rbias[e0], rb1 = rbias[16 + e0];
#pragma unroll
            for (int r = 0; r < 4; ++r) {
                float l0 = acc0[r] + rb0, l1 = acc1[r] + rb1; float tv[4]; int te[4];
#pragma unroll
                for (int k = 0; k < 4; ++k) { float bvv = (l1 > l0) ? l1 : l0; int be = (l1 > l0) ? 16 + e0 : e0;
#pragma unroll
                    for (int o = 1; o < 16; o <<= 1) { const float ov = __shfl_xor(bvv, o); const int oe = __shfl_xor(be, o); const bool take = (ov > bvv) || (ov == bvv && oe < be); bvv = take ? ov : bvv; be = take ? oe : be; }
                    tv[k] = bvv; te[k] = be; if (be == e0) l0 = -INFINITY; if (be == 16 + e0) l1 = -INFINITY; }
                const float w0 = 1.0f, w1 = __expf(tv[1] - tv[0]), w2 = __expf(tv[2] - tv[0]), w3 = __expf(tv[3] - tv[0]); const float wi = 1.0f / (w0 + w1 + w2 + w3);
                if (e0 < 4) {
                    const int tl = tg * 16 + 4 * kq + r, token = grp * 64 + tl;
                    const int ek = (e0 == 0) ? te[0] : (e0 == 1) ? te[1] : (e0 == 2) ? te[2] : te[3];
                    const float wk = (e0 == 0) ? w0 : (e0 == 1) ? w1 : (e0 == 2) ? w2 : w3;
                    const int li = atomicAdd((int*)(lcnt + ek), 1); rec[tl * 8 + e0] = ek; rec[tl * 8 + 4 + e0] = li;
                    toke[token * 4 + e0] = ek; tokg[token * 4 + e0] = wk * wi;
                }
            }
        }
        __syncthreads();
        if (F.tid < 32) gbase[F.tid] = (int)__hip_atomic_fetch_add(cntg + F.tid * 64, (unsigned)lcnt[F.tid], RLX_AGENT);
        __syncthreads();
        if (F.tid < 256) { const int tl = F.tid >> 2, k = F.tid & 3; const int token = grp * 64 + tl; const int e = rec[tl * 8 + k]; const int pos = gbase[e] + rec[tl * 8 + 4 + k];
            tokp[token * 4 + k] = pos; rowtok[(size_t)e * NTOK + pos] = (unsigned short)token; }
        __syncthreads();
    }
}

__device__ __forceinline__ int moe_tables(Frame& F, int layer) {
    LAS int* tile_e = (LAS int*)(F.lds + LX_TILEE); LAS int* tbase = (LAS int*)(F.lds + LX_TBASE);
    if (F.tid < 64) {
        const int e = F.lane & 31; const int c = (int)__hip_atomic_load(F.ctl + CW_CNT + layer * 2048 + e * 64, RLX_AGENT); const int nt = (F.lane < 32) ? ((c + 255) >> 8) : 0;
        int inc = nt;
#pragma unroll
        for (int o = 1; o < 32; o <<= 1) { const int up = __shfl_up(inc, o); if (F.lane >= o) inc += up; }
        const int t0 = inc - nt;
        if (F.lane < 32) { tbase[e] = t0; for (int i = 0; i < nt; ++i) tile_e[t0 + i] = e; }
        if (F.lane == 31) tbase[32] = inc;
    }
    __syncthreads();
    return tbase[32];
}

template <bool NEXT_MLSTM>
__device__ __forceinline__ void phase_combine(Frame& F, const float* __restrict__ x1, float* __restrict__ out, const float* lng, const float* lnb, const float* bgates, int layer) {
    unsigned char* ws = F.ws;
    (void)moe_tables(F, layer);
    const LAS int* tbase = (const LAS int*)(F.lds + LX_TBASE);
    const int* toke = (const int*)(ws + WS_TOKE); const int* tokp = (const int*)(ws + WS_TOKP); const float* tokg = (const float*)(ws + WS_TOKG);
    const bf16_t* Y = (const bf16_t*)(ws + WS_Y); bf16_t* xb = (bf16_t*)(ws + WS_XB);
    LAS float* wg = (LAS float*)(F.lds + RING_OFF);
    if constexpr (NEXT_MLSTM) { const f32x4* src = (const f32x4*)(ws + WS_WG); for (int i = F.tid; i < 2048; i += NTHR) ((LAS f32x4*)wg)[i] = src[i]; __syncthreads(); }
    const int lane = F.lane; const int gw = F.vcu * NWAVES + F.wave, NGW = F.G * NWAVES;
    f32x4 gv[4], bv[4];
#pragma unroll
    for (int j = 0; j < 4; ++j) { gv[j] = *(const f32x4*)(lng + 4 * lane + 256 * j); bv[j] = *(const f32x4*)(lnb + 4 * lane + 256 * j); }
    constexpr int NTK = NEXT_MLSTM ? 1 : 2;
    for (int token0 = gw; token0 < NTOK; token0 += NTK * NGW) {
        f32x4 vv[NTK][4];
#pragma unroll
        for (int u = 0; u < NTK; ++u) { const int token = token0 + u * NGW; if (token < NTOK) {
#pragma unroll
            for (int j = 0; j < 4; ++j) vv[u][j] = *(const f32x4*)(x1 + (size_t)token * DM + 4 * lane + 256 * j) * ALPHA;
#pragma unroll
            for (int k = 0; k < 4; ++k) { const int e = toke[token * 4 + k]; const size_t row = (size_t)tbase[e] * 256 + tokp[token * 4 + k]; const float gt = tokg[token * 4 + k] * DBG_MOE_MUL;
#pragma unroll
                for (int j = 0; j < 4; ++j) { const u32x2 y = *(const u32x2*)(Y + row * DM + 4 * lane + 256 * j); vv[u][j][0] += gt * bflo(y.x); vv[u][j][1] += gt * bfhi(y.x); vv[u][j][2] += gt * bflo(y.y); vv[u][j][3] += gt * bfhi(y.y); } } } }
#pragma unroll
        for (int u = 0; u < NTK; ++u) { const int token = token0 + u * NGW; if (token < NTOK) {
        f32x4 v[4];
#pragma unroll
        for (int j = 0; j < 4; ++j) v[j] = vv[u][j];
        float s = 0.f;
#pragma unroll
        for (int j = 0; j < 4; ++j) s += (v[j][0] + v[j][1]) + (v[j][2] + v[j][3]);
        const float mean = wave_sum(s) * (1.0f / DM); float s2 = 0.f;
#pragma unroll
        for (int j = 0; j < 4; ++j) { v[j] = v[j] - mean; s2 += (v[j][0] * v[j][0] + v[j][1] * v[j][1]) + (v[j][2] * v[j][2] + v[j][3] * v[j][3]); }
        const float rstd = 1.0f / sqrtf(wave_sum(s2) * (1.0f / DM) + LN_EPS);
#pragma unroll
        for (int j = 0; j < 4; ++j) { v[j] = v[j] * rstd * gv[j] + bv[j]; *(f32x4*)(out + (size_t)token * DM + 4 * lane + 256 * j) = v[j]; }
        if constexpr (NEXT_MLSTM) {
#pragma unroll
            for (int j = 0; j < 4; ++j) { u32x2 w; w.x = cvt_pk_bf16(v[j][0], v[j][1]); w.y = cvt_pk_bf16(v[j][2], v[j][3]); *(u32x2*)(xb + (size_t)token * DM + 4 * lane + 256 * j) = w; }
            float gp[8];
#pragma unroll
            for (int gi = 0; gi < 8; ++gi) { float a = 0.f;
#pragma unroll
                for (int j = 0; j < 4; ++j) { const f32x4 w = *(const LAS f32x4*)(wg + gi * 1024 + 4 * lane + 256 * j); a += (v[j][0] * w[0] + v[j][1] * w[1]) + (v[j][2] * w[2] + v[j][3] * w[3]); }
                gp[gi] = a; }
#pragma unroll
            for (int o = 1; o < 64; o <<= 1) {
#pragma unroll
                for (int gi = 0; gi < 8; ++gi) gp[gi] += __shfl_xor(gp[gi], o); }
#pragma unroll
            for (int gi = 0; gi < 8; ++gi) gp[gi] += bgates[gi];
            if (lane == 0) {
#pragma unroll
                for (int hh = 0; hh < 4; ++hh) { ((float*)(ws + WS_GI))[(size_t)hh * NTOK + token] = gp[hh];
                    const float f = gp[4 + hh]; const float lf = (f >= 0.f) ? -log1pf(__expf(-f)) : (f - log1pf(__expf(f)));
                    ((float*)(ws + WS_LF))[(size_t)hh * NTOK + token] = lf; } }
        }
        } }
    }
}

__device__ __forceinline__ void phase_gate_scan(Frame& F) {
    unsigned char* ws = F.ws; const int lane = F.lane; const int gw = F.vcu * NWAVES + F.wave, NGW = F.G * NWAVES;
    for (int mu = gw; mu < 256; mu += NGW) {
        const int b = mu >> 6, hh = (mu >> 4) & 3, ch = mu & 15; const size_t base = (size_t)hh * NTOK + (size_t)b * SEQ + ch * 256 + 4 * lane;
        const f32x4 lf = *(const f32x4*)((const float*)(ws + WS_LF) + base), gi = *(const f32x4*)((const float*)(ws + WS_GI) + base);
        f32x4 c; c[0] = lf[0]; c[1] = c[0] + lf[1]; c[2] = c[1] + lf[2]; c[3] = c[2] + lf[3];
        float tot = c[3];
#pragma unroll
        for (int o = 1; o < 64; o <<= 1) { const float up = __shfl_up(tot, o); if (lane >= o) tot += up; }
        const float excl = tot - c[3];
        f32x4 rf, cf;
#pragma unroll
        for (int j = 0; j < 4; ++j) { const float bt = excl + c[j]; rf[j] = __expf(bt); cf[j] = __expf(gi[j] - bt); }
        *(f32x4*)((float*)(ws + WS_RF) + base) = rf; *(f32x4*)((float*)(ws + WS_CF) + base) = cf;
        if (lane == 63) ((float*)(ws + WS_DEC))[mu] = __expf(tot);
    }
}
__device__ __forceinline__ void phase_nu(Frame& F) {
    unsigned char* ws = F.ws; const int lane = F.lane; const int gw = F.vcu * NWAVES + F.wave, NGW = F.G * NWAVES;
    const bf16_t* KT = (const bf16_t*)(ws + WS_KT); float* NU = (float*)(ws + WS_NU);
    for (int r0 = gw * 16; r0 < 256 * 128; r0 += NGW * 16) {
        const int mu = r0 >> 7, d0 = r0 & 127, b = mu >> 6, hh = (mu >> 4) & 3, ch = mu & 15;
        const bf16_t* base = KT + (size_t)(hh * 128 + d0) * NTOK + (size_t)b * SEQ + ch * 256 + 4 * lane;
        u32x2 kv[16];
#pragma unroll
        for (int i = 0; i < 16; ++i) kv[i] = *(const u32x2*)(base + (size_t)i * NTOK);
        float s[16];
#pragma unroll
        for (int i = 0; i < 16; ++i) s[i] = (bflo(kv[i].x) + bfhi(kv[i].x)) + (bflo(kv[i].y) + bfhi(kv[i].y));
#pragma unroll
        for (int o = 1; o < 64; o <<= 1) {
#pragma unroll
            for (int i = 0; i < 16; ++i) s[i] += __shfl_xor(s[i], o); }
        float mine = s[0];
#pragma unroll
        for (int i = 1; i < 16; ++i) mine = (lane == i) ? s[i] : mine;
        if (lane < 16) NU[r0 + lane] = mine;
    }
}
__device__ __forceinline__ void phase_state_scan(Frame& F) {
    unsigned char* ws = F.ws; const int gt = F.vcu * NTHR + F.tid, NGT = F.G * NTHR;
    const float* UT = (const float*)(ws + WS_UT); const float* DEC = (const float*)(ws + WS_DEC); bf16_t* BE = (bf16_t*)(ws + WS_BE);
    for (int i = gt; i < 16 * 256 * 32; i += NGT) { const int bh = i >> 13, e = (i >> 5) & 255, dg = i & 31;
        f32x4 U[16]; float dc[16];
#pragma unroll
        for (int ch = 0; ch < 16; ++ch) { const size_t mu = (size_t)bh * 16 + ch; U[ch] = *(const f32x4*)(UT + (mu * 256 + e) * 128 + 4 * dg); dc[ch] = DEC[mu]; }
        f32x4 C = {0.f, 0.f, 0.f, 0.f};
#pragma unroll
        for (int ch = 0; ch < 16; ++ch) { const size_t mu = (size_t)bh * 16 + ch;
            u32x2 w; w.x = cvt_pk_bf16(C[0], C[1]); w.y = cvt_pk_bf16(C[2], C[3]);
#ifdef DBG_NO_INTER
            w.x = 0u; w.y = 0u;
#endif
            *(u32x2*)(BE + (mu * 256 + e) * 384 + 256 + 4 * dg) = w;
            C = (C + U[ch]) * dc[ch]; } }
    const float* NU = (const float*)(ws + WS_NU); float* NP = (float*)(ws + WS_NPREV);
    for (int i = gt; i < 16 * 128; i += NGT) { const int bh = i >> 7, d = i & 127; float n = 0.f;
        for (int ch = 0; ch < 16; ++ch) { const int mu = bh * 16 + ch; NP[mu * 128 + d] = n; n = (n + NU[mu * 128 + d]) * DEC[mu];
#ifdef DBG_NO_INTER
            n = 0.f;
#endif
        } }
}
struct Args { const float* in[18]; float* out; unsigned char* ws; int ph_lo, ph_hi; };
__global__ void __launch_bounds__(NTHR, 2) mk_fwd(Args args) {
    extern __shared__ __attribute__((aligned(16))) unsigned char lds[];
    Frame F;
    const char __attribute__((address_space(4)))* kargp = (const char __attribute__((address_space(4)))*)__builtin_amdgcn_kernarg_segment_ptr();
#define AIN(i) ({ const char __attribute__((address_space(4)))* k_ = kargp; asm volatile("" : "+s"(k_)); *(const float* const __attribute__((address_space(4)))*)(k_ + 8 * (i)); })
    unsigned char* const ws0 = (unsigned char*)AIN(19);
    F.lds = (LAS unsigned char*)lds; F.ws = ws0; F.ctl = (unsigned*)(ws0 + WS_CTL);
    F.tid = threadIdx.x; F.lane = F.tid & 63; F.wave = __builtin_amdgcn_readfirstlane(F.tid >> 6);
    F.G = gridDim.x; { const int bx = blockIdx.x; F.vcu = (F.G % 8 == 0) ? (bx % 8) * (F.G / 8) + bx / 8 : bx; }
    for (int u = F.tid; u < (LDS_BYTES - LX) / 4; u += NTHR) ((LAS unsigned*)(F.lds + LX))[u] = 0u;
    __syncthreads();
    int lo, hi; { const char __attribute__((address_space(4)))* k_ = kargp; lo = *(const int __attribute__((address_space(4)))*)(k_ + 160); hi = *(const int __attribute__((address_space(4)))*)(k_ + 164); }
    XcdBarrier bar; bar.bar = (unsigned*)(F.ctl + CW_BAR); bar.x = 0; bar.st = nullptr;
    if (hi - lo > 1) bar = xcd_barrier_post((unsigned*)(F.ctl + CW_BAR), (volatile LAS unsigned*)(F.lds + LX_MISC) + 8);
#ifndef PHASE_MASK
#define PHASE_MASK 0x7FFFF
#endif
#define IN(k) ((((PHASE_MASK) >> (k)) & 1) && lo <= (k) && (k) < hi)
#ifndef REPEAT_MASK
#define REPEAT_MASK 0
#endif
#define PH(k) if (IN(k))
#define SEAM(k) do { if (IN(k) && IN((k) + 1)) xcd_barrier(bar); } while (0)
    unsigned char* ws = ws0;
#define x_in AIN(0)
#define ln_mix_g AIN(8)
#define ln_mix_b AIN(9)
#define ln_ffn_g AIN(10)
#define ln_ffn_b AIN(11)
#define router_b AIN(13)
#define b_gu AIN(15)
#define b_dn AIN(17)
    bf16_t* XB = (bf16_t*)(ws + WS_XB); bf16_t* QB_ = (bf16_t*)(ws + WS_Q); bf16_t* KB_ = (bf16_t*)(ws + WS_K); bf16_t* VB_ = (bf16_t*)(ws + WS_V);
    float* R0 = (float*)(ws + WS_R0); float* R1 = (float*)(ws + WS_R1); float* R2 = (float*)(ws + WS_R2);
    bf16_t* HB = (bf16_t*)(ws + WS_H); bf16_t* YB = (bf16_t*)(ws + WS_Y);
    LAS unsigned char* ring = F.lds + RING_OFF;
    const int cG = (int)blockIdx.x;
    const bool isConv = (NCONV > 0) && ((int)blockIdx.x >= F.G - NCONV);
    const int Gc = F.G - NCONV, cwv = ((int)blockIdx.x - Gc) * NWAVES + F.wave, ncw = NCONV * NWAVES;
#define CONV_SLICE(a, b) conv_items(F, AIN(14), AIN(16), (int)((long)CONV_ITEMS * (a) / 1000), (int)((long)CONV_ITEMS * (b) / 1000), cwv, ncw)

    PH(0) { P0In I{x_in, AIN(2), AIN(3), AIN(4), AIN(7), AIN(12), AIN(14), AIN(16), (const int*)AIN(1)}; p0_prologue(F, I); }
    SEAM(0);
    PH(1) { { Gemm g{1024, 1024, 1024, nullptr}; DenseSched S{64, 12, F.G, cG, (const char*)XB, (const char*)(ws + WS_WQKV), (size_t)256 * 1024 * 2, (size_t)256 * 1024 * 2};
        EpiQKV E{QB_, KB_, VB_, (const float*)(ws + WS_ROPE), (float*)(ws + WS_KSUM)};
        pg8::gemm_phase<EpiQKV, DenseSched, true, false>(ring, g, S, E); } }
    SEAM(1);
    PH(2) { if (isConv) CONV_SLICE(0, 1000); else {
        const attn_body::AttnTensors AT{(const attn_body::bf16*)QB_, (const attn_body::bf16*)KB_, (const attn_body::bf16*)VB_, (attn_body::bf16*)QB_, (const float*)(ws + WS_KSUM)};
        if (NCONV == 0) { const attn_body::StaticOrder S((int)F.G, (int)blockIdx.x); attn_body::attn_phase<attn_body::StaticOrder>((char*)lds + RING_OFF, AT, S); }
        else { const attn_body::SnakeOrder S{cG, Gc}; attn_body::attn_phase<attn_body::SnakeOrder>((char*)lds + RING_OFF, AT, S); } } }
    SEAM(2);
    PH(3) { { Gemm g{1024, 1024, 1024, nullptr}; DenseSched S{64, 4, F.G, cG, (const char*)QB_, (const char*)(ws + WS_WO), (size_t)256 * 1024 * 2, (size_t)256 * 1024 * 2};
        EpiZ E{x_in, R0, DBG_ATTN_MUL}; pg8::gemm_phase<EpiZ, DenseSched, true, false>(ring, g, S, E); } }
    SEAM(3);
    PH(4) phase_ln_router(F, R0, R1, ln_mix_g, ln_mix_b, router_b, 0, 0);
    SEAM(4);
    PH(5) { const int nT = moe_tables(F, 0); LAS unsigned short* tokl = (LAS unsigned short*)(F.lds + LX_TOKL);
        { const unsigned short* rowtok = (const unsigned short*)(ws + WS_ROWTOK); const LAS int* tile_e = (const LAS int*)(F.lds + LX_TILEE); const LAS int* tbase = (const LAS int*)(F.lds + LX_TBASE);
          for (int i = 0; i < TOKL_ROUNDS; ++i) { int pm, pn, hf; if (!moe_unit(i, F.G, cG, nT, 8, pm, pn, hf)) break;
              if (F.tid < 256) { const int e = tile_e[pm]; const int r = (pm - tbase[e]) * 256 + F.tid; const int c = (int)__hip_atomic_load(F.ctl + CW_CNT + 0 * 2048 + e * 64, RLX_AGENT);
                  tokl[i * 256 + F.tid] = (r < c) ? rowtok[(size_t)e * NTOK + r] : (unsigned short)0; } }
          __syncthreads(); }
        Gemm g{512, 512, 512, (const char*)XB};
        MoeSched S{nT, 8, F.G, cG, (const LAS int*)(F.lds + LX_TILEE), (const LAS int*)(F.lds + LX_TBASE), tokl, nullptr, (const char*)(ws + WS_WGU) + (size_t)0 * 32 * 2048 * 1024, 0, (size_t)2048 * 1024, (size_t)256 * 1024};
        EpiGU E{b_gu + (size_t)0 * 32 * 2048, (unsigned char*)HB, (LAS float*)(F.lds + LX_BIAS), 0}; pg8::gemm_phase<EpiGU, MoeSched, true, true, true, true>(ring, g, S, E); }
    SEAM(5);
    PH(6) { const int nT = moe_tables(F, 0); Gemm g{512, 512, 512, nullptr};
        MoeSched S{nT, 4, F.G, cG, (const LAS int*)(F.lds + LX_TILEE), (const LAS int*)(F.lds + LX_TBASE), nullptr, (const char*)HB, (const char*)(ws + WS_WD) + (size_t)0 * 32 * 1024 * 1024, (size_t)256 * 1024, (size_t)1024 * 1024, (size_t)256 * 1024};
        EpiDN E{b_dn + (size_t)0 * 32 * 1024, YB, (LAS float*)(F.lds + LX_BIAS), 0}; pg8::gemm_phase<EpiDN, MoeSched, true, false, true, true>(ring, g, S, E); }
    SEAM(6);
    PH(7) phase_combine<true>(F, R1, R2, ln_ffn_g, ln_ffn_b, AIN(5), 0);
    SEAM(7);
    PH(8) phase_gate_scan(F);
    SEAM(8);
    PH(9) {
        { Gemm g{1024, 1024, 1024, nullptr}; DenseSched S{64, 8, F.G, cG, (const char*)XB, (const char*)(ws + WS_WINA), (size_t)256 * 1024 * 2, (size_t)256 * 1024 * 2};
          EpiINA E{(const float*)(ws + WS_RF), (const float*)(ws + WS_CF), (bf16_t*)(ws + WS_AE), (bf16_t*)(ws + WS_KN), (bf16_t*)(ws + WS_OS)};
          pg8::gemm_phase<EpiINA, DenseSched, true, false>(ring, g, S, E); }
        { Gemm g{1024, 1024, 1024, nullptr}; DenseSched S{6, 64, F.G, cG, (const char*)(ws + WS_WINB), (const char*)XB, (size_t)256 * 1024 * 2, (size_t)256 * 1024 * 2, true};
          EpiINB E{(const float*)(ws + WS_CF), (bf16_t*)(ws + WS_KT), (bf16_t*)(ws + WS_BE)};
          pg8::gemm_phase<EpiINB, DenseSched, true, false, false, true>(ring, g, S, E); }
    }
    SEAM(9);
    PH(10) { Gemm g{256, 384, NTOK, nullptr}; MuSched S{F.G, cG, 0, (const char*)(ws + WS_BE), (const char*)(ws + WS_KT)};
        EpiM1 E{(float*)(ws + WS_UT)}; pg8::gemm_phase<EpiM1, MuSched, true, false>(ring, g, S, E);
        phase_nu(F); }
    SEAM(10);
    PH(11) phase_state_scan(F);
    SEAM(11);
    PH(12) { Gemm g{256, 512, 1024, nullptr}; MuSched S{F.G, cG, 1, (const char*)(ws + WS_AE), (const char*)(ws + WS_KN)};
        EpiM2A E{(bf16_t*)(ws + WS_AE), (const float*)(ws + WS_NPREV), (float*)(ws + WS_DEN)}; pg8::gemm_phase<EpiM2A, MuSched, true, false>(ring, g, S, E); }
    SEAM(12);
    PH(13) { Gemm g{384, 512, 384, nullptr}; MuSched S{F.G, cG, 2, (const char*)(ws + WS_AE), (const char*)(ws + WS_BE)};
        EpiM2B E{(const float*)(ws + WS_DEN), AIN(6), (const bf16_t*)(ws + WS_OS), (bf16_t*)(ws + WS_HN), (LAS float*)(F.lds + LX_LNX)};
        pg8::gemm_phase<EpiM2B, MuSched, true, false>(ring, g, S, E); }
    SEAM(13);
    PH(14) { Gemm g{1024, 1024, 1024, nullptr}; DenseSched S{64, 4, F.G, cG, (const char*)(ws + DBG_P14_A), (const char*)(ws + WS_WOUT), (size_t)256 * 1024 * 2, (size_t)256 * 1024 * 2};
        EpiZ E{R2, R0, DBG_MLSTM_MUL}; pg8::gemm_phase<EpiZ, DenseSched, true, false>(ring, g, S, E); }
    SEAM(14);
    PH(15) phase_ln_router(F, R0, R1, ln_mix_g + 1024, ln_mix_b + 1024, router_b + 32, 1, 1);
    SEAM(15);
    PH(16) { const int nT = moe_tables(F, 1); LAS unsigned short* tokl = (LAS unsigned short*)(F.lds + LX_TOKL);
        { const unsigned short* rowtok = (const unsigned short*)(ws + WS_ROWTOK); const LAS int* tile_e = (const LAS int*)(F.lds + LX_TILEE); const LAS int* tbase = (const LAS int*)(F.lds + LX_TBASE);
          for (int i = 0; i < TOKL_ROUNDS; ++i) { int pm, pn, hf; if (!moe_unit(i, F.G, cG, nT, 8, pm, pn, hf)) break;
              if (F.tid < 256) { const int e = tile_e[pm]; const int r = (pm - tbase[e]) * 256 + F.tid; const int c = (int)__hip_atomic_load(F.ctl + CW_CNT + 1 * 2048 + e * 64, RLX_AGENT);
                  tokl[i * 256 + F.tid] = (r < c) ? rowtok[(size_t)e * NTOK + r] : (unsigned short)0; } }
          __syncthreads(); }
        Gemm g{512, 512, 512, (const char*)XB};
        MoeSched S{nT, 8, F.G, cG, (const LAS int*)(F.lds + LX_TILEE), (const LAS int*)(F.lds + LX_TBASE), tokl, nullptr, (const char*)(ws + WS_WGU) + (size_t)1 * 32 * 2048 * 1024, 0, (size_t)2048 * 1024, (size_t)256 * 1024};
        EpiGU E{b_gu + (size_t)1 * 32 * 2048, (unsigned char*)HB, (LAS float*)(F.lds + LX_BIAS), 0}; pg8::gemm_phase<EpiGU, MoeSched, true, true, true, true>(ring, g, S, E); }
    SEAM(16);
    PH(17) { const int nT = moe_tables(F, 1); Gemm g{512, 512, 512, nullptr};
        MoeSched S{nT, 4, F.G, cG, (const LAS int*)(F.lds + LX_TILEE), (const LAS int*)(F.lds + LX_TBASE), nullptr, (const char*)HB, (const char*)(ws + WS_WD) + (size_t)1 * 32 * 1024 * 1024, (size_t)256 * 1024, (size_t)1024 * 1024, (size_t)256 * 1024};
        EpiDN E{b_dn + (size_t)1 * 32 * 1024, YB, (LAS float*)(F.lds + LX_BIAS), 0}; pg8::gemm_phase<EpiDN, MoeSched, true, false, true, true>(ring, g, S, E); }
    SEAM(17);
    PH(18) phase_combine<false>(F, R1, (float*)AIN(18), ln_ffn_g + 1024, ln_ffn_b + 1024, nullptr, 1);
#undef IN
#undef CONV_SLICE
#undef AIN
#undef x_in
#undef ln_mix_g
#undef ln_mix_b
#undef ln_ffn_g
#undef ln_ffn_b
#undef router_b
#undef b_gu
#undef b_dn
#undef SEAM
}

extern "C" void kernel_launch(void* const* d_in, const int* in_sizes, int n_in, void* d_out, int out_size, void* d_ws, size_t ws_size, hipStream_t stream) {
    static int grid = 0;
    if (grid == 0) {
        if (n_in != 18 || out_size != NTOK * DM || ws_size < WS_END) { fprintf(stderr, "kernel_launch: unexpected problem shape (n_in %d, out %d, ws %zu)\n", n_in, out_size, ws_size); grid = -1; return; }
        int dev = 0, cus = 0, per_cu = 0;
        if (hipGetDevice(&dev) != hipSuccess || hipDeviceGetAttribute(&cus, hipDeviceAttributeMultiprocessorCount, dev) != hipSuccess) { grid = -1; return; }
        if (hipFuncSetAttribute((const void*)mk_fwd, hipFuncAttributeMaxDynamicSharedMemorySize, LDS_BYTES) != hipSuccess) { fprintf(stderr, "kernel_launch: hipFuncSetAttribute failed\n"); grid = -1; return; }
        if (hipOccupancyMaxActiveBlocksPerMultiprocessor(&per_cu, (const void*)mk_fwd, NTHR, LDS_BYTES) != hipSuccess || per_cu < 1) fprintf(stderr, "kernel_launch: occupancy query reports %d\n", per_cu);
        (void)hipGetLastError();
        grid = cus;
        if (grid > 256) grid = 256;
        if (grid < 240) { fprintf(stderr, "kernel_launch: %d CUs: this build needs 240..256\n", cus); grid = -1; return; }
    }
    if (grid < 0) return;
    if (hipMemsetAsync((char*)d_ws + WS_CTL, 0, CTL_ZERO_BYTES, stream) != hipSuccess) return;
    Args a{};
    for (int i = 0; i < 18; ++i) a.in[i] = (const float*)d_in[i];
    a.out = (float*)d_out; a.ws = (unsigned char*)d_ws;
#if MK_ONE_LAUNCH
    a.ph_lo = 0; a.ph_hi = NPHASE;
    hipLaunchKernelGGL(mk_fwd, dim3(grid), dim3(NTHR), LDS_BYTES, stream, a);
#else
    for (int p = 0; p < NPHASE; ++p) { a.ph_lo = p; a.ph_hi = p + 1; hipLaunchKernelGGL(mk_fwd, dim3(grid), dim3(NTHR), LDS_BYTES, stream, a); }
#endif
}
```

```cpp
#include <hip/hip_runtime.h>
#include <hip/hip_bf16.h>
#include <cstdio>
#include <cstdint>
#include <cmath>

#define LAS __attribute__((address_space(3)))
#define GAS __attribute__((address_space(1)))
typedef unsigned short bf16_t;
typedef short bf16x8 __attribute__((ext_vector_type(8)));
typedef float f32x4 __attribute__((ext_vector_type(4)));
typedef float f32x2 __attribute__((ext_vector_type(2)));
typedef unsigned u32x4 __attribute__((ext_vector_type(4)));
typedef unsigned u32x2 __attribute__((ext_vector_type(2)));
typedef int i32x4 __attribute__((ext_vector_type(4)));
typedef int i32x8 __attribute__((ext_vector_type(8)));

typedef __bf16 bf16x2_t __attribute__((ext_vector_type(2)));
__device__ __forceinline__ unsigned cvt_pk_bf16(float lo, float hi) { const f32x2 v = {lo, hi}; const bf16x2_t b = __builtin_convertvector(v, bf16x2_t); return __builtin_bit_cast(unsigned, b); }
__device__ __forceinline__ float bf2f(unsigned short b) { return __uint_as_float(((unsigned)b) << 16); }
__device__ __forceinline__ float bflo(unsigned w) { return __uint_as_float(w << 16); }
__device__ __forceinline__ float bfhi(unsigned w) { return __uint_as_float(w & 0xffff0000u); }

__device__ __forceinline__ void glds16s(const void* sbase, unsigned voff, unsigned lds_dst) { unsigned keep;
    asm volatile("s_nop 4\n\ts_mov_b32 %0, m0\n\ts_mov_b32 m0, %3\n\ts_nop 0\n\tglobal_load_lds_dwordx4 %1, %2\n\ts_mov_b32 m0, %0" : "=&s"(keep) : "v"(voff), "s"(sbase), "s"(lds_dst) : "memory"); }
__device__ __forceinline__ void glds4s(const void* sbase, unsigned voff, unsigned lds_dst) { unsigned keep;
    asm volatile("s_nop 4\n\ts_mov_b32 %0, m0\n\ts_mov_b32 m0, %3\n\ts_nop 0\n\tglobal_load_lds_dword %1, %2\n\ts_mov_b32 m0, %0" : "=&s"(keep) : "v"(voff), "s"(sbase), "s"(lds_dst) : "memory"); }
__device__ __forceinline__ const char* uni_ptr(const char* p) { const unsigned long long v = (unsigned long long)p; const unsigned lo = __builtin_amdgcn_readfirstlane((unsigned)v), hi = __builtin_amdgcn_readfirstlane((unsigned)(v >> 32)); return (const char*)(((unsigned long long)hi << 32) | lo); }
namespace pg8 {
constexpr int BM = 256, BK = 64, HALF = 128, HTB = HALF * BK * 2, STAGE_BYTES = 8 * HTB, NXCD = 8, WGM = 8;
__host__ __device__ __forceinline__ int lds_byte(int r, int c) { const int st = (r >> 4) * 2 + (c >> 5), rr = r & 15, cc = c & 31, ob = rr * 64 + cc * 2; return st * 1024 + (ob ^ (((ob >> 9) & 1) << 5)); }
__host__ __device__ __forceinline__ void stage_rc(int b, int& R, int& C) { const int st = b / 1024, sb = b % 1024, swz = sb ^ (((sb >> 9) & 1) << 5); R = (st >> 1) * 16 + swz / 64; C = (st & 1) * 32 + (swz % 64) / 2; }
__host__ __device__ __forceinline__ int perm32(int rho) { const int n = rho >> 4, i = rho & 15; return 8 * (i >> 2) + 4 * n + (i & 3); }

struct Unit { int pm, pn; const char* A; const char* B; const LAS unsigned short* tl; int x0, x1, x2; };
struct Gemm { int K, lda, ldb; const char* Abase; };

__device__ __forceinline__ bool tile_order(int i, int G, int c, int nM, int nN, int& pm, int& pn) {
    const int nwg = nM * nN; const long L = (long)i * G + c; if (L >= nwg) return false;
    int wgid = (int)L; { const int q = nwg / NXCD, r = nwg % NXCD, xcd = wgid % NXCD, off = wgid / NXCD; wgid = (xcd < r ? xcd * (q + 1) : r * (q + 1) + (xcd - r) * q) + off; }
    const int nig = WGM * nN, gid = wgid / nig, fm = gid * WGM, gsz = (nM - fm) < WGM ? (nM - fm) : WGM;
    pm = fm + ((wgid % nig) % gsz); pn = (wgid % nig) / gsz; return true;
}

template <class Epi, class Sched, bool ALIGN_EPI, bool GATHER, bool FP8 = false, bool HALFSEL = false>
__device__ __forceinline__ void gemm_phase(LAS unsigned char* lds, const Gemm g, const Sched& S, const Epi& E) {
    const int tid = threadIdx.x, wid = __builtin_amdgcn_readfirstlane(tid >> 6), lane = tid & 63, wr = wid >> 2, wc = wid & 3, fr = lane & 15, fq = lane >> 4;
    const int K = g.K, nt = K / BK;
    int RA[2]; unsigned cA2[2], voffB[2];
#pragma unroll
    for (int i = 0; i < 2; ++i) { int R, C; stage_rc(tid * 16 + i * 8192, R, C); const int Rb = Epi::PERM ? ((R & ~31) + perm32(R & 31)) : R;
        RA[i] = R; cA2[i] = (unsigned)C * 2u; voffB[i] = (unsigned)(Rb * g.ldb + C) * 2u; }
    const size_t kstep = (size_t)(BK * 2);
    const unsigned hstepA = (unsigned)HALF * (unsigned)g.lda * 2u; const size_t hstepB = (size_t)HALF * g.ldb * 2;
    const unsigned ldsb = (unsigned)__builtin_amdgcn_readfirstlane((unsigned)(unsigned long long)lds + (unsigned)wid * 1024u);
    const int aoff = lds_byte(wr * 64 + fr, fq * 8), boff = lds_byte(wc * 32 + fr, fq * 8);
    const int aoff2 = aoff + 1024, boff2 = boff + 1024;
#define PG8_SA(b, h) (((b) * 2 + (h)) * HTB)
#define PG8_SB(b, h) ((4 + (b) * 2 + (h)) * HTB)
#define PG8_STAGE(bufoff, gbase, voff) do { _Pragma("unroll") for (int _i = 0; _i < 2; ++_i) glds16s((gbase), (voff)[_i], ldsb + (unsigned)(bufoff) + _i * 8192u); } while (0)
#define PG8_STAGE_A(bufoff, gbase, AO, h) do { _Pragma("unroll") for (int _i = 0; _i < 2; ++_i) glds16s((gbase), (AO)[h][_i], ldsb + (unsigned)(bufoff) + _i * 8192u); } while (0)
#define PG8_LD8(base_, o1_, o2_) __builtin_shufflevector(*(const LAS i32x4*)(lds + (base_) + (o1_)), *(const LAS i32x4*)(lds + (base_) + (o2_)), 0, 1, 2, 3, 4, 5, 6, 7)
#define PG8_LDA(dst, b, h) do { if constexpr (FP8) { _Pragma("unroll") for (int m = 0; m < 4; ++m) dst##8[m] = PG8_LD8(PG8_SA(b, h) + m * 2048, aoff, aoff2); } \
        else { _Pragma("unroll") for (int m = 0; m < 4; ++m) _Pragma("unroll") for (int k = 0; k < 2; ++k) dst[m][k] = *(const LAS bf16x8*)(lds + PG8_SA(b, h) + aoff + m * 2048 + k * 1024); } } while (0)
#define PG8_LDB(dst, b, h) do { if constexpr (FP8) { _Pragma("unroll") for (int n = 0; n < 2; ++n) dst##8[n] = PG8_LD8(PG8_SB(b, h) + n * 2048, boff, boff2); } \
        else { _Pragma("unroll") for (int n = 0; n < 2; ++n) _Pragma("unroll") for (int k = 0; k < 2; ++k) dst[n][k] = *(const LAS bf16x8*)(lds + PG8_SB(b, h) + boff + n * 2048 + k * 1024); } } while (0)
#define PG8_MMA(ai, bj, At, Bt) do { __builtin_amdgcn_s_setprio(1); _Pragma("unroll") for (int m = 0; m < 4; ++m) _Pragma("unroll") for (int n = 0; n < 2; ++n) { \
        if constexpr (FP8) asm volatile("v_mfma_f32_16x16x128_f8f6f4 %0, %1, %2, %0" : "+v"(acc[ai][bj][m][n]) : "v"(Bt##8[n]), "v"(At##8[m])); \
        else { _Pragma("unroll") for (int k = 0; k < 2; ++k) acc[ai][bj][m][n] = __builtin_amdgcn_mfma_f32_16x16x32_bf16(Bt[n][k], At[m][k], acc[ai][bj][m][n], 0, 0, 0); } } \
        __builtin_amdgcn_s_setprio(0); } while (0)
#define PG8_WAIT_V(n) asm volatile("s_waitcnt vmcnt(" #n ")" ::: "memory")
#define PG8_WAIT_L(n) asm volatile("s_waitcnt lgkmcnt(" #n ")" ::: "memory")
#define PG8_BAR __builtin_amdgcn_s_barrier()
#define PG8_SCHED __builtin_amdgcn_sched_barrier(0)
#define PG8_AOFF(AO, U) do { _Pragma("unroll") for (int _h = 0; _h < 2; ++_h) _Pragma("unroll") for (int _i = 0; _i < 2; ++_i) { \
        if constexpr (GATHER) AO[_h][_i] = (unsigned)(U).tl[RA[_i] + _h * HALF] * (unsigned)(g.lda * 2) + cA2[_i]; \
        else AO[_h][_i] = (unsigned)RA[_i] * (unsigned)(g.lda * 2) + cA2[_i] + (unsigned)_h * hstepA; } } while (0)
    Unit cur, nxt; int ui = 0;
    if (!S.next(0, cur)) return;
    f32x4 acc[2][2][4][2];
#pragma unroll
    for (int a = 0; a < 2; ++a)
#pragma unroll
        for (int b = 0; b < 2; ++b)
#pragma unroll
            for (int m = 0; m < 4; ++m)
#pragma unroll
                for (int n = 0; n < 2; ++n) acc[a][b][m][n] = (f32x4){0.f, 0.f, 0.f, 0.f};
    bf16x8 At[4][2], B0[2][2], B1[2][2]; i32x8 At8[4], B08[2], B18[2];
    E.prep(cur, 0, wid, lane);
    unsigned aoC[2][2], aoN[2][2];
    PG8_AOFF(aoC, cur);
    const char* cA = uni_ptr(GATHER ? g.Abase : cur.A); const char* cB = uni_ptr(cur.B);
    PG8_STAGE(PG8_SB(0, 0), cB, voffB); PG8_STAGE(PG8_SB(0, 1), cB + hstepB, voffB); PG8_STAGE_A(PG8_SA(0, 0), cA, aoC, 0); PG8_STAGE_A(PG8_SA(0, 1), cA, aoC, 1);
    if (wr == 1) PG8_BAR;
    PG8_WAIT_V(2); PG8_BAR;
    PG8_STAGE(PG8_SB(1, 0), cB + kstep, voffB); PG8_STAGE_A(PG8_SA(1, 0), cA + kstep, aoC, 0); PG8_STAGE(PG8_SB(1, 1), cB + hstepB + kstep, voffB);
    PG8_WAIT_V(6); PG8_BAR;
    for (;;) {
        const bool has_next = S.next(ui + 1, nxt);
        if (has_next) E.prep(nxt, ui + 1, wid, lane);
        if constexpr (GATHER) { if (has_next) PG8_AOFF(aoN, nxt); else { _Pragma("unroll") for (int _h = 0; _h < 2; ++_h) _Pragma("unroll") for (int _i = 0; _i < 2; ++_i) aoN[_h][_i] = aoC[_h][_i]; } }
        const char* nA = uni_ptr(GATHER ? g.Abase : (has_next ? nxt.A : cA)); const char* nB = uni_ptr(has_next ? nxt.B : cB);
        const bool dh0 = cur.x2 != 2, dh1 = cur.x2 != 1;
#pragma nounroll
        for (int t = 0; t < nt; t += 2) {
            const bool last = (t == nt - 2);
            const char* a1 = cA + (size_t)(t + 1) * kstep;
            const char* a2 = last ? nA : cA + (size_t)(t + 2) * kstep; const char* b2 = last ? nB : cB + (size_t)(t + 2) * kstep;
            const char* a3 = a2 + kstep; const char* b3 = b2 + kstep;
            unsigned aoS[2][2];
#pragma unroll
            for (int _h = 0; _h < 2; ++_h)
#pragma unroll
                for (int _i = 0; _i < 2; ++_i) aoS[_h][_i] = (GATHER && last) ? aoN[_h][_i] : aoC[_h][_i];
            PG8_LDB(B0, 0, 0); PG8_LDB(B1, 0, 1); PG8_SCHED; PG8_LDA(At, 0, 0); PG8_STAGE_A(PG8_SA(1, 1), a1, aoC, 1);
            PG8_WAIT_V(8); PG8_WAIT_L(0); PG8_BAR; if (!HALFSEL || dh0) PG8_MMA(0, 0, At, B0); if (!HALFSEL || dh1) PG8_MMA(0, 1, At, B1); PG8_BAR; PG8_SCHED;
            PG8_LDA(At, 0, 1); PG8_STAGE(PG8_SB(0, 0), b2, voffB); PG8_STAGE(PG8_SB(0, 1), b2 + hstepB, voffB); PG8_STAGE_A(PG8_SA(0, 0), a2, aoS, 0);
            PG8_WAIT_V(8); PG8_WAIT_L(0); PG8_BAR; if (!HALFSEL || dh0) PG8_MMA(1, 0, At, B0); if (!HALFSEL || dh1) PG8_MMA(1, 1, At, B1); PG8_BAR; PG8_SCHED;
            PG8_LDB(B0, 1, 0); PG8_LDB(B1, 1, 1); PG8_SCHED; PG8_LDA(At, 1, 0); PG8_STAGE_A(PG8_SA(0, 1), a2, aoS, 1);
            PG8_WAIT_V(8); PG8_WAIT_L(0); PG8_BAR; if (!HALFSEL || dh0) PG8_MMA(0, 0, At, B0); if (!HALFSEL || dh1) PG8_MMA(0, 1, At, B1); PG8_BAR; PG8_SCHED;
            PG8_LDA(At, 1, 1); PG8_STAGE(PG8_SB(1, 0), b3, voffB); PG8_STAGE(PG8_SB(1, 1), b3 + hstepB, voffB); PG8_STAGE_A(PG8_SA(1, 0), a3, aoS, 0);
            PG8_WAIT_V(8); PG8_WAIT_L(0); PG8_BAR; if (!HALFSEL || dh0) PG8_MMA(1, 0, At, B0); if (!HALFSEL || dh1) PG8_MMA(1, 1, At, B1); PG8_BAR; PG8_SCHED;
        }
        if constexpr (FP8) asm volatile("s_nop 15\n\ts_nop 15" ::: "memory");
        if constexpr (ALIGN_EPI) { if (wr == 0) PG8_BAR; }
        E(acc, cur, wr, wc, fr, fq);
        if (!has_next) break;
#pragma unroll
        for (int a = 0; a < 2; ++a)
#pragma unroll
            for (int b = 0; b < 2; ++b)
#pragma unroll
                for (int m = 0; m < 4; ++m)
#pragma unroll
                    for (int n = 0; n < 2; ++n) acc[a][b][m][n] = (f32x4){0.f, 0.f, 0.f, 0.f};
        if constexpr (FP8) asm volatile("s_nop 7" ::: "memory");
        cur = nxt; cA = nA; cB = nB; ++ui;
        if constexpr (GATHER) {
#pragma unroll
            for (int _h = 0; _h < 2; ++_h)
#pragma unroll
                for (int _i = 0; _i < 2; ++_i) aoC[_h][_i] = aoN[_h][_i]; }
        if constexpr (ALIGN_EPI) { if (wr == 1) PG8_BAR; }
    }
    PG8_WAIT_V(0);
    if constexpr (!ALIGN_EPI) { if (wr == 0) PG8_BAR; }
    PG8_BAR;
#undef PG8_SA
#undef PG8_SB
#undef PG8_STAGE
#undef PG8_STAGE_A
#undef PG8_LDA
#undef PG8_LD8
#undef PG8_LDB
#undef PG8_MMA
#undef PG8_WAIT_V
#undef PG8_WAIT_L
#undef PG8_BAR
#undef PG8_SCHED
#undef PG8_AOFF
}
}
#include <hip/hip_bf16.h>
namespace attn_body {
using bf16=__hip_bfloat16;
using bf16x8=__attribute__((ext_vector_type(8)))short;
using s16x4=__attribute__((ext_vector_type(4)))short;
using f32x16=__attribute__((ext_vector_type(16)))float;
using u32x4=__attribute__((ext_vector_type(4)))unsigned;
constexpr int BATCH=4,NHEAD=16,SEQ=4096,D=64,DM=NHEAD*D;
constexpr int NW=8,QBLK=32,QB=QBLK*NW,KVBLK=64,NQB=SEQ/QB;
constexpr int ATTN_PITCH=DM, ATTN_UNIT_ROWS=QB;
__device__ __forceinline__ int crow(int r,int hi){return (r&3)+8*(r>>2)+4*hi;}
#define SBAR() __builtin_amdgcn_sched_barrier(0)
__device__ __forceinline__ void cmask(f32x16&p0,f32x16&p1,int jb,int qrel,int hi){
  const float NEG=-INFINITY; int d=qrel-64*jb-4*hi; asm volatile("":"+v"(d));
  #pragma unroll
  for(int r=0;r<16;++r){const int c=(r&3)+8*(r>>2); if(c>d)p0[r]=NEG; if(c+32>d)p1[r]=NEG;}
}

constexpr int NSLOT=3, SLOTB=8192;
constexpr int LDS_GT=98304;
constexpr int LDS_K=0, LDS_V=NSLOT*SLOTB, LDS_WS=2*NSLOT*SLOTB, LDS_OST=LDS_WS+NW*64*4, LDS_BYTES=LDS_OST+NW*4096;
constexpr float C2=0.125f*1.4426950408889634f;
__device__ __forceinline__ void glds16(const void*gsrc,unsigned lds_dst){unsigned keep;
  asm volatile("s_mov_b32 %0, m0\n\ts_mov_b32 m0, %2\n\ts_nop 0\n\tglobal_load_lds_dwordx4 %1, off\n\ts_mov_b32 m0, %0":"=&s"(keep):"v"(gsrc),"s"(lds_dst):"memory");}
__device__ __forceinline__ void glds16s(const void*sbase,unsigned voff,unsigned lds_dst){unsigned keep;
  asm volatile("s_nop 4\n\ts_mov_b32 %0, m0\n\ts_mov_b32 m0, %3\n\ts_nop 0\n\tglobal_load_lds_dwordx4 %1, %2\n\ts_mov_b32 m0, %0":"=&s"(keep):"v"(voff),"s"(sbase),"s"(lds_dst):"memory");}
__device__ __forceinline__ unsigned lane_now(){unsigned l;asm volatile("v_mbcnt_lo_u32_b32 %0, -1, 0\n\tv_mbcnt_hi_u32_b32 %0, -1, %0":"=v"(l));return l;}
__device__ __forceinline__ float max3f(float a,float b,float c){float r;asm("v_max3_f32 %0, %1, %2, %3":"=v"(r):"v"(a),"v"(b),"v"(c));return r;}
__device__ __forceinline__ float max2f(float a,float b){float r;asm("v_max_f32_e32 %0, %1, %2":"=v"(r):"v"(a),"v"(b));return r;}
__device__ __forceinline__ float fadd_s(float a,float b){float r;asm("v_add_f32_e32 %0, %1, %2":"=v"(r):"v"(a),"v"(b));return r;}
__device__ __forceinline__ float fsub_s(float a,float b){float r;asm("v_sub_f32_e32 %0, %1, %2":"=v"(r):"v"(a),"v"(b));return r;}
typedef float f32x2_t __attribute__((ext_vector_type(2))); typedef __bf16 bf16x2_t __attribute__((ext_vector_type(2)));
__device__ __forceinline__ unsigned cvtpk_s(float lo,float hi){f32x2_t v={lo,hi};bf16x2_t b=__builtin_convertvector(v,bf16x2_t);return __builtin_bit_cast(unsigned,b);}
#define WAIT_BAR(N) asm volatile("s_waitcnt vmcnt(" #N ") lgkmcnt(0)\n\ts_barrier":::"memory")

__device__ __forceinline__ void qkt(f32x16&p0,f32x16&p1,const char*Kslot,const bf16x8*qr,int r32,int hi){
  const char*kb=Kslot+hi*1024+r32*16;
  #pragma unroll
  for(int d0=0;d0<4;++d0){
    const bf16x8 b0=*reinterpret_cast<const bf16x8*>(kb+d0*2048);
    const bf16x8 b1=*reinterpret_cast<const bf16x8*>(kb+d0*2048+512);
    if(d0==0){p0=__builtin_amdgcn_mfma_f32_32x32x16_bf16(b0,qr[0],(f32x16){0.f,0.f,0.f,0.f,0.f,0.f,0.f,0.f,0.f,0.f,0.f,0.f,0.f,0.f,0.f,0.f},0,0,0);p1=__builtin_amdgcn_mfma_f32_32x32x16_bf16(b1,qr[0],(f32x16){0.f,0.f,0.f,0.f,0.f,0.f,0.f,0.f,0.f,0.f,0.f,0.f,0.f,0.f,0.f,0.f},0,0,0);}
    else{p0=__builtin_amdgcn_mfma_f32_32x32x16_bf16(b0,qr[d0],p0,0,0,0);p1=__builtin_amdgcn_mfma_f32_32x32x16_bf16(b1,qr[d0],p1,0,0,0);}}
}
typedef __attribute__((address_space(3))) const char* lds_cptr;
typedef short v4i16_t __attribute__((ext_vector_type(4)));
__device__ __forceinline__ void kload8(bf16x8*kf,lds_cptr kp){
  kf[0]=*(const __attribute__((address_space(3))) bf16x8*)(kp);      kf[1]=*(const __attribute__((address_space(3))) bf16x8*)(kp+512);
  kf[2]=*(const __attribute__((address_space(3))) bf16x8*)(kp+2048); kf[3]=*(const __attribute__((address_space(3))) bf16x8*)(kp+2560);
  kf[4]=*(const __attribute__((address_space(3))) bf16x8*)(kp+4096); kf[5]=*(const __attribute__((address_space(3))) bf16x8*)(kp+4608);
  kf[6]=*(const __attribute__((address_space(3))) bf16x8*)(kp+6144); kf[7]=*(const __attribute__((address_space(3))) bf16x8*)(kp+6656);
}
__device__ __forceinline__ void kload2(bf16x8*kf,lds_cptr kp,int j){ kf[2*j]=*(const __attribute__((address_space(3))) bf16x8*)(kp+j*2048); kf[2*j+1]=*(const __attribute__((address_space(3))) bf16x8*)(kp+j*2048+512); }
__device__ __forceinline__ s16x4 vtr(lds_cptr p){ return __builtin_bit_cast(s16x4,__builtin_amdgcn_ds_read_tr16_b64_v4i16((__attribute__((address_space(3))) v4i16_t*)p)); }
__device__ __forceinline__ float rowmax(const f32x16&p0,const f32x16&p1){
  float a=max3f(p0[0],p0[1],p1[0]),b=max3f(p0[2],p0[3],p1[1]);a=max3f(a,p1[2],p1[3]);
  #pragma unroll
  for(int r=4;r<16;r+=4){a=max3f(a,p0[r],p0[r+1]);b=max3f(b,p0[r+2],p0[r+3]);a=max3f(a,p1[r],p1[r+1]);b=max3f(b,p1[r+2],p1[r+3]);}
  const float m=max2f(a,b);
  auto rr=__builtin_amdgcn_permlane32_swap(__float_as_uint(m),__float_as_uint(m),false,false);
  return max2f(__uint_as_float(rr[0]),__uint_as_float(rr[1]));
}
__device__ __forceinline__ void pv(f32x16*o,int vb,bf16x8 pa0,bf16x8 pa1,bf16x8 pa2,bf16x8 pa3){
  #pragma unroll
  for(int d0=0;d0<2;++d0){s16x4 lo[4],hi[4];
    #pragma unroll
    for(int ks=0;ks<4;++ks){
      asm volatile("ds_read_b64_tr_b16 %0,%1 offset:%c2":"=&v"(lo[ks]):"v"(vb),"i"(d0*4096+ks*1024):"memory");
      asm volatile("ds_read_b64_tr_b16 %0,%1 offset:%c2":"=&v"(hi[ks]):"v"(vb),"i"(d0*4096+ks*1024+512):"memory");}
    asm volatile("s_waitcnt lgkmcnt(0)":::"memory");SBAR();
    #define PK(k) (bf16x8){lo[k][0],lo[k][1],lo[k][2],lo[k][3],hi[k][0],hi[k][1],hi[k][2],hi[k][3]}
    o[d0]=__builtin_amdgcn_mfma_f32_32x32x16_bf16(pa0,PK(0),o[d0],0,0,0);
    o[d0]=__builtin_amdgcn_mfma_f32_32x32x16_bf16(pa1,PK(1),o[d0],0,0,0);
    o[d0]=__builtin_amdgcn_mfma_f32_32x32x16_bf16(pa2,PK(2),o[d0],0,0,0);
    o[d0]=__builtin_amdgcn_mfma_f32_32x32x16_bf16(pa3,PK(3),o[d0],0,0,0);
    #undef PK
  }
}

#ifndef ATTN_STORE16
#define ATTN_STORE16(p,v) (*(u32x4*)(p)=(v))
#endif
template<int THRL> __device__ __forceinline__ void attn_unit(int b,int h,int qb,const bf16*Q,const bf16*__restrict__ K,const bf16*__restrict__ V,bf16*O,const float*ksum,char*shm){
  const int tid=threadIdx.x,lane=tid&63,r32=lane&31,hi=lane>>5; const int wid=__builtin_amdgcn_readfirstlane(tid>>6);
  const long rowbase=(long)b*SEQ; const int q0=qb*QB;
  const bf16*Qw=Q+(rowbase+q0+wid*QBLK)*DM+h*D;
  const bf16*Kh=K+rowbase*DM+h*D,*Vh=V+rowbase*DM+h*D;
  const unsigned lds0=(unsigned)(uintptr_t)shm;
  float*wsf=(float*)(shm+LDS_WS)+wid*64;
  const unsigned kdst=lds0+LDS_K+wid*1024, vdst=lds0+LDS_V+wid*1024;
  #define PHYS(t) (((t)<4)?(4*qb+(t)):((t)-4))
  #define DMA_K(t,slot) glds16s((const char*)Kh+(size_t)PHYS(t)*(KVBLK*DM*2)+wid*16,lane_now()*(unsigned)(DM*2),(unsigned)__builtin_amdgcn_readfirstlane(kdst+(slot)))
  #define DMA_V(t,slot) glds16s((const char*)Vh+(size_t)PHYS(t)*(KVBLK*DM*2)+(size_t)(16*(wid&3))*(DM*2)+(wid>>2)*64,({const unsigned l_=lane_now(); (l_>>2)*(unsigned)(DM*2)+(l_&3u)*16u;}),(unsigned)__builtin_amdgcn_readfirstlane(vdst+(slot)))
  const int vb0=(int)(lds0+LDS_V)+((lane>>4)&1)*32+(lane&3)*8+(4*hi+((lane&15)>>2))*64;
  const char*Kbase=shm+LDS_K; bf16x8 kf[8];
  const lds_cptr shm3=(lds_cptr)shm; const lds_cptr kp0=shm3+LDS_K+hi*1024+r32*16; const lds_cptr vp0=shm3+LDS_V+((lane>>4)&1)*32+(lane&3)*8+(4*hi+((lane&15)>>2))*64;
  const int NT=(q0+QB)/KVBLK;
  DMA_K(0,0);DMA_V(0,0);DMA_K(1,SLOTB);
  { float*gt=(float*)(shm+LDS_GT);
    #pragma unroll
    for(int k=0;k<2;++k){ const int j=2*wid+k; if(j<qb) gt[j*64+lane]=ksum[(long)(b*16+j)*DM+h*D+lane]; } }
  bf16x8 qr[4];
  #pragma unroll
  for(int d0=0;d0<4;++d0)qr[d0]=*reinterpret_cast<const bf16x8*>(&Qw[(long)r32*DM+d0*16+hi*8]);

  unsigned sel=0u;
  float mhat=0.f,l_reg=0.f;f32x16 o[2];o[0]=f32x16{};o[1]=f32x16{};
  bf16x8 kone=(bf16x8){0,0,0,0,0,0,0,0}, qm=(bf16x8){0,0,0,0,0,0,0,0}; if(hi==0) kone[0]=(short)0x3F80;
  #define SETQM() do{ const unsigned short mb_=(unsigned short)(cvtpk_s(-mhat,0.f)&0xffffu); qm[0]=(hi==0)?(short)mb_:(short)0; asm volatile("":"+v"(qm)); }while(0)
  const int qrel=wid*QBLK+r32;
  #define CMASK(P0,P1,t) do{ const int t_=(t); if(t_<4){ const int l_=(int)lane_now(); cmask(P0,P1,t_,wid*QBLK+(l_&31),l_>>5); } else if(!((sel>>(((t_-4)>>2)&15))&1u)){ _Pragma("unroll") for(int r=0;r<16;++r){P0[r]=-INFINITY;P1[r]=-INFINITY;} } }while(0)
  bool resc=false;
  #define START(P0,P1) do{ const float rm=rowmax(P0,P1); resc=false; \
    { const float dl=__uint_as_float(cvtpk_s(rm,0.f)<<16); mhat=fadd_s(mhat,dl);          \
      _Pragma("unroll") for(int r=0;r<16;++r){P0[r]=fsub_s(P0[r],dl);P1[r]=fsub_s(P1[r],dl);} \
      SETQM(); } \
    _Pragma("unroll") for(int r=0;r<16;++r)P0[r]=__builtin_amdgcn_exp2f(P0[r]); }while(0)
  #define RESC() do{ if(resc){ asm volatile("s_waitcnt lgkmcnt(0)":::"memory"); \
      _Pragma("unroll") for(int d_=0;d_<2;++d_) _Pragma("unroll") for(int r=0;r<16;++r)o[d_][r]*=wsf[crow(r,(int)(lane_now()>>5))]; } }while(0)
  f32x16 pA0,pA1,pB0,pB1;
  int sl_prev=0,sl_cur=0,sl_next=SLOTB;
  #define ROT() do{sl_prev=sl_cur;sl_cur=sl_next;sl_next=(sl_next==(NSLOT-1)*SLOTB)?0:sl_next+SLOTB;}while(0)
  DMA_K(2,2*SLOTB);
  WAIT_BAR(3);
  { float qf[32];
    #pragma unroll
    for(int d0=0;d0<4;++d0){
      #pragma unroll
      for(int i=0;i<8;++i) qf[d0*8+i]=__uint_as_float(((unsigned)(unsigned short)qr[d0][i])<<16); }
    const float*gt=(const float*)(shm+LDS_GT)+hi*8; float g[15];
    #pragma unroll
    for(int j=0;j<15;++j){ g[j]=-INFINITY;
      if(j<qb){ const float*kp=gt+j*64; float a=0.f;
        #pragma unroll
        for(int d0=0;d0<4;++d0){ const float4 k0=*reinterpret_cast<const float4*>(kp+d0*16), k1=*reinterpret_cast<const float4*>(kp+d0*16+4);
          a+=qf[d0*8+0]*k0.x; a+=qf[d0*8+1]*k0.y; a+=qf[d0*8+2]*k0.z; a+=qf[d0*8+3]*k0.w; a+=qf[d0*8+4]*k1.x; a+=qf[d0*8+5]*k1.y; a+=qf[d0*8+6]*k1.z; a+=qf[d0*8+7]*k1.w; }
        g[j]=a+__shfl_xor(a,32); } }
    #pragma unroll
    for(int kk=0;kk<3;++kk){ float best=-INFINITY; int bj=-1;
      #pragma unroll
      for(int j=0;j<15;++j){ const bool c=(j<qb)&&!((sel>>j)&1u)&&(g[j]>best); best=c?g[j]:best; bj=c?j:bj; }
      if(bj>=0) sel|=(1u<<bj); } }
  qkt(pA0,pA1,Kbase,qr,r32,hi);asm volatile("s_nop 15\n\ts_nop 7":"+v"(pA0),"+v"(pA1));CMASK(pA0,pA1,0);
  START(pA0,pA1);
  _Pragma("unroll") for(int r=0;r<16;++r)pA1[r]=__builtin_amdgcn_exp2f(pA1[r]);
  WAIT_BAR(0);
  DMA_K(3,0);DMA_V(1,SLOTB);
  ROT();
  kload8(kf,kp0+sl_cur);
  WAIT_BAR(2);
  s16x4 vlo[8],vhi[8]; u32x4 pw0,pw1,pw2,pw3;
  #define PKW(P,B) cvtpk_s(P[B],P[B+1])
  #define PAF(k) __builtin_bit_cast(bf16x8,pw##k)
  #define VFR(i) (bf16x8){vlo[i][0],vlo[i][1],vlo[i][2],vlo[i][3],vhi[i][0],vhi[i][1],vhi[i][2],vhi[i][3]}
  #define PIN(x) asm volatile("":"+v"(x))
  #define MX3(a,b,c) __builtin_fmaxf(__builtin_fmaxf((a),(b)),(c))
  #define GAPA(MF,A0,A1,A2,A3,W0,W1,PW) do{ MF; sacc+=A0; sacc+=A1; sacc+=A2; sacc+=A3; PIN(sacc); W0; W1; PIN(PW); SBAR(); }while(0)
  #define EX(v) __builtin_amdgcn_exp2f(v)
  #define GAPB(MF,X,B) do{ MF; X[B]=EX(X[B]); X[B+1]=EX(X[B+1]); X[B+2]=EX(X[B+2]); X[B+3]=EX(X[B+3]); PIN(X); SBAR(); }while(0)
  #define VRD(i) do{ vlo[i]=vtr(vp_+(((i)>>2)*4096+((i)&3)*1024)); vhi[i]=vtr(vp_+(((i)>>2)*4096+((i)&3)*1024+512)); }while(0)
  #define KRD(G,j) do{ if(G){ kload2(kf,kp0+sl_next,j); SBAR(); } }while(0)
  #define STEP(C0,C1,P0,P1,t,GK,GV,GL) do{ SBAR(); \
    const lds_cptr vp_=vp0+sl_prev; \
    C0=__builtin_amdgcn_mfma_f32_32x32x16_bf16(kone,qm,(f32x16){0.f,0.f,0.f,0.f,0.f,0.f,0.f,0.f,0.f,0.f,0.f,0.f,0.f,0.f,0.f,0.f},0,0,0); C1=__builtin_amdgcn_mfma_f32_32x32x16_bf16(kone,qm,(f32x16){0.f,0.f,0.f,0.f,0.f,0.f,0.f,0.f,0.f,0.f,0.f,0.f,0.f,0.f,0.f,0.f},0,0,0); SBAR(); \
    VRD(0); SBAR(); float sacc=(P0[0]+P0[1]); \
    GAPA(C0=__builtin_amdgcn_mfma_f32_32x32x16_bf16(kf[0],qr[0],C0,0,0,0), P0[2],P0[3],P0[4],P0[5],     pw0[0]=PKW(P0,0), pw0[1]=PKW(P0,2), pw0); \
    VRD(4); SBAR(); GAPA(C1=__builtin_amdgcn_mfma_f32_32x32x16_bf16(kf[1],qr[0],C1,0,0,0), P0[6],P0[7],P0[8],P0[9],     pw0[2]=PKW(P0,4), pw0[3]=PKW(P0,6), pw0); \
    VRD(1); SBAR(); GAPA(C0=__builtin_amdgcn_mfma_f32_32x32x16_bf16(kf[2],qr[1],C0,0,0,0),   P0[10],P0[11],P0[12],P0[13], pw1[0]=PKW(P0,8), pw1[1]=PKW(P0,10), pw1); \
    VRD(5); SBAR(); GAPA(C1=__builtin_amdgcn_mfma_f32_32x32x16_bf16(kf[3],qr[1],C1,0,0,0),   P0[14],P0[15],P1[0],P1[1],   pw1[2]=PKW(P0,12),pw1[3]=PKW(P0,14), pw1); \
    VRD(2); SBAR(); GAPA(C0=__builtin_amdgcn_mfma_f32_32x32x16_bf16(kf[4],qr[2],C0,0,0,0),   P1[2],P1[3],P1[4],P1[5],     pw2[0]=PKW(P1,0), pw2[1]=PKW(P1,2), pw2); \
    VRD(6); SBAR(); GAPA(C1=__builtin_amdgcn_mfma_f32_32x32x16_bf16(kf[5],qr[2],C1,0,0,0),   P1[6],P1[7],P1[8],P1[9],     pw2[2]=PKW(P1,4), pw2[3]=PKW(P1,6), pw2); \
    VRD(3); SBAR(); GAPA(C0=__builtin_amdgcn_mfma_f32_32x32x16_bf16(kf[6],qr[3],C0,0,0,0),   P1[10],P1[11],P1[12],P1[13], pw3[0]=PKW(P1,8), pw3[1]=PKW(P1,10), pw3); \
    VRD(7); SBAR(); GAPA(C1=__builtin_amdgcn_mfma_f32_32x32x16_bf16(kf[7],qr[3],C1,0,0,0),   P1[14],P1[15],0.f,0.f,       pw3[2]=PKW(P1,12),pw3[3]=PKW(P1,14), pw3); \
    l_reg+=sacc; \
    if(GK){DMA_K((t)+3,sl_cur);} if(GV){DMA_V((t)+1,sl_next);} \
    CMASK(C0,C1,t); \
    { float a=MX3(C0[0],C0[1],C1[0]),b=MX3(C0[2],C0[3],C1[1]); a=MX3(a,C1[2],C1[3]); \
      _Pragma("unroll") for(int r=4;r<16;r+=4){a=MX3(a,C0[r],C0[r+1]);b=MX3(b,C0[r+2],C0[r+3]);a=MX3(a,C1[r],C1[r+1]);b=MX3(b,C1[r+2],C1[r+3]);} \
      float rm=__builtin_fmaxf(a,b); { auto rr=__builtin_amdgcn_permlane32_swap(__float_as_uint(rm),__float_as_uint(rm),false,false); rm=__builtin_fmaxf(__uint_as_float(rr[0]),__uint_as_float(rr[1])); } \
      resc=false; \
      if(__builtin_expect(__any(rm>(float)THRL),0)){ const float mn_=__uint_as_float(cvtpk_s(mhat+__builtin_fmaxf(rm,0.f),0.f)<<16); const float dl=mn_-mhat; mhat=mn_; \
        _Pragma("unroll") for(int r=0;r<16;++r){C0[r]-=dl;C1[r]-=dl;} \
        SETQM(); \
        const float f=__builtin_amdgcn_exp2f(-dl); l_reg*=f; { const int l_=(int)lane_now(); if((l_>>5)==0)wsf[l_&31]=f; } resc=true; } } \
    SBAR(); \
    GAPB(o[0]=__builtin_amdgcn_mfma_f32_32x32x16_bf16(PAF(0),VFR(0),o[0],0,0,0), C0,0); \
    GAPB(o[1]=__builtin_amdgcn_mfma_f32_32x32x16_bf16(PAF(0),VFR(4),o[1],0,0,0), C0,4); \
    KRD(GL,0); GAPB(o[0]=__builtin_amdgcn_mfma_f32_32x32x16_bf16(PAF(1),VFR(1),o[0],0,0,0), C0,8); \
    KRD(GL,1); GAPB(o[1]=__builtin_amdgcn_mfma_f32_32x32x16_bf16(PAF(1),VFR(5),o[1],0,0,0), C0,12); \
    KRD(GL,2); GAPB(o[0]=__builtin_amdgcn_mfma_f32_32x32x16_bf16(PAF(2),VFR(2),o[0],0,0,0), C1,0); \
    KRD(GL,3); GAPB(o[1]=__builtin_amdgcn_mfma_f32_32x32x16_bf16(PAF(2),VFR(6),o[1],0,0,0), C1,4); \
    GAPB(o[0]=__builtin_amdgcn_mfma_f32_32x32x16_bf16(PAF(3),VFR(3),o[0],0,0,0), C1,8); \
    GAPB(o[1]=__builtin_amdgcn_mfma_f32_32x32x16_bf16(PAF(3),VFR(7),o[1],0,0,0), C1,12); \
    }while(0)
  int t=1;
  #undef CMASK
  #define CMASK(P0,P1,t) do{ const int t_=(t); if(t_<4){ const int l_=(int)lane_now(); cmask(P0,P1,t_,wid*QBLK+(l_&31),l_>>5); } else if(!((sel>>(((t_-4)>>2)&15))&1u)){ _Pragma("unroll") for(int r=0;r<16;++r){P0[r]=-INFINITY;P1[r]=-INFINITY;} } }while(0)
  for(;t+5<NT;t+=2){
    STEP(pB0,pB1,pA0,pA1,t,true,true,true);     WAIT_BAR(2); RESC(); ROT();
    STEP(pA0,pA1,pB0,pB1,t+1,true,true,true);   WAIT_BAR(2); RESC(); ROT();
  }
  #undef CMASK
  #define CMASK(P0,P1,t) do{ const int t_=(t); if(t_<4){ const int l_=(int)lane_now(); cmask(P0,P1,t_,wid*QBLK+(l_&31),l_>>5); } else if(!((sel>>(((t_-4)>>2)&15))&1u)){ _Pragma("unroll") for(int r=0;r<16;++r){P0[r]=-INFINITY;P1[r]=-INFINITY;} } }while(0)
  #define ENDW(tt) do{ if((tt)+3<NT){WAIT_BAR(2);} else if((tt)+2<NT){WAIT_BAR(1);} else {WAIT_BAR(0);} }while(0)
  for(;t+1<NT;t+=2){
    STEP(pB0,pB1,pA0,pA1,t,(t+3<NT),(t+1<NT),(t+1<NT));       ENDW(t);   RESC(); ROT();
    STEP(pA0,pA1,pB0,pB1,t+1,(t+4<NT),(t+2<NT),(t+2<NT));     ENDW(t+1); RESC(); ROT();
  }
  STEP(pB0,pB1,pA0,pA1,NT-1,false,false,false); RESC();
  { float sacc=pB0[0]+pB0[1]; _Pragma("unroll") for(int r=2;r<16;++r)sacc+=pB0[r]; _Pragma("unroll") for(int r=0;r<16;++r)sacc+=pB1[r]; l_reg+=sacc;
    pw0=(u32x4){PKW(pB0,0),PKW(pB0,2),PKW(pB0,4),PKW(pB0,6)};pw1=(u32x4){PKW(pB0,8),PKW(pB0,10),PKW(pB0,12),PKW(pB0,14)};pw2=(u32x4){PKW(pB1,0),PKW(pB1,2),PKW(pB1,4),PKW(pB1,6)};pw3=(u32x4){PKW(pB1,8),PKW(pB1,10),PKW(pB1,12),PKW(pB1,14)};
    SBAR(); pv(o,vb0+sl_cur,PAF(0),PAF(1),PAF(2),PAF(3)); }
  #undef PKW
  #undef PAF
  #undef VFR
  #undef PIN
  #undef MX3
  #undef GAPA
  #undef GAPB
  #undef EX
  #undef VRD
  #undef KRD
  #undef STEP
  #undef ENDW
  {auto rr=__builtin_amdgcn_permlane32_swap(__float_as_uint(l_reg),__float_as_uint(l_reg),false,false);l_reg=__uint_as_float(rr[0])+__uint_as_float(rr[1]);}
  if(hi==0)wsf[32+r32]=l_reg;asm volatile("s_waitcnt lgkmcnt(0)":::"memory");
  float rli[16];
  #pragma unroll
  for(int r=0;r<16;++r)rli[r]=__builtin_amdgcn_rcpf(wsf[32+crow(r,hi)]);
  bf16*Ow=O+(rowbase+q0+wid*QBLK)*DM+h*D;
  { bf16*stg=(bf16*)(shm+LDS_OST)+wid*2048;
    #pragma unroll
    for(int r=0;r<16;++r){const int orow=crow(r,hi);
      #pragma unroll
      for(int d0=0;d0<2;++d0)stg[orow*64+d0*32+r32]=__float2bfloat16(o[d0][r]*rli[r]);}
    asm volatile("s_waitcnt lgkmcnt(0)":::"memory");
    #pragma unroll
    for(int i=0;i<4;++i){const int row=i*8+(lane>>3),ch=lane&7; const u32x4 v=*(const u32x4*)(stg+row*64+ch*8); ATTN_STORE16(Ow+(long)row*DM+ch*8,v);} }
  asm volatile("s_waitcnt lgkmcnt(0)\n\ts_barrier":::"memory");
  #undef DMA_K
  #undef PHYS
  #undef DMA_V
  #undef CMASK
  #undef START
  #undef SETQM
  #undef RESC
  #undef ROT
}
constexpr int ATTN_LDS_BYTES=LDS_BYTES;
struct AttnTensors { const bf16* Q; const bf16* K; const bf16* V; bf16* O; const float* ksum; };
struct AttnUnit { int bh; int qb; };
struct StaticOrder {
  int vcu, G;
  __device__ __forceinline__ explicit StaticOrder(int grid,int block):vcu((grid%8==0)?((block%8)*(grid/8)+block/8):block),G(grid){}
  __device__ __forceinline__ bool next(int i,AttnUnit&u)const{ const int L=i*G+vcu; if(L>=1024)return false; const int w=L&255, rnd=L>>8, s=w&3; u.bh=w>>2; u.qb=(rnd==0)?s:(rnd==1)?7-s:(rnd==2)?8+s:15-s; return true; }
  __device__ __forceinline__ void a_ready(const AttnUnit&)const{}
  __device__ __forceinline__ void done(const AttnUnit&)const{}
};
struct SnakeOrder {
  int v, G;
  __device__ __forceinline__ bool next(int i,AttnUnit&u)const{ const int idx=i*G+((i&1)?(G-1-v):v); if(idx>=1024)return false; u.qb=15-(idx>>6); u.bh=idx&63; return true; }
  __device__ __forceinline__ void a_ready(const AttnUnit&)const{}
  __device__ __forceinline__ void done(const AttnUnit&)const{}
};
template<class Sched,int THRL=8> __device__ __forceinline__ void attn_phase(char*lds,const AttnTensors&T,const Sched&S){
  AttnUnit u;
  for(int i=0;S.next(i,u);++i){ S.a_ready(u); attn_unit<THRL>(u.bh/NHEAD,u.bh%NHEAD,u.qb,T.Q,T.K,T.V,T.O,T.ksum,lds); S.done(u); }
}
#undef SBAR
#undef WAIT_BAR
}
constexpr int NWAVES = 8, NTHR = 512;
constexpr int NTOK = 16384, DM = 1024, SEQ = 4096, NBATCH = 4, NEXP = 32;
constexpr float ALPHA = 1.4142135623730951f;
constexpr float LN_EPS = 1e-5f;
constexpr float RSQRT_DQK = 0.08838834764831845f;
constexpr int NPHASE = 19;
constexpr float FP8_SA = 4.0f, FP8_SWGU = 64.0f, FP8_SWD = 128.0f;
#ifndef DBG_ATTN_MUL
#define DBG_ATTN_MUL 1.0f
#endif
#ifndef DBG_MLSTM_MUL
#define DBG_MLSTM_MUL 1.0f
#endif
#ifndef DBG_MOE_MUL
#define DBG_MOE_MUL 1.0f
#endif
#ifndef DBG_P14_A
#define DBG_P14_A WS_HN
#endif
#ifndef NCONV
#define NCONV 80
#endif
#ifndef MK_ONE_LAUNCH
#define MK_ONE_LAUNCH 1
#endif

constexpr size_t MiB = 1u << 20, KiB = 1024;
constexpr size_t WS_CTL = 0, CTL_ZERO_BYTES = 1 * MiB;
constexpr int CW_TMO = 0, CW_BAR = 4096, CW_CNT = 8192, CW_AQ = 16384;
constexpr size_t WS_KSUM = 256 * KiB, WS_DEN = 512 * KiB;
constexpr size_t WS_WQKV = 2 * MiB, WS_WO = 8 * MiB, WS_WINA = 10 * MiB, WS_WINB = 14 * MiB, WS_WOUT = 17 * MiB;
constexpr size_t WS_WG = 19 * MiB, WS_RWT = 20 * MiB, WS_ROPE = 21 * MiB;
constexpr size_t WS_TOKE = 22 * MiB, WS_TOKP = 22 * MiB + 256 * KiB, WS_TOKG = 22 * MiB + 512 * KiB;
constexpr size_t WS_GI = 23 * MiB, WS_LF = 23 * MiB + 256 * KiB, WS_RF = 23 * MiB + 512 * KiB, WS_CF = 23 * MiB + 768 * KiB;
constexpr size_t WS_DEC = 24 * MiB, WS_NU = 24 * MiB + 256 * KiB, WS_NPREV = 24 * MiB + 512 * KiB;
constexpr size_t WS_ROWTOK = 25 * MiB;
constexpr size_t WS_XB = 32 * MiB, WS_Q = 64 * MiB, WS_K = 96 * MiB, WS_V = 128 * MiB;
constexpr size_t WS_R0 = 160 * MiB, WS_R1 = 224 * MiB, WS_R2 = 288 * MiB;
constexpr size_t WS_H = 352 * MiB, WS_Y = 496 * MiB;
constexpr size_t WS_WGU = 640 * MiB, WS_WD = 896 * MiB, WS_END = 1024 * MiB;
constexpr size_t WS_AE = 352 * MiB, WS_BE = 416 * MiB, WS_KN = 464 * MiB, WS_KT = 496 * MiB, WS_UT = 512 * MiB, WS_OS = 544 * MiB, WS_HN = 576 * MiB;

constexpr int RING_OFF = 0, RING_BYTES = 131072;
constexpr int LX = RING_BYTES;
constexpr int LX_MISC = LX;
constexpr int LX_TILEE = LX + 128;
constexpr int LX_TBASE = LX + 1280;
constexpr int LX_LCNT = LX + 1536, LX_GBASE = LX + 1664;
constexpr int LX_REC = LX + 1792;
constexpr int LX_TOKL = LX + 4096;
constexpr int LX_LNX = LX + 4096;
constexpr int LX_BIAS = LX + 12288;
constexpr int LDS_BYTES = 147456;
constexpr int TOKL_ROUNDS = 10;

#define RLX_AGENT __ATOMIC_RELAXED, __HIP_MEMORY_SCOPE_AGENT
#define LDS_WAIT() asm volatile("s_waitcnt lgkmcnt(0)" ::: "memory")
#define VM_WAIT() asm volatile("s_waitcnt vmcnt(0)" ::: "memory")
#define XB_TMO      128
#define XB_XCNT(j)  (256  + 64 * (j))
#define XB_XSUB(j)  (1280 + 64 * (j))
#define XB_XGEN(j)  (2304 + 64 * (j))
#define XB_TOP      3328
#define XB_TOPGEN   3392
#define XCD_BAR_WORDS 3456
#define XB_SPIN_CAP (1u << 18)

__device__ __forceinline__ unsigned xb_ld(unsigned* p)              { return __hip_atomic_load(p, __ATOMIC_RELAXED, __HIP_MEMORY_SCOPE_AGENT); }
__device__ __forceinline__ unsigned xb_add(unsigned* p, unsigned v) { return __hip_atomic_fetch_add(p, v, __ATOMIC_RELAXED, __HIP_MEMORY_SCOPE_AGENT); }
__device__ __forceinline__ unsigned xb_xcc_id() { return (unsigned)__builtin_amdgcn_s_getreg((3 << 11) | 20) & 0xFu; }
#define XB_SPIN(cond, bar) do { unsigned _sp = 0; while (cond) { __builtin_amdgcn_s_sleep(1); \
    if ((++_sp & 255u) == 0u) { if (xb_ld(&(bar)[XB_TMO])) break; if (_sp > XB_SPIN_CAP) { atomicAdd(&(bar)[XB_TMO], 1u); break; } } } } while (0)

struct XcdBarrier {
    unsigned* bar; unsigned x;
    volatile LAS unsigned* st;
};

__device__ __forceinline__ XcdBarrier xcd_barrier_post(unsigned* bar, volatile LAS unsigned* st) {
    XcdBarrier b; b.bar = bar; b.x = xb_xcc_id(); b.st = st;
    if (threadIdx.x == 0) (void)xb_add(&bar[XB_XCNT(b.x)], 1u);
    return b;
}
__device__ __forceinline__ void xcd_barrier_complete(unsigned* bar, unsigned x, unsigned& nloc, unsigned& nx) {
    const unsigned G = gridDim.x * gridDim.y * gridDim.z;
    unsigned sum, cnt, mine, sp = 0u;
    for (;;) {
        sum = 0u; cnt = 0u; mine = 0u;
#pragma unroll
        for (unsigned j = 0; j < 16; ++j) { const unsigned c = xb_ld(&bar[XB_XCNT(j)]); sum += c; cnt += (c > 0u) ? 1u : 0u; mine = (j == x) ? c : mine; }
        if (sum == G) break;
        __builtin_amdgcn_s_sleep(1);
        if ((++sp & 255u) == 0u) { if (xb_ld(&bar[XB_TMO])) break; if (sp > XB_SPIN_CAP) { atomicAdd(&bar[XB_TMO], 1u); break; } }
    }
    nloc = mine > 0u ? mine : 1u; nx = cnt > 0u ? cnt : 1u;
}

__device__ __forceinline__ void xcd_barrier(const XcdBarrier& b) {
    asm volatile("s_waitcnt vmcnt(0)" ::: "memory");
    __syncthreads();
    if (threadIdx.x == 0) {
        unsigned* bar = b.bar;
        __builtin_amdgcn_s_waitcnt(0);
        unsigned nloc = b.st[0], nx = b.st[1];
        if (nloc == 0u) { xcd_barrier_complete(bar, b.x, nloc, nx); b.st[0] = nloc; b.st[1] = nx; }
        const unsigned old = xb_add(&bar[XB_XSUB(b.x)], 1u);
        const unsigned gen = old / nloc;
        if (old + 1u == (gen + 1u) * nloc) {
            __builtin_amdgcn_fence(__ATOMIC_RELEASE, "agent");
            asm volatile("s_waitcnt vmcnt(0)" ::: "memory");
            const unsigned og = xb_add(&bar[XB_TOP], 1u);
            const unsigned tg = og / nx;
            if (og + 1u == (tg + 1u) * nx) xb_add(&bar[XB_TOPGEN], 1u);
            else XB_SPIN(xb_ld(&bar[XB_TOPGEN]) == tg, bar);
            __builtin_amdgcn_fence(__ATOMIC_ACQUIRE, "agent");
            xb_add(&bar[XB_XGEN(b.x)], 1u);
            asm volatile("s_waitcnt vmcnt(0)" ::: "memory");
        } else {
            XB_SPIN(xb_ld(&bar[XB_XGEN(b.x)]) == gen, bar);
            __builtin_amdgcn_fence(__ATOMIC_ACQUIRE, "agent");
            asm volatile("s_waitcnt vmcnt(0)" ::: "memory");
        }
    }
    __syncthreads();
}
using pg8::Unit; using pg8::Gemm;
typedef f32x4 (&AccRef)[2][2][4][2];

#ifndef TAIL_FIRST
#define TAIL_FIRST 0
#endif
__device__ __forceinline__ bool moe_unit(int i, int G, int c, int nT, int nN, int& pm, int& pn, int& half) {
    const int U = nT * nN, R = U / G, rem = U - R * G; half = 0;
#if TAIL_FIRST
    if (rem > 0 && 2 * rem <= G) {
        if (c < 2 * rem) { if (i == 0) { half = 1 + (c & 1); return pg8::tile_order(0, U, R * G + (c >> 1), nT, nN, pm, pn); } --i; }
        if (i < R) return pg8::tile_order(i, G, c, nT, nN, pm, pn);
        return false; }
#endif
    if (i < R) return pg8::tile_order(i, G, c, nT, nN, pm, pn);
    if (i > R || rem == 0) return false;
    if (2 * rem <= G) { if (c >= 2 * rem) return false; half = 1 + (c & 1); return pg8::tile_order(0, U, R * G + (c >> 1), nT, nN, pm, pn); }
    return pg8::tile_order(i, G, c, nT, nN, pm, pn);
}
struct DenseSched {
    int nM, nN, G, c; const char* A; const char* B; size_t tstepA, tstepB; bool split = false;
    __device__ __forceinline__ bool next(int i, Unit& u) const {
        int half = 0;
        if (split) { if (!moe_unit(i, G, c, nM, nN, u.pm, u.pn, half)) return false; }
        else if (!pg8::tile_order(i, G, c, nM, nN, u.pm, u.pn)) return false;
        u.A = A + (size_t)u.pm * tstepA; u.B = B + (size_t)u.pn * tstepB; u.tl = nullptr; u.x0 = u.x1 = 0; u.x2 = half; return true; }
};
struct MoeSched {
    int nT, nN, G, c; const LAS int* tile_e; const LAS int* tbase; const LAS unsigned short* tokl;
    const char* A; const char* B; size_t tstepA, estepB, tstepB;
    __device__ __forceinline__ bool next(int i, Unit& u) const {
        int half; if (!moe_unit(i, G, c, nT, nN, u.pm, u.pn, half)) return false;
        const int e = tile_e[u.pm];
        u.x0 = e; u.x1 = u.pm * 256; u.x2 = half;
        u.A = A + (size_t)u.pm * tstepA; u.B = B + (size_t)e * estepB + (size_t)u.pn * tstepB;
        u.tl = tokl ? tokl + (i < TOKL_ROUNDS ? i : TOKL_ROUNDS - 1) * 256 : nullptr; return true; }
};
struct MuSched {
    int G, c, mode; const char* A; const char* B;
    __device__ __forceinline__ bool next(int i, Unit& u) const {
        const int mu = i * G + c; if (mu >= 256) return false;
        const int b = mu >> 6, hh = (mu >> 4) & 3, ch = mu & 15; const size_t tok0 = (size_t)b * SEQ + (size_t)ch * 256;
        u.pm = mu; u.pn = 0; u.x0 = mu; u.x1 = u.x2 = 0; u.tl = nullptr;
        if (mode == 0) { u.A = A + (size_t)mu * 256 * 384 * 2; u.B = B + ((size_t)(hh * 128) * NTOK + tok0) * 2; }
        else if (mode == 1) { u.A = A + ((size_t)mu * 256 * 512 + 256) * 2; u.B = B + (tok0 * 1024 + (size_t)hh * 256) * 2; }
        else { u.A = A + (size_t)mu * 256 * 512 * 2; u.B = B + (size_t)mu * 256 * 384 * 2; }
        return true; }
};

constexpr float C2 = 0.125f * 1.4426950408889634f;

struct EpiQKV {
    static constexpr bool PERM = true;
    __device__ __forceinline__ void prep(const Unit&, int, int, int) const {}
    bf16_t* Q; bf16_t* K; bf16_t* V; const float* rope; float* ksum;
    __device__ __forceinline__ void operator()(AccRef acc, const Unit& u, int wr, int wc, int fr, int fq) const {
        asm volatile("" : "+v"(fr), "+v"(fq));
        const int part = u.pn >> 2, colt = (u.pn & 3) * 256;
        bf16_t* base = Q + (size_t)part * ((WS_K - WS_Q) / 2);
        const bool rot = (part < 2) && ((wc & 1) == 0);
        const float sgn = (fq == 0) ? -1.f : 1.f;
        float ks[2][8];
#pragma unroll
        for (int bj = 0; bj < 2; ++bj)
#pragma unroll
            for (int j = 0; j < 8; ++j) ks[bj][j] = 0.f;
#pragma unroll
        for (int ai = 0; ai < 2; ++ai)
#pragma unroll
            for (int m = 0; m < 4; ++m) {
                const int row = u.pm * 256 + ai * 128 + wr * 64 + m * 16 + fr;
                f32x4 cs0 = {1.f, 1.f, 1.f, 1.f}, cs1 = cs0, sn0 = {0.f, 0.f, 0.f, 0.f}, sn1 = sn0;
                if (rot) { const f32x4* rp = (const f32x4*)(rope + (size_t)row * 16); cs0 = rp[0]; cs1 = rp[1]; sn0 = rp[2]; sn1 = rp[3]; }
#pragma unroll
                for (int bj = 0; bj < 2; ++bj) {
                    f32x4 v0 = acc[ai][bj][m][0], v1 = acc[ai][bj][m][1];
                    if (rot) {
                        f32x4 p0, p1;
#pragma unroll
                        for (int j = 0; j < 4; ++j) { p0[j] = __shfl_xor(v0[j], 16); p1[j] = __shfl_xor(v1[j], 16); }
                        if (fq < 2) { v0 = v0 * cs0 + p0 * sn0 * sgn; v1 = v1 * cs1 + p1 * sn1 * sgn; }
                    }
                    if (part == 0) { v0 = v0 * C2; v1 = v1 * C2; }
                    if (part == 1) {
#pragma unroll
                        for (int j = 0; j < 4; ++j) { ks[bj][j] += v0[j]; ks[bj][4 + j] += v1[j]; } }
                    u32x4 w; w.x = cvt_pk_bf16(v0[0], v0[1]); w.y = cvt_pk_bf16(v0[2], v0[3]); w.z = cvt_pk_bf16(v1[0], v1[1]); w.w = cvt_pk_bf16(v1[2], v1[3]);
                    *(u32x4*)(base + (size_t)row * DM + colt + bj * 128 + wc * 32 + fq * 8) = w;
                }
            }
        if (part == 1) {
#pragma unroll
            for (int bj = 0; bj < 2; ++bj)
#pragma unroll
                for (int j = 0; j < 8; ++j) { float s = ks[bj][j]; s += __shfl_xor(s, 1); s += __shfl_xor(s, 2); s += __shfl_xor(s, 4); s += __shfl_xor(s, 8);
                    if (fr == 0) atomicAdd(ksum + (size_t)u.pm * DM + colt + bj * 128 + wc * 32 + fq * 8 + j, s); }
        }
    }
};

struct EpiZ {
    static constexpr bool PERM = false;
    __device__ __forceinline__ void prep(const Unit&, int, int, int) const {}
    const float* xin; float* z; float ymul;
    __device__ __forceinline__ void operator()(AccRef acc, const Unit& u, int wr, int wc, int fr, int fq) const {
        asm volatile("" : "+v"(fr), "+v"(fq));
#pragma unroll
        for (int ai = 0; ai < 2; ++ai) {
            const size_t off0 = (size_t)(u.pm * 256 + ai * 128 + wr * 64 + fr) * DM + u.pn * 256 + wc * 32 + fq * 4;
            f32x4 xr[4][2][2];
#pragma unroll
            for (int m = 0; m < 4; ++m)
#pragma unroll
                for (int bj = 0; bj < 2; ++bj)
#pragma unroll
                    for (int n = 0; n < 2; ++n) xr[m][bj][n] = *(const f32x4*)(xin + off0 + (size_t)m * 16 * DM + bj * 128 + n * 16);
#pragma unroll
            for (int m = 0; m < 4; ++m)
#pragma unroll
                for (int bj = 0; bj < 2; ++bj)
#pragma unroll
                    for (int n = 0; n < 2; ++n) *(f32x4*)(z + off0 + (size_t)m * 16 * DM + bj * 128 + n * 16) = xr[m][bj][n] * ALPHA + acc[ai][bj][m][n] * ymul;
            asm volatile("" ::: "memory");
        }
    }
};

__device__ __forceinline__ float swiglu1(float glu, float lin) {
    const float g = fminf(glu, 7.0f), l = fminf(fmaxf(lin, -7.0f), 7.0f);
    const float sg = __builtin_amdgcn_rcpf(1.0f + __builtin_amdgcn_exp2f(-1.702f * 1.4426950408889634f * g));
    return g * sg * (l + 1.0f);
}
__device__ __forceinline__ f32x2 swiglu2(float glu0, float lin0, float glu1, float lin1) {
    const f32x2 g = {fminf(glu0, 7.0f), fminf(glu1, 7.0f)}, l = {fminf(fmaxf(lin0, -7.0f), 7.0f), fminf(fmaxf(lin1, -7.0f), 7.0f)};
    const f32x2 t = g * (f32x2){-1.702f * 1.4426950408889634f, -1.702f * 1.4426950408889634f};
    const f32x2 d = (f32x2){__builtin_amdgcn_exp2f(t[0]), __builtin_amdgcn_exp2f(t[1])} + (f32x2){1.0f, 1.0f};
    const f32x2 r = {__builtin_amdgcn_rcpf(d[0]), __builtin_amdgcn_rcpf(d[1])};
    const f32x2 lp = l * (f32x2){FP8_SA, FP8_SA} + (f32x2){FP8_SA, FP8_SA};
    return (g * lp) * r;
}
struct EpiGU {
    static constexpr bool PERM = true;
    __device__ __forceinline__ void prep(const Unit& u, int ui, int wid, int lane) const { if (wid < 4) glds4s(uni_ptr((const char*)(bias + (size_t)u.x0 * 2048 + u.pn * 256 + wid * 64)), (unsigned)lane * 4u, (unsigned)__builtin_amdgcn_readfirstlane((unsigned)(unsigned long long)bl + (unsigned)(((ui & 1) * 256 + wid * 64) * 4))); }
    const float* bias; unsigned char* H; LAS float* bl; mutable int ucnt;
    __device__ __forceinline__ void operator()(AccRef acc, const Unit& u, int wr, int wc, int fr, int fq) const {
        asm volatile("" : "+v"(fr), "+v"(fq));
        const int c0 = u.pn * 256 + wc * 32 + fq * 8; const LAS float* bp = bl + (ucnt & 1) * 256 + wc * 32 + fq * 8; ++ucnt; constexpr float SC = 1.0f / (FP8_SA * FP8_SWGU);
        f32x4 b[2][2];
#pragma unroll
        for (int bj = 0; bj < 2; ++bj) { b[bj][0] = *(const LAS f32x4*)(bp + bj * 128); b[bj][1] = *(const LAS f32x4*)(bp + bj * 128 + 4); }
#pragma unroll
        for (int ai = 0; ai < 2; ++ai)
#pragma unroll
            for (int m = 0; m < 4; ++m) {
                unsigned char* rowp = H + (size_t)(u.x1 + ai * 128 + wr * 64 + m * 16 + fr) * DM + (c0 >> 1);
#pragma unroll
                for (int bj = 0; bj < 2; ++bj) { if (u.x2 == 2 - bj) continue;
                    const f32x4 v0 = acc[ai][bj][m][0] * SC + b[bj][0], v1 = acc[ai][bj][m][1] * SC + b[bj][1];
                    const f32x2 h0 = swiglu2(v0[0], v0[1], v0[2], v0[3]), h1 = swiglu2(v1[0], v1[1], v1[2], v1[3]);
                    int w = __builtin_amdgcn_cvt_pk_fp8_f32(h0[0], h0[1], 0, false);
                    w = __builtin_amdgcn_cvt_pk_fp8_f32(h1[0], h1[1], w, true);
                    *(int*)(rowp + bj * 64) = w; }
            }
    }
};
struct EpiDN {
    static constexpr bool PERM = true;
    __device__ __forceinline__ void prep(const Unit& u, int ui, int wid, int lane) const { if (wid < 4) glds4s(uni_ptr((const char*)(bias + (size_t)u.x0 * 1024 + u.pn * 256 + wid * 64)), (unsigned)lane * 4u, (unsigned)__builtin_amdgcn_readfirstlane((unsigned)(unsigned long long)bl + (unsigned)(((ui & 1) * 256 + wid * 64) * 4))); }
    const float* bias; bf16_t* Y; LAS float* bl; mutable int ucnt;
    __device__ __forceinline__ void operator()(AccRef acc, const Unit& u, int wr, int wc, int fr, int fq) const {
        asm volatile("" : "+v"(fr), "+v"(fq));
        const int c0 = u.pn * 256 + wc * 32 + fq * 8; const LAS float* bp = bl + (ucnt & 1) * 256 + wc * 32 + fq * 8; ++ucnt; constexpr float SC = 1.0f / (FP8_SA * FP8_SWD);
        f32x4 b[2][2];
#pragma unroll
        for (int bj = 0; bj < 2; ++bj) { b[bj][0] = *(const LAS f32x4*)(bp + bj * 128); b[bj][1] = *(const LAS f32x4*)(bp + bj * 128 + 4); }
#pragma unroll
        for (int ai = 0; ai < 2; ++ai)
#pragma unroll
            for (int m = 0; m < 4; ++m) {
                bf16_t* rowp = Y + (size_t)(u.x1 + ai * 128 + wr * 64 + m * 16 + fr) * DM + c0;
#pragma unroll
                for (int bj = 0; bj < 2; ++bj) { if (u.x2 == 2 - bj) continue;
                    const f32x4 v0 = acc[ai][bj][m][0] * SC + b[bj][0], v1 = acc[ai][bj][m][1] * SC + b[bj][1];
                    u32x4 w; w.x = cvt_pk_bf16(v0[0], v0[1]); w.y = cvt_pk_bf16(v0[2], v0[3]); w.z = cvt_pk_bf16(v1[0], v1[1]); w.w = cvt_pk_bf16(v1[2], v1[3]);
                    *(u32x4*)(rowp + bj * 128) = w; }
            }
    }
};

struct EpiINA {
    static constexpr bool PERM = true;
    __device__ __forceinline__ void prep(const Unit&, int, int, int) const {}
    const float* rf; const float* cf; bf16_t* AE; bf16_t* KN; bf16_t* OS;
    __device__ __forceinline__ void operator()(AccRef acc, const Unit& u, int wr, int wc, int fr, int fq) const {
        asm volatile("" : "+v"(fr), "+v"(fq));
        const int b = u.pm >> 4, ch = u.pm & 15, d0 = wc * 32 + fq * 8; const u32x4 zero = {0u, 0u, 0u, 0u};
        if (u.pn < 4) {
            const bool isq = u.pn < 2; const float* fac = isq ? rf : cf; const float fs = isq ? 1.0f : RSQRT_DQK; const int h0 = (u.pn & 1) * 2;
            float sf[2][4][2];
#pragma unroll
            for (int ai = 0; ai < 2; ++ai)
#pragma unroll
                for (int m = 0; m < 4; ++m)
#pragma unroll
                    for (int bj = 0; bj < 2; ++bj) sf[ai][m][bj] = fac[(size_t)(h0 + bj) * NTOK + (size_t)u.pm * 256 + ai * 128 + wr * 64 + m * 16 + fr];
#pragma unroll
            for (int ai = 0; ai < 2; ++ai)
#pragma unroll
                for (int m = 0; m < 4; ++m) {
                    const int t = ai * 128 + wr * 64 + m * 16 + fr; const size_t token = (size_t)u.pm * 256 + t;
#pragma unroll
                    for (int bj = 0; bj < 2; ++bj) { const int hh = h0 + bj; const float s = sf[ai][m][bj] * fs;
                        const f32x4 v0 = acc[ai][bj][m][0] * s, v1 = acc[ai][bj][m][1] * s;
                        const size_t oq = ((size_t)(((b * 4 + hh) * 16 + ch) * 256 + t)) * 512 + 256 + d0, ok = token * 1024 + hh * 256 + d0;
                        bf16_t* dst = isq ? (AE + oq) : (KN + ok);
                        u32x4 w; w.x = cvt_pk_bf16(v0[0], v0[1]); w.y = cvt_pk_bf16(v0[2], v0[3]); w.z = cvt_pk_bf16(v1[0], v1[1]); w.w = cvt_pk_bf16(v1[2], v1[3]);
                        *(u32x4*)dst = w; }
                }
        } else {
#pragma unroll
            for (int ai = 0; ai < 2; ++ai)
#pragma unroll
                for (int m = 0; m < 4; ++m) {
                    const int t = ai * 128 + wr * 64 + m * 16 + fr; const size_t token = (size_t)u.pm * 256 + t;
#pragma unroll
                    for (int bj = 0; bj < 2; ++bj) { f32x4 v0 = acc[ai][bj][m][0], v1 = acc[ai][bj][m][1];
#pragma unroll
                        for (int j = 0; j < 4; ++j) { v0[j] = __builtin_amdgcn_rcpf(1.0f + __builtin_amdgcn_exp2f(-1.4426950408889634f * v0[j])); v1[j] = __builtin_amdgcn_rcpf(1.0f + __builtin_amdgcn_exp2f(-1.4426950408889634f * v1[j])); }
                        u32x4 w; w.x = cvt_pk_bf16(v0[0], v0[1]); w.y = cvt_pk_bf16(v0[2], v0[3]); w.z = cvt_pk_bf16(v1[0], v1[1]); w.w = cvt_pk_bf16(v1[2], v1[3]);
                        *(u32x4*)(OS + token * 1024 + (u.pn - 4) * 256 + bj * 128 + d0) = w; }
                }
        }
    }
};
struct EpiINB {
    static constexpr bool PERM = true;
    __device__ __forceinline__ void prep(const Unit&, int, int, int) const {}
    const float* cf; bf16_t* KT; bf16_t* BE;
    __device__ __forceinline__ void operator()(AccRef acc, const Unit& u, int wr, int wc, int fr, int fq) const {
        asm volatile("" : "+v"(fr), "+v"(fq));
        const int b = u.pn >> 4, ch = u.pn & 15;
        f32x4 cv[2][2][2];
#pragma unroll
        for (int ai = 0; ai < 2; ++ai)
#pragma unroll
            for (int bj = 0; bj < 2; ++bj) { const size_t tok0 = (size_t)u.pn * 256 + bj * 128 + wc * 32 + fq * 8;
                if (u.pm < 2) { const int hh = u.pm * 2 + ai; cv[ai][bj][0] = *(const f32x4*)(cf + (size_t)hh * NTOK + tok0) * RSQRT_DQK; cv[ai][bj][1] = *(const f32x4*)(cf + (size_t)hh * NTOK + tok0 + 4) * RSQRT_DQK; }
                else { cv[ai][bj][0] = (f32x4){1.f, 1.f, 1.f, 1.f}; cv[ai][bj][1] = cv[ai][bj][0]; } }
#pragma unroll
        for (int ai = 0; ai < 2; ++ai)
#pragma unroll
            for (int m = 0; m < 4; ++m) {
                const int R = u.pm * 256 + ai * 128 + wr * 64 + m * 16 + fr;
#pragma unroll
                for (int bj = 0; bj < 2; ++bj) { if (u.x2 == 2 - bj) continue;
                    const f32x4 v0 = acc[ai][bj][m][0] * cv[ai][bj][0], v1 = acc[ai][bj][m][1] * cv[ai][bj][1]; const int s0 = bj * 128 + wc * 32 + fq * 8; const size_t tok0 = (size_t)u.pn * 256 + s0; bf16_t* dst;
                    if (u.pm < 2) dst = KT + (size_t)R * NTOK + tok0;
                    else { const int eg = R - 512, hh = eg >> 8, e = eg & 255; dst = BE + ((size_t)(((b * 4 + hh) * 16 + ch) * 256 + e)) * 384 + s0; }
                    u32x4 w; w.x = cvt_pk_bf16(v0[0], v0[1]); w.y = cvt_pk_bf16(v0[2], v0[3]); w.z = cvt_pk_bf16(v1[0], v1[1]); w.w = cvt_pk_bf16(v1[2], v1[3]);
                    *(u32x4*)dst = w;
                }
            }
    }
};
struct EpiM1 {
    static constexpr bool PERM = false;
    __device__ __forceinline__ void prep(const Unit&, int, int, int) const {}
    float* UT;
    __device__ __forceinline__ void operator()(AccRef acc, const Unit& u, int wr, int wc, int fr, int fq) const {
        asm volatile("" : "+v"(fr), "+v"(fq));
#pragma unroll
        for (int ai = 0; ai < 2; ++ai)
#pragma unroll
            for (int m = 0; m < 4; ++m) { float* rowp = UT + ((size_t)u.x0 * 256 + ai * 128 + wr * 64 + m * 16 + fr) * 128 + wc * 32 + fq * 4;
#pragma unroll
                for (int n = 0; n < 2; ++n) *(f32x4*)(rowp + n * 16) = acc[ai][0][m][n]; }
    }
};
struct EpiM2A {
    static constexpr bool PERM = true;
    __device__ __forceinline__ void prep(const Unit&, int, int, int) const {}
    bf16_t* AE; const float* nprev; float* den;
    __device__ __forceinline__ void operator()(AccRef acc, const Unit& u, int wr, int wc, int fr, int fq) const {
        asm volatile("" : "+v"(fr), "+v"(fq));
        const int mu = u.x0, dd = wc * 32 + fq * 8;
        const f32x4 n0 = *(const f32x4*)(nprev + (size_t)mu * 128 + dd), n1 = *(const f32x4*)(nprev + (size_t)mu * 128 + dd + 4);
        u32x4 qv8[2][4];
#pragma unroll
        for (int ai = 0; ai < 2; ++ai)
#pragma unroll
            for (int m = 0; m < 4; ++m) qv8[ai][m] = *(const u32x4*)(AE + ((size_t)mu * 256 + ai * 128 + wr * 64 + m * 16 + fr) * 512 + 256 + dd);
#pragma unroll
        for (int ai = 0; ai < 2; ++ai)
#pragma unroll
            for (int m = 0; m < 4; ++m) {
                const int t = ai * 128 + wr * 64 + m * 16 + fr; bf16_t* rowp = AE + ((size_t)mu * 256 + t) * 512;
                const u32x4 qv = qv8[ai][m];
                float part = bflo(qv.x) * n0[0] + bfhi(qv.x) * n0[1] + bflo(qv.y) * n0[2] + bfhi(qv.y) * n0[3] + bflo(qv.z) * n1[0] + bfhi(qv.z) * n1[1] + bflo(qv.w) * n1[2] + bfhi(qv.w) * n1[3];
#pragma unroll
                for (int bj = 0; bj < 2; ++bj) { const int s0 = bj * 128 + wc * 32 + fq * 8; f32x4 v0 = acc[ai][bj][m][0], v1 = acc[ai][bj][m][1];
                    int dts = t - s0; asm volatile("" : "+v"(dts));
#pragma unroll
                    for (int j = 0; j < 4; ++j) { v0[j] = (j <= dts) ? v0[j] : 0.f; v1[j] = (4 + j <= dts) ? v1[j] : 0.f; part += v0[j] + v1[j]; }
                    u32x4 w; w.x = cvt_pk_bf16(v0[0], v0[1]); w.y = cvt_pk_bf16(v0[2], v0[3]); w.z = cvt_pk_bf16(v1[0], v1[1]); w.w = cvt_pk_bf16(v1[2], v1[3]);
                    *(u32x4*)(rowp + s0) = w; }
                part += __shfl_xor(part, 16); part += __shfl_xor(part, 32);
                if (fq == 0) atomicAdd(den + (size_t)mu * 256 + (wr * 64 + fr) + (ai * 128 + m * 16), part);
            }
    }
};
struct EpiM2B {
    static constexpr bool PERM = true;
    __device__ __forceinline__ void prep(const Unit&, int, int, int) const {}
    const float* den; const float* normg; const bf16_t* OS; bf16_t* HN; LAS float* lnx;
    __device__ __forceinline__ void operator()(AccRef acc, const Unit& u, int wr, int wc, int fr, int fq) const {
        asm volatile("" : "+v"(fr), "+v"(fq));
        const int mu = u.x0, b = mu >> 6, hh = (mu >> 4) & 3, ch = mu & 15;
        float dnv[2][4];
#pragma unroll
        for (int ai = 0; ai < 2; ++ai)
#pragma unroll
            for (int m = 0; m < 4; ++m) dnv[ai][m] = den[(size_t)mu * 256 + ai * 128 + wr * 64 + m * 16 + fr];
#pragma unroll
        for (int ai = 0; ai < 2; ++ai)
#pragma unroll
            for (int m = 0; m < 4; ++m) {
                const int t = ai * 128 + wr * 64 + m * 16 + fr; const float dn = dnv[ai][m];
#ifdef DBG_DEN1
                const float inv = 1.0f;
#else
                const float inv = 1.0f / fmaxf(fabsf(dn), 1.0f);
#endif
                float s1 = 0.f, s2 = 0.f;
#pragma unroll
                for (int bj = 0; bj < 2; ++bj)
#pragma unroll
                    for (int n = 0; n < 2; ++n) { f32x4 h = acc[ai][bj][m][n] * inv; acc[ai][bj][m][n] = h; s1 += (h[0] + h[1]) + (h[2] + h[3]); s2 += (h[0] * h[0] + h[1] * h[1]) + (h[2] * h[2] + h[3] * h[3]); }
                s1 += __shfl_xor(s1, 16); s1 += __shfl_xor(s1, 32); s2 += __shfl_xor(s2, 16); s2 += __shfl_xor(s2, 32);
                if (fq == 0) { lnx[(t * 4 + wc) * 2] = s1; lnx[(t * 4 + wc) * 2 + 1] = s2; }
            }
        const int e0 = wc * 32 + fq * 8;
        f32x4 gg[2][2];
#pragma unroll
        for (int bj = 0; bj < 2; ++bj) { gg[bj][0] = *(const f32x4*)(normg + hh * 256 + bj * 128 + e0); gg[bj][1] = *(const f32x4*)(normg + hh * 256 + bj * 128 + e0 + 4); }
        asm volatile("s_waitcnt lgkmcnt(0)" ::: "memory"); __builtin_amdgcn_s_barrier(); asm volatile("" ::: "memory");
#pragma unroll
        for (int ai = 0; ai < 2; ++ai) {
            u32x4 ovv[4][2];
#pragma unroll
            for (int m = 0; m < 4; ++m)
#pragma unroll
                for (int bj = 0; bj < 2; ++bj) ovv[m][bj] = *(const u32x4*)(OS + (((size_t)(b * 16 + ch)) * 256 + ai * 128 + wr * 64 + m * 16 + fr) * 1024 + hh * 256 + bj * 128 + e0);
#pragma unroll
            for (int m = 0; m < 4; ++m) {
                const int t = ai * 128 + wr * 64 + m * 16 + fr; const size_t token = ((size_t)(b * 16 + ch)) * 256 + t;
                const LAS f32x4* lp = (const LAS f32x4*)(lnx + t * 8); const f32x4 a = lp[0], c = lp[1];
                const float mean = (a[0] + a[2] + c[0] + c[2]) * (1.0f / 256.0f); const float ex2 = (a[1] + a[3] + c[1] + c[3]) * (1.0f / 256.0f);
                const float rstd = 1.0f / sqrtf(fmaxf(ex2 - mean * mean, 0.f) + LN_EPS);
#pragma unroll
                for (int bj = 0; bj < 2; ++bj) { const int e = bj * 128 + e0; const size_t off = token * 1024 + hh * 256 + e; const u32x4 ov = ovv[m][bj];
#ifdef DBG_HN_OS
                    f32x4 v0 = {1.f, 1.f, 1.f, 1.f}, v1 = v0;
#elif defined(DBG_HN_RAW)
                    f32x4 v0 = acc[ai][bj][m][0], v1 = acc[ai][bj][m][1];
#else
                    f32x4 v0 = (acc[ai][bj][m][0] - mean) * rstd * gg[bj][0], v1 = (acc[ai][bj][m][1] - mean) * rstd * gg[bj][1];
#endif
#ifndef DBG_HN_ONE
                    v0[0] *= bflo(ov.x); v0[1] *= bfhi(ov.x); v0[2] *= bflo(ov.y); v0[3] *= bfhi(ov.y); v1[0] *= bflo(ov.z); v1[1] *= bfhi(ov.z); v1[2] *= bflo(ov.w); v1[3] *= bfhi(ov.w);
#endif
                    u32x4 w; w.x = cvt_pk_bf16(v0[0], v0[1]); w.y = cvt_pk_bf16(v0[2], v0[3]); w.z = cvt_pk_bf16(v1[0], v1[1]); w.w = cvt_pk_bf16(v1[2], v1[3]);
                    *(u32x4*)(HN + off) = w; }
            }
            asm volatile("" ::: "memory");
        }
        asm volatile("s_waitcnt lgkmcnt(0)" ::: "memory"); __builtin_amdgcn_s_barrier(); asm volatile("" ::: "memory");
    }
};
struct Frame {
    LAS unsigned char* lds;
    unsigned* ctl;
    unsigned char* ws;
    int tid, lane, wave, vcu, G;
};
__device__ __forceinline__ float wave_sum(float v) {
#pragma unroll
    for (int o = 1; o < 64; o <<= 1) v += __shfl_xor(v, o);
    return v;
}

__device__ __forceinline__ void tr_block(const float* src, size_t pitch, bf16_t* dst, size_t kd, int kb, int nb, LAS unsigned* scr, int lane) {
    const float* s0 = src + (size_t)(64 * kb) * pitch + 64 * nb + 4 * (lane & 15);
#pragma unroll
    for (int i = 0; i < 8; ++i) {
        const int kp = 4 * i + (lane >> 4);
        const f32x4 a = __builtin_nontemporal_load((const f32x4*)(s0 + (size_t)(2 * kp) * pitch)), b = __builtin_nontemporal_load((const f32x4*)(s0 + (size_t)(2 * kp + 1) * pitch));
#pragma unroll
        for (int j = 0; j < 4; ++j) scr[(4 * (lane & 15) + j) * 33 + kp] = cvt_pk_bf16(a[j], b[j]);
    }
    LDS_WAIT(); asm volatile("" ::: "memory");
    u32x4 o[8];
#pragma unroll
    for (int c = 0; c < 8; ++c) { const int rr = 8 * c + (lane >> 3), q4 = 4 * (lane & 7); o[c].x = scr[rr * 33 + q4]; o[c].y = scr[rr * 33 + q4 + 1]; o[c].z = scr[rr * 33 + q4 + 2]; o[c].w = scr[rr * 33 + q4 + 3]; }
    bf16_t* d = dst + (size_t)(64 * nb + (lane >> 3)) * kd + 64 * kb + 8 * (lane & 7);
#pragma unroll
    for (int c = 0; c < 8; ++c) *(u32x4*)(d + (size_t)(8 * c) * kd) = o[c];
    LDS_WAIT(); asm volatile("" ::: "memory");
}
__device__ __forceinline__ void tr_block8(const float* src, size_t pitch, unsigned char* dst, size_t kd, int kb, int nb, float scale, LAS unsigned* scr, int lane) {
    const float* s0 = src + (size_t)(128 * kb) * pitch + 64 * nb + 4 * (lane & 15);
#pragma unroll
    for (int i = 0; i < 8; ++i) {
        const int kq = 4 * i + (lane >> 4);
        const f32x4 r0 = __builtin_nontemporal_load((const f32x4*)(s0 + (size_t)(4 * kq) * pitch)) * scale, r1 = __builtin_nontemporal_load((const f32x4*)(s0 + (size_t)(4 * kq + 1) * pitch)) * scale,
                    r2 = __builtin_nontemporal_load((const f32x4*)(s0 + (size_t)(4 * kq + 2) * pitch)) * scale, r3 = __builtin_nontemporal_load((const f32x4*)(s0 + (size_t)(4 * kq + 3) * pitch)) * scale;
#pragma unroll
        for (int j = 0; j < 4; ++j) { int w = __builtin_amdgcn_cvt_pk_fp8_f32(r0[j], r1[j], 0, false); w = __builtin_amdgcn_cvt_pk_fp8_f32(r2[j], r3[j], w, true); scr[(4 * (lane & 15) + j) * 33 + kq] = (unsigned)w; }
    }
    LDS_WAIT(); asm volatile("" ::: "memory");
    u32x4 o[8];
#pragma unroll
    for (int c = 0; c < 8; ++c) { const int rr = 8 * c + (lane >> 3), q4 = 4 * (lane & 7); o[c].x = scr[rr * 33 + q4]; o[c].y = scr[rr * 33 + q4 + 1]; o[c].z = scr[rr * 33 + q4 + 2]; o[c].w = scr[rr * 33 + q4 + 3]; }
    unsigned char* d = dst + (size_t)(64 * nb + (lane >> 3)) * kd + 128 * kb + 16 * (lane & 7);
#pragma unroll
    for (int c = 0; c < 8; ++c) *(u32x4*)(d + (size_t)(8 * c) * kd) = o[c];
    LDS_WAIT(); asm volatile("" ::: "memory");
}
constexpr int CONV_ITEMS = 24576;
struct ConvItem { const float* s0; size_t pitch; unsigned char* d; float scale; };
__device__ __forceinline__ ConvItem conv_desc(const float* wgu, const float* wd, unsigned char* ws, int v, int lane) {
    const int layer = v >= 12288; int r = v - layer * 12288; ConvItem it;
    if (r < 8192) { const int mat = layer * 32 + (r >> 8); r &= 255; const int kb = r >> 5, nb = r & 31; it.pitch = 2048; it.scale = FP8_SWGU;
        it.s0 = wgu + (size_t)mat * 1024 * 2048 + (size_t)(128 * kb) * 2048 + 64 * nb + 4 * (lane & 15); it.d = ws + WS_WGU + (size_t)mat * 2048 * 1024 + (size_t)(64 * nb + (lane >> 3)) * 1024 + 128 * kb + 16 * (lane & 7); }
    else { r -= 8192; const int mat = layer * 32 + (r >> 7); r &= 127; const int kb = r >> 4, nb = r & 15; it.pitch = 1024; it.scale = FP8_SWD;
        it.s0 = wd + (size_t)mat * 1024 * 1024 + (size_t)(128 * kb) * 1024 + 64 * nb + 4 * (lane & 15); it.d = ws + WS_WD + (size_t)mat * 1024 * 1024 + (size_t)(64 * nb + (lane >> 3)) * 1024 + 128 * kb + 16 * (lane & 7); }
    return it;
}
__device__ __forceinline__ void conv_items(Frame& F, const float* wgu, const float* wd, int v_lo, int v_hi, int cw, int ncw) {
    LAS unsigned* scr = (LAS unsigned*)(F.lds + RING_OFF + F.wave * 8448); unsigned char* ws = F.ws; const int lane = F.lane;
    int v = v_lo + cw; if (v >= v_hi) return;
    ConvItem cur = conv_desc(wgu, wd, ws, v, lane);
    f32x4 r[8][4];
#pragma unroll
    for (int i = 0; i < 8; ++i) { const int kq = 4 * i + (lane >> 4);
#pragma unroll
        for (int q = 0; q < 4; ++q) r[i][q] = __builtin_nontemporal_load((const f32x4*)(cur.s0 + (size_t)(4 * kq + q) * cur.pitch)); }
    for (;;) {
        const int vn = v + ncw; const bool has = vn < v_hi; ConvItem nx = cur; if (has) nx = conv_desc(wgu, wd, ws, vn, lane);
#pragma unroll
        for (int i = 0; i < 8; ++i) { const int kq = 4 * i + (lane >> 4);
#pragma unroll
            for (int j = 0; j < 4; ++j) { int w = __builtin_amdgcn_cvt_pk_fp8_f32(r[i][0][j] * cur.scale, r[i][1][j] * cur.scale, 0, false); w = __builtin_amdgcn_cvt_pk_fp8_f32(r[i][2][j] * cur.scale, r[i][3][j] * cur.scale, w, true); scr[(4 * (lane & 15) + j) * 33 + kq] = (unsigned)w; }
            if (has) {
#pragma unroll
                for (int q = 0; q < 4; ++q) r[i][q] = __builtin_nontemporal_load((const f32x4*)(nx.s0 + (size_t)(4 * kq + q) * nx.pitch)); } }
        LDS_WAIT(); asm volatile("" ::: "memory");
        u32x4 o[8];
#pragma unroll
        for (int c = 0; c < 8; ++c) { const int rr = 8 * c + (lane >> 3), q4 = 4 * (lane & 7); o[c].x = scr[rr * 33 + q4]; o[c].y = scr[rr * 33 + q4 + 1]; o[c].z = scr[rr * 33 + q4 + 2]; o[c].w = scr[rr * 33 + q4 + 3]; }
#pragma unroll
        for (int c = 0; c < 8; ++c) *(u32x4*)(cur.d + (size_t)(8 * c) * 1024) = o[c];
        LDS_WAIT(); asm volatile("" ::: "memory");
        if (!has) break;
        v = vn; cur = nx;
    }
}
struct P0In { const float *x, *wqkv, *wo, *win, *wout, *rw, *wgu, *wd; const int* pos; };
__device__ __forceinline__ void p0_prologue(Frame& F, const P0In& I) {
    LAS unsigned* scr = (LAS unsigned*)(F.lds + RING_OFF + F.wave * 8448);
    const int gw = F.vcu * NWAVES + F.wave, NGW = F.G * NWAVES;
    unsigned char* ws = F.ws;
    constexpr int KB = 16;
    constexpr int I_QKV = KB * 48, I_WO = KB * 16, I_INA1 = KB * 16, I_INA2 = KB * 16, I_INB = KB * 24, I_WOUT = KB * 16;
    constexpr int I_SMALL = I_QKV + I_WO + I_INA1 + I_INA2 + I_INB + I_WOUT;
    constexpr int NITEMS = I_SMALL;
    for (int it = gw; it < NITEMS; it += NGW) {
        int r = it; const float* src; size_t pitch; bf16_t* dst; int nbl;
        if (r < I_QKV) { src = I.wqkv; pitch = 3072; dst = (bf16_t*)(ws + WS_WQKV); nbl = 48; }
        else if ((r -= I_QKV) < I_WO) { src = I.wo; pitch = 1024; dst = (bf16_t*)(ws + WS_WO); nbl = 16; }
        else if ((r -= I_WO) < I_INA1) { src = I.win; pitch = 3080; dst = (bf16_t*)(ws + WS_WINA); nbl = 16; }
        else if ((r -= I_INA1) < I_INA2) { src = I.win + 2048; pitch = 3080; dst = (bf16_t*)(ws + WS_WINA) + (size_t)1024 * 1024; nbl = 16; }
        else if ((r -= I_INA2) < I_INB) { src = I.win + 512; pitch = 3080; dst = (bf16_t*)(ws + WS_WINB); nbl = 24; }
        else { r -= I_INB; src = I.wout; pitch = 1024; dst = (bf16_t*)(ws + WS_WOUT); nbl = 16; }
        tr_block(src, pitch, dst, 1024, r / nbl, r % nbl, scr, F.lane);
    }
    if (NCONV == 0) conv_items(F, I.wgu, I.wd, 0, CONV_ITEMS, gw, NGW);
    const int gt = F.vcu * NTHR + F.tid, NGT = F.G * NTHR;
    for (int i = gt; i < NTOK * DM / 8; i += NGT) { const f32x4 a = ((const f32x4*)I.x)[2 * i], b = ((const f32x4*)I.x)[2 * i + 1];
        u32x4 w; w.x = cvt_pk_bf16(a[0], a[1]); w.y = cvt_pk_bf16(a[2], a[3]); w.z = cvt_pk_bf16(b[0], b[1]); w.w = cvt_pk_bf16(b[2], b[3]); ((u32x4*)(ws + WS_XB))[i] = w; }
    for (int i = gt; i < NTOK * 8; i += NGT) { const int tok = i >> 3, f = i & 7; const float inv = powf(500000.0f, -(float)f * 0.125f); const float ang = (float)I.pos[tok] * inv;
        float sn, cs; sincosf(ang, &sn, &cs); float* rp = (float*)(ws + WS_ROPE) + (size_t)tok * 16; rp[f] = cs; rp[8 + f] = sn; }
    for (int i = gt; i < 2 * 32 * 1024; i += NGT) { const int l = i >> 15, e = (i >> 10) & 31, k = i & 1023; ((float*)(ws + WS_RWT))[i] = I.rw[((size_t)l * 1024 + k) * 32 + e]; }
    for (int i = gt; i < 8 * 1024; i += NGT) { const int gidx = i >> 10, k = i & 1023; ((float*)(ws + WS_WG))[i] = I.win[(size_t)k * 3080 + 3072 + gidx]; }
}

__device__ __forceinline__ void phase_ln_router(Frame& F, const float* __restrict__ z, float* __restrict__ x1, const float* lng, const float* lnb, const float* rbias, int layer, int cset) {
    unsigned char* ws = F.ws;
    LAS f32x4* rwv = (LAS f32x4*)(F.lds + RING_OFF);
    LAS int* lcnt = (LAS int*)(F.lds + LX_LCNT); LAS int* gbase = (LAS int*)(F.lds + LX_GBASE); LAS int* rec = (LAS int*)(F.lds + LX_REC);
    LAS float* lgb = (LAS float*)(F.lds + LX_LNX);
    { const f32x4* src = (const f32x4*)((const float*)(ws + WS_RWT) + (size_t)layer * 32768);
      for (int i = F.tid; i < 8192; i += NTHR) { const int e = i >> 8, c = i & 255; rwv[e * 256 + (c ^ (e & 15))] = src[i]; } }
    int* toke = (int*)(ws + WS_TOKE); int* tokp = (int*)(ws + WS_TOKP); float* tokg = (float*)(ws + WS_TOKG);
    unsigned short* rowtok = (unsigned short*)(ws + WS_ROWTOK); unsigned char* xb8 = (unsigned char*)(ws + WS_XB);
    unsigned* cntg = F.ctl + CW_CNT + cset * 2048;
    const int lane = F.lane;
    for (int grp = F.vcu; grp < NTOK / 64; grp += F.G) {
        if (F.tid < 32) lcnt[F.tid] = 0;
        for (int i = F.tid; i < 1024; i += NTHR) { lgb[i] = lng[i]; lgb[1024 + i] = lnb[i]; }
        __syncthreads();
#pragma unroll 2
        for (int tk = 0; tk < 8; tk += 2) {
            const int token0 = grp * 64 + F.wave * 8 + tk;
            f32x4 v[2][4]; float s[2] = {0.f, 0.f};
#pragma unroll
            for (int u = 0; u < 2; ++u)
#pragma unroll
                for (int j = 0; j < 4; ++j) { v[u][j] = *(const f32x4*)(z + (size_t)(token0 + u) * DM + 4 * lane + 256 * j); s[u] += (v[u][j][0] + v[u][j][1]) + (v[u][j][2] + v[u][j][3]); }
#pragma unroll
            for (int o = 1; o < 64; o <<= 1) { const float a0 = __shfl_xor(s[0], o), a1 = __shfl_xor(s[1], o); s[0] += a0; s[1] += a1; }
            float s2[2] = {0.f, 0.f};
#pragma unroll
            for (int u = 0; u < 2; ++u) { const float mean = s[u] * (1.0f / DM);
#pragma unroll
                for (int j = 0; j < 4; ++j) { v[u][j] = v[u][j] - mean; s2[u] += (v[u][j][0] * v[u][j][0] + v[u][j][1] * v[u][j][1]) + (v[u][j][2] * v[u][j][2] + v[u][j][3] * v[u][j][3]); } }
#pragma unroll
            for (int o = 1; o < 64; o <<= 1) { const float a0 = __shfl_xor(s2[0], o), a1 = __shfl_xor(s2[1], o); s2[0] += a0; s2[1] += a1; }
#pragma unroll
            for (int u = 0; u < 2; ++u) { const float rstd = 1.0f / sqrtf(s2[u] * (1.0f / DM) + LN_EPS); const int token = token0 + u;
#pragma unroll
                for (int j = 0; j < 4; ++j) { const f32x4 gvj = *(const LAS f32x4*)(lgb + 4 * lane + 256 * j), bvj = *(const LAS f32x4*)(lgb + 1024 + 4 * lane + 256 * j);
                    const f32x4 y = v[u][j] * rstd * gvj + bvj; *(f32x4*)(x1 + (size_t)token * DM + 4 * lane + 256 * j) = y;
                    int w8 = __builtin_amdgcn_cvt_pk_fp8_f32(y[0] * FP8_SA, y[1] * FP8_SA, 0, false); w8 = __builtin_amdgcn_cvt_pk_fp8_f32(y[2] * FP8_SA, y[3] * FP8_SA, w8, true);
                    *(int*)(xb8 + (size_t)token * DM + 4 * lane + 256 * j) = w8; } }
        }
        VM_WAIT(); __syncthreads();
        const int tg = F.wave & 3, kh = F.wave >> 2, e0 = lane & 15, kq = lane >> 4;
        f32x4 acc0 = {0.f, 0.f, 0.f, 0.f}, acc1 = acc0;
        { const float* arow = x1 + (size_t)(grp * 64 + tg * 16 + e0) * DM + kh * 512 + 4 * kq;
#pragma unroll 4
          for (int blk = 0; blk < 32; ++blk) {
              const f32x4 a4 = *(const f32x4*)(arow + blk * 16); const int c = ((kh * 512 + blk * 16) >> 2) + kq;
              const f32x4 b0 = rwv[e0 * 256 + (c ^ e0)], b1 = rwv[(16 + e0) * 256 + (c ^ e0)];
#pragma unroll
              for (int j = 0; j < 4; ++j) { acc0 = __builtin_amdgcn_mfma_f32_16x16x4f32(a4[j], b0[j], acc0, 0, 0, 0); acc1 = __builtin_amdgcn_mfma_f32_16x16x4f32(a4[j], b1[j], acc1, 0, 0, 0); } } }
        __syncthreads();
        if (kh == 1) { ((LAS f32x4*)lgb)[(tg * 2 + 0) * 64 + lane] = acc0; ((LAS f32x4*)lgb)[(tg * 2 + 1) * 64 + lane] = acc1; }
        __syncthreads();
        if (kh == 0) {
            acc0 = acc0 + ((LAS f32x4*)lgb)[(tg * 2 + 0) * 64 + lane]; acc1 = acc1 + ((LAS f32x4*)lgb)[(tg * 2 + 1) * 64 + lane];
            const float rb0 = rbias[e0], rb1 = rbias[16 + e0];
#pragma unroll
            for (int r = 0; r < 4; ++r) {
                float l0 = acc0[r] + rb0, l1 = acc1[r] + rb1; float tv[4]; int te[4];
#pragma unroll
                for (int k = 0; k < 4; ++k) { float bvv = (l1 > l0) ? l1 : l0; int be = (l1 > l0) ? 16 + e0 : e0;
#pragma unroll
                    for (int o = 1; o < 16; o <<= 1) { const float ov = __shfl_xor(bvv, o); const int oe = __shfl_xor(be, o); const bool take = (ov > bvv) || (ov == bvv && oe < be); bvv = take ? ov : bvv; be = take ? oe : be; }
                    tv[k] = bvv; te[k] = be; if (be == e0) l0 = -INFINITY; if (be == 16 + e0) l1 = -INFINITY; }
                const float w0 = 1.0f, w1 = __expf(tv[1] - tv[0]), w2 = __expf(tv[2] - tv[0]), w3 = __expf(tv[3] - tv[0]); const float wi = 1.0f / (w0 + w1 + w2 + w3);
                if (e0 < 4) {
                    const int tl = tg * 16 + 4 * kq + r, token = grp * 64 + tl;
                    const int ek = (e0 == 0) ? te[0] : (e0 == 1) ? te[1] : (e0 == 2) ? te[2] : te[3];
                    const float wk = (e0 == 0) ? w0 : (e0 == 1) ? w1 : (e0 == 2) ? w2 : w3;
                    const int li = atomicAdd((int*)(lcnt + ek), 1); rec[tl * 8 + e0] = ek; rec[tl * 8 + 4 + e0] = li;
                    toke[token * 4 + e0] = ek; tokg[token * 4 + e0] = wk * wi;
                }
            }
        }
        __syncthreads();
        if (F.tid < 32) gbase[F.tid] = (int)__hip_atomic_fetch_add(cntg + F.tid * 64, (unsigned)lcnt[F.tid], RLX_AGENT);
        __syncthreads();
        if (F.tid < 256) { const int tl = F.tid >> 2, k = F.tid & 3; const int token = grp * 64 + tl; const int e = rec[tl * 8 + k]; const int pos = gbase[e] + rec[tl * 8 + 4 + k];
            tokp[token * 4 + k] = pos; rowtok[(size_t)e * NTOK + pos] = (unsigned short)token; }
        __syncthreads();
    }
}

__device__ __forceinline__ int moe_tables(Frame& F, int layer) {
    LAS int* tile_e = (LAS int*)(F.lds + LX_TILEE); LAS int* tbase = (LAS int*)(F.lds + LX_TBASE);
    if (F.tid < 64) {
        const int e = F.lane & 31; const int c = (int)__hip_atomic_load(F.ctl + CW_CNT + layer * 2048 + e * 64, RLX_AGENT); const int nt = (F.lane < 32) ? ((c + 255) >> 8) : 0;
        int inc = nt;
#pragma unroll
        for (int o = 1; o < 32; o <<= 1) { const int up = __shfl_up(inc, o); if (F.lane >= o) inc += up; }
        const int t0 = inc - nt;
        if (F.lane < 32) { tbase[e] = t0; for (int i = 0; i < nt; ++i) tile_e[t0 + i] = e; }
        if (F.lane == 31) tbase[32] = inc;
    }
    __syncthreads();
    return tbase[32];
}

template <bool NEXT_MLSTM>
__device__ __forceinline__ void phase_combine(Frame& F, const float* __restrict__ x1, float* __restrict__ out, const float* lng, const float* lnb, const float* bgates, int layer) {
    unsigned char* ws = F.ws;
    (void)moe_tables(F, layer);
    const LAS int* tbase = (const LAS int*)(F.lds + LX_TBASE);
    const int* toke = (const int*)(ws + WS_TOKE); const int* tokp = (const int*)(ws + WS_TOKP); const float* tokg = (const float*)(ws + WS_TOKG);
    const bf16_t* Y = (const bf16_t*)(ws + WS_Y); bf16_t* xb = (bf16_t*)(ws + WS_XB);
    LAS float* wg = (LAS float*)(F.lds + RING_OFF);
    if constexpr (NEXT_MLSTM) { const f32x4* src = (const f32x4*)(ws + WS_WG); for (int i = F.tid; i < 2048; i += NTHR) ((LAS f32x4*)wg)[i] = src[i]; __syncthreads(); }
    const int lane = F.lane; const int gw = F.vcu * NWAVES + F.wave, NGW = F.G * NWAVES;
    f32x4 gv[4], bv[4];
#pragma unroll
    for (int j = 0; j < 4; ++j) { gv[j] = *(const f32x4*)(lng + 4 * lane + 256 * j); bv[j] = *(const f32x4*)(lnb + 4 * lane + 256 * j); }
    constexpr int NTK = NEXT_MLSTM ? 1 : 2;
    for (int token0 = gw; token0 < NTOK; token0 += NTK * NGW) {
        f32x4 vv[NTK][4];
#pragma unroll
        for (int u = 0; u < NTK; ++u) { const int token = token0 + u * NGW; if (token < NTOK) {
#pragma unroll
            for (int j = 0; j < 4; ++j) vv[u][j] = *(const f32x4*)(x1 + (size_t)token * DM + 4 * lane + 256 * j) * ALPHA;
#pragma unroll
            for (int k = 0; k < 4; ++k) { const int e = toke[token * 4 + k]; const size_t row = (size_t)tbase[e] * 256 + tokp[token * 4 + k]; const float gt = tokg[token * 4 + k] * DBG_MOE_MUL;
#pragma unroll
                for (int j = 0; j < 4; ++j) { const u32x2 y = *(const u32x2*)(Y + row * DM + 4 * lane + 256 * j); vv[u][j][0] += gt * bflo(y.x); vv[u][j][1] += gt * bfhi(y.x); vv[u][j][2] += gt * bflo(y.y); vv[u][j][3] += gt * bfhi(y.y); } } } }
#pragma unroll
        for (int u = 0; u < NTK; ++u) { const int token = token0 + u * NGW; if (token < NTOK) {
        f32x4 v[4];
#pragma unroll
        for (int j = 0; j < 4; ++j) v[j] = vv[u][j];
        float s = 0.f;
#pragma unroll
        for (int j = 0; j < 4; ++j) s += (v[j][0] + v[j][1]) + (v[j][2] + v[j][3]);
        const float mean = wave_sum(s) * (1.0f / DM); float s2 = 0.f;
#pragma unroll
        for (int j = 0; j < 4; ++j) { v[j] = v[j] - mean; s2 += (v[j][0] * v[j][0] + v[j][1] * v[j][1]) + (v[j][2] * v[j][2] + v[j][3] * v[j][3]); }
        const float rstd = 1.0f / sqrtf(wave_sum(s2) * (1.0f / DM) + LN_EPS);
#pragma unroll
        for (int j = 0; j < 4; ++j) { v[j] = v[j] * rstd * gv[j] + bv[j]; *(f32x4*)(out + (size_t)token * DM + 4 * lane + 256 * j) = v[j]; }
        if constexpr (NEXT_MLSTM) {
#pragma unroll
            for (int j = 0; j < 4; ++j) { u32x2 w; w.x = cvt_pk_bf16(v[j][0], v[j][1]); w.y = cvt_pk_bf16(v[j][2], v[j][3]); *(u32x2*)(xb + (size_t)token * DM + 4 * lane + 256 * j) = w; }
            float gp[8];
#pragma unroll
            for (int gi = 0; gi < 8; ++gi) { float a = 0.f;
#pragma unroll
                for (int j = 0; j < 4; ++j) { const f32x4 w = *(const LAS f32x4*)(wg + gi * 1024 + 4 * lane + 256 * j); a += (v[j][0] * w[0] + v[j][1] * w[1]) + (v[j][2] * w[2] + v[j][3] * w[3]); }
                gp[gi] = a; }
#pragma unroll
            for (int o = 1; o < 64; o <<= 1) {
#pragma unroll
                for (int gi = 0; gi < 8; ++gi) gp[gi] += __shfl_xor(gp[gi], o); }
#pragma unroll
            for (int gi = 0; gi < 8; ++gi) gp[gi] += bgates[gi];
            if (lane == 0) {
#pragma unroll
                for (int hh = 0; hh < 4; ++hh) { ((float*)(ws + WS_GI))[(size_t)hh * NTOK + token] = gp[hh];
                    const float f = gp[4 + hh]; const float lf = (f >= 0.f) ? -log1pf(__expf(-f)) : (f - log1pf(__expf(f)));
                    ((float*)(ws + WS_LF))[(size_t)hh * NTOK + token] = lf; } }
        }
        } }
    }
}

__device__ __forceinline__ void phase_gate_scan(Frame& F) {
    unsigned char* ws = F.ws; const int lane = F.lane; const int gw = F.vcu * NWAVES + F.wave, NGW = F.G * NWAVES;
    for (int mu = gw; mu < 256; mu += NGW) {
        const int b = mu >> 6, hh = (mu >> 4) & 3, ch = mu & 15; const size_t base = (size_t)hh * NTOK + (size_t)b * SEQ + ch * 256 + 4 * lane;
        const f32x4 lf = *(const f32x4*)((const float*)(ws + WS_LF) + base), gi = *(const f32x4*)((const float*)(ws + WS_GI) + base);
        f32x4 c; c[0] = lf[0]; c[1] = c[0] + lf[1]; c[2] = c[1] + lf[2]; c[3] = c[2] + lf[3];
        float tot = c[3];
#pragma unroll
        for (int o = 1; o < 64; o <<= 1) { const float up = __shfl_up(tot, o); if (lane >= o) tot += up; }
        const float excl = tot - c[3];
        f32x4 rf, cf;
#pragma unroll
        for (int j = 0; j < 4; ++j) { const float bt = excl + c[j]; rf[j] = __expf(bt); cf[j] = __expf(gi[j] - bt); }
        *(f32x4*)((float*)(ws + WS_RF) + base) = rf; *(f32x4*)((float*)(ws + WS_CF) + base) = cf;
        if (lane == 63) ((float*)(ws + WS_DEC))[mu] = __expf(tot);
    }
}
__device__ __forceinline__ void phase_nu(Frame& F) {
    unsigned char* ws = F.ws; const int lane = F.lane; const int gw = F.vcu * NWAVES + F.wave, NGW = F.G * NWAVES;
    const bf16_t* KT = (const bf16_t*)(ws + WS_KT); float* NU = (float*)(ws + WS_NU);
    for (int r0 = gw * 16; r0 < 256 * 128; r0 += NGW * 16) {
        const int mu = r0 >> 7, d0 = r0 & 127, b = mu >> 6, hh = (mu >> 4) & 3, ch = mu & 15;
        const bf16_t* base = KT + (size_t)(hh * 128 + d0) * NTOK + (size_t)b * SEQ + ch * 256 + 4 * lane;
        u32x2 kv[16];
#pragma unroll
        for (int i = 0; i < 16; ++i) kv[i] = *(const u32x2*)(base + (size_t)i * NTOK);
        float s[16];
#pragma unroll
        for (int i = 0; i < 16; ++i) s[i] = (bflo(kv[i].x) + bfhi(kv[i].x)) + (bflo(kv[i].y) + bfhi(kv[i].y));
#pragma unroll
        for (int o = 1; o < 64; o <<= 1) {
#pragma unroll
            for (int i = 0; i < 16; ++i) s[i] += __shfl_xor(s[i], o); }
        float mine = s[0];
#pragma unroll
        for (int i = 1; i < 16; ++i) mine = (lane == i) ? s[i] : mine;
        if (lane < 16) NU[r0 + lane] = mine;
    }
}
__device__ __forceinline__ void phase_state_scan(Frame& F) {
    unsigned char* ws = F.ws; const int gt = F.vcu * NTHR + F.tid, NGT = F.G * NTHR;
    const float* UT = (const float*)(ws + WS_UT); const float* DEC = (const float*)(ws + WS_DEC); bf16_t* BE = (bf16_t*)(ws + WS_BE);
    for (int i = gt; i < 16 * 256 * 32; i += NGT) { const int bh = i >> 13, e = (i >> 5) & 255, dg = i & 31;
        f32x4 U[16]; float dc[16];
#pragma unroll
        for (int ch = 0; ch < 16; ++ch) { const size_t mu = (size_t)bh * 16 + ch; U[ch] = *(const f32x4*)(UT + (mu * 256 + e) * 128 + 4 * dg); dc[ch] = DEC[mu]; }
        f32x4 C = {0.f, 0.f, 0.f, 0.f};
#pragma unroll
        for (int ch = 0; ch < 16; ++ch) { const size_t mu = (size_t)bh * 16 + ch;
            u32x2 w; w.x = cvt_pk_bf16(C[0], C[1]); w.y = cvt_pk_bf16(C[2], C[3]);
#ifdef DBG_NO_INTER
            w.x = 0u; w.y = 0u;
#endif
            *(u32x2*)(BE + (mu * 256 + e) * 384 + 256 + 4 * dg) = w;
            C = (C + U[ch]) * dc[ch]; } }
    const float* NU = (const float*)(ws + WS_NU); float* NP = (float*)(ws + WS_NPREV);
    for (int i = gt; i < 16 * 128; i += NGT) { const int bh = i >> 7, d = i & 127; float n = 0.f;
        for (int ch = 0; ch < 16; ++ch) { const int mu = bh * 16 + ch; NP[mu * 128 + d] = n; n = (n + NU[mu * 128 + d]) * DEC[mu];
#ifdef DBG_NO_INTER
            n = 0.f;
#endif
        } }
}
struct Args { const float* in[18]; float* out; unsigned char* ws; int ph_lo, ph_hi; };
__global__ void __launch_bounds__(NTHR, 2) mk_fwd(Args args) {
    extern __shared__ __attribute__((aligned(16))) unsigned char lds[];
    Frame F;
    const char __attribute__((address_space(4)))* kargp = (const char __attribute__((address_space(4)))*)__builtin_amdgcn_kernarg_segment_ptr();
#define AIN(i) ({ const char __attribute__((address_space(4)))* k_ = kargp; asm volatile("" : "+s"(k_)); *(const float* const __attribute__((address_space(4)))*)(k_ + 8 * (i)); })
    unsigned char* const ws0 = (unsigned char*)AIN(19);
    F.lds = (LAS unsigned char*)lds; F.ws = ws0; F.ctl = (unsigned*)(ws0 + WS_CTL);
    F.tid = threadIdx.x; F.lane = F.tid & 63; F.wave = __builtin_amdgcn_readfirstlane(F.tid >> 6);
    F.G = gridDim.x; { const int bx = blockIdx.x; F.vcu = (F.G % 8 == 0) ? (bx % 8) * (F.G / 8) + bx / 8 : bx; }
    for (int u = F.tid; u < (LDS_BYTES - LX) / 4; u += NTHR) ((LAS unsigned*)(F.lds + LX))[u] = 0u;
    __syncthreads();
    int lo, hi; { const char __attribute__((address_space(4)))* k_ = kargp; lo = *(const int __attribute__((address_space(4)))*)(k_ + 160); hi = *(const int __attribute__((address_space(4)))*)(k_ + 164); }
    XcdBarrier bar; bar.bar = (unsigned*)(F.ctl + CW_BAR); bar.x = 0; bar.st = nullptr;
    if (hi - lo > 1) bar = xcd_barrier_post((unsigned*)(F.ctl + CW_BAR), (volatile LAS unsigned*)(F.lds + LX_MISC) + 8);
#ifndef PHASE_MASK
#define PHASE_MASK 0x7FFFF
#endif
#define IN(k) ((((PHASE_MASK) >> (k)) & 1) && lo <= (k) && (k) < hi)
#ifndef REPEAT_MASK
#define REPEAT_MASK 0
#endif
#define PH(k) if (IN(k))
#define SEAM(k) do { if (IN(k) && IN((k) + 1)) xcd_barrier(bar); } while (0)
    unsigned char* ws = ws0;
#define x_in AIN(0)
#define ln_mix_g AIN(8)
#define ln_mix_b AIN(9)
#define ln_ffn_g AIN(10)
#define ln_ffn_b AIN(11)
#define router_b AIN(13)
#define b_gu AIN(15)
#define b_dn AIN(17)
    bf16_t* XB = (bf16_t*)(ws + WS_XB); bf16_t* QB_ = (bf16_t*)(ws + WS_Q); bf16_t* KB_ = (bf16_t*)(ws + WS_K); bf16_t* VB_ = (bf16_t*)(ws + WS_V);
    float* R0 = (float*)(ws + WS_R0); float* R1 = (float*)(ws + WS_R1); float* R2 = (float*)(ws + WS_R2);
    bf16_t* HB = (bf16_t*)(ws + WS_H); bf16_t* YB = (bf16_t*)(ws + WS_Y);
    LAS unsigned char* ring = F.lds + RING_OFF;
    const int cG = (int)blockIdx.x;
    const bool isConv = (NCONV > 0) && ((int)blockIdx.x >= F.G - NCONV);
    const int Gc = F.G - NCONV, cwv = ((int)blockIdx.x - Gc) * NWAVES + F.wave, ncw = NCONV * NWAVES;
#define CONV_SLICE(a, b) conv_items(F, AIN(14), AIN(16), (int)((long)CONV_ITEMS * (a) / 1000), (int)((long)CONV_ITEMS * (b) / 1000), cwv, ncw)

    PH(0) { P0In I{x_in, AIN(2), AIN(3), AIN(4), AIN(7), AIN(12), AIN(14), AIN(16), (const int*)AIN(1)}; p0_prologue(F, I); }
    SEAM(0);
    PH(1) { { Gemm g{1024, 1024, 1024, nullptr}; DenseSched S{64, 12, F.G, cG, (const char*)XB, (const char*)(ws + WS_WQKV), (size_t)256 * 1024 * 2, (size_t)256 * 1024 * 2};
        EpiQKV E{QB_, KB_, VB_, (const float*)(ws + WS_ROPE), (float*)(ws + WS_KSUM)};
        pg8::gemm_phase<EpiQKV, DenseSched, true, false>(ring, g, S, E); } }
    SEAM(1);
    PH(2) { if (isConv) CONV_SLICE(0, 1000); else {
        const attn_body::AttnTensors AT{(const attn_body::bf16*)QB_, (const attn_body::bf16*)KB_, (const attn_body::bf16*)VB_, (attn_body::bf16*)QB_, (const float*)(ws + WS_KSUM)};
        if (NCONV == 0) { const attn_body::StaticOrder S((int)F.G, (int)blockIdx.x); attn_body::attn_phase<attn_body::StaticOrder>((char*)lds + RING_OFF, AT, S); }
        else { const attn_body::SnakeOrder S{cG, Gc}; attn_body::attn_phase<attn_body::SnakeOrder>((char*)lds + RING_OFF, AT, S); } } }
    SEAM(2);
    PH(3) { { Gemm g{1024, 1024, 1024, nullptr}; DenseSched S{64, 4, F.G, cG, (const char*)QB_, (const char*)(ws + WS_WO), (size_t)256 * 1024 * 2, (size_t)256 * 1024 * 2};
        EpiZ E{x_in, R0, DBG_ATTN_MUL}; pg8::gemm_phase<EpiZ, DenseSched, true, false>(ring, g, S, E); } }
    SEAM(3);
    PH(4) phase_ln_router(F, R0, R1, ln_mix_g, ln_mix_b, router_b, 0, 0);
    SEAM(4);
    PH(5) { const int nT = moe_tables(F, 0); LAS unsigned short* tokl = (LAS unsigned short*)(F.lds + LX_TOKL);
        { const unsigned short* rowtok = (const unsigned short*)(ws + WS_ROWTOK); const LAS int* tile_e = (const LAS int*)(F.lds + LX_TILEE); const LAS int* tbase = (const LAS int*)(F.lds + LX_TBASE);
          for (int i = 0; i < TOKL_ROUNDS; ++i) { int pm, pn, hf; if (!moe_unit(i, F.G, cG, nT, 8, pm, pn, hf)) break;
              if (F.tid < 256) { const int e = tile_e[pm]; const int r = (pm - tbase[e]) * 256 + F.tid; const int c = (int)__hip_atomic_load(F.ctl + CW_CNT + 0 * 2048 + e * 64, RLX_AGENT);
                  tokl[i * 256 + F.tid] = (r < c) ? rowtok[(size_t)e * NTOK + r] : (unsigned short)0; } }
          __syncthreads(); }
        Gemm g{512, 512, 512, (const char*)XB};
        MoeSched S{nT, 8, F.G, cG, (const LAS int*)(F.lds + LX_TILEE), (const LAS int*)(F.lds + LX_TBASE), tokl, nullptr, (const char*)(ws + WS_WGU) + (size_t)0 * 32 * 2048 * 1024, 0, (size_t)2048 * 1024, (size_t)256 * 1024};
        EpiGU E{b_gu + (size_t)0 * 32 * 2048, (unsigned char*)HB, (LAS float*)(F.lds + LX_BIAS), 0}; pg8::gemm_phase<EpiGU, MoeSched, true, true, true, true>(ring, g, S, E); }
    SEAM(5);
    PH(6) { const int nT = moe_tables(F, 0); Gemm g{512, 512, 512, nullptr};
        MoeSched S{nT, 4, F.G, cG, (const LAS int*)(F.lds + LX_TILEE), (const LAS int*)(F.lds + LX_TBASE), nullptr, (const char*)HB, (const char*)(ws + WS_WD) + (size_t)0 * 32 * 1024 * 1024, (size_t)256 * 1024, (size_t)1024 * 1024, (size_t)256 * 1024};
        EpiDN E{b_dn + (size_t)0 * 32 * 1024, YB, (LAS float*)(F.lds + LX_BIAS), 0}; pg8::gemm_phase<EpiDN, MoeSched, true, false, true, true>(ring, g, S, E); }
    SEAM(6);
    PH(7) phase_combine<true>(F, R1, R2, ln_ffn_g, ln_ffn_b, AIN(5), 0);
    SEAM(7);
    PH(8) phase_gate_scan(F);
    SEAM(8);
    PH(9) {
        { Gemm g{1024, 1024, 1024, nullptr}; DenseSched S{64, 8, F.G, cG, (const char*)XB, (const char*)(ws + WS_WINA), (size_t)256 * 1024 * 2, (size_t)256 * 1024 * 2};
          EpiINA E{(const float*)(ws + WS_RF), (const float*)(ws + WS_CF), (bf16_t*)(ws + WS_AE), (bf16_t*)(ws + WS_KN), (bf16_t*)(ws + WS_OS)};
          pg8::gemm_phase<EpiINA, DenseSched, true, false>(ring, g, S, E); }
        { Gemm g{1024, 1024, 1024, nullptr}; DenseSched S{6, 64, F.G, cG, (const char*)(ws + WS_WINB), (const char*)XB, (size_t)256 * 1024 * 2, (size_t)256 * 1024 * 2, true};
          EpiINB E{(const float*)(ws + WS_CF), (bf16_t*)(ws + WS_KT), (bf16_t*)(ws + WS_BE)};
          pg8::gemm_phase<EpiINB, DenseSched, true, false, false, true>(ring, g, S, E); }
    }
    SEAM(9);
    PH(10) { Gemm g{256, 384, NTOK, nullptr}; MuSched S{F.G, cG, 0, (const char*)(ws + WS_BE), (const char*)(ws + WS_KT)};
        EpiM1 E{(float*)(ws + WS_UT)}; pg8::gemm_phase<EpiM1, MuSched, true, false>(ring, g, S, E);
        phase_nu(F); }
    SEAM(10);
    PH(11) phase_state_scan(F);
    SEAM(11);
    PH(12) { Gemm g{128, 512, 1024, nullptr}; MuSched S{F.G, cG, 1, (const char*)(ws + WS_AE), (const char*)(ws + WS_KN)};
        EpiM2A E{(bf16_t*)(ws + WS_AE), (const float*)(ws + WS_NPREV), (float*)(ws + WS_DEN)}; pg8::gemm_phase<EpiM2A, MuSched, true, false>(ring, g, S, E); }
    SEAM(12);
    PH(13) { Gemm g{384, 512, 384, nullptr}; MuSched S{F.G, cG, 2, (const char*)(ws + WS_AE), (const char*)(ws + WS_BE)};
        EpiM2B E{(const float*)(ws + WS_DEN), AIN(6), (const bf16_t*)(ws + WS_OS), (bf16_t*)(ws + WS_HN), (LAS float*)(F.lds + LX_LNX)};
        pg8::gemm_phase<EpiM2B, MuSched, true, false>(ring, g, S, E); }
    SEAM(13);
    PH(14) { Gemm g{1024, 1024, 1024, nullptr}; DenseSched S{64, 4, F.G, cG, (const char*)(ws + DBG_P14_A), (const char*)(ws + WS_WOUT), (size_t)256 * 1024 * 2, (size_t)256 * 1024 * 2};
        EpiZ E{R2, R0, DBG_MLSTM_MUL}; pg8::gemm_phase<EpiZ, DenseSched, true, false>(ring, g, S, E); }
    SEAM(14);
    PH(15) phase_ln_router(F, R0, R1, ln_mix_g + 1024, ln_mix_b + 1024, router_b + 32, 1, 1);
    SEAM(15);
    PH(16) { const int nT = moe_tables(F, 1); LAS unsigned short* tokl = (LAS unsigned short*)(F.lds + LX_TOKL);
        { const unsigned short* rowtok = (const unsigned short*)(ws + WS_ROWTOK); const LAS int* tile_e = (const LAS int*)(F.lds + LX_TILEE); const LAS int* tbase = (const LAS int*)(F.lds + LX_TBASE);
          for (int i = 0; i < TOKL_ROUNDS; ++i) { int pm, pn, hf; if (!moe_unit(i, F.G, cG, nT, 8, pm, pn, hf)) break;
              if (F.tid < 256) { const int e = tile_e[pm]; const int r = (pm - tbase[e]) * 256 + F.tid; const int c = (int)__hip_atomic_load(F.ctl + CW_CNT + 1 * 2048 + e * 64, RLX_AGENT);
                  tokl[i * 256 + F.tid] = (r < c) ? rowtok[(size_t)e * NTOK + r] : (unsigned short)0; } }
          __syncthreads(); }
        Gemm g{512, 512, 512, (const char*)XB};
        MoeSched S{nT, 8, F.G, cG, (const LAS int*)(F.lds + LX_TILEE), (const LAS int*)(F.lds + LX_TBASE), tokl, nullptr, (const char*)(ws + WS_WGU) + (size_t)1 * 32 * 2048 * 1024, 0, (size_t)2048 * 1024, (size_t)256 * 1024};
        EpiGU E{b_gu + (size_t)1 * 32 * 2048, (unsigned char*)HB, (LAS float*)(F.lds + LX_BIAS), 0}; pg8::gemm_phase<EpiGU, MoeSched, true, true, true, true>(ring, g, S, E); }
    SEAM(16);
    PH(17) { const int nT = moe_tables(F, 1); Gemm g{512, 512, 512, nullptr};
        MoeSched S{nT, 4, F.G, cG, (const LAS int*)(F.lds + LX_TILEE), (const LAS int*)(F.lds + LX_TBASE), nullptr, (const char*)HB, (const char*)(ws + WS_WD) + (size_t)1 * 32 * 1024 * 1024, (size_t)256 * 1024, (size_t)1024 * 1024, (size_t)256 * 1024};
        EpiDN E{b_dn + (size_t)1 * 32 * 1024, YB, (LAS float*)(F.lds + LX_BIAS), 0}; pg8::gemm_phase<EpiDN, MoeSched, true, false, true, true>(ring, g, S, E); }
    SEAM(17);
    PH(18) phase_combine<false>(F, R1, (float*)AIN(18), ln_ffn_g + 1024, ln_ffn_b + 1024, nullptr, 1);
#undef IN
#undef CONV_SLICE
#undef AIN
#undef x_in
#undef ln_mix_g
#undef ln_mix_b
#undef ln_ffn_g
#undef ln_ffn_b
#undef router_b
#undef b_gu
#undef b_dn
#undef SEAM
}

extern "C" void kernel_launch(void* const* d_in, const int* in_sizes, int n_in, void* d_out, int out_size, void* d_ws, size_t ws_size, hipStream_t stream) {
    static int grid = 0;
    if (grid == 0) {
        if (n_in != 18 || out_size != NTOK * DM || ws_size < WS_END) { fprintf(stderr, "kernel_launch: unexpected problem shape (n_in %d, out %d, ws %zu)\n", n_in, out_size, ws_size); grid = -1; return; }
        int dev = 0, cus = 0, per_cu = 0;
        if (hipGetDevice(&dev) != hipSuccess || hipDeviceGetAttribute(&cus, hipDeviceAttributeMultiprocessorCount, dev) != hipSuccess) { grid = -1; return; }
        if (hipFuncSetAttribute((const void*)mk_fwd, hipFuncAttributeMaxDynamicSharedMemorySize, LDS_BYTES) != hipSuccess) { fprintf(stderr, "kernel_launch: hipFuncSetAttribute failed\n"); grid = -1; return; }
        if (hipOccupancyMaxActiveBlocksPerMultiprocessor(&per_cu, (const void*)mk_fwd, NTHR, LDS_BYTES) != hipSuccess || per_cu < 1) fprintf(stderr, "kernel_launch: occupancy query reports %d\n", per_cu);
        (void)hipGetLastError();
        grid = cus;
        if (grid > 256) grid = 256;
        if (grid < 240) { fprintf(stderr, "kernel_launch: %d CUs: this build needs 240..256\n", cus); grid = -1; return; }
    }
    if (grid < 0) return;
    if (hipMemsetAsync((char*)d_ws + WS_CTL, 0, CTL_ZERO_BYTES, stream) != hipSuccess) return;
    Args a{};
    for (int i = 0; i < 18; ++i) a.in[i] = (const float*)d_in[i];
    a.out = (float*)d_out; a.ws = (unsigned char*)d_ws;
#if MK_ONE_LAUNCH
    a.ph_lo = 0; a.ph_hi = NPHASE;
    hipLaunchKernelGGL(mk_fwd, dim3(grid), dim3(NTHR), LDS_BYTES, stream, a);
#else
    for (int p = 0; p < NPHASE; ++p) { a.ph_lo = p; a.ph_hi = p + 1; hipLaunchKernelGGL(mk_fwd, dim3(grid), dim3(NTHR), LDS_BYTES, stream, a); }
#endif
}
```

```cpp
#include <hip/hip_runtime.h>
#include <hip/hip_bf16.h>
#include <cstdio>
#include <cstdint>
#include <cmath>

#define LAS __attribute__((address_space(3)))
#define GAS __attribute__((address_space(1)))
typedef unsigned short bf16_t;
typedef short bf16x8 __attribute__((ext_vector_type(8)));
typedef float f32x4 __attribute__((ext_vector_type(4)));
typedef float f32x2 __attribute__((ext_vector_type(2)));
typedef unsigned u32x4 __attribute__((ext_vector_type(4)));
typedef unsigned u32x2 __attribute__((ext_vector_type(2)));
typedef int i32x4 __attribute__((ext_vector_type(4)));
typedef int i32x8 __attribute__((ext_vector_type(8)));

typedef __bf16 bf16x2_t __attribute__((ext_vector_type(2)));
__device__ __forceinline__ unsigned cvt_pk_bf16(float lo, float hi) { const f32x2 v = {lo, hi}; const bf16x2_t b = __builtin_convertvector(v, bf16x2_t); return __builtin_bit_cast(unsigned, b); }
__device__ __forceinline__ float bf2f(unsigned short b) { return __uint_as_float(((unsigned)b) << 16); }
__device__ __forceinline__ float bflo(unsigned w) { return __uint_as_float(w << 16); }
__device__ __forceinline__ float bfhi(unsigned w) { return __uint_as_float(w & 0xffff0000u); }

__device__ __forceinline__ void glds16s(const void* sbase, unsigned voff, unsigned lds_dst) { unsigned keep;
    asm volatile("s_nop 4\n\ts_mov_b32 %0, m0\n\ts_mov_b32 m0, %3\n\ts_nop 0\n\tglobal_load_lds_dwordx4 %1, %2\n\ts_mov_b32 m0, %0" : "=&s"(keep) : "v"(voff), "s"(sbase), "s"(lds_dst) : "memory"); }
__device__ __forceinline__ void glds4s(const void* sbase, unsigned voff, unsigned lds_dst) { unsigned keep;
    asm volatile("s_nop 4\n\ts_mov_b32 %0, m0\n\ts_mov_b32 m0, %3\n\ts_nop 0\n\tglobal_load_lds_dword %1, %2\n\ts_mov_b32 m0, %0" : "=&s"(keep) : "v"(voff), "s"(sbase), "s"(lds_dst) : "memory"); }
__device__ __forceinline__ const char* uni_ptr(const char* p) { const unsigned long long v = (unsigned long long)p; const unsigned lo = __builtin_amdgcn_readfirstlane((unsigned)v), hi = __builtin_amdgcn_readfirstlane((unsigned)(v >> 32)); return (const char*)(((unsigned long long)hi << 32) | lo); }
namespace pg8 {
constexpr int BM = 256, BK = 64, HALF = 128, HTB = HALF * BK * 2, STAGE_BYTES = 8 * HTB, NXCD = 8, WGM = 8;
__host__ __device__ __forceinline__ int lds_byte(int r, int c) { const int st = (r >> 4) * 2 + (c >> 5), rr = r & 15, cc = c & 31, ob = rr * 64 + cc * 2; return st * 1024 + (ob ^ (((ob >> 9) & 1) << 5)); }
__host__ __device__ __forceinline__ void stage_rc(int b, int& R, int& C) { const int st = b / 1024, sb = b % 1024, swz = sb ^ (((sb >> 9) & 1) << 5); R = (st >> 1) * 16 + swz / 64; C = (st & 1) * 32 + (swz % 64) / 2; }
__host__ __device__ __forceinline__ int perm32(int rho) { const int n = rho >> 4, i = rho & 15; return 8 * (i >> 2) + 4 * n + (i & 3); }

struct Unit { int pm, pn; const char* A; const char* B; const LAS unsigned short* tl; int x0, x1, x2; };
struct Gemm { int K, lda, ldb; const char* Abase; };

__device__ __forceinline__ bool tile_order(int i, int G, int c, int nM, int nN, int& pm, int& pn) {
    const int nwg = nM * nN; const long L = (long)i * G + c; if (L >= nwg) return false;
    int wgid = (int)L; { const int q = nwg / NXCD, r = nwg % NXCD, xcd = wgid % NXCD, off = wgid / NXCD; wgid = (xcd < r ? xcd * (q + 1) : r * (q + 1) + (xcd - r) * q) + off; }
    const int nig = WGM * nN, gid = wgid / nig, fm = gid * WGM, gsz = (nM - fm) < WGM ? (nM - fm) : WGM;
    pm = fm + ((wgid % nig) % gsz); pn = (wgid % nig) / gsz; return true;
}

template <class Epi, class Sched, bool ALIGN_EPI, bool GATHER, bool FP8 = false, bool HALFSEL = false>
__device__ __forceinline__ void gemm_phase(LAS unsigned char* lds, const Gemm g, const Sched& S, const Epi& E) {
    const int tid = threadIdx.x, wid = __builtin_amdgcn_readfirstlane(tid >> 6), lane = tid & 63, wr = wid >> 2, wc = wid & 3, fr = lane & 15, fq = lane >> 4;
    const int K = g.K, nt = K / BK;
    int RA[2]; unsigned cA2[2], voffB[2];
#pragma unroll
    for (int i = 0; i < 2; ++i) { int R, C; stage_rc(tid * 16 + i * 8192, R, C); const int Rb = Epi::PERM ? ((R & ~31) + perm32(R & 31)) : R;
        RA[i] = R; cA2[i] = (unsigned)C * 2u; voffB[i] = (unsigned)(Rb * g.ldb + C) * 2u; }
    const size_t kstep = (size_t)(BK * 2);
    const unsigned hstepA = (unsigned)HALF * (unsigned)g.lda * 2u; const size_t hstepB = (size_t)HALF * g.ldb * 2;
    const unsigned ldsb = (unsigned)__builtin_amdgcn_readfirstlane((unsigned)(unsigned long long)lds + (unsigned)wid * 1024u);
    const int aoff = lds_byte(wr * 64 + fr, fq * 8), boff = lds_byte(wc * 32 + fr, fq * 8);
    const int aoff2 = aoff + 1024, boff2 = boff + 1024;
#define PG8_SA(b, h) (((b) * 2 + (h)) * HTB)
#define PG8_SB(b, h) ((4 + (b) * 2 + (h)) * HTB)
#define PG8_STAGE(bufoff, gbase, voff) do { _Pragma("unroll") for (int _i = 0; _i < 2; ++_i) glds16s((gbase), (voff)[_i], ldsb + (unsigned)(bufoff) + _i * 8192u); } while (0)
#define PG8_STAGE_A(bufoff, gbase, AO, h) do { _Pragma("unroll") for (int _i = 0; _i < 2; ++_i) glds16s((gbase), (AO)[h][_i], ldsb + (unsigned)(bufoff) + _i * 8192u); } while (0)
#define PG8_LD8(base_, o1_, o2_) __builtin_shufflevector(*(const LAS i32x4*)(lds + (base_) + (o1_)), *(const LAS i32x4*)(lds + (base_) + (o2_)), 0, 1, 2, 3, 4, 5, 6, 7)
#define PG8_LDA(dst, b, h) do { if constexpr (FP8) { _Pragma("unroll") for (int m = 0; m < 4; ++m) dst##8[m] = PG8_LD8(PG8_SA(b, h) + m * 2048, aoff, aoff2); } \
        else { _Pragma("unroll") for (int m = 0; m < 4; ++m) _Pragma("unroll") for (int k = 0; k < 2; ++k) dst[m][k] = *(const LAS bf16x8*)(lds + PG8_SA(b, h) + aoff + m * 2048 + k * 1024); } } while (0)
#define PG8_LDB(dst, b, h) do { if constexpr (FP8) { _Pragma("unroll") for (int n = 0; n < 2; ++n) dst##8[n] = PG8_LD8(PG8_SB(b, h) + n * 2048, boff, boff2); } \
        else { _Pragma("unroll") for (int n = 0; n < 2; ++n) _Pragma("unroll") for (int k = 0; k < 2; ++k) dst[n][k] = *(const LAS bf16x8*)(lds + PG8_SB(b, h) + boff + n * 2048 + k * 1024); } } while (0)
#define PG8_MMA(ai, bj, At, Bt) do { __builtin_amdgcn_s_setprio(1); _Pragma("unroll") for (int m = 0; m < 4; ++m) _Pragma("unroll") for (int n = 0; n < 2; ++n) { \
        if constexpr (FP8) asm volatile("v_mfma_f32_16x16x128_f8f6f4 %0, %1, %2, %0" : "+v"(acc[ai][bj][m][n]) : "v"(Bt##8[n]), "v"(At##8[m])); \
        else { _Pragma("unroll") for (int k = 0; k < 2; ++k) acc[ai][bj][m][n] = __builtin_amdgcn_mfma_f32_16x16x32_bf16(Bt[n][k], At[m][k], acc[ai][bj][m][n], 0, 0, 0); } } \
        __builtin_amdgcn_s_setprio(0); } while (0)
#define PG8_WAIT_V(n) asm volatile("s_waitcnt vmcnt(" #n ")" ::: "memory")
#define PG8_WAIT_L(n) asm volatile("s_waitcnt lgkmcnt(" #n ")" ::: "memory")
#define PG8_BAR __builtin_amdgcn_s_barrier()
#define PG8_SCHED __builtin_amdgcn_sched_barrier(0)
#define PG8_AOFF(AO, U) do { _Pragma("unroll") for (int _h = 0; _h < 2; ++_h) _Pragma("unroll") for (int _i = 0; _i < 2; ++_i) { \
        if constexpr (GATHER) AO[_h][_i] = (unsigned)(U).tl[RA[_i] + _h * HALF] * (unsigned)(g.lda * 2) + cA2[_i]; \
        else AO[_h][_i] = (unsigned)RA[_i] * (unsigned)(g.lda * 2) + cA2[_i] + (unsigned)_h * hstepA; } } while (0)
    Unit cur, nxt; int ui = 0;
    if (!S.next(0, cur)) return;
    f32x4 acc[2][2][4][2];
#pragma unroll
    for (int a = 0; a < 2; ++a)
#pragma unroll
        for (int b = 0; b < 2; ++b)
#pragma unroll
            for (int m = 0; m < 4; ++m)
#pragma unroll
                for (int n = 0; n < 2; ++n) acc[a][b][m][n] = (f32x4){0.f, 0.f, 0.f, 0.f};
    bf16x8 At[4][2], B0[2][2], B1[2][2]; i32x8 At8[4], B08[2], B18[2];
    E.prep(cur, 0, wid, lane);
    unsigned aoC[2][2], aoN[2][2];
    PG8_AOFF(aoC, cur);
    const char* cA = uni_ptr(GATHER ? g.Abase : cur.A); const char* cB = uni_ptr(cur.B);
    PG8_STAGE(PG8_SB(0, 0), cB, voffB); PG8_STAGE(PG8_SB(0, 1), cB + hstepB, voffB); PG8_STAGE_A(PG8_SA(0, 0), cA, aoC, 0); PG8_STAGE_A(PG8_SA(0, 1), cA, aoC, 1);
    if (wr == 1) PG8_BAR;
    PG8_WAIT_V(2); PG8_BAR;
    PG8_STAGE(PG8_SB(1, 0), cB + kstep, voffB); PG8_STAGE_A(PG8_SA(1, 0), cA + kstep, aoC, 0); PG8_STAGE(PG8_SB(1, 1), cB + hstepB + kstep, voffB);
    PG8_WAIT_V(6); PG8_BAR;
    for (;;) {
        const bool has_next = S.next(ui + 1, nxt);
        if (has_next) E.prep(nxt, ui + 1, wid, lane);
        if constexpr (GATHER) { if (has_next) PG8_AOFF(aoN, nxt); else { _Pragma("unroll") for (int _h = 0; _h < 2; ++_h) _Pragma("unroll") for (int _i = 0; _i < 2; ++_i) aoN[_h][_i] = aoC[_h][_i]; } }
        const char* nA = uni_ptr(GATHER ? g.Abase : (has_next ? nxt.A : cA)); const char* nB = uni_ptr(has_next ? nxt.B : cB);
        const bool dh0 = cur.x2 != 2, dh1 = cur.x2 != 1;
#pragma nounroll
        for (int t = 0; t < nt; t += 2) {
            const bool last = (t == nt - 2);
            const char* a1 = cA + (size_t)(t + 1) * kstep;
            const char* a2 = last ? nA : cA + (size_t)(t + 2) * kstep; const char* b2 = last ? nB : cB + (size_t)(t + 2) * kstep;
            const char* a3 = a2 + kstep; const char* b3 = b2 + kstep;
            unsigned aoS[2][2];
#pragma unroll
            for (int _h = 0; _h < 2; ++_h)
#pragma unroll
                for (int _i = 0; _i < 2; ++_i) aoS[_h][_i] = (GATHER && last) ? aoN[_h][_i] : aoC[_h][_i];
            PG8_LDB(B0, 0, 0); PG8_LDB(B1, 0, 1); PG8_SCHED; PG8_LDA(At, 0, 0); PG8_STAGE_A(PG8_SA(1, 1), a1, aoC, 1);
            PG8_WAIT_V(8); PG8_WAIT_L(0); PG8_BAR; if (!HALFSEL || dh0) PG8_MMA(0, 0, At, B0); if (!HALFSEL || dh1) PG8_MMA(0, 1, At, B1); PG8_BAR; PG8_SCHED;
            PG8_LDA(At, 0, 1); PG8_STAGE(PG8_SB(0, 0), b2, voffB); PG8_STAGE(PG8_SB(0, 1), b2 + hstepB, voffB); PG8_STAGE_A(PG8_SA(0, 0), a2, aoS, 0);
            PG8_WAIT_V(8); PG8_WAIT_L(0); PG8_BAR; if (!HALFSEL || dh0) PG8_MMA(1, 0, At, B0); if (!HALFSEL || dh1) PG8_MMA(1, 1, At, B1); PG8_BAR; PG8_SCHED;
            PG8_LDB(B0, 1, 0); PG8_LDB(B1, 1, 1); PG8_SCHED; PG8_LDA(At, 1, 0); PG8_STAGE_A(PG8_SA(0, 1), a2, aoS, 1);
            PG8_WAIT_V(8); PG8_WAIT_L(0); PG8_BAR; if (!HALFSEL || dh0) PG8_MMA(0, 0, At, B0); if (!HALFSEL || dh1) PG8_MMA(0, 1, At, B1); PG8_BAR; PG8_SCHED;
            PG8_LDA(At, 1, 1); PG8_STAGE(PG8_SB(1, 0), b3, voffB); PG8_STAGE(PG8_SB(1, 1), b3 + hstepB, voffB); PG8_STAGE_A(PG8_SA(1, 0), a3, aoS, 0);
            PG8_WAIT_V(8); PG8_WAIT_L(0); PG8_BAR; if (!HALFSEL || dh0) PG8_MMA(1, 0, At, B0); if (!HALFSEL || dh1) PG8_MMA(1, 1, At, B1); PG8_BAR; PG8_SCHED;
        }
        if constexpr (FP8) asm volatile("s_nop 15\n\ts_nop 15" ::: "memory");
        if constexpr (ALIGN_EPI) { if (wr == 0) PG8_BAR; }
        E(acc, cur, wr, wc, fr, fq);
        if (!has_next) break;
#pragma unroll
        for (int a = 0; a < 2; ++a)
#pragma unroll
            for (int b = 0; b < 2; ++b)
#pragma unroll
                for (int m = 0; m < 4; ++m)
#pragma unroll
                    for (int n = 0; n < 2; ++n) acc[a][b][m][n] = (f32x4){0.f, 0.f, 0.f, 0.f};
        if constexpr (FP8) asm volatile("s_nop 7" ::: "memory");
        cur = nxt; cA = nA; cB = nB; ++ui;
        if constexpr (GATHER) {
#pragma unroll
            for (int _h = 0; _h < 2; ++_h)
#pragma unroll
                for (int _i = 0; _i < 2; ++_i) aoC[_h][_i] = aoN[_h][_i]; }
        if constexpr (ALIGN_EPI) { if (wr == 1) PG8_BAR; }
    }
    PG8_WAIT_V(0);
    if constexpr (!ALIGN_EPI) { if (wr == 0) PG8_BAR; }
    PG8_BAR;
#undef PG8_SA
#undef PG8_SB
#undef PG8_STAGE
#undef PG8_STAGE_A
#undef PG8_LDA
#undef PG8_LD8
#undef PG8_LDB
#undef PG8_MMA
#undef PG8_WAIT_V
#undef PG8_WAIT_L
#undef PG8_BAR
#undef PG8_SCHED
#undef PG8_AOFF
}
}
#include <hip/hip_bf16.h>
namespace attn_body {
using bf16=__hip_bfloat16;
using bf16x8=__attribute__((ext_vector_type(8)))short;
using s16x4=__attribute__((ext_vector_type(4)))short;
using f32x16=__attribute__((ext_vector_type(16)))float;
using u32x4=__attribute__((ext_vector_type(4)))unsigned;
constexpr int BATCH=4,NHEAD=16,SEQ=4096,D=64,DM=NHEAD*D;
constexpr int NW=8,QBLK=32,QB=QBLK*NW,KVBLK=64,NQB=SEQ/QB;
constexpr int ATTN_PITCH=DM, ATTN_UNIT_ROWS=QB;
__device__ __forceinline__ int crow(int r,int hi){return (r&3)+8*(r>>2)+4*hi;}
#define SBAR() __builtin_amdgcn_sched_barrier(0)
__device__ __forceinline__ void cmask(f32x16&p0,f32x16&p1,int jb,int qrel,int hi){
  const float NEG=-INFINITY; int d=qrel-64*jb-4*hi; asm volatile("":"+v"(d));
  #pragma unroll
  for(int r=0;r<16;++r){const int c=(r&3)+8*(r>>2); if(c>d)p0[r]=NEG; if(c+32>d)p1[r]=NEG;}
}

constexpr int NSLOT=3, SLOTB=8192;
constexpr int LDS_GT=98304;
constexpr int LDS_K=0, LDS_V=NSLOT*SLOTB, LDS_WS=2*NSLOT*SLOTB, LDS_OST=LDS_WS+NW*64*4, LDS_BYTES=LDS_OST+NW*4096;
constexpr float C2=0.125f*1.4426950408889634f;
__device__ __forceinline__ void glds16(const void*gsrc,unsigned lds_dst){unsigned keep;
  asm volatile("s_mov_b32 %0, m0\n\ts_mov_b32 m0, %2\n\ts_nop 0\n\tglobal_load_lds_dwordx4 %1, off\n\ts_mov_b32 m0, %0":"=&s"(keep):"v"(gsrc),"s"(lds_dst):"memory");}
__device__ __forceinline__ void glds16s(const void*sbase,unsigned voff,unsigned lds_dst){unsigned keep;
  asm volatile("s_nop 4\n\ts_mov_b32 %0, m0\n\ts_mov_b32 m0, %3\n\ts_nop 0\n\tglobal_load_lds_dwordx4 %1, %2\n\ts_mov_b32 m0, %0":"=&s"(keep):"v"(voff),"s"(sbase),"s"(lds_dst):"memory");}
__device__ __forceinline__ unsigned lane_now(){unsigned l;asm volatile("v_mbcnt_lo_u32_b32 %0, -1, 0\n\tv_mbcnt_hi_u32_b32 %0, -1, %0":"=v"(l));return l;}
__device__ __forceinline__ float max3f(float a,float b,float c){float r;asm("v_max3_f32 %0, %1, %2, %3":"=v"(r):"v"(a),"v"(b),"v"(c));return r;}
__device__ __forceinline__ float max2f(float a,float b){float r;asm("v_max_f32_e32 %0, %1, %2":"=v"(r):"v"(a),"v"(b));return r;}
__device__ __forceinline__ float fadd_s(float a,float b){float r;asm("v_add_f32_e32 %0, %1, %2":"=v"(r):"v"(a),"v"(b));return r;}
__device__ __forceinline__ float fsub_s(float a,float b){float r;asm("v_sub_f32_e32 %0, %1, %2":"=v"(r):"v"(a),"v"(b));return r;}
typedef float f32x2_t __attribute__((ext_vector_type(2))); typedef __bf16 bf16x2_t __attribute__((ext_vector_type(2)));
__device__ __forceinline__ unsigned cvtpk_s(float lo,float hi){f32x2_t v={lo,hi};bf16x2_t b=__builtin_convertvector(v,bf16x2_t);return __builtin_bit_cast(unsigned,b);}
#define WAIT_BAR(N) asm volatile("s_waitcnt vmcnt(" #N ") lgkmcnt(0)\n\ts_barrier":::"memory")

__device__ __forceinline__ void qkt(f32x16&p0,f32x16&p1,const char*Kslot,const bf16x8*qr,int r32,int hi){
  const char*kb=Kslot+hi*1024+r32*16;
  #pragma unroll
  for(int d0=0;d0<4;++d0){
    const bf16x8 b0=*reinterpret_cast<const bf16x8*>(kb+d0*2048);
    const bf16x8 b1=*reinterpret_cast<const bf16x8*>(kb+d0*2048+512);
    if(d0==0){p0=__builtin_amdgcn_mfma_f32_32x32x16_bf16(b0,qr[0],(f32x16){0.f,0.f,0.f,0.f,0.f,0.f,0.f,0.f,0.f,0.f,0.f,0.f,0.f,0.f,0.f,0.f},0,0,0);p1=__builtin_amdgcn_mfma_f32_32x32x16_bf16(b1,qr[0],(f32x16){0.f,0.f,0.f,0.f,0.f,0.f,0.f,0.f,0.f,0.f,0.f,0.f,0.f,0.f,0.f,0.f},0,0,0);}
    else{p0=__builtin_amdgcn_mfma_f32_32x32x16_bf16(b0,qr[d0],p0,0,0,0);p1=__builtin_amdgcn_mfma_f32_32x32x16_bf16(b1,qr[d0],p1,0,0,0);}}
}
typedef __attribute__((address_space(3))) const char* lds_cptr;
typedef short v4i16_t __attribute__((ext_vector_type(4)));
__device__ __forceinline__ void kload8(bf16x8*kf,lds_cptr kp){
  kf[0]=*(const __attribute__((address_space(3))) bf16x8*)(kp);      kf[1]=*(const __attribute__((address_space(3))) bf16x8*)(kp+512);
  kf[2]=*(const __attribute__((address_space(3))) bf16x8*)(kp+2048); kf[3]=*(const __attribute__((address_space(3))) bf16x8*)(kp+2560);
  kf[4]=*(const __attribute__((address_space(3))) bf16x8*)(kp+4096); kf[5]=*(const __attribute__((address_space(3))) bf16x8*)(kp+4608);
  kf[6]=*(const __attribute__((address_space(3))) bf16x8*)(kp+6144); kf[7]=*(const __attribute__((address_space(3))) bf16x8*)(kp+6656);
}
__device__ __forceinline__ void kload2(bf16x8*kf,lds_cptr kp,int j){ kf[2*j]=*(const __attribute__((address_space(3))) bf16x8*)(kp+j*2048); kf[2*j+1]=*(const __attribute__((address_space(3))) bf16x8*)(kp+j*2048+512); }
__device__ __forceinline__ s16x4 vtr(lds_cptr p){ return __builtin_bit_cast(s16x4,__builtin_amdgcn_ds_read_tr16_b64_v4i16((__attribute__((address_space(3))) v4i16_t*)p)); }
__device__ __forceinline__ float rowmax(const f32x16&p0,const f32x16&p1){
  float a=max3f(p0[0],p0[1],p1[0]),b=max3f(p0[2],p0[3],p1[1]);a=max3f(a,p1[2],p1[3]);
  #pragma unroll
  for(int r=4;r<16;r+=4){a=max3f(a,p0[r],p0[r+1]);b=max3f(b,p0[r+2],p0[r+3]);a=max3f(a,p1[r],p1[r+1]);b=max3f(b,p1[r+2],p1[r+3]);}
  const float m=max2f(a,b);
  auto rr=__builtin_amdgcn_permlane32_swap(__float_as_uint(m),__float_as_uint(m),false,false);
  return max2f(__uint_as_float(rr[0]),__uint_as_float(rr[1]));
}
__device__ __forceinline__ void pv(f32x16*o,int vb,bf16x8 pa0,bf16x8 pa1,bf16x8 pa2,bf16x8 pa3){
  #pragma unroll
  for(int d0=0;d0<2;++d0){s16x4 lo[4],hi[4];
    #pragma unroll
    for(int ks=0;ks<4;++ks){
      asm volatile("ds_read_b64_tr_b16 %0,%1 offset:%c2":"=&v"(lo[ks]):"v"(vb),"i"(d0*4096+ks*1024):"memory");
      asm volatile("ds_read_b64_tr_b16 %0,%1 offset:%c2":"=&v"(hi[ks]):"v"(vb),"i"(d0*4096+ks*1024+512):"memory");}
    asm volatile("s_waitcnt lgkmcnt(0)":::"memory");SBAR();
    #define PK(k) (bf16x8){lo[k][0],lo[k][1],lo[k][2],lo[k][3],hi[k][0],hi[k][1],hi[k][2],hi[k][3]}
    o[d0]=__builtin_amdgcn_mfma_f32_32x32x16_bf16(pa0,PK(0),o[d0],0,0,0);
    o[d0]=__builtin_amdgcn_mfma_f32_32x32x16_bf16(pa1,PK(1),o[d0],0,0,0);
    o[d0]=__builtin_amdgcn_mfma_f32_32x32x16_bf16(pa2,PK(2),o[d0],0,0,0);
    o[d0]=__builtin_amdgcn_mfma_f32_32x32x16_bf16(pa3,PK(3),o[d0],0,0,0);
    #undef PK
  }
}

#ifndef ATTN_STORE16
#define ATTN_STORE16(p,v) (*(u32x4*)(p)=(v))
#endif
template<int THRL> __device__ __forceinline__ void attn_unit(int b,int h,int qb,const bf16*Q,const bf16*__restrict__ K,const bf16*__restrict__ V,bf16*O,const float*ksum,char*shm){
  const int tid=threadIdx.x,lane=tid&63,r32=lane&31,hi=lane>>5; const int wid=__builtin_amdgcn_readfirstlane(tid>>6);
  const long rowbase=(long)b*SEQ; const int q0=qb*QB;
  const bf16*Qw=Q+(rowbase+q0+wid*QBLK)*DM+h*D;
  const bf16*Kh=K+rowbase*DM+h*D,*Vh=V+rowbase*DM+h*D;
  const unsigned lds0=(unsigned)(uintptr_t)shm;
  float*wsf=(float*)(shm+LDS_WS)+wid*64;
  const unsigned kdst=lds0+LDS_K+wid*1024, vdst=lds0+LDS_V+wid*1024;
  #define PHYS(t) (((t)<4)?(4*qb+(t)):((t)-4))
  #define DMA_K(t,slot) glds16s((const char*)Kh+(size_t)PHYS(t)*(KVBLK*DM*2)+wid*16,lane_now()*(unsigned)(DM*2),(unsigned)__builtin_amdgcn_readfirstlane(kdst+(slot)))
  #define DMA_V(t,slot) glds16s((const char*)Vh+(size_t)PHYS(t)*(KVBLK*DM*2)+(size_t)(16*(wid&3))*(DM*2)+(wid>>2)*64,({const unsigned l_=lane_now(); (l_>>2)*(unsigned)(DM*2)+(l_&3u)*16u;}),(unsigned)__builtin_amdgcn_readfirstlane(vdst+(slot)))
  const int vb0=(int)(lds0+LDS_V)+((lane>>4)&1)*32+(lane&3)*8+(4*hi+((lane&15)>>2))*64;
  const char*Kbase=shm+LDS_K; bf16x8 kf[8];
  const lds_cptr shm3=(lds_cptr)shm; const lds_cptr kp0=shm3+LDS_K+hi*1024+r32*16; const lds_cptr vp0=shm3+LDS_V+((lane>>4)&1)*32+(lane&3)*8+(4*hi+((lane&15)>>2))*64;
  const int NT=(q0+QB)/KVBLK;
  DMA_K(0,0);DMA_V(0,0);DMA_K(1,SLOTB);
  { float*gt=(float*)(shm+LDS_GT);
    #pragma unroll
    for(int k=0;k<2;++k){ const int j=2*wid+k; if(j<qb) gt[j*64+lane]=ksum[(long)(b*16+j)*DM+h*D+lane]; } }
  bf16x8 qr[4];
  #pragma unroll
  for(int d0=0;d0<4;++d0)qr[d0]=*reinterpret_cast<const bf16x8*>(&Qw[(long)r32*DM+d0*16+hi*8]);

  unsigned sel=0u;
  float mhat=0.f,l_reg=0.f;f32x16 o[2];o[0]=f32x16{};o[1]=f32x16{};
  bf16x8 kone=(bf16x8){0,0,0,0,0,0,0,0}, qm=(bf16x8){0,0,0,0,0,0,0,0}; if(hi==0) kone[0]=(short)0x3F80;
  #define SETQM() do{ const unsigned short mb_=(unsigned short)(cvtpk_s(-mhat,0.f)&0xffffu); qm[0]=(hi==0)?(short)mb_:(short)0; asm volatile("":"+v"(qm)); }while(0)
  const int qrel=wid*QBLK+r32;
  #define CMASK(P0,P1,t) do{ const int t_=(t); if(t_<4){ const int l_=(int)lane_now(); cmask(P0,P1,t_,wid*QBLK+(l_&31),l_>>5); } else if(!((sel>>(((t_-4)>>2)&15))&1u)){ _Pragma("unroll") for(int r=0;r<16;++r){P0[r]=-INFINITY;P1[r]=-INFINITY;} } }while(0)
  bool resc=false;
  #define START(P0,P1) do{ const float rm=rowmax(P0,P1); resc=false; \
    { const float dl=__uint_as_float(cvtpk_s(rm,0.f)<<16); mhat=fadd_s(mhat,dl);          \
      _Pragma("unroll") for(int r=0;r<16;++r){P0[r]=fsub_s(P0[r],dl);P1[r]=fsub_s(P1[r],dl);} \
      SETQM(); } \
    _Pragma("unroll") for(int r=0;r<16;++r)P0[r]=__builtin_amdgcn_exp2f(P0[r]); }while(0)
  #define RESC() do{ if(resc){ asm volatile("s_waitcnt lgkmcnt(0)":::"memory"); \
      _Pragma("unroll") for(int d_=0;d_<2;++d_) _Pragma("unroll") for(int r=0;r<16;++r)o[d_][r]*=wsf[crow(r,(int)(lane_now()>>5))]; } }while(0)
  f32x16 pA0,pA1,pB0,pB1;
  int sl_prev=0,sl_cur=0,sl_next=SLOTB;
  #define ROT() do{sl_prev=sl_cur;sl_cur=sl_next;sl_next=(sl_next==(NSLOT-1)*SLOTB)?0:sl_next+SLOTB;}while(0)
  DMA_K(2,2*SLOTB);
  WAIT_BAR(3);
  { float qf[32];
    #pragma unroll
    for(int d0=0;d0<4;++d0){
      #pragma unroll
      for(int i=0;i<8;++i) qf[d0*8+i]=__uint_as_float(((unsigned)(unsigned short)qr[d0][i])<<16); }
    const float*gt=(const float*)(shm+LDS_GT)+hi*8; float g[15];
    #pragma unroll
    for(int j=0;j<15;++j){ g[j]=-INFINITY;
      if(j<qb){ const float*kp=gt+j*64; float a=0.f;
        #pragma unroll
        for(int d0=0;d0<4;++d0){ const float4 k0=*reinterpret_cast<const float4*>(kp+d0*16), k1=*reinterpret_cast<const float4*>(kp+d0*16+4);
          a+=qf[d0*8+0]*k0.x; a+=qf[d0*8+1]*k0.y; a+=qf[d0*8+2]*k0.z; a+=qf[d0*8+3]*k0.w; a+=qf[d0*8+4]*k1.x; a+=qf[d0*8+5]*k1.y; a+=qf[d0*8+6]*k1.z; a+=qf[d0*8+7]*k1.w; }
        g[j]=a+__shfl_xor(a,32); } }
    #pragma unroll
    for(int kk=0;kk<3;++kk){ float best=-INFINITY; int bj=-1;
      #pragma unroll
      for(int j=0;j<15;++j){ const bool c=(j<qb)&&!((sel>>j)&1u)&&(g[j]>best); best=c?g[j]:best; bj=c?j:bj; }
      if(bj>=0) sel|=(1u<<bj); } }
  qkt(pA0,pA1,Kbase,qr,r32,hi);asm volatile("s_nop 15\n\ts_nop 7":"+v"(pA0),"+v"(pA1));CMASK(pA0,pA1,0);
  START(pA0,pA1);
  _Pragma("unroll") for(int r=0;r<16;++r)pA1[r]=__builtin_amdgcn_exp2f(pA1[r]);
  WAIT_BAR(0);
  DMA_K(3,0);DMA_V(1,SLOTB);
  ROT();
  kload8(kf,kp0+sl_cur);
  WAIT_BAR(2);
  s16x4 vlo[8],vhi[8]; u32x4 pw0,pw1,pw2,pw3;
  #define PKW(P,B) cvtpk_s(P[B],P[B+1])
  #define PAF(k) __builtin_bit_cast(bf16x8,pw##k)
  #define VFR(i) (bf16x8){vlo[i][0],vlo[i][1],vlo[i][2],vlo[i][3],vhi[i][0],vhi[i][1],vhi[i][2],vhi[i][3]}
  #define PIN(x) asm volatile("":"+v"(x))
  #define MX3(a,b,c) __builtin_fmaxf(__builtin_fmaxf((a),(b)),(c))
  #define GAPA(MF,A0,A1,A2,A3,W0,W1,PW) do{ MF; sacc+=A0; sacc+=A1; sacc+=A2; sacc+=A3; PIN(sacc); W0; W1; PIN(PW); SBAR(); }while(0)
  #define EX(v) __builtin_amdgcn_exp2f(v)
  #define GAPB(MF,X,B) do{ MF; X[B]=EX(X[B]); X[B+1]=EX(X[B+1]); X[B+2]=EX(X[B+2]); X[B+3]=EX(X[B+3]); PIN(X); SBAR(); }while(0)
  #define VRD(i) do{ vlo[i]=vtr(vp_+(((i)>>2)*4096+((i)&3)*1024)); vhi[i]=vtr(vp_+(((i)>>2)*4096+((i)&3)*1024+512)); }while(0)
  #define KRD(G,j) do{ if(G){ kload2(kf,kp0+sl_next,j); SBAR(); } }while(0)
  #define STEP(C0,C1,P0,P1,t,GK,GV,GL) do{ SBAR(); \
    const lds_cptr vp_=vp0+sl_prev; \
    C0=__builtin_amdgcn_mfma_f32_32x32x16_bf16(kone,qm,(f32x16){0.f,0.f,0.f,0.f,0.f,0.f,0.f,0.f,0.f,0.f,0.f,0.f,0.f,0.f,0.f,0.f},0,0,0); C1=__builtin_amdgcn_mfma_f32_32x32x16_bf16(kone,qm,(f32x16){0.f,0.f,0.f,0.f,0.f,0.f,0.f,0.f,0.f,0.f,0.f,0.f,0.f,0.f,0.f,0.f},0,0,0); SBAR(); \
    VRD(0); SBAR(); float sacc=(P0[0]+P0[1]); \
    GAPA(C0=__builtin_amdgcn_mfma_f32_32x32x16_bf16(kf[0],qr[0],C0,0,0,0), P0[2],P0[3],P0[4],P0[5],     pw0[0]=PKW(P0,0), pw0[1]=PKW(P0,2), pw0); \
    VRD(4); SBAR(); GAPA(C1=__builtin_amdgcn_mfma_f32_32x32x16_bf16(kf[1],qr[0],C1,0,0,0), P0[6],P0[7],P0[8],P0[9],     pw0[2]=PKW(P0,4), pw0[3]=PKW(P0,6), pw0); \
    VRD(1); SBAR(); GAPA(C0=__builtin_amdgcn_mfma_f32_32x32x16_bf16(kf[2],qr[1],C0,0,0,0),   P0[10],P0[11],P0[12],P0[13], pw1[0]=PKW(P0,8), pw1[1]=PKW(P0,10), pw1); \
    VRD(5); SBAR(); GAPA(C1=__builtin_amdgcn_mfma_f32_32x32x16_bf16(kf[3],qr[1],C1,0,0,0),   P0[14],P0[15],P1[0],P1[1],   pw1[2]=PKW(P0,12),pw1[3]=PKW(P0,14), pw1); \
    VRD(2); SBAR(); GAPA(C0=__builtin_amdgcn_mfma_f32_32x32x16_bf16(kf[4],qr[2],C0,0,0,0),   P1[2],P1[3],P1[4],P1[5],     pw2[0]=PKW(P1,0), pw2[1]=PKW(P1,2), pw2); \
    VRD(6); SBAR(); GAPA(C1=__builtin_amdgcn_mfma_f32_32x32x16_bf16(kf[5],qr[2],C1,0,0,0),   P1[6],P1[7],P1[8],P1[9],     pw2[2]=PKW(P1,4), pw2[3]=PKW(P1,6), pw2); \
    VRD(3); SBAR(); GAPA(C0=__builtin_amdgcn_mfma_f32_32x32x16_bf16(kf[6],qr[3],C0,0,0,0),   P1[10],P1[11],P1[12],P1[13], pw3[0]=PKW(P1,8), pw3[1]=PKW(P1,10), pw3); \
    VRD(7); SBAR(); GAPA(C1=__builtin_amdgcn_mfma_f32_32x32x16_bf16(kf[7],qr[3],C1,0,0,0),   P1[14],P1[15],0.f,0.f,       pw3[2]=PKW(P1,12),pw3[3]=PKW(P1,14), pw3); \
    l_reg+=sacc; \
    if(GK){DMA_K((t)+3,sl_cur);} if(GV){DMA_V((t)+1,sl_next);} \
    CMASK(C0,C1,t); \
    { float a=MX3(C0[0],C0[1],C1[0]),b=MX3(C0[2],C0[3],C1[1]); a=MX3(a,C1[2],C1[3]); \
      _Pragma("unroll") for(int r=4;r<16;r+=4){a=MX3(a,C0[r],C0[r+1]);b=MX3(b,C0[r+2],C0[r+3]);a=MX3(a,C1[r],C1[r+1]);b=MX3(b,C1[r+2],C1[r+3]);} \
      float rm=__builtin_fmaxf(a,b); { auto rr=__builtin_amdgcn_permlane32_swap(__float_as_uint(rm),__float_as_uint(rm),false,false); rm=__builtin_fmaxf(__uint_as_float(rr[0]),__uint_as_float(rr[1])); } \
      resc=false; \
      if(__builtin_expect(__any(rm>(float)THRL),0)){ const float mn_=__uint_as_float(cvtpk_s(mhat+__builtin_fmaxf(rm,0.f),0.f)<<16); const float dl=mn_-mhat; mhat=mn_; \
        _Pragma("unroll") for(int r=0;r<16;++r){C0[r]-=dl;C1[r]-=dl;} \
        SETQM(); \
        const float f=__builtin_amdgcn_exp2f(-dl); l_reg*=f; { const int l_=(int)lane_now(); if((l_>>5)==0)wsf[l_&31]=f; } resc=true; } } \
    SBAR(); \
    GAPB(o[0]=__builtin_amdgcn_mfma_f32_32x32x16_bf16(PAF(0),VFR(0),o[0],0,0,0), C0,0); \
    GAPB(o[1]=__builtin_amdgcn_mfma_f32_32x32x16_bf16(PAF(0),VFR(4),o[1],0,0,0), C0,4); \
    KRD(GL,0); GAPB(o[0]=__builtin_amdgcn_mfma_f32_32x32x16_bf16(PAF(1),VFR(1),o[0],0,0,0), C0,8); \
    KRD(GL,1); GAPB(o[1]=__builtin_amdgcn_mfma_f32_32x32x16_bf16(PAF(1),VFR(5),o[1],0,0,0), C0,12); \
    KRD(GL,2); GAPB(o[0]=__builtin_amdgcn_mfma_f32_32x32x16_bf16(PAF(2),VFR(2),o[0],0,0,0), C1,0); \
    KRD(GL,3); GAPB(o[1]=__builtin_amdgcn_mfma_f32_32x32x16_bf16(PAF(2),VFR(6),o[1],0,0,0), C1,4); \
    GAPB(o[0]=__builtin_amdgcn_mfma_f32_32x32x16_bf16(PAF(3),VFR(3),o[0],0,0,0), C1,8); \
    GAPB(o[1]=__builtin_amdgcn_mfma_f32_32x32x16_bf16(PAF(3),VFR(7),o[1],0,0,0), C1,12); \
    }while(0)
  int t=1;
  #undef CMASK
  #define CMASK(P0,P1,t) do{ const int t_=(t); if(t_<4){ const int l_=(int)lane_now(); cmask(P0,P1,t_,wid*QBLK+(l_&31),l_>>5); } else if(!((sel>>(((t_-4)>>2)&15))&1u)){ _Pragma("unroll") for(int r=0;r<16;++r){P0[r]=-INFINITY;P1[r]=-INFINITY;} } }while(0)
  for(;t+5<NT;t+=2){
    STEP(pB0,pB1,pA0,pA1,t,true,true,true);     WAIT_BAR(2); RESC(); ROT();
    STEP(pA0,pA1,pB0,pB1,t+1,true,true,true);   WAIT_BAR(2); RESC(); ROT();
  }
  #undef CMASK
  #define CMASK(P0,P1,t) do{ const int t_=(t); if(t_<4){ const int l_=(int)lane_now(); cmask(P0,P1,t_,wid*QBLK+(l_&31),l_>>5); } else if(!((sel>>(((t_-4)>>2)&15))&1u)){ _Pragma("unroll") for(int r=0;r<16;++r){P0[r]=-INFINITY;P1[r]=-INFINITY;} } }while(0)
  #define ENDW(tt) do{ if((tt)+3<NT){WAIT_BAR(2);} else if((tt)+2<NT){WAIT_BAR(1);} else {WAIT_BAR(0);} }while(0)
  for(;t+1<NT;t+=2){
    STEP(pB0,pB1,pA0,pA1,t,(t+3<NT),(t+1<NT),(t+1<NT));       ENDW(t);   RESC(); ROT();
    STEP(pA0,pA1,pB0,pB1,t+1,(t+4<NT),(t+2<NT),(t+2<NT));     ENDW(t+1); RESC(); ROT();
  }
  STEP(pB0,pB1,pA0,pA1,NT-1,false,false,false); RESC();
  { float sacc=pB0[0]+pB0[1]; _Pragma("unroll") for(int r=2;r<16;++r)sacc+=pB0[r]; _Pragma("unroll") for(int r=0;r<16;++r)sacc+=pB1[r]; l_reg+=sacc;
    pw0=(u32x4){PKW(pB0,0),PKW(pB0,2),PKW(pB0,4),PKW(pB0,6)};pw1=(u32x4){PKW(pB0,8),PKW(pB0,10),PKW(pB0,12),PKW(pB0,14)};pw2=(u32x4){PKW(pB1,0),PKW(pB1,2),PKW(pB1,4),PKW(pB1,6)};pw3=(u32x4){PKW(pB1,8),PKW(pB1,10),PKW(pB1,12),PKW(pB1,14)};
    SBAR(); pv(o,vb0+sl_cur,PAF(0),PAF(1),PAF(2),PAF(3)); }
  #undef PKW
  #undef PAF
  #undef VFR
  #undef PIN
  #undef MX3
  #undef GAPA
  #undef GAPB
  #undef EX
  #undef VRD
  #undef KRD
  #undef STEP
  #undef ENDW
  {auto rr=__builtin_amdgcn_permlane32_swap(__float_as_uint(l_reg),__float_as_uint(l_reg),false,false);l_reg=__uint_as_float(rr[0])+__uint_as_float(rr[1]);}
  if(hi==0)wsf[32+r32]=l_reg;asm volatile("s_waitcnt lgkmcnt(0)":::"memory");
  float rli[16];
  #pragma unroll
  for(int r=0;r<16;++r)rli[r]=__builtin_amdgcn_rcpf(wsf[32+crow(r,hi)]);
  bf16*Ow=O+(rowbase+q0+wid*QBLK)*DM+h*D;
  { bf16*stg=(bf16*)(shm+LDS_OST)+wid*2048;
    #pragma unroll
    for(int r=0;r<16;++r){const int orow=crow(r,hi);
      #pragma unroll
      for(int d0=0;d0<2;++d0)stg[orow*64+d0*32+r32]=__float2bfloat16(o[d0][r]*rli[r]);}
    asm volatile("s_waitcnt lgkmcnt(0)":::"memory");
    #pragma unroll
    for(int i=0;i<4;++i){const int row=i*8+(lane>>3),ch=lane&7; const u32x4 v=*(const u32x4*)(stg+row*64+ch*8); ATTN_STORE16(Ow+(long)row*DM+ch*8,v);} }
  asm volatile("s_waitcnt lgkmcnt(0)\n\ts_barrier":::"memory");
  #undef DMA_K
  #undef PHYS
  #undef DMA_V
  #undef CMASK
  #undef START
  #undef SETQM
  #undef RESC
  #undef ROT
}
constexpr int ATTN_LDS_BYTES=LDS_BYTES;
struct AttnTensors { const bf16* Q; const bf16* K; const bf16* V; bf16* O; const float* ksum; };
struct AttnUnit { int bh; int qb; };
struct StaticOrder {
  int vcu, G;
  __device__ __forceinline__ explicit StaticOrder(int grid,int block):vcu((grid%8==0)?((block%8)*(grid/8)+block/8):block),G(grid){}
  __device__ __forceinline__ bool next(int i,AttnUnit&u)const{ const int L=i*G+vcu; if(L>=1024)return false; const int w=L&255, rnd=L>>8, s=w&3; u.bh=w>>2; u.qb=(rnd==0)?s:(rnd==1)?7-s:(rnd==2)?8+s:15-s; return true; }
  __device__ __forceinline__ void a_ready(const AttnUnit&)const{}
  __device__ __forceinline__ void done(const AttnUnit&)const{}
};
struct SnakeOrder {
  int v, G;
  __device__ __forceinline__ bool next(int i,AttnUnit&u)const{ const int idx=i*G+((i&1)?(G-1-v):v); if(idx>=1024)return false; u.qb=15-(idx>>6); u.bh=idx&63; return true; }
  __device__ __forceinline__ void a_ready(const AttnUnit&)const{}
  __device__ __forceinline__ void done(const AttnUnit&)const{}
};
template<class Sched,int THRL=8> __device__ __forceinline__ void attn_phase(char*lds,const AttnTensors&T,const Sched&S){
  AttnUnit u;
  for(int i=0;S.next(i,u);++i){ S.a_ready(u); attn_unit<THRL>(u.bh/NHEAD,u.bh%NHEAD,u.qb,T.Q,T.K,T.V,T.O,T.ksum,lds); S.done(u); }
}
#undef SBAR
#undef WAIT_BAR
}
constexpr int NWAVES = 8, NTHR = 512;
constexpr int NTOK = 16384, DM = 1024, SEQ = 4096, NBATCH = 4, NEXP = 32;
constexpr float ALPHA = 1.4142135623730951f;
constexpr float LN_EPS = 1e-5f;
constexpr float RSQRT_DQK = 0.08838834764831845f;
constexpr int NPHASE = 19;
constexpr float FP8_SA = 4.0f, FP8_SWGU = 64.0f, FP8_SWD = 128.0f;
constexpr float FP8_SY = 32.0f, FP8_MAXV = 448.0f;
#ifndef DBG_ATTN_MUL
#define DBG_ATTN_MUL 1.0f
#endif
#ifndef DBG_MLSTM_MUL
#define DBG_MLSTM_MUL 1.0f
#endif
#ifndef DBG_MOE_MUL
#define DBG_MOE_MUL 1.0f
#endif
#ifndef DBG_P14_A
#define DBG_P14_A WS_HN
#endif
#ifndef NCONV
#define NCONV 80
#endif
#ifndef MK_ONE_LAUNCH
#define MK_ONE_LAUNCH 1
#endif

constexpr size_t MiB = 1u << 20, KiB = 1024;
constexpr size_t WS_CTL = 0, CTL_ZERO_BYTES = 1 * MiB;
constexpr int CW_TMO = 0, CW_BAR = 4096, CW_CNT = 8192, CW_AQ = 16384;
constexpr size_t WS_KSUM = 256 * KiB, WS_DEN = 512 * KiB;
constexpr size_t WS_WQKV = 2 * MiB, WS_WO = 8 * MiB, WS_WINA = 10 * MiB, WS_WINB = 14 * MiB, WS_WOUT = 17 * MiB;
constexpr size_t WS_WG = 19 * MiB, WS_RWT = 20 * MiB, WS_ROPE = 21 * MiB;
constexpr size_t WS_TOKE = 22 * MiB, WS_TOKP = 22 * MiB + 256 * KiB, WS_TOKG = 22 * MiB + 512 * KiB;
constexpr size_t WS_GI = 23 * MiB, WS_LF = 23 * MiB + 256 * KiB, WS_RF = 23 * MiB + 512 * KiB, WS_CF = 23 * MiB + 768 * KiB;
constexpr size_t WS_DEC = 24 * MiB, WS_NU = 24 * MiB + 256 * KiB, WS_NPREV = 24 * MiB + 512 * KiB;
constexpr size_t WS_ROWTOK = 25 * MiB;
constexpr size_t WS_XB = 32 * MiB, WS_Q = 64 * MiB, WS_K = 96 * MiB, WS_V = 128 * MiB;
constexpr size_t WS_R0 = 160 * MiB, WS_R1 = 224 * MiB, WS_R2 = 288 * MiB;
constexpr size_t WS_H = 352 * MiB, WS_Y = 496 * MiB;
constexpr size_t WS_WGU = 640 * MiB, WS_WD = 896 * MiB, WS_END = 1024 * MiB;
constexpr size_t WS_AE = 352 * MiB, WS_BE = 416 * MiB, WS_KN = 464 * MiB, WS_KT = 496 * MiB, WS_UT = 512 * MiB, WS_OS = 544 * MiB, WS_HN = 576 * MiB;

constexpr int RING_OFF = 0, RING_BYTES = 131072;
constexpr int LX = RING_BYTES;
constexpr int LX_MISC = LX;
constexpr int LX_TILEE = LX + 128;
constexpr int LX_TBASE = LX + 1280;
constexpr int LX_LCNT = LX + 1536, LX_GBASE = LX + 1664;
constexpr int LX_REC = LX + 1792;
constexpr int LX_TOKL = LX + 4096;
constexpr int LX_LNX = LX + 4096;
constexpr int LX_BIAS = LX + 12288;
constexpr int LDS_BYTES = 147456;
constexpr int TOKL_ROUNDS = 10;

#define RLX_AGENT __ATOMIC_RELAXED, __HIP_MEMORY_SCOPE_AGENT
#define LDS_WAIT() asm volatile("s_waitcnt lgkmcnt(0)" ::: "memory")
#define VM_WAIT() asm volatile("s_waitcnt vmcnt(0)" ::: "memory")
#define XB_TMO      128
#define XB_XCNT(j)  (256  + 64 * (j))
#define XB_XSUB(j)  (1280 + 64 * (j))
#define XB_XGEN(j)  (2304 + 64 * (j))
#define XB_TOP      3328
#define XB_TOPGEN   3392
#define XCD_BAR_WORDS 3456
#define XB_SPIN_CAP (1u << 18)

__device__ __forceinline__ unsigned xb_ld(unsigned* p)              { return __hip_atomic_load(p, __ATOMIC_RELAXED, __HIP_MEMORY_SCOPE_AGENT); }
__device__ __forceinline__ unsigned xb_add(unsigned* p, unsigned v) { return __hip_atomic_fetch_add(p, v, __ATOMIC_RELAXED, __HIP_MEMORY_SCOPE_AGENT); }
__device__ __forceinline__ unsigned xb_xcc_id() { return (unsigned)__builtin_amdgcn_s_getreg((3 << 11) | 20) & 0xFu; }
#define XB_SPIN(cond, bar) do { unsigned _sp = 0; while (cond) { __builtin_amdgcn_s_sleep(1); \
    if ((++_sp & 255u) == 0u) { if (xb_ld(&(bar)[XB_TMO])) break; if (_sp > XB_SPIN_CAP) { atomicAdd(&(bar)[XB_TMO], 1u); break; } } } } while (0)

struct XcdBarrier {
    unsigned* bar; unsigned x;
    volatile LAS unsigned* st;
};

__device__ __forceinline__ XcdBarrier xcd_barrier_post(unsigned* bar, volatile LAS unsigned* st) {
    XcdBarrier b; b.bar = bar; b.x = xb_xcc_id(); b.st = st;
    if (threadIdx.x == 0) (void)xb_add(&bar[XB_XCNT(b.x)], 1u);
    return b;
}
__device__ __forceinline__ void xcd_barrier_complete(unsigned* bar, unsigned x, unsigned& nloc, unsigned& nx) {
    const unsigned G = gridDim.x * gridDim.y * gridDim.z;
    unsigned sum, cnt, mine, sp = 0u;
    for (;;) {
        sum = 0u; cnt = 0u; mine = 0u;
#pragma unroll
        for (unsigned j = 0; j < 16; ++j) { const unsigned c = xb_ld(&bar[XB_XCNT(j)]); sum += c; cnt += (c > 0u) ? 1u : 0u; mine = (j == x) ? c : mine; }
        if (sum == G) break;
        __builtin_amdgcn_s_sleep(1);
        if ((++sp & 255u) == 0u) { if (xb_ld(&bar[XB_TMO])) break; if (sp > XB_SPIN_CAP) { atomicAdd(&bar[XB_TMO], 1u); break; } }
    }
    nloc = mine > 0u ? mine : 1u; nx = cnt > 0u ? cnt : 1u;
}

__device__ __forceinline__ void xcd_barrier(const XcdBarrier& b) {
    asm volatile("s_waitcnt vmcnt(0)" ::: "memory");
    __syncthreads();
    if (threadIdx.x == 0) {
        unsigned* bar = b.bar;
        __builtin_amdgcn_s_waitcnt(0);
        unsigned nloc = b.st[0], nx = b.st[1];
        if (nloc == 0u) { xcd_barrier_complete(bar, b.x, nloc, nx); b.st[0] = nloc; b.st[1] = nx; }
        const unsigned old = xb_add(&bar[XB_XSUB(b.x)], 1u);
        const unsigned gen = old / nloc;
        if (old + 1u == (gen + 1u) * nloc) {
            __builtin_amdgcn_fence(__ATOMIC_RELEASE, "agent");
            asm volatile("s_waitcnt vmcnt(0)" ::: "memory");
            const unsigned og = xb_add(&bar[XB_TOP], 1u);
            const unsigned tg = og / nx;
            if (og + 1u == (tg + 1u) * nx) xb_add(&bar[XB_TOPGEN], 1u);
            else XB_SPIN(xb_ld(&bar[XB_TOPGEN]) == tg, bar);
            __builtin_amdgcn_fence(__ATOMIC_ACQUIRE, "agent");
            xb_add(&bar[XB_XGEN(b.x)], 1u);
            asm volatile("s_waitcnt vmcnt(0)" ::: "memory");
        } else {
            XB_SPIN(xb_ld(&bar[XB_XGEN(b.x)]) == gen, bar);
            __builtin_amdgcn_fence(__ATOMIC_ACQUIRE, "agent");
            asm volatile("s_waitcnt vmcnt(0)" ::: "memory");
        }
    }
    __syncthreads();
}
using pg8::Unit; using pg8::Gemm;
typedef f32x4 (&AccRef)[2][2][4][2];

#ifndef TAIL_FIRST
#define TAIL_FIRST 0
#endif
__device__ __forceinline__ bool moe_unit(int i, int G, int c, int nT, int nN, int& pm, int& pn, int& half) {
    const int U = nT * nN, R = U / G, rem = U - R * G; half = 0;
#if TAIL_FIRST
    if (rem > 0 && 2 * rem <= G) {
        if (c < 2 * rem) { if (i == 0) { half = 1 + (c & 1); return pg8::tile_order(0, U, R * G + (c >> 1), nT, nN, pm, pn); } --i; }
        if (i < R) return pg8::tile_order(i, G, c, nT, nN, pm, pn);
        return false; }
#endif
    if (i < R) return pg8::tile_order(i, G, c, nT, nN, pm, pn);
    if (i > R || rem == 0) return false;
    if (2 * rem <= G) { if (c >= 2 * rem) return false; half = 1 + (c & 1); return pg8::tile_order(0, U, R * G + (c >> 1), nT, nN, pm, pn); }
    return pg8::tile_order(i, G, c, nT, nN, pm, pn);
}
struct DenseSched {
    int nM, nN, G, c; const char* A; const char* B; size_t tstepA, tstepB; bool split = false;
    __device__ __forceinline__ bool next(int i, Unit& u) const {
        int half = 0;
        if (split) { if (!moe_unit(i, G, c, nM, nN, u.pm, u.pn, half)) return false; }
        else if (!pg8::tile_order(i, G, c, nM, nN, u.pm, u.pn)) return false;
        u.A = A + (size_t)u.pm * tstepA; u.B = B + (size_t)u.pn * tstepB; u.tl = nullptr; u.x0 = u.x1 = 0; u.x2 = half; return true; }
};
struct MoeSched {
    int nT, nN, G, c; const LAS int* tile_e; const LAS int* tbase; const LAS unsigned short* tokl;
    const char* A; const char* B; size_t tstepA, estepB, tstepB;
    __device__ __forceinline__ bool next(int i, Unit& u) const {
        int half; if (!moe_unit(i, G, c, nT, nN, u.pm, u.pn, half)) return false;
        const int e = tile_e[u.pm];
        u.x0 = e; u.x1 = u.pm * 256; u.x2 = half;
        u.A = A + (size_t)u.pm * tstepA; u.B = B + (size_t)e * estepB + (size_t)u.pn * tstepB;
        u.tl = tokl ? tokl + (i < TOKL_ROUNDS ? i : TOKL_ROUNDS - 1) * 256 : nullptr; return true; }
};
struct MuSched {
    int G, c, mode; const char* A; const char* B;
    __device__ __forceinline__ bool next(int i, Unit& u) const {
        const int mu = i * G + c; if (mu >= 256) return false;
        const int b = mu >> 6, hh = (mu >> 4) & 3, ch = mu & 15; const size_t tok0 = (size_t)b * SEQ + (size_t)ch * 256;
        u.pm = mu; u.pn = 0; u.x0 = mu; u.x1 = u.x2 = 0; u.tl = nullptr;
        if (mode == 0) { u.A = A + (size_t)mu * 256 * 384 * 2; u.B = B + ((size_t)(hh * 128) * NTOK + tok0) * 2; }
        else if (mode == 1) { u.A = A + ((size_t)mu * 256 * 512 + 256) * 2; u.B = B + (tok0 * 1024 + (size_t)hh * 256) * 2; }
        else { u.A = A + (size_t)mu * 256 * 512 * 2; u.B = B + (size_t)mu * 256 * 384 * 2; }
        return true; }
};

constexpr float C2 = 0.125f * 1.4426950408889634f;

struct EpiQKV {
    static constexpr bool PERM = true;
    __device__ __forceinline__ void prep(const Unit&, int, int, int) const {}
    bf16_t* Q; bf16_t* K; bf16_t* V; const float* rope; float* ksum;
    __device__ __forceinline__ void operator()(AccRef acc, const Unit& u, int wr, int wc, int fr, int fq) const {
        asm volatile("" : "+v"(fr), "+v"(fq));
        const int part = u.pn >> 2, colt = (u.pn & 3) * 256;
        bf16_t* base = Q + (size_t)part * ((WS_K - WS_Q) / 2);
        const bool rot = (part < 2) && ((wc & 1) == 0);
        const float sgn = (fq == 0) ? -1.f : 1.f;
        float ks[2][8];
#pragma unroll
        for (int bj = 0; bj < 2; ++bj)
#pragma unroll
            for (int j = 0; j < 8; ++j) ks[bj][j] = 0.f;
#pragma unroll
        for (int ai = 0; ai < 2; ++ai)
#pragma unroll
            for (int m = 0; m < 4; ++m) {
                const int row = u.pm * 256 + ai * 128 + wr * 64 + m * 16 + fr;
                f32x4 cs0 = {1.f, 1.f, 1.f, 1.f}, cs1 = cs0, sn0 = {0.f, 0.f, 0.f, 0.f}, sn1 = sn0;
                if (rot) { const f32x4* rp = (const f32x4*)(rope + (size_t)row * 16); cs0 = rp[0]; cs1 = rp[1]; sn0 = rp[2]; sn1 = rp[3]; }
#pragma unroll
                for (int bj = 0; bj < 2; ++bj) {
                    f32x4 v0 = acc[ai][bj][m][0], v1 = acc[ai][bj][m][1];
                    if (rot) {
                        f32x4 p0, p1;
#pragma unroll
                        for (int j = 0; j < 4; ++j) { p0[j] = __shfl_xor(v0[j], 16); p1[j] = __shfl_xor(v1[j], 16); }
                        if (fq < 2) { v0 = v0 * cs0 + p0 * sn0 * sgn; v1 = v1 * cs1 + p1 * sn1 * sgn; }
                    }
                    if (part == 0) { v0 = v0 * C2; v1 = v1 * C2; }
                    if (part == 1) {
#pragma unroll
                        for (int j = 0; j < 4; ++j) { ks[bj][j] += v0[j]; ks[bj][4 + j] += v1[j]; } }
                    u32x4 w; w.x = cvt_pk_bf16(v0[0], v0[1]); w.y = cvt_pk_bf16(v0[2], v0[3]); w.z = cvt_pk_bf16(v1[0], v1[1]); w.w = cvt_pk_bf16(v1[2], v1[3]);
                    *(u32x4*)(base + (size_t)row * DM + colt + bj * 128 + wc * 32 + fq * 8) = w;
                }
            }
        if (part == 1) {
#pragma unroll
            for (int bj = 0; bj < 2; ++bj)
#pragma unroll
                for (int j = 0; j < 8; ++j) { float s = ks[bj][j]; s += __shfl_xor(s, 1); s += __shfl_xor(s, 2); s += __shfl_xor(s, 4); s += __shfl_xor(s, 8);
                    if (fr == 0) atomicAdd(ksum + (size_t)u.pm * DM + colt + bj * 128 + wc * 32 + fq * 8 + j, s); }
        }
    }
};

struct EpiZ {
    static constexpr bool PERM = false;
    __device__ __forceinline__ void prep(const Unit&, int, int, int) const {}
    const float* xin; float* z; float ymul;
    __device__ __forceinline__ void operator()(AccRef acc, const Unit& u, int wr, int wc, int fr, int fq) const {
        asm volatile("" : "+v"(fr), "+v"(fq));
#pragma unroll
        for (int ai = 0; ai < 2; ++ai) {
            const size_t off0 = (size_t)(u.pm * 256 + ai * 128 + wr * 64 + fr) * DM + u.pn * 256 + wc * 32 + fq * 4;
            f32x4 xr[4][2][2];
#pragma unroll
            for (int m = 0; m < 4; ++m)
#pragma unroll
                for (int bj = 0; bj < 2; ++bj)
#pragma unroll
                    for (int n = 0; n < 2; ++n) xr[m][bj][n] = *(const f32x4*)(xin + off0 + (size_t)m * 16 * DM + bj * 128 + n * 16);
#pragma unroll
            for (int m = 0; m < 4; ++m)
#pragma unroll
                for (int bj = 0; bj < 2; ++bj)
#pragma unroll
                    for (int n = 0; n < 2; ++n) *(f32x4*)(z + off0 + (size_t)m * 16 * DM + bj * 128 + n * 16) = xr[m][bj][n] * ALPHA + acc[ai][bj][m][n] * ymul;
            asm volatile("" ::: "memory");
        }
    }
};

__device__ __forceinline__ float swiglu1(float glu, float lin) {
    const float g = fminf(glu, 7.0f), l = fminf(fmaxf(lin, -7.0f), 7.0f);
    const float sg = __builtin_amdgcn_rcpf(1.0f + __builtin_amdgcn_exp2f(-1.702f * 1.4426950408889634f * g));
    return g * sg * (l + 1.0f);
}
__device__ __forceinline__ f32x2 swiglu2(float glu0, float lin0, float glu1, float lin1) {
    const f32x2 g = {fminf(glu0, 7.0f), fminf(glu1, 7.0f)}, l = {fminf(fmaxf(lin0, -7.0f), 7.0f), fminf(fmaxf(lin1, -7.0f), 7.0f)};
    const f32x2 t = g * (f32x2){-1.702f * 1.4426950408889634f, -1.702f * 1.4426950408889634f};
    const f32x2 d = (f32x2){__builtin_amdgcn_exp2f(t[0]), __builtin_amdgcn_exp2f(t[1])} + (f32x2){1.0f, 1.0f};
    const f32x2 r = {__builtin_amdgcn_rcpf(d[0]), __builtin_amdgcn_rcpf(d[1])};
    const f32x2 lp = l * (f32x2){FP8_SA, FP8_SA} + (f32x2){FP8_SA, FP8_SA};
    return (g * lp) * r;
}
struct EpiGU {
    static constexpr bool PERM = true;
    __device__ __forceinline__ void prep(const Unit& u, int ui, int wid, int lane) const { if (wid < 4) glds4s(uni_ptr((const char*)(bias + (size_t)u.x0 * 2048 + u.pn * 256 + wid * 64)), (unsigned)lane * 4u, (unsigned)__builtin_amdgcn_readfirstlane((unsigned)(unsigned long long)bl + (unsigned)(((ui & 1) * 256 + wid * 64) * 4))); }
    const float* bias; unsigned char* H; LAS float* bl; mutable int ucnt;
    __device__ __forceinline__ void operator()(AccRef acc, const Unit& u, int wr, int wc, int fr, int fq) const {
        asm volatile("" : "+v"(fr), "+v"(fq));
        const int c0 = u.pn * 256 + wc * 32 + fq * 8; const LAS float* bp = bl + (ucnt & 1) * 256 + wc * 32 + fq * 8; ++ucnt; constexpr float SC = 1.0f / (FP8_SA * FP8_SWGU);
        f32x4 b[2][2];
#pragma unroll
        for (int bj = 0; bj < 2; ++bj) { b[bj][0] = *(const LAS f32x4*)(bp + bj * 128); b[bj][1] = *(const LAS f32x4*)(bp + bj * 128 + 4); }
#pragma unroll
        for (int ai = 0; ai < 2; ++ai)
#pragma unroll
            for (int m = 0; m < 4; ++m) {
                unsigned char* rowp = H + (size_t)(u.x1 + ai * 128 + wr * 64 + m * 16 + fr) * DM + (c0 >> 1);
#pragma unroll
                for (int bj = 0; bj < 2; ++bj) { if (u.x2 == 2 - bj) continue;
                    const f32x4 v0 = acc[ai][bj][m][0] * SC + b[bj][0], v1 = acc[ai][bj][m][1] * SC + b[bj][1];
                    const f32x2 h0 = swiglu2(v0[0], v0[1], v0[2], v0[3]), h1 = swiglu2(v1[0], v1[1], v1[2], v1[3]);
                    int w = __builtin_amdgcn_cvt_pk_fp8_f32(h0[0], h0[1], 0, false);
                    w = __builtin_amdgcn_cvt_pk_fp8_f32(h1[0], h1[1], w, true);
                    *(int*)(rowp + bj * 64) = w; }
            }
    }
};
struct EpiDN {
    static constexpr bool PERM = true;
    __device__ __forceinline__ void prep(const Unit& u, int ui, int wid, int lane) const { if (wid < 4) glds4s(uni_ptr((const char*)(bias + (size_t)u.x0 * 1024 + u.pn * 256 + wid * 64)), (unsigned)lane * 4u, (unsigned)__builtin_amdgcn_readfirstlane((unsigned)(unsigned long long)bl + (unsigned)(((ui & 1) * 256 + wid * 64) * 4))); }
    const float* bias; unsigned char* Y; LAS float* bl; mutable int ucnt;
    __device__ __forceinline__ void operator()(AccRef acc, const Unit& u, int wr, int wc, int fr, int fq) const {
        asm volatile("" : "+v"(fr), "+v"(fq));
        const int c0 = u.pn * 256 + wc * 32 + fq * 8; const LAS float* bp = bl + (ucnt & 1) * 256 + wc * 32 + fq * 8; ++ucnt; constexpr float SC = FP8_SY / (FP8_SA * FP8_SWD);
        f32x4 b[2][2];
#pragma unroll
        for (int bj = 0; bj < 2; ++bj) { b[bj][0] = *(const LAS f32x4*)(bp + bj * 128) * FP8_SY; b[bj][1] = *(const LAS f32x4*)(bp + bj * 128 + 4) * FP8_SY; }
#pragma unroll
        for (int ai = 0; ai < 2; ++ai)
#pragma unroll
            for (int m = 0; m < 4; ++m) {
                unsigned char* rowp = Y + (size_t)(u.x1 + ai * 128 + wr * 64 + m * 16 + fr) * DM + c0;
#pragma unroll
                for (int bj = 0; bj < 2; ++bj) { if (u.x2 == 2 - bj) continue;
                    f32x4 v0 = acc[ai][bj][m][0] * SC + b[bj][0], v1 = acc[ai][bj][m][1] * SC + b[bj][1];
#pragma unroll
                    for (int q = 0; q < 4; ++q) { v0[q] = __builtin_amdgcn_fmed3f(v0[q], -FP8_MAXV, FP8_MAXV); v1[q] = __builtin_amdgcn_fmed3f(v1[q], -FP8_MAXV, FP8_MAXV); }
                    int w0 = __builtin_amdgcn_cvt_pk_fp8_f32(v0[0], v0[1], 0, false); w0 = __builtin_amdgcn_cvt_pk_fp8_f32(v0[2], v0[3], w0, true);
                    int w1 = __builtin_amdgcn_cvt_pk_fp8_f32(v1[0], v1[1], 0, false); w1 = __builtin_amdgcn_cvt_pk_fp8_f32(v1[2], v1[3], w1, true);
                    u32x2 w; w.x = (unsigned)w0; w.y = (unsigned)w1;
                    *(u32x2*)(rowp + bj * 128) = w; }
            }
    }
};

struct EpiINA {
    static constexpr bool PERM = true;
    __device__ __forceinline__ void prep(const Unit&, int, int, int) const {}
    const float* rf; const float* cf; bf16_t* AE; bf16_t* KN; bf16_t* OS;
    __device__ __forceinline__ void operator()(AccRef acc, const Unit& u, int wr, int wc, int fr, int fq) const {
        asm volatile("" : "+v"(fr), "+v"(fq));
        const int b = u.pm >> 4, ch = u.pm & 15, d0 = wc * 32 + fq * 8; const u32x4 zero = {0u, 0u, 0u, 0u};
        if (u.pn < 4) {
            const bool isq = u.pn < 2; const float* fac = isq ? rf : cf; const float fs = isq ? 1.0f : RSQRT_DQK; const int h0 = (u.pn & 1) * 2;
            float sf[2][4][2];
#pragma unroll
            for (int ai = 0; ai < 2; ++ai)
#pragma unroll
                for (int m = 0; m < 4; ++m)
#pragma unroll
                    for (int bj = 0; bj < 2; ++bj) sf[ai][m][bj] = fac[(size_t)(h0 + bj) * NTOK + (size_t)u.pm * 256 + ai * 128 + wr * 64 + m * 16 + fr];
#pragma unroll
            for (int ai = 0; ai < 2; ++ai)
#pragma unroll
                for (int m = 0; m < 4; ++m) {
                    const int t = ai * 128 + wr * 64 + m * 16 + fr; const size_t token = (size_t)u.pm * 256 + t;
#pragma unroll
                    for (int bj = 0; bj < 2; ++bj) { const int hh = h0 + bj; const float s = sf[ai][m][bj] * fs;
                        const f32x4 v0 = acc[ai][bj][m][0] * s, v1 = acc[ai][bj][m][1] * s;
                        const size_t oq = ((size_t)(((b * 4 + hh) * 16 + ch) * 256 + t)) * 512 + 256 + d0, ok = token * 1024 + hh * 256 + d0;
                        bf16_t* dst = isq ? (AE + oq) : (KN + ok);
                        u32x4 w; w.x = cvt_pk_bf16(v0[0], v0[1]); w.y = cvt_pk_bf16(v0[2], v0[3]); w.z = cvt_pk_bf16(v1[0], v1[1]); w.w = cvt_pk_bf16(v1[2], v1[3]);
                        *(u32x4*)dst = w; }
                }
        } else {
#pragma unroll
            for (int ai = 0; ai < 2; ++ai)
#pragma unroll
                for (int m = 0; m < 4; ++m) {
                    const int t = ai * 128 + wr * 64 + m * 16 + fr; const size_t token = (size_t)u.pm * 256 + t;
#pragma unroll
                    for (int bj = 0; bj < 2; ++bj) { f32x4 v0 = acc[ai][bj][m][0], v1 = acc[ai][bj][m][1];
#pragma unroll
                        for (int j = 0; j < 4; ++j) { v0[j] = __builtin_amdgcn_rcpf(1.0f + __builtin_amdgcn_exp2f(-1.4426950408889634f * v0[j])); v1[j] = __builtin_amdgcn_rcpf(1.0f + __builtin_amdgcn_exp2f(-1.4426950408889634f * v1[j])); }
                        u32x4 w; w.x = cvt_pk_bf16(v0[0], v0[1]); w.y = cvt_pk_bf16(v0[2], v0[3]); w.z = cvt_pk_bf16(v1[0], v1[1]); w.w = cvt_pk_bf16(v1[2], v1[3]);
                        *(u32x4*)(OS + token * 1024 + (u.pn - 4) * 256 + bj * 128 + d0) = w; }
                }
        }
    }
};
struct EpiINB {
    static constexpr bool PERM = true;
    __device__ __forceinline__ void prep(const Unit&, int, int, int) const {}
    const float* cf; bf16_t* KT; bf16_t* BE;
    __device__ __forceinline__ void operator()(AccRef acc, const Unit& u, int wr, int wc, int fr, int fq) const {
        asm volatile("" : "+v"(fr), "+v"(fq));
        const int b = u.pn >> 4, ch = u.pn & 15;
        f32x4 cv[2][2][2];
#pragma unroll
        for (int ai = 0; ai < 2; ++ai)
#pragma unroll
            for (int bj = 0; bj < 2; ++bj) { const size_t tok0 = (size_t)u.pn * 256 + bj * 128 + wc * 32 + fq * 8;
                if (u.pm < 2) { const int hh = u.pm * 2 + ai; cv[ai][bj][0] = *(const f32x4*)(cf + (size_t)hh * NTOK + tok0) * RSQRT_DQK; cv[ai][bj][1] = *(const f32x4*)(cf + (size_t)hh * NTOK + tok0 + 4) * RSQRT_DQK; }
                else { cv[ai][bj][0] = (f32x4){1.f, 1.f, 1.f, 1.f}; cv[ai][bj][1] = cv[ai][bj][0]; } }
#pragma unroll
        for (int ai = 0; ai < 2; ++ai)
#pragma unroll
            for (int m = 0; m < 4; ++m) {
                const int R = u.pm * 256 + ai * 128 + wr * 64 + m * 16 + fr;
#pragma unroll
                for (int bj = 0; bj < 2; ++bj) { if (u.x2 == 2 - bj) continue;
                    const f32x4 v0 = acc[ai][bj][m][0] * cv[ai][bj][0], v1 = acc[ai][bj][m][1] * cv[ai][bj][1]; const int s0 = bj * 128 + wc * 32 + fq * 8; const size_t tok0 = (size_t)u.pn * 256 + s0; bf16_t* dst;
                    if (u.pm < 2) dst = KT + (size_t)R * NTOK + tok0;
                    else { const int eg = R - 512, hh = eg >> 8, e = eg & 255; dst = BE + ((size_t)(((b * 4 + hh) * 16 + ch) * 256 + e)) * 384 + s0; }
                    u32x4 w; w.x = cvt_pk_bf16(v0[0], v0[1]); w.y = cvt_pk_bf16(v0[2], v0[3]); w.z = cvt_pk_bf16(v1[0], v1[1]); w.w = cvt_pk_bf16(v1[2], v1[3]);
                    *(u32x4*)dst = w;
                }
            }
    }
};
struct EpiM1 {
    static constexpr bool PERM = false;
    __device__ __forceinline__ void prep(const Unit&, int, int, int) const {}
    float* UT;
    __device__ __forceinline__ void operator()(AccRef acc, const Unit& u, int wr, int wc, int fr, int fq) const {
        asm volatile("" : "+v"(fr), "+v"(fq));
#pragma unroll
        for (int ai = 0; ai < 2; ++ai)
#pragma unroll
            for (int m = 0; m < 4; ++m) { float* rowp = UT + ((size_t)u.x0 * 256 + ai * 128 + wr * 64 + m * 16 + fr) * 128 + wc * 32 + fq * 4;
#pragma unroll
                for (int n = 0; n < 2; ++n) *(f32x4*)(rowp + n * 16) = acc[ai][0][m][n]; }
    }
};
struct EpiM2A {
    static constexpr bool PERM = true;
    __device__ __forceinline__ void prep(const Unit&, int, int, int) const {}
    bf16_t* AE; const float* nprev; float* den;
    __device__ __forceinline__ void operator()(AccRef acc, const Unit& u, int wr, int wc, int fr, int fq) const {
        asm volatile("" : "+v"(fr), "+v"(fq));
        const int mu = u.x0, dd = wc * 32 + fq * 8;
        const f32x4 n0 = *(const f32x4*)(nprev + (size_t)mu * 128 + dd), n1 = *(const f32x4*)(nprev + (size_t)mu * 128 + dd + 4);
        u32x4 qv8[2][4];
#pragma unroll
        for (int ai = 0; ai < 2; ++ai)
#pragma unroll
            for (int m = 0; m < 4; ++m) qv8[ai][m] = *(const u32x4*)(AE + ((size_t)mu * 256 + ai * 128 + wr * 64 + m * 16 + fr) * 512 + 256 + dd);
#pragma unroll
        for (int ai = 0; ai < 2; ++ai)
#pragma unroll
            for (int m = 0; m < 4; ++m) {
                const int t = ai * 128 + wr * 64 + m * 16 + fr; bf16_t* rowp = AE + ((size_t)mu * 256 + t) * 512;
                const u32x4 qv = qv8[ai][m];
                float part = bflo(qv.x) * n0[0] + bfhi(qv.x) * n0[1] + bflo(qv.y) * n0[2] + bfhi(qv.y) * n0[3] + bflo(qv.z) * n1[0] + bfhi(qv.z) * n1[1] + bflo(qv.w) * n1[2] + bfhi(qv.w) * n1[3];
#pragma unroll
                for (int bj = 0; bj < 2; ++bj) { const int s0 = bj * 128 + wc * 32 + fq * 8; f32x4 v0 = acc[ai][bj][m][0], v1 = acc[ai][bj][m][1];
                    int dts = t - s0; asm volatile("" : "+v"(dts));
#pragma unroll
                    for (int j = 0; j < 4; ++j) { v0[j] = (j <= dts) ? v0[j] : 0.f; v1[j] = (4 + j <= dts) ? v1[j] : 0.f; part += v0[j] + v1[j]; }
                    u32x4 w; w.x = cvt_pk_bf16(v0[0], v0[1]); w.y = cvt_pk_bf16(v0[2], v0[3]); w.z = cvt_pk_bf16(v1[0], v1[1]); w.w = cvt_pk_bf16(v1[2], v1[3]);
                    *(u32x4*)(rowp + s0) = w; }
                part += __shfl_xor(part, 16); part += __shfl_xor(part, 32);
                if (fq == 0) atomicAdd(den + (size_t)mu * 256 + (wr * 64 + fr) + (ai * 128 + m * 16), part);
            }
    }
};
struct EpiM2B {
    static constexpr bool PERM = true;
    __device__ __forceinline__ void prep(const Unit&, int, int, int) const {}
    const float* den; const float* normg; const bf16_t* OS; bf16_t* HN; LAS float* lnx;
    __device__ __forceinline__ void operator()(AccRef acc, const Unit& u, int wr, int wc, int fr, int fq) const {
        asm volatile("" : "+v"(fr), "+v"(fq));
        const int mu = u.x0, b = mu >> 6, hh = (mu >> 4) & 3, ch = mu & 15;
        float dnv[2][4];
#pragma unroll
        for (int ai = 0; ai < 2; ++ai)
#pragma unroll
            for (int m = 0; m < 4; ++m) dnv[ai][m] = den[(size_t)mu * 256 + ai * 128 + wr * 64 + m * 16 + fr];
#pragma unroll
        for (int ai = 0; ai < 2; ++ai)
#pragma unroll
            for (int m = 0; m < 4; ++m) {
                const int t = ai * 128 + wr * 64 + m * 16 + fr; const float dn = dnv[ai][m];
#ifdef DBG_DEN1
                const float inv = 1.0f;
#else
                const float inv = 1.0f / fmaxf(fabsf(dn), 1.0f);
#endif
                float s1 = 0.f, s2 = 0.f;
#pragma unroll
                for (int bj = 0; bj < 2; ++bj)
#pragma unroll
                    for (int n = 0; n < 2; ++n) { f32x4 h = acc[ai][bj][m][n] * inv; acc[ai][bj][m][n] = h; s1 += (h[0] + h[1]) + (h[2] + h[3]); s2 += (h[0] * h[0] + h[1] * h[1]) + (h[2] * h[2] + h[3] * h[3]); }
                s1 += __shfl_xor(s1, 16); s1 += __shfl_xor(s1, 32); s2 += __shfl_xor(s2, 16); s2 += __shfl_xor(s2, 32);
                if (fq == 0) { lnx[(t * 4 + wc) * 2] = s1; lnx[(t * 4 + wc) * 2 + 1] = s2; }
            }
        const int e0 = wc * 32 + fq * 8;
        f32x4 gg[2][2];
#pragma unroll
        for (int bj = 0; bj < 2; ++bj) { gg[bj][0] = *(const f32x4*)(normg + hh * 256 + bj * 128 + e0); gg[bj][1] = *(const f32x4*)(normg + hh * 256 + bj * 128 + e0 + 4); }
        asm volatile("s_waitcnt lgkmcnt(0)" ::: "memory"); __builtin_amdgcn_s_barrier(); asm volatile("" ::: "memory");
#pragma unroll
        for (int ai = 0; ai < 2; ++ai) {
            u32x4 ovv[4][2];
#pragma unroll
            for (int m = 0; m < 4; ++m)
#pragma unroll
                for (int bj = 0; bj < 2; ++bj) ovv[m][bj] = *(const u32x4*)(OS + (((size_t)(b * 16 + ch)) * 256 + ai * 128 + wr * 64 + m * 16 + fr) * 1024 + hh * 256 + bj * 128 + e0);
#pragma unroll
            for (int m = 0; m < 4; ++m) {
                const int t = ai * 128 + wr * 64 + m * 16 + fr; const size_t token = ((size_t)(b * 16 + ch)) * 256 + t;
                const LAS f32x4* lp = (const LAS f32x4*)(lnx + t * 8); const f32x4 a = lp[0], c = lp[1];
                const float mean = (a[0] + a[2] + c[0] + c[2]) * (1.0f / 256.0f); const float ex2 = (a[1] + a[3] + c[1] + c[3]) * (1.0f / 256.0f);
                const float rstd = 1.0f / sqrtf(fmaxf(ex2 - mean * mean, 0.f) + LN_EPS);
#pragma unroll
                for (int bj = 0; bj < 2; ++bj) { const int e = bj * 128 + e0; const size_t off = token * 1024 + hh * 256 + e; const u32x4 ov = ovv[m][bj];
#ifdef DBG_HN_OS
                    f32x4 v0 = {1.f, 1.f, 1.f, 1.f}, v1 = v0;
#elif defined(DBG_HN_RAW)
                    f32x4 v0 = acc[ai][bj][m][0], v1 = acc[ai][bj][m][1];
#else
                    f32x4 v0 = (acc[ai][bj][m][0] - mean) * rstd * gg[bj][0], v1 = (acc[ai][bj][m][1] - mean) * rstd * gg[bj][1];
#endif
#ifndef DBG_HN_ONE
                    v0[0] *= bflo(ov.x); v0[1] *= bfhi(ov.x); v0[2] *= bflo(ov.y); v0[3] *= bfhi(ov.y); v1[0] *= bflo(ov.z); v1[1] *= bfhi(ov.z); v1[2] *= bflo(ov.w); v1[3] *= bfhi(ov.w);
#endif
                    u32x4 w; w.x = cvt_pk_bf16(v0[0], v0[1]); w.y = cvt_pk_bf16(v0[2], v0[3]); w.z = cvt_pk_bf16(v1[0], v1[1]); w.w = cvt_pk_bf16(v1[2], v1[3]);
                    *(u32x4*)(HN + off) = w; }
            }
            asm volatile("" ::: "memory");
        }
        asm volatile("s_waitcnt lgkmcnt(0)" ::: "memory"); __builtin_amdgcn_s_barrier(); asm volatile("" ::: "memory");
    }
};
struct Frame {
    LAS unsigned char* lds;
    unsigned* ctl;
    unsigned char* ws;
    int tid, lane, wave, vcu, G;
};
__device__ __forceinline__ float wave_sum(float v) {
#pragma unroll
    for (int o = 1; o < 64; o <<= 1) v += __shfl_xor(v, o);
    return v;
}

__device__ __forceinline__ void tr_block(const float* src, size_t pitch, bf16_t* dst, size_t kd, int kb, int nb, LAS unsigned* scr, int lane) {
    const float* s0 = src + (size_t)(64 * kb) * pitch + 64 * nb + 4 * (lane & 15);
#pragma unroll
    for (int i = 0; i < 8; ++i) {
        const int kp = 4 * i + (lane >> 4);
        const f32x4 a = __builtin_nontemporal_load((const f32x4*)(s0 + (size_t)(2 * kp) * pitch)), b = __builtin_nontemporal_load((const f32x4*)(s0 + (size_t)(2 * kp + 1) * pitch));
#pragma unroll
        for (int j = 0; j < 4; ++j) scr[(4 * (lane & 15) + j) * 33 + kp] = cvt_pk_bf16(a[j], b[j]);
    }
    LDS_WAIT(); asm volatile("" ::: "memory");
    u32x4 o[8];
#pragma unroll
    for (int c = 0; c < 8; ++c) { const int rr = 8 * c + (lane >> 3), q4 = 4 * (lane & 7); o[c].x = scr[rr * 33 + q4]; o[c].y = scr[rr * 33 + q4 + 1]; o[c].z = scr[rr * 33 + q4 + 2]; o[c].w = scr[rr * 33 + q4 + 3]; }
    bf16_t* d = dst + (size_t)(64 * nb + (lane >> 3)) * kd + 64 * kb + 8 * (lane & 7);
#pragma unroll
    for (int c = 0; c < 8; ++c) *(u32x4*)(d + (size_t)(8 * c) * kd) = o[c];
    LDS_WAIT(); asm volatile("" ::: "memory");
}
__device__ __forceinline__ void tr_block8(const float* src, size_t pitch, unsigned char* dst, size_t kd, int kb, int nb, float scale, LAS unsigned* scr, int lane) {
    const float* s0 = src + (size_t)(128 * kb) * pitch + 64 * nb + 4 * (lane & 15);
#pragma unroll
    for (int i = 0; i < 8; ++i) {
        const int kq = 4 * i + (lane >> 4);
        const f32x4 r0 = __builtin_nontemporal_load((const f32x4*)(s0 + (size_t)(4 * kq) * pitch)) * scale, r1 = __builtin_nontemporal_load((const f32x4*)(s0 + (size_t)(4 * kq + 1) * pitch)) * scale,
                    r2 = __builtin_nontemporal_load((const f32x4*)(s0 + (size_t)(4 * kq + 2) * pitch)) * scale, r3 = __builtin_nontemporal_load((const f32x4*)(s0 + (size_t)(4 * kq + 3) * pitch)) * scale;
#pragma unroll
        for (int j = 0; j < 4; ++j) { int w = __builtin_amdgcn_cvt_pk_fp8_f32(r0[j], r1[j], 0, false); w = __builtin_amdgcn_cvt_pk_fp8_f32(r2[j], r3[j], w, true); scr[(4 * (lane & 15) + j) * 33 + kq] = (unsigned)w; }
    }
    LDS_WAIT(); asm volatile("" ::: "memory");
    u32x4 o[8];
#pragma unroll
    for (int c = 0; c < 8; ++c) { const int rr = 8 * c + (lane >> 3), q4 = 4 * (lane & 7); o[c].x = scr[rr * 33 + q4]; o[c].y = scr[rr * 33 + q4 + 1]; o[c].z = scr[rr * 33 + q4 + 2]; o[c].w = scr[rr * 33 + q4 + 3]; }
    unsigned char* d = dst + (size_t)(64 * nb + (lane >> 3)) * kd + 128 * kb + 16 * (lane & 7);
#pragma unroll
    for (int c = 0; c < 8; ++c) *(u32x4*)(d + (size_t)(8 * c) * kd) = o[c];
    LDS_WAIT(); asm volatile("" ::: "memory");
}
constexpr int CONV_ITEMS = 24576;
struct ConvItem { const float* s0; size_t pitch; unsigned char* d; float scale; };
__device__ __forceinline__ ConvItem conv_desc(const float* wgu, const float* wd, unsigned char* ws, int v, int lane) {
    const int layer = v >= 12288; int r = v - layer * 12288; ConvItem it;
    if (r < 8192) { const int mat = layer * 32 + (r >> 8); r &= 255; const int kb = r >> 5, nb = r & 31; it.pitch = 2048; it.scale = FP8_SWGU;
        it.s0 = wgu + (size_t)mat * 1024 * 2048 + (size_t)(128 * kb) * 2048 + 64 * nb + 4 * (lane & 15); it.d = ws + WS_WGU + (size_t)mat * 2048 * 1024 + (size_t)(64 * nb + (lane >> 3)) * 1024 + 128 * kb + 16 * (lane & 7); }
    else { r -= 8192; const int mat = layer * 32 + (r >> 7); r &= 127; const int kb = r >> 4, nb = r & 15; it.pitch = 1024; it.scale = FP8_SWD;
        it.s0 = wd + (size_t)mat * 1024 * 1024 + (size_t)(128 * kb) * 1024 + 64 * nb + 4 * (lane & 15); it.d = ws + WS_WD + (size_t)mat * 1024 * 1024 + (size_t)(64 * nb + (lane >> 3)) * 1024 + 128 * kb + 16 * (lane & 7); }
    return it;
}
__device__ __forceinline__ void conv_items(Frame& F, const float* wgu, const float* wd, int v_lo, int v_hi, int cw, int ncw) {
    LAS unsigned* scr = (LAS unsigned*)(F.lds + RING_OFF + F.wave * 8448); unsigned char* ws = F.ws; const int lane = F.lane;
    int v = v_lo + cw; if (v >= v_hi) return;
    ConvItem cur = conv_desc(wgu, wd, ws, v, lane);
    f32x4 r[8][4];
#pragma unroll
    for (int i = 0; i < 8; ++i) { const int kq = 4 * i + (lane >> 4);
#pragma unroll
        for (int q = 0; q < 4; ++q) r[i][q] = __builtin_nontemporal_load((const f32x4*)(cur.s0 + (size_t)(4 * kq + q) * cur.pitch)); }
    for (;;) {
        const int vn = v + ncw; const bool has = vn < v_hi; ConvItem nx = cur; if (has) nx = conv_desc(wgu, wd, ws, vn, lane);
#pragma unroll
        for (int i = 0; i < 8; ++i) { const int kq = 4 * i + (lane >> 4);
#pragma unroll
            for (int j = 0; j < 4; ++j) { int w = __builtin_amdgcn_cvt_pk_fp8_f32(r[i][0][j] * cur.scale, r[i][1][j] * cur.scale, 0, false); w = __builtin_amdgcn_cvt_pk_fp8_f32(r[i][2][j] * cur.scale, r[i][3][j] * cur.scale, w, true); scr[(4 * (lane & 15) + j) * 33 + kq] = (unsigned)w; }
            if (has) {
#pragma unroll
                for (int q = 0; q < 4; ++q) r[i][q] = __builtin_nontemporal_load((const f32x4*)(nx.s0 + (size_t)(4 * kq + q) * nx.pitch)); } }
        LDS_WAIT(); asm volatile("" ::: "memory");
        u32x4 o[8];
#pragma unroll
        for (int c = 0; c < 8; ++c) { const int rr = 8 * c + (lane >> 3), q4 = 4 * (lane & 7); o[c].x = scr[rr * 33 + q4]; o[c].y = scr[rr * 33 + q4 + 1]; o[c].z = scr[rr * 33 + q4 + 2]; o[c].w = scr[rr * 33 + q4 + 3]; }
#pragma unroll
        for (int c = 0; c < 8; ++c) *(u32x4*)(cur.d + (size_t)(8 * c) * 1024) = o[c];
        LDS_WAIT(); asm volatile("" ::: "memory");
        if (!has) break;
        v = vn; cur = nx;
    }
}
struct P0In { const float *x, *wqkv, *wo, *win, *wout, *rw, *wgu, *wd; const int* pos; };
__device__ __forceinline__ void p0_prologue(Frame& F, const P0In& I) {
    LAS unsigned* scr = (LAS unsigned*)(F.lds + RING_OFF + F.wave * 8448);
    const int gw = F.vcu * NWAVES + F.wave, NGW = F.G * NWAVES;
    unsigned char* ws = F.ws;
    constexpr int KB = 16;
    constexpr int I_QKV = KB * 48, I_WO = KB * 16, I_INA1 = KB * 16, I_INA2 = KB * 16, I_INB = KB * 24, I_WOUT = KB * 16;
    constexpr int I_SMALL = I_QKV + I_WO + I_INA1 + I_INA2 + I_INB + I_WOUT;
    constexpr int NITEMS = I_SMALL;
    for (int it = gw; it < NITEMS; it += NGW) {
        int r = it; const float* src; size_t pitch; bf16_t* dst; int nbl;
        if (r < I_QKV) { src = I.wqkv; pitch = 3072; dst = (bf16_t*)(ws + WS_WQKV); nbl = 48; }
        else if ((r -= I_QKV) < I_WO) { src = I.wo; pitch = 1024; dst = (bf16_t*)(ws + WS_WO); nbl = 16; }
        else if ((r -= I_WO) < I_INA1) { src = I.win; pitch = 3080; dst = (bf16_t*)(ws + WS_WINA); nbl = 16; }
        else if ((r -= I_INA1) < I_INA2) { src = I.win + 2048; pitch = 3080; dst = (bf16_t*)(ws + WS_WINA) + (size_t)1024 * 1024; nbl = 16; }
        else if ((r -= I_INA2) < I_INB) { src = I.win + 512; pitch = 3080; dst = (bf16_t*)(ws + WS_WINB); nbl = 24; }
        else { r -= I_INB; src = I.wout; pitch = 1024; dst = (bf16_t*)(ws + WS_WOUT); nbl = 16; }
        tr_block(src, pitch, dst, 1024, r / nbl, r % nbl, scr, F.lane);
    }
    if (NCONV == 0) conv_items(F, I.wgu, I.wd, 0, CONV_ITEMS, gw, NGW);
    const int gt = F.vcu * NTHR + F.tid, NGT = F.G * NTHR;
    for (int i = gt; i < NTOK * DM / 8; i += NGT) { const f32x4 a = ((const f32x4*)I.x)[2 * i], b = ((const f32x4*)I.x)[2 * i + 1];
        u32x4 w; w.x = cvt_pk_bf16(a[0], a[1]); w.y = cvt_pk_bf16(a[2], a[3]); w.z = cvt_pk_bf16(b[0], b[1]); w.w = cvt_pk_bf16(b[2], b[3]); ((u32x4*)(ws + WS_XB))[i] = w; }
    for (int i = gt; i < NTOK * 8; i += NGT) { const int tok = i >> 3, f = i & 7; const float inv = powf(500000.0f, -(float)f * 0.125f); const float ang = (float)I.pos[tok] * inv;
        float sn, cs; sincosf(ang, &sn, &cs); float* rp = (float*)(ws + WS_ROPE) + (size_t)tok * 16; rp[f] = cs; rp[8 + f] = sn; }
    for (int i = gt; i < 2 * 32 * 1024; i += NGT) { const int l = i >> 15, e = (i >> 10) & 31, k = i & 1023; ((float*)(ws + WS_RWT))[i] = I.rw[((size_t)l * 1024 + k) * 32 + e]; }
    for (int i = gt; i < 8 * 1024; i += NGT) { const int gidx = i >> 10, k = i & 1023; ((float*)(ws + WS_WG))[i] = I.win[(size_t)k * 3080 + 3072 + gidx]; }
}

__device__ __forceinline__ void phase_ln_router(Frame& F, const float* __restrict__ z, float* __restrict__ x1, const float* lng, const float* lnb, const float* rbias, int layer, int cset) {
    unsigned char* ws = F.ws;
    LAS f32x4* rwv = (LAS f32x4*)(F.lds + RING_OFF);
    LAS int* lcnt = (LAS int*)(F.lds + LX_LCNT); LAS int* gbase = (LAS int*)(F.lds + LX_GBASE); LAS int* rec = (LAS int*)(F.lds + LX_REC);
    LAS float* lgb = (LAS float*)(F.lds + LX_LNX);
    { const f32x4* src = (const f32x4*)((const float*)(ws + WS_RWT) + (size_t)layer * 32768);
      for (int i = F.tid; i < 8192; i += NTHR) { const int e = i >> 8, c = i & 255; rwv[e * 256 + (c ^ (e & 15))] = src[i]; } }
    int* toke = (int*)(ws + WS_TOKE); int* tokp = (int*)(ws + WS_TOKP); float* tokg = (float*)(ws + WS_TOKG);
    unsigned short* rowtok = (unsigned short*)(ws + WS_ROWTOK); unsigned char* xb8 = (unsigned char*)(ws + WS_XB);
    unsigned* cntg = F.ctl + CW_CNT + cset * 2048;
    const int lane = F.lane;
    for (int grp = F.vcu; grp < NTOK / 64; grp += F.G) {
        if (F.tid < 32) lcnt[F.tid] = 0;
        for (int i = F.tid; i < 1024; i += NTHR) { lgb[i] = lng[i]; lgb[1024 + i] = lnb[i]; }
        __syncthreads();
#pragma unroll 2
        for (int tk = 0; tk < 8; tk += 2) {
            const int token0 = grp * 64 + F.wave * 8 + tk;
            f32x4 v[2][4]; float s[2] = {0.f, 0.f};
#pragma unroll
            for (int u = 0; u < 2; ++u)
#pragma unroll
                for (int j = 0; j < 4; ++j) { v[u][j] = *(const f32x4*)(z + (size_t)(token0 + u) * DM + 4 * lane + 256 * j); s[u] += (v[u][j][0] + v[u][j][1]) + (v[u][j][2] + v[u][j][3]); }
#pragma unroll
            for (int o = 1; o < 64; o <<= 1) { const float a0 = __shfl_xor(s[0], o), a1 = __shfl_xor(s[1], o); s[0] += a0; s[1] += a1; }
            float s2[2] = {0.f, 0.f};
#pragma unroll
            for (int u = 0; u < 2; ++u) { const float mean = s[u] * (1.0f / DM);
#pragma unroll
                for (int j = 0; j < 4; ++j) { v[u][j] = v[u][j] - mean; s2[u] += (v[u][j][0] * v[u][j][0] + v[u][j][1] * v[u][j][1]) + (v[u][j][2] * v[u][j][2] + v[u][j][3] * v[u][j][3]); } }
#pragma unroll
            for (int o = 1; o < 64; o <<= 1) { const float a0 = __shfl_xor(s2[0], o), a1 = __shfl_xor(s2[1], o); s2[0] += a0; s2[1] += a1; }
#pragma unroll
            for (int u = 0; u < 2; ++u) { const float rstd = 1.0f / sqrtf(s2[u] * (1.0f / DM) + LN_EPS); const int token = token0 + u;
#pragma unroll
                for (int j = 0; j < 4; ++j) { const f32x4 gvj = *(const LAS f32x4*)(lgb + 4 * lane + 256 * j), bvj = *(const LAS f32x4*)(lgb + 1024 + 4 * lane + 256 * j);
                    const f32x4 y = v[u][j] * rstd * gvj + bvj; *(f32x4*)(x1 + (size_t)token * DM + 4 * lane + 256 * j) = y;
                    int w8 = __builtin_amdgcn_cvt_pk_fp8_f32(y[0] * FP8_SA, y[1] * FP8_SA, 0, false); w8 = __builtin_amdgcn_cvt_pk_fp8_f32(y[2] * FP8_SA, y[3] * FP8_SA, w8, true);
                    *(int*)(xb8 + (size_t)token * DM + 4 * lane + 256 * j) = w8; } }
        }
        VM_WAIT(); __syncthreads();
        const int tg = F.wave & 3, kh = F.wave >> 2, e0 = lane & 15, kq = lane >> 4;
        f32x4 acc0 = {0.f, 0.f, 0.f, 0.f}, acc1 = acc0;
        { const float* arow = x1 + (size_t)(grp * 64 + tg * 16 + e0) * DM + kh * 512 + 4 * kq;
#pragma unroll 4
          for (int blk = 0; blk < 32; ++blk) {
              const f32x4 a4 = *(const f32x4*)(arow + blk * 16); const int c = ((kh * 512 + blk * 16) >> 2) + kq;
              const f32x4 b0 = rwv[e0 * 256 + (c ^ e0)], b1 = rwv[(16 + e0) * 256 + (c ^ e0)];
#pragma unroll
              for (int j = 0; j < 4; ++j) { acc0 = __builtin_amdgcn_mfma_f32_16x16x4f32(a4[j], b0[j], acc0, 0, 0, 0); acc1 = __builtin_amdgcn_mfma_f32_16x16x4f32(a4[j], b1[j], acc1, 0, 0, 0); } } }
        __syncthreads();
        if (kh == 1) { ((LAS f32x4*)lgb)[(tg * 2 + 0) * 64 + lane] = acc0; ((LAS f32x4*)lgb)[(tg * 2 + 1) * 64 + lane] = acc1; }
        __syncthreads();
        if (kh == 0) {
            acc0 = acc0 + ((LAS f32x4*)lgb)[(tg * 2 + 0) * 64 + lane]; acc1 = acc1 + ((LAS f32x4*)lgb)[(tg * 2 + 1) * 64 + lane];
            const float rb0 = rbias[e0], rb1 = rbias[16 + e0];
#pragma unroll
            for (int r = 0; r < 4; ++r) {
                float l0 = acc0[r] + rb0, l1 = acc1[r] + rb1; float tv[4]; int te[4];
#pragma unroll
                for (int k = 0; k < 4; ++k) { float bvv = (l1 > l0) ? l1 : l0; int be = (l1 > l0) ? 16 + e0 : e0;
#pragma unroll
                    for (int o = 1; o < 16; o <<= 1) { const float ov = __shfl_xor(bvv, o); const int oe = __shfl_xor(be, o); const bool take = (ov > bvv) || (ov == bvv && oe < be); bvv = take ? ov : bvv; be = take ? oe : be; }
                    tv[k] = bvv; te[k] = be; if (be == e0) l0 = -INFINITY; if (be == 16 + e0) l1 = -INFINITY; }
                const float w0 = 1.0f, w1 = __expf(tv[1] - tv[0]), w2 = __expf(tv[2] - tv[0]), w3 = __expf(tv[3] - tv[0]); const float wi = 1.0f / (w0 + w1 + w2 + w3);
                if (e0 < 4) {
                    const int tl = tg * 16 + 4 * kq + r, token = grp * 64 + tl;
                    const int ek = (e0 == 0) ? te[0] : (e0 == 1) ? te[1] : (e0 == 2) ? te[2] : te[3];
                    const float wk = (e0 == 0) ? w0 : (e0 == 1) ? w1 : (e0 == 2) ? w2 : w3;
                    const int li = atomicAdd((int*)(lcnt + ek), 1); rec[tl * 8 + e0] = ek; rec[tl * 8 + 4 + e0] = li;
                    toke[token * 4 + e0] = ek; tokg[token * 4 + e0] = wk * wi;
                }
            }
        }
        __syncthreads();
        if (F.tid < 32) gbase[F.tid] = (int)__hip_atomic_fetch_add(cntg + F.tid * 64, (unsigned)lcnt[F.tid], RLX_AGENT);
        __syncthreads();
        if (F.tid < 256) { const int tl = F.tid >> 2, k = F.tid & 3; const int token = grp * 64 + tl; const int e = rec[tl * 8 + k]; const int pos = gbase[e] + rec[tl * 8 + 4 + k];
            tokp[token * 4 + k] = pos; rowtok[(size_t)e * NTOK + pos] = (unsigned short)token; }
        __syncthreads();
    }
}

__device__ __forceinline__ int moe_tables(Frame& F, int layer) {
    LAS int* tile_e = (LAS int*)(F.lds + LX_TILEE); LAS int* tbase = (LAS int*)(F.lds + LX_TBASE);
    if (F.tid < 64) {
        const int e = F.lane & 31; const int c = (int)__hip_atomic_load(F.ctl + CW_CNT + layer * 2048 + e * 64, RLX_AGENT); const int nt = (F.lane < 32) ? ((c + 255) >> 8) : 0;
        int inc = nt;
#pragma unroll
        for (int o = 1; o < 32; o <<= 1) { const int up = __shfl_up(inc, o); if (F.lane >= o) inc += up; }
        const int t0 = inc - nt;
        if (F.lane < 32) { tbase[e] = t0; for (int i = 0; i < nt; ++i) tile_e[t0 + i] = e; }
        if (F.lane == 31) tbase[32] = inc;
    }
    __syncthreads();
    return tbase[32];
}

template <bool NEXT_MLSTM>
__device__ __forceinline__ void phase_combine(Frame& F, const float* __restrict__ x1, float* __restrict__ out, const float* lng, const float* lnb, const float* bgates, int layer) {
    unsigned char* ws = F.ws;
    (void)moe_tables(F, layer);
    const LAS int* tbase = (const LAS int*)(F.lds + LX_TBASE);
    const int* toke = (const int*)(ws + WS_TOKE); const int* tokp = (const int*)(ws + WS_TOKP); const float* tokg = (const float*)(ws + WS_TOKG);
    const unsigned char* Y = (const unsigned char*)(ws + WS_Y); bf16_t* xb = (bf16_t*)(ws + WS_XB);
    LAS float* wg = (LAS float*)(F.lds + RING_OFF);
    if constexpr (NEXT_MLSTM) { const f32x4* src = (const f32x4*)(ws + WS_WG); for (int i = F.tid; i < 2048; i += NTHR) ((LAS f32x4*)wg)[i] = src[i]; __syncthreads(); }
    const int lane = F.lane; const int gw = F.vcu * NWAVES + F.wave, NGW = F.G * NWAVES;
    f32x4 gv[4], bv[4];
#pragma unroll
    for (int j = 0; j < 4; ++j) { gv[j] = *(const f32x4*)(lng + 4 * lane + 256 * j); bv[j] = *(const f32x4*)(lnb + 4 * lane + 256 * j); }
    constexpr int NTK = NEXT_MLSTM ? 1 : 2;
    for (int token0 = gw; token0 < NTOK; token0 += NTK * NGW) {
        f32x4 vv[NTK][4];
#pragma unroll
        for (int u = 0; u < NTK; ++u) { const int token = token0 + u * NGW; if (token < NTOK) {
#pragma unroll
            for (int j = 0; j < 4; ++j) vv[u][j] = *(const f32x4*)(x1 + (size_t)token * DM + 4 * lane + 256 * j) * ALPHA;
#pragma unroll
            for (int k = 0; k < 4; ++k) { const int e = toke[token * 4 + k]; const size_t row = (size_t)tbase[e] * 256 + tokp[token * 4 + k]; const float gt = tokg[token * 4 + k] * (DBG_MOE_MUL / FP8_SY);
#pragma unroll
                for (int j = 0; j < 4; ++j) { const int y = *(const int*)(Y + row * DM + 4 * lane + 256 * j); const f32x2 lo = __builtin_amdgcn_cvt_pk_f32_fp8(y, false), hi = __builtin_amdgcn_cvt_pk_f32_fp8(y, true);
                    vv[u][j][0] += gt * lo[0]; vv[u][j][1] += gt * lo[1]; vv[u][j][2] += gt * hi[0]; vv[u][j][3] += gt * hi[1]; } } } }
#pragma unroll
        for (int u = 0; u < NTK; ++u) { const int token = token0 + u * NGW; if (token < NTOK) {
        f32x4 v[4];
#pragma unroll
        for (int j = 0; j < 4; ++j) v[j] = vv[u][j];
        float s = 0.f;
#pragma unroll
        for (int j = 0; j < 4; ++j) s += (v[j][0] + v[j][1]) + (v[j][2] + v[j][3]);
        const float mean = wave_sum(s) * (1.0f / DM); float s2 = 0.f;
#pragma unroll
        for (int j = 0; j < 4; ++j) { v[j] = v[j] - mean; s2 += (v[j][0] * v[j][0] + v[j][1] * v[j][1]) + (v[j][2] * v[j][2] + v[j][3] * v[j][3]); }
        const float rstd = 1.0f / sqrtf(wave_sum(s2) * (1.0f / DM) + LN_EPS);
#pragma unroll
        for (int j = 0; j < 4; ++j) { v[j] = v[j] * rstd * gv[j] + bv[j]; *(f32x4*)(out + (size_t)token * DM + 4 * lane + 256 * j) = v[j]; }
        if constexpr (NEXT_MLSTM) {
#pragma unroll
            for (int j = 0; j < 4; ++j) { u32x2 w; w.x = cvt_pk_bf16(v[j][0], v[j][1]); w.y = cvt_pk_bf16(v[j][2], v[j][3]); *(u32x2*)(xb + (size_t)token * DM + 4 * lane + 256 * j) = w; }
            float gp[8];
#pragma unroll
            for (int gi = 0; gi < 8; ++gi) { float a = 0.f;
#pragma unroll
                for (int j = 0; j < 4; ++j) { const f32x4 w = *(const LAS f32x4*)(wg + gi * 1024 + 4 * lane + 256 * j); a += (v[j][0] * w[0] + v[j][1] * w[1]) + (v[j][2] * w[2] + v[j][3] * w[3]); }
                gp[gi] = a; }
#pragma unroll
            for (int o = 1; o < 64; o <<= 1) {
#pragma unroll
                for (int gi = 0; gi < 8; ++gi) gp[gi] += __shfl_xor(gp[gi], o); }
#pragma unroll
            for (int gi = 0; gi < 8; ++gi) gp[gi] += bgates[gi];
            if (lane == 0) {
#pragma unroll
                for (int hh = 0; hh < 4; ++hh) { ((float*)(ws + WS_GI))[(size_t)hh * NTOK + token] = gp[hh];
                    const float f = gp[4 + hh]; const float lf = (f >= 0.f) ? -log1pf(__expf(-f)) : (f - log1pf(__expf(f)));
                    ((float*)(ws + WS_LF))[(size_t)hh * NTOK + token] = lf; } }
        }
        } }
    }
}

__device__ __forceinline__ void phase_gate_scan(Frame& F) {
    unsigned char* ws = F.ws; const int lane = F.lane; const int gw = F.vcu * NWAVES + F.wave, NGW = F.G * NWAVES;
    for (int mu = gw; mu < 256; mu += NGW) {
        const int b = mu >> 6, hh = (mu >> 4) & 3, ch = mu & 15; const size_t base = (size_t)hh * NTOK + (size_t)b * SEQ + ch * 256 + 4 * lane;
        const f32x4 lf = *(const f32x4*)((const float*)(ws + WS_LF) + base), gi = *(const f32x4*)((const float*)(ws + WS_GI) + base);
        f32x4 c; c[0] = lf[0]; c[1] = c[0] + lf[1]; c[2] = c[1] + lf[2]; c[3] = c[2] + lf[3];
        float tot = c[3];
#pragma unroll
        for (int o = 1; o < 64; o <<= 1) { const float up = __shfl_up(tot, o); if (lane >= o) tot += up; }
        const float excl = tot - c[3];
        f32x4 rf, cf;
#pragma unroll
        for (int j = 0; j < 4; ++j) { const float bt = excl + c[j]; rf[j] = __expf(bt); cf[j] = __expf(gi[j] - bt); }
        *(f32x4*)((float*)(ws + WS_RF) + base) = rf; *(f32x4*)((float*)(ws + WS_CF) + base) = cf;
        if (lane == 63) ((float*)(ws + WS_DEC))[mu] = __expf(tot);
    }
}
__device__ __forceinline__ void phase_nu(Frame& F) {
    unsigned char* ws = F.ws; const int lane = F.lane; const int gw = F.vcu * NWAVES + F.wave, NGW = F.G * NWAVES;
    const bf16_t* KT = (const bf16_t*)(ws + WS_KT); float* NU = (float*)(ws + WS_NU);
    for (int r0 = gw * 16; r0 < 256 * 128; r0 += NGW * 16) {
        const int mu = r0 >> 7, d0 = r0 & 127, b = mu >> 6, hh = (mu >> 4) & 3, ch = mu & 15;
        const bf16_t* base = KT + (size_t)(hh * 128 + d0) * NTOK + (size_t)b * SEQ + ch * 256 + 4 * lane;
        u32x2 kv[16];
#pragma unroll
        for (int i = 0; i < 16; ++i) kv[i] = *(const u32x2*)(base + (size_t)i * NTOK);
        float s[16];
#pragma unroll
        for (int i = 0; i < 16; ++i) s[i] = (bflo(kv[i].x) + bfhi(kv[i].x)) + (bflo(kv[i].y) + bfhi(kv[i].y));
#pragma unroll
        for (int o = 1; o < 64; o <<= 1) {
#pragma unroll
            for (int i = 0; i < 16; ++i) s[i] += __shfl_xor(s[i], o); }
        float mine = s[0];
#pragma unroll
        for (int i = 1; i < 16; ++i) mine = (lane == i) ? s[i] : mine;
        if (lane < 16) NU[r0 + lane] = mine;
    }
}
__device__ __forceinline__ void phase_state_scan(Frame& F) {
    unsigned char* ws = F.ws; const int gt = F.vcu * NTHR + F.tid, NGT = F.G * NTHR;
    const float* UT = (const float*)(ws + WS_UT); const float* DEC = (const float*)(ws + WS_DEC); bf16_t* BE = (bf16_t*)(ws + WS_BE);
    for (int i = gt; i < 16 * 256 * 32; i += NGT) { const int bh = i >> 13, e = (i >> 5) & 255, dg = i & 31;
        f32x4 U[16]; float dc[16];
#pragma unroll
        for (int ch = 0; ch < 16; ++ch) { const size_t mu = (size_t)bh * 16 + ch; U[ch] = *(const f32x4*)(UT + (mu * 256 + e) * 128 + 4 * dg); dc[ch] = DEC[mu]; }
        f32x4 C = {0.f, 0.f, 0.f, 0.f};
#pragma unroll
        for (int ch = 0; ch < 16; ++ch) { const size_t mu = (size_t)bh * 16 + ch;
            u32x2 w; w.x = cvt_pk_bf16(C[0], C[1]); w.y = cvt_pk_bf16(C[2], C[3]);
#ifdef DBG_NO_INTER
            w.x = 0u; w.y = 0u;
#endif
            *(u32x2*)(BE + (mu * 256 + e) * 384 + 256 + 4 * dg) = w;
            C = (C + U[ch]) * dc[ch]; } }
    const float* NU = (const float*)(ws + WS_NU); float* NP = (float*)(ws + WS_NPREV);
    for (int i = gt; i < 16 * 128; i += NGT) { const int bh = i >> 7, d = i & 127; float n = 0.f;
        for (int ch = 0; ch < 16; ++ch) { const int mu = bh * 16 + ch; NP[mu * 128 + d] = n; n = (n + NU[mu * 128 + d]) * DEC[mu];
#ifdef DBG_NO_INTER
            n = 0.f;
#endif
        } }
}
struct Args { const float* in[18]; float* out; unsigned char* ws; int ph_lo, ph_hi; };
__global__ void __launch_bounds__(NTHR, 2) mk_fwd(Args args) {
    extern __shared__ __attribute__((aligned(16))) unsigned char lds[];
    Frame F;
    const char __attribute__((address_space(4)))* kargp = (const char __attribute__((address_space(4)))*)__builtin_amdgcn_kernarg_segment_ptr();
#define AIN(i) ({ const char __attribute__((address_space(4)))* k_ = kargp; asm volatile("" : "+s"(k_)); *(const float* const __attribute__((address_space(4)))*)(k_ + 8 * (i)); })
    unsigned char* const ws0 = (unsigned char*)AIN(19);
    F.lds = (LAS unsigned char*)lds; F.ws = ws0; F.ctl = (unsigned*)(ws0 + WS_CTL);
    F.tid = threadIdx.x; F.lane = F.tid & 63; F.wave = __builtin_amdgcn_readfirstlane(F.tid >> 6);
    F.G = gridDim.x; { const int bx = blockIdx.x; F.vcu = (F.G % 8 == 0) ? (bx % 8) * (F.G / 8) + bx / 8 : bx; }
    for (int u = F.tid; u < (LDS_BYTES - LX) / 4; u += NTHR) ((LAS unsigned*)(F.lds + LX))[u] = 0u;
    __syncthreads();
    int lo, hi; { const char __attribute__((address_space(4)))* k_ = kargp; lo = *(const int __attribute__((address_space(4)))*)(k_ + 160); hi = *(const int __attribute__((address_space(4)))*)(k_ + 164); }
    XcdBarrier bar; bar.bar = (unsigned*)(F.ctl + CW_BAR); bar.x = 0; bar.st = nullptr;
    if (hi - lo > 1) bar = xcd_barrier_post((unsigned*)(F.ctl + CW_BAR), (volatile LAS unsigned*)(F.lds + LX_MISC) + 8);
#ifndef PHASE_MASK
#define PHASE_MASK 0x7FFFF
#endif
#define IN(k) ((((PHASE_MASK) >> (k)) & 1) && lo <= (k) && (k) < hi)
#ifndef REPEAT_MASK
#define REPEAT_MASK 0
#endif
#define PH(k) if (IN(k))
#define SEAM(k) do { if (IN(k) && IN((k) + 1)) xcd_barrier(bar); } while (0)
    unsigned char* ws = ws0;
#define x_in AIN(0)
#define ln_mix_g AIN(8)
#define ln_mix_b AIN(9)
#define ln_ffn_g AIN(10)
#define ln_ffn_b AIN(11)
#define router_b AIN(13)
#define b_gu AIN(15)
#define b_dn AIN(17)
    bf16_t* XB = (bf16_t*)(ws + WS_XB); bf16_t* QB_ = (bf16_t*)(ws + WS_Q); bf16_t* KB_ = (bf16_t*)(ws + WS_K); bf16_t* VB_ = (bf16_t*)(ws + WS_V);
    float* R0 = (float*)(ws + WS_R0); float* R1 = (float*)(ws + WS_R1); float* R2 = (float*)(ws + WS_R2);
    bf16_t* HB = (bf16_t*)(ws + WS_H); bf16_t* YB = (bf16_t*)(ws + WS_Y);
    LAS unsigned char* ring = F.lds + RING_OFF;
    const int cG = (int)blockIdx.x;
    const bool isConv = (NCONV > 0) && ((int)blockIdx.x >= F.G - NCONV);
    const int Gc = F.G - NCONV, cwv = ((int)blockIdx.x - Gc) * NWAVES + F.wave, ncw = NCONV * NWAVES;
#define CONV_SLICE(a, b) conv_items(F, AIN(14), AIN(16), (int)((long)CONV_ITEMS * (a) / 1000), (int)((long)CONV_ITEMS * (b) / 1000), cwv, ncw)

    PH(0) { P0In I{x_in, AIN(2), AIN(3), AIN(4), AIN(7), AIN(12), AIN(14), AIN(16), (const int*)AIN(1)}; p0_prologue(F, I); }
    SEAM(0);
    PH(1) { { Gemm g{1024, 1024, 1024, nullptr}; DenseSched S{64, 12, F.G, cG, (const char*)XB, (const char*)(ws + WS_WQKV), (size_t)256 * 1024 * 2, (size_t)256 * 1024 * 2};
        EpiQKV E{QB_, KB_, VB_, (const float*)(ws + WS_ROPE), (float*)(ws + WS_KSUM)};
        pg8::gemm_phase<EpiQKV, DenseSched, true, false>(ring, g, S, E); } }
    SEAM(1);
    PH(2) { if (isConv) CONV_SLICE(0, 1000); else {
        const attn_body::AttnTensors AT{(const attn_body::bf16*)QB_, (const attn_body::bf16*)KB_, (const attn_body::bf16*)VB_, (attn_body::bf16*)QB_, (const float*)(ws + WS_KSUM)};
        if (NCONV == 0) { const attn_body::StaticOrder S((int)F.G, (int)blockIdx.x); attn_body::attn_phase<attn_body::StaticOrder>((char*)lds + RING_OFF, AT, S); }
        else { const attn_body::SnakeOrder S{cG, Gc}; attn_body::attn_phase<attn_body::SnakeOrder>((char*)lds + RING_OFF, AT, S); } } }
    SEAM(2);
    PH(3) { { Gemm g{1024, 1024, 1024, nullptr}; DenseSched S{64, 4, F.G, cG, (const char*)QB_, (const char*)(ws + WS_WO), (size_t)256 * 1024 * 2, (size_t)256 * 1024 * 2};
        EpiZ E{x_in, R0, DBG_ATTN_MUL}; pg8::gemm_phase<EpiZ, DenseSched, true, false>(ring, g, S, E); } }
    SEAM(3);
    PH(4) phase_ln_router(F, R0, R1, ln_mix_g, ln_mix_b, router_b, 0, 0);
    SEAM(4);
    PH(5) { const int nT = moe_tables(F, 0); LAS unsigned short* tokl = (LAS unsigned short*)(F.lds + LX_TOKL);
        { const unsigned short* rowtok = (const unsigned short*)(ws + WS_ROWTOK); const LAS int* tile_e = (const LAS int*)(F.lds + LX_TILEE); const LAS int* tbase = (const LAS int*)(F.lds + LX_TBASE);
          for (int i = 0; i < TOKL_ROUNDS; ++i) { int pm, pn, hf; if (!moe_unit(i, F.G, cG, nT, 8, pm, pn, hf)) break;
              if (F.tid < 256) { const int e = tile_e[pm]; const int r = (pm - tbase[e]) * 256 + F.tid; const int c = (int)__hip_atomic_load(F.ctl + CW_CNT + 0 * 2048 + e * 64, RLX_AGENT);
                  tokl[i * 256 + F.tid] = (r < c) ? rowtok[(size_t)e * NTOK + r] : (unsigned short)0; } }
          __syncthreads(); }
        Gemm g{512, 512, 512, (const char*)XB};
        MoeSched S{nT, 8, F.G, cG, (const LAS int*)(F.lds + LX_TILEE), (const LAS int*)(F.lds + LX_TBASE), tokl, nullptr, (const char*)(ws + WS_WGU) + (size_t)0 * 32 * 2048 * 1024, 0, (size_t)2048 * 1024, (size_t)256 * 1024};
        EpiGU E{b_gu + (size_t)0 * 32 * 2048, (unsigned char*)HB, (LAS float*)(F.lds + LX_BIAS), 0}; pg8::gemm_phase<EpiGU, MoeSched, true, true, true, true>(ring, g, S, E); }
    SEAM(5);
    PH(6) { const int nT = moe_tables(F, 0); Gemm g{512, 512, 512, nullptr};
        MoeSched S{nT, 4, F.G, cG, (const LAS int*)(F.lds + LX_TILEE), (const LAS int*)(F.lds + LX_TBASE), nullptr, (const char*)HB, (const char*)(ws + WS_WD) + (size_t)0 * 32 * 1024 * 1024, (size_t)256 * 1024, (size_t)1024 * 1024, (size_t)256 * 1024};
        EpiDN E{b_dn + (size_t)0 * 32 * 1024, (unsigned char*)YB, (LAS float*)(F.lds + LX_BIAS), 0}; pg8::gemm_phase<EpiDN, MoeSched, true, false, true, true>(ring, g, S, E); }
    SEAM(6);
    PH(7) phase_combine<true>(F, R1, R2, ln_ffn_g, ln_ffn_b, AIN(5), 0);
    SEAM(7);
    PH(8) phase_gate_scan(F);
    SEAM(8);
    PH(9) {
        { Gemm g{1024, 1024, 1024, nullptr}; DenseSched S{64, 8, F.G, cG, (const char*)XB, (const char*)(ws + WS_WINA), (size_t)256 * 1024 * 2, (size_t)256 * 1024 * 2};
          EpiINA E{(const float*)(ws + WS_RF), (const float*)(ws + WS_CF), (bf16_t*)(ws + WS_AE), (bf16_t*)(ws + WS_KN), (bf16_t*)(ws + WS_OS)};
          pg8::gemm_phase<EpiINA, DenseSched, true, false>(ring, g, S, E); }
        { Gemm g{1024, 1024, 1024, nullptr}; DenseSched S{6, 64, F.G, cG, (const char*)(ws + WS_WINB), (const char*)XB, (size_t)256 * 1024 * 2, (size_t)256 * 1024 * 2, true};
          EpiINB E{(const float*)(ws + WS_CF), (bf16_t*)(ws + WS_KT), (bf16_t*)(ws + WS_BE)};
          pg8::gemm_phase<EpiINB, DenseSched, true, false, false, true>(ring, g, S, E); }
    }
    SEAM(9);
    PH(10) { Gemm g{256, 384, NTOK, nullptr}; MuSched S{F.G, cG, 0, (const char*)(ws + WS_BE), (const char*)(ws + WS_KT)};
        EpiM1 E{(float*)(ws + WS_UT)}; pg8::gemm_phase<EpiM1, MuSched, true, false>(ring, g, S, E);
        phase_nu(F); }
    SEAM(10);
    PH(11) phase_state_scan(F);
    SEAM(11);
    PH(12) { Gemm g{128, 512, 1024, nullptr}; MuSched S{F.G, cG, 1, (const char*)(ws + WS_AE), (const char*)(ws + WS_KN)};
        EpiM2A E{(bf16_t*)(ws + WS_AE), (const float*)(ws + WS_NPREV), (float*)(ws + WS_DEN)}; pg8::gemm_phase<EpiM2A, MuSched, true, false>(ring, g, S, E); }
    SEAM(12);
    PH(13) { Gemm g{384, 512, 384, nullptr}; MuSched S{F.G, cG, 2, (const char*)(ws + WS_AE), (const char*)(ws + WS_BE)};
        EpiM2B E{(const float*)(ws + WS_DEN), AIN(6), (const bf16_t*)(ws + WS_OS), (bf16_t*)(ws + WS_HN), (LAS float*)(F.lds + LX_LNX)};
        pg8::gemm_phase<EpiM2B, MuSched, true, false>(ring, g, S, E); }
    SEAM(13);
    PH(14) { Gemm g{1024, 1024, 1024, nullptr}; DenseSched S{64, 4, F.G, cG, (const char*)(ws + DBG_P14_A), (const char*)(ws + WS_WOUT), (size_t)256 * 1024 * 2, (size_t)256 * 1024 * 2};
        EpiZ E{R2, R0, DBG_MLSTM_MUL}; pg8::gemm_phase<EpiZ, DenseSched, true, false>(ring, g, S, E); }
    SEAM(14);
    PH(15) phase_ln_router(F, R0, R1, ln_mix_g + 1024, ln_mix_b + 1024, router_b + 32, 1, 1);
    SEAM(15);
    PH(16) { const int nT = moe_tables(F, 1); LAS unsigned short* tokl = (LAS unsigned short*)(F.lds + LX_TOKL);
        { const unsigned short* rowtok = (const unsigned short*)(ws + WS_ROWTOK); const LAS int* tile_e = (const LAS int*)(F.lds + LX_TILEE); const LAS int* tbase = (const LAS int*)(F.lds + LX_TBASE);
          for (int i = 0; i < TOKL_ROUNDS; ++i) { int pm, pn, hf; if (!moe_unit(i, F.G, cG, nT, 8, pm, pn, hf)) break;
              if (F.tid < 256) { const int e = tile_e[pm]; const int r = (pm - tbase[e]) * 256 + F.tid; const int c = (int)__hip_atomic_load(F.ctl + CW_CNT + 1 * 2048 + e * 64, RLX_AGENT);
                  tokl[i * 256 + F.tid] = (r < c) ? rowtok[(size_t)e * NTOK + r] : (unsigned short)0; } }
          __syncthreads(); }
        Gemm g{512, 512, 512, (const char*)XB};
        MoeSched S{nT, 8, F.G, cG, (const LAS int*)(F.lds + LX_TILEE), (const LAS int*)(F.lds + LX_TBASE), tokl, nullptr, (const char*)(ws + WS_WGU) + (size_t)1 * 32 * 2048 * 1024, 0, (size_t)2048 * 1024, (size_t)256 * 1024};
        EpiGU E{b_gu + (size_t)1 * 32 * 2048, (unsigned char*)HB, (LAS float*)(F.lds + LX_BIAS), 0}; pg8::gemm_phase<EpiGU, MoeSched, true, true, true, true>(ring, g, S, E); }
    SEAM(16);
    PH(17) { const int nT = moe_tables(F, 1); Gemm g{512, 512, 512, nullptr};
        MoeSched S{nT, 4, F.G, cG, (const LAS int*)(F.lds + LX_TILEE), (const LAS int*)(F.lds + LX_TBASE), nullptr, (const char*)HB, (const char*)(ws + WS_WD) + (size_t)1 * 32 * 1024 * 1024, (size_t)256 * 1024, (size_t)1024 * 1024, (size_t)256 * 1024};
        EpiDN E{b_dn + (size_t)1 * 32 * 1024, (unsigned char*)YB, (LAS float*)(F.lds + LX_BIAS), 0}; pg8::gemm_phase<EpiDN, MoeSched, true, false, true, true>(ring, g, S, E); }
    SEAM(17);
    PH(18) phase_combine<false>(F, R1, (float*)AIN(18), ln_ffn_g + 1024, ln_ffn_b + 1024, nullptr, 1);
#undef IN
#undef CONV_SLICE
#undef AIN
#undef x_in
#undef ln_mix_g
#undef ln_mix_b
#undef ln_ffn_g
#undef ln_ffn_b
#undef router_b
#undef b_gu
#undef b_dn
#undef SEAM
}

extern "C" void kernel_launch(void* const* d_in, const int* in_sizes, int n_in, void* d_out, int out_size, void* d_ws, size_t ws_size, hipStream_t stream) {
    static int grid = 0;
    if (grid == 0) {
        if (n_in != 18 || out_size != NTOK * DM || ws_size < WS_END) { fprintf(stderr, "kernel_launch: unexpected problem shape (n_in %d, out %d, ws %zu)\n", n_in, out_size, ws_size); grid = -1; return; }
        int dev = 0, cus = 0, per_cu = 0;
        if (hipGetDevice(&dev) != hipSuccess || hipDeviceGetAttribute(&cus, hipDeviceAttributeMultiprocessorCount, dev) != hipSuccess) { grid = -1; return; }
        if (hipFuncSetAttribute((const void*)mk_fwd, hipFuncAttributeMaxDynamicSharedMemorySize, LDS_BYTES) != hipSuccess) { fprintf(stderr, "kernel_launch: hipFuncSetAttribute failed\n"); grid = -1; return; }
        if (hipOccupancyMaxActiveBlocksPerMultiprocessor(&per_cu, (const void*)mk_fwd, NTHR, LDS_BYTES) != hipSuccess || per_cu < 1) fprintf(stderr, "kernel_launch: occupancy query reports %d\n", per_cu);
        (void)hipGetLastError();
        grid = cus;
        if (grid > 256) grid = 256;
        if (grid < 240) { fprintf(stderr, "kernel_launch: %d CUs: this build needs 240..256\n", cus); grid = -1; return; }
    }
    if (grid < 0) return;
    if (hipMemsetAsync((char*)d_ws + WS_CTL, 0, CTL_ZERO_BYTES, stream) != hipSuccess) return;
    Args a{};
    for (int i = 0; i < 18; ++i) a.in[i] = (const float*)d_in[i];
    a.out = (float*)d_out; a.ws = (unsigned char*)d_ws;
#if MK_ONE_LAUNCH
    a.ph_lo = 0; a.ph_hi = NPHASE;
    hipLaunchKernelGGL(mk_fwd, dim3(grid), dim3(NTHR), LDS_BYTES, stream, a);
#else
    for (int p = 0; p < NPHASE; ++p) { a.ph_lo = p; a.ph_hi = p + 1; hipLaunchKernelGGL(mk_fwd, dim3(grid), dim3(NTHR), LDS_BYTES, stream, a); }
#endif
}
```

```cpp
#include <hip/hip_runtime.h>
#include <hip/hip_bf16.h>
#include <cstdio>
#include <cstdint>
#include <cmath>

#define LAS __attribute__((address_space(3)))
#define GAS __attribute__((address_space(1)))
typedef unsigned short bf16_t;
typedef short bf16x8 __attribute__((ext_vector_type(8)));
typedef float f32x4 __attribute__((ext_vector_type(4)));
typedef float f32x2 __attribute__((ext_vector_type(2)));
typedef unsigned u32x4 __attribute__((ext_vector_type(4)));
typedef unsigned u32x2 __attribute__((ext_vector_type(2)));
typedef int i32x4 __attribute__((ext_vector_type(4)));
typedef int i32x8 __attribute__((ext_vector_type(8)));

typedef __bf16 bf16x2_t __attribute__((ext_vector_type(2)));
__device__ __forceinline__ unsigned cvt_pk_bf16(float lo, float hi) { const f32x2 v = {lo, hi}; const bf16x2_t b = __builtin_convertvector(v, bf16x2_t); return __builtin_bit_cast(unsigned, b); }
__device__ __forceinline__ float bf2f(unsigned short b) { return __uint_as_float(((unsigned)b) << 16); }
__device__ __forceinline__ float bflo(unsigned w) { return __uint_as_float(w << 16); }
__device__ __forceinline__ float bfhi(unsigned w) { return __uint_as_float(w & 0xffff0000u); }

__device__ __forceinline__ void glds16s(const void* sbase, unsigned voff, unsigned lds_dst) { unsigned keep;
    asm volatile("s_nop 4\n\ts_mov_b32 %0, m0\n\ts_mov_b32 m0, %3\n\ts_nop 0\n\tglobal_load_lds_dwordx4 %1, %2\n\ts_mov_b32 m0, %0" : "=&s"(keep) : "v"(voff), "s"(sbase), "s"(lds_dst) : "memory"); }
__device__ __forceinline__ void glds4s(const void* sbase, unsigned voff, unsigned lds_dst) { unsigned keep;
    asm volatile("s_nop 4\n\ts_mov_b32 %0, m0\n\ts_mov_b32 m0, %3\n\ts_nop 0\n\tglobal_load_lds_dword %1, %2\n\ts_mov_b32 m0, %0" : "=&s"(keep) : "v"(voff), "s"(sbase), "s"(lds_dst) : "memory"); }
__device__ __forceinline__ const char* uni_ptr(const char* p) { const unsigned long long v = (unsigned long long)p; const unsigned lo = __builtin_amdgcn_readfirstlane((unsigned)v), hi = __builtin_amdgcn_readfirstlane((unsigned)(v >> 32)); return (const char*)(((unsigned long long)hi << 32) | lo); }
namespace pg8 {
constexpr int BM = 256, BK = 64, HALF = 128, HTB = HALF * BK * 2, STAGE_BYTES = 8 * HTB, NXCD = 8, WGM = 8;
__host__ __device__ __forceinline__ int lds_byte(int r, int c) { const int st = (r >> 4) * 2 + (c >> 5), rr = r & 15, cc = c & 31, ob = rr * 64 + cc * 2; return st * 1024 + (ob ^ (((ob >> 9) & 1) << 5)); }
__host__ __device__ __forceinline__ void stage_rc(int b, int& R, int& C) { const int st = b / 1024, sb = b % 1024, swz = sb ^ (((sb >> 9) & 1) << 5); R = (st >> 1) * 16 + swz / 64; C = (st & 1) * 32 + (swz % 64) / 2; }
__host__ __device__ __forceinline__ int perm32(int rho) { const int n = rho >> 4, i = rho & 15; return 8 * (i >> 2) + 4 * n + (i & 3); }

struct Unit { int pm, pn; const char* A; const char* B; const LAS unsigned short* tl; int x0, x1, x2; };
struct Gemm { int K, lda, ldb; const char* Abase; };

__device__ __forceinline__ bool tile_order(int i, int G, int c, int nM, int nN, int& pm, int& pn) {
    const int nwg = nM * nN; const long L = (long)i * G + c; if (L >= nwg) return false;
    int wgid = (int)L; { const int q = nwg / NXCD, r = nwg % NXCD, xcd = wgid % NXCD, off = wgid / NXCD; wgid = (xcd < r ? xcd * (q + 1) : r * (q + 1) + (xcd - r) * q) + off; }
    const int nig = WGM * nN, gid = wgid / nig, fm = gid * WGM, gsz = (nM - fm) < WGM ? (nM - fm) : WGM;
    pm = fm + ((wgid % nig) % gsz); pn = (wgid % nig) / gsz; return true;
}

template <class Epi, class Sched, bool ALIGN_EPI, bool GATHER, bool FP8 = false, bool HALFSEL = false>
__device__ __forceinline__ void gemm_phase(LAS unsigned char* lds, const Gemm g, const Sched& S, const Epi& E) {
    const int tid = threadIdx.x, wid = __builtin_amdgcn_readfirstlane(tid >> 6), lane = tid & 63, wr = wid >> 2, wc = wid & 3, fr = lane & 15, fq = lane >> 4;
    const int K = g.K, nt = K / BK;
    int RA[2]; unsigned cA2[2], voffB[2];
#pragma unroll
    for (int i = 0; i < 2; ++i) { int R, C; stage_rc(tid * 16 + i * 8192, R, C); const int Rb = Epi::PERM ? ((R & ~31) + perm32(R & 31)) : R;
        RA[i] = R; cA2[i] = (unsigned)C * 2u; voffB[i] = (unsigned)(Rb * g.ldb + C) * 2u; }
    const size_t kstep = (size_t)(BK * 2);
    const unsigned hstepA = (unsigned)HALF * (unsigned)g.lda * 2u; const size_t hstepB = (size_t)HALF * g.ldb * 2;
    const unsigned ldsb = (unsigned)__builtin_amdgcn_readfirstlane((unsigned)(unsigned long long)lds + (unsigned)wid * 1024u);
    const int aoff = lds_byte(wr * 64 + fr, fq * 8), boff = lds_byte(wc * 32 + fr, fq * 8);
    const int aoff2 = aoff + 1024, boff2 = boff + 1024;
#define PG8_SA(b, h) (((b) * 2 + (h)) * HTB)
#define PG8_SB(b, h) ((4 + (b) * 2 + (h)) * HTB)
#define PG8_STAGE(bufoff, gbase, voff) do { _Pragma("unroll") for (int _i = 0; _i < 2; ++_i) glds16s((gbase), (voff)[_i], ldsb + (unsigned)(bufoff) + _i * 8192u); } while (0)
#define PG8_STAGE_A(bufoff, gbase, AO, h) do { _Pragma("unroll") for (int _i = 0; _i < 2; ++_i) glds16s((gbase), (AO)[h][_i], ldsb + (unsigned)(bufoff) + _i * 8192u); } while (0)
#define PG8_LD8(base_, o1_, o2_) __builtin_shufflevector(*(const LAS i32x4*)(lds + (base_) + (o1_)), *(const LAS i32x4*)(lds + (base_) + (o2_)), 0, 1, 2, 3, 4, 5, 6, 7)
#define PG8_LDA(dst, b, h) do { if constexpr (FP8) { _Pragma("unroll") for (int m = 0; m < 4; ++m) dst##8[m] = PG8_LD8(PG8_SA(b, h) + m * 2048, aoff, aoff2); } \
        else { _Pragma("unroll") for (int m = 0; m < 4; ++m) _Pragma("unroll") for (int k = 0; k < 2; ++k) dst[m][k] = *(const LAS bf16x8*)(lds + PG8_SA(b, h) + aoff + m * 2048 + k * 1024); } } while (0)
#define PG8_LDB(dst, b, h) do { if constexpr (FP8) { _Pragma("unroll") for (int n = 0; n < 2; ++n) dst##8[n] = PG8_LD8(PG8_SB(b, h) + n * 2048, boff, boff2); } \
        else { _Pragma("unroll") for (int n = 0; n < 2; ++n) _Pragma("unroll") for (int k = 0; k < 2; ++k) dst[n][k] = *(const LAS bf16x8*)(lds + PG8_SB(b, h) + boff + n * 2048 + k * 1024); } } while (0)
#define PG8_MMA(ai, bj, At, Bt) do { __builtin_amdgcn_s_setprio(1); _Pragma("unroll") for (int m = 0; m < 4; ++m) _Pragma("unroll") for (int n = 0; n < 2; ++n) { \
        if constexpr (FP8) asm volatile("v_mfma_f32_16x16x128_f8f6f4 %0, %1, %2, %0" : "+v"(acc[ai][bj][m][n]) : "v"(Bt##8[n]), "v"(At##8[m])); \
        else { _Pragma("unroll") for (int k = 0; k < 2; ++k) acc[ai][bj][m][n] = __builtin_amdgcn_mfma_f32_16x16x32_bf16(Bt[n][k], At[m][k], acc[ai][bj][m][n], 0, 0, 0); } } \
        __builtin_amdgcn_s_setprio(0); } while (0)
#define PG8_WAIT_V(n) asm volatile("s_waitcnt vmcnt(" #n ")" ::: "memory")
#define PG8_WAIT_L(n) asm volatile("s_waitcnt lgkmcnt(" #n ")" ::: "memory")
#define PG8_BAR __builtin_amdgcn_s_barrier()
#define PG8_SCHED __builtin_amdgcn_sched_barrier(0)
#define PG8_AOFF(AO, U) do { _Pragma("unroll") for (int _h = 0; _h < 2; ++_h) _Pragma("unroll") for (int _i = 0; _i < 2; ++_i) { \
        if constexpr (GATHER) AO[_h][_i] = (unsigned)(U).tl[RA[_i] + _h * HALF] * (unsigned)(g.lda * 2) + cA2[_i]; \
        else AO[_h][_i] = (unsigned)RA[_i] * (unsigned)(g.lda * 2) + cA2[_i] + (unsigned)_h * hstepA; } } while (0)
    Unit cur, nxt; int ui = 0;
    if (!S.next(0, cur)) return;
    f32x4 acc[2][2][4][2];
#pragma unroll
    for (int a = 0; a < 2; ++a)
#pragma unroll
        for (int b = 0; b < 2; ++b)
#pragma unroll
            for (int m = 0; m < 4; ++m)
#pragma unroll
                for (int n = 0; n < 2; ++n) acc[a][b][m][n] = (f32x4){0.f, 0.f, 0.f, 0.f};
    bf16x8 At[4][2], B0[2][2], B1[2][2]; i32x8 At8[4], B08[2], B18[2];
    E.prep(cur, 0, wid, lane);
    unsigned aoC[2][2], aoN[2][2];
    PG8_AOFF(aoC, cur);
    const char* cA = uni_ptr(GATHER ? g.Abase : cur.A); const char* cB = uni_ptr(cur.B);
    PG8_STAGE(PG8_SB(0, 0), cB, voffB); PG8_STAGE(PG8_SB(0, 1), cB + hstepB, voffB); PG8_STAGE_A(PG8_SA(0, 0), cA, aoC, 0); PG8_STAGE_A(PG8_SA(0, 1), cA, aoC, 1);
    if (wr == 1) PG8_BAR;
    PG8_WAIT_V(2); PG8_BAR;
    PG8_STAGE(PG8_SB(1, 0), cB + kstep, voffB); PG8_STAGE_A(PG8_SA(1, 0), cA + kstep, aoC, 0); PG8_STAGE(PG8_SB(1, 1), cB + hstepB + kstep, voffB);
    PG8_WAIT_V(6); PG8_BAR;
    for (;;) {
        const bool has_next = S.next(ui + 1, nxt);
        if (has_next) E.prep(nxt, ui + 1, wid, lane);
        if constexpr (GATHER) { if (has_next) PG8_AOFF(aoN, nxt); else { _Pragma("unroll") for (int _h = 0; _h < 2; ++_h) _Pragma("unroll") for (int _i = 0; _i < 2; ++_i) aoN[_h][_i] = aoC[_h][_i]; } }
        const char* nA = uni_ptr(GATHER ? g.Abase : (has_next ? nxt.A : cA)); const char* nB = uni_ptr(has_next ? nxt.B : cB);
        const bool dh0 = cur.x2 != 2, dh1 = cur.x2 != 1;
#pragma nounroll
        for (int t = 0; t < nt; t += 2) {
            const bool last = (t == nt - 2);
            const char* a1 = cA + (size_t)(t + 1) * kstep;
            const char* a2 = last ? nA : cA + (size_t)(t + 2) * kstep; const char* b2 = last ? nB : cB + (size_t)(t + 2) * kstep;
            const char* a3 = a2 + kstep; const char* b3 = b2 + kstep;
            unsigned aoS[2][2];
#pragma unroll
            for (int _h = 0; _h < 2; ++_h)
#pragma unroll
                for (int _i = 0; _i < 2; ++_i) aoS[_h][_i] = (GATHER && last) ? aoN[_h][_i] : aoC[_h][_i];
            PG8_LDB(B0, 0, 0); PG8_LDB(B1, 0, 1); PG8_SCHED; PG8_LDA(At, 0, 0); PG8_STAGE_A(PG8_SA(1, 1), a1, aoC, 1);
            PG8_WAIT_V(8); PG8_WAIT_L(0); PG8_BAR; if (!HALFSEL || dh0) PG8_MMA(0, 0, At, B0); if (!HALFSEL || dh1) PG8_MMA(0, 1, At, B1); PG8_BAR; PG8_SCHED;
            PG8_LDA(At, 0, 1); PG8_STAGE(PG8_SB(0, 0), b2, voffB); PG8_STAGE(PG8_SB(0, 1), b2 + hstepB, voffB); PG8_STAGE_A(PG8_SA(0, 0), a2, aoS, 0);
            PG8_WAIT_V(8); PG8_WAIT_L(0); PG8_BAR; if (!HALFSEL || dh0) PG8_MMA(1, 0, At, B0); if (!HALFSEL || dh1) PG8_MMA(1, 1, At, B1); PG8_BAR; PG8_SCHED;
            PG8_LDB(B0, 1, 0); PG8_LDB(B1, 1, 1); PG8_SCHED; PG8_LDA(At, 1, 0); PG8_STAGE_A(PG8_SA(0, 1), a2, aoS, 1);
            PG8_WAIT_V(8); PG8_WAIT_L(0); PG8_BAR; if (!HALFSEL || dh0) PG8_MMA(0, 0, At, B0); if (!HALFSEL || dh1) PG8_MMA(0, 1, At, B1); PG8_BAR; PG8_SCHED;
            PG8_LDA(At, 1, 1); PG8_STAGE(PG8_SB(1, 0), b3, voffB); PG8_STAGE(PG8_SB(1, 1), b3 + hstepB, voffB); PG8_STAGE_A(PG8_SA(1, 0), a3, aoS, 0);
            PG8_WAIT_V(8); PG8_WAIT_L(0); PG8_BAR; if (!HALFSEL || dh0) PG8_MMA(1, 0, At, B0); if (!HALFSEL || dh1) PG8_MMA(1, 1, At, B1); PG8_BAR; PG8_SCHED;
        }
        if constexpr (FP8) asm volatile("s_nop 15\n\ts_nop 15" ::: "memory");
        if constexpr (ALIGN_EPI) { if (wr == 0) PG8_BAR; }
        E(acc, cur, wr, wc, fr, fq);
        if (!has_next) break;
#pragma unroll
        for (int a = 0; a < 2; ++a)
#pragma unroll
            for (int b = 0; b < 2; ++b)
#pragma unroll
                for (int m = 0; m < 4; ++m)
#pragma unroll
                    for (int n = 0; n < 2; ++n) acc[a][b][m][n] = (f32x4){0.f, 0.f, 0.f, 0.f};
        if constexpr (FP8) asm volatile("s_nop 7" ::: "memory");
        cur = nxt; cA = nA; cB = nB; ++ui;
        if constexpr (GATHER) {
#pragma unroll
            for (int _h = 0; _h < 2; ++_h)
#pragma unroll
                for (int _i = 0; _i < 2; ++_i) aoC[_h][_i] = aoN[_h][_i]; }
        if constexpr (ALIGN_EPI) { if (wr == 1) PG8_BAR; }
    }
    PG8_WAIT_V(0);
    if constexpr (!ALIGN_EPI) { if (wr == 0) PG8_BAR; }
    PG8_BAR;
#undef PG8_SA
#undef PG8_SB
#undef PG8_STAGE
#undef PG8_STAGE_A
#undef PG8_LDA
#undef PG8_LD8
#undef PG8_LDB
#undef PG8_MMA
#undef PG8_WAIT_V
#undef PG8_WAIT_L
#undef PG8_BAR
#undef PG8_SCHED
#undef PG8_AOFF
}
}
#include <hip/hip_bf16.h>
namespace attn_body {
using bf16=__hip_bfloat16;
using bf16x8=__attribute__((ext_vector_type(8)))short;
using s16x4=__attribute__((ext_vector_type(4)))short;
using f32x16=__attribute__((ext_vector_type(16)))float;
using u32x4=__attribute__((ext_vector_type(4)))unsigned;
constexpr int BATCH=4,NHEAD=16,SEQ=4096,D=64,DM=NHEAD*D;
constexpr int NW=8,QBLK=32,QB=QBLK*NW,KVBLK=64,NQB=SEQ/QB;
constexpr int ATTN_PITCH=DM, ATTN_UNIT_ROWS=QB;
__device__ __forceinline__ int crow(int r,int hi){return (r&3)+8*(r>>2)+4*hi;}
#define SBAR() __builtin_amdgcn_sched_barrier(0)
__device__ __forceinline__ void cmask(f32x16&p0,f32x16&p1,int jb,int qrel,int hi){
  const float NEG=-INFINITY; int d=qrel-64*jb-4*hi; asm volatile("":"+v"(d));
  #pragma unroll
  for(int r=0;r<16;++r){const int c=(r&3)+8*(r>>2); if(c>d)p0[r]=NEG; if(c+32>d)p1[r]=NEG;}
}

constexpr int NSLOT=3, SLOTB=8192;
constexpr int LDS_GT=98304;
constexpr int LDS_K=0, LDS_V=NSLOT*SLOTB, LDS_WS=2*NSLOT*SLOTB, LDS_OST=LDS_WS+NW*64*4, LDS_BYTES=LDS_OST+NW*4096;
constexpr float C2=0.125f*1.4426950408889634f;
__device__ __forceinline__ void glds16(const void*gsrc,unsigned lds_dst){unsigned keep;
  asm volatile("s_mov_b32 %0, m0\n\ts_mov_b32 m0, %2\n\ts_nop 0\n\tglobal_load_lds_dwordx4 %1, off\n\ts_mov_b32 m0, %0":"=&s"(keep):"v"(gsrc),"s"(lds_dst):"memory");}
__device__ __forceinline__ void glds16s(const void*sbase,unsigned voff,unsigned lds_dst){unsigned keep;
  asm volatile("s_nop 4\n\ts_mov_b32 %0, m0\n\ts_mov_b32 m0, %3\n\ts_nop 0\n\tglobal_load_lds_dwordx4 %1, %2\n\ts_mov_b32 m0, %0":"=&s"(keep):"v"(voff),"s"(sbase),"s"(lds_dst):"memory");}
__device__ __forceinline__ unsigned lane_now(){unsigned l;asm volatile("v_mbcnt_lo_u32_b32 %0, -1, 0\n\tv_mbcnt_hi_u32_b32 %0, -1, %0":"=v"(l));return l;}
__device__ __forceinline__ float max3f(float a,float b,float c){float r;asm("v_max3_f32 %0, %1, %2, %3":"=v"(r):"v"(a),"v"(b),"v"(c));return r;}
__device__ __forceinline__ float max2f(float a,float b){float r;asm("v_max_f32_e32 %0, %1, %2":"=v"(r):"v"(a),"v"(b));return r;}
__device__ __forceinline__ float fadd_s(float a,float b){float r;asm("v_add_f32_e32 %0, %1, %2":"=v"(r):"v"(a),"v"(b));return r;}
__device__ __forceinline__ float fsub_s(float a,float b){float r;asm("v_sub_f32_e32 %0, %1, %2":"=v"(r):"v"(a),"v"(b));return r;}
typedef float f32x2_t __attribute__((ext_vector_type(2))); typedef __bf16 bf16x2_t __attribute__((ext_vector_type(2)));
__device__ __forceinline__ unsigned cvtpk_s(float lo,float hi){f32x2_t v={lo,hi};bf16x2_t b=__builtin_convertvector(v,bf16x2_t);return __builtin_bit_cast(unsigned,b);}
#define WAIT_BAR(N) asm volatile("s_waitcnt vmcnt(" #N ") lgkmcnt(0)\n\ts_barrier":::"memory")

__device__ __forceinline__ void qkt(f32x16&p0,f32x16&p1,const char*Kslot,const bf16x8*qr,int r32,int hi){
  const char*kb=Kslot+hi*1024+r32*16;
  #pragma unroll
  for(int d0=0;d0<4;++d0){
    const bf16x8 b0=*reinterpret_cast<const bf16x8*>(kb+d0*2048);
    const bf16x8 b1=*reinterpret_cast<const bf16x8*>(kb+d0*2048+512);
    if(d0==0){p0=__builtin_amdgcn_mfma_f32_32x32x16_bf16(b0,qr[0],(f32x16){0.f,0.f,0.f,0.f,0.f,0.f,0.f,0.f,0.f,0.f,0.f,0.f,0.f,0.f,0.f,0.f},0,0,0);p1=__builtin_amdgcn_mfma_f32_32x32x16_bf16(b1,qr[0],(f32x16){0.f,0.f,0.f,0.f,0.f,0.f,0.f,0.f,0.f,0.f,0.f,0.f,0.f,0.f,0.f,0.f},0,0,0);}
    else{p0=__builtin_amdgcn_mfma_f32_32x32x16_bf16(b0,qr[d0],p0,0,0,0);p1=__builtin_amdgcn_mfma_f32_32x32x16_bf16(b1,qr[d0],p1,0,0,0);}}
}
typedef __attribute__((address_space(3))) const char* lds_cptr;
typedef short v4i16_t __attribute__((ext_vector_type(4)));
__device__ __forceinline__ void kload8(bf16x8*kf,lds_cptr kp){
  kf[0]=*(const __attribute__((address_space(3))) bf16x8*)(kp);      kf[1]=*(const __attribute__((address_space(3))) bf16x8*)(kp+512);
  kf[2]=*(const __attribute__((address_space(3))) bf16x8*)(kp+2048); kf[3]=*(const __attribute__((address_space(3))) bf16x8*)(kp+2560);
  kf[4]=*(const __attribute__((address_space(3))) bf16x8*)(kp+4096); kf[5]=*(const __attribute__((address_space(3))) bf16x8*)(kp+4608);
  kf[6]=*(const __attribute__((address_space(3))) bf16x8*)(kp+6144); kf[7]=*(const __attribute__((address_space(3))) bf16x8*)(kp+6656);
}
__device__ __forceinline__ void kload2(bf16x8*kf,lds_cptr kp,int j){ kf[2*j]=*(const __attribute__((address_space(3))) bf16x8*)(kp+j*2048); kf[2*j+1]=*(const __attribute__((address_space(3))) bf16x8*)(kp+j*2048+512); }
__device__ __forceinline__ s16x4 vtr(lds_cptr p){ return __builtin_bit_cast(s16x4,__builtin_amdgcn_ds_read_tr16_b64_v4i16((__attribute__((address_space(3))) v4i16_t*)p)); }
__device__ __forceinline__ float rowmax(const f32x16&p0,const f32x16&p1){
  float a=max3f(p0[0],p0[1],p1[0]),b=max3f(p0[2],p0[3],p1[1]);a=max3f(a,p1[2],p1[3]);
  #pragma unroll
  for(int r=4;r<16;r+=4){a=max3f(a,p0[r],p0[r+1]);b=max3f(b,p0[r+2],p0[r+3]);a=max3f(a,p1[r],p1[r+1]);b=max3f(b,p1[r+2],p1[r+3]);}
  const float m=max2f(a,b);
  auto rr=__builtin_amdgcn_permlane32_swap(__float_as_uint(m),__float_as_uint(m),false,false);
  return max2f(__uint_as_float(rr[0]),__uint_as_float(rr[1]));
}
__device__ __forceinline__ void pv(f32x16*o,int vb,bf16x8 pa0,bf16x8 pa1,bf16x8 pa2,bf16x8 pa3){
  #pragma unroll
  for(int d0=0;d0<2;++d0){s16x4 lo[4],hi[4];
    #pragma unroll
    for(int ks=0;ks<4;++ks){
      asm volatile("ds_read_b64_tr_b16 %0,%1 offset:%c2":"=&v"(lo[ks]):"v"(vb),"i"(d0*4096+ks*1024):"memory");
      asm volatile("ds_read_b64_tr_b16 %0,%1 offset:%c2":"=&v"(hi[ks]):"v"(vb),"i"(d0*4096+ks*1024+512):"memory");}
    asm volatile("s_waitcnt lgkmcnt(0)":::"memory");SBAR();
    #define PK(k) (bf16x8){lo[k][0],lo[k][1],lo[k][2],lo[k][3],hi[k][0],hi[k][1],hi[k][2],hi[k][3]}
    o[d0]=__builtin_amdgcn_mfma_f32_32x32x16_bf16(pa0,PK(0),o[d0],0,0,0);
    o[d0]=__builtin_amdgcn_mfma_f32_32x32x16_bf16(pa1,PK(1),o[d0],0,0,0);
    o[d0]=__builtin_amdgcn_mfma_f32_32x32x16_bf16(pa2,PK(2),o[d0],0,0,0);
    o[d0]=__builtin_amdgcn_mfma_f32_32x32x16_bf16(pa3,PK(3),o[d0],0,0,0);
    #undef PK
  }
}

#ifndef ATTN_STORE16
#define ATTN_STORE16(p,v) (*(u32x4*)(p)=(v))
#endif
template<int THRL> __device__ __forceinline__ void attn_unit(int b,int h,int qb,const bf16*Q,const bf16*__restrict__ K,const bf16*__restrict__ V,bf16*O,const float*ksum,char*shm){
  const int tid=threadIdx.x,lane=tid&63,r32=lane&31,hi=lane>>5; const int wid=__builtin_amdgcn_readfirstlane(tid>>6);
  const long rowbase=(long)b*SEQ; const int q0=qb*QB;
  const bf16*Qw=Q+(rowbase+q0+wid*QBLK)*DM+h*D;
  const bf16*Kh=K+rowbase*DM+h*D,*Vh=V+rowbase*DM+h*D;
  const unsigned lds0=(unsigned)(uintptr_t)shm;
  float*wsf=(float*)(shm+LDS_WS)+wid*64;
  const unsigned kdst=lds0+LDS_K+wid*1024, vdst=lds0+LDS_V+wid*1024;
  #define PHYS(t) (((t)<4)?(4*qb+(t)):((t)-4))
  #define DMA_K(t,slot) glds16s((const char*)Kh+(size_t)PHYS(t)*(KVBLK*DM*2)+wid*16,lane_now()*(unsigned)(DM*2),(unsigned)__builtin_amdgcn_readfirstlane(kdst+(slot)))
  #define DMA_V(t,slot) glds16s((const char*)Vh+(size_t)PHYS(t)*(KVBLK*DM*2)+(size_t)(16*(wid&3))*(DM*2)+(wid>>2)*64,({const unsigned l_=lane_now(); (l_>>2)*(unsigned)(DM*2)+(l_&3u)*16u;}),(unsigned)__builtin_amdgcn_readfirstlane(vdst+(slot)))
  const int vb0=(int)(lds0+LDS_V)+((lane>>4)&1)*32+(lane&3)*8+(4*hi+((lane&15)>>2))*64;
  const char*Kbase=shm+LDS_K; bf16x8 kf[8];
  const lds_cptr shm3=(lds_cptr)shm; const lds_cptr kp0=shm3+LDS_K+hi*1024+r32*16; const lds_cptr vp0=shm3+LDS_V+((lane>>4)&1)*32+(lane&3)*8+(4*hi+((lane&15)>>2))*64;
  const int NT=(q0+QB)/KVBLK;
  DMA_K(0,0);DMA_V(0,0);DMA_K(1,SLOTB);
  { float*gt=(float*)(shm+LDS_GT);
    #pragma unroll
    for(int k=0;k<2;++k){ const int j=2*wid+k; if(j<qb) gt[j*64+lane]=ksum[(long)(b*16+j)*DM+h*D+lane]; } }
  bf16x8 qr[4];
  #pragma unroll
  for(int d0=0;d0<4;++d0)qr[d0]=*reinterpret_cast<const bf16x8*>(&Qw[(long)r32*DM+d0*16+hi*8]);

  unsigned sel=0u;
  float mhat=0.f,l_reg=0.f;f32x16 o[2];o[0]=f32x16{};o[1]=f32x16{};
  bf16x8 kone=(bf16x8){0,0,0,0,0,0,0,0}, qm=(bf16x8){0,0,0,0,0,0,0,0}; if(hi==0) kone[0]=(short)0x3F80;
  #define SETQM() do{ const unsigned short mb_=(unsigned short)(cvtpk_s(-mhat,0.f)&0xffffu); qm[0]=(hi==0)?(short)mb_:(short)0; asm volatile("":"+v"(qm)); }while(0)
  const int qrel=wid*QBLK+r32;
  #define CMASK(P0,P1,t) do{ const int t_=(t); if(t_<4){ const int l_=(int)lane_now(); cmask(P0,P1,t_,wid*QBLK+(l_&31),l_>>5); } else if(!((sel>>(((t_-4)>>2)&15))&1u)){ _Pragma("unroll") for(int r=0;r<16;++r){P0[r]=-INFINITY;P1[r]=-INFINITY;} } }while(0)
  bool resc=false;
  #define START(P0,P1) do{ const float rm=rowmax(P0,P1); resc=false; \
    { const float dl=__uint_as_float(cvtpk_s(rm,0.f)<<16); mhat=fadd_s(mhat,dl);          \
      _Pragma("unroll") for(int r=0;r<16;++r){P0[r]=fsub_s(P0[r],dl);P1[r]=fsub_s(P1[r],dl);} \
      SETQM(); } \
    _Pragma("unroll") for(int r=0;r<16;++r)P0[r]=__builtin_amdgcn_exp2f(P0[r]); }while(0)
  #define RESC() do{ if(resc){ asm volatile("s_waitcnt lgkmcnt(0)":::"memory"); \
      _Pragma("unroll") for(int d_=0;d_<2;++d_) _Pragma("unroll") for(int r=0;r<16;++r)o[d_][r]*=wsf[crow(r,(int)(lane_now()>>5))]; } }while(0)
  f32x16 pA0,pA1,pB0,pB1;
  int sl_prev=0,sl_cur=0,sl_next=SLOTB;
  #define ROT() do{sl_prev=sl_cur;sl_cur=sl_next;sl_next=(sl_next==(NSLOT-1)*SLOTB)?0:sl_next+SLOTB;}while(0)
  DMA_K(2,2*SLOTB);
  WAIT_BAR(3);
  { float qf[32];
    #pragma unroll
    for(int d0=0;d0<4;++d0){
      #pragma unroll
      for(int i=0;i<8;++i) qf[d0*8+i]=__uint_as_float(((unsigned)(unsigned short)qr[d0][i])<<16); }
    const float*gt=(const float*)(shm+LDS_GT)+hi*8; float g[15];
    #pragma unroll
    for(int j=0;j<15;++j){ g[j]=-INFINITY;
      if(j<qb){ const float*kp=gt+j*64; float a=0.f;
        #pragma unroll
        for(int d0=0;d0<4;++d0){ const float4 k0=*reinterpret_cast<const float4*>(kp+d0*16), k1=*reinterpret_cast<const float4*>(kp+d0*16+4);
          a+=qf[d0*8+0]*k0.x; a+=qf[d0*8+1]*k0.y; a+=qf[d0*8+2]*k0.z; a+=qf[d0*8+3]*k0.w; a+=qf[d0*8+4]*k1.x; a+=qf[d0*8+5]*k1.y; a+=qf[d0*8+6]*k1.z; a+=qf[d0*8+7]*k1.w; }
        g[j]=a+__shfl_xor(a,32); } }
    #pragma unroll
    for(int kk=0;kk<3;++kk){ float best=-INFINITY; int bj=-1;
      #pragma unroll
      for(int j=0;j<15;++j){ const bool c=(j<qb)&&!((sel>>j)&1u)&&(g[j]>best); best=c?g[j]:best; bj=c?j:bj; }
      if(bj>=0) sel|=(1u<<bj); } }
  qkt(pA0,pA1,Kbase,qr,r32,hi);asm volatile("s_nop 15\n\ts_nop 7":"+v"(pA0),"+v"(pA1));CMASK(pA0,pA1,0);
  START(pA0,pA1);
  _Pragma("unroll") for(int r=0;r<16;++r)pA1[r]=__builtin_amdgcn_exp2f(pA1[r]);
  WAIT_BAR(0);
  DMA_K(3,0);DMA_V(1,SLOTB);
  ROT();
  kload8(kf,kp0+sl_cur);
  WAIT_BAR(2);
  s16x4 vlo[8],vhi[8]; u32x4 pw0,pw1,pw2,pw3;
  #define PKW(P,B) cvtpk_s(P[B],P[B+1])
  #define PAF(k) __builtin_bit_cast(bf16x8,pw##k)
  #define VFR(i) (bf16x8){vlo[i][0],vlo[i][1],vlo[i][2],vlo[i][3],vhi[i][0],vhi[i][1],vhi[i][2],vhi[i][3]}
  #define PIN(x) asm volatile("":"+v"(x))
  #define MX3(a,b,c) __builtin_fmaxf(__builtin_fmaxf((a),(b)),(c))
  #define GAPA(MF,A0,A1,A2,A3,W0,W1,PW) do{ MF; sacc+=A0; sacc+=A1; sacc+=A2; sacc+=A3; PIN(sacc); W0; W1; PIN(PW); SBAR(); }while(0)
  #define EX(v) __builtin_amdgcn_exp2f(v)
  #define GAPB(MF,X,B) do{ MF; X[B]=EX(X[B]); X[B+1]=EX(X[B+1]); X[B+2]=EX(X[B+2]); X[B+3]=EX(X[B+3]); PIN(X); SBAR(); }while(0)
  #define VRD(i) do{ vlo[i]=vtr(vp_+(((i)>>2)*4096+((i)&3)*1024)); vhi[i]=vtr(vp_+(((i)>>2)*4096+((i)&3)*1024+512)); }while(0)
  #define KRD(G,j) do{ if(G){ kload2(kf,kp0+sl_next,j); SBAR(); } }while(0)
  #define STEP(C0,C1,P0,P1,t,GK,GV,GL) do{ SBAR(); \
    const lds_cptr vp_=vp0+sl_prev; \
    C0=__builtin_amdgcn_mfma_f32_32x32x16_bf16(kone,qm,(f32x16){0.f,0.f,0.f,0.f,0.f,0.f,0.f,0.f,0.f,0.f,0.f,0.f,0.f,0.f,0.f,0.f},0,0,0); C1=__builtin_amdgcn_mfma_f32_32x32x16_bf16(kone,qm,(f32x16){0.f,0.f,0.f,0.f,0.f,0.f,0.f,0.f,0.f,0.f,0.f,0.f,0.f,0.f,0.f,0.f},0,0,0); SBAR(); \
    VRD(0); SBAR(); float sacc=(P0[0]+P0[1]); \
    GAPA(C0=__builtin_amdgcn_mfma_f32_32x32x16_bf16(kf[0],qr[0],C0,0,0,0), P0[2],P0[3],P0[4],P0[5],     pw0[0]=PKW(P0,0), pw0[1]=PKW(P0,2), pw0); \
    VRD(4); SBAR(); GAPA(C1=__builtin_amdgcn_mfma_f32_32x32x16_bf16(kf[1],qr[0],C1,0,0,0), P0[6],P0[7],P0[8],P0[9],     pw0[2]=PKW(P0,4), pw0[3]=PKW(P0,6), pw0); \
    VRD(1); SBAR(); GAPA(C0=__builtin_amdgcn_mfma_f32_32x32x16_bf16(kf[2],qr[1],C0,0,0,0),   P0[10],P0[11],P0[12],P0[13], pw1[0]=PKW(P0,8), pw1[1]=PKW(P0,10), pw1); \
    VRD(5); SBAR(); GAPA(C1=__builtin_amdgcn_mfma_f32_32x32x16_bf16(kf[3],qr[1],C1,0,0,0),   P0[14],P0[15],P1[0],P1[1],   pw1[2]=PKW(P0,12),pw1[3]=PKW(P0,14), pw1); \
    VRD(2); SBAR(); GAPA(C0=__builtin_amdgcn_mfma_f32_32x32x16_bf16(kf[4],qr[2],C0,0,0,0),   P1[2],P1[3],P1[4],P1[5],     pw2[0]=PKW(P1,0), pw2[1]=PKW(P1,2), pw2); \
    VRD(6); SBAR(); GAPA(C1=__builtin_amdgcn_mfma_f32_32x32x16_bf16(kf[5],qr[2],C1,0,0,0),   P1[6],P1[7],P1[8],P1[9],     pw2[2]=PKW(P1,4), pw2[3]=PKW(P1,6), pw2); \
    VRD(3); SBAR(); GAPA(C0=__builtin_amdgcn_mfma_f32_32x32x16_bf16(kf[6],qr[3],C0,0,0,0),   P1[10],P1[11],P1[12],P1[13], pw3[0]=PKW(P1,8), pw3[1]=PKW(P1,10), pw3); \
    VRD(7); SBAR(); GAPA(C1=__builtin_amdgcn_mfma_f32_32x32x16_bf16(kf[7],qr[3],C1,0,0,0),   P1[14],P1[15],0.f,0.f,       pw3[2]=PKW(P1,12),pw3[3]=PKW(P1,14), pw3); \
    l_reg+=sacc; \
    if(GK){DMA_K((t)+3,sl_cur);} if(GV){DMA_V((t)+1,sl_next);} \
    CMASK(C0,C1,t); \
    { float a=MX3(C0[0],C0[1],C1[0]),b=MX3(C0[2],C0[3],C1[1]); a=MX3(a,C1[2],C1[3]); \
      _Pragma("unroll") for(int r=4;r<16;r+=4){a=MX3(a,C0[r],C0[r+1]);b=MX3(b,C0[r+2],C0[r+3]);a=MX3(a,C1[r],C1[r+1]);b=MX3(b,C1[r+2],C1[r+3]);} \
      float rm=__builtin_fmaxf(a,b); { auto rr=__builtin_amdgcn_permlane32_swap(__float_as_uint(rm),__float_as_uint(rm),false,false); rm=__builtin_fmaxf(__uint_as_float(rr[0]),__uint_as_float(rr[1])); } \
      resc=false; \
      if(__builtin_expect(__any(rm>(float)THRL),0)){ const float mn_=__uint_as_float(cvtpk_s(mhat+__builtin_fmaxf(rm,0.f),0.f)<<16); const float dl=mn_-mhat; mhat=mn_; \
        _Pragma("unroll") for(int r=0;r<16;++r){C0[r]-=dl;C1[r]-=dl;} \
        SETQM(); \
        const float f=__builtin_amdgcn_exp2f(-dl); l_reg*=f; { const int l_=(int)lane_now(); if((l_>>5)==0)wsf[l_&31]=f; } resc=true; } } \
    SBAR(); \
    GAPB(o[0]=__builtin_amdgcn_mfma_f32_32x32x16_bf16(PAF(0),VFR(0),o[0],0,0,0), C0,0); \
    GAPB(o[1]=__builtin_amdgcn_mfma_f32_32x32x16_bf16(PAF(0),VFR(4),o[1],0,0,0), C0,4); \
    KRD(GL,0); GAPB(o[0]=__builtin_amdgcn_mfma_f32_32x32x16_bf16(PAF(1),VFR(1),o[0],0,0,0), C0,8); \
    KRD(GL,1); GAPB(o[1]=__builtin_amdgcn_mfma_f32_32x32x16_bf16(PAF(1),VFR(5),o[1],0,0,0), C0,12); \
    KRD(GL,2); GAPB(o[0]=__builtin_amdgcn_mfma_f32_32x32x16_bf16(PAF(2),VFR(2),o[0],0,0,0), C1,0); \
    KRD(GL,3); GAPB(o[1]=__builtin_amdgcn_mfma_f32_32x32x16_bf16(PAF(2),VFR(6),o[1],0,0,0), C1,4); \
    GAPB(o[0]=__builtin_amdgcn_mfma_f32_32x32x16_bf16(PAF(3),VFR(3),o[0],0,0,0), C1,8); \
    GAPB(o[1]=__builtin_amdgcn_mfma_f32_32x32x16_bf16(PAF(3),VFR(7),o[1],0,0,0), C1,12); \
    }while(0)
  int t=1;
  #undef CMASK
  #define CMASK(P0,P1,t) do{ const int t_=(t); if(t_<4){ const int l_=(int)lane_now(); cmask(P0,P1,t_,wid*QBLK+(l_&31),l_>>5); } else if(!((sel>>(((t_-4)>>2)&15))&1u)){ _Pragma("unroll") for(int r=0;r<16;++r){P0[r]=-INFINITY;P1[r]=-INFINITY;} } }while(0)
  for(;t+5<NT;t+=2){
    STEP(pB0,pB1,pA0,pA1,t,true,true,true);     WAIT_BAR(2); RESC(); ROT();
    STEP(pA0,pA1,pB0,pB1,t+1,true,true,true);   WAIT_BAR(2); RESC(); ROT();
  }
  #undef CMASK
  #define CMASK(P0,P1,t) do{ const int t_=(t); if(t_<4){ const int l_=(int)lane_now(); cmask(P0,P1,t_,wid*QBLK+(l_&31),l_>>5); } else if(!((sel>>(((t_-4)>>2)&15))&1u)){ _Pragma("unroll") for(int r=0;r<16;++r){P0[r]=-INFINITY;P1[r]=-INFINITY;} } }while(0)
  #define ENDW(tt) do{ if((tt)+3<NT){WAIT_BAR(2);} else if((tt)+2<NT){WAIT_BAR(1);} else {WAIT_BAR(0);} }while(0)
  for(;t+1<NT;t+=2){
    STEP(pB0,pB1,pA0,pA1,t,(t+3<NT),(t+1<NT),(t+1<NT));       ENDW(t);   RESC(); ROT();
    STEP(pA0,pA1,pB0,pB1,t+1,(t+4<NT),(t+2<NT),(t+2<NT));     ENDW(t+1); RESC(); ROT();
  }
  STEP(pB0,pB1,pA0,pA1,NT-1,false,false,false); RESC();
  { float sacc=pB0[0]+pB0[1]; _Pragma("unroll") for(int r=2;r<16;++r)sacc+=pB0[r]; _Pragma("unroll") for(int r=0;r<16;++r)sacc+=pB1[r]; l_reg+=sacc;
    pw0=(u32x4){PKW(pB0,0),PKW(pB0,2),PKW(pB0,4),PKW(pB0,6)};pw1=(u32x4){PKW(pB0,8),PKW(pB0,10),PKW(pB0,12),PKW(pB0,14)};pw2=(u32x4){PKW(pB1,0),PKW(pB1,2),PKW(pB1,4),PKW(pB1,6)};pw3=(u32x4){PKW(pB1,8),PKW(pB1,10),PKW(pB1,12),PKW(pB1,14)};
    SBAR(); pv(o,vb0+sl_cur,PAF(0),PAF(1),PAF(2),PAF(3)); }
  #undef PKW
  #undef PAF
  #undef VFR
  #undef PIN
  #undef MX3
  #undef GAPA
  #undef GAPB
  #undef EX
  #undef VRD
  #undef KRD
  #undef STEP
  #undef ENDW
  {auto rr=__builtin_amdgcn_permlane32_swap(__float_as_uint(l_reg),__float_as_uint(l_reg),false,false);l_reg=__uint_as_float(rr[0])+__uint_as_float(rr[1]);}
  if(hi==0)wsf[32+r32]=l_reg;asm volatile("s_waitcnt lgkmcnt(0)":::"memory");
  float rli[16];
  #pragma unroll
  for(int r=0;r<16;++r)rli[r]=__builtin_amdgcn_rcpf(wsf[32+crow(r,hi)]);
  bf16*Ow=O+(rowbase+q0+wid*QBLK)*DM+h*D;
  { bf16*stg=(bf16*)(shm+LDS_OST)+wid*2048;
    #pragma unroll
    for(int r=0;r<16;++r){const int orow=crow(r,hi);
      #pragma unroll
      for(int d0=0;d0<2;++d0)stg[orow*64+d0*32+r32]=__float2bfloat16(o[d0][r]*rli[r]);}
    asm volatile("s_waitcnt lgkmcnt(0)":::"memory");
    #pragma unroll
    for(int i=0;i<4;++i){const int row=i*8+(lane>>3),ch=lane&7; const u32x4 v=*(const u32x4*)(stg+row*64+ch*8); ATTN_STORE16(Ow+(long)row*DM+ch*8,v);} }
  asm volatile("s_waitcnt lgkmcnt(0)\n\ts_barrier":::"memory");
  #undef DMA_K
  #undef PHYS
  #undef DMA_V
  #undef CMASK
  #undef START
  #undef SETQM
  #undef RESC
  #undef ROT
}
constexpr int ATTN_LDS_BYTES=LDS_BYTES;
struct AttnTensors { const bf16* Q; const bf16* K; const bf16* V; bf16* O; const float* ksum; };
struct AttnUnit { int bh; int qb; };
struct StaticOrder {
  int vcu, G;
  __device__ __forceinline__ explicit StaticOrder(int grid,int block):vcu((grid%8==0)?((block%8)*(grid/8)+block/8):block),G(grid){}
  __device__ __forceinline__ bool next(int i,AttnUnit&u)const{ const int L=i*G+vcu; if(L>=1024)return false; const int w=L&255, rnd=L>>8, s=w&3; u.bh=w>>2; u.qb=(rnd==0)?s:(rnd==1)?7-s:(rnd==2)?8+s:15-s; return true; }
  __device__ __forceinline__ void a_ready(const AttnUnit&)const{}
  __device__ __forceinline__ void done(const AttnUnit&)const{}
};
struct SnakeOrder {
  int v, G;
  __device__ __forceinline__ bool next(int i,AttnUnit&u)const{ const int idx=i*G+((i&1)?(G-1-v):v); if(idx>=1024)return false; u.qb=15-(idx>>6); u.bh=idx&63; return true; }
  __device__ __forceinline__ void a_ready(const AttnUnit&)const{}
  __device__ __forceinline__ void done(const AttnUnit&)const{}
};
template<class Sched,int THRL=8> __device__ __forceinline__ void attn_phase(char*lds,const AttnTensors&T,const Sched&S){
  AttnUnit u;
  for(int i=0;S.next(i,u);++i){ S.a_ready(u); attn_unit<THRL>(u.bh/NHEAD,u.bh%NHEAD,u.qb,T.Q,T.K,T.V,T.O,T.ksum,lds); S.done(u); }
}
#undef SBAR
#undef WAIT_BAR
}
constexpr int NWAVES = 8, NTHR = 512;
constexpr int NTOK = 16384, DM = 1024, SEQ = 4096, NBATCH = 4, NEXP = 32;
constexpr float ALPHA = 1.4142135623730951f;
constexpr float LN_EPS = 1e-5f;
constexpr float RSQRT_DQK = 0.08838834764831845f;
constexpr int NPHASE = 19;
constexpr float FP8_SA = 4.0f, FP8_SWGU = 64.0f, FP8_SWD = 128.0f;
constexpr float FP8_SY = 32.0f, FP8_MAXV = 448.0f;
#ifndef DBG_ATTN_MUL
#define DBG_ATTN_MUL 1.0f
#endif
#ifndef DBG_MLSTM_MUL
#define DBG_MLSTM_MUL 1.0f
#endif
#ifndef DBG_MOE_MUL
#define DBG_MOE_MUL 1.0f
#endif
#ifndef DBG_P14_A
#define DBG_P14_A WS_HN
#endif
#ifndef NCONV
#define NCONV 80
#endif
#ifndef MK_ONE_LAUNCH
#define MK_ONE_LAUNCH 1
#endif

constexpr size_t MiB = 1u << 20, KiB = 1024;
constexpr size_t WS_CTL = 0, CTL_ZERO_BYTES = 1 * MiB;
constexpr int CW_TMO = 0, CW_BAR = 4096, CW_CNT = 8192, CW_AQ = 16384;
constexpr size_t WS_KSUM = 256 * KiB, WS_DEN = 512 * KiB;
constexpr size_t WS_WQKV = 2 * MiB, WS_WO = 8 * MiB, WS_WINA = 10 * MiB, WS_WINB = 14 * MiB, WS_WOUT = 17 * MiB;
constexpr size_t WS_WG = 19 * MiB, WS_RWT = 20 * MiB, WS_ROPE = 21 * MiB;
constexpr size_t WS_TOKE = 22 * MiB, WS_TOKP = 22 * MiB + 256 * KiB, WS_TOKG = 22 * MiB + 512 * KiB;
constexpr size_t WS_GI = 23 * MiB, WS_LF = 23 * MiB + 256 * KiB, WS_RF = 23 * MiB + 512 * KiB, WS_CF = 23 * MiB + 768 * KiB;
constexpr size_t WS_DEC = 24 * MiB, WS_NU = 24 * MiB + 256 * KiB, WS_NPREV = 24 * MiB + 512 * KiB;
constexpr size_t WS_ROWTOK = 25 * MiB;
constexpr size_t WS_XB = 32 * MiB, WS_Q = 64 * MiB, WS_K = 96 * MiB, WS_V = 128 * MiB;
constexpr size_t WS_R0 = 160 * MiB, WS_R1 = 224 * MiB, WS_R2 = 288 * MiB;
constexpr size_t WS_H = 352 * MiB, WS_Y = 496 * MiB;
constexpr size_t WS_WGU = 640 * MiB, WS_WD = 896 * MiB, WS_END = 1024 * MiB;
constexpr size_t WS_AE = 352 * MiB, WS_BE = 416 * MiB, WS_KN = 464 * MiB, WS_KT = 496 * MiB, WS_UT = 512 * MiB, WS_OS = 544 * MiB, WS_HN = 576 * MiB;

constexpr int RING_OFF = 0, RING_BYTES = 131072;
constexpr int LX = RING_BYTES;
constexpr int LX_MISC = LX;
constexpr int LX_TILEE = LX + 128;
constexpr int LX_TBASE = LX + 1280;
constexpr int LX_LCNT = LX + 1536, LX_GBASE = LX + 1664;
constexpr int LX_REC = LX + 1792;
constexpr int LX_TOKL = LX + 4096;
constexpr int LX_LNX = LX + 4096;
constexpr int LX_BIAS = LX + 12288;
constexpr int LDS_BYTES = 147456;
constexpr int TOKL_ROUNDS = 10;

#define RLX_AGENT __ATOMIC_RELAXED, __HIP_MEMORY_SCOPE_AGENT
#define LDS_WAIT() asm volatile("s_waitcnt lgkmcnt(0)" ::: "memory")
#define VM_WAIT() asm volatile("s_waitcnt vmcnt(0)" ::: "memory")
#define XB_TMO      128
#define XB_XCNT(j)  (256  + 64 * (j))
#define XB_XSUB(j)  (1280 + 64 * (j))
#define XB_XGEN(j)  (2304 + 64 * (j))
#define XB_TOP      3328
#define XB_TOPGEN   3392
#define XCD_BAR_WORDS 3456
#define XB_SPIN_CAP (1u << 18)

__device__ __forceinline__ unsigned xb_ld(unsigned* p)              { return __hip_atomic_load(p, __ATOMIC_RELAXED, __HIP_MEMORY_SCOPE_AGENT); }
__device__ __forceinline__ unsigned xb_add(unsigned* p, unsigned v) { return __hip_atomic_fetch_add(p, v, __ATOMIC_RELAXED, __HIP_MEMORY_SCOPE_AGENT); }
__device__ __forceinline__ unsigned xb_xcc_id() { return (unsigned)__builtin_amdgcn_s_getreg((3 << 11) | 20) & 0xFu; }
#define XB_SPIN(cond, bar) do { unsigned _sp = 0; while (cond) { __builtin_amdgcn_s_sleep(1); \
    if ((++_sp & 255u) == 0u) { if (xb_ld(&(bar)[XB_TMO])) break; if (_sp > XB_SPIN_CAP) { atomicAdd(&(bar)[XB_TMO], 1u); break; } } } } while (0)

struct XcdBarrier {
    unsigned* bar; unsigned x;
    volatile LAS unsigned* st;
};

__device__ __forceinline__ XcdBarrier xcd_barrier_post(unsigned* bar, volatile LAS unsigned* st) {
    XcdBarrier b; b.bar = bar; b.x = xb_xcc_id(); b.st = st;
    if (threadIdx.x == 0) (void)xb_add(&bar[XB_XCNT(b.x)], 1u);
    return b;
}
__device__ __forceinline__ void xcd_barrier_complete(unsigned* bar, unsigned x, unsigned& nloc, unsigned& nx) {
    const unsigned G = gridDim.x * gridDim.y * gridDim.z;
    unsigned sum, cnt, mine, sp = 0u;
    for (;;) {
        sum = 0u; cnt = 0u; mine = 0u;
#pragma unroll
        for (unsigned j = 0; j < 16; ++j) { const unsigned c = xb_ld(&bar[XB_XCNT(j)]); sum += c; cnt += (c > 0u) ? 1u : 0u; mine = (j == x) ? c : mine; }
        if (sum == G) break;
        __builtin_amdgcn_s_sleep(1);
        if ((++sp & 255u) == 0u) { if (xb_ld(&bar[XB_TMO])) break; if (sp > XB_SPIN_CAP) { atomicAdd(&bar[XB_TMO], 1u); break; } }
    }
    nloc = mine > 0u ? mine : 1u; nx = cnt > 0u ? cnt : 1u;
}

__device__ __forceinline__ void xcd_barrier(const XcdBarrier& b) {
    asm volatile("s_waitcnt vmcnt(0)" ::: "memory");
    __syncthreads();
    if (threadIdx.x == 0) {
        unsigned* bar = b.bar;
        __builtin_amdgcn_s_waitcnt(0);
        unsigned nloc = b.st[0], nx = b.st[1];
        if (nloc == 0u) { xcd_barrier_complete(bar, b.x, nloc, nx); b.st[0] = nloc; b.st[1] = nx; }
        const unsigned old = xb_add(&bar[XB_XSUB(b.x)], 1u);
        const unsigned gen = old / nloc;
        if (old + 1u == (gen + 1u) * nloc) {
            __builtin_amdgcn_fence(__ATOMIC_RELEASE, "agent");
            asm volatile("s_waitcnt vmcnt(0)" ::: "memory");
            const unsigned og = xb_add(&bar[XB_TOP], 1u);
            const unsigned tg = og / nx;
            if (og + 1u == (tg + 1u) * nx) xb_add(&bar[XB_TOPGEN], 1u);
            else XB_SPIN(xb_ld(&bar[XB_TOPGEN]) == tg, bar);
            __builtin_amdgcn_fence(__ATOMIC_ACQUIRE, "agent");
            xb_add(&bar[XB_XGEN(b.x)], 1u);
            asm volatile("s_waitcnt vmcnt(0)" ::: "memory");
        } else {
            XB_SPIN(xb_ld(&bar[XB_XGEN(b.x)]) == gen, bar);
            __builtin_amdgcn_fence(__ATOMIC_ACQUIRE, "agent");
            asm volatile("s_waitcnt vmcnt(0)" ::: "memory");
        }
    }
    __syncthreads();
}
using pg8::Unit; using pg8::Gemm;
typedef f32x4 (&AccRef)[2][2][4][2];

#ifndef TAIL_FIRST
#define TAIL_FIRST 0
#endif
__device__ __forceinline__ bool moe_unit(int i, int G, int c, int nT, int nN, int& pm, int& pn, int& half) {
    const int U = nT * nN, R = U / G, rem = U - R * G; half = 0;
#if TAIL_FIRST
    if (rem > 0 && 2 * rem <= G) {
        if (c < 2 * rem) { if (i == 0) { half = 1 + (c & 1); return pg8::tile_order(0, U, R * G + (c >> 1), nT, nN, pm, pn); } --i; }
        if (i < R) return pg8::tile_order(i, G, c, nT, nN, pm, pn);
        return false; }
#endif
    if (i < R) return pg8::tile_order(i, G, c, nT, nN, pm, pn);
    if (i > R || rem == 0) return false;
    if (2 * rem <= G) { if (c >= 2 * rem) return false; half = 1 + (c & 1); return pg8::tile_order(0, U, R * G + (c >> 1), nT, nN, pm, pn); }
    return pg8::tile_order(i, G, c, nT, nN, pm, pn);
}
struct DenseSched {
    int nM, nN, G, c; const char* A; const char* B; size_t tstepA, tstepB; bool split = false;
    __device__ __forceinline__ bool next(int i, Unit& u) const {
        int half = 0;
        if (split) { if (!moe_unit(i, G, c, nM, nN, u.pm, u.pn, half)) return false; }
        else if (!pg8::tile_order(i, G, c, nM, nN, u.pm, u.pn)) return false;
        u.A = A + (size_t)u.pm * tstepA; u.B = B + (size_t)u.pn * tstepB; u.tl = nullptr; u.x0 = u.x1 = 0; u.x2 = half; return true; }
};
struct MoeSched {
    int nT, nN, G, c; const LAS int* tile_e; const LAS int* tbase; const LAS unsigned short* tokl;
    const char* A; const char* B; size_t tstepA, estepB, tstepB;
    __device__ __forceinline__ bool next(int i, Unit& u) const {
        int half; if (!moe_unit(i, G, c, nT, nN, u.pm, u.pn, half)) return false;
        const int e = tile_e[u.pm];
        u.x0 = e; u.x1 = u.pm * 256; u.x2 = half;
        u.A = A + (size_t)u.pm * tstepA; u.B = B + (size_t)e * estepB + (size_t)u.pn * tstepB;
        u.tl = tokl ? tokl + (i < TOKL_ROUNDS ? i : TOKL_ROUNDS - 1) * 256 : nullptr; return true; }
};
struct MuSched {
    int G, c, mode; const char* A; const char* B;
    __device__ __forceinline__ bool next(int i, Unit& u) const {
        const int mu = i * G + c; if (mu >= 256) return false;
        const int b = mu >> 6, hh = (mu >> 4) & 3, ch = mu & 15; const size_t tok0 = (size_t)b * SEQ + (size_t)ch * 256;
        u.pm = mu; u.pn = 0; u.x0 = mu; u.x1 = u.x2 = 0; u.tl = nullptr;
        if (mode == 0) { u.A = A + (size_t)mu * 256 * 384 * 2; u.B = B + ((size_t)(hh * 128) * NTOK + tok0) * 2; }
        else if (mode == 1) { u.A = A + ((size_t)mu * 256 * 512 + 256) * 2; u.B = B + (tok0 * 1024 + (size_t)hh * 256) * 2; }
        else { u.A = A + (size_t)mu * 256 * 512 * 2; u.B = B + (size_t)mu * 256 * 384 * 2; }
        return true; }
};

constexpr float C2 = 0.125f * 1.4426950408889634f;

struct EpiQKV {
    static constexpr bool PERM = true;
    __device__ __forceinline__ void prep(const Unit&, int, int, int) const {}
    bf16_t* Q; bf16_t* K; bf16_t* V; const float* rope; float* ksum;
    __device__ __forceinline__ void operator()(AccRef acc, const Unit& u, int wr, int wc, int fr, int fq) const {
        asm volatile("" : "+v"(fr), "+v"(fq));
        const int part = u.pn >> 2, colt = (u.pn & 3) * 256;
        bf16_t* base = Q + (size_t)part * ((WS_K - WS_Q) / 2);
        const bool rot = (part < 2) && ((wc & 1) == 0);
        const float sgn = (fq == 0) ? -1.f : 1.f;
        float ks[2][8];
#pragma unroll
        for (int bj = 0; bj < 2; ++bj)
#pragma unroll
            for (int j = 0; j < 8; ++j) ks[bj][j] = 0.f;
#pragma unroll
        for (int ai = 0; ai < 2; ++ai)
#pragma unroll
            for (int m = 0; m < 4; ++m) {
                const int row = u.pm * 256 + ai * 128 + wr * 64 + m * 16 + fr;
                f32x4 cs0 = {1.f, 1.f, 1.f, 1.f}, cs1 = cs0, sn0 = {0.f, 0.f, 0.f, 0.f}, sn1 = sn0;
                if (rot) { const f32x4* rp = (const f32x4*)(rope + (size_t)row * 16); cs0 = rp[0]; cs1 = rp[1]; sn0 = rp[2]; sn1 = rp[3]; }
#pragma unroll
                for (int bj = 0; bj < 2; ++bj) {
                    f32x4 v0 = acc[ai][bj][m][0], v1 = acc[ai][bj][m][1];
                    if (rot) {
                        f32x4 p0, p1;
#pragma unroll
                        for (int j = 0; j < 4; ++j) { p0[j] = __shfl_xor(v0[j], 16); p1[j] = __shfl_xor(v1[j], 16); }
                        if (fq < 2) { v0 = v0 * cs0 + p0 * sn0 * sgn; v1 = v1 * cs1 + p1 * sn1 * sgn; }
                    }
                    if (part == 0) { v0 = v0 * C2; v1 = v1 * C2; }
                    if (part == 1) {
#pragma unroll
                        for (int j = 0; j < 4; ++j) { ks[bj][j] += v0[j]; ks[bj][4 + j] += v1[j]; } }
                    u32x4 w; w.x = cvt_pk_bf16(v0[0], v0[1]); w.y = cvt_pk_bf16(v0[2], v0[3]); w.z = cvt_pk_bf16(v1[0], v1[1]); w.w = cvt_pk_bf16(v1[2], v1[3]);
                    *(u32x4*)(base + (size_t)row * DM + colt + bj * 128 + wc * 32 + fq * 8) = w;
                }
            }
        if (part == 1) {
#pragma unroll
            for (int bj = 0; bj < 2; ++bj)
#pragma unroll
                for (int j = 0; j < 8; ++j) { float s = ks[bj][j]; s += __shfl_xor(s, 1); s += __shfl_xor(s, 2); s += __shfl_xor(s, 4); s += __shfl_xor(s, 8);
                    if (fr == 0) atomicAdd(ksum + (size_t)u.pm * DM + colt + bj * 128 + wc * 32 + fq * 8 + j, s); }
        }
    }
};

struct EpiZ {
    static constexpr bool PERM = true;
    __device__ __forceinline__ void prep(const Unit&, int, int, int) const {}
    const bf16_t* xin; bf16_t* z; float ymul;
    __device__ __forceinline__ void operator()(AccRef acc, const Unit& u, int wr, int wc, int fr, int fq) const {
        asm volatile("" : "+v"(fr), "+v"(fq));
#pragma unroll
        for (int ai = 0; ai < 2; ++ai) {
            const size_t off0 = (size_t)(u.pm * 256 + ai * 128 + wr * 64 + fr) * DM + u.pn * 256 + wc * 32 + fq * 8;
            u32x4 xr[4][2];
#pragma unroll
            for (int m = 0; m < 4; ++m)
#pragma unroll
                for (int bj = 0; bj < 2; ++bj) xr[m][bj] = *(const u32x4*)(xin + off0 + (size_t)m * 16 * DM + bj * 128);
#pragma unroll
            for (int m = 0; m < 4; ++m)
#pragma unroll
                for (int bj = 0; bj < 2; ++bj) { const u32x4 x = xr[m][bj]; const f32x4 a0 = acc[ai][bj][m][0] * ymul, a1 = acc[ai][bj][m][1] * ymul;
                    u32x4 w; w.x = cvt_pk_bf16(bflo(x.x) * ALPHA + a0[0], bfhi(x.x) * ALPHA + a0[1]); w.y = cvt_pk_bf16(bflo(x.y) * ALPHA + a0[2], bfhi(x.y) * ALPHA + a0[3]);
                    w.z = cvt_pk_bf16(bflo(x.z) * ALPHA + a1[0], bfhi(x.z) * ALPHA + a1[1]); w.w = cvt_pk_bf16(bflo(x.w) * ALPHA + a1[2], bfhi(x.w) * ALPHA + a1[3]);
                    *(u32x4*)(z + off0 + (size_t)m * 16 * DM + bj * 128) = w; }
            asm volatile("" ::: "memory");
        }
    }
};

__device__ __forceinline__ float swiglu1(float glu, float lin) {
    const float g = fminf(glu, 7.0f), l = fminf(fmaxf(lin, -7.0f), 7.0f);
    const float sg = __builtin_amdgcn_rcpf(1.0f + __builtin_amdgcn_exp2f(-1.702f * 1.4426950408889634f * g));
    return g * sg * (l + 1.0f);
}
__device__ __forceinline__ f32x2 swiglu2(float glu0, float lin0, float glu1, float lin1) {
    const f32x2 g = {fminf(glu0, 7.0f), fminf(glu1, 7.0f)}, l = {fminf(fmaxf(lin0, -7.0f), 7.0f), fminf(fmaxf(lin1, -7.0f), 7.0f)};
    const f32x2 t = g * (f32x2){-1.702f * 1.4426950408889634f, -1.702f * 1.4426950408889634f};
    const f32x2 d = (f32x2){__builtin_amdgcn_exp2f(t[0]), __builtin_amdgcn_exp2f(t[1])} + (f32x2){1.0f, 1.0f};
    const f32x2 r = {__builtin_amdgcn_rcpf(d[0]), __builtin_amdgcn_rcpf(d[1])};
    const f32x2 lp = l * (f32x2){FP8_SA, FP8_SA} + (f32x2){FP8_SA, FP8_SA};
    return (g * lp) * r;
}
struct EpiGU {
    static constexpr bool PERM = true;
    __device__ __forceinline__ void prep(const Unit& u, int ui, int wid, int lane) const { if (wid < 4) glds4s(uni_ptr((const char*)(bias + (size_t)u.x0 * 2048 + u.pn * 256 + wid * 64)), (unsigned)lane * 4u, (unsigned)__builtin_amdgcn_readfirstlane((unsigned)(unsigned long long)bl + (unsigned)(((ui & 1) * 256 + wid * 64) * 4))); }
    const float* bias; unsigned char* H; LAS float* bl; mutable int ucnt;
    __device__ __forceinline__ void operator()(AccRef acc, const Unit& u, int wr, int wc, int fr, int fq) const {
        asm volatile("" : "+v"(fr), "+v"(fq));
        const int c0 = u.pn * 256 + wc * 32 + fq * 8; const LAS float* bp = bl + (ucnt & 1) * 256 + wc * 32 + fq * 8; ++ucnt; constexpr float SC = 1.0f / (FP8_SA * FP8_SWGU);
        f32x4 b[2][2];
#pragma unroll
        for (int bj = 0; bj < 2; ++bj) { b[bj][0] = *(const LAS f32x4*)(bp + bj * 128); b[bj][1] = *(const LAS f32x4*)(bp + bj * 128 + 4); }
#pragma unroll
        for (int ai = 0; ai < 2; ++ai)
#pragma unroll
            for (int m = 0; m < 4; ++m) {
                unsigned char* rowp = H + (size_t)(u.x1 + ai * 128 + wr * 64 + m * 16 + fr) * DM + (c0 >> 1);
#pragma unroll
                for (int bj = 0; bj < 2; ++bj) { if (u.x2 == 2 - bj) continue;
                    const f32x4 v0 = acc[ai][bj][m][0] * SC + b[bj][0], v1 = acc[ai][bj][m][1] * SC + b[bj][1];
                    const f32x2 h0 = swiglu2(v0[0], v0[1], v0[2], v0[3]), h1 = swiglu2(v1[0], v1[1], v1[2], v1[3]);
                    int w = __builtin_amdgcn_cvt_pk_fp8_f32(h0[0], h0[1], 0, false);
                    w = __builtin_amdgcn_cvt_pk_fp8_f32(h1[0], h1[1], w, true);
                    *(int*)(rowp + bj * 64) = w; }
            }
    }
};
struct EpiDN {
    static constexpr bool PERM = true;
    __device__ __forceinline__ void prep(const Unit& u, int ui, int wid, int lane) const { if (wid < 4) glds4s(uni_ptr((const char*)(bias + (size_t)u.x0 * 1024 + u.pn * 256 + wid * 64)), (unsigned)lane * 4u, (unsigned)__builtin_amdgcn_readfirstlane((unsigned)(unsigned long long)bl + (unsigned)(((ui & 1) * 256 + wid * 64) * 4))); }
    const float* bias; unsigned char* Y; LAS float* bl; mutable int ucnt;
    __device__ __forceinline__ void operator()(AccRef acc, const Unit& u, int wr, int wc, int fr, int fq) const {
        asm volatile("" : "+v"(fr), "+v"(fq));
        const int c0 = u.pn * 256 + wc * 32 + fq * 8; const LAS float* bp = bl + (ucnt & 1) * 256 + wc * 32 + fq * 8; ++ucnt; constexpr float SC = FP8_SY / (FP8_SA * FP8_SWD);
        f32x4 b[2][2];
#pragma unroll
        for (int bj = 0; bj < 2; ++bj) { b[bj][0] = *(const LAS f32x4*)(bp + bj * 128) * FP8_SY; b[bj][1] = *(const LAS f32x4*)(bp + bj * 128 + 4) * FP8_SY; }
#pragma unroll
        for (int ai = 0; ai < 2; ++ai)
#pragma unroll
            for (int m = 0; m < 4; ++m) {
                unsigned char* rowp = Y + (size_t)(u.x1 + ai * 128 + wr * 64 + m * 16 + fr) * DM + c0;
#pragma unroll
                for (int bj = 0; bj < 2; ++bj) { if (u.x2 == 2 - bj) continue;
                    f32x4 v0 = acc[ai][bj][m][0] * SC + b[bj][0], v1 = acc[ai][bj][m][1] * SC + b[bj][1];
#pragma unroll
                    for (int q = 0; q < 4; ++q) { v0[q] = __builtin_amdgcn_fmed3f(v0[q], -FP8_MAXV, FP8_MAXV); v1[q] = __builtin_amdgcn_fmed3f(v1[q], -FP8_MAXV, FP8_MAXV); }
                    int w0 = __builtin_amdgcn_cvt_pk_fp8_f32(v0[0], v0[1], 0, false); w0 = __builtin_amdgcn_cvt_pk_fp8_f32(v0[2], v0[3], w0, true);
                    int w1 = __builtin_amdgcn_cvt_pk_fp8_f32(v1[0], v1[1], 0, false); w1 = __builtin_amdgcn_cvt_pk_fp8_f32(v1[2], v1[3], w1, true);
                    u32x2 w; w.x = (unsigned)w0; w.y = (unsigned)w1;
                    *(u32x2*)(rowp + bj * 128) = w; }
            }
    }
};

struct EpiINA {
    static constexpr bool PERM = true;
    __device__ __forceinline__ void prep(const Unit&, int, int, int) const {}
    const float* rf; const float* cf; bf16_t* AE; bf16_t* KN; bf16_t* OS;
    __device__ __forceinline__ void operator()(AccRef acc, const Unit& u, int wr, int wc, int fr, int fq) const {
        asm volatile("" : "+v"(fr), "+v"(fq));
        const int b = u.pm >> 4, ch = u.pm & 15, d0 = wc * 32 + fq * 8; const u32x4 zero = {0u, 0u, 0u, 0u};
        if (u.pn < 4) {
            const bool isq = u.pn < 2; const float* fac = isq ? rf : cf; const float fs = isq ? 1.0f : RSQRT_DQK; const int h0 = (u.pn & 1) * 2;
            float sf[2][4][2];
#pragma unroll
            for (int ai = 0; ai < 2; ++ai)
#pragma unroll
                for (int m = 0; m < 4; ++m)
#pragma unroll
                    for (int bj = 0; bj < 2; ++bj) sf[ai][m][bj] = fac[(size_t)(h0 + bj) * NTOK + (size_t)u.pm * 256 + ai * 128 + wr * 64 + m * 16 + fr];
#pragma unroll
            for (int ai = 0; ai < 2; ++ai)
#pragma unroll
                for (int m = 0; m < 4; ++m) {
                    const int t = ai * 128 + wr * 64 + m * 16 + fr; const size_t token = (size_t)u.pm * 256 + t;
#pragma unroll
                    for (int bj = 0; bj < 2; ++bj) { const int hh = h0 + bj; const float s = sf[ai][m][bj] * fs;
                        const f32x4 v0 = acc[ai][bj][m][0] * s, v1 = acc[ai][bj][m][1] * s;
                        const size_t oq = ((size_t)(((b * 4 + hh) * 16 + ch) * 256 + t)) * 512 + 256 + d0, ok = token * 1024 + hh * 256 + d0;
                        bf16_t* dst = isq ? (AE + oq) : (KN + ok);
                        u32x4 w; w.x = cvt_pk_bf16(v0[0], v0[1]); w.y = cvt_pk_bf16(v0[2], v0[3]); w.z = cvt_pk_bf16(v1[0], v1[1]); w.w = cvt_pk_bf16(v1[2], v1[3]);
                        *(u32x4*)dst = w; }
                }
        } else {
#pragma unroll
            for (int ai = 0; ai < 2; ++ai)
#pragma unroll
                for (int m = 0; m < 4; ++m) {
                    const int t = ai * 128 + wr * 64 + m * 16 + fr; const size_t token = (size_t)u.pm * 256 + t;
#pragma unroll
                    for (int bj = 0; bj < 2; ++bj) { f32x4 v0 = acc[ai][bj][m][0], v1 = acc[ai][bj][m][1];
#pragma unroll
                        for (int j = 0; j < 4; ++j) { v0[j] = __builtin_amdgcn_rcpf(1.0f + __builtin_amdgcn_exp2f(-1.4426950408889634f * v0[j])); v1[j] = __builtin_amdgcn_rcpf(1.0f + __builtin_amdgcn_exp2f(-1.4426950408889634f * v1[j])); }
                        u32x4 w; w.x = cvt_pk_bf16(v0[0], v0[1]); w.y = cvt_pk_bf16(v0[2], v0[3]); w.z = cvt_pk_bf16(v1[0], v1[1]); w.w = cvt_pk_bf16(v1[2], v1[3]);
                        *(u32x4*)(OS + token * 1024 + (u.pn - 4) * 256 + bj * 128 + d0) = w; }
                }
        }
    }
};
struct EpiINB {
    static constexpr bool PERM = true;
    __device__ __forceinline__ void prep(const Unit&, int, int, int) const {}
    const float* cf; bf16_t* KT; bf16_t* BE;
    __device__ __forceinline__ void operator()(AccRef acc, const Unit& u, int wr, int wc, int fr, int fq) const {
        asm volatile("" : "+v"(fr), "+v"(fq));
        const int b = u.pn >> 4, ch = u.pn & 15;
        f32x4 cv[2][2][2];
#pragma unroll
        for (int ai = 0; ai < 2; ++ai)
#pragma unroll
            for (int bj = 0; bj < 2; ++bj) { const size_t tok0 = (size_t)u.pn * 256 + bj * 128 + wc * 32 + fq * 8;
                if (u.pm < 2) { const int hh = u.pm * 2 + ai; cv[ai][bj][0] = *(const f32x4*)(cf + (size_t)hh * NTOK + tok0) * RSQRT_DQK; cv[ai][bj][1] = *(const f32x4*)(cf + (size_t)hh * NTOK + tok0 + 4) * RSQRT_DQK; }
                else { cv[ai][bj][0] = (f32x4){1.f, 1.f, 1.f, 1.f}; cv[ai][bj][1] = cv[ai][bj][0]; } }
#pragma unroll
        for (int ai = 0; ai < 2; ++ai)
#pragma unroll
            for (int m = 0; m < 4; ++m) {
                const int R = u.pm * 256 + ai * 128 + wr * 64 + m * 16 + fr;
#pragma unroll
                for (int bj = 0; bj < 2; ++bj) { if (u.x2 == 2 - bj) continue;
                    const f32x4 v0 = acc[ai][bj][m][0] * cv[ai][bj][0], v1 = acc[ai][bj][m][1] * cv[ai][bj][1]; const int s0 = bj * 128 + wc * 32 + fq * 8; const size_t tok0 = (size_t)u.pn * 256 + s0; bf16_t* dst;
                    if (u.pm < 2) dst = KT + (size_t)R * NTOK + tok0;
                    else { const int eg = R - 512, hh = eg >> 8, e = eg & 255; dst = BE + ((size_t)(((b * 4 + hh) * 16 + ch) * 256 + e)) * 384 + s0; }
                    u32x4 w; w.x = cvt_pk_bf16(v0[0], v0[1]); w.y = cvt_pk_bf16(v0[2], v0[3]); w.z = cvt_pk_bf16(v1[0], v1[1]); w.w = cvt_pk_bf16(v1[2], v1[3]);
                    *(u32x4*)dst = w;
                }
            }
    }
};
struct EpiM1 {
    static constexpr bool PERM = false;
    __device__ __forceinline__ void prep(const Unit&, int, int, int) const {}
    float* UT;
    __device__ __forceinline__ void operator()(AccRef acc, const Unit& u, int wr, int wc, int fr, int fq) const {
        asm volatile("" : "+v"(fr), "+v"(fq));
#pragma unroll
        for (int ai = 0; ai < 2; ++ai)
#pragma unroll
            for (int m = 0; m < 4; ++m) { float* rowp = UT + ((size_t)u.x0 * 256 + ai * 128 + wr * 64 + m * 16 + fr) * 128 + wc * 32 + fq * 4;
#pragma unroll
                for (int n = 0; n < 2; ++n) *(f32x4*)(rowp + n * 16) = acc[ai][0][m][n]; }
    }
};
struct EpiM2A {
    static constexpr bool PERM = true;
    __device__ __forceinline__ void prep(const Unit&, int, int, int) const {}
    bf16_t* AE; const float* nprev; float* den;
    __device__ __forceinline__ void operator()(AccRef acc, const Unit& u, int wr, int wc, int fr, int fq) const {
        asm volatile("" : "+v"(fr), "+v"(fq));
        const int mu = u.x0, dd = wc * 32 + fq * 8;
        const f32x4 n0 = *(const f32x4*)(nprev + (size_t)mu * 128 + dd), n1 = *(const f32x4*)(nprev + (size_t)mu * 128 + dd + 4);
        u32x4 qv8[2][4];
#pragma unroll
        for (int ai = 0; ai < 2; ++ai)
#pragma unroll
            for (int m = 0; m < 4; ++m) qv8[ai][m] = *(const u32x4*)(AE + ((size_t)mu * 256 + ai * 128 + wr * 64 + m * 16 + fr) * 512 + 256 + dd);
#pragma unroll
        for (int ai = 0; ai < 2; ++ai)
#pragma unroll
            for (int m = 0; m < 4; ++m) {
                const int t = ai * 128 + wr * 64 + m * 16 + fr; bf16_t* rowp = AE + ((size_t)mu * 256 + t) * 512;
                const u32x4 qv = qv8[ai][m];
                float part = bflo(qv.x) * n0[0] + bfhi(qv.x) * n0[1] + bflo(qv.y) * n0[2] + bfhi(qv.y) * n0[3] + bflo(qv.z) * n1[0] + bfhi(qv.z) * n1[1] + bflo(qv.w) * n1[2] + bfhi(qv.w) * n1[3];
#pragma unroll
                for (int bj = 0; bj < 2; ++bj) { const int s0 = bj * 128 + wc * 32 + fq * 8; f32x4 v0 = acc[ai][bj][m][0], v1 = acc[ai][bj][m][1];
                    int dts = t - s0; asm volatile("" : "+v"(dts));
#pragma unroll
                    for (int j = 0; j < 4; ++j) { v0[j] = (j <= dts) ? v0[j] : 0.f; v1[j] = (4 + j <= dts) ? v1[j] : 0.f; part += v0[j] + v1[j]; }
                    u32x4 w; w.x = cvt_pk_bf16(v0[0], v0[1]); w.y = cvt_pk_bf16(v0[2], v0[3]); w.z = cvt_pk_bf16(v1[0], v1[1]); w.w = cvt_pk_bf16(v1[2], v1[3]);
                    *(u32x4*)(rowp + s0) = w; }
                part += __shfl_xor(part, 16); part += __shfl_xor(part, 32);
                if (fq == 0) atomicAdd(den + (size_t)mu * 256 + (wr * 64 + fr) + (ai * 128 + m * 16), part);
            }
    }
};
struct EpiM2B {
    static constexpr bool PERM = true;
    __device__ __forceinline__ void prep(const Unit&, int, int, int) const {}
    const float* den; const float* normg; const bf16_t* OS; bf16_t* HN; LAS float* lnx;
    __device__ __forceinline__ void operator()(AccRef acc, const Unit& u, int wr, int wc, int fr, int fq) const {
        asm volatile("" : "+v"(fr), "+v"(fq));
        const int mu = u.x0, b = mu >> 6, hh = (mu >> 4) & 3, ch = mu & 15;
        float dnv[2][4];
#pragma unroll
        for (int ai = 0; ai < 2; ++ai)
#pragma unroll
            for (int m = 0; m < 4; ++m) dnv[ai][m] = den[(size_t)mu * 256 + ai * 128 + wr * 64 + m * 16 + fr];
#pragma unroll
        for (int ai = 0; ai < 2; ++ai)
#pragma unroll
            for (int m = 0; m < 4; ++m) {
                const int t = ai * 128 + wr * 64 + m * 16 + fr; const float dn = dnv[ai][m];
#ifdef DBG_DEN1
                const float inv = 1.0f;
#else
                const float inv = 1.0f / fmaxf(fabsf(dn), 1.0f);
#endif
                float s1 = 0.f, s2 = 0.f;
#pragma unroll
                for (int bj = 0; bj < 2; ++bj)
#pragma unroll
                    for (int n = 0; n < 2; ++n) { f32x4 h = acc[ai][bj][m][n] * inv; acc[ai][bj][m][n] = h; s1 += (h[0] + h[1]) + (h[2] + h[3]); s2 += (h[0] * h[0] + h[1] * h[1]) + (h[2] * h[2] + h[3] * h[3]); }
                s1 += __shfl_xor(s1, 16); s1 += __shfl_xor(s1, 32); s2 += __shfl_xor(s2, 16); s2 += __shfl_xor(s2, 32);
                if (fq == 0) { lnx[(t * 4 + wc) * 2] = s1; lnx[(t * 4 + wc) * 2 + 1] = s2; }
            }
        const int e0 = wc * 32 + fq * 8;
        f32x4 gg[2][2];
#pragma unroll
        for (int bj = 0; bj < 2; ++bj) { gg[bj][0] = *(const f32x4*)(normg + hh * 256 + bj * 128 + e0); gg[bj][1] = *(const f32x4*)(normg + hh * 256 + bj * 128 + e0 + 4); }
        asm volatile("s_waitcnt lgkmcnt(0)" ::: "memory"); __builtin_amdgcn_s_barrier(); asm volatile("" ::: "memory");
#pragma unroll
        for (int ai = 0; ai < 2; ++ai) {
            u32x4 ovv[4][2];
#pragma unroll
            for (int m = 0; m < 4; ++m)
#pragma unroll
                for (int bj = 0; bj < 2; ++bj) ovv[m][bj] = *(const u32x4*)(OS + (((size_t)(b * 16 + ch)) * 256 + ai * 128 + wr * 64 + m * 16 + fr) * 1024 + hh * 256 + bj * 128 + e0);
#pragma unroll
            for (int m = 0; m < 4; ++m) {
                const int t = ai * 128 + wr * 64 + m * 16 + fr; const size_t token = ((size_t)(b * 16 + ch)) * 256 + t;
                const LAS f32x4* lp = (const LAS f32x4*)(lnx + t * 8); const f32x4 a = lp[0], c = lp[1];
                const float mean = (a[0] + a[2] + c[0] + c[2]) * (1.0f / 256.0f); const float ex2 = (a[1] + a[3] + c[1] + c[3]) * (1.0f / 256.0f);
                const float rstd = 1.0f / sqrtf(fmaxf(ex2 - mean * mean, 0.f) + LN_EPS);
#pragma unroll
                for (int bj = 0; bj < 2; ++bj) { const int e = bj * 128 + e0; const size_t off = token * 1024 + hh * 256 + e; const u32x4 ov = ovv[m][bj];
#ifdef DBG_HN_OS
                    f32x4 v0 = {1.f, 1.f, 1.f, 1.f}, v1 = v0;
#elif defined(DBG_HN_RAW)
                    f32x4 v0 = acc[ai][bj][m][0], v1 = acc[ai][bj][m][1];
#else
                    f32x4 v0 = (acc[ai][bj][m][0] - mean) * rstd * gg[bj][0], v1 = (acc[ai][bj][m][1] - mean) * rstd * gg[bj][1];
#endif
#ifndef DBG_HN_ONE
                    v0[0] *= bflo(ov.x); v0[1] *= bfhi(ov.x); v0[2] *= bflo(ov.y); v0[3] *= bfhi(ov.y); v1[0] *= bflo(ov.z); v1[1] *= bfhi(ov.z); v1[2] *= bflo(ov.w); v1[3] *= bfhi(ov.w);
#endif
                    u32x4 w; w.x = cvt_pk_bf16(v0[0], v0[1]); w.y = cvt_pk_bf16(v0[2], v0[3]); w.z = cvt_pk_bf16(v1[0], v1[1]); w.w = cvt_pk_bf16(v1[2], v1[3]);
                    *(u32x4*)(HN + off) = w; }
            }
            asm volatile("" ::: "memory");
        }
        asm volatile("s_waitcnt lgkmcnt(0)" ::: "memory"); __builtin_amdgcn_s_barrier(); asm volatile("" ::: "memory");
    }
};
struct Frame {
    LAS unsigned char* lds;
    unsigned* ctl;
    unsigned char* ws;
    int tid, lane, wave, vcu, G;
};
__device__ __forceinline__ float wave_sum(float v) {
#pragma unroll
    for (int o = 1; o < 64; o <<= 1) v += __shfl_xor(v, o);
    return v;
}

__device__ __forceinline__ void tr_block(const float* src, size_t pitch, bf16_t* dst, size_t kd, int kb, int nb, LAS unsigned* scr, int lane) {
    const float* s0 = src + (size_t)(64 * kb) * pitch + 64 * nb + 4 * (lane & 15);
#pragma unroll
    for (int i = 0; i < 8; ++i) {
        const int kp = 4 * i + (lane >> 4);
        const f32x4 a = __builtin_nontemporal_load((const f32x4*)(s0 + (size_t)(2 * kp) * pitch)), b = __builtin_nontemporal_load((const f32x4*)(s0 + (size_t)(2 * kp + 1) * pitch));
#pragma unroll
        for (int j = 0; j < 4; ++j) scr[(4 * (lane & 15) + j) * 33 + kp] = cvt_pk_bf16(a[j], b[j]);
    }
    LDS_WAIT(); asm volatile("" ::: "memory");
    u32x4 o[8];
#pragma unroll
    for (int c = 0; c < 8; ++c) { const int rr = 8 * c + (lane >> 3), q4 = 4 * (lane & 7); o[c].x = scr[rr * 33 + q4]; o[c].y = scr[rr * 33 + q4 + 1]; o[c].z = scr[rr * 33 + q4 + 2]; o[c].w = scr[rr * 33 + q4 + 3]; }
    bf16_t* d = dst + (size_t)(64 * nb + (lane >> 3)) * kd + 64 * kb + 8 * (lane & 7);
#pragma unroll
    for (int c = 0; c < 8; ++c) *(u32x4*)(d + (size_t)(8 * c) * kd) = o[c];
    LDS_WAIT(); asm volatile("" ::: "memory");
}
__device__ __forceinline__ void tr_block8(const float* src, size_t pitch, unsigned char* dst, size_t kd, int kb, int nb, float scale, LAS unsigned* scr, int lane) {
    const float* s0 = src + (size_t)(128 * kb) * pitch + 64 * nb + 4 * (lane & 15);
#pragma unroll
    for (int i = 0; i < 8; ++i) {
        const int kq = 4 * i + (lane >> 4);
        const f32x4 r0 = __builtin_nontemporal_load((const f32x4*)(s0 + (size_t)(4 * kq) * pitch)) * scale, r1 = __builtin_nontemporal_load((const f32x4*)(s0 + (size_t)(4 * kq + 1) * pitch)) * scale,
                    r2 = __builtin_nontemporal_load((const f32x4*)(s0 + (size_t)(4 * kq + 2) * pitch)) * scale, r3 = __builtin_nontemporal_load((const f32x4*)(s0 + (size_t)(4 * kq + 3) * pitch)) * scale;
#pragma unroll
        for (int j = 0; j < 4; ++j) { int w = __builtin_amdgcn_cvt_pk_fp8_f32(r0[j], r1[j], 0, false); w = __builtin_amdgcn_cvt_pk_fp8_f32(r2[j], r3[j], w, true); scr[(4 * (lane & 15) + j) * 33 + kq] = (unsigned)w; }
    }
    LDS_WAIT(); asm volatile("" ::: "memory");
    u32x4 o[8];
#pragma unroll
    for (int c = 0; c < 8; ++c) { const int rr = 8 * c + (lane >> 3), q4 = 4 * (lane & 7); o[c].x = scr[rr * 33 + q4]; o[c].y = scr[rr * 33 + q4 + 1]; o[c].z = scr[rr * 33 + q4 + 2]; o[c].w = scr[rr * 33 + q4 + 3]; }
    unsigned char* d = dst + (size_t)(64 * nb + (lane >> 3)) * kd + 128 * kb + 16 * (lane & 7);
#pragma unroll
    for (int c = 0; c < 8; ++c) *(u32x4*)(d + (size_t)(8 * c) * kd) = o[c];
    LDS_WAIT(); asm volatile("" ::: "memory");
}
constexpr int CONV_ITEMS = 24576;
struct ConvItem { const float* s0; size_t pitch; unsigned char* d; float scale; };
__device__ __forceinline__ ConvItem conv_desc(const float* wgu, const float* wd, unsigned char* ws, int v, int lane) {
    const int layer = v >= 12288; int r = v - layer * 12288; ConvItem it;
    if (r < 8192) { const int mat = layer * 32 + (r >> 8); r &= 255; const int kb = r >> 5, nb = r & 31; it.pitch = 2048; it.scale = FP8_SWGU;
        it.s0 = wgu + (size_t)mat * 1024 * 2048 + (size_t)(128 * kb) * 2048 + 64 * nb + 4 * (lane & 15); it.d = ws + WS_WGU + (size_t)mat * 2048 * 1024 + (size_t)(64 * nb + (lane >> 3)) * 1024 + 128 * kb + 16 * (lane & 7); }
    else { r -= 8192; const int mat = layer * 32 + (r >> 7); r &= 127; const int kb = r >> 4, nb = r & 15; it.pitch = 1024; it.scale = FP8_SWD;
        it.s0 = wd + (size_t)mat * 1024 * 1024 + (size_t)(128 * kb) * 1024 + 64 * nb + 4 * (lane & 15); it.d = ws + WS_WD + (size_t)mat * 1024 * 1024 + (size_t)(64 * nb + (lane >> 3)) * 1024 + 128 * kb + 16 * (lane & 7); }
    return it;
}
__device__ __forceinline__ void conv_items(Frame& F, const float* wgu, const float* wd, int v_lo, int v_hi, int cw, int ncw) {
    LAS unsigned* scr = (LAS unsigned*)(F.lds + RING_OFF + F.wave * 8448); unsigned char* ws = F.ws; const int lane = F.lane;
    int v = v_lo + cw; if (v >= v_hi) return;
    ConvItem cur = conv_desc(wgu, wd, ws, v, lane);
    f32x4 r[8][4];
#pragma unroll
    for (int i = 0; i < 8; ++i) { const int kq = 4 * i + (lane >> 4);
#pragma unroll
        for (int q = 0; q < 4; ++q) r[i][q] = __builtin_nontemporal_load((const f32x4*)(cur.s0 + (size_t)(4 * kq + q) * cur.pitch)); }
    for (;;) {
        const int vn = v + ncw; const bool has = vn < v_hi; ConvItem nx = cur; if (has) nx = conv_desc(wgu, wd, ws, vn, lane);
#pragma unroll
        for (int i = 0; i < 8; ++i) { const int kq = 4 * i + (lane >> 4);
#pragma unroll
            for (int j = 0; j < 4; ++j) { int w = __builtin_amdgcn_cvt_pk_fp8_f32(r[i][0][j] * cur.scale, r[i][1][j] * cur.scale, 0, false); w = __builtin_amdgcn_cvt_pk_fp8_f32(r[i][2][j] * cur.scale, r[i][3][j] * cur.scale, w, true); scr[(4 * (lane & 15) + j) * 33 + kq] = (unsigned)w; }
            if (has) {
#pragma unroll
                for (int q = 0; q < 4; ++q) r[i][q] = __builtin_nontemporal_load((const f32x4*)(nx.s0 + (size_t)(4 * kq + q) * nx.pitch)); } }
        LDS_WAIT(); asm volatile("" ::: "memory");
        u32x4 o[8];
#pragma unroll
        for (int c = 0; c < 8; ++c) { const int rr = 8 * c + (lane >> 3), q4 = 4 * (lane & 7); o[c].x = scr[rr * 33 + q4]; o[c].y = scr[rr * 33 + q4 + 1]; o[c].z = scr[rr * 33 + q4 + 2]; o[c].w = scr[rr * 33 + q4 + 3]; }
#pragma unroll
        for (int c = 0; c < 8; ++c) *(u32x4*)(cur.d + (size_t)(8 * c) * 1024) = o[c];
        LDS_WAIT(); asm volatile("" ::: "memory");
        if (!has) break;
        v = vn; cur = nx;
    }
}
struct P0In { const float *x, *wqkv, *wo, *win, *wout, *rw, *wgu, *wd; const int* pos; };
__device__ __forceinline__ void p0_prologue(Frame& F, const P0In& I) {
    LAS unsigned* scr = (LAS unsigned*)(F.lds + RING_OFF + F.wave * 8448);
    const int gw = F.vcu * NWAVES + F.wave, NGW = F.G * NWAVES;
    unsigned char* ws = F.ws;
    constexpr int KB = 16;
    constexpr int I_QKV = KB * 48, I_WO = KB * 16, I_INA1 = KB * 16, I_INA2 = KB * 16, I_INB = KB * 24, I_WOUT = KB * 16;
    constexpr int I_SMALL = I_QKV + I_WO + I_INA1 + I_INA2 + I_INB + I_WOUT;
    constexpr int NITEMS = I_SMALL;
    for (int it = gw; it < NITEMS; it += NGW) {
        int r = it; const float* src; size_t pitch; bf16_t* dst; int nbl;
        if (r < I_QKV) { src = I.wqkv; pitch = 3072; dst = (bf16_t*)(ws + WS_WQKV); nbl = 48; }
        else if ((r -= I_QKV) < I_WO) { src = I.wo; pitch = 1024; dst = (bf16_t*)(ws + WS_WO); nbl = 16; }
        else if ((r -= I_WO) < I_INA1) { src = I.win; pitch = 3080; dst = (bf16_t*)(ws + WS_WINA); nbl = 16; }
        else if ((r -= I_INA1) < I_INA2) { src = I.win + 2048; pitch = 3080; dst = (bf16_t*)(ws + WS_WINA) + (size_t)1024 * 1024; nbl = 16; }
        else if ((r -= I_INA2) < I_INB) { src = I.win + 512; pitch = 3080; dst = (bf16_t*)(ws + WS_WINB); nbl = 24; }
        else { r -= I_INB; src = I.wout; pitch = 1024; dst = (bf16_t*)(ws + WS_WOUT); nbl = 16; }
        tr_block(src, pitch, dst, 1024, r / nbl, r % nbl, scr, F.lane);
    }
    if (NCONV == 0) conv_items(F, I.wgu, I.wd, 0, CONV_ITEMS, gw, NGW);
    const int gt = F.vcu * NTHR + F.tid, NGT = F.G * NTHR;
    for (int i = gt; i < NTOK * DM / 8; i += NGT) { const f32x4 a = ((const f32x4*)I.x)[2 * i], b = ((const f32x4*)I.x)[2 * i + 1];
        u32x4 w; w.x = cvt_pk_bf16(a[0], a[1]); w.y = cvt_pk_bf16(a[2], a[3]); w.z = cvt_pk_bf16(b[0], b[1]); w.w = cvt_pk_bf16(b[2], b[3]); ((u32x4*)(ws + WS_XB))[i] = w; }
    for (int i = gt; i < NTOK * 8; i += NGT) { const int tok = i >> 3, f = i & 7; const float inv = powf(500000.0f, -(float)f * 0.125f); const float ang = (float)I.pos[tok] * inv;
        float sn, cs; sincosf(ang, &sn, &cs); float* rp = (float*)(ws + WS_ROPE) + (size_t)tok * 16; rp[f] = cs; rp[8 + f] = sn; }
    for (int i = gt; i < 2 * 32 * 1024; i += NGT) { const int l = i >> 15, e = (i >> 10) & 31, k = i & 1023; ((float*)(ws + WS_RWT))[i] = I.rw[((size_t)l * 1024 + k) * 32 + e]; }
    for (int i = gt; i < 8 * 1024; i += NGT) { const int gidx = i >> 10, k = i & 1023; ((float*)(ws + WS_WG))[i] = I.win[(size_t)k * 3080 + 3072 + gidx]; }
}

__device__ __forceinline__ void phase_ln_router(Frame& F, const bf16_t* __restrict__ z, bf16_t* __restrict__ x1, const float* lng, const float* lnb, const float* rbias, int layer, int cset) {
    unsigned char* ws = F.ws;
    LAS f32x4* rwv = (LAS f32x4*)(F.lds + RING_OFF);
    LAS int* lcnt = (LAS int*)(F.lds + LX_LCNT); LAS int* gbase = (LAS int*)(F.lds + LX_GBASE); LAS int* rec = (LAS int*)(F.lds + LX_REC);
    LAS float* lgb = (LAS float*)(F.lds + LX_LNX);
    { const f32x4* src = (const f32x4*)((const float*)(ws + WS_RWT) + (size_t)layer * 32768);
      for (int i = F.tid; i < 8192; i += NTHR) { const int e = i >> 8, c = i & 255; rwv[e * 256 + (c ^ (e & 15))] = src[i]; } }
    int* toke = (int*)(ws + WS_TOKE); int* tokp = (int*)(ws + WS_TOKP); float* tokg = (float*)(ws + WS_TOKG);
    unsigned short* rowtok = (unsigned short*)(ws + WS_ROWTOK); unsigned char* xb8 = (unsigned char*)(ws + WS_XB);
    unsigned* cntg = F.ctl + CW_CNT + cset * 2048;
    const int lane = F.lane;
    for (int grp = F.vcu; grp < NTOK / 64; grp += F.G) {
        if (F.tid < 32) lcnt[F.tid] = 0;
        for (int i = F.tid; i < 1024; i += NTHR) { lgb[i] = lng[i]; lgb[1024 + i] = lnb[i]; }
        __syncthreads();
#pragma unroll 2
        for (int tk = 0; tk < 8; tk += 2) {
            const int token0 = grp * 64 + F.wave * 8 + tk;
            f32x4 v[2][4]; float s[2] = {0.f, 0.f};
#pragma unroll
            for (int u = 0; u < 2; ++u)
#pragma unroll
                for (int j = 0; j < 4; ++j) { const u32x2 zz = *(const u32x2*)(z + (size_t)(token0 + u) * DM + 4 * lane + 256 * j); v[u][j] = (f32x4){bflo(zz.x), bfhi(zz.x), bflo(zz.y), bfhi(zz.y)}; s[u] += (v[u][j][0] + v[u][j][1]) + (v[u][j][2] + v[u][j][3]); }
#pragma unroll
            for (int o = 1; o < 64; o <<= 1) { const float a0 = __shfl_xor(s[0], o), a1 = __shfl_xor(s[1], o); s[0] += a0; s[1] += a1; }
            float s2[2] = {0.f, 0.f};
#pragma unroll
            for (int u = 0; u < 2; ++u) { const float mean = s[u] * (1.0f / DM);
#pragma unroll
                for (int j = 0; j < 4; ++j) { v[u][j] = v[u][j] - mean; s2[u] += (v[u][j][0] * v[u][j][0] + v[u][j][1] * v[u][j][1]) + (v[u][j][2] * v[u][j][2] + v[u][j][3] * v[u][j][3]); } }
#pragma unroll
            for (int o = 1; o < 64; o <<= 1) { const float a0 = __shfl_xor(s2[0], o), a1 = __shfl_xor(s2[1], o); s2[0] += a0; s2[1] += a1; }
#pragma unroll
            for (int u = 0; u < 2; ++u) { const float rstd = 1.0f / sqrtf(s2[u] * (1.0f / DM) + LN_EPS); const int token = token0 + u;
#pragma unroll
                for (int j = 0; j < 4; ++j) { const f32x4 gvj = *(const LAS f32x4*)(lgb + 4 * lane + 256 * j), bvj = *(const LAS f32x4*)(lgb + 1024 + 4 * lane + 256 * j);
                    const f32x4 y = v[u][j] * rstd * gvj + bvj; { u32x2 wb; wb.x = cvt_pk_bf16(y[0], y[1]); wb.y = cvt_pk_bf16(y[2], y[3]); *(u32x2*)(x1 + (size_t)token * DM + 4 * lane + 256 * j) = wb; }
                    int w8 = __builtin_amdgcn_cvt_pk_fp8_f32(y[0] * FP8_SA, y[1] * FP8_SA, 0, false); w8 = __builtin_amdgcn_cvt_pk_fp8_f32(y[2] * FP8_SA, y[3] * FP8_SA, w8, true);
                    *(int*)(xb8 + (size_t)token * DM + 4 * lane + 256 * j) = w8; } }
        }
        VM_WAIT(); __syncthreads();
        const int tg = F.wave & 3, kh = F.wave >> 2, e0 = lane & 15, kq = lane >> 4;
        f32x4 acc0 = {0.f, 0.f, 0.f, 0.f}, acc1 = acc0;
        { const bf16_t* arow = x1 + (size_t)(grp * 64 + tg * 16 + e0) * DM + kh * 512 + 4 * kq;
#pragma unroll 4
          for (int blk = 0; blk < 32; ++blk) {
              const u32x2 ab = *(const u32x2*)(arow + blk * 16); const f32x4 a4 = {bflo(ab.x), bfhi(ab.x), bflo(ab.y), bfhi(ab.y)}; const int c = ((kh * 512 + blk * 16) >> 2) + kq;
              const f32x4 b0 = rwv[e0 * 256 + (c ^ e0)], b1 = rwv[(16 + e0) * 256 + (c ^ e0)];
#pragma unroll
              for (int j = 0; j < 4; ++j) { acc0 = __builtin_amdgcn_mfma_f32_16x16x4f32(a4[j], b0[j], acc0, 0, 0, 0); acc1 = __builtin_amdgcn_mfma_f32_16x16x4f32(a4[j], b1[j], acc1, 0, 0, 0); } } }
        __syncthreads();
        if (kh == 1) { ((LAS f32x4*)lgb)[(tg * 2 + 0) * 64 + lane] = acc0; ((LAS f32x4*)lgb)[(tg * 2 + 1) * 64 + lane] = acc1; }
        __syncthreads();
        if (kh == 0) {
            acc0 = acc0 + ((LAS f32x4*)lgb)[(tg * 2 + 0) * 64 + lane]; acc1 = acc1 + ((LAS f32x4*)lgb)[(tg * 2 + 1) * 64 + lane];
            const float rb0 = rbias[e0], rb1 = rbias[16 + e0];
#pragma unroll
            for (int r = 0; r < 4; ++r) {
                float l0 = acc0[r] + rb0, l1 = acc1[r] + rb1; float tv[4]; int te[4];
#pragma unroll
                for (int k = 0; k < 4; ++k) { float bvv = (l1 > l0) ? l1 : l0; int be = (l1 > l0) ? 16 + e0 : e0;
#pragma unroll
                    for (int o = 1; o < 16; o <<= 1) { const float ov = __shfl_xor(bvv, o); const int oe = __shfl_xor(be, o); const bool take = (ov > bvv) || (ov == bvv && oe < be); bvv = take ? ov : bvv; be = take ? oe : be; }
                    tv[k] = bvv; te[k] = be; if (be == e0) l0 = -INFINITY; if (be == 16 + e0) l1 = -INFINITY; }
                const float w0 = 1.0f, w1 = __expf(tv[1] - tv[0]), w2 = __expf(tv[2] - tv[0]), w3 = __expf(tv[3] - tv[0]); const float wi = 1.0f / (w0 + w1 + w2 + w3);
                if (e0 < 4) {
                    const int tl = tg * 16 + 4 * kq + r, token = grp * 64 + tl;
                    const int ek = (e0 == 0) ? te[0] : (e0 == 1) ? te[1] : (e0 == 2) ? te[2] : te[3];
                    const float wk = (e0 == 0) ? w0 : (e0 == 1) ? w1 : (e0 == 2) ? w2 : w3;
                    const int li = atomicAdd((int*)(lcnt + ek), 1); rec[tl * 8 + e0] = ek; rec[tl * 8 + 4 + e0] = li;
                    toke[token * 4 + e0] = ek; tokg[token * 4 + e0] = wk * wi;
                }
            }
        }
        __syncthreads();
        if (F.tid < 32) gbase[F.tid] = (int)__hip_atomic_fetch_add(cntg + F.tid * 64, (unsigned)lcnt[F.tid], RLX_AGENT);
        __syncthreads();
        if (F.tid < 256) { const int tl = F.tid >> 2, k = F.tid & 3; const int token = grp * 64 + tl; const int e = rec[tl * 8 + k]; const int pos = gbase[e] + rec[tl * 8 + 4 + k];
            tokp[token * 4 + k] = pos; rowtok[(size_t)e * NTOK + pos] = (unsigned short)token; }
        __syncthreads();
    }
}

__device__ __forceinline__ int moe_tables(Frame& F, int layer) {
    LAS int* tile_e = (LAS int*)(F.lds + LX_TILEE); LAS int* tbase = (LAS int*)(F.lds + LX_TBASE);
    if (F.tid < 64) {
        const int e = F.lane & 31; const int c = (int)__hip_atomic_load(F.ctl + CW_CNT + layer * 2048 + e * 64, RLX_AGENT); const int nt = (F.lane < 32) ? ((c + 255) >> 8) : 0;
        int inc = nt;
#pragma unroll
        for (int o = 1; o < 32; o <<= 1) { const int up = __shfl_up(inc, o); if (F.lane >= o) inc += up; }
        const int t0 = inc - nt;
        if (F.lane < 32) { tbase[e] = t0; for (int i = 0; i < nt; ++i) tile_e[t0 + i] = e; }
        if (F.lane == 31) tbase[32] = inc;
    }
    __syncthreads();
    return tbase[32];
}

template <bool NEXT_MLSTM>
__device__ __forceinline__ void phase_combine(Frame& F, const bf16_t* __restrict__ x1, float* __restrict__ out, const float* lng, const float* lnb, const float* bgates, int layer) {
    unsigned char* ws = F.ws;
    (void)moe_tables(F, layer);
    const LAS int* tbase = (const LAS int*)(F.lds + LX_TBASE);
    const int* toke = (const int*)(ws + WS_TOKE); const int* tokp = (const int*)(ws + WS_TOKP); const float* tokg = (const float*)(ws + WS_TOKG);
    const unsigned char* Y = (const unsigned char*)(ws + WS_Y); bf16_t* xb = (bf16_t*)(ws + WS_XB);
    LAS float* wg = (LAS float*)(F.lds + RING_OFF);
    LAS float* lgb = wg + 8192;
    if constexpr (NEXT_MLSTM) { const f32x4* src = (const f32x4*)(ws + WS_WG); for (int i = F.tid; i < 2048; i += NTHR) ((LAS f32x4*)wg)[i] = src[i];
        for (int i = F.tid; i < 1024; i += NTHR) { lgb[i] = lng[i]; lgb[1024 + i] = lnb[i]; } __syncthreads(); }
    const int lane = F.lane; const int gw = F.vcu * NWAVES + F.wave, NGW = F.G * NWAVES;
    f32x4 gv[4], bv[4];
    if constexpr (!NEXT_MLSTM) {
#pragma unroll
        for (int j = 0; j < 4; ++j) { gv[j] = *(const f32x4*)(lng + 4 * lane + 256 * j); bv[j] = *(const f32x4*)(lnb + 4 * lane + 256 * j); } }
    constexpr int NTK = NEXT_MLSTM ? 1 : 2;
    for (int token0 = gw; token0 < NTOK; token0 += NTK * NGW) {
        f32x4 vv[NTK][4];
#pragma unroll
        for (int u = 0; u < NTK; ++u) { const int token = token0 + u * NGW; if (token < NTOK) {
#pragma unroll
            for (int j = 0; j < 4; ++j) { const u32x2 xx = *(const u32x2*)(x1 + (size_t)token * DM + 4 * lane + 256 * j); vv[u][j] = (f32x4){bflo(xx.x), bfhi(xx.x), bflo(xx.y), bfhi(xx.y)} * ALPHA; }
#pragma unroll
            for (int k = 0; k < 4; ++k) { const int e = toke[token * 4 + k]; const size_t row = (size_t)tbase[e] * 256 + tokp[token * 4 + k]; const float gt = tokg[token * 4 + k] * (DBG_MOE_MUL / FP8_SY);
#pragma unroll
                for (int j = 0; j < 4; ++j) { const int y = *(const int*)(Y + row * DM + 4 * lane + 256 * j); const f32x2 lo = __builtin_amdgcn_cvt_pk_f32_fp8(y, false), hi = __builtin_amdgcn_cvt_pk_f32_fp8(y, true);
                    vv[u][j][0] += gt * lo[0]; vv[u][j][1] += gt * lo[1]; vv[u][j][2] += gt * hi[0]; vv[u][j][3] += gt * hi[1]; } } } }
#pragma unroll
        for (int u = 0; u < NTK; ++u) { const int token = token0 + u * NGW; if (token < NTOK) {
        f32x4 v[4];
#pragma unroll
        for (int j = 0; j < 4; ++j) v[j] = vv[u][j];
        float s = 0.f;
#pragma unroll
        for (int j = 0; j < 4; ++j) s += (v[j][0] + v[j][1]) + (v[j][2] + v[j][3]);
        const float mean = wave_sum(s) * (1.0f / DM); float s2 = 0.f;
#pragma unroll
        for (int j = 0; j < 4; ++j) { v[j] = v[j] - mean; s2 += (v[j][0] * v[j][0] + v[j][1] * v[j][1]) + (v[j][2] * v[j][2] + v[j][3] * v[j][3]); }
        const float rstd = 1.0f / sqrtf(wave_sum(s2) * (1.0f / DM) + LN_EPS);
#pragma unroll
        for (int j = 0; j < 4; ++j) { if constexpr (NEXT_MLSTM) { gv[j] = *(const LAS f32x4*)(lgb + 4 * lane + 256 * j); bv[j] = *(const LAS f32x4*)(lgb + 1024 + 4 * lane + 256 * j); }
            v[j] = v[j] * rstd * gv[j] + bv[j]; if constexpr (!NEXT_MLSTM) *(f32x4*)(out + (size_t)token * DM + 4 * lane + 256 * j) = v[j]; }
        if constexpr (NEXT_MLSTM) {
#pragma unroll
            for (int j = 0; j < 4; ++j) { u32x2 w; w.x = cvt_pk_bf16(v[j][0], v[j][1]); w.y = cvt_pk_bf16(v[j][2], v[j][3]); *(u32x2*)(xb + (size_t)token * DM + 4 * lane + 256 * j) = w; }
            float gp[8];
#pragma unroll
            for (int gi = 0; gi < 8; ++gi) { float a = 0.f;
#pragma unroll
                for (int j = 0; j < 4; ++j) { const f32x4 w = *(const LAS f32x4*)(wg + gi * 1024 + 4 * lane + 256 * j); a += (v[j][0] * w[0] + v[j][1] * w[1]) + (v[j][2] * w[2] + v[j][3] * w[3]); }
                gp[gi] = a; }
#pragma unroll
            for (int o = 1; o < 64; o <<= 1) {
#pragma unroll
                for (int gi = 0; gi < 8; ++gi) gp[gi] += __shfl_xor(gp[gi], o); }
#pragma unroll
            for (int gi = 0; gi < 8; ++gi) gp[gi] += bgates[gi];
            if (lane == 0) {
#pragma unroll
                for (int hh = 0; hh < 4; ++hh) { ((float*)(ws + WS_GI))[(size_t)hh * NTOK + token] = gp[hh];
                    const float f = gp[4 + hh]; const float lf = (f >= 0.f) ? -log1pf(__expf(-f)) : (f - log1pf(__expf(f)));
                    ((float*)(ws + WS_LF))[(size_t)hh * NTOK + token] = lf; } }
        }
        } }
    }
}

__device__ __forceinline__ void phase_gate_scan(Frame& F) {
    unsigned char* ws = F.ws; const int lane = F.lane; const int gw = F.vcu * NWAVES + F.wave, NGW = F.G * NWAVES;
    for (int mu = gw; mu < 256; mu += NGW) {
        const int b = mu >> 6, hh = (mu >> 4) & 3, ch = mu & 15; const size_t base = (size_t)hh * NTOK + (size_t)b * SEQ + ch * 256 + 4 * lane;
        const f32x4 lf = *(const f32x4*)((const float*)(ws + WS_LF) + base), gi = *(const f32x4*)((const float*)(ws + WS_GI) + base);
        f32x4 c; c[0] = lf[0]; c[1] = c[0] + lf[1]; c[2] = c[1] + lf[2]; c[3] = c[2] + lf[3];
        float tot = c[3];
#pragma unroll
        for (int o = 1; o < 64; o <<= 1) { const float up = __shfl_up(tot, o); if (lane >= o) tot += up; }
        const float excl = tot - c[3];
        f32x4 rf, cf;
#pragma unroll
        for (int j = 0; j < 4; ++j) { const float bt = excl + c[j]; rf[j] = __expf(bt); cf[j] = __expf(gi[j] - bt); }
        *(f32x4*)((float*)(ws + WS_RF) + base) = rf; *(f32x4*)((float*)(ws + WS_CF) + base) = cf;
        if (lane == 63) ((float*)(ws + WS_DEC))[mu] = __expf(tot);
    }
}
__device__ __forceinline__ void phase_nu(Frame& F) {
    unsigned char* ws = F.ws; const int lane = F.lane; const int gw = F.vcu * NWAVES + F.wave, NGW = F.G * NWAVES;
    const bf16_t* KT = (const bf16_t*)(ws + WS_KT); float* NU = (float*)(ws + WS_NU);
    for (int r0 = gw * 16; r0 < 256 * 128; r0 += NGW * 16) {
        const int mu = r0 >> 7, d0 = r0 & 127, b = mu >> 6, hh = (mu >> 4) & 3, ch = mu & 15;
        const bf16_t* base = KT + (size_t)(hh * 128 + d0) * NTOK + (size_t)b * SEQ + ch * 256 + 4 * lane;
        u32x2 kv[16];
#pragma unroll
        for (int i = 0; i < 16; ++i) kv[i] = *(const u32x2*)(base + (size_t)i * NTOK);
        float s[16];
#pragma unroll
        for (int i = 0; i < 16; ++i) s[i] = (bflo(kv[i].x) + bfhi(kv[i].x)) + (bflo(kv[i].y) + bfhi(kv[i].y));
#pragma unroll
        for (int o = 1; o < 64; o <<= 1) {
#pragma unroll
            for (int i = 0; i < 16; ++i) s[i] += __shfl_xor(s[i], o); }
        float mine = s[0];
#pragma unroll
        for (int i = 1; i < 16; ++i) mine = (lane == i) ? s[i] : mine;
        if (lane < 16) NU[r0 + lane] = mine;
    }
}
__device__ __forceinline__ void phase_state_scan(Frame& F) {
    unsigned char* ws = F.ws; const int gt = F.vcu * NTHR + F.tid, NGT = F.G * NTHR;
    const float* UT = (const float*)(ws + WS_UT); const float* DEC = (const float*)(ws + WS_DEC); bf16_t* BE = (bf16_t*)(ws + WS_BE);
    for (int i = gt; i < 16 * 256 * 32; i += NGT) { const int bh = i >> 13, e = (i >> 5) & 255, dg = i & 31;
        f32x4 U[16]; float dc[16];
#pragma unroll
        for (int ch = 0; ch < 16; ++ch) { const size_t mu = (size_t)bh * 16 + ch; U[ch] = *(const f32x4*)(UT + (mu * 256 + e) * 128 + 4 * dg); dc[ch] = DEC[mu]; }
        f32x4 C = {0.f, 0.f, 0.f, 0.f};
#pragma unroll
        for (int ch = 0; ch < 16; ++ch) { const size_t mu = (size_t)bh * 16 + ch;
            u32x2 w; w.x = cvt_pk_bf16(C[0], C[1]); w.y = cvt_pk_bf16(C[2], C[3]);
#ifdef DBG_NO_INTER
            w.x = 0u; w.y = 0u;
#endif
            *(u32x2*)(BE + (mu * 256 + e) * 384 + 256 + 4 * dg) = w;
            C = (C + U[ch]) * dc[ch]; } }
    const float* NU = (const float*)(ws + WS_NU); float* NP = (float*)(ws + WS_NPREV);
    for (int i = gt; i < 16 * 128; i += NGT) { const int bh = i >> 7, d = i & 127; float n = 0.f;
        for (int ch = 0; ch < 16; ++ch) { const int mu = bh * 16 + ch; NP[mu * 128 + d] = n; n = (n + NU[mu * 128 + d]) * DEC[mu];
#ifdef DBG_NO_INTER
            n = 0.f;
#endif
        } }
}
struct Args { const float* in[18]; float* out; unsigned char* ws; int ph_lo, ph_hi; };
__global__ void __launch_bounds__(NTHR, 2) mk_fwd(Args args) {
    extern __shared__ __attribute__((aligned(16))) unsigned char lds[];
    Frame F;
    const char __attribute__((address_space(4)))* kargp = (const char __attribute__((address_space(4)))*)__builtin_amdgcn_kernarg_segment_ptr();
#define AIN(i) ({ const char __attribute__((address_space(4)))* k_ = kargp; asm volatile("" : "+s"(k_)); *(const float* const __attribute__((address_space(4)))*)(k_ + 8 * (i)); })
    unsigned char* const ws0 = (unsigned char*)AIN(19);
    F.lds = (LAS unsigned char*)lds; F.ws = ws0; F.ctl = (unsigned*)(ws0 + WS_CTL);
    F.tid = threadIdx.x; F.lane = F.tid & 63; F.wave = __builtin_amdgcn_readfirstlane(F.tid >> 6);
    F.G = gridDim.x; { const int bx = blockIdx.x; F.vcu = (F.G % 8 == 0) ? (bx % 8) * (F.G / 8) + bx / 8 : bx; }
    for (int u = F.tid; u < (LDS_BYTES - LX) / 4; u += NTHR) ((LAS unsigned*)(F.lds + LX))[u] = 0u;
    __syncthreads();
    int lo, hi; { const char __attribute__((address_space(4)))* k_ = kargp; lo = *(const int __attribute__((address_space(4)))*)(k_ + 160); hi = *(const int __attribute__((address_space(4)))*)(k_ + 164); }
    XcdBarrier bar; bar.bar = (unsigned*)(F.ctl + CW_BAR); bar.x = 0; bar.st = nullptr;
    if (hi - lo > 1) bar = xcd_barrier_post((unsigned*)(F.ctl + CW_BAR), (volatile LAS unsigned*)(F.lds + LX_MISC) + 8);
#ifndef PHASE_MASK
#define PHASE_MASK 0x7FFFF
#endif
#define IN(k) ((((PHASE_MASK) >> (k)) & 1) && lo <= (k) && (k) < hi)
#ifndef REPEAT_MASK
#define REPEAT_MASK 0
#endif
#define PH(k) if (IN(k))
#define SEAM(k) do { if (IN(k) && IN((k) + 1)) xcd_barrier(bar); } while (0)
    unsigned char* ws = ws0;
#define x_in AIN(0)
#define ln_mix_g AIN(8)
#define ln_mix_b AIN(9)
#define ln_ffn_g AIN(10)
#define ln_ffn_b AIN(11)
#define router_b AIN(13)
#define b_gu AIN(15)
#define b_dn AIN(17)
    bf16_t* XB = (bf16_t*)(ws + WS_XB); bf16_t* QB_ = (bf16_t*)(ws + WS_Q); bf16_t* KB_ = (bf16_t*)(ws + WS_K); bf16_t* VB_ = (bf16_t*)(ws + WS_V);
    bf16_t* R0 = (bf16_t*)(ws + WS_R0); bf16_t* R1 = (bf16_t*)(ws + WS_R1);
    bf16_t* HB = (bf16_t*)(ws + WS_H); bf16_t* YB = (bf16_t*)(ws + WS_Y);
    LAS unsigned char* ring = F.lds + RING_OFF;
    const int cG = (int)blockIdx.x;
    const bool isConv = (NCONV > 0) && ((int)blockIdx.x >= F.G - NCONV);
    const int Gc = F.G - NCONV, cwv = ((int)blockIdx.x - Gc) * NWAVES + F.wave, ncw = NCONV * NWAVES;
#define CONV_SLICE(a, b) conv_items(F, AIN(14), AIN(16), (int)((long)CONV_ITEMS * (a) / 1000), (int)((long)CONV_ITEMS * (b) / 1000), cwv, ncw)

    PH(0) { P0In I{x_in, AIN(2), AIN(3), AIN(4), AIN(7), AIN(12), AIN(14), AIN(16), (const int*)AIN(1)}; p0_prologue(F, I); }
    SEAM(0);
    PH(1) { { Gemm g{1024, 1024, 1024, nullptr}; DenseSched S{64, 12, F.G, cG, (const char*)XB, (const char*)(ws + WS_WQKV), (size_t)256 * 1024 * 2, (size_t)256 * 1024 * 2};
        EpiQKV E{QB_, KB_, VB_, (const float*)(ws + WS_ROPE), (float*)(ws + WS_KSUM)};
        pg8::gemm_phase<EpiQKV, DenseSched, true, false>(ring, g, S, E); } }
    SEAM(1);
    PH(2) { if (isConv) CONV_SLICE(0, 1000); else {
        const attn_body::AttnTensors AT{(const attn_body::bf16*)QB_, (const attn_body::bf16*)KB_, (const attn_body::bf16*)VB_, (attn_body::bf16*)QB_, (const float*)(ws + WS_KSUM)};
        if (NCONV == 0) { const attn_body::StaticOrder S((int)F.G, (int)blockIdx.x); attn_body::attn_phase<attn_body::StaticOrder>((char*)lds + RING_OFF, AT, S); }
        else { const attn_body::SnakeOrder S{cG, Gc}; attn_body::attn_phase<attn_body::SnakeOrder>((char*)lds + RING_OFF, AT, S); } } }
    SEAM(2);
    PH(3) { { Gemm g{1024, 1024, 1024, nullptr}; DenseSched S{64, 4, F.G, cG, (const char*)QB_, (const char*)(ws + WS_WO), (size_t)256 * 1024 * 2, (size_t)256 * 1024 * 2};
        EpiZ E{XB, R0, DBG_ATTN_MUL}; pg8::gemm_phase<EpiZ, DenseSched, true, false>(ring, g, S, E); } }
    SEAM(3);
    PH(4) phase_ln_router(F, R0, R1, ln_mix_g, ln_mix_b, router_b, 0, 0);
    SEAM(4);
    PH(5) { const int nT = moe_tables(F, 0); LAS unsigned short* tokl = (LAS unsigned short*)(F.lds + LX_TOKL);
        { const unsigned short* rowtok = (const unsigned short*)(ws + WS_ROWTOK); const LAS int* tile_e = (const LAS int*)(F.lds + LX_TILEE); const LAS int* tbase = (const LAS int*)(F.lds + LX_TBASE);
          for (int i = 0; i < TOKL_ROUNDS; ++i) { int pm, pn, hf; if (!moe_unit(i, F.G, cG, nT, 8, pm, pn, hf)) break;
              if (F.tid < 256) { const int e = tile_e[pm]; const int r = (pm - tbase[e]) * 256 + F.tid; const int c = (int)__hip_atomic_load(F.ctl + CW_CNT + 0 * 2048 + e * 64, RLX_AGENT);
                  tokl[i * 256 + F.tid] = (r < c) ? rowtok[(size_t)e * NTOK + r] : (unsigned short)0; } }
          __syncthreads(); }
        Gemm g{512, 512, 512, (const char*)XB};
        MoeSched S{nT, 8, F.G, cG, (const LAS int*)(F.lds + LX_TILEE), (const LAS int*)(F.lds + LX_TBASE), tokl, nullptr, (const char*)(ws + WS_WGU) + (size_t)0 * 32 * 2048 * 1024, 0, (size_t)2048 * 1024, (size_t)256 * 1024};
        EpiGU E{b_gu + (size_t)0 * 32 * 2048, (unsigned char*)HB, (LAS float*)(F.lds + LX_BIAS), 0}; pg8::gemm_phase<EpiGU, MoeSched, true, true, true, true>(ring, g, S, E); }
    SEAM(5);
    PH(6) { const int nT = moe_tables(F, 0); Gemm g{512, 512, 512, nullptr};
        MoeSched S{nT, 4, F.G, cG, (const LAS int*)(F.lds + LX_TILEE), (const LAS int*)(F.lds + LX_TBASE), nullptr, (const char*)HB, (const char*)(ws + WS_WD) + (size_t)0 * 32 * 1024 * 1024, (size_t)256 * 1024, (size_t)1024 * 1024, (size_t)256 * 1024};
        EpiDN E{b_dn + (size_t)0 * 32 * 1024, (unsigned char*)YB, (LAS float*)(F.lds + LX_BIAS), 0}; pg8::gemm_phase<EpiDN, MoeSched, true, false, true, true>(ring, g, S, E); }
    SEAM(6);
    PH(7) phase_combine<true>(F, R1, nullptr, ln_ffn_g, ln_ffn_b, AIN(5), 0);
    { F.lane = (int)attn_body::lane_now(); F.tid = F.wave * 64 + F.lane; }
    SEAM(7);
    PH(8) phase_gate_scan(F);
    SEAM(8);
    PH(9) {
        { Gemm g{1024, 1024, 1024, nullptr}; DenseSched S{64, 8, F.G, cG, (const char*)XB, (const char*)(ws + WS_WINA), (size_t)256 * 1024 * 2, (size_t)256 * 1024 * 2};
          EpiINA E{(const float*)(ws + WS_RF), (const float*)(ws + WS_CF), (bf16_t*)(ws + WS_AE), (bf16_t*)(ws + WS_KN), (bf16_t*)(ws + WS_OS)};
          pg8::gemm_phase<EpiINA, DenseSched, true, false>(ring, g, S, E); }
        { Gemm g{1024, 1024, 1024, nullptr}; DenseSched S{6, 64, F.G, cG, (const char*)(ws + WS_WINB), (const char*)XB, (size_t)256 * 1024 * 2, (size_t)256 * 1024 * 2, true};
          EpiINB E{(const float*)(ws + WS_CF), (bf16_t*)(ws + WS_KT), (bf16_t*)(ws + WS_BE)};
          pg8::gemm_phase<EpiINB, DenseSched, true, false, false, true>(ring, g, S, E); }
    }
    SEAM(9);
    PH(10) { Gemm g{256, 384, NTOK, nullptr}; MuSched S{F.G, cG, 0, (const char*)(ws + WS_BE), (const char*)(ws + WS_KT)};
        EpiM1 E{(float*)(ws + WS_UT)}; pg8::gemm_phase<EpiM1, MuSched, true, false>(ring, g, S, E);
        phase_nu(F); }
    SEAM(10);
    PH(11) phase_state_scan(F);
    SEAM(11);
    PH(12) { Gemm g{128, 512, 1024, nullptr}; MuSched S{F.G, cG, 1, (const char*)(ws + WS_AE), (const char*)(ws + WS_KN)};
        EpiM2A E{(bf16_t*)(ws + WS_AE), (const float*)(ws + WS_NPREV), (float*)(ws + WS_DEN)}; pg8::gemm_phase<EpiM2A, MuSched, true, false>(ring, g, S, E); }
    SEAM(12);
    PH(13) { Gemm g{384, 512, 384, nullptr}; MuSched S{F.G, cG, 2, (const char*)(ws + WS_AE), (const char*)(ws + WS_BE)};
        EpiM2B E{(const float*)(ws + WS_DEN), AIN(6), (const bf16_t*)(ws + WS_OS), (bf16_t*)(ws + WS_HN), (LAS float*)(F.lds + LX_LNX)};
        pg8::gemm_phase<EpiM2B, MuSched, true, false>(ring, g, S, E); }
    SEAM(13);
    PH(14) { Gemm g{1024, 1024, 1024, nullptr}; DenseSched S{64, 4, F.G, cG, (const char*)(ws + DBG_P14_A), (const char*)(ws + WS_WOUT), (size_t)256 * 1024 * 2, (size_t)256 * 1024 * 2};
        EpiZ E{XB, R0, DBG_MLSTM_MUL}; pg8::gemm_phase<EpiZ, DenseSched, true, false>(ring, g, S, E); }
    SEAM(14);
    PH(15) phase_ln_router(F, R0, R1, ln_mix_g + 1024, ln_mix_b + 1024, router_b + 32, 1, 1);
    SEAM(15);
    PH(16) { const int nT = moe_tables(F, 1); LAS unsigned short* tokl = (LAS unsigned short*)(F.lds + LX_TOKL);
        { const unsigned short* rowtok = (const unsigned short*)(ws + WS_ROWTOK); const LAS int* tile_e = (const LAS int*)(F.lds + LX_TILEE); const LAS int* tbase = (const LAS int*)(F.lds + LX_TBASE);
          for (int i = 0; i < TOKL_ROUNDS; ++i) { int pm, pn, hf; if (!moe_unit(i, F.G, cG, nT, 8, pm, pn, hf)) break;
              if (F.tid < 256) { const int e = tile_e[pm]; const int r = (pm - tbase[e]) * 256 + F.tid; const int c = (int)__hip_atomic_load(F.ctl + CW_CNT + 1 * 2048 + e * 64, RLX_AGENT);
                  tokl[i * 256 + F.tid] = (r < c) ? rowtok[(size_t)e * NTOK + r] : (unsigned short)0; } }
          __syncthreads(); }
        Gemm g{512, 512, 512, (const char*)XB};
        MoeSched S{nT, 8, F.G, cG, (const LAS int*)(F.lds + LX_TILEE), (const LAS int*)(F.lds + LX_TBASE), tokl, nullptr, (const char*)(ws + WS_WGU) + (size_t)1 * 32 * 2048 * 1024, 0, (size_t)2048 * 1024, (size_t)256 * 1024};
        EpiGU E{b_gu + (size_t)1 * 32 * 2048, (unsigned char*)HB, (LAS float*)(F.lds + LX_BIAS), 0}; pg8::gemm_phase<EpiGU, MoeSched, true, true, true, true>(ring, g, S, E); }
    SEAM(16);
    PH(17) { const int nT = moe_tables(F, 1); Gemm g{512, 512, 512, nullptr};
        MoeSched S{nT, 4, F.G, cG, (const LAS int*)(F.lds + LX_TILEE), (const LAS int*)(F.lds + LX_TBASE), nullptr, (const char*)HB, (const char*)(ws + WS_WD) + (size_t)1 * 32 * 1024 * 1024, (size_t)256 * 1024, (size_t)1024 * 1024, (size_t)256 * 1024};
        EpiDN E{b_dn + (size_t)1 * 32 * 1024, (unsigned char*)YB, (LAS float*)(F.lds + LX_BIAS), 0}; pg8::gemm_phase<EpiDN, MoeSched, true, false, true, true>(ring, g, S, E); }
    SEAM(17);
    PH(18) phase_combine<false>(F, R1, (float*)AIN(18), ln_ffn_g + 1024, ln_ffn_b + 1024, nullptr, 1);
#undef IN
#undef CONV_SLICE
#undef AIN
#undef x_in
#undef ln_mix_g
#undef ln_mix_b
#undef ln_ffn_g
#undef ln_ffn_b
#undef router_b
#undef b_gu
#undef b_dn
#undef SEAM
}

extern "C" void kernel_launch(void* const* d_in, const int* in_sizes, int n_in, void* d_out, int out_size, void* d_ws, size_t ws_size, hipStream_t stream) {
    static int grid = 0;
    if (grid == 0) {
        if (n_in != 18 || out_size != NTOK * DM || ws_size < WS_END) { fprintf(stderr, "kernel_launch: unexpected problem shape (n_in %d, out %d, ws %zu)\n", n_in, out_size, ws_size); grid = -1; return; }
        int dev = 0, cus = 0, per_cu = 0;
        if (hipGetDevice(&dev) != hipSuccess || hipDeviceGetAttribute(&cus, hipDeviceAttributeMultiprocessorCount, dev) != hipSuccess) { grid = -1; return; }
        if (hipFuncSetAttribute((const void*)mk_fwd, hipFuncAttributeMaxDynamicSharedMemorySize, LDS_BYTES) != hipSuccess) { fprintf(stderr, "kernel_launch: hipFuncSetAttribute failed\n"); grid = -1; return; }
        if (hipOccupancyMaxActiveBlocksPerMultiprocessor(&per_cu, (const void*)mk_fwd, NTHR, LDS_BYTES) != hipSuccess || per_cu < 1) fprintf(stderr, "kernel_launch: occupancy query reports %d\n", per_cu);
        (void)hipGetLastError();
        grid = cus;
        if (grid > 256) grid = 256;
        if (grid < 240) { fprintf(stderr, "kernel_launch: %d CUs: this build needs 240..256\n", cus); grid = -1; return; }
    }
    if (grid < 0) return;
    if (hipMemsetAsync((char*)d_ws + WS_CTL, 0, CTL_ZERO_BYTES, stream) != hipSuccess) return;
    Args a{};
    for (int i = 0; i < 18; ++i) a.in[i] = (const float*)d_in[i];
    a.out = (float*)d_out; a.ws = (unsigned char*)d_ws;
#if MK_ONE_LAUNCH
    a.ph_lo = 0; a.ph_hi = NPHASE;
    hipLaunchKernelGGL(mk_fwd, dim3(grid), dim3(NTHR), LDS_BYTES, stream, a);
#else
    for (int p = 0; p < NPHASE; ++p) { a.ph_lo = p; a.ph_hi = p + 1; hipLaunchKernelGGL(mk_fwd, dim3(grid), dim3(NTHR), LDS_BYTES, stream, a); }
#endif
}
```

```cpp
#include <hip/hip_runtime.h>
#include <hip/hip_bf16.h>
#include <cstdio>
#include <cstdint>
#include <cmath>

#define LAS __attribute__((address_space(3)))
#define GAS __attribute__((address_space(1)))
typedef unsigned short bf16_t;
typedef short bf16x8 __attribute__((ext_vector_type(8)));
typedef float f32x4 __attribute__((ext_vector_type(4)));
typedef float f32x2 __attribute__((ext_vector_type(2)));
typedef unsigned u32x4 __attribute__((ext_vector_type(4)));
typedef unsigned u32x2 __attribute__((ext_vector_type(2)));
typedef int i32x4 __attribute__((ext_vector_type(4)));
typedef int i32x8 __attribute__((ext_vector_type(8)));

typedef __bf16 bf16x2_t __attribute__((ext_vector_type(2)));
__device__ __forceinline__ unsigned cvt_pk_bf16(float lo, float hi) { const f32x2 v = {lo, hi}; const bf16x2_t b = __builtin_convertvector(v, bf16x2_t); return __builtin_bit_cast(unsigned, b); }
__device__ __forceinline__ float bf2f(unsigned short b) { return __uint_as_float(((unsigned)b) << 16); }
__device__ __forceinline__ float bflo(unsigned w) { return __uint_as_float(w << 16); }
__device__ __forceinline__ float bfhi(unsigned w) { return __uint_as_float(w & 0xffff0000u); }

__device__ __forceinline__ void glds16s(const void* sbase, unsigned voff, unsigned lds_dst) { unsigned keep;
    asm volatile("s_nop 4\n\ts_mov_b32 %0, m0\n\ts_mov_b32 m0, %3\n\ts_nop 0\n\tglobal_load_lds_dwordx4 %1, %2\n\ts_mov_b32 m0, %0" : "=&s"(keep) : "v"(voff), "s"(sbase), "s"(lds_dst) : "memory"); }
__device__ __forceinline__ void glds4s(const void* sbase, unsigned voff, unsigned lds_dst) { unsigned keep;
    asm volatile("s_nop 4\n\ts_mov_b32 %0, m0\n\ts_mov_b32 m0, %3\n\ts_nop 0\n\tglobal_load_lds_dword %1, %2\n\ts_mov_b32 m0, %0" : "=&s"(keep) : "v"(voff), "s"(sbase), "s"(lds_dst) : "memory"); }
__device__ __forceinline__ const char* uni_ptr(const char* p) { const unsigned long long v = (unsigned long long)p; const unsigned lo = __builtin_amdgcn_readfirstlane((unsigned)v), hi = __builtin_amdgcn_readfirstlane((unsigned)(v >> 32)); return (const char*)(((unsigned long long)hi << 32) | lo); }
namespace pg8 {
constexpr int BM = 256, BK = 64, HALF = 128, HTB = HALF * BK * 2, STAGE_BYTES = 8 * HTB, NXCD = 8, WGM = 8;
__host__ __device__ __forceinline__ int lds_byte(int r, int c) { const int st = (r >> 4) * 2 + (c >> 5), rr = r & 15, cc = c & 31, ob = rr * 64 + cc * 2; return st * 1024 + (ob ^ (((ob >> 9) & 1) << 5)); }
__host__ __device__ __forceinline__ void stage_rc(int b, int& R, int& C) { const int st = b / 1024, sb = b % 1024, swz = sb ^ (((sb >> 9) & 1) << 5); R = (st >> 1) * 16 + swz / 64; C = (st & 1) * 32 + (swz % 64) / 2; }
__host__ __device__ __forceinline__ int perm32(int rho) { const int n = rho >> 4, i = rho & 15; return 8 * (i >> 2) + 4 * n + (i & 3); }

struct Unit { int pm, pn; const char* A; const char* B; const LAS unsigned short* tl; int x0, x1, x2; };
struct Gemm { int K, lda, ldb; const char* Abase; };

__device__ __forceinline__ bool tile_order(int i, int G, int c, int nM, int nN, int& pm, int& pn) {
    const int nwg = nM * nN; const long L = (long)i * G + c; if (L >= nwg) return false;
    int wgid = (int)L; { const int q = nwg / NXCD, r = nwg % NXCD, xcd = wgid % NXCD, off = wgid / NXCD; wgid = (xcd < r ? xcd * (q + 1) : r * (q + 1) + (xcd - r) * q) + off; }
    const int nig = WGM * nN, gid = wgid / nig, fm = gid * WGM, gsz = (nM - fm) < WGM ? (nM - fm) : WGM;
    pm = fm + ((wgid % nig) % gsz); pn = (wgid % nig) / gsz; return true;
}

template <class Epi, class Sched, bool ALIGN_EPI, bool GATHER, bool FP8 = false, bool HALFSEL = false>
__device__ __forceinline__ void gemm_phase(LAS unsigned char* lds, const Gemm g, const Sched& S, const Epi& E) {
    const int tid = threadIdx.x, wid = __builtin_amdgcn_readfirstlane(tid >> 6), lane = tid & 63, wr = wid >> 2, wc = wid & 3, fr = lane & 15, fq = lane >> 4;
    const int K = g.K, nt = K / BK;
    int RA[2]; unsigned cA2[2], voffB[2];
#pragma unroll
    for (int i = 0; i < 2; ++i) { int R, C; stage_rc(tid * 16 + i * 8192, R, C); const int Rb = Epi::PERM ? ((R & ~31) + perm32(R & 31)) : R;
        RA[i] = R; cA2[i] = (unsigned)C * 2u; voffB[i] = (unsigned)(Rb * g.ldb + C) * 2u; }
    const size_t kstep = (size_t)(BK * 2);
    const unsigned hstepA = (unsigned)HALF * (unsigned)g.lda * 2u; const size_t hstepB = (size_t)HALF * g.ldb * 2;
    const unsigned ldsb = (unsigned)__builtin_amdgcn_readfirstlane((unsigned)(unsigned long long)lds + (unsigned)wid * 1024u);
    const int aoff = lds_byte(wr * 64 + fr, fq * 8), boff = lds_byte(wc * 32 + fr, fq * 8);
    const int aoff2 = aoff + 1024, boff2 = boff + 1024;
#define PG8_SA(b, h) (((b) * 2 + (h)) * HTB)
#define PG8_SB(b, h) ((4 + (b) * 2 + (h)) * HTB)
#define PG8_STAGE(bufoff, gbase, voff) do { _Pragma("unroll") for (int _i = 0; _i < 2; ++_i) glds16s((gbase), (voff)[_i], ldsb + (unsigned)(bufoff) + _i * 8192u); } while (0)
#define PG8_STAGE_A(bufoff, gbase, AO, h) do { _Pragma("unroll") for (int _i = 0; _i < 2; ++_i) glds16s((gbase), (AO)[h][_i], ldsb + (unsigned)(bufoff) + _i * 8192u); } while (0)
#define PG8_LD8(base_, o1_, o2_) __builtin_shufflevector(*(const LAS i32x4*)(lds + (base_) + (o1_)), *(const LAS i32x4*)(lds + (base_) + (o2_)), 0, 1, 2, 3, 4, 5, 6, 7)
#define PG8_LDA(dst, b, h) do { if constexpr (FP8) { _Pragma("unroll") for (int m = 0; m < 4; ++m) dst##8[m] = PG8_LD8(PG8_SA(b, h) + m * 2048, aoff, aoff2); } \
        else { _Pragma("unroll") for (int m = 0; m < 4; ++m) _Pragma("unroll") for (int k = 0; k < 2; ++k) dst[m][k] = *(const LAS bf16x8*)(lds + PG8_SA(b, h) + aoff + m * 2048 + k * 1024); } } while (0)
#define PG8_LDB(dst, b, h) do { if constexpr (FP8) { _Pragma("unroll") for (int n = 0; n < 2; ++n) dst##8[n] = PG8_LD8(PG8_SB(b, h) + n * 2048, boff, boff2); } \
        else { _Pragma("unroll") for (int n = 0; n < 2; ++n) _Pragma("unroll") for (int k = 0; k < 2; ++k) dst[n][k] = *(const LAS bf16x8*)(lds + PG8_SB(b, h) + boff + n * 2048 + k * 1024); } } while (0)
#define PG8_MMA(ai, bj, At, Bt) do { __builtin_amdgcn_s_setprio(1); _Pragma("unroll") for (int m = 0; m < 4; ++m) _Pragma("unroll") for (int n = 0; n < 2; ++n) { \
        if constexpr (FP8) asm volatile("v_mfma_f32_16x16x128_f8f6f4 %0, %1, %2, %0" : "+v"(acc[ai][bj][m][n]) : "v"(Bt##8[n]), "v"(At##8[m])); \
        else { _Pragma("unroll") for (int k = 0; k < 2; ++k) acc[ai][bj][m][n] = __builtin_amdgcn_mfma_f32_16x16x32_bf16(Bt[n][k], At[m][k], acc[ai][bj][m][n], 0, 0, 0); } } \
        __builtin_amdgcn_s_setprio(0); } while (0)
#define PG8_WAIT_V(n) asm volatile("s_waitcnt vmcnt(" #n ")" ::: "memory")
#define PG8_WAIT_L(n) asm volatile("s_waitcnt lgkmcnt(" #n ")" ::: "memory")
#define PG8_BAR __builtin_amdgcn_s_barrier()
#define PG8_SCHED __builtin_amdgcn_sched_barrier(0)
#define PG8_AOFF(AO, U) do { _Pragma("unroll") for (int _h = 0; _h < 2; ++_h) _Pragma("unroll") for (int _i = 0; _i < 2; ++_i) { \
        if constexpr (GATHER) AO[_h][_i] = (unsigned)(U).tl[RA[_i] + _h * HALF] * (unsigned)(g.lda * 2) + cA2[_i]; \
        else AO[_h][_i] = (unsigned)RA[_i] * (unsigned)(g.lda * 2) + cA2[_i] + (unsigned)_h * hstepA; } } while (0)
    Unit cur, nxt; int ui = 0;
    if (!S.next(0, cur)) return;
    f32x4 acc[2][2][4][2];
#pragma unroll
    for (int a = 0; a < 2; ++a)
#pragma unroll
        for (int b = 0; b < 2; ++b)
#pragma unroll
            for (int m = 0; m < 4; ++m)
#pragma unroll
                for (int n = 0; n < 2; ++n) acc[a][b][m][n] = (f32x4){0.f, 0.f, 0.f, 0.f};
    bf16x8 At[4][2], B0[2][2], B1[2][2]; i32x8 At8[4], B08[2], B18[2];
    E.prep(cur, 0, wid, lane);
    unsigned aoC[2][2], aoN[2][2];
    PG8_AOFF(aoC, cur);
    const char* cA = uni_ptr(GATHER ? g.Abase : cur.A); const char* cB = uni_ptr(cur.B);
    PG8_STAGE(PG8_SB(0, 0), cB, voffB); PG8_STAGE(PG8_SB(0, 1), cB + hstepB, voffB); PG8_STAGE_A(PG8_SA(0, 0), cA, aoC, 0); PG8_STAGE_A(PG8_SA(0, 1), cA, aoC, 1);
    if (wr == 1) PG8_BAR;
    PG8_WAIT_V(2); PG8_BAR;
    PG8_STAGE(PG8_SB(1, 0), cB + kstep, voffB); PG8_STAGE_A(PG8_SA(1, 0), cA + kstep, aoC, 0); PG8_STAGE(PG8_SB(1, 1), cB + hstepB + kstep, voffB);
    PG8_WAIT_V(6); PG8_BAR;
    for (;;) {
        const bool has_next = S.next(ui + 1, nxt);
        if (has_next) E.prep(nxt, ui + 1, wid, lane);
        if constexpr (GATHER) { if (has_next) PG8_AOFF(aoN, nxt); else { _Pragma("unroll") for (int _h = 0; _h < 2; ++_h) _Pragma("unroll") for (int _i = 0; _i < 2; ++_i) aoN[_h][_i] = aoC[_h][_i]; } }
        const char* nA = uni_ptr(GATHER ? g.Abase : (has_next ? nxt.A : cA)); const char* nB = uni_ptr(has_next ? nxt.B : cB);
        const bool dh0 = cur.x2 != 2, dh1 = cur.x2 != 1;
#pragma nounroll
        for (int t = 0; t < nt; t += 2) {
            const bool last = (t == nt - 2);
            const char* a1 = cA + (size_t)(t + 1) * kstep;
            const char* a2 = last ? nA : cA + (size_t)(t + 2) * kstep; const char* b2 = last ? nB : cB + (size_t)(t + 2) * kstep;
            const char* a3 = a2 + kstep; const char* b3 = b2 + kstep;
            unsigned aoS[2][2];
#pragma unroll
            for (int _h = 0; _h < 2; ++_h)
#pragma unroll
                for (int _i = 0; _i < 2; ++_i) aoS[_h][_i] = (GATHER && last) ? aoN[_h][_i] : aoC[_h][_i];
            PG8_LDB(B0, 0, 0); PG8_LDB(B1, 0, 1); PG8_SCHED; PG8_LDA(At, 0, 0); PG8_STAGE_A(PG8_SA(1, 1), a1, aoC, 1);
            PG8_WAIT_V(8); PG8_WAIT_L(0); PG8_BAR; if (!HALFSEL || dh0) PG8_MMA(0, 0, At, B0); if (!HALFSEL || dh1) PG8_MMA(0, 1, At, B1); PG8_BAR; PG8_SCHED;
            PG8_LDA(At, 0, 1); PG8_STAGE(PG8_SB(0, 0), b2, voffB); PG8_STAGE(PG8_SB(0, 1), b2 + hstepB, voffB); PG8_STAGE_A(PG8_SA(0, 0), a2, aoS, 0);
            PG8_WAIT_V(8); PG8_WAIT_L(0); PG8_BAR; if (!HALFSEL || dh0) PG8_MMA(1, 0, At, B0); if (!HALFSEL || dh1) PG8_MMA(1, 1, At, B1); PG8_BAR; PG8_SCHED;
            PG8_LDB(B0, 1, 0); PG8_LDB(B1, 1, 1); PG8_SCHED; PG8_LDA(At, 1, 0); PG8_STAGE_A(PG8_SA(0, 1), a2, aoS, 1);
            PG8_WAIT_V(8); PG8_WAIT_L(0); PG8_BAR; if (!HALFSEL || dh0) PG8_MMA(0, 0, At, B0); if (!HALFSEL || dh1) PG8_MMA(0, 1, At, B1); PG8_BAR; PG8_SCHED;
            PG8_LDA(At, 1, 1); PG8_STAGE(PG8_SB(1, 0), b3, voffB); PG8_STAGE(PG8_SB(1, 1), b3 + hstepB, voffB); PG8_STAGE_A(PG8_SA(1, 0), a3, aoS, 0);
            PG8_WAIT_V(8); PG8_WAIT_L(0); PG8_BAR; if (!HALFSEL || dh0) PG8_MMA(1, 0, At, B0); if (!HALFSEL || dh1) PG8_MMA(1, 1, At, B1); PG8_BAR; PG8_SCHED;
        }
        if constexpr (FP8) asm volatile("s_nop 15\n\ts_nop 15" ::: "memory");
        if constexpr (ALIGN_EPI) { if (wr == 0) PG8_BAR; }
        E(acc, cur, wr, wc, fr, fq);
        if (!has_next) break;
#pragma unroll
        for (int a = 0; a < 2; ++a)
#pragma unroll
            for (int b = 0; b < 2; ++b)
#pragma unroll
                for (int m = 0; m < 4; ++m)
#pragma unroll
                    for (int n = 0; n < 2; ++n) acc[a][b][m][n] = (f32x4){0.f, 0.f, 0.f, 0.f};
        if constexpr (FP8) asm volatile("s_nop 7" ::: "memory");
        cur = nxt; cA = nA; cB = nB; ++ui;
        if constexpr (GATHER) {
#pragma unroll
            for (int _h = 0; _h < 2; ++_h)
#pragma unroll
                for (int _i = 0; _i < 2; ++_i) aoC[_h][_i] = aoN[_h][_i]; }
        if constexpr (ALIGN_EPI) { if (wr == 1) PG8_BAR; }
    }
    PG8_WAIT_V(0);
    if constexpr (!ALIGN_EPI) { if (wr == 0) PG8_BAR; }
    PG8_BAR;
#undef PG8_SA
#undef PG8_SB
#undef PG8_STAGE
#undef PG8_STAGE_A
#undef PG8_LDA
#undef PG8_LD8
#undef PG8_LDB
#undef PG8_MMA
#undef PG8_WAIT_V
#undef PG8_WAIT_L
#undef PG8_BAR
#undef PG8_SCHED
#undef PG8_AOFF
}
}
#include <hip/hip_bf16.h>
namespace attn_body {
using bf16=__hip_bfloat16;
using bf16x8=__attribute__((ext_vector_type(8)))short;
using s16x4=__attribute__((ext_vector_type(4)))short;
using f32x16=__attribute__((ext_vector_type(16)))float;
using u32x4=__attribute__((ext_vector_type(4)))unsigned;
constexpr int BATCH=4,NHEAD=16,SEQ=4096,D=64,DM=NHEAD*D;
constexpr int NW=8,QBLK=32,QB=QBLK*NW,KVBLK=64,NQB=SEQ/QB;
constexpr int ATTN_PITCH=DM, ATTN_UNIT_ROWS=QB;
__device__ __forceinline__ int crow(int r,int hi){return (r&3)+8*(r>>2)+4*hi;}
#define SBAR() __builtin_amdgcn_sched_barrier(0)
__device__ __forceinline__ void cmask(f32x16&p0,f32x16&p1,int jb,int qrel,int hi){
  const float NEG=-INFINITY; int d=qrel-64*jb-4*hi; asm volatile("":"+v"(d));
  #pragma unroll
  for(int r=0;r<16;++r){const int c=(r&3)+8*(r>>2); if(c>d)p0[r]=NEG; if(c+32>d)p1[r]=NEG;}
}

constexpr int NSLOT=3, SLOTB=8192;
constexpr int LDS_GT=98304;
constexpr int LDS_K=0, LDS_V=NSLOT*SLOTB, LDS_WS=2*NSLOT*SLOTB, LDS_OST=LDS_WS+NW*64*4, LDS_BYTES=LDS_OST+NW*4096;
constexpr float C2=0.125f*1.4426950408889634f;
__device__ __forceinline__ void glds16(const void*gsrc,unsigned lds_dst){unsigned keep;
  asm volatile("s_mov_b32 %0, m0\n\ts_mov_b32 m0, %2\n\ts_nop 0\n\tglobal_load_lds_dwordx4 %1, off\n\ts_mov_b32 m0, %0":"=&s"(keep):"v"(gsrc),"s"(lds_dst):"memory");}
__device__ __forceinline__ void glds16s(const void*sbase,unsigned voff,unsigned lds_dst){unsigned keep;
  asm volatile("s_nop 4\n\ts_mov_b32 %0, m0\n\ts_mov_b32 m0, %3\n\ts_nop 0\n\tglobal_load_lds_dwordx4 %1, %2\n\ts_mov_b32 m0, %0":"=&s"(keep):"v"(voff),"s"(sbase),"s"(lds_dst):"memory");}
__device__ __forceinline__ unsigned lane_now(){unsigned l;asm volatile("v_mbcnt_lo_u32_b32 %0, -1, 0\n\tv_mbcnt_hi_u32_b32 %0, -1, %0":"=v"(l));return l;}
__device__ __forceinline__ float max3f(float a,float b,float c){float r;asm("v_max3_f32 %0, %1, %2, %3":"=v"(r):"v"(a),"v"(b),"v"(c));return r;}
__device__ __forceinline__ float max2f(float a,float b){float r;asm("v_max_f32_e32 %0, %1, %2":"=v"(r):"v"(a),"v"(b));return r;}
__device__ __forceinline__ float fadd_s(float a,float b){float r;asm("v_add_f32_e32 %0, %1, %2":"=v"(r):"v"(a),"v"(b));return r;}
__device__ __forceinline__ float fsub_s(float a,float b){float r;asm("v_sub_f32_e32 %0, %1, %2":"=v"(r):"v"(a),"v"(b));return r;}
typedef float f32x2_t __attribute__((ext_vector_type(2))); typedef __bf16 bf16x2_t __attribute__((ext_vector_type(2)));
__device__ __forceinline__ unsigned cvtpk_s(float lo,float hi){f32x2_t v={lo,hi};bf16x2_t b=__builtin_convertvector(v,bf16x2_t);return __builtin_bit_cast(unsigned,b);}
#define WAIT_BAR(N) asm volatile("s_waitcnt vmcnt(" #N ") lgkmcnt(0)\n\ts_barrier":::"memory")

__device__ __forceinline__ void qkt(f32x16&p0,f32x16&p1,const char*Kslot,const bf16x8*qr,int r32,int hi){
  const char*kb=Kslot+hi*1024+r32*16;
  #pragma unroll
  for(int d0=0;d0<4;++d0){
    const bf16x8 b0=*reinterpret_cast<const bf16x8*>(kb+d0*2048);
    const bf16x8 b1=*reinterpret_cast<const bf16x8*>(kb+d0*2048+512);
    if(d0==0){p0=__builtin_amdgcn_mfma_f32_32x32x16_bf16(b0,qr[0],(f32x16){0.f,0.f,0.f,0.f,0.f,0.f,0.f,0.f,0.f,0.f,0.f,0.f,0.f,0.f,0.f,0.f},0,0,0);p1=__builtin_amdgcn_mfma_f32_32x32x16_bf16(b1,qr[0],(f32x16){0.f,0.f,0.f,0.f,0.f,0.f,0.f,0.f,0.f,0.f,0.f,0.f,0.f,0.f,0.f,0.f},0,0,0);}
    else{p0=__builtin_amdgcn_mfma_f32_32x32x16_bf16(b0,qr[d0],p0,0,0,0);p1=__builtin_amdgcn_mfma_f32_32x32x16_bf16(b1,qr[d0],p1,0,0,0);}}
}
typedef __attribute__((address_space(3))) const char* lds_cptr;
typedef short v4i16_t __attribute__((ext_vector_type(4)));
__device__ __forceinline__ void kload8(bf16x8*kf,lds_cptr kp){
  kf[0]=*(const __attribute__((address_space(3))) bf16x8*)(kp);      kf[1]=*(const __attribute__((address_space(3))) bf16x8*)(kp+512);
  kf[2]=*(const __attribute__((address_space(3))) bf16x8*)(kp+2048); kf[3]=*(const __attribute__((address_space(3))) bf16x8*)(kp+2560);
  kf[4]=*(const __attribute__((address_space(3))) bf16x8*)(kp+4096); kf[5]=*(const __attribute__((address_space(3))) bf16x8*)(kp+4608);
  kf[6]=*(const __attribute__((address_space(3))) bf16x8*)(kp+6144); kf[7]=*(const __attribute__((address_space(3))) bf16x8*)(kp+6656);
}
__device__ __forceinline__ void kload2(bf16x8*kf,lds_cptr kp,int j){ kf[2*j]=*(const __attribute__((address_space(3))) bf16x8*)(kp+j*2048); kf[2*j+1]=*(const __attribute__((address_space(3))) bf16x8*)(kp+j*2048+512); }
__device__ __forceinline__ s16x4 vtr(lds_cptr p){ return __builtin_bit_cast(s16x4,__builtin_amdgcn_ds_read_tr16_b64_v4i16((__attribute__((address_space(3))) v4i16_t*)p)); }
__device__ __forceinline__ float rowmax(const f32x16&p0,const f32x16&p1){
  float a=max3f(p0[0],p0[1],p1[0]),b=max3f(p0[2],p0[3],p1[1]);a=max3f(a,p1[2],p1[3]);
  #pragma unroll
  for(int r=4;r<16;r+=4){a=max3f(a,p0[r],p0[r+1]);b=max3f(b,p0[r+2],p0[r+3]);a=max3f(a,p1[r],p1[r+1]);b=max3f(b,p1[r+2],p1[r+3]);}
  const float m=max2f(a,b);
  auto rr=__builtin_amdgcn_permlane32_swap(__float_as_uint(m),__float_as_uint(m),false,false);
  return max2f(__uint_as_float(rr[0]),__uint_as_float(rr[1]));
}
__device__ __forceinline__ void pv(f32x16*o,int vb,bf16x8 pa0,bf16x8 pa1,bf16x8 pa2,bf16x8 pa3){
  #pragma unroll
  for(int d0=0;d0<2;++d0){s16x4 lo[4],hi[4];
    #pragma unroll
    for(int ks=0;ks<4;++ks){
      asm volatile("ds_read_b64_tr_b16 %0,%1 offset:%c2":"=&v"(lo[ks]):"v"(vb),"i"(d0*4096+ks*1024):"memory");
      asm volatile("ds_read_b64_tr_b16 %0,%1 offset:%c2":"=&v"(hi[ks]):"v"(vb),"i"(d0*4096+ks*1024+512):"memory");}
    asm volatile("s_waitcnt lgkmcnt(0)":::"memory");SBAR();
    #define PK(k) (bf16x8){lo[k][0],lo[k][1],lo[k][2],lo[k][3],hi[k][0],hi[k][1],hi[k][2],hi[k][3]}
    o[d0]=__builtin_amdgcn_mfma_f32_32x32x16_bf16(pa0,PK(0),o[d0],0,0,0);
    o[d0]=__builtin_amdgcn_mfma_f32_32x32x16_bf16(pa1,PK(1),o[d0],0,0,0);
    o[d0]=__builtin_amdgcn_mfma_f32_32x32x16_bf16(pa2,PK(2),o[d0],0,0,0);
    o[d0]=__builtin_amdgcn_mfma_f32_32x32x16_bf16(pa3,PK(3),o[d0],0,0,0);
    #undef PK
  }
}

#ifndef ATTN_STORE16
#define ATTN_STORE16(p,v) (*(u32x4*)(p)=(v))
#endif
template<int THRL> __device__ __forceinline__ void attn_unit(int b,int h,int qb,const bf16*Q,const bf16*__restrict__ K,const bf16*__restrict__ V,bf16*O,const float*ksum,char*shm){
  const int tid=threadIdx.x,lane=tid&63,r32=lane&31,hi=lane>>5; const int wid=__builtin_amdgcn_readfirstlane(tid>>6);
  const long rowbase=(long)b*SEQ; const int q0=qb*QB;
  const bf16*Qw=Q+(rowbase+q0+wid*QBLK)*DM+h*D;
  const bf16*Kh=K+rowbase*DM+h*D,*Vh=V+rowbase*DM+h*D;
  const unsigned lds0=(unsigned)(uintptr_t)shm;
  float*wsf=(float*)(shm+LDS_WS)+wid*64;
  const unsigned kdst=lds0+LDS_K+wid*1024, vdst=lds0+LDS_V+wid*1024;
  #define PHYS(t) (((t)<4)?(4*qb+(t)):((t)-4))
  #define DMA_K(t,slot) glds16s((const char*)Kh+(size_t)PHYS(t)*(KVBLK*DM*2)+wid*16,lane_now()*(unsigned)(DM*2),(unsigned)__builtin_amdgcn_readfirstlane(kdst+(slot)))
  #define DMA_V(t,slot) glds16s((const char*)Vh+(size_t)PHYS(t)*(KVBLK*DM*2)+(size_t)(16*(wid&3))*(DM*2)+(wid>>2)*64,({const unsigned l_=lane_now(); (l_>>2)*(unsigned)(DM*2)+(l_&3u)*16u;}),(unsigned)__builtin_amdgcn_readfirstlane(vdst+(slot)))
  const int vb0=(int)(lds0+LDS_V)+((lane>>4)&1)*32+(lane&3)*8+(4*hi+((lane&15)>>2))*64;
  const char*Kbase=shm+LDS_K; bf16x8 kf[8];
  const lds_cptr shm3=(lds_cptr)shm; const lds_cptr kp0=shm3+LDS_K+hi*1024+r32*16; const lds_cptr vp0=shm3+LDS_V+((lane>>4)&1)*32+(lane&3)*8+(4*hi+((lane&15)>>2))*64;
  const int NT=(q0+QB)/KVBLK;
  DMA_K(0,0);DMA_V(0,0);DMA_K(1,SLOTB);
  { float*gt=(float*)(shm+LDS_GT);
    #pragma unroll
    for(int k=0;k<2;++k){ const int j=2*wid+k; if(j<qb) gt[j*64+lane]=ksum[(long)(b*16+j)*DM+h*D+lane]; } }
  bf16x8 qr[4];
  #pragma unroll
  for(int d0=0;d0<4;++d0)qr[d0]=*reinterpret_cast<const bf16x8*>(&Qw[(long)r32*DM+d0*16+hi*8]);

  unsigned sel=0u;
  float mhat=0.f,l_reg=0.f;f32x16 o[2];o[0]=f32x16{};o[1]=f32x16{};
  bf16x8 kone=(bf16x8){0,0,0,0,0,0,0,0}, qm=(bf16x8){0,0,0,0,0,0,0,0}; if(hi==0) kone[0]=(short)0x3F80;
  #define SETQM() do{ const unsigned short mb_=(unsigned short)(cvtpk_s(-mhat,0.f)&0xffffu); qm[0]=(hi==0)?(short)mb_:(short)0; asm volatile("":"+v"(qm)); }while(0)
  const int qrel=wid*QBLK+r32;
  #define CMASK(P0,P1,t) do{ const int t_=(t); if(t_<4){ const int l_=(int)lane_now(); cmask(P0,P1,t_,wid*QBLK+(l_&31),l_>>5); } else if(!((sel>>(((t_-4)>>2)&15))&1u)){ _Pragma("unroll") for(int r=0;r<16;++r){P0[r]=-INFINITY;P1[r]=-INFINITY;} } }while(0)
  bool resc=false;
  #define START(P0,P1) do{ const float rm=rowmax(P0,P1); resc=false; \
    { const float dl=__uint_as_float(cvtpk_s(rm,0.f)<<16); mhat=fadd_s(mhat,dl);          \
      _Pragma("unroll") for(int r=0;r<16;++r){P0[r]=fsub_s(P0[r],dl);P1[r]=fsub_s(P1[r],dl);} \
      SETQM(); } \
    _Pragma("unroll") for(int r=0;r<16;++r)P0[r]=__builtin_amdgcn_exp2f(P0[r]); }while(0)
  #define RESC() do{ if(resc){ asm volatile("s_waitcnt lgkmcnt(0)":::"memory"); \
      _Pragma("unroll") for(int d_=0;d_<2;++d_) _Pragma("unroll") for(int r=0;r<16;++r)o[d_][r]*=wsf[crow(r,(int)(lane_now()>>5))]; } }while(0)
  f32x16 pA0,pA1,pB0,pB1;
  int sl_prev=0,sl_cur=0,sl_next=SLOTB;
  #define ROT() do{sl_prev=sl_cur;sl_cur=sl_next;sl_next=(sl_next==(NSLOT-1)*SLOTB)?0:sl_next+SLOTB;}while(0)
  DMA_K(2,2*SLOTB);
  WAIT_BAR(3);
  { float qf[32];
    #pragma unroll
    for(int d0=0;d0<4;++d0){
      #pragma unroll
      for(int i=0;i<8;++i) qf[d0*8+i]=__uint_as_float(((unsigned)(unsigned short)qr[d0][i])<<16); }
    const float*gt=(const float*)(shm+LDS_GT)+hi*8; float g[15];
    #pragma unroll
    for(int j=0;j<15;++j){ g[j]=-INFINITY;
      if(j<qb){ const float*kp=gt+j*64; float a=0.f;
        #pragma unroll
        for(int d0=0;d0<4;++d0){ const float4 k0=*reinterpret_cast<const float4*>(kp+d0*16), k1=*reinterpret_cast<const float4*>(kp+d0*16+4);
          a+=qf[d0*8+0]*k0.x; a+=qf[d0*8+1]*k0.y; a+=qf[d0*8+2]*k0.z; a+=qf[d0*8+3]*k0.w; a+=qf[d0*8+4]*k1.x; a+=qf[d0*8+5]*k1.y; a+=qf[d0*8+6]*k1.z; a+=qf[d0*8+7]*k1.w; }
        g[j]=a+__shfl_xor(a,32); } }
    #pragma unroll
    for(int kk=0;kk<3;++kk){ float best=-INFINITY; int bj=-1;
      #pragma unroll
      for(int j=0;j<15;++j){ const bool c=(j<qb)&&!((sel>>j)&1u)&&(g[j]>best); best=c?g[j]:best; bj=c?j:bj; }
      if(bj>=0) sel|=(1u<<bj); } }
  qkt(pA0,pA1,Kbase,qr,r32,hi);asm volatile("s_nop 15\n\ts_nop 7":"+v"(pA0),"+v"(pA1));CMASK(pA0,pA1,0);
  START(pA0,pA1);
  _Pragma("unroll") for(int r=0;r<16;++r)pA1[r]=__builtin_amdgcn_exp2f(pA1[r]);
  WAIT_BAR(0);
  DMA_K(3,0);DMA_V(1,SLOTB);
  ROT();
  kload8(kf,kp0+sl_cur);
  WAIT_BAR(2);
  s16x4 vlo[8],vhi[8]; u32x4 pw0,pw1,pw2,pw3;
  #define PKW(P,B) cvtpk_s(P[B],P[B+1])
  #define PAF(k) __builtin_bit_cast(bf16x8,pw##k)
  #define VFR(i) (bf16x8){vlo[i][0],vlo[i][1],vlo[i][2],vlo[i][3],vhi[i][0],vhi[i][1],vhi[i][2],vhi[i][3]}
  #define PIN(x) asm volatile("":"+v"(x))
  #define MX3(a,b,c) __builtin_fmaxf(__builtin_fmaxf((a),(b)),(c))
  #define GAPA(MF,A0,A1,A2,A3,W0,W1,PW) do{ MF; sacc+=A0; sacc+=A1; sacc+=A2; sacc+=A3; PIN(sacc); W0; W1; PIN(PW); SBAR(); }while(0)
  #define EX(v) __builtin_amdgcn_exp2f(v)
  #define GAPB(MF,X,B) do{ MF; X[B]=EX(X[B]); X[B+1]=EX(X[B+1]); X[B+2]=EX(X[B+2]); X[B+3]=EX(X[B+3]); PIN(X); SBAR(); }while(0)
  #define VRD(i) do{ vlo[i]=vtr(vp_+(((i)>>2)*4096+((i)&3)*1024)); vhi[i]=vtr(vp_+(((i)>>2)*4096+((i)&3)*1024+512)); }while(0)
  #define KRD(G,j) do{ if(G){ kload2(kf,kp0+sl_next,j); SBAR(); } }while(0)
  #define STEP(C0,C1,P0,P1,t,GK,GV,GL) do{ SBAR(); \
    const lds_cptr vp_=vp0+sl_prev; \
    C0=__builtin_amdgcn_mfma_f32_32x32x16_bf16(kone,qm,(f32x16){0.f,0.f,0.f,0.f,0.f,0.f,0.f,0.f,0.f,0.f,0.f,0.f,0.f,0.f,0.f,0.f},0,0,0); C1=__builtin_amdgcn_mfma_f32_32x32x16_bf16(kone,qm,(f32x16){0.f,0.f,0.f,0.f,0.f,0.f,0.f,0.f,0.f,0.f,0.f,0.f,0.f,0.f,0.f,0.f},0,0,0); SBAR(); \
    VRD(0); SBAR(); float sacc=(P0[0]+P0[1]); \
    GAPA(C0=__builtin_amdgcn_mfma_f32_32x32x16_bf16(kf[0],qr[0],C0,0,0,0), P0[2],P0[3],P0[4],P0[5],     pw0[0]=PKW(P0,0), pw0[1]=PKW(P0,2), pw0); \
    VRD(4); SBAR(); GAPA(C1=__builtin_amdgcn_mfma_f32_32x32x16_bf16(kf[1],qr[0],C1,0,0,0), P0[6],P0[7],P0[8],P0[9],     pw0[2]=PKW(P0,4), pw0[3]=PKW(P0,6), pw0); \
    VRD(1); SBAR(); GAPA(C0=__builtin_amdgcn_mfma_f32_32x32x16_bf16(kf[2],qr[1],C0,0,0,0),   P0[10],P0[11],P0[12],P0[13], pw1[0]=PKW(P0,8), pw1[1]=PKW(P0,10), pw1); \
    VRD(5); SBAR(); GAPA(C1=__builtin_amdgcn_mfma_f32_32x32x16_bf16(kf[3],qr[1],C1,0,0,0),   P0[14],P0[15],P1[0],P1[1],   pw1[2]=PKW(P0,12),pw1[3]=PKW(P0,14), pw1); \
    VRD(2); SBAR(); GAPA(C0=__builtin_amdgcn_mfma_f32_32x32x16_bf16(kf[4],qr[2],C0,0,0,0),   P1[2],P1[3],P1[4],P1[5],     pw2[0]=PKW(P1,0), pw2[1]=PKW(P1,2), pw2); \
    VRD(6); SBAR(); GAPA(C1=__builtin_amdgcn_mfma_f32_32x32x16_bf16(kf[5],qr[2],C1,0,0,0),   P1[6],P1[7],P1[8],P1[9],     pw2[2]=PKW(P1,4), pw2[3]=PKW(P1,6), pw2); \
    VRD(3); SBAR(); GAPA(C0=__builtin_amdgcn_mfma_f32_32x32x16_bf16(kf[6],qr[3],C0,0,0,0),   P1[10],P1[11],P1[12],P1[13], pw3[0]=PKW(P1,8), pw3[1]=PKW(P1,10), pw3); \
    VRD(7); SBAR(); GAPA(C1=__builtin_amdgcn_mfma_f32_32x32x16_bf16(kf[7],qr[3],C1,0,0,0),   P1[14],P1[15],0.f,0.f,       pw3[2]=PKW(P1,12),pw3[3]=PKW(P1,14), pw3); \
    l_reg+=sacc; \
    if(GK){DMA_K((t)+3,sl_cur);} if(GV){DMA_V((t)+1,sl_next);} \
    CMASK(C0,C1,t); \
    { float a=MX3(C0[0],C0[1],C1[0]),b=MX3(C0[2],C0[3],C1[1]); a=MX3(a,C1[2],C1[3]); \
      _Pragma("unroll") for(int r=4;r<16;r+=4){a=MX3(a,C0[r],C0[r+1]);b=MX3(b,C0[r+2],C0[r+3]);a=MX3(a,C1[r],C1[r+1]);b=MX3(b,C1[r+2],C1[r+3]);} \
      float rm=__builtin_fmaxf(a,b); { auto rr=__builtin_amdgcn_permlane32_swap(__float_as_uint(rm),__float_as_uint(rm),false,false); rm=__builtin_fmaxf(__uint_as_float(rr[0]),__uint_as_float(rr[1])); } \
      resc=false; \
      if(__builtin_expect(__any(rm>(float)THRL),0)){ const float mn_=__uint_as_float(cvtpk_s(mhat+__builtin_fmaxf(rm,0.f),0.f)<<16); const float dl=mn_-mhat; mhat=mn_; \
        _Pragma("unroll") for(int r=0;r<16;++r){C0[r]-=dl;C1[r]-=dl;} \
        SETQM(); \
        const float f=__builtin_amdgcn_exp2f(-dl); l_reg*=f; { const int l_=(int)lane_now(); if((l_>>5)==0)wsf[l_&31]=f; } resc=true; } } \
    SBAR(); \
    GAPB(o[0]=__builtin_amdgcn_mfma_f32_32x32x16_bf16(PAF(0),VFR(0),o[0],0,0,0), C0,0); \
    GAPB(o[1]=__builtin_amdgcn_mfma_f32_32x32x16_bf16(PAF(0),VFR(4),o[1],0,0,0), C0,4); \
    KRD(GL,0); GAPB(o[0]=__builtin_amdgcn_mfma_f32_32x32x16_bf16(PAF(1),VFR(1),o[0],0,0,0), C0,8); \
    KRD(GL,1); GAPB(o[1]=__builtin_amdgcn_mfma_f32_32x32x16_bf16(PAF(1),VFR(5),o[1],0,0,0), C0,12); \
    KRD(GL,2); GAPB(o[0]=__builtin_amdgcn_mfma_f32_32x32x16_bf16(PAF(2),VFR(2),o[0],0,0,0), C1,0); \
    KRD(GL,3); GAPB(o[1]=__builtin_amdgcn_mfma_f32_32x32x16_bf16(PAF(2),VFR(6),o[1],0,0,0), C1,4); \
    GAPB(o[0]=__builtin_amdgcn_mfma_f32_32x32x16_bf16(PAF(3),VFR(3),o[0],0,0,0), C1,8); \
    GAPB(o[1]=__builtin_amdgcn_mfma_f32_32x32x16_bf16(PAF(3),VFR(7),o[1],0,0,0), C1,12); \
    }while(0)
  int t=1;
  #undef CMASK
  #define CMASK(P0,P1,t) do{ const int t_=(t); if(t_<4){ const int l_=(int)lane_now(); cmask(P0,P1,t_,wid*QBLK+(l_&31),l_>>5); } else if(!((sel>>(((t_-4)>>2)&15))&1u)){ _Pragma("unroll") for(int r=0;r<16;++r){P0[r]=-INFINITY;P1[r]=-INFINITY;} } }while(0)
  for(;t+5<NT;t+=2){
    STEP(pB0,pB1,pA0,pA1,t,true,true,true);     WAIT_BAR(2); RESC(); ROT();
    STEP(pA0,pA1,pB0,pB1,t+1,true,true,true);   WAIT_BAR(2); RESC(); ROT();
  }
  #undef CMASK
  #define CMASK(P0,P1,t) do{ const int t_=(t); if(t_<4){ const int l_=(int)lane_now(); cmask(P0,P1,t_,wid*QBLK+(l_&31),l_>>5); } else if(!((sel>>(((t_-4)>>2)&15))&1u)){ _Pragma("unroll") for(int r=0;r<16;++r){P0[r]=-INFINITY;P1[r]=-INFINITY;} } }while(0)
  #define ENDW(tt) do{ if((tt)+3<NT){WAIT_BAR(2);} else if((tt)+2<NT){WAIT_BAR(1);} else {WAIT_BAR(0);} }while(0)
  for(;t+1<NT;t+=2){
    STEP(pB0,pB1,pA0,pA1,t,(t+3<NT),(t+1<NT),(t+1<NT));       ENDW(t);   RESC(); ROT();
    STEP(pA0,pA1,pB0,pB1,t+1,(t+4<NT),(t+2<NT),(t+2<NT));     ENDW(t+1); RESC(); ROT();
  }
  STEP(pB0,pB1,pA0,pA1,NT-1,false,false,false); RESC();
  { float sacc=pB0[0]+pB0[1]; _Pragma("unroll") for(int r=2;r<16;++r)sacc+=pB0[r]; _Pragma("unroll") for(int r=0;r<16;++r)sacc+=pB1[r]; l_reg+=sacc;
    pw0=(u32x4){PKW(pB0,0),PKW(pB0,2),PKW(pB0,4),PKW(pB0,6)};pw1=(u32x4){PKW(pB0,8),PKW(pB0,10),PKW(pB0,12),PKW(pB0,14)};pw2=(u32x4){PKW(pB1,0),PKW(pB1,2),PKW(pB1,4),PKW(pB1,6)};pw3=(u32x4){PKW(pB1,8),PKW(pB1,10),PKW(pB1,12),PKW(pB1,14)};
    SBAR(); pv(o,vb0+sl_cur,PAF(0),PAF(1),PAF(2),PAF(3)); }
  #undef PKW
  #undef PAF
  #undef VFR
  #undef PIN
  #undef MX3
  #undef GAPA
  #undef GAPB
  #undef EX
  #undef VRD
  #undef KRD
  #undef STEP
  #undef ENDW
  {auto rr=__builtin_amdgcn_permlane32_swap(__float_as_uint(l_reg),__float_as_uint(l_reg),false,false);l_reg=__uint_as_float(rr[0])+__uint_as_float(rr[1]);}
  if(hi==0)wsf[32+r32]=l_reg;asm volatile("s_waitcnt lgkmcnt(0)":::"memory");
  float rli[16];
  #pragma unroll
  for(int r=0;r<16;++r)rli[r]=__builtin_amdgcn_rcpf(wsf[32+crow(r,hi)]);
  bf16*Ow=O+(rowbase+q0+wid*QBLK)*DM+h*D;
  { bf16*stg=(bf16*)(shm+LDS_OST)+wid*2048;
    #pragma unroll
    for(int r=0;r<16;++r){const int orow=crow(r,hi);
      #pragma unroll
      for(int d0=0;d0<2;++d0)stg[orow*64+d0*32+r32]=__float2bfloat16(o[d0][r]*rli[r]);}
    asm volatile("s_waitcnt lgkmcnt(0)":::"memory");
    #pragma unroll
    for(int i=0;i<4;++i){const int row=i*8+(lane>>3),ch=lane&7; const u32x4 v=*(const u32x4*)(stg+row*64+ch*8); ATTN_STORE16(Ow+(long)row*DM+ch*8,v);} }
  asm volatile("s_waitcnt lgkmcnt(0)\n\ts_barrier":::"memory");
  #undef DMA_K
  #undef PHYS
  #undef DMA_V
  #undef CMASK
  #undef START
  #undef SETQM
  #undef RESC
  #undef ROT
}
constexpr int ATTN_LDS_BYTES=LDS_BYTES;
struct AttnTensors { const bf16* Q; const bf16* K; const bf16* V; bf16* O; const float* ksum; };
struct AttnUnit { int bh; int qb; };
struct StaticOrder {
  int vcu, G;
  __device__ __forceinline__ explicit StaticOrder(int grid,int block):vcu((grid%8==0)?((block%8)*(grid/8)+block/8):block),G(grid){}
  __device__ __forceinline__ bool next(int i,AttnUnit&u)const{ const int L=i*G+vcu; if(L>=1024)return false; const int w=L&255, rnd=L>>8, s=w&3; u.bh=w>>2; u.qb=(rnd==0)?s:(rnd==1)?7-s:(rnd==2)?8+s:15-s; return true; }
  __device__ __forceinline__ void a_ready(const AttnUnit&)const{}
  __device__ __forceinline__ void done(const AttnUnit&)const{}
};
struct SnakeOrder {
  int v, G;
  __device__ __forceinline__ bool next(int i,AttnUnit&u)const{ const int idx=i*G+((i&1)?(G-1-v):v); if(idx>=1024)return false; u.qb=15-(idx>>6); u.bh=idx&63; return true; }
  __device__ __forceinline__ void a_ready(const AttnUnit&)const{}
  __device__ __forceinline__ void done(const AttnUnit&)const{}
};
template<class Sched,int THRL=8> __device__ __forceinline__ void attn_phase(char*lds,const AttnTensors&T,const Sched&S){
  AttnUnit u;
  for(int i=0;S.next(i,u);++i){ S.a_ready(u); attn_unit<THRL>(u.bh/NHEAD,u.bh%NHEAD,u.qb,T.Q,T.K,T.V,T.O,T.ksum,lds); S.done(u); }
}
#undef SBAR
#undef WAIT_BAR
}
constexpr int NWAVES = 8, NTHR = 512;
constexpr int NTOK = 16384, DM = 1024, SEQ = 4096, NBATCH = 4, NEXP = 32;
constexpr float ALPHA = 1.4142135623730951f;
constexpr float LN_EPS = 1e-5f;
constexpr float RSQRT_DQK = 0.08838834764831845f;
constexpr int NPHASE = 19;
constexpr float FP8_SA = 4.0f, FP8_SWGU = 64.0f, FP8_SWD = 128.0f;
constexpr float FP8_SY = 32.0f, FP8_MAXV = 448.0f;
#ifndef DBG_ATTN_MUL
#define DBG_ATTN_MUL 1.0f
#endif
#ifndef DBG_MLSTM_MUL
#define DBG_MLSTM_MUL 1.0f
#endif
#ifndef DBG_MOE_MUL
#define DBG_MOE_MUL 1.0f
#endif
#ifndef DBG_P14_A
#define DBG_P14_A WS_HN
#endif
#ifndef NCONV
#define NCONV 80
#endif
#ifndef MK_ONE_LAUNCH
#define MK_ONE_LAUNCH 1
#endif

constexpr size_t MiB = 1u << 20, KiB = 1024;
constexpr size_t WS_CTL = 0, CTL_ZERO_BYTES = 1 * MiB;
constexpr int CW_TMO = 0, CW_BAR = 4096, CW_CNT = 8192, CW_AQ = 16384;
constexpr size_t WS_KSUM = 256 * KiB, WS_DEN = 512 * KiB;
constexpr size_t WS_WQKV = 2 * MiB, WS_WO = 8 * MiB, WS_WINA = 10 * MiB, WS_WINB = 14 * MiB, WS_WOUT = 17 * MiB;
constexpr size_t WS_WG = 19 * MiB, WS_RWT = 20 * MiB, WS_ROPE = 21 * MiB;
constexpr size_t WS_TOKE = 22 * MiB, WS_TOKP = 22 * MiB + 256 * KiB, WS_TOKG = 22 * MiB + 512 * KiB;
constexpr size_t WS_GI = 23 * MiB, WS_LF = 23 * MiB + 256 * KiB, WS_RF = 23 * MiB + 512 * KiB, WS_CF = 23 * MiB + 768 * KiB;
constexpr size_t WS_DEC = 24 * MiB, WS_NU = 24 * MiB + 256 * KiB, WS_NPREV = 24 * MiB + 512 * KiB;
constexpr size_t WS_ROWTOK = 25 * MiB;
constexpr size_t WS_XB = 32 * MiB, WS_Q = 64 * MiB, WS_K = 96 * MiB, WS_V = 128 * MiB;
constexpr size_t WS_R0 = 160 * MiB, WS_R1 = 224 * MiB, WS_R2 = 288 * MiB;
constexpr size_t WS_H = 352 * MiB, WS_Y = 496 * MiB;
constexpr size_t WS_WGU = 640 * MiB, WS_WD = 896 * MiB, WS_END = 1024 * MiB;
constexpr size_t WS_AE = 352 * MiB, WS_BE = 416 * MiB, WS_KN = 464 * MiB, WS_KT = 496 * MiB, WS_UT = 512 * MiB, WS_OS = 544 * MiB, WS_HN = 576 * MiB;

constexpr int RING_OFF = 0, RING_BYTES = 131072;
constexpr int LX = RING_BYTES;
constexpr int LX_MISC = LX;
constexpr int LX_TILEE = LX + 128;
constexpr int LX_TBASE = LX + 1280;
constexpr int LX_LCNT = LX + 1536, LX_GBASE = LX + 1664;
constexpr int LX_REC = LX + 1792;
constexpr int LX_TOKL = LX + 4096;
constexpr int LX_LNX = LX + 4096;
constexpr int LX_BIAS = LX + 12288;
constexpr int LDS_BYTES = 147456;
constexpr int TOKL_ROUNDS = 10;

#define RLX_AGENT __ATOMIC_RELAXED, __HIP_MEMORY_SCOPE_AGENT
#define LDS_WAIT() asm volatile("s_waitcnt lgkmcnt(0)" ::: "memory")
#define VM_WAIT() asm volatile("s_waitcnt vmcnt(0)" ::: "memory")
#define XB_TMO      128
#define XB_XCNT(j)  (256  + 64 * (j))
#define XB_XSUB(j)  (1280 + 64 * (j))
#define XB_XGEN(j)  (2304 + 64 * (j))
#define XB_TOP      3328
#define XB_TOPGEN   3392
#define XCD_BAR_WORDS 3456
#define XB_SPIN_CAP (1u << 18)

__device__ __forceinline__ unsigned xb_ld(unsigned* p)              { return __hip_atomic_load(p, __ATOMIC_RELAXED, __HIP_MEMORY_SCOPE_AGENT); }
__device__ __forceinline__ unsigned xb_add(unsigned* p, unsigned v) { return __hip_atomic_fetch_add(p, v, __ATOMIC_RELAXED, __HIP_MEMORY_SCOPE_AGENT); }
__device__ __forceinline__ unsigned xb_xcc_id() { return (unsigned)__builtin_amdgcn_s_getreg((3 << 11) | 20) & 0xFu; }
#define XB_SPIN(cond, bar) do { unsigned _sp = 0; while (cond) { __builtin_amdgcn_s_sleep(1); \
    if ((++_sp & 255u) == 0u) { if (xb_ld(&(bar)[XB_TMO])) break; if (_sp > XB_SPIN_CAP) { atomicAdd(&(bar)[XB_TMO], 1u); break; } } } } while (0)

struct XcdBarrier {
    unsigned* bar; unsigned x;
    volatile LAS unsigned* st;
};

__device__ __forceinline__ XcdBarrier xcd_barrier_post(unsigned* bar, volatile LAS unsigned* st) {
    XcdBarrier b; b.bar = bar; b.x = xb_xcc_id(); b.st = st;
    if (threadIdx.x == 0) (void)xb_add(&bar[XB_XCNT(b.x)], 1u);
    return b;
}
__device__ __forceinline__ void xcd_barrier_complete(unsigned* bar, unsigned x, unsigned& nloc, unsigned& nx) {
    const unsigned G = gridDim.x * gridDim.y * gridDim.z;
    unsigned sum, cnt, mine, sp = 0u;
    for (;;) {
        sum = 0u; cnt = 0u; mine = 0u;
#pragma unroll
        for (unsigned j = 0; j < 16; ++j) { const unsigned c = xb_ld(&bar[XB_XCNT(j)]); sum += c; cnt += (c > 0u) ? 1u : 0u; mine = (j == x) ? c : mine; }
        if (sum == G) break;
        __builtin_amdgcn_s_sleep(1);
        if ((++sp & 255u) == 0u) { if (xb_ld(&bar[XB_TMO])) break; if (sp > XB_SPIN_CAP) { atomicAdd(&bar[XB_TMO], 1u); break; } }
    }
    nloc = mine > 0u ? mine : 1u; nx = cnt > 0u ? cnt : 1u;
}

__device__ __forceinline__ void xcd_barrier(const XcdBarrier& b) {
    asm volatile("s_waitcnt vmcnt(0)" ::: "memory");
    __syncthreads();
    if (threadIdx.x == 0) {
        unsigned* bar = b.bar;
        __builtin_amdgcn_s_waitcnt(0);
        unsigned nloc = b.st[0], nx = b.st[1];
        if (nloc == 0u) { xcd_barrier_complete(bar, b.x, nloc, nx); b.st[0] = nloc; b.st[1] = nx; }
        const unsigned old = xb_add(&bar[XB_XSUB(b.x)], 1u);
        const unsigned gen = old / nloc;
        if (old + 1u == (gen + 1u) * nloc) {
            __builtin_amdgcn_fence(__ATOMIC_RELEASE, "agent");
            asm volatile("s_waitcnt vmcnt(0)" ::: "memory");
            const unsigned og = xb_add(&bar[XB_TOP], 1u);
            const unsigned tg = og / nx;
            if (og + 1u == (tg + 1u) * nx) xb_add(&bar[XB_TOPGEN], 1u);
            else XB_SPIN(xb_ld(&bar[XB_TOPGEN]) == tg, bar);
            __builtin_amdgcn_fence(__ATOMIC_ACQUIRE, "agent");
            xb_add(&bar[XB_XGEN(b.x)], 1u);
            asm volatile("s_waitcnt vmcnt(0)" ::: "memory");
        } else {
            XB_SPIN(xb_ld(&bar[XB_XGEN(b.x)]) == gen, bar);
            __builtin_amdgcn_fence(__ATOMIC_ACQUIRE, "agent");
            asm volatile("s_waitcnt vmcnt(0)" ::: "memory");
        }
    }
    __syncthreads();
}
using pg8::Unit; using pg8::Gemm;
typedef f32x4 (&AccRef)[2][2][4][2];

#ifndef TAIL_FIRST
#define TAIL_FIRST 0
#endif
__device__ __forceinline__ bool moe_unit(int i, int G, int c, int nT, int nN, int& pm, int& pn, int& half) {
    const int U = nT * nN, R = U / G, rem = U - R * G; half = 0;
#if TAIL_FIRST
    if (rem > 0 && 2 * rem <= G) {
        if (c < 2 * rem) { if (i == 0) { half = 1 + (c & 1); return pg8::tile_order(0, U, R * G + (c >> 1), nT, nN, pm, pn); } --i; }
        if (i < R) return pg8::tile_order(i, G, c, nT, nN, pm, pn);
        return false; }
#endif
    if (i < R) return pg8::tile_order(i, G, c, nT, nN, pm, pn);
    if (i > R || rem == 0) return false;
    if (2 * rem <= G) { if (c >= 2 * rem) return false; half = 1 + (c & 1); return pg8::tile_order(0, U, R * G + (c >> 1), nT, nN, pm, pn); }
    return pg8::tile_order(i, G, c, nT, nN, pm, pn);
}
struct DenseSched {
    int nM, nN, G, c; const char* A; const char* B; size_t tstepA, tstepB; bool split = false;
    __device__ __forceinline__ bool next(int i, Unit& u) const {
        int half = 0;
        if (split) { if (!moe_unit(i, G, c, nM, nN, u.pm, u.pn, half)) return false; }
        else if (!pg8::tile_order(i, G, c, nM, nN, u.pm, u.pn)) return false;
        u.A = A + (size_t)u.pm * tstepA; u.B = B + (size_t)u.pn * tstepB; u.tl = nullptr; u.x0 = u.x1 = 0; u.x2 = half; return true; }
};
struct MoeSched {
    int nT, nN, G, c; const LAS int* tile_e; const LAS int* tbase; const LAS unsigned short* tokl;
    const char* A; const char* B; size_t tstepA, estepB, tstepB;
    __device__ __forceinline__ bool next(int i, Unit& u) const {
        int half; if (!moe_unit(i, G, c, nT, nN, u.pm, u.pn, half)) return false;
        const int e = tile_e[u.pm];
        u.x0 = e; u.x1 = u.pm * 256; u.x2 = half;
        u.A = A + (size_t)u.pm * tstepA; u.B = B + (size_t)e * estepB + (size_t)u.pn * tstepB;
        u.tl = tokl ? tokl + (i < TOKL_ROUNDS ? i : TOKL_ROUNDS - 1) * 256 : nullptr; return true; }
};
struct MuSched {
    int G, c, mode; const char* A; const char* B;
    __device__ __forceinline__ bool next(int i, Unit& u) const {
        const int mu = i * G + c; if (mu >= 256) return false;
        const int b = mu >> 6, hh = (mu >> 4) & 3, ch = mu & 15; const size_t tok0 = (size_t)b * SEQ + (size_t)ch * 256;
        u.pm = mu; u.pn = 0; u.x0 = mu; u.x1 = 0; u.x2 = (mode == 0) ? 1 : 0; u.tl = nullptr;
        if (mode == 0) { u.A = A + (size_t)mu * 256 * 384 * 2; u.B = B + ((size_t)(hh * 128) * NTOK + tok0) * 2; }
        else if (mode == 1) { u.A = A + ((size_t)mu * 256 * 512 + 256) * 2; u.B = B + (tok0 * 1024 + (size_t)hh * 256) * 2; }
        else { u.A = A + (size_t)mu * 256 * 512 * 2; u.B = B + (size_t)mu * 256 * 384 * 2; }
        return true; }
};

constexpr float C2 = 0.125f * 1.4426950408889634f;

struct EpiQKV {
    static constexpr bool PERM = true;
    __device__ __forceinline__ void prep(const Unit&, int, int, int) const {}
    bf16_t* Q; bf16_t* K; bf16_t* V; const float* rope; float* ksum;
    __device__ __forceinline__ void operator()(AccRef acc, const Unit& u, int wr, int wc, int fr, int fq) const {
        asm volatile("" : "+v"(fr), "+v"(fq));
        const int part = u.pn >> 2, colt = (u.pn & 3) * 256;
        bf16_t* base = Q + (size_t)part * ((WS_K - WS_Q) / 2);
        const bool rot = (part < 2) && ((wc & 1) == 0);
        const float sgn = (fq == 0) ? -1.f : 1.f;
        float ks[2][8];
#pragma unroll
        for (int bj = 0; bj < 2; ++bj)
#pragma unroll
            for (int j = 0; j < 8; ++j) ks[bj][j] = 0.f;
#pragma unroll
        for (int ai = 0; ai < 2; ++ai)
#pragma unroll
            for (int m = 0; m < 4; ++m) {
                const int row = u.pm * 256 + ai * 128 + wr * 64 + m * 16 + fr;
                f32x4 cs0 = {1.f, 1.f, 1.f, 1.f}, cs1 = cs0, sn0 = {0.f, 0.f, 0.f, 0.f}, sn1 = sn0;
                if (rot) { const f32x4* rp = (const f32x4*)(rope + (size_t)row * 16); cs0 = rp[0]; cs1 = rp[1]; sn0 = rp[2]; sn1 = rp[3]; }
#pragma unroll
                for (int bj = 0; bj < 2; ++bj) {
                    f32x4 v0 = acc[ai][bj][m][0], v1 = acc[ai][bj][m][1];
                    if (rot) {
                        f32x4 p0, p1;
#pragma unroll
                        for (int j = 0; j < 4; ++j) { p0[j] = __shfl_xor(v0[j], 16); p1[j] = __shfl_xor(v1[j], 16); }
                        if (fq < 2) { v0 = v0 * cs0 + p0 * sn0 * sgn; v1 = v1 * cs1 + p1 * sn1 * sgn; }
                    }
                    if (part == 0) { v0 = v0 * C2; v1 = v1 * C2; }
                    if (part == 1) {
#pragma unroll
                        for (int j = 0; j < 4; ++j) { ks[bj][j] += v0[j]; ks[bj][4 + j] += v1[j]; } }
                    u32x4 w; w.x = cvt_pk_bf16(v0[0], v0[1]); w.y = cvt_pk_bf16(v0[2], v0[3]); w.z = cvt_pk_bf16(v1[0], v1[1]); w.w = cvt_pk_bf16(v1[2], v1[3]);
                    *(u32x4*)(base + (size_t)row * DM + colt + bj * 128 + wc * 32 + fq * 8) = w;
                }
            }
        if (part == 1) {
#pragma unroll
            for (int bj = 0; bj < 2; ++bj)
#pragma unroll
                for (int j = 0; j < 8; ++j) { float s = ks[bj][j]; s += __shfl_xor(s, 1); s += __shfl_xor(s, 2); s += __shfl_xor(s, 4); s += __shfl_xor(s, 8);
                    if (fr == 0) atomicAdd(ksum + (size_t)u.pm * DM + colt + bj * 128 + wc * 32 + fq * 8 + j, s); }
        }
    }
};

struct EpiZ {
    static constexpr bool PERM = true;
    __device__ __forceinline__ void prep(const Unit&, int, int, int) const {}
    const bf16_t* xin; bf16_t* z; float ymul;
    __device__ __forceinline__ void operator()(AccRef acc, const Unit& u, int wr, int wc, int fr, int fq) const {
        asm volatile("" : "+v"(fr), "+v"(fq));
#pragma unroll
        for (int ai = 0; ai < 2; ++ai) {
            const size_t off0 = (size_t)(u.pm * 256 + ai * 128 + wr * 64 + fr) * DM + u.pn * 256 + wc * 32 + fq * 8;
            u32x4 xr[4][2];
#pragma unroll
            for (int m = 0; m < 4; ++m)
#pragma unroll
                for (int bj = 0; bj < 2; ++bj) xr[m][bj] = *(const u32x4*)(xin + off0 + (size_t)m * 16 * DM + bj * 128);
#pragma unroll
            for (int m = 0; m < 4; ++m)
#pragma unroll
                for (int bj = 0; bj < 2; ++bj) { const u32x4 x = xr[m][bj]; const f32x4 a0 = acc[ai][bj][m][0] * ymul, a1 = acc[ai][bj][m][1] * ymul;
                    u32x4 w; w.x = cvt_pk_bf16(bflo(x.x) * ALPHA + a0[0], bfhi(x.x) * ALPHA + a0[1]); w.y = cvt_pk_bf16(bflo(x.y) * ALPHA + a0[2], bfhi(x.y) * ALPHA + a0[3]);
                    w.z = cvt_pk_bf16(bflo(x.z) * ALPHA + a1[0], bfhi(x.z) * ALPHA + a1[1]); w.w = cvt_pk_bf16(bflo(x.w) * ALPHA + a1[2], bfhi(x.w) * ALPHA + a1[3]);
                    *(u32x4*)(z + off0 + (size_t)m * 16 * DM + bj * 128) = w; }
            asm volatile("" ::: "memory");
        }
    }
};

__device__ __forceinline__ float swiglu1(float glu, float lin) {
    const float g = fminf(glu, 7.0f), l = fminf(fmaxf(lin, -7.0f), 7.0f);
    const float sg = __builtin_amdgcn_rcpf(1.0f + __builtin_amdgcn_exp2f(-1.702f * 1.4426950408889634f * g));
    return g * sg * (l + 1.0f);
}
__device__ __forceinline__ f32x2 swiglu2(float glu0, float lin0, float glu1, float lin1) {
    const f32x2 g = {fminf(glu0, 7.0f), fminf(glu1, 7.0f)}, l = {fminf(fmaxf(lin0, -7.0f), 7.0f), fminf(fmaxf(lin1, -7.0f), 7.0f)};
    const f32x2 t = g * (f32x2){-1.702f * 1.4426950408889634f, -1.702f * 1.4426950408889634f};
    const f32x2 d = (f32x2){__builtin_amdgcn_exp2f(t[0]), __builtin_amdgcn_exp2f(t[1])} + (f32x2){1.0f, 1.0f};
    const f32x2 r = {__builtin_amdgcn_rcpf(d[0]), __builtin_amdgcn_rcpf(d[1])};
    const f32x2 lp = l * (f32x2){FP8_SA, FP8_SA} + (f32x2){FP8_SA, FP8_SA};
    return (g * lp) * r;
}
struct EpiGU {
    static constexpr bool PERM = true;
    __device__ __forceinline__ void prep(const Unit& u, int ui, int wid, int lane) const { if (wid < 4) glds4s(uni_ptr((const char*)(bias + (size_t)u.x0 * 2048 + u.pn * 256 + wid * 64)), (unsigned)lane * 4u, (unsigned)__builtin_amdgcn_readfirstlane((unsigned)(unsigned long long)bl + (unsigned)(((ui & 1) * 256 + wid * 64) * 4))); }
    const float* bias; unsigned char* H; LAS float* bl; mutable int ucnt;
    __device__ __forceinline__ void operator()(AccRef acc, const Unit& u, int wr, int wc, int fr, int fq) const {
        asm volatile("" : "+v"(fr), "+v"(fq));
        const int c0 = u.pn * 256 + wc * 32 + fq * 8; const LAS float* bp = bl + (ucnt & 1) * 256 + wc * 32 + fq * 8; ++ucnt; constexpr float SC = 1.0f / (FP8_SA * FP8_SWGU);
        f32x4 b[2][2];
#pragma unroll
        for (int bj = 0; bj < 2; ++bj) { b[bj][0] = *(const LAS f32x4*)(bp + bj * 128); b[bj][1] = *(const LAS f32x4*)(bp + bj * 128 + 4); }
#pragma unroll
        for (int ai = 0; ai < 2; ++ai)
#pragma unroll
            for (int m = 0; m < 4; ++m) {
                unsigned char* rowp = H + (size_t)(u.x1 + ai * 128 + wr * 64 + m * 16 + fr) * DM + (c0 >> 1);
#pragma unroll
                for (int bj = 0; bj < 2; ++bj) { if (u.x2 == 2 - bj) continue;
                    const f32x4 v0 = acc[ai][bj][m][0] * SC + b[bj][0], v1 = acc[ai][bj][m][1] * SC + b[bj][1];
                    const f32x2 h0 = swiglu2(v0[0], v0[1], v0[2], v0[3]), h1 = swiglu2(v1[0], v1[1], v1[2], v1[3]);
                    int w = __builtin_amdgcn_cvt_pk_fp8_f32(h0[0], h0[1], 0, false);
                    w = __builtin_amdgcn_cvt_pk_fp8_f32(h1[0], h1[1], w, true);
                    *(int*)(rowp + bj * 64) = w; }
            }
    }
};
struct EpiDN {
    static constexpr bool PERM = true;
    __device__ __forceinline__ void prep(const Unit& u, int ui, int wid, int lane) const { if (wid < 4) glds4s(uni_ptr((const char*)(bias + (size_t)u.x0 * 1024 + u.pn * 256 + wid * 64)), (unsigned)lane * 4u, (unsigned)__builtin_amdgcn_readfirstlane((unsigned)(unsigned long long)bl + (unsigned)(((ui & 1) * 256 + wid * 64) * 4))); }
    const float* bias; unsigned char* Y; LAS float* bl; mutable int ucnt;
    __device__ __forceinline__ void operator()(AccRef acc, const Unit& u, int wr, int wc, int fr, int fq) const {
        asm volatile("" : "+v"(fr), "+v"(fq));
        const int c0 = u.pn * 256 + wc * 32 + fq * 8; const LAS float* bp = bl + (ucnt & 1) * 256 + wc * 32 + fq * 8; ++ucnt; constexpr float SC = FP8_SY / (FP8_SA * FP8_SWD);
        f32x4 b[2][2];
#pragma unroll
        for (int bj = 0; bj < 2; ++bj) { b[bj][0] = *(const LAS f32x4*)(bp + bj * 128) * FP8_SY; b[bj][1] = *(const LAS f32x4*)(bp + bj * 128 + 4) * FP8_SY; }
#pragma unroll
        for (int ai = 0; ai < 2; ++ai)
#pragma unroll
            for (int m = 0; m < 4; ++m) {
                unsigned char* rowp = Y + (size_t)(u.x1 + ai * 128 + wr * 64 + m * 16 + fr) * DM + c0;
#pragma unroll
                for (int bj = 0; bj < 2; ++bj) { if (u.x2 == 2 - bj) continue;
                    f32x4 v0 = acc[ai][bj][m][0] * SC + b[bj][0], v1 = acc[ai][bj][m][1] * SC + b[bj][1];
#pragma unroll
                    for (int q = 0; q < 4; ++q) { v0[q] = __builtin_amdgcn_fmed3f(v0[q], -FP8_MAXV, FP8_MAXV); v1[q] = __builtin_amdgcn_fmed3f(v1[q], -FP8_MAXV, FP8_MAXV); }
                    int w0 = __builtin_amdgcn_cvt_pk_fp8_f32(v0[0], v0[1], 0, false); w0 = __builtin_amdgcn_cvt_pk_fp8_f32(v0[2], v0[3], w0, true);
                    int w1 = __builtin_amdgcn_cvt_pk_fp8_f32(v1[0], v1[1], 0, false); w1 = __builtin_amdgcn_cvt_pk_fp8_f32(v1[2], v1[3], w1, true);
                    u32x2 w; w.x = (unsigned)w0; w.y = (unsigned)w1;
                    *(u32x2*)(rowp + bj * 128) = w; }
            }
    }
};

struct EpiINA {
    static constexpr bool PERM = true;
    __device__ __forceinline__ void prep(const Unit&, int, int, int) const {}
    const float* rf; const float* cf; bf16_t* AE; bf16_t* KN; bf16_t* OS;
    __device__ __forceinline__ void operator()(AccRef acc, const Unit& u, int wr, int wc, int fr, int fq) const {
        asm volatile("" : "+v"(fr), "+v"(fq));
        const int b = u.pm >> 4, ch = u.pm & 15, d0 = wc * 32 + fq * 8; const u32x4 zero = {0u, 0u, 0u, 0u};
        if (u.pn < 4) {
            const bool isq = u.pn < 2; const float* fac = isq ? rf : cf; const float fs = isq ? 1.0f : RSQRT_DQK; const int h0 = (u.pn & 1) * 2;
            float sf[2][4][2];
#pragma unroll
            for (int ai = 0; ai < 2; ++ai)
#pragma unroll
                for (int m = 0; m < 4; ++m)
#pragma unroll
                    for (int bj = 0; bj < 2; ++bj) sf[ai][m][bj] = fac[(size_t)(h0 + bj) * NTOK + (size_t)u.pm * 256 + ai * 128 + wr * 64 + m * 16 + fr];
#pragma unroll
            for (int ai = 0; ai < 2; ++ai)
#pragma unroll
                for (int m = 0; m < 4; ++m) {
                    const int t = ai * 128 + wr * 64 + m * 16 + fr; const size_t token = (size_t)u.pm * 256 + t;
#pragma unroll
                    for (int bj = 0; bj < 2; ++bj) { const int hh = h0 + bj; const float s = sf[ai][m][bj] * fs;
                        const f32x4 v0 = acc[ai][bj][m][0] * s, v1 = acc[ai][bj][m][1] * s;
                        const size_t oq = ((size_t)(((b * 4 + hh) * 16 + ch) * 256 + t)) * 512 + 256 + d0, ok = token * 1024 + hh * 256 + d0;
                        bf16_t* dst = isq ? (AE + oq) : (KN + ok);
                        u32x4 w; w.x = cvt_pk_bf16(v0[0], v0[1]); w.y = cvt_pk_bf16(v0[2], v0[3]); w.z = cvt_pk_bf16(v1[0], v1[1]); w.w = cvt_pk_bf16(v1[2], v1[3]);
                        *(u32x4*)dst = w; }
                }
        } else {
#pragma unroll
            for (int ai = 0; ai < 2; ++ai)
#pragma unroll
                for (int m = 0; m < 4; ++m) {
                    const int t = ai * 128 + wr * 64 + m * 16 + fr; const size_t token = (size_t)u.pm * 256 + t;
#pragma unroll
                    for (int bj = 0; bj < 2; ++bj) { f32x4 v0 = acc[ai][bj][m][0], v1 = acc[ai][bj][m][1];
#pragma unroll
                        for (int j = 0; j < 4; ++j) { v0[j] = __builtin_amdgcn_rcpf(1.0f + __builtin_amdgcn_exp2f(-1.4426950408889634f * v0[j])); v1[j] = __builtin_amdgcn_rcpf(1.0f + __builtin_amdgcn_exp2f(-1.4426950408889634f * v1[j])); }
                        u32x4 w; w.x = cvt_pk_bf16(v0[0], v0[1]); w.y = cvt_pk_bf16(v0[2], v0[3]); w.z = cvt_pk_bf16(v1[0], v1[1]); w.w = cvt_pk_bf16(v1[2], v1[3]);
                        *(u32x4*)(OS + token * 1024 + (u.pn - 4) * 256 + bj * 128 + d0) = w; }
                }
        }
    }
};
struct EpiINB {
    static constexpr bool PERM = true;
    __device__ __forceinline__ void prep(const Unit&, int, int, int) const {}
    const float* cf; bf16_t* KT; bf16_t* BE;
    __device__ __forceinline__ void operator()(AccRef acc, const Unit& u, int wr, int wc, int fr, int fq) const {
        asm volatile("" : "+v"(fr), "+v"(fq));
        const int b = u.pn >> 4, ch = u.pn & 15;
        f32x4 cv[2][2][2];
#pragma unroll
        for (int ai = 0; ai < 2; ++ai)
#pragma unroll
            for (int bj = 0; bj < 2; ++bj) { const size_t tok0 = (size_t)u.pn * 256 + bj * 128 + wc * 32 + fq * 8;
                if (u.pm < 2) { const int hh = u.pm * 2 + ai; cv[ai][bj][0] = *(const f32x4*)(cf + (size_t)hh * NTOK + tok0) * RSQRT_DQK; cv[ai][bj][1] = *(const f32x4*)(cf + (size_t)hh * NTOK + tok0 + 4) * RSQRT_DQK; }
                else { cv[ai][bj][0] = (f32x4){1.f, 1.f, 1.f, 1.f}; cv[ai][bj][1] = cv[ai][bj][0]; } }
#pragma unroll
        for (int ai = 0; ai < 2; ++ai)
#pragma unroll
            for (int m = 0; m < 4; ++m) {
                const int R = u.pm * 256 + ai * 128 + wr * 64 + m * 16 + fr;
#pragma unroll
                for (int bj = 0; bj < 2; ++bj) { if (u.x2 == 2 - bj) continue;
                    const f32x4 v0 = acc[ai][bj][m][0] * cv[ai][bj][0], v1 = acc[ai][bj][m][1] * cv[ai][bj][1]; const int s0 = bj * 128 + wc * 32 + fq * 8; const size_t tok0 = (size_t)u.pn * 256 + s0; bf16_t* dst;
                    if (u.pm < 2) dst = KT + (size_t)R * NTOK + tok0;
                    else { const int eg = R - 512, hh = eg >> 8, e = eg & 255; dst = BE + ((size_t)(((b * 4 + hh) * 16 + ch) * 256 + e)) * 384 + s0; }
                    u32x4 w; w.x = cvt_pk_bf16(v0[0], v0[1]); w.y = cvt_pk_bf16(v0[2], v0[3]); w.z = cvt_pk_bf16(v1[0], v1[1]); w.w = cvt_pk_bf16(v1[2], v1[3]);
                    *(u32x4*)dst = w;
                }
            }
    }
};
struct EpiM1 {
    static constexpr bool PERM = true;
    __device__ __forceinline__ void prep(const Unit&, int, int, int) const {}
    bf16_t* UT;
    __device__ __forceinline__ void operator()(AccRef acc, const Unit& u, int wr, int wc, int fr, int fq) const {
        asm volatile("" : "+v"(fr), "+v"(fq));
#pragma unroll
        for (int ai = 0; ai < 2; ++ai)
#pragma unroll
            for (int m = 0; m < 4; ++m) { bf16_t* rowp = UT + ((size_t)u.x0 * 256 + ai * 128 + wr * 64 + m * 16 + fr) * 128 + wc * 32 + fq * 8;
                const f32x4 v0 = acc[ai][0][m][0], v1 = acc[ai][0][m][1];
                u32x4 w; w.x = cvt_pk_bf16(v0[0], v0[1]); w.y = cvt_pk_bf16(v0[2], v0[3]); w.z = cvt_pk_bf16(v1[0], v1[1]); w.w = cvt_pk_bf16(v1[2], v1[3]);
                *(u32x4*)rowp = w; }
    }
};
struct EpiM2A {
    static constexpr bool PERM = true;
    __device__ __forceinline__ void prep(const Unit&, int, int, int) const {}
    bf16_t* AE; const float* nprev; float* den;
    __device__ __forceinline__ void operator()(AccRef acc, const Unit& u, int wr, int wc, int fr, int fq) const {
        asm volatile("" : "+v"(fr), "+v"(fq));
        const int mu = u.x0, dd = wc * 32 + fq * 8;
        const f32x4 n0 = *(const f32x4*)(nprev + (size_t)mu * 128 + dd), n1 = *(const f32x4*)(nprev + (size_t)mu * 128 + dd + 4);
        u32x4 qv8[2][4];
#pragma unroll
        for (int ai = 0; ai < 2; ++ai)
#pragma unroll
            for (int m = 0; m < 4; ++m) qv8[ai][m] = *(const u32x4*)(AE + ((size_t)mu * 256 + ai * 128 + wr * 64 + m * 16 + fr) * 512 + 256 + dd);
#pragma unroll
        for (int ai = 0; ai < 2; ++ai)
#pragma unroll
            for (int m = 0; m < 4; ++m) {
                const int t = ai * 128 + wr * 64 + m * 16 + fr; bf16_t* rowp = AE + ((size_t)mu * 256 + t) * 512;
                const u32x4 qv = qv8[ai][m];
                float part = bflo(qv.x) * n0[0] + bfhi(qv.x) * n0[1] + bflo(qv.y) * n0[2] + bfhi(qv.y) * n0[3] + bflo(qv.z) * n1[0] + bfhi(qv.z) * n1[1] + bflo(qv.w) * n1[2] + bfhi(qv.w) * n1[3];
#pragma unroll
                for (int bj = 0; bj < 2; ++bj) { const int s0 = bj * 128 + wc * 32 + fq * 8; f32x4 v0 = acc[ai][bj][m][0], v1 = acc[ai][bj][m][1];
                    int dts = t - s0; asm volatile("" : "+v"(dts));
#pragma unroll
                    for (int j = 0; j < 4; ++j) { v0[j] = (j <= dts) ? v0[j] : 0.f; v1[j] = (4 + j <= dts) ? v1[j] : 0.f; part += v0[j] + v1[j]; }
                    u32x4 w; w.x = cvt_pk_bf16(v0[0], v0[1]); w.y = cvt_pk_bf16(v0[2], v0[3]); w.z = cvt_pk_bf16(v1[0], v1[1]); w.w = cvt_pk_bf16(v1[2], v1[3]);
                    *(u32x4*)(rowp + s0) = w; }
                part += __shfl_xor(part, 16); part += __shfl_xor(part, 32);
                if (fq == 0) atomicAdd(den + (size_t)mu * 256 + (wr * 64 + fr) + (ai * 128 + m * 16), part);
            }
    }
};
struct EpiM2B {
    static constexpr bool PERM = true;
    __device__ __forceinline__ void prep(const Unit&, int, int, int) const {}
    const float* den; const float* normg; const bf16_t* OS; bf16_t* HN; LAS float* lnx;
    __device__ __forceinline__ void operator()(AccRef acc, const Unit& u, int wr, int wc, int fr, int fq) const {
        asm volatile("" : "+v"(fr), "+v"(fq));
        const int mu = u.x0, b = mu >> 6, hh = (mu >> 4) & 3, ch = mu & 15;
        float dnv[2][4];
#pragma unroll
        for (int ai = 0; ai < 2; ++ai)
#pragma unroll
            for (int m = 0; m < 4; ++m) dnv[ai][m] = den[(size_t)mu * 256 + ai * 128 + wr * 64 + m * 16 + fr];
#pragma unroll
        for (int ai = 0; ai < 2; ++ai)
#pragma unroll
            for (int m = 0; m < 4; ++m) {
                const int t = ai * 128 + wr * 64 + m * 16 + fr; const float dn = dnv[ai][m];
#ifdef DBG_DEN1
                const float inv = 1.0f;
#else
                const float inv = 1.0f / fmaxf(fabsf(dn), 1.0f);
#endif
                float s1 = 0.f, s2 = 0.f;
#pragma unroll
                for (int bj = 0; bj < 2; ++bj)
#pragma unroll
                    for (int n = 0; n < 2; ++n) { f32x4 h = acc[ai][bj][m][n] * inv; acc[ai][bj][m][n] = h; s1 += (h[0] + h[1]) + (h[2] + h[3]); s2 += (h[0] * h[0] + h[1] * h[1]) + (h[2] * h[2] + h[3] * h[3]); }
                s1 += __shfl_xor(s1, 16); s1 += __shfl_xor(s1, 32); s2 += __shfl_xor(s2, 16); s2 += __shfl_xor(s2, 32);
                if (fq == 0) { lnx[(t * 4 + wc) * 2] = s1; lnx[(t * 4 + wc) * 2 + 1] = s2; }
            }
        const int e0 = wc * 32 + fq * 8;
        f32x4 gg[2][2];
#pragma unroll
        for (int bj = 0; bj < 2; ++bj) { gg[bj][0] = *(const f32x4*)(normg + hh * 256 + bj * 128 + e0); gg[bj][1] = *(const f32x4*)(normg + hh * 256 + bj * 128 + e0 + 4); }
        asm volatile("s_waitcnt lgkmcnt(0)" ::: "memory"); __builtin_amdgcn_s_barrier(); asm volatile("" ::: "memory");
#pragma unroll
        for (int ai = 0; ai < 2; ++ai) {
            u32x4 ovv[4][2];
#pragma unroll
            for (int m = 0; m < 4; ++m)
#pragma unroll
                for (int bj = 0; bj < 2; ++bj) ovv[m][bj] = *(const u32x4*)(OS + (((size_t)(b * 16 + ch)) * 256 + ai * 128 + wr * 64 + m * 16 + fr) * 1024 + hh * 256 + bj * 128 + e0);
#pragma unroll
            for (int m = 0; m < 4; ++m) {
                const int t = ai * 128 + wr * 64 + m * 16 + fr; const size_t token = ((size_t)(b * 16 + ch)) * 256 + t;
                const LAS f32x4* lp = (const LAS f32x4*)(lnx + t * 8); const f32x4 a = lp[0], c = lp[1];
                const float mean = (a[0] + a[2] + c[0] + c[2]) * (1.0f / 256.0f); const float ex2 = (a[1] + a[3] + c[1] + c[3]) * (1.0f / 256.0f);
                const float rstd = 1.0f / sqrtf(fmaxf(ex2 - mean * mean, 0.f) + LN_EPS);
#pragma unroll
                for (int bj = 0; bj < 2; ++bj) { const int e = bj * 128 + e0; const size_t off = token * 1024 + hh * 256 + e; const u32x4 ov = ovv[m][bj];
#ifdef DBG_HN_OS
                    f32x4 v0 = {1.f, 1.f, 1.f, 1.f}, v1 = v0;
#elif defined(DBG_HN_RAW)
                    f32x4 v0 = acc[ai][bj][m][0], v1 = acc[ai][bj][m][1];
#else
                    f32x4 v0 = (acc[ai][bj][m][0] - mean) * rstd * gg[bj][0], v1 = (acc[ai][bj][m][1] - mean) * rstd * gg[bj][1];
#endif
#ifndef DBG_HN_ONE
                    v0[0] *= bflo(ov.x); v0[1] *= bfhi(ov.x); v0[2] *= bflo(ov.y); v0[3] *= bfhi(ov.y); v1[0] *= bflo(ov.z); v1[1] *= bfhi(ov.z); v1[2] *= bflo(ov.w); v1[3] *= bfhi(ov.w);
#endif
                    u32x4 w; w.x = cvt_pk_bf16(v0[0], v0[1]); w.y = cvt_pk_bf16(v0[2], v0[3]); w.z = cvt_pk_bf16(v1[0], v1[1]); w.w = cvt_pk_bf16(v1[2], v1[3]);
                    *(u32x4*)(HN + off) = w; }
            }
            asm volatile("" ::: "memory");
        }
        asm volatile("s_waitcnt lgkmcnt(0)" ::: "memory"); __builtin_amdgcn_s_barrier(); asm volatile("" ::: "memory");
    }
};
struct Frame {
    LAS unsigned char* lds;
    unsigned* ctl;
    unsigned char* ws;
    int tid, lane, wave, vcu, G;
};
__device__ __forceinline__ float wave_sum(float v) {
#pragma unroll
    for (int o = 1; o < 64; o <<= 1) v += __shfl_xor(v, o);
    return v;
}

__device__ __forceinline__ void tr_block(const float* src, size_t pitch, bf16_t* dst, size_t kd, int kb, int nb, LAS unsigned* scr, int lane) {
    const float* s0 = src + (size_t)(64 * kb) * pitch + 64 * nb + 4 * (lane & 15);
#pragma unroll
    for (int i = 0; i < 8; ++i) {
        const int kp = 4 * i + (lane >> 4);
        const f32x4 a = __builtin_nontemporal_load((const f32x4*)(s0 + (size_t)(2 * kp) * pitch)), b = __builtin_nontemporal_load((const f32x4*)(s0 + (size_t)(2 * kp + 1) * pitch));
#pragma unroll
        for (int j = 0; j < 4; ++j) scr[(4 * (lane & 15) + j) * 33 + kp] = cvt_pk_bf16(a[j], b[j]);
    }
    LDS_WAIT(); asm volatile("" ::: "memory");
    u32x4 o[8];
#pragma unroll
    for (int c = 0; c < 8; ++c) { const int rr = 8 * c + (lane >> 3), q4 = 4 * (lane & 7); o[c].x = scr[rr * 33 + q4]; o[c].y = scr[rr * 33 + q4 + 1]; o[c].z = scr[rr * 33 + q4 + 2]; o[c].w = scr[rr * 33 + q4 + 3]; }
    bf16_t* d = dst + (size_t)(64 * nb + (lane >> 3)) * kd + 64 * kb + 8 * (lane & 7);
#pragma unroll
    for (int c = 0; c < 8; ++c) *(u32x4*)(d + (size_t)(8 * c) * kd) = o[c];
    LDS_WAIT(); asm volatile("" ::: "memory");
}
__device__ __forceinline__ void tr_block8(const float* src, size_t pitch, unsigned char* dst, size_t kd, int kb, int nb, float scale, LAS unsigned* scr, int lane) {
    const float* s0 = src + (size_t)(128 * kb) * pitch + 64 * nb + 4 * (lane & 15);
#pragma unroll
    for (int i = 0; i < 8; ++i) {
        const int kq = 4 * i + (lane >> 4);
        const f32x4 r0 = __builtin_nontemporal_load((const f32x4*)(s0 + (size_t)(4 * kq) * pitch)) * scale, r1 = __builtin_nontemporal_load((const f32x4*)(s0 + (size_t)(4 * kq + 1) * pitch)) * scale,
                    r2 = __builtin_nontemporal_load((const f32x4*)(s0 + (size_t)(4 * kq + 2) * pitch)) * scale, r3 = __builtin_nontemporal_load((const f32x4*)(s0 + (size_t)(4 * kq + 3) * pitch)) * scale;
#pragma unroll
        for (int j = 0; j < 4; ++j) { int w = __builtin_amdgcn_cvt_pk_fp8_f32(r0[j], r1[j], 0, false); w = __builtin_amdgcn_cvt_pk_fp8_f32(r2[j], r3[j], w, true); scr[(4 * (lane & 15) + j) * 33 + kq] = (unsigned)w; }
    }
    LDS_WAIT(); asm volatile("" ::: "memory");
    u32x4 o[8];
#pragma unroll
    for (int c = 0; c < 8; ++c) { const int rr = 8 * c + (lane >> 3), q4 = 4 * (lane & 7); o[c].x = scr[rr * 33 + q4]; o[c].y = scr[rr * 33 + q4 + 1]; o[c].z = scr[rr * 33 + q4 + 2]; o[c].w = scr[rr * 33 + q4 + 3]; }
    unsigned char* d = dst + (size_t)(64 * nb + (lane >> 3)) * kd + 128 * kb + 16 * (lane & 7);
#pragma unroll
    for (int c = 0; c < 8; ++c) *(u32x4*)(d + (size_t)(8 * c) * kd) = o[c];
    LDS_WAIT(); asm volatile("" ::: "memory");
}
constexpr int CONV_ITEMS = 24576;
struct ConvItem { const float* s0; size_t pitch; unsigned char* d; float scale; };
__device__ __forceinline__ ConvItem conv_desc(const float* wgu, const float* wd, unsigned char* ws, int v, int lane) {
    const int layer = v >= 12288; int r = v - layer * 12288; ConvItem it;
    if (r < 8192) { const int mat = layer * 32 + (r >> 8); r &= 255; const int kb = r >> 5, nb = r & 31; it.pitch = 2048; it.scale = FP8_SWGU;
        it.s0 = wgu + (size_t)mat * 1024 * 2048 + (size_t)(128 * kb) * 2048 + 64 * nb + 4 * (lane & 15); it.d = ws + WS_WGU + (size_t)mat * 2048 * 1024 + (size_t)(64 * nb + (lane >> 3)) * 1024 + 128 * kb + 16 * (lane & 7); }
    else { r -= 8192; const int mat = layer * 32 + (r >> 7); r &= 127; const int kb = r >> 4, nb = r & 15; it.pitch = 1024; it.scale = FP8_SWD;
        it.s0 = wd + (size_t)mat * 1024 * 1024 + (size_t)(128 * kb) * 1024 + 64 * nb + 4 * (lane & 15); it.d = ws + WS_WD + (size_t)mat * 1024 * 1024 + (size_t)(64 * nb + (lane >> 3)) * 1024 + 128 * kb + 16 * (lane & 7); }
    return it;
}
__device__ __forceinline__ void conv_items(Frame& F, const float* wgu, const float* wd, int v_lo, int v_hi, int cw, int ncw) {
    LAS unsigned* scr = (LAS unsigned*)(F.lds + RING_OFF + F.wave * 8448); unsigned char* ws = F.ws; const int lane = F.lane;
    int v = v_lo + cw; if (v >= v_hi) return;
    ConvItem cur = conv_desc(wgu, wd, ws, v, lane);
    f32x4 r[8][4];
#pragma unroll
    for (int i = 0; i < 8; ++i) { const int kq = 4 * i + (lane >> 4);
#pragma unroll
        for (int q = 0; q < 4; ++q) r[i][q] = __builtin_nontemporal_load((const f32x4*)(cur.s0 + (size_t)(4 * kq + q) * cur.pitch)); }
    for (;;) {
        const int vn = v + ncw; const bool has = vn < v_hi; ConvItem nx = cur; if (has) nx = conv_desc(wgu, wd, ws, vn, lane);
#pragma unroll
        for (int i = 0; i < 8; ++i) { const int kq = 4 * i + (lane >> 4);
#pragma unroll
            for (int j = 0; j < 4; ++j) { int w = __builtin_amdgcn_cvt_pk_fp8_f32(r[i][0][j] * cur.scale, r[i][1][j] * cur.scale, 0, false); w = __builtin_amdgcn_cvt_pk_fp8_f32(r[i][2][j] * cur.scale, r[i][3][j] * cur.scale, w, true); scr[(4 * (lane & 15) + j) * 33 + kq] = (unsigned)w; }
            if (has) {
#pragma unroll
                for (int q = 0; q < 4; ++q) r[i][q] = __builtin_nontemporal_load((const f32x4*)(nx.s0 + (size_t)(4 * kq + q) * nx.pitch)); } }
        LDS_WAIT(); asm volatile("" ::: "memory");
        u32x4 o[8];
#pragma unroll
        for (int c = 0; c < 8; ++c) { const int rr = 8 * c + (lane >> 3), q4 = 4 * (lane & 7); o[c].x = scr[rr * 33 + q4]; o[c].y = scr[rr * 33 + q4 + 1]; o[c].z = scr[rr * 33 + q4 + 2]; o[c].w = scr[rr * 33 + q4 + 3]; }
#pragma unroll
        for (int c = 0; c < 8; ++c) *(u32x4*)(cur.d + (size_t)(8 * c) * 1024) = o[c];
        LDS_WAIT(); asm volatile("" ::: "memory");
        if (!has) break;
        v = vn; cur = nx;
    }
}
struct P0In { const float *x, *wqkv, *wo, *win, *wout, *rw, *wgu, *wd; const int* pos; };
__device__ __forceinline__ void p0_prologue(Frame& F, const P0In& I) {
    LAS unsigned* scr = (LAS unsigned*)(F.lds + RING_OFF + F.wave * 8448);
    const int gw = F.vcu * NWAVES + F.wave, NGW = F.G * NWAVES;
    unsigned char* ws = F.ws;
    constexpr int KB = 16;
    constexpr int I_QKV = KB * 48, I_WO = KB * 16, I_INA1 = KB * 16, I_INA2 = KB * 16, I_INB = KB * 24, I_WOUT = KB * 16;
    constexpr int I_SMALL = I_QKV + I_WO + I_INA1 + I_INA2 + I_INB + I_WOUT;
    constexpr int NITEMS = I_SMALL;
    for (int it = gw; it < NITEMS; it += NGW) {
        int r = it; const float* src; size_t pitch; bf16_t* dst; int nbl;
        if (r < I_QKV) { src = I.wqkv; pitch = 3072; dst = (bf16_t*)(ws + WS_WQKV); nbl = 48; }
        else if ((r -= I_QKV) < I_WO) { src = I.wo; pitch = 1024; dst = (bf16_t*)(ws + WS_WO); nbl = 16; }
        else if ((r -= I_WO) < I_INA1) { src = I.win; pitch = 3080; dst = (bf16_t*)(ws + WS_WINA); nbl = 16; }
        else if ((r -= I_INA1) < I_INA2) { src = I.win + 2048; pitch = 3080; dst = (bf16_t*)(ws + WS_WINA) + (size_t)1024 * 1024; nbl = 16; }
        else if ((r -= I_INA2) < I_INB) { src = I.win + 512; pitch = 3080; dst = (bf16_t*)(ws + WS_WINB); nbl = 24; }
        else { r -= I_INB; src = I.wout; pitch = 1024; dst = (bf16_t*)(ws + WS_WOUT); nbl = 16; }
        tr_block(src, pitch, dst, 1024, r / nbl, r % nbl, scr, F.lane);
    }
    if (NCONV == 0) conv_items(F, I.wgu, I.wd, 0, CONV_ITEMS, gw, NGW);
    const int gt = F.vcu * NTHR + F.tid, NGT = F.G * NTHR;
    for (int i = gt; i < NTOK * DM / 8; i += NGT) { const f32x4 a = ((const f32x4*)I.x)[2 * i], b = ((const f32x4*)I.x)[2 * i + 1];
        u32x4 w; w.x = cvt_pk_bf16(a[0], a[1]); w.y = cvt_pk_bf16(a[2], a[3]); w.z = cvt_pk_bf16(b[0], b[1]); w.w = cvt_pk_bf16(b[2], b[3]); ((u32x4*)(ws + WS_XB))[i] = w; }
    for (int i = gt; i < NTOK * 8; i += NGT) { const int tok = i >> 3, f = i & 7; const float inv = powf(500000.0f, -(float)f * 0.125f); const float ang = (float)I.pos[tok] * inv;
        float sn, cs; sincosf(ang, &sn, &cs); float* rp = (float*)(ws + WS_ROPE) + (size_t)tok * 16; rp[f] = cs; rp[8 + f] = sn; }
    for (int i = gt; i < 2 * 32 * 1024; i += NGT) { const int l = i >> 15, e = (i >> 10) & 31, k = i & 1023; ((float*)(ws + WS_RWT))[i] = I.rw[((size_t)l * 1024 + k) * 32 + e]; }
    for (int i = gt; i < 8 * 1024; i += NGT) { const int gidx = i >> 10, k = i & 1023; ((float*)(ws + WS_WG))[i] = I.win[(size_t)k * 3080 + 3072 + gidx]; }
}

__device__ __forceinline__ void phase_ln_router(Frame& F, const bf16_t* __restrict__ z, bf16_t* __restrict__ x1, const float* lng, const float* lnb, const float* rbias, int layer, int cset) {
    unsigned char* ws = F.ws;
    LAS f32x4* rwv = (LAS f32x4*)(F.lds + RING_OFF);
    LAS int* lcnt = (LAS int*)(F.lds + LX_LCNT); LAS int* gbase = (LAS int*)(F.lds + LX_GBASE); LAS int* rec = (LAS int*)(F.lds + LX_REC);
    LAS float* lgb = (LAS float*)(F.lds + LX_LNX);
    { const f32x4* src = (const f32x4*)((const float*)(ws + WS_RWT) + (size_t)layer * 32768);
      for (int i = F.tid; i < 8192; i += NTHR) { const int e = i >> 8, c = i & 255; rwv[e * 256 + (c ^ (e & 15))] = src[i]; } }
    int* toke = (int*)(ws + WS_TOKE); int* tokp = (int*)(ws + WS_TOKP); float* tokg = (float*)(ws + WS_TOKG);
    unsigned short* rowtok = (unsigned short*)(ws + WS_ROWTOK); unsigned char* xb8 = (unsigned char*)(ws + WS_XB);
    unsigned* cntg = F.ctl + CW_CNT + cset * 2048;
    const int lane = F.lane;
    for (int grp = F.vcu; grp < NTOK / 64; grp += F.G) {
        if (F.tid < 32) lcnt[F.tid] = 0;
        for (int i = F.tid; i < 1024; i += NTHR) { lgb[i] = lng[i]; lgb[1024 + i] = lnb[i]; }
        __syncthreads();
#pragma unroll 2
        for (int tk = 0; tk < 8; tk += 2) {
            const int token0 = grp * 64 + F.wave * 8 + tk;
            f32x4 v[2][4]; float s[2] = {0.f, 0.f};
#pragma unroll
            for (int u = 0; u < 2; ++u)
#pragma unroll
                for (int j = 0; j < 4; ++j) { const u32x2 zz = *(const u32x2*)(z + (size_t)(token0 + u) * DM + 4 * lane + 256 * j); v[u][j] = (f32x4){bflo(zz.x), bfhi(zz.x), bflo(zz.y), bfhi(zz.y)}; s[u] += (v[u][j][0] + v[u][j][1]) + (v[u][j][2] + v[u][j][3]); }
#pragma unroll
            for (int o = 1; o < 64; o <<= 1) { const float a0 = __shfl_xor(s[0], o), a1 = __shfl_xor(s[1], o); s[0] += a0; s[1] += a1; }
            float s2[2] = {0.f, 0.f};
#pragma unroll
            for (int u = 0; u < 2; ++u) { const float mean = s[u] * (1.0f / DM);
#pragma unroll
                for (int j = 0; j < 4; ++j) { v[u][j] = v[u][j] - mean; s2[u] += (v[u][j][0] * v[u][j][0] + v[u][j][1] * v[u][j][1]) + (v[u][j][2] * v[u][j][2] + v[u][j][3] * v[u][j][3]); } }
#pragma unroll
            for (int o = 1; o < 64; o <<= 1) { const float a0 = __shfl_xor(s2[0], o), a1 = __shfl_xor(s2[1], o); s2[0] += a0; s2[1] += a1; }
#pragma unroll
            for (int u = 0; u < 2; ++u) { const float rstd = 1.0f / sqrtf(s2[u] * (1.0f / DM) + LN_EPS); const int token = token0 + u;
#pragma unroll
                for (int j = 0; j < 4; ++j) { const f32x4 gvj = *(const LAS f32x4*)(lgb + 4 * lane + 256 * j), bvj = *(const LAS f32x4*)(lgb + 1024 + 4 * lane + 256 * j);
                    const f32x4 y = v[u][j] * rstd * gvj + bvj; { u32x2 wb; wb.x = cvt_pk_bf16(y[0], y[1]); wb.y = cvt_pk_bf16(y[2], y[3]); *(u32x2*)(x1 + (size_t)token * DM + 4 * lane + 256 * j) = wb; }
                    int w8 = __builtin_amdgcn_cvt_pk_fp8_f32(y[0] * FP8_SA, y[1] * FP8_SA, 0, false); w8 = __builtin_amdgcn_cvt_pk_fp8_f32(y[2] * FP8_SA, y[3] * FP8_SA, w8, true);
                    *(int*)(xb8 + (size_t)token * DM + 4 * lane + 256 * j) = w8; } }
        }
        VM_WAIT(); __syncthreads();
        const int tg = F.wave & 3, kh = F.wave >> 2, e0 = lane & 15, kq = lane >> 4;
        f32x4 acc0 = {0.f, 0.f, 0.f, 0.f}, acc1 = acc0;
        { const bf16_t* arow = x1 + (size_t)(grp * 64 + tg * 16 + e0) * DM + kh * 512 + 4 * kq;
#pragma unroll 4
          for (int blk = 0; blk < 32; ++blk) {
              const u32x2 ab = *(const u32x2*)(arow + blk * 16); const f32x4 a4 = {bflo(ab.x), bfhi(ab.x), bflo(ab.y), bfhi(ab.y)}; const int c = ((kh * 512 + blk * 16) >> 2) + kq;
              const f32x4 b0 = rwv[e0 * 256 + (c ^ e0)], b1 = rwv[(16 + e0) * 256 + (c ^ e0)];
#pragma unroll
              for (int j = 0; j < 4; ++j) { acc0 = __builtin_amdgcn_mfma_f32_16x16x4f32(a4[j], b0[j], acc0, 0, 0, 0); acc1 = __builtin_amdgcn_mfma_f32_16x16x4f32(a4[j], b1[j], acc1, 0, 0, 0); } } }
        __syncthreads();
        if (kh == 1) { ((LAS f32x4*)lgb)[(tg * 2 + 0) * 64 + lane] = acc0; ((LAS f32x4*)lgb)[(tg * 2 + 1) * 64 + lane] = acc1; }
        __syncthreads();
        if (kh == 0) {
            acc0 = acc0 + ((LAS f32x4*)lgb)[(tg * 2 + 0) * 64 + lane]; acc1 = acc1 + ((LAS f32x4*)lgb)[(tg * 2 + 1) * 64 + lane];
            const float rb0 = rbias[e0], rb1 = rbias[16 + e0];
#pragma unroll
            for (int r = 0; r < 4; ++r) {
                float l0 = acc0[r] + rb0, l1 = acc1[r] + rb1; float tv[4]; int te[4];
#pragma unroll
                for (int k = 0; k < 4; ++k) { float bvv = (l1 > l0) ? l1 : l0; int be = (l1 > l0) ? 16 + e0 : e0;
#pragma unroll
                    for (int o = 1; o < 16; o <<= 1) { const float ov = __shfl_xor(bvv, o); const int oe = __shfl_xor(be, o); const bool take = (ov > bvv) || (ov == bvv && oe < be); bvv = take ? ov : bvv; be = take ? oe : be; }
                    tv[k] = bvv; te[k] = be; if (be == e0) l0 = -INFINITY; if (be == 16 + e0) l1 = -INFINITY; }
                const float w0 = 1.0f, w1 = __expf(tv[1] - tv[0]), w2 = __expf(tv[2] - tv[0]), w3 = __expf(tv[3] - tv[0]); const float wi = 1.0f / (w0 + w1 + w2 + w3);
                if (e0 < 4) {
                    const int tl = tg * 16 + 4 * kq + r, token = grp * 64 + tl;
                    const int ek = (e0 == 0) ? te[0] : (e0 == 1) ? te[1] : (e0 == 2) ? te[2] : te[3];
                    const float wk = (e0 == 0) ? w0 : (e0 == 1) ? w1 : (e0 == 2) ? w2 : w3;
                    const int li = atomicAdd((int*)(lcnt + ek), 1); rec[tl * 8 + e0] = ek; rec[tl * 8 + 4 + e0] = li;
                    toke[token * 4 + e0] = ek; tokg[token * 4 + e0] = wk * wi;
                }
            }
        }
        __syncthreads();
        if (F.tid < 32) gbase[F.tid] = (int)__hip_atomic_fetch_add(cntg + F.tid * 64, (unsigned)lcnt[F.tid], RLX_AGENT);
        __syncthreads();
        if (F.tid < 256) { const int tl = F.tid >> 2, k = F.tid & 3; const int token = grp * 64 + tl; const int e = rec[tl * 8 + k]; const int pos = gbase[e] + rec[tl * 8 + 4 + k];
            tokp[token * 4 + k] = pos; rowtok[(size_t)e * NTOK + pos] = (unsigned short)token; }
        __syncthreads();
    }
}

__device__ __forceinline__ int moe_tables(Frame& F, int layer) {
    LAS int* tile_e = (LAS int*)(F.lds + LX_TILEE); LAS int* tbase = (LAS int*)(F.lds + LX_TBASE);
    if (F.tid < 64) {
        const int e = F.lane & 31; const int c = (int)__hip_atomic_load(F.ctl + CW_CNT + layer * 2048 + e * 64, RLX_AGENT); const int nt = (F.lane < 32) ? ((c + 255) >> 8) : 0;
        int inc = nt;
#pragma unroll
        for (int o = 1; o < 32; o <<= 1) { const int up = __shfl_up(inc, o); if (F.lane >= o) inc += up; }
        const int t0 = inc - nt;
        if (F.lane < 32) { tbase[e] = t0; for (int i = 0; i < nt; ++i) tile_e[t0 + i] = e; }
        if (F.lane == 31) tbase[32] = inc;
    }
    __syncthreads();
    return tbase[32];
}

template <bool NEXT_MLSTM>
__device__ __forceinline__ void phase_combine(Frame& F, const bf16_t* __restrict__ x1, float* __restrict__ out, const float* lng, const float* lnb, const float* bgates, int layer) {
    unsigned char* ws = F.ws;
    (void)moe_tables(F, layer);
    const LAS int* tbase = (const LAS int*)(F.lds + LX_TBASE);
    const int* toke = (const int*)(ws + WS_TOKE); const int* tokp = (const int*)(ws + WS_TOKP); const float* tokg = (const float*)(ws + WS_TOKG);
    const unsigned char* Y = (const unsigned char*)(ws + WS_Y); bf16_t* xb = (bf16_t*)(ws + WS_XB);
    LAS float* wg = (LAS float*)(F.lds + RING_OFF);
    LAS float* lgb = wg + 8192;
    if constexpr (NEXT_MLSTM) { const f32x4* src = (const f32x4*)(ws + WS_WG); for (int i = F.tid; i < 2048; i += NTHR) ((LAS f32x4*)wg)[i] = src[i];
        for (int i = F.tid; i < 1024; i += NTHR) { lgb[i] = lng[i]; lgb[1024 + i] = lnb[i]; } __syncthreads(); }
    const int lane = F.lane; const int gw = F.vcu * NWAVES + F.wave, NGW = F.G * NWAVES;
    f32x4 gv[4], bv[4];
    if constexpr (!NEXT_MLSTM) {
#pragma unroll
        for (int j = 0; j < 4; ++j) { gv[j] = *(const f32x4*)(lng + 4 * lane + 256 * j); bv[j] = *(const f32x4*)(lnb + 4 * lane + 256 * j); } }
    constexpr int NTK = NEXT_MLSTM ? 1 : 2;
    for (int token0 = gw; token0 < NTOK; token0 += NTK * NGW) {
        f32x4 vv[NTK][4];
#pragma unroll
        for (int u = 0; u < NTK; ++u) { const int token = token0 + u * NGW; if (token < NTOK) {
#pragma unroll
            for (int j = 0; j < 4; ++j) { const u32x2 xx = *(const u32x2*)(x1 + (size_t)token * DM + 4 * lane + 256 * j); vv[u][j] = (f32x4){bflo(xx.x), bfhi(xx.x), bflo(xx.y), bfhi(xx.y)} * ALPHA; }
#pragma unroll
            for (int k = 0; k < 4; ++k) { const int e = toke[token * 4 + k]; const size_t row = (size_t)tbase[e] * 256 + tokp[token * 4 + k]; const float gt = tokg[token * 4 + k] * (DBG_MOE_MUL / FP8_SY);
#pragma unroll
                for (int j = 0; j < 4; ++j) { const int y = *(const int*)(Y + row * DM + 4 * lane + 256 * j); const f32x2 lo = __builtin_amdgcn_cvt_pk_f32_fp8(y, false), hi = __builtin_amdgcn_cvt_pk_f32_fp8(y, true);
                    vv[u][j][0] += gt * lo[0]; vv[u][j][1] += gt * lo[1]; vv[u][j][2] += gt * hi[0]; vv[u][j][3] += gt * hi[1]; } } } }
#pragma unroll
        for (int u = 0; u < NTK; ++u) { const int token = token0 + u * NGW; if (token < NTOK) {
        f32x4 v[4];
#pragma unroll
        for (int j = 0; j < 4; ++j) v[j] = vv[u][j];
        float s = 0.f;
#pragma unroll
        for (int j = 0; j < 4; ++j) s += (v[j][0] + v[j][1]) + (v[j][2] + v[j][3]);
        const float mean = wave_sum(s) * (1.0f / DM); float s2 = 0.f;
#pragma unroll
        for (int j = 0; j < 4; ++j) { v[j] = v[j] - mean; s2 += (v[j][0] * v[j][0] + v[j][1] * v[j][1]) + (v[j][2] * v[j][2] + v[j][3] * v[j][3]); }
        const float rstd = 1.0f / sqrtf(wave_sum(s2) * (1.0f / DM) + LN_EPS);
#pragma unroll
        for (int j = 0; j < 4; ++j) { if constexpr (NEXT_MLSTM) { gv[j] = *(const LAS f32x4*)(lgb + 4 * lane + 256 * j); bv[j] = *(const LAS f32x4*)(lgb + 1024 + 4 * lane + 256 * j); }
            v[j] = v[j] * rstd * gv[j] + bv[j]; if constexpr (!NEXT_MLSTM) *(f32x4*)(out + (size_t)token * DM + 4 * lane + 256 * j) = v[j]; }
        if constexpr (NEXT_MLSTM) {
#pragma unroll
            for (int j = 0; j < 4; ++j) { u32x2 w; w.x = cvt_pk_bf16(v[j][0], v[j][1]); w.y = cvt_pk_bf16(v[j][2], v[j][3]); *(u32x2*)(xb + (size_t)token * DM + 4 * lane + 256 * j) = w; }
            float gp[8];
#pragma unroll
            for (int gi = 0; gi < 8; ++gi) { float a = 0.f;
#pragma unroll
                for (int j = 0; j < 4; ++j) { const f32x4 w = *(const LAS f32x4*)(wg + gi * 1024 + 4 * lane + 256 * j); a += (v[j][0] * w[0] + v[j][1] * w[1]) + (v[j][2] * w[2] + v[j][3] * w[3]); }
                gp[gi] = a; }
#pragma unroll
            for (int o = 1; o < 64; o <<= 1) {
#pragma unroll
                for (int gi = 0; gi < 8; ++gi) gp[gi] += __shfl_xor(gp[gi], o); }
#pragma unroll
            for (int gi = 0; gi < 8; ++gi) gp[gi] += bgates[gi];
            if (lane == 0) {
#pragma unroll
                for (int hh = 0; hh < 4; ++hh) { ((float*)(ws + WS_GI))[(size_t)hh * NTOK + token] = gp[hh];
                    const float f = gp[4 + hh]; const float lf = (f >= 0.f) ? -log1pf(__expf(-f)) : (f - log1pf(__expf(f)));
                    ((float*)(ws + WS_LF))[(size_t)hh * NTOK + token] = lf; } }
        }
        } }
    }
}

__device__ __forceinline__ void phase_gate_scan(Frame& F) {
    unsigned char* ws = F.ws; const int lane = F.lane; const int gw = F.vcu * NWAVES + F.wave, NGW = F.G * NWAVES;
    for (int mu = gw; mu < 256; mu += NGW) {
        const int b = mu >> 6, hh = (mu >> 4) & 3, ch = mu & 15; const size_t base = (size_t)hh * NTOK + (size_t)b * SEQ + ch * 256 + 4 * lane;
        const f32x4 lf = *(const f32x4*)((const float*)(ws + WS_LF) + base), gi = *(const f32x4*)((const float*)(ws + WS_GI) + base);
        f32x4 c; c[0] = lf[0]; c[1] = c[0] + lf[1]; c[2] = c[1] + lf[2]; c[3] = c[2] + lf[3];
        float tot = c[3];
#pragma unroll
        for (int o = 1; o < 64; o <<= 1) { const float up = __shfl_up(tot, o); if (lane >= o) tot += up; }
        const float excl = tot - c[3];
        f32x4 rf, cf;
#pragma unroll
        for (int j = 0; j < 4; ++j) { const float bt = excl + c[j]; rf[j] = __expf(bt); cf[j] = __expf(gi[j] - bt); }
        *(f32x4*)((float*)(ws + WS_RF) + base) = rf; *(f32x4*)((float*)(ws + WS_CF) + base) = cf;
        if (lane == 63) ((float*)(ws + WS_DEC))[mu] = __expf(tot);
    }
}
__device__ __forceinline__ void phase_nu(Frame& F) {
    unsigned char* ws = F.ws; const int lane = F.lane; const int gw = F.vcu * NWAVES + F.wave, NGW = F.G * NWAVES;
    const bf16_t* KT = (const bf16_t*)(ws + WS_KT); float* NU = (float*)(ws + WS_NU);
    for (int r0 = gw * 16; r0 < 256 * 128; r0 += NGW * 16) {
        const int mu = r0 >> 7, d0 = r0 & 127, b = mu >> 6, hh = (mu >> 4) & 3, ch = mu & 15;
        const bf16_t* base = KT + (size_t)(hh * 128 + d0) * NTOK + (size_t)b * SEQ + ch * 256 + 4 * lane;
        u32x2 kv[16];
#pragma unroll
        for (int i = 0; i < 16; ++i) kv[i] = *(const u32x2*)(base + (size_t)i * NTOK);
        float s[16];
#pragma unroll
        for (int i = 0; i < 16; ++i) s[i] = (bflo(kv[i].x) + bfhi(kv[i].x)) + (bflo(kv[i].y) + bfhi(kv[i].y));
#pragma unroll
        for (int o = 1; o < 64; o <<= 1) {
#pragma unroll
            for (int i = 0; i < 16; ++i) s[i] += __shfl_xor(s[i], o); }
        float mine = s[0];
#pragma unroll
        for (int i = 1; i < 16; ++i) mine = (lane == i) ? s[i] : mine;
        if (lane < 16) NU[r0 + lane] = mine;
    }
}
__device__ __forceinline__ void phase_state_scan(Frame& F) {
    unsigned char* ws = F.ws; const int gt = F.vcu * NTHR + F.tid, NGT = F.G * NTHR;
    const bf16_t* UT = (const bf16_t*)(ws + WS_UT); const float* DEC = (const float*)(ws + WS_DEC); bf16_t* BE = (bf16_t*)(ws + WS_BE);
    for (int i = gt; i < 16 * 256 * 32; i += NGT) { const int bh = i >> 13, e = (i >> 5) & 255, dg = i & 31;
        f32x4 U[16]; float dc[16];
#pragma unroll
        for (int ch = 0; ch < 16; ++ch) { const size_t mu = (size_t)bh * 16 + ch; { const u32x2 uu = *(const u32x2*)(UT + (mu * 256 + e) * 128 + 4 * dg); U[ch] = (f32x4){bflo(uu.x), bfhi(uu.x), bflo(uu.y), bfhi(uu.y)}; } dc[ch] = DEC[mu]; }
        f32x4 C = {0.f, 0.f, 0.f, 0.f};
#pragma unroll
        for (int ch = 0; ch < 16; ++ch) { const size_t mu = (size_t)bh * 16 + ch;
            u32x2 w; w.x = cvt_pk_bf16(C[0], C[1]); w.y = cvt_pk_bf16(C[2], C[3]);
#ifdef DBG_NO_INTER
            w.x = 0u; w.y = 0u;
#endif
            *(u32x2*)(BE + (mu * 256 + e) * 384 + 256 + 4 * dg) = w;
            C = (C + U[ch]) * dc[ch]; } }
    const float* NU = (const float*)(ws + WS_NU); float* NP = (float*)(ws + WS_NPREV);
    for (int i = gt; i < 16 * 128; i += NGT) { const int bh = i >> 7, d = i & 127; float n = 0.f;
        for (int ch = 0; ch < 16; ++ch) { const int mu = bh * 16 + ch; NP[mu * 128 + d] = n; n = (n + NU[mu * 128 + d]) * DEC[mu];
#ifdef DBG_NO_INTER
            n = 0.f;
#endif
        } }
}
struct Args { const float* in[18]; float* out; unsigned char* ws; int ph_lo, ph_hi; };
__global__ void __launch_bounds__(NTHR, 2) mk_fwd(Args args) {
    extern __shared__ __attribute__((aligned(16))) unsigned char lds[];
    Frame F;
    const char __attribute__((address_space(4)))* kargp = (const char __attribute__((address_space(4)))*)__builtin_amdgcn_kernarg_segment_ptr();
#define AIN(i) ({ const char __attribute__((address_space(4)))* k_ = kargp; asm volatile("" : "+s"(k_)); *(const float* const __attribute__((address_space(4)))*)(k_ + 8 * (i)); })
    unsigned char* const ws0 = (unsigned char*)AIN(19);
    F.lds = (LAS unsigned char*)lds; F.ws = ws0; F.ctl = (unsigned*)(ws0 + WS_CTL);
    F.tid = threadIdx.x; F.lane = F.tid & 63; F.wave = __builtin_amdgcn_readfirstlane(F.tid >> 6);
    F.G = gridDim.x; { const int bx = blockIdx.x; F.vcu = (F.G % 8 == 0) ? (bx % 8) * (F.G / 8) + bx / 8 : bx; }
    for (int u = F.tid; u < (LDS_BYTES - LX) / 4; u += NTHR) ((LAS unsigned*)(F.lds + LX))[u] = 0u;
    __syncthreads();
    int lo, hi; { const char __attribute__((address_space(4)))* k_ = kargp; lo = *(const int __attribute__((address_space(4)))*)(k_ + 160); hi = *(const int __attribute__((address_space(4)))*)(k_ + 164); }
    XcdBarrier bar; bar.bar = (unsigned*)(F.ctl + CW_BAR); bar.x = 0; bar.st = nullptr;
    if (hi - lo > 1) bar = xcd_barrier_post((unsigned*)(F.ctl + CW_BAR), (volatile LAS unsigned*)(F.lds + LX_MISC) + 8);
#ifndef PHASE_MASK
#define PHASE_MASK 0x7FFFF
#endif
#define IN(k) ((((PHASE_MASK) >> (k)) & 1) && lo <= (k) && (k) < hi)
#ifndef REPEAT_MASK
#define REPEAT_MASK 0
#endif
#define PH(k) if (IN(k))
#define SEAM(k) do { if (IN(k) && IN((k) + 1)) xcd_barrier(bar); } while (0)
    unsigned char* ws = ws0;
#define x_in AIN(0)
#define ln_mix_g AIN(8)
#define ln_mix_b AIN(9)
#define ln_ffn_g AIN(10)
#define ln_ffn_b AIN(11)
#define router_b AIN(13)
#define b_gu AIN(15)
#define b_dn AIN(17)
    bf16_t* XB = (bf16_t*)(ws + WS_XB); bf16_t* QB_ = (bf16_t*)(ws + WS_Q); bf16_t* KB_ = (bf16_t*)(ws + WS_K); bf16_t* VB_ = (bf16_t*)(ws + WS_V);
    bf16_t* R0 = (bf16_t*)(ws + WS_R0); bf16_t* R1 = (bf16_t*)(ws + WS_R1);
    bf16_t* HB = (bf16_t*)(ws + WS_H); bf16_t* YB = (bf16_t*)(ws + WS_Y);
    LAS unsigned char* ring = F.lds + RING_OFF;
    const int cG = (int)blockIdx.x;
    const bool isConv = (NCONV > 0) && ((int)blockIdx.x >= F.G - NCONV);
    const int Gc = F.G - NCONV, cwv = ((int)blockIdx.x - Gc) * NWAVES + F.wave, ncw = NCONV * NWAVES;
#define CONV_SLICE(a, b) conv_items(F, AIN(14), AIN(16), (int)((long)CONV_ITEMS * (a) / 1000), (int)((long)CONV_ITEMS * (b) / 1000), cwv, ncw)

    PH(0) { P0In I{x_in, AIN(2), AIN(3), AIN(4), AIN(7), AIN(12), AIN(14), AIN(16), (const int*)AIN(1)}; p0_prologue(F, I); }
    SEAM(0);
    PH(1) { { Gemm g{1024, 1024, 1024, nullptr}; DenseSched S{64, 12, F.G, cG, (const char*)XB, (const char*)(ws + WS_WQKV), (size_t)256 * 1024 * 2, (size_t)256 * 1024 * 2};
        EpiQKV E{QB_, KB_, VB_, (const float*)(ws + WS_ROPE), (float*)(ws + WS_KSUM)};
        pg8::gemm_phase<EpiQKV, DenseSched, true, false>(ring, g, S, E); } }
    SEAM(1);
    PH(2) { if (isConv) CONV_SLICE(0, 1000); else {
        const attn_body::AttnTensors AT{(const attn_body::bf16*)QB_, (const attn_body::bf16*)KB_, (const attn_body::bf16*)VB_, (attn_body::bf16*)QB_, (const float*)(ws + WS_KSUM)};
        if (NCONV == 0) { const attn_body::StaticOrder S((int)F.G, (int)blockIdx.x); attn_body::attn_phase<attn_body::StaticOrder>((char*)lds + RING_OFF, AT, S); }
        else { const attn_body::SnakeOrder S{cG, Gc}; attn_body::attn_phase<attn_body::SnakeOrder>((char*)lds + RING_OFF, AT, S); } } }
    SEAM(2);
    PH(3) { { Gemm g{1024, 1024, 1024, nullptr}; DenseSched S{64, 4, F.G, cG, (const char*)QB_, (const char*)(ws + WS_WO), (size_t)256 * 1024 * 2, (size_t)256 * 1024 * 2};
        EpiZ E{XB, R0, DBG_ATTN_MUL}; pg8::gemm_phase<EpiZ, DenseSched, true, false>(ring, g, S, E); } }
    SEAM(3);
    PH(4) phase_ln_router(F, R0, R1, ln_mix_g, ln_mix_b, router_b, 0, 0);
    SEAM(4);
    PH(5) { const int nT = moe_tables(F, 0); LAS unsigned short* tokl = (LAS unsigned short*)(F.lds + LX_TOKL);
        { const unsigned short* rowtok = (const unsigned short*)(ws + WS_ROWTOK); const LAS int* tile_e = (const LAS int*)(F.lds + LX_TILEE); const LAS int* tbase = (const LAS int*)(F.lds + LX_TBASE);
          for (int i = 0; i < TOKL_ROUNDS; ++i) { int pm, pn, hf; if (!moe_unit(i, F.G, cG, nT, 8, pm, pn, hf)) break;
              if (F.tid < 256) { const int e = tile_e[pm]; const int r = (pm - tbase[e]) * 256 + F.tid; const int c = (int)__hip_atomic_load(F.ctl + CW_CNT + 0 * 2048 + e * 64, RLX_AGENT);
                  tokl[i * 256 + F.tid] = (r < c) ? rowtok[(size_t)e * NTOK + r] : (unsigned short)0; } }
          __syncthreads(); }
        Gemm g{512, 512, 512, (const char*)XB};
        MoeSched S{nT, 8, F.G, cG, (const LAS int*)(F.lds + LX_TILEE), (const LAS int*)(F.lds + LX_TBASE), tokl, nullptr, (const char*)(ws + WS_WGU) + (size_t)0 * 32 * 2048 * 1024, 0, (size_t)2048 * 1024, (size_t)256 * 1024};
        EpiGU E{b_gu + (size_t)0 * 32 * 2048, (unsigned char*)HB, (LAS float*)(F.lds + LX_BIAS), 0}; pg8::gemm_phase<EpiGU, MoeSched, true, true, true, true>(ring, g, S, E); }
    SEAM(5);
    PH(6) { const int nT = moe_tables(F, 0); Gemm g{512, 512, 512, nullptr};
        MoeSched S{nT, 4, F.G, cG, (const LAS int*)(F.lds + LX_TILEE), (const LAS int*)(F.lds + LX_TBASE), nullptr, (const char*)HB, (const char*)(ws + WS_WD) + (size_t)0 * 32 * 1024 * 1024, (size_t)256 * 1024, (size_t)1024 * 1024, (size_t)256 * 1024};
        EpiDN E{b_dn + (size_t)0 * 32 * 1024, (unsigned char*)YB, (LAS float*)(F.lds + LX_BIAS), 0}; pg8::gemm_phase<EpiDN, MoeSched, true, false, true, true>(ring, g, S, E); }
    SEAM(6);
    PH(7) phase_combine<true>(F, R1, nullptr, ln_ffn_g, ln_ffn_b, AIN(5), 0);
    { F.lane = (int)attn_body::lane_now(); F.tid = F.wave * 64 + F.lane; }
    SEAM(7);
    PH(8) phase_gate_scan(F);
    SEAM(8);
    PH(9) {
        { Gemm g{1024, 1024, 1024, nullptr}; DenseSched S{64, 8, F.G, cG, (const char*)XB, (const char*)(ws + WS_WINA), (size_t)256 * 1024 * 2, (size_t)256 * 1024 * 2};
          EpiINA E{(const float*)(ws + WS_RF), (const float*)(ws + WS_CF), (bf16_t*)(ws + WS_AE), (bf16_t*)(ws + WS_KN), (bf16_t*)(ws + WS_OS)};
          pg8::gemm_phase<EpiINA, DenseSched, true, false>(ring, g, S, E); }
        { Gemm g{1024, 1024, 1024, nullptr}; DenseSched S{6, 64, F.G, cG, (const char*)(ws + WS_WINB), (const char*)XB, (size_t)256 * 1024 * 2, (size_t)256 * 1024 * 2, true};
          EpiINB E{(const float*)(ws + WS_CF), (bf16_t*)(ws + WS_KT), (bf16_t*)(ws + WS_BE)};
          pg8::gemm_phase<EpiINB, DenseSched, true, false, false, true>(ring, g, S, E); }
    }
    SEAM(9);
    PH(10) { Gemm g{256, 384, NTOK, nullptr}; MuSched S{F.G, cG, 0, (const char*)(ws + WS_BE), (const char*)(ws + WS_KT)};
        EpiM1 E{(bf16_t*)(ws + WS_UT)}; pg8::gemm_phase<EpiM1, MuSched, true, false, false, true>(ring, g, S, E);
        phase_nu(F); }
    SEAM(10);
    PH(11) phase_state_scan(F);
    SEAM(11);
    PH(12) { Gemm g{128, 512, 1024, nullptr}; MuSched S{F.G, cG, 1, (const char*)(ws + WS_AE), (const char*)(ws + WS_KN)};
        EpiM2A E{(bf16_t*)(ws + WS_AE), (const float*)(ws + WS_NPREV), (float*)(ws + WS_DEN)}; pg8::gemm_phase<EpiM2A, MuSched, true, false>(ring, g, S, E); }
    SEAM(12);
    PH(13) { Gemm g{384, 512, 384, nullptr}; MuSched S{F.G, cG, 2, (const char*)(ws + WS_AE), (const char*)(ws + WS_BE)};
        EpiM2B E{(const float*)(ws + WS_DEN), AIN(6), (const bf16_t*)(ws + WS_OS), (bf16_t*)(ws + WS_HN), (LAS float*)(F.lds + LX_LNX)};
        pg8::gemm_phase<EpiM2B, MuSched, true, false>(ring, g, S, E); }
    SEAM(13);
    PH(14) { Gemm g{1024, 1024, 1024, nullptr}; DenseSched S{64, 4, F.G, cG, (const char*)(ws + DBG_P14_A), (const char*)(ws + WS_WOUT), (size_t)256 * 1024 * 2, (size_t)256 * 1024 * 2};
        EpiZ E{XB, R0, DBG_MLSTM_MUL}; pg8::gemm_phase<EpiZ, DenseSched, true, false>(ring, g, S, E); }
    SEAM(14);
    PH(15) phase_ln_router(F, R0, R1, ln_mix_g + 1024, ln_mix_b + 1024, router_b + 32, 1, 1);
    SEAM(15);
    PH(16) { const int nT = moe_tables(F, 1); LAS unsigned short* tokl = (LAS unsigned short*)(F.lds + LX_TOKL);
        { const unsigned short* rowtok = (const unsigned short*)(ws + WS_ROWTOK); const LAS int* tile_e = (const LAS int*)(F.lds + LX_TILEE); const LAS int* tbase = (const LAS int*)(F.lds + LX_TBASE);
          for (int i = 0; i < TOKL_ROUNDS; ++i) { int pm, pn, hf; if (!moe_unit(i, F.G, cG, nT, 8, pm, pn, hf)) break;
              if (F.tid < 256) { const int e = tile_e[pm]; const int r = (pm - tbase[e]) * 256 + F.tid; const int c = (int)__hip_atomic_load(F.ctl + CW_CNT + 1 * 2048 + e * 64, RLX_AGENT);
                  tokl[i * 256 + F.tid] = (r < c) ? rowtok[(size_t)e * NTOK + r] : (unsigned short)0; } }
          __syncthreads(); }
        Gemm g{512, 512, 512, (const char*)XB};
        MoeSched S{nT, 8, F.G, cG, (const LAS int*)(F.lds + LX_TILEE), (const LAS int*)(F.lds + LX_TBASE), tokl, nullptr, (const char*)(ws + WS_WGU) + (size_t)1 * 32 * 2048 * 1024, 0, (size_t)2048 * 1024, (size_t)256 * 1024};
        EpiGU E{b_gu + (size_t)1 * 32 * 2048, (unsigned char*)HB, (LAS float*)(F.lds + LX_BIAS), 0}; pg8::gemm_phase<EpiGU, MoeSched, true, true, true, true>(ring, g, S, E); }
    SEAM(16);
    PH(17) { const int nT = moe_tables(F, 1); Gemm g{512, 512, 512, nullptr};
        MoeSched S{nT, 4, F.G, cG, (const LAS int*)(F.lds + LX_TILEE), (const LAS int*)(F.lds + LX_TBASE), nullptr, (const char*)HB, (const char*)(ws + WS_WD) + (size_t)1 * 32 * 1024 * 1024, (size_t)256 * 1024, (size_t)1024 * 1024, (size_t)256 * 1024};
        EpiDN E{b_dn + (size_t)1 * 32 * 1024, (unsigned char*)YB, (LAS float*)(F.lds + LX_BIAS), 0}; pg8::gemm_phase<EpiDN, MoeSched, true, false, true, true>(ring, g, S, E); }
    SEAM(17);
    PH(18) phase_combine<false>(F, R1, (float*)AIN(18), ln_ffn_g + 1024, ln_ffn_b + 1024, nullptr, 1);
#undef IN
#undef CONV_SLICE
#undef AIN
#undef x_in
#undef ln_mix_g
#undef ln_mix_b
#undef ln_ffn_g
#undef ln_ffn_b
#undef router_b
#undef b_gu
#undef b_dn
#undef SEAM
}

extern "C" void kernel_launch(void* const* d_in, const int* in_sizes, int n_in, void* d_out, int out_size, void* d_ws, size_t ws_size, hipStream_t stream) {
    static int grid = 0;
    if (grid == 0) {
        if (n_in != 18 || out_size != NTOK * DM || ws_size < WS_END) { fprintf(stderr, "kernel_launch: unexpected problem shape (n_in %d, out %d, ws %zu)\n", n_in, out_size, ws_size); grid = -1; return; }
        int dev = 0, cus = 0, per_cu = 0;
        if (hipGetDevice(&dev) != hipSuccess || hipDeviceGetAttribute(&cus, hipDeviceAttributeMultiprocessorCount, dev) != hipSuccess) { grid = -1; return; }
        if (hipFuncSetAttribute((const void*)mk_fwd, hipFuncAttributeMaxDynamicSharedMemorySize, LDS_BYTES) != hipSuccess) { fprintf(stderr, "kernel_launch: hipFuncSetAttribute failed\n"); grid = -1; return; }
        if (hipOccupancyMaxActiveBlocksPerMultiprocessor(&per_cu, (const void*)mk_fwd, NTHR, LDS_BYTES) != hipSuccess || per_cu < 1) fprintf(stderr, "kernel_launch: occupancy query reports %d\n", per_cu);
        (void)hipGetLastError();
        grid = cus;
        if (grid > 256) grid = 256;
        if (grid < 240) { fprintf(stderr, "kernel_launch: %d CUs: this build needs 240..256\n", cus); grid = -1; return; }
    }
    if (grid < 0) return;
    if (hipMemsetAsync((char*)d_ws + WS_CTL, 0, CTL_ZERO_BYTES, stream) != hipSuccess) return;
    Args a{};
    for (int i = 0; i < 18; ++i) a.in[i] = (const float*)d_in[i];
    a.out = (float*)d_out; a.ws = (unsigned char*)d_ws;
#if MK_ONE_LAUNCH
    a.ph_lo = 0; a.ph_hi = NPHASE;
    hipLaunchKernelGGL(mk_fwd, dim3(grid), dim3(NTHR), LDS_BYTES, stream, a);
#else
    for (int p = 0; p < NPHASE; ++p) { a.ph_lo = p; a.ph_hi = p + 1; hipLaunchKernelGGL(mk_fwd, dim3(grid), dim3(NTHR), LDS_BYTES, stream, a); }
#endif
}
```

```cpp
#include <hip/hip_runtime.h>
#include <hip/hip_bf16.h>
#include <cstdio>
#include <cstdint>
#include <cmath>

#define LAS __attribute__((address_space(3)))
#define GAS __attribute__((address_space(1)))
typedef unsigned short bf16_t;
typedef short bf16x8 __attribute__((ext_vector_type(8)));
typedef float f32x4 __attribute__((ext_vector_type(4)));
typedef float f32x2 __attribute__((ext_vector_type(2)));
typedef unsigned u32x4 __attribute__((ext_vector_type(4)));
typedef unsigned u32x2 __attribute__((ext_vector_type(2)));
typedef int i32x4 __attribute__((ext_vector_type(4)));
typedef int i32x8 __attribute__((ext_vector_type(8)));

typedef __bf16 bf16x2_t __attribute__((ext_vector_type(2)));
__device__ __forceinline__ unsigned cvt_pk_bf16(float lo, float hi) { const f32x2 v = {lo, hi}; const bf16x2_t b = __builtin_convertvector(v, bf16x2_t); return __builtin_bit_cast(unsigned, b); }
__device__ __forceinline__ float bf2f(unsigned short b) { return __uint_as_float(((unsigned)b) << 16); }
__device__ __forceinline__ float bflo(unsigned w) { return __uint_as_float(w << 16); }
__device__ __forceinline__ float bfhi(unsigned w) { return __uint_as_float(w & 0xffff0000u); }

__device__ __forceinline__ void glds16s(const void* sbase, unsigned voff, unsigned lds_dst) { unsigned keep;
    asm volatile("s_nop 4\n\ts_mov_b32 %0, m0\n\ts_mov_b32 m0, %3\n\ts_nop 0\n\tglobal_load_lds_dwordx4 %1, %2\n\ts_mov_b32 m0, %0" : "=&s"(keep) : "v"(voff), "s"(sbase), "s"(lds_dst) : "memory"); }
__device__ __forceinline__ void glds4s(const void* sbase, unsigned voff, unsigned lds_dst) { unsigned keep;
    asm volatile("s_nop 4\n\ts_mov_b32 %0, m0\n\ts_mov_b32 m0, %3\n\ts_nop 0\n\tglobal_load_lds_dword %1, %2\n\ts_mov_b32 m0, %0" : "=&s"(keep) : "v"(voff), "s"(sbase), "s"(lds_dst) : "memory"); }
__device__ __forceinline__ const char* uni_ptr(const char* p) { const unsigned long long v = (unsigned long long)p; const unsigned lo = __builtin_amdgcn_readfirstlane((unsigned)v), hi = __builtin_amdgcn_readfirstlane((unsigned)(v >> 32)); return (const char*)(((unsigned long long)hi << 32) | lo); }
namespace pg8 {
constexpr int BM = 256, BK = 64, HALF = 128, HTB = HALF * BK * 2, STAGE_BYTES = 8 * HTB, NXCD = 8, WGM = 8;
__host__ __device__ __forceinline__ int lds_byte(int r, int c) { const int st = (r >> 4) * 2 + (c >> 5), rr = r & 15, cc = c & 31, ob = rr * 64 + cc * 2; return st * 1024 + (ob ^ (((ob >> 9) & 1) << 5)); }
__host__ __device__ __forceinline__ void stage_rc(int b, int& R, int& C) { const int st = b / 1024, sb = b % 1024, swz = sb ^ (((sb >> 9) & 1) << 5); R = (st >> 1) * 16 + swz / 64; C = (st & 1) * 32 + (swz % 64) / 2; }
__host__ __device__ __forceinline__ int perm32(int rho) { const int n = rho >> 4, i = rho & 15; return 8 * (i >> 2) + 4 * n + (i & 3); }

struct Unit { int pm, pn; const char* A; const char* B; const LAS unsigned short* tl; int x0, x1, x2; };
struct Gemm { int K, lda, ldb; const char* Abase; };

__device__ __forceinline__ bool tile_order(int i, int G, int c, int nM, int nN, int& pm, int& pn) {
    const int nwg = nM * nN; const long L = (long)i * G + c; if (L >= nwg) return false;
    int wgid = (int)L; { const int q = nwg / NXCD, r = nwg % NXCD, xcd = wgid % NXCD, off = wgid / NXCD; wgid = (xcd < r ? xcd * (q + 1) : r * (q + 1) + (xcd - r) * q) + off; }
    const int nig = WGM * nN, gid = wgid / nig, fm = gid * WGM, gsz = (nM - fm) < WGM ? (nM - fm) : WGM;
    pm = fm + ((wgid % nig) % gsz); pn = (wgid % nig) / gsz; return true;
}

template <class Epi, class Sched, bool ALIGN_EPI, bool GATHER, bool FP8 = false, bool HALFSEL = false>
__device__ __forceinline__ void gemm_phase(LAS unsigned char* lds, const Gemm g, const Sched& S, const Epi& E) {
    const int tid = threadIdx.x, wid = __builtin_amdgcn_readfirstlane(tid >> 6), lane = tid & 63, wr = wid >> 2, wc = wid & 3, fr = lane & 15, fq = lane >> 4;
    const int K = g.K, nt = K / BK;
    int RA[2]; unsigned cA2[2], voffB[2];
#pragma unroll
    for (int i = 0; i < 2; ++i) { int R, C; stage_rc(tid * 16 + i * 8192, R, C); const int Rb = Epi::PERM ? ((R & ~31) + perm32(R & 31)) : R;
        RA[i] = R; cA2[i] = (unsigned)C * 2u; voffB[i] = (unsigned)(Rb * g.ldb + C) * 2u; }
    const size_t kstep = (size_t)(BK * 2);
    const unsigned hstepA = (unsigned)HALF * (unsigned)g.lda * 2u; const size_t hstepB = (size_t)HALF * g.ldb * 2;
    const unsigned ldsb = (unsigned)__builtin_amdgcn_readfirstlane((unsigned)(unsigned long long)lds + (unsigned)wid * 1024u);
    const int aoff = lds_byte(wr * 64 + fr, fq * 8), boff = lds_byte(wc * 32 + fr, fq * 8);
    const int aoff2 = aoff + 1024, boff2 = boff + 1024;
#define PG8_SA(b, h) (((b) * 2 + (h)) * HTB)
#define PG8_SB(b, h) ((4 + (b) * 2 + (h)) * HTB)
#define PG8_STAGE(bufoff, gbase, voff) do { _Pragma("unroll") for (int _i = 0; _i < 2; ++_i) glds16s((gbase), (voff)[_i], ldsb + (unsigned)(bufoff) + _i * 8192u); } while (0)
#define PG8_STAGE_A(bufoff, gbase, AO, h) do { _Pragma("unroll") for (int _i = 0; _i < 2; ++_i) glds16s((gbase), (AO)[h][_i], ldsb + (unsigned)(bufoff) + _i * 8192u); } while (0)
#define PG8_LD8(base_, o1_, o2_) __builtin_shufflevector(*(const LAS i32x4*)(lds + (base_) + (o1_)), *(const LAS i32x4*)(lds + (base_) + (o2_)), 0, 1, 2, 3, 4, 5, 6, 7)
#define PG8_LDA(dst, b, h) do { if constexpr (FP8) { _Pragma("unroll") for (int m = 0; m < 4; ++m) dst##8[m] = PG8_LD8(PG8_SA(b, h) + m * 2048, aoff, aoff2); } \
        else { _Pragma("unroll") for (int m = 0; m < 4; ++m) _Pragma("unroll") for (int k = 0; k < 2; ++k) dst[m][k] = *(const LAS bf16x8*)(lds + PG8_SA(b, h) + aoff + m * 2048 + k * 1024); } } while (0)
#define PG8_LDB(dst, b, h) do { if constexpr (FP8) { _Pragma("unroll") for (int n = 0; n < 2; ++n) dst##8[n] = PG8_LD8(PG8_SB(b, h) + n * 2048, boff, boff2); } \
        else { _Pragma("unroll") for (int n = 0; n < 2; ++n) _Pragma("unroll") for (int k = 0; k < 2; ++k) dst[n][k] = *(const LAS bf16x8*)(lds + PG8_SB(b, h) + boff + n * 2048 + k * 1024); } } while (0)
#define PG8_MMA(ai, bj, At, Bt) do { __builtin_amdgcn_s_setprio(1); _Pragma("unroll") for (int m = 0; m < 4; ++m) _Pragma("unroll") for (int n = 0; n < 2; ++n) { \
        if constexpr (FP8) asm volatile("v_mfma_f32_16x16x128_f8f6f4 %0, %1, %2, %0" : "+v"(acc[ai][bj][m][n]) : "v"(Bt##8[n]), "v"(At##8[m])); \
        else { _Pragma("unroll") for (int k = 0; k < 2; ++k) acc[ai][bj][m][n] = __builtin_amdgcn_mfma_f32_16x16x32_bf16(Bt[n][k], At[m][k], acc[ai][bj][m][n], 0, 0, 0); } } \
        __builtin_amdgcn_s_setprio(0); } while (0)
#define PG8_WAIT_V(n) asm volatile("s_waitcnt vmcnt(" #n ")" ::: "memory")
#define PG8_WAIT_L(n) asm volatile("s_waitcnt lgkmcnt(" #n ")" ::: "memory")
#define PG8_BAR __builtin_amdgcn_s_barrier()
#define PG8_SCHED __builtin_amdgcn_sched_barrier(0)
#define PG8_AOFF(AO, U) do { _Pragma("unroll") for (int _h = 0; _h < 2; ++_h) _Pragma("unroll") for (int _i = 0; _i < 2; ++_i) { \
        if constexpr (GATHER) AO[_h][_i] = (unsigned)(U).tl[RA[_i] + _h * HALF] * (unsigned)(g.lda * 2) + cA2[_i]; \
        else AO[_h][_i] = (unsigned)RA[_i] * (unsigned)(g.lda * 2) + cA2[_i] + (unsigned)_h * hstepA; } } while (0)
    Unit cur, nxt; int ui = 0;
    if (!S.next(0, cur)) return;
    f32x4 acc[2][2][4][2];
#pragma unroll
    for (int a = 0; a < 2; ++a)
#pragma unroll
        for (int b = 0; b < 2; ++b)
#pragma unroll
            for (int m = 0; m < 4; ++m)
#pragma unroll
                for (int n = 0; n < 2; ++n) acc[a][b][m][n] = (f32x4){0.f, 0.f, 0.f, 0.f};
    bf16x8 At[4][2], B0[2][2], B1[2][2]; i32x8 At8[4], B08[2], B18[2];
    E.prep(cur, 0, wid, lane);
    unsigned aoC[2][2], aoN[2][2];
    PG8_AOFF(aoC, cur);
    const char* cA = uni_ptr(GATHER ? g.Abase : cur.A); const char* cB = uni_ptr(cur.B);
    PG8_STAGE(PG8_SB(0, 0), cB, voffB); PG8_STAGE(PG8_SB(0, 1), cB + hstepB, voffB); PG8_STAGE_A(PG8_SA(0, 0), cA, aoC, 0); PG8_STAGE_A(PG8_SA(0, 1), cA, aoC, 1);
    if (wr == 1) PG8_BAR;
    PG8_WAIT_V(2); PG8_BAR;
    PG8_STAGE(PG8_SB(1, 0), cB + kstep, voffB); PG8_STAGE_A(PG8_SA(1, 0), cA + kstep, aoC, 0); PG8_STAGE(PG8_SB(1, 1), cB + hstepB + kstep, voffB);
    PG8_WAIT_V(6); PG8_BAR;
    for (;;) {
        const bool has_next = S.next(ui + 1, nxt);
        if (has_next) E.prep(nxt, ui + 1, wid, lane);
        if constexpr (GATHER) { if (has_next) PG8_AOFF(aoN, nxt); else { _Pragma("unroll") for (int _h = 0; _h < 2; ++_h) _Pragma("unroll") for (int _i = 0; _i < 2; ++_i) aoN[_h][_i] = aoC[_h][_i]; } }
        const char* nA = uni_ptr(GATHER ? g.Abase : (has_next ? nxt.A : cA)); const char* nB = uni_ptr(has_next ? nxt.B : cB);
        const bool dh0 = cur.x2 != 2, dh1 = cur.x2 != 1;
#pragma nounroll
        for (int t = 0; t < nt; t += 2) {
            const bool last = (t == nt - 2);
            const char* a1 = cA + (size_t)(t + 1) * kstep;
            const char* a2 = last ? nA : cA + (size_t)(t + 2) * kstep; const char* b2 = last ? nB : cB + (size_t)(t + 2) * kstep;
            const char* a3 = a2 + kstep; const char* b3 = b2 + kstep;
            unsigned aoS[2][2];
#pragma unroll
            for (int _h = 0; _h < 2; ++_h)
#pragma unroll
                for (int _i = 0; _i < 2; ++_i) aoS[_h][_i] = (GATHER && last) ? aoN[_h][_i] : aoC[_h][_i];
            PG8_LDB(B0, 0, 0); PG8_LDB(B1, 0, 1); PG8_SCHED; PG8_LDA(At, 0, 0); PG8_STAGE_A(PG8_SA(1, 1), a1, aoC, 1);
            PG8_WAIT_V(8); PG8_WAIT_L(0); PG8_BAR; if (!HALFSEL || dh0) PG8_MMA(0, 0, At, B0); if (!HALFSEL || dh1) PG8_MMA(0, 1, At, B1); PG8_BAR; PG8_SCHED;
            PG8_LDA(At, 0, 1); PG8_STAGE(PG8_SB(0, 0), b2, voffB); PG8_STAGE(PG8_SB(0, 1), b2 + hstepB, voffB); PG8_STAGE_A(PG8_SA(0, 0), a2, aoS, 0);
            PG8_WAIT_V(8); PG8_WAIT_L(0); PG8_BAR; if (!HALFSEL || dh0) PG8_MMA(1, 0, At, B0); if (!HALFSEL || dh1) PG8_MMA(1, 1, At, B1); PG8_BAR; PG8_SCHED;
            PG8_LDB(B0, 1, 0); PG8_LDB(B1, 1, 1); PG8_SCHED; PG8_LDA(At, 1, 0); PG8_STAGE_A(PG8_SA(0, 1), a2, aoS, 1);
            PG8_WAIT_V(8); PG8_WAIT_L(0); PG8_BAR; if (!HALFSEL || dh0) PG8_MMA(0, 0, At, B0); if (!HALFSEL || dh1) PG8_MMA(0, 1, At, B1); PG8_BAR; PG8_SCHED;
            PG8_LDA(At, 1, 1); PG8_STAGE(PG8_SB(1, 0), b3, voffB); PG8_STAGE(PG8_SB(1, 1), b3 + hstepB, voffB); PG8_STAGE_A(PG8_SA(1, 0), a3, aoS, 0);
            PG8_WAIT_V(8); PG8_WAIT_L(0); PG8_BAR; if (!HALFSEL || dh0) PG8_MMA(1, 0, At, B0); if (!HALFSEL || dh1) PG8_MMA(1, 1, At, B1); PG8_BAR; PG8_SCHED;
        }
        if constexpr (FP8) asm volatile("s_nop 15\n\ts_nop 15" ::: "memory");
        if constexpr (ALIGN_EPI) { if (wr == 0) PG8_BAR; }
        E(acc, cur, wr, wc, fr, fq);
        if (!has_next) break;
#pragma unroll
        for (int a = 0; a < 2; ++a)
#pragma unroll
            for (int b = 0; b < 2; ++b)
#pragma unroll
                for (int m = 0; m < 4; ++m)
#pragma unroll
                    for (int n = 0; n < 2; ++n) acc[a][b][m][n] = (f32x4){0.f, 0.f, 0.f, 0.f};
        if constexpr (FP8) asm volatile("s_nop 7" ::: "memory");
        cur = nxt; cA = nA; cB = nB; ++ui;
        if constexpr (GATHER) {
#pragma unroll
            for (int _h = 0; _h < 2; ++_h)
#pragma unroll
                for (int _i = 0; _i < 2; ++_i) aoC[_h][_i] = aoN[_h][_i]; }
        if constexpr (ALIGN_EPI) { if (wr == 1) PG8_BAR; }
    }
    PG8_WAIT_V(0);
    if constexpr (!ALIGN_EPI) { if (wr == 0) PG8_BAR; }
    PG8_BAR;
#undef PG8_SA
#undef PG8_SB
#undef PG8_STAGE
#undef PG8_STAGE_A
#undef PG8_LDA
#undef PG8_LD8
#undef PG8_LDB
#undef PG8_MMA
#undef PG8_WAIT_V
#undef PG8_WAIT_L
#undef PG8_BAR
#undef PG8_SCHED
#undef PG8_AOFF
}
}
#include <hip/hip_bf16.h>
namespace attn_body {
using bf16=__hip_bfloat16;
using bf16x8=__attribute__((ext_vector_type(8)))short;
using s16x4=__attribute__((ext_vector_type(4)))short;
using f32x16=__attribute__((ext_vector_type(16)))float;
using u32x4=__attribute__((ext_vector_type(4)))unsigned;
constexpr int BATCH=4,NHEAD=16,SEQ=4096,D=64,DM=NHEAD*D;
constexpr int NW=8,QBLK=32,QB=QBLK*NW,KVBLK=64,NQB=SEQ/QB;
constexpr int ATTN_PITCH=DM, ATTN_UNIT_ROWS=QB;
__device__ __forceinline__ int crow(int r,int hi){return (r&3)+8*(r>>2)+4*hi;}
#define SBAR() __builtin_amdgcn_sched_barrier(0)
__device__ __forceinline__ void cmask(f32x16&p0,f32x16&p1,int jb,int qrel,int hi){
  const float NEG=-INFINITY; int d=qrel-64*jb-4*hi; asm volatile("":"+v"(d));
  #pragma unroll
  for(int r=0;r<16;++r){const int c=(r&3)+8*(r>>2); if(c>d)p0[r]=NEG; if(c+32>d)p1[r]=NEG;}
}

constexpr int NSLOT=3, SLOTB=8192;
constexpr int LDS_GT=98304;
constexpr int LDS_K=0, LDS_V=NSLOT*SLOTB, LDS_WS=2*NSLOT*SLOTB, LDS_OST=LDS_WS+NW*64*4, LDS_BYTES=LDS_OST+NW*4096;
constexpr float C2=0.125f*1.4426950408889634f;
__device__ __forceinline__ void glds16(const void*gsrc,unsigned lds_dst){unsigned keep;
  asm volatile("s_mov_b32 %0, m0\n\ts_mov_b32 m0, %2\n\ts_nop 0\n\tglobal_load_lds_dwordx4 %1, off\n\ts_mov_b32 m0, %0":"=&s"(keep):"v"(gsrc),"s"(lds_dst):"memory");}
__device__ __forceinline__ void glds16s(const void*sbase,unsigned voff,unsigned lds_dst){unsigned keep;
  asm volatile("s_nop 4\n\ts_mov_b32 %0, m0\n\ts_mov_b32 m0, %3\n\ts_nop 0\n\tglobal_load_lds_dwordx4 %1, %2\n\ts_mov_b32 m0, %0":"=&s"(keep):"v"(voff),"s"(sbase),"s"(lds_dst):"memory");}
__device__ __forceinline__ unsigned lane_now(){unsigned l;asm volatile("v_mbcnt_lo_u32_b32 %0, -1, 0\n\tv_mbcnt_hi_u32_b32 %0, -1, %0":"=v"(l));return l;}
__device__ __forceinline__ float max3f(float a,float b,float c){float r;asm("v_max3_f32 %0, %1, %2, %3":"=v"(r):"v"(a),"v"(b),"v"(c));return r;}
__device__ __forceinline__ float max2f(float a,float b){float r;asm("v_max_f32_e32 %0, %1, %2":"=v"(r):"v"(a),"v"(b));return r;}
__device__ __forceinline__ float fadd_s(float a,float b){float r;asm("v_add_f32_e32 %0, %1, %2":"=v"(r):"v"(a),"v"(b));return r;}
__device__ __forceinline__ float fsub_s(float a,float b){float r;asm("v_sub_f32_e32 %0, %1, %2":"=v"(r):"v"(a),"v"(b));return r;}
typedef float f32x2_t __attribute__((ext_vector_type(2))); typedef __bf16 bf16x2_t __attribute__((ext_vector_type(2)));
__device__ __forceinline__ unsigned cvtpk_s(float lo,float hi){f32x2_t v={lo,hi};bf16x2_t b=__builtin_convertvector(v,bf16x2_t);return __builtin_bit_cast(unsigned,b);}
#define WAIT_BAR(N) asm volatile("s_waitcnt vmcnt(" #N ") lgkmcnt(0)\n\ts_barrier":::"memory")

__device__ __forceinline__ void qkt(f32x16&p0,f32x16&p1,const char*Kslot,const bf16x8*qr,int r32,int hi){
  const char*kb=Kslot+hi*1024+r32*16;
  #pragma unroll
  for(int d0=0;d0<4;++d0){
    const bf16x8 b0=*reinterpret_cast<const bf16x8*>(kb+d0*2048);
    const bf16x8 b1=*reinterpret_cast<const bf16x8*>(kb+d0*2048+512);
    if(d0==0){p0=__builtin_amdgcn_mfma_f32_32x32x16_bf16(b0,qr[0],(f32x16){0.f,0.f,0.f,0.f,0.f,0.f,0.f,0.f,0.f,0.f,0.f,0.f,0.f,0.f,0.f,0.f},0,0,0);p1=__builtin_amdgcn_mfma_f32_32x32x16_bf16(b1,qr[0],(f32x16){0.f,0.f,0.f,0.f,0.f,0.f,0.f,0.f,0.f,0.f,0.f,0.f,0.f,0.f,0.f,0.f},0,0,0);}
    else{p0=__builtin_amdgcn_mfma_f32_32x32x16_bf16(b0,qr[d0],p0,0,0,0);p1=__builtin_amdgcn_mfma_f32_32x32x16_bf16(b1,qr[d0],p1,0,0,0);}}
}
typedef __attribute__((address_space(3))) const char* lds_cptr;
typedef short v4i16_t __attribute__((ext_vector_type(4)));
__device__ __forceinline__ void kload8(bf16x8*kf,lds_cptr kp){
  kf[0]=*(const __attribute__((address_space(3))) bf16x8*)(kp);      kf[1]=*(const __attribute__((address_space(3))) bf16x8*)(kp+512);
  kf[2]=*(const __attribute__((address_space(3))) bf16x8*)(kp+2048); kf[3]=*(const __attribute__((address_space(3))) bf16x8*)(kp+2560);
  kf[4]=*(const __attribute__((address_space(3))) bf16x8*)(kp+4096); kf[5]=*(const __attribute__((address_space(3))) bf16x8*)(kp+4608);
  kf[6]=*(const __attribute__((address_space(3))) bf16x8*)(kp+6144); kf[7]=*(const __attribute__((address_space(3))) bf16x8*)(kp+6656);
}
__device__ __forceinline__ void kload2(bf16x8*kf,lds_cptr kp,int j){ kf[2*j]=*(const __attribute__((address_space(3))) bf16x8*)(kp+j*2048); kf[2*j+1]=*(const __attribute__((address_space(3))) bf16x8*)(kp+j*2048+512); }
__device__ __forceinline__ s16x4 vtr(lds_cptr p){ return __builtin_bit_cast(s16x4,__builtin_amdgcn_ds_read_tr16_b64_v4i16((__attribute__((address_space(3))) v4i16_t*)p)); }
__device__ __forceinline__ float rowmax(const f32x16&p0,const f32x16&p1){
  float a=max3f(p0[0],p0[1],p1[0]),b=max3f(p0[2],p0[3],p1[1]);a=max3f(a,p1[2],p1[3]);
  #pragma unroll
  for(int r=4;r<16;r+=4){a=max3f(a,p0[r],p0[r+1]);b=max3f(b,p0[r+2],p0[r+3]);a=max3f(a,p1[r],p1[r+1]);b=max3f(b,p1[r+2],p1[r+3]);}
  const float m=max2f(a,b);
  auto rr=__builtin_amdgcn_permlane32_swap(__float_as_uint(m),__float_as_uint(m),false,false);
  return max2f(__uint_as_float(rr[0]),__uint_as_float(rr[1]));
}
__device__ __forceinline__ void pv(f32x16*o,int vb,bf16x8 pa0,bf16x8 pa1,bf16x8 pa2,bf16x8 pa3){
  #pragma unroll
  for(int d0=0;d0<2;++d0){s16x4 lo[4],hi[4];
    #pragma unroll
    for(int ks=0;ks<4;++ks){
      asm volatile("ds_read_b64_tr_b16 %0,%1 offset:%c2":"=&v"(lo[ks]):"v"(vb),"i"(d0*4096+ks*1024):"memory");
      asm volatile("ds_read_b64_tr_b16 %0,%1 offset:%c2":"=&v"(hi[ks]):"v"(vb),"i"(d0*4096+ks*1024+512):"memory");}
    asm volatile("s_waitcnt lgkmcnt(0)":::"memory");SBAR();
    #define PK(k) (bf16x8){lo[k][0],lo[k][1],lo[k][2],lo[k][3],hi[k][0],hi[k][1],hi[k][2],hi[k][3]}
    o[d0]=__builtin_amdgcn_mfma_f32_32x32x16_bf16(pa0,PK(0),o[d0],0,0,0);
    o[d0]=__builtin_amdgcn_mfma_f32_32x32x16_bf16(pa1,PK(1),o[d0],0,0,0);
    o[d0]=__builtin_amdgcn_mfma_f32_32x32x16_bf16(pa2,PK(2),o[d0],0,0,0);
    o[d0]=__builtin_amdgcn_mfma_f32_32x32x16_bf16(pa3,PK(3),o[d0],0,0,0);
    #undef PK
  }
}

#ifndef ATTN_STORE16
#define ATTN_STORE16(p,v) (*(u32x4*)(p)=(v))
#endif
template<int THRL> __device__ __forceinline__ void attn_unit(int b,int h,int qb,const bf16*Q,const bf16*__restrict__ K,const bf16*__restrict__ V,bf16*O,const float*ksum,char*shm){
  const int tid=threadIdx.x,lane=tid&63,r32=lane&31,hi=lane>>5; const int wid=__builtin_amdgcn_readfirstlane(tid>>6);
  const long rowbase=(long)b*SEQ; const int q0=qb*QB;
  const bf16*Qw=Q+(rowbase+q0+wid*QBLK)*DM+h*D;
  const bf16*Kh=K+rowbase*DM+h*D,*Vh=V+rowbase*DM+h*D;
  const unsigned lds0=(unsigned)(uintptr_t)shm;
  float*wsf=(float*)(shm+LDS_WS)+wid*64;
  const unsigned kdst=lds0+LDS_K+wid*1024, vdst=lds0+LDS_V+wid*1024;
  #define PHYS(t) (((t)<4)?(4*qb+(t)):((t)-4))
  #define DMA_K(t,slot) glds16s((const char*)Kh+(size_t)PHYS(t)*(KVBLK*DM*2)+wid*16,lane_now()*(unsigned)(DM*2),(unsigned)__builtin_amdgcn_readfirstlane(kdst+(slot)))
  #define DMA_V(t,slot) glds16s((const char*)Vh+(size_t)PHYS(t)*(KVBLK*DM*2)+(size_t)(16*(wid&3))*(DM*2)+(wid>>2)*64,({const unsigned l_=lane_now(); (l_>>2)*(unsigned)(DM*2)+(l_&3u)*16u;}),(unsigned)__builtin_amdgcn_readfirstlane(vdst+(slot)))
  const int vb0=(int)(lds0+LDS_V)+((lane>>4)&1)*32+(lane&3)*8+(4*hi+((lane&15)>>2))*64;
  const char*Kbase=shm+LDS_K; bf16x8 kf[8];
  const lds_cptr shm3=(lds_cptr)shm; const lds_cptr kp0=shm3+LDS_K+hi*1024+r32*16; const lds_cptr vp0=shm3+LDS_V+((lane>>4)&1)*32+(lane&3)*8+(4*hi+((lane&15)>>2))*64;
  const int NT=(q0+QB)/KVBLK;
  DMA_K(0,0);DMA_V(0,0);DMA_K(1,SLOTB);
  { float*gt=(float*)(shm+LDS_GT);
    #pragma unroll
    for(int k=0;k<2;++k){ const int j=2*wid+k; if(j<qb) gt[j*64+lane]=ksum[(long)(b*16+j)*DM+h*D+lane]; } }
  bf16x8 qr[4];
  #pragma unroll
  for(int d0=0;d0<4;++d0)qr[d0]=*reinterpret_cast<const bf16x8*>(&Qw[(long)r32*DM+d0*16+hi*8]);

  unsigned sel=0u;
  float mhat=0.f,l_reg=0.f;f32x16 o[2];o[0]=f32x16{};o[1]=f32x16{};
  bf16x8 kone=(bf16x8){0,0,0,0,0,0,0,0}, qm=(bf16x8){0,0,0,0,0,0,0,0}; if(hi==0) kone[0]=(short)0x3F80;
  #define SETQM() do{ const unsigned short mb_=(unsigned short)(cvtpk_s(-mhat,0.f)&0xffffu); qm[0]=(hi==0)?(short)mb_:(short)0; asm volatile("":"+v"(qm)); }while(0)
  const int qrel=wid*QBLK+r32;
  #define CMASK(P0,P1,t) do{ const int t_=(t); if(t_<4){ const int l_=(int)lane_now(); cmask(P0,P1,t_,wid*QBLK+(l_&31),l_>>5); } else if(!((sel>>(((t_-4)>>2)&15))&1u)){ _Pragma("unroll") for(int r=0;r<16;++r){P0[r]=-INFINITY;P1[r]=-INFINITY;} } }while(0)
  bool resc=false;
  #define START(P0,P1) do{ const float rm=rowmax(P0,P1); resc=false; \
    { const float dl=__uint_as_float(cvtpk_s(rm,0.f)<<16); mhat=fadd_s(mhat,dl);          \
      _Pragma("unroll") for(int r=0;r<16;++r){P0[r]=fsub_s(P0[r],dl);P1[r]=fsub_s(P1[r],dl);} \
      SETQM(); } \
    _Pragma("unroll") for(int r=0;r<16;++r)P0[r]=__builtin_amdgcn_exp2f(P0[r]); }while(0)
  #define RESC() do{ if(resc){ asm volatile("s_waitcnt lgkmcnt(0)":::"memory"); \
      _Pragma("unroll") for(int d_=0;d_<2;++d_) _Pragma("unroll") for(int r=0;r<16;++r)o[d_][r]*=wsf[crow(r,(int)(lane_now()>>5))]; } }while(0)
  f32x16 pA0,pA1,pB0,pB1;
  int sl_prev=0,sl_cur=0,sl_next=SLOTB;
  #define ROT() do{sl_prev=sl_cur;sl_cur=sl_next;sl_next=(sl_next==(NSLOT-1)*SLOTB)?0:sl_next+SLOTB;}while(0)
  DMA_K(2,2*SLOTB);
  WAIT_BAR(3);
  { float qf[32];
    #pragma unroll
    for(int d0=0;d0<4;++d0){
      #pragma unroll
      for(int i=0;i<8;++i) qf[d0*8+i]=__uint_as_float(((unsigned)(unsigned short)qr[d0][i])<<16); }
    const float*gt=(const float*)(shm+LDS_GT)+hi*8; float g[15];
    #pragma unroll
    for(int j=0;j<15;++j){ g[j]=-INFINITY;
      if(j<qb){ const float*kp=gt+j*64; float a=0.f;
        #pragma unroll
        for(int d0=0;d0<4;++d0){ const float4 k0=*reinterpret_cast<const float4*>(kp+d0*16), k1=*reinterpret_cast<const float4*>(kp+d0*16+4);
          a+=qf[d0*8+0]*k0.x; a+=qf[d0*8+1]*k0.y; a+=qf[d0*8+2]*k0.z; a+=qf[d0*8+3]*k0.w; a+=qf[d0*8+4]*k1.x; a+=qf[d0*8+5]*k1.y; a+=qf[d0*8+6]*k1.z; a+=qf[d0*8+7]*k1.w; }
        g[j]=a+__shfl_xor(a,32); } }
    #pragma unroll
    for(int kk=0;kk<3;++kk){ float best=-INFINITY; int bj=-1;
      #pragma unroll
      for(int j=0;j<15;++j){ const bool c=(j<qb)&&!((sel>>j)&1u)&&(g[j]>best); best=c?g[j]:best; bj=c?j:bj; }
      if(bj>=0) sel|=(1u<<bj); } }
  qkt(pA0,pA1,Kbase,qr,r32,hi);asm volatile("s_nop 15\n\ts_nop 7":"+v"(pA0),"+v"(pA1));CMASK(pA0,pA1,0);
  START(pA0,pA1);
  _Pragma("unroll") for(int r=0;r<16;++r)pA1[r]=__builtin_amdgcn_exp2f(pA1[r]);
  WAIT_BAR(0);
  DMA_K(3,0);DMA_V(1,SLOTB);
  ROT();
  kload8(kf,kp0+sl_cur);
  WAIT_BAR(2);
  s16x4 vlo[8],vhi[8]; u32x4 pw0,pw1,pw2,pw3;
  #define PKW(P,B) cvtpk_s(P[B],P[B+1])
  #define PAF(k) __builtin_bit_cast(bf16x8,pw##k)
  #define VFR(i) (bf16x8){vlo[i][0],vlo[i][1],vlo[i][2],vlo[i][3],vhi[i][0],vhi[i][1],vhi[i][2],vhi[i][3]}
  #define PIN(x) asm volatile("":"+v"(x))
  #define MX3(a,b,c) __builtin_fmaxf(__builtin_fmaxf((a),(b)),(c))
  #define GAPA(MF,A0,A1,A2,A3,W0,W1,PW) do{ MF; sacc+=A0; sacc+=A1; sacc+=A2; sacc+=A3; PIN(sacc); W0; W1; PIN(PW); SBAR(); }while(0)
  #define EX(v) __builtin_amdgcn_exp2f(v)
  #define GAPB(MF,X,B) do{ MF; X[B]=EX(X[B]); X[B+1]=EX(X[B+1]); X[B+2]=EX(X[B+2]); X[B+3]=EX(X[B+3]); PIN(X); SBAR(); }while(0)
  #define VRD(i) do{ vlo[i]=vtr(vp_+(((i)>>2)*4096+((i)&3)*1024)); vhi[i]=vtr(vp_+(((i)>>2)*4096+((i)&3)*1024+512)); }while(0)
  #define KRD(G,j) do{ if(G){ kload2(kf,kp0+sl_next,j); SBAR(); } }while(0)
  #define STEP(C0,C1,P0,P1,t,GK,GV,GL) do{ SBAR(); \
    const lds_cptr vp_=vp0+sl_prev; \
    C0=__builtin_amdgcn_mfma_f32_32x32x16_bf16(kone,qm,(f32x16){0.f,0.f,0.f,0.f,0.f,0.f,0.f,0.f,0.f,0.f,0.f,0.f,0.f,0.f,0.f,0.f},0,0,0); C1=__builtin_amdgcn_mfma_f32_32x32x16_bf16(kone,qm,(f32x16){0.f,0.f,0.f,0.f,0.f,0.f,0.f,0.f,0.f,0.f,0.f,0.f,0.f,0.f,0.f,0.f},0,0,0); SBAR(); \
    VRD(0); SBAR(); float sacc=(P0[0]+P0[1]); \
    GAPA(C0=__builtin_amdgcn_mfma_f32_32x32x16_bf16(kf[0],qr[0],C0,0,0,0), P0[2],P0[3],P0[4],P0[5],     pw0[0]=PKW(P0,0), pw0[1]=PKW(P0,2), pw0); \
    VRD(4); SBAR(); GAPA(C1=__builtin_amdgcn_mfma_f32_32x32x16_bf16(kf[1],qr[0],C1,0,0,0), P0[6],P0[7],P0[8],P0[9],     pw0[2]=PKW(P0,4), pw0[3]=PKW(P0,6), pw0); \
    VRD(1); SBAR(); GAPA(C0=__builtin_amdgcn_mfma_f32_32x32x16_bf16(kf[2],qr[1],C0,0,0,0),   P0[10],P0[11],P0[12],P0[13], pw1[0]=PKW(P0,8), pw1[1]=PKW(P0,10), pw1); \
    VRD(5); SBAR(); GAPA(C1=__builtin_amdgcn_mfma_f32_32x32x16_bf16(kf[3],qr[1],C1,0,0,0),   P0[14],P0[15],P1[0],P1[1],   pw1[2]=PKW(P0,12),pw1[3]=PKW(P0,14), pw1); \
    VRD(2); SBAR(); GAPA(C0=__builtin_amdgcn_mfma_f32_32x32x16_bf16(kf[4],qr[2],C0,0,0,0),   P1[2],P1[3],P1[4],P1[5],     pw2[0]=PKW(P1,0), pw2[1]=PKW(P1,2), pw2); \
    VRD(6); SBAR(); GAPA(C1=__builtin_amdgcn_mfma_f32_32x32x16_bf16(kf[5],qr[2],C1,0,0,0),   P1[6],P1[7],P1[8],P1[9],     pw2[2]=PKW(P1,4), pw2[3]=PKW(P1,6), pw2); \
    VRD(3); SBAR(); GAPA(C0=__builtin_amdgcn_mfma_f32_32x32x16_bf16(kf[6],qr[3],C0,0,0,0),   P1[10],P1[11],P1[12],P1[13], pw3[0]=PKW(P1,8), pw3[1]=PKW(P1,10), pw3); \
    VRD(7); SBAR(); GAPA(C1=__builtin_amdgcn_mfma_f32_32x32x16_bf16(kf[7],qr[3],C1,0,0,0),   P1[14],P1[15],0.f,0.f,       pw3[2]=PKW(P1,12),pw3[3]=PKW(P1,14), pw3); \
    l_reg+=sacc; \
    if(GK){DMA_K((t)+3,sl_cur);} if(GV){DMA_V((t)+1,sl_next);} \
    CMASK(C0,C1,t); \
    { float a=MX3(C0[0],C0[1],C1[0]),b=MX3(C0[2],C0[3],C1[1]); a=MX3(a,C1[2],C1[3]); \
      _Pragma("unroll") for(int r=4;r<16;r+=4){a=MX3(a,C0[r],C0[r+1]);b=MX3(b,C0[r+2],C0[r+3]);a=MX3(a,C1[r],C1[r+1]);b=MX3(b,C1[r+2],C1[r+3]);} \
      float rm=__builtin_fmaxf(a,b); { auto rr=__builtin_amdgcn_permlane32_swap(__float_as_uint(rm),__float_as_uint(rm),false,false); rm=__builtin_fmaxf(__uint_as_float(rr[0]),__uint_as_float(rr[1])); } \
      resc=false; \
      if(__builtin_expect(__any(rm>(float)THRL),0)){ const float mn_=__uint_as_float(cvtpk_s(mhat+__builtin_fmaxf(rm,0.f),0.f)<<16); const float dl=mn_-mhat; mhat=mn_; \
        _Pragma("unroll") for(int r=0;r<16;++r){C0[r]-=dl;C1[r]-=dl;} \
        SETQM(); \
        const float f=__builtin_amdgcn_exp2f(-dl); l_reg*=f; { const int l_=(int)lane_now(); if((l_>>5)==0)wsf[l_&31]=f; } resc=true; } } \
    SBAR(); \
    GAPB(o[0]=__builtin_amdgcn_mfma_f32_32x32x16_bf16(PAF(0),VFR(0),o[0],0,0,0), C0,0); \
    GAPB(o[1]=__builtin_amdgcn_mfma_f32_32x32x16_bf16(PAF(0),VFR(4),o[1],0,0,0), C0,4); \
    KRD(GL,0); GAPB(o[0]=__builtin_amdgcn_mfma_f32_32x32x16_bf16(PAF(1),VFR(1),o[0],0,0,0), C0,8); \
    KRD(GL,1); GAPB(o[1]=__builtin_amdgcn_mfma_f32_32x32x16_bf16(PAF(1),VFR(5),o[1],0,0,0), C0,12); \
    KRD(GL,2); GAPB(o[0]=__builtin_amdgcn_mfma_f32_32x32x16_bf16(PAF(2),VFR(2),o[0],0,0,0), C1,0); \
    KRD(GL,3); GAPB(o[1]=__builtin_amdgcn_mfma_f32_32x32x16_bf16(PAF(2),VFR(6),o[1],0,0,0), C1,4); \
    GAPB(o[0]=__builtin_amdgcn_mfma_f32_32x32x16_bf16(PAF(3),VFR(3),o[0],0,0,0), C1,8); \
    GAPB(o[1]=__builtin_amdgcn_mfma_f32_32x32x16_bf16(PAF(3),VFR(7),o[1],0,0,0), C1,12); \
    }while(0)
  int t=1;
  #undef CMASK
  #define CMASK(P0,P1,t) do{ const int t_=(t); if(t_<4){ const int l_=(int)lane_now(); cmask(P0,P1,t_,wid*QBLK+(l_&31),l_>>5); } else if(!((sel>>(((t_-4)>>2)&15))&1u)){ _Pragma("unroll") for(int r=0;r<16;++r){P0[r]=-INFINITY;P1[r]=-INFINITY;} } }while(0)
  for(;t+5<NT;t+=2){
    STEP(pB0,pB1,pA0,pA1,t,true,true,true);     WAIT_BAR(2); RESC(); ROT();
    STEP(pA0,pA1,pB0,pB1,t+1,true,true,true);   WAIT_BAR(2); RESC(); ROT();
  }
  #undef CMASK
  #define CMASK(P0,P1,t) do{ const int t_=(t); if(t_<4){ const int l_=(int)lane_now(); cmask(P0,P1,t_,wid*QBLK+(l_&31),l_>>5); } else if(!((sel>>(((t_-4)>>2)&15))&1u)){ _Pragma("unroll") for(int r=0;r<16;++r){P0[r]=-INFINITY;P1[r]=-INFINITY;} } }while(0)
  #define ENDW(tt) do{ if((tt)+3<NT){WAIT_BAR(2);} else if((tt)+2<NT){WAIT_BAR(1);} else {WAIT_BAR(0);} }while(0)
  for(;t+1<NT;t+=2){
    STEP(pB0,pB1,pA0,pA1,t,(t+3<NT),(t+1<NT),(t+1<NT));       ENDW(t);   RESC(); ROT();
    STEP(pA0,pA1,pB0,pB1,t+1,(t+4<NT),(t+2<NT),(t+2<NT));     ENDW(t+1); RESC(); ROT();
  }
  STEP(pB0,pB1,pA0,pA1,NT-1,false,false,false); RESC();
  { float sacc=pB0[0]+pB0[1]; _Pragma("unroll") for(int r=2;r<16;++r)sacc+=pB0[r]; _Pragma("unroll") for(int r=0;r<16;++r)sacc+=pB1[r]; l_reg+=sacc;
    pw0=(u32x4){PKW(pB0,0),PKW(pB0,2),PKW(pB0,4),PKW(pB0,6)};pw1=(u32x4){PKW(pB0,8),PKW(pB0,10),PKW(pB0,12),PKW(pB0,14)};pw2=(u32x4){PKW(pB1,0),PKW(pB1,2),PKW(pB1,4),PKW(pB1,6)};pw3=(u32x4){PKW(pB1,8),PKW(pB1,10),PKW(pB1,12),PKW(pB1,14)};
    SBAR(); pv(o,vb0+sl_cur,PAF(0),PAF(1),PAF(2),PAF(3)); }
  #undef PKW
  #undef PAF
  #undef VFR
  #undef PIN
  #undef MX3
  #undef GAPA
  #undef GAPB
  #undef EX
  #undef VRD
  #undef KRD
  #undef STEP
  #undef ENDW
  {auto rr=__builtin_amdgcn_permlane32_swap(__float_as_uint(l_reg),__float_as_uint(l_reg),false,false);l_reg=__uint_as_float(rr[0])+__uint_as_float(rr[1]);}
  if(hi==0)wsf[32+r32]=l_reg;asm volatile("s_waitcnt lgkmcnt(0)":::"memory");
  float rli[16];
  #pragma unroll
  for(int r=0;r<16;++r)rli[r]=__builtin_amdgcn_rcpf(wsf[32+crow(r,hi)]);
  bf16*Ow=O+(rowbase+q0+wid*QBLK)*DM+h*D;
  { bf16*stg=(bf16*)(shm+LDS_OST)+wid*2048;
    #pragma unroll
    for(int r=0;r<16;++r){const int orow=crow(r,hi);
      #pragma unroll
      for(int d0=0;d0<2;++d0)stg[orow*64+d0*32+r32]=__float2bfloat16(o[d0][r]*rli[r]);}
    asm volatile("s_waitcnt lgkmcnt(0)":::"memory");
    #pragma unroll
    for(int i=0;i<4;++i){const int row=i*8+(lane>>3),ch=lane&7; const u32x4 v=*(const u32x4*)(stg+row*64+ch*8); ATTN_STORE16(Ow+(long)row*DM+ch*8,v);} }
  asm volatile("s_waitcnt lgkmcnt(0)\n\ts_barrier":::"memory");
  #undef DMA_K
  #undef PHYS
  #undef DMA_V
  #undef CMASK
  #undef START
  #undef SETQM
  #undef RESC
  #undef ROT
}
constexpr int ATTN_LDS_BYTES=LDS_BYTES;
struct AttnTensors { const bf16* Q; const bf16* K; const bf16* V; bf16* O; const float* ksum; };
struct AttnUnit { int bh; int qb; };
struct StaticOrder {
  int vcu, G;
  __device__ __forceinline__ explicit StaticOrder(int grid,int block):vcu((grid%8==0)?((block%8)*(grid/8)+block/8):block),G(grid){}
  __device__ __forceinline__ bool next(int i,AttnUnit&u)const{ const int L=i*G+vcu; if(L>=1024)return false; const int w=L&255, rnd=L>>8, s=w&3; u.bh=w>>2; u.qb=(rnd==0)?s:(rnd==1)?7-s:(rnd==2)?8+s:15-s; return true; }
  __device__ __forceinline__ void a_ready(const AttnUnit&)const{}
  __device__ __forceinline__ void done(const AttnUnit&)const{}
};
struct SnakeOrder {
  int v, G;
  __device__ __forceinline__ bool next(int i,AttnUnit&u)const{ const int idx=i*G+((i&1)?(G-1-v):v); if(idx>=1024)return false; u.qb=15-(idx>>6); u.bh=idx&63; return true; }
  __device__ __forceinline__ void a_ready(const AttnUnit&)const{}
  __device__ __forceinline__ void done(const AttnUnit&)const{}
};
template<class Sched,int THRL=8> __device__ __forceinline__ void attn_phase(char*lds,const AttnTensors&T,const Sched&S){
  AttnUnit u;
  for(int i=0;S.next(i,u);++i){ S.a_ready(u); attn_unit<THRL>(u.bh/NHEAD,u.bh%NHEAD,u.qb,T.Q,T.K,T.V,T.O,T.ksum,lds); S.done(u); }
}
#undef SBAR
#undef WAIT_BAR
}
constexpr int NWAVES = 8, NTHR = 512;
constexpr int NTOK = 16384, DM = 1024, SEQ = 4096, NBATCH = 4, NEXP = 32;
constexpr float ALPHA = 1.4142135623730951f;
constexpr float LN_EPS = 1e-5f;
constexpr float RSQRT_DQK = 0.08838834764831845f;
constexpr int NPHASE = 19;
constexpr float FP8_SA = 4.0f, FP8_SWGU = 64.0f, FP8_SWD = 128.0f;
constexpr float FP8_SY = 32.0f, FP8_MAXV = 448.0f;
#ifndef DBG_ATTN_MUL
#define DBG_ATTN_MUL 1.0f
#endif
#ifndef DBG_MLSTM_MUL
#define DBG_MLSTM_MUL 1.0f
#endif
#ifndef DBG_MOE_MUL
#define DBG_MOE_MUL 1.0f
#endif
#ifndef DBG_P14_A
#define DBG_P14_A WS_HN
#endif
#ifndef NCONV
#define NCONV 80
#endif
#ifndef MK_ONE_LAUNCH
#define MK_ONE_LAUNCH 1
#endif

constexpr size_t MiB = 1u << 20, KiB = 1024;
constexpr size_t WS_CTL = 0, CTL_ZERO_BYTES = 1 * MiB;
constexpr int CW_TMO = 0, CW_BAR = 4096, CW_CNT = 8192, CW_AQ = 16384;
constexpr size_t WS_KSUM = 256 * KiB, WS_DEN = 512 * KiB;
constexpr size_t WS_WQKV = 2 * MiB, WS_WO = 8 * MiB, WS_WINA = 10 * MiB, WS_WINB = 14 * MiB, WS_WOUT = 17 * MiB;
constexpr size_t WS_WG = 19 * MiB, WS_RWT = 20 * MiB, WS_ROPE = 21 * MiB;
constexpr size_t WS_TOKE = 22 * MiB, WS_TOKP = 22 * MiB + 256 * KiB, WS_TOKG = 22 * MiB + 512 * KiB;
constexpr size_t WS_GI = 23 * MiB, WS_LF = 23 * MiB + 256 * KiB, WS_RF = 23 * MiB + 512 * KiB, WS_CF = 23 * MiB + 768 * KiB;
constexpr size_t WS_DEC = 24 * MiB, WS_NU = 24 * MiB + 256 * KiB, WS_NPREV = 24 * MiB + 512 * KiB;
constexpr size_t WS_ROWTOK = 25 * MiB;
constexpr size_t WS_XB = 32 * MiB, WS_Q = 64 * MiB, WS_K = 96 * MiB, WS_V = 128 * MiB;
constexpr size_t WS_R0 = 160 * MiB, WS_R1 = 224 * MiB, WS_R2 = 288 * MiB;
constexpr size_t WS_H = 352 * MiB, WS_Y = 496 * MiB;
constexpr size_t WS_WGU = 640 * MiB, WS_WD = 896 * MiB, WS_END = 1024 * MiB;
constexpr size_t WS_AE = 352 * MiB, WS_BE = 416 * MiB, WS_KN = 464 * MiB, WS_KT = 496 * MiB, WS_UT = 512 * MiB, WS_OS = 544 * MiB, WS_HN = 576 * MiB;

constexpr int RING_OFF = 0, RING_BYTES = 131072;
constexpr int LX = RING_BYTES;
constexpr int LX_MISC = LX;
constexpr int LX_TILEE = LX + 128;
constexpr int LX_TBASE = LX + 1280;
constexpr int LX_LCNT = LX + 1536, LX_GBASE = LX + 1664;
constexpr int LX_REC = LX + 1792;
constexpr int LX_TOKL = LX + 4096;
constexpr int LX_LNX = LX + 4096;
constexpr int LX_BIAS = LX + 12288;
constexpr int LDS_BYTES = 147456;
constexpr int TOKL_ROUNDS = 10;

#define RLX_AGENT __ATOMIC_RELAXED, __HIP_MEMORY_SCOPE_AGENT
#define LDS_WAIT() asm volatile("s_waitcnt lgkmcnt(0)" ::: "memory")
#define VM_WAIT() asm volatile("s_waitcnt vmcnt(0)" ::: "memory")
#define XB_TMO      128
#define XB_XCNT(j)  (256  + 64 * (j))
#define XB_XSUB(j)  (1280 + 64 * (j))
#define XB_XGEN(j)  (2304 + 64 * (j))
#define XB_TOP      3328
#define XB_TOPGEN   3392
#define XCD_BAR_WORDS 3456
#define XB_SPIN_CAP (1u << 18)

__device__ __forceinline__ unsigned xb_ld(unsigned* p)              { return __hip_atomic_load(p, __ATOMIC_RELAXED, __HIP_MEMORY_SCOPE_AGENT); }
__device__ __forceinline__ unsigned xb_add(unsigned* p, unsigned v) { return __hip_atomic_fetch_add(p, v, __ATOMIC_RELAXED, __HIP_MEMORY_SCOPE_AGENT); }
__device__ __forceinline__ unsigned xb_xcc_id() { return (unsigned)__builtin_amdgcn_s_getreg((3 << 11) | 20) & 0xFu; }
#define XB_SPIN(cond, bar) do { unsigned _sp = 0; while (cond) { __builtin_amdgcn_s_sleep(1); \
    if ((++_sp & 255u) == 0u) { if (xb_ld(&(bar)[XB_TMO])) break; if (_sp > XB_SPIN_CAP) { atomicAdd(&(bar)[XB_TMO], 1u); break; } } } } while (0)

struct XcdBarrier {
    unsigned* bar; unsigned x;
    volatile LAS unsigned* st;
};

__device__ __forceinline__ XcdBarrier xcd_barrier_post(unsigned* bar, volatile LAS unsigned* st) {
    XcdBarrier b; b.bar = bar; b.x = xb_xcc_id(); b.st = st;
    if (threadIdx.x == 0) (void)xb_add(&bar[XB_XCNT(b.x)], 1u);
    return b;
}
__device__ __forceinline__ void xcd_barrier_complete(unsigned* bar, unsigned x, unsigned& nloc, unsigned& nx) {
    const unsigned G = gridDim.x * gridDim.y * gridDim.z;
    unsigned sum, cnt, mine, sp = 0u;
    for (;;) {
        sum = 0u; cnt = 0u; mine = 0u;
#pragma unroll
        for (unsigned j = 0; j < 16; ++j) { const unsigned c = xb_ld(&bar[XB_XCNT(j)]); sum += c; cnt += (c > 0u) ? 1u : 0u; mine = (j == x) ? c : mine; }
        if (sum == G) break;
        __builtin_amdgcn_s_sleep(1);
        if ((++sp & 255u) == 0u) { if (xb_ld(&bar[XB_TMO])) break; if (sp > XB_SPIN_CAP) { atomicAdd(&bar[XB_TMO], 1u); break; } }
    }
    nloc = mine > 0u ? mine : 1u; nx = cnt > 0u ? cnt : 1u;
}

__device__ __forceinline__ void xcd_barrier(const XcdBarrier& b) {
    asm volatile("s_waitcnt vmcnt(0)" ::: "memory");
    __syncthreads();
    if (threadIdx.x == 0) {
        unsigned* bar = b.bar;
        __builtin_amdgcn_s_waitcnt(0);
        unsigned nloc = b.st[0], nx = b.st[1];
        if (nloc == 0u) { xcd_barrier_complete(bar, b.x, nloc, nx); b.st[0] = nloc; b.st[1] = nx; }
        const unsigned old = xb_add(&bar[XB_XSUB(b.x)], 1u);
        const unsigned gen = old / nloc;
        if (old + 1u == (gen + 1u) * nloc) {
            __builtin_amdgcn_fence(__ATOMIC_RELEASE, "agent");
            asm volatile("s_waitcnt vmcnt(0)" ::: "memory");
            const unsigned og = xb_add(&bar[XB_TOP], 1u);
            const unsigned tg = og / nx;
            if (og + 1u == (tg + 1u) * nx) xb_add(&bar[XB_TOPGEN], 1u);
            else XB_SPIN(xb_ld(&bar[XB_TOPGEN]) == tg, bar);
            __builtin_amdgcn_fence(__ATOMIC_ACQUIRE, "agent");
            xb_add(&bar[XB_XGEN(b.x)], 1u);
            asm volatile("s_waitcnt vmcnt(0)" ::: "memory");
        } else {
            XB_SPIN(xb_ld(&bar[XB_XGEN(b.x)]) == gen, bar);
            __builtin_amdgcn_fence(__ATOMIC_ACQUIRE, "agent");
            asm volatile("s_waitcnt vmcnt(0)" ::: "memory");
        }
    }
    __syncthreads();
}
using pg8::Unit; using pg8::Gemm;
typedef f32x4 (&AccRef)[2][2][4][2];

#ifndef TAIL_FIRST
#define TAIL_FIRST 0
#endif
__device__ __forceinline__ bool moe_unit(int i, int G, int c, int nT, int nN, int& pm, int& pn, int& half) {
    const int U = nT * nN, R = U / G, rem = U - R * G; half = 0;
#if TAIL_FIRST
    if (rem > 0 && 2 * rem <= G) {
        if (c < 2 * rem) { if (i == 0) { half = 1 + (c & 1); return pg8::tile_order(0, U, R * G + (c >> 1), nT, nN, pm, pn); } --i; }
        if (i < R) return pg8::tile_order(i, G, c, nT, nN, pm, pn);
        return false; }
#endif
    if (i < R) return pg8::tile_order(i, G, c, nT, nN, pm, pn);
    if (i > R || rem == 0) return false;
    if (2 * rem <= G) { if (c >= 2 * rem) return false; half = 1 + (c & 1); return pg8::tile_order(0, U, R * G + (c >> 1), nT, nN, pm, pn); }
    return pg8::tile_order(i, G, c, nT, nN, pm, pn);
}
struct DenseSched {
    int nM, nN, G, c; const char* A; const char* B; size_t tstepA, tstepB; bool split = false;
    __device__ __forceinline__ bool next(int i, Unit& u) const {
        int half = 0;
        if (split) { if (!moe_unit(i, G, c, nM, nN, u.pm, u.pn, half)) return false; }
        else if (!pg8::tile_order(i, G, c, nM, nN, u.pm, u.pn)) return false;
        u.A = A + (size_t)u.pm * tstepA; u.B = B + (size_t)u.pn * tstepB; u.tl = nullptr; u.x0 = u.x1 = 0; u.x2 = half; return true; }
};
struct MoeSched {
    int nT, nN, G, c; const LAS int* tile_e; const LAS int* tbase; const LAS unsigned short* tokl;
    const char* A; const char* B; size_t tstepA, estepB, tstepB;
    __device__ __forceinline__ bool next(int i, Unit& u) const {
        int half; if (!moe_unit(i, G, c, nT, nN, u.pm, u.pn, half)) return false;
        const int e = tile_e[u.pm];
        u.x0 = e; u.x1 = u.pm * 256; u.x2 = half;
        u.A = A + (size_t)u.pm * tstepA; u.B = B + (size_t)e * estepB + (size_t)u.pn * tstepB;
        u.tl = tokl ? tokl + (i < TOKL_ROUNDS ? i : TOKL_ROUNDS - 1) * 256 : nullptr; return true; }
};
struct MuSched {
    int G, c, mode; const char* A; const char* B;
    __device__ __forceinline__ bool next(int i, Unit& u) const {
        const int mu = i * G + c; if (mu >= 256) return false;
        const int b = mu >> 6, hh = (mu >> 4) & 3, ch = mu & 15; const size_t tok0 = (size_t)b * SEQ + (size_t)ch * 256;
        u.pm = mu; u.pn = 0; u.x0 = mu; u.x1 = 0; u.x2 = (mode == 0) ? 1 : 0; u.tl = nullptr;
        if (mode == 0) { u.A = A + (size_t)mu * 256 * 384 * 2; u.B = B + ((size_t)(hh * 128) * NTOK + tok0) * 2; }
        else if (mode == 1) { u.A = A + ((size_t)mu * 256 * 512 + 256) * 2; u.B = B + (tok0 * 1024 + (size_t)hh * 256) * 2; }
        else { u.A = A + (size_t)mu * 256 * 512 * 2; u.B = B + (size_t)mu * 256 * 384 * 2; }
        return true; }
};

constexpr float C2 = 0.125f * 1.4426950408889634f;

struct EpiQKV {
    static constexpr bool PERM = true;
    __device__ __forceinline__ void prep(const Unit&, int, int, int) const {}
    bf16_t* Q; bf16_t* K; bf16_t* V; const float* rope; float* ksum;
    __device__ __forceinline__ void operator()(AccRef acc, const Unit& u, int wr, int wc, int fr, int fq) const {
        asm volatile("" : "+v"(fr), "+v"(fq));
        const int part = u.pn >> 2, colt = (u.pn & 3) * 256;
        bf16_t* base = Q + (size_t)part * ((WS_K - WS_Q) / 2);
        const bool rot = (part < 2) && ((wc & 1) == 0);
        const float sgn = (fq == 0) ? -1.f : 1.f;
        float ks[2][8];
#pragma unroll
        for (int bj = 0; bj < 2; ++bj)
#pragma unroll
            for (int j = 0; j < 8; ++j) ks[bj][j] = 0.f;
#pragma unroll
        for (int ai = 0; ai < 2; ++ai)
#pragma unroll
            for (int m = 0; m < 4; ++m) {
                const int row = u.pm * 256 + ai * 128 + wr * 64 + m * 16 + fr;
                f32x4 cs0 = {1.f, 1.f, 1.f, 1.f}, cs1 = cs0, sn0 = {0.f, 0.f, 0.f, 0.f}, sn1 = sn0;
                if (rot) { const f32x4* rp = (const f32x4*)(rope + (size_t)row * 16); cs0 = rp[0]; cs1 = rp[1]; sn0 = rp[2]; sn1 = rp[3]; }
#pragma unroll
                for (int bj = 0; bj < 2; ++bj) {
                    f32x4 v0 = acc[ai][bj][m][0], v1 = acc[ai][bj][m][1];
                    if (rot) {
                        f32x4 p0, p1;
#pragma unroll
                        for (int j = 0; j < 4; ++j) { p0[j] = __shfl_xor(v0[j], 16); p1[j] = __shfl_xor(v1[j], 16); }
                        if (fq < 2) { v0 = v0 * cs0 + p0 * sn0 * sgn; v1 = v1 * cs1 + p1 * sn1 * sgn; }
                    }
                    if (part == 0) { v0 = v0 * C2; v1 = v1 * C2; }
                    if (part == 1) {
#pragma unroll
                        for (int j = 0; j < 4; ++j) { ks[bj][j] += v0[j]; ks[bj][4 + j] += v1[j]; } }
                    u32x4 w; w.x = cvt_pk_bf16(v0[0], v0[1]); w.y = cvt_pk_bf16(v0[2], v0[3]); w.z = cvt_pk_bf16(v1[0], v1[1]); w.w = cvt_pk_bf16(v1[2], v1[3]);
                    *(u32x4*)(base + (size_t)row * DM + colt + bj * 128 + wc * 32 + fq * 8) = w;
                }
            }
        if (part == 1) {
#pragma unroll
            for (int bj = 0; bj < 2; ++bj)
#pragma unroll
                for (int j = 0; j < 8; ++j) { float s = ks[bj][j]; s += __shfl_xor(s, 1); s += __shfl_xor(s, 2); s += __shfl_xor(s, 4); s += __shfl_xor(s, 8);
                    if (fr == 0) atomicAdd(ksum + (size_t)u.pm * DM + colt + bj * 128 + wc * 32 + fq * 8 + j, s); }
        }
    }
};

struct EpiZ {
    static constexpr bool PERM = true;
    __device__ __forceinline__ void prep(const Unit&, int, int, int) const {}
    const bf16_t* xin; bf16_t* z; float ymul;
    __device__ __forceinline__ void operator()(AccRef acc, const Unit& u, int wr, int wc, int fr, int fq) const {
        asm volatile("" : "+v"(fr), "+v"(fq));
#pragma unroll
        for (int ai = 0; ai < 2; ++ai) {
            const size_t off0 = (size_t)(u.pm * 256 + ai * 128 + wr * 64 + fr) * DM + u.pn * 256 + wc * 32 + fq * 8;
            u32x4 xr[4][2];
#pragma unroll
            for (int m = 0; m < 4; ++m)
#pragma unroll
                for (int bj = 0; bj < 2; ++bj) xr[m][bj] = *(const u32x4*)(xin + off0 + (size_t)m * 16 * DM + bj * 128);
#pragma unroll
            for (int m = 0; m < 4; ++m)
#pragma unroll
                for (int bj = 0; bj < 2; ++bj) { const u32x4 x = xr[m][bj]; const f32x4 a0 = acc[ai][bj][m][0] * ymul, a1 = acc[ai][bj][m][1] * ymul;
                    u32x4 w; w.x = cvt_pk_bf16(bflo(x.x) * ALPHA + a0[0], bfhi(x.x) * ALPHA + a0[1]); w.y = cvt_pk_bf16(bflo(x.y) * ALPHA + a0[2], bfhi(x.y) * ALPHA + a0[3]);
                    w.z = cvt_pk_bf16(bflo(x.z) * ALPHA + a1[0], bfhi(x.z) * ALPHA + a1[1]); w.w = cvt_pk_bf16(bflo(x.w) * ALPHA + a1[2], bfhi(x.w) * ALPHA + a1[3]);
                    *(u32x4*)(z + off0 + (size_t)m * 16 * DM + bj * 128) = w; }
            asm volatile("" ::: "memory");
        }
    }
};

__device__ __forceinline__ float swiglu1(float glu, float lin) {
    const float g = fminf(glu, 7.0f), l = fminf(fmaxf(lin, -7.0f), 7.0f);
    const float sg = __builtin_amdgcn_rcpf(1.0f + __builtin_amdgcn_exp2f(-1.702f * 1.4426950408889634f * g));
    return g * sg * (l + 1.0f);
}
__device__ __forceinline__ f32x2 swiglu2(float glu0, float lin0, float glu1, float lin1) {
    const f32x2 g = {fminf(glu0, 7.0f), fminf(glu1, 7.0f)}, l = {fminf(fmaxf(lin0, -7.0f), 7.0f), fminf(fmaxf(lin1, -7.0f), 7.0f)};
    const f32x2 t = g * (f32x2){-1.702f * 1.4426950408889634f, -1.702f * 1.4426950408889634f};
    const f32x2 d = (f32x2){__builtin_amdgcn_exp2f(t[0]), __builtin_amdgcn_exp2f(t[1])} + (f32x2){1.0f, 1.0f};
    const f32x2 r = {__builtin_amdgcn_rcpf(d[0]), __builtin_amdgcn_rcpf(d[1])};
    const f32x2 lp = l * (f32x2){FP8_SA, FP8_SA} + (f32x2){FP8_SA, FP8_SA};
    return (g * lp) * r;
}
struct EpiGU {
    static constexpr bool PERM = true;
    __device__ __forceinline__ void prep(const Unit& u, int ui, int wid, int lane) const { if (wid < 4) glds4s(uni_ptr((const char*)(bias + (size_t)u.x0 * 2048 + u.pn * 256 + wid * 64)), (unsigned)lane * 4u, (unsigned)__builtin_amdgcn_readfirstlane((unsigned)(unsigned long long)bl + (unsigned)(((ui & 1) * 256 + wid * 64) * 4))); }
    const float* bias; unsigned char* H; LAS float* bl; mutable int ucnt;
    __device__ __forceinline__ void operator()(AccRef acc, const Unit& u, int wr, int wc, int fr, int fq) const {
        asm volatile("" : "+v"(fr), "+v"(fq));
        const int c0 = u.pn * 256 + wc * 32 + fq * 8; const LAS float* bp = bl + (ucnt & 1) * 256 + wc * 32 + fq * 8; ++ucnt; constexpr float SC = 1.0f / (FP8_SA * FP8_SWGU);
        f32x4 b[2][2];
#pragma unroll
        for (int bj = 0; bj < 2; ++bj) { b[bj][0] = *(const LAS f32x4*)(bp + bj * 128); b[bj][1] = *(const LAS f32x4*)(bp + bj * 128 + 4); }
#pragma unroll
        for (int ai = 0; ai < 2; ++ai)
#pragma unroll
            for (int m = 0; m < 4; ++m) {
                unsigned char* rowp = H + (size_t)(u.x1 + ai * 128 + wr * 64 + m * 16 + fr) * DM + (c0 >> 1);
#pragma unroll
                for (int bj = 0; bj < 2; ++bj) { if (u.x2 == 2 - bj) continue;
                    const f32x4 v0 = acc[ai][bj][m][0] * SC + b[bj][0], v1 = acc[ai][bj][m][1] * SC + b[bj][1];
                    const f32x2 h0 = swiglu2(v0[0], v0[1], v0[2], v0[3]), h1 = swiglu2(v1[0], v1[1], v1[2], v1[3]);
                    int w = __builtin_amdgcn_cvt_pk_fp8_f32(h0[0], h0[1], 0, false);
                    w = __builtin_amdgcn_cvt_pk_fp8_f32(h1[0], h1[1], w, true);
                    *(int*)(rowp + bj * 64) = w; }
            }
    }
};
struct EpiDN {
    static constexpr bool PERM = true;
    __device__ __forceinline__ void prep(const Unit& u, int ui, int wid, int lane) const { if (wid < 4) glds4s(uni_ptr((const char*)(bias + (size_t)u.x0 * 1024 + u.pn * 256 + wid * 64)), (unsigned)lane * 4u, (unsigned)__builtin_amdgcn_readfirstlane((unsigned)(unsigned long long)bl + (unsigned)(((ui & 1) * 256 + wid * 64) * 4))); }
    const float* bias; unsigned char* Y; LAS float* bl; mutable int ucnt;
    __device__ __forceinline__ void operator()(AccRef acc, const Unit& u, int wr, int wc, int fr, int fq) const {
        asm volatile("" : "+v"(fr), "+v"(fq));
        const int c0 = u.pn * 256 + wc * 32 + fq * 8; const LAS float* bp = bl + (ucnt & 1) * 256 + wc * 32 + fq * 8; ++ucnt; constexpr float SC = FP8_SY / (FP8_SA * FP8_SWD);
        f32x4 b[2][2];
#pragma unroll
        for (int bj = 0; bj < 2; ++bj) { b[bj][0] = *(const LAS f32x4*)(bp + bj * 128) * FP8_SY; b[bj][1] = *(const LAS f32x4*)(bp + bj * 128 + 4) * FP8_SY; }
#pragma unroll
        for (int ai = 0; ai < 2; ++ai)
#pragma unroll
            for (int m = 0; m < 4; ++m) {
                unsigned char* rowp = Y + (size_t)(u.x1 + ai * 128 + wr * 64 + m * 16 + fr) * DM + c0;
#pragma unroll
                for (int bj = 0; bj < 2; ++bj) { if (u.x2 == 2 - bj) continue;
                    f32x4 v0 = acc[ai][bj][m][0] * SC + b[bj][0], v1 = acc[ai][bj][m][1] * SC + b[bj][1];
#pragma unroll
                    for (int q = 0; q < 4; ++q) { v0[q] = __builtin_amdgcn_fmed3f(v0[q], -FP8_MAXV, FP8_MAXV); v1[q] = __builtin_amdgcn_fmed3f(v1[q], -FP8_MAXV, FP8_MAXV); }
                    int w0 = __builtin_amdgcn_cvt_pk_fp8_f32(v0[0], v0[1], 0, false); w0 = __builtin_amdgcn_cvt_pk_fp8_f32(v0[2], v0[3], w0, true);
                    int w1 = __builtin_amdgcn_cvt_pk_fp8_f32(v1[0], v1[1], 0, false); w1 = __builtin_amdgcn_cvt_pk_fp8_f32(v1[2], v1[3], w1, true);
                    u32x2 w; w.x = (unsigned)w0; w.y = (unsigned)w1;
                    *(u32x2*)(rowp + bj * 128) = w; }
            }
    }
};

struct EpiINA {
    static constexpr bool PERM = true;
    __device__ __forceinline__ void prep(const Unit&, int, int, int) const {}
    const float* rf; const float* cf; bf16_t* AE; bf16_t* KN; bf16_t* OS;
    __device__ __forceinline__ void operator()(AccRef acc, const Unit& u, int wr, int wc, int fr, int fq) const {
        asm volatile("" : "+v"(fr), "+v"(fq));
        const int b = u.pm >> 4, ch = u.pm & 15, d0 = wc * 32 + fq * 8; const u32x4 zero = {0u, 0u, 0u, 0u};
        if (u.pn < 4) {
            const bool isq = u.pn < 2; const float* fac = isq ? rf : cf; const float fs = isq ? 1.0f : RSQRT_DQK; const int h0 = (u.pn & 1) * 2;
            float sf[2][4][2];
#pragma unroll
            for (int ai = 0; ai < 2; ++ai)
#pragma unroll
                for (int m = 0; m < 4; ++m)
#pragma unroll
                    for (int bj = 0; bj < 2; ++bj) sf[ai][m][bj] = fac[(size_t)(h0 + bj) * NTOK + (size_t)u.pm * 256 + ai * 128 + wr * 64 + m * 16 + fr];
#pragma unroll
            for (int ai = 0; ai < 2; ++ai)
#pragma unroll
                for (int m = 0; m < 4; ++m) {
                    const int t = ai * 128 + wr * 64 + m * 16 + fr; const size_t token = (size_t)u.pm * 256 + t;
#pragma unroll
                    for (int bj = 0; bj < 2; ++bj) { const int hh = h0 + bj; const float s = sf[ai][m][bj] * fs;
                        const f32x4 v0 = acc[ai][bj][m][0] * s, v1 = acc[ai][bj][m][1] * s;
                        const size_t oq = ((size_t)(((b * 4 + hh) * 16 + ch) * 256 + t)) * 512 + 256 + d0, ok = token * 1024 + hh * 256 + d0;
                        bf16_t* dst = isq ? (AE + oq) : (KN + ok);
                        u32x4 w; w.x = cvt_pk_bf16(v0[0], v0[1]); w.y = cvt_pk_bf16(v0[2], v0[3]); w.z = cvt_pk_bf16(v1[0], v1[1]); w.w = cvt_pk_bf16(v1[2], v1[3]);
                        *(u32x4*)dst = w; }
                }
        } else {
#pragma unroll
            for (int ai = 0; ai < 2; ++ai)
#pragma unroll
                for (int m = 0; m < 4; ++m) {
                    const int t = ai * 128 + wr * 64 + m * 16 + fr; const size_t token = (size_t)u.pm * 256 + t;
#pragma unroll
                    for (int bj = 0; bj < 2; ++bj) { f32x4 v0 = acc[ai][bj][m][0], v1 = acc[ai][bj][m][1];
#pragma unroll
                        for (int j = 0; j < 4; ++j) { v0[j] = __builtin_amdgcn_rcpf(1.0f + __builtin_amdgcn_exp2f(-1.4426950408889634f * v0[j])); v1[j] = __builtin_amdgcn_rcpf(1.0f + __builtin_amdgcn_exp2f(-1.4426950408889634f * v1[j])); }
                        u32x4 w; w.x = cvt_pk_bf16(v0[0], v0[1]); w.y = cvt_pk_bf16(v0[2], v0[3]); w.z = cvt_pk_bf16(v1[0], v1[1]); w.w = cvt_pk_bf16(v1[2], v1[3]);
                        *(u32x4*)(OS + token * 1024 + (u.pn - 4) * 256 + bj * 128 + d0) = w; }
                }
        }
    }
};
struct EpiINB {
    static constexpr bool PERM = true;
    __device__ __forceinline__ void prep(const Unit&, int, int, int) const {}
    const float* cf; bf16_t* KT; bf16_t* BE;
    __device__ __forceinline__ void operator()(AccRef acc, const Unit& u, int wr, int wc, int fr, int fq) const {
        asm volatile("" : "+v"(fr), "+v"(fq));
        const int b = u.pn >> 4, ch = u.pn & 15;
        f32x4 cv[2][2][2];
#pragma unroll
        for (int ai = 0; ai < 2; ++ai)
#pragma unroll
            for (int bj = 0; bj < 2; ++bj) { const size_t tok0 = (size_t)u.pn * 256 + bj * 128 + wc * 32 + fq * 8;
                if (u.pm < 2) { const int hh = u.pm * 2 + ai; cv[ai][bj][0] = *(const f32x4*)(cf + (size_t)hh * NTOK + tok0) * RSQRT_DQK; cv[ai][bj][1] = *(const f32x4*)(cf + (size_t)hh * NTOK + tok0 + 4) * RSQRT_DQK; }
                else { cv[ai][bj][0] = (f32x4){1.f, 1.f, 1.f, 1.f}; cv[ai][bj][1] = cv[ai][bj][0]; } }
#pragma unroll
        for (int ai = 0; ai < 2; ++ai)
#pragma unroll
            for (int m = 0; m < 4; ++m) {
                const int R = u.pm * 256 + ai * 128 + wr * 64 + m * 16 + fr;
#pragma unroll
                for (int bj = 0; bj < 2; ++bj) { if (u.x2 == 2 - bj) continue;
                    const f32x4 v0 = acc[ai][bj][m][0] * cv[ai][bj][0], v1 = acc[ai][bj][m][1] * cv[ai][bj][1]; const int s0 = bj * 128 + wc * 32 + fq * 8; const size_t tok0 = (size_t)u.pn * 256 + s0; bf16_t* dst;
                    if (u.pm < 2) dst = KT + (size_t)R * NTOK + tok0;
                    else { const int eg = R - 512, hh = eg >> 8, e = eg & 255; dst = BE + ((size_t)(((b * 4 + hh) * 16 + ch) * 256 + e)) * 384 + s0; }
                    u32x4 w; w.x = cvt_pk_bf16(v0[0], v0[1]); w.y = cvt_pk_bf16(v0[2], v0[3]); w.z = cvt_pk_bf16(v1[0], v1[1]); w.w = cvt_pk_bf16(v1[2], v1[3]);
                    *(u32x4*)dst = w;
                }
            }
    }
};
struct EpiM1 {
    static constexpr bool PERM = true;
    __device__ __forceinline__ void prep(const Unit&, int, int, int) const {}
    bf16_t* UT;
    __device__ __forceinline__ void operator()(AccRef acc, const Unit& u, int wr, int wc, int fr, int fq) const {
        asm volatile("" : "+v"(fr), "+v"(fq));
#pragma unroll
        for (int ai = 0; ai < 2; ++ai)
#pragma unroll
            for (int m = 0; m < 4; ++m) { bf16_t* rowp = UT + ((size_t)u.x0 * 256 + ai * 128 + wr * 64 + m * 16 + fr) * 128 + wc * 32 + fq * 8;
                const f32x4 v0 = acc[ai][0][m][0], v1 = acc[ai][0][m][1];
                u32x4 w; w.x = cvt_pk_bf16(v0[0], v0[1]); w.y = cvt_pk_bf16(v0[2], v0[3]); w.z = cvt_pk_bf16(v1[0], v1[1]); w.w = cvt_pk_bf16(v1[2], v1[3]);
                *(u32x4*)rowp = w; }
    }
};
struct EpiM2A {
    static constexpr bool PERM = true;
    __device__ __forceinline__ void prep(const Unit&, int, int, int) const {}
    bf16_t* AE; const float* nprev; float* den;
    __device__ __forceinline__ void operator()(AccRef acc, const Unit& u, int wr, int wc, int fr, int fq) const {
        asm volatile("" : "+v"(fr), "+v"(fq));
        const int mu = u.x0, dd = wc * 32 + fq * 8;
        const f32x4 n0 = *(const f32x4*)(nprev + (size_t)mu * 128 + dd), n1 = *(const f32x4*)(nprev + (size_t)mu * 128 + dd + 4);
        u32x4 qv8[2][4];
#pragma unroll
        for (int ai = 0; ai < 2; ++ai)
#pragma unroll
            for (int m = 0; m < 4; ++m) qv8[ai][m] = *(const u32x4*)(AE + ((size_t)mu * 256 + ai * 128 + wr * 64 + m * 16 + fr) * 512 + 256 + dd);
#pragma unroll
        for (int ai = 0; ai < 2; ++ai)
#pragma unroll
            for (int m = 0; m < 4; ++m) {
                const int t = ai * 128 + wr * 64 + m * 16 + fr; bf16_t* rowp = AE + ((size_t)mu * 256 + t) * 512;
                const u32x4 qv = qv8[ai][m];
                float part = bflo(qv.x) * n0[0] + bfhi(qv.x) * n0[1] + bflo(qv.y) * n0[2] + bfhi(qv.y) * n0[3] + bflo(qv.z) * n1[0] + bfhi(qv.z) * n1[1] + bflo(qv.w) * n1[2] + bfhi(qv.w) * n1[3];
#pragma unroll
                for (int bj = 0; bj < 2; ++bj) { const int s0 = bj * 128 + wc * 32 + fq * 8; f32x4 v0 = acc[ai][bj][m][0], v1 = acc[ai][bj][m][1];
                    int dts = t - s0; asm volatile("" : "+v"(dts));
#pragma unroll
                    for (int j = 0; j < 4; ++j) { v0[j] = (j <= dts) ? v0[j] : 0.f; v1[j] = (4 + j <= dts) ? v1[j] : 0.f; part += v0[j] + v1[j]; }
                    u32x4 w; w.x = cvt_pk_bf16(v0[0], v0[1]); w.y = cvt_pk_bf16(v0[2], v0[3]); w.z = cvt_pk_bf16(v1[0], v1[1]); w.w = cvt_pk_bf16(v1[2], v1[3]);
                    *(u32x4*)(rowp + s0) = w; }
                part += __shfl_xor(part, 16); part += __shfl_xor(part, 32);
                if (fq == 0) atomicAdd(den + (size_t)mu * 256 + (wr * 64 + fr) + (ai * 128 + m * 16), part);
            }
    }
};
struct EpiM2B {
    static constexpr bool PERM = true;
    __device__ __forceinline__ void prep(const Unit&, int, int, int) const {}
    const float* den; const float* normg; const bf16_t* OS; bf16_t* HN; LAS float* lnx;
    __device__ __forceinline__ void operator()(AccRef acc, const Unit& u, int wr, int wc, int fr, int fq) const {
        asm volatile("" : "+v"(fr), "+v"(fq));
        const int mu = u.x0, b = mu >> 6, hh = (mu >> 4) & 3, ch = mu & 15;
        float dnv[2][4];
#pragma unroll
        for (int ai = 0; ai < 2; ++ai)
#pragma unroll
            for (int m = 0; m < 4; ++m) dnv[ai][m] = den[(size_t)mu * 256 + ai * 128 + wr * 64 + m * 16 + fr];
#pragma unroll
        for (int ai = 0; ai < 2; ++ai)
#pragma unroll
            for (int m = 0; m < 4; ++m) {
                const int t = ai * 128 + wr * 64 + m * 16 + fr; const float dn = dnv[ai][m];
#ifdef DBG_DEN1
                const float inv = 1.0f;
#else
                const float inv = 1.0f / fmaxf(fabsf(dn), 1.0f);
#endif
                float s1 = 0.f, s2 = 0.f;
#pragma unroll
                for (int bj = 0; bj < 2; ++bj)
#pragma unroll
                    for (int n = 0; n < 2; ++n) { f32x4 h = acc[ai][bj][m][n] * inv; acc[ai][bj][m][n] = h; s1 += (h[0] + h[1]) + (h[2] + h[3]); s2 += (h[0] * h[0] + h[1] * h[1]) + (h[2] * h[2] + h[3] * h[3]); }
                s1 += __shfl_xor(s1, 16); s1 += __shfl_xor(s1, 32); s2 += __shfl_xor(s2, 16); s2 += __shfl_xor(s2, 32);
                if (fq == 0) { lnx[(t * 4 + wc) * 2] = s1; lnx[(t * 4 + wc) * 2 + 1] = s2; }
            }
        const int e0 = wc * 32 + fq * 8;
        f32x4 gg[2][2];
#pragma unroll
        for (int bj = 0; bj < 2; ++bj) { gg[bj][0] = *(const f32x4*)(normg + hh * 256 + bj * 128 + e0); gg[bj][1] = *(const f32x4*)(normg + hh * 256 + bj * 128 + e0 + 4); }
        asm volatile("s_waitcnt lgkmcnt(0)" ::: "memory"); __builtin_amdgcn_s_barrier(); asm volatile("" ::: "memory");
#pragma unroll
        for (int ai = 0; ai < 2; ++ai) {
            u32x4 ovv[4][2];
#pragma unroll
            for (int m = 0; m < 4; ++m)
#pragma unroll
                for (int bj = 0; bj < 2; ++bj) ovv[m][bj] = *(const u32x4*)(OS + (((size_t)(b * 16 + ch)) * 256 + ai * 128 + wr * 64 + m * 16 + fr) * 1024 + hh * 256 + bj * 128 + e0);
#pragma unroll
            for (int m = 0; m < 4; ++m) {
                const int t = ai * 128 + wr * 64 + m * 16 + fr; const size_t token = ((size_t)(b * 16 + ch)) * 256 + t;
                const LAS f32x4* lp = (const LAS f32x4*)(lnx + t * 8); const f32x4 a = lp[0], c = lp[1];
                const float mean = (a[0] + a[2] + c[0] + c[2]) * (1.0f / 256.0f); const float ex2 = (a[1] + a[3] + c[1] + c[3]) * (1.0f / 256.0f);
                const float rstd = 1.0f / sqrtf(fmaxf(ex2 - mean * mean, 0.f) + LN_EPS);
#pragma unroll
                for (int bj = 0; bj < 2; ++bj) { const int e = bj * 128 + e0; const size_t off = token * 1024 + hh * 256 + e; const u32x4 ov = ovv[m][bj];
#ifdef DBG_HN_OS
                    f32x4 v0 = {1.f, 1.f, 1.f, 1.f}, v1 = v0;
#elif defined(DBG_HN_RAW)
                    f32x4 v0 = acc[ai][bj][m][0], v1 = acc[ai][bj][m][1];
#else
                    f32x4 v0 = (acc[ai][bj][m][0] - mean) * rstd * gg[bj][0], v1 = (acc[ai][bj][m][1] - mean) * rstd * gg[bj][1];
#endif
#ifndef DBG_HN_ONE
                    v0[0] *= bflo(ov.x); v0[1] *= bfhi(ov.x); v0[2] *= bflo(ov.y); v0[3] *= bfhi(ov.y); v1[0] *= bflo(ov.z); v1[1] *= bfhi(ov.z); v1[2] *= bflo(ov.w); v1[3] *= bfhi(ov.w);
#endif
                    u32x4 w; w.x = cvt_pk_bf16(v0[0], v0[1]); w.y = cvt_pk_bf16(v0[2], v0[3]); w.z = cvt_pk_bf16(v1[0], v1[1]); w.w = cvt_pk_bf16(v1[2], v1[3]);
                    *(u32x4*)(HN + off) = w; }
            }
            asm volatile("" ::: "memory");
        }
        asm volatile("s_waitcnt lgkmcnt(0)" ::: "memory"); __builtin_amdgcn_s_barrier(); asm volatile("" ::: "memory");
    }
};
struct Frame {
    LAS unsigned char* lds;
    unsigned* ctl;
    unsigned char* ws;
    int tid, lane, wave, vcu, G;
};
__device__ __forceinline__ float wave_sum(float v) {
#pragma unroll
    for (int o = 1; o < 64; o <<= 1) v += __shfl_xor(v, o);
    return v;
}

__device__ __forceinline__ void tr_block(const float* src, size_t pitch, bf16_t* dst, size_t kd, int kb, int nb, LAS unsigned* scr, int lane) {
    const float* s0 = src + (size_t)(64 * kb) * pitch + 64 * nb + 4 * (lane & 15);
#pragma unroll
    for (int i = 0; i < 8; ++i) {
        const int kp = 4 * i + (lane >> 4);
        const f32x4 a = __builtin_nontemporal_load((const f32x4*)(s0 + (size_t)(2 * kp) * pitch)), b = __builtin_nontemporal_load((const f32x4*)(s0 + (size_t)(2 * kp + 1) * pitch));
#pragma unroll
        for (int j = 0; j < 4; ++j) scr[(4 * (lane & 15) + j) * 33 + kp] = cvt_pk_bf16(a[j], b[j]);
    }
    LDS_WAIT(); asm volatile("" ::: "memory");
    u32x4 o[8];
#pragma unroll
    for (int c = 0; c < 8; ++c) { const int rr = 8 * c + (lane >> 3), q4 = 4 * (lane & 7); o[c].x = scr[rr * 33 + q4]; o[c].y = scr[rr * 33 + q4 + 1]; o[c].z = scr[rr * 33 + q4 + 2]; o[c].w = scr[rr * 33 + q4 + 3]; }
    bf16_t* d = dst + (size_t)(64 * nb + (lane >> 3)) * kd + 64 * kb + 8 * (lane & 7);
#pragma unroll
    for (int c = 0; c < 8; ++c) *(u32x4*)(d + (size_t)(8 * c) * kd) = o[c];
    LDS_WAIT(); asm volatile("" ::: "memory");
}
__device__ __forceinline__ void tr_block8(const float* src, size_t pitch, unsigned char* dst, size_t kd, int kb, int nb, float scale, LAS unsigned* scr, int lane) {
    const float* s0 = src + (size_t)(128 * kb) * pitch + 64 * nb + 4 * (lane & 15);
#pragma unroll
    for (int i = 0; i < 8; ++i) {
        const int kq = 4 * i + (lane >> 4);
        const f32x4 r0 = __builtin_nontemporal_load((const f32x4*)(s0 + (size_t)(4 * kq) * pitch)) * scale, r1 = __builtin_nontemporal_load((const f32x4*)(s0 + (size_t)(4 * kq + 1) * pitch)) * scale,
                    r2 = __builtin_nontemporal_load((const f32x4*)(s0 + (size_t)(4 * kq + 2) * pitch)) * scale, r3 = __builtin_nontemporal_load((const f32x4*)(s0 + (size_t)(4 * kq + 3) * pitch)) * scale;
#pragma unroll
        for (int j = 0; j < 4; ++j) { int w = __builtin_amdgcn_cvt_pk_fp8_f32(r0[j], r1[j], 0, false); w = __builtin_amdgcn_cvt_pk_fp8_f32(r2[j], r3[j], w, true); scr[(4 * (lane & 15) + j) * 33 + kq] = (unsigned)w; }
    }
    LDS_WAIT(); asm volatile("" ::: "memory");
    u32x4 o[8];
#pragma unroll
    for (int c = 0; c < 8; ++c) { const int rr = 8 * c + (lane >> 3), q4 = 4 * (lane & 7); o[c].x = scr[rr * 33 + q4]; o[c].y = scr[rr * 33 + q4 + 1]; o[c].z = scr[rr * 33 + q4 + 2]; o[c].w = scr[rr * 33 + q4 + 3]; }
    unsigned char* d = dst + (size_t)(64 * nb + (lane >> 3)) * kd + 128 * kb + 16 * (lane & 7);
#pragma unroll
    for (int c = 0; c < 8; ++c) *(u32x4*)(d + (size_t)(8 * c) * kd) = o[c];
    LDS_WAIT(); asm volatile("" ::: "memory");
}
constexpr int CONV_ITEMS = 24576;
struct ConvItem { const float* s0; size_t pitch; unsigned char* d; float scale; };
__device__ __forceinline__ ConvItem conv_desc(const float* wgu, const float* wd, unsigned char* ws, int v, int lane) {
    const int layer = v >= 12288; int r = v - layer * 12288; ConvItem it;
    if (r < 8192) { const int mat = layer * 32 + (r >> 8); r &= 255; const int kb = r >> 5, nb = r & 31; it.pitch = 2048; it.scale = FP8_SWGU;
        it.s0 = wgu + (size_t)mat * 1024 * 2048 + (size_t)(128 * kb) * 2048 + 64 * nb + 4 * (lane & 15); it.d = ws + WS_WGU + (size_t)mat * 2048 * 1024 + (size_t)(64 * nb + (lane >> 3)) * 1024 + 128 * kb + 16 * (lane & 7); }
    else { r -= 8192; const int mat = layer * 32 + (r >> 7); r &= 127; const int kb = r >> 4, nb = r & 15; it.pitch = 1024; it.scale = FP8_SWD;
        it.s0 = wd + (size_t)mat * 1024 * 1024 + (size_t)(128 * kb) * 1024 + 64 * nb + 4 * (lane & 15); it.d = ws + WS_WD + (size_t)mat * 1024 * 1024 + (size_t)(64 * nb + (lane >> 3)) * 1024 + 128 * kb + 16 * (lane & 7); }
    return it;
}
__device__ __forceinline__ void conv_items(Frame& F, const float* wgu, const float* wd, int v_lo, int v_hi, int cw, int ncw) {
    LAS unsigned* scr = (LAS unsigned*)(F.lds + RING_OFF + F.wave * 8448); unsigned char* ws = F.ws; const int lane = F.lane;
    int v = v_lo + cw; if (v >= v_hi) return;
    ConvItem cur = conv_desc(wgu, wd, ws, v, lane);
    f32x4 r[8][4];
#pragma unroll
    for (int i = 0; i < 8; ++i) { const int kq = 4 * i + (lane >> 4);
#pragma unroll
        for (int q = 0; q < 4; ++q) r[i][q] = __builtin_nontemporal_load((const f32x4*)(cur.s0 + (size_t)(4 * kq + q) * cur.pitch)); }
    for (;;) {
        const int vn = v + ncw; const bool has = vn < v_hi; ConvItem nx = cur; if (has) nx = conv_desc(wgu, wd, ws, vn, lane);
#pragma unroll
        for (int i = 0; i < 8; ++i) { const int kq = 4 * i + (lane >> 4);
#pragma unroll
            for (int j = 0; j < 4; ++j) { int w = __builtin_amdgcn_cvt_pk_fp8_f32(r[i][0][j] * cur.scale, r[i][1][j] * cur.scale, 0, false); w = __builtin_amdgcn_cvt_pk_fp8_f32(r[i][2][j] * cur.scale, r[i][3][j] * cur.scale, w, true); scr[(4 * (lane & 15) + j) * 33 + kq] = (unsigned)w; }
            if (has) {
#pragma unroll
                for (int q = 0; q < 4; ++q) r[i][q] = __builtin_nontemporal_load((const f32x4*)(nx.s0 + (size_t)(4 * kq + q) * nx.pitch)); } }
        LDS_WAIT(); asm volatile("" ::: "memory");
        u32x4 o[8];
#pragma unroll
        for (int c = 0; c < 8; ++c) { const int rr = 8 * c + (lane >> 3), q4 = 4 * (lane & 7); o[c].x = scr[rr * 33 + q4]; o[c].y = scr[rr * 33 + q4 + 1]; o[c].z = scr[rr * 33 + q4 + 2]; o[c].w = scr[rr * 33 + q4 + 3]; }
#pragma unroll
        for (int c = 0; c < 8; ++c) *(u32x4*)(cur.d + (size_t)(8 * c) * 1024) = o[c];
        LDS_WAIT(); asm volatile("" ::: "memory");
        if (!has) break;
        v = vn; cur = nx;
    }
}
struct P0In { const float *x, *wqkv, *wo, *win, *wout, *rw, *wgu, *wd; const int* pos; };
__device__ __forceinline__ void p0_prologue(Frame& F, const P0In& I) {
    LAS unsigned* scr = (LAS unsigned*)(F.lds + RING_OFF + F.wave * 8448);
    const int gw = F.vcu * NWAVES + F.wave, NGW = F.G * NWAVES;
    unsigned char* ws = F.ws;
    constexpr int KB = 16;
    constexpr int I_QKV = KB * 48, I_WO = KB * 16, I_INA1 = KB * 16, I_INA2 = KB * 16, I_INB = KB * 24, I_WOUT = KB * 16;
    constexpr int I_SMALL = I_QKV + I_WO + I_INA1 + I_INA2 + I_INB + I_WOUT;
    constexpr int NITEMS = I_SMALL;
    for (int it = gw; it < NITEMS; it += NGW) {
        int r = it; const float* src; size_t pitch; bf16_t* dst; int nbl;
        if (r < I_QKV) { src = I.wqkv; pitch = 3072; dst = (bf16_t*)(ws + WS_WQKV); nbl = 48; }
        else if ((r -= I_QKV) < I_WO) { src = I.wo; pitch = 1024; dst = (bf16_t*)(ws + WS_WO); nbl = 16; }
        else if ((r -= I_WO) < I_INA1) { src = I.win; pitch = 3080; dst = (bf16_t*)(ws + WS_WINA); nbl = 16; }
        else if ((r -= I_INA1) < I_INA2) { src = I.win + 2048; pitch = 3080; dst = (bf16_t*)(ws + WS_WINA) + (size_t)1024 * 1024; nbl = 16; }
        else if ((r -= I_INA2) < I_INB) { src = I.win + 512; pitch = 3080; dst = (bf16_t*)(ws + WS_WINB); nbl = 24; }
        else { r -= I_INB; src = I.wout; pitch = 1024; dst = (bf16_t*)(ws + WS_WOUT); nbl = 16; }
        tr_block(src, pitch, dst, 1024, r / nbl, r % nbl, scr, F.lane);
    }
    if (NCONV == 0) conv_items(F, I.wgu, I.wd, 0, CONV_ITEMS, gw, NGW);
    const int gt = F.vcu * NTHR + F.tid, NGT = F.G * NTHR;
    for (int i = gt; i < NTOK * DM / 8; i += NGT) { const f32x4 a = ((const f32x4*)I.x)[2 * i], b = ((const f32x4*)I.x)[2 * i + 1];
        u32x4 w; w.x = cvt_pk_bf16(a[0], a[1]); w.y = cvt_pk_bf16(a[2], a[3]); w.z = cvt_pk_bf16(b[0], b[1]); w.w = cvt_pk_bf16(b[2], b[3]); ((u32x4*)(ws + WS_XB))[i] = w; }
    for (int i = gt; i < NTOK * 8; i += NGT) { const int tok = i >> 3, f = i & 7; const float inv = powf(500000.0f, -(float)f * 0.125f); const float ang = (float)I.pos[tok] * inv;
        float sn, cs; sincosf(ang, &sn, &cs); float* rp = (float*)(ws + WS_ROPE) + (size_t)tok * 16; rp[f] = cs; rp[8 + f] = sn; }
    for (int i = gt; i < 2 * 32 * 1024; i += NGT) { const int l = i >> 15, e = (i >> 10) & 31, k = i & 1023; ((float*)(ws + WS_RWT))[i] = I.rw[((size_t)l * 1024 + k) * 32 + e]; }
    for (int i = gt; i < 8 * 1024; i += NGT) { const int gidx = i >> 10, k = i & 1023; ((float*)(ws + WS_WG))[i] = I.win[(size_t)k * 3080 + 3072 + gidx]; }
}

__device__ __forceinline__ void phase_ln_router(Frame& F, const bf16_t* __restrict__ z, bf16_t* __restrict__ x1, const float* lng, const float* lnb, const float* rbias, int layer, int cset) {
    unsigned char* ws = F.ws;
    LAS f32x4* rwv = (LAS f32x4*)(F.lds + RING_OFF);
    LAS int* lcnt = (LAS int*)(F.lds + LX_LCNT); LAS int* gbase = (LAS int*)(F.lds + LX_GBASE); LAS int* rec = (LAS int*)(F.lds + LX_REC);
    LAS float* lgb = (LAS float*)(F.lds + LX_LNX);
    { const f32x4* src = (const f32x4*)((const float*)(ws + WS_RWT) + (size_t)layer * 32768);
      for (int i = F.tid; i < 8192; i += NTHR) { const int e = i >> 8, c = i & 255; rwv[e * 256 + (c ^ (e & 15))] = src[i]; } }
    int* toke = (int*)(ws + WS_TOKE); int* tokp = (int*)(ws + WS_TOKP); float* tokg = (float*)(ws + WS_TOKG);
    unsigned short* rowtok = (unsigned short*)(ws + WS_ROWTOK); unsigned char* xb8 = (unsigned char*)(ws + WS_XB);
    unsigned* cntg = F.ctl + CW_CNT + cset * 2048;
    const int lane = F.lane;
    for (int grp = F.vcu; grp < NTOK / 64; grp += F.G) {
        if (F.tid < 32) lcnt[F.tid] = 0;
        for (int i = F.tid; i < 1024; i += NTHR) { lgb[i] = lng[i]; lgb[1024 + i] = lnb[i]; }
        __syncthreads();
#pragma unroll 2
        for (int tk = 0; tk < 8; tk += 2) {
            const int token0 = grp * 64 + F.wave * 8 + tk;
            f32x4 v[2][4]; float s[2] = {0.f, 0.f};
#pragma unroll
            for (int u = 0; u < 2; ++u)
#pragma unroll
                for (int j = 0; j < 4; ++j) { const u32x2 zz = *(const u32x2*)(z + (size_t)(token0 + u) * DM + 4 * lane + 256 * j); v[u][j] = (f32x4){bflo(zz.x), bfhi(zz.x), bflo(zz.y), bfhi(zz.y)}; s[u] += (v[u][j][0] + v[u][j][1]) + (v[u][j][2] + v[u][j][3]); }
#pragma unroll
            for (int o = 1; o < 64; o <<= 1) { const float a0 = __shfl_xor(s[0], o), a1 = __shfl_xor(s[1], o); s[0] += a0; s[1] += a1; }
            float s2[2] = {0.f, 0.f};
#pragma unroll
            for (int u = 0; u < 2; ++u) { const float mean = s[u] * (1.0f / DM);
#pragma unroll
                for (int j = 0; j < 4; ++j) { v[u][j] = v[u][j] - mean; s2[u] += (v[u][j][0] * v[u][j][0] + v[u][j][1] * v[u][j][1]) + (v[u][j][2] * v[u][j][2] + v[u][j][3] * v[u][j][3]); } }
#pragma unroll
            for (int o = 1; o < 64; o <<= 1) { const float a0 = __shfl_xor(s2[0], o), a1 = __shfl_xor(s2[1], o); s2[0] += a0; s2[1] += a1; }
#pragma unroll
            for (int u = 0; u < 2; ++u) { const float rstd = 1.0f / sqrtf(s2[u] * (1.0f / DM) + LN_EPS); const int token = token0 + u;
#pragma unroll
                for (int j = 0; j < 4; ++j) { const f32x4 gvj = *(const LAS f32x4*)(lgb + 4 * lane + 256 * j), bvj = *(const LAS f32x4*)(lgb + 1024 + 4 * lane + 256 * j);
                    const f32x4 y = v[u][j] * rstd * gvj + bvj; { u32x2 wb; wb.x = cvt_pk_bf16(y[0], y[1]); wb.y = cvt_pk_bf16(y[2], y[3]); *(u32x2*)(x1 + (size_t)token * DM + 4 * lane + 256 * j) = wb; }
                    int w8 = __builtin_amdgcn_cvt_pk_fp8_f32(y[0] * FP8_SA, y[1] * FP8_SA, 0, false); w8 = __builtin_amdgcn_cvt_pk_fp8_f32(y[2] * FP8_SA, y[3] * FP8_SA, w8, true);
                    *(int*)(xb8 + (size_t)token * DM + 4 * lane + 256 * j) = w8; } }
        }
        VM_WAIT(); __syncthreads();
        const int tg = F.wave & 3, kh = F.wave >> 2, e0 = lane & 15, kq = lane >> 4;
        f32x4 acc0 = {0.f, 0.f, 0.f, 0.f}, acc1 = acc0;
        { const bf16_t* arow = x1 + (size_t)(grp * 64 + tg * 16 + e0) * DM + kh * 512 + 4 * kq;
#pragma unroll 4
          for (int blk = 0; blk < 32; ++blk) {
              const u32x2 ab = *(const u32x2*)(arow + blk * 16); const f32x4 a4 = {bflo(ab.x), bfhi(ab.x), bflo(ab.y), bfhi(ab.y)}; const int c = ((kh * 512 + blk * 16) >> 2) + kq;
              const f32x4 b0 = rwv[e0 * 256 + (c ^ e0)], b1 = rwv[(16 + e0) * 256 + (c ^ e0)];
#pragma unroll
              for (int j = 0; j < 4; ++j) { acc0 = __builtin_amdgcn_mfma_f32_16x16x4f32(a4[j], b0[j], acc0, 0, 0, 0); acc1 = __builtin_amdgcn_mfma_f32_16x16x4f32(a4[j], b1[j], acc1, 0, 0, 0); } } }
        __syncthreads();
        if (kh == 1) { ((LAS f32x4*)lgb)[(tg * 2 + 0) * 64 + lane] = acc0; ((LAS f32x4*)lgb)[(tg * 2 + 1) * 64 + lane] = acc1; }
        __syncthreads();
        if (kh == 0) {
            acc0 = acc0 + ((LAS f32x4*)lgb)[(tg * 2 + 0) * 64 + lane]; acc1 = acc1 + ((LAS f32x4*)lgb)[(tg * 2 + 1) * 64 + lane];
            const float rb0 = rbias[e0], rb1 = rbias[16 + e0];
#pragma unroll
            for (int r = 0; r < 4; ++r) {
                float l0 = acc0[r] + rb0, l1 = acc1[r] + rb1; float tv[4]; int te[4];
#pragma unroll
                for (int k = 0; k < 4; ++k) { float bvv = (l1 > l0) ? l1 : l0; int be = (l1 > l0) ? 16 + e0 : e0;
#pragma unroll
                    for (int o = 1; o < 16; o <<= 1) { const float ov = __shfl_xor(bvv, o); const int oe = __shfl_xor(be, o); const bool take = (ov > bvv) || (ov == bvv && oe < be); bvv = take ? ov : bvv; be = take ? oe : be; }
                    tv[k] = bvv; te[k] = be; if (be == e0) l0 = -INFINITY; if (be == 16 + e0) l1 = -INFINITY; }
                const float w0 = 1.0f, w1 = __expf(tv[1] - tv[0]), w2 = __expf(tv[2] - tv[0]), w3 = __expf(tv[3] - tv[0]); const float wi = 1.0f / (w0 + w1 + w2 + w3);
                if (e0 < 4) {
                    const int tl = tg * 16 + 4 * kq + r, token = grp * 64 + tl;
                    const int ek = (e0 == 0) ? te[0] : (e0 == 1) ? te[1] : (e0 == 2) ? te[2] : te[3];
                    const float wk = (e0 == 0) ? w0 : (e0 == 1) ? w1 : (e0 == 2) ? w2 : w3;
                    const int li = atomicAdd((int*)(lcnt + ek), 1); rec[tl * 8 + e0] = ek; rec[tl * 8 + 4 + e0] = li;
                    toke[token * 4 + e0] = ek; tokg[token * 4 + e0] = wk * wi;
                }
            }
        }
        __syncthreads();
        if (F.tid < 32) gbase[F.tid] = (int)__hip_atomic_fetch_add(cntg + F.tid * 64, (unsigned)lcnt[F.tid], RLX_AGENT);
        __syncthreads();
        if (F.tid < 256) { const int tl = F.tid >> 2, k = F.tid & 3; const int token = grp * 64 + tl; const int e = rec[tl * 8 + k]; const int pos = gbase[e] + rec[tl * 8 + 4 + k];
            tokp[token * 4 + k] = pos; rowtok[(size_t)e * NTOK + pos] = (unsigned short)token; }
        __syncthreads();
    }
}

__device__ __forceinline__ int moe_tables(Frame& F, int layer) {
    LAS int* tile_e = (LAS int*)(F.lds + LX_TILEE); LAS int* tbase = (LAS int*)(F.lds + LX_TBASE);
    if (F.tid < 64) {
        const int e = F.lane & 31; const int c = (int)__hip_atomic_load(F.ctl + CW_CNT + layer * 2048 + e * 64, RLX_AGENT); const int nt = (F.lane < 32) ? ((c + 255) >> 8) : 0;
        int inc = nt;
#pragma unroll
        for (int o = 1; o < 32; o <<= 1) { const int up = __shfl_up(inc, o); if (F.lane >= o) inc += up; }
        const int t0 = inc - nt;
        if (F.lane < 32) { tbase[e] = t0; for (int i = 0; i < nt; ++i) tile_e[t0 + i] = e; }
        if (F.lane == 31) tbase[32] = inc;
    }
    __syncthreads();
    return tbase[32];
}

template <bool NEXT_MLSTM>
__device__ __forceinline__ void phase_combine(Frame& F, const bf16_t* __restrict__ x1, float* __restrict__ out, const float* lng, const float* lnb, const float* bgates, int layer) {
    unsigned char* ws = F.ws;
    (void)moe_tables(F, layer);
    const LAS int* tbase = (const LAS int*)(F.lds + LX_TBASE);
    const int* toke = (const int*)(ws + WS_TOKE); const int* tokp = (const int*)(ws + WS_TOKP); const float* tokg = (const float*)(ws + WS_TOKG);
    const unsigned char* Y = (const unsigned char*)(ws + WS_Y); bf16_t* xb = (bf16_t*)(ws + WS_XB);
    LAS float* wg = (LAS float*)(F.lds + RING_OFF);
    LAS float* lgb = wg + 8192;
    if constexpr (NEXT_MLSTM) { const f32x4* src = (const f32x4*)(ws + WS_WG); for (int i = F.tid; i < 2048; i += NTHR) ((LAS f32x4*)wg)[i] = src[i];
        for (int i = F.tid; i < 1024; i += NTHR) { lgb[i] = lng[i]; lgb[1024 + i] = lnb[i]; } __syncthreads(); }
    const int lane = F.lane; const int gw = F.vcu * NWAVES + F.wave, NGW = F.G * NWAVES;
    f32x4 gv[4], bv[4];
    if constexpr (!NEXT_MLSTM) {
#pragma unroll
        for (int j = 0; j < 4; ++j) { gv[j] = *(const f32x4*)(lng + 4 * lane + 256 * j); bv[j] = *(const f32x4*)(lnb + 4 * lane + 256 * j); } }
    constexpr int NTK = NEXT_MLSTM ? 1 : 2;
    int rowv = 0; float gatev = 0.f;
    { const int mt = gw + (lane >> 2) * NGW; if (mt < NTOK) { const int ee = toke[mt * 4 + (lane & 3)]; rowv = tbase[ee] * 256 + tokp[mt * 4 + (lane & 3)]; gatev = tokg[mt * 4 + (lane & 3)] * (DBG_MOE_MUL / FP8_SY); } }
    int it = 0;
    for (int token0 = gw; token0 < NTOK; token0 += NTK * NGW, ++it) {
        f32x4 vv[NTK][4];
#pragma unroll
        for (int u = 0; u < NTK; ++u) { const int token = token0 + u * NGW; if (token < NTOK) {
#pragma unroll
            for (int j = 0; j < 4; ++j) { const u32x2 xx = *(const u32x2*)(x1 + (size_t)token * DM + 4 * lane + 256 * j); vv[u][j] = (f32x4){bflo(xx.x), bfhi(xx.x), bflo(xx.y), bfhi(xx.y)} * ALPHA; }
#pragma unroll
            for (int k = 0; k < 4; ++k) { const int sl = (it * NTK + u) * 4 + k; const size_t row = (size_t)__builtin_amdgcn_readlane(rowv, sl); const float gt = __int_as_float(__builtin_amdgcn_readlane(__float_as_int(gatev), sl));
#pragma unroll
                for (int j = 0; j < 4; ++j) { const int y = *(const int*)(Y + row * DM + 4 * lane + 256 * j); const f32x2 lo = __builtin_amdgcn_cvt_pk_f32_fp8(y, false), hi = __builtin_amdgcn_cvt_pk_f32_fp8(y, true);
                    vv[u][j][0] += gt * lo[0]; vv[u][j][1] += gt * lo[1]; vv[u][j][2] += gt * hi[0]; vv[u][j][3] += gt * hi[1]; } } } }
#pragma unroll
        for (int u = 0; u < NTK; ++u) { const int token = token0 + u * NGW; if (token < NTOK) {
        f32x4 v[4];
#pragma unroll
        for (int j = 0; j < 4; ++j) v[j] = vv[u][j];
        float s = 0.f;
#pragma unroll
        for (int j = 0; j < 4; ++j) s += (v[j][0] + v[j][1]) + (v[j][2] + v[j][3]);
        const float mean = wave_sum(s) * (1.0f / DM); float s2 = 0.f;
#pragma unroll
        for (int j = 0; j < 4; ++j) { v[j] = v[j] - mean; s2 += (v[j][0] * v[j][0] + v[j][1] * v[j][1]) + (v[j][2] * v[j][2] + v[j][3] * v[j][3]); }
        const float rstd = 1.0f / sqrtf(wave_sum(s2) * (1.0f / DM) + LN_EPS);
#pragma unroll
        for (int j = 0; j < 4; ++j) { if constexpr (NEXT_MLSTM) { gv[j] = *(const LAS f32x4*)(lgb + 4 * lane + 256 * j); bv[j] = *(const LAS f32x4*)(lgb + 1024 + 4 * lane + 256 * j); }
            v[j] = v[j] * rstd * gv[j] + bv[j]; if constexpr (!NEXT_MLSTM) *(f32x4*)(out + (size_t)token * DM + 4 * lane + 256 * j) = v[j]; }
        if constexpr (NEXT_MLSTM) {
#pragma unroll
            for (int j = 0; j < 4; ++j) { u32x2 w; w.x = cvt_pk_bf16(v[j][0], v[j][1]); w.y = cvt_pk_bf16(v[j][2], v[j][3]); *(u32x2*)(xb + (size_t)token * DM + 4 * lane + 256 * j) = w; }
            float gp[8];
#pragma unroll
            for (int gi = 0; gi < 8; ++gi) { float a = 0.f;
#pragma unroll
                for (int j = 0; j < 4; ++j) { const f32x4 w = *(const LAS f32x4*)(wg + gi * 1024 + 4 * lane + 256 * j); a += (v[j][0] * w[0] + v[j][1] * w[1]) + (v[j][2] * w[2] + v[j][3] * w[3]); }
                gp[gi] = a; }
#pragma unroll
            for (int o = 1; o < 64; o <<= 1) {
#pragma unroll
                for (int gi = 0; gi < 8; ++gi) gp[gi] += __shfl_xor(gp[gi], o); }
#pragma unroll
            for (int gi = 0; gi < 8; ++gi) gp[gi] += bgates[gi];
            if (lane == 0) {
#pragma unroll
                for (int hh = 0; hh < 4; ++hh) { ((float*)(ws + WS_GI))[(size_t)hh * NTOK + token] = gp[hh];
                    const float f = gp[4 + hh]; const float lf = (f >= 0.f) ? -log1pf(__expf(-f)) : (f - log1pf(__expf(f)));
                    ((float*)(ws + WS_LF))[(size_t)hh * NTOK + token] = lf; } }
        }
        } }
    }
}

__device__ __forceinline__ void phase_gate_scan(Frame& F) {
    unsigned char* ws = F.ws; const int lane = F.lane; const int gw = F.vcu * NWAVES + F.wave, NGW = F.G * NWAVES;
    for (int mu = gw; mu < 256; mu += NGW) {
        const int b = mu >> 6, hh = (mu >> 4) & 3, ch = mu & 15; const size_t base = (size_t)hh * NTOK + (size_t)b * SEQ + ch * 256 + 4 * lane;
        const f32x4 lf = *(const f32x4*)((const float*)(ws + WS_LF) + base), gi = *(const f32x4*)((const float*)(ws + WS_GI) + base);
        f32x4 c; c[0] = lf[0]; c[1] = c[0] + lf[1]; c[2] = c[1] + lf[2]; c[3] = c[2] + lf[3];
        float tot = c[3];
#pragma unroll
        for (int o = 1; o < 64; o <<= 1) { const float up = __shfl_up(tot, o); if (lane >= o) tot += up; }
        const float excl = tot - c[3];
        f32x4 rf, cf;
#pragma unroll
        for (int j = 0; j < 4; ++j) { const float bt = excl + c[j]; rf[j] = __expf(bt); cf[j] = __expf(gi[j] - bt); }
        *(f32x4*)((float*)(ws + WS_RF) + base) = rf; *(f32x4*)((float*)(ws + WS_CF) + base) = cf;
        if (lane == 63) ((float*)(ws + WS_DEC))[mu] = __expf(tot);
    }
}
__device__ __forceinline__ void phase_nu(Frame& F) {
    unsigned char* ws = F.ws; const int lane = F.lane; const int gw = F.vcu * NWAVES + F.wave, NGW = F.G * NWAVES;
    const bf16_t* KT = (const bf16_t*)(ws + WS_KT); float* NU = (float*)(ws + WS_NU);
    for (int r0 = gw * 16; r0 < 256 * 128; r0 += NGW * 16) {
        const int mu = r0 >> 7, d0 = r0 & 127, b = mu >> 6, hh = (mu >> 4) & 3, ch = mu & 15;
        const bf16_t* base = KT + (size_t)(hh * 128 + d0) * NTOK + (size_t)b * SEQ + ch * 256 + 4 * lane;
        u32x2 kv[16];
#pragma unroll
        for (int i = 0; i < 16; ++i) kv[i] = *(const u32x2*)(base + (size_t)i * NTOK);
        float s[16];
#pragma unroll
        for (int i = 0; i < 16; ++i) s[i] = (bflo(kv[i].x) + bfhi(kv[i].x)) + (bflo(kv[i].y) + bfhi(kv[i].y));
#pragma unroll
        for (int o = 1; o < 64; o <<= 1) {
#pragma unroll
            for (int i = 0; i < 16; ++i) s[i] += __shfl_xor(s[i], o); }
        float mine = s[0];
#pragma unroll
        for (int i = 1; i < 16; ++i) mine = (lane == i) ? s[i] : mine;
        if (lane < 16) NU[r0 + lane] = mine;
    }
}
__device__ __forceinline__ void phase_state_scan(Frame& F) {
    unsigned char* ws = F.ws; const int gt = F.vcu * NTHR + F.tid, NGT = F.G * NTHR;
    const bf16_t* UT = (const bf16_t*)(ws + WS_UT); const float* DEC = (const float*)(ws + WS_DEC); bf16_t* BE = (bf16_t*)(ws + WS_BE);
    for (int i = gt; i < 16 * 256 * 32; i += NGT) { const int bh = i >> 13, e = (i >> 5) & 255, dg = i & 31;
        f32x4 U[16]; float dc[16];
#pragma unroll
        for (int ch = 0; ch < 16; ++ch) { const size_t mu = (size_t)bh * 16 + ch; { const u32x2 uu = *(const u32x2*)(UT + (mu * 256 + e) * 128 + 4 * dg); U[ch] = (f32x4){bflo(uu.x), bfhi(uu.x), bflo(uu.y), bfhi(uu.y)}; } dc[ch] = DEC[mu]; }
        f32x4 C = {0.f, 0.f, 0.f, 0.f};
#pragma unroll
        for (int ch = 0; ch < 16; ++ch) { const size_t mu = (size_t)bh * 16 + ch;
            u32x2 w; w.x = cvt_pk_bf16(C[0], C[1]); w.y = cvt_pk_bf16(C[2], C[3]);
#ifdef DBG_NO_INTER
            w.x = 0u; w.y = 0u;
#endif
            *(u32x2*)(BE + (mu * 256 + e) * 384 + 256 + 4 * dg) = w;
            C = (C + U[ch]) * dc[ch]; } }
    const float* NU = (const float*)(ws + WS_NU); float* NP = (float*)(ws + WS_NPREV);
    for (int i = gt; i < 16 * 128; i += NGT) { const int bh = i >> 7, d = i & 127; float n = 0.f;
        for (int ch = 0; ch < 16; ++ch) { const int mu = bh * 16 + ch; NP[mu * 128 + d] = n; n = (n + NU[mu * 128 + d]) * DEC[mu];
#ifdef DBG_NO_INTER
            n = 0.f;
#endif
        } }
}
struct Args { const float* in[18]; float* out; unsigned char* ws; int ph_lo, ph_hi; };
__global__ void __launch_bounds__(NTHR, 2) mk_fwd(Args args) {
    extern __shared__ __attribute__((aligned(16))) unsigned char lds[];
    Frame F;
    const char __attribute__((address_space(4)))* kargp = (const char __attribute__((address_space(4)))*)__builtin_amdgcn_kernarg_segment_ptr();
#define AIN(i) ({ const char __attribute__((address_space(4)))* k_ = kargp; asm volatile("" : "+s"(k_)); *(const float* const __attribute__((address_space(4)))*)(k_ + 8 * (i)); })
    unsigned char* const ws0 = (unsigned char*)AIN(19);
    F.lds = (LAS unsigned char*)lds; F.ws = ws0; F.ctl = (unsigned*)(ws0 + WS_CTL);
    F.tid = threadIdx.x; F.lane = F.tid & 63; F.wave = __builtin_amdgcn_readfirstlane(F.tid >> 6);
    F.G = gridDim.x; { const int bx = blockIdx.x; F.vcu = (F.G % 8 == 0) ? (bx % 8) * (F.G / 8) + bx / 8 : bx; }
    for (int u = F.tid; u < (LDS_BYTES - LX) / 4; u += NTHR) ((LAS unsigned*)(F.lds + LX))[u] = 0u;
    __syncthreads();
    int lo, hi; { const char __attribute__((address_space(4)))* k_ = kargp; lo = *(const int __attribute__((address_space(4)))*)(k_ + 160); hi = *(const int __attribute__((address_space(4)))*)(k_ + 164); }
    XcdBarrier bar; bar.bar = (unsigned*)(F.ctl + CW_BAR); bar.x = 0; bar.st = nullptr;
    if (hi - lo > 1) bar = xcd_barrier_post((unsigned*)(F.ctl + CW_BAR), (volatile LAS unsigned*)(F.lds + LX_MISC) + 8);
#ifndef PHASE_MASK
#define PHASE_MASK 0x7FFFF
#endif
#define IN(k) ((((PHASE_MASK) >> (k)) & 1) && lo <= (k) && (k) < hi)
#ifndef REPEAT_MASK
#define REPEAT_MASK 0
#endif
#define PH(k) if (IN(k))
#define SEAM(k) do { if (IN(k) && IN((k) + 1)) xcd_barrier(bar); } while (0)
    unsigned char* ws = ws0;
#define x_in AIN(0)
#define ln_mix_g AIN(8)
#define ln_mix_b AIN(9)
#define ln_ffn_g AIN(10)
#define ln_ffn_b AIN(11)
#define router_b AIN(13)
#define b_gu AIN(15)
#define b_dn AIN(17)
    bf16_t* XB = (bf16_t*)(ws + WS_XB); bf16_t* QB_ = (bf16_t*)(ws + WS_Q); bf16_t* KB_ = (bf16_t*)(ws + WS_K); bf16_t* VB_ = (bf16_t*)(ws + WS_V);
    bf16_t* R0 = (bf16_t*)(ws + WS_R0); bf16_t* R1 = (bf16_t*)(ws + WS_R1);
    bf16_t* HB = (bf16_t*)(ws + WS_H); bf16_t* YB = (bf16_t*)(ws + WS_Y);
    LAS unsigned char* ring = F.lds + RING_OFF;
    const int cG = (int)blockIdx.x;
    const bool isConv = (NCONV > 0) && ((int)blockIdx.x >= F.G - NCONV);
    const int Gc = F.G - NCONV, cwv = ((int)blockIdx.x - Gc) * NWAVES + F.wave, ncw = NCONV * NWAVES;
#define CONV_SLICE(a, b) conv_items(F, AIN(14), AIN(16), (int)((long)CONV_ITEMS * (a) / 1000), (int)((long)CONV_ITEMS * (b) / 1000), cwv, ncw)

    PH(0) { P0In I{x_in, AIN(2), AIN(3), AIN(4), AIN(7), AIN(12), AIN(14), AIN(16), (const int*)AIN(1)}; p0_prologue(F, I); }
    SEAM(0);
    PH(1) { { Gemm g{1024, 1024, 1024, nullptr}; DenseSched S{64, 12, F.G, cG, (const char*)XB, (const char*)(ws + WS_WQKV), (size_t)256 * 1024 * 2, (size_t)256 * 1024 * 2};
        EpiQKV E{QB_, KB_, VB_, (const float*)(ws + WS_ROPE), (float*)(ws + WS_KSUM)};
        pg8::gemm_phase<EpiQKV, DenseSched, true, false>(ring, g, S, E); } }
    SEAM(1);
    PH(2) { if (isConv) CONV_SLICE(0, 1000); else {
        const attn_body::AttnTensors AT{(const attn_body::bf16*)QB_, (const attn_body::bf16*)KB_, (const attn_body::bf16*)VB_, (attn_body::bf16*)QB_, (const float*)(ws + WS_KSUM)};
        if (NCONV == 0) { const attn_body::StaticOrder S((int)F.G, (int)blockIdx.x); attn_body::attn_phase<attn_body::StaticOrder>((char*)lds + RING_OFF, AT, S); }
        else { const attn_body::SnakeOrder S{cG, Gc}; attn_body::attn_phase<attn_body::SnakeOrder>((char*)lds + RING_OFF, AT, S); } } }
    SEAM(2);
    PH(3) { { Gemm g{1024, 1024, 1024, nullptr}; DenseSched S{64, 4, F.G, cG, (const char*)QB_, (const char*)(ws + WS_WO), (size_t)256 * 1024 * 2, (size_t)256 * 1024 * 2};
        EpiZ E{XB, R0, DBG_ATTN_MUL}; pg8::gemm_phase<EpiZ, DenseSched, true, false>(ring, g, S, E); } }
    SEAM(3);
    PH(4) phase_ln_router(F, R0, R1, ln_mix_g, ln_mix_b, router_b, 0, 0);
    SEAM(4);
    PH(5) { const int nT = moe_tables(F, 0); LAS unsigned short* tokl = (LAS unsigned short*)(F.lds + LX_TOKL);
        { const unsigned short* rowtok = (const unsigned short*)(ws + WS_ROWTOK); const LAS int* tile_e = (const LAS int*)(F.lds + LX_TILEE); const LAS int* tbase = (const LAS int*)(F.lds + LX_TBASE);
          for (int i = 0; i < TOKL_ROUNDS; ++i) { int pm, pn, hf; if (!moe_unit(i, F.G, cG, nT, 8, pm, pn, hf)) break;
              if (F.tid < 256) { const int e = tile_e[pm]; const int r = (pm - tbase[e]) * 256 + F.tid; const int c = (int)__hip_atomic_load(F.ctl + CW_CNT + 0 * 2048 + e * 64, RLX_AGENT);
                  tokl[i * 256 + F.tid] = (r < c) ? rowtok[(size_t)e * NTOK + r] : (unsigned short)0; } }
          __syncthreads(); }
        Gemm g{512, 512, 512, (const char*)XB};
        MoeSched S{nT, 8, F.G, cG, (const LAS int*)(F.lds + LX_TILEE), (const LAS int*)(F.lds + LX_TBASE), tokl, nullptr, (const char*)(ws + WS_WGU) + (size_t)0 * 32 * 2048 * 1024, 0, (size_t)2048 * 1024, (size_t)256 * 1024};
        EpiGU E{b_gu + (size_t)0 * 32 * 2048, (unsigned char*)HB, (LAS float*)(F.lds + LX_BIAS), 0}; pg8::gemm_phase<EpiGU, MoeSched, true, true, true, true>(ring, g, S, E); }
    SEAM(5);
    PH(6) { const int nT = moe_tables(F, 0); Gemm g{512, 512, 512, nullptr};
        MoeSched S{nT, 4, F.G, cG, (const LAS int*)(F.lds + LX_TILEE), (const LAS int*)(F.lds + LX_TBASE), nullptr, (const char*)HB, (const char*)(ws + WS_WD) + (size_t)0 * 32 * 1024 * 1024, (size_t)256 * 1024, (size_t)1024 * 1024, (size_t)256 * 1024};
        EpiDN E{b_dn + (size_t)0 * 32 * 1024, (unsigned char*)YB, (LAS float*)(F.lds + LX_BIAS), 0}; pg8::gemm_phase<EpiDN, MoeSched, true, false, true, true>(ring, g, S, E); }
    SEAM(6);
    PH(7) phase_combine<true>(F, R1, nullptr, ln_ffn_g, ln_ffn_b, AIN(5), 0);
    { F.lane = (int)attn_body::lane_now(); F.tid = F.wave * 64 + F.lane; }
    SEAM(7);
    PH(8) phase_gate_scan(F);
    SEAM(8);
    PH(9) {
        { Gemm g{1024, 1024, 1024, nullptr}; DenseSched S{64, 8, F.G, cG, (const char*)XB, (const char*)(ws + WS_WINA), (size_t)256 * 1024 * 2, (size_t)256 * 1024 * 2};
          EpiINA E{(const float*)(ws + WS_RF), (const float*)(ws + WS_CF), (bf16_t*)(ws + WS_AE), (bf16_t*)(ws + WS_KN), (bf16_t*)(ws + WS_OS)};
          pg8::gemm_phase<EpiINA, DenseSched, true, false>(ring, g, S, E); }
        { Gemm g{1024, 1024, 1024, nullptr}; DenseSched S{6, 64, F.G, cG, (const char*)(ws + WS_WINB), (const char*)XB, (size_t)256 * 1024 * 2, (size_t)256 * 1024 * 2, true};
          EpiINB E{(const float*)(ws + WS_CF), (bf16_t*)(ws + WS_KT), (bf16_t*)(ws + WS_BE)};
          pg8::gemm_phase<EpiINB, DenseSched, true, false, false, true>(ring, g, S, E); }
    }
    SEAM(9);
    PH(10) { Gemm g{256, 384, NTOK, nullptr}; MuSched S{F.G, cG, 0, (const char*)(ws + WS_BE), (const char*)(ws + WS_KT)};
        EpiM1 E{(bf16_t*)(ws + WS_UT)}; pg8::gemm_phase<EpiM1, MuSched, true, false, false, true>(ring, g, S, E);
        phase_nu(F); }
    SEAM(10);
    PH(11) phase_state_scan(F);
    SEAM(11);
    PH(12) { Gemm g{128, 512, 1024, nullptr}; MuSched S{F.G, cG, 1, (const char*)(ws + WS_AE), (const char*)(ws + WS_KN)};
        EpiM2A E{(bf16_t*)(ws + WS_AE), (const float*)(ws + WS_NPREV), (float*)(ws + WS_DEN)}; pg8::gemm_phase<EpiM2A, MuSched, true, false>(ring, g, S, E); }
    SEAM(12);
    PH(13) { Gemm g{384, 512, 384, nullptr}; MuSched S{F.G, cG, 2, (const char*)(ws + WS_AE), (const char*)(ws + WS_BE)};
        EpiM2B E{(const float*)(ws + WS_DEN), AIN(6), (const bf16_t*)(ws + WS_OS), (bf16_t*)(ws + WS_HN), (LAS float*)(F.lds + LX_LNX)};
        pg8::gemm_phase<EpiM2B, MuSched, true, false>(ring, g, S, E); }
    SEAM(13);
    PH(14) { Gemm g{1024, 1024, 1024, nullptr}; DenseSched S{64, 4, F.G, cG, (const char*)(ws + DBG_P14_A), (const char*)(ws + WS_WOUT), (size_t)256 * 1024 * 2, (size_t)256 * 1024 * 2};
        EpiZ E{XB, R0, DBG_MLSTM_MUL}; pg8::gemm_phase<EpiZ, DenseSched, true, false>(ring, g, S, E); }
    SEAM(14);
    PH(15) phase_ln_router(F, R0, R1, ln_mix_g + 1024, ln_mix_b + 1024, router_b + 32, 1, 1);
    SEAM(15);
    PH(16) { const int nT = moe_tables(F, 1); LAS unsigned short* tokl = (LAS unsigned short*)(F.lds + LX_TOKL);
        { const unsigned short* rowtok = (const unsigned short*)(ws + WS_ROWTOK); const LAS int* tile_e = (const LAS int*)(F.lds + LX_TILEE); const LAS int* tbase = (const LAS int*)(F.lds + LX_TBASE);
          for (int i = 0; i < TOKL_ROUNDS; ++i) { int pm, pn, hf; if (!moe_unit(i, F.G, cG, nT, 8, pm, pn, hf)) break;
              if (F.tid < 256) { const int e = tile_e[pm]; const int r = (pm - tbase[e]) * 256 + F.tid; const int c = (int)__hip_atomic_load(F.ctl + CW_CNT + 1 * 2048 + e * 64, RLX_AGENT);
                  tokl[i * 256 + F.tid] = (r < c) ? rowtok[(size_t)e * NTOK + r] : (unsigned short)0; } }
          __syncthreads(); }
        Gemm g{512, 512, 512, (const char*)XB};
        MoeSched S{nT, 8, F.G, cG, (const LAS int*)(F.lds + LX_TILEE), (const LAS int*)(F.lds + LX_TBASE), tokl, nullptr, (const char*)(ws + WS_WGU) + (size_t)1 * 32 * 2048 * 1024, 0, (size_t)2048 * 1024, (size_t)256 * 1024};
        EpiGU E{b_gu + (size_t)1 * 32 * 2048, (unsigned char*)HB, (LAS float*)(F.lds + LX_BIAS), 0}; pg8::gemm_phase<EpiGU, MoeSched, true, true, true, true>(ring, g, S, E); }
    SEAM(16);
    PH(17) { const int nT = moe_tables(F, 1); Gemm g{512, 512, 512, nullptr};
        MoeSched S{nT, 4, F.G, cG, (const LAS int*)(F.lds + LX_TILEE), (const LAS int*)(F.lds + LX_TBASE), nullptr, (const char*)HB, (const char*)(ws + WS_WD) + (size_t)1 * 32 * 1024 * 1024, (size_t)256 * 1024, (size_t)1024 * 1024, (size_t)256 * 1024};
        EpiDN E{b_dn + (size_t)1 * 32 * 1024, (unsigned char*)YB, (LAS float*)(F.lds + LX_BIAS), 0}; pg8::gemm_phase<EpiDN, MoeSched, true, false, true, true>(ring, g, S, E); }
    SEAM(17);
    PH(18) phase_combine<false>(F, R1, (float*)AIN(18), ln_ffn_g + 1024, ln_ffn_b + 1024, nullptr, 1);
#undef IN
#undef CONV_SLICE
#undef AIN
#undef x_in
#undef ln_mix_g
#undef ln_mix_b
#undef ln_ffn_g
#undef ln_ffn_b
#undef router_b
#undef b_gu
#undef b_dn
#undef SEAM
}

extern "C" void kernel_launch(void* const* d_in, const int* in_sizes, int n_in, void* d_out, int out_size, void* d_ws, size_t ws_size, hipStream_t stream) {
    static int grid = 0;
    if (grid == 0) {
        if (n_in != 18 || out_size != NTOK * DM || ws_size < WS_END) { fprintf(stderr, "kernel_launch: unexpected problem shape (n_in %d, out %d, ws %zu)\n", n_in, out_size, ws_size); grid = -1; return; }
        int dev = 0, cus = 0, per_cu = 0;
        if (hipGetDevice(&dev) != hipSuccess || hipDeviceGetAttribute(&cus, hipDeviceAttributeMultiprocessorCount, dev) != hipSuccess) { grid = -1; return; }
        if (hipFuncSetAttribute((const void*)mk_fwd, hipFuncAttributeMaxDynamicSharedMemorySize, LDS_BYTES) != hipSuccess) { fprintf(stderr, "kernel_launch: hipFuncSetAttribute failed\n"); grid = -1; return; }
        if (hipOccupancyMaxActiveBlocksPerMultiprocessor(&per_cu, (const void*)mk_fwd, NTHR, LDS_BYTES) != hipSuccess || per_cu < 1) fprintf(stderr, "kernel_launch: occupancy query reports %d\n", per_cu);
        (void)hipGetLastError();
        grid = cus;
        if (grid > 256) grid = 256;
        if (grid < 240) { fprintf(stderr, "kernel_launch: %d CUs: this build needs 240..256\n", cus); grid = -1; return; }
    }
    if (grid < 0) return;
    if (hipMemsetAsync((char*)d_ws + WS_CTL, 0, CTL_ZERO_BYTES, stream) != hipSuccess) return;
    Args a{};
    for (int i = 0; i < 18; ++i) a.in[i] = (const float*)d_in[i];
    a.out = (float*)d_out; a.ws = (unsigned char*)d_ws;
#if MK_ONE_LAUNCH
    a.ph_lo = 0; a.ph_hi = NPHASE;
    hipLaunchKernelGGL(mk_fwd, dim3(grid), dim3(NTHR), LDS_BYTES, stream, a);
#else
    for (int p = 0; p < NPHASE; ++p) { a.ph_lo = p; a.ph_hi = p + 1; hipLaunchKernelGGL(mk_fwd, dim3(grid), dim3(NTHR), LDS_BYTES, stream, a); }
#endif
}
```

```cpp
#include <hip/hip_runtime.h>
#include <hip/hip_bf16.h>
#include <cstdio>
#include <cstdint>
#include <cmath>

#define LAS __attribute__((address_space(3)))
#define GAS __attribute__((address_space(1)))
typedef unsigned short bf16_t;
typedef short bf16x8 __attribute__((ext_vector_type(8)));
typedef float f32x4 __attribute__((ext_vector_type(4)));
typedef float f32x2 __attribute__((ext_vector_type(2)));
typedef unsigned u32x4 __attribute__((ext_vector_type(4)));
typedef unsigned u32x2 __attribute__((ext_vector_type(2)));
typedef int i32x4 __attribute__((ext_vector_type(4)));
typedef int i32x8 __attribute__((ext_vector_type(8)));

typedef __bf16 bf16x2_t __attribute__((ext_vector_type(2)));
__device__ __forceinline__ unsigned cvt_pk_bf16(float lo, float hi) { const f32x2 v = {lo, hi}; const bf16x2_t b = __builtin_convertvector(v, bf16x2_t); return __builtin_bit_cast(unsigned, b); }
__device__ __forceinline__ float bf2f(unsigned short b) { return __uint_as_float(((unsigned)b) << 16); }
__device__ __forceinline__ float bflo(unsigned w) { return __uint_as_float(w << 16); }
__device__ __forceinline__ float bfhi(unsigned w) { return __uint_as_float(w & 0xffff0000u); }

__device__ __forceinline__ void glds16s(const void* sbase, unsigned voff, unsigned lds_dst) { unsigned keep;
    asm volatile("s_nop 4\n\ts_mov_b32 %0, m0\n\ts_mov_b32 m0, %3\n\ts_nop 0\n\tglobal_load_lds_dwordx4 %1, %2\n\ts_mov_b32 m0, %0" : "=&s"(keep) : "v"(voff), "s"(sbase), "s"(lds_dst) : "memory"); }
__device__ __forceinline__ void glds4s(const void* sbase, unsigned voff, unsigned lds_dst) { unsigned keep;
    asm volatile("s_nop 4\n\ts_mov_b32 %0, m0\n\ts_mov_b32 m0, %3\n\ts_nop 0\n\tglobal_load_lds_dword %1, %2\n\ts_mov_b32 m0, %0" : "=&s"(keep) : "v"(voff), "s"(sbase), "s"(lds_dst) : "memory"); }
__device__ __forceinline__ const char* uni_ptr(const char* p) { const unsigned long long v = (unsigned long long)p; const unsigned lo = __builtin_amdgcn_readfirstlane((unsigned)v), hi = __builtin_amdgcn_readfirstlane((unsigned)(v >> 32)); return (const char*)(((unsigned long long)hi << 32) | lo); }
namespace pg8 {
constexpr int BM = 256, BK = 64, HALF = 128, HTB = HALF * BK * 2, STAGE_BYTES = 8 * HTB, NXCD = 8, WGM = 8;
__host__ __device__ __forceinline__ int lds_byte(int r, int c) { const int st = (r >> 4) * 2 + (c >> 5), rr = r & 15, cc = c & 31, ob = rr * 64 + cc * 2; return st * 1024 + (ob ^ (((ob >> 9) & 1) << 5)); }
__host__ __device__ __forceinline__ void stage_rc(int b, int& R, int& C) { const int st = b / 1024, sb = b % 1024, swz = sb ^ (((sb >> 9) & 1) << 5); R = (st >> 1) * 16 + swz / 64; C = (st & 1) * 32 + (swz % 64) / 2; }
__host__ __device__ __forceinline__ int perm32(int rho) { const int n = rho >> 4, i = rho & 15; return 8 * (i >> 2) + 4 * n + (i & 3); }

struct Unit { int pm, pn; const char* A; const char* B; const LAS unsigned short* tl; int x0, x1, x2; };
struct Gemm { int K, lda, ldb; const char* Abase; };

__device__ __forceinline__ bool tile_order(int i, int G, int c, int nM, int nN, int& pm, int& pn) {
    const int nwg = nM * nN; const long L = (long)i * G + c; if (L >= nwg) return false;
    int wgid = (int)L; { const int q = nwg / NXCD, r = nwg % NXCD, xcd = wgid % NXCD, off = wgid / NXCD; wgid = (xcd < r ? xcd * (q + 1) : r * (q + 1) + (xcd - r) * q) + off; }
    const int nig = WGM * nN, gid = wgid / nig, fm = gid * WGM, gsz = (nM - fm) < WGM ? (nM - fm) : WGM;
    pm = fm + ((wgid % nig) % gsz); pn = (wgid % nig) / gsz; return true;
}

template <class Epi, class Sched, bool ALIGN_EPI, bool GATHER, bool FP8 = false, bool HALFSEL = false>
__device__ __forceinline__ void gemm_phase(LAS unsigned char* lds, const Gemm g, const Sched& S, const Epi& E) {
    const int tid = threadIdx.x, wid = __builtin_amdgcn_readfirstlane(tid >> 6), lane = tid & 63, wr = wid >> 2, wc = wid & 3, fr = lane & 15, fq = lane >> 4;
    const int K = g.K, nt = K / BK;
    int RA[2]; unsigned cA2[2], voffB[2];
#pragma unroll
    for (int i = 0; i < 2; ++i) { int R, C; stage_rc(tid * 16 + i * 8192, R, C); const int Rb = Epi::PERM ? ((R & ~31) + perm32(R & 31)) : R;
        RA[i] = R; cA2[i] = (unsigned)C * 2u; voffB[i] = (unsigned)(Rb * g.ldb + C) * 2u; }
    const size_t kstep = (size_t)(BK * 2);
    const unsigned hstepA = (unsigned)HALF * (unsigned)g.lda * 2u; const size_t hstepB = (size_t)HALF * g.ldb * 2;
    const unsigned ldsb = (unsigned)__builtin_amdgcn_readfirstlane((unsigned)(unsigned long long)lds + (unsigned)wid * 1024u);
    const int aoff = lds_byte(wr * 64 + fr, fq * 8), boff = lds_byte(wc * 32 + fr, fq * 8);
    const int aoff2 = aoff + 1024, boff2 = boff + 1024;
#define PG8_SA(b, h) (((b) * 2 + (h)) * HTB)
#define PG8_SB(b, h) ((4 + (b) * 2 + (h)) * HTB)
#define PG8_STAGE(bufoff, gbase, voff) do { _Pragma("unroll") for (int _i = 0; _i < 2; ++_i) glds16s((gbase), (voff)[_i], ldsb + (unsigned)(bufoff) + _i * 8192u); } while (0)
#define PG8_STAGE_A(bufoff, gbase, AO, h) do { _Pragma("unroll") for (int _i = 0; _i < 2; ++_i) glds16s((gbase), (AO)[h][_i], ldsb + (unsigned)(bufoff) + _i * 8192u); } while (0)
#define PG8_LD8(base_, o1_, o2_) __builtin_shufflevector(*(const LAS i32x4*)(lds + (base_) + (o1_)), *(const LAS i32x4*)(lds + (base_) + (o2_)), 0, 1, 2, 3, 4, 5, 6, 7)
#define PG8_LDA(dst, b, h) do { if constexpr (FP8) { _Pragma("unroll") for (int m = 0; m < 4; ++m) dst##8[m] = PG8_LD8(PG8_SA(b, h) + m * 2048, aoff, aoff2); } \
        else { _Pragma("unroll") for (int m = 0; m < 4; ++m) _Pragma("unroll") for (int k = 0; k < 2; ++k) dst[m][k] = *(const LAS bf16x8*)(lds + PG8_SA(b, h) + aoff + m * 2048 + k * 1024); } } while (0)
#define PG8_LDB(dst, b, h) do { if constexpr (FP8) { _Pragma("unroll") for (int n = 0; n < 2; ++n) dst##8[n] = PG8_LD8(PG8_SB(b, h) + n * 2048, boff, boff2); } \
        else { _Pragma("unroll") for (int n = 0; n < 2; ++n) _Pragma("unroll") for (int k = 0; k < 2; ++k) dst[n][k] = *(const LAS bf16x8*)(lds + PG8_SB(b, h) + boff + n * 2048 + k * 1024); } } while (0)
#define PG8_MMA(ai, bj, At, Bt) do { __builtin_amdgcn_s_setprio(1); _Pragma("unroll") for (int m = 0; m < 4; ++m) _Pragma("unroll") for (int n = 0; n < 2; ++n) { \
        if constexpr (FP8) asm volatile("v_mfma_f32_16x16x128_f8f6f4 %0, %1, %2, %0" : "+v"(acc[ai][bj][m][n]) : "v"(Bt##8[n]), "v"(At##8[m])); \
        else { _Pragma("unroll") for (int k = 0; k < 2; ++k) acc[ai][bj][m][n] = __builtin_amdgcn_mfma_f32_16x16x32_bf16(Bt[n][k], At[m][k], acc[ai][bj][m][n], 0, 0, 0); } } \
        __builtin_amdgcn_s_setprio(0); } while (0)
#define PG8_WAIT_V(n) asm volatile("s_waitcnt vmcnt(" #n ")" ::: "memory")
#define PG8_WAIT_L(n) asm volatile("s_waitcnt lgkmcnt(" #n ")" ::: "memory")
#define PG8_BAR __builtin_amdgcn_s_barrier()
#define PG8_SCHED __builtin_amdgcn_sched_barrier(0)
#define PG8_AOFF(AO, U) do { _Pragma("unroll") for (int _h = 0; _h < 2; ++_h) _Pragma("unroll") for (int _i = 0; _i < 2; ++_i) { \
        if constexpr (GATHER) AO[_h][_i] = (unsigned)(U).tl[RA[_i] + _h * HALF] * (unsigned)(g.lda * 2) + cA2[_i]; \
        else AO[_h][_i] = (unsigned)RA[_i] * (unsigned)(g.lda * 2) + cA2[_i] + (unsigned)_h * hstepA; } } while (0)
    Unit cur, nxt; int ui = 0;
    if (!S.next(0, cur)) return;
    f32x4 acc[2][2][4][2];
#pragma unroll
    for (int a = 0; a < 2; ++a)
#pragma unroll
        for (int b = 0; b < 2; ++b)
#pragma unroll
            for (int m = 0; m < 4; ++m)
#pragma unroll
                for (int n = 0; n < 2; ++n) acc[a][b][m][n] = (f32x4){0.f, 0.f, 0.f, 0.f};
    bf16x8 At[4][2], B0[2][2], B1[2][2]; i32x8 At8[4], B08[2], B18[2];
    E.prep(cur, 0, wid, lane);
    unsigned aoC[2][2], aoN[2][2];
    PG8_AOFF(aoC, cur);
    const char* cA = uni_ptr(GATHER ? g.Abase : cur.A); const char* cB = uni_ptr(cur.B);
    PG8_STAGE(PG8_SB(0, 0), cB, voffB); PG8_STAGE(PG8_SB(0, 1), cB + hstepB, voffB); PG8_STAGE_A(PG8_SA(0, 0), cA, aoC, 0); PG8_STAGE_A(PG8_SA(0, 1), cA, aoC, 1);
    if (wr == 1) PG8_BAR;
    PG8_WAIT_V(2); PG8_BAR;
    PG8_STAGE(PG8_SB(1, 0), cB + kstep, voffB); PG8_STAGE_A(PG8_SA(1, 0), cA + kstep, aoC, 0); PG8_STAGE(PG8_SB(1, 1), cB + hstepB + kstep, voffB);
    PG8_WAIT_V(6); PG8_BAR;
    for (;;) {
        const bool has_next = S.next(ui + 1, nxt);
        if (has_next) E.prep(nxt, ui + 1, wid, lane);
        if constexpr (GATHER) { if (has_next) PG8_AOFF(aoN, nxt); else { _Pragma("unroll") for (int _h = 0; _h < 2; ++_h) _Pragma("unroll") for (int _i = 0; _i < 2; ++_i) aoN[_h][_i] = aoC[_h][_i]; } }
        const char* nA = uni_ptr(GATHER ? g.Abase : (has_next ? nxt.A : cA)); const char* nB = uni_ptr(has_next ? nxt.B : cB);
        const bool dh0 = cur.x2 != 2, dh1 = cur.x2 != 1;
#pragma nounroll
        for (int t = 0; t < nt; t += 2) {
            const bool last = (t == nt - 2);
            if constexpr (Epi::MID) { if (t == 2) E.prep_mid(cur, wid, lane); }
            const char* a1 = cA + (size_t)(t + 1) * kstep;
            const char* a2 = last ? nA : cA + (size_t)(t + 2) * kstep; const char* b2 = last ? nB : cB + (size_t)(t + 2) * kstep;
            const char* a3 = a2 + kstep; const char* b3 = b2 + kstep;
            unsigned aoS[2][2];
#pragma unroll
            for (int _h = 0; _h < 2; ++_h)
#pragma unroll
                for (int _i = 0; _i < 2; ++_i) aoS[_h][_i] = (GATHER && last) ? aoN[_h][_i] : aoC[_h][_i];
            PG8_LDB(B0, 0, 0); PG8_LDB(B1, 0, 1); PG8_SCHED; PG8_LDA(At, 0, 0); PG8_STAGE_A(PG8_SA(1, 1), a1, aoC, 1);
            PG8_WAIT_V(8); PG8_WAIT_L(0); PG8_BAR; if (!HALFSEL || dh0) PG8_MMA(0, 0, At, B0); if (!HALFSEL || dh1) PG8_MMA(0, 1, At, B1); PG8_BAR; PG8_SCHED;
            PG8_LDA(At, 0, 1); PG8_STAGE(PG8_SB(0, 0), b2, voffB); PG8_STAGE(PG8_SB(0, 1), b2 + hstepB, voffB); PG8_STAGE_A(PG8_SA(0, 0), a2, aoS, 0);
            PG8_WAIT_V(8); PG8_WAIT_L(0); PG8_BAR; if (!HALFSEL || dh0) PG8_MMA(1, 0, At, B0); if (!HALFSEL || dh1) PG8_MMA(1, 1, At, B1); PG8_BAR; PG8_SCHED;
            PG8_LDB(B0, 1, 0); PG8_LDB(B1, 1, 1); PG8_SCHED; PG8_LDA(At, 1, 0); PG8_STAGE_A(PG8_SA(0, 1), a2, aoS, 1);
            PG8_WAIT_V(8); PG8_WAIT_L(0); PG8_BAR; if (!HALFSEL || dh0) PG8_MMA(0, 0, At, B0); if (!HALFSEL || dh1) PG8_MMA(0, 1, At, B1); PG8_BAR; PG8_SCHED;
            PG8_LDA(At, 1, 1); PG8_STAGE(PG8_SB(1, 0), b3, voffB); PG8_STAGE(PG8_SB(1, 1), b3 + hstepB, voffB); PG8_STAGE_A(PG8_SA(1, 0), a3, aoS, 0);
            PG8_WAIT_V(8); PG8_WAIT_L(0); PG8_BAR; if (!HALFSEL || dh0) PG8_MMA(1, 0, At, B0); if (!HALFSEL || dh1) PG8_MMA(1, 1, At, B1); PG8_BAR; PG8_SCHED;
        }
        if constexpr (FP8) asm volatile("s_nop 15\n\ts_nop 15" ::: "memory");
        if constexpr (ALIGN_EPI) { if (wr == 0) PG8_BAR; }
        E(acc, cur, wr, wc, fr, fq);
        if (!has_next) break;
#pragma unroll
        for (int a = 0; a < 2; ++a)
#pragma unroll
            for (int b = 0; b < 2; ++b)
#pragma unroll
                for (int m = 0; m < 4; ++m)
#pragma unroll
                    for (int n = 0; n < 2; ++n) acc[a][b][m][n] = (f32x4){0.f, 0.f, 0.f, 0.f};
        if constexpr (FP8) asm volatile("s_nop 7" ::: "memory");
        cur = nxt; cA = nA; cB = nB; ++ui;
        if constexpr (GATHER) {
#pragma unroll
            for (int _h = 0; _h < 2; ++_h)
#pragma unroll
                for (int _i = 0; _i < 2; ++_i) aoC[_h][_i] = aoN[_h][_i]; }
        if constexpr (ALIGN_EPI) { if (wr == 1) PG8_BAR; }
    }
    PG8_WAIT_V(0);
    if constexpr (!ALIGN_EPI) { if (wr == 0) PG8_BAR; }
    PG8_BAR;
#undef PG8_SA
#undef PG8_SB
#undef PG8_STAGE
#undef PG8_STAGE_A
#undef PG8_LDA
#undef PG8_LD8
#undef PG8_LDB
#undef PG8_MMA
#undef PG8_WAIT_V
#undef PG8_WAIT_L
#undef PG8_BAR
#undef PG8_SCHED
#undef PG8_AOFF
}
}
#include <hip/hip_bf16.h>
namespace attn_body {
using bf16=__hip_bfloat16;
using bf16x8=__attribute__((ext_vector_type(8)))short;
using s16x4=__attribute__((ext_vector_type(4)))short;
using f32x16=__attribute__((ext_vector_type(16)))float;
using u32x4=__attribute__((ext_vector_type(4)))unsigned;
constexpr int BATCH=4,NHEAD=16,SEQ=4096,D=64,DM=NHEAD*D;
constexpr int NW=8,QBLK=32,QB=QBLK*NW,KVBLK=64,NQB=SEQ/QB;
constexpr int ATTN_PITCH=DM, ATTN_UNIT_ROWS=QB;
__device__ __forceinline__ int crow(int r,int hi){return (r&3)+8*(r>>2)+4*hi;}
#define SBAR() __builtin_amdgcn_sched_barrier(0)
__device__ __forceinline__ void cmask(f32x16&p0,f32x16&p1,int jb,int qrel,int hi){
  const float NEG=-INFINITY; int d=qrel-64*jb-4*hi; asm volatile("":"+v"(d));
  #pragma unroll
  for(int r=0;r<16;++r){const int c=(r&3)+8*(r>>2); if(c>d)p0[r]=NEG; if(c+32>d)p1[r]=NEG;}
}

constexpr int NSLOT=3, SLOTB=8192;
constexpr int LDS_GT=98304;
constexpr int LDS_K=0, LDS_V=NSLOT*SLOTB, LDS_WS=2*NSLOT*SLOTB, LDS_OST=LDS_WS+NW*64*4, LDS_BYTES=LDS_OST+NW*4096;
constexpr float C2=0.125f*1.4426950408889634f;
__device__ __forceinline__ void glds16(const void*gsrc,unsigned lds_dst){unsigned keep;
  asm volatile("s_mov_b32 %0, m0\n\ts_mov_b32 m0, %2\n\ts_nop 0\n\tglobal_load_lds_dwordx4 %1, off\n\ts_mov_b32 m0, %0":"=&s"(keep):"v"(gsrc),"s"(lds_dst):"memory");}
__device__ __forceinline__ void glds16s(const void*sbase,unsigned voff,unsigned lds_dst){unsigned keep;
  asm volatile("s_nop 4\n\ts_mov_b32 %0, m0\n\ts_mov_b32 m0, %3\n\ts_nop 0\n\tglobal_load_lds_dwordx4 %1, %2\n\ts_mov_b32 m0, %0":"=&s"(keep):"v"(voff),"s"(sbase),"s"(lds_dst):"memory");}
__device__ __forceinline__ unsigned lane_now(){unsigned l;asm volatile("v_mbcnt_lo_u32_b32 %0, -1, 0\n\tv_mbcnt_hi_u32_b32 %0, -1, %0":"=v"(l));return l;}
__device__ __forceinline__ float max3f(float a,float b,float c){float r;asm("v_max3_f32 %0, %1, %2, %3":"=v"(r):"v"(a),"v"(b),"v"(c));return r;}
__device__ __forceinline__ float max2f(float a,float b){float r;asm("v_max_f32_e32 %0, %1, %2":"=v"(r):"v"(a),"v"(b));return r;}
__device__ __forceinline__ float fadd_s(float a,float b){float r;asm("v_add_f32_e32 %0, %1, %2":"=v"(r):"v"(a),"v"(b));return r;}
__device__ __forceinline__ float fsub_s(float a,float b){float r;asm("v_sub_f32_e32 %0, %1, %2":"=v"(r):"v"(a),"v"(b));return r;}
typedef float f32x2_t __attribute__((ext_vector_type(2))); typedef __bf16 bf16x2_t __attribute__((ext_vector_type(2)));
__device__ __forceinline__ unsigned cvtpk_s(float lo,float hi){f32x2_t v={lo,hi};bf16x2_t b=__builtin_convertvector(v,bf16x2_t);return __builtin_bit_cast(unsigned,b);}
#define WAIT_BAR(N) asm volatile("s_waitcnt vmcnt(" #N ") lgkmcnt(0)\n\ts_barrier":::"memory")

__device__ __forceinline__ void qkt(f32x16&p0,f32x16&p1,const char*Kslot,const bf16x8*qr,int r32,int hi){
  const char*kb=Kslot+hi*1024+r32*16;
  #pragma unroll
  for(int d0=0;d0<4;++d0){
    const bf16x8 b0=*reinterpret_cast<const bf16x8*>(kb+d0*2048);
    const bf16x8 b1=*reinterpret_cast<const bf16x8*>(kb+d0*2048+512);
    if(d0==0){p0=__builtin_amdgcn_mfma_f32_32x32x16_bf16(b0,qr[0],(f32x16){0.f,0.f,0.f,0.f,0.f,0.f,0.f,0.f,0.f,0.f,0.f,0.f,0.f,0.f,0.f,0.f},0,0,0);p1=__builtin_amdgcn_mfma_f32_32x32x16_bf16(b1,qr[0],(f32x16){0.f,0.f,0.f,0.f,0.f,0.f,0.f,0.f,0.f,0.f,0.f,0.f,0.f,0.f,0.f,0.f},0,0,0);}
    else{p0=__builtin_amdgcn_mfma_f32_32x32x16_bf16(b0,qr[d0],p0,0,0,0);p1=__builtin_amdgcn_mfma_f32_32x32x16_bf16(b1,qr[d0],p1,0,0,0);}}
}
typedef __attribute__((address_space(3))) const char* lds_cptr;
typedef short v4i16_t __attribute__((ext_vector_type(4)));
__device__ __forceinline__ void kload8(bf16x8*kf,lds_cptr kp){
  kf[0]=*(const __attribute__((address_space(3))) bf16x8*)(kp);      kf[1]=*(const __attribute__((address_space(3))) bf16x8*)(kp+512);
  kf[2]=*(const __attribute__((address_space(3))) bf16x8*)(kp+2048); kf[3]=*(const __attribute__((address_space(3))) bf16x8*)(kp+2560);
  kf[4]=*(const __attribute__((address_space(3))) bf16x8*)(kp+4096); kf[5]=*(const __attribute__((address_space(3))) bf16x8*)(kp+4608);
  kf[6]=*(const __attribute__((address_space(3))) bf16x8*)(kp+6144); kf[7]=*(const __attribute__((address_space(3))) bf16x8*)(kp+6656);
}
__device__ __forceinline__ void kload2(bf16x8*kf,lds_cptr kp,int j){ kf[2*j]=*(const __attribute__((address_space(3))) bf16x8*)(kp+j*2048); kf[2*j+1]=*(const __attribute__((address_space(3))) bf16x8*)(kp+j*2048+512); }
__device__ __forceinline__ s16x4 vtr(lds_cptr p){ return __builtin_bit_cast(s16x4,__builtin_amdgcn_ds_read_tr16_b64_v4i16((__attribute__((address_space(3))) v4i16_t*)p)); }
__device__ __forceinline__ float rowmax(const f32x16&p0,const f32x16&p1){
  float a=max3f(p0[0],p0[1],p1[0]),b=max3f(p0[2],p0[3],p1[1]);a=max3f(a,p1[2],p1[3]);
  #pragma unroll
  for(int r=4;r<16;r+=4){a=max3f(a,p0[r],p0[r+1]);b=max3f(b,p0[r+2],p0[r+3]);a=max3f(a,p1[r],p1[r+1]);b=max3f(b,p1[r+2],p1[r+3]);}
  const float m=max2f(a,b);
  auto rr=__builtin_amdgcn_permlane32_swap(__float_as_uint(m),__float_as_uint(m),false,false);
  return max2f(__uint_as_float(rr[0]),__uint_as_float(rr[1]));
}
__device__ __forceinline__ void pv(f32x16*o,int vb,bf16x8 pa0,bf16x8 pa1,bf16x8 pa2,bf16x8 pa3){
  #pragma unroll
  for(int d0=0;d0<2;++d0){s16x4 lo[4],hi[4];
    #pragma unroll
    for(int ks=0;ks<4;++ks){
      asm volatile("ds_read_b64_tr_b16 %0,%1 offset:%c2":"=&v"(lo[ks]):"v"(vb),"i"(d0*4096+ks*1024):"memory");
      asm volatile("ds_read_b64_tr_b16 %0,%1 offset:%c2":"=&v"(hi[ks]):"v"(vb),"i"(d0*4096+ks*1024+512):"memory");}
    asm volatile("s_waitcnt lgkmcnt(0)":::"memory");SBAR();
    #define PK(k) (bf16x8){lo[k][0],lo[k][1],lo[k][2],lo[k][3],hi[k][0],hi[k][1],hi[k][2],hi[k][3]}
    o[d0]=__builtin_amdgcn_mfma_f32_32x32x16_bf16(pa0,PK(0),o[d0],0,0,0);
    o[d0]=__builtin_amdgcn_mfma_f32_32x32x16_bf16(pa1,PK(1),o[d0],0,0,0);
    o[d0]=__builtin_amdgcn_mfma_f32_32x32x16_bf16(pa2,PK(2),o[d0],0,0,0);
    o[d0]=__builtin_amdgcn_mfma_f32_32x32x16_bf16(pa3,PK(3),o[d0],0,0,0);
    #undef PK
  }
}

#ifndef ATTN_STORE16
#define ATTN_STORE16(p,v) (*(u32x4*)(p)=(v))
#endif
template<int THRL> __device__ __forceinline__ void attn_unit(int b,int h,int qb,const bf16*Q,const bf16*__restrict__ K,const bf16*__restrict__ V,bf16*O,const float*ksum,char*shm){
  const int tid=threadIdx.x,lane=tid&63,r32=lane&31,hi=lane>>5; const int wid=__builtin_amdgcn_readfirstlane(tid>>6);
  const long rowbase=(long)b*SEQ; const int q0=qb*QB;
  const bf16*Qw=Q+(rowbase+q0+wid*QBLK)*DM+h*D;
  const bf16*Kh=K+rowbase*DM+h*D,*Vh=V+rowbase*DM+h*D;
  const unsigned lds0=(unsigned)(uintptr_t)shm;
  float*wsf=(float*)(shm+LDS_WS)+wid*64;
  const unsigned kdst=lds0+LDS_K+wid*1024, vdst=lds0+LDS_V+wid*1024;
  #define PHYS(t) (((t)<4)?(4*qb+(t)):((t)-4))
  #define DMA_K(t,slot) glds16s((const char*)Kh+(size_t)PHYS(t)*(KVBLK*DM*2)+wid*16,lane_now()*(unsigned)(DM*2),(unsigned)__builtin_amdgcn_readfirstlane(kdst+(slot)))
  #define DMA_V(t,slot) glds16s((const char*)Vh+(size_t)PHYS(t)*(KVBLK*DM*2)+(size_t)(16*(wid&3))*(DM*2)+(wid>>2)*64,({const unsigned l_=lane_now(); (l_>>2)*(unsigned)(DM*2)+(l_&3u)*16u;}),(unsigned)__builtin_amdgcn_readfirstlane(vdst+(slot)))
  const int vb0=(int)(lds0+LDS_V)+((lane>>4)&1)*32+(lane&3)*8+(4*hi+((lane&15)>>2))*64;
  const char*Kbase=shm+LDS_K; bf16x8 kf[8];
  const lds_cptr shm3=(lds_cptr)shm; const lds_cptr kp0=shm3+LDS_K+hi*1024+r32*16; const lds_cptr vp0=shm3+LDS_V+((lane>>4)&1)*32+(lane&3)*8+(4*hi+((lane&15)>>2))*64;
  const int NT=(q0+QB)/KVBLK;
  DMA_K(0,0);DMA_V(0,0);DMA_K(1,SLOTB);
  { float*gt=(float*)(shm+LDS_GT);
    #pragma unroll
    for(int k=0;k<2;++k){ const int j=2*wid+k; if(j<qb) gt[j*64+lane]=ksum[(long)(b*16+j)*DM+h*D+lane]; } }
  bf16x8 qr[4];
  #pragma unroll
  for(int d0=0;d0<4;++d0)qr[d0]=*reinterpret_cast<const bf16x8*>(&Qw[(long)r32*DM+d0*16+hi*8]);

  unsigned sel=0u;
  float mhat=0.f,l_reg=0.f;f32x16 o[2];o[0]=f32x16{};o[1]=f32x16{};
  bf16x8 kone=(bf16x8){0,0,0,0,0,0,0,0}, qm=(bf16x8){0,0,0,0,0,0,0,0}; if(hi==0) kone[0]=(short)0x3F80;
  #define SETQM() do{ const unsigned short mb_=(unsigned short)(cvtpk_s(-mhat,0.f)&0xffffu); qm[0]=(hi==0)?(short)mb_:(short)0; asm volatile("":"+v"(qm)); }while(0)
  const int qrel=wid*QBLK+r32;
  #define CMASK(P0,P1,t) do{ const int t_=(t); if(t_<4){ const int l_=(int)lane_now(); cmask(P0,P1,t_,wid*QBLK+(l_&31),l_>>5); } else if(!((sel>>(((t_-4)>>2)&15))&1u)){ _Pragma("unroll") for(int r=0;r<16;++r){P0[r]=-INFINITY;P1[r]=-INFINITY;} } }while(0)
  bool resc=false;
  #define START(P0,P1) do{ const float rm=rowmax(P0,P1); resc=false; \
    { const float dl=__uint_as_float(cvtpk_s(rm,0.f)<<16); mhat=fadd_s(mhat,dl);          \
      _Pragma("unroll") for(int r=0;r<16;++r){P0[r]=fsub_s(P0[r],dl);P1[r]=fsub_s(P1[r],dl);} \
      SETQM(); } \
    _Pragma("unroll") for(int r=0;r<16;++r)P0[r]=__builtin_amdgcn_exp2f(P0[r]); }while(0)
  #define RESC() do{ if(resc){ asm volatile("s_waitcnt lgkmcnt(0)":::"memory"); \
      _Pragma("unroll") for(int d_=0;d_<2;++d_) _Pragma("unroll") for(int r=0;r<16;++r)o[d_][r]*=wsf[crow(r,(int)(lane_now()>>5))]; } }while(0)
  f32x16 pA0,pA1,pB0,pB1;
  int sl_prev=0,sl_cur=0,sl_next=SLOTB;
  #define ROT() do{sl_prev=sl_cur;sl_cur=sl_next;sl_next=(sl_next==(NSLOT-1)*SLOTB)?0:sl_next+SLOTB;}while(0)
  DMA_K(2,2*SLOTB);
  WAIT_BAR(3);
  { float qf[32];
    #pragma unroll
    for(int d0=0;d0<4;++d0){
      #pragma unroll
      for(int i=0;i<8;++i) qf[d0*8+i]=__uint_as_float(((unsigned)(unsigned short)qr[d0][i])<<16); }
    const float*gt=(const float*)(shm+LDS_GT)+hi*8; float g[15];
    #pragma unroll
    for(int j=0;j<15;++j){ g[j]=-INFINITY;
      if(j<qb){ const float*kp=gt+j*64; float a=0.f;
        #pragma unroll
        for(int d0=0;d0<4;++d0){ const float4 k0=*reinterpret_cast<const float4*>(kp+d0*16), k1=*reinterpret_cast<const float4*>(kp+d0*16+4);
          a+=qf[d0*8+0]*k0.x; a+=qf[d0*8+1]*k0.y; a+=qf[d0*8+2]*k0.z; a+=qf[d0*8+3]*k0.w; a+=qf[d0*8+4]*k1.x; a+=qf[d0*8+5]*k1.y; a+=qf[d0*8+6]*k1.z; a+=qf[d0*8+7]*k1.w; }
        g[j]=a+__shfl_xor(a,32); } }
    #pragma unroll
    for(int kk=0;kk<3;++kk){ float best=-INFINITY; int bj=-1;
      #pragma unroll
      for(int j=0;j<15;++j){ const bool c=(j<qb)&&!((sel>>j)&1u)&&(g[j]>best); best=c?g[j]:best; bj=c?j:bj; }
      if(bj>=0) sel|=(1u<<bj); } }
  qkt(pA0,pA1,Kbase,qr,r32,hi);asm volatile("s_nop 15\n\ts_nop 7":"+v"(pA0),"+v"(pA1));CMASK(pA0,pA1,0);
  START(pA0,pA1);
  _Pragma("unroll") for(int r=0;r<16;++r)pA1[r]=__builtin_amdgcn_exp2f(pA1[r]);
  WAIT_BAR(0);
  DMA_K(3,0);DMA_V(1,SLOTB);
  ROT();
  kload8(kf,kp0+sl_cur);
  WAIT_BAR(2);
  s16x4 vlo[8],vhi[8]; u32x4 pw0,pw1,pw2,pw3;
  #define PKW(P,B) cvtpk_s(P[B],P[B+1])
  #define PAF(k) __builtin_bit_cast(bf16x8,pw##k)
  #define VFR(i) (bf16x8){vlo[i][0],vlo[i][1],vlo[i][2],vlo[i][3],vhi[i][0],vhi[i][1],vhi[i][2],vhi[i][3]}
  #define PIN(x) asm volatile("":"+v"(x))
  #define MX3(a,b,c) __builtin_fmaxf(__builtin_fmaxf((a),(b)),(c))
  #define GAPA(MF,A0,A1,A2,A3,W0,W1,PW) do{ MF; sacc+=A0; sacc+=A1; sacc+=A2; sacc+=A3; PIN(sacc); W0; W1; PIN(PW); SBAR(); }while(0)
  #define EX(v) __builtin_amdgcn_exp2f(v)
  #define GAPB(MF,X,B) do{ MF; X[B]=EX(X[B]); X[B+1]=EX(X[B+1]); X[B+2]=EX(X[B+2]); X[B+3]=EX(X[B+3]); PIN(X); SBAR(); }while(0)
  #define VRD(i) do{ vlo[i]=vtr(vp_+(((i)>>2)*4096+((i)&3)*1024)); vhi[i]=vtr(vp_+(((i)>>2)*4096+((i)&3)*1024+512)); }while(0)
  #define KRD(G,j) do{ if(G){ kload2(kf,kp0+sl_next,j); SBAR(); } }while(0)
  #define STEP(C0,C1,P0,P1,t,GK,GV,GL) do{ SBAR(); \
    const lds_cptr vp_=vp0+sl_prev; \
    C0=__builtin_amdgcn_mfma_f32_32x32x16_bf16(kone,qm,(f32x16){0.f,0.f,0.f,0.f,0.f,0.f,0.f,0.f,0.f,0.f,0.f,0.f,0.f,0.f,0.f,0.f},0,0,0); C1=__builtin_amdgcn_mfma_f32_32x32x16_bf16(kone,qm,(f32x16){0.f,0.f,0.f,0.f,0.f,0.f,0.f,0.f,0.f,0.f,0.f,0.f,0.f,0.f,0.f,0.f},0,0,0); SBAR(); \
    VRD(0); SBAR(); float sacc=(P0[0]+P0[1]); \
    GAPA(C0=__builtin_amdgcn_mfma_f32_32x32x16_bf16(kf[0],qr[0],C0,0,0,0), P0[2],P0[3],P0[4],P0[5],     pw0[0]=PKW(P0,0), pw0[1]=PKW(P0,2), pw0); \
    VRD(4); SBAR(); GAPA(C1=__builtin_amdgcn_mfma_f32_32x32x16_bf16(kf[1],qr[0],C1,0,0,0), P0[6],P0[7],P0[8],P0[9],     pw0[2]=PKW(P0,4), pw0[3]=PKW(P0,6), pw0); \
    VRD(1); SBAR(); GAPA(C0=__builtin_amdgcn_mfma_f32_32x32x16_bf16(kf[2],qr[1],C0,0,0,0),   P0[10],P0[11],P0[12],P0[13], pw1[0]=PKW(P0,8), pw1[1]=PKW(P0,10), pw1); \
    VRD(5); SBAR(); GAPA(C1=__builtin_amdgcn_mfma_f32_32x32x16_bf16(kf[3],qr[1],C1,0,0,0),   P0[14],P0[15],P1[0],P1[1],   pw1[2]=PKW(P0,12),pw1[3]=PKW(P0,14), pw1); \
    VRD(2); SBAR(); GAPA(C0=__builtin_amdgcn_mfma_f32_32x32x16_bf16(kf[4],qr[2],C0,0,0,0),   P1[2],P1[3],P1[4],P1[5],     pw2[0]=PKW(P1,0), pw2[1]=PKW(P1,2), pw2); \
    VRD(6); SBAR(); GAPA(C1=__builtin_amdgcn_mfma_f32_32x32x16_bf16(kf[5],qr[2],C1,0,0,0),   P1[6],P1[7],P1[8],P1[9],     pw2[2]=PKW(P1,4), pw2[3]=PKW(P1,6), pw2); \
    VRD(3); SBAR(); GAPA(C0=__builtin_amdgcn_mfma_f32_32x32x16_bf16(kf[6],qr[3],C0,0,0,0),   P1[10],P1[11],P1[12],P1[13], pw3[0]=PKW(P1,8), pw3[1]=PKW(P1,10), pw3); \
    VRD(7); SBAR(); GAPA(C1=__builtin_amdgcn_mfma_f32_32x32x16_bf16(kf[7],qr[3],C1,0,0,0),   P1[14],P1[15],0.f,0.f,       pw3[2]=PKW(P1,12),pw3[3]=PKW(P1,14), pw3); \
    l_reg+=sacc; \
    if(GK){DMA_K((t)+3,sl_cur);} if(GV){DMA_V((t)+1,sl_next);} \
    CMASK(C0,C1,t); \
    { float a=MX3(C0[0],C0[1],C1[0]),b=MX3(C0[2],C0[3],C1[1]); a=MX3(a,C1[2],C1[3]); \
      _Pragma("unroll") for(int r=4;r<16;r+=4){a=MX3(a,C0[r],C0[r+1]);b=MX3(b,C0[r+2],C0[r+3]);a=MX3(a,C1[r],C1[r+1]);b=MX3(b,C1[r+2],C1[r+3]);} \
      float rm=__builtin_fmaxf(a,b); { auto rr=__builtin_amdgcn_permlane32_swap(__float_as_uint(rm),__float_as_uint(rm),false,false); rm=__builtin_fmaxf(__uint_as_float(rr[0]),__uint_as_float(rr[1])); } \
      resc=false; \
      if(__builtin_expect(__any(rm>(float)THRL),0)){ const float mn_=__uint_as_float(cvtpk_s(mhat+__builtin_fmaxf(rm,0.f),0.f)<<16); const float dl=mn_-mhat; mhat=mn_; \
        _Pragma("unroll") for(int r=0;r<16;++r){C0[r]-=dl;C1[r]-=dl;} \
        SETQM(); \
        const float f=__builtin_amdgcn_exp2f(-dl); l_reg*=f; { const int l_=(int)lane_now(); if((l_>>5)==0)wsf[l_&31]=f; } resc=true; } } \
    SBAR(); \
    GAPB(o[0]=__builtin_amdgcn_mfma_f32_32x32x16_bf16(PAF(0),VFR(0),o[0],0,0,0), C0,0); \
    GAPB(o[1]=__builtin_amdgcn_mfma_f32_32x32x16_bf16(PAF(0),VFR(4),o[1],0,0,0), C0,4); \
    KRD(GL,0); GAPB(o[0]=__builtin_amdgcn_mfma_f32_32x32x16_bf16(PAF(1),VFR(1),o[0],0,0,0), C0,8); \
    KRD(GL,1); GAPB(o[1]=__builtin_amdgcn_mfma_f32_32x32x16_bf16(PAF(1),VFR(5),o[1],0,0,0), C0,12); \
    KRD(GL,2); GAPB(o[0]=__builtin_amdgcn_mfma_f32_32x32x16_bf16(PAF(2),VFR(2),o[0],0,0,0), C1,0); \
    KRD(GL,3); GAPB(o[1]=__builtin_amdgcn_mfma_f32_32x32x16_bf16(PAF(2),VFR(6),o[1],0,0,0), C1,4); \
    GAPB(o[0]=__builtin_amdgcn_mfma_f32_32x32x16_bf16(PAF(3),VFR(3),o[0],0,0,0), C1,8); \
    GAPB(o[1]=__builtin_amdgcn_mfma_f32_32x32x16_bf16(PAF(3),VFR(7),o[1],0,0,0), C1,12); \
    }while(0)
  int t=1;
  #undef CMASK
  #define CMASK(P0,P1,t) do{ const int t_=(t); if(t_<4){ const int l_=(int)lane_now(); cmask(P0,P1,t_,wid*QBLK+(l_&31),l_>>5); } else if(!((sel>>(((t_-4)>>2)&15))&1u)){ _Pragma("unroll") for(int r=0;r<16;++r){P0[r]=-INFINITY;P1[r]=-INFINITY;} } }while(0)
  for(;t+5<NT;t+=2){
    STEP(pB0,pB1,pA0,pA1,t,true,true,true);     WAIT_BAR(2); RESC(); ROT();
    STEP(pA0,pA1,pB0,pB1,t+1,true,true,true);   WAIT_BAR(2); RESC(); ROT();
  }
  #undef CMASK
  #define CMASK(P0,P1,t) do{ const int t_=(t); if(t_<4){ const int l_=(int)lane_now(); cmask(P0,P1,t_,wid*QBLK+(l_&31),l_>>5); } else if(!((sel>>(((t_-4)>>2)&15))&1u)){ _Pragma("unroll") for(int r=0;r<16;++r){P0[r]=-INFINITY;P1[r]=-INFINITY;} } }while(0)
  #define ENDW(tt) do{ if((tt)+3<NT){WAIT_BAR(2);} else if((tt)+2<NT){WAIT_BAR(1);} else {WAIT_BAR(0);} }while(0)
  for(;t+1<NT;t+=2){
    STEP(pB0,pB1,pA0,pA1,t,(t+3<NT),(t+1<NT),(t+1<NT));       ENDW(t);   RESC(); ROT();
    STEP(pA0,pA1,pB0,pB1,t+1,(t+4<NT),(t+2<NT),(t+2<NT));     ENDW(t+1); RESC(); ROT();
  }
  STEP(pB0,pB1,pA0,pA1,NT-1,false,false,false); RESC();
  { float sacc=pB0[0]+pB0[1]; _Pragma("unroll") for(int r=2;r<16;++r)sacc+=pB0[r]; _Pragma("unroll") for(int r=0;r<16;++r)sacc+=pB1[r]; l_reg+=sacc;
    pw0=(u32x4){PKW(pB0,0),PKW(pB0,2),PKW(pB0,4),PKW(pB0,6)};pw1=(u32x4){PKW(pB0,8),PKW(pB0,10),PKW(pB0,12),PKW(pB0,14)};pw2=(u32x4){PKW(pB1,0),PKW(pB1,2),PKW(pB1,4),PKW(pB1,6)};pw3=(u32x4){PKW(pB1,8),PKW(pB1,10),PKW(pB1,12),PKW(pB1,14)};
    SBAR(); pv(o,vb0+sl_cur,PAF(0),PAF(1),PAF(2),PAF(3)); }
  #undef PKW
  #undef PAF
  #undef VFR
  #undef PIN
  #undef MX3
  #undef GAPA
  #undef GAPB
  #undef EX
  #undef VRD
  #undef KRD
  #undef STEP
  #undef ENDW
  {auto rr=__builtin_amdgcn_permlane32_swap(__float_as_uint(l_reg),__float_as_uint(l_reg),false,false);l_reg=__uint_as_float(rr[0])+__uint_as_float(rr[1]);}
  if(hi==0)wsf[32+r32]=l_reg;asm volatile("s_waitcnt lgkmcnt(0)":::"memory");
  float rli[16];
  #pragma unroll
  for(int r=0;r<16;++r)rli[r]=__builtin_amdgcn_rcpf(wsf[32+crow(r,hi)]);
  bf16*Ow=O+(rowbase+q0+wid*QBLK)*DM+h*D;
  { bf16*stg=(bf16*)(shm+LDS_OST)+wid*2048;
    #pragma unroll
    for(int r=0;r<16;++r){const int orow=crow(r,hi);
      #pragma unroll
      for(int d0=0;d0<2;++d0)stg[orow*64+d0*32+r32]=__float2bfloat16(o[d0][r]*rli[r]);}
    asm volatile("s_waitcnt lgkmcnt(0)":::"memory");
    #pragma unroll
    for(int i=0;i<4;++i){const int row=i*8+(lane>>3),ch=lane&7; const u32x4 v=*(const u32x4*)(stg+row*64+ch*8); ATTN_STORE16(Ow+(long)row*DM+ch*8,v);} }
  asm volatile("s_waitcnt lgkmcnt(0)\n\ts_barrier":::"memory");
  #undef DMA_K
  #undef PHYS
  #undef DMA_V
  #undef CMASK
  #undef START
  #undef SETQM
  #undef RESC
  #undef ROT
}
constexpr int ATTN_LDS_BYTES=LDS_BYTES;
struct AttnTensors { const bf16* Q; const bf16* K; const bf16* V; bf16* O; const float* ksum; };
struct AttnUnit { int bh; int qb; };
struct StaticOrder {
  int vcu, G;
  __device__ __forceinline__ explicit StaticOrder(int grid,int block):vcu((grid%8==0)?((block%8)*(grid/8)+block/8):block),G(grid){}
  __device__ __forceinline__ bool next(int i,AttnUnit&u)const{ const int L=i*G+vcu; if(L>=1024)return false; const int w=L&255, rnd=L>>8, s=w&3; u.bh=w>>2; u.qb=(rnd==0)?s:(rnd==1)?7-s:(rnd==2)?8+s:15-s; return true; }
  __device__ __forceinline__ void a_ready(const AttnUnit&)const{}
  __device__ __forceinline__ void done(const AttnUnit&)const{}
};
struct SnakeOrder {
  int v, G;
  __device__ __forceinline__ bool next(int i,AttnUnit&u)const{ const int idx=i*G+((i&1)?(G-1-v):v); if(idx>=1024)return false; u.qb=15-(idx>>6); u.bh=idx&63; return true; }
  __device__ __forceinline__ void a_ready(const AttnUnit&)const{}
  __device__ __forceinline__ void done(const AttnUnit&)const{}
};
template<class Sched,int THRL=8> __device__ __forceinline__ void attn_phase(char*lds,const AttnTensors&T,const Sched&S){
  AttnUnit u;
  for(int i=0;S.next(i,u);++i){ S.a_ready(u); attn_unit<THRL>(u.bh/NHEAD,u.bh%NHEAD,u.qb,T.Q,T.K,T.V,T.O,T.ksum,lds); S.done(u); }
}
#undef SBAR
#undef WAIT_BAR
}
constexpr int NWAVES = 8, NTHR = 512;
constexpr int NTOK = 16384, DM = 1024, SEQ = 4096, NBATCH = 4, NEXP = 32;
constexpr float ALPHA = 1.4142135623730951f;
constexpr float LN_EPS = 1e-5f;
constexpr float RSQRT_DQK = 0.08838834764831845f;
constexpr int NPHASE = 19;
constexpr float FP8_SA = 4.0f, FP8_SWGU = 64.0f, FP8_SWD = 128.0f;
constexpr float FP8_SY = 32.0f, FP8_MAXV = 448.0f;
#ifndef DBG_ATTN_MUL
#define DBG_ATTN_MUL 1.0f
#endif
#ifndef DBG_MLSTM_MUL
#define DBG_MLSTM_MUL 1.0f
#endif
#ifndef DBG_MOE_MUL
#define DBG_MOE_MUL 1.0f
#endif
#ifndef DBG_P14_A
#define DBG_P14_A WS_HN
#endif
#ifndef NCONV
#define NCONV 80
#endif
#ifndef MK_ONE_LAUNCH
#define MK_ONE_LAUNCH 1
#endif

constexpr size_t MiB = 1u << 20, KiB = 1024;
constexpr size_t WS_CTL = 0, CTL_ZERO_BYTES = 1 * MiB;
constexpr int CW_TMO = 0, CW_BAR = 4096, CW_CNT = 8192, CW_AQ = 16384;
constexpr size_t WS_KSUM = 256 * KiB, WS_DEN = 512 * KiB;
constexpr size_t WS_WQKV = 2 * MiB, WS_WO = 8 * MiB, WS_WINA = 10 * MiB, WS_WINB = 14 * MiB, WS_WOUT = 17 * MiB;
constexpr size_t WS_WG = 19 * MiB, WS_RWT = 20 * MiB, WS_ROPE = 21 * MiB;
constexpr size_t WS_TOKE = 22 * MiB, WS_TOKP = 22 * MiB + 256 * KiB, WS_TOKG = 22 * MiB + 512 * KiB;
constexpr size_t WS_GI = 23 * MiB, WS_LF = 23 * MiB + 256 * KiB, WS_RF = 23 * MiB + 512 * KiB, WS_CF = 23 * MiB + 768 * KiB;
constexpr size_t WS_DEC = 24 * MiB, WS_NU = 24 * MiB + 256 * KiB, WS_NPREV = 24 * MiB + 512 * KiB;
constexpr size_t WS_ROWTOK = 25 * MiB;
constexpr size_t WS_XB = 32 * MiB, WS_Q = 64 * MiB, WS_K = 96 * MiB, WS_V = 128 * MiB;
constexpr size_t WS_R0 = 160 * MiB, WS_R1 = 224 * MiB, WS_R2 = 288 * MiB;
constexpr size_t WS_H = 352 * MiB, WS_Y = 496 * MiB;
constexpr size_t WS_WGU = 640 * MiB, WS_WD = 896 * MiB, WS_END = 1024 * MiB;
constexpr size_t WS_AE = 352 * MiB, WS_BE = 416 * MiB, WS_KN = 464 * MiB, WS_KT = 496 * MiB, WS_UT = 512 * MiB, WS_OS = 544 * MiB, WS_HN = 576 * MiB;

constexpr int RING_OFF = 0, RING_BYTES = 131072;
constexpr int LX = RING_BYTES;
constexpr int LX_MISC = LX;
constexpr int LX_TILEE = LX + 128;
constexpr int LX_TBASE = LX + 1280;
constexpr int LX_LCNT = LX + 1536, LX_GBASE = LX + 1664;
constexpr int LX_REC = LX + 1792;
constexpr int LX_TOKL = LX + 4096;
constexpr int LX_LNX = LX + 4096;
constexpr int LX_BIAS = LX + 12288;
constexpr int LX_ROPE = LX + 16384;
constexpr int LDS_BYTES = 163840;
constexpr int TOKL_ROUNDS = 10;

#define RLX_AGENT __ATOMIC_RELAXED, __HIP_MEMORY_SCOPE_AGENT
#define LDS_WAIT() asm volatile("s_waitcnt lgkmcnt(0)" ::: "memory")
#define VM_WAIT() asm volatile("s_waitcnt vmcnt(0)" ::: "memory")
#define XB_TMO      128
#define XB_XCNT(j)  (256  + 64 * (j))
#define XB_XSUB(j)  (1280 + 64 * (j))
#define XB_XGEN(j)  (2304 + 64 * (j))
#define XB_TOP      3328
#define XB_TOPGEN   3392
#define XCD_BAR_WORDS 3456
#define XB_SPIN_CAP (1u << 18)

__device__ __forceinline__ unsigned xb_ld(unsigned* p)              { return __hip_atomic_load(p, __ATOMIC_RELAXED, __HIP_MEMORY_SCOPE_AGENT); }
__device__ __forceinline__ unsigned xb_add(unsigned* p, unsigned v) { return __hip_atomic_fetch_add(p, v, __ATOMIC_RELAXED, __HIP_MEMORY_SCOPE_AGENT); }
__device__ __forceinline__ unsigned xb_xcc_id() { return (unsigned)__builtin_amdgcn_s_getreg((3 << 11) | 20) & 0xFu; }
#define XB_SPIN(cond, bar) do { unsigned _sp = 0; while (cond) { __builtin_amdgcn_s_sleep(1); \
    if ((++_sp & 255u) == 0u) { if (xb_ld(&(bar)[XB_TMO])) break; if (_sp > XB_SPIN_CAP) { atomicAdd(&(bar)[XB_TMO], 1u); break; } } } } while (0)

struct XcdBarrier {
    unsigned* bar; unsigned x;
    volatile LAS unsigned* st;
};

__device__ __forceinline__ XcdBarrier xcd_barrier_post(unsigned* bar, volatile LAS unsigned* st) {
    XcdBarrier b; b.bar = bar; b.x = xb_xcc_id(); b.st = st;
    if (threadIdx.x == 0) (void)xb_add(&bar[XB_XCNT(b.x)], 1u);
    return b;
}
__device__ __forceinline__ void xcd_barrier_complete(unsigned* bar, unsigned x, unsigned& nloc, unsigned& nx) {
    const unsigned G = gridDim.x * gridDim.y * gridDim.z;
    unsigned sum, cnt, mine, sp = 0u;
    for (;;) {
        sum = 0u; cnt = 0u; mine = 0u;
#pragma unroll
        for (unsigned j = 0; j < 16; ++j) { const unsigned c = xb_ld(&bar[XB_XCNT(j)]); sum += c; cnt += (c > 0u) ? 1u : 0u; mine = (j == x) ? c : mine; }
        if (sum == G) break;
        __builtin_amdgcn_s_sleep(1);
        if ((++sp & 255u) == 0u) { if (xb_ld(&bar[XB_TMO])) break; if (sp > XB_SPIN_CAP) { atomicAdd(&bar[XB_TMO], 1u); break; } }
    }
    nloc = mine > 0u ? mine : 1u; nx = cnt > 0u ? cnt : 1u;
}

__device__ __forceinline__ void xcd_barrier(const XcdBarrier& b) {
    asm volatile("s_waitcnt vmcnt(0)" ::: "memory");
    __syncthreads();
    if (threadIdx.x == 0) {
        unsigned* bar = b.bar;
        __builtin_amdgcn_s_waitcnt(0);
        unsigned nloc = b.st[0], nx = b.st[1];
        if (nloc == 0u) { xcd_barrier_complete(bar, b.x, nloc, nx); b.st[0] = nloc; b.st[1] = nx; }
        const unsigned old = xb_add(&bar[XB_XSUB(b.x)], 1u);
        const unsigned gen = old / nloc;
        if (old + 1u == (gen + 1u) * nloc) {
            __builtin_amdgcn_fence(__ATOMIC_RELEASE, "agent");
            asm volatile("s_waitcnt vmcnt(0)" ::: "memory");
            const unsigned og = xb_add(&bar[XB_TOP], 1u);
            const unsigned tg = og / nx;
            if (og + 1u == (tg + 1u) * nx) xb_add(&bar[XB_TOPGEN], 1u);
            else XB_SPIN(xb_ld(&bar[XB_TOPGEN]) == tg, bar);
            __builtin_amdgcn_fence(__ATOMIC_ACQUIRE, "agent");
            xb_add(&bar[XB_XGEN(b.x)], 1u);
            asm volatile("s_waitcnt vmcnt(0)" ::: "memory");
        } else {
            XB_SPIN(xb_ld(&bar[XB_XGEN(b.x)]) == gen, bar);
            __builtin_amdgcn_fence(__ATOMIC_ACQUIRE, "agent");
            asm volatile("s_waitcnt vmcnt(0)" ::: "memory");
        }
    }
    __syncthreads();
}
using pg8::Unit; using pg8::Gemm;
typedef f32x4 (&AccRef)[2][2][4][2];

#ifndef TAIL_FIRST
#define TAIL_FIRST 0
#endif
__device__ __forceinline__ bool moe_unit(int i, int G, int c, int nT, int nN, int& pm, int& pn, int& half) {
    const int U = nT * nN, R = U / G, rem = U - R * G; half = 0;
#if TAIL_FIRST
    if (rem > 0 && 2 * rem <= G) {
        if (c < 2 * rem) { if (i == 0) { half = 1 + (c & 1); return pg8::tile_order(0, U, R * G + (c >> 1), nT, nN, pm, pn); } --i; }
        if (i < R) return pg8::tile_order(i, G, c, nT, nN, pm, pn);
        return false; }
#endif
    if (i < R) return pg8::tile_order(i, G, c, nT, nN, pm, pn);
    if (i > R || rem == 0) return false;
    if (2 * rem <= G) { if (c >= 2 * rem) return false; half = 1 + (c & 1); return pg8::tile_order(0, U, R * G + (c >> 1), nT, nN, pm, pn); }
    return pg8::tile_order(i, G, c, nT, nN, pm, pn);
}
struct DenseSched {
    int nM, nN, G, c; const char* A; const char* B; size_t tstepA, tstepB; bool split = false;
    __device__ __forceinline__ bool next(int i, Unit& u) const {
        int half = 0;
        if (split) { if (!moe_unit(i, G, c, nM, nN, u.pm, u.pn, half)) return false; }
        else if (!pg8::tile_order(i, G, c, nM, nN, u.pm, u.pn)) return false;
        u.A = A + (size_t)u.pm * tstepA; u.B = B + (size_t)u.pn * tstepB; u.tl = nullptr; u.x0 = u.x1 = 0; u.x2 = half; return true; }
};
struct MoeSched {
    int nT, nN, G, c; const LAS int* tile_e; const LAS int* tbase; const LAS unsigned short* tokl;
    const char* A; const char* B; size_t tstepA, estepB, tstepB;
    __device__ __forceinline__ bool next(int i, Unit& u) const {
        int half; if (!moe_unit(i, G, c, nT, nN, u.pm, u.pn, half)) return false;
        const int e = tile_e[u.pm];
        u.x0 = e; u.x1 = u.pm * 256; u.x2 = half;
        u.A = A + (size_t)u.pm * tstepA; u.B = B + (size_t)e * estepB + (size_t)u.pn * tstepB;
        u.tl = tokl ? tokl + (i < TOKL_ROUNDS ? i : TOKL_ROUNDS - 1) * 256 : nullptr; return true; }
};
struct MuSched {
    int G, c, mode; const char* A; const char* B;
    __device__ __forceinline__ bool next(int i, Unit& u) const {
        const int mu = i * G + c; if (mu >= 256) return false;
        const int b = mu >> 6, hh = (mu >> 4) & 3, ch = mu & 15; const size_t tok0 = (size_t)b * SEQ + (size_t)ch * 256;
        u.pm = mu; u.pn = 0; u.x0 = mu; u.x1 = 0; u.x2 = (mode == 0) ? 1 : 0; u.tl = nullptr;
        if (mode == 0) { u.A = A + (size_t)mu * 256 * 384 * 2; u.B = B + ((size_t)(hh * 128) * NTOK + tok0) * 2; }
        else if (mode == 1) { u.A = A + ((size_t)mu * 256 * 512 + 256) * 2; u.B = B + (tok0 * 1024 + (size_t)hh * 256) * 2; }
        else { u.A = A + (size_t)mu * 256 * 512 * 2; u.B = B + (size_t)mu * 256 * 384 * 2; }
        return true; }
};

constexpr float C2 = 0.125f * 1.4426950408889634f;

struct EpiQKV {
    static constexpr bool PERM = true; static constexpr bool MID = true;
    __device__ __forceinline__ void prep(const Unit&, int, int, int) const {}
    __device__ __forceinline__ void prep_mid(const Unit& u, int wid, int lane) const { if ((u.pn >> 2) < 2) {
#pragma unroll
        for (int i = 0; i < 2; ++i) { const int row = (wid * 2 + i) * 16 + (lane >> 2), c = (lane & 3) ^ ((row >> 1) & 3);
            glds16s(uni_ptr((const char*)(rope + (size_t)u.pm * 256 * 16)), (unsigned)(row * 64 + c * 16), (unsigned)__builtin_amdgcn_readfirstlane((unsigned)(unsigned long long)ropel + (unsigned)((wid * 2 + i) * 1024))); } } }
    bf16_t* Q; bf16_t* K; bf16_t* V; const float* rope; float* ksum; LAS float* ropel;
    __device__ __forceinline__ void operator()(AccRef acc, const Unit& u, int wr, int wc, int fr, int fq) const {
        asm volatile("" : "+v"(fr), "+v"(fq));
        const int part = u.pn >> 2, colt = (u.pn & 3) * 256;
        bf16_t* base = Q + (size_t)part * ((WS_K - WS_Q) / 2);
        const bool rot = (part < 2) && ((wc & 1) == 0);
        float ks[2][8];
#pragma unroll
        for (int bj = 0; bj < 2; ++bj)
#pragma unroll
            for (int j = 0; j < 8; ++j) ks[bj][j] = 0.f;
#pragma unroll
        for (int ai = 0; ai < 2; ++ai)
#pragma unroll
            for (int m = 0; m < 4; ++m) {
                const int row = u.pm * 256 + ai * 128 + wr * 64 + m * 16 + fr;
                f32x4 cs = {1.f, 1.f, 1.f, 1.f}, sn = {0.f, 0.f, 0.f, 0.f};
                if (rot && fq < 2) { const int rl = ai * 128 + wr * 64 + m * 16 + fr, sw = (rl >> 1) & 3; const LAS f32x4* rp = (const LAS f32x4*)(ropel + rl * 16);
                    cs = rp[fq ^ sw]; sn = rp[(2 + fq) ^ sw]; }
#pragma unroll
                for (int bj = 0; bj < 2; ++bj) {
                    f32x4 v0 = acc[ai][bj][m][0], v1 = acc[ai][bj][m][1];
                    if (rot) { const f32x4 lo = v0 * cs - v1 * sn, hi = v1 * cs + v0 * sn; v0 = lo; v1 = hi; }
                    if (part == 0) { v0 = v0 * C2; v1 = v1 * C2; }
                    if (part == 1) {
#pragma unroll
                        for (int j = 0; j < 4; ++j) { ks[bj][j] += v0[j]; ks[bj][4 + j] += v1[j]; } }
                    u32x4 w; w.x = cvt_pk_bf16(v0[0], v0[1]); w.y = cvt_pk_bf16(v0[2], v0[3]); w.z = cvt_pk_bf16(v1[0], v1[1]); w.w = cvt_pk_bf16(v1[2], v1[3]);
                    *(u32x4*)(base + (size_t)row * DM + colt + bj * 128 + wc * 32 + fq * 8) = w;
                }
            }
        if (part == 1) {
#pragma unroll
            for (int bj = 0; bj < 2; ++bj)
#pragma unroll
                for (int j = 0; j < 8; ++j) { float s = ks[bj][j]; s += __shfl_xor(s, 1); s += __shfl_xor(s, 2); s += __shfl_xor(s, 4); s += __shfl_xor(s, 8);
                    if (fr == 0) atomicAdd(ksum + (size_t)u.pm * DM + colt + bj * 128 + wc * 32 + fq * 8 + j, s); }
        }
    }
};

struct EpiZ {
    static constexpr bool PERM = true; static constexpr bool MID = false;
    __device__ __forceinline__ void prep(const Unit&, int, int, int) const {}
    const bf16_t* xin; bf16_t* z; float ymul;
    __device__ __forceinline__ void operator()(AccRef acc, const Unit& u, int wr, int wc, int fr, int fq) const {
        asm volatile("" : "+v"(fr), "+v"(fq));
        const size_t off0 = (size_t)(u.pm * 256 + wr * 64 + fr) * DM + u.pn * 256 + wc * 32 + fq * 8;
        u32x4 xr[2][4][2];
#pragma unroll
        for (int ai = 0; ai < 2; ++ai)
#pragma unroll
            for (int m = 0; m < 4; ++m)
#pragma unroll
                for (int bj = 0; bj < 2; ++bj) xr[ai][m][bj] = *(const u32x4*)(xin + off0 + (size_t)(ai * 128 + m * 16) * DM + bj * 128);
        asm volatile("" ::: "memory");
#pragma unroll
        for (int ai = 0; ai < 2; ++ai)
#pragma unroll
            for (int m = 0; m < 4; ++m)
#pragma unroll
                for (int bj = 0; bj < 2; ++bj) { const u32x4 x = xr[ai][m][bj]; const f32x4 a0 = acc[ai][bj][m][0] * ymul, a1 = acc[ai][bj][m][1] * ymul;
                    u32x4 w; w.x = cvt_pk_bf16(bflo(x.x) * ALPHA + a0[0], bfhi(x.x) * ALPHA + a0[1]); w.y = cvt_pk_bf16(bflo(x.y) * ALPHA + a0[2], bfhi(x.y) * ALPHA + a0[3]);
                    w.z = cvt_pk_bf16(bflo(x.z) * ALPHA + a1[0], bfhi(x.z) * ALPHA + a1[1]); w.w = cvt_pk_bf16(bflo(x.w) * ALPHA + a1[2], bfhi(x.w) * ALPHA + a1[3]);
                    *(u32x4*)(z + off0 + (size_t)(ai * 128 + m * 16) * DM + bj * 128) = w; }
    }
};

__device__ __forceinline__ float swiglu1(float glu, float lin) {
    const float g = fminf(glu, 7.0f), l = fminf(fmaxf(lin, -7.0f), 7.0f);
    const float sg = __builtin_amdgcn_rcpf(1.0f + __builtin_amdgcn_exp2f(-1.702f * 1.4426950408889634f * g));
    return g * sg * (l + 1.0f);
}
__device__ __forceinline__ f32x2 swiglu2(float glu0, float lin0, float glu1, float lin1) {
    const f32x2 g = {fminf(glu0, 7.0f), fminf(glu1, 7.0f)}, l = {fminf(fmaxf(lin0, -7.0f), 7.0f), fminf(fmaxf(lin1, -7.0f), 7.0f)};
    const f32x2 t = g * (f32x2){-1.702f * 1.4426950408889634f, -1.702f * 1.4426950408889634f};
    const f32x2 d = (f32x2){__builtin_amdgcn_exp2f(t[0]), __builtin_amdgcn_exp2f(t[1])} + (f32x2){1.0f, 1.0f};
    const f32x2 r = {__builtin_amdgcn_rcpf(d[0]), __builtin_amdgcn_rcpf(d[1])};
    const f32x2 lp = l * (f32x2){FP8_SA, FP8_SA} + (f32x2){FP8_SA, FP8_SA};
    return (g * lp) * r;
}
struct EpiGU {
    static constexpr bool PERM = true; static constexpr bool MID = false;
    __device__ __forceinline__ void prep(const Unit& u, int ui, int wid, int lane) const { if (wid < 4) glds4s(uni_ptr((const char*)(bias + (size_t)u.x0 * 2048 + u.pn * 256 + wid * 64)), (unsigned)lane * 4u, (unsigned)__builtin_amdgcn_readfirstlane((unsigned)(unsigned long long)bl + (unsigned)(((ui & 1) * 256 + wid * 64) * 4))); }
    const float* bias; unsigned char* H; LAS float* bl; mutable int ucnt;
    __device__ __forceinline__ void operator()(AccRef acc, const Unit& u, int wr, int wc, int fr, int fq) const {
        asm volatile("" : "+v"(fr), "+v"(fq));
        const int c0 = u.pn * 256 + wc * 32 + fq * 8; const LAS float* bp = bl + (ucnt & 1) * 256 + wc * 32 + fq * 8; ++ucnt; constexpr float SC = 1.0f / (FP8_SA * FP8_SWGU);
        f32x4 b[2][2];
#pragma unroll
        for (int bj = 0; bj < 2; ++bj) { b[bj][0] = *(const LAS f32x4*)(bp + bj * 128); b[bj][1] = *(const LAS f32x4*)(bp + bj * 128 + 4); }
#pragma unroll
        for (int ai = 0; ai < 2; ++ai)
#pragma unroll
            for (int m = 0; m < 4; ++m) {
                unsigned char* rowp = H + (size_t)(u.x1 + ai * 128 + wr * 64 + m * 16 + fr) * DM + (c0 >> 1);
#pragma unroll
                for (int bj = 0; bj < 2; ++bj) { if (u.x2 == 2 - bj) continue;
                    const f32x4 v0 = acc[ai][bj][m][0] * SC + b[bj][0], v1 = acc[ai][bj][m][1] * SC + b[bj][1];
                    const f32x2 h0 = swiglu2(v0[0], v0[1], v0[2], v0[3]), h1 = swiglu2(v1[0], v1[1], v1[2], v1[3]);
                    int w = __builtin_amdgcn_cvt_pk_fp8_f32(h0[0], h0[1], 0, false);
                    w = __builtin_amdgcn_cvt_pk_fp8_f32(h1[0], h1[1], w, true);
                    *(int*)(rowp + bj * 64) = w; }
            }
    }
};
struct EpiDN {
    static constexpr bool PERM = true; static constexpr bool MID = false;
    __device__ __forceinline__ void prep(const Unit& u, int ui, int wid, int lane) const { if (wid < 4) glds4s(uni_ptr((const char*)(bias + (size_t)u.x0 * 1024 + u.pn * 256 + wid * 64)), (unsigned)lane * 4u, (unsigned)__builtin_amdgcn_readfirstlane((unsigned)(unsigned long long)bl + (unsigned)(((ui & 1) * 256 + wid * 64) * 4))); }
    const float* bias; unsigned char* Y; LAS float* bl; mutable int ucnt;
    __device__ __forceinline__ void operator()(AccRef acc, const Unit& u, int wr, int wc, int fr, int fq) const {
        asm volatile("" : "+v"(fr), "+v"(fq));
        const int c0 = u.pn * 256 + wc * 32 + fq * 8; const LAS float* bp = bl + (ucnt & 1) * 256 + wc * 32 + fq * 8; ++ucnt; constexpr float SC = FP8_SY / (FP8_SA * FP8_SWD);
        f32x4 b[2][2];
#pragma unroll
        for (int bj = 0; bj < 2; ++bj) { b[bj][0] = *(const LAS f32x4*)(bp + bj * 128) * FP8_SY; b[bj][1] = *(const LAS f32x4*)(bp + bj * 128 + 4) * FP8_SY; }
#pragma unroll
        for (int ai = 0; ai < 2; ++ai)
#pragma unroll
            for (int m = 0; m < 4; ++m) {
                unsigned char* rowp = Y + (size_t)(u.x1 + ai * 128 + wr * 64 + m * 16 + fr) * DM + c0;
#pragma unroll
                for (int bj = 0; bj < 2; ++bj) { if (u.x2 == 2 - bj) continue;
                    f32x4 v0 = acc[ai][bj][m][0] * SC + b[bj][0], v1 = acc[ai][bj][m][1] * SC + b[bj][1];
#pragma unroll
                    for (int q = 0; q < 4; ++q) { v0[q] = __builtin_amdgcn_fmed3f(v0[q], -FP8_MAXV, FP8_MAXV); v1[q] = __builtin_amdgcn_fmed3f(v1[q], -FP8_MAXV, FP8_MAXV); }
                    int w0 = __builtin_amdgcn_cvt_pk_fp8_f32(v0[0], v0[1], 0, false); w0 = __builtin_amdgcn_cvt_pk_fp8_f32(v0[2], v0[3], w0, true);
                    int w1 = __builtin_amdgcn_cvt_pk_fp8_f32(v1[0], v1[1], 0, false); w1 = __builtin_amdgcn_cvt_pk_fp8_f32(v1[2], v1[3], w1, true);
                    u32x2 w; w.x = (unsigned)w0; w.y = (unsigned)w1;
                    *(u32x2*)(rowp + bj * 128) = w; }
            }
    }
};

struct EpiINA {
    static constexpr bool PERM = true; static constexpr bool MID = false;
    __device__ __forceinline__ void prep(const Unit&, int, int, int) const {}
    const float* rf; const float* cf; bf16_t* AE; bf16_t* KN; bf16_t* OS;
    __device__ __forceinline__ void operator()(AccRef acc, const Unit& u, int wr, int wc, int fr, int fq) const {
        asm volatile("" : "+v"(fr), "+v"(fq));
        const int b = u.pm >> 4, ch = u.pm & 15, d0 = wc * 32 + fq * 8; const u32x4 zero = {0u, 0u, 0u, 0u};
        if (u.pn < 4) {
            const bool isq = u.pn < 2; const float* fac = isq ? rf : cf; const float fs = isq ? 1.0f : RSQRT_DQK; const int h0 = (u.pn & 1) * 2;
            float sf[2][4][2];
#pragma unroll
            for (int ai = 0; ai < 2; ++ai)
#pragma unroll
                for (int m = 0; m < 4; ++m)
#pragma unroll
                    for (int bj = 0; bj < 2; ++bj) sf[ai][m][bj] = fac[(size_t)(h0 + bj) * NTOK + (size_t)u.pm * 256 + ai * 128 + wr * 64 + m * 16 + fr];
#pragma unroll
            for (int ai = 0; ai < 2; ++ai)
#pragma unroll
                for (int m = 0; m < 4; ++m) {
                    const int t = ai * 128 + wr * 64 + m * 16 + fr; const size_t token = (size_t)u.pm * 256 + t;
#pragma unroll
                    for (int bj = 0; bj < 2; ++bj) { const int hh = h0 + bj; const float s = sf[ai][m][bj] * fs;
                        const f32x4 v0 = acc[ai][bj][m][0] * s, v1 = acc[ai][bj][m][1] * s;
                        const size_t oq = ((size_t)(((b * 4 + hh) * 16 + ch) * 256 + t)) * 512 + 256 + d0, ok = token * 1024 + hh * 256 + d0;
                        bf16_t* dst = isq ? (AE + oq) : (KN + ok);
                        u32x4 w; w.x = cvt_pk_bf16(v0[0], v0[1]); w.y = cvt_pk_bf16(v0[2], v0[3]); w.z = cvt_pk_bf16(v1[0], v1[1]); w.w = cvt_pk_bf16(v1[2], v1[3]);
                        *(u32x4*)dst = w; }
                }
        } else {
#pragma unroll
            for (int ai = 0; ai < 2; ++ai)
#pragma unroll
                for (int m = 0; m < 4; ++m) {
                    const int t = ai * 128 + wr * 64 + m * 16 + fr; const size_t token = (size_t)u.pm * 256 + t;
#pragma unroll
                    for (int bj = 0; bj < 2; ++bj) { f32x4 v0 = acc[ai][bj][m][0], v1 = acc[ai][bj][m][1];
#pragma unroll
                        for (int j = 0; j < 4; ++j) { v0[j] = __builtin_amdgcn_rcpf(1.0f + __builtin_amdgcn_exp2f(-1.4426950408889634f * v0[j])); v1[j] = __builtin_amdgcn_rcpf(1.0f + __builtin_amdgcn_exp2f(-1.4426950408889634f * v1[j])); }
                        u32x4 w; w.x = cvt_pk_bf16(v0[0], v0[1]); w.y = cvt_pk_bf16(v0[2], v0[3]); w.z = cvt_pk_bf16(v1[0], v1[1]); w.w = cvt_pk_bf16(v1[2], v1[3]);
                        *(u32x4*)(OS + token * 1024 + (u.pn - 4) * 256 + bj * 128 + d0) = w; }
                }
        }
    }
};
struct EpiINB {
    static constexpr bool PERM = true; static constexpr bool MID = false;
    __device__ __forceinline__ void prep(const Unit&, int, int, int) const {}
    const float* cf; bf16_t* KT; bf16_t* BE;
    __device__ __forceinline__ void operator()(AccRef acc, const Unit& u, int wr, int wc, int fr, int fq) const {
        asm volatile("" : "+v"(fr), "+v"(fq));
        const int b = u.pn >> 4, ch = u.pn & 15;
        f32x4 cv[2][2][2];
#pragma unroll
        for (int ai = 0; ai < 2; ++ai)
#pragma unroll
            for (int bj = 0; bj < 2; ++bj) { const size_t tok0 = (size_t)u.pn * 256 + bj * 128 + wc * 32 + fq * 8;
                if (u.pm < 2) { const int hh = u.pm * 2 + ai; cv[ai][bj][0] = *(const f32x4*)(cf + (size_t)hh * NTOK + tok0) * RSQRT_DQK; cv[ai][bj][1] = *(const f32x4*)(cf + (size_t)hh * NTOK + tok0 + 4) * RSQRT_DQK; }
                else { cv[ai][bj][0] = (f32x4){1.f, 1.f, 1.f, 1.f}; cv[ai][bj][1] = cv[ai][bj][0]; } }
#pragma unroll
        for (int ai = 0; ai < 2; ++ai)
#pragma unroll
            for (int m = 0; m < 4; ++m) {
                const int R = u.pm * 256 + ai * 128 + wr * 64 + m * 16 + fr;
#pragma unroll
                for (int bj = 0; bj < 2; ++bj) { if (u.x2 == 2 - bj) continue;
                    const f32x4 v0 = acc[ai][bj][m][0] * cv[ai][bj][0], v1 = acc[ai][bj][m][1] * cv[ai][bj][1]; const int s0 = bj * 128 + wc * 32 + fq * 8; const size_t tok0 = (size_t)u.pn * 256 + s0; bf16_t* dst;
                    if (u.pm < 2) dst = KT + (size_t)R * NTOK + tok0;
                    else { const int eg = R - 512, hh = eg >> 8, e = eg & 255; dst = BE + ((size_t)(((b * 4 + hh) * 16 + ch) * 256 + e)) * 384 + s0; }
                    u32x4 w; w.x = cvt_pk_bf16(v0[0], v0[1]); w.y = cvt_pk_bf16(v0[2], v0[3]); w.z = cvt_pk_bf16(v1[0], v1[1]); w.w = cvt_pk_bf16(v1[2], v1[3]);
                    *(u32x4*)dst = w;
                }
            }
    }
};
struct EpiM1 {
    static constexpr bool PERM = true; static constexpr bool MID = false;
    __device__ __forceinline__ void prep(const Unit&, int, int, int) const {}
    bf16_t* UT;
    __device__ __forceinline__ void operator()(AccRef acc, const Unit& u, int wr, int wc, int fr, int fq) const {
        asm volatile("" : "+v"(fr), "+v"(fq));
#pragma unroll
        for (int ai = 0; ai < 2; ++ai)
#pragma unroll
            for (int m = 0; m < 4; ++m) { bf16_t* rowp = UT + ((size_t)u.x0 * 256 + ai * 128 + wr * 64 + m * 16 + fr) * 128 + wc * 32 + fq * 8;
                const f32x4 v0 = acc[ai][0][m][0], v1 = acc[ai][0][m][1];
                u32x4 w; w.x = cvt_pk_bf16(v0[0], v0[1]); w.y = cvt_pk_bf16(v0[2], v0[3]); w.z = cvt_pk_bf16(v1[0], v1[1]); w.w = cvt_pk_bf16(v1[2], v1[3]);
                *(u32x4*)rowp = w; }
    }
};
struct EpiM2A {
    static constexpr bool PERM = true; static constexpr bool MID = false;
    __device__ __forceinline__ void prep(const Unit&, int, int, int) const {}
    bf16_t* AE; const float* nprev; float* den;
    __device__ __forceinline__ void operator()(AccRef acc, const Unit& u, int wr, int wc, int fr, int fq) const {
        asm volatile("" : "+v"(fr), "+v"(fq));
        const int mu = u.x0, dd = wc * 32 + fq * 8;
        const f32x4 n0 = *(const f32x4*)(nprev + (size_t)mu * 128 + dd), n1 = *(const f32x4*)(nprev + (size_t)mu * 128 + dd + 4);
        u32x4 qv8[2][4];
#pragma unroll
        for (int ai = 0; ai < 2; ++ai)
#pragma unroll
            for (int m = 0; m < 4; ++m) qv8[ai][m] = *(const u32x4*)(AE + ((size_t)mu * 256 + ai * 128 + wr * 64 + m * 16 + fr) * 512 + 256 + dd);
#pragma unroll
        for (int ai = 0; ai < 2; ++ai)
#pragma unroll
            for (int m = 0; m < 4; ++m) {
                const int t = ai * 128 + wr * 64 + m * 16 + fr; bf16_t* rowp = AE + ((size_t)mu * 256 + t) * 512;
                const u32x4 qv = qv8[ai][m];
                float part = bflo(qv.x) * n0[0] + bfhi(qv.x) * n0[1] + bflo(qv.y) * n0[2] + bfhi(qv.y) * n0[3] + bflo(qv.z) * n1[0] + bfhi(qv.z) * n1[1] + bflo(qv.w) * n1[2] + bfhi(qv.w) * n1[3];
#pragma unroll
                for (int bj = 0; bj < 2; ++bj) { const int s0 = bj * 128 + wc * 32 + fq * 8; f32x4 v0 = acc[ai][bj][m][0], v1 = acc[ai][bj][m][1];
                    int dts = t - s0; asm volatile("" : "+v"(dts));
#pragma unroll
                    for (int j = 0; j < 4; ++j) { v0[j] = (j <= dts) ? v0[j] : 0.f; v1[j] = (4 + j <= dts) ? v1[j] : 0.f; part += v0[j] + v1[j]; }
                    u32x4 w; w.x = cvt_pk_bf16(v0[0], v0[1]); w.y = cvt_pk_bf16(v0[2], v0[3]); w.z = cvt_pk_bf16(v1[0], v1[1]); w.w = cvt_pk_bf16(v1[2], v1[3]);
                    *(u32x4*)(rowp + s0) = w; }
                part += __shfl_xor(part, 16); part += __shfl_xor(part, 32);
                if (fq == 0) atomicAdd(den + (size_t)mu * 256 + (wr * 64 + fr) + (ai * 128 + m * 16), part);
            }
    }
};
struct EpiM2B {
    static constexpr bool PERM = true; static constexpr bool MID = false;
    __device__ __forceinline__ void prep(const Unit&, int, int, int) const {}
    const float* den; const float* normg; const bf16_t* OS; bf16_t* HN; LAS float* lnx;
    __device__ __forceinline__ void operator()(AccRef acc, const Unit& u, int wr, int wc, int fr, int fq) const {
        asm volatile("" : "+v"(fr), "+v"(fq));
        const int mu = u.x0, b = mu >> 6, hh = (mu >> 4) & 3, ch = mu & 15;
        float dnv[2][4];
#pragma unroll
        for (int ai = 0; ai < 2; ++ai)
#pragma unroll
            for (int m = 0; m < 4; ++m) dnv[ai][m] = den[(size_t)mu * 256 + ai * 128 + wr * 64 + m * 16 + fr];
#pragma unroll
        for (int ai = 0; ai < 2; ++ai)
#pragma unroll
            for (int m = 0; m < 4; ++m) {
                const int t = ai * 128 + wr * 64 + m * 16 + fr; const float dn = dnv[ai][m];
#ifdef DBG_DEN1
                const float inv = 1.0f;
#else
                const float inv = 1.0f / fmaxf(fabsf(dn), 1.0f);
#endif
                float s1 = 0.f, s2 = 0.f;
#pragma unroll
                for (int bj = 0; bj < 2; ++bj)
#pragma unroll
                    for (int n = 0; n < 2; ++n) { f32x4 h = acc[ai][bj][m][n] * inv; acc[ai][bj][m][n] = h; s1 += (h[0] + h[1]) + (h[2] + h[3]); s2 += (h[0] * h[0] + h[1] * h[1]) + (h[2] * h[2] + h[3] * h[3]); }
                s1 += __shfl_xor(s1, 16); s1 += __shfl_xor(s1, 32); s2 += __shfl_xor(s2, 16); s2 += __shfl_xor(s2, 32);
                if (fq == 0) { lnx[(t * 4 + wc) * 2] = s1; lnx[(t * 4 + wc) * 2 + 1] = s2; }
            }
        const int e0 = wc * 32 + fq * 8;
        f32x4 gg[2][2];
#pragma unroll
        for (int bj = 0; bj < 2; ++bj) { gg[bj][0] = *(const f32x4*)(normg + hh * 256 + bj * 128 + e0); gg[bj][1] = *(const f32x4*)(normg + hh * 256 + bj * 128 + e0 + 4); }
        asm volatile("s_waitcnt lgkmcnt(0)" ::: "memory"); __builtin_amdgcn_s_barrier(); asm volatile("" ::: "memory");
#pragma unroll
        for (int ai = 0; ai < 2; ++ai) {
            u32x4 ovv[4][2];
#pragma unroll
            for (int m = 0; m < 4; ++m)
#pragma unroll
                for (int bj = 0; bj < 2; ++bj) ovv[m][bj] = *(const u32x4*)(OS + (((size_t)(b * 16 + ch)) * 256 + ai * 128 + wr * 64 + m * 16 + fr) * 1024 + hh * 256 + bj * 128 + e0);
#pragma unroll
            for (int m = 0; m < 4; ++m) {
                const int t = ai * 128 + wr * 64 + m * 16 + fr; const size_t token = ((size_t)(b * 16 + ch)) * 256 + t;
                const LAS f32x4* lp = (const LAS f32x4*)(lnx + t * 8); const f32x4 a = lp[0], c = lp[1];
                const float mean = (a[0] + a[2] + c[0] + c[2]) * (1.0f / 256.0f); const float ex2 = (a[1] + a[3] + c[1] + c[3]) * (1.0f / 256.0f);
                const float rstd = 1.0f / sqrtf(fmaxf(ex2 - mean * mean, 0.f) + LN_EPS);
#pragma unroll
                for (int bj = 0; bj < 2; ++bj) { const int e = bj * 128 + e0; const size_t off = token * 1024 + hh * 256 + e; const u32x4 ov = ovv[m][bj];
#ifdef DBG_HN_OS
                    f32x4 v0 = {1.f, 1.f, 1.f, 1.f}, v1 = v0;
#elif defined(DBG_HN_RAW)
                    f32x4 v0 = acc[ai][bj][m][0], v1 = acc[ai][bj][m][1];
#else
                    f32x4 v0 = (acc[ai][bj][m][0] - mean) * rstd * gg[bj][0], v1 = (acc[ai][bj][m][1] - mean) * rstd * gg[bj][1];
#endif
#ifndef DBG_HN_ONE
                    v0[0] *= bflo(ov.x); v0[1] *= bfhi(ov.x); v0[2] *= bflo(ov.y); v0[3] *= bfhi(ov.y); v1[0] *= bflo(ov.z); v1[1] *= bfhi(ov.z); v1[2] *= bflo(ov.w); v1[3] *= bfhi(ov.w);
#endif
                    u32x4 w; w.x = cvt_pk_bf16(v0[0], v0[1]); w.y = cvt_pk_bf16(v0[2], v0[3]); w.z = cvt_pk_bf16(v1[0], v1[1]); w.w = cvt_pk_bf16(v1[2], v1[3]);
                    *(u32x4*)(HN + off) = w; }
            }
            asm volatile("" ::: "memory");
        }
        asm volatile("s_waitcnt lgkmcnt(0)" ::: "memory"); __builtin_amdgcn_s_barrier(); asm volatile("" ::: "memory");
    }
};
struct Frame {
    LAS unsigned char* lds;
    unsigned* ctl;
    unsigned char* ws;
    int tid, lane, wave, vcu, G;
};
__device__ __forceinline__ float wave_sum(float v) {
#pragma unroll
    for (int o = 1; o < 64; o <<= 1) v += __shfl_xor(v, o);
    return v;
}

__device__ __forceinline__ void tr_block(const float* src, size_t pitch, bf16_t* dst, size_t kd, int kb, int nb, LAS unsigned* scr, int lane, bool rotperm = false) {
    const float* s0 = src + (size_t)(64 * kb) * pitch + 64 * nb + 4 * (lane & 15);
#pragma unroll
    for (int i = 0; i < 8; ++i) {
        const int kp = 4 * i + (lane >> 4);
        const f32x4 a = __builtin_nontemporal_load((const f32x4*)(s0 + (size_t)(2 * kp) * pitch)), b = __builtin_nontemporal_load((const f32x4*)(s0 + (size_t)(2 * kp + 1) * pitch));
#pragma unroll
        for (int j = 0; j < 4; ++j) scr[(4 * (lane & 15) + j) * 33 + kp] = cvt_pk_bf16(a[j], b[j]);
    }
    LDS_WAIT(); asm volatile("" ::: "memory");
    u32x4 o[8];
#pragma unroll
    for (int c = 0; c < 8; ++c) { const int r0 = 8 * c + (lane >> 3), rr = (rotperm && c < 2) ? (8 * ((r0 >> 2) & 1) + 4 * (r0 >> 3) + (r0 & 3)) : r0, q4 = 4 * (lane & 7); o[c].x = scr[rr * 33 + q4]; o[c].y = scr[rr * 33 + q4 + 1]; o[c].z = scr[rr * 33 + q4 + 2]; o[c].w = scr[rr * 33 + q4 + 3]; }
    bf16_t* d = dst + (size_t)(64 * nb + (lane >> 3)) * kd + 64 * kb + 8 * (lane & 7);
#pragma unroll
    for (int c = 0; c < 8; ++c) *(u32x4*)(d + (size_t)(8 * c) * kd) = o[c];
    LDS_WAIT(); asm volatile("" ::: "memory");
}
__device__ __forceinline__ void tr_block8(const float* src, size_t pitch, unsigned char* dst, size_t kd, int kb, int nb, float scale, LAS unsigned* scr, int lane) {
    const float* s0 = src + (size_t)(128 * kb) * pitch + 64 * nb + 4 * (lane & 15);
#pragma unroll
    for (int i = 0; i < 8; ++i) {
        const int kq = 4 * i + (lane >> 4);
        const f32x4 r0 = __builtin_nontemporal_load((const f32x4*)(s0 + (size_t)(4 * kq) * pitch)) * scale, r1 = __builtin_nontemporal_load((const f32x4*)(s0 + (size_t)(4 * kq + 1) * pitch)) * scale,
                    r2 = __builtin_nontemporal_load((const f32x4*)(s0 + (size_t)(4 * kq + 2) * pitch)) * scale, r3 = __builtin_nontemporal_load((const f32x4*)(s0 + (size_t)(4 * kq + 3) * pitch)) * scale;
#pragma unroll
        for (int j = 0; j < 4; ++j) { int w = __builtin_amdgcn_cvt_pk_fp8_f32(r0[j], r1[j], 0, false); w = __builtin_amdgcn_cvt_pk_fp8_f32(r2[j], r3[j], w, true); scr[(4 * (lane & 15) + j) * 33 + kq] = (unsigned)w; }
    }
    LDS_WAIT(); asm volatile("" ::: "memory");
    u32x4 o[8];
#pragma unroll
    for (int c = 0; c < 8; ++c) { const int rr = 8 * c + (lane >> 3), q4 = 4 * (lane & 7); o[c].x = scr[rr * 33 + q4]; o[c].y = scr[rr * 33 + q4 + 1]; o[c].z = scr[rr * 33 + q4 + 2]; o[c].w = scr[rr * 33 + q4 + 3]; }
    unsigned char* d = dst + (size_t)(64 * nb + (lane >> 3)) * kd + 128 * kb + 16 * (lane & 7);
#pragma unroll
    for (int c = 0; c < 8; ++c) *(u32x4*)(d + (size_t)(8 * c) * kd) = o[c];
    LDS_WAIT(); asm volatile("" ::: "memory");
}
constexpr int CONV_ITEMS = 24576;
struct ConvItem { const float* s0; size_t pitch; unsigned char* d; float scale; };
__device__ __forceinline__ ConvItem conv_desc(const float* wgu, const float* wd, unsigned char* ws, int v, int lane) {
    const int layer = v >= 12288; int r = v - layer * 12288; ConvItem it;
    if (r < 8192) { const int mat = layer * 32 + (r >> 8); r &= 255; const int kb = r >> 5, nb = r & 31; it.pitch = 2048; it.scale = FP8_SWGU;
        it.s0 = wgu + (size_t)mat * 1024 * 2048 + (size_t)(128 * kb) * 2048 + 64 * nb + 4 * (lane & 15); it.d = ws + WS_WGU + (size_t)mat * 2048 * 1024 + (size_t)(64 * nb + (lane >> 3)) * 1024 + 128 * kb + 16 * (lane & 7); }
    else { r -= 8192; const int mat = layer * 32 + (r >> 7); r &= 127; const int kb = r >> 4, nb = r & 15; it.pitch = 1024; it.scale = FP8_SWD;
        it.s0 = wd + (size_t)mat * 1024 * 1024 + (size_t)(128 * kb) * 1024 + 64 * nb + 4 * (lane & 15); it.d = ws + WS_WD + (size_t)mat * 1024 * 1024 + (size_t)(64 * nb + (lane >> 3)) * 1024 + 128 * kb + 16 * (lane & 7); }
    return it;
}
__device__ __forceinline__ void conv_items(Frame& F, const float* wgu, const float* wd, int v_lo, int v_hi, int cw, int ncw) {
    LAS unsigned* scr = (LAS unsigned*)(F.lds + RING_OFF + F.wave * 8448); unsigned char* ws = F.ws; const int lane = F.lane;
    int v = v_lo + cw; if (v >= v_hi) return;
    ConvItem cur = conv_desc(wgu, wd, ws, v, lane);
    f32x4 r[8][4];
#pragma unroll
    for (int i = 0; i < 8; ++i) { const int kq = 4 * i + (lane >> 4);
#pragma unroll
        for (int q = 0; q < 4; ++q) r[i][q] = __builtin_nontemporal_load((const f32x4*)(cur.s0 + (size_t)(4 * kq + q) * cur.pitch)); }
    for (;;) {
        const int vn = v + ncw; const bool has = vn < v_hi; ConvItem nx = cur; if (has) nx = conv_desc(wgu, wd, ws, vn, lane);
#pragma unroll
        for (int i = 0; i < 8; ++i) { const int kq = 4 * i + (lane >> 4);
#pragma unroll
            for (int j = 0; j < 4; ++j) { int w = __builtin_amdgcn_cvt_pk_fp8_f32(r[i][0][j] * cur.scale, r[i][1][j] * cur.scale, 0, false); w = __builtin_amdgcn_cvt_pk_fp8_f32(r[i][2][j] * cur.scale, r[i][3][j] * cur.scale, w, true); scr[(4 * (lane & 15) + j) * 33 + kq] = (unsigned)w; }
            if (has) {
#pragma unroll
                for (int q = 0; q < 4; ++q) r[i][q] = __builtin_nontemporal_load((const f32x4*)(nx.s0 + (size_t)(4 * kq + q) * nx.pitch)); } }
        LDS_WAIT(); asm volatile("" ::: "memory");
        u32x4 o[8];
#pragma unroll
        for (int c = 0; c < 8; ++c) { const int rr = 8 * c + (lane >> 3), q4 = 4 * (lane & 7); o[c].x = scr[rr * 33 + q4]; o[c].y = scr[rr * 33 + q4 + 1]; o[c].z = scr[rr * 33 + q4 + 2]; o[c].w = scr[rr * 33 + q4 + 3]; }
#pragma unroll
        for (int c = 0; c < 8; ++c) *(u32x4*)(cur.d + (size_t)(8 * c) * 1024) = o[c];
        LDS_WAIT(); asm volatile("" ::: "memory");
        if (!has) break;
        v = vn; cur = nx;
    }
}
struct P0In { const float *x, *wqkv, *wo, *win, *wout, *rw, *wgu, *wd; const int* pos; };
__device__ __forceinline__ void p0_prologue(Frame& F, const P0In& I) {
    LAS unsigned* scr = (LAS unsigned*)(F.lds + RING_OFF + F.wave * 8448);
    const int gw = F.vcu * NWAVES + F.wave, NGW = F.G * NWAVES;
    unsigned char* ws = F.ws;
    constexpr int KB = 16;
    constexpr int I_QKV = KB * 48, I_WO = KB * 16, I_INA1 = KB * 16, I_INA2 = KB * 16, I_INB = KB * 24, I_WOUT = KB * 16;
    constexpr int I_SMALL = I_QKV + I_WO + I_INA1 + I_INA2 + I_INB + I_WOUT;
    constexpr int NITEMS = I_SMALL;
    for (int it = gw; it < NITEMS; it += NGW) {
        int r = it; const float* src; size_t pitch; bf16_t* dst; int nbl; const bool isqkv = it < I_QKV;
        if (r < I_QKV) { src = I.wqkv; pitch = 3072; dst = (bf16_t*)(ws + WS_WQKV); nbl = 48; }
        else if ((r -= I_QKV) < I_WO) { src = I.wo; pitch = 1024; dst = (bf16_t*)(ws + WS_WO); nbl = 16; }
        else if ((r -= I_WO) < I_INA1) { src = I.win; pitch = 3080; dst = (bf16_t*)(ws + WS_WINA); nbl = 16; }
        else if ((r -= I_INA1) < I_INA2) { src = I.win + 2048; pitch = 3080; dst = (bf16_t*)(ws + WS_WINA) + (size_t)1024 * 1024; nbl = 16; }
        else if ((r -= I_INA2) < I_INB) { src = I.win + 512; pitch = 3080; dst = (bf16_t*)(ws + WS_WINB); nbl = 24; }
        else { r -= I_INB; src = I.wout; pitch = 1024; dst = (bf16_t*)(ws + WS_WOUT); nbl = 16; }
        tr_block(src, pitch, dst, 1024, r / nbl, r % nbl, scr, F.lane, isqkv && (r % nbl) < 32);
    }
    if (NCONV == 0) conv_items(F, I.wgu, I.wd, 0, CONV_ITEMS, gw, NGW);
    const int gt = F.vcu * NTHR + F.tid, NGT = F.G * NTHR;
    for (int i = gt; i < NTOK * DM / 8; i += NGT) { const f32x4 a = ((const f32x4*)I.x)[2 * i], b = ((const f32x4*)I.x)[2 * i + 1];
        u32x4 w; w.x = cvt_pk_bf16(a[0], a[1]); w.y = cvt_pk_bf16(a[2], a[3]); w.z = cvt_pk_bf16(b[0], b[1]); w.w = cvt_pk_bf16(b[2], b[3]); ((u32x4*)(ws + WS_XB))[i] = w; }
    for (int i = gt; i < NTOK * 8; i += NGT) { const int tok = i >> 3, f = i & 7; const float inv = powf(500000.0f, -(float)f * 0.125f); const float ang = (float)I.pos[tok] * inv;
        float sn, cs; sincosf(ang, &sn, &cs); float* rp = (float*)(ws + WS_ROPE) + (size_t)tok * 16; rp[f] = cs; rp[8 + f] = sn; }
    for (int i = gt; i < 2 * 32 * 1024; i += NGT) { const int l = i >> 15, e = (i >> 10) & 31, k = i & 1023; ((float*)(ws + WS_RWT))[i] = I.rw[((size_t)l * 1024 + k) * 32 + e]; }
    for (int i = gt; i < 8 * 1024; i += NGT) { const int gidx = i >> 10, k = i & 1023; ((float*)(ws + WS_WG))[i] = I.win[(size_t)k * 3080 + 3072 + gidx]; }
}

__device__ __forceinline__ void phase_ln_router(Frame& F, const bf16_t* __restrict__ z, bf16_t* __restrict__ x1, const float* lng, const float* lnb, const float* rbias, int layer, int cset) {
    unsigned char* ws = F.ws;
    LAS f32x4* rwv = (LAS f32x4*)(F.lds + RING_OFF);
    LAS int* lcnt = (LAS int*)(F.lds + LX_LCNT); LAS int* gbase = (LAS int*)(F.lds + LX_GBASE); LAS int* rec = (LAS int*)(F.lds + LX_REC);
    LAS float* lgb = (LAS float*)(F.lds + LX_LNX);
    { const f32x4* src = (const f32x4*)((const float*)(ws + WS_RWT) + (size_t)layer * 32768);
      for (int i = F.tid; i < 8192; i += NTHR) { const int e = i >> 8, c = i & 255; rwv[e * 256 + (c ^ (e & 15))] = src[i]; } }
    int* toke = (int*)(ws + WS_TOKE); int* tokp = (int*)(ws + WS_TOKP); float* tokg = (float*)(ws + WS_TOKG);
    unsigned short* rowtok = (unsigned short*)(ws + WS_ROWTOK); unsigned char* xb8 = (unsigned char*)(ws + WS_XB);
    unsigned* cntg = F.ctl + CW_CNT + cset * 2048;
    const int lane = F.lane;
    for (int grp = F.vcu; grp < NTOK / 64; grp += F.G) {
        if (F.tid < 32) lcnt[F.tid] = 0;
        for (int i = F.tid; i < 1024; i += NTHR) { lgb[i] = lng[i]; lgb[1024 + i] = lnb[i]; }
        __syncthreads();
#pragma unroll 2
        for (int tk = 0; tk < 8; tk += 2) {
            const int token0 = grp * 64 + F.wave * 8 + tk;
            f32x4 v[2][4]; float s[2] = {0.f, 0.f};
#pragma unroll
            for (int u = 0; u < 2; ++u)
#pragma unroll
                for (int j = 0; j < 4; ++j) { const u32x2 zz = *(const u32x2*)(z + (size_t)(token0 + u) * DM + 4 * lane + 256 * j); v[u][j] = (f32x4){bflo(zz.x), bfhi(zz.x), bflo(zz.y), bfhi(zz.y)}; s[u] += (v[u][j][0] + v[u][j][1]) + (v[u][j][2] + v[u][j][3]); }
#pragma unroll
            for (int o = 1; o < 64; o <<= 1) { const float a0 = __shfl_xor(s[0], o), a1 = __shfl_xor(s[1], o); s[0] += a0; s[1] += a1; }
            float s2[2] = {0.f, 0.f};
#pragma unroll
            for (int u = 0; u < 2; ++u) { const float mean = s[u] * (1.0f / DM);
#pragma unroll
                for (int j = 0; j < 4; ++j) { v[u][j] = v[u][j] - mean; s2[u] += (v[u][j][0] * v[u][j][0] + v[u][j][1] * v[u][j][1]) + (v[u][j][2] * v[u][j][2] + v[u][j][3] * v[u][j][3]); } }
#pragma unroll
            for (int o = 1; o < 64; o <<= 1) { const float a0 = __shfl_xor(s2[0], o), a1 = __shfl_xor(s2[1], o); s2[0] += a0; s2[1] += a1; }
#pragma unroll
            for (int u = 0; u < 2; ++u) { const float rstd = 1.0f / sqrtf(s2[u] * (1.0f / DM) + LN_EPS); const int token = token0 + u;
#pragma unroll
                for (int j = 0; j < 4; ++j) { const f32x4 gvj = *(const LAS f32x4*)(lgb + 4 * lane + 256 * j), bvj = *(const LAS f32x4*)(lgb + 1024 + 4 * lane + 256 * j);
                    const f32x4 y = v[u][j] * rstd * gvj + bvj; { u32x2 wb; wb.x = cvt_pk_bf16(y[0], y[1]); wb.y = cvt_pk_bf16(y[2], y[3]); *(u32x2*)(x1 + (size_t)token * DM + 4 * lane + 256 * j) = wb; }
                    int w8 = __builtin_amdgcn_cvt_pk_fp8_f32(y[0] * FP8_SA, y[1] * FP8_SA, 0, false); w8 = __builtin_amdgcn_cvt_pk_fp8_f32(y[2] * FP8_SA, y[3] * FP8_SA, w8, true);
                    *(int*)(xb8 + (size_t)token * DM + 4 * lane + 256 * j) = w8; } }
        }
        VM_WAIT(); __syncthreads();
        const int tg = F.wave & 3, kh = F.wave >> 2, e0 = lane & 15, kq = lane >> 4;
        f32x4 acc0 = {0.f, 0.f, 0.f, 0.f}, acc1 = acc0;
        { const bf16_t* arow = x1 + (size_t)(grp * 64 + tg * 16 + e0) * DM + kh * 512 + 4 * kq;
#pragma unroll 4
          for (int blk = 0; blk < 32; ++blk) {
              const u32x2 ab = *(const u32x2*)(arow + blk * 16); const f32x4 a4 = {bflo(ab.x), bfhi(ab.x), bflo(ab.y), bfhi(ab.y)}; const int c = ((kh * 512 + blk * 16) >> 2) + kq;
              const f32x4 b0 = rwv[e0 * 256 + (c ^ e0)], b1 = rwv[(16 + e0) * 256 + (c ^ e0)];
#pragma unroll
              for (int j = 0; j < 4; ++j) { acc0 = __builtin_amdgcn_mfma_f32_16x16x4f32(a4[j], b0[j], acc0, 0, 0, 0); acc1 = __builtin_amdgcn_mfma_f32_16x16x4f32(a4[j], b1[j], acc1, 0, 0, 0); } } }
        __syncthreads();
        if (kh == 1) { ((LAS f32x4*)lgb)[(tg * 2 + 0) * 64 + lane] = acc0; ((LAS f32x4*)lgb)[(tg * 2 + 1) * 64 + lane] = acc1; }
        __syncthreads();
        if (kh == 0) {
            acc0 = acc0 + ((LAS f32x4*)lgb)[(tg * 2 + 0) * 64 + lane]; acc1 = acc1 + ((LAS f32x4*)lgb)[(tg * 2 + 1) * 64 + lane];
            const float rb0 = rbias[e0], rb1 = rbias[16 + e0];
#pragma unroll
            for (int r = 0; r < 4; ++r) {
                float l0 = acc0[r] + rb0, l1 = acc1[r] + rb1; float tv[4]; int te[4];
#pragma unroll
                for (int k = 0; k < 4; ++k) { float bvv = (l1 > l0) ? l1 : l0; int be = (l1 > l0) ? 16 + e0 : e0;
#pragma unroll
                    for (int o = 1; o < 16; o <<= 1) { const float ov = __shfl_xor(bvv, o); const int oe = __shfl_xor(be, o); const bool take = (ov > bvv) || (ov == bvv && oe < be); bvv = take ? ov : bvv; be = take ? oe : be; }
                    tv[k] = bvv; te[k] = be; if (be == e0) l0 = -INFINITY; if (be == 16 + e0) l1 = -INFINITY; }
                const float w0 = 1.0f, w1 = __expf(tv[1] - tv[0]), w2 = __expf(tv[2] - tv[0]), w3 = __expf(tv[3] - tv[0]); const float wi = 1.0f / (w0 + w1 + w2 + w3);
                if (e0 < 4) {
                    const int tl = tg * 16 + 4 * kq + r, token = grp * 64 + tl;
                    const int ek = (e0 == 0) ? te[0] : (e0 == 1) ? te[1] : (e0 == 2) ? te[2] : te[3];
                    const float wk = (e0 == 0) ? w0 : (e0 == 1) ? w1 : (e0 == 2) ? w2 : w3;
                    const int li = atomicAdd((int*)(lcnt + ek), 1); rec[tl * 8 + e0] = ek; rec[tl * 8 + 4 + e0] = li;
                    toke[token * 4 + e0] = ek; tokg[token * 4 + e0] = wk * wi;
                }
            }
        }
        __syncthreads();
        if (F.tid < 32) gbase[F.tid] = (int)__hip_atomic_fetch_add(cntg + F.tid * 64, (unsigned)lcnt[F.tid], RLX_AGENT);
        __syncthreads();
        if (F.tid < 256) { const int tl = F.tid >> 2, k = F.tid & 3; const int token = grp * 64 + tl; const int e = rec[tl * 8 + k]; const int pos = gbase[e] + rec[tl * 8 + 4 + k];
            tokp[token * 4 + k] = pos; rowtok[(size_t)e * NTOK + pos] = (unsigned short)token; }
        __syncthreads();
    }
}

__device__ __forceinline__ int moe_tables(Frame& F, int layer) {
    LAS int* tile_e = (LAS int*)(F.lds + LX_TILEE); LAS int* tbase = (LAS int*)(F.lds + LX_TBASE);
    if (F.tid < 64) {
        const int e = F.lane & 31; const int c = (int)__hip_atomic_load(F.ctl + CW_CNT + layer * 2048 + e * 64, RLX_AGENT); const int nt = (F.lane < 32) ? ((c + 255) >> 8) : 0;
        int inc = nt;
#pragma unroll
        for (int o = 1; o < 32; o <<= 1) { const int up = __shfl_up(inc, o); if (F.lane >= o) inc += up; }
        const int t0 = inc - nt;
        if (F.lane < 32) { tbase[e] = t0; for (int i = 0; i < nt; ++i) tile_e[t0 + i] = e; }
        if (F.lane == 31) tbase[32] = inc;
    }
    __syncthreads();
    return tbase[32];
}

template <bool NEXT_MLSTM>
__device__ __forceinline__ void phase_combine(Frame& F, const bf16_t* __restrict__ x1, float* __restrict__ out, const float* lng, const float* lnb, const float* bgates, int layer) {
    unsigned char* ws = F.ws;
    (void)moe_tables(F, layer);
    const LAS int* tbase = (const LAS int*)(F.lds + LX_TBASE);
    const int* toke = (const int*)(ws + WS_TOKE); const int* tokp = (const int*)(ws + WS_TOKP); const float* tokg = (const float*)(ws + WS_TOKG);
    const unsigned char* Y = (const unsigned char*)(ws + WS_Y); bf16_t* xb = (bf16_t*)(ws + WS_XB);
    LAS float* wg = (LAS float*)(F.lds + RING_OFF);
    LAS float* lgb = wg + 8192;
    if constexpr (NEXT_MLSTM) { const f32x4* src = (const f32x4*)(ws + WS_WG); for (int i = F.tid; i < 2048; i += NTHR) ((LAS f32x4*)wg)[i] = src[i];
        for (int i = F.tid; i < 1024; i += NTHR) { lgb[i] = lng[i]; lgb[1024 + i] = lnb[i]; } __syncthreads(); }
    const int lane = F.lane; const int gw = F.vcu * NWAVES + F.wave, NGW = F.G * NWAVES;
    f32x4 gv[4], bv[4];
    if constexpr (!NEXT_MLSTM) {
#pragma unroll
        for (int j = 0; j < 4; ++j) { gv[j] = *(const f32x4*)(lng + 4 * lane + 256 * j); bv[j] = *(const f32x4*)(lnb + 4 * lane + 256 * j); } }
    constexpr int NTK = 2;
    int rowv = 0; float gatev = 0.f;
    { const int mt = gw + (lane >> 2) * NGW; if (mt < NTOK) { const int ee = toke[mt * 4 + (lane & 3)]; rowv = tbase[ee] * 256 + tokp[mt * 4 + (lane & 3)]; gatev = tokg[mt * 4 + (lane & 3)] * (DBG_MOE_MUL / FP8_SY); } }
    int it = 0;
    for (int token0 = gw; token0 < NTOK; token0 += NTK * NGW, ++it) {
        f32x4 vv[NTK][4];
#pragma unroll
        for (int u = 0; u < NTK; ++u) { const int token = token0 + u * NGW; if (token < NTOK) {
#pragma unroll
            for (int j = 0; j < 4; ++j) { const u32x2 xx = *(const u32x2*)(x1 + (size_t)token * DM + 4 * lane + 256 * j); vv[u][j] = (f32x4){bflo(xx.x), bfhi(xx.x), bflo(xx.y), bfhi(xx.y)} * ALPHA; }
#pragma unroll
            for (int k = 0; k < 4; ++k) { const int sl = (it * NTK + u) * 4 + k; const size_t row = (size_t)__builtin_amdgcn_readlane(rowv, sl); const float gt = __int_as_float(__builtin_amdgcn_readlane(__float_as_int(gatev), sl));
#pragma unroll
                for (int j = 0; j < 4; ++j) { const int y = *(const int*)(Y + row * DM + 4 * lane + 256 * j); const f32x2 lo = __builtin_amdgcn_cvt_pk_f32_fp8(y, false), hi = __builtin_amdgcn_cvt_pk_f32_fp8(y, true);
                    vv[u][j][0] += gt * lo[0]; vv[u][j][1] += gt * lo[1]; vv[u][j][2] += gt * hi[0]; vv[u][j][3] += gt * hi[1]; } } } }
#pragma unroll
        for (int u = 0; u < NTK; ++u) { const int token = token0 + u * NGW; if (token < NTOK) {
        f32x4 v[4];
#pragma unroll
        for (int j = 0; j < 4; ++j) v[j] = vv[u][j];
        float s = 0.f;
#pragma unroll
        for (int j = 0; j < 4; ++j) s += (v[j][0] + v[j][1]) + (v[j][2] + v[j][3]);
        const float mean = wave_sum(s) * (1.0f / DM); float s2 = 0.f;
#pragma unroll
        for (int j = 0; j < 4; ++j) { v[j] = v[j] - mean; s2 += (v[j][0] * v[j][0] + v[j][1] * v[j][1]) + (v[j][2] * v[j][2] + v[j][3] * v[j][3]); }
        const float rstd = 1.0f / sqrtf(wave_sum(s2) * (1.0f / DM) + LN_EPS);
#pragma unroll
        for (int j = 0; j < 4; ++j) { if constexpr (NEXT_MLSTM) { gv[j] = *(const LAS f32x4*)(lgb + 4 * lane + 256 * j); bv[j] = *(const LAS f32x4*)(lgb + 1024 + 4 * lane + 256 * j); }
            v[j] = v[j] * rstd * gv[j] + bv[j]; if constexpr (!NEXT_MLSTM) *(f32x4*)(out + (size_t)token * DM + 4 * lane + 256 * j) = v[j]; }
        if constexpr (NEXT_MLSTM) {
#pragma unroll
            for (int j = 0; j < 4; ++j) { u32x2 w; w.x = cvt_pk_bf16(v[j][0], v[j][1]); w.y = cvt_pk_bf16(v[j][2], v[j][3]); *(u32x2*)(xb + (size_t)token * DM + 4 * lane + 256 * j) = w; }
            float gp[8];
#pragma unroll
            for (int gi = 0; gi < 8; ++gi) { float a = 0.f;
#pragma unroll
                for (int j = 0; j < 4; ++j) { const f32x4 w = *(const LAS f32x4*)(wg + gi * 1024 + 4 * lane + 256 * j); a += (v[j][0] * w[0] + v[j][1] * w[1]) + (v[j][2] * w[2] + v[j][3] * w[3]); }
                gp[gi] = a; if (gi & 1) asm volatile("" ::: "memory"); }
#pragma unroll
            for (int o = 1; o < 64; o <<= 1) {
#pragma unroll
                for (int gi = 0; gi < 8; ++gi) gp[gi] += __shfl_xor(gp[gi], o); }
#pragma unroll
            for (int gi = 0; gi < 8; ++gi) gp[gi] += bgates[gi];
            if (lane == 0) {
#pragma unroll
                for (int hh = 0; hh < 4; ++hh) { ((float*)(ws + WS_GI))[(size_t)hh * NTOK + token] = gp[hh];
                    const float f = gp[4 + hh]; const float lf = (f >= 0.f) ? -log1pf(__expf(-f)) : (f - log1pf(__expf(f)));
                    ((float*)(ws + WS_LF))[(size_t)hh * NTOK + token] = lf; } }
        }
        } }
    }
}

__device__ __forceinline__ void phase_gate_scan(Frame& F) {
    unsigned char* ws = F.ws; const int lane = F.lane; const int gw = F.vcu * NWAVES + F.wave, NGW = F.G * NWAVES;
    for (int mu = gw; mu < 256; mu += NGW) {
        const int b = mu >> 6, hh = (mu >> 4) & 3, ch = mu & 15; const size_t base = (size_t)hh * NTOK + (size_t)b * SEQ + ch * 256 + 4 * lane;
        const f32x4 lf = *(const f32x4*)((const float*)(ws + WS_LF) + base), gi = *(const f32x4*)((const float*)(ws + WS_GI) + base);
        f32x4 c; c[0] = lf[0]; c[1] = c[0] + lf[1]; c[2] = c[1] + lf[2]; c[3] = c[2] + lf[3];
        float tot = c[3];
#pragma unroll
        for (int o = 1; o < 64; o <<= 1) { const float up = __shfl_up(tot, o); if (lane >= o) tot += up; }
        const float excl = tot - c[3];
        f32x4 rf, cf;
#pragma unroll
        for (int j = 0; j < 4; ++j) { const float bt = excl + c[j]; rf[j] = __expf(bt); cf[j] = __expf(gi[j] - bt); }
        *(f32x4*)((float*)(ws + WS_RF) + base) = rf; *(f32x4*)((float*)(ws + WS_CF) + base) = cf;
        if (lane == 63) ((float*)(ws + WS_DEC))[mu] = __expf(tot);
    }
}
__device__ __forceinline__ void phase_nu(Frame& F) {
    unsigned char* ws = F.ws; const int lane = F.lane; const int gw = F.vcu * NWAVES + F.wave, NGW = F.G * NWAVES;
    const bf16_t* KT = (const bf16_t*)(ws + WS_KT); float* NU = (float*)(ws + WS_NU);
    for (int r0 = gw * 16; r0 < 256 * 128; r0 += NGW * 16) {
        const int mu = r0 >> 7, d0 = r0 & 127, b = mu >> 6, hh = (mu >> 4) & 3, ch = mu & 15;
        const bf16_t* base = KT + (size_t)(hh * 128 + d0) * NTOK + (size_t)b * SEQ + ch * 256 + 4 * lane;
        u32x2 kv[16];
#pragma unroll
        for (int i = 0; i < 16; ++i) kv[i] = *(const u32x2*)(base + (size_t)i * NTOK);
        float s[16];
#pragma unroll
        for (int i = 0; i < 16; ++i) s[i] = (bflo(kv[i].x) + bfhi(kv[i].x)) + (bflo(kv[i].y) + bfhi(kv[i].y));
#pragma unroll
        for (int o = 1; o < 64; o <<= 1) {
#pragma unroll
            for (int i = 0; i < 16; ++i) s[i] += __shfl_xor(s[i], o); }
        float mine = s[0];
#pragma unroll
        for (int i = 1; i < 16; ++i) mine = (lane == i) ? s[i] : mine;
        if (lane < 16) NU[r0 + lane] = mine;
    }
}
__device__ __forceinline__ void phase_state_scan(Frame& F) {
    unsigned char* ws = F.ws; const int gt = F.vcu * NTHR + F.tid, NGT = F.G * NTHR;
    const bf16_t* UT = (const bf16_t*)(ws + WS_UT); const float* DEC = (const float*)(ws + WS_DEC); bf16_t* BE = (bf16_t*)(ws + WS_BE);
    for (int i = gt; i < 16 * 256 * 32; i += NGT) { const int bh = i >> 13, e = (i >> 5) & 255, dg = i & 31;
        f32x4 U[16]; float dc[16];
#pragma unroll
        for (int ch = 0; ch < 16; ++ch) { const size_t mu = (size_t)bh * 16 + ch; { const u32x2 uu = *(const u32x2*)(UT + (mu * 256 + e) * 128 + 4 * dg); U[ch] = (f32x4){bflo(uu.x), bfhi(uu.x), bflo(uu.y), bfhi(uu.y)}; } dc[ch] = DEC[mu]; }
        f32x4 C = {0.f, 0.f, 0.f, 0.f};
#pragma unroll
        for (int ch = 0; ch < 16; ++ch) { const size_t mu = (size_t)bh * 16 + ch;
            u32x2 w; w.x = cvt_pk_bf16(C[0], C[1]); w.y = cvt_pk_bf16(C[2], C[3]);
#ifdef DBG_NO_INTER
            w.x = 0u; w.y = 0u;
#endif
            *(u32x2*)(BE + (mu * 256 + e) * 384 + 256 + 4 * dg) = w;
            C = (C + U[ch]) * dc[ch]; } }
    const float* NU = (const float*)(ws + WS_NU); float* NP = (float*)(ws + WS_NPREV);
    for (int i = gt; i < 16 * 128; i += NGT) { const int bh = i >> 7, d = i & 127; float n = 0.f;
        for (int ch = 0; ch < 16; ++ch) { const int mu = bh * 16 + ch; NP[mu * 128 + d] = n; n = (n + NU[mu * 128 + d]) * DEC[mu];
#ifdef DBG_NO_INTER
            n = 0.f;
#endif
        } }
}
struct Args { const float* in[18]; float* out; unsigned char* ws; int ph_lo, ph_hi; };
__global__ void __launch_bounds__(NTHR, 2) mk_fwd(Args args) {
    extern __shared__ __attribute__((aligned(16))) unsigned char lds[];
    Frame F;
    const char __attribute__((address_space(4)))* kargp = (const char __attribute__((address_space(4)))*)__builtin_amdgcn_kernarg_segment_ptr();
#define AIN(i) ({ const char __attribute__((address_space(4)))* k_ = kargp; asm volatile("" : "+s"(k_)); *(const float* const __attribute__((address_space(4)))*)(k_ + 8 * (i)); })
    unsigned char* const ws0 = (unsigned char*)AIN(19);
    F.lds = (LAS unsigned char*)lds; F.ws = ws0; F.ctl = (unsigned*)(ws0 + WS_CTL);
    F.tid = threadIdx.x; F.lane = F.tid & 63; F.wave = __builtin_amdgcn_readfirstlane(F.tid >> 6);
    F.G = gridDim.x; { const int bx = blockIdx.x; F.vcu = (F.G % 8 == 0) ? (bx % 8) * (F.G / 8) + bx / 8 : bx; }
    for (int u = F.tid; u < (LDS_BYTES - LX) / 4; u += NTHR) ((LAS unsigned*)(F.lds + LX))[u] = 0u;
    __syncthreads();
    int lo, hi; { const char __attribute__((address_space(4)))* k_ = kargp; lo = *(const int __attribute__((address_space(4)))*)(k_ + 160); hi = *(const int __attribute__((address_space(4)))*)(k_ + 164); }
    XcdBarrier bar; bar.bar = (unsigned*)(F.ctl + CW_BAR); bar.x = 0; bar.st = nullptr;
    if (hi - lo > 1) bar = xcd_barrier_post((unsigned*)(F.ctl + CW_BAR), (volatile LAS unsigned*)(F.lds + LX_MISC) + 8);
#ifndef PHASE_MASK
#define PHASE_MASK 0x7FFFF
#endif
#define IN(k) ((((PHASE_MASK) >> (k)) & 1) && lo <= (k) && (k) < hi)
#ifndef REPEAT_MASK
#define REPEAT_MASK 0
#endif
#define PH(k) if (IN(k))
#define SEAM(k) do { if (IN(k) && IN((k) + 1)) xcd_barrier(bar); } while (0)
    unsigned char* ws = ws0;
#define x_in AIN(0)
#define ln_mix_g AIN(8)
#define ln_mix_b AIN(9)
#define ln_ffn_g AIN(10)
#define ln_ffn_b AIN(11)
#define router_b AIN(13)
#define b_gu AIN(15)
#define b_dn AIN(17)
    bf16_t* XB = (bf16_t*)(ws + WS_XB); bf16_t* QB_ = (bf16_t*)(ws + WS_Q); bf16_t* KB_ = (bf16_t*)(ws + WS_K); bf16_t* VB_ = (bf16_t*)(ws + WS_V);
    bf16_t* R0 = (bf16_t*)(ws + WS_R0); bf16_t* R1 = (bf16_t*)(ws + WS_R1);
    bf16_t* HB = (bf16_t*)(ws + WS_H); bf16_t* YB = (bf16_t*)(ws + WS_Y);
    LAS unsigned char* ring = F.lds + RING_OFF;
    const int cG = (int)blockIdx.x;
    const bool isConv = (NCONV > 0) && ((int)blockIdx.x >= F.G - NCONV);
    const int Gc = F.G - NCONV, cwv = ((int)blockIdx.x - Gc) * NWAVES + F.wave, ncw = NCONV * NWAVES;
#define CONV_SLICE(a, b) conv_items(F, AIN(14), AIN(16), (int)((long)CONV_ITEMS * (a) / 1000), (int)((long)CONV_ITEMS * (b) / 1000), cwv, ncw)

    PH(0) { P0In I{x_in, AIN(2), AIN(3), AIN(4), AIN(7), AIN(12), AIN(14), AIN(16), (const int*)AIN(1)}; p0_prologue(F, I); }
    SEAM(0);
    PH(1) { { Gemm g{1024, 1024, 1024, nullptr}; DenseSched S{64, 12, F.G, cG, (const char*)XB, (const char*)(ws + WS_WQKV), (size_t)256 * 1024 * 2, (size_t)256 * 1024 * 2};
        EpiQKV E{QB_, KB_, VB_, (const float*)(ws + WS_ROPE), (float*)(ws + WS_KSUM), (LAS float*)(F.lds + LX_ROPE)};
        pg8::gemm_phase<EpiQKV, DenseSched, true, false>(ring, g, S, E); } }
    SEAM(1);
    PH(2) { if (isConv) CONV_SLICE(0, 1000); else {
        const attn_body::AttnTensors AT{(const attn_body::bf16*)QB_, (const attn_body::bf16*)KB_, (const attn_body::bf16*)VB_, (attn_body::bf16*)QB_, (const float*)(ws + WS_KSUM)};
        if (NCONV == 0) { const attn_body::StaticOrder S((int)F.G, (int)blockIdx.x); attn_body::attn_phase<attn_body::StaticOrder>((char*)lds + RING_OFF, AT, S); }
        else { const attn_body::SnakeOrder S{cG, Gc}; attn_body::attn_phase<attn_body::SnakeOrder>((char*)lds + RING_OFF, AT, S); } } }
    SEAM(2);
    PH(3) { { Gemm g{1024, 1024, 1024, nullptr}; DenseSched S{64, 4, F.G, cG, (const char*)QB_, (const char*)(ws + WS_WO), (size_t)256 * 1024 * 2, (size_t)256 * 1024 * 2};
        EpiZ E{XB, R0, DBG_ATTN_MUL}; pg8::gemm_phase<EpiZ, DenseSched, true, false>(ring, g, S, E); } }
    SEAM(3);
    PH(4) phase_ln_router(F, R0, R1, ln_mix_g, ln_mix_b, router_b, 0, 0);
    SEAM(4);
    PH(5) { const int nT = moe_tables(F, 0); LAS unsigned short* tokl = (LAS unsigned short*)(F.lds + LX_TOKL);
        { const unsigned short* rowtok = (const unsigned short*)(ws + WS_ROWTOK); const LAS int* tile_e = (const LAS int*)(F.lds + LX_TILEE); const LAS int* tbase = (const LAS int*)(F.lds + LX_TBASE);
          for (int i = 0; i < TOKL_ROUNDS; ++i) { int pm, pn, hf; if (!moe_unit(i, F.G, cG, nT, 8, pm, pn, hf)) break;
              if (F.tid < 256) { const int e = tile_e[pm]; const int r = (pm - tbase[e]) * 256 + F.tid; const int c = (int)__hip_atomic_load(F.ctl + CW_CNT + 0 * 2048 + e * 64, RLX_AGENT);
                  tokl[i * 256 + F.tid] = (r < c) ? rowtok[(size_t)e * NTOK + r] : (unsigned short)0; } }
          __syncthreads(); }
        Gemm g{512, 512, 512, (const char*)XB};
        MoeSched S{nT, 8, F.G, cG, (const LAS int*)(F.lds + LX_TILEE), (const LAS int*)(F.lds + LX_TBASE), tokl, nullptr, (const char*)(ws + WS_WGU) + (size_t)0 * 32 * 2048 * 1024, 0, (size_t)2048 * 1024, (size_t)256 * 1024};
        EpiGU E{b_gu + (size_t)0 * 32 * 2048, (unsigned char*)HB, (LAS float*)(F.lds + LX_BIAS), 0}; pg8::gemm_phase<EpiGU, MoeSched, true, true, true, true>(ring, g, S, E); }
    SEAM(5);
    PH(6) { const int nT = moe_tables(F, 0); Gemm g{512, 512, 512, nullptr};
        MoeSched S{nT, 4, F.G, cG, (const LAS int*)(F.lds + LX_TILEE), (const LAS int*)(F.lds + LX_TBASE), nullptr, (const char*)HB, (const char*)(ws + WS_WD) + (size_t)0 * 32 * 1024 * 1024, (size_t)256 * 1024, (size_t)1024 * 1024, (size_t)256 * 1024};
        EpiDN E{b_dn + (size_t)0 * 32 * 1024, (unsigned char*)YB, (LAS float*)(F.lds + LX_BIAS), 0}; pg8::gemm_phase<EpiDN, MoeSched, true, false, true, true>(ring, g, S, E); }
    SEAM(6);
    PH(7) phase_combine<true>(F, R1, nullptr, ln_ffn_g, ln_ffn_b, AIN(5), 0);
    { F.lane = (int)attn_body::lane_now(); F.tid = F.wave * 64 + F.lane; }
    SEAM(7);
    PH(8) phase_gate_scan(F);
    SEAM(8);
    PH(9) {
        { Gemm g{1024, 1024, 1024, nullptr}; DenseSched S{64, 8, F.G, cG, (const char*)XB, (const char*)(ws + WS_WINA), (size_t)256 * 1024 * 2, (size_t)256 * 1024 * 2};
          EpiINA E{(const float*)(ws + WS_RF), (const float*)(ws + WS_CF), (bf16_t*)(ws + WS_AE), (bf16_t*)(ws + WS_KN), (bf16_t*)(ws + WS_OS)};
          pg8::gemm_phase<EpiINA, DenseSched, true, false>(ring, g, S, E); }
        { Gemm g{1024, 1024, 1024, nullptr}; DenseSched S{6, 64, F.G, cG, (const char*)(ws + WS_WINB), (const char*)XB, (size_t)256 * 1024 * 2, (size_t)256 * 1024 * 2, true};
          EpiINB E{(const float*)(ws + WS_CF), (bf16_t*)(ws + WS_KT), (bf16_t*)(ws + WS_BE)};
          pg8::gemm_phase<EpiINB, DenseSched, true, false, false, true>(ring, g, S, E); }
    }
    SEAM(9);
    PH(10) { Gemm g{256, 384, NTOK, nullptr}; MuSched S{F.G, cG, 0, (const char*)(ws + WS_BE), (const char*)(ws + WS_KT)};
        EpiM1 E{(bf16_t*)(ws + WS_UT)}; pg8::gemm_phase<EpiM1, MuSched, true, false, false, true>(ring, g, S, E);
        phase_nu(F); }
    SEAM(10);
    PH(11) phase_state_scan(F);
    SEAM(11);
    PH(12) { Gemm g{128, 512, 1024, nullptr}; MuSched S{F.G, cG, 1, (const char*)(ws + WS_AE), (const char*)(ws + WS_KN)};
        EpiM2A E{(bf16_t*)(ws + WS_AE), (const float*)(ws + WS_NPREV), (float*)(ws + WS_DEN)}; pg8::gemm_phase<EpiM2A, MuSched, true, false>(ring, g, S, E); }
    SEAM(12);
    PH(13) { Gemm g{384, 512, 384, nullptr}; MuSched S{F.G, cG, 2, (const char*)(ws + WS_AE), (const char*)(ws + WS_BE)};
        EpiM2B E{(const float*)(ws + WS_DEN), AIN(6), (const bf16_t*)(ws + WS_OS), (bf16_t*)(ws + WS_HN), (LAS float*)(F.lds + LX_LNX)};
        pg8::gemm_phase<EpiM2B, MuSched, true, false>(ring, g, S, E); }
    SEAM(13);
    PH(14) { Gemm g{1024, 1024, 1024, nullptr}; DenseSched S{64, 4, F.G, cG, (const char*)(ws + DBG_P14_A), (const char*)(ws + WS_WOUT), (size_t)256 * 1024 * 2, (size_t)256 * 1024 * 2};
        EpiZ E{XB, R0, DBG_MLSTM_MUL}; pg8::gemm_phase<EpiZ, DenseSched, true, false>(ring, g, S, E); }
    SEAM(14);
    PH(15) phase_ln_router(F, R0, R1, ln_mix_g + 1024, ln_mix_b + 1024, router_b + 32, 1, 1);
    SEAM(15);
    PH(16) { const int nT = moe_tables(F, 1); LAS unsigned short* tokl = (LAS unsigned short*)(F.lds + LX_TOKL);
        { const unsigned short* rowtok = (const unsigned short*)(ws + WS_ROWTOK); const LAS int* tile_e = (const LAS int*)(F.lds + LX_TILEE); const LAS int* tbase = (const LAS int*)(F.lds + LX_TBASE);
          for (int i = 0; i < TOKL_ROUNDS; ++i) { int pm, pn, hf; if (!moe_unit(i, F.G, cG, nT, 8, pm, pn, hf)) break;
              if (F.tid < 256) { const int e = tile_e[pm]; const int r = (pm - tbase[e]) * 256 + F.tid; const int c = (int)__hip_atomic_load(F.ctl + CW_CNT + 1 * 2048 + e * 64, RLX_AGENT);
                  tokl[i * 256 + F.tid] = (r < c) ? rowtok[(size_t)e * NTOK + r] : (unsigned short)0; } }
          __syncthreads(); }
        Gemm g{512, 512, 512, (const char*)XB};
        MoeSched S{nT, 8, F.G, cG, (const LAS int*)(F.lds + LX_TILEE), (const LAS int*)(F.lds + LX_TBASE), tokl, nullptr, (const char*)(ws + WS_WGU) + (size_t)1 * 32 * 2048 * 1024, 0, (size_t)2048 * 1024, (size_t)256 * 1024};
        EpiGU E{b_gu + (size_t)1 * 32 * 2048, (unsigned char*)HB, (LAS float*)(F.lds + LX_BIAS), 0}; pg8::gemm_phase<EpiGU, MoeSched, true, true, true, true>(ring, g, S, E); }
    SEAM(16);
    PH(17) { const int nT = moe_tables(F, 1); Gemm g{512, 512, 512, nullptr};
        MoeSched S{nT, 4, F.G, cG, (const LAS int*)(F.lds + LX_TILEE), (const LAS int*)(F.lds + LX_TBASE), nullptr, (const char*)HB, (const char*)(ws + WS_WD) + (size_t)1 * 32 * 1024 * 1024, (size_t)256 * 1024, (size_t)1024 * 1024, (size_t)256 * 1024};
        EpiDN E{b_dn + (size_t)1 * 32 * 1024, (unsigned char*)YB, (LAS float*)(F.lds + LX_BIAS), 0}; pg8::gemm_phase<EpiDN, MoeSched, true, false, true, true>(ring, g, S, E); }
    SEAM(17);
    PH(18) phase_combine<false>(F, R1, (float*)AIN(18), ln_ffn_g + 1024, ln_ffn_b + 1024, nullptr, 1);
#undef IN
#undef CONV_SLICE
#undef AIN
#undef x_in
#undef ln_mix_g
#undef ln_mix_b
#undef ln_ffn_g
#undef ln_ffn_b
#undef router_b
#undef b_gu
#undef b_dn
#undef SEAM
}

extern "C" void kernel_launch(void* const* d_in, const int* in_sizes, int n_in, void* d_out, int out_size, void* d_ws, size_t ws_size, hipStream_t stream) {
    static int grid = 0;
    if (grid == 0) {
        if (n_in != 18 || out_size != NTOK * DM || ws_size < WS_END) { fprintf(stderr, "kernel_launch: unexpected problem shape (n_in %d, out %d, ws %zu)\n", n_in, out_size, ws_size); grid = -1; return; }
        int dev = 0, cus = 0, per_cu = 0;
        if (hipGetDevice(&dev) != hipSuccess || hipDeviceGetAttribute(&cus, hipDeviceAttributeMultiprocessorCount, dev) != hipSuccess) { grid = -1; return; }
        if (hipFuncSetAttribute((const void*)mk_fwd, hipFuncAttributeMaxDynamicSharedMemorySize, LDS_BYTES) != hipSuccess) { fprintf(stderr, "kernel_launch: hipFuncSetAttribute failed\n"); grid = -1; return; }
        if (hipOccupancyMaxActiveBlocksPerMultiprocessor(&per_cu, (const void*)mk_fwd, NTHR, LDS_BYTES) != hipSuccess || per_cu < 1) fprintf(stderr, "kernel_launch: occupancy query reports %d\n", per_cu);
        (void)hipGetLastError();
        grid = cus;
        if (grid > 256) grid = 256;
        if (grid < 240) { fprintf(stderr, "kernel_launch: %d CUs: this build needs 240..256\n", cus); grid = -1; return; }
    }
    if (grid < 0) return;
    if (hipMemsetAsync((char*)d_ws + WS_CTL, 0, CTL_ZERO_BYTES, stream) != hipSuccess) return;
    Args a{};
    for (int i = 0; i < 18; ++i) a.in[i] = (const float*)d_in[i];
    a.out = (float*)d_out; a.ws = (unsigned char*)d_ws;
#if MK_ONE_LAUNCH
    a.ph_lo = 0; a.ph_hi = NPHASE;
    hipLaunchKernelGGL(mk_fwd, dim3(grid), dim3(NTHR), LDS_BYTES, stream, a);
#else
    for (int p = 0; p < NPHASE; ++p) { a.ph_lo = p; a.ph_hi = p + 1; hipLaunchKernelGGL(mk_fwd, dim3(grid), dim3(NTHR), LDS_BYTES, stream, a); }
#endif
}
```

```cpp
#include <hip/hip_runtime.h>
#include <hip/hip_bf16.h>
#include <cstdio>
#include <cstdint>
#include <cmath>

#define LAS __attribute__((address_space(3)))
#define GAS __attribute__((address_space(1)))
typedef unsigned short bf16_t;
typedef short bf16x8 __attribute__((ext_vector_type(8)));
typedef float f32x4 __attribute__((ext_vector_type(4)));
typedef float f32x2 __attribute__((ext_vector_type(2)));
typedef unsigned u32x4 __attribute__((ext_vector_type(4)));
typedef unsigned u32x2 __attribute__((ext_vector_type(2)));
typedef int i32x4 __attribute__((ext_vector_type(4)));
typedef int i32x8 __attribute__((ext_vector_type(8)));

typedef __bf16 bf16x2_t __attribute__((ext_vector_type(2)));
__device__ __forceinline__ unsigned cvt_pk_bf16(float lo, float hi) { const f32x2 v = {lo, hi}; const bf16x2_t b = __builtin_convertvector(v, bf16x2_t); return __builtin_bit_cast(unsigned, b); }
__device__ __forceinline__ float bf2f(unsigned short b) { return __uint_as_float(((unsigned)b) << 16); }
__device__ __forceinline__ float bflo(unsigned w) { return __uint_as_float(w << 16); }
__device__ __forceinline__ float bfhi(unsigned w) { return __uint_as_float(w & 0xffff0000u); }

__device__ __forceinline__ void glds16s(const void* sbase, unsigned voff, unsigned lds_dst) { unsigned keep;
    asm volatile("s_nop 4\n\ts_mov_b32 %0, m0\n\ts_mov_b32 m0, %3\n\ts_nop 0\n\tglobal_load_lds_dwordx4 %1, %2\n\ts_mov_b32 m0, %0" : "=&s"(keep) : "v"(voff), "s"(sbase), "s"(lds_dst) : "memory"); }
__device__ __forceinline__ void glds4s(const void* sbase, unsigned voff, unsigned lds_dst) { unsigned keep;
    asm volatile("s_nop 4\n\ts_mov_b32 %0, m0\n\ts_mov_b32 m0, %3\n\ts_nop 0\n\tglobal_load_lds_dword %1, %2\n\ts_mov_b32 m0, %0" : "=&s"(keep) : "v"(voff), "s"(sbase), "s"(lds_dst) : "memory"); }
__device__ __forceinline__ const char* uni_ptr(const char* p) { const unsigned long long v = (unsigned long long)p; const unsigned lo = __builtin_amdgcn_readfirstlane((unsigned)v), hi = __builtin_amdgcn_readfirstlane((unsigned)(v >> 32)); return (const char*)(((unsigned long long)hi << 32) | lo); }
namespace pg8 {
constexpr int BM = 256, BK = 64, HALF = 128, HTB = HALF * BK * 2, STAGE_BYTES = 8 * HTB, NXCD = 8, WGM = 8;
__host__ __device__ __forceinline__ int lds_byte(int r, int c) { const int st = (r >> 4) * 2 + (c >> 5), rr = r & 15, cc = c & 31, ob = rr * 64 + cc * 2; return st * 1024 + (ob ^ (((ob >> 9) & 1) << 5)); }
__host__ __device__ __forceinline__ void stage_rc(int b, int& R, int& C) { const int st = b / 1024, sb = b % 1024, swz = sb ^ (((sb >> 9) & 1) << 5); R = (st >> 1) * 16 + swz / 64; C = (st & 1) * 32 + (swz % 64) / 2; }
__host__ __device__ __forceinline__ int perm32(int rho) { const int n = rho >> 4, i = rho & 15; return 8 * (i >> 2) + 4 * n + (i & 3); }

struct Unit { int pm, pn; const char* A; const char* B; const LAS unsigned short* tl; int x0, x1, x2; };
struct Gemm { int K, lda, ldb; const char* Abase; };

__device__ __forceinline__ bool tile_order(int i, int G, int c, int nM, int nN, int& pm, int& pn) {
    const int nwg = nM * nN; const long L = (long)i * G + c; if (L >= nwg) return false;
    int wgid = (int)L; { const int q = nwg / NXCD, r = nwg % NXCD, xcd = wgid % NXCD, off = wgid / NXCD; wgid = (xcd < r ? xcd * (q + 1) : r * (q + 1) + (xcd - r) * q) + off; }
    const int nig = WGM * nN, gid = wgid / nig, fm = gid * WGM, gsz = (nM - fm) < WGM ? (nM - fm) : WGM;
    pm = fm + ((wgid % nig) % gsz); pn = (wgid % nig) / gsz; return true;
}

template <class Epi, class Sched, bool ALIGN_EPI, bool GATHER, bool FP8 = false, bool HALFSEL = false>
__device__ __forceinline__ void gemm_phase(LAS unsigned char* lds, const Gemm g, const Sched& S, const Epi& E) {
    const int tid = threadIdx.x, wid = __builtin_amdgcn_readfirstlane(tid >> 6), lane = tid & 63, wr = wid >> 2, wc = wid & 3, fr = lane & 15, fq = lane >> 4;
    const int K = g.K, nt = K / BK;
    int RA[2]; unsigned cA2[2], voffB[2];
#pragma unroll
    for (int i = 0; i < 2; ++i) { int R, C; stage_rc(tid * 16 + i * 8192, R, C); const int Rb = Epi::PERM ? ((R & ~31) + perm32(R & 31)) : R;
        RA[i] = R; cA2[i] = (unsigned)C * 2u; voffB[i] = (unsigned)(Rb * g.ldb + C) * 2u; }
    const size_t kstep = (size_t)(BK * 2);
    const unsigned hstepA = (unsigned)HALF * (unsigned)g.lda * 2u; const size_t hstepB = (size_t)HALF * g.ldb * 2;
    const unsigned ldsb = (unsigned)__builtin_amdgcn_readfirstlane((unsigned)(unsigned long long)lds + (unsigned)wid * 1024u);
    const int aoff = lds_byte(wr * 64 + fr, fq * 8), boff = lds_byte(wc * 32 + fr, fq * 8);
    const int aoff2 = aoff + 1024, boff2 = boff + 1024;
#define PG8_SA(b, h) (((b) * 2 + (h)) * HTB)
#define PG8_SB(b, h) ((4 + (b) * 2 + (h)) * HTB)
#define PG8_STAGE(bufoff, gbase, voff) do { _Pragma("unroll") for (int _i = 0; _i < 2; ++_i) glds16s((gbase), (voff)[_i], ldsb + (unsigned)(bufoff) + _i * 8192u); } while (0)
#define PG8_STAGE_A(bufoff, gbase, AO, h) do { _Pragma("unroll") for (int _i = 0; _i < 2; ++_i) glds16s((gbase), (AO)[h][_i], ldsb + (unsigned)(bufoff) + _i * 8192u); } while (0)
#define PG8_LD8(base_, o1_, o2_) __builtin_shufflevector(*(const LAS i32x4*)(lds + (base_) + (o1_)), *(const LAS i32x4*)(lds + (base_) + (o2_)), 0, 1, 2, 3, 4, 5, 6, 7)
#define PG8_LDA(dst, b, h) do { if constexpr (FP8) { _Pragma("unroll") for (int m = 0; m < 4; ++m) dst##8[m] = PG8_LD8(PG8_SA(b, h) + m * 2048, aoff, aoff2); } \
        else { _Pragma("unroll") for (int m = 0; m < 4; ++m) _Pragma("unroll") for (int k = 0; k < 2; ++k) dst[m][k] = *(const LAS bf16x8*)(lds + PG8_SA(b, h) + aoff + m * 2048 + k * 1024); } } while (0)
#define PG8_LDB(dst, b, h) do { if constexpr (FP8) { _Pragma("unroll") for (int n = 0; n < 2; ++n) dst##8[n] = PG8_LD8(PG8_SB(b, h) + n * 2048, boff, boff2); } \
        else { _Pragma("unroll") for (int n = 0; n < 2; ++n) _Pragma("unroll") for (int k = 0; k < 2; ++k) dst[n][k] = *(const LAS bf16x8*)(lds + PG8_SB(b, h) + boff + n * 2048 + k * 1024); } } while (0)
#define PG8_MMA(ai, bj, At, Bt) do { __builtin_amdgcn_s_setprio(1); _Pragma("unroll") for (int m = 0; m < 4; ++m) _Pragma("unroll") for (int n = 0; n < 2; ++n) { \
        if constexpr (FP8) asm volatile("v_mfma_f32_16x16x128_f8f6f4 %0, %1, %2, %0" : "+v"(acc[ai][bj][m][n]) : "v"(Bt##8[n]), "v"(At##8[m])); \
        else { _Pragma("unroll") for (int k = 0; k < 2; ++k) acc[ai][bj][m][n] = __builtin_amdgcn_mfma_f32_16x16x32_bf16(Bt[n][k], At[m][k], acc[ai][bj][m][n], 0, 0, 0); } } \
        __builtin_amdgcn_s_setprio(0); } while (0)
#define PG8_WAIT_V(n) asm volatile("s_waitcnt vmcnt(" #n ")" ::: "memory")
#define PG8_WAIT_L(n) asm volatile("s_waitcnt lgkmcnt(" #n ")" ::: "memory")
#define PG8_BAR __builtin_amdgcn_s_barrier()
#define PG8_SCHED __builtin_amdgcn_sched_barrier(0)
#define PG8_AOFF(AO, U) do { _Pragma("unroll") for (int _h = 0; _h < 2; ++_h) _Pragma("unroll") for (int _i = 0; _i < 2; ++_i) { \
        if constexpr (GATHER) AO[_h][_i] = (unsigned)(U).tl[RA[_i] + _h * HALF] * (unsigned)(g.lda * 2) + cA2[_i]; \
        else AO[_h][_i] = (unsigned)RA[_i] * (unsigned)(g.lda * 2) + cA2[_i] + (unsigned)_h * hstepA; } } while (0)
    Unit cur, nxt; int ui = 0;
    if (!S.next(0, cur)) return;
    f32x4 acc[2][2][4][2];
#pragma unroll
    for (int a = 0; a < 2; ++a)
#pragma unroll
        for (int b = 0; b < 2; ++b)
#pragma unroll
            for (int m = 0; m < 4; ++m)
#pragma unroll
                for (int n = 0; n < 2; ++n) acc[a][b][m][n] = (f32x4){0.f, 0.f, 0.f, 0.f};
    bf16x8 At[4][2], B0[2][2], B1[2][2]; i32x8 At8[4], B08[2], B18[2];
    E.prep(cur, 0, wid, lane);
    unsigned aoC[2][2], aoN[2][2];
    PG8_AOFF(aoC, cur);
    const char* cA = uni_ptr(GATHER ? g.Abase : cur.A); const char* cB = uni_ptr(cur.B);
    PG8_STAGE(PG8_SB(0, 0), cB, voffB); PG8_STAGE(PG8_SB(0, 1), cB + hstepB, voffB); PG8_STAGE_A(PG8_SA(0, 0), cA, aoC, 0); PG8_STAGE_A(PG8_SA(0, 1), cA, aoC, 1);
    if (wr == 1) PG8_BAR;
    PG8_WAIT_V(2); PG8_BAR;
    PG8_STAGE(PG8_SB(1, 0), cB + kstep, voffB); PG8_STAGE_A(PG8_SA(1, 0), cA + kstep, aoC, 0); PG8_STAGE(PG8_SB(1, 1), cB + hstepB + kstep, voffB);
    PG8_WAIT_V(6); PG8_BAR;
    for (;;) {
        const bool has_next = S.next(ui + 1, nxt);
        if (has_next) E.prep(nxt, ui + 1, wid, lane);
        if constexpr (GATHER) { if (has_next) PG8_AOFF(aoN, nxt); else { _Pragma("unroll") for (int _h = 0; _h < 2; ++_h) _Pragma("unroll") for (int _i = 0; _i < 2; ++_i) aoN[_h][_i] = aoC[_h][_i]; } }
        const char* nA = uni_ptr(GATHER ? g.Abase : (has_next ? nxt.A : cA)); const char* nB = uni_ptr(has_next ? nxt.B : cB);
        const bool dh0 = cur.x2 != 2, dh1 = cur.x2 != 1;
#pragma nounroll
        for (int t = 0; t < nt; t += 2) {
            const bool last = (t == nt - 2);
            if constexpr (Epi::MID) { if (t == 2) E.prep_mid(cur, wid, lane); }
            const char* a1 = cA + (size_t)(t + 1) * kstep;
            const char* a2 = last ? nA : cA + (size_t)(t + 2) * kstep; const char* b2 = last ? nB : cB + (size_t)(t + 2) * kstep;
            const char* a3 = a2 + kstep; const char* b3 = b2 + kstep;
            unsigned aoS[2][2];
#pragma unroll
            for (int _h = 0; _h < 2; ++_h)
#pragma unroll
                for (int _i = 0; _i < 2; ++_i) aoS[_h][_i] = (GATHER && last) ? aoN[_h][_i] : aoC[_h][_i];
            PG8_LDB(B0, 0, 0); PG8_LDB(B1, 0, 1); PG8_SCHED; PG8_LDA(At, 0, 0); PG8_STAGE_A(PG8_SA(1, 1), a1, aoC, 1);
            PG8_WAIT_V(8); PG8_WAIT_L(0); PG8_BAR; if (!HALFSEL || dh0) PG8_MMA(0, 0, At, B0); if (!HALFSEL || dh1) PG8_MMA(0, 1, At, B1); PG8_BAR; PG8_SCHED;
            PG8_LDA(At, 0, 1); PG8_STAGE(PG8_SB(0, 0), b2, voffB); PG8_STAGE(PG8_SB(0, 1), b2 + hstepB, voffB); PG8_STAGE_A(PG8_SA(0, 0), a2, aoS, 0);
            PG8_WAIT_V(8); PG8_WAIT_L(0); PG8_BAR; if (!HALFSEL || dh0) PG8_MMA(1, 0, At, B0); if (!HALFSEL || dh1) PG8_MMA(1, 1, At, B1); PG8_BAR; PG8_SCHED;
            PG8_LDB(B0, 1, 0); PG8_LDB(B1, 1, 1); PG8_SCHED; PG8_LDA(At, 1, 0); PG8_STAGE_A(PG8_SA(0, 1), a2, aoS, 1);
            PG8_WAIT_V(8); PG8_WAIT_L(0); PG8_BAR; if (!HALFSEL || dh0) PG8_MMA(0, 0, At, B0); if (!HALFSEL || dh1) PG8_MMA(0, 1, At, B1); PG8_BAR; PG8_SCHED;
            PG8_LDA(At, 1, 1); PG8_STAGE(PG8_SB(1, 0), b3, voffB); PG8_STAGE(PG8_SB(1, 1), b3 + hstepB, voffB); PG8_STAGE_A(PG8_SA(1, 0), a3, aoS, 0);
            PG8_WAIT_V(8); PG8_WAIT_L(0); PG8_BAR; if (!HALFSEL || dh0) PG8_MMA(1, 0, At, B0); if (!HALFSEL || dh1) PG8_MMA(1, 1, At, B1); PG8_BAR; PG8_SCHED;
        }
        if constexpr (FP8) asm volatile("s_nop 15\n\ts_nop 15" ::: "memory");
        if constexpr (ALIGN_EPI) { if (wr == 0) PG8_BAR; }
        E(acc, cur, wr, wc, fr, fq);
        if (!has_next) break;
#pragma unroll
        for (int a = 0; a < 2; ++a)
#pragma unroll
            for (int b = 0; b < 2; ++b)
#pragma unroll
                for (int m = 0; m < 4; ++m)
#pragma unroll
                    for (int n = 0; n < 2; ++n) acc[a][b][m][n] = (f32x4){0.f, 0.f, 0.f, 0.f};
        if constexpr (FP8) asm volatile("s_nop 7" ::: "memory");
        cur = nxt; cA = nA; cB = nB; ++ui;
        if constexpr (GATHER) {
#pragma unroll
            for (int _h = 0; _h < 2; ++_h)
#pragma unroll
                for (int _i = 0; _i < 2; ++_i) aoC[_h][_i] = aoN[_h][_i]; }
        if constexpr (ALIGN_EPI) { if (wr == 1) PG8_BAR; }
    }
    PG8_WAIT_V(0);
    if constexpr (!ALIGN_EPI) { if (wr == 0) PG8_BAR; }
    PG8_BAR;
#undef PG8_SA
#undef PG8_SB
#undef PG8_STAGE
#undef PG8_STAGE_A
#undef PG8_LDA
#undef PG8_LD8
#undef PG8_LDB
#undef PG8_MMA
#undef PG8_WAIT_V
#undef PG8_WAIT_L
#undef PG8_BAR
#undef PG8_SCHED
#undef PG8_AOFF
}
}
#include <hip/hip_bf16.h>
namespace attn_body {
using bf16=__hip_bfloat16;
using bf16x8=__attribute__((ext_vector_type(8)))short;
using s16x4=__attribute__((ext_vector_type(4)))short;
using f32x16=__attribute__((ext_vector_type(16)))float;
using u32x4=__attribute__((ext_vector_type(4)))unsigned;
constexpr int BATCH=4,NHEAD=16,SEQ=4096,D=64,DM=NHEAD*D;
constexpr int NW=8,QBLK=32,QB=QBLK*NW,KVBLK=64,NQB=SEQ/QB;
constexpr int ATTN_PITCH=DM, ATTN_UNIT_ROWS=QB;
__device__ __forceinline__ int crow(int r,int hi){return (r&3)+8*(r>>2)+4*hi;}
#define SBAR() __builtin_amdgcn_sched_barrier(0)
__device__ __forceinline__ void cmask(f32x16&p0,f32x16&p1,int jb,int qrel,int hi){
  const float NEG=-INFINITY; int d=qrel-64*jb-4*hi; asm volatile("":"+v"(d));
  #pragma unroll
  for(int r=0;r<16;++r){const int c=(r&3)+8*(r>>2); if(c>d)p0[r]=NEG; if(c+32>d)p1[r]=NEG;}
}

constexpr int NSLOT=3, SLOTB=8192;
constexpr int LDS_GT=98304;
constexpr int LDS_K=0, LDS_V=NSLOT*SLOTB, LDS_WS=2*NSLOT*SLOTB, LDS_OST=LDS_WS+NW*64*4, LDS_BYTES=LDS_OST+NW*4096;
constexpr float C2=0.125f*1.4426950408889634f;
__device__ __forceinline__ void glds16(const void*gsrc,unsigned lds_dst){unsigned keep;
  asm volatile("s_mov_b32 %0, m0\n\ts_mov_b32 m0, %2\n\ts_nop 0\n\tglobal_load_lds_dwordx4 %1, off\n\ts_mov_b32 m0, %0":"=&s"(keep):"v"(gsrc),"s"(lds_dst):"memory");}
__device__ __forceinline__ void glds16s(const void*sbase,unsigned voff,unsigned lds_dst){unsigned keep;
  asm volatile("s_nop 4\n\ts_mov_b32 %0, m0\n\ts_mov_b32 m0, %3\n\ts_nop 0\n\tglobal_load_lds_dwordx4 %1, %2\n\ts_mov_b32 m0, %0":"=&s"(keep):"v"(voff),"s"(sbase),"s"(lds_dst):"memory");}
__device__ __forceinline__ unsigned lane_now(){unsigned l;asm volatile("v_mbcnt_lo_u32_b32 %0, -1, 0\n\tv_mbcnt_hi_u32_b32 %0, -1, %0":"=v"(l));return l;}
__device__ __forceinline__ float max3f(float a,float b,float c){float r;asm("v_max3_f32 %0, %1, %2, %3":"=v"(r):"v"(a),"v"(b),"v"(c));return r;}
__device__ __forceinline__ float max2f(float a,float b){float r;asm("v_max_f32_e32 %0, %1, %2":"=v"(r):"v"(a),"v"(b));return r;}
__device__ __forceinline__ float fadd_s(float a,float b){float r;asm("v_add_f32_e32 %0, %1, %2":"=v"(r):"v"(a),"v"(b));return r;}
__device__ __forceinline__ float fsub_s(float a,float b){float r;asm("v_sub_f32_e32 %0, %1, %2":"=v"(r):"v"(a),"v"(b));return r;}
typedef float f32x2_t __attribute__((ext_vector_type(2))); typedef __bf16 bf16x2_t __attribute__((ext_vector_type(2)));
__device__ __forceinline__ unsigned cvtpk_s(float lo,float hi){f32x2_t v={lo,hi};bf16x2_t b=__builtin_convertvector(v,bf16x2_t);return __builtin_bit_cast(unsigned,b);}
#define WAIT_BAR(N) asm volatile("s_waitcnt vmcnt(" #N ") lgkmcnt(0)\n\ts_barrier":::"memory")

__device__ __forceinline__ void qkt(f32x16&p0,f32x16&p1,const char*Kslot,const bf16x8*qr,int r32,int hi){
  const char*kb=Kslot+hi*1024+r32*16;
  #pragma unroll
  for(int d0=0;d0<4;++d0){
    const bf16x8 b0=*reinterpret_cast<const bf16x8*>(kb+d0*2048);
    const bf16x8 b1=*reinterpret_cast<const bf16x8*>(kb+d0*2048+512);
    if(d0==0){p0=__builtin_amdgcn_mfma_f32_32x32x16_bf16(b0,qr[0],(f32x16){0.f,0.f,0.f,0.f,0.f,0.f,0.f,0.f,0.f,0.f,0.f,0.f,0.f,0.f,0.f,0.f},0,0,0);p1=__builtin_amdgcn_mfma_f32_32x32x16_bf16(b1,qr[0],(f32x16){0.f,0.f,0.f,0.f,0.f,0.f,0.f,0.f,0.f,0.f,0.f,0.f,0.f,0.f,0.f,0.f},0,0,0);}
    else{p0=__builtin_amdgcn_mfma_f32_32x32x16_bf16(b0,qr[d0],p0,0,0,0);p1=__builtin_amdgcn_mfma_f32_32x32x16_bf16(b1,qr[d0],p1,0,0,0);}}
}
typedef __attribute__((address_space(3))) const char* lds_cptr;
typedef short v4i16_t __attribute__((ext_vector_type(4)));
__device__ __forceinline__ void kload8(bf16x8*kf,lds_cptr kp){
  kf[0]=*(const __attribute__((address_space(3))) bf16x8*)(kp);      kf[1]=*(const __attribute__((address_space(3))) bf16x8*)(kp+512);
  kf[2]=*(const __attribute__((address_space(3))) bf16x8*)(kp+2048); kf[3]=*(const __attribute__((address_space(3))) bf16x8*)(kp+2560);
  kf[4]=*(const __attribute__((address_space(3))) bf16x8*)(kp+4096); kf[5]=*(const __attribute__((address_space(3))) bf16x8*)(kp+4608);
  kf[6]=*(const __attribute__((address_space(3))) bf16x8*)(kp+6144); kf[7]=*(const __attribute__((address_space(3))) bf16x8*)(kp+6656);
}
__device__ __forceinline__ void kload2(bf16x8*kf,lds_cptr kp,int j){ kf[2*j]=*(const __attribute__((address_space(3))) bf16x8*)(kp+j*2048); kf[2*j+1]=*(const __attribute__((address_space(3))) bf16x8*)(kp+j*2048+512); }
__device__ __forceinline__ s16x4 vtr(lds_cptr p){ return __builtin_bit_cast(s16x4,__builtin_amdgcn_ds_read_tr16_b64_v4i16((__attribute__((address_space(3))) v4i16_t*)p)); }
__device__ __forceinline__ float rowmax(const f32x16&p0,const f32x16&p1){
  float a=max3f(p0[0],p0[1],p1[0]),b=max3f(p0[2],p0[3],p1[1]);a=max3f(a,p1[2],p1[3]);
  #pragma unroll
  for(int r=4;r<16;r+=4){a=max3f(a,p0[r],p0[r+1]);b=max3f(b,p0[r+2],p0[r+3]);a=max3f(a,p1[r],p1[r+1]);b=max3f(b,p1[r+2],p1[r+3]);}
  const float m=max2f(a,b);
  auto rr=__builtin_amdgcn_permlane32_swap(__float_as_uint(m),__float_as_uint(m),false,false);
  return max2f(__uint_as_float(rr[0]),__uint_as_float(rr[1]));
}
__device__ __forceinline__ void pv(f32x16*o,int vb,bf16x8 pa0,bf16x8 pa1,bf16x8 pa2,bf16x8 pa3){
  #pragma unroll
  for(int d0=0;d0<2;++d0){s16x4 lo[4],hi[4];
    #pragma unroll
    for(int ks=0;ks<4;++ks){
      asm volatile("ds_read_b64_tr_b16 %0,%1 offset:%c2":"=&v"(lo[ks]):"v"(vb),"i"(d0*4096+ks*1024):"memory");
      asm volatile("ds_read_b64_tr_b16 %0,%1 offset:%c2":"=&v"(hi[ks]):"v"(vb),"i"(d0*4096+ks*1024+512):"memory");}
    asm volatile("s_waitcnt lgkmcnt(0)":::"memory");SBAR();
    #define PK(k) (bf16x8){lo[k][0],lo[k][1],lo[k][2],lo[k][3],hi[k][0],hi[k][1],hi[k][2],hi[k][3]}
    o[d0]=__builtin_amdgcn_mfma_f32_32x32x16_bf16(pa0,PK(0),o[d0],0,0,0);
    o[d0]=__builtin_amdgcn_mfma_f32_32x32x16_bf16(pa1,PK(1),o[d0],0,0,0);
    o[d0]=__builtin_amdgcn_mfma_f32_32x32x16_bf16(pa2,PK(2),o[d0],0,0,0);
    o[d0]=__builtin_amdgcn_mfma_f32_32x32x16_bf16(pa3,PK(3),o[d0],0,0,0);
    #undef PK
  }
}

#ifndef ATTN_STORE16
#define ATTN_STORE16(p,v) (*(u32x4*)(p)=(v))
#endif
template<int THRL> __device__ __forceinline__ void attn_unit(int b,int h,int qb,const bf16*Q,const bf16*__restrict__ K,const bf16*__restrict__ V,bf16*O,const float*ksum,char*shm){
  const int tid=threadIdx.x,lane=tid&63,r32=lane&31,hi=lane>>5; const int wid=__builtin_amdgcn_readfirstlane(tid>>6);
  const long rowbase=(long)b*SEQ; const int q0=qb*QB;
  const bf16*Qw=Q+(rowbase+q0+wid*QBLK)*DM+h*D;
  const bf16*Kh=K+rowbase*DM+h*D,*Vh=V+rowbase*DM+h*D;
  const unsigned lds0=(unsigned)(uintptr_t)shm;
  float*wsf=(float*)(shm+LDS_WS)+wid*64;
  const unsigned kdst=lds0+LDS_K+wid*1024, vdst=lds0+LDS_V+wid*1024;
  #define PHYS(t) (((t)<4)?(4*qb+(t)):((t)-4))
  #define DMA_K(t,slot) glds16s((const char*)Kh+(size_t)PHYS(t)*(KVBLK*DM*2)+wid*16,lane_now()*(unsigned)(DM*2),(unsigned)__builtin_amdgcn_readfirstlane(kdst+(slot)))
  #define DMA_V(t,slot) glds16s((const char*)Vh+(size_t)PHYS(t)*(KVBLK*DM*2)+(size_t)(16*(wid&3))*(DM*2)+(wid>>2)*64,({const unsigned l_=lane_now(); (l_>>2)*(unsigned)(DM*2)+(l_&3u)*16u;}),(unsigned)__builtin_amdgcn_readfirstlane(vdst+(slot)))
  const int vb0=(int)(lds0+LDS_V)+((lane>>4)&1)*32+(lane&3)*8+(4*hi+((lane&15)>>2))*64;
  const char*Kbase=shm+LDS_K; bf16x8 kf[8];
  const lds_cptr shm3=(lds_cptr)shm; const lds_cptr kp0=shm3+LDS_K+hi*1024+r32*16; const lds_cptr vp0=shm3+LDS_V+((lane>>4)&1)*32+(lane&3)*8+(4*hi+((lane&15)>>2))*64;
  const int NT=(q0+QB)/KVBLK;
  DMA_K(0,0);DMA_V(0,0);DMA_K(1,SLOTB);
  { float*gt=(float*)(shm+LDS_GT);
    #pragma unroll
    for(int k=0;k<2;++k){ const int j=2*wid+k; if(j<qb) gt[j*64+lane]=ksum[(long)(b*16+j)*DM+h*D+lane]; } }
  bf16x8 qr[4];
  #pragma unroll
  for(int d0=0;d0<4;++d0)qr[d0]=*reinterpret_cast<const bf16x8*>(&Qw[(long)r32*DM+d0*16+hi*8]);

  unsigned sel=0u;
  float mhat=0.f,l_reg=0.f;f32x16 o[2];o[0]=f32x16{};o[1]=f32x16{};
  bf16x8 kone=(bf16x8){0,0,0,0,0,0,0,0}, qm=(bf16x8){0,0,0,0,0,0,0,0}; if(hi==0) kone[0]=(short)0x3F80;
  #define SETQM() do{ const unsigned short mb_=(unsigned short)(cvtpk_s(-mhat,0.f)&0xffffu); qm[0]=(hi==0)?(short)mb_:(short)0; asm volatile("":"+v"(qm)); }while(0)
  const int qrel=wid*QBLK+r32;
  #define CMASK(P0,P1,t) do{ const int t_=(t); if(t_<4){ const int l_=(int)lane_now(); cmask(P0,P1,t_,wid*QBLK+(l_&31),l_>>5); } else if(!((sel>>(((t_-4)>>2)&15))&1u)){ _Pragma("unroll") for(int r=0;r<16;++r){P0[r]=-INFINITY;P1[r]=-INFINITY;} } }while(0)
  bool resc=false;
  #define START(P0,P1) do{ const float rm=rowmax(P0,P1); resc=false; \
    { const float dl=__uint_as_float(cvtpk_s(rm,0.f)<<16); mhat=fadd_s(mhat,dl);          \
      _Pragma("unroll") for(int r=0;r<16;++r){P0[r]=fsub_s(P0[r],dl);P1[r]=fsub_s(P1[r],dl);} \
      SETQM(); } \
    _Pragma("unroll") for(int r=0;r<16;++r)P0[r]=__builtin_amdgcn_exp2f(P0[r]); }while(0)
  #define RESC() do{ if(resc){ asm volatile("s_waitcnt lgkmcnt(0)":::"memory"); \
      _Pragma("unroll") for(int d_=0;d_<2;++d_) _Pragma("unroll") for(int r=0;r<16;++r)o[d_][r]*=wsf[crow(r,(int)(lane_now()>>5))]; } }while(0)
  f32x16 pA0,pA1,pB0,pB1;
  int sl_prev=0,sl_cur=0,sl_next=SLOTB;
  #define ROT() do{sl_prev=sl_cur;sl_cur=sl_next;sl_next=(sl_next==(NSLOT-1)*SLOTB)?0:sl_next+SLOTB;}while(0)
  DMA_K(2,2*SLOTB);
  WAIT_BAR(3);
  { float qf[32];
    #pragma unroll
    for(int d0=0;d0<4;++d0){
      #pragma unroll
      for(int i=0;i<8;++i) qf[d0*8+i]=__uint_as_float(((unsigned)(unsigned short)qr[d0][i])<<16); }
    const float*gt=(const float*)(shm+LDS_GT)+hi*8; float g[15];
    #pragma unroll
    for(int j=0;j<15;++j){ g[j]=-INFINITY;
      if(j<qb){ const float*kp=gt+j*64; float a=0.f;
        #pragma unroll
        for(int d0=0;d0<4;++d0){ const float4 k0=*reinterpret_cast<const float4*>(kp+d0*16), k1=*reinterpret_cast<const float4*>(kp+d0*16+4);
          a+=qf[d0*8+0]*k0.x; a+=qf[d0*8+1]*k0.y; a+=qf[d0*8+2]*k0.z; a+=qf[d0*8+3]*k0.w; a+=qf[d0*8+4]*k1.x; a+=qf[d0*8+5]*k1.y; a+=qf[d0*8+6]*k1.z; a+=qf[d0*8+7]*k1.w; }
        g[j]=a+__shfl_xor(a,32); } }
    #pragma unroll
    for(int kk=0;kk<3;++kk){ float best=-INFINITY; int bj=-1;
      #pragma unroll
      for(int j=0;j<15;++j){ const bool c=(j<qb)&&!((sel>>j)&1u)&&(g[j]>best); best=c?g[j]:best; bj=c?j:bj; }
      if(bj>=0) sel|=(1u<<bj); } }
  qkt(pA0,pA1,Kbase,qr,r32,hi);asm volatile("s_nop 15\n\ts_nop 7":"+v"(pA0),"+v"(pA1));CMASK(pA0,pA1,0);
  START(pA0,pA1);
  _Pragma("unroll") for(int r=0;r<16;++r)pA1[r]=__builtin_amdgcn_exp2f(pA1[r]);
  WAIT_BAR(0);
  DMA_K(3,0);DMA_V(1,SLOTB);
  ROT();
  kload8(kf,kp0+sl_cur);
  WAIT_BAR(2);
  s16x4 vlo[8],vhi[8]; u32x4 pw0,pw1,pw2,pw3;
  #define PKW(P,B) cvtpk_s(P[B],P[B+1])
  #define PAF(k) __builtin_bit_cast(bf16x8,pw##k)
  #define VFR(i) (bf16x8){vlo[i][0],vlo[i][1],vlo[i][2],vlo[i][3],vhi[i][0],vhi[i][1],vhi[i][2],vhi[i][3]}
  #define PIN(x) asm volatile("":"+v"(x))
  #define MX3(a,b,c) __builtin_fmaxf(__builtin_fmaxf((a),(b)),(c))
  #define GAPA(MF,A0,A1,A2,A3,W0,W1,PW) do{ MF; sacc+=A0; sacc+=A1; sacc+=A2; sacc+=A3; PIN(sacc); W0; W1; PIN(PW); SBAR(); }while(0)
  #define EX(v) __builtin_amdgcn_exp2f(v)
  #define GAPB(MF,X,B) do{ MF; X[B]=EX(X[B]); X[B+1]=EX(X[B+1]); X[B+2]=EX(X[B+2]); X[B+3]=EX(X[B+3]); PIN(X); SBAR(); }while(0)
  #define VRD(i) do{ vlo[i]=vtr(vp_+(((i)>>2)*4096+((i)&3)*1024)); vhi[i]=vtr(vp_+(((i)>>2)*4096+((i)&3)*1024+512)); }while(0)
  #define KRD(G,j) do{ if(G){ kload2(kf,kp0+sl_next,j); SBAR(); } }while(0)
  #define STEP(C0,C1,P0,P1,t,GK,GV,GL) do{ SBAR(); \
    const lds_cptr vp_=vp0+sl_prev; \
    C0=__builtin_amdgcn_mfma_f32_32x32x16_bf16(kone,qm,(f32x16){0.f,0.f,0.f,0.f,0.f,0.f,0.f,0.f,0.f,0.f,0.f,0.f,0.f,0.f,0.f,0.f},0,0,0); C1=__builtin_amdgcn_mfma_f32_32x32x16_bf16(kone,qm,(f32x16){0.f,0.f,0.f,0.f,0.f,0.f,0.f,0.f,0.f,0.f,0.f,0.f,0.f,0.f,0.f,0.f},0,0,0); SBAR(); \
    VRD(0); SBAR(); float sacc=(P0[0]+P0[1]); \
    GAPA(C0=__builtin_amdgcn_mfma_f32_32x32x16_bf16(kf[0],qr[0],C0,0,0,0), P0[2],P0[3],P0[4],P0[5],     pw0[0]=PKW(P0,0), pw0[1]=PKW(P0,2), pw0); \
    VRD(4); SBAR(); GAPA(C1=__builtin_amdgcn_mfma_f32_32x32x16_bf16(kf[1],qr[0],C1,0,0,0), P0[6],P0[7],P0[8],P0[9],     pw0[2]=PKW(P0,4), pw0[3]=PKW(P0,6), pw0); \
    VRD(1); SBAR(); GAPA(C0=__builtin_amdgcn_mfma_f32_32x32x16_bf16(kf[2],qr[1],C0,0,0,0),   P0[10],P0[11],P0[12],P0[13], pw1[0]=PKW(P0,8), pw1[1]=PKW(P0,10), pw1); \
    VRD(5); SBAR(); GAPA(C1=__builtin_amdgcn_mfma_f32_32x32x16_bf16(kf[3],qr[1],C1,0,0,0),   P0[14],P0[15],P1[0],P1[1],   pw1[2]=PKW(P0,12),pw1[3]=PKW(P0,14), pw1); \
    VRD(2); SBAR(); GAPA(C0=__builtin_amdgcn_mfma_f32_32x32x16_bf16(kf[4],qr[2],C0,0,0,0),   P1[2],P1[3],P1[4],P1[5],     pw2[0]=PKW(P1,0), pw2[1]=PKW(P1,2), pw2); \
    VRD(6); SBAR(); GAPA(C1=__builtin_amdgcn_mfma_f32_32x32x16_bf16(kf[5],qr[2],C1,0,0,0),   P1[6],P1[7],P1[8],P1[9],     pw2[2]=PKW(P1,4), pw2[3]=PKW(P1,6), pw2); \
    VRD(3); SBAR(); GAPA(C0=__builtin_amdgcn_mfma_f32_32x32x16_bf16(kf[6],qr[3],C0,0,0,0),   P1[10],P1[11],P1[12],P1[13], pw3[0]=PKW(P1,8), pw3[1]=PKW(P1,10), pw3); \
    VRD(7); SBAR(); GAPA(C1=__builtin_amdgcn_mfma_f32_32x32x16_bf16(kf[7],qr[3],C1,0,0,0),   P1[14],P1[15],0.f,0.f,       pw3[2]=PKW(P1,12),pw3[3]=PKW(P1,14), pw3); \
    l_reg+=sacc; \
    if(GK){DMA_K((t)+3,sl_cur);} if(GV){DMA_V((t)+1,sl_next);} \
    CMASK(C0,C1,t); \
    { float a=MX3(C0[0],C0[1],C1[0]),b=MX3(C0[2],C0[3],C1[1]); a=MX3(a,C1[2],C1[3]); \
      _Pragma("unroll") for(int r=4;r<16;r+=4){a=MX3(a,C0[r],C0[r+1]);b=MX3(b,C0[r+2],C0[r+3]);a=MX3(a,C1[r],C1[r+1]);b=MX3(b,C1[r+2],C1[r+3]);} \
      float rm=__builtin_fmaxf(a,b); { auto rr=__builtin_amdgcn_permlane32_swap(__float_as_uint(rm),__float_as_uint(rm),false,false); rm=__builtin_fmaxf(__uint_as_float(rr[0]),__uint_as_float(rr[1])); } \
      resc=false; \
      if(__builtin_expect(__any(rm>(float)THRL),0)){ const float mn_=__uint_as_float(cvtpk_s(mhat+__builtin_fmaxf(rm,0.f),0.f)<<16); const float dl=mn_-mhat; mhat=mn_; \
        _Pragma("unroll") for(int r=0;r<16;++r){C0[r]-=dl;C1[r]-=dl;} \
        SETQM(); \
        const float f=__builtin_amdgcn_exp2f(-dl); l_reg*=f; { const int l_=(int)lane_now(); if((l_>>5)==0)wsf[l_&31]=f; } resc=true; } } \
    SBAR(); \
    GAPB(o[0]=__builtin_amdgcn_mfma_f32_32x32x16_bf16(PAF(0),VFR(0),o[0],0,0,0), C0,0); \
    GAPB(o[1]=__builtin_amdgcn_mfma_f32_32x32x16_bf16(PAF(0),VFR(4),o[1],0,0,0), C0,4); \
    KRD(GL,0); GAPB(o[0]=__builtin_amdgcn_mfma_f32_32x32x16_bf16(PAF(1),VFR(1),o[0],0,0,0), C0,8); \
    KRD(GL,1); GAPB(o[1]=__builtin_amdgcn_mfma_f32_32x32x16_bf16(PAF(1),VFR(5),o[1],0,0,0), C0,12); \
    KRD(GL,2); GAPB(o[0]=__builtin_amdgcn_mfma_f32_32x32x16_bf16(PAF(2),VFR(2),o[0],0,0,0), C1,0); \
    KRD(GL,3); GAPB(o[1]=__builtin_amdgcn_mfma_f32_32x32x16_bf16(PAF(2),VFR(6),o[1],0,0,0), C1,4); \
    GAPB(o[0]=__builtin_amdgcn_mfma_f32_32x32x16_bf16(PAF(3),VFR(3),o[0],0,0,0), C1,8); \
    GAPB(o[1]=__builtin_amdgcn_mfma_f32_32x32x16_bf16(PAF(3),VFR(7),o[1],0,0,0), C1,12); \
    }while(0)
  int t=1;
  #undef CMASK
  #define CMASK(P0,P1,t) do{ const int t_=(t); if(t_<4){ const int l_=(int)lane_now(); cmask(P0,P1,t_,wid*QBLK+(l_&31),l_>>5); } else if(!((sel>>(((t_-4)>>2)&15))&1u)){ _Pragma("unroll") for(int r=0;r<16;++r){P0[r]=-INFINITY;P1[r]=-INFINITY;} } }while(0)
  for(;t+5<NT;t+=2){
    STEP(pB0,pB1,pA0,pA1,t,true,true,true);     WAIT_BAR(2); RESC(); ROT();
    STEP(pA0,pA1,pB0,pB1,t+1,true,true,true);   WAIT_BAR(2); RESC(); ROT();
  }
  #undef CMASK
  #define CMASK(P0,P1,t) do{ const int t_=(t); if(t_<4){ const int l_=(int)lane_now(); cmask(P0,P1,t_,wid*QBLK+(l_&31),l_>>5); } else if(!((sel>>(((t_-4)>>2)&15))&1u)){ _Pragma("unroll") for(int r=0;r<16;++r){P0[r]=-INFINITY;P1[r]=-INFINITY;} } }while(0)
  #define ENDW(tt) do{ if((tt)+3<NT){WAIT_BAR(2);} else if((tt)+2<NT){WAIT_BAR(1);} else {WAIT_BAR(0);} }while(0)
  for(;t+1<NT;t+=2){
    STEP(pB0,pB1,pA0,pA1,t,(t+3<NT),(t+1<NT),(t+1<NT));       ENDW(t);   RESC(); ROT();
    STEP(pA0,pA1,pB0,pB1,t+1,(t+4<NT),(t+2<NT),(t+2<NT));     ENDW(t+1); RESC(); ROT();
  }
  STEP(pB0,pB1,pA0,pA1,NT-1,false,false,false); RESC();
  { float sacc=pB0[0]+pB0[1]; _Pragma("unroll") for(int r=2;r<16;++r)sacc+=pB0[r]; _Pragma("unroll") for(int r=0;r<16;++r)sacc+=pB1[r]; l_reg+=sacc;
    pw0=(u32x4){PKW(pB0,0),PKW(pB0,2),PKW(pB0,4),PKW(pB0,6)};pw1=(u32x4){PKW(pB0,8),PKW(pB0,10),PKW(pB0,12),PKW(pB0,14)};pw2=(u32x4){PKW(pB1,0),PKW(pB1,2),PKW(pB1,4),PKW(pB1,6)};pw3=(u32x4){PKW(pB1,8),PKW(pB1,10),PKW(pB1,12),PKW(pB1,14)};
    SBAR(); pv(o,vb0+sl_cur,PAF(0),PAF(1),PAF(2),PAF(3)); }
  #undef PKW
  #undef PAF
  #undef VFR
  #undef PIN
  #undef MX3
  #undef GAPA
  #undef GAPB
  #undef EX
  #undef VRD
  #undef KRD
  #undef STEP
  #undef ENDW
  {auto rr=__builtin_amdgcn_permlane32_swap(__float_as_uint(l_reg),__float_as_uint(l_reg),false,false);l_reg=__uint_as_float(rr[0])+__uint_as_float(rr[1]);}
  if(hi==0)wsf[32+r32]=l_reg;asm volatile("s_waitcnt lgkmcnt(0)":::"memory");
  float rli[16];
  #pragma unroll
  for(int r=0;r<16;++r)rli[r]=__builtin_amdgcn_rcpf(wsf[32+crow(r,hi)]);
  bf16*Ow=O+(rowbase+q0+wid*QBLK)*DM+h*D;
  { bf16*stg=(bf16*)(shm+LDS_OST)+wid*2048;
    #pragma unroll
    for(int r=0;r<16;++r){const int orow=crow(r,hi);
      #pragma unroll
      for(int d0=0;d0<2;++d0)stg[orow*64+d0*32+r32]=__float2bfloat16(o[d0][r]*rli[r]);}
    asm volatile("s_waitcnt lgkmcnt(0)":::"memory");
    #pragma unroll
    for(int i=0;i<4;++i){const int row=i*8+(lane>>3),ch=lane&7; const u32x4 v=*(const u32x4*)(stg+row*64+ch*8); ATTN_STORE16(Ow+(long)row*DM+ch*8,v);} }
  asm volatile("s_waitcnt lgkmcnt(0)\n\ts_barrier":::"memory");
  #undef DMA_K
  #undef PHYS
  #undef DMA_V
  #undef CMASK
  #undef START
  #undef SETQM
  #undef RESC
  #undef ROT
}
constexpr int ATTN_LDS_BYTES=LDS_BYTES;
struct AttnTensors { const bf16* Q; const bf16* K; const bf16* V; bf16* O; const float* ksum; };
struct AttnUnit { int bh; int qb; };
struct StaticOrder {
  int vcu, G;
  __device__ __forceinline__ explicit StaticOrder(int grid,int block):vcu((grid%8==0)?((block%8)*(grid/8)+block/8):block),G(grid){}
  __device__ __forceinline__ bool next(int i,AttnUnit&u)const{ const int L=i*G+vcu; if(L>=1024)return false; const int w=L&255, rnd=L>>8, s=w&3; u.bh=w>>2; u.qb=(rnd==0)?s:(rnd==1)?7-s:(rnd==2)?8+s:15-s; return true; }
  __device__ __forceinline__ void a_ready(const AttnUnit&)const{}
  __device__ __forceinline__ void done(const AttnUnit&)const{}
};
struct SnakeOrder {
  int v, G;
  __device__ __forceinline__ bool next(int i,AttnUnit&u)const{ const int idx=i*G+((i&1)?(G-1-v):v); if(idx>=1024)return false; u.qb=15-(idx>>6); u.bh=idx&63; return true; }
  __device__ __forceinline__ void a_ready(const AttnUnit&)const{}
  __device__ __forceinline__ void done(const AttnUnit&)const{}
};
template<class Sched,int THRL=8> __device__ __forceinline__ void attn_phase(char*lds,const AttnTensors&T,const Sched&S){
  AttnUnit u;
  for(int i=0;S.next(i,u);++i){ S.a_ready(u); attn_unit<THRL>(u.bh/NHEAD,u.bh%NHEAD,u.qb,T.Q,T.K,T.V,T.O,T.ksum,lds); S.done(u); }
}
#undef SBAR
#undef WAIT_BAR
}
constexpr int NWAVES = 8, NTHR = 512;
constexpr int NTOK = 16384, DM = 1024, SEQ = 4096, NBATCH = 4, NEXP = 32;
constexpr float ALPHA = 1.4142135623730951f;
constexpr float LN_EPS = 1e-5f;
constexpr float RSQRT_DQK = 0.08838834764831845f;
constexpr int NPHASE = 19;
constexpr float FP8_SA = 4.0f, FP8_SWGU = 64.0f, FP8_SWD = 128.0f;
constexpr float FP8_SY = 32.0f, FP8_MAXV = 448.0f;
#ifndef DBG_ATTN_MUL
#define DBG_ATTN_MUL 1.0f
#endif
#ifndef DBG_MLSTM_MUL
#define DBG_MLSTM_MUL 1.0f
#endif
#ifndef DBG_MOE_MUL
#define DBG_MOE_MUL 1.0f
#endif
#ifndef DBG_P14_A
#define DBG_P14_A WS_HN
#endif
#ifndef NCONV
#define NCONV 80
#endif
#ifndef MK_ONE_LAUNCH
#define MK_ONE_LAUNCH 1
#endif

constexpr size_t MiB = 1u << 20, KiB = 1024;
constexpr size_t WS_CTL = 0, CTL_ZERO_BYTES = 1 * MiB;
constexpr int CW_TMO = 0, CW_BAR = 4096, CW_CNT = 8192, CW_AQ = 16384;
constexpr size_t WS_KSUM = 256 * KiB, WS_DEN = 512 * KiB;
constexpr size_t WS_WQKV = 2 * MiB, WS_WO = 8 * MiB, WS_WINA = 10 * MiB, WS_WINB = 14 * MiB, WS_WOUT = 17 * MiB;
constexpr size_t WS_WG = 19 * MiB, WS_RWT = 20 * MiB, WS_ROPE = 21 * MiB;
constexpr size_t WS_TOKE = 22 * MiB, WS_TOKP = 22 * MiB + 256 * KiB, WS_TOKG = 22 * MiB + 512 * KiB;
constexpr size_t WS_GI = 23 * MiB, WS_LF = 23 * MiB + 256 * KiB, WS_RF = 23 * MiB + 512 * KiB, WS_CF = 23 * MiB + 768 * KiB;
constexpr size_t WS_DEC = 24 * MiB, WS_NU = 24 * MiB + 256 * KiB, WS_NPREV = 24 * MiB + 512 * KiB;
constexpr size_t WS_ROWTOK = 25 * MiB;
constexpr size_t WS_XB = 32 * MiB, WS_Q = 64 * MiB, WS_K = 96 * MiB, WS_V = 128 * MiB;
constexpr size_t WS_R0 = 160 * MiB, WS_R1 = 224 * MiB, WS_R2 = 288 * MiB;
constexpr size_t WS_H = 352 * MiB, WS_Y = 496 * MiB;
constexpr size_t WS_WGU = 640 * MiB, WS_WD = 896 * MiB, WS_END = 1024 * MiB;
constexpr size_t WS_AE = 352 * MiB, WS_BE = 416 * MiB, WS_KN = 464 * MiB, WS_KT = 496 * MiB, WS_UT = 512 * MiB, WS_OS = 544 * MiB, WS_HN = 576 * MiB;

constexpr int RING_OFF = 0, RING_BYTES = 131072;
constexpr int LX = RING_BYTES;
constexpr int LX_MISC = LX;
constexpr int LX_TILEE = LX + 128;
constexpr int LX_TBASE = LX + 1280;
constexpr int LX_LCNT = LX + 1536, LX_GBASE = LX + 1664;
constexpr int LX_REC = LX + 1792;
constexpr int LX_TOKL = LX + 4096;
constexpr int LX_LNX = LX + 4096;
constexpr int LX_BIAS = LX + 12288;
constexpr int LX_ROPE = LX + 16384;
constexpr int LDS_BYTES = 163840;
constexpr int TOKL_ROUNDS = 10;

#define RLX_AGENT __ATOMIC_RELAXED, __HIP_MEMORY_SCOPE_AGENT
#define LDS_WAIT() asm volatile("s_waitcnt lgkmcnt(0)" ::: "memory")
#define VM_WAIT() asm volatile("s_waitcnt vmcnt(0)" ::: "memory")
#define XB_TMO      128
#define XB_XCNT(j)  (256  + 64 * (j))
#define XB_XSUB(j)  (1280 + 64 * (j))
#define XB_XGEN(j)  (2304 + 64 * (j))
#define XB_TOP      3328
#define XB_TOPGEN   3392
#define XCD_BAR_WORDS 3456
#define XB_SPIN_CAP (1u << 18)

__device__ __forceinline__ unsigned xb_ld(unsigned* p)              { return __hip_atomic_load(p, __ATOMIC_RELAXED, __HIP_MEMORY_SCOPE_AGENT); }
__device__ __forceinline__ unsigned xb_add(unsigned* p, unsigned v) { return __hip_atomic_fetch_add(p, v, __ATOMIC_RELAXED, __HIP_MEMORY_SCOPE_AGENT); }
__device__ __forceinline__ unsigned xb_xcc_id() { return (unsigned)__builtin_amdgcn_s_getreg((3 << 11) | 20) & 0xFu; }
#define XB_SPIN(cond, bar) do { unsigned _sp = 0; while (cond) { __builtin_amdgcn_s_sleep(1); \
    if ((++_sp & 255u) == 0u) { if (xb_ld(&(bar)[XB_TMO])) break; if (_sp > XB_SPIN_CAP) { atomicAdd(&(bar)[XB_TMO], 1u); break; } } } } while (0)

struct XcdBarrier {
    unsigned* bar; unsigned x;
    volatile LAS unsigned* st;
};

__device__ __forceinline__ XcdBarrier xcd_barrier_post(unsigned* bar, volatile LAS unsigned* st) {
    XcdBarrier b; b.bar = bar; b.x = xb_xcc_id(); b.st = st;
    if (threadIdx.x == 0) (void)xb_add(&bar[XB_XCNT(b.x)], 1u);
    return b;
}
__device__ __forceinline__ void xcd_barrier_complete(unsigned* bar, unsigned x, unsigned& nloc, unsigned& nx) {
    const unsigned G = gridDim.x * gridDim.y * gridDim.z;
    unsigned sum, cnt, mine, sp = 0u;
    for (;;) {
        sum = 0u; cnt = 0u; mine = 0u;
#pragma unroll
        for (unsigned j = 0; j < 16; ++j) { const unsigned c = xb_ld(&bar[XB_XCNT(j)]); sum += c; cnt += (c > 0u) ? 1u : 0u; mine = (j == x) ? c : mine; }
        if (sum == G) break;
        __builtin_amdgcn_s_sleep(1);
        if ((++sp & 255u) == 0u) { if (xb_ld(&bar[XB_TMO])) break; if (sp > XB_SPIN_CAP) { atomicAdd(&bar[XB_TMO], 1u); break; } }
    }
    nloc = mine > 0u ? mine : 1u; nx = cnt > 0u ? cnt : 1u;
}

__device__ __forceinline__ void xcd_barrier(const XcdBarrier& b) {
    asm volatile("s_waitcnt vmcnt(0)" ::: "memory");
    __syncthreads();
    if (threadIdx.x == 0) {
        unsigned* bar = b.bar;
        __builtin_amdgcn_s_waitcnt(0);
        unsigned nloc = b.st[0], nx = b.st[1];
        if (nloc == 0u) { xcd_barrier_complete(bar, b.x, nloc, nx); b.st[0] = nloc; b.st[1] = nx; }
        const unsigned old = xb_add(&bar[XB_XSUB(b.x)], 1u);
        const unsigned gen = old / nloc;
        if (old + 1u == (gen + 1u) * nloc) {
            __builtin_amdgcn_fence(__ATOMIC_RELEASE, "agent");
            asm volatile("s_waitcnt vmcnt(0)" ::: "memory");
            const unsigned og = xb_add(&bar[XB_TOP], 1u);
            const unsigned tg = og / nx;
            if (og + 1u == (tg + 1u) * nx) xb_add(&bar[XB_TOPGEN], 1u);
            else XB_SPIN(xb_ld(&bar[XB_TOPGEN]) == tg, bar);
            __builtin_amdgcn_fence(__ATOMIC_ACQUIRE, "agent");
            xb_add(&bar[XB_XGEN(b.x)], 1u);
            asm volatile("s_waitcnt vmcnt(0)" ::: "memory");
        } else {
            XB_SPIN(xb_ld(&bar[XB_XGEN(b.x)]) == gen, bar);
            __builtin_amdgcn_fence(__ATOMIC_ACQUIRE, "agent");
            asm volatile("s_waitcnt vmcnt(0)" ::: "memory");
        }
    }
    __syncthreads();
}
using pg8::Unit; using pg8::Gemm;
typedef f32x4 (&AccRef)[2][2][4][2];

#ifndef TAIL_FIRST
#define TAIL_FIRST 0
#endif
__device__ __forceinline__ bool moe_unit(int i, int G, int c, int nT, int nN, int& pm, int& pn, int& half) {
    const int U = nT * nN, R = U / G, rem = U - R * G; half = 0;
#if TAIL_FIRST
    if (rem > 0 && 2 * rem <= G) {
        if (c < 2 * rem) { if (i == 0) { half = 1 + (c & 1); return pg8::tile_order(0, U, R * G + (c >> 1), nT, nN, pm, pn); } --i; }
        if (i < R) return pg8::tile_order(i, G, c, nT, nN, pm, pn);
        return false; }
#endif
    if (i < R) return pg8::tile_order(i, G, c, nT, nN, pm, pn);
    if (i > R || rem == 0) return false;
    if (2 * rem <= G) { if (c >= 2 * rem) return false; half = 1 + (c & 1); return pg8::tile_order(0, U, R * G + (c >> 1), nT, nN, pm, pn); }
    return pg8::tile_order(i, G, c, nT, nN, pm, pn);
}
struct DenseSched {
    int nM, nN, G, c; const char* A; const char* B; size_t tstepA, tstepB; bool split = false;
    __device__ __forceinline__ bool next(int i, Unit& u) const {
        int half = 0;
        if (split) { if (!moe_unit(i, G, c, nM, nN, u.pm, u.pn, half)) return false; }
        else if (!pg8::tile_order(i, G, c, nM, nN, u.pm, u.pn)) return false;
        u.A = A + (size_t)u.pm * tstepA; u.B = B + (size_t)u.pn * tstepB; u.tl = nullptr; u.x0 = u.x1 = 0; u.x2 = half; return true; }
};
struct MoeSched {
    int nT, nN, G, c; const LAS int* tile_e; const LAS int* tbase; const LAS unsigned short* tokl;
    const char* A; const char* B; size_t tstepA, estepB, tstepB;
    __device__ __forceinline__ bool next(int i, Unit& u) const {
        int half; if (!moe_unit(i, G, c, nT, nN, u.pm, u.pn, half)) return false;
        const int e = tile_e[u.pm];
        u.x0 = e; u.x1 = u.pm * 256; u.x2 = half;
        u.A = A + (size_t)u.pm * tstepA; u.B = B + (size_t)e * estepB + (size_t)u.pn * tstepB;
        u.tl = tokl ? tokl + (i < TOKL_ROUNDS ? i : TOKL_ROUNDS - 1) * 256 : nullptr; return true; }
};
struct MuSched {
    int G, c, mode; const char* A; const char* B;
    __device__ __forceinline__ bool next(int i, Unit& u) const {
        const int mu = i * G + c; if (mu >= 256) return false;
        const int b = mu >> 6, hh = (mu >> 4) & 3, ch = mu & 15; const size_t tok0 = (size_t)b * SEQ + (size_t)ch * 256;
        u.pm = mu; u.pn = 0; u.x0 = mu; u.x1 = 0; u.x2 = (mode == 0) ? 1 : 0; u.tl = nullptr;
        if (mode == 0) { u.A = A + (size_t)mu * 256 * 384 * 2; u.B = B + ((size_t)(hh * 128) * NTOK + tok0) * 2; }
        else if (mode == 1) { u.A = A + ((size_t)mu * 256 * 512 + 256) * 2; u.B = B + (tok0 * 1024 + (size_t)hh * 256) * 2; }
        else { u.A = A + (size_t)mu * 256 * 512 * 2; u.B = B + (size_t)mu * 256 * 384 * 2; }
        return true; }
};

constexpr float C2 = 0.125f * 1.4426950408889634f;

struct EpiQKV {
    static constexpr bool PERM = true; static constexpr bool MID = true;
    __device__ __forceinline__ void prep(const Unit&, int, int, int) const {}
    __device__ __forceinline__ void prep_mid(const Unit& u, int wid, int lane) const { if ((u.pn >> 2) < 2) {
#pragma unroll
        for (int i = 0; i < 2; ++i) { const int row = (wid * 2 + i) * 16 + (lane >> 2), c = (lane & 3) ^ ((row >> 1) & 3);
            glds16s(uni_ptr((const char*)(rope + (size_t)u.pm * 256 * 16)), (unsigned)(row * 64 + c * 16), (unsigned)__builtin_amdgcn_readfirstlane((unsigned)(unsigned long long)ropel + (unsigned)((wid * 2 + i) * 1024))); } } }
    bf16_t* Q; bf16_t* K; bf16_t* V; const float* rope; float* ksum; LAS float* ropel;
    __device__ __forceinline__ void operator()(AccRef acc, const Unit& u, int wr, int wc, int fr, int fq) const {
        asm volatile("" : "+v"(fr), "+v"(fq));
        const int part = u.pn >> 2, colt = (u.pn & 3) * 256;
        bf16_t* base = Q + (size_t)part * ((WS_K - WS_Q) / 2);
        const bool rot = (part < 2) && ((wc & 1) == 0);
        float ks[2][8];
#pragma unroll
        for (int bj = 0; bj < 2; ++bj)
#pragma unroll
            for (int j = 0; j < 8; ++j) ks[bj][j] = 0.f;
#pragma unroll
        for (int ai = 0; ai < 2; ++ai)
#pragma unroll
            for (int m = 0; m < 4; ++m) {
                const int row = u.pm * 256 + ai * 128 + wr * 64 + m * 16 + fr;
                f32x4 cs = {1.f, 1.f, 1.f, 1.f}, sn = {0.f, 0.f, 0.f, 0.f};
                if (rot && fq < 2) { const int rl = ai * 128 + wr * 64 + m * 16 + fr, sw = (rl >> 1) & 3; const LAS f32x4* rp = (const LAS f32x4*)(ropel + rl * 16);
                    cs = rp[fq ^ sw]; sn = rp[(2 + fq) ^ sw]; }
#pragma unroll
                for (int bj = 0; bj < 2; ++bj) {
                    f32x4 v0 = acc[ai][bj][m][0], v1 = acc[ai][bj][m][1];
                    if (rot) { const f32x4 lo = v0 * cs - v1 * sn, hi = v1 * cs + v0 * sn; v0 = lo; v1 = hi; }
                    if (part == 0) { v0 = v0 * C2; v1 = v1 * C2; }
                    if (part == 1) {
#pragma unroll
                        for (int j = 0; j < 4; ++j) { ks[bj][j] += v0[j]; ks[bj][4 + j] += v1[j]; } }
                    u32x4 w; w.x = cvt_pk_bf16(v0[0], v0[1]); w.y = cvt_pk_bf16(v0[2], v0[3]); w.z = cvt_pk_bf16(v1[0], v1[1]); w.w = cvt_pk_bf16(v1[2], v1[3]);
                    *(u32x4*)(base + (size_t)row * DM + colt + bj * 128 + wc * 32 + fq * 8) = w;
                }
            }
        if (part == 1) {
#pragma unroll
            for (int bj = 0; bj < 2; ++bj)
#pragma unroll
                for (int j = 0; j < 8; ++j) { float s = ks[bj][j]; s += __shfl_xor(s, 1); s += __shfl_xor(s, 2); s += __shfl_xor(s, 4); s += __shfl_xor(s, 8);
                    if (fr == 0) atomicAdd(ksum + (size_t)u.pm * DM + colt + bj * 128 + wc * 32 + fq * 8 + j, s); }
        }
    }
};

struct EpiZ {
    static constexpr bool PERM = true; static constexpr bool MID = false;
    __device__ __forceinline__ void prep(const Unit&, int, int, int) const {}
    const bf16_t* xin; bf16_t* z; float ymul;
    __device__ __forceinline__ void operator()(AccRef acc, const Unit& u, int wr, int wc, int fr, int fq) const {
        asm volatile("" : "+v"(fr), "+v"(fq));
        const size_t off0 = (size_t)(u.pm * 256 + wr * 64 + fr) * DM + u.pn * 256 + wc * 32 + fq * 8;
        u32x4 xr[2][4][2];
#pragma unroll
        for (int ai = 0; ai < 2; ++ai)
#pragma unroll
            for (int m = 0; m < 4; ++m)
#pragma unroll
                for (int bj = 0; bj < 2; ++bj) xr[ai][m][bj] = *(const u32x4*)(xin + off0 + (size_t)(ai * 128 + m * 16) * DM + bj * 128);
        asm volatile("" ::: "memory");
#pragma unroll
        for (int ai = 0; ai < 2; ++ai)
#pragma unroll
            for (int m = 0; m < 4; ++m)
#pragma unroll
                for (int bj = 0; bj < 2; ++bj) { const u32x4 x = xr[ai][m][bj]; const f32x4 a0 = acc[ai][bj][m][0] * ymul, a1 = acc[ai][bj][m][1] * ymul;
                    u32x4 w; w.x = cvt_pk_bf16(bflo(x.x) * ALPHA + a0[0], bfhi(x.x) * ALPHA + a0[1]); w.y = cvt_pk_bf16(bflo(x.y) * ALPHA + a0[2], bfhi(x.y) * ALPHA + a0[3]);
                    w.z = cvt_pk_bf16(bflo(x.z) * ALPHA + a1[0], bfhi(x.z) * ALPHA + a1[1]); w.w = cvt_pk_bf16(bflo(x.w) * ALPHA + a1[2], bfhi(x.w) * ALPHA + a1[3]);
                    *(u32x4*)(z + off0 + (size_t)(ai * 128 + m * 16) * DM + bj * 128) = w; }
    }
};

__device__ __forceinline__ float swiglu1(float glu, float lin) {
    const float g = fminf(glu, 7.0f), l = fminf(fmaxf(lin, -7.0f), 7.0f);
    const float sg = __builtin_amdgcn_rcpf(1.0f + __builtin_amdgcn_exp2f(-1.702f * 1.4426950408889634f * g));
    return g * sg * (l + 1.0f);
}
__device__ __forceinline__ f32x2 swiglu2(float glu0, float lin0, float glu1, float lin1) {
    const f32x2 g = {fminf(glu0, 7.0f), fminf(glu1, 7.0f)}, l = {fminf(fmaxf(lin0, -7.0f), 7.0f), fminf(fmaxf(lin1, -7.0f), 7.0f)};
    const f32x2 t = g * (f32x2){-1.702f * 1.4426950408889634f, -1.702f * 1.4426950408889634f};
    const f32x2 d = (f32x2){__builtin_amdgcn_exp2f(t[0]), __builtin_amdgcn_exp2f(t[1])} + (f32x2){1.0f, 1.0f};
    const f32x2 r = {__builtin_amdgcn_rcpf(d[0]), __builtin_amdgcn_rcpf(d[1])};
    const f32x2 lp = l * (f32x2){FP8_SA, FP8_SA} + (f32x2){FP8_SA, FP8_SA};
    return (g * lp) * r;
}
struct EpiGU {
    static constexpr bool PERM = true; static constexpr bool MID = false;
    __device__ __forceinline__ void prep(const Unit& u, int ui, int wid, int lane) const { if (wid < 4) glds4s(uni_ptr((const char*)(bias + (size_t)u.x0 * 2048 + u.pn * 256 + wid * 64)), (unsigned)lane * 4u, (unsigned)__builtin_amdgcn_readfirstlane((unsigned)(unsigned long long)bl + (unsigned)(((ui & 1) * 256 + wid * 64) * 4))); }
    const float* bias; unsigned char* H; LAS float* bl; mutable int ucnt;
    __device__ __forceinline__ void operator()(AccRef acc, const Unit& u, int wr, int wc, int fr, int fq) const {
        asm volatile("" : "+v"(fr), "+v"(fq));
        const int c0 = u.pn * 256 + wc * 32 + fq * 8; const LAS float* bp = bl + (ucnt & 1) * 256 + wc * 32 + fq * 8; ++ucnt; constexpr float SC = 1.0f / (FP8_SA * FP8_SWGU);
        f32x4 b[2][2];
#pragma unroll
        for (int bj = 0; bj < 2; ++bj) { b[bj][0] = *(const LAS f32x4*)(bp + bj * 128); b[bj][1] = *(const LAS f32x4*)(bp + bj * 128 + 4); }
#pragma unroll
        for (int ai = 0; ai < 2; ++ai)
#pragma unroll
            for (int m = 0; m < 4; ++m) {
                unsigned char* rowp = H + (size_t)(u.x1 + ai * 128 + wr * 64 + m * 16 + fr) * DM + (c0 >> 1);
#pragma unroll
                for (int bj = 0; bj < 2; ++bj) { if (u.x2 == 2 - bj) continue;
                    const f32x4 v0 = acc[ai][bj][m][0] * SC + b[bj][0], v1 = acc[ai][bj][m][1] * SC + b[bj][1];
                    const f32x2 h0 = swiglu2(v0[0], v0[1], v0[2], v0[3]), h1 = swiglu2(v1[0], v1[1], v1[2], v1[3]);
                    int w = __builtin_amdgcn_cvt_pk_fp8_f32(h0[0], h0[1], 0, false);
                    w = __builtin_amdgcn_cvt_pk_fp8_f32(h1[0], h1[1], w, true);
                    *(int*)(rowp + bj * 64) = w; }
            }
    }
};
struct EpiDN {
    static constexpr bool PERM = true; static constexpr bool MID = false;
    __device__ __forceinline__ void prep(const Unit& u, int ui, int wid, int lane) const { if (wid < 4) glds4s(uni_ptr((const char*)(bias + (size_t)u.x0 * 1024 + u.pn * 256 + wid * 64)), (unsigned)lane * 4u, (unsigned)__builtin_amdgcn_readfirstlane((unsigned)(unsigned long long)bl + (unsigned)(((ui & 1) * 256 + wid * 64) * 4))); }
    const float* bias; unsigned char* Y; LAS float* bl; mutable int ucnt;
    __device__ __forceinline__ void operator()(AccRef acc, const Unit& u, int wr, int wc, int fr, int fq) const {
        asm volatile("" : "+v"(fr), "+v"(fq));
        const int c0 = u.pn * 256 + wc * 32 + fq * 8; const LAS float* bp = bl + (ucnt & 1) * 256 + wc * 32 + fq * 8; ++ucnt; constexpr float SC = FP8_SY / (FP8_SA * FP8_SWD);
        f32x4 b[2][2];
#pragma unroll
        for (int bj = 0; bj < 2; ++bj) { b[bj][0] = *(const LAS f32x4*)(bp + bj * 128) * FP8_SY; b[bj][1] = *(const LAS f32x4*)(bp + bj * 128 + 4) * FP8_SY; }
#pragma unroll
        for (int ai = 0; ai < 2; ++ai)
#pragma unroll
            for (int m = 0; m < 4; ++m) {
                unsigned char* rowp = Y + (size_t)(u.x1 + ai * 128 + wr * 64 + m * 16 + fr) * DM + c0;
#pragma unroll
                for (int bj = 0; bj < 2; ++bj) { if (u.x2 == 2 - bj) continue;
                    f32x4 v0 = acc[ai][bj][m][0] * SC + b[bj][0], v1 = acc[ai][bj][m][1] * SC + b[bj][1];
#pragma unroll
                    for (int q = 0; q < 4; ++q) { v0[q] = __builtin_amdgcn_fmed3f(v0[q], -FP8_MAXV, FP8_MAXV); v1[q] = __builtin_amdgcn_fmed3f(v1[q], -FP8_MAXV, FP8_MAXV); }
                    int w0 = __builtin_amdgcn_cvt_pk_fp8_f32(v0[0], v0[1], 0, false); w0 = __builtin_amdgcn_cvt_pk_fp8_f32(v0[2], v0[3], w0, true);
                    int w1 = __builtin_amdgcn_cvt_pk_fp8_f32(v1[0], v1[1], 0, false); w1 = __builtin_amdgcn_cvt_pk_fp8_f32(v1[2], v1[3], w1, true);
                    u32x2 w; w.x = (unsigned)w0; w.y = (unsigned)w1;
                    *(u32x2*)(rowp + bj * 128) = w; }
            }
    }
};

struct EpiINA {
    static constexpr bool PERM = true; static constexpr bool MID = false;
    __device__ __forceinline__ void prep(const Unit&, int, int, int) const {}
    const float* rf; const float* cf; bf16_t* AE; bf16_t* KN; bf16_t* OS;
    __device__ __forceinline__ void operator()(AccRef acc, const Unit& u, int wr, int wc, int fr, int fq) const {
        asm volatile("" : "+v"(fr), "+v"(fq));
        const int b = u.pm >> 4, ch = u.pm & 15, d0 = wc * 32 + fq * 8; const u32x4 zero = {0u, 0u, 0u, 0u};
        if (u.pn < 4) {
            const bool isq = u.pn < 2; const float* fac = isq ? rf : cf; const float fs = isq ? 1.0f : RSQRT_DQK; const int h0 = (u.pn & 1) * 2;
            float sf[2][4][2];
#pragma unroll
            for (int ai = 0; ai < 2; ++ai)
#pragma unroll
                for (int m = 0; m < 4; ++m)
#pragma unroll
                    for (int bj = 0; bj < 2; ++bj) sf[ai][m][bj] = fac[(size_t)(h0 + bj) * NTOK + (size_t)u.pm * 256 + ai * 128 + wr * 64 + m * 16 + fr];
#pragma unroll
            for (int ai = 0; ai < 2; ++ai)
#pragma unroll
                for (int m = 0; m < 4; ++m) {
                    const int t = ai * 128 + wr * 64 + m * 16 + fr; const size_t token = (size_t)u.pm * 256 + t;
#pragma unroll
                    for (int bj = 0; bj < 2; ++bj) { const int hh = h0 + bj; const float s = sf[ai][m][bj] * fs;
                        const f32x4 v0 = acc[ai][bj][m][0] * s, v1 = acc[ai][bj][m][1] * s;
                        const size_t oq = ((size_t)(((b * 4 + hh) * 16 + ch) * 256 + t)) * 512 + 256 + d0, ok = token * 1024 + hh * 256 + d0;
                        bf16_t* dst = isq ? (AE + oq) : (KN + ok);
                        u32x4 w; w.x = cvt_pk_bf16(v0[0], v0[1]); w.y = cvt_pk_bf16(v0[2], v0[3]); w.z = cvt_pk_bf16(v1[0], v1[1]); w.w = cvt_pk_bf16(v1[2], v1[3]);
                        *(u32x4*)dst = w; }
                }
        } else {
#pragma unroll
            for (int ai = 0; ai < 2; ++ai)
#pragma unroll
                for (int m = 0; m < 4; ++m) {
                    const int t = ai * 128 + wr * 64 + m * 16 + fr; const size_t token = (size_t)u.pm * 256 + t;
#pragma unroll
                    for (int bj = 0; bj < 2; ++bj) { f32x4 v0 = acc[ai][bj][m][0], v1 = acc[ai][bj][m][1];
#pragma unroll
                        for (int j = 0; j < 4; ++j) { v0[j] = __builtin_amdgcn_rcpf(1.0f + __builtin_amdgcn_exp2f(-1.4426950408889634f * v0[j])); v1[j] = __builtin_amdgcn_rcpf(1.0f + __builtin_amdgcn_exp2f(-1.4426950408889634f * v1[j])); }
                        u32x4 w; w.x = cvt_pk_bf16(v0[0], v0[1]); w.y = cvt_pk_bf16(v0[2], v0[3]); w.z = cvt_pk_bf16(v1[0], v1[1]); w.w = cvt_pk_bf16(v1[2], v1[3]);
                        *(u32x4*)(OS + token * 1024 + (u.pn - 4) * 256 + bj * 128 + d0) = w; }
                }
        }
    }
};
struct EpiINB {
    static constexpr bool PERM = true; static constexpr bool MID = false;
    __device__ __forceinline__ void prep(const Unit&, int, int, int) const {}
    const float* cf; bf16_t* KT; bf16_t* BE;
    __device__ __forceinline__ void operator()(AccRef acc, const Unit& u, int wr, int wc, int fr, int fq) const {
        asm volatile("" : "+v"(fr), "+v"(fq));
        const int b = u.pn >> 4, ch = u.pn & 15;
        f32x4 cv[2][2][2];
#pragma unroll
        for (int ai = 0; ai < 2; ++ai)
#pragma unroll
            for (int bj = 0; bj < 2; ++bj) { const size_t tok0 = (size_t)u.pn * 256 + bj * 128 + wc * 32 + fq * 8;
                if (u.pm < 2) { const int hh = u.pm * 2 + ai; cv[ai][bj][0] = *(const f32x4*)(cf + (size_t)hh * NTOK + tok0) * RSQRT_DQK; cv[ai][bj][1] = *(const f32x4*)(cf + (size_t)hh * NTOK + tok0 + 4) * RSQRT_DQK; }
                else { cv[ai][bj][0] = (f32x4){1.f, 1.f, 1.f, 1.f}; cv[ai][bj][1] = cv[ai][bj][0]; } }
#pragma unroll
        for (int ai = 0; ai < 2; ++ai)
#pragma unroll
            for (int m = 0; m < 4; ++m) {
                const int R = u.pm * 256 + ai * 128 + wr * 64 + m * 16 + fr;
#pragma unroll
                for (int bj = 0; bj < 2; ++bj) { if (u.x2 == 2 - bj) continue;
                    const f32x4 v0 = acc[ai][bj][m][0] * cv[ai][bj][0], v1 = acc[ai][bj][m][1] * cv[ai][bj][1]; const int s0 = bj * 128 + wc * 32 + fq * 8; const size_t tok0 = (size_t)u.pn * 256 + s0; bf16_t* dst;
                    if (u.pm < 2) dst = KT + (size_t)R * NTOK + tok0;
                    else { const int eg = R - 512, hh = eg >> 8, e = eg & 255; dst = BE + ((size_t)(((b * 4 + hh) * 16 + ch) * 256 + e)) * 384 + s0; }
                    u32x4 w; w.x = cvt_pk_bf16(v0[0], v0[1]); w.y = cvt_pk_bf16(v0[2], v0[3]); w.z = cvt_pk_bf16(v1[0], v1[1]); w.w = cvt_pk_bf16(v1[2], v1[3]);
                    *(u32x4*)dst = w;
                }
            }
    }
};
struct EpiM1 {
    static constexpr bool PERM = true; static constexpr bool MID = false;
    __device__ __forceinline__ void prep(const Unit&, int, int, int) const {}
    bf16_t* UT;
    __device__ __forceinline__ void operator()(AccRef acc, const Unit& u, int wr, int wc, int fr, int fq) const {
        asm volatile("" : "+v"(fr), "+v"(fq));
#pragma unroll
        for (int ai = 0; ai < 2; ++ai)
#pragma unroll
            for (int m = 0; m < 4; ++m) { bf16_t* rowp = UT + ((size_t)u.x0 * 256 + ai * 128 + wr * 64 + m * 16 + fr) * 128 + wc * 32 + fq * 8;
                const f32x4 v0 = acc[ai][0][m][0], v1 = acc[ai][0][m][1];
                u32x4 w; w.x = cvt_pk_bf16(v0[0], v0[1]); w.y = cvt_pk_bf16(v0[2], v0[3]); w.z = cvt_pk_bf16(v1[0], v1[1]); w.w = cvt_pk_bf16(v1[2], v1[3]);
                *(u32x4*)rowp = w; }
    }
};
struct EpiM2A {
    static constexpr bool PERM = true; static constexpr bool MID = false;
    __device__ __forceinline__ void prep(const Unit&, int, int, int) const {}
    bf16_t* AE; const float* nprev; float* den;
    __device__ __forceinline__ void operator()(AccRef acc, const Unit& u, int wr, int wc, int fr, int fq) const {
        asm volatile("" : "+v"(fr), "+v"(fq));
        const int mu = u.x0, dd = wc * 32 + fq * 8;
        const f32x4 n0 = *(const f32x4*)(nprev + (size_t)mu * 128 + dd), n1 = *(const f32x4*)(nprev + (size_t)mu * 128 + dd + 4);
        u32x4 qv8[2][4];
#pragma unroll
        for (int ai = 0; ai < 2; ++ai)
#pragma unroll
            for (int m = 0; m < 4; ++m) qv8[ai][m] = *(const u32x4*)(AE + ((size_t)mu * 256 + ai * 128 + wr * 64 + m * 16 + fr) * 512 + 256 + dd);
#pragma unroll
        for (int ai = 0; ai < 2; ++ai)
#pragma unroll
            for (int m = 0; m < 4; ++m) {
                const int t = ai * 128 + wr * 64 + m * 16 + fr; bf16_t* rowp = AE + ((size_t)mu * 256 + t) * 512;
                const u32x4 qv = qv8[ai][m];
                float part = bflo(qv.x) * n0[0] + bfhi(qv.x) * n0[1] + bflo(qv.y) * n0[2] + bfhi(qv.y) * n0[3] + bflo(qv.z) * n1[0] + bfhi(qv.z) * n1[1] + bflo(qv.w) * n1[2] + bfhi(qv.w) * n1[3];
#pragma unroll
                for (int bj = 0; bj < 2; ++bj) { const int s0 = bj * 128 + wc * 32 + fq * 8; f32x4 v0 = acc[ai][bj][m][0], v1 = acc[ai][bj][m][1];
                    int dts = t - s0; asm volatile("" : "+v"(dts));
#pragma unroll
                    for (int j = 0; j < 4; ++j) { v0[j] = (j <= dts) ? v0[j] : 0.f; v1[j] = (4 + j <= dts) ? v1[j] : 0.f; part += v0[j] + v1[j]; }
                    u32x4 w; w.x = cvt_pk_bf16(v0[0], v0[1]); w.y = cvt_pk_bf16(v0[2], v0[3]); w.z = cvt_pk_bf16(v1[0], v1[1]); w.w = cvt_pk_bf16(v1[2], v1[3]);
                    *(u32x4*)(rowp + s0) = w; }
                part += __shfl_xor(part, 16); part += __shfl_xor(part, 32);
                if (fq == 0) atomicAdd(den + (size_t)mu * 256 + (wr * 64 + fr) + (ai * 128 + m * 16), part);
            }
    }
};
struct EpiM2B {
    static constexpr bool PERM = true; static constexpr bool MID = false;
    __device__ __forceinline__ void prep(const Unit&, int, int, int) const {}
    const float* den; const float* normg; const bf16_t* OS; bf16_t* HN; LAS float* lnx;
    __device__ __forceinline__ void operator()(AccRef acc, const Unit& u, int wr, int wc, int fr, int fq) const {
        asm volatile("" : "+v"(fr), "+v"(fq));
        const int mu = u.x0, b = mu >> 6, hh = (mu >> 4) & 3, ch = mu & 15;
        float dnv[2][4];
#pragma unroll
        for (int ai = 0; ai < 2; ++ai)
#pragma unroll
            for (int m = 0; m < 4; ++m) dnv[ai][m] = den[(size_t)mu * 256 + ai * 128 + wr * 64 + m * 16 + fr];
#pragma unroll
        for (int ai = 0; ai < 2; ++ai)
#pragma unroll
            for (int m = 0; m < 4; ++m) {
                const int t = ai * 128 + wr * 64 + m * 16 + fr; const float dn = dnv[ai][m];
#ifdef DBG_DEN1
                const float inv = 1.0f;
#else
                const float inv = 1.0f / fmaxf(fabsf(dn), 1.0f);
#endif
                float s1 = 0.f, s2 = 0.f;
#pragma unroll
                for (int bj = 0; bj < 2; ++bj)
#pragma unroll
                    for (int n = 0; n < 2; ++n) { f32x4 h = acc[ai][bj][m][n] * inv; acc[ai][bj][m][n] = h; s1 += (h[0] + h[1]) + (h[2] + h[3]); s2 += (h[0] * h[0] + h[1] * h[1]) + (h[2] * h[2] + h[3] * h[3]); }
                s1 += __shfl_xor(s1, 16); s1 += __shfl_xor(s1, 32); s2 += __shfl_xor(s2, 16); s2 += __shfl_xor(s2, 32);
                if (fq == 0) { lnx[(t * 4 + wc) * 2] = s1; lnx[(t * 4 + wc) * 2 + 1] = s2; }
            }
        const int e0 = wc * 32 + fq * 8;
        f32x4 gg[2][2];
#pragma unroll
        for (int bj = 0; bj < 2; ++bj) { gg[bj][0] = *(const f32x4*)(normg + hh * 256 + bj * 128 + e0); gg[bj][1] = *(const f32x4*)(normg + hh * 256 + bj * 128 + e0 + 4); }
        asm volatile("s_waitcnt lgkmcnt(0)" ::: "memory"); __builtin_amdgcn_s_barrier(); asm volatile("" ::: "memory");
#pragma unroll
        for (int ai = 0; ai < 2; ++ai) {
            u32x4 ovv[4][2];
#pragma unroll
            for (int m = 0; m < 4; ++m)
#pragma unroll
                for (int bj = 0; bj < 2; ++bj) ovv[m][bj] = *(const u32x4*)(OS + (((size_t)(b * 16 + ch)) * 256 + ai * 128 + wr * 64 + m * 16 + fr) * 1024 + hh * 256 + bj * 128 + e0);
#pragma unroll
            for (int m = 0; m < 4; ++m) {
                const int t = ai * 128 + wr * 64 + m * 16 + fr; const size_t token = ((size_t)(b * 16 + ch)) * 256 + t;
                const LAS f32x4* lp = (const LAS f32x4*)(lnx + t * 8); const f32x4 a = lp[0], c = lp[1];
                const float mean = (a[0] + a[2] + c[0] + c[2]) * (1.0f / 256.0f); const float ex2 = (a[1] + a[3] + c[1] + c[3]) * (1.0f / 256.0f);
                const float rstd = 1.0f / sqrtf(fmaxf(ex2 - mean * mean, 0.f) + LN_EPS);
#pragma unroll
                for (int bj = 0; bj < 2; ++bj) { const int e = bj * 128 + e0; const size_t off = token * 1024 + hh * 256 + e; const u32x4 ov = ovv[m][bj];
#ifdef DBG_HN_OS
                    f32x4 v0 = {1.f, 1.f, 1.f, 1.f}, v1 = v0;
#elif defined(DBG_HN_RAW)
                    f32x4 v0 = acc[ai][bj][m][0], v1 = acc[ai][bj][m][1];
#else
                    f32x4 v0 = (acc[ai][bj][m][0] - mean) * rstd * gg[bj][0], v1 = (acc[ai][bj][m][1] - mean) * rstd * gg[bj][1];
#endif
#ifndef DBG_HN_ONE
                    v0[0] *= bflo(ov.x); v0[1] *= bfhi(ov.x); v0[2] *= bflo(ov.y); v0[3] *= bfhi(ov.y); v1[0] *= bflo(ov.z); v1[1] *= bfhi(ov.z); v1[2] *= bflo(ov.w); v1[3] *= bfhi(ov.w);
#endif
                    u32x4 w; w.x = cvt_pk_bf16(v0[0], v0[1]); w.y = cvt_pk_bf16(v0[2], v0[3]); w.z = cvt_pk_bf16(v1[0], v1[1]); w.w = cvt_pk_bf16(v1[2], v1[3]);
                    *(u32x4*)(HN + off) = w; }
            }
            asm volatile("" ::: "memory");
        }
        asm volatile("s_waitcnt lgkmcnt(0)" ::: "memory"); __builtin_amdgcn_s_barrier(); asm volatile("" ::: "memory");
    }
};
struct Frame {
    LAS unsigned char* lds;
    unsigned* ctl;
    unsigned char* ws;
    int tid, lane, wave, vcu, G;
};
__device__ __forceinline__ float wave_sum(float v) {
#pragma unroll
    for (int o = 1; o < 64; o <<= 1) v += __shfl_xor(v, o);
    return v;
}

__device__ __forceinline__ void tr_block(const float* src, size_t pitch, bf16_t* dst, size_t kd, int kb, int nb, LAS unsigned* scr, int lane, bool rotperm = false) {
    const float* s0 = src + (size_t)(64 * kb) * pitch + 64 * nb + 4 * (lane & 15);
#pragma unroll
    for (int i = 0; i < 8; ++i) {
        const int kp = 4 * i + (lane >> 4);
        const f32x4 a = __builtin_nontemporal_load((const f32x4*)(s0 + (size_t)(2 * kp) * pitch)), b = __builtin_nontemporal_load((const f32x4*)(s0 + (size_t)(2 * kp + 1) * pitch));
#pragma unroll
        for (int j = 0; j < 4; ++j) scr[(4 * (lane & 15) + j) * 33 + kp] = cvt_pk_bf16(a[j], b[j]);
    }
    LDS_WAIT(); asm volatile("" ::: "memory");
    u32x4 o[8];
#pragma unroll
    for (int c = 0; c < 8; ++c) { const int r0 = 8 * c + (lane >> 3), rr = (rotperm && c < 2) ? (8 * ((r0 >> 2) & 1) + 4 * (r0 >> 3) + (r0 & 3)) : r0, q4 = 4 * (lane & 7); o[c].x = scr[rr * 33 + q4]; o[c].y = scr[rr * 33 + q4 + 1]; o[c].z = scr[rr * 33 + q4 + 2]; o[c].w = scr[rr * 33 + q4 + 3]; }
    bf16_t* d = dst + (size_t)(64 * nb + (lane >> 3)) * kd + 64 * kb + 8 * (lane & 7);
#pragma unroll
    for (int c = 0; c < 8; ++c) *(u32x4*)(d + (size_t)(8 * c) * kd) = o[c];
    LDS_WAIT(); asm volatile("" ::: "memory");
}
__device__ __forceinline__ void tr_block8(const float* src, size_t pitch, unsigned char* dst, size_t kd, int kb, int nb, float scale, LAS unsigned* scr, int lane) {
    const float* s0 = src + (size_t)(128 * kb) * pitch + 64 * nb + 4 * (lane & 15);
#pragma unroll
    for (int i = 0; i < 8; ++i) {
        const int kq = 4 * i + (lane >> 4);
        const f32x4 r0 = __builtin_nontemporal_load((const f32x4*)(s0 + (size_t)(4 * kq) * pitch)) * scale, r1 = __builtin_nontemporal_load((const f32x4*)(s0 + (size_t)(4 * kq + 1) * pitch)) * scale,
                    r2 = __builtin_nontemporal_load((const f32x4*)(s0 + (size_t)(4 * kq + 2) * pitch)) * scale, r3 = __builtin_nontemporal_load((const f32x4*)(s0 + (size_t)(4 * kq + 3) * pitch)) * scale;
#pragma unroll
        for (int j = 0; j < 4; ++j) { int w = __builtin_amdgcn_cvt_pk_fp8_f32(r0[j], r1[j], 0, false); w = __builtin_amdgcn_cvt_pk_fp8_f32(r2[j], r3[j], w, true); scr[(4 * (lane & 15) + j) * 33 + kq] = (unsigned)w; }
    }
    LDS_WAIT(); asm volatile("" ::: "memory");
    u32x4 o[8];
#pragma unroll
    for (int c = 0; c < 8; ++c) { const int rr = 8 * c + (lane >> 3), q4 = 4 * (lane & 7); o[c].x = scr[rr * 33 + q4]; o[c].y = scr[rr * 33 + q4 + 1]; o[c].z = scr[rr * 33 + q4 + 2]; o[c].w = scr[rr * 33 + q4 + 3]; }
    unsigned char* d = dst + (size_t)(64 * nb + (lane >> 3)) * kd + 128 * kb + 16 * (lane & 7);
#pragma unroll
    for (int c = 0; c < 8; ++c) *(u32x4*)(d + (size_t)(8 * c) * kd) = o[c];
    LDS_WAIT(); asm volatile("" ::: "memory");
}
constexpr int CONV_ITEMS = 24576;
struct ConvItem { const float* s0; size_t pitch; unsigned char* d; float scale; };
__device__ __forceinline__ ConvItem conv_desc(const float* wgu, const float* wd, unsigned char* ws, int v, int lane) {
    const int layer = v >= 12288; int r = v - layer * 12288; ConvItem it;
    if (r < 8192) { const int mat = layer * 32 + (r >> 8); r &= 255; const int kb = r >> 5, nb = r & 31; it.pitch = 2048; it.scale = FP8_SWGU;
        it.s0 = wgu + (size_t)mat * 1024 * 2048 + (size_t)(128 * kb) * 2048 + 64 * nb + 4 * (lane & 15); it.d = ws + WS_WGU + (size_t)mat * 2048 * 1024 + (size_t)(64 * nb + (lane >> 3)) * 1024 + 128 * kb + 16 * (lane & 7); }
    else { r -= 8192; const int mat = layer * 32 + (r >> 7); r &= 127; const int kb = r >> 4, nb = r & 15; it.pitch = 1024; it.scale = FP8_SWD;
        it.s0 = wd + (size_t)mat * 1024 * 1024 + (size_t)(128 * kb) * 1024 + 64 * nb + 4 * (lane & 15); it.d = ws + WS_WD + (size_t)mat * 1024 * 1024 + (size_t)(64 * nb + (lane >> 3)) * 1024 + 128 * kb + 16 * (lane & 7); }
    return it;
}
__device__ __forceinline__ void conv_items(Frame& F, const float* wgu, const float* wd, int v_lo, int v_hi, int cw, int ncw) {
    LAS unsigned* scr = (LAS unsigned*)(F.lds + RING_OFF + F.wave * 8448); unsigned char* ws = F.ws; const int lane = F.lane;
    int v = v_lo + cw; if (v >= v_hi) return;
    ConvItem cur = conv_desc(wgu, wd, ws, v, lane);
    f32x4 r[8][4];
#pragma unroll
    for (int i = 0; i < 8; ++i) { const int kq = 4 * i + (lane >> 4);
#pragma unroll
        for (int q = 0; q < 4; ++q) r[i][q] = __builtin_nontemporal_load((const f32x4*)(cur.s0 + (size_t)(4 * kq + q) * cur.pitch)); }
    for (;;) {
        const int vn = v + ncw; const bool has = vn < v_hi; ConvItem nx = cur; if (has) nx = conv_desc(wgu, wd, ws, vn, lane);
#pragma unroll
        for (int i = 0; i < 8; ++i) { const int kq = 4 * i + (lane >> 4);
#pragma unroll
            for (int j = 0; j < 4; ++j) { int w = __builtin_amdgcn_cvt_pk_fp8_f32(r[i][0][j] * cur.scale, r[i][1][j] * cur.scale, 0, false); w = __builtin_amdgcn_cvt_pk_fp8_f32(r[i][2][j] * cur.scale, r[i][3][j] * cur.scale, w, true); scr[(4 * (lane & 15) + j) * 33 + kq] = (unsigned)w; }
            if (has) {
#pragma unroll
                for (int q = 0; q < 4; ++q) r[i][q] = __builtin_nontemporal_load((const f32x4*)(nx.s0 + (size_t)(4 * kq + q) * nx.pitch)); } }
        LDS_WAIT(); asm volatile("" ::: "memory");
        u32x4 o[8];
#pragma unroll
        for (int c = 0; c < 8; ++c) { const int rr = 8 * c + (lane >> 3), q4 = 4 * (lane & 7); o[c].x = scr[rr * 33 + q4]; o[c].y = scr[rr * 33 + q4 + 1]; o[c].z = scr[rr * 33 + q4 + 2]; o[c].w = scr[rr * 33 + q4 + 3]; }
#pragma unroll
        for (int c = 0; c < 8; ++c) __builtin_nontemporal_store(o[c], (u32x4*)(cur.d + (size_t)(8 * c) * 1024));
        LDS_WAIT(); asm volatile("" ::: "memory");
        if (!has) break;
        v = vn; cur = nx;
    }
}
struct P0In { const float *x, *wqkv, *wo, *win, *wout, *rw, *wgu, *wd; const int* pos; };
__device__ __forceinline__ void p0_prologue(Frame& F, const P0In& I) {
    LAS unsigned* scr = (LAS unsigned*)(F.lds + RING_OFF + F.wave * 8448);
    const int gw = F.vcu * NWAVES + F.wave, NGW = F.G * NWAVES;
    unsigned char* ws = F.ws;
    constexpr int KB = 16;
    constexpr int I_QKV = KB * 48, I_WO = KB * 16, I_INA1 = KB * 16, I_INA2 = KB * 16, I_INB = KB * 24, I_WOUT = KB * 16;
    constexpr int I_SMALL = I_QKV + I_WO + I_INA1 + I_INA2 + I_INB + I_WOUT;
    constexpr int NITEMS = I_SMALL;
    for (int it = gw; it < NITEMS; it += NGW) {
        int r = it; const float* src; size_t pitch; bf16_t* dst; int nbl; const bool isqkv = it < I_QKV;
        if (r < I_QKV) { src = I.wqkv; pitch = 3072; dst = (bf16_t*)(ws + WS_WQKV); nbl = 48; }
        else if ((r -= I_QKV) < I_WO) { src = I.wo; pitch = 1024; dst = (bf16_t*)(ws + WS_WO); nbl = 16; }
        else if ((r -= I_WO) < I_INA1) { src = I.win; pitch = 3080; dst = (bf16_t*)(ws + WS_WINA); nbl = 16; }
        else if ((r -= I_INA1) < I_INA2) { src = I.win + 2048; pitch = 3080; dst = (bf16_t*)(ws + WS_WINA) + (size_t)1024 * 1024; nbl = 16; }
        else if ((r -= I_INA2) < I_INB) { src = I.win + 512; pitch = 3080; dst = (bf16_t*)(ws + WS_WINB); nbl = 24; }
        else { r -= I_INB; src = I.wout; pitch = 1024; dst = (bf16_t*)(ws + WS_WOUT); nbl = 16; }
        tr_block(src, pitch, dst, 1024, r / nbl, r % nbl, scr, F.lane, isqkv && (r % nbl) < 32);
    }
    if (NCONV == 0) conv_items(F, I.wgu, I.wd, 0, CONV_ITEMS, gw, NGW);
    const int gt = F.vcu * NTHR + F.tid, NGT = F.G * NTHR;
    for (int i = gt; i < NTOK * DM / 8; i += NGT) { const f32x4 a = ((const f32x4*)I.x)[2 * i], b = ((const f32x4*)I.x)[2 * i + 1];
        u32x4 w; w.x = cvt_pk_bf16(a[0], a[1]); w.y = cvt_pk_bf16(a[2], a[3]); w.z = cvt_pk_bf16(b[0], b[1]); w.w = cvt_pk_bf16(b[2], b[3]); ((u32x4*)(ws + WS_XB))[i] = w; }
    for (int i = gt; i < NTOK * 8; i += NGT) { const int tok = i >> 3, f = i & 7; const float inv = powf(500000.0f, -(float)f * 0.125f); const float ang = (float)I.pos[tok] * inv;
        float sn, cs; sincosf(ang, &sn, &cs); float* rp = (float*)(ws + WS_ROPE) + (size_t)tok * 16; rp[f] = cs; rp[8 + f] = sn; }
    for (int i = gt; i < 2 * 32 * 1024; i += NGT) { const int l = i >> 15, e = (i >> 10) & 31, k = i & 1023; ((float*)(ws + WS_RWT))[i] = I.rw[((size_t)l * 1024 + k) * 32 + e]; }
    for (int i = gt; i < 8 * 1024; i += NGT) { const int gidx = i >> 10, k = i & 1023; ((float*)(ws + WS_WG))[i] = I.win[(size_t)k * 3080 + 3072 + gidx]; }
}

__device__ __forceinline__ void phase_ln_router(Frame& F, const bf16_t* __restrict__ z, bf16_t* __restrict__ x1, const float* lng, const float* lnb, const float* rbias, int layer, int cset) {
    unsigned char* ws = F.ws;
    LAS f32x4* rwv = (LAS f32x4*)(F.lds + RING_OFF);
    LAS int* lcnt = (LAS int*)(F.lds + LX_LCNT); LAS int* gbase = (LAS int*)(F.lds + LX_GBASE); LAS int* rec = (LAS int*)(F.lds + LX_REC);
    LAS float* lgb = (LAS float*)(F.lds + LX_LNX);
    { const f32x4* src = (const f32x4*)((const float*)(ws + WS_RWT) + (size_t)layer * 32768);
      for (int i = F.tid; i < 8192; i += NTHR) { const int e = i >> 8, c = i & 255; rwv[e * 256 + (c ^ (e & 15))] = src[i]; } }
    int* toke = (int*)(ws + WS_TOKE); int* tokp = (int*)(ws + WS_TOKP); float* tokg = (float*)(ws + WS_TOKG);
    unsigned short* rowtok = (unsigned short*)(ws + WS_ROWTOK); unsigned char* xb8 = (unsigned char*)(ws + WS_XB);
    unsigned* cntg = F.ctl + CW_CNT + cset * 2048;
    const int lane = F.lane;
    for (int grp = F.vcu; grp < NTOK / 64; grp += F.G) {
        if (F.tid < 32) lcnt[F.tid] = 0;
        for (int i = F.tid; i < 1024; i += NTHR) { lgb[i] = lng[i]; lgb[1024 + i] = lnb[i]; }
        __syncthreads();
#pragma unroll 2
        for (int tk = 0; tk < 8; tk += 2) {
            const int token0 = grp * 64 + F.wave * 8 + tk;
            f32x4 v[2][4]; float s[2] = {0.f, 0.f};
#pragma unroll
            for (int u = 0; u < 2; ++u)
#pragma unroll
                for (int j = 0; j < 4; ++j) { const u32x2 zz = *(const u32x2*)(z + (size_t)(token0 + u) * DM + 4 * lane + 256 * j); v[u][j] = (f32x4){bflo(zz.x), bfhi(zz.x), bflo(zz.y), bfhi(zz.y)}; s[u] += (v[u][j][0] + v[u][j][1]) + (v[u][j][2] + v[u][j][3]); }
#pragma unroll
            for (int o = 1; o < 64; o <<= 1) { const float a0 = __shfl_xor(s[0], o), a1 = __shfl_xor(s[1], o); s[0] += a0; s[1] += a1; }
            float s2[2] = {0.f, 0.f};
#pragma unroll
            for (int u = 0; u < 2; ++u) { const float mean = s[u] * (1.0f / DM);
#pragma unroll
                for (int j = 0; j < 4; ++j) { v[u][j] = v[u][j] - mean; s2[u] += (v[u][j][0] * v[u][j][0] + v[u][j][1] * v[u][j][1]) + (v[u][j][2] * v[u][j][2] + v[u][j][3] * v[u][j][3]); } }
#pragma unroll
            for (int o = 1; o < 64; o <<= 1) { const float a0 = __shfl_xor(s2[0], o), a1 = __shfl_xor(s2[1], o); s2[0] += a0; s2[1] += a1; }
#pragma unroll
            for (int u = 0; u < 2; ++u) { const float rstd = 1.0f / sqrtf(s2[u] * (1.0f / DM) + LN_EPS); const int token = token0 + u;
#pragma unroll
                for (int j = 0; j < 4; ++j) { const f32x4 gvj = *(const LAS f32x4*)(lgb + 4 * lane + 256 * j), bvj = *(const LAS f32x4*)(lgb + 1024 + 4 * lane + 256 * j);
                    const f32x4 y = v[u][j] * rstd * gvj + bvj; { u32x2 wb; wb.x = cvt_pk_bf16(y[0], y[1]); wb.y = cvt_pk_bf16(y[2], y[3]); *(u32x2*)(x1 + (size_t)token * DM + 4 * lane + 256 * j) = wb; }
                    int w8 = __builtin_amdgcn_cvt_pk_fp8_f32(y[0] * FP8_SA, y[1] * FP8_SA, 0, false); w8 = __builtin_amdgcn_cvt_pk_fp8_f32(y[2] * FP8_SA, y[3] * FP8_SA, w8, true);
                    *(int*)(xb8 + (size_t)token * DM + 4 * lane + 256 * j) = w8; } }
        }
        VM_WAIT(); __syncthreads();
        const int tg = F.wave & 3, kh = F.wave >> 2, e0 = lane & 15, kq = lane >> 4;
        f32x4 acc0 = {0.f, 0.f, 0.f, 0.f}, acc1 = acc0;
        { const bf16_t* arow = x1 + (size_t)(grp * 64 + tg * 16 + e0) * DM + kh * 512 + 4 * kq;
#pragma unroll 4
          for (int blk = 0; blk < 32; ++blk) {
              const u32x2 ab = *(const u32x2*)(arow + blk * 16); const f32x4 a4 = {bflo(ab.x), bfhi(ab.x), bflo(ab.y), bfhi(ab.y)}; const int c = ((kh * 512 + blk * 16) >> 2) + kq;
              const f32x4 b0 = rwv[e0 * 256 + (c ^ e0)], b1 = rwv[(16 + e0) * 256 + (c ^ e0)];
#pragma unroll
              for (int j = 0; j < 4; ++j) { acc0 = __builtin_amdgcn_mfma_f32_16x16x4f32(a4[j], b0[j], acc0, 0, 0, 0); acc1 = __builtin_amdgcn_mfma_f32_16x16x4f32(a4[j], b1[j], acc1, 0, 0, 0); } } }
        __syncthreads();
        if (kh == 1) { ((LAS f32x4*)lgb)[(tg * 2 + 0) * 64 + lane] = acc0; ((LAS f32x4*)lgb)[(tg * 2 + 1) * 64 + lane] = acc1; }
        __syncthreads();
        if (kh == 0) {
            acc0 = acc0 + ((LAS f32x4*)lgb)[(tg * 2 + 0) * 64 + lane]; acc1 = acc1 + ((LAS f32x4*)lgb)[(tg * 2 + 1) * 64 + lane];
            const float rb0 = rbias[e0], rb1 = rbias[16 + e0];
#pragma unroll
            for (int r = 0; r < 4; ++r) {
                float l0 = acc0[r] + rb0, l1 = acc1[r] + rb1; float tv[4]; int te[4];
#pragma unroll
                for (int k = 0; k < 4; ++k) { float bvv = (l1 > l0) ? l1 : l0; int be = (l1 > l0) ? 16 + e0 : e0;
#pragma unroll
                    for (int o = 1; o < 16; o <<= 1) { const float ov = __shfl_xor(bvv, o); const int oe = __shfl_xor(be, o); const bool take = (ov > bvv) || (ov == bvv && oe < be); bvv = take ? ov : bvv; be = take ? oe : be; }
                    tv[k] = bvv; te[k] = be; if (be == e0) l0 = -INFINITY; if (be == 16 + e0) l1 = -INFINITY; }
                const float w0 = 1.0f, w1 = __expf(tv[1] - tv[0]), w2 = __expf(tv[2] - tv[0]), w3 = __expf(tv[3] - tv[0]); const float wi = 1.0f / (w0 + w1 + w2 + w3);
                if (e0 < 4) {
                    const int tl = tg * 16 + 4 * kq + r, token = grp * 64 + tl;
                    const int ek = (e0 == 0) ? te[0] : (e0 == 1) ? te[1] : (e0 == 2) ? te[2] : te[3];
                    const float wk = (e0 == 0) ? w0 : (e0 == 1) ? w1 : (e0 == 2) ? w2 : w3;
                    const int li = atomicAdd((int*)(lcnt + ek), 1); rec[tl * 8 + e0] = ek; rec[tl * 8 + 4 + e0] = li;
                    toke[token * 4 + e0] = ek; tokg[token * 4 + e0] = wk * wi;
                }
            }
        }
        __syncthreads();
        if (F.tid < 32) gbase[F.tid] = (int)__hip_atomic_fetch_add(cntg + F.tid * 64, (unsigned)lcnt[F.tid], RLX_AGENT);
        __syncthreads();
        if (F.tid < 256) { const int tl = F.tid >> 2, k = F.tid & 3; const int token = grp * 64 + tl; const int e = rec[tl * 8 + k]; const int pos = gbase[e] + rec[tl * 8 + 4 + k];
            tokp[token * 4 + k] = pos; rowtok[(size_t)e * NTOK + pos] = (unsigned short)token; }
        __syncthreads();
    }
}

__device__ __forceinline__ int moe_tables(Frame& F, int layer) {
    LAS int* tile_e = (LAS int*)(F.lds + LX_TILEE); LAS int* tbase = (LAS int*)(F.lds + LX_TBASE);
    if (F.tid < 64) {
        const int e = F.lane & 31; const int c = (int)__hip_atomic_load(F.ctl + CW_CNT + layer * 2048 + e * 64, RLX_AGENT); const int nt = (F.lane < 32) ? ((c + 255) >> 8) : 0;
        int inc = nt;
#pragma unroll
        for (int o = 1; o < 32; o <<= 1) { const int up = __shfl_up(inc, o); if (F.lane >= o) inc += up; }
        const int t0 = inc - nt;
        if (F.lane < 32) { tbase[e] = t0; for (int i = 0; i < nt; ++i) tile_e[t0 + i] = e; }
        if (F.lane == 31) tbase[32] = inc;
    }
    __syncthreads();
    return tbase[32];
}

template <bool NEXT_MLSTM>
__device__ __forceinline__ void phase_combine(Frame& F, const bf16_t* __restrict__ x1, float* __restrict__ out, const float* lng, const float* lnb, const float* bgates, int layer) {
    unsigned char* ws = F.ws;
    (void)moe_tables(F, layer);
    const LAS int* tbase = (const LAS int*)(F.lds + LX_TBASE);
    const int* toke = (const int*)(ws + WS_TOKE); const int* tokp = (const int*)(ws + WS_TOKP); const float* tokg = (const float*)(ws + WS_TOKG);
    const unsigned char* Y = (const unsigned char*)(ws + WS_Y); bf16_t* xb = (bf16_t*)(ws + WS_XB);
    LAS float* wg = (LAS float*)(F.lds + RING_OFF);
    LAS float* lgb = wg + 8192;
    if constexpr (NEXT_MLSTM) { const f32x4* src = (const f32x4*)(ws + WS_WG); for (int i = F.tid; i < 2048; i += NTHR) ((LAS f32x4*)wg)[i] = src[i];
        for (int i = F.tid; i < 1024; i += NTHR) { lgb[i] = lng[i]; lgb[1024 + i] = lnb[i]; } __syncthreads(); }
    const int lane = F.lane; const int gw = F.vcu * NWAVES + F.wave, NGW = F.G * NWAVES;
    f32x4 gv[4], bv[4];
    if constexpr (!NEXT_MLSTM) {
#pragma unroll
        for (int j = 0; j < 4; ++j) { gv[j] = *(const f32x4*)(lng + 4 * lane + 256 * j); bv[j] = *(const f32x4*)(lnb + 4 * lane + 256 * j); } }
    constexpr int NTK = 2;
    int rowv = 0; float gatev = 0.f;
    { const int mt = gw + (lane >> 2) * NGW; if (mt < NTOK) { const int ee = toke[mt * 4 + (lane & 3)]; rowv = tbase[ee] * 256 + tokp[mt * 4 + (lane & 3)]; gatev = tokg[mt * 4 + (lane & 3)] * (DBG_MOE_MUL / FP8_SY); } }
    int it = 0;
    for (int token0 = gw; token0 < NTOK; token0 += NTK * NGW, ++it) {
        f32x4 vv[NTK][4];
#pragma unroll
        for (int u = 0; u < NTK; ++u) { const int token = token0 + u * NGW; if (token < NTOK) {
#pragma unroll
            for (int j = 0; j < 4; ++j) { const u32x2 xx = *(const u32x2*)(x1 + (size_t)token * DM + 4 * lane + 256 * j); vv[u][j] = (f32x4){bflo(xx.x), bfhi(xx.x), bflo(xx.y), bfhi(xx.y)} * ALPHA; }
#pragma unroll
            for (int k = 0; k < 4; ++k) { const int sl = (it * NTK + u) * 4 + k; const size_t row = (size_t)__builtin_amdgcn_readlane(rowv, sl); const float gt = __int_as_float(__builtin_amdgcn_readlane(__float_as_int(gatev), sl));
#pragma unroll
                for (int j = 0; j < 4; ++j) { const int y = *(const int*)(Y + row * DM + 4 * lane + 256 * j); const f32x2 lo = __builtin_amdgcn_cvt_pk_f32_fp8(y, false), hi = __builtin_amdgcn_cvt_pk_f32_fp8(y, true);
                    vv[u][j][0] += gt * lo[0]; vv[u][j][1] += gt * lo[1]; vv[u][j][2] += gt * hi[0]; vv[u][j][3] += gt * hi[1]; } } } }
#pragma unroll
        for (int u = 0; u < NTK; ++u) { const int token = token0 + u * NGW; if (token < NTOK) {
        f32x4 v[4];
#pragma unroll
        for (int j = 0; j < 4; ++j) v[j] = vv[u][j];
        float s = 0.f;
#pragma unroll
        for (int j = 0; j < 4; ++j) s += (v[j][0] + v[j][1]) + (v[j][2] + v[j][3]);
        const float mean = wave_sum(s) * (1.0f / DM); float s2 = 0.f;
#pragma unroll
        for (int j = 0; j < 4; ++j) { v[j] = v[j] - mean; s2 += (v[j][0] * v[j][0] + v[j][1] * v[j][1]) + (v[j][2] * v[j][2] + v[j][3] * v[j][3]); }
        const float rstd = 1.0f / sqrtf(wave_sum(s2) * (1.0f / DM) + LN_EPS);
#pragma unroll
        for (int j = 0; j < 4; ++j) { if constexpr (NEXT_MLSTM) { gv[j] = *(const LAS f32x4*)(lgb + 4 * lane + 256 * j); bv[j] = *(const LAS f32x4*)(lgb + 1024 + 4 * lane + 256 * j); }
            v[j] = v[j] * rstd * gv[j] + bv[j]; if constexpr (!NEXT_MLSTM) *(f32x4*)(out + (size_t)token * DM + 4 * lane + 256 * j) = v[j]; }
        if constexpr (NEXT_MLSTM) {
#pragma unroll
            for (int j = 0; j < 4; ++j) { u32x2 w; w.x = cvt_pk_bf16(v[j][0], v[j][1]); w.y = cvt_pk_bf16(v[j][2], v[j][3]); *(u32x2*)(xb + (size_t)token * DM + 4 * lane + 256 * j) = w; }
            float gp[8];
#pragma unroll
            for (int gi = 0; gi < 8; ++gi) { float a = 0.f;
#pragma unroll
                for (int j = 0; j < 4; ++j) { const f32x4 w = *(const LAS f32x4*)(wg + gi * 1024 + 4 * lane + 256 * j); a += (v[j][0] * w[0] + v[j][1] * w[1]) + (v[j][2] * w[2] + v[j][3] * w[3]); }
                gp[gi] = a; if (gi & 1) asm volatile("" ::: "memory"); }
#pragma unroll
            for (int o = 1; o < 64; o <<= 1) {
#pragma unroll
                for (int gi = 0; gi < 8; ++gi) gp[gi] += __shfl_xor(gp[gi], o); }
#pragma unroll
            for (int gi = 0; gi < 8; ++gi) gp[gi] += bgates[gi];
            if (lane == 0) {
#pragma unroll
                for (int hh = 0; hh < 4; ++hh) { ((float*)(ws + WS_GI))[(size_t)hh * NTOK + token] = gp[hh];
                    const float f = gp[4 + hh]; const float lf = (f >= 0.f) ? -log1pf(__expf(-f)) : (f - log1pf(__expf(f)));
                    ((float*)(ws + WS_LF))[(size_t)hh * NTOK + token] = lf; } }
        }
        } }
    }
}

__device__ __forceinline__ void phase_gate_scan(Frame& F) {
    unsigned char* ws = F.ws; const int lane = F.lane; const int gw = F.vcu * NWAVES + F.wave, NGW = F.G * NWAVES;
    for (int mu = gw; mu < 256; mu += NGW) {
        const int b = mu >> 6, hh = (mu >> 4) & 3, ch = mu & 15; const size_t base = (size_t)hh * NTOK + (size_t)b * SEQ + ch * 256 + 4 * lane;
        const f32x4 lf = *(const f32x4*)((const float*)(ws + WS_LF) + base), gi = *(const f32x4*)((const float*)(ws + WS_GI) + base);
        f32x4 c; c[0] = lf[0]; c[1] = c[0] + lf[1]; c[2] = c[1] + lf[2]; c[3] = c[2] + lf[3];
        float tot = c[3];
#pragma unroll
        for (int o = 1; o < 64; o <<= 1) { const float up = __shfl_up(tot, o); if (lane >= o) tot += up; }
        const float excl = tot - c[3];
        f32x4 rf, cf;
#pragma unroll
        for (int j = 0; j < 4; ++j) { const float bt = excl + c[j]; rf[j] = __expf(bt); cf[j] = __expf(gi[j] - bt); }
        *(f32x4*)((float*)(ws + WS_RF) + base) = rf; *(f32x4*)((float*)(ws + WS_CF) + base) = cf;
        if (lane == 63) ((float*)(ws + WS_DEC))[mu] = __expf(tot);
    }
}
__device__ __forceinline__ void phase_nu(Frame& F) {
    unsigned char* ws = F.ws; const int lane = F.lane; const int gw = F.vcu * NWAVES + F.wave, NGW = F.G * NWAVES;
    const bf16_t* KT = (const bf16_t*)(ws + WS_KT); float* NU = (float*)(ws + WS_NU);
    for (int r0 = gw * 16; r0 < 256 * 128; r0 += NGW * 16) {
        const int mu = r0 >> 7, d0 = r0 & 127, b = mu >> 6, hh = (mu >> 4) & 3, ch = mu & 15;
        const bf16_t* base = KT + (size_t)(hh * 128 + d0) * NTOK + (size_t)b * SEQ + ch * 256 + 4 * lane;
        u32x2 kv[16];
#pragma unroll
        for (int i = 0; i < 16; ++i) kv[i] = *(const u32x2*)(base + (size_t)i * NTOK);
        float s[16];
#pragma unroll
        for (int i = 0; i < 16; ++i) s[i] = (bflo(kv[i].x) + bfhi(kv[i].x)) + (bflo(kv[i].y) + bfhi(kv[i].y));
#pragma unroll
        for (int o = 1; o < 64; o <<= 1) {
#pragma unroll
            for (int i = 0; i < 16; ++i) s[i] += __shfl_xor(s[i], o); }
        float mine = s[0];
#pragma unroll
        for (int i = 1; i < 16; ++i) mine = (lane == i) ? s[i] : mine;
        if (lane < 16) NU[r0 + lane] = mine;
    }
}
__device__ __forceinline__ void phase_state_scan(Frame& F) {
    unsigned char* ws = F.ws; const int gt = F.vcu * NTHR + F.tid, NGT = F.G * NTHR;
    const bf16_t* UT = (const bf16_t*)(ws + WS_UT); const float* DEC = (const float*)(ws + WS_DEC); bf16_t* BE = (bf16_t*)(ws + WS_BE);
    for (int i = gt; i < 16 * 256 * 32; i += NGT) { const int bh = i >> 13, e = (i >> 5) & 255, dg = i & 31;
        f32x4 U[16]; float dc[16];
#pragma unroll
        for (int ch = 0; ch < 16; ++ch) { const size_t mu = (size_t)bh * 16 + ch; { const u32x2 uu = *(const u32x2*)(UT + (mu * 256 + e) * 128 + 4 * dg); U[ch] = (f32x4){bflo(uu.x), bfhi(uu.x), bflo(uu.y), bfhi(uu.y)}; } dc[ch] = DEC[mu]; }
        f32x4 C = {0.f, 0.f, 0.f, 0.f};
#pragma unroll
        for (int ch = 0; ch < 16; ++ch) { const size_t mu = (size_t)bh * 16 + ch;
            u32x2 w; w.x = cvt_pk_bf16(C[0], C[1]); w.y = cvt_pk_bf16(C[2], C[3]);
#ifdef DBG_NO_INTER
            w.x = 0u; w.y = 0u;
#endif
            *(u32x2*)(BE + (mu * 256 + e) * 384 + 256 + 4 * dg) = w;
            C = (C + U[ch]) * dc[ch]; } }
    const float* NU = (const float*)(ws + WS_NU); float* NP = (float*)(ws + WS_NPREV);
    for (int i = gt; i < 16 * 128; i += NGT) { const int bh = i >> 7, d = i & 127; float n = 0.f;
        for (int ch = 0; ch < 16; ++ch) { const int mu = bh * 16 + ch; NP[mu * 128 + d] = n; n = (n + NU[mu * 128 + d]) * DEC[mu];
#ifdef DBG_NO_INTER
            n = 0.f;
#endif
        } }
}
struct Args { const float* in[18]; float* out; unsigned char* ws; int ph_lo, ph_hi; };
__global__ void __launch_bounds__(NTHR, 2) mk_fwd(Args args) {
    extern __shared__ __attribute__((aligned(16))) unsigned char lds[];
    Frame F;
    const char __attribute__((address_space(4)))* kargp = (const char __attribute__((address_space(4)))*)__builtin_amdgcn_kernarg_segment_ptr();
#define AIN(i) ({ const char __attribute__((address_space(4)))* k_ = kargp; asm volatile("" : "+s"(k_)); *(const float* const __attribute__((address_space(4)))*)(k_ + 8 * (i)); })
    unsigned char* const ws0 = (unsigned char*)AIN(19);
    F.lds = (LAS unsigned char*)lds; F.ws = ws0; F.ctl = (unsigned*)(ws0 + WS_CTL);
    F.tid = threadIdx.x; F.lane = F.tid & 63; F.wave = __builtin_amdgcn_readfirstlane(F.tid >> 6);
    F.G = gridDim.x; { const int bx = blockIdx.x; F.vcu = (F.G % 8 == 0) ? (bx % 8) * (F.G / 8) + bx / 8 : bx; }
    for (int u = F.tid; u < (LDS_BYTES - LX) / 4; u += NTHR) ((LAS unsigned*)(F.lds + LX))[u] = 0u;
    __syncthreads();
    int lo, hi; { const char __attribute__((address_space(4)))* k_ = kargp; lo = *(const int __attribute__((address_space(4)))*)(k_ + 160); hi = *(const int __attribute__((address_space(4)))*)(k_ + 164); }
    XcdBarrier bar; bar.bar = (unsigned*)(F.ctl + CW_BAR); bar.x = 0; bar.st = nullptr;
    if (hi - lo > 1) bar = xcd_barrier_post((unsigned*)(F.ctl + CW_BAR), (volatile LAS unsigned*)(F.lds + LX_MISC) + 8);
#ifndef PHASE_MASK
#define PHASE_MASK 0x7FFFF
#endif
#define IN(k) ((((PHASE_MASK) >> (k)) & 1) && lo <= (k) && (k) < hi)
#ifndef REPEAT_MASK
#define REPEAT_MASK 0
#endif
#define PH(k) if (IN(k))
#define SEAM(k) do { if (IN(k) && IN((k) + 1)) xcd_barrier(bar); } while (0)
    unsigned char* ws = ws0;
#define x_in AIN(0)
#define ln_mix_g AIN(8)
#define ln_mix_b AIN(9)
#define ln_ffn_g AIN(10)
#define ln_ffn_b AIN(11)
#define router_b AIN(13)
#define b_gu AIN(15)
#define b_dn AIN(17)
    bf16_t* XB = (bf16_t*)(ws + WS_XB); bf16_t* QB_ = (bf16_t*)(ws + WS_Q); bf16_t* KB_ = (bf16_t*)(ws + WS_K); bf16_t* VB_ = (bf16_t*)(ws + WS_V);
    bf16_t* R0 = (bf16_t*)(ws + WS_R0); bf16_t* R1 = (bf16_t*)(ws + WS_R1);
    bf16_t* HB = (bf16_t*)(ws + WS_H); bf16_t* YB = (bf16_t*)(ws + WS_Y);
    LAS unsigned char* ring = F.lds + RING_OFF;
    const int cG = (int)blockIdx.x;
    const bool isConv = (NCONV > 0) && ((int)blockIdx.x >= F.G - NCONV);
    const int Gc = F.G - NCONV, cwv = ((int)blockIdx.x - Gc) * NWAVES + F.wave, ncw = NCONV * NWAVES;
#define CONV_SLICE(a, b) conv_items(F, AIN(14), AIN(16), (int)((long)CONV_ITEMS * (a) / 1000), (int)((long)CONV_ITEMS * (b) / 1000), cwv, ncw)

    PH(0) { P0In I{x_in, AIN(2), AIN(3), AIN(4), AIN(7), AIN(12), AIN(14), AIN(16), (const int*)AIN(1)}; p0_prologue(F, I); }
    SEAM(0);
    PH(1) { { Gemm g{1024, 1024, 1024, nullptr}; DenseSched S{64, 12, F.G, cG, (const char*)XB, (const char*)(ws + WS_WQKV), (size_t)256 * 1024 * 2, (size_t)256 * 1024 * 2};
        EpiQKV E{QB_, KB_, VB_, (const float*)(ws + WS_ROPE), (float*)(ws + WS_KSUM), (LAS float*)(F.lds + LX_ROPE)};
        pg8::gemm_phase<EpiQKV, DenseSched, true, false>(ring, g, S, E); } }
    SEAM(1);
    PH(2) { if (isConv) CONV_SLICE(0, 1000); else {
        const attn_body::AttnTensors AT{(const attn_body::bf16*)QB_, (const attn_body::bf16*)KB_, (const attn_body::bf16*)VB_, (attn_body::bf16*)QB_, (const float*)(ws + WS_KSUM)};
        if (NCONV == 0) { const attn_body::StaticOrder S((int)F.G, (int)blockIdx.x); attn_body::attn_phase<attn_body::StaticOrder>((char*)lds + RING_OFF, AT, S); }
        else { const attn_body::SnakeOrder S{cG, Gc}; attn_body::attn_phase<attn_body::SnakeOrder>((char*)lds + RING_OFF, AT, S); } } }
    SEAM(2);
    PH(3) { { Gemm g{1024, 1024, 1024, nullptr}; DenseSched S{64, 4, F.G, cG, (const char*)QB_, (const char*)(ws + WS_WO), (size_t)256 * 1024 * 2, (size_t)256 * 1024 * 2};
        EpiZ E{XB, R0, DBG_ATTN_MUL}; pg8::gemm_phase<EpiZ, DenseSched, true, false>(ring, g, S, E); } }
    SEAM(3);
    PH(4) phase_ln_router(F, R0, R1, ln_mix_g, ln_mix_b, router_b, 0, 0);
    SEAM(4);
    PH(5) { const int nT = moe_tables(F, 0); LAS unsigned short* tokl = (LAS unsigned short*)(F.lds + LX_TOKL);
        { const unsigned short* rowtok = (const unsigned short*)(ws + WS_ROWTOK); const LAS int* tile_e = (const LAS int*)(F.lds + LX_TILEE); const LAS int* tbase = (const LAS int*)(F.lds + LX_TBASE);
          for (int i = 0; i < TOKL_ROUNDS; ++i) { int pm, pn, hf; if (!moe_unit(i, F.G, cG, nT, 8, pm, pn, hf)) break;
              if (F.tid < 256) { const int e = tile_e[pm]; const int r = (pm - tbase[e]) * 256 + F.tid; const int c = (int)__hip_atomic_load(F.ctl + CW_CNT + 0 * 2048 + e * 64, RLX_AGENT);
                  tokl[i * 256 + F.tid] = (r < c) ? rowtok[(size_t)e * NTOK + r] : (unsigned short)0; } }
          __syncthreads(); }
        Gemm g{512, 512, 512, (const char*)XB};
        MoeSched S{nT, 8, F.G, cG, (const LAS int*)(F.lds + LX_TILEE), (const LAS int*)(F.lds + LX_TBASE), tokl, nullptr, (const char*)(ws + WS_WGU) + (size_t)0 * 32 * 2048 * 1024, 0, (size_t)2048 * 1024, (size_t)256 * 1024};
        EpiGU E{b_gu + (size_t)0 * 32 * 2048, (unsigned char*)HB, (LAS float*)(F.lds + LX_BIAS), 0}; pg8::gemm_phase<EpiGU, MoeSched, true, true, true, true>(ring, g, S, E); }
    SEAM(5);
    PH(6) { const int nT = moe_tables(F, 0); Gemm g{512, 512, 512, nullptr};
        MoeSched S{nT, 4, F.G, cG, (const LAS int*)(F.lds + LX_TILEE), (const LAS int*)(F.lds + LX_TBASE), nullptr, (const char*)HB, (const char*)(ws + WS_WD) + (size_t)0 * 32 * 1024 * 1024, (size_t)256 * 1024, (size_t)1024 * 1024, (size_t)256 * 1024};
        EpiDN E{b_dn + (size_t)0 * 32 * 1024, (unsigned char*)YB, (LAS float*)(F.lds + LX_BIAS), 0}; pg8::gemm_phase<EpiDN, MoeSched, true, false, true, true>(ring, g, S, E); }
    SEAM(6);
    PH(7) phase_combine<true>(F, R1, nullptr, ln_ffn_g, ln_ffn_b, AIN(5), 0);
    { F.lane = (int)attn_body::lane_now(); F.tid = F.wave * 64 + F.lane; }
    SEAM(7);
    PH(8) phase_gate_scan(F);
    SEAM(8);
    PH(9) {
        { Gemm g{1024, 1024, 1024, nullptr}; DenseSched S{64, 8, F.G, cG, (const char*)XB, (const char*)(ws + WS_WINA), (size_t)256 * 1024 * 2, (size_t)256 * 1024 * 2};
          EpiINA E{(const float*)(ws + WS_RF), (const float*)(ws + WS_CF), (bf16_t*)(ws + WS_AE), (bf16_t*)(ws + WS_KN), (bf16_t*)(ws + WS_OS)};
          pg8::gemm_phase<EpiINA, DenseSched, true, false>(ring, g, S, E); }
        { Gemm g{1024, 1024, 1024, nullptr}; DenseSched S{6, 64, F.G, cG, (const char*)(ws + WS_WINB), (const char*)XB, (size_t)256 * 1024 * 2, (size_t)256 * 1024 * 2, true};
          EpiINB E{(const float*)(ws + WS_CF), (bf16_t*)(ws + WS_KT), (bf16_t*)(ws + WS_BE)};
          pg8::gemm_phase<EpiINB, DenseSched, true, false, false, true>(ring, g, S, E); }
    }
    SEAM(9);
    PH(10) { Gemm g{256, 384, NTOK, nullptr}; MuSched S{F.G, cG, 0, (const char*)(ws + WS_BE), (const char*)(ws + WS_KT)};
        EpiM1 E{(bf16_t*)(ws + WS_UT)}; pg8::gemm_phase<EpiM1, MuSched, true, false, false, true>(ring, g, S, E);
        phase_nu(F); }
    SEAM(10);
    PH(11) phase_state_scan(F);
    SEAM(11);
    PH(12) { Gemm g{128, 512, 1024, nullptr}; MuSched S{F.G, cG, 1, (const char*)(ws + WS_AE), (const char*)(ws + WS_KN)};
        EpiM2A E{(bf16_t*)(ws + WS_AE), (const float*)(ws + WS_NPREV), (float*)(ws + WS_DEN)}; pg8::gemm_phase<EpiM2A, MuSched, true, false>(ring, g, S, E); }
    SEAM(12);
    PH(13) { Gemm g{384, 512, 384, nullptr}; MuSched S{F.G, cG, 2, (const char*)(ws + WS_AE), (const char*)(ws + WS_BE)};
        EpiM2B E{(const float*)(ws + WS_DEN), AIN(6), (const bf16_t*)(ws + WS_OS), (bf16_t*)(ws + WS_HN), (LAS float*)(F.lds + LX_LNX)};
        pg8::gemm_phase<EpiM2B, MuSched, true, false>(ring, g, S, E); }
    SEAM(13);
    PH(14) { Gemm g{1024, 1024, 1024, nullptr}; DenseSched S{64, 4, F.G, cG, (const char*)(ws + DBG_P14_A), (const char*)(ws + WS_WOUT), (size_t)256 * 1024 * 2, (size_t)256 * 1024 * 2};
        EpiZ E{XB, R0, DBG_MLSTM_MUL}; pg8::gemm_phase<EpiZ, DenseSched, true, false>(ring, g, S, E); }
    SEAM(14);
    PH(15) phase_ln_router(F, R0, R1, ln_mix_g + 1024, ln_mix_b + 1024, router_b + 32, 1, 1);
    SEAM(15);
    PH(16) { const int nT = moe_tables(F, 1); LAS unsigned short* tokl = (LAS unsigned short*)(F.lds + LX_TOKL);
        { const unsigned short* rowtok = (const unsigned short*)(ws + WS_ROWTOK); const LAS int* tile_e = (const LAS int*)(F.lds + LX_TILEE); const LAS int* tbase = (const LAS int*)(F.lds + LX_TBASE);
          for (int i = 0; i < TOKL_ROUNDS; ++i) { int pm, pn, hf; if (!moe_unit(i, F.G, cG, nT, 8, pm, pn, hf)) break;
              if (F.tid < 256) { const int e = tile_e[pm]; const int r = (pm - tbase[e]) * 256 + F.tid; const int c = (int)__hip_atomic_load(F.ctl + CW_CNT + 1 * 2048 + e * 64, RLX_AGENT);
                  tokl[i * 256 + F.tid] = (r < c) ? rowtok[(size_t)e * NTOK + r] : (unsigned short)0; } }
          __syncthreads(); }
        Gemm g{512, 512, 512, (const char*)XB};
        MoeSched S{nT, 8, F.G, cG, (const LAS int*)(F.lds + LX_TILEE), (const LAS int*)(F.lds + LX_TBASE), tokl, nullptr, (const char*)(ws + WS_WGU) + (size_t)1 * 32 * 2048 * 1024, 0, (size_t)2048 * 1024, (size_t)256 * 1024};
        EpiGU E{b_gu + (size_t)1 * 32 * 2048, (unsigned char*)HB, (LAS float*)(F.lds + LX_BIAS), 0}; pg8::gemm_phase<EpiGU, MoeSched, true, true, true, true>(ring, g, S, E); }
    SEAM(16);
    PH(17) { const int nT = moe_tables(F, 1); Gemm g{512, 512, 512, nullptr};
        MoeSched S{nT, 4, F.G, cG, (const LAS int*)(F.lds + LX_TILEE), (const LAS int*)(F.lds + LX_TBASE), nullptr, (const char*)HB, (const char*)(ws + WS_WD) + (size_t)1 * 32 * 1024 * 1024, (size_t)256 * 1024, (size_t)1024 * 1024, (size_t)256 * 1024};
        EpiDN E{b_dn + (size_t)1 * 32 * 1024, (unsigned char*)YB, (LAS float*)(F.lds + LX_BIAS), 0}; pg8::gemm_phase<EpiDN, MoeSched, true, false, true, true>(ring, g, S, E); }
    SEAM(17);
    PH(18) phase_combine<false>(F, R1, (float*)AIN(18), ln_ffn_g + 1024, ln_ffn_b + 1024, nullptr, 1);
#undef IN
#undef CONV_SLICE
#undef AIN
#undef x_in
#undef ln_mix_g
#undef ln_mix_b
#undef ln_ffn_g
#undef ln_ffn_b
#undef router_b
#undef b_gu
#undef b_dn
#undef SEAM
}

extern "C" void kernel_launch(void* const* d_in, const int* in_sizes, int n_in, void* d_out, int out_size, void* d_ws, size_t ws_size, hipStream_t stream) {
    static int grid = 0;
    if (grid == 0) {
        if (n_in != 18 || out_size != NTOK * DM || ws_size < WS_END) { fprintf(stderr, "kernel_launch: unexpected problem shape (n_in %d, out %d, ws %zu)\n", n_in, out_size, ws_size); grid = -1; return; }
        int dev = 0, cus = 0, per_cu = 0;
        if (hipGetDevice(&dev) != hipSuccess || hipDeviceGetAttribute(&cus, hipDeviceAttributeMultiprocessorCount, dev) != hipSuccess) { grid = -1; return; }
        if (hipFuncSetAttribute((const void*)mk_fwd, hipFuncAttributeMaxDynamicSharedMemorySize, LDS_BYTES) != hipSuccess) { fprintf(stderr, "kernel_launch: hipFuncSetAttribute failed\n"); grid = -1; return; }
        if (hipOccupancyMaxActiveBlocksPerMultiprocessor(&per_cu, (const void*)mk_fwd, NTHR, LDS_BYTES) != hipSuccess || per_cu < 1) fprintf(stderr, "kernel_launch: occupancy query reports %d\n", per_cu);
        (void)hipGetLastError();
        grid = cus;
        if (grid > 256) grid = 256;
        if (grid < 240) { fprintf(stderr, "kernel_launch: %d CUs: this build needs 240..256\n", cus); grid = -1; return; }
    }
    if (grid < 0) return;
    if (hipMemsetAsync((char*)d_ws + WS_CTL, 0, CTL_ZERO_BYTES, stream) != hipSuccess) return;
    Args a{};
    for (int i = 0; i < 18; ++i) a.in[i] = (const float*)d_in[i];
    a.out = (float*)d_out; a.ws = (unsigned char*)d_ws;
#if MK_ONE_LAUNCH
    a.ph_lo = 0; a.ph_hi = NPHASE;
    hipLaunchKernelGGL(mk_fwd, dim3(grid), dim3(NTHR), LDS_BYTES, stream, a);
#else
    for (int p = 0; p < NPHASE; ++p) { a.ph_lo = p; a.ph_hi = p + 1; hipLaunchKernelGGL(mk_fwd, dim3(grid), dim3(NTHR), LDS_BYTES, stream, a); }
#endif
}
```

```cpp
#include <hip/hip_runtime.h>
#include <hip/hip_bf16.h>
#include <cstdio>
#include <cstdint>
#include <cmath>

#define LAS __attribute__((address_space(3)))
#define GAS __attribute__((address_space(1)))
typedef unsigned short bf16_t;
typedef short bf16x8 __attribute__((ext_vector_type(8)));
typedef float f32x4 __attribute__((ext_vector_type(4)));
typedef float f32x2 __attribute__((ext_vector_type(2)));
typedef unsigned u32x4 __attribute__((ext_vector_type(4)));
typedef unsigned u32x2 __attribute__((ext_vector_type(2)));
typedef int i32x4 __attribute__((ext_vector_type(4)));
typedef int i32x8 __attribute__((ext_vector_type(8)));

typedef __bf16 bf16x2_t __attribute__((ext_vector_type(2)));
__device__ __forceinline__ unsigned cvt_pk_bf16(float lo, float hi) { const f32x2 v = {lo, hi}; const bf16x2_t b = __builtin_convertvector(v, bf16x2_t); return __builtin_bit_cast(unsigned, b); }
__device__ __forceinline__ float bf2f(unsigned short b) { return __uint_as_float(((unsigned)b) << 16); }
__device__ __forceinline__ float bflo(unsigned w) { return __uint_as_float(w << 16); }
__device__ __forceinline__ float bfhi(unsigned w) { return __uint_as_float(w & 0xffff0000u); }

__device__ __forceinline__ void glds16s(const void* sbase, unsigned voff, unsigned lds_dst) { unsigned keep;
    asm volatile("s_nop 4\n\ts_mov_b32 %0, m0\n\ts_mov_b32 m0, %3\n\ts_nop 0\n\tglobal_load_lds_dwordx4 %1, %2\n\ts_mov_b32 m0, %0" : "=&s"(keep) : "v"(voff), "s"(sbase), "s"(lds_dst) : "memory"); }
__device__ __forceinline__ void glds4s(const void* sbase, unsigned voff, unsigned lds_dst) { unsigned keep;
    asm volatile("s_nop 4\n\ts_mov_b32 %0, m0\n\ts_mov_b32 m0, %3\n\ts_nop 0\n\tglobal_load_lds_dword %1, %2\n\ts_mov_b32 m0, %0" : "=&s"(keep) : "v"(voff), "s"(sbase), "s"(lds_dst) : "memory"); }
__device__ __forceinline__ const char* uni_ptr(const char* p) { const unsigned long long v = (unsigned long long)p; const unsigned lo = __builtin_amdgcn_readfirstlane((unsigned)v), hi = __builtin_amdgcn_readfirstlane((unsigned)(v >> 32)); return (const char*)(((unsigned long long)hi << 32) | lo); }
namespace pg8 {
constexpr int BM = 256, BK = 64, HALF = 128, HTB = HALF * BK * 2, STAGE_BYTES = 8 * HTB, NXCD = 8, WGM = 8;
__host__ __device__ __forceinline__ int lds_byte(int r, int c) { const int st = (r >> 4) * 2 + (c >> 5), rr = r & 15, cc = c & 31, ob = rr * 64 + cc * 2; return st * 1024 + (ob ^ (((ob >> 9) & 1) << 5)); }
__host__ __device__ __forceinline__ void stage_rc(int b, int& R, int& C) { const int st = b / 1024, sb = b % 1024, swz = sb ^ (((sb >> 9) & 1) << 5); R = (st >> 1) * 16 + swz / 64; C = (st & 1) * 32 + (swz % 64) / 2; }
__host__ __device__ __forceinline__ int perm32(int rho) { const int n = rho >> 4, i = rho & 15; return 8 * (i >> 2) + 4 * n + (i & 3); }

struct Unit { int pm, pn; const char* A; const char* B; const LAS unsigned short* tl; int x0, x1, x2; };
struct Gemm { int K, lda, ldb; const char* Abase; };

__device__ __forceinline__ bool tile_order(int i, int G, int c, int nM, int nN, int& pm, int& pn) {
    const int nwg = nM * nN; const long L = (long)i * G + c; if (L >= nwg) return false;
    int wgid = (int)L; { const int q = nwg / NXCD, r = nwg % NXCD, xcd = wgid % NXCD, off = wgid / NXCD; wgid = (xcd < r ? xcd * (q + 1) : r * (q + 1) + (xcd - r) * q) + off; }
    const int nig = WGM * nN, gid = wgid / nig, fm = gid * WGM, gsz = (nM - fm) < WGM ? (nM - fm) : WGM;
    pm = fm + ((wgid % nig) % gsz); pn = (wgid % nig) / gsz; return true;
}

template <class Epi, class Sched, bool ALIGN_EPI, bool GATHER, bool FP8 = false, bool HALFSEL = false>
__device__ __forceinline__ void gemm_phase(LAS unsigned char* lds, const Gemm g, const Sched& S, const Epi& E) {
    const int tid = threadIdx.x, wid = __builtin_amdgcn_readfirstlane(tid >> 6), lane = tid & 63, wr = wid >> 2, wc = wid & 3, fr = lane & 15, fq = lane >> 4;
    const int K = g.K, nt = K / BK;
    int RA[2]; unsigned cA2[2], voffB[2];
#pragma unroll
    for (int i = 0; i < 2; ++i) { int R, C; stage_rc(tid * 16 + i * 8192, R, C); const int Rb = Epi::PERM ? ((R & ~31) + perm32(R & 31)) : R;
        RA[i] = R; cA2[i] = (unsigned)C * 2u; voffB[i] = (unsigned)(Rb * g.ldb + C) * 2u; }
    const size_t kstep = (size_t)(BK * 2);
    const unsigned hstepA = (unsigned)HALF * (unsigned)g.lda * 2u; const size_t hstepB = (size_t)HALF * g.ldb * 2;
    const unsigned ldsb = (unsigned)__builtin_amdgcn_readfirstlane((unsigned)(unsigned long long)lds + (unsigned)wid * 1024u);
    const int aoff = lds_byte(wr * 64 + fr, fq * 8), boff = lds_byte(wc * 32 + fr, fq * 8);
    const int aoff2 = aoff + 1024, boff2 = boff + 1024;
#define PG8_SA(b, h) (((b) * 2 + (h)) * HTB)
#define PG8_SB(b, h) ((4 + (b) * 2 + (h)) * HTB)
#define PG8_STAGE(bufoff, gbase, voff) do { _Pragma("unroll") for (int _i = 0; _i < 2; ++_i) glds16s((gbase), (voff)[_i], ldsb + (unsigned)(bufoff) + _i * 8192u); } while (0)
#define PG8_STAGE_A(bufoff, gbase, AO, h) do { _Pragma("unroll") for (int _i = 0; _i < 2; ++_i) glds16s((gbase), (AO)[h][_i], ldsb + (unsigned)(bufoff) + _i * 8192u); } while (0)
#define PG8_LD8(base_, o1_, o2_) __builtin_shufflevector(*(const LAS i32x4*)(lds + (base_) + (o1_)), *(const LAS i32x4*)(lds + (base_) + (o2_)), 0, 1, 2, 3, 4, 5, 6, 7)
#define PG8_LDA(dst, b, h) do { if constexpr (FP8) { _Pragma("unroll") for (int m = 0; m < 4; ++m) dst##8[m] = PG8_LD8(PG8_SA(b, h) + m * 2048, aoff, aoff2); } \
        else { _Pragma("unroll") for (int m = 0; m < 4; ++m) _Pragma("unroll") for (int k = 0; k < 2; ++k) dst[m][k] = *(const LAS bf16x8*)(lds + PG8_SA(b, h) + aoff + m * 2048 + k * 1024); } } while (0)
#define PG8_LDB(dst, b, h) do { if constexpr (FP8) { _Pragma("unroll") for (int n = 0; n < 2; ++n) dst##8[n] = PG8_LD8(PG8_SB(b, h) + n * 2048, boff, boff2); } \
        else { _Pragma("unroll") for (int n = 0; n < 2; ++n) _Pragma("unroll") for (int k = 0; k < 2; ++k) dst[n][k] = *(const LAS bf16x8*)(lds + PG8_SB(b, h) + boff + n * 2048 + k * 1024); } } while (0)
#define PG8_MMA(ai, bj, At, Bt) do { __builtin_amdgcn_s_setprio(1); _Pragma("unroll") for (int m = 0; m < 4; ++m) _Pragma("unroll") for (int n = 0; n < 2; ++n) { \
        if constexpr (FP8) asm volatile("v_mfma_f32_16x16x128_f8f6f4 %0, %1, %2, %0" : "+v"(acc[ai][bj][m][n]) : "v"(Bt##8[n]), "v"(At##8[m])); \
        else { _Pragma("unroll") for (int k = 0; k < 2; ++k) acc[ai][bj][m][n] = __builtin_amdgcn_mfma_f32_16x16x32_bf16(Bt[n][k], At[m][k], acc[ai][bj][m][n], 0, 0, 0); } } \
        __builtin_amdgcn_s_setprio(0); } while (0)
#define PG8_WAIT_V(n) asm volatile("s_waitcnt vmcnt(" #n ")" ::: "memory")
#define PG8_WAIT_L(n) asm volatile("s_waitcnt lgkmcnt(" #n ")" ::: "memory")
#define PG8_BAR __builtin_amdgcn_s_barrier()
#define PG8_SCHED __builtin_amdgcn_sched_barrier(0)
#define PG8_AOFF(AO, U) do { _Pragma("unroll") for (int _h = 0; _h < 2; ++_h) _Pragma("unroll") for (int _i = 0; _i < 2; ++_i) { \
        if constexpr (GATHER) AO[_h][_i] = (unsigned)(U).tl[RA[_i] + _h * HALF] * (unsigned)(g.lda * 2) + cA2[_i]; \
        else AO[_h][_i] = (unsigned)RA[_i] * (unsigned)(g.lda * 2) + cA2[_i] + (unsigned)_h * hstepA; } } while (0)
    Unit cur, nxt; int ui = 0;
    if (!S.next(0, cur)) return;
    f32x4 acc[2][2][4][2];
#pragma unroll
    for (int a = 0; a < 2; ++a)
#pragma unroll
        for (int b = 0; b < 2; ++b)
#pragma unroll
            for (int m = 0; m < 4; ++m)
#pragma unroll
                for (int n = 0; n < 2; ++n) acc[a][b][m][n] = (f32x4){0.f, 0.f, 0.f, 0.f};
    bf16x8 At[4][2], B0[2][2], B1[2][2]; i32x8 At8[4], B08[2], B18[2];
    E.prep(cur, 0, wid, lane);
    unsigned aoC[2][2], aoN[2][2];
    PG8_AOFF(aoC, cur);
    const char* cA = uni_ptr(GATHER ? g.Abase : cur.A); const char* cB = uni_ptr(cur.B);
    PG8_STAGE(PG8_SB(0, 0), cB, voffB); PG8_STAGE(PG8_SB(0, 1), cB + hstepB, voffB); PG8_STAGE_A(PG8_SA(0, 0), cA, aoC, 0); PG8_STAGE_A(PG8_SA(0, 1), cA, aoC, 1);
    if (wr == 1) PG8_BAR;
    PG8_WAIT_V(2); PG8_BAR;
    PG8_STAGE(PG8_SB(1, 0), cB + kstep, voffB); PG8_STAGE_A(PG8_SA(1, 0), cA + kstep, aoC, 0); PG8_STAGE(PG8_SB(1, 1), cB + hstepB + kstep, voffB);
    PG8_WAIT_V(6); PG8_BAR;
    for (;;) {
        const bool has_next = S.next(ui + 1, nxt);
        if (has_next) E.prep(nxt, ui + 1, wid, lane);
        if constexpr (GATHER) { if (has_next) PG8_AOFF(aoN, nxt); else { _Pragma("unroll") for (int _h = 0; _h < 2; ++_h) _Pragma("unroll") for (int _i = 0; _i < 2; ++_i) aoN[_h][_i] = aoC[_h][_i]; } }
        const char* nA = uni_ptr(GATHER ? g.Abase : (has_next ? nxt.A : cA)); const char* nB = uni_ptr(has_next ? nxt.B : cB);
        const bool dh0 = cur.x2 != 2, dh1 = cur.x2 != 1;
#pragma nounroll
        for (int t = 0; t < nt; t += 2) {
            const bool last = (t == nt - 2);
            if constexpr (Epi::MID) { if (t == 2) E.prep_mid(cur, wid, lane); }
            const char* a1 = cA + (size_t)(t + 1) * kstep;
            const char* a2 = last ? nA : cA + (size_t)(t + 2) * kstep; const char* b2 = last ? nB : cB + (size_t)(t + 2) * kstep;
            const char* a3 = a2 + kstep; const char* b3 = b2 + kstep;
            unsigned aoS[2][2];
#pragma unroll
            for (int _h = 0; _h < 2; ++_h)
#pragma unroll
                for (int _i = 0; _i < 2; ++_i) aoS[_h][_i] = (GATHER && last) ? aoN[_h][_i] : aoC[_h][_i];
            PG8_LDB(B0, 0, 0); PG8_LDB(B1, 0, 1); PG8_SCHED; PG8_LDA(At, 0, 0); PG8_STAGE_A(PG8_SA(1, 1), a1, aoC, 1);
            PG8_WAIT_V(8); PG8_WAIT_L(0); PG8_BAR; if (!HALFSEL || dh0) PG8_MMA(0, 0, At, B0); if (!HALFSEL || dh1) PG8_MMA(0, 1, At, B1); PG8_BAR; PG8_SCHED;
            PG8_LDA(At, 0, 1); PG8_STAGE(PG8_SB(0, 0), b2, voffB); PG8_STAGE(PG8_SB(0, 1), b2 + hstepB, voffB); PG8_STAGE_A(PG8_SA(0, 0), a2, aoS, 0);
            PG8_WAIT_V(8); PG8_WAIT_L(0); PG8_BAR; if (!HALFSEL || dh0) PG8_MMA(1, 0, At, B0); if (!HALFSEL || dh1) PG8_MMA(1, 1, At, B1); PG8_BAR; PG8_SCHED;
            PG8_LDB(B0, 1, 0); PG8_LDB(B1, 1, 1); PG8_SCHED; PG8_LDA(At, 1, 0); PG8_STAGE_A(PG8_SA(0, 1), a2, aoS, 1);
            PG8_WAIT_V(8); PG8_WAIT_L(0); PG8_BAR; if (!HALFSEL || dh0) PG8_MMA(0, 0, At, B0); if (!HALFSEL || dh1) PG8_MMA(0, 1, At, B1); PG8_BAR; PG8_SCHED;
            PG8_LDA(At, 1, 1); PG8_STAGE(PG8_SB(1, 0), b3, voffB); PG8_STAGE(PG8_SB(1, 1), b3 + hstepB, voffB); PG8_STAGE_A(PG8_SA(1, 0), a3, aoS, 0);
            PG8_WAIT_V(8); PG8_WAIT_L(0); PG8_BAR; if (!HALFSEL || dh0) PG8_MMA(1, 0, At, B0); if (!HALFSEL || dh1) PG8_MMA(1, 1, At, B1); PG8_BAR; PG8_SCHED;
        }
        if constexpr (FP8) asm volatile("s_nop 15\n\ts_nop 15" ::: "memory");
        if constexpr (ALIGN_EPI) { if (wr == 0) PG8_BAR; }
        E(acc, cur, wr, wc, fr, fq);
        if (!has_next) break;
#pragma unroll
        for (int a = 0; a < 2; ++a)
#pragma unroll
            for (int b = 0; b < 2; ++b)
#pragma unroll
                for (int m = 0; m < 4; ++m)
#pragma unroll
                    for (int n = 0; n < 2; ++n) acc[a][b][m][n] = (f32x4){0.f, 0.f, 0.f, 0.f};
        if constexpr (FP8) asm volatile("s_nop 7" ::: "memory");
        cur = nxt; cA = nA; cB = nB; ++ui;
        if constexpr (GATHER) {
#pragma unroll
            for (int _h = 0; _h < 2; ++_h)
#pragma unroll
                for (int _i = 0; _i < 2; ++_i) aoC[_h][_i] = aoN[_h][_i]; }
        if constexpr (ALIGN_EPI) { if (wr == 1) PG8_BAR; }
    }
    PG8_WAIT_V(0);
    if constexpr (!ALIGN_EPI) { if (wr == 0) PG8_BAR; }
    PG8_BAR;
#undef PG8_SA
#undef PG8_SB
#undef PG8_STAGE
#undef PG8_STAGE_A
#undef PG8_LDA
#undef PG8_LD8
#undef PG8_LDB
#undef PG8_MMA
#undef PG8_WAIT_V
#undef PG8_WAIT_L
#undef PG8_BAR
#undef PG8_SCHED
#undef PG8_AOFF
}
}
#include <hip/hip_bf16.h>
namespace attn_body {
using bf16=__hip_bfloat16;
using bf16x8=__attribute__((ext_vector_type(8)))short;
using s16x4=__attribute__((ext_vector_type(4)))short;
using f32x16=__attribute__((ext_vector_type(16)))float;
using u32x4=__attribute__((ext_vector_type(4)))unsigned;
constexpr int BATCH=4,NHEAD=16,SEQ=4096,D=64,DM=NHEAD*D;
constexpr int NW=8,QBLK=32,QB=QBLK*NW,KVBLK=64,NQB=SEQ/QB;
constexpr int ATTN_PITCH=DM, ATTN_UNIT_ROWS=QB;
__device__ __forceinline__ int crow(int r,int hi){return (r&3)+8*(r>>2)+4*hi;}
#define SBAR() __builtin_amdgcn_sched_barrier(0)
__device__ __forceinline__ void cmask(f32x16&p0,f32x16&p1,int jb,int qrel,int hi){
  const float NEG=-INFINITY; int d=qrel-64*jb-4*hi; asm volatile("":"+v"(d));
  #pragma unroll
  for(int r=0;r<16;++r){const int c=(r&3)+8*(r>>2); if(c>d)p0[r]=NEG; if(c+32>d)p1[r]=NEG;}
}

constexpr int NSLOT=3, SLOTB=8192;
constexpr int LDS_GT=98304;
constexpr int LDS_K=0, LDS_V=NSLOT*SLOTB, LDS_WS=2*NSLOT*SLOTB, LDS_OST=LDS_WS+NW*64*4, LDS_BYTES=LDS_OST+NW*4096;
constexpr float C2=0.125f*1.4426950408889634f;
__device__ __forceinline__ void glds16(const void*gsrc,unsigned lds_dst){unsigned keep;
  asm volatile("s_mov_b32 %0, m0\n\ts_mov_b32 m0, %2\n\ts_nop 0\n\tglobal_load_lds_dwordx4 %1, off\n\ts_mov_b32 m0, %0":"=&s"(keep):"v"(gsrc),"s"(lds_dst):"memory");}
__device__ __forceinline__ void glds16s(const void*sbase,unsigned voff,unsigned lds_dst){unsigned keep;
  asm volatile("s_nop 4\n\ts_mov_b32 %0, m0\n\ts_mov_b32 m0, %3\n\ts_nop 0\n\tglobal_load_lds_dwordx4 %1, %2\n\ts_mov_b32 m0, %0":"=&s"(keep):"v"(voff),"s"(sbase),"s"(lds_dst):"memory");}
__device__ __forceinline__ unsigned lane_now(){unsigned l;asm volatile("v_mbcnt_lo_u32_b32 %0, -1, 0\n\tv_mbcnt_hi_u32_b32 %0, -1, %0":"=v"(l));return l;}
__device__ __forceinline__ float max3f(float a,float b,float c){float r;asm("v_max3_f32 %0, %1, %2, %3":"=v"(r):"v"(a),"v"(b),"v"(c));return r;}
__device__ __forceinline__ float max2f(float a,float b){float r;asm("v_max_f32_e32 %0, %1, %2":"=v"(r):"v"(a),"v"(b));return r;}
__device__ __forceinline__ float fadd_s(float a,float b){float r;asm("v_add_f32_e32 %0, %1, %2":"=v"(r):"v"(a),"v"(b));return r;}
__device__ __forceinline__ float fsub_s(float a,float b){float r;asm("v_sub_f32_e32 %0, %1, %2":"=v"(r):"v"(a),"v"(b));return r;}
typedef float f32x2_t __attribute__((ext_vector_type(2))); typedef __bf16 bf16x2_t __attribute__((ext_vector_type(2)));
__device__ __forceinline__ unsigned cvtpk_s(float lo,float hi){f32x2_t v={lo,hi};bf16x2_t b=__builtin_convertvector(v,bf16x2_t);return __builtin_bit_cast(unsigned,b);}
#define WAIT_BAR(N) asm volatile("s_waitcnt vmcnt(" #N ") lgkmcnt(0)\n\ts_barrier":::"memory")

__device__ __forceinline__ void qkt(f32x16&p0,f32x16&p1,const char*Kslot,const bf16x8*qr,int r32,int hi){
  const char*kb=Kslot+hi*1024+r32*16;
  #pragma unroll
  for(int d0=0;d0<4;++d0){
    const bf16x8 b0=*reinterpret_cast<const bf16x8*>(kb+d0*2048);
    const bf16x8 b1=*reinterpret_cast<const bf16x8*>(kb+d0*2048+512);
    if(d0==0){p0=__builtin_amdgcn_mfma_f32_32x32x16_bf16(b0,qr[0],(f32x16){0.f,0.f,0.f,0.f,0.f,0.f,0.f,0.f,0.f,0.f,0.f,0.f,0.f,0.f,0.f,0.f},0,0,0);p1=__builtin_amdgcn_mfma_f32_32x32x16_bf16(b1,qr[0],(f32x16){0.f,0.f,0.f,0.f,0.f,0.f,0.f,0.f,0.f,0.f,0.f,0.f,0.f,0.f,0.f,0.f},0,0,0);}
    else{p0=__builtin_amdgcn_mfma_f32_32x32x16_bf16(b0,qr[d0],p0,0,0,0);p1=__builtin_amdgcn_mfma_f32_32x32x16_bf16(b1,qr[d0],p1,0,0,0);}}
}
typedef __attribute__((address_space(3))) const char* lds_cptr;
typedef short v4i16_t __attribute__((ext_vector_type(4)));
__device__ __forceinline__ void kload8(bf16x8*kf,lds_cptr kp){
  kf[0]=*(const __attribute__((address_space(3))) bf16x8*)(kp);      kf[1]=*(const __attribute__((address_space(3))) bf16x8*)(kp+512);
  kf[2]=*(const __attribute__((address_space(3))) bf16x8*)(kp+2048); kf[3]=*(const __attribute__((address_space(3))) bf16x8*)(kp+2560);
  kf[4]=*(const __attribute__((address_space(3))) bf16x8*)(kp+4096); kf[5]=*(const __attribute__((address_space(3))) bf16x8*)(kp+4608);
  kf[6]=*(const __attribute__((address_space(3))) bf16x8*)(kp+6144); kf[7]=*(const __attribute__((address_space(3))) bf16x8*)(kp+6656);
}
__device__ __forceinline__ void kload2(bf16x8*kf,lds_cptr kp,int j){ kf[2*j]=*(const __attribute__((address_space(3))) bf16x8*)(kp+j*2048); kf[2*j+1]=*(const __attribute__((address_space(3))) bf16x8*)(kp+j*2048+512); }
__device__ __forceinline__ s16x4 vtr(lds_cptr p){ return __builtin_bit_cast(s16x4,__builtin_amdgcn_ds_read_tr16_b64_v4i16((__attribute__((address_space(3))) v4i16_t*)p)); }
__device__ __forceinline__ float rowmax(const f32x16&p0,const f32x16&p1){
  float a=max3f(p0[0],p0[1],p1[0]),b=max3f(p0[2],p0[3],p1[1]);a=max3f(a,p1[2],p1[3]);
  #pragma unroll
  for(int r=4;r<16;r+=4){a=max3f(a,p0[r],p0[r+1]);b=max3f(b,p0[r+2],p0[r+3]);a=max3f(a,p1[r],p1[r+1]);b=max3f(b,p1[r+2],p1[r+3]);}
  const float m=max2f(a,b);
  auto rr=__builtin_amdgcn_permlane32_swap(__float_as_uint(m),__float_as_uint(m),false,false);
  return max2f(__uint_as_float(rr[0]),__uint_as_float(rr[1]));
}
__device__ __forceinline__ void pv(f32x16*o,int vb,bf16x8 pa0,bf16x8 pa1,bf16x8 pa2,bf16x8 pa3){
  #pragma unroll
  for(int d0=0;d0<2;++d0){s16x4 lo[4],hi[4];
    #pragma unroll
    for(int ks=0;ks<4;++ks){
      asm volatile("ds_read_b64_tr_b16 %0,%1 offset:%c2":"=&v"(lo[ks]):"v"(vb),"i"(d0*4096+ks*1024):"memory");
      asm volatile("ds_read_b64_tr_b16 %0,%1 offset:%c2":"=&v"(hi[ks]):"v"(vb),"i"(d0*4096+ks*1024+512):"memory");}
    asm volatile("s_waitcnt lgkmcnt(0)":::"memory");SBAR();
    #define PK(k) (bf16x8){lo[k][0],lo[k][1],lo[k][2],lo[k][3],hi[k][0],hi[k][1],hi[k][2],hi[k][3]}
    o[d0]=__builtin_amdgcn_mfma_f32_32x32x16_bf16(pa0,PK(0),o[d0],0,0,0);
    o[d0]=__builtin_amdgcn_mfma_f32_32x32x16_bf16(pa1,PK(1),o[d0],0,0,0);
    o[d0]=__builtin_amdgcn_mfma_f32_32x32x16_bf16(pa2,PK(2),o[d0],0,0,0);
    o[d0]=__builtin_amdgcn_mfma_f32_32x32x16_bf16(pa3,PK(3),o[d0],0,0,0);
    #undef PK
  }
}

#ifndef ATTN_STORE16
#define ATTN_STORE16(p,v) (*(u32x4*)(p)=(v))
#endif
template<int THRL> __device__ __forceinline__ void attn_unit(int b,int h,int qb,const bf16*Q,const bf16*__restrict__ K,const bf16*__restrict__ V,bf16*O,const float*ksum,char*shm){
  const int tid=threadIdx.x,lane=tid&63,r32=lane&31,hi=lane>>5; const int wid=__builtin_amdgcn_readfirstlane(tid>>6);
  const long rowbase=(long)b*SEQ; const int q0=qb*QB;
  const bf16*Qw=Q+(rowbase+q0+wid*QBLK)*DM+h*D;
  const bf16*Kh=K+rowbase*DM+h*D,*Vh=V+rowbase*DM+h*D;
  const unsigned lds0=(unsigned)(uintptr_t)shm;
  float*wsf=(float*)(shm+LDS_WS)+wid*64;
  const unsigned kdst=lds0+LDS_K+wid*1024, vdst=lds0+LDS_V+wid*1024;
  #define PHYS(t) (((t)<4)?(4*qb+(t)):((t)-4))
  #define DMA_K(t,slot) glds16s((const char*)Kh+(size_t)PHYS(t)*(KVBLK*DM*2)+wid*16,lane_now()*(unsigned)(DM*2),(unsigned)__builtin_amdgcn_readfirstlane(kdst+(slot)))
  #define DMA_V(t,slot) glds16s((const char*)Vh+(size_t)PHYS(t)*(KVBLK*DM*2)+(size_t)(16*(wid&3))*(DM*2)+(wid>>2)*64,({const unsigned l_=lane_now(); (l_>>2)*(unsigned)(DM*2)+(l_&3u)*16u;}),(unsigned)__builtin_amdgcn_readfirstlane(vdst+(slot)))
  const int vb0=(int)(lds0+LDS_V)+((lane>>4)&1)*32+(lane&3)*8+(4*hi+((lane&15)>>2))*64;
  const char*Kbase=shm+LDS_K; bf16x8 kf[8];
  const lds_cptr shm3=(lds_cptr)shm; const lds_cptr kp0=shm3+LDS_K+hi*1024+r32*16; const lds_cptr vp0=shm3+LDS_V+((lane>>4)&1)*32+(lane&3)*8+(4*hi+((lane&15)>>2))*64;
  const int NT=(q0+QB)/KVBLK;
  DMA_K(0,0);DMA_V(0,0);DMA_K(1,SLOTB);
  { float*gt=(float*)(shm+LDS_GT);
    #pragma unroll
    for(int k=0;k<2;++k){ const int j=2*wid+k; if(j<qb) gt[j*64+lane]=ksum[(long)(b*16+j)*DM+h*D+lane]; } }
  bf16x8 qr[4];
  #pragma unroll
  for(int d0=0;d0<4;++d0)qr[d0]=*reinterpret_cast<const bf16x8*>(&Qw[(long)r32*DM+d0*16+hi*8]);

  unsigned sel=0u;
  float mhat=0.f,l_reg=0.f;f32x16 o[2];o[0]=f32x16{};o[1]=f32x16{};
  bf16x8 kone=(bf16x8){0,0,0,0,0,0,0,0}, qm=(bf16x8){0,0,0,0,0,0,0,0}; if(hi==0) kone[0]=(short)0x3F80;
  #define SETQM() do{ const unsigned short mb_=(unsigned short)(cvtpk_s(-mhat,0.f)&0xffffu); qm[0]=(hi==0)?(short)mb_:(short)0; asm volatile("":"+v"(qm)); }while(0)
  const int qrel=wid*QBLK+r32;
  #define CMASK(P0,P1,t) do{ const int t_=(t); if(t_<4){ const int l_=(int)lane_now(); cmask(P0,P1,t_,wid*QBLK+(l_&31),l_>>5); } else if(!((sel>>(((t_-4)>>2)&15))&1u)){ _Pragma("unroll") for(int r=0;r<16;++r){P0[r]=-INFINITY;P1[r]=-INFINITY;} } }while(0)
  bool resc=false;
  #define START(P0,P1) do{ const float rm=rowmax(P0,P1); resc=false; \
    { const float dl=__uint_as_float(cvtpk_s(rm,0.f)<<16); mhat=fadd_s(mhat,dl);          \
      _Pragma("unroll") for(int r=0;r<16;++r){P0[r]=fsub_s(P0[r],dl);P1[r]=fsub_s(P1[r],dl);} \
      SETQM(); } \
    _Pragma("unroll") for(int r=0;r<16;++r)P0[r]=__builtin_amdgcn_exp2f(P0[r]); }while(0)
  #define RESC() do{ if(resc){ asm volatile("s_waitcnt lgkmcnt(0)":::"memory"); \
      _Pragma("unroll") for(int d_=0;d_<2;++d_) _Pragma("unroll") for(int r=0;r<16;++r)o[d_][r]*=wsf[crow(r,(int)(lane_now()>>5))]; } }while(0)
  f32x16 pA0,pA1,pB0,pB1;
  int sl_prev=0,sl_cur=0,sl_next=SLOTB;
  #define ROT() do{sl_prev=sl_cur;sl_cur=sl_next;sl_next=(sl_next==(NSLOT-1)*SLOTB)?0:sl_next+SLOTB;}while(0)
  DMA_K(2,2*SLOTB);
  WAIT_BAR(3);
  { float qf[32];
    #pragma unroll
    for(int d0=0;d0<4;++d0){
      #pragma unroll
      for(int i=0;i<8;++i) qf[d0*8+i]=__uint_as_float(((unsigned)(unsigned short)qr[d0][i])<<16); }
    const float*gt=(const float*)(shm+LDS_GT)+hi*8; float g[15];
    #pragma unroll
    for(int j=0;j<15;++j){ g[j]=-INFINITY;
      if(j<qb){ const float*kp=gt+j*64; float a=0.f;
        #pragma unroll
        for(int d0=0;d0<4;++d0){ const float4 k0=*reinterpret_cast<const float4*>(kp+d0*16), k1=*reinterpret_cast<const float4*>(kp+d0*16+4);
          a+=qf[d0*8+0]*k0.x; a+=qf[d0*8+1]*k0.y; a+=qf[d0*8+2]*k0.z; a+=qf[d0*8+3]*k0.w; a+=qf[d0*8+4]*k1.x; a+=qf[d0*8+5]*k1.y; a+=qf[d0*8+6]*k1.z; a+=qf[d0*8+7]*k1.w; }
        g[j]=a+__shfl_xor(a,32); } }
    #pragma unroll
    for(int kk=0;kk<3;++kk){ float best=-INFINITY; int bj=-1;
      #pragma unroll
      for(int j=0;j<15;++j){ const bool c=(j<qb)&&!((sel>>j)&1u)&&(g[j]>best); best=c?g[j]:best; bj=c?j:bj; }
      if(bj>=0) sel|=(1u<<bj); } }
  qkt(pA0,pA1,Kbase,qr,r32,hi);asm volatile("s_nop 15\n\ts_nop 7":"+v"(pA0),"+v"(pA1));CMASK(pA0,pA1,0);
  START(pA0,pA1);
  _Pragma("unroll") for(int r=0;r<16;++r)pA1[r]=__builtin_amdgcn_exp2f(pA1[r]);
  WAIT_BAR(0);
  DMA_K(3,0);DMA_V(1,SLOTB);
  ROT();
  kload8(kf,kp0+sl_cur);
  WAIT_BAR(2);
  s16x4 vlo[8],vhi[8]; u32x4 pw0,pw1,pw2,pw3;
  #define PKW(P,B) cvtpk_s(P[B],P[B+1])
  #define PAF(k) __builtin_bit_cast(bf16x8,pw##k)
  #define VFR(i) (bf16x8){vlo[i][0],vlo[i][1],vlo[i][2],vlo[i][3],vhi[i][0],vhi[i][1],vhi[i][2],vhi[i][3]}
  #define PIN(x) asm volatile("":"+v"(x))
  #define MX3(a,b,c) __builtin_fmaxf(__builtin_fmaxf((a),(b)),(c))
  #define GAPA(MF,A0,A1,A2,A3,W0,W1,PW) do{ MF; sacc+=A0; sacc+=A1; sacc+=A2; sacc+=A3; PIN(sacc); W0; W1; PIN(PW); SBAR(); }while(0)
  #define EX(v) __builtin_amdgcn_exp2f(v)
  #define GAPB(MF,X,B) do{ MF; X[B]=EX(X[B]); X[B+1]=EX(X[B+1]); X[B+2]=EX(X[B+2]); X[B+3]=EX(X[B+3]); PIN(X); SBAR(); }while(0)
  #define VRD(i) do{ vlo[i]=vtr(vp_+(((i)>>2)*4096+((i)&3)*1024)); vhi[i]=vtr(vp_+(((i)>>2)*4096+((i)&3)*1024+512)); }while(0)
  #define KRD(G,j) do{ if(G){ kload2(kf,kp0+sl_next,j); SBAR(); } }while(0)
  #define STEP(C0,C1,P0,P1,t,GK,GV,GL) do{ SBAR(); \
    const lds_cptr vp_=vp0+sl_prev; \
    C0=__builtin_amdgcn_mfma_f32_32x32x16_bf16(kone,qm,(f32x16){0.f,0.f,0.f,0.f,0.f,0.f,0.f,0.f,0.f,0.f,0.f,0.f,0.f,0.f,0.f,0.f},0,0,0); C1=__builtin_amdgcn_mfma_f32_32x32x16_bf16(kone,qm,(f32x16){0.f,0.f,0.f,0.f,0.f,0.f,0.f,0.f,0.f,0.f,0.f,0.f,0.f,0.f,0.f,0.f},0,0,0); SBAR(); \
    VRD(0); SBAR(); float sacc=(P0[0]+P0[1]); \
    GAPA(C0=__builtin_amdgcn_mfma_f32_32x32x16_bf16(kf[0],qr[0],C0,0,0,0), P0[2],P0[3],P0[4],P0[5],     pw0[0]=PKW(P0,0), pw0[1]=PKW(P0,2), pw0); \
    VRD(4); SBAR(); GAPA(C1=__builtin_amdgcn_mfma_f32_32x32x16_bf16(kf[1],qr[0],C1,0,0,0), P0[6],P0[7],P0[8],P0[9],     pw0[2]=PKW(P0,4), pw0[3]=PKW(P0,6), pw0); \
    VRD(1); SBAR(); GAPA(C0=__builtin_amdgcn_mfma_f32_32x32x16_bf16(kf[2],qr[1],C0,0,0,0),   P0[10],P0[11],P0[12],P0[13], pw1[0]=PKW(P0,8), pw1[1]=PKW(P0,10), pw1); \
    VRD(5); SBAR(); GAPA(C1=__builtin_amdgcn_mfma_f32_32x32x16_bf16(kf[3],qr[1],C1,0,0,0),   P0[14],P0[15],P1[0],P1[1],   pw1[2]=PKW(P0,12),pw1[3]=PKW(P0,14), pw1); \
    VRD(2); SBAR(); GAPA(C0=__builtin_amdgcn_mfma_f32_32x32x16_bf16(kf[4],qr[2],C0,0,0,0),   P1[2],P1[3],P1[4],P1[5],     pw2[0]=PKW(P1,0), pw2[1]=PKW(P1,2), pw2); \
    VRD(6); SBAR(); GAPA(C1=__builtin_amdgcn_mfma_f32_32x32x16_bf16(kf[5],qr[2],C1,0,0,0),   P1[6],P1[7],P1[8],P1[9],     pw2[2]=PKW(P1,4), pw2[3]=PKW(P1,6), pw2); \
    VRD(3); SBAR(); GAPA(C0=__builtin_amdgcn_mfma_f32_32x32x16_bf16(kf[6],qr[3],C0,0,0,0),   P1[10],P1[11],P1[12],P1[13], pw3[0]=PKW(P1,8), pw3[1]=PKW(P1,10), pw3); \
    VRD(7); SBAR(); GAPA(C1=__builtin_amdgcn_mfma_f32_32x32x16_bf16(kf[7],qr[3],C1,0,0,0),   P1[14],P1[15],0.f,0.f,       pw3[2]=PKW(P1,12),pw3[3]=PKW(P1,14), pw3); \
    l_reg+=sacc; \
    if(GK){DMA_K((t)+3,sl_cur);} if(GV){DMA_V((t)+1,sl_next);} \
    CMASK(C0,C1,t); \
    { float a=MX3(C0[0],C0[1],C1[0]),b=MX3(C0[2],C0[3],C1[1]); a=MX3(a,C1[2],C1[3]); \
      _Pragma("unroll") for(int r=4;r<16;r+=4){a=MX3(a,C0[r],C0[r+1]);b=MX3(b,C0[r+2],C0[r+3]);a=MX3(a,C1[r],C1[r+1]);b=MX3(b,C1[r+2],C1[r+3]);} \
      float rm=__builtin_fmaxf(a,b); { auto rr=__builtin_amdgcn_permlane32_swap(__float_as_uint(rm),__float_as_uint(rm),false,false); rm=__builtin_fmaxf(__uint_as_float(rr[0]),__uint_as_float(rr[1])); } \
      resc=false; \
      if(__builtin_expect(__any(rm>(float)THRL),0)){ const float mn_=__uint_as_float(cvtpk_s(mhat+__builtin_fmaxf(rm,0.f),0.f)<<16); const float dl=mn_-mhat; mhat=mn_; \
        _Pragma("unroll") for(int r=0;r<16;++r){C0[r]-=dl;C1[r]-=dl;} \
        SETQM(); \
        const float f=__builtin_amdgcn_exp2f(-dl); l_reg*=f; { const int l_=(int)lane_now(); if((l_>>5)==0)wsf[l_&31]=f; } resc=true; } } \
    SBAR(); \
    GAPB(o[0]=__builtin_amdgcn_mfma_f32_32x32x16_bf16(PAF(0),VFR(0),o[0],0,0,0), C0,0); \
    GAPB(o[1]=__builtin_amdgcn_mfma_f32_32x32x16_bf16(PAF(0),VFR(4),o[1],0,0,0), C0,4); \
    KRD(GL,0); GAPB(o[0]=__builtin_amdgcn_mfma_f32_32x32x16_bf16(PAF(1),VFR(1),o[0],0,0,0), C0,8); \
    KRD(GL,1); GAPB(o[1]=__builtin_amdgcn_mfma_f32_32x32x16_bf16(PAF(1),VFR(5),o[1],0,0,0), C0,12); \
    KRD(GL,2); GAPB(o[0]=__builtin_amdgcn_mfma_f32_32x32x16_bf16(PAF(2),VFR(2),o[0],0,0,0), C1,0); \
    KRD(GL,3); GAPB(o[1]=__builtin_amdgcn_mfma_f32_32x32x16_bf16(PAF(2),VFR(6),o[1],0,0,0), C1,4); \
    GAPB(o[0]=__builtin_amdgcn_mfma_f32_32x32x16_bf16(PAF(3),VFR(3),o[0],0,0,0), C1,8); \
    GAPB(o[1]=__builtin_amdgcn_mfma_f32_32x32x16_bf16(PAF(3),VFR(7),o[1],0,0,0), C1,12); \
    }while(0)
  int t=1;
  #undef CMASK
  #define CMASK(P0,P1,t) do{ const int t_=(t); if(t_<4){ const int l_=(int)lane_now(); cmask(P0,P1,t_,wid*QBLK+(l_&31),l_>>5); } else if(!((sel>>(((t_-4)>>2)&15))&1u)){ _Pragma("unroll") for(int r=0;r<16;++r){P0[r]=-INFINITY;P1[r]=-INFINITY;} } }while(0)
  for(;t+5<NT;t+=2){
    STEP(pB0,pB1,pA0,pA1,t,true,true,true);     WAIT_BAR(2); RESC(); ROT();
    STEP(pA0,pA1,pB0,pB1,t+1,true,true,true);   WAIT_BAR(2); RESC(); ROT();
  }
  #undef CMASK
  #define CMASK(P0,P1,t) do{ const int t_=(t); if(t_<4){ const int l_=(int)lane_now(); cmask(P0,P1,t_,wid*QBLK+(l_&31),l_>>5); } else if(!((sel>>(((t_-4)>>2)&15))&1u)){ _Pragma("unroll") for(int r=0;r<16;++r){P0[r]=-INFINITY;P1[r]=-INFINITY;} } }while(0)
  #define ENDW(tt) do{ if((tt)+3<NT){WAIT_BAR(2);} else if((tt)+2<NT){WAIT_BAR(1);} else {WAIT_BAR(0);} }while(0)
  for(;t+1<NT;t+=2){
    STEP(pB0,pB1,pA0,pA1,t,(t+3<NT),(t+1<NT),(t+1<NT));       ENDW(t);   RESC(); ROT();
    STEP(pA0,pA1,pB0,pB1,t+1,(t+4<NT),(t+2<NT),(t+2<NT));     ENDW(t+1); RESC(); ROT();
  }
  STEP(pB0,pB1,pA0,pA1,NT-1,false,false,false); RESC();
  { float sacc=pB0[0]+pB0[1]; _Pragma("unroll") for(int r=2;r<16;++r)sacc+=pB0[r]; _Pragma("unroll") for(int r=0;r<16;++r)sacc+=pB1[r]; l_reg+=sacc;
    pw0=(u32x4){PKW(pB0,0),PKW(pB0,2),PKW(pB0,4),PKW(pB0,6)};pw1=(u32x4){PKW(pB0,8),PKW(pB0,10),PKW(pB0,12),PKW(pB0,14)};pw2=(u32x4){PKW(pB1,0),PKW(pB1,2),PKW(pB1,4),PKW(pB1,6)};pw3=(u32x4){PKW(pB1,8),PKW(pB1,10),PKW(pB1,12),PKW(pB1,14)};
    SBAR(); pv(o,vb0+sl_cur,PAF(0),PAF(1),PAF(2),PAF(3)); }
  #undef PKW
  #undef PAF
  #undef VFR
  #undef PIN
  #undef MX3
  #undef GAPA
  #undef GAPB
  #undef EX
  #undef VRD
  #undef KRD
  #undef STEP
  #undef ENDW
  {auto rr=__builtin_amdgcn_permlane32_swap(__float_as_uint(l_reg),__float_as_uint(l_reg),false,false);l_reg=__uint_as_float(rr[0])+__uint_as_float(rr[1]);}
  if(hi==0)wsf[32+r32]=l_reg;asm volatile("s_waitcnt lgkmcnt(0)":::"memory");
  float rli[16];
  #pragma unroll
  for(int r=0;r<16;++r)rli[r]=__builtin_amdgcn_rcpf(wsf[32+crow(r,hi)]);
  bf16*Ow=O+(rowbase+q0+wid*QBLK)*DM+h*D;
  { bf16*stg=(bf16*)(shm+LDS_OST)+wid*2048;
    #pragma unroll
    for(int r=0;r<16;++r){const int orow=crow(r,hi);
      #pragma unroll
      for(int d0=0;d0<2;++d0)stg[orow*64+d0*32+r32]=__float2bfloat16(o[d0][r]*rli[r]);}
    asm volatile("s_waitcnt lgkmcnt(0)":::"memory");
    #pragma unroll
    for(int i=0;i<4;++i){const int row=i*8+(lane>>3),ch=lane&7; const u32x4 v=*(const u32x4*)(stg+row*64+ch*8); ATTN_STORE16(Ow+(long)row*DM+ch*8,v);} }
  asm volatile("s_waitcnt lgkmcnt(0)\n\ts_barrier":::"memory");
  #undef DMA_K
  #undef PHYS
  #undef DMA_V
  #undef CMASK
  #undef START
  #undef SETQM
  #undef RESC
  #undef ROT
}
constexpr int ATTN_LDS_BYTES=LDS_BYTES;
struct AttnTensors { const bf16* Q; const bf16* K; const bf16* V; bf16* O; const float* ksum; };
struct AttnUnit { int bh; int qb; };
struct StaticOrder {
  int vcu, G;
  __device__ __forceinline__ explicit StaticOrder(int grid,int block):vcu((grid%8==0)?((block%8)*(grid/8)+block/8):block),G(grid){}
  __device__ __forceinline__ bool next(int i,AttnUnit&u)const{ const int L=i*G+vcu; if(L>=1024)return false; const int w=L&255, rnd=L>>8, s=w&3; u.bh=w>>2; u.qb=(rnd==0)?s:(rnd==1)?7-s:(rnd==2)?8+s:15-s; return true; }
  __device__ __forceinline__ void a_ready(const AttnUnit&)const{}
  __device__ __forceinline__ void done(const AttnUnit&)const{}
};
struct SnakeOrder {
  int v, G;
  __device__ __forceinline__ bool next(int i,AttnUnit&u)const{ const int idx=i*G+((i&1)?(G-1-v):v); if(idx>=1024)return false; u.qb=15-(idx>>6); u.bh=idx&63; return true; }
  __device__ __forceinline__ void a_ready(const AttnUnit&)const{}
  __device__ __forceinline__ void done(const AttnUnit&)const{}
};
template<class Sched,int THRL=8> __device__ __forceinline__ void attn_phase(char*lds,const AttnTensors&T,const Sched&S){
  AttnUnit u;
  for(int i=0;S.next(i,u);++i){ S.a_ready(u); attn_unit<THRL>(u.bh/NHEAD,u.bh%NHEAD,u.qb,T.Q,T.K,T.V,T.O,T.ksum,lds); S.done(u); }
}
#undef SBAR
#undef WAIT_BAR
}
constexpr int NWAVES = 8, NTHR = 512;
constexpr int NTOK = 16384, DM = 1024, SEQ = 4096, NBATCH = 4, NEXP = 32;
constexpr float ALPHA = 1.4142135623730951f;
constexpr float LN_EPS = 1e-5f;
constexpr float RSQRT_DQK = 0.08838834764831845f;
constexpr int NPHASE = 19;
constexpr float FP8_SA = 4.0f, FP8_SWGU = 64.0f, FP8_SWD = 128.0f;
constexpr float FP8_SY = 32.0f, FP8_MAXV = 448.0f;
#ifndef DBG_ATTN_MUL
#define DBG_ATTN_MUL 1.0f
#endif
#ifndef DBG_MLSTM_MUL
#define DBG_MLSTM_MUL 1.0f
#endif
#ifndef DBG_MOE_MUL
#define DBG_MOE_MUL 1.0f
#endif
#ifndef DBG_P14_A
#define DBG_P14_A WS_HN
#endif
#ifndef NCONV
#define NCONV 80
#endif
#ifndef MK_ONE_LAUNCH
#define MK_ONE_LAUNCH 1
#endif

constexpr size_t MiB = 1u << 20, KiB = 1024;
constexpr size_t WS_CTL = 0, CTL_ZERO_BYTES = 1 * MiB;
constexpr int CW_TMO = 0, CW_BAR = 4096, CW_CNT = 8192, CW_AQ = 16384;
constexpr size_t WS_KSUM = 256 * KiB, WS_DEN = 512 * KiB;
constexpr size_t WS_WQKV = 2 * MiB, WS_WO = 8 * MiB, WS_WINA = 10 * MiB, WS_WINB = 14 * MiB, WS_WOUT = 17 * MiB;
constexpr size_t WS_WG = 19 * MiB, WS_RWT = 20 * MiB, WS_ROPE = 21 * MiB;
constexpr size_t WS_TOKE = 22 * MiB, WS_TOKP = 22 * MiB + 256 * KiB, WS_TOKG = 22 * MiB + 512 * KiB;
constexpr size_t WS_GI = 23 * MiB, WS_LF = 23 * MiB + 256 * KiB, WS_RF = 23 * MiB + 512 * KiB, WS_CF = 23 * MiB + 768 * KiB;
constexpr size_t WS_DEC = 24 * MiB, WS_NU = 24 * MiB + 256 * KiB, WS_NPREV = 24 * MiB + 512 * KiB;
constexpr size_t WS_ROWTOK = 25 * MiB;
constexpr size_t WS_XB = 32 * MiB, WS_Q = 64 * MiB, WS_K = 96 * MiB, WS_V = 128 * MiB;
constexpr size_t WS_R0 = 160 * MiB, WS_R1 = 224 * MiB, WS_R2 = 288 * MiB;
constexpr size_t WS_H = 352 * MiB, WS_Y = 496 * MiB;
constexpr size_t WS_WGU = 640 * MiB, WS_WD = 896 * MiB, WS_END = 1024 * MiB;
constexpr size_t WS_AE = 352 * MiB, WS_BE = 416 * MiB, WS_KN = 464 * MiB, WS_KT = 496 * MiB, WS_UT = 512 * MiB, WS_OS = 544 * MiB, WS_HN = 576 * MiB;

constexpr int RING_OFF = 0, RING_BYTES = 131072;
constexpr int LX = RING_BYTES;
constexpr int LX_MISC = LX;
constexpr int LX_TILEE = LX + 128;
constexpr int LX_TBASE = LX + 1280;
constexpr int LX_LCNT = LX + 1536, LX_GBASE = LX + 1664;
constexpr int LX_REC = LX + 1792;
constexpr int LX_TOKL = LX + 4096;
constexpr int LX_LNX = LX + 4096;
constexpr int LX_BIAS = LX + 12288;
constexpr int LX_ROPE = LX + 16384;
constexpr int LDS_BYTES = 163840;
constexpr int TOKL_ROUNDS = 10;

#define RLX_AGENT __ATOMIC_RELAXED, __HIP_MEMORY_SCOPE_AGENT
#define LDS_WAIT() asm volatile("s_waitcnt lgkmcnt(0)" ::: "memory")
#define VM_WAIT() asm volatile("s_waitcnt vmcnt(0)" ::: "memory")
#define XB_TMO      128
#define XB_XCNT(j)  (256  + 64 * (j))
#define XB_XSUB(j)  (1280 + 64 * (j))
#define XB_XGEN(j)  (2304 + 64 * (j))
#define XB_TOP      3328
#define XB_TOPGEN   3392
#define XCD_BAR_WORDS 3456
#define XB_SPIN_CAP (1u << 18)

__device__ __forceinline__ unsigned xb_ld(unsigned* p)              { return __hip_atomic_load(p, __ATOMIC_RELAXED, __HIP_MEMORY_SCOPE_AGENT); }
__device__ __forceinline__ unsigned xb_add(unsigned* p, unsigned v) { return __hip_atomic_fetch_add(p, v, __ATOMIC_RELAXED, __HIP_MEMORY_SCOPE_AGENT); }
__device__ __forceinline__ unsigned xb_xcc_id() { return (unsigned)__builtin_amdgcn_s_getreg((3 << 11) | 20) & 0xFu; }
#define XB_SPIN(cond, bar) do { unsigned _sp = 0; while (cond) { __builtin_amdgcn_s_sleep(1); \
    if ((++_sp & 255u) == 0u) { if (xb_ld(&(bar)[XB_TMO])) break; if (_sp > XB_SPIN_CAP) { atomicAdd(&(bar)[XB_TMO], 1u); break; } } } } while (0)

struct XcdBarrier {
    unsigned* bar; unsigned x;
    volatile LAS unsigned* st;
};

__device__ __forceinline__ XcdBarrier xcd_barrier_post(unsigned* bar, volatile LAS unsigned* st) {
    XcdBarrier b; b.bar = bar; b.x = xb_xcc_id(); b.st = st;
    if (threadIdx.x == 0) (void)xb_add(&bar[XB_XCNT(b.x)], 1u);
    return b;
}
__device__ __forceinline__ void xcd_barrier_complete(unsigned* bar, unsigned x, unsigned& nloc, unsigned& nx) {
    const unsigned G = gridDim.x * gridDim.y * gridDim.z;
    unsigned sum, cnt, mine, sp = 0u;
    for (;;) {
        sum = 0u; cnt = 0u; mine = 0u;
#pragma unroll
        for (unsigned j = 0; j < 16; ++j) { const unsigned c = xb_ld(&bar[XB_XCNT(j)]); sum += c; cnt += (c > 0u) ? 1u : 0u; mine = (j == x) ? c : mine; }
        if (sum == G) break;
        __builtin_amdgcn_s_sleep(1);
        if ((++sp & 255u) == 0u) { if (xb_ld(&bar[XB_TMO])) break; if (sp > XB_SPIN_CAP) { atomicAdd(&bar[XB_TMO], 1u); break; } }
    }
    nloc = mine > 0u ? mine : 1u; nx = cnt > 0u ? cnt : 1u;
}

__device__ __forceinline__ void xcd_barrier(const XcdBarrier& b) {
    asm volatile("s_waitcnt vmcnt(0)" ::: "memory");
    __syncthreads();
    if (threadIdx.x == 0) {
        unsigned* bar = b.bar;
        __builtin_amdgcn_s_waitcnt(0);
        unsigned nloc = b.st[0], nx = b.st[1];
        if (nloc == 0u) { xcd_barrier_complete(bar, b.x, nloc, nx); b.st[0] = nloc; b.st[1] = nx; }
        const unsigned old = xb_add(&bar[XB_XSUB(b.x)], 1u);
        const unsigned gen = old / nloc;
        if (old + 1u == (gen + 1u) * nloc) {
            __builtin_amdgcn_fence(__ATOMIC_RELEASE, "agent");
            asm volatile("s_waitcnt vmcnt(0)" ::: "memory");
            asm volatile("buffer_inv sc1" ::: "memory");
            const unsigned og = xb_add(&bar[XB_TOP], 1u);
            const unsigned tg = og / nx;
            if (og + 1u == (tg + 1u) * nx) xb_add(&bar[XB_TOPGEN], 1u);
            else XB_SPIN(xb_ld(&bar[XB_TOPGEN]) == tg, bar);
            xb_add(&bar[XB_XGEN(b.x)], 1u);
            asm volatile("s_waitcnt vmcnt(0)" ::: "memory");
        } else {
            asm volatile("buffer_inv sc1" ::: "memory");
            XB_SPIN(xb_ld(&bar[XB_XGEN(b.x)]) == gen, bar);
            asm volatile("" ::: "memory");
            asm volatile("s_waitcnt vmcnt(0)" ::: "memory");
        }
    }
    __syncthreads();
}
using pg8::Unit; using pg8::Gemm;
typedef f32x4 (&AccRef)[2][2][4][2];

#ifndef TAIL_FIRST
#define TAIL_FIRST 0
#endif
__device__ __forceinline__ bool moe_unit(int i, int G, int c, int nT, int nN, int& pm, int& pn, int& half) {
    const int U = nT * nN, R = U / G, rem = U - R * G; half = 0;
#if TAIL_FIRST
    if (rem > 0 && 2 * rem <= G) {
        if (c < 2 * rem) { if (i == 0) { half = 1 + (c & 1); return pg8::tile_order(0, U, R * G + (c >> 1), nT, nN, pm, pn); } --i; }
        if (i < R) return pg8::tile_order(i, G, c, nT, nN, pm, pn);
        return false; }
#endif
    if (i < R) return pg8::tile_order(i, G, c, nT, nN, pm, pn);
    if (i > R || rem == 0) return false;
    if (2 * rem <= G) { if (c >= 2 * rem) return false; half = 1 + (c & 1); return pg8::tile_order(0, U, R * G + (c >> 1), nT, nN, pm, pn); }
    return pg8::tile_order(i, G, c, nT, nN, pm, pn);
}
struct DenseSched {
    int nM, nN, G, c; const char* A; const char* B; size_t tstepA, tstepB; bool split = false;
    __device__ __forceinline__ bool next(int i, Unit& u) const {
        int half = 0;
        if (split) { if (!moe_unit(i, G, c, nM, nN, u.pm, u.pn, half)) return false; }
        else if (!pg8::tile_order(i, G, c, nM, nN, u.pm, u.pn)) return false;
        u.A = A + (size_t)u.pm * tstepA; u.B = B + (size_t)u.pn * tstepB; u.tl = nullptr; u.x0 = u.x1 = 0; u.x2 = half; return true; }
};
struct MoeSched {
    int nT, nN, G, c; const LAS int* tile_e; const LAS int* tbase; const LAS unsigned short* tokl;
    const char* A; const char* B; size_t tstepA, estepB, tstepB;
    __device__ __forceinline__ bool next(int i, Unit& u) const {
        int half; if (!moe_unit(i, G, c, nT, nN, u.pm, u.pn, half)) return false;
        const int e = tile_e[u.pm];
        u.x0 = e; u.x1 = u.pm * 256; u.x2 = half;
        u.A = A + (size_t)u.pm * tstepA; u.B = B + (size_t)e * estepB + (size_t)u.pn * tstepB;
        u.tl = tokl ? tokl + (i < TOKL_ROUNDS ? i : TOKL_ROUNDS - 1) * 256 : nullptr; return true; }
};
struct MuSched {
    int G, c, mode; const char* A; const char* B;
    __device__ __forceinline__ bool next(int i, Unit& u) const {
        const int mu = i * G + c; if (mu >= 256) return false;
        const int b = mu >> 6, hh = (mu >> 4) & 3, ch = mu & 15; const size_t tok0 = (size_t)b * SEQ + (size_t)ch * 256;
        u.pm = mu; u.pn = 0; u.x0 = mu; u.x1 = 0; u.x2 = (mode == 0) ? 1 : 0; u.tl = nullptr;
        if (mode == 0) { u.A = A + (size_t)mu * 256 * 384 * 2; u.B = B + ((size_t)(hh * 128) * NTOK + tok0) * 2; }
        else if (mode == 1) { u.A = A + ((size_t)mu * 256 * 512 + 256) * 2; u.B = B + (tok0 * 1024 + (size_t)hh * 256) * 2; }
        else { u.A = A + (size_t)mu * 256 * 512 * 2; u.B = B + (size_t)mu * 256 * 384 * 2; }
        return true; }
};

constexpr float C2 = 0.125f * 1.4426950408889634f;

struct EpiQKV {
    static constexpr bool PERM = true; static constexpr bool MID = true;
    __device__ __forceinline__ void prep(const Unit&, int, int, int) const {}
    __device__ __forceinline__ void prep_mid(const Unit& u, int wid, int lane) const { if ((u.pn >> 2) < 2) {
#pragma unroll
        for (int i = 0; i < 2; ++i) { const int row = (wid * 2 + i) * 16 + (lane >> 2), c = (lane & 3) ^ ((row >> 1) & 3);
            glds16s(uni_ptr((const char*)(rope + (size_t)u.pm * 256 * 16)), (unsigned)(row * 64 + c * 16), (unsigned)__builtin_amdgcn_readfirstlane((unsigned)(unsigned long long)ropel + (unsigned)((wid * 2 + i) * 1024))); } } }
    bf16_t* Q; bf16_t* K; bf16_t* V; const float* rope; float* ksum; LAS float* ropel;
    __device__ __forceinline__ void operator()(AccRef acc, const Unit& u, int wr, int wc, int fr, int fq) const {
        asm volatile("" : "+v"(fr), "+v"(fq));
        const int part = u.pn >> 2, colt = (u.pn & 3) * 256;
        bf16_t* base = Q + (size_t)part * ((WS_K - WS_Q) / 2);
        const bool rot = (part < 2) && ((wc & 1) == 0);
        float ks[2][8];
#pragma unroll
        for (int bj = 0; bj < 2; ++bj)
#pragma unroll
            for (int j = 0; j < 8; ++j) ks[bj][j] = 0.f;
#pragma unroll
        for (int ai = 0; ai < 2; ++ai)
#pragma unroll
            for (int m = 0; m < 4; ++m) {
                const int row = u.pm * 256 + ai * 128 + wr * 64 + m * 16 + fr;
                f32x4 cs = {1.f, 1.f, 1.f, 1.f}, sn = {0.f, 0.f, 0.f, 0.f};
                if (rot && fq < 2) { const int rl = ai * 128 + wr * 64 + m * 16 + fr, sw = (rl >> 1) & 3; const LAS f32x4* rp = (const LAS f32x4*)(ropel + rl * 16);
                    cs = rp[fq ^ sw]; sn = rp[(2 + fq) ^ sw]; }
#pragma unroll
                for (int bj = 0; bj < 2; ++bj) {
                    f32x4 v0 = acc[ai][bj][m][0], v1 = acc[ai][bj][m][1];
                    if (rot) { const f32x4 lo = v0 * cs - v1 * sn, hi = v1 * cs + v0 * sn; v0 = lo; v1 = hi; }
                    if (part == 0) { v0 = v0 * C2; v1 = v1 * C2; }
                    if (part == 1) {
#pragma unroll
                        for (int j = 0; j < 4; ++j) { ks[bj][j] += v0[j]; ks[bj][4 + j] += v1[j]; } }
                    u32x4 w; w.x = cvt_pk_bf16(v0[0], v0[1]); w.y = cvt_pk_bf16(v0[2], v0[3]); w.z = cvt_pk_bf16(v1[0], v1[1]); w.w = cvt_pk_bf16(v1[2], v1[3]);
                    *(u32x4*)(base + (size_t)row * DM + colt + bj * 128 + wc * 32 + fq * 8) = w;
                }
            }
        if (part == 1) {
#pragma unroll
            for (int bj = 0; bj < 2; ++bj)
#pragma unroll
                for (int j = 0; j < 8; ++j) { float s = ks[bj][j]; s += __shfl_xor(s, 1); s += __shfl_xor(s, 2); s += __shfl_xor(s, 4); s += __shfl_xor(s, 8);
                    if (fr == 0) atomicAdd(ksum + (size_t)u.pm * DM + colt + bj * 128 + wc * 32 + fq * 8 + j, s); }
        }
    }
};

struct EpiZ {
    static constexpr bool PERM = true; static constexpr bool MID = false;
    __device__ __forceinline__ void prep(const Unit&, int, int, int) const {}
    const bf16_t* xin; bf16_t* z; float ymul;
    __device__ __forceinline__ void operator()(AccRef acc, const Unit& u, int wr, int wc, int fr, int fq) const {
        asm volatile("" : "+v"(fr), "+v"(fq));
        const size_t off0 = (size_t)(u.pm * 256 + wr * 64 + fr) * DM + u.pn * 256 + wc * 32 + fq * 8;
        u32x4 xr[2][4][2];
#pragma unroll
        for (int ai = 0; ai < 2; ++ai)
#pragma unroll
            for (int m = 0; m < 4; ++m)
#pragma unroll
                for (int bj = 0; bj < 2; ++bj) xr[ai][m][bj] = *(const u32x4*)(xin + off0 + (size_t)(ai * 128 + m * 16) * DM + bj * 128);
        asm volatile("" ::: "memory");
#pragma unroll
        for (int ai = 0; ai < 2; ++ai)
#pragma unroll
            for (int m = 0; m < 4; ++m)
#pragma unroll
                for (int bj = 0; bj < 2; ++bj) { const u32x4 x = xr[ai][m][bj]; const f32x4 a0 = acc[ai][bj][m][0] * ymul, a1 = acc[ai][bj][m][1] * ymul;
                    u32x4 w; w.x = cvt_pk_bf16(bflo(x.x) * ALPHA + a0[0], bfhi(x.x) * ALPHA + a0[1]); w.y = cvt_pk_bf16(bflo(x.y) * ALPHA + a0[2], bfhi(x.y) * ALPHA + a0[3]);
                    w.z = cvt_pk_bf16(bflo(x.z) * ALPHA + a1[0], bfhi(x.z) * ALPHA + a1[1]); w.w = cvt_pk_bf16(bflo(x.w) * ALPHA + a1[2], bfhi(x.w) * ALPHA + a1[3]);
                    *(u32x4*)(z + off0 + (size_t)(ai * 128 + m * 16) * DM + bj * 128) = w; }
    }
};

__device__ __forceinline__ float swiglu1(float glu, float lin) {
    const float g = fminf(glu, 7.0f), l = fminf(fmaxf(lin, -7.0f), 7.0f);
    const float sg = __builtin_amdgcn_rcpf(1.0f + __builtin_amdgcn_exp2f(-1.702f * 1.4426950408889634f * g));
    return g * sg * (l + 1.0f);
}
__device__ __forceinline__ f32x2 swiglu2(float glu0, float lin0, float glu1, float lin1) {
    const f32x2 g = {fminf(glu0, 7.0f), fminf(glu1, 7.0f)}, l = {fminf(fmaxf(lin0, -7.0f), 7.0f), fminf(fmaxf(lin1, -7.0f), 7.0f)};
    const f32x2 t = g * (f32x2){-1.702f * 1.4426950408889634f, -1.702f * 1.4426950408889634f};
    const f32x2 d = (f32x2){__builtin_amdgcn_exp2f(t[0]), __builtin_amdgcn_exp2f(t[1])} + (f32x2){1.0f, 1.0f};
    const f32x2 r = {__builtin_amdgcn_rcpf(d[0]), __builtin_amdgcn_rcpf(d[1])};
    const f32x2 lp = l * (f32x2){FP8_SA, FP8_SA} + (f32x2){FP8_SA, FP8_SA};
    return (g * lp) * r;
}
struct EpiGU {
    static constexpr bool PERM = true; static constexpr bool MID = false;
    __device__ __forceinline__ void prep(const Unit& u, int ui, int wid, int lane) const { if (wid < 4) glds4s(uni_ptr((const char*)(bias + (size_t)u.x0 * 2048 + u.pn * 256 + wid * 64)), (unsigned)lane * 4u, (unsigned)__builtin_amdgcn_readfirstlane((unsigned)(unsigned long long)bl + (unsigned)(((ui & 1) * 256 + wid * 64) * 4))); }
    const float* bias; unsigned char* H; LAS float* bl; mutable int ucnt;
    __device__ __forceinline__ void operator()(AccRef acc, const Unit& u, int wr, int wc, int fr, int fq) const {
        asm volatile("" : "+v"(fr), "+v"(fq));
        const int c0 = u.pn * 256 + wc * 32 + fq * 8; const LAS float* bp = bl + (ucnt & 1) * 256 + wc * 32 + fq * 8; ++ucnt; constexpr float SC = 1.0f / (FP8_SA * FP8_SWGU);
        f32x4 b[2][2];
#pragma unroll
        for (int bj = 0; bj < 2; ++bj) { b[bj][0] = *(const LAS f32x4*)(bp + bj * 128); b[bj][1] = *(const LAS f32x4*)(bp + bj * 128 + 4); }
#pragma unroll
        for (int ai = 0; ai < 2; ++ai)
#pragma unroll
            for (int m = 0; m < 4; ++m) {
                unsigned char* rowp = H + (size_t)(u.x1 + ai * 128 + wr * 64 + m * 16 + fr) * DM + (c0 >> 1);
#pragma unroll
                for (int bj = 0; bj < 2; ++bj) { if (u.x2 == 2 - bj) continue;
                    const f32x4 v0 = acc[ai][bj][m][0] * SC + b[bj][0], v1 = acc[ai][bj][m][1] * SC + b[bj][1];
                    const f32x2 h0 = swiglu2(v0[0], v0[1], v0[2], v0[3]), h1 = swiglu2(v1[0], v1[1], v1[2], v1[3]);
                    int w = __builtin_amdgcn_cvt_pk_fp8_f32(h0[0], h0[1], 0, false);
                    w = __builtin_amdgcn_cvt_pk_fp8_f32(h1[0], h1[1], w, true);
                    *(int*)(rowp + bj * 64) = w; }
            }
    }
};
struct EpiDN {
    static constexpr bool PERM = true; static constexpr bool MID = false;
    __device__ __forceinline__ void prep(const Unit& u, int ui, int wid, int lane) const { if (wid < 4) glds4s(uni_ptr((const char*)(bias + (size_t)u.x0 * 1024 + u.pn * 256 + wid * 64)), (unsigned)lane * 4u, (unsigned)__builtin_amdgcn_readfirstlane((unsigned)(unsigned long long)bl + (unsigned)(((ui & 1) * 256 + wid * 64) * 4))); }
    const float* bias; unsigned char* Y; LAS float* bl; mutable int ucnt;
    __device__ __forceinline__ void operator()(AccRef acc, const Unit& u, int wr, int wc, int fr, int fq) const {
        asm volatile("" : "+v"(fr), "+v"(fq));
        const int c0 = u.pn * 256 + wc * 32 + fq * 8; const LAS float* bp = bl + (ucnt & 1) * 256 + wc * 32 + fq * 8; ++ucnt; constexpr float SC = FP8_SY / (FP8_SA * FP8_SWD);
        f32x4 b[2][2];
#pragma unroll
        for (int bj = 0; bj < 2; ++bj) { b[bj][0] = *(const LAS f32x4*)(bp + bj * 128) * FP8_SY; b[bj][1] = *(const LAS f32x4*)(bp + bj * 128 + 4) * FP8_SY; }
#pragma unroll
        for (int ai = 0; ai < 2; ++ai)
#pragma unroll
            for (int m = 0; m < 4; ++m) {
                unsigned char* rowp = Y + (size_t)(u.x1 + ai * 128 + wr * 64 + m * 16 + fr) * DM + c0;
#pragma unroll
                for (int bj = 0; bj < 2; ++bj) { if (u.x2 == 2 - bj) continue;
                    f32x4 v0 = acc[ai][bj][m][0] * SC + b[bj][0], v1 = acc[ai][bj][m][1] * SC + b[bj][1];
#pragma unroll
                    for (int q = 0; q < 4; ++q) { v0[q] = __builtin_amdgcn_fmed3f(v0[q], -FP8_MAXV, FP8_MAXV); v1[q] = __builtin_amdgcn_fmed3f(v1[q], -FP8_MAXV, FP8_MAXV); }
                    int w0 = __builtin_amdgcn_cvt_pk_fp8_f32(v0[0], v0[1], 0, false); w0 = __builtin_amdgcn_cvt_pk_fp8_f32(v0[2], v0[3], w0, true);
                    int w1 = __builtin_amdgcn_cvt_pk_fp8_f32(v1[0], v1[1], 0, false); w1 = __builtin_amdgcn_cvt_pk_fp8_f32(v1[2], v1[3], w1, true);
                    u32x2 w; w.x = (unsigned)w0; w.y = (unsigned)w1;
                    *(u32x2*)(rowp + bj * 128) = w; }
            }
    }
};

struct EpiINA {
    static constexpr bool PERM = true; static constexpr bool MID = false;
    __device__ __forceinline__ void prep(const Unit&, int, int, int) const {}
    const float* rf; const float* cf; bf16_t* AE; bf16_t* KN; bf16_t* OS;
    __device__ __forceinline__ void operator()(AccRef acc, const Unit& u, int wr, int wc, int fr, int fq) const {
        asm volatile("" : "+v"(fr), "+v"(fq));
        const int b = u.pm >> 4, ch = u.pm & 15, d0 = wc * 32 + fq * 8; const u32x4 zero = {0u, 0u, 0u, 0u};
        if (u.pn < 4) {
            const bool isq = u.pn < 2; const float* fac = isq ? rf : cf; const float fs = isq ? 1.0f : RSQRT_DQK; const int h0 = (u.pn & 1) * 2;
            float sf[2][4][2];
#pragma unroll
            for (int ai = 0; ai < 2; ++ai)
#pragma unroll
                for (int m = 0; m < 4; ++m)
#pragma unroll
                    for (int bj = 0; bj < 2; ++bj) sf[ai][m][bj] = fac[(size_t)(h0 + bj) * NTOK + (size_t)u.pm * 256 + ai * 128 + wr * 64 + m * 16 + fr];
#pragma unroll
            for (int ai = 0; ai < 2; ++ai)
#pragma unroll
                for (int m = 0; m < 4; ++m) {
                    const int t = ai * 128 + wr * 64 + m * 16 + fr; const size_t token = (size_t)u.pm * 256 + t;
#pragma unroll
                    for (int bj = 0; bj < 2; ++bj) { const int hh = h0 + bj; const float s = sf[ai][m][bj] * fs;
                        const f32x4 v0 = acc[ai][bj][m][0] * s, v1 = acc[ai][bj][m][1] * s;
                        const size_t oq = ((size_t)(((b * 4 + hh) * 16 + ch) * 256 + t)) * 512 + 256 + d0, ok = token * 1024 + hh * 256 + d0;
                        bf16_t* dst = isq ? (AE + oq) : (KN + ok);
                        u32x4 w; w.x = cvt_pk_bf16(v0[0], v0[1]); w.y = cvt_pk_bf16(v0[2], v0[3]); w.z = cvt_pk_bf16(v1[0], v1[1]); w.w = cvt_pk_bf16(v1[2], v1[3]);
                        *(u32x4*)dst = w; }
                }
        } else {
#pragma unroll
            for (int ai = 0; ai < 2; ++ai)
#pragma unroll
                for (int m = 0; m < 4; ++m) {
                    const int t = ai * 128 + wr * 64 + m * 16 + fr; const size_t token = (size_t)u.pm * 256 + t;
#pragma unroll
                    for (int bj = 0; bj < 2; ++bj) { f32x4 v0 = acc[ai][bj][m][0], v1 = acc[ai][bj][m][1];
#pragma unroll
                        for (int j = 0; j < 4; ++j) { v0[j] = __builtin_amdgcn_rcpf(1.0f + __builtin_amdgcn_exp2f(-1.4426950408889634f * v0[j])); v1[j] = __builtin_amdgcn_rcpf(1.0f + __builtin_amdgcn_exp2f(-1.4426950408889634f * v1[j])); }
                        u32x4 w; w.x = cvt_pk_bf16(v0[0], v0[1]); w.y = cvt_pk_bf16(v0[2], v0[3]); w.z = cvt_pk_bf16(v1[0], v1[1]); w.w = cvt_pk_bf16(v1[2], v1[3]);
                        *(u32x4*)(OS + token * 1024 + (u.pn - 4) * 256 + bj * 128 + d0) = w; }
                }
        }
    }
};
struct EpiINB {
    static constexpr bool PERM = true; static constexpr bool MID = false;
    __device__ __forceinline__ void prep(const Unit&, int, int, int) const {}
    const float* cf; bf16_t* KT; bf16_t* BE;
    __device__ __forceinline__ void operator()(AccRef acc, const Unit& u, int wr, int wc, int fr, int fq) const {
        asm volatile("" : "+v"(fr), "+v"(fq));
        const int b = u.pn >> 4, ch = u.pn & 15;
        f32x4 cv[2][2][2];
#pragma unroll
        for (int ai = 0; ai < 2; ++ai)
#pragma unroll
            for (int bj = 0; bj < 2; ++bj) { const size_t tok0 = (size_t)u.pn * 256 + bj * 128 + wc * 32 + fq * 8;
                if (u.pm < 2) { const int hh = u.pm * 2 + ai; cv[ai][bj][0] = *(const f32x4*)(cf + (size_t)hh * NTOK + tok0) * RSQRT_DQK; cv[ai][bj][1] = *(const f32x4*)(cf + (size_t)hh * NTOK + tok0 + 4) * RSQRT_DQK; }
                else { cv[ai][bj][0] = (f32x4){1.f, 1.f, 1.f, 1.f}; cv[ai][bj][1] = cv[ai][bj][0]; } }
#pragma unroll
        for (int ai = 0; ai < 2; ++ai)
#pragma unroll
            for (int m = 0; m < 4; ++m) {
                const int R = u.pm * 256 + ai * 128 + wr * 64 + m * 16 + fr;
#pragma unroll
                for (int bj = 0; bj < 2; ++bj) { if (u.x2 == 2 - bj) continue;
                    const f32x4 v0 = acc[ai][bj][m][0] * cv[ai][bj][0], v1 = acc[ai][bj][m][1] * cv[ai][bj][1]; const int s0 = bj * 128 + wc * 32 + fq * 8; const size_t tok0 = (size_t)u.pn * 256 + s0; bf16_t* dst;
                    if (u.pm < 2) dst = KT + (size_t)R * NTOK + tok0;
                    else { const int eg = R - 512, hh = eg >> 8, e = eg & 255; dst = BE + ((size_t)(((b * 4 + hh) * 16 + ch) * 256 + e)) * 384 + s0; }
                    u32x4 w; w.x = cvt_pk_bf16(v0[0], v0[1]); w.y = cvt_pk_bf16(v0[2], v0[3]); w.z = cvt_pk_bf16(v1[0], v1[1]); w.w = cvt_pk_bf16(v1[2], v1[3]);
                    *(u32x4*)dst = w;
                }
            }
    }
};
struct EpiM1 {
    static constexpr bool PERM = true; static constexpr bool MID = false;
    __device__ __forceinline__ void prep(const Unit&, int, int, int) const {}
    bf16_t* UT;
    __device__ __forceinline__ void operator()(AccRef acc, const Unit& u, int wr, int wc, int fr, int fq) const {
        asm volatile("" : "+v"(fr), "+v"(fq));
#pragma unroll
        for (int ai = 0; ai < 2; ++ai)
#pragma unroll
            for (int m = 0; m < 4; ++m) { bf16_t* rowp = UT + ((size_t)u.x0 * 256 + ai * 128 + wr * 64 + m * 16 + fr) * 128 + wc * 32 + fq * 8;
                const f32x4 v0 = acc[ai][0][m][0], v1 = acc[ai][0][m][1];
                u32x4 w; w.x = cvt_pk_bf16(v0[0], v0[1]); w.y = cvt_pk_bf16(v0[2], v0[3]); w.z = cvt_pk_bf16(v1[0], v1[1]); w.w = cvt_pk_bf16(v1[2], v1[3]);
                *(u32x4*)rowp = w; }
    }
};
struct EpiM2A {
    static constexpr bool PERM = true; static constexpr bool MID = false;
    __device__ __forceinline__ void prep(const Unit&, int, int, int) const {}
    bf16_t* AE; const float* nprev; float* den;
    __device__ __forceinline__ void operator()(AccRef acc, const Unit& u, int wr, int wc, int fr, int fq) const {
        asm volatile("" : "+v"(fr), "+v"(fq));
        const int mu = u.x0, dd = wc * 32 + fq * 8;
        const f32x4 n0 = *(const f32x4*)(nprev + (size_t)mu * 128 + dd), n1 = *(const f32x4*)(nprev + (size_t)mu * 128 + dd + 4);
        u32x4 qv8[2][4];
#pragma unroll
        for (int ai = 0; ai < 2; ++ai)
#pragma unroll
            for (int m = 0; m < 4; ++m) qv8[ai][m] = *(const u32x4*)(AE + ((size_t)mu * 256 + ai * 128 + wr * 64 + m * 16 + fr) * 512 + 256 + dd);
#pragma unroll
        for (int ai = 0; ai < 2; ++ai)
#pragma unroll
            for (int m = 0; m < 4; ++m) {
                const int t = ai * 128 + wr * 64 + m * 16 + fr; bf16_t* rowp = AE + ((size_t)mu * 256 + t) * 512;
                const u32x4 qv = qv8[ai][m];
                float part = bflo(qv.x) * n0[0] + bfhi(qv.x) * n0[1] + bflo(qv.y) * n0[2] + bfhi(qv.y) * n0[3] + bflo(qv.z) * n1[0] + bfhi(qv.z) * n1[1] + bflo(qv.w) * n1[2] + bfhi(qv.w) * n1[3];
#pragma unroll
                for (int bj = 0; bj < 2; ++bj) { const int s0 = bj * 128 + wc * 32 + fq * 8; f32x4 v0 = acc[ai][bj][m][0], v1 = acc[ai][bj][m][1];
                    int dts = t - s0; asm volatile("" : "+v"(dts));
#pragma unroll
                    for (int j = 0; j < 4; ++j) { v0[j] = (j <= dts) ? v0[j] : 0.f; v1[j] = (4 + j <= dts) ? v1[j] : 0.f; part += v0[j] + v1[j]; }
                    u32x4 w; w.x = cvt_pk_bf16(v0[0], v0[1]); w.y = cvt_pk_bf16(v0[2], v0[3]); w.z = cvt_pk_bf16(v1[0], v1[1]); w.w = cvt_pk_bf16(v1[2], v1[3]);
                    *(u32x4*)(rowp + s0) = w; }
                part += __shfl_xor(part, 16); part += __shfl_xor(part, 32);
                if (fq == 0) atomicAdd(den + (size_t)mu * 256 + (wr * 64 + fr) + (ai * 128 + m * 16), part);
            }
    }
};
struct EpiM2B {
    static constexpr bool PERM = true; static constexpr bool MID = false;
    __device__ __forceinline__ void prep(const Unit&, int, int, int) const {}
    const float* den; const float* normg; const bf16_t* OS; bf16_t* HN; LAS float* lnx;
    __device__ __forceinline__ void operator()(AccRef acc, const Unit& u, int wr, int wc, int fr, int fq) const {
        asm volatile("" : "+v"(fr), "+v"(fq));
        const int mu = u.x0, b = mu >> 6, hh = (mu >> 4) & 3, ch = mu & 15;
        float dnv[2][4];
#pragma unroll
        for (int ai = 0; ai < 2; ++ai)
#pragma unroll
            for (int m = 0; m < 4; ++m) dnv[ai][m] = den[(size_t)mu * 256 + ai * 128 + wr * 64 + m * 16 + fr];
#pragma unroll
        for (int ai = 0; ai < 2; ++ai)
#pragma unroll
            for (int m = 0; m < 4; ++m) {
                const int t = ai * 128 + wr * 64 + m * 16 + fr; const float dn = dnv[ai][m];
#ifdef DBG_DEN1
                const float inv = 1.0f;
#else
                const float inv = 1.0f / fmaxf(fabsf(dn), 1.0f);
#endif
                float s1 = 0.f, s2 = 0.f;
#pragma unroll
                for (int bj = 0; bj < 2; ++bj)
#pragma unroll
                    for (int n = 0; n < 2; ++n) { f32x4 h = acc[ai][bj][m][n] * inv; acc[ai][bj][m][n] = h; s1 += (h[0] + h[1]) + (h[2] + h[3]); s2 += (h[0] * h[0] + h[1] * h[1]) + (h[2] * h[2] + h[3] * h[3]); }
                s1 += __shfl_xor(s1, 16); s1 += __shfl_xor(s1, 32); s2 += __shfl_xor(s2, 16); s2 += __shfl_xor(s2, 32);
                if (fq == 0) { lnx[(t * 4 + wc) * 2] = s1; lnx[(t * 4 + wc) * 2 + 1] = s2; }
            }
        const int e0 = wc * 32 + fq * 8;
        f32x4 gg[2][2];
#pragma unroll
        for (int bj = 0; bj < 2; ++bj) { gg[bj][0] = *(const f32x4*)(normg + hh * 256 + bj * 128 + e0); gg[bj][1] = *(const f32x4*)(normg + hh * 256 + bj * 128 + e0 + 4); }
        asm volatile("s_waitcnt lgkmcnt(0)" ::: "memory"); __builtin_amdgcn_s_barrier(); asm volatile("" ::: "memory");
#pragma unroll
        for (int ai = 0; ai < 2; ++ai) {
            u32x4 ovv[4][2];
#pragma unroll
            for (int m = 0; m < 4; ++m)
#pragma unroll
                for (int bj = 0; bj < 2; ++bj) ovv[m][bj] = *(const u32x4*)(OS + (((size_t)(b * 16 + ch)) * 256 + ai * 128 + wr * 64 + m * 16 + fr) * 1024 + hh * 256 + bj * 128 + e0);
#pragma unroll
            for (int m = 0; m < 4; ++m) {
                const int t = ai * 128 + wr * 64 + m * 16 + fr; const size_t token = ((size_t)(b * 16 + ch)) * 256 + t;
                const LAS f32x4* lp = (const LAS f32x4*)(lnx + t * 8); const f32x4 a = lp[0], c = lp[1];
                const float mean = (a[0] + a[2] + c[0] + c[2]) * (1.0f / 256.0f); const float ex2 = (a[1] + a[3] + c[1] + c[3]) * (1.0f / 256.0f);
                const float rstd = 1.0f / sqrtf(fmaxf(ex2 - mean * mean, 0.f) + LN_EPS);
#pragma unroll
                for (int bj = 0; bj < 2; ++bj) { const int e = bj * 128 + e0; const size_t off = token * 1024 + hh * 256 + e; const u32x4 ov = ovv[m][bj];
#ifdef DBG_HN_OS
                    f32x4 v0 = {1.f, 1.f, 1.f, 1.f}, v1 = v0;
#elif defined(DBG_HN_RAW)
                    f32x4 v0 = acc[ai][bj][m][0], v1 = acc[ai][bj][m][1];
#else
                    f32x4 v0 = (acc[ai][bj][m][0] - mean) * rstd * gg[bj][0], v1 = (acc[ai][bj][m][1] - mean) * rstd * gg[bj][1];
#endif
#ifndef DBG_HN_ONE
                    v0[0] *= bflo(ov.x); v0[1] *= bfhi(ov.x); v0[2] *= bflo(ov.y); v0[3] *= bfhi(ov.y); v1[0] *= bflo(ov.z); v1[1] *= bfhi(ov.z); v1[2] *= bflo(ov.w); v1[3] *= bfhi(ov.w);
#endif
                    u32x4 w; w.x = cvt_pk_bf16(v0[0], v0[1]); w.y = cvt_pk_bf16(v0[2], v0[3]); w.z = cvt_pk_bf16(v1[0], v1[1]); w.w = cvt_pk_bf16(v1[2], v1[3]);
                    *(u32x4*)(HN + off) = w; }
            }
            asm volatile("" ::: "memory");
        }
        asm volatile("s_waitcnt lgkmcnt(0)" ::: "memory"); __builtin_amdgcn_s_barrier(); asm volatile("" ::: "memory");
    }
};
struct Frame {
    LAS unsigned char* lds;
    unsigned* ctl;
    unsigned char* ws;
    int tid, lane, wave, vcu, G;
};
__device__ __forceinline__ float wave_sum(float v) {
#pragma unroll
    for (int o = 1; o < 64; o <<= 1) v += __shfl_xor(v, o);
    return v;
}

__device__ __forceinline__ void tr_block(const float* src, size_t pitch, bf16_t* dst, size_t kd, int kb, int nb, LAS unsigned* scr, int lane, bool rotperm = false) {
    const float* s0 = src + (size_t)(64 * kb) * pitch + 64 * nb + 4 * (lane & 15);
#pragma unroll
    for (int i = 0; i < 8; ++i) {
        const int kp = 4 * i + (lane >> 4);
        const f32x4 a = __builtin_nontemporal_load((const f32x4*)(s0 + (size_t)(2 * kp) * pitch)), b = __builtin_nontemporal_load((const f32x4*)(s0 + (size_t)(2 * kp + 1) * pitch));
#pragma unroll
        for (int j = 0; j < 4; ++j) scr[(4 * (lane & 15) + j) * 33 + kp] = cvt_pk_bf16(a[j], b[j]);
    }
    LDS_WAIT(); asm volatile("" ::: "memory");
    u32x4 o[8];
#pragma unroll
    for (int c = 0; c < 8; ++c) { const int r0 = 8 * c + (lane >> 3), rr = (rotperm && c < 2) ? (8 * ((r0 >> 2) & 1) + 4 * (r0 >> 3) + (r0 & 3)) : r0, q4 = 4 * (lane & 7); o[c].x = scr[rr * 33 + q4]; o[c].y = scr[rr * 33 + q4 + 1]; o[c].z = scr[rr * 33 + q4 + 2]; o[c].w = scr[rr * 33 + q4 + 3]; }
    bf16_t* d = dst + (size_t)(64 * nb + (lane >> 3)) * kd + 64 * kb + 8 * (lane & 7);
#pragma unroll
    for (int c = 0; c < 8; ++c) *(u32x4*)(d + (size_t)(8 * c) * kd) = o[c];
    LDS_WAIT(); asm volatile("" ::: "memory");
}
__device__ __forceinline__ void tr_block8(const float* src, size_t pitch, unsigned char* dst, size_t kd, int kb, int nb, float scale, LAS unsigned* scr, int lane) {
    const float* s0 = src + (size_t)(128 * kb) * pitch + 64 * nb + 4 * (lane & 15);
#pragma unroll
    for (int i = 0; i < 8; ++i) {
        const int kq = 4 * i + (lane >> 4);
        const f32x4 r0 = __builtin_nontemporal_load((const f32x4*)(s0 + (size_t)(4 * kq) * pitch)) * scale, r1 = __builtin_nontemporal_load((const f32x4*)(s0 + (size_t)(4 * kq + 1) * pitch)) * scale,
                    r2 = __builtin_nontemporal_load((const f32x4*)(s0 + (size_t)(4 * kq + 2) * pitch)) * scale, r3 = __builtin_nontemporal_load((const f32x4*)(s0 + (size_t)(4 * kq + 3) * pitch)) * scale;
#pragma unroll
        for (int j = 0; j < 4; ++j) { int w = __builtin_amdgcn_cvt_pk_fp8_f32(r0[j], r1[j], 0, false); w = __builtin_amdgcn_cvt_pk_fp8_f32(r2[j], r3[j], w, true); scr[(4 * (lane & 15) + j) * 33 + kq] = (unsigned)w; }
    }
    LDS_WAIT(); asm volatile("" ::: "memory");
    u32x4 o[8];
#pragma unroll
    for (int c = 0; c < 8; ++c) { const int rr = 8 * c + (lane >> 3), q4 = 4 * (lane & 7); o[c].x = scr[rr * 33 + q4]; o[c].y = scr[rr * 33 + q4 + 1]; o[c].z = scr[rr * 33 + q4 + 2]; o[c].w = scr[rr * 33 + q4 + 3]; }
    unsigned char* d = dst + (size_t)(64 * nb + (lane >> 3)) * kd + 128 * kb + 16 * (lane & 7);
#pragma unroll
    for (int c = 0; c < 8; ++c) *(u32x4*)(d + (size_t)(8 * c) * kd) = o[c];
    LDS_WAIT(); asm volatile("" ::: "memory");
}
constexpr int CONV_ITEMS = 24576;
struct ConvItem { const float* s0; size_t pitch; unsigned char* d; float scale; };
__device__ __forceinline__ ConvItem conv_desc(const float* wgu, const float* wd, unsigned char* ws, int v, int lane) {
    const int layer = v >= 12288; int r = v - layer * 12288; ConvItem it;
    if (r < 8192) { const int mat = layer * 32 + (r >> 8); r &= 255; const int kb = r >> 5, nb = r & 31; it.pitch = 2048; it.scale = FP8_SWGU;
        it.s0 = wgu + (size_t)mat * 1024 * 2048 + (size_t)(128 * kb) * 2048 + 64 * nb + 4 * (lane & 15); it.d = ws + WS_WGU + (size_t)mat * 2048 * 1024 + (size_t)(64 * nb + (lane >> 3)) * 1024 + 128 * kb + 16 * (lane & 7); }
    else { r -= 8192; const int mat = layer * 32 + (r >> 7); r &= 127; const int kb = r >> 4, nb = r & 15; it.pitch = 1024; it.scale = FP8_SWD;
        it.s0 = wd + (size_t)mat * 1024 * 1024 + (size_t)(128 * kb) * 1024 + 64 * nb + 4 * (lane & 15); it.d = ws + WS_WD + (size_t)mat * 1024 * 1024 + (size_t)(64 * nb + (lane >> 3)) * 1024 + 128 * kb + 16 * (lane & 7); }
    return it;
}
__device__ __forceinline__ void conv_items(Frame& F, const float* wgu, const float* wd, int v_lo, int v_hi, int cw, int ncw) {
    LAS unsigned* scr = (LAS unsigned*)(F.lds + RING_OFF + F.wave * 8448); unsigned char* ws = F.ws; const int lane = F.lane;
    int v = v_lo + cw; if (v >= v_hi) return;
    ConvItem cur = conv_desc(wgu, wd, ws, v, lane);
    f32x4 r[8][4];
#pragma unroll
    for (int i = 0; i < 8; ++i) { const int kq = 4 * i + (lane >> 4);
#pragma unroll
        for (int q = 0; q < 4; ++q) r[i][q] = __builtin_nontemporal_load((const f32x4*)(cur.s0 + (size_t)(4 * kq + q) * cur.pitch)); }
    for (;;) {
        const int vn = v + ncw; const bool has = vn < v_hi; ConvItem nx = cur; if (has) nx = conv_desc(wgu, wd, ws, vn, lane);
#pragma unroll
        for (int i = 0; i < 8; ++i) { const int kq = 4 * i + (lane >> 4);
#pragma unroll
            for (int j = 0; j < 4; ++j) { int w = __builtin_amdgcn_cvt_pk_fp8_f32(r[i][0][j] * cur.scale, r[i][1][j] * cur.scale, 0, false); w = __builtin_amdgcn_cvt_pk_fp8_f32(r[i][2][j] * cur.scale, r[i][3][j] * cur.scale, w, true); scr[(4 * (lane & 15) + j) * 33 + kq] = (unsigned)w; }
            if (has) {
#pragma unroll
                for (int q = 0; q < 4; ++q) r[i][q] = __builtin_nontemporal_load((const f32x4*)(nx.s0 + (size_t)(4 * kq + q) * nx.pitch)); } }
        LDS_WAIT(); asm volatile("" ::: "memory");
        u32x4 o[8];
#pragma unroll
        for (int c = 0; c < 8; ++c) { const int rr = 8 * c + (lane >> 3), q4 = 4 * (lane & 7); o[c].x = scr[rr * 33 + q4]; o[c].y = scr[rr * 33 + q4 + 1]; o[c].z = scr[rr * 33 + q4 + 2]; o[c].w = scr[rr * 33 + q4 + 3]; }
#pragma unroll
        for (int c = 0; c < 8; ++c) __builtin_nontemporal_store(o[c], (u32x4*)(cur.d + (size_t)(8 * c) * 1024));
        LDS_WAIT(); asm volatile("" ::: "memory");
        if (!has) break;
        v = vn; cur = nx;
    }
}
struct P0In { const float *x, *wqkv, *wo, *win, *wout, *rw, *wgu, *wd; const int* pos; };
__device__ __forceinline__ void p0_prologue(Frame& F, const P0In& I) {
    LAS unsigned* scr = (LAS unsigned*)(F.lds + RING_OFF + F.wave * 8448);
    const int gw = F.vcu * NWAVES + F.wave, NGW = F.G * NWAVES;
    unsigned char* ws = F.ws;
    constexpr int KB = 16;
    constexpr int I_QKV = KB * 48, I_WO = KB * 16, I_INA1 = KB * 16, I_INA2 = KB * 16, I_INB = KB * 24, I_WOUT = KB * 16;
    constexpr int I_SMALL = I_QKV + I_WO + I_INA1 + I_INA2 + I_INB + I_WOUT;
    constexpr int NITEMS = I_SMALL;
    for (int it = gw; it < NITEMS; it += NGW) {
        int r = it; const float* src; size_t pitch; bf16_t* dst; int nbl; const bool isqkv = it < I_QKV;
        if (r < I_QKV) { src = I.wqkv; pitch = 3072; dst = (bf16_t*)(ws + WS_WQKV); nbl = 48; }
        else if ((r -= I_QKV) < I_WO) { src = I.wo; pitch = 1024; dst = (bf16_t*)(ws + WS_WO); nbl = 16; }
        else if ((r -= I_WO) < I_INA1) { src = I.win; pitch = 3080; dst = (bf16_t*)(ws + WS_WINA); nbl = 16; }
        else if ((r -= I_INA1) < I_INA2) { src = I.win + 2048; pitch = 3080; dst = (bf16_t*)(ws + WS_WINA) + (size_t)1024 * 1024; nbl = 16; }
        else if ((r -= I_INA2) < I_INB) { src = I.win + 512; pitch = 3080; dst = (bf16_t*)(ws + WS_WINB); nbl = 24; }
        else { r -= I_INB; src = I.wout; pitch = 1024; dst = (bf16_t*)(ws + WS_WOUT); nbl = 16; }
        tr_block(src, pitch, dst, 1024, r / nbl, r % nbl, scr, F.lane, isqkv && (r % nbl) < 32);
    }
    if (NCONV == 0) conv_items(F, I.wgu, I.wd, 0, CONV_ITEMS, gw, NGW);
    const int gt = F.vcu * NTHR + F.tid, NGT = F.G * NTHR;
    for (int i = gt; i < NTOK * DM / 8; i += NGT) { const f32x4 a = ((const f32x4*)I.x)[2 * i], b = ((const f32x4*)I.x)[2 * i + 1];
        u32x4 w; w.x = cvt_pk_bf16(a[0], a[1]); w.y = cvt_pk_bf16(a[2], a[3]); w.z = cvt_pk_bf16(b[0], b[1]); w.w = cvt_pk_bf16(b[2], b[3]); ((u32x4*)(ws + WS_XB))[i] = w; }
    for (int i = gt; i < NTOK * 8; i += NGT) { const int tok = i >> 3, f = i & 7; const float inv = powf(500000.0f, -(float)f * 0.125f); const float ang = (float)I.pos[tok] * inv;
        float sn, cs; sincosf(ang, &sn, &cs); float* rp = (float*)(ws + WS_ROPE) + (size_t)tok * 16; rp[f] = cs; rp[8 + f] = sn; }
    for (int i = gt; i < 2 * 32 * 1024; i += NGT) { const int l = i >> 15, e = (i >> 10) & 31, k = i & 1023; ((float*)(ws + WS_RWT))[i] = I.rw[((size_t)l * 1024 + k) * 32 + e]; }
    for (int i = gt; i < 8 * 1024; i += NGT) { const int gidx = i >> 10, k = i & 1023; ((float*)(ws + WS_WG))[i] = I.win[(size_t)k * 3080 + 3072 + gidx]; }
}

__device__ __forceinline__ void phase_ln_router(Frame& F, const bf16_t* __restrict__ z, bf16_t* __restrict__ x1, const float* lng, const float* lnb, const float* rbias, int layer, int cset) {
    unsigned char* ws = F.ws;
    LAS f32x4* rwv = (LAS f32x4*)(F.lds + RING_OFF);
    LAS int* lcnt = (LAS int*)(F.lds + LX_LCNT); LAS int* gbase = (LAS int*)(F.lds + LX_GBASE); LAS int* rec = (LAS int*)(F.lds + LX_REC);
    LAS float* lgb = (LAS float*)(F.lds + LX_LNX);
    { const f32x4* src = (const f32x4*)((const float*)(ws + WS_RWT) + (size_t)layer * 32768);
      for (int i = F.tid; i < 8192; i += NTHR) { const int e = i >> 8, c = i & 255; rwv[e * 256 + (c ^ (e & 15))] = src[i]; } }
    int* toke = (int*)(ws + WS_TOKE); int* tokp = (int*)(ws + WS_TOKP); float* tokg = (float*)(ws + WS_TOKG);
    unsigned short* rowtok = (unsigned short*)(ws + WS_ROWTOK); unsigned char* xb8 = (unsigned char*)(ws + WS_XB);
    unsigned* cntg = F.ctl + CW_CNT + cset * 2048;
    const int lane = F.lane;
    for (int grp = F.vcu; grp < NTOK / 64; grp += F.G) {
        if (F.tid < 32) lcnt[F.tid] = 0;
        for (int i = F.tid; i < 1024; i += NTHR) { lgb[i] = lng[i]; lgb[1024 + i] = lnb[i]; }
        __syncthreads();
#pragma unroll 2
        for (int tk = 0; tk < 8; tk += 2) {
            const int token0 = grp * 64 + F.wave * 8 + tk;
            f32x4 v[2][4]; float s[2] = {0.f, 0.f};
#pragma unroll
            for (int u = 0; u < 2; ++u)
#pragma unroll
                for (int j = 0; j < 4; ++j) { const u32x2 zz = *(const u32x2*)(z + (size_t)(token0 + u) * DM + 4 * lane + 256 * j); v[u][j] = (f32x4){bflo(zz.x), bfhi(zz.x), bflo(zz.y), bfhi(zz.y)}; s[u] += (v[u][j][0] + v[u][j][1]) + (v[u][j][2] + v[u][j][3]); }
#pragma unroll
            for (int o = 1; o < 64; o <<= 1) { const float a0 = __shfl_xor(s[0], o), a1 = __shfl_xor(s[1], o); s[0] += a0; s[1] += a1; }
            float s2[2] = {0.f, 0.f};
#pragma unroll
            for (int u = 0; u < 2; ++u) { const float mean = s[u] * (1.0f / DM);
#pragma unroll
                for (int j = 0; j < 4; ++j) { v[u][j] = v[u][j] - mean; s2[u] += (v[u][j][0] * v[u][j][0] + v[u][j][1] * v[u][j][1]) + (v[u][j][2] * v[u][j][2] + v[u][j][3] * v[u][j][3]); } }
#pragma unroll
            for (int o = 1; o < 64; o <<= 1) { const float a0 = __shfl_xor(s2[0], o), a1 = __shfl_xor(s2[1], o); s2[0] += a0; s2[1] += a1; }
#pragma unroll
            for (int u = 0; u < 2; ++u) { const float rstd = 1.0f / sqrtf(s2[u] * (1.0f / DM) + LN_EPS); const int token = token0 + u;
#pragma unroll
                for (int j = 0; j < 4; ++j) { const f32x4 gvj = *(const LAS f32x4*)(lgb + 4 * lane + 256 * j), bvj = *(const LAS f32x4*)(lgb + 1024 + 4 * lane + 256 * j);
                    const f32x4 y = v[u][j] * rstd * gvj + bvj; { u32x2 wb; wb.x = cvt_pk_bf16(y[0], y[1]); wb.y = cvt_pk_bf16(y[2], y[3]); *(u32x2*)(x1 + (size_t)token * DM + 4 * lane + 256 * j) = wb; }
                    int w8 = __builtin_amdgcn_cvt_pk_fp8_f32(y[0] * FP8_SA, y[1] * FP8_SA, 0, false); w8 = __builtin_amdgcn_cvt_pk_fp8_f32(y[2] * FP8_SA, y[3] * FP8_SA, w8, true);
                    *(int*)(xb8 + (size_t)token * DM + 4 * lane + 256 * j) = w8; } }
        }
        VM_WAIT(); __syncthreads();
        const int tg = F.wave & 3, kh = F.wave >> 2, e0 = lane & 15, kq = lane >> 4;
        f32x4 acc0 = {0.f, 0.f, 0.f, 0.f}, acc1 = acc0;
        { const bf16_t* arow = x1 + (size_t)(grp * 64 + tg * 16 + e0) * DM + kh * 512 + 4 * kq;
#pragma unroll 4
          for (int blk = 0; blk < 32; ++blk) {
              const u32x2 ab = *(const u32x2*)(arow + blk * 16); const f32x4 a4 = {bflo(ab.x), bfhi(ab.x), bflo(ab.y), bfhi(ab.y)}; const int c = ((kh * 512 + blk * 16) >> 2) + kq;
              const f32x4 b0 = rwv[e0 * 256 + (c ^ e0)], b1 = rwv[(16 + e0) * 256 + (c ^ e0)];
#pragma unroll
              for (int j = 0; j < 4; ++j) { acc0 = __builtin_amdgcn_mfma_f32_16x16x4f32(a4[j], b0[j], acc0, 0, 0, 0); acc1 = __builtin_amdgcn_mfma_f32_16x16x4f32(a4[j], b1[j], acc1, 0, 0, 0); } } }
        __syncthreads();
        if (kh == 1) { ((LAS f32x4*)lgb)[(tg * 2 + 0) * 64 + lane] = acc0; ((LAS f32x4*)lgb)[(tg * 2 + 1) * 64 + lane] = acc1; }
        __syncthreads();
        if (kh == 0) {
            acc0 = acc0 + ((LAS f32x4*)lgb)[(tg * 2 + 0) * 64 + lane]; acc1 = acc1 + ((LAS f32x4*)lgb)[(tg * 2 + 1) * 64 + lane];
            const float rb0 = rbias[e0], rb1 = rbias[16 + e0];
#pragma unroll
            for (int r = 0; r < 4; ++r) {
                float l0 = acc0[r] + rb0, l1 = acc1[r] + rb1; float tv[4]; int te[4];
#pragma unroll
                for (int k = 0; k < 4; ++k) { float bvv = (l1 > l0) ? l1 : l0; int be = (l1 > l0) ? 16 + e0 : e0;
#pragma unroll
                    for (int o = 1; o < 16; o <<= 1) { const float ov = __shfl_xor(bvv, o); const int oe = __shfl_xor(be, o); const bool take = (ov > bvv) || (ov == bvv && oe < be); bvv = take ? ov : bvv; be = take ? oe : be; }
                    tv[k] = bvv; te[k] = be; if (be == e0) l0 = -INFINITY; if (be == 16 + e0) l1 = -INFINITY; }
                const float w0 = 1.0f, w1 = __expf(tv[1] - tv[0]), w2 = __expf(tv[2] - tv[0]), w3 = __expf(tv[3] - tv[0]); const float wi = 1.0f / (w0 + w1 + w2 + w3);
                if (e0 < 4) {
                    const int tl = tg * 16 + 4 * kq + r, token = grp * 64 + tl;
                    const int ek = (e0 == 0) ? te[0] : (e0 == 1) ? te[1] : (e0 == 2) ? te[2] : te[3];
                    const float wk = (e0 == 0) ? w0 : (e0 == 1) ? w1 : (e0 == 2) ? w2 : w3;
                    const int li = atomicAdd((int*)(lcnt + ek), 1); rec[tl * 8 + e0] = ek; rec[tl * 8 + 4 + e0] = li;
                    toke[token * 4 + e0] = ek; tokg[token * 4 + e0] = wk * wi;
                }
            }
        }
        __syncthreads();
        if (F.tid < 32) gbase[F.tid] = (int)__hip_atomic_fetch_add(cntg + F.tid * 64, (unsigned)lcnt[F.tid], RLX_AGENT);
        __syncthreads();
        if (F.tid < 256) { const int tl = F.tid >> 2, k = F.tid & 3; const int token = grp * 64 + tl; const int e = rec[tl * 8 + k]; const int pos = gbase[e] + rec[tl * 8 + 4 + k];
            tokp[token * 4 + k] = pos; rowtok[(size_t)e * NTOK + pos] = (unsigned short)token; }
        __syncthreads();
    }
}

__device__ __forceinline__ int moe_tables(Frame& F, int layer) {
    LAS int* tile_e = (LAS int*)(F.lds + LX_TILEE); LAS int* tbase = (LAS int*)(F.lds + LX_TBASE);
    if (F.tid < 64) {
        const int e = F.lane & 31; const int c = (int)__hip_atomic_load(F.ctl + CW_CNT + layer * 2048 + e * 64, RLX_AGENT); const int nt = (F.lane < 32) ? ((c + 255) >> 8) : 0;
        int inc = nt;
#pragma unroll
        for (int o = 1; o < 32; o <<= 1) { const int up = __shfl_up(inc, o); if (F.lane >= o) inc += up; }
        const int t0 = inc - nt;
        if (F.lane < 32) { tbase[e] = t0; for (int i = 0; i < nt; ++i) tile_e[t0 + i] = e; }
        if (F.lane == 31) tbase[32] = inc;
    }
    __syncthreads();
    return tbase[32];
}

template <bool NEXT_MLSTM>
__device__ __forceinline__ void phase_combine(Frame& F, const bf16_t* __restrict__ x1, float* __restrict__ out, const float* lng, const float* lnb, const float* bgates, int layer) {
    unsigned char* ws = F.ws;
    (void)moe_tables(F, layer);
    const LAS int* tbase = (const LAS int*)(F.lds + LX_TBASE);
    const int* toke = (const int*)(ws + WS_TOKE); const int* tokp = (const int*)(ws + WS_TOKP); const float* tokg = (const float*)(ws + WS_TOKG);
    const unsigned char* Y = (const unsigned char*)(ws + WS_Y); bf16_t* xb = (bf16_t*)(ws + WS_XB);
    LAS float* wg = (LAS float*)(F.lds + RING_OFF);
    LAS float* lgb = wg + 8192;
    if constexpr (NEXT_MLSTM) { const f32x4* src = (const f32x4*)(ws + WS_WG); for (int i = F.tid; i < 2048; i += NTHR) ((LAS f32x4*)wg)[i] = src[i];
        for (int i = F.tid; i < 1024; i += NTHR) { lgb[i] = lng[i]; lgb[1024 + i] = lnb[i]; } __syncthreads(); }
    const int lane = F.lane; const int gw = F.vcu * NWAVES + F.wave, NGW = F.G * NWAVES;
    f32x4 gv[4], bv[4];
    if constexpr (!NEXT_MLSTM) {
#pragma unroll
        for (int j = 0; j < 4; ++j) { gv[j] = *(const f32x4*)(lng + 4 * lane + 256 * j); bv[j] = *(const f32x4*)(lnb + 4 * lane + 256 * j); } }
    constexpr int NTK = 2;
    int rowv = 0; float gatev = 0.f;
    { const int mt = gw + (lane >> 2) * NGW; if (mt < NTOK) { const int ee = toke[mt * 4 + (lane & 3)]; rowv = tbase[ee] * 256 + tokp[mt * 4 + (lane & 3)]; gatev = tokg[mt * 4 + (lane & 3)] * (DBG_MOE_MUL / FP8_SY); } }
    int it = 0;
    for (int token0 = gw; token0 < NTOK; token0 += NTK * NGW, ++it) {
        f32x4 vv[NTK][4];
#pragma unroll
        for (int u = 0; u < NTK; ++u) { const int token = token0 + u * NGW; if (token < NTOK) {
#pragma unroll
            for (int j = 0; j < 4; ++j) { const u32x2 xx = *(const u32x2*)(x1 + (size_t)token * DM + 4 * lane + 256 * j); vv[u][j] = (f32x4){bflo(xx.x), bfhi(xx.x), bflo(xx.y), bfhi(xx.y)} * ALPHA; }
#pragma unroll
            for (int k = 0; k < 4; ++k) { const int sl = (it * NTK + u) * 4 + k; const size_t row = (size_t)__builtin_amdgcn_readlane(rowv, sl); const float gt = __int_as_float(__builtin_amdgcn_readlane(__float_as_int(gatev), sl));
#pragma unroll
                for (int j = 0; j < 4; ++j) { const int y = *(const int*)(Y + row * DM + 4 * lane + 256 * j); const f32x2 lo = __builtin_amdgcn_cvt_pk_f32_fp8(y, false), hi = __builtin_amdgcn_cvt_pk_f32_fp8(y, true);
                    vv[u][j][0] += gt * lo[0]; vv[u][j][1] += gt * lo[1]; vv[u][j][2] += gt * hi[0]; vv[u][j][3] += gt * hi[1]; } } } }
#pragma unroll
        for (int u = 0; u < NTK; ++u) { const int token = token0 + u * NGW; if (token < NTOK) {
        f32x4 v[4];
#pragma unroll
        for (int j = 0; j < 4; ++j) v[j] = vv[u][j];
        float s = 0.f;
#pragma unroll
        for (int j = 0; j < 4; ++j) s += (v[j][0] + v[j][1]) + (v[j][2] + v[j][3]);
        const float mean = wave_sum(s) * (1.0f / DM); float s2 = 0.f;
#pragma unroll
        for (int j = 0; j < 4; ++j) { v[j] = v[j] - mean; s2 += (v[j][0] * v[j][0] + v[j][1] * v[j][1]) + (v[j][2] * v[j][2] + v[j][3] * v[j][3]); }
        const float rstd = 1.0f / sqrtf(wave_sum(s2) * (1.0f / DM) + LN_EPS);
#pragma unroll
        for (int j = 0; j < 4; ++j) { if constexpr (NEXT_MLSTM) { gv[j] = *(const LAS f32x4*)(lgb + 4 * lane + 256 * j); bv[j] = *(const LAS f32x4*)(lgb + 1024 + 4 * lane + 256 * j); }
            v[j] = v[j] * rstd * gv[j] + bv[j]; if constexpr (!NEXT_MLSTM) *(f32x4*)(out + (size_t)token * DM + 4 * lane + 256 * j) = v[j]; }
        if constexpr (NEXT_MLSTM) {
#pragma unroll
            for (int j = 0; j < 4; ++j) { u32x2 w; w.x = cvt_pk_bf16(v[j][0], v[j][1]); w.y = cvt_pk_bf16(v[j][2], v[j][3]); *(u32x2*)(xb + (size_t)token * DM + 4 * lane + 256 * j) = w; }
            float gp[8];
#pragma unroll
            for (int gi = 0; gi < 8; ++gi) { float a = 0.f;
#pragma unroll
                for (int j = 0; j < 4; ++j) { const f32x4 w = *(const LAS f32x4*)(wg + gi * 1024 + 4 * lane + 256 * j); a += (v[j][0] * w[0] + v[j][1] * w[1]) + (v[j][2] * w[2] + v[j][3] * w[3]); }
                gp[gi] = a; if (gi & 1) asm volatile("" ::: "memory"); }
#pragma unroll
            for (int o = 1; o < 64; o <<= 1) {
#pragma unroll
                for (int gi = 0; gi < 8; ++gi) gp[gi] += __shfl_xor(gp[gi], o); }
#pragma unroll
            for (int gi = 0; gi < 8; ++gi) gp[gi] += bgates[gi];
            if (lane == 0) {
#pragma unroll
                for (int hh = 0; hh < 4; ++hh) { ((float*)(ws + WS_GI))[(size_t)hh * NTOK + token] = gp[hh];
                    const float f = gp[4 + hh]; const float lf = (f >= 0.f) ? -log1pf(__expf(-f)) : (f - log1pf(__expf(f)));
                    ((float*)(ws + WS_LF))[(size_t)hh * NTOK + token] = lf; } }
        }
        } }
    }
}

__device__ __forceinline__ void phase_gate_scan(Frame& F) {
    unsigned char* ws = F.ws; const int lane = F.lane; const int gw = F.vcu * NWAVES + F.wave, NGW = F.G * NWAVES;
    for (int mu = gw; mu < 256; mu += NGW) {
        const int b = mu >> 6, hh = (mu >> 4) & 3, ch = mu & 15; const size_t base = (size_t)hh * NTOK + (size_t)b * SEQ + ch * 256 + 4 * lane;
        const f32x4 lf = *(const f32x4*)((const float*)(ws + WS_LF) + base), gi = *(const f32x4*)((const float*)(ws + WS_GI) + base);
        f32x4 c; c[0] = lf[0]; c[1] = c[0] + lf[1]; c[2] = c[1] + lf[2]; c[3] = c[2] + lf[3];
        float tot = c[3];
#pragma unroll
        for (int o = 1; o < 64; o <<= 1) { const float up = __shfl_up(tot, o); if (lane >= o) tot += up; }
        const float excl = tot - c[3];
        f32x4 rf, cf;
#pragma unroll
        for (int j = 0; j < 4; ++j) { const float bt = excl + c[j]; rf[j] = __expf(bt); cf[j] = __expf(gi[j] - bt); }
        *(f32x4*)((float*)(ws + WS_RF) + base) = rf; *(f32x4*)((float*)(ws + WS_CF) + base) = cf;
        if (lane == 63) ((float*)(ws + WS_DEC))[mu] = __expf(tot);
    }
}
__device__ __forceinline__ void phase_nu(Frame& F) {
    unsigned char* ws = F.ws; const int lane = F.lane; const int gw = F.vcu * NWAVES + F.wave, NGW = F.G * NWAVES;
    const bf16_t* KT = (const bf16_t*)(ws + WS_KT); float* NU = (float*)(ws + WS_NU);
    for (int r0 = gw * 16; r0 < 256 * 128; r0 += NGW * 16) {
        const int mu = r0 >> 7, d0 = r0 & 127, b = mu >> 6, hh = (mu >> 4) & 3, ch = mu & 15;
        const bf16_t* base = KT + (size_t)(hh * 128 + d0) * NTOK + (size_t)b * SEQ + ch * 256 + 4 * lane;
        u32x2 kv[16];
#pragma unroll
        for (int i = 0; i < 16; ++i) kv[i] = *(const u32x2*)(base + (size_t)i * NTOK);
        float s[16];
#pragma unroll
        for (int i = 0; i < 16; ++i) s[i] = (bflo(kv[i].x) + bfhi(kv[i].x)) + (bflo(kv[i].y) + bfhi(kv[i].y));
#pragma unroll
        for (int o = 1; o < 64; o <<= 1) {
#pragma unroll
            for (int i = 0; i < 16; ++i) s[i] += __shfl_xor(s[i], o); }
        float mine = s[0];
#pragma unroll
        for (int i = 1; i < 16; ++i) mine = (lane == i) ? s[i] : mine;
        if (lane < 16) NU[r0 + lane] = mine;
    }
}
__device__ __forceinline__ void phase_state_scan(Frame& F) {
    unsigned char* ws = F.ws; const int gt = F.vcu * NTHR + F.tid, NGT = F.G * NTHR;
    const bf16_t* UT = (const bf16_t*)(ws + WS_UT); const float* DEC = (const float*)(ws + WS_DEC); bf16_t* BE = (bf16_t*)(ws + WS_BE);
    for (int i = gt; i < 16 * 256 * 32; i += NGT) { const int bh = i >> 13, e = (i >> 5) & 255, dg = i & 31;
        f32x4 U[16]; float dc[16];
#pragma unroll
        for (int ch = 0; ch < 16; ++ch) { const size_t mu = (size_t)bh * 16 + ch; { const u32x2 uu = *(const u32x2*)(UT + (mu * 256 + e) * 128 + 4 * dg); U[ch] = (f32x4){bflo(uu.x), bfhi(uu.x), bflo(uu.y), bfhi(uu.y)}; } dc[ch] = DEC[mu]; }
        f32x4 C = {0.f, 0.f, 0.f, 0.f};
#pragma unroll
        for (int ch = 0; ch < 16; ++ch) { const size_t mu = (size_t)bh * 16 + ch;
            u32x2 w; w.x = cvt_pk_bf16(C[0], C[1]); w.y = cvt_pk_bf16(C[2], C[3]);
#ifdef DBG_NO_INTER
            w.x = 0u; w.y = 0u;
#endif
            *(u32x2*)(BE + (mu * 256 + e) * 384 + 256 + 4 * dg) = w;
            C = (C + U[ch]) * dc[ch]; } }
    const float* NU = (const float*)(ws + WS_NU); float* NP = (float*)(ws + WS_NPREV);
    for (int i = gt; i < 16 * 128; i += NGT) { const int bh = i >> 7, d = i & 127; float n = 0.f;
        for (int ch = 0; ch < 16; ++ch) { const int mu = bh * 16 + ch; NP[mu * 128 + d] = n; n = (n + NU[mu * 128 + d]) * DEC[mu];
#ifdef DBG_NO_INTER
            n = 0.f;
#endif
        } }
}
struct Args { const float* in[18]; float* out; unsigned char* ws; int ph_lo, ph_hi; };
__global__ void __launch_bounds__(NTHR, 2) mk_fwd(Args args) {
    extern __shared__ __attribute__((aligned(16))) unsigned char lds[];
    Frame F;
    const char __attribute__((address_space(4)))* kargp = (const char __attribute__((address_space(4)))*)__builtin_amdgcn_kernarg_segment_ptr();
#define AIN(i) ({ const char __attribute__((address_space(4)))* k_ = kargp; asm volatile("" : "+s"(k_)); *(const float* const __attribute__((address_space(4)))*)(k_ + 8 * (i)); })
    unsigned char* const ws0 = (unsigned char*)AIN(19);
    F.lds = (LAS unsigned char*)lds; F.ws = ws0; F.ctl = (unsigned*)(ws0 + WS_CTL);
    F.tid = threadIdx.x; F.lane = F.tid & 63; F.wave = __builtin_amdgcn_readfirstlane(F.tid >> 6);
    F.G = gridDim.x; { const int bx = blockIdx.x; F.vcu = (F.G % 8 == 0) ? (bx % 8) * (F.G / 8) + bx / 8 : bx; }
    for (int u = F.tid; u < (LDS_BYTES - LX) / 4; u += NTHR) ((LAS unsigned*)(F.lds + LX))[u] = 0u;
    __syncthreads();
    int lo, hi; { const char __attribute__((address_space(4)))* k_ = kargp; lo = *(const int __attribute__((address_space(4)))*)(k_ + 160); hi = *(const int __attribute__((address_space(4)))*)(k_ + 164); }
    XcdBarrier bar; bar.bar = (unsigned*)(F.ctl + CW_BAR); bar.x = 0; bar.st = nullptr;
    if (hi - lo > 1) bar = xcd_barrier_post((unsigned*)(F.ctl + CW_BAR), (volatile LAS unsigned*)(F.lds + LX_MISC) + 8);
#ifndef PHASE_MASK
#define PHASE_MASK 0x7FFFF
#endif
#define IN(k) ((((PHASE_MASK) >> (k)) & 1) && lo <= (k) && (k) < hi)
#ifndef REPEAT_MASK
#define REPEAT_MASK 0
#endif
#define PH(k) if (IN(k))
#define SEAM(k) do { if (IN(k) && IN((k) + 1)) xcd_barrier(bar); } while (0)
    unsigned char* ws = ws0;
#define x_in AIN(0)
#define ln_mix_g AIN(8)
#define ln_mix_b AIN(9)
#define ln_ffn_g AIN(10)
#define ln_ffn_b AIN(11)
#define router_b AIN(13)
#define b_gu AIN(15)
#define b_dn AIN(17)
    bf16_t* XB = (bf16_t*)(ws + WS_XB); bf16_t* QB_ = (bf16_t*)(ws + WS_Q); bf16_t* KB_ = (bf16_t*)(ws + WS_K); bf16_t* VB_ = (bf16_t*)(ws + WS_V);
    bf16_t* R0 = (bf16_t*)(ws + WS_R0); bf16_t* R1 = (bf16_t*)(ws + WS_R1);
    bf16_t* HB = (bf16_t*)(ws + WS_H); bf16_t* YB = (bf16_t*)(ws + WS_Y);
    LAS unsigned char* ring = F.lds + RING_OFF;
    const int cG = (int)blockIdx.x;
    const bool isConv = (NCONV > 0) && ((int)blockIdx.x >= F.G - NCONV);
    const int Gc = F.G - NCONV, cwv = ((int)blockIdx.x - Gc) * NWAVES + F.wave, ncw = NCONV * NWAVES;
#define CONV_SLICE(a, b) conv_items(F, AIN(14), AIN(16), (int)((long)CONV_ITEMS * (a) / 1000), (int)((long)CONV_ITEMS * (b) / 1000), cwv, ncw)

    PH(0) { P0In I{x_in, AIN(2), AIN(3), AIN(4), AIN(7), AIN(12), AIN(14), AIN(16), (const int*)AIN(1)}; p0_prologue(F, I); }
    SEAM(0);
    PH(1) { { Gemm g{1024, 1024, 1024, nullptr}; DenseSched S{64, 12, F.G, cG, (const char*)XB, (const char*)(ws + WS_WQKV), (size_t)256 * 1024 * 2, (size_t)256 * 1024 * 2};
        EpiQKV E{QB_, KB_, VB_, (const float*)(ws + WS_ROPE), (float*)(ws + WS_KSUM), (LAS float*)(F.lds + LX_ROPE)};
        pg8::gemm_phase<EpiQKV, DenseSched, true, false>(ring, g, S, E); } }
    SEAM(1);
    PH(2) { if (isConv) CONV_SLICE(0, 1000); else {
        const attn_body::AttnTensors AT{(const attn_body::bf16*)QB_, (const attn_body::bf16*)KB_, (const attn_body::bf16*)VB_, (attn_body::bf16*)QB_, (const float*)(ws + WS_KSUM)};
        if (NCONV == 0) { const attn_body::StaticOrder S((int)F.G, (int)blockIdx.x); attn_body::attn_phase<attn_body::StaticOrder>((char*)lds + RING_OFF, AT, S); }
        else { const attn_body::SnakeOrder S{cG, Gc}; attn_body::attn_phase<attn_body::SnakeOrder>((char*)lds + RING_OFF, AT, S); } } }
    SEAM(2);
    PH(3) { { Gemm g{1024, 1024, 1024, nullptr}; DenseSched S{64, 4, F.G, cG, (const char*)QB_, (const char*)(ws + WS_WO), (size_t)256 * 1024 * 2, (size_t)256 * 1024 * 2};
        EpiZ E{XB, R0, DBG_ATTN_MUL}; pg8::gemm_phase<EpiZ, DenseSched, true, false>(ring, g, S, E); } }
    SEAM(3);
    PH(4) phase_ln_router(F, R0, R1, ln_mix_g, ln_mix_b, router_b, 0, 0);
    SEAM(4);
    PH(5) { const int nT = moe_tables(F, 0); LAS unsigned short* tokl = (LAS unsigned short*)(F.lds + LX_TOKL);
        { const unsigned short* rowtok = (const unsigned short*)(ws + WS_ROWTOK); const LAS int* tile_e = (const LAS int*)(F.lds + LX_TILEE); const LAS int* tbase = (const LAS int*)(F.lds + LX_TBASE);
          for (int i = 0; i < TOKL_ROUNDS; ++i) { int pm, pn, hf; if (!moe_unit(i, F.G, cG, nT, 8, pm, pn, hf)) break;
              if (F.tid < 256) { const int e = tile_e[pm]; const int r = (pm - tbase[e]) * 256 + F.tid; const int c = (int)__hip_atomic_load(F.ctl + CW_CNT + 0 * 2048 + e * 64, RLX_AGENT);
                  tokl[i * 256 + F.tid] = (r < c) ? rowtok[(size_t)e * NTOK + r] : (unsigned short)0; } }
          __syncthreads(); }
        Gemm g{512, 512, 512, (const char*)XB};
        MoeSched S{nT, 8, F.G, cG, (const LAS int*)(F.lds + LX_TILEE), (const LAS int*)(F.lds + LX_TBASE), tokl, nullptr, (const char*)(ws + WS_WGU) + (size_t)0 * 32 * 2048 * 1024, 0, (size_t)2048 * 1024, (size_t)256 * 1024};
        EpiGU E{b_gu + (size_t)0 * 32 * 2048, (unsigned char*)HB, (LAS float*)(F.lds + LX_BIAS), 0}; pg8::gemm_phase<EpiGU, MoeSched, true, true, true, true>(ring, g, S, E); }
    SEAM(5);
    PH(6) { const int nT = moe_tables(F, 0); Gemm g{512, 512, 512, nullptr};
        MoeSched S{nT, 4, F.G, cG, (const LAS int*)(F.lds + LX_TILEE), (const LAS int*)(F.lds + LX_TBASE), nullptr, (const char*)HB, (const char*)(ws + WS_WD) + (size_t)0 * 32 * 1024 * 1024, (size_t)256 * 1024, (size_t)1024 * 1024, (size_t)256 * 1024};
        EpiDN E{b_dn + (size_t)0 * 32 * 1024, (unsigned char*)YB, (LAS float*)(F.lds + LX_BIAS), 0}; pg8::gemm_phase<EpiDN, MoeSched, true, false, true, true>(ring, g, S, E); }
    SEAM(6);
    PH(7) phase_combine<true>(F, R1, nullptr, ln_ffn_g, ln_ffn_b, AIN(5), 0);
    { F.lane = (int)attn_body::lane_now(); F.tid = F.wave * 64 + F.lane; }
    SEAM(7);
    PH(8) phase_gate_scan(F);
    SEAM(8);
    PH(9) {
        { Gemm g{1024, 1024, 1024, nullptr}; DenseSched S{64, 8, F.G, cG, (const char*)XB, (const char*)(ws + WS_WINA), (size_t)256 * 1024 * 2, (size_t)256 * 1024 * 2};
          EpiINA E{(const float*)(ws + WS_RF), (const float*)(ws + WS_CF), (bf16_t*)(ws + WS_AE), (bf16_t*)(ws + WS_KN), (bf16_t*)(ws + WS_OS)};
          pg8::gemm_phase<EpiINA, DenseSched, true, false>(ring, g, S, E); }
        { Gemm g{1024, 1024, 1024, nullptr}; DenseSched S{6, 64, F.G, cG, (const char*)(ws + WS_WINB), (const char*)XB, (size_t)256 * 1024 * 2, (size_t)256 * 1024 * 2, true};
          EpiINB E{(const float*)(ws + WS_CF), (bf16_t*)(ws + WS_KT), (bf16_t*)(ws + WS_BE)};
          pg8::gemm_phase<EpiINB, DenseSched, true, false, false, true>(ring, g, S, E); }
    }
    SEAM(9);
    PH(10) { Gemm g{256, 384, NTOK, nullptr}; MuSched S{F.G, cG, 0, (const char*)(ws + WS_BE), (const char*)(ws + WS_KT)};
        EpiM1 E{(bf16_t*)(ws + WS_UT)}; pg8::gemm_phase<EpiM1, MuSched, true, false, false, true>(ring, g, S, E);
        phase_nu(F); }
    SEAM(10);
    PH(11) phase_state_scan(F);
    SEAM(11);
    PH(12) { Gemm g{128, 512, 1024, nullptr}; MuSched S{F.G, cG, 1, (const char*)(ws + WS_AE), (const char*)(ws + WS_KN)};
        EpiM2A E{(bf16_t*)(ws + WS_AE), (const float*)(ws + WS_NPREV), (float*)(ws + WS_DEN)}; pg8::gemm_phase<EpiM2A, MuSched, true, false>(ring, g, S, E); }
    SEAM(12);
    PH(13) { Gemm g{384, 512, 384, nullptr}; MuSched S{F.G, cG, 2, (const char*)(ws + WS_AE), (const char*)(ws + WS_BE)};
        EpiM2B E{(const float*)(ws + WS_DEN), AIN(6), (const bf16_t*)(ws + WS_OS), (bf16_t*)(ws + WS_HN), (LAS float*)(F.lds + LX_LNX)};
        pg8::gemm_phase<EpiM2B, MuSched, true, false>(ring, g, S, E); }
    SEAM(13);
    PH(14) { Gemm g{1024, 1024, 1024, nullptr}; DenseSched S{64, 4, F.G, cG, (const char*)(ws + DBG_P14_A), (const char*)(ws + WS_WOUT), (size_t)256 * 1024 * 2, (size_t)256 * 1024 * 2};
        EpiZ E{XB, R0, DBG_MLSTM_MUL}; pg8::gemm_phase<EpiZ, DenseSched, true, false>(ring, g, S, E); }
    SEAM(14);
    PH(15) phase_ln_router(F, R0, R1, ln_mix_g + 1024, ln_mix_b + 1024, router_b + 32, 1, 1);
    SEAM(15);
    PH(16) { const int nT = moe_tables(F, 1); LAS unsigned short* tokl = (LAS unsigned short*)(F.lds + LX_TOKL);
        { const unsigned short* rowtok = (const unsigned short*)(ws + WS_ROWTOK); const LAS int* tile_e = (const LAS int*)(F.lds + LX_TILEE); const LAS int* tbase = (const LAS int*)(F.lds + LX_TBASE);
          for (int i = 0; i < TOKL_ROUNDS; ++i) { int pm, pn, hf; if (!moe_unit(i, F.G, cG, nT, 8, pm, pn, hf)) break;
              if (F.tid < 256) { const int e = tile_e[pm]; const int r = (pm - tbase[e]) * 256 + F.tid; const int c = (int)__hip_atomic_load(F.ctl + CW_CNT + 1 * 2048 + e * 64, RLX_AGENT);
                  tokl[i * 256 + F.tid] = (r < c) ? rowtok[(size_t)e * NTOK + r] : (unsigned short)0; } }
          __syncthreads(); }
        Gemm g{512, 512, 512, (const char*)XB};
        MoeSched S{nT, 8, F.G, cG, (const LAS int*)(F.lds + LX_TILEE), (const LAS int*)(F.lds + LX_TBASE), tokl, nullptr, (const char*)(ws + WS_WGU) + (size_t)1 * 32 * 2048 * 1024, 0, (size_t)2048 * 1024, (size_t)256 * 1024};
        EpiGU E{b_gu + (size_t)1 * 32 * 2048, (unsigned char*)HB, (LAS float*)(F.lds + LX_BIAS), 0}; pg8::gemm_phase<EpiGU, MoeSched, true, true, true, true>(ring, g, S, E); }
    SEAM(16);
    PH(17) { const int nT = moe_tables(F, 1); Gemm g{512, 512, 512, nullptr};
        MoeSched S{nT, 4, F.G, cG, (const LAS int*)(F.lds + LX_TILEE), (const LAS int*)(F.lds + LX_TBASE), nullptr, (const char*)HB, (const char*)(ws + WS_WD) + (size_t)1 * 32 * 1024 * 1024, (size_t)256 * 1024, (size_t)1024 * 1024, (size_t)256 * 1024};
        EpiDN E{b_dn + (size_t)1 * 32 * 1024, (unsigned char*)YB, (LAS float*)(F.lds + LX_BIAS), 0}; pg8::gemm_phase<EpiDN, MoeSched, true, false, true, true>(ring, g, S, E); }
    SEAM(17);
    PH(18) phase_combine<false>(F, R1, (float*)AIN(18), ln_ffn_g + 1024, ln_ffn_b + 1024, nullptr, 1);
#undef IN
#undef CONV_SLICE
#undef AIN
#undef x_in
#undef ln_mix_g
#undef ln_mix_b
#undef ln_ffn_g
#undef ln_ffn_b
#undef router_b
#undef b_gu
#undef b_dn
#undef SEAM
}

extern "C" void kernel_launch(void* const* d_in, const int* in_sizes, int n_in, void* d_out, int out_size, void* d_ws, size_t ws_size, hipStream_t stream) {
    static int grid = 0;
    if (grid == 0) {
        if (n_in != 18 || out_size != NTOK * DM || ws_size < WS_END) { fprintf(stderr, "kernel_launch: unexpected problem shape (n_in %d, out %d, ws %zu)\n", n_in, out_size, ws_size); grid = -1; return; }
        int dev = 0, cus = 0, per_cu = 0;
        if (hipGetDevice(&dev) != hipSuccess || hipDeviceGetAttribute(&cus, hipDeviceAttributeMultiprocessorCount, dev) != hipSuccess) { grid = -1; return; }
        if (hipFuncSetAttribute((const void*)mk_fwd, hipFuncAttributeMaxDynamicSharedMemorySize, LDS_BYTES) != hipSuccess) { fprintf(stderr, "kernel_launch: hipFuncSetAttribute failed\n"); grid = -1; return; }
        if (hipOccupancyMaxActiveBlocksPerMultiprocessor(&per_cu, (const void*)mk_fwd, NTHR, LDS_BYTES) != hipSuccess || per_cu < 1) fprintf(stderr, "kernel_launch: occupancy query reports %d\n", per_cu);
        (void)hipGetLastError();
        grid = cus;
        if (grid > 256) grid = 256;
        if (grid < 240) { fprintf(stderr, "kernel_launch: %d CUs: this build needs 240..256\n", cus); grid = -1; return; }
    }
    if (grid < 0) return;
    if (hipMemsetAsync((char*)d_ws + WS_CTL, 0, CTL_ZERO_BYTES, stream) != hipSuccess) return;
    Args a{};
    for (int i = 0; i < 18; ++i) a.in[i] = (const float*)d_in[i];
    a.out = (float*)d_out; a.ws = (unsigned char*)d_ws;
#if MK_ONE_LAUNCH
    a.ph_lo = 0; a.ph_hi = NPHASE;
    hipLaunchKernelGGL(mk_fwd, dim3(grid), dim3(NTHR), LDS_BYTES, stream, a);
#else
    for (int p = 0; p < NPHASE; ++p) { a.ph_lo = p; a.ph_hi = p + 1; hipLaunchKernelGGL(mk_fwd, dim3(grid), dim3(NTHR), LDS_BYTES, stream, a); }
#endif
}
```

```cpp
#include <hip/hip_runtime.h>
#include <hip/hip_bf16.h>
#include <cstdio>
#include <cstdint>
#include <cmath>

#define LAS __attribute__((address_space(3)))
#define GAS __attribute__((address_space(1)))
typedef unsigned short bf16_t;
typedef short bf16x8 __attribute__((ext_vector_type(8)));
typedef float f32x4 __attribute__((ext_vector_type(4)));
typedef float f32x2 __attribute__((ext_vector_type(2)));
typedef unsigned u32x4 __attribute__((ext_vector_type(4)));
typedef unsigned u32x2 __attribute__((ext_vector_type(2)));
typedef int i32x4 __attribute__((ext_vector_type(4)));
typedef int i32x8 __attribute__((ext_vector_type(8)));

typedef __bf16 bf16x2_t __attribute__((ext_vector_type(2)));
__device__ __forceinline__ unsigned cvt_pk_bf16(float lo, float hi) { const f32x2 v = {lo, hi}; const bf16x2_t b = __builtin_convertvector(v, bf16x2_t); return __builtin_bit_cast(unsigned, b); }
__device__ __forceinline__ float bf2f(unsigned short b) { return __uint_as_float(((unsigned)b) << 16); }
__device__ __forceinline__ float bflo(unsigned w) { return __uint_as_float(w << 16); }
__device__ __forceinline__ float bfhi(unsigned w) { return __uint_as_float(w & 0xffff0000u); }

__device__ __forceinline__ void glds16s(const void* sbase, unsigned voff, unsigned lds_dst) { unsigned keep;
    asm volatile("s_nop 4\n\ts_mov_b32 %0, m0\n\ts_mov_b32 m0, %3\n\ts_nop 0\n\tglobal_load_lds_dwordx4 %1, %2\n\ts_mov_b32 m0, %0" : "=&s"(keep) : "v"(voff), "s"(sbase), "s"(lds_dst) : "memory"); }
__device__ __forceinline__ void glds4s(const void* sbase, unsigned voff, unsigned lds_dst) { unsigned keep;
    asm volatile("s_nop 4\n\ts_mov_b32 %0, m0\n\ts_mov_b32 m0, %3\n\ts_nop 0\n\tglobal_load_lds_dword %1, %2\n\ts_mov_b32 m0, %0" : "=&s"(keep) : "v"(voff), "s"(sbase), "s"(lds_dst) : "memory"); }
__device__ __forceinline__ const char* uni_ptr(const char* p) { const unsigned long long v = (unsigned long long)p; const unsigned lo = __builtin_amdgcn_readfirstlane((unsigned)v), hi = __builtin_amdgcn_readfirstlane((unsigned)(v >> 32)); return (const char*)(((unsigned long long)hi << 32) | lo); }
namespace pg8 {
constexpr int BM = 256, BK = 64, HALF = 128, HTB = HALF * BK * 2, STAGE_BYTES = 8 * HTB, NXCD = 8, WGM = 8;
__host__ __device__ __forceinline__ int lds_byte(int r, int c) { const int st = (r >> 4) * 2 + (c >> 5), rr = r & 15, cc = c & 31, ob = rr * 64 + cc * 2; return st * 1024 + (ob ^ (((ob >> 9) & 1) << 5)); }
__host__ __device__ __forceinline__ void stage_rc(int b, int& R, int& C) { const int st = b / 1024, sb = b % 1024, swz = sb ^ (((sb >> 9) & 1) << 5); R = (st >> 1) * 16 + swz / 64; C = (st & 1) * 32 + (swz % 64) / 2; }
__host__ __device__ __forceinline__ int perm32(int rho) { const int n = rho >> 4, i = rho & 15; return 8 * (i >> 2) + 4 * n + (i & 3); }

struct Unit { int pm, pn; const char* A; const char* B; const LAS unsigned short* tl; int x0, x1, x2; };
struct Gemm { int K, lda, ldb; const char* Abase; };

__device__ __forceinline__ bool tile_order(int i, int G, int c, int nM, int nN, int& pm, int& pn) {
    const int nwg = nM * nN; const long L = (long)i * G + c; if (L >= nwg) return false;
    int wgid = (int)L; { const int q = nwg / NXCD, r = nwg % NXCD, xcd = wgid % NXCD, off = wgid / NXCD; wgid = (xcd < r ? xcd * (q + 1) : r * (q + 1) + (xcd - r) * q) + off; }
    const int nig = WGM * nN, gid = wgid / nig, fm = gid * WGM, gsz = (nM - fm) < WGM ? (nM - fm) : WGM;
    pm = fm + ((wgid % nig) % gsz); pn = (wgid % nig) / gsz; return true;
}

template <class Epi, class Sched, bool ALIGN_EPI, bool GATHER, bool FP8 = false, bool HALFSEL = false>
__device__ __forceinline__ void gemm_phase(LAS unsigned char* lds, const Gemm g, const Sched& S, const Epi& E) {
    const int tid = threadIdx.x, wid = __builtin_amdgcn_readfirstlane(tid >> 6), lane = tid & 63, wr = wid >> 2, wc = wid & 3, fr = lane & 15, fq = lane >> 4;
    const int K = g.K, nt = K / BK;
    int RA[2]; unsigned cA2[2], voffB[2];
#pragma unroll
    for (int i = 0; i < 2; ++i) { int R, C; stage_rc(tid * 16 + i * 8192, R, C); const int Rb = Epi::PERM ? ((R & ~31) + perm32(R & 31)) : R;
        RA[i] = R; cA2[i] = (unsigned)C * 2u; voffB[i] = (unsigned)(Rb * g.ldb + C) * 2u; }
    const size_t kstep = (size_t)(BK * 2);
    const unsigned hstepA = (unsigned)HALF * (unsigned)g.lda * 2u; const size_t hstepB = (size_t)HALF * g.ldb * 2;
    const unsigned ldsb = (unsigned)__builtin_amdgcn_readfirstlane((unsigned)(unsigned long long)lds + (unsigned)wid * 1024u);
    const int aoff = lds_byte(wr * 64 + fr, fq * 8), boff = lds_byte(wc * 32 + fr, fq * 8);
    const int aoff2 = aoff + 1024, boff2 = boff + 1024;
#define PG8_SA(b, h) (((b) * 2 + (h)) * HTB)
#define PG8_SB(b, h) ((4 + (b) * 2 + (h)) * HTB)
#define PG8_STAGE(bufoff, gbase, voff) do { _Pragma("unroll") for (int _i = 0; _i < 2; ++_i) glds16s((gbase), (voff)[_i], ldsb + (unsigned)(bufoff) + _i * 8192u); } while (0)
#define PG8_STAGE_A(bufoff, gbase, AO, h) do { _Pragma("unroll") for (int _i = 0; _i < 2; ++_i) glds16s((gbase), (AO)[h][_i], ldsb + (unsigned)(bufoff) + _i * 8192u); } while (0)
#define PG8_LD8(base_, o1_, o2_) __builtin_shufflevector(*(const LAS i32x4*)(lds + (base_) + (o1_)), *(const LAS i32x4*)(lds + (base_) + (o2_)), 0, 1, 2, 3, 4, 5, 6, 7)
#define PG8_LDA(dst, b, h) do { if constexpr (FP8) { _Pragma("unroll") for (int m = 0; m < 4; ++m) dst##8[m] = PG8_LD8(PG8_SA(b, h) + m * 2048, aoff, aoff2); } \
        else { _Pragma("unroll") for (int m = 0; m < 4; ++m) _Pragma("unroll") for (int k = 0; k < 2; ++k) dst[m][k] = *(const LAS bf16x8*)(lds + PG8_SA(b, h) + aoff + m * 2048 + k * 1024); } } while (0)
#define PG8_LDB(dst, b, h) do { if constexpr (FP8) { _Pragma("unroll") for (int n = 0; n < 2; ++n) dst##8[n] = PG8_LD8(PG8_SB(b, h) + n * 2048, boff, boff2); } \
        else { _Pragma("unroll") for (int n = 0; n < 2; ++n) _Pragma("unroll") for (int k = 0; k < 2; ++k) dst[n][k] = *(const LAS bf16x8*)(lds + PG8_SB(b, h) + boff + n * 2048 + k * 1024); } } while (0)
#define PG8_MMA(ai, bj, At, Bt) do { __builtin_amdgcn_s_setprio(1); _Pragma("unroll") for (int m = 0; m < 4; ++m) _Pragma("unroll") for (int n = 0; n < 2; ++n) { \
        if constexpr (FP8) asm volatile("v_mfma_f32_16x16x128_f8f6f4 %0, %1, %2, %0" : "+v"(acc[ai][bj][m][n]) : "v"(Bt##8[n]), "v"(At##8[m])); \
        else { _Pragma("unroll") for (int k = 0; k < 2; ++k) acc[ai][bj][m][n] = __builtin_amdgcn_mfma_f32_16x16x32_bf16(Bt[n][k], At[m][k], acc[ai][bj][m][n], 0, 0, 0); } } \
        __builtin_amdgcn_s_setprio(0); } while (0)
#define PG8_WAIT_V(n) asm volatile("s_waitcnt vmcnt(" #n ")" ::: "memory")
#define PG8_WAIT_L(n) asm volatile("s_waitcnt lgkmcnt(" #n ")" ::: "memory")
#define PG8_BAR __builtin_amdgcn_s_barrier()
#define PG8_SCHED __builtin_amdgcn_sched_barrier(0)
#define PG8_AOFF(AO, U) do { _Pragma("unroll") for (int _h = 0; _h < 2; ++_h) _Pragma("unroll") for (int _i = 0; _i < 2; ++_i) { \
        if constexpr (GATHER) AO[_h][_i] = (unsigned)(U).tl[RA[_i] + _h * HALF] * (unsigned)(g.lda * 2) + cA2[_i]; \
        else AO[_h][_i] = (unsigned)RA[_i] * (unsigned)(g.lda * 2) + cA2[_i] + (unsigned)_h * hstepA; } } while (0)
    Unit cur, nxt; int ui = 0;
    if (!S.next(0, cur)) return;
    f32x4 acc[2][2][4][2];
#pragma unroll
    for (int a = 0; a < 2; ++a)
#pragma unroll
        for (int b = 0; b < 2; ++b)
#pragma unroll
            for (int m = 0; m < 4; ++m)
#pragma unroll
                for (int n = 0; n < 2; ++n) acc[a][b][m][n] = (f32x4){0.f, 0.f, 0.f, 0.f};
    bf16x8 At[4][2], B0[2][2], B1[2][2]; i32x8 At8[4], B08[2], B18[2];
    E.prep(cur, 0, wid, lane);
    unsigned aoC[2][2], aoN[2][2];
    PG8_AOFF(aoC, cur);
    const char* cA = uni_ptr(GATHER ? g.Abase : cur.A); const char* cB = uni_ptr(cur.B);
    PG8_STAGE(PG8_SB(0, 0), cB, voffB); PG8_STAGE(PG8_SB(0, 1), cB + hstepB, voffB); PG8_STAGE_A(PG8_SA(0, 0), cA, aoC, 0); PG8_STAGE_A(PG8_SA(0, 1), cA, aoC, 1);
    if (wr == 1) PG8_BAR;
    PG8_WAIT_V(2); PG8_BAR;
    PG8_STAGE(PG8_SB(1, 0), cB + kstep, voffB); PG8_STAGE_A(PG8_SA(1, 0), cA + kstep, aoC, 0); PG8_STAGE(PG8_SB(1, 1), cB + hstepB + kstep, voffB);
    PG8_WAIT_V(6); PG8_BAR;
    for (;;) {
        const bool has_next = S.next(ui + 1, nxt);
        if (has_next) E.prep(nxt, ui + 1, wid, lane);
        if constexpr (GATHER) { if (has_next) PG8_AOFF(aoN, nxt); else { _Pragma("unroll") for (int _h = 0; _h < 2; ++_h) _Pragma("unroll") for (int _i = 0; _i < 2; ++_i) aoN[_h][_i] = aoC[_h][_i]; } }
        const char* nA = uni_ptr(GATHER ? g.Abase : (has_next ? nxt.A : cA)); const char* nB = uni_ptr(has_next ? nxt.B : cB);
        const bool dh0 = cur.x2 != 2, dh1 = cur.x2 != 1;
#pragma nounroll
        for (int t = 0; t < nt; t += 2) {
            const bool last = (t == nt - 2);
            if constexpr (Epi::MID) { if (t == 2) E.prep_mid(cur, wid, lane); }
            const char* a1 = cA + (size_t)(t + 1) * kstep;
            const char* a2 = last ? nA : cA + (size_t)(t + 2) * kstep; const char* b2 = last ? nB : cB + (size_t)(t + 2) * kstep;
            const char* a3 = a2 + kstep; const char* b3 = b2 + kstep;
            unsigned aoS[2][2];
#pragma unroll
            for (int _h = 0; _h < 2; ++_h)
#pragma unroll
                for (int _i = 0; _i < 2; ++_i) aoS[_h][_i] = (GATHER && last) ? aoN[_h][_i] : aoC[_h][_i];
            PG8_LDB(B0, 0, 0); PG8_LDB(B1, 0, 1); PG8_SCHED; PG8_LDA(At, 0, 0); PG8_STAGE_A(PG8_SA(1, 1), a1, aoC, 1);
            PG8_WAIT_V(8); PG8_WAIT_L(0); PG8_BAR; if (!HALFSEL || dh0) PG8_MMA(0, 0, At, B0); if (!HALFSEL || dh1) PG8_MMA(0, 1, At, B1); PG8_BAR; PG8_SCHED;
            PG8_LDA(At, 0, 1); PG8_STAGE(PG8_SB(0, 0), b2, voffB); PG8_STAGE(PG8_SB(0, 1), b2 + hstepB, voffB); PG8_STAGE_A(PG8_SA(0, 0), a2, aoS, 0);
            PG8_WAIT_V(8); PG8_WAIT_L(0); PG8_BAR; if (!HALFSEL || dh0) PG8_MMA(1, 0, At, B0); if (!HALFSEL || dh1) PG8_MMA(1, 1, At, B1); PG8_BAR; PG8_SCHED;
            PG8_LDB(B0, 1, 0); PG8_LDB(B1, 1, 1); PG8_SCHED; PG8_LDA(At, 1, 0); PG8_STAGE_A(PG8_SA(0, 1), a2, aoS, 1);
            PG8_WAIT_V(8); PG8_WAIT_L(0); PG8_BAR; if (!HALFSEL || dh0) PG8_MMA(0, 0, At, B0); if (!HALFSEL || dh1) PG8_MMA(0, 1, At, B1); PG8_BAR; PG8_SCHED;
            PG8_LDA(At, 1, 1); PG8_STAGE(PG8_SB(1, 0), b3, voffB); PG8_STAGE(PG8_SB(1, 1), b3 + hstepB, voffB); PG8_STAGE_A(PG8_SA(1, 0), a3, aoS, 0);
            PG8_WAIT_V(8); PG8_WAIT_L(0); PG8_BAR; if (!HALFSEL || dh0) PG8_MMA(1, 0, At, B0); if (!HALFSEL || dh1) PG8_MMA(1, 1, At, B1); PG8_BAR; PG8_SCHED;
        }
        if constexpr (FP8) asm volatile("s_nop 15\n\ts_nop 15" ::: "memory");
        if constexpr (ALIGN_EPI) { if (wr == 0) PG8_BAR; }
        E(acc, cur, wr, wc, fr, fq);
        if (!has_next) break;
#pragma unroll
        for (int a = 0; a < 2; ++a)
#pragma unroll
            for (int b = 0; b < 2; ++b)
#pragma unroll
                for (int m = 0; m < 4; ++m)
#pragma unroll
                    for (int n = 0; n < 2; ++n) acc[a][b][m][n] = (f32x4){0.f, 0.f, 0.f, 0.f};
        if constexpr (FP8) asm volatile("s_nop 7" ::: "memory");
        cur = nxt; cA = nA; cB = nB; ++ui;
        if constexpr (GATHER) {
#pragma unroll
            for (int _h = 0; _h < 2; ++_h)
#pragma unroll
                for (int _i = 0; _i < 2; ++_i) aoC[_h][_i] = aoN[_h][_i]; }
        if constexpr (ALIGN_EPI) { if (wr == 1) PG8_BAR; }
    }
    PG8_WAIT_V(0);
    if constexpr (!ALIGN_EPI) { if (wr == 0) PG8_BAR; }
    PG8_BAR;
#undef PG8_SA
#undef PG8_SB
#undef PG8_STAGE
#undef PG8_STAGE_A
#undef PG8_LDA
#undef PG8_LD8
#undef PG8_LDB
#undef PG8_MMA
#undef PG8_WAIT_V
#undef PG8_WAIT_L
#undef PG8_BAR
#undef PG8_SCHED
#undef PG8_AOFF
}
}
#include <hip/hip_bf16.h>
namespace attn_body {
using bf16=__hip_bfloat16;
using bf16x8=__attribute__((ext_vector_type(8)))short;
using s16x4=__attribute__((ext_vector_type(4)))short;
using f32x16=__attribute__((ext_vector_type(16)))float;
using u32x4=__attribute__((ext_vector_type(4)))unsigned;
constexpr int BATCH=4,NHEAD=16,SEQ=4096,D=64,DM=NHEAD*D;
constexpr int NW=8,QBLK=32,QB=QBLK*NW,KVBLK=64,NQB=SEQ/QB;
constexpr int ATTN_PITCH=DM, ATTN_UNIT_ROWS=QB;
__device__ __forceinline__ int crow(int r,int hi){return (r&3)+8*(r>>2)+4*hi;}
#define SBAR() __builtin_amdgcn_sched_barrier(0)
__device__ __forceinline__ void cmask(f32x16&p0,f32x16&p1,int jb,int qrel,int hi){
  const float NEG=-INFINITY; int d=qrel-64*jb-4*hi; asm volatile("":"+v"(d));
  #pragma unroll
  for(int r=0;r<16;++r){const int c=(r&3)+8*(r>>2); if(c>d)p0[r]=NEG; if(c+32>d)p1[r]=NEG;}
}

constexpr int NSLOT=3, SLOTB=8192;
constexpr int LDS_GT=98304;
constexpr int LDS_K=0, LDS_V=NSLOT*SLOTB, LDS_WS=2*NSLOT*SLOTB, LDS_OST=LDS_WS+NW*64*4, LDS_BYTES=LDS_OST+NW*4096;
constexpr float C2=0.125f*1.4426950408889634f;
__device__ __forceinline__ void glds16(const void*gsrc,unsigned lds_dst){unsigned keep;
  asm volatile("s_mov_b32 %0, m0\n\ts_mov_b32 m0, %2\n\ts_nop 0\n\tglobal_load_lds_dwordx4 %1, off\n\ts_mov_b32 m0, %0":"=&s"(keep):"v"(gsrc),"s"(lds_dst):"memory");}
__device__ __forceinline__ void glds16s(const void*sbase,unsigned voff,unsigned lds_dst){unsigned keep;
  asm volatile("s_nop 4\n\ts_mov_b32 %0, m0\n\ts_mov_b32 m0, %3\n\ts_nop 0\n\tglobal_load_lds_dwordx4 %1, %2\n\ts_mov_b32 m0, %0":"=&s"(keep):"v"(voff),"s"(sbase),"s"(lds_dst):"memory");}
__device__ __forceinline__ unsigned lane_now(){unsigned l;asm volatile("v_mbcnt_lo_u32_b32 %0, -1, 0\n\tv_mbcnt_hi_u32_b32 %0, -1, %0":"=v"(l));return l;}
__device__ __forceinline__ float max3f(float a,float b,float c){float r;asm("v_max3_f32 %0, %1, %2, %3":"=v"(r):"v"(a),"v"(b),"v"(c));return r;}
__device__ __forceinline__ float max2f(float a,float b){float r;asm("v_max_f32_e32 %0, %1, %2":"=v"(r):"v"(a),"v"(b));return r;}
__device__ __forceinline__ float fadd_s(float a,float b){float r;asm("v_add_f32_e32 %0, %1, %2":"=v"(r):"v"(a),"v"(b));return r;}
__device__ __forceinline__ float fsub_s(float a,float b){float r;asm("v_sub_f32_e32 %0, %1, %2":"=v"(r):"v"(a),"v"(b));return r;}
typedef float f32x2_t __attribute__((ext_vector_type(2))); typedef __bf16 bf16x2_t __attribute__((ext_vector_type(2)));
__device__ __forceinline__ unsigned cvtpk_s(float lo,float hi){f32x2_t v={lo,hi};bf16x2_t b=__builtin_convertvector(v,bf16x2_t);return __builtin_bit_cast(unsigned,b);}
#define WAIT_BAR(N) asm volatile("s_waitcnt vmcnt(" #N ") lgkmcnt(0)\n\ts_barrier":::"memory")

__device__ __forceinline__ void qkt(f32x16&p0,f32x16&p1,const char*Kslot,const bf16x8*qr,int r32,int hi){
  const char*kb=Kslot+hi*1024+r32*16;
  #pragma unroll
  for(int d0=0;d0<4;++d0){
    const bf16x8 b0=*reinterpret_cast<const bf16x8*>(kb+d0*2048);
    const bf16x8 b1=*reinterpret_cast<const bf16x8*>(kb+d0*2048+512);
    if(d0==0){p0=__builtin_amdgcn_mfma_f32_32x32x16_bf16(b0,qr[0],(f32x16){0.f,0.f,0.f,0.f,0.f,0.f,0.f,0.f,0.f,0.f,0.f,0.f,0.f,0.f,0.f,0.f},0,0,0);p1=__builtin_amdgcn_mfma_f32_32x32x16_bf16(b1,qr[0],(f32x16){0.f,0.f,0.f,0.f,0.f,0.f,0.f,0.f,0.f,0.f,0.f,0.f,0.f,0.f,0.f,0.f},0,0,0);}
    else{p0=__builtin_amdgcn_mfma_f32_32x32x16_bf16(b0,qr[d0],p0,0,0,0);p1=__builtin_amdgcn_mfma_f32_32x32x16_bf16(b1,qr[d0],p1,0,0,0);}}
}
typedef __attribute__((address_space(3))) const char* lds_cptr;
typedef short v4i16_t __attribute__((ext_vector_type(4)));
__device__ __forceinline__ void kload8(bf16x8*kf,lds_cptr kp){
  kf[0]=*(const __attribute__((address_space(3))) bf16x8*)(kp);      kf[1]=*(const __attribute__((address_space(3))) bf16x8*)(kp+512);
  kf[2]=*(const __attribute__((address_space(3))) bf16x8*)(kp+2048); kf[3]=*(const __attribute__((address_space(3))) bf16x8*)(kp+2560);
  kf[4]=*(const __attribute__((address_space(3))) bf16x8*)(kp+4096); kf[5]=*(const __attribute__((address_space(3))) bf16x8*)(kp+4608);
  kf[6]=*(const __attribute__((address_space(3))) bf16x8*)(kp+6144); kf[7]=*(const __attribute__((address_space(3))) bf16x8*)(kp+6656);
}
__device__ __forceinline__ void kload2(bf16x8*kf,lds_cptr kp,int j){ kf[2*j]=*(const __attribute__((address_space(3))) bf16x8*)(kp+j*2048); kf[2*j+1]=*(const __attribute__((address_space(3))) bf16x8*)(kp+j*2048+512); }
__device__ __forceinline__ s16x4 vtr(lds_cptr p){ return __builtin_bit_cast(s16x4,__builtin_amdgcn_ds_read_tr16_b64_v4i16((__attribute__((address_space(3))) v4i16_t*)p)); }
__device__ __forceinline__ float rowmax(const f32x16&p0,const f32x16&p1){
  float a=max3f(p0[0],p0[1],p1[0]),b=max3f(p0[2],p0[3],p1[1]);a=max3f(a,p1[2],p1[3]);
  #pragma unroll
  for(int r=4;r<16;r+=4){a=max3f(a,p0[r],p0[r+1]);b=max3f(b,p0[r+2],p0[r+3]);a=max3f(a,p1[r],p1[r+1]);b=max3f(b,p1[r+2],p1[r+3]);}
  const float m=max2f(a,b);
  auto rr=__builtin_amdgcn_permlane32_swap(__float_as_uint(m),__float_as_uint(m),false,false);
  return max2f(__uint_as_float(rr[0]),__uint_as_float(rr[1]));
}
__device__ __forceinline__ void pv(f32x16*o,int vb,bf16x8 pa0,bf16x8 pa1,bf16x8 pa2,bf16x8 pa3){
  #pragma unroll
  for(int d0=0;d0<2;++d0){s16x4 lo[4],hi[4];
    #pragma unroll
    for(int ks=0;ks<4;++ks){
      asm volatile("ds_read_b64_tr_b16 %0,%1 offset:%c2":"=&v"(lo[ks]):"v"(vb),"i"(d0*4096+ks*1024):"memory");
      asm volatile("ds_read_b64_tr_b16 %0,%1 offset:%c2":"=&v"(hi[ks]):"v"(vb),"i"(d0*4096+ks*1024+512):"memory");}
    asm volatile("s_waitcnt lgkmcnt(0)":::"memory");SBAR();
    #define PK(k) (bf16x8){lo[k][0],lo[k][1],lo[k][2],lo[k][3],hi[k][0],hi[k][1],hi[k][2],hi[k][3]}
    o[d0]=__builtin_amdgcn_mfma_f32_32x32x16_bf16(pa0,PK(0),o[d0],0,0,0);
    o[d0]=__builtin_amdgcn_mfma_f32_32x32x16_bf16(pa1,PK(1),o[d0],0,0,0);
    o[d0]=__builtin_amdgcn_mfma_f32_32x32x16_bf16(pa2,PK(2),o[d0],0,0,0);
    o[d0]=__builtin_amdgcn_mfma_f32_32x32x16_bf16(pa3,PK(3),o[d0],0,0,0);
    #undef PK
  }
}

#ifndef ATTN_STORE16
#define ATTN_STORE16(p,v) (*(u32x4*)(p)=(v))
#endif
template<int THRL> __device__ __forceinline__ void attn_unit(int b,int h,int qb,const bf16*Q,const bf16*__restrict__ K,const bf16*__restrict__ V,bf16*O,const float*ksum,char*shm){
  const int tid=threadIdx.x,lane=tid&63,r32=lane&31,hi=lane>>5; const int wid=__builtin_amdgcn_readfirstlane(tid>>6);
  const long rowbase=(long)b*SEQ; const int q0=qb*QB;
  const bf16*Qw=Q+(rowbase+q0+wid*QBLK)*DM+h*D;
  const bf16*Kh=K+rowbase*DM+h*D,*Vh=V+rowbase*DM+h*D;
  const unsigned lds0=(unsigned)(uintptr_t)shm;
  float*wsf=(float*)(shm+LDS_WS)+wid*64;
  const unsigned kdst=lds0+LDS_K+wid*1024, vdst=lds0+LDS_V+wid*1024;
  #define PHYS(t) (((t)<4)?(4*qb+(t)):((t)-4))
  #define DMA_K(t,slot) glds16s((const char*)Kh+(size_t)PHYS(t)*(KVBLK*DM*2)+wid*16,lane_now()*(unsigned)(DM*2),(unsigned)__builtin_amdgcn_readfirstlane(kdst+(slot)))
  #define DMA_V(t,slot) glds16s((const char*)Vh+(size_t)PHYS(t)*(KVBLK*DM*2)+(size_t)(16*(wid&3))*(DM*2)+(wid>>2)*64,({const unsigned l_=lane_now(); (l_>>2)*(unsigned)(DM*2)+(l_&3u)*16u;}),(unsigned)__builtin_amdgcn_readfirstlane(vdst+(slot)))
  const int vb0=(int)(lds0+LDS_V)+((lane>>4)&1)*32+(lane&3)*8+(4*hi+((lane&15)>>2))*64;
  const char*Kbase=shm+LDS_K; bf16x8 kf[8];
  const lds_cptr shm3=(lds_cptr)shm; const lds_cptr kp0=shm3+LDS_K+hi*1024+r32*16; const lds_cptr vp0=shm3+LDS_V+((lane>>4)&1)*32+(lane&3)*8+(4*hi+((lane&15)>>2))*64;
  const int NT=(q0+QB)/KVBLK;
  DMA_K(0,0);DMA_V(0,0);DMA_K(1,SLOTB);
  { float*gt=(float*)(shm+LDS_GT);
    #pragma unroll
    for(int k=0;k<2;++k){ const int j=2*wid+k; if(j<qb) gt[j*64+lane]=ksum[(long)(b*16+j)*DM+h*D+lane]; } }
  bf16x8 qr[4];
  #pragma unroll
  for(int d0=0;d0<4;++d0)qr[d0]=*reinterpret_cast<const bf16x8*>(&Qw[(long)r32*DM+d0*16+hi*8]);

  unsigned sel=0u;
  float mhat=0.f,l_reg=0.f;f32x16 o[2];o[0]=f32x16{};o[1]=f32x16{};
  bf16x8 kone=(bf16x8){0,0,0,0,0,0,0,0}, qm=(bf16x8){0,0,0,0,0,0,0,0}; if(hi==0) kone[0]=(short)0x3F80;
  #define SETQM() do{ const unsigned short mb_=(unsigned short)(cvtpk_s(-mhat,0.f)&0xffffu); qm[0]=(hi==0)?(short)mb_:(short)0; asm volatile("":"+v"(qm)); }while(0)
  const int qrel=wid*QBLK+r32;
  #define CMASK(P0,P1,t) do{ const int t_=(t); if(t_<4){ const int l_=(int)lane_now(); cmask(P0,P1,t_,wid*QBLK+(l_&31),l_>>5); } else if(!((sel>>(((t_-4)>>2)&15))&1u)){ _Pragma("unroll") for(int r=0;r<16;++r){P0[r]=-INFINITY;P1[r]=-INFINITY;} } }while(0)
  bool resc=false;
  #define START(P0,P1) do{ const float rm=rowmax(P0,P1); resc=false; \
    { const float dl=__uint_as_float(cvtpk_s(rm,0.f)<<16); mhat=fadd_s(mhat,dl);          \
      _Pragma("unroll") for(int r=0;r<16;++r){P0[r]=fsub_s(P0[r],dl);P1[r]=fsub_s(P1[r],dl);} \
      SETQM(); } \
    _Pragma("unroll") for(int r=0;r<16;++r)P0[r]=__builtin_amdgcn_exp2f(P0[r]); }while(0)
  #define RESC() do{ if(resc){ asm volatile("s_waitcnt lgkmcnt(0)":::"memory"); \
      _Pragma("unroll") for(int d_=0;d_<2;++d_) _Pragma("unroll") for(int r=0;r<16;++r)o[d_][r]*=wsf[crow(r,(int)(lane_now()>>5))]; } }while(0)
  f32x16 pA0,pA1,pB0,pB1;
  int sl_prev=0,sl_cur=0,sl_next=SLOTB;
  #define ROT() do{sl_prev=sl_cur;sl_cur=sl_next;sl_next=(sl_next==(NSLOT-1)*SLOTB)?0:sl_next+SLOTB;}while(0)
  DMA_K(2,2*SLOTB);
  WAIT_BAR(3);
  { float qf[32];
    #pragma unroll
    for(int d0=0;d0<4;++d0){
      #pragma unroll
      for(int i=0;i<8;++i) qf[d0*8+i]=__uint_as_float(((unsigned)(unsigned short)qr[d0][i])<<16); }
    const float*gt=(const float*)(shm+LDS_GT)+hi*8; float g[15];
    #pragma unroll
    for(int j=0;j<15;++j){ g[j]=-INFINITY;
      if(j<qb){ const float*kp=gt+j*64; float a=0.f;
        #pragma unroll
        for(int d0=0;d0<4;++d0){ const float4 k0=*reinterpret_cast<const float4*>(kp+d0*16), k1=*reinterpret_cast<const float4*>(kp+d0*16+4);
          a+=qf[d0*8+0]*k0.x; a+=qf[d0*8+1]*k0.y; a+=qf[d0*8+2]*k0.z; a+=qf[d0*8+3]*k0.w; a+=qf[d0*8+4]*k1.x; a+=qf[d0*8+5]*k1.y; a+=qf[d0*8+6]*k1.z; a+=qf[d0*8+7]*k1.w; }
        g[j]=a+__shfl_xor(a,32); } }
    #pragma unroll
    for(int kk=0;kk<3;++kk){ float best=-INFINITY; int bj=-1;
      #pragma unroll
      for(int j=0;j<15;++j){ const bool c=(j<qb)&&!((sel>>j)&1u)&&(g[j]>best); best=c?g[j]:best; bj=c?j:bj; }
      if(bj>=0) sel|=(1u<<bj); } }
  qkt(pA0,pA1,Kbase,qr,r32,hi);asm volatile("s_nop 15\n\ts_nop 7":"+v"(pA0),"+v"(pA1));CMASK(pA0,pA1,0);
  START(pA0,pA1);
  _Pragma("unroll") for(int r=0;r<16;++r)pA1[r]=__builtin_amdgcn_exp2f(pA1[r]);
  WAIT_BAR(0);
  DMA_K(3,0);DMA_V(1,SLOTB);
  ROT();
  kload8(kf,kp0+sl_cur);
  WAIT_BAR(2);
  s16x4 vlo[8],vhi[8]; u32x4 pw0,pw1,pw2,pw3;
  #define PKW(P,B) cvtpk_s(P[B],P[B+1])
  #define PAF(k) __builtin_bit_cast(bf16x8,pw##k)
  #define VFR(i) (bf16x8){vlo[i][0],vlo[i][1],vlo[i][2],vlo[i][3],vhi[i][0],vhi[i][1],vhi[i][2],vhi[i][3]}
  #define PIN(x) asm volatile("":"+v"(x))
  #define MX3(a,b,c) __builtin_fmaxf(__builtin_fmaxf((a),(b)),(c))
  #define GAPA(MF,A0,A1,A2,A3,W0,W1,PW) do{ MF; sacc+=A0; sacc+=A1; sacc+=A2; sacc+=A3; PIN(sacc); W0; W1; PIN(PW); SBAR(); }while(0)
  #define EX(v) __builtin_amdgcn_exp2f(v)
  #define GAPB(MF,X,B) do{ MF; X[B]=EX(X[B]); X[B+1]=EX(X[B+1]); X[B+2]=EX(X[B+2]); X[B+3]=EX(X[B+3]); PIN(X); SBAR(); }while(0)
  #define VRD(i) do{ vlo[i]=vtr(vp_+(((i)>>2)*4096+((i)&3)*1024)); vhi[i]=vtr(vp_+(((i)>>2)*4096+((i)&3)*1024+512)); }while(0)
  #define KRD(G,j) do{ if(G){ kload2(kf,kp0+sl_next,j); SBAR(); } }while(0)
  #define STEP(C0,C1,P0,P1,t,GK,GV,GL) do{ SBAR(); \
    const lds_cptr vp_=vp0+sl_prev; \
    C0=__builtin_amdgcn_mfma_f32_32x32x16_bf16(kone,qm,(f32x16){0.f,0.f,0.f,0.f,0.f,0.f,0.f,0.f,0.f,0.f,0.f,0.f,0.f,0.f,0.f,0.f},0,0,0); C1=__builtin_amdgcn_mfma_f32_32x32x16_bf16(kone,qm,(f32x16){0.f,0.f,0.f,0.f,0.f,0.f,0.f,0.f,0.f,0.f,0.f,0.f,0.f,0.f,0.f,0.f},0,0,0); SBAR(); \
    VRD(0); SBAR(); float sacc=(P0[0]+P0[1]); \
    GAPA(C0=__builtin_amdgcn_mfma_f32_32x32x16_bf16(kf[0],qr[0],C0,0,0,0), P0[2],P0[3],P0[4],P0[5],     pw0[0]=PKW(P0,0), pw0[1]=PKW(P0,2), pw0); \
    VRD(4); SBAR(); GAPA(C1=__builtin_amdgcn_mfma_f32_32x32x16_bf16(kf[1],qr[0],C1,0,0,0), P0[6],P0[7],P0[8],P0[9],     pw0[2]=PKW(P0,4), pw0[3]=PKW(P0,6), pw0); \
    VRD(1); SBAR(); GAPA(C0=__builtin_amdgcn_mfma_f32_32x32x16_bf16(kf[2],qr[1],C0,0,0,0),   P0[10],P0[11],P0[12],P0[13], pw1[0]=PKW(P0,8), pw1[1]=PKW(P0,10), pw1); \
    VRD(5); SBAR(); GAPA(C1=__builtin_amdgcn_mfma_f32_32x32x16_bf16(kf[3],qr[1],C1,0,0,0),   P0[14],P0[15],P1[0],P1[1],   pw1[2]=PKW(P0,12),pw1[3]=PKW(P0,14), pw1); \
    VRD(2); SBAR(); GAPA(C0=__builtin_amdgcn_mfma_f32_32x32x16_bf16(kf[4],qr[2],C0,0,0,0),   P1[2],P1[3],P1[4],P1[5],     pw2[0]=PKW(P1,0), pw2[1]=PKW(P1,2), pw2); \
    VRD(6); SBAR(); GAPA(C1=__builtin_amdgcn_mfma_f32_32x32x16_bf16(kf[5],qr[2],C1,0,0,0),   P1[6],P1[7],P1[8],P1[9],     pw2[2]=PKW(P1,4), pw2[3]=PKW(P1,6), pw2); \
    VRD(3); SBAR(); GAPA(C0=__builtin_amdgcn_mfma_f32_32x32x16_bf16(kf[6],qr[3],C0,0,0,0),   P1[10],P1[11],P1[12],P1[13], pw3[0]=PKW(P1,8), pw3[1]=PKW(P1,10), pw3); \
    VRD(7); SBAR(); GAPA(C1=__builtin_amdgcn_mfma_f32_32x32x16_bf16(kf[7],qr[3],C1,0,0,0),   P1[14],P1[15],0.f,0.f,       pw3[2]=PKW(P1,12),pw3[3]=PKW(P1,14), pw3); \
    l_reg+=sacc; \
    if(GK){DMA_K((t)+3,sl_cur);} if(GV){DMA_V((t)+1,sl_next);} \
    CMASK(C0,C1,t); \
    { float a=MX3(C0[0],C0[1],C1[0]),b=MX3(C0[2],C0[3],C1[1]); a=MX3(a,C1[2],C1[3]); \
      _Pragma("unroll") for(int r=4;r<16;r+=4){a=MX3(a,C0[r],C0[r+1]);b=MX3(b,C0[r+2],C0[r+3]);a=MX3(a,C1[r],C1[r+1]);b=MX3(b,C1[r+2],C1[r+3]);} \
      float rm=__builtin_fmaxf(a,b); { auto rr=__builtin_amdgcn_permlane32_swap(__float_as_uint(rm),__float_as_uint(rm),false,false); rm=__builtin_fmaxf(__uint_as_float(rr[0]),__uint_as_float(rr[1])); } \
      resc=false; \
      if(__builtin_expect(__any(rm>(float)THRL),0)){ const float mn_=__uint_as_float(cvtpk_s(mhat+__builtin_fmaxf(rm,0.f),0.f)<<16); const float dl=mn_-mhat; mhat=mn_; \
        _Pragma("unroll") for(int r=0;r<16;++r){C0[r]-=dl;C1[r]-=dl;} \
        SETQM(); \
        const float f=__builtin_amdgcn_exp2f(-dl); l_reg*=f; { const int l_=(int)lane_now(); if((l_>>5)==0)wsf[l_&31]=f; } resc=true; } } \
    SBAR(); \
    GAPB(o[0]=__builtin_amdgcn_mfma_f32_32x32x16_bf16(PAF(0),VFR(0),o[0],0,0,0), C0,0); \
    GAPB(o[1]=__builtin_amdgcn_mfma_f32_32x32x16_bf16(PAF(0),VFR(4),o[1],0,0,0), C0,4); \
    KRD(GL,0); GAPB(o[0]=__builtin_amdgcn_mfma_f32_32x32x16_bf16(PAF(1),VFR(1),o[0],0,0,0), C0,8); \
    KRD(GL,1); GAPB(o[1]=__builtin_amdgcn_mfma_f32_32x32x16_bf16(PAF(1),VFR(5),o[1],0,0,0), C0,12); \
    KRD(GL,2); GAPB(o[0]=__builtin_amdgcn_mfma_f32_32x32x16_bf16(PAF(2),VFR(2),o[0],0,0,0), C1,0); \
    KRD(GL,3); GAPB(o[1]=__builtin_amdgcn_mfma_f32_32x32x16_bf16(PAF(2),VFR(6),o[1],0,0,0), C1,4); \
    GAPB(o[0]=__builtin_amdgcn_mfma_f32_32x32x16_bf16(PAF(3),VFR(3),o[0],0,0,0), C1,8); \
    GAPB(o[1]=__builtin_amdgcn_mfma_f32_32x32x16_bf16(PAF(3),VFR(7),o[1],0,0,0), C1,12); \
    }while(0)
  int t=1;
  #undef CMASK
  #define CMASK(P0,P1,t) do{ const int t_=(t); if(t_<4){ const int l_=(int)lane_now(); cmask(P0,P1,t_,wid*QBLK+(l_&31),l_>>5); } else if(!((sel>>(((t_-4)>>2)&15))&1u)){ _Pragma("unroll") for(int r=0;r<16;++r){P0[r]=-INFINITY;P1[r]=-INFINITY;} } }while(0)
  for(;t+5<NT;t+=2){
    STEP(pB0,pB1,pA0,pA1,t,true,true,true);     WAIT_BAR(2); RESC(); ROT();
    STEP(pA0,pA1,pB0,pB1,t+1,true,true,true);   WAIT_BAR(2); RESC(); ROT();
  }
  #undef CMASK
  #define CMASK(P0,P1,t) do{ const int t_=(t); if(t_<4){ const int l_=(int)lane_now(); cmask(P0,P1,t_,wid*QBLK+(l_&31),l_>>5); } else if(!((sel>>(((t_-4)>>2)&15))&1u)){ _Pragma("unroll") for(int r=0;r<16;++r){P0[r]=-INFINITY;P1[r]=-INFINITY;} } }while(0)
  #define ENDW(tt) do{ if((tt)+3<NT){WAIT_BAR(2);} else if((tt)+2<NT){WAIT_BAR(1);} else {WAIT_BAR(0);} }while(0)
  for(;t+1<NT;t+=2){
    STEP(pB0,pB1,pA0,pA1,t,(t+3<NT),(t+1<NT),(t+1<NT));       ENDW(t);   RESC(); ROT();
    STEP(pA0,pA1,pB0,pB1,t+1,(t+4<NT),(t+2<NT),(t+2<NT));     ENDW(t+1); RESC(); ROT();
  }
  STEP(pB0,pB1,pA0,pA1,NT-1,false,false,false); RESC();
  { float sacc=pB0[0]+pB0[1]; _Pragma("unroll") for(int r=2;r<16;++r)sacc+=pB0[r]; _Pragma("unroll") for(int r=0;r<16;++r)sacc+=pB1[r]; l_reg+=sacc;
    pw0=(u32x4){PKW(pB0,0),PKW(pB0,2),PKW(pB0,4),PKW(pB0,6)};pw1=(u32x4){PKW(pB0,8),PKW(pB0,10),PKW(pB0,12),PKW(pB0,14)};pw2=(u32x4){PKW(pB1,0),PKW(pB1,2),PKW(pB1,4),PKW(pB1,6)};pw3=(u32x4){PKW(pB1,8),PKW(pB1,10),PKW(pB1,12),PKW(pB1,14)};
    SBAR(); pv(o,vb0+sl_cur,PAF(0),PAF(1),PAF(2),PAF(3)); }
  #undef PKW
  #undef PAF
  #undef VFR
  #undef PIN
  #undef MX3
  #undef GAPA
  #undef GAPB
  #undef EX
  #undef VRD
  #undef KRD
  #undef STEP
  #undef ENDW
  {auto rr=__builtin_amdgcn_permlane32_swap(__float_as_uint(l_reg),__float_as_uint(l_reg),false,false);l_reg=__uint_as_float(rr[0])+__uint_as_float(rr[1]);}
  if(hi==0)wsf[32+r32]=l_reg;asm volatile("s_waitcnt lgkmcnt(0)":::"memory");
  float rli[16];
  #pragma unroll
  for(int r=0;r<16;++r)rli[r]=__builtin_amdgcn_rcpf(wsf[32+crow(r,hi)]);
  bf16*Ow=O+(rowbase+q0+wid*QBLK)*DM+h*D;
  { bf16*stg=(bf16*)(shm+LDS_OST)+wid*2048;
    #pragma unroll
    for(int r=0;r<16;++r){const int orow=crow(r,hi);
      #pragma unroll
      for(int d0=0;d0<2;++d0)stg[orow*64+d0*32+r32]=__float2bfloat16(o[d0][r]*rli[r]);}
    asm volatile("s_waitcnt lgkmcnt(0)":::"memory");
    #pragma unroll
    for(int i=0;i<4;++i){const int row=i*8+(lane>>3),ch=lane&7; const u32x4 v=*(const u32x4*)(stg+row*64+ch*8); ATTN_STORE16(Ow+(long)row*DM+ch*8,v);} }
  asm volatile("s_waitcnt lgkmcnt(0)\n\ts_barrier":::"memory");
  #undef DMA_K
  #undef PHYS
  #undef DMA_V
  #undef CMASK
  #undef START
  #undef SETQM
  #undef RESC
  #undef ROT
}
constexpr int ATTN_LDS_BYTES=LDS_BYTES;
struct AttnTensors { const bf16* Q; const bf16* K; const bf16* V; bf16* O; const float* ksum; };
struct AttnUnit { int bh; int qb; };
struct StaticOrder {
  int vcu, G;
  __device__ __forceinline__ explicit StaticOrder(int grid,int block):vcu((grid%8==0)?((block%8)*(grid/8)+block/8):block),G(grid){}
  __device__ __forceinline__ bool next(int i,AttnUnit&u)const{ const int L=i*G+vcu; if(L>=1024)return false; const int w=L&255, rnd=L>>8, s=w&3; u.bh=w>>2; u.qb=(rnd==0)?s:(rnd==1)?7-s:(rnd==2)?8+s:15-s; return true; }
  __device__ __forceinline__ void a_ready(const AttnUnit&)const{}
  __device__ __forceinline__ void done(const AttnUnit&)const{}
};
struct SnakeOrder {
  int v, G;
  __device__ __forceinline__ bool next(int i,AttnUnit&u)const{ const int idx=i*G+((i&1)?(G-1-v):v); if(idx>=1024)return false; u.qb=15-(idx>>6); u.bh=idx&63; return true; }
  __device__ __forceinline__ void a_ready(const AttnUnit&)const{}
  __device__ __forceinline__ void done(const AttnUnit&)const{}
};
template<class Sched,int THRL=8> __device__ __forceinline__ void attn_phase(char*lds,const AttnTensors&T,const Sched&S){
  AttnUnit u;
  for(int i=0;S.next(i,u);++i){ S.a_ready(u); attn_unit<THRL>(u.bh/NHEAD,u.bh%NHEAD,u.qb,T.Q,T.K,T.V,T.O,T.ksum,lds); S.done(u); }
}
#undef SBAR
#undef WAIT_BAR
}
constexpr int NWAVES = 8, NTHR = 512;
constexpr int NTOK = 16384, DM = 1024, SEQ = 4096, NBATCH = 4, NEXP = 32;
constexpr float ALPHA = 1.4142135623730951f;
constexpr float LN_EPS = 1e-5f;
constexpr float RSQRT_DQK = 0.08838834764831845f;
constexpr int NPHASE = 19;
constexpr float FP8_SA = 4.0f, FP8_SWGU = 64.0f, FP8_SWD = 128.0f;
constexpr float FP8_SY = 32.0f, FP8_MAXV = 448.0f;
#ifndef DBG_ATTN_MUL
#define DBG_ATTN_MUL 1.0f
#endif
#ifndef DBG_MLSTM_MUL
#define DBG_MLSTM_MUL 1.0f
#endif
#ifndef DBG_MOE_MUL
#define DBG_MOE_MUL 1.0f
#endif
#ifndef DBG_P14_A
#define DBG_P14_A WS_HN
#endif
#ifndef NCONV
#define NCONV 80
#endif
#ifndef MK_ONE_LAUNCH
#define MK_ONE_LAUNCH 1
#endif

constexpr size_t MiB = 1u << 20, KiB = 1024;
constexpr size_t WS_CTL = 0, CTL_ZERO_BYTES = 1 * MiB;
constexpr int CW_TMO = 0, CW_BAR = 4096, CW_CNT = 8192, CW_AQ = 16384;
constexpr size_t WS_KSUM = 256 * KiB, WS_DEN = 512 * KiB;
constexpr size_t WS_WQKV = 2 * MiB, WS_WO = 8 * MiB, WS_WINA = 10 * MiB, WS_WINB = 14 * MiB, WS_WOUT = 17 * MiB;
constexpr size_t WS_WG = 19 * MiB, WS_RWT = 20 * MiB, WS_ROPE = 21 * MiB;
constexpr size_t WS_TOKE = 22 * MiB, WS_TOKP = 22 * MiB + 256 * KiB, WS_TOKG = 22 * MiB + 512 * KiB;
constexpr size_t WS_GI = 23 * MiB, WS_LF = 23 * MiB + 256 * KiB, WS_RF = 23 * MiB + 512 * KiB, WS_CF = 23 * MiB + 768 * KiB;
constexpr size_t WS_DEC = 24 * MiB, WS_NU = 24 * MiB + 256 * KiB, WS_NPREV = 24 * MiB + 512 * KiB;
constexpr size_t WS_ROWTOK = 25 * MiB;
constexpr size_t WS_XB = 32 * MiB, WS_Q = 64 * MiB, WS_K = 96 * MiB, WS_V = 128 * MiB;
constexpr size_t WS_R0 = 160 * MiB, WS_R1 = 224 * MiB, WS_R2 = 288 * MiB;
constexpr size_t WS_H = 352 * MiB, WS_Y = 496 * MiB;
constexpr size_t WS_WGU = 640 * MiB, WS_WD = 896 * MiB, WS_END = 1024 * MiB;
constexpr size_t WS_AE = 352 * MiB, WS_BE = 416 * MiB, WS_KN = 464 * MiB, WS_KT = 496 * MiB, WS_UT = 512 * MiB, WS_OS = 544 * MiB, WS_HN = 576 * MiB;

constexpr int RING_OFF = 0, RING_BYTES = 131072;
constexpr int LX = RING_BYTES;
constexpr int LX_MISC = LX;
constexpr int LX_TILEE = LX + 128;
constexpr int LX_TBASE = LX + 1280;
constexpr int LX_LCNT = LX + 1536, LX_GBASE = LX + 1664;
constexpr int LX_REC = LX + 1792;
constexpr int LX_TOKL = LX + 4096;
constexpr int LX_LNX = LX + 4096;
constexpr int LX_BIAS = LX + 12288;
constexpr int LX_ROPE = LX + 16384;
constexpr int LDS_BYTES = 163840;
constexpr int TOKL_ROUNDS = 10;

#define RLX_AGENT __ATOMIC_RELAXED, __HIP_MEMORY_SCOPE_AGENT
#define LDS_WAIT() asm volatile("s_waitcnt lgkmcnt(0)" ::: "memory")
#define VM_WAIT() asm volatile("s_waitcnt vmcnt(0)" ::: "memory")
#define XB_TMO      128
#define XB_XCNT(j)  (256  + 64 * (j))
#define XB_XSUB(j)  (1280 + 64 * (j))
#define XB_XGEN(j)  (2304 + 64 * (j))
#define XB_TOP      3328
#define XB_TOPGEN   3392
#define XCD_BAR_WORDS 3456
#define XB_SPIN_CAP (1u << 18)

__device__ __forceinline__ unsigned xb_ld(unsigned* p)              { return __hip_atomic_load(p, __ATOMIC_RELAXED, __HIP_MEMORY_SCOPE_AGENT); }
__device__ __forceinline__ unsigned xb_add(unsigned* p, unsigned v) { return __hip_atomic_fetch_add(p, v, __ATOMIC_RELAXED, __HIP_MEMORY_SCOPE_AGENT); }
__device__ __forceinline__ unsigned xb_xcc_id() { return (unsigned)__builtin_amdgcn_s_getreg((3 << 11) | 20) & 0xFu; }
#define XB_SPIN(cond, bar) do { unsigned _sp = 0; while (cond) { __builtin_amdgcn_s_sleep(1); \
    if ((++_sp & 255u) == 0u) { if (xb_ld(&(bar)[XB_TMO])) break; if (_sp > XB_SPIN_CAP) { atomicAdd(&(bar)[XB_TMO], 1u); break; } } } } while (0)

struct XcdBarrier {
    unsigned* bar; unsigned x;
    volatile LAS unsigned* st;
};

__device__ __forceinline__ XcdBarrier xcd_barrier_post(unsigned* bar, volatile LAS unsigned* st) {
    XcdBarrier b; b.bar = bar; b.x = xb_xcc_id(); b.st = st;
    if (threadIdx.x == 0) (void)xb_add(&bar[XB_XCNT(b.x)], 1u);
    return b;
}
__device__ __forceinline__ void xcd_barrier_complete(unsigned* bar, unsigned x, unsigned& nloc, unsigned& nx) {
    const unsigned G = gridDim.x * gridDim.y * gridDim.z;
    unsigned sum, cnt, mine, sp = 0u;
    for (;;) {
        sum = 0u; cnt = 0u; mine = 0u;
#pragma unroll
        for (unsigned j = 0; j < 16; ++j) { const unsigned c = xb_ld(&bar[XB_XCNT(j)]); sum += c; cnt += (c > 0u) ? 1u : 0u; mine = (j == x) ? c : mine; }
        if (sum == G) break;
        __builtin_amdgcn_s_sleep(1);
        if ((++sp & 255u) == 0u) { if (xb_ld(&bar[XB_TMO])) break; if (sp > XB_SPIN_CAP) { atomicAdd(&bar[XB_TMO], 1u); break; } }
    }
    nloc = mine > 0u ? mine : 1u; nx = cnt > 0u ? cnt : 1u;
}

__device__ __forceinline__ void xcd_barrier(const XcdBarrier& b) {
    asm volatile("s_waitcnt vmcnt(0)" ::: "memory");
    __syncthreads();
    if (threadIdx.x == 0) {
        unsigned* bar = b.bar;
        __builtin_amdgcn_s_waitcnt(0);
        unsigned nloc = b.st[0], nx = b.st[1];
        if (nloc == 0u) { xcd_barrier_complete(bar, b.x, nloc, nx); b.st[0] = nloc; b.st[1] = nx; }
        const unsigned old = xb_add(&bar[XB_XSUB(b.x)], 1u);
        const unsigned gen = old / nloc;
        if (old + 1u == (gen + 1u) * nloc) {
            __builtin_amdgcn_fence(__ATOMIC_RELEASE, "agent");
            asm volatile("s_waitcnt vmcnt(0)" ::: "memory");
            asm volatile("buffer_inv sc1" ::: "memory");
            const unsigned og = xb_add(&bar[XB_TOP], 1u);
            const unsigned tg = og / nx;
            if (og + 1u == (tg + 1u) * nx) xb_add(&bar[XB_TOPGEN], 1u);
            else XB_SPIN(xb_ld(&bar[XB_TOPGEN]) == tg, bar);
            asm volatile("s_waitcnt vmcnt(0)" ::: "memory");
        } else {
            asm volatile("buffer_inv sc1" ::: "memory");
            XB_SPIN(xb_ld(&bar[XB_TOPGEN]) == gen, bar);
            asm volatile("" ::: "memory");
            asm volatile("s_waitcnt vmcnt(0)" ::: "memory");
        }
    }
    __syncthreads();
}
using pg8::Unit; using pg8::Gemm;
typedef f32x4 (&AccRef)[2][2][4][2];

#ifndef TAIL_FIRST
#define TAIL_FIRST 0
#endif
__device__ __forceinline__ bool moe_unit(int i, int G, int c, int nT, int nN, int& pm, int& pn, int& half) {
    const int U = nT * nN, R = U / G, rem = U - R * G; half = 0;
#if TAIL_FIRST
    if (rem > 0 && 2 * rem <= G) {
        if (c < 2 * rem) { if (i == 0) { half = 1 + (c & 1); return pg8::tile_order(0, U, R * G + (c >> 1), nT, nN, pm, pn); } --i; }
        if (i < R) return pg8::tile_order(i, G, c, nT, nN, pm, pn);
        return false; }
#endif
    if (i < R) return pg8::tile_order(i, G, c, nT, nN, pm, pn);
    if (i > R || rem == 0) return false;
    if (2 * rem <= G) { if (c >= 2 * rem) return false; half = 1 + (c & 1); return pg8::tile_order(0, U, R * G + (c >> 1), nT, nN, pm, pn); }
    return pg8::tile_order(i, G, c, nT, nN, pm, pn);
}
struct DenseSched {
    int nM, nN, G, c; const char* A; const char* B; size_t tstepA, tstepB; bool split = false;
    __device__ __forceinline__ bool next(int i, Unit& u) const {
        int half = 0;
        if (split) { if (!moe_unit(i, G, c, nM, nN, u.pm, u.pn, half)) return false; }
        else if (!pg8::tile_order(i, G, c, nM, nN, u.pm, u.pn)) return false;
        u.A = A + (size_t)u.pm * tstepA; u.B = B + (size_t)u.pn * tstepB; u.tl = nullptr; u.x0 = u.x1 = 0; u.x2 = half; return true; }
};
struct MoeSched {
    int nT, nN, G, c; const LAS int* tile_e; const LAS int* tbase; const LAS unsigned short* tokl;
    const char* A; const char* B; size_t tstepA, estepB, tstepB;
    __device__ __forceinline__ bool next(int i, Unit& u) const {
        int half; if (!moe_unit(i, G, c, nT, nN, u.pm, u.pn, half)) return false;
        const int e = tile_e[u.pm];
        u.x0 = e; u.x1 = u.pm * 256; u.x2 = half;
        u.A = A + (size_t)u.pm * tstepA; u.B = B + (size_t)e * estepB + (size_t)u.pn * tstepB;
        u.tl = tokl ? tokl + (i < TOKL_ROUNDS ? i : TOKL_ROUNDS - 1) * 256 : nullptr; return true; }
};
struct MuSched {
    int G, c, mode; const char* A; const char* B;
    __device__ __forceinline__ bool next(int i, Unit& u) const {
        const int mu = i * G + c; if (mu >= 256) return false;
        const int b = mu >> 6, hh = (mu >> 4) & 3, ch = mu & 15; const size_t tok0 = (size_t)b * SEQ + (size_t)ch * 256;
        u.pm = mu; u.pn = 0; u.x0 = mu; u.x1 = 0; u.x2 = (mode == 0) ? 1 : 0; u.tl = nullptr;
        if (mode == 0) { u.A = A + (size_t)mu * 256 * 384 * 2; u.B = B + ((size_t)(hh * 128) * NTOK + tok0) * 2; }
        else if (mode == 1) { u.A = A + ((size_t)mu * 256 * 512 + 256) * 2; u.B = B + (tok0 * 1024 + (size_t)hh * 256) * 2; }
        else { u.A = A + (size_t)mu * 256 * 512 * 2; u.B = B + (size_t)mu * 256 * 384 * 2; }
        return true; }
};

constexpr float C2 = 0.125f * 1.4426950408889634f;

struct EpiQKV {
    static constexpr bool PERM = true; static constexpr bool MID = true;
    __device__ __forceinline__ void prep(const Unit&, int, int, int) const {}
    __device__ __forceinline__ void prep_mid(const Unit& u, int wid, int lane) const { if ((u.pn >> 2) < 2) {
#pragma unroll
        for (int i = 0; i < 2; ++i) { const int row = (wid * 2 + i) * 16 + (lane >> 2), c = (lane & 3) ^ ((row >> 1) & 3);
            glds16s(uni_ptr((const char*)(rope + (size_t)u.pm * 256 * 16)), (unsigned)(row * 64 + c * 16), (unsigned)__builtin_amdgcn_readfirstlane((unsigned)(unsigned long long)ropel + (unsigned)((wid * 2 + i) * 1024))); } } }
    bf16_t* Q; bf16_t* K; bf16_t* V; const float* rope; float* ksum; LAS float* ropel;
    __device__ __forceinline__ void operator()(AccRef acc, const Unit& u, int wr, int wc, int fr, int fq) const {
        asm volatile("" : "+v"(fr), "+v"(fq));
        const int part = u.pn >> 2, colt = (u.pn & 3) * 256;
        bf16_t* base = Q + (size_t)part * ((WS_K - WS_Q) / 2);
        const bool rot = (part < 2) && ((wc & 1) == 0);
        float ks[2][8];
#pragma unroll
        for (int bj = 0; bj < 2; ++bj)
#pragma unroll
            for (int j = 0; j < 8; ++j) ks[bj][j] = 0.f;
#pragma unroll
        for (int ai = 0; ai < 2; ++ai)
#pragma unroll
            for (int m = 0; m < 4; ++m) {
                const int row = u.pm * 256 + ai * 128 + wr * 64 + m * 16 + fr;
                f32x4 cs = {1.f, 1.f, 1.f, 1.f}, sn = {0.f, 0.f, 0.f, 0.f};
                if (rot && fq < 2) { const int rl = ai * 128 + wr * 64 + m * 16 + fr, sw = (rl >> 1) & 3; const LAS f32x4* rp = (const LAS f32x4*)(ropel + rl * 16);
                    cs = rp[fq ^ sw]; sn = rp[(2 + fq) ^ sw]; }
#pragma unroll
                for (int bj = 0; bj < 2; ++bj) {
                    f32x4 v0 = acc[ai][bj][m][0], v1 = acc[ai][bj][m][1];
                    if (rot) { const f32x4 lo = v0 * cs - v1 * sn, hi = v1 * cs + v0 * sn; v0 = lo; v1 = hi; }
                    if (part == 0) { v0 = v0 * C2; v1 = v1 * C2; }
                    if (part == 1) {
#pragma unroll
                        for (int j = 0; j < 4; ++j) { ks[bj][j] += v0[j]; ks[bj][4 + j] += v1[j]; } }
                    u32x4 w; w.x = cvt_pk_bf16(v0[0], v0[1]); w.y = cvt_pk_bf16(v0[2], v0[3]); w.z = cvt_pk_bf16(v1[0], v1[1]); w.w = cvt_pk_bf16(v1[2], v1[3]);
                    *(u32x4*)(base + (size_t)row * DM + colt + bj * 128 + wc * 32 + fq * 8) = w;
                }
            }
        if (part == 1) {
#pragma unroll
            for (int bj = 0; bj < 2; ++bj)
#pragma unroll
                for (int j = 0; j < 8; ++j) { float s = ks[bj][j]; s += __shfl_xor(s, 1); s += __shfl_xor(s, 2); s += __shfl_xor(s, 4); s += __shfl_xor(s, 8);
                    if (fr == 0) atomicAdd(ksum + (size_t)u.pm * DM + colt + bj * 128 + wc * 32 + fq * 8 + j, s); }
        }
    }
};

struct EpiZ {
    static constexpr bool PERM = true; static constexpr bool MID = false;
    __device__ __forceinline__ void prep(const Unit&, int, int, int) const {}
    const bf16_t* xin; bf16_t* z; float ymul;
    __device__ __forceinline__ void operator()(AccRef acc, const Unit& u, int wr, int wc, int fr, int fq) const {
        asm volatile("" : "+v"(fr), "+v"(fq));
        const size_t off0 = (size_t)(u.pm * 256 + wr * 64 + fr) * DM + u.pn * 256 + wc * 32 + fq * 8;
        u32x4 xr[2][4][2];
#pragma unroll
        for (int ai = 0; ai < 2; ++ai)
#pragma unroll
            for (int m = 0; m < 4; ++m)
#pragma unroll
                for (int bj = 0; bj < 2; ++bj) xr[ai][m][bj] = *(const u32x4*)(xin + off0 + (size_t)(ai * 128 + m * 16) * DM + bj * 128);
        asm volatile("" ::: "memory");
#pragma unroll
        for (int ai = 0; ai < 2; ++ai)
#pragma unroll
            for (int m = 0; m < 4; ++m)
#pragma unroll
                for (int bj = 0; bj < 2; ++bj) { const u32x4 x = xr[ai][m][bj]; const f32x4 a0 = acc[ai][bj][m][0] * ymul, a1 = acc[ai][bj][m][1] * ymul;
                    u32x4 w; w.x = cvt_pk_bf16(bflo(x.x) * ALPHA + a0[0], bfhi(x.x) * ALPHA + a0[1]); w.y = cvt_pk_bf16(bflo(x.y) * ALPHA + a0[2], bfhi(x.y) * ALPHA + a0[3]);
                    w.z = cvt_pk_bf16(bflo(x.z) * ALPHA + a1[0], bfhi(x.z) * ALPHA + a1[1]); w.w = cvt_pk_bf16(bflo(x.w) * ALPHA + a1[2], bfhi(x.w) * ALPHA + a1[3]);
                    *(u32x4*)(z + off0 + (size_t)(ai * 128 + m * 16) * DM + bj * 128) = w; }
    }
};

__device__ __forceinline__ float swiglu1(float glu, float lin) {
    const float g = fminf(glu, 7.0f), l = fminf(fmaxf(lin, -7.0f), 7.0f);
    const float sg = __builtin_amdgcn_rcpf(1.0f + __builtin_amdgcn_exp2f(-1.702f * 1.4426950408889634f * g));
    return g * sg * (l + 1.0f);
}
__device__ __forceinline__ f32x2 swiglu2(float glu0, float lin0, float glu1, float lin1) {
    const f32x2 g = {fminf(glu0, 7.0f), fminf(glu1, 7.0f)}, l = {fminf(fmaxf(lin0, -7.0f), 7.0f), fminf(fmaxf(lin1, -7.0f), 7.0f)};
    const f32x2 t = g * (f32x2){-1.702f * 1.4426950408889634f, -1.702f * 1.4426950408889634f};
    const f32x2 d = (f32x2){__builtin_amdgcn_exp2f(t[0]), __builtin_amdgcn_exp2f(t[1])} + (f32x2){1.0f, 1.0f};
    const f32x2 r = {__builtin_amdgcn_rcpf(d[0]), __builtin_amdgcn_rcpf(d[1])};
    const f32x2 lp = l * (f32x2){FP8_SA, FP8_SA} + (f32x2){FP8_SA, FP8_SA};
    return (g * lp) * r;
}
struct EpiGU {
    static constexpr bool PERM = true; static constexpr bool MID = false;
    __device__ __forceinline__ void prep(const Unit& u, int ui, int wid, int lane) const { if (wid < 4) glds4s(uni_ptr((const char*)(bias + (size_t)u.x0 * 2048 + u.pn * 256 + wid * 64)), (unsigned)lane * 4u, (unsigned)__builtin_amdgcn_readfirstlane((unsigned)(unsigned long long)bl + (unsigned)(((ui & 1) * 256 + wid * 64) * 4))); }
    const float* bias; unsigned char* H; LAS float* bl; mutable int ucnt;
    __device__ __forceinline__ void operator()(AccRef acc, const Unit& u, int wr, int wc, int fr, int fq) const {
        asm volatile("" : "+v"(fr), "+v"(fq));
        const int c0 = u.pn * 256 + wc * 32 + fq * 8; const LAS float* bp = bl + (ucnt & 1) * 256 + wc * 32 + fq * 8; ++ucnt; constexpr float SC = 1.0f / (FP8_SA * FP8_SWGU);
        f32x4 b[2][2];
#pragma unroll
        for (int bj = 0; bj < 2; ++bj) { b[bj][0] = *(const LAS f32x4*)(bp + bj * 128); b[bj][1] = *(const LAS f32x4*)(bp + bj * 128 + 4); }
#pragma unroll
        for (int ai = 0; ai < 2; ++ai)
#pragma unroll
            for (int m = 0; m < 4; ++m) {
                unsigned char* rowp = H + (size_t)(u.x1 + ai * 128 + wr * 64 + m * 16 + fr) * DM + (c0 >> 1);
#pragma unroll
                for (int bj = 0; bj < 2; ++bj) { if (u.x2 == 2 - bj) continue;
                    const f32x4 v0 = acc[ai][bj][m][0] * SC + b[bj][0], v1 = acc[ai][bj][m][1] * SC + b[bj][1];
                    const f32x2 h0 = swiglu2(v0[0], v0[1], v0[2], v0[3]), h1 = swiglu2(v1[0], v1[1], v1[2], v1[3]);
                    int w = __builtin_amdgcn_cvt_pk_fp8_f32(h0[0], h0[1], 0, false);
                    w = __builtin_amdgcn_cvt_pk_fp8_f32(h1[0], h1[1], w, true);
                    *(int*)(rowp + bj * 64) = w; }
            }
    }
};
struct EpiDN {
    static constexpr bool PERM = true; static constexpr bool MID = false;
    __device__ __forceinline__ void prep(const Unit& u, int ui, int wid, int lane) const { if (wid < 4) glds4s(uni_ptr((const char*)(bias + (size_t)u.x0 * 1024 + u.pn * 256 + wid * 64)), (unsigned)lane * 4u, (unsigned)__builtin_amdgcn_readfirstlane((unsigned)(unsigned long long)bl + (unsigned)(((ui & 1) * 256 + wid * 64) * 4))); }
    const float* bias; unsigned char* Y; LAS float* bl; mutable int ucnt;
    __device__ __forceinline__ void operator()(AccRef acc, const Unit& u, int wr, int wc, int fr, int fq) const {
        asm volatile("" : "+v"(fr), "+v"(fq));
        const int c0 = u.pn * 256 + wc * 32 + fq * 8; const LAS float* bp = bl + (ucnt & 1) * 256 + wc * 32 + fq * 8; ++ucnt; constexpr float SC = FP8_SY / (FP8_SA * FP8_SWD);
        f32x4 b[2][2];
#pragma unroll
        for (int bj = 0; bj < 2; ++bj) { b[bj][0] = *(const LAS f32x4*)(bp + bj * 128) * FP8_SY; b[bj][1] = *(const LAS f32x4*)(bp + bj * 128 + 4) * FP8_SY; }
#pragma unroll
        for (int ai = 0; ai < 2; ++ai)
#pragma unroll
            for (int m = 0; m < 4; ++m) {
                unsigned char* rowp = Y + (size_t)(u.x1 + ai * 128 + wr * 64 + m * 16 + fr) * DM + c0;
#pragma unroll
                for (int bj = 0; bj < 2; ++bj) { if (u.x2 == 2 - bj) continue;
                    f32x4 v0 = acc[ai][bj][m][0] * SC + b[bj][0], v1 = acc[ai][bj][m][1] * SC + b[bj][1];
#pragma unroll
                    for (int q = 0; q < 4; ++q) { v0[q] = __builtin_amdgcn_fmed3f(v0[q], -FP8_MAXV, FP8_MAXV); v1[q] = __builtin_amdgcn_fmed3f(v1[q], -FP8_MAXV, FP8_MAXV); }
                    int w0 = __builtin_amdgcn_cvt_pk_fp8_f32(v0[0], v0[1], 0, false); w0 = __builtin_amdgcn_cvt_pk_fp8_f32(v0[2], v0[3], w0, true);
                    int w1 = __builtin_amdgcn_cvt_pk_fp8_f32(v1[0], v1[1], 0, false); w1 = __builtin_amdgcn_cvt_pk_fp8_f32(v1[2], v1[3], w1, true);
                    u32x2 w; w.x = (unsigned)w0; w.y = (unsigned)w1;
                    *(u32x2*)(rowp + bj * 128) = w; }
            }
    }
};

struct EpiINA {
    static constexpr bool PERM = true; static constexpr bool MID = false;
    __device__ __forceinline__ void prep(const Unit&, int, int, int) const {}
    const float* rf; const float* cf; bf16_t* AE; bf16_t* KN; bf16_t* OS;
    __device__ __forceinline__ void operator()(AccRef acc, const Unit& u, int wr, int wc, int fr, int fq) const {
        asm volatile("" : "+v"(fr), "+v"(fq));
        const int b = u.pm >> 4, ch = u.pm & 15, d0 = wc * 32 + fq * 8; const u32x4 zero = {0u, 0u, 0u, 0u};
        if (u.pn < 4) {
            const bool isq = u.pn < 2; const float* fac = isq ? rf : cf; const float fs = isq ? 1.0f : RSQRT_DQK; const int h0 = (u.pn & 1) * 2;
            float sf[2][4][2];
#pragma unroll
            for (int ai = 0; ai < 2; ++ai)
#pragma unroll
                for (int m = 0; m < 4; ++m)
#pragma unroll
                    for (int bj = 0; bj < 2; ++bj) sf[ai][m][bj] = fac[(size_t)(h0 + bj) * NTOK + (size_t)u.pm * 256 + ai * 128 + wr * 64 + m * 16 + fr];
#pragma unroll
            for (int ai = 0; ai < 2; ++ai)
#pragma unroll
                for (int m = 0; m < 4; ++m) {
                    const int t = ai * 128 + wr * 64 + m * 16 + fr; const size_t token = (size_t)u.pm * 256 + t;
#pragma unroll
                    for (int bj = 0; bj < 2; ++bj) { const int hh = h0 + bj; const float s = sf[ai][m][bj] * fs;
                        const f32x4 v0 = acc[ai][bj][m][0] * s, v1 = acc[ai][bj][m][1] * s;
                        const size_t oq = ((size_t)(((b * 4 + hh) * 16 + ch) * 256 + t)) * 512 + 256 + d0, ok = token * 1024 + hh * 256 + d0;
                        bf16_t* dst = isq ? (AE + oq) : (KN + ok);
                        u32x4 w; w.x = cvt_pk_bf16(v0[0], v0[1]); w.y = cvt_pk_bf16(v0[2], v0[3]); w.z = cvt_pk_bf16(v1[0], v1[1]); w.w = cvt_pk_bf16(v1[2], v1[3]);
                        *(u32x4*)dst = w; }
                }
        } else {
#pragma unroll
            for (int ai = 0; ai < 2; ++ai)
#pragma unroll
                for (int m = 0; m < 4; ++m) {
                    const int t = ai * 128 + wr * 64 + m * 16 + fr; const size_t token = (size_t)u.pm * 256 + t;
#pragma unroll
                    for (int bj = 0; bj < 2; ++bj) { f32x4 v0 = acc[ai][bj][m][0], v1 = acc[ai][bj][m][1];
#pragma unroll
                        for (int j = 0; j < 4; ++j) { v0[j] = __builtin_amdgcn_rcpf(1.0f + __builtin_amdgcn_exp2f(-1.4426950408889634f * v0[j])); v1[j] = __builtin_amdgcn_rcpf(1.0f + __builtin_amdgcn_exp2f(-1.4426950408889634f * v1[j])); }
                        u32x4 w; w.x = cvt_pk_bf16(v0[0], v0[1]); w.y = cvt_pk_bf16(v0[2], v0[3]); w.z = cvt_pk_bf16(v1[0], v1[1]); w.w = cvt_pk_bf16(v1[2], v1[3]);
                        *(u32x4*)(OS + token * 1024 + (u.pn - 4) * 256 + bj * 128 + d0) = w; }
                }
        }
    }
};
struct EpiINB {
    static constexpr bool PERM = true; static constexpr bool MID = false;
    __device__ __forceinline__ void prep(const Unit&, int, int, int) const {}
    const float* cf; bf16_t* KT; bf16_t* BE;
    __device__ __forceinline__ void operator()(AccRef acc, const Unit& u, int wr, int wc, int fr, int fq) const {
        asm volatile("" : "+v"(fr), "+v"(fq));
        const int b = u.pn >> 4, ch = u.pn & 15;
        f32x4 cv[2][2][2];
#pragma unroll
        for (int ai = 0; ai < 2; ++ai)
#pragma unroll
            for (int bj = 0; bj < 2; ++bj) { const size_t tok0 = (size_t)u.pn * 256 + bj * 128 + wc * 32 + fq * 8;
                if (u.pm < 2) { const int hh = u.pm * 2 + ai; cv[ai][bj][0] = *(const f32x4*)(cf + (size_t)hh * NTOK + tok0) * RSQRT_DQK; cv[ai][bj][1] = *(const f32x4*)(cf + (size_t)hh * NTOK + tok0 + 4) * RSQRT_DQK; }
                else { cv[ai][bj][0] = (f32x4){1.f, 1.f, 1.f, 1.f}; cv[ai][bj][1] = cv[ai][bj][0]; } }
#pragma unroll
        for (int ai = 0; ai < 2; ++ai)
#pragma unroll
            for (int m = 0; m < 4; ++m) {
                const int R = u.pm * 256 + ai * 128 + wr * 64 + m * 16 + fr;
#pragma unroll
                for (int bj = 0; bj < 2; ++bj) { if (u.x2 == 2 - bj) continue;
                    const f32x4 v0 = acc[ai][bj][m][0] * cv[ai][bj][0], v1 = acc[ai][bj][m][1] * cv[ai][bj][1]; const int s0 = bj * 128 + wc * 32 + fq * 8; const size_t tok0 = (size_t)u.pn * 256 + s0; bf16_t* dst;
                    if (u.pm < 2) dst = KT + (size_t)R * NTOK + tok0;
                    else { const int eg = R - 512, hh = eg >> 8, e = eg & 255; dst = BE + ((size_t)(((b * 4 + hh) * 16 + ch) * 256 + e)) * 384 + s0; }
                    u32x4 w; w.x = cvt_pk_bf16(v0[0], v0[1]); w.y = cvt_pk_bf16(v0[2], v0[3]); w.z = cvt_pk_bf16(v1[0], v1[1]); w.w = cvt_pk_bf16(v1[2], v1[3]);
                    *(u32x4*)dst = w;
                }
            }
    }
};
struct EpiM1 {
    static constexpr bool PERM = true; static constexpr bool MID = false;
    __device__ __forceinline__ void prep(const Unit&, int, int, int) const {}
    bf16_t* UT;
    __device__ __forceinline__ void operator()(AccRef acc, const Unit& u, int wr, int wc, int fr, int fq) const {
        asm volatile("" : "+v"(fr), "+v"(fq));
#pragma unroll
        for (int ai = 0; ai < 2; ++ai)
#pragma unroll
            for (int m = 0; m < 4; ++m) { bf16_t* rowp = UT + ((size_t)u.x0 * 256 + ai * 128 + wr * 64 + m * 16 + fr) * 128 + wc * 32 + fq * 8;
                const f32x4 v0 = acc[ai][0][m][0], v1 = acc[ai][0][m][1];
                u32x4 w; w.x = cvt_pk_bf16(v0[0], v0[1]); w.y = cvt_pk_bf16(v0[2], v0[3]); w.z = cvt_pk_bf16(v1[0], v1[1]); w.w = cvt_pk_bf16(v1[2], v1[3]);
                *(u32x4*)rowp = w; }
    }
};
struct EpiM2A {
    static constexpr bool PERM = true; static constexpr bool MID = false;
    __device__ __forceinline__ void prep(const Unit&, int, int, int) const {}
    bf16_t* AE; const float* nprev; float* den;
    __device__ __forceinline__ void operator()(AccRef acc, const Unit& u, int wr, int wc, int fr, int fq) const {
        asm volatile("" : "+v"(fr), "+v"(fq));
        const int mu = u.x0, dd = wc * 32 + fq * 8;
        const f32x4 n0 = *(const f32x4*)(nprev + (size_t)mu * 128 + dd), n1 = *(const f32x4*)(nprev + (size_t)mu * 128 + dd + 4);
        u32x4 qv8[2][4];
#pragma unroll
        for (int ai = 0; ai < 2; ++ai)
#pragma unroll
            for (int m = 0; m < 4; ++m) qv8[ai][m] = *(const u32x4*)(AE + ((size_t)mu * 256 + ai * 128 + wr * 64 + m * 16 + fr) * 512 + 256 + dd);
#pragma unroll
        for (int ai = 0; ai < 2; ++ai)
#pragma unroll
            for (int m = 0; m < 4; ++m) {
                const int t = ai * 128 + wr * 64 + m * 16 + fr; bf16_t* rowp = AE + ((size_t)mu * 256 + t) * 512;
                const u32x4 qv = qv8[ai][m];
                float part = bflo(qv.x) * n0[0] + bfhi(qv.x) * n0[1] + bflo(qv.y) * n0[2] + bfhi(qv.y) * n0[3] + bflo(qv.z) * n1[0] + bfhi(qv.z) * n1[1] + bflo(qv.w) * n1[2] + bfhi(qv.w) * n1[3];
#pragma unroll
                for (int bj = 0; bj < 2; ++bj) { const int s0 = bj * 128 + wc * 32 + fq * 8; f32x4 v0 = acc[ai][bj][m][0], v1 = acc[ai][bj][m][1];
                    int dts = t - s0; asm volatile("" : "+v"(dts));
#pragma unroll
                    for (int j = 0; j < 4; ++j) { v0[j] = (j <= dts) ? v0[j] : 0.f; v1[j] = (4 + j <= dts) ? v1[j] : 0.f; part += v0[j] + v1[j]; }
                    u32x4 w; w.x = cvt_pk_bf16(v0[0], v0[1]); w.y = cvt_pk_bf16(v0[2], v0[3]); w.z = cvt_pk_bf16(v1[0], v1[1]); w.w = cvt_pk_bf16(v1[2], v1[3]);
                    *(u32x4*)(rowp + s0) = w; }
                part += __shfl_xor(part, 16); part += __shfl_xor(part, 32);
                if (fq == 0) atomicAdd(den + (size_t)mu * 256 + (wr * 64 + fr) + (ai * 128 + m * 16), part);
            }
    }
};
struct EpiM2B {
    static constexpr bool PERM = true; static constexpr bool MID = false;
    __device__ __forceinline__ void prep(const Unit&, int, int, int) const {}
    const float* den; const float* normg; const bf16_t* OS; bf16_t* HN; LAS float* lnx;
    __device__ __forceinline__ void operator()(AccRef acc, const Unit& u, int wr, int wc, int fr, int fq) const {
        asm volatile("" : "+v"(fr), "+v"(fq));
        const int mu = u.x0, b = mu >> 6, hh = (mu >> 4) & 3, ch = mu & 15;
        float dnv[2][4];
#pragma unroll
        for (int ai = 0; ai < 2; ++ai)
#pragma unroll
            for (int m = 0; m < 4; ++m) dnv[ai][m] = den[(size_t)mu * 256 + ai * 128 + wr * 64 + m * 16 + fr];
#pragma unroll
        for (int ai = 0; ai < 2; ++ai)
#pragma unroll
            for (int m = 0; m < 4; ++m) {
                const int t = ai * 128 + wr * 64 + m * 16 + fr; const float dn = dnv[ai][m];
#ifdef DBG_DEN1
                const float inv = 1.0f;
#else
                const float inv = 1.0f / fmaxf(fabsf(dn), 1.0f);
#endif
                float s1 = 0.f, s2 = 0.f;
#pragma unroll
                for (int bj = 0; bj < 2; ++bj)
#pragma unroll
                    for (int n = 0; n < 2; ++n) { f32x4 h = acc[ai][bj][m][n] * inv; acc[ai][bj][m][n] = h; s1 += (h[0] + h[1]) + (h[2] + h[3]); s2 += (h[0] * h[0] + h[1] * h[1]) + (h[2] * h[2] + h[3] * h[3]); }
                s1 += __shfl_xor(s1, 16); s1 += __shfl_xor(s1, 32); s2 += __shfl_xor(s2, 16); s2 += __shfl_xor(s2, 32);
                if (fq == 0) { lnx[(t * 4 + wc) * 2] = s1; lnx[(t * 4 + wc) * 2 + 1] = s2; }
            }
        const int e0 = wc * 32 + fq * 8;
        f32x4 gg[2][2];
#pragma unroll
        for (int bj = 0; bj < 2; ++bj) { gg[bj][0] = *(const f32x4*)(normg + hh * 256 + bj * 128 + e0); gg[bj][1] = *(const f32x4*)(normg + hh * 256 + bj * 128 + e0 + 4); }
        asm volatile("s_waitcnt lgkmcnt(0)" ::: "memory"); __builtin_amdgcn_s_barrier(); asm volatile("" ::: "memory");
#pragma unroll
        for (int ai = 0; ai < 2; ++ai) {
            u32x4 ovv[4][2];
#pragma unroll
            for (int m = 0; m < 4; ++m)
#pragma unroll
                for (int bj = 0; bj < 2; ++bj) ovv[m][bj] = *(const u32x4*)(OS + (((size_t)(b * 16 + ch)) * 256 + ai * 128 + wr * 64 + m * 16 + fr) * 1024 + hh * 256 + bj * 128 + e0);
#pragma unroll
            for (int m = 0; m < 4; ++m) {
                const int t = ai * 128 + wr * 64 + m * 16 + fr; const size_t token = ((size_t)(b * 16 + ch)) * 256 + t;
                const LAS f32x4* lp = (const LAS f32x4*)(lnx + t * 8); const f32x4 a = lp[0], c = lp[1];
                const float mean = (a[0] + a[2] + c[0] + c[2]) * (1.0f / 256.0f); const float ex2 = (a[1] + a[3] + c[1] + c[3]) * (1.0f / 256.0f);
                const float rstd = 1.0f / sqrtf(fmaxf(ex2 - mean * mean, 0.f) + LN_EPS);
#pragma unroll
                for (int bj = 0; bj < 2; ++bj) { const int e = bj * 128 + e0; const size_t off = token * 1024 + hh * 256 + e; const u32x4 ov = ovv[m][bj];
#ifdef DBG_HN_OS
                    f32x4 v0 = {1.f, 1.f, 1.f, 1.f}, v1 = v0;
#elif defined(DBG_HN_RAW)
                    f32x4 v0 = acc[ai][bj][m][0], v1 = acc[ai][bj][m][1];
#else
                    f32x4 v0 = (acc[ai][bj][m][0] - mean) * rstd * gg[bj][0], v1 = (acc[ai][bj][m][1] - mean) * rstd * gg[bj][1];
#endif
#ifndef DBG_HN_ONE
                    v0[0] *= bflo(ov.x); v0[1] *= bfhi(ov.x); v0[2] *= bflo(ov.y); v0[3] *= bfhi(ov.y); v1[0] *= bflo(ov.z); v1[1] *= bfhi(ov.z); v1[2] *= bflo(ov.w); v1[3] *= bfhi(ov.w);
#endif
                    u32x4 w; w.x = cvt_pk_bf16(v0[0], v0[1]); w.y = cvt_pk_bf16(v0[2], v0[3]); w.z = cvt_pk_bf16(v1[0], v1[1]); w.w = cvt_pk_bf16(v1[2], v1[3]);
                    *(u32x4*)(HN + off) = w; }
            }
            asm volatile("" ::: "memory");
        }
        asm volatile("s_waitcnt lgkmcnt(0)" ::: "memory"); __builtin_amdgcn_s_barrier(); asm volatile("" ::: "memory");
    }
};
struct Frame {
    LAS unsigned char* lds;
    unsigned* ctl;
    unsigned char* ws;
    int tid, lane, wave, vcu, G;
};
__device__ __forceinline__ float wave_sum(float v) {
#pragma unroll
    for (int o = 1; o < 64; o <<= 1) v += __shfl_xor(v, o);
    return v;
}

__device__ __forceinline__ void tr_block(const float* src, size_t pitch, bf16_t* dst, size_t kd, int kb, int nb, LAS unsigned* scr, int lane, bool rotperm = false) {
    const float* s0 = src + (size_t)(64 * kb) * pitch + 64 * nb + 4 * (lane & 15);
#pragma unroll
    for (int i = 0; i < 8; ++i) {
        const int kp = 4 * i + (lane >> 4);
        const f32x4 a = __builtin_nontemporal_load((const f32x4*)(s0 + (size_t)(2 * kp) * pitch)), b = __builtin_nontemporal_load((const f32x4*)(s0 + (size_t)(2 * kp + 1) * pitch));
#pragma unroll
        for (int j = 0; j < 4; ++j) scr[(4 * (lane & 15) + j) * 33 + kp] = cvt_pk_bf16(a[j], b[j]);
    }
    LDS_WAIT(); asm volatile("" ::: "memory");
    u32x4 o[8];
#pragma unroll
    for (int c = 0; c < 8; ++c) { const int r0 = 8 * c + (lane >> 3), rr = (rotperm && c < 2) ? (8 * ((r0 >> 2) & 1) + 4 * (r0 >> 3) + (r0 & 3)) : r0, q4 = 4 * (lane & 7); o[c].x = scr[rr * 33 + q4]; o[c].y = scr[rr * 33 + q4 + 1]; o[c].z = scr[rr * 33 + q4 + 2]; o[c].w = scr[rr * 33 + q4 + 3]; }
    bf16_t* d = dst + (size_t)(64 * nb + (lane >> 3)) * kd + 64 * kb + 8 * (lane & 7);
#pragma unroll
    for (int c = 0; c < 8; ++c) *(u32x4*)(d + (size_t)(8 * c) * kd) = o[c];
    LDS_WAIT(); asm volatile("" ::: "memory");
}
__device__ __forceinline__ void tr_block8(const float* src, size_t pitch, unsigned char* dst, size_t kd, int kb, int nb, float scale, LAS unsigned* scr, int lane) {
    const float* s0 = src + (size_t)(128 * kb) * pitch + 64 * nb + 4 * (lane & 15);
#pragma unroll
    for (int i = 0; i < 8; ++i) {
        const int kq = 4 * i + (lane >> 4);
        const f32x4 r0 = __builtin_nontemporal_load((const f32x4*)(s0 + (size_t)(4 * kq) * pitch)) * scale, r1 = __builtin_nontemporal_load((const f32x4*)(s0 + (size_t)(4 * kq + 1) * pitch)) * scale,
                    r2 = __builtin_nontemporal_load((const f32x4*)(s0 + (size_t)(4 * kq + 2) * pitch)) * scale, r3 = __builtin_nontemporal_load((const f32x4*)(s0 + (size_t)(4 * kq + 3) * pitch)) * scale;
#pragma unroll
        for (int j = 0; j < 4; ++j) { int w = __builtin_amdgcn_cvt_pk_fp8_f32(r0[j], r1[j], 0, false); w = __builtin_amdgcn_cvt_pk_fp8_f32(r2[j], r3[j], w, true); scr[(4 * (lane & 15) + j) * 33 + kq] = (unsigned)w; }
    }
    LDS_WAIT(); asm volatile("" ::: "memory");
    u32x4 o[8];
#pragma unroll
    for (int c = 0; c < 8; ++c) { const int rr = 8 * c + (lane >> 3), q4 = 4 * (lane & 7); o[c].x = scr[rr * 33 + q4]; o[c].y = scr[rr * 33 + q4 + 1]; o[c].z = scr[rr * 33 + q4 + 2]; o[c].w = scr[rr * 33 + q4 + 3]; }
    unsigned char* d = dst + (size_t)(64 * nb + (lane >> 3)) * kd + 128 * kb + 16 * (lane & 7);
#pragma unroll
    for (int c = 0; c < 8; ++c) *(u32x4*)(d + (size_t)(8 * c) * kd) = o[c];
    LDS_WAIT(); asm volatile("" ::: "memory");
}
constexpr int CONV_ITEMS = 24576;
struct ConvItem { const float* s0; size_t pitch; unsigned char* d; float scale; };
__device__ __forceinline__ ConvItem conv_desc(const float* wgu, const float* wd, unsigned char* ws, int v, int lane) {
    const int layer = v >= 12288; int r = v - layer * 12288; ConvItem it;
    if (r < 8192) { const int mat = layer * 32 + (r >> 8); r &= 255; const int kb = r >> 5, nb = r & 31; it.pitch = 2048; it.scale = FP8_SWGU;
        it.s0 = wgu + (size_t)mat * 1024 * 2048 + (size_t)(128 * kb) * 2048 + 64 * nb + 4 * (lane & 15); it.d = ws + WS_WGU + (size_t)mat * 2048 * 1024 + (size_t)(64 * nb + (lane >> 3)) * 1024 + 128 * kb + 16 * (lane & 7); }
    else { r -= 8192; const int mat = layer * 32 + (r >> 7); r &= 127; const int kb = r >> 4, nb = r & 15; it.pitch = 1024; it.scale = FP8_SWD;
        it.s0 = wd + (size_t)mat * 1024 * 1024 + (size_t)(128 * kb) * 1024 + 64 * nb + 4 * (lane & 15); it.d = ws + WS_WD + (size_t)mat * 1024 * 1024 + (size_t)(64 * nb + (lane >> 3)) * 1024 + 128 * kb + 16 * (lane & 7); }
    return it;
}
__device__ __forceinline__ void conv_items(Frame& F, const float* wgu, const float* wd, int v_lo, int v_hi, int cw, int ncw) {
    LAS unsigned* scr = (LAS unsigned*)(F.lds + RING_OFF + F.wave * 8448); unsigned char* ws = F.ws; const int lane = F.lane;
    int v = v_lo + cw; if (v >= v_hi) return;
    ConvItem cur = conv_desc(wgu, wd, ws, v, lane);
    f32x4 r[8][4];
#pragma unroll
    for (int i = 0; i < 8; ++i) { const int kq = 4 * i + (lane >> 4);
#pragma unroll
        for (int q = 0; q < 4; ++q) r[i][q] = __builtin_nontemporal_load((const f32x4*)(cur.s0 + (size_t)(4 * kq + q) * cur.pitch)); }
    for (;;) {
        const int vn = v + ncw; const bool has = vn < v_hi; ConvItem nx = cur; if (has) nx = conv_desc(wgu, wd, ws, vn, lane);
#pragma unroll
        for (int i = 0; i < 8; ++i) { const int kq = 4 * i + (lane >> 4);
#pragma unroll
            for (int j = 0; j < 4; ++j) { int w = __builtin_amdgcn_cvt_pk_fp8_f32(r[i][0][j] * cur.scale, r[i][1][j] * cur.scale, 0, false); w = __builtin_amdgcn_cvt_pk_fp8_f32(r[i][2][j] * cur.scale, r[i][3][j] * cur.scale, w, true); scr[(4 * (lane & 15) + j) * 33 + kq] = (unsigned)w; }
            if (has) {
#pragma unroll
                for (int q = 0; q < 4; ++q) r[i][q] = __builtin_nontemporal_load((const f32x4*)(nx.s0 + (size_t)(4 * kq + q) * nx.pitch)); } }
        LDS_WAIT(); asm volatile("" ::: "memory");
        u32x4 o[8];
#pragma unroll
        for (int c = 0; c < 8; ++c) { const int rr = 8 * c + (lane >> 3), q4 = 4 * (lane & 7); o[c].x = scr[rr * 33 + q4]; o[c].y = scr[rr * 33 + q4 + 1]; o[c].z = scr[rr * 33 + q4 + 2]; o[c].w = scr[rr * 33 + q4 + 3]; }
#pragma unroll
        for (int c = 0; c < 8; ++c) __builtin_nontemporal_store(o[c], (u32x4*)(cur.d + (size_t)(8 * c) * 1024));
        LDS_WAIT(); asm volatile("" ::: "memory");
        if (!has) break;
        v = vn; cur = nx;
    }
}
struct P0In { const float *x, *wqkv, *wo, *win, *wout, *rw, *wgu, *wd; const int* pos; };
__device__ __forceinline__ void p0_prologue(Frame& F, const P0In& I) {
    LAS unsigned* scr = (LAS unsigned*)(F.lds + RING_OFF + F.wave * 8448);
    const int gw = F.vcu * NWAVES + F.wave, NGW = F.G * NWAVES;
    unsigned char* ws = F.ws;
    constexpr int KB = 16;
    constexpr int I_QKV = KB * 48, I_WO = KB * 16, I_INA1 = KB * 16, I_INA2 = KB * 16, I_INB = KB * 24, I_WOUT = KB * 16;
    constexpr int I_SMALL = I_QKV + I_WO + I_INA1 + I_INA2 + I_INB + I_WOUT;
    constexpr int NITEMS = I_SMALL;
    for (int it = gw; it < NITEMS; it += NGW) {
        int r = it; const float* src; size_t pitch; bf16_t* dst; int nbl; const bool isqkv = it < I_QKV;
        if (r < I_QKV) { src = I.wqkv; pitch = 3072; dst = (bf16_t*)(ws + WS_WQKV); nbl = 48; }
        else if ((r -= I_QKV) < I_WO) { src = I.wo; pitch = 1024; dst = (bf16_t*)(ws + WS_WO); nbl = 16; }
        else if ((r -= I_WO) < I_INA1) { src = I.win; pitch = 3080; dst = (bf16_t*)(ws + WS_WINA); nbl = 16; }
        else if ((r -= I_INA1) < I_INA2) { src = I.win + 2048; pitch = 3080; dst = (bf16_t*)(ws + WS_WINA) + (size_t)1024 * 1024; nbl = 16; }
        else if ((r -= I_INA2) < I_INB) { src = I.win + 512; pitch = 3080; dst = (bf16_t*)(ws + WS_WINB); nbl = 24; }
        else { r -= I_INB; src = I.wout; pitch = 1024; dst = (bf16_t*)(ws + WS_WOUT); nbl = 16; }
        tr_block(src, pitch, dst, 1024, r / nbl, r % nbl, scr, F.lane, isqkv && (r % nbl) < 32);
    }
    if (NCONV == 0) conv_items(F, I.wgu, I.wd, 0, CONV_ITEMS, gw, NGW);
    const int gt = F.vcu * NTHR + F.tid, NGT = F.G * NTHR;
    for (int i = gt; i < NTOK * DM / 8; i += NGT) { const f32x4 a = ((const f32x4*)I.x)[2 * i], b = ((const f32x4*)I.x)[2 * i + 1];
        u32x4 w; w.x = cvt_pk_bf16(a[0], a[1]); w.y = cvt_pk_bf16(a[2], a[3]); w.z = cvt_pk_bf16(b[0], b[1]); w.w = cvt_pk_bf16(b[2], b[3]); ((u32x4*)(ws + WS_XB))[i] = w; }
    for (int i = gt; i < NTOK * 8; i += NGT) { const int tok = i >> 3, f = i & 7; const float inv = powf(500000.0f, -(float)f * 0.125f); const float ang = (float)I.pos[tok] * inv;
        float sn, cs; sincosf(ang, &sn, &cs); float* rp = (float*)(ws + WS_ROPE) + (size_t)tok * 16; rp[f] = cs; rp[8 + f] = sn; }
    for (int i = gt; i < 2 * 32 * 1024; i += NGT) { const int l = i >> 15, e = (i >> 10) & 31, k = i & 1023; ((float*)(ws + WS_RWT))[i] = I.rw[((size_t)l * 1024 + k) * 32 + e]; }
    for (int i = gt; i < 8 * 1024; i += NGT) { const int gidx = i >> 10, k = i & 1023; ((float*)(ws + WS_WG))[i] = I.win[(size_t)k * 3080 + 3072 + gidx]; }
}

__device__ __forceinline__ void phase_ln_router(Frame& F, const bf16_t* __restrict__ z, bf16_t* __restrict__ x1, const float* lng, const float* lnb, const float* rbias, int layer, int cset) {
    unsigned char* ws = F.ws;
    LAS f32x4* rwv = (LAS f32x4*)(F.lds + RING_OFF);
    LAS int* lcnt = (LAS int*)(F.lds + LX_LCNT); LAS int* gbase = (LAS int*)(F.lds + LX_GBASE); LAS int* rec = (LAS int*)(F.lds + LX_REC);
    LAS float* lgb = (LAS float*)(F.lds + LX_LNX);
    { const f32x4* src = (const f32x4*)((const float*)(ws + WS_RWT) + (size_t)layer * 32768);
      for (int i = F.tid; i < 8192; i += NTHR) { const int e = i >> 8, c = i & 255; rwv[e * 256 + (c ^ (e & 15))] = src[i]; } }
    int* toke = (int*)(ws + WS_TOKE); int* tokp = (int*)(ws + WS_TOKP); float* tokg = (float*)(ws + WS_TOKG);
    unsigned short* rowtok = (unsigned short*)(ws + WS_ROWTOK); unsigned char* xb8 = (unsigned char*)(ws + WS_XB);
    unsigned* cntg = F.ctl + CW_CNT + cset * 2048;
    const int lane = F.lane;
    for (int grp = F.vcu; grp < NTOK / 64; grp += F.G) {
        if (F.tid < 32) lcnt[F.tid] = 0;
        for (int i = F.tid; i < 1024; i += NTHR) { lgb[i] = lng[i]; lgb[1024 + i] = lnb[i]; }
        __syncthreads();
#pragma unroll 2
        for (int tk = 0; tk < 8; tk += 2) {
            const int token0 = grp * 64 + F.wave * 8 + tk;
            f32x4 v[2][4]; float s[2] = {0.f, 0.f};
#pragma unroll
            for (int u = 0; u < 2; ++u)
#pragma unroll
                for (int j = 0; j < 4; ++j) { const u32x2 zz = *(const u32x2*)(z + (size_t)(token0 + u) * DM + 4 * lane + 256 * j); v[u][j] = (f32x4){bflo(zz.x), bfhi(zz.x), bflo(zz.y), bfhi(zz.y)}; s[u] += (v[u][j][0] + v[u][j][1]) + (v[u][j][2] + v[u][j][3]); }
#pragma unroll
            for (int o = 1; o < 64; o <<= 1) { const float a0 = __shfl_xor(s[0], o), a1 = __shfl_xor(s[1], o); s[0] += a0; s[1] += a1; }
            float s2[2] = {0.f, 0.f};
#pragma unroll
            for (int u = 0; u < 2; ++u) { const float mean = s[u] * (1.0f / DM);
#pragma unroll
                for (int j = 0; j < 4; ++j) { v[u][j] = v[u][j] - mean; s2[u] += (v[u][j][0] * v[u][j][0] + v[u][j][1] * v[u][j][1]) + (v[u][j][2] * v[u][j][2] + v[u][j][3] * v[u][j][3]); } }
#pragma unroll
            for (int o = 1; o < 64; o <<= 1) { const float a0 = __shfl_xor(s2[0], o), a1 = __shfl_xor(s2[1], o); s2[0] += a0; s2[1] += a1; }
#pragma unroll
            for (int u = 0; u < 2; ++u) { const float rstd = 1.0f / sqrtf(s2[u] * (1.0f / DM) + LN_EPS); const int token = token0 + u;
#pragma unroll
                for (int j = 0; j < 4; ++j) { const f32x4 gvj = *(const LAS f32x4*)(lgb + 4 * lane + 256 * j), bvj = *(const LAS f32x4*)(lgb + 1024 + 4 * lane + 256 * j);
                    const f32x4 y = v[u][j] * rstd * gvj + bvj; { u32x2 wb; wb.x = cvt_pk_bf16(y[0], y[1]); wb.y = cvt_pk_bf16(y[2], y[3]); *(u32x2*)(x1 + (size_t)token * DM + 4 * lane + 256 * j) = wb; }
                    int w8 = __builtin_amdgcn_cvt_pk_fp8_f32(y[0] * FP8_SA, y[1] * FP8_SA, 0, false); w8 = __builtin_amdgcn_cvt_pk_fp8_f32(y[2] * FP8_SA, y[3] * FP8_SA, w8, true);
                    *(int*)(xb8 + (size_t)token * DM + 4 * lane + 256 * j) = w8; } }
        }
        VM_WAIT(); __syncthreads();
        const int tg = F.wave & 3, kh = F.wave >> 2, e0 = lane & 15, kq = lane >> 4;
        f32x4 acc0 = {0.f, 0.f, 0.f, 0.f}, acc1 = acc0;
        { const bf16_t* arow = x1 + (size_t)(grp * 64 + tg * 16 + e0) * DM + kh * 512 + 4 * kq;
#pragma unroll 4
          for (int blk = 0; blk < 32; ++blk) {
              const u32x2 ab = *(const u32x2*)(arow + blk * 16); const f32x4 a4 = {bflo(ab.x), bfhi(ab.x), bflo(ab.y), bfhi(ab.y)}; const int c = ((kh * 512 + blk * 16) >> 2) + kq;
              const f32x4 b0 = rwv[e0 * 256 + (c ^ e0)], b1 = rwv[(16 + e0) * 256 + (c ^ e0)];
#pragma unroll
              for (int j = 0; j < 4; ++j) { acc0 = __builtin_amdgcn_mfma_f32_16x16x4f32(a4[j], b0[j], acc0, 0, 0, 0); acc1 = __builtin_amdgcn_mfma_f32_16x16x4f32(a4[j], b1[j], acc1, 0, 0, 0); } } }
        __syncthreads();
        if (kh == 1) { ((LAS f32x4*)lgb)[(tg * 2 + 0) * 64 + lane] = acc0; ((LAS f32x4*)lgb)[(tg * 2 + 1) * 64 + lane] = acc1; }
        __syncthreads();
        if (kh == 0) {
            acc0 = acc0 + ((LAS f32x4*)lgb)[(tg * 2 + 0) * 64 + lane]; acc1 = acc1 + ((LAS f32x4*)lgb)[(tg * 2 + 1) * 64 + lane];
            const float rb0 = rbias[e0], rb1 = rbias[16 + e0];
#pragma unroll
            for (int r = 0; r < 4; ++r) {
                float l0 = acc0[r] + rb0, l1 = acc1[r] + rb1; float tv[4]; int te[4];
#pragma unroll
                for (int k = 0; k < 4; ++k) { float bvv = (l1 > l0) ? l1 : l0; int be = (l1 > l0) ? 16 + e0 : e0;
#pragma unroll
                    for (int o = 1; o < 16; o <<= 1) { const float ov = __shfl_xor(bvv, o); const int oe = __shfl_xor(be, o); const bool take = (ov > bvv) || (ov == bvv && oe < be); bvv = take ? ov : bvv; be = take ? oe : be; }
                    tv[k] = bvv; te[k] = be; if (be == e0) l0 = -INFINITY; if (be == 16 + e0) l1 = -INFINITY; }
                const float w0 = 1.0f, w1 = __expf(tv[1] - tv[0]), w2 = __expf(tv[2] - tv[0]), w3 = __expf(tv[3] - tv[0]); const float wi = 1.0f / (w0 + w1 + w2 + w3);
                if (e0 < 4) {
                    const int tl = tg * 16 + 4 * kq + r, token = grp * 64 + tl;
                    const int ek = (e0 == 0) ? te[0] : (e0 == 1) ? te[1] : (e0 == 2) ? te[2] : te[3];
                    const float wk = (e0 == 0) ? w0 : (e0 == 1) ? w1 : (e0 == 2) ? w2 : w3;
                    const int li = atomicAdd((int*)(lcnt + ek), 1); rec[tl * 8 + e0] = ek; rec[tl * 8 + 4 + e0] = li;
                    toke[token * 4 + e0] = ek; tokg[token * 4 + e0] = wk * wi;
                }
            }
        }
        __syncthreads();
        if (F.tid < 32) gbase[F.tid] = (int)__hip_atomic_fetch_add(cntg + F.tid * 64, (unsigned)lcnt[F.tid], RLX_AGENT);
        __syncthreads();
        if (F.tid < 256) { const int tl = F.tid >> 2, k = F.tid & 3; const int token = grp * 64 + tl; const int e = rec[tl * 8 + k]; const int pos = gbase[e] + rec[tl * 8 + 4 + k];
            tokp[token * 4 + k] = pos; rowtok[(size_t)e * NTOK + pos] = (unsigned short)token; }
        __syncthreads();
    }
}

__device__ __forceinline__ int moe_tables(Frame& F, int layer) {
    LAS int* tile_e = (LAS int*)(F.lds + LX_TILEE); LAS int* tbase = (LAS int*)(F.lds + LX_TBASE);
    if (F.tid < 64) {
        const int e = F.lane & 31; const int c = (int)__hip_atomic_load(F.ctl + CW_CNT + layer * 2048 + e * 64, RLX_AGENT); const int nt = (F.lane < 32) ? ((c + 255) >> 8) : 0;
        int inc = nt;
#pragma unroll
        for (int o = 1; o < 32; o <<= 1) { const int up = __shfl_up(inc, o); if (F.lane >= o) inc += up; }
        const int t0 = inc - nt;
        if (F.lane < 32) { tbase[e] = t0; for (int i = 0; i < nt; ++i) tile_e[t0 + i] = e; }
        if (F.lane == 31) tbase[32] = inc;
    }
    __syncthreads();
    return tbase[32];
}

template <bool NEXT_MLSTM>
__device__ __forceinline__ void phase_combine(Frame& F, const bf16_t* __restrict__ x1, float* __restrict__ out, const float* lng, const float* lnb, const float* bgates, int layer) {
    unsigned char* ws = F.ws;
    (void)moe_tables(F, layer);
    const LAS int* tbase = (const LAS int*)(F.lds + LX_TBASE);
    const int* toke = (const int*)(ws + WS_TOKE); const int* tokp = (const int*)(ws + WS_TOKP); const float* tokg = (const float*)(ws + WS_TOKG);
    const unsigned char* Y = (const unsigned char*)(ws + WS_Y); bf16_t* xb = (bf16_t*)(ws + WS_XB);
    LAS float* wg = (LAS float*)(F.lds + RING_OFF);
    LAS float* lgb = wg + 8192;
    if constexpr (NEXT_MLSTM) { const f32x4* src = (const f32x4*)(ws + WS_WG); for (int i = F.tid; i < 2048; i += NTHR) ((LAS f32x4*)wg)[i] = src[i];
        for (int i = F.tid; i < 1024; i += NTHR) { lgb[i] = lng[i]; lgb[1024 + i] = lnb[i]; } __syncthreads(); }
    const int lane = F.lane; const int gw = F.vcu * NWAVES + F.wave, NGW = F.G * NWAVES;
    f32x4 gv[4], bv[4];
    if constexpr (!NEXT_MLSTM) {
#pragma unroll
        for (int j = 0; j < 4; ++j) { gv[j] = *(const f32x4*)(lng + 4 * lane + 256 * j); bv[j] = *(const f32x4*)(lnb + 4 * lane + 256 * j); } }
    constexpr int NTK = 2;
    int rowv = 0; float gatev = 0.f;
    { const int mt = gw + (lane >> 2) * NGW; if (mt < NTOK) { const int ee = toke[mt * 4 + (lane & 3)]; rowv = tbase[ee] * 256 + tokp[mt * 4 + (lane & 3)]; gatev = tokg[mt * 4 + (lane & 3)] * (DBG_MOE_MUL / FP8_SY); } }
    int it = 0;
    for (int token0 = gw; token0 < NTOK; token0 += NTK * NGW, ++it) {
        f32x4 vv[NTK][4];
#pragma unroll
        for (int u = 0; u < NTK; ++u) { const int token = token0 + u * NGW; if (token < NTOK) {
#pragma unroll
            for (int j = 0; j < 4; ++j) { const u32x2 xx = *(const u32x2*)(x1 + (size_t)token * DM + 4 * lane + 256 * j); vv[u][j] = (f32x4){bflo(xx.x), bfhi(xx.x), bflo(xx.y), bfhi(xx.y)} * ALPHA; }
#pragma unroll
            for (int k = 0; k < 4; ++k) { const int sl = (it * NTK + u) * 4 + k; const size_t row = (size_t)__builtin_amdgcn_readlane(rowv, sl); const float gt = __int_as_float(__builtin_amdgcn_readlane(__float_as_int(gatev), sl));
#pragma unroll
                for (int j = 0; j < 4; ++j) { const int y = *(const int*)(Y + row * DM + 4 * lane + 256 * j); const f32x2 lo = __builtin_amdgcn_cvt_pk_f32_fp8(y, false), hi = __builtin_amdgcn_cvt_pk_f32_fp8(y, true);
                    vv[u][j][0] += gt * lo[0]; vv[u][j][1] += gt * lo[1]; vv[u][j][2] += gt * hi[0]; vv[u][j][3] += gt * hi[1]; } } } }
#pragma unroll
        for (int u = 0; u < NTK; ++u) { const int token = token0 + u * NGW; if (token < NTOK) {
        f32x4 v[4];
#pragma unroll
        for (int j = 0; j < 4; ++j) v[j] = vv[u][j];
        float s = 0.f;
#pragma unroll
        for (int j = 0; j < 4; ++j) s += (v[j][0] + v[j][1]) + (v[j][2] + v[j][3]);
        const float mean = wave_sum(s) * (1.0f / DM); float s2 = 0.f;
#pragma unroll
        for (int j = 0; j < 4; ++j) { v[j] = v[j] - mean; s2 += (v[j][0] * v[j][0] + v[j][1] * v[j][1]) + (v[j][2] * v[j][2] + v[j][3] * v[j][3]); }
        const float rstd = 1.0f / sqrtf(wave_sum(s2) * (1.0f / DM) + LN_EPS);
#pragma unroll
        for (int j = 0; j < 4; ++j) { if constexpr (NEXT_MLSTM) { gv[j] = *(const LAS f32x4*)(lgb + 4 * lane + 256 * j); bv[j] = *(const LAS f32x4*)(lgb + 1024 + 4 * lane + 256 * j); }
            v[j] = v[j] * rstd * gv[j] + bv[j]; if constexpr (!NEXT_MLSTM) *(f32x4*)(out + (size_t)token * DM + 4 * lane + 256 * j) = v[j]; }
        if constexpr (NEXT_MLSTM) {
#pragma unroll
            for (int j = 0; j < 4; ++j) { u32x2 w; w.x = cvt_pk_bf16(v[j][0], v[j][1]); w.y = cvt_pk_bf16(v[j][2], v[j][3]); *(u32x2*)(xb + (size_t)token * DM + 4 * lane + 256 * j) = w; }
            float gp[8];
#pragma unroll
            for (int gi = 0; gi < 8; ++gi) { float a = 0.f;
#pragma unroll
                for (int j = 0; j < 4; ++j) { const f32x4 w = *(const LAS f32x4*)(wg + gi * 1024 + 4 * lane + 256 * j); a += (v[j][0] * w[0] + v[j][1] * w[1]) + (v[j][2] * w[2] + v[j][3] * w[3]); }
                gp[gi] = a; if (gi & 1) asm volatile("" ::: "memory"); }
#pragma unroll
            for (int o = 1; o < 64; o <<= 1) {
#pragma unroll
                for (int gi = 0; gi < 8; ++gi) gp[gi] += __shfl_xor(gp[gi], o); }
#pragma unroll
            for (int gi = 0; gi < 8; ++gi) gp[gi] += bgates[gi];
            if (lane == 0) {
#pragma unroll
                for (int hh = 0; hh < 4; ++hh) { ((float*)(ws + WS_GI))[(size_t)hh * NTOK + token] = gp[hh];
                    const float f = gp[4 + hh]; const float lf = (f >= 0.f) ? -log1pf(__expf(-f)) : (f - log1pf(__expf(f)));
                    ((float*)(ws + WS_LF))[(size_t)hh * NTOK + token] = lf; } }
        }
        } }
    }
}

__device__ __forceinline__ void phase_gate_scan(Frame& F) {
    unsigned char* ws = F.ws; const int lane = F.lane; const int gw = F.vcu * NWAVES + F.wave, NGW = F.G * NWAVES;
    for (int mu = gw; mu < 256; mu += NGW) {
        const int b = mu >> 6, hh = (mu >> 4) & 3, ch = mu & 15; const size_t base = (size_t)hh * NTOK + (size_t)b * SEQ + ch * 256 + 4 * lane;
        const f32x4 lf = *(const f32x4*)((const float*)(ws + WS_LF) + base), gi = *(const f32x4*)((const float*)(ws + WS_GI) + base);
        f32x4 c; c[0] = lf[0]; c[1] = c[0] + lf[1]; c[2] = c[1] + lf[2]; c[3] = c[2] + lf[3];
        float tot = c[3];
#pragma unroll
        for (int o = 1; o < 64; o <<= 1) { const float up = __shfl_up(tot, o); if (lane >= o) tot += up; }
        const float excl = tot - c[3];
        f32x4 rf, cf;
#pragma unroll
        for (int j = 0; j < 4; ++j) { const float bt = excl + c[j]; rf[j] = __expf(bt); cf[j] = __expf(gi[j] - bt); }
        *(f32x4*)((float*)(ws + WS_RF) + base) = rf; *(f32x4*)((float*)(ws + WS_CF) + base) = cf;
        if (lane == 63) ((float*)(ws + WS_DEC))[mu] = __expf(tot);
    }
}
__device__ __forceinline__ void phase_nu(Frame& F) {
    unsigned char* ws = F.ws; const int lane = F.lane; const int gw = F.vcu * NWAVES + F.wave, NGW = F.G * NWAVES;
    const bf16_t* KT = (const bf16_t*)(ws + WS_KT); float* NU = (float*)(ws + WS_NU);
    for (int r0 = gw * 16; r0 < 256 * 128; r0 += NGW * 16) {
        const int mu = r0 >> 7, d0 = r0 & 127, b = mu >> 6, hh = (mu >> 4) & 3, ch = mu & 15;
        const bf16_t* base = KT + (size_t)(hh * 128 + d0) * NTOK + (size_t)b * SEQ + ch * 256 + 4 * lane;
        u32x2 kv[16];
#pragma unroll
        for (int i = 0; i < 16; ++i) kv[i] = *(const u32x2*)(base + (size_t)i * NTOK);
        float s[16];
#pragma unroll
        for (int i = 0; i < 16; ++i) s[i] = (bflo(kv[i].x) + bfhi(kv[i].x)) + (bflo(kv[i].y) + bfhi(kv[i].y));
#pragma unroll
        for (int o = 1; o < 64; o <<= 1) {
#pragma unroll
            for (int i = 0; i < 16; ++i) s[i] += __shfl_xor(s[i], o); }
        float mine = s[0];
#pragma unroll
        for (int i = 1; i < 16; ++i) mine = (lane == i) ? s[i] : mine;
        if (lane < 16) NU[r0 + lane] = mine;
    }
}
__device__ __forceinline__ void phase_state_scan(Frame& F) {
    unsigned char* ws = F.ws; const int gt = F.vcu * NTHR + F.tid, NGT = F.G * NTHR;
    const bf16_t* UT = (const bf16_t*)(ws + WS_UT); const float* DEC = (const float*)(ws + WS_DEC); bf16_t* BE = (bf16_t*)(ws + WS_BE);
    for (int i = gt; i < 16 * 256 * 32; i += NGT) { const int bh = i >> 13, e = (i >> 5) & 255, dg = i & 31;
        f32x4 U[16]; float dc[16];
#pragma unroll
        for (int ch = 0; ch < 16; ++ch) { const size_t mu = (size_t)bh * 16 + ch; { const u32x2 uu = *(const u32x2*)(UT + (mu * 256 + e) * 128 + 4 * dg); U[ch] = (f32x4){bflo(uu.x), bfhi(uu.x), bflo(uu.y), bfhi(uu.y)}; } dc[ch] = DEC[mu]; }
        f32x4 C = {0.f, 0.f, 0.f, 0.f};
#pragma unroll
        for (int ch = 0; ch < 16; ++ch) { const size_t mu = (size_t)bh * 16 + ch;
            u32x2 w; w.x = cvt_pk_bf16(C[0], C[1]); w.y = cvt_pk_bf16(C[2], C[3]);
#ifdef DBG_NO_INTER
            w.x = 0u; w.y = 0u;
#endif
            *(u32x2*)(BE + (mu * 256 + e) * 384 + 256 + 4 * dg) = w;
            C = (C + U[ch]) * dc[ch]; } }
    const float* NU = (const float*)(ws + WS_NU); float* NP = (float*)(ws + WS_NPREV);
    for (int i = gt; i < 16 * 128; i += NGT) { const int bh = i >> 7, d = i & 127; float n = 0.f;
        for (int ch = 0; ch < 16; ++ch) { const int mu = bh * 16 + ch; NP[mu * 128 + d] = n; n = (n + NU[mu * 128 + d]) * DEC[mu];
#ifdef DBG_NO_INTER
            n = 0.f;
#endif
        } }
}
struct Args { const float* in[18]; float* out; unsigned char* ws; int ph_lo, ph_hi; };
__global__ void __launch_bounds__(NTHR, 2) mk_fwd(Args args) {
    extern __shared__ __attribute__((aligned(16))) unsigned char lds[];
    Frame F;
    const char __attribute__((address_space(4)))* kargp = (const char __attribute__((address_space(4)))*)__builtin_amdgcn_kernarg_segment_ptr();
#define AIN(i) ({ const char __attribute__((address_space(4)))* k_ = kargp; asm volatile("" : "+s"(k_)); *(const float* const __attribute__((address_space(4)))*)(k_ + 8 * (i)); })
    unsigned char* const ws0 = (unsigned char*)AIN(19);
    F.lds = (LAS unsigned char*)lds; F.ws = ws0; F.ctl = (unsigned*)(ws0 + WS_CTL);
    F.tid = threadIdx.x; F.lane = F.tid & 63; F.wave = __builtin_amdgcn_readfirstlane(F.tid >> 6);
    F.G = gridDim.x; { const int bx = blockIdx.x; F.vcu = (F.G % 8 == 0) ? (bx % 8) * (F.G / 8) + bx / 8 : bx; }
    for (int u = F.tid; u < (LDS_BYTES - LX) / 4; u += NTHR) ((LAS unsigned*)(F.lds + LX))[u] = 0u;
    __syncthreads();
    int lo, hi; { const char __attribute__((address_space(4)))* k_ = kargp; lo = *(const int __attribute__((address_space(4)))*)(k_ + 160); hi = *(const int __attribute__((address_space(4)))*)(k_ + 164); }
    XcdBarrier bar; bar.bar = (unsigned*)(F.ctl + CW_BAR); bar.x = 0; bar.st = nullptr;
    if (hi - lo > 1) bar = xcd_barrier_post((unsigned*)(F.ctl + CW_BAR), (volatile LAS unsigned*)(F.lds + LX_MISC) + 8);
#ifndef PHASE_MASK
#define PHASE_MASK 0x7FFFF
#endif
#define IN(k) ((((PHASE_MASK) >> (k)) & 1) && lo <= (k) && (k) < hi)
#ifndef REPEAT_MASK
#define REPEAT_MASK 0
#endif
#define PH(k) if (IN(k))
#define SEAM(k) do { if (IN(k) && IN((k) + 1)) xcd_barrier(bar); } while (0)
    unsigned char* ws = ws0;
#define x_in AIN(0)
#define ln_mix_g AIN(8)
#define ln_mix_b AIN(9)
#define ln_ffn_g AIN(10)
#define ln_ffn_b AIN(11)
#define router_b AIN(13)
#define b_gu AIN(15)
#define b_dn AIN(17)
    bf16_t* XB = (bf16_t*)(ws + WS_XB); bf16_t* QB_ = (bf16_t*)(ws + WS_Q); bf16_t* KB_ = (bf16_t*)(ws + WS_K); bf16_t* VB_ = (bf16_t*)(ws + WS_V);
    bf16_t* R0 = (bf16_t*)(ws + WS_R0); bf16_t* R1 = (bf16_t*)(ws + WS_R1);
    bf16_t* HB = (bf16_t*)(ws + WS_H); bf16_t* YB = (bf16_t*)(ws + WS_Y);
    LAS unsigned char* ring = F.lds + RING_OFF;
    const int cG = (int)blockIdx.x;
    const bool isConv = (NCONV > 0) && ((int)blockIdx.x >= F.G - NCONV);
    const int Gc = F.G - NCONV, cwv = ((int)blockIdx.x - Gc) * NWAVES + F.wave, ncw = NCONV * NWAVES;
#define CONV_SLICE(a, b) conv_items(F, AIN(14), AIN(16), (int)((long)CONV_ITEMS * (a) / 1000), (int)((long)CONV_ITEMS * (b) / 1000), cwv, ncw)

    PH(0) { P0In I{x_in, AIN(2), AIN(3), AIN(4), AIN(7), AIN(12), AIN(14), AIN(16), (const int*)AIN(1)}; p0_prologue(F, I); }
    SEAM(0);
    PH(1) { { Gemm g{1024, 1024, 1024, nullptr}; DenseSched S{64, 12, F.G, cG, (const char*)XB, (const char*)(ws + WS_WQKV), (size_t)256 * 1024 * 2, (size_t)256 * 1024 * 2};
        EpiQKV E{QB_, KB_, VB_, (const float*)(ws + WS_ROPE), (float*)(ws + WS_KSUM), (LAS float*)(F.lds + LX_ROPE)};
        pg8::gemm_phase<EpiQKV, DenseSched, true, false>(ring, g, S, E); } }
    SEAM(1);
    PH(2) { if (isConv) CONV_SLICE(0, 1000); else {
        const attn_body::AttnTensors AT{(const attn_body::bf16*)QB_, (const attn_body::bf16*)KB_, (const attn_body::bf16*)VB_, (attn_body::bf16*)QB_, (const float*)(ws + WS_KSUM)};
        if (NCONV == 0) { const attn_body::StaticOrder S((int)F.G, (int)blockIdx.x); attn_body::attn_phase<attn_body::StaticOrder>((char*)lds + RING_OFF, AT, S); }
        else { const attn_body::SnakeOrder S{cG, Gc}; attn_body::attn_phase<attn_body::SnakeOrder>((char*)lds + RING_OFF, AT, S); } } }
    SEAM(2);
    PH(3) { { Gemm g{1024, 1024, 1024, nullptr}; DenseSched S{64, 4, F.G, cG, (const char*)QB_, (const char*)(ws + WS_WO), (size_t)256 * 1024 * 2, (size_t)256 * 1024 * 2};
        EpiZ E{XB, R0, DBG_ATTN_MUL}; pg8::gemm_phase<EpiZ, DenseSched, true, false>(ring, g, S, E); } }
    SEAM(3);
    PH(4) phase_ln_router(F, R0, R1, ln_mix_g, ln_mix_b, router_b, 0, 0);
    SEAM(4);
    PH(5) { const int nT = moe_tables(F, 0); LAS unsigned short* tokl = (LAS unsigned short*)(F.lds + LX_TOKL);
        { const unsigned short* rowtok = (const unsigned short*)(ws + WS_ROWTOK); const LAS int* tile_e = (const LAS int*)(F.lds + LX_TILEE); const LAS int* tbase = (const LAS int*)(F.lds + LX_TBASE);
          for (int i = 0; i < TOKL_ROUNDS; ++i) { int pm, pn, hf; if (!moe_unit(i, F.G, cG, nT, 8, pm, pn, hf)) break;
              if (F.tid < 256) { const int e = tile_e[pm]; const int r = (pm - tbase[e]) * 256 + F.tid; const int c = (int)__hip_atomic_load(F.ctl + CW_CNT + 0 * 2048 + e * 64, RLX_AGENT);
                  tokl[i * 256 + F.tid] = (r < c) ? rowtok[(size_t)e * NTOK + r] : (unsigned short)0; } }
          __syncthreads(); }
        Gemm g{512, 512, 512, (const char*)XB};
        MoeSched S{nT, 8, F.G, cG, (const LAS int*)(F.lds + LX_TILEE), (const LAS int*)(F.lds + LX_TBASE), tokl, nullptr, (const char*)(ws + WS_WGU) + (size_t)0 * 32 * 2048 * 1024, 0, (size_t)2048 * 1024, (size_t)256 * 1024};
        EpiGU E{b_gu + (size_t)0 * 32 * 2048, (unsigned char*)HB, (LAS float*)(F.lds + LX_BIAS), 0}; pg8::gemm_phase<EpiGU, MoeSched, true, true, true, true>(ring, g, S, E); }
    SEAM(5);
    PH(6) { const int nT = moe_tables(F, 0); Gemm g{512, 512, 512, nullptr};
        MoeSched S{nT, 4, F.G, cG, (const LAS int*)(F.lds + LX_TILEE), (const LAS int*)(F.lds + LX_TBASE), nullptr, (const char*)HB, (const char*)(ws + WS_WD) + (size_t)0 * 32 * 1024 * 1024, (size_t)256 * 1024, (size_t)1024 * 1024, (size_t)256 * 1024};
        EpiDN E{b_dn + (size_t)0 * 32 * 1024, (unsigned char*)YB, (LAS float*)(F.lds + LX_BIAS), 0}; pg8::gemm_phase<EpiDN, MoeSched, true, false, true, true>(ring, g, S, E); }
    SEAM(6);
    PH(7) phase_combine<true>(F, R1, nullptr, ln_ffn_g, ln_ffn_b, AIN(5), 0);
    { F.lane = (int)attn_body::lane_now(); F.tid = F.wave * 64 + F.lane; }
    SEAM(7);
    PH(8) phase_gate_scan(F);
    SEAM(8);
    PH(9) {
        { Gemm g{1024, 1024, 1024, nullptr}; DenseSched S{64, 8, F.G, cG, (const char*)XB, (const char*)(ws + WS_WINA), (size_t)256 * 1024 * 2, (size_t)256 * 1024 * 2};
          EpiINA E{(const float*)(ws + WS_RF), (const float*)(ws + WS_CF), (bf16_t*)(ws + WS_AE), (bf16_t*)(ws + WS_KN), (bf16_t*)(ws + WS_OS)};
          pg8::gemm_phase<EpiINA, DenseSched, true, false>(ring, g, S, E); }
        { Gemm g{1024, 1024, 1024, nullptr}; DenseSched S{6, 64, F.G, cG, (const char*)(ws + WS_WINB), (const char*)XB, (size_t)256 * 1024 * 2, (size_t)256 * 1024 * 2, true};
          EpiINB E{(const float*)(ws + WS_CF), (bf16_t*)(ws + WS_KT), (bf16_t*)(ws + WS_BE)};
          pg8::gemm_phase<EpiINB, DenseSched, true, false, false, true>(ring, g, S, E); }
    }
    SEAM(9);
    PH(10) { Gemm g{256, 384, NTOK, nullptr}; MuSched S{F.G, cG, 0, (const char*)(ws + WS_BE), (const char*)(ws + WS_KT)};
        EpiM1 E{(bf16_t*)(ws + WS_UT)}; pg8::gemm_phase<EpiM1, MuSched, true, false, false, true>(ring, g, S, E);
        phase_nu(F); }
    SEAM(10);
    PH(11) phase_state_scan(F);
    SEAM(11);
    PH(12) { Gemm g{128, 512, 1024, nullptr}; MuSched S{F.G, cG, 1, (const char*)(ws + WS_AE), (const char*)(ws + WS_KN)};
        EpiM2A E{(bf16_t*)(ws + WS_AE), (const float*)(ws + WS_NPREV), (float*)(ws + WS_DEN)}; pg8::gemm_phase<EpiM2A, MuSched, true, false>(ring, g, S, E); }
    SEAM(12);
    PH(13) { Gemm g{384, 512, 384, nullptr}; MuSched S{F.G, cG, 2, (const char*)(ws + WS_AE), (const char*)(ws + WS_BE)};
        EpiM2B E{(const float*)(ws + WS_DEN), AIN(6), (const bf16_t*)(ws + WS_OS), (bf16_t*)(ws + WS_HN), (LAS float*)(F.lds + LX_LNX)};
        pg8::gemm_phase<EpiM2B, MuSched, true, false>(ring, g, S, E); }
    SEAM(13);
    PH(14) { Gemm g{1024, 1024, 1024, nullptr}; DenseSched S{64, 4, F.G, cG, (const char*)(ws + DBG_P14_A), (const char*)(ws + WS_WOUT), (size_t)256 * 1024 * 2, (size_t)256 * 1024 * 2};
        EpiZ E{XB, R0, DBG_MLSTM_MUL}; pg8::gemm_phase<EpiZ, DenseSched, true, false>(ring, g, S, E); }
    SEAM(14);
    PH(15) phase_ln_router(F, R0, R1, ln_mix_g + 1024, ln_mix_b + 1024, router_b + 32, 1, 1);
    SEAM(15);
    PH(16) { const int nT = moe_tables(F, 1); LAS unsigned short* tokl = (LAS unsigned short*)(F.lds + LX_TOKL);
        { const unsigned short* rowtok = (const unsigned short*)(ws + WS_ROWTOK); const LAS int* tile_e = (const LAS int*)(F.lds + LX_TILEE); const LAS int* tbase = (const LAS int*)(F.lds + LX_TBASE);
          for (int i = 0; i < TOKL_ROUNDS; ++i) { int pm, pn, hf; if (!moe_unit(i, F.G, cG, nT, 8, pm, pn, hf)) break;
              if (F.tid < 256) { const int e = tile_e[pm]; const int r = (pm - tbase[e]) * 256 + F.tid; const int c = (int)__hip_atomic_load(F.ctl + CW_CNT + 1 * 2048 + e * 64, RLX_AGENT);
                  tokl[i * 256 + F.tid] = (r < c) ? rowtok[(size_t)e * NTOK + r] : (unsigned short)0; } }
          __syncthreads(); }
        Gemm g{512, 512, 512, (const char*)XB};
        MoeSched S{nT, 8, F.G, cG, (const LAS int*)(F.lds + LX_TILEE), (const LAS int*)(F.lds + LX_TBASE), tokl, nullptr, (const char*)(ws + WS_WGU) + (size_t)1 * 32 * 2048 * 1024, 0, (size_t)2048 * 1024, (size_t)256 * 1024};
        EpiGU E{b_gu + (size_t)1 * 32 * 2048, (unsigned char*)HB, (LAS float*)(F.lds + LX_BIAS), 0}; pg8::gemm_phase<EpiGU, MoeSched, true, true, true, true>(ring, g, S, E); }
    SEAM(16);
    PH(17) { const int nT = moe_tables(F, 1); Gemm g{512, 512, 512, nullptr};
        MoeSched S{nT, 4, F.G, cG, (const LAS int*)(F.lds + LX_TILEE), (const LAS int*)(F.lds + LX_TBASE), nullptr, (const char*)HB, (const char*)(ws + WS_WD) + (size_t)1 * 32 * 1024 * 1024, (size_t)256 * 1024, (size_t)1024 * 1024, (size_t)256 * 1024};
        EpiDN E{b_dn + (size_t)1 * 32 * 1024, (unsigned char*)YB, (LAS float*)(F.lds + LX_BIAS), 0}; pg8::gemm_phase<EpiDN, MoeSched, true, false, true, true>(ring, g, S, E); }
    SEAM(17);
    PH(18) phase_combine<false>(F, R1, (float*)AIN(18), ln_ffn_g + 1024, ln_ffn_b + 1024, nullptr, 1);
#undef IN
#undef CONV_SLICE
#undef AIN
#undef x_in
#undef ln_mix_g
#undef ln_mix_b
#undef ln_ffn_g
#undef ln_ffn_b
#undef router_b
#undef b_gu
#undef b_dn
#undef SEAM
}

extern "C" void kernel_launch(void* const* d_in, const int* in_sizes, int n_in, void* d_out, int out_size, void* d_ws, size_t ws_size, hipStream_t stream) {
    static int grid = 0;
    if (grid == 0) {
        if (n_in != 18 || out_size != NTOK * DM || ws_size < WS_END) { fprintf(stderr, "kernel_launch: unexpected problem shape (n_in %d, out %d, ws %zu)\n", n_in, out_size, ws_size); grid = -1; return; }
        int dev = 0, cus = 0, per_cu = 0;
        if (hipGetDevice(&dev) != hipSuccess || hipDeviceGetAttribute(&cus, hipDeviceAttributeMultiprocessorCount, dev) != hipSuccess) { grid = -1; return; }
        if (hipFuncSetAttribute((const void*)mk_fwd, hipFuncAttributeMaxDynamicSharedMemorySize, LDS_BYTES) != hipSuccess) { fprintf(stderr, "kernel_launch: hipFuncSetAttribute failed\n"); grid = -1; return; }
        if (hipOccupancyMaxActiveBlocksPerMultiprocessor(&per_cu, (const void*)mk_fwd, NTHR, LDS_BYTES) != hipSuccess || per_cu < 1) fprintf(stderr, "kernel_launch: occupancy query reports %d\n", per_cu);
        (void)hipGetLastError();
        grid = cus;
        if (grid > 256) grid = 256;
        if (grid < 240) { fprintf(stderr, "kernel_launch: %d CUs: this build needs 240..256\n", cus); grid = -1; return; }
    }
    if (grid < 0) return;
    if (hipMemsetAsync((char*)d_ws + WS_CTL, 0, CTL_ZERO_BYTES, stream) != hipSuccess) return;
    Args a{};
    for (int i = 0; i < 18; ++i) a.in[i] = (const float*)d_in[i];
    a.out = (float*)d_out; a.ws = (unsigned char*)d_ws;
#if MK_ONE_LAUNCH
    a.ph_lo = 0; a.ph_hi = NPHASE;
    hipLaunchKernelGGL(mk_fwd, dim3(grid), dim3(NTHR), LDS_BYTES, stream, a);
#else
    for (int p = 0; p < NPHASE; ++p) { a.ph_lo = p; a.ph_hi = p + 1; hipLaunchKernelGGL(mk_fwd, dim3(grid), dim3(NTHR), LDS_BYTES, stream, a); }
#endif
}
```

```cpp
#include <hip/hip_runtime.h>
#include <hip/hip_bf16.h>
#include <cstdio>
#include <cstdint>
#include <cmath>

#define LAS __attribute__((address_space(3)))
#define GAS __attribute__((address_space(1)))
typedef unsigned short bf16_t;
typedef short bf16x8 __attribute__((ext_vector_type(8)));
typedef float f32x4 __attribute__((ext_vector_type(4)));
typedef float f32x2 __attribute__((ext_vector_type(2)));
typedef unsigned u32x4 __attribute__((ext_vector_type(4)));
typedef unsigned u32x2 __attribute__((ext_vector_type(2)));
typedef int i32x4 __attribute__((ext_vector_type(4)));
typedef int i32x8 __attribute__((ext_vector_type(8)));

typedef __bf16 bf16x2_t __attribute__((ext_vector_type(2)));
__device__ __forceinline__ unsigned cvt_pk_bf16(float lo, float hi) { const f32x2 v = {lo, hi}; const bf16x2_t b = __builtin_convertvector(v, bf16x2_t); return __builtin_bit_cast(unsigned, b); }
__device__ __forceinline__ float bf2f(unsigned short b) { return __uint_as_float(((unsigned)b) << 16); }
__device__ __forceinline__ float bflo(unsigned w) { return __uint_as_float(w << 16); }
__device__ __forceinline__ float bfhi(unsigned w) { return __uint_as_float(w & 0xffff0000u); }

__device__ __forceinline__ void glds16s(const void* sbase, unsigned voff, unsigned lds_dst) { unsigned keep;
    asm volatile("s_nop 4\n\ts_mov_b32 %0, m0\n\ts_mov_b32 m0, %3\n\ts_nop 0\n\tglobal_load_lds_dwordx4 %1, %2\n\ts_mov_b32 m0, %0" : "=&s"(keep) : "v"(voff), "s"(sbase), "s"(lds_dst) : "memory"); }
__device__ __forceinline__ void glds4s(const void* sbase, unsigned voff, unsigned lds_dst) { unsigned keep;
    asm volatile("s_nop 4\n\ts_mov_b32 %0, m0\n\ts_mov_b32 m0, %3\n\ts_nop 0\n\tglobal_load_lds_dword %1, %2\n\ts_mov_b32 m0, %0" : "=&s"(keep) : "v"(voff), "s"(sbase), "s"(lds_dst) : "memory"); }
__device__ __forceinline__ const char* uni_ptr(const char* p) { const unsigned long long v = (unsigned long long)p; const unsigned lo = __builtin_amdgcn_readfirstlane((unsigned)v), hi = __builtin_amdgcn_readfirstlane((unsigned)(v >> 32)); return (const char*)(((unsigned long long)hi << 32) | lo); }
namespace pg8 {
constexpr int BM = 256, BK = 64, HALF = 128, HTB = HALF * BK * 2, STAGE_BYTES = 8 * HTB, NXCD = 8, WGM = 8;
__host__ __device__ __forceinline__ int lds_byte(int r, int c) { const int st = (r >> 4) * 2 + (c >> 5), rr = r & 15, cc = c & 31, ob = rr * 64 + cc * 2; return st * 1024 + (ob ^ (((ob >> 9) & 1) << 5)); }
__host__ __device__ __forceinline__ void stage_rc(int b, int& R, int& C) { const int st = b / 1024, sb = b % 1024, swz = sb ^ (((sb >> 9) & 1) << 5); R = (st >> 1) * 16 + swz / 64; C = (st & 1) * 32 + (swz % 64) / 2; }
__host__ __device__ __forceinline__ int perm32(int rho) { const int n = rho >> 4, i = rho & 15; return 8 * (i >> 2) + 4 * n + (i & 3); }

struct Unit { int pm, pn; const char* A; const char* B; const LAS unsigned short* tl; int x0, x1, x2; };
struct Gemm { int K, lda, ldb; const char* Abase; };

__device__ __forceinline__ bool tile_order(int i, int G, int c, int nM, int nN, int& pm, int& pn) {
    const int nwg = nM * nN; const long L = (long)i * G + c; if (L >= nwg) return false;
    int wgid = (int)L; { const int q = nwg / NXCD, r = nwg % NXCD, xcd = wgid % NXCD, off = wgid / NXCD; wgid = (xcd < r ? xcd * (q + 1) : r * (q + 1) + (xcd - r) * q) + off; }
    const int nig = WGM * nN, gid = wgid / nig, fm = gid * WGM, gsz = (nM - fm) < WGM ? (nM - fm) : WGM;
    pm = fm + ((wgid % nig) % gsz); pn = (wgid % nig) / gsz; return true;
}

template <class Epi, class Sched, bool ALIGN_EPI, bool GATHER, bool FP8 = false, bool HALFSEL = false>
__device__ __forceinline__ void gemm_phase(LAS unsigned char* lds, const Gemm g, const Sched& S, const Epi& E) {
    const int tid = threadIdx.x, wid = __builtin_amdgcn_readfirstlane(tid >> 6), lane = tid & 63, wr = wid >> 2, wc = wid & 3, fr = lane & 15, fq = lane >> 4;
    const int K = g.K, nt = K / BK;
    int RA[2]; unsigned cA2[2], voffB[2];
#pragma unroll
    for (int i = 0; i < 2; ++i) { int R, C; stage_rc(tid * 16 + i * 8192, R, C); const int Rb = Epi::PERM ? ((R & ~31) + perm32(R & 31)) : R;
        RA[i] = R; cA2[i] = (unsigned)C * 2u; voffB[i] = (unsigned)(Rb * g.ldb + C) * 2u; }
    const size_t kstep = (size_t)(BK * 2);
    const unsigned hstepA = (unsigned)HALF * (unsigned)g.lda * 2u; const size_t hstepB = (size_t)HALF * g.ldb * 2;
    const unsigned ldsb = (unsigned)__builtin_amdgcn_readfirstlane((unsigned)(unsigned long long)lds + (unsigned)wid * 1024u);
    const int aoff = lds_byte(wr * 64 + fr, fq * 8), boff = lds_byte(wc * 32 + fr, fq * 8);
    const int aoff2 = aoff + 1024, boff2 = boff + 1024;
#define PG8_SA(b, h) (((b) * 2 + (h)) * HTB)
#define PG8_SB(b, h) ((4 + (b) * 2 + (h)) * HTB)
#define PG8_STAGE(bufoff, gbase, voff) do { _Pragma("unroll") for (int _i = 0; _i < 2; ++_i) glds16s((gbase), (voff)[_i], ldsb + (unsigned)(bufoff) + _i * 8192u); } while (0)
#define PG8_STAGE_A(bufoff, gbase, AO, h) do { _Pragma("unroll") for (int _i = 0; _i < 2; ++_i) glds16s((gbase), (AO)[h][_i], ldsb + (unsigned)(bufoff) + _i * 8192u); } while (0)
#define PG8_LD8(base_, o1_, o2_) __builtin_shufflevector(*(const LAS i32x4*)(lds + (base_) + (o1_)), *(const LAS i32x4*)(lds + (base_) + (o2_)), 0, 1, 2, 3, 4, 5, 6, 7)
#define PG8_LDA(dst, b, h) do { if constexpr (FP8) { _Pragma("unroll") for (int m = 0; m < 4; ++m) dst##8[m] = PG8_LD8(PG8_SA(b, h) + m * 2048, aoff, aoff2); } \
        else { _Pragma("unroll") for (int m = 0; m < 4; ++m) _Pragma("unroll") for (int k = 0; k < 2; ++k) dst[m][k] = *(const LAS bf16x8*)(lds + PG8_SA(b, h) + aoff + m * 2048 + k * 1024); } } while (0)
#define PG8_LDB(dst, b, h) do { if constexpr (FP8) { _Pragma("unroll") for (int n = 0; n < 2; ++n) dst##8[n] = PG8_LD8(PG8_SB(b, h) + n * 2048, boff, boff2); } \
        else { _Pragma("unroll") for (int n = 0; n < 2; ++n) _Pragma("unroll") for (int k = 0; k < 2; ++k) dst[n][k] = *(const LAS bf16x8*)(lds + PG8_SB(b, h) + boff + n * 2048 + k * 1024); } } while (0)
#define PG8_MMA(ai, bj, At, Bt) do { __builtin_amdgcn_s_setprio(1); _Pragma("unroll") for (int m = 0; m < 4; ++m) _Pragma("unroll") for (int n = 0; n < 2; ++n) { \
        if constexpr (FP8) asm volatile("v_mfma_f32_16x16x128_f8f6f4 %0, %1, %2, %0" : "+v"(acc[ai][bj][m][n]) : "v"(Bt##8[n]), "v"(At##8[m])); \
        else { _Pragma("unroll") for (int k = 0; k < 2; ++k) acc[ai][bj][m][n] = __builtin_amdgcn_mfma_f32_16x16x32_bf16(Bt[n][k], At[m][k], acc[ai][bj][m][n], 0, 0, 0); } } \
        __builtin_amdgcn_s_setprio(0); } while (0)
#define PG8_WAIT_V(n) asm volatile("s_waitcnt vmcnt(" #n ")" ::: "memory")
#define PG8_WAIT_L(n) asm volatile("s_waitcnt lgkmcnt(" #n ")" ::: "memory")
#define PG8_BAR __builtin_amdgcn_s_barrier()
#define PG8_SCHED __builtin_amdgcn_sched_barrier(0)
#define PG8_AOFF(AO, U) do { _Pragma("unroll") for (int _h = 0; _h < 2; ++_h) _Pragma("unroll") for (int _i = 0; _i < 2; ++_i) { \
        if constexpr (GATHER) AO[_h][_i] = (unsigned)(U).tl[RA[_i] + _h * HALF] * (unsigned)(g.lda * 2) + cA2[_i]; \
        else AO[_h][_i] = (unsigned)RA[_i] * (unsigned)(g.lda * 2) + cA2[_i] + (unsigned)_h * hstepA; } } while (0)
    Unit cur, nxt; int ui = 0;
    if (!S.next(0, cur)) return;
    f32x4 acc[2][2][4][2];
#pragma unroll
    for (int a = 0; a < 2; ++a)
#pragma unroll
        for (int b = 0; b < 2; ++b)
#pragma unroll
            for (int m = 0; m < 4; ++m)
#pragma unroll
                for (int n = 0; n < 2; ++n) acc[a][b][m][n] = (f32x4){0.f, 0.f, 0.f, 0.f};
    bf16x8 At[4][2], B0[2][2], B1[2][2]; i32x8 At8[4], B08[2], B18[2];
    E.prep(cur, 0, wid, lane);
    unsigned aoC[2][2], aoN[2][2];
    PG8_AOFF(aoC, cur);
    const char* cA = uni_ptr(GATHER ? g.Abase : cur.A); const char* cB = uni_ptr(cur.B);
    PG8_STAGE(PG8_SB(0, 0), cB, voffB); PG8_STAGE(PG8_SB(0, 1), cB + hstepB, voffB); PG8_STAGE_A(PG8_SA(0, 0), cA, aoC, 0); PG8_STAGE_A(PG8_SA(0, 1), cA, aoC, 1);
    if (wr == 1) PG8_BAR;
    PG8_WAIT_V(2); PG8_BAR;
    PG8_STAGE(PG8_SB(1, 0), cB + kstep, voffB); PG8_STAGE_A(PG8_SA(1, 0), cA + kstep, aoC, 0); PG8_STAGE(PG8_SB(1, 1), cB + hstepB + kstep, voffB);
    PG8_WAIT_V(6); PG8_BAR;
    for (;;) {
        const bool has_next = S.next(ui + 1, nxt);
        if (has_next) E.prep(nxt, ui + 1, wid, lane);
        if constexpr (GATHER) { if (has_next) PG8_AOFF(aoN, nxt); else { _Pragma("unroll") for (int _h = 0; _h < 2; ++_h) _Pragma("unroll") for (int _i = 0; _i < 2; ++_i) aoN[_h][_i] = aoC[_h][_i]; } }
        const char* nA = uni_ptr(GATHER ? g.Abase : (has_next ? nxt.A : cA)); const char* nB = uni_ptr(has_next ? nxt.B : cB);
        const bool dh0 = cur.x2 != 2, dh1 = cur.x2 != 1;
#pragma nounroll
        for (int t = 0; t < nt; t += 2) {
            const bool last = (t == nt - 2);
            if constexpr (Epi::MID) { if (t == 2) E.prep_mid(cur, wid, lane); }
            const char* a1 = cA + (size_t)(t + 1) * kstep;
            const char* a2 = last ? nA : cA + (size_t)(t + 2) * kstep; const char* b2 = last ? nB : cB + (size_t)(t + 2) * kstep;
            const char* a3 = a2 + kstep; const char* b3 = b2 + kstep;
            unsigned aoS[2][2];
#pragma unroll
            for (int _h = 0; _h < 2; ++_h)
#pragma unroll
                for (int _i = 0; _i < 2; ++_i) aoS[_h][_i] = (GATHER && last) ? aoN[_h][_i] : aoC[_h][_i];
            PG8_LDB(B0, 0, 0); PG8_LDB(B1, 0, 1); PG8_SCHED; PG8_LDA(At, 0, 0); PG8_STAGE_A(PG8_SA(1, 1), a1, aoC, 1);
            PG8_WAIT_V(8); PG8_WAIT_L(0); PG8_BAR; if (!HALFSEL || dh0) PG8_MMA(0, 0, At, B0); if (!HALFSEL || dh1) PG8_MMA(0, 1, At, B1); PG8_BAR; PG8_SCHED;
            PG8_LDA(At, 0, 1); PG8_STAGE(PG8_SB(0, 0), b2, voffB); PG8_STAGE(PG8_SB(0, 1), b2 + hstepB, voffB); PG8_STAGE_A(PG8_SA(0, 0), a2, aoS, 0);
            PG8_WAIT_V(8); PG8_WAIT_L(0); PG8_BAR; if (!HALFSEL || dh0) PG8_MMA(1, 0, At, B0); if (!HALFSEL || dh1) PG8_MMA(1, 1, At, B1); PG8_BAR; PG8_SCHED;
            PG8_LDB(B0, 1, 0); PG8_LDB(B1, 1, 1); PG8_SCHED; PG8_LDA(At, 1, 0); PG8_STAGE_A(PG8_SA(0, 1), a2, aoS, 1);
            PG8_WAIT_V(8); PG8_WAIT_L(0); PG8_BAR; if (!HALFSEL || dh0) PG8_MMA(0, 0, At, B0); if (!HALFSEL || dh1) PG8_MMA(0, 1, At, B1); PG8_BAR; PG8_SCHED;
            PG8_LDA(At, 1, 1); PG8_STAGE(PG8_SB(1, 0), b3, voffB); PG8_STAGE(PG8_SB(1, 1), b3 + hstepB, voffB); PG8_STAGE_A(PG8_SA(1, 0), a3, aoS, 0);
            PG8_WAIT_V(8); PG8_WAIT_L(0); PG8_BAR; if (!HALFSEL || dh0) PG8_MMA(1, 0, At, B0); if (!HALFSEL || dh1) PG8_MMA(1, 1, At, B1); PG8_BAR; PG8_SCHED;
        }
        if constexpr (FP8) asm volatile("s_nop 15\n\ts_nop 15" ::: "memory");
        if constexpr (ALIGN_EPI) { if (wr == 0) PG8_BAR; }
        E(acc, cur, wr, wc, fr, fq);
        if (!has_next) break;
#pragma unroll
        for (int a = 0; a < 2; ++a)
#pragma unroll
            for (int b = 0; b < 2; ++b)
#pragma unroll
                for (int m = 0; m < 4; ++m)
#pragma unroll
                    for (int n = 0; n < 2; ++n) acc[a][b][m][n] = (f32x4){0.f, 0.f, 0.f, 0.f};
        if constexpr (FP8) asm volatile("s_nop 7" ::: "memory");
        cur = nxt; cA = nA; cB = nB; ++ui;
        if constexpr (GATHER) {
#pragma unroll
            for (int _h = 0; _h < 2; ++_h)
#pragma unroll
                for (int _i = 0; _i < 2; ++_i) aoC[_h][_i] = aoN[_h][_i]; }
        if constexpr (ALIGN_EPI) { if (wr == 1) PG8_BAR; }
    }
    PG8_WAIT_V(0);
    if constexpr (!ALIGN_EPI) { if (wr == 0) PG8_BAR; }
    PG8_BAR;
#undef PG8_SA
#undef PG8_SB
#undef PG8_STAGE
#undef PG8_STAGE_A
#undef PG8_LDA
#undef PG8_LD8
#undef PG8_LDB
#undef PG8_MMA
#undef PG8_WAIT_V
#undef PG8_WAIT_L
#undef PG8_BAR
#undef PG8_SCHED
#undef PG8_AOFF
}
}
#include <hip/hip_bf16.h>
namespace attn_body {
using bf16=__hip_bfloat16;
using bf16x8=__attribute__((ext_vector_type(8)))short;
using s16x4=__attribute__((ext_vector_type(4)))short;
using f32x16=__attribute__((ext_vector_type(16)))float;
using u32x4=__attribute__((ext_vector_type(4)))unsigned;
constexpr int BATCH=4,NHEAD=16,SEQ=4096,D=64,DM=NHEAD*D;
constexpr int NW=8,QBLK=32,QB=QBLK*NW,KVBLK=64,NQB=SEQ/QB;
constexpr int ATTN_PITCH=DM, ATTN_UNIT_ROWS=QB;
__device__ __forceinline__ int crow(int r,int hi){return (r&3)+8*(r>>2)+4*hi;}
#define SBAR() __builtin_amdgcn_sched_barrier(0)
__device__ __forceinline__ void cmask(f32x16&p0,f32x16&p1,int jb,int qrel,int hi){
  const float NEG=-INFINITY; int d=qrel-64*jb-4*hi; asm volatile("":"+v"(d));
  #pragma unroll
  for(int r=0;r<16;++r){const int c=(r&3)+8*(r>>2); if(c>d)p0[r]=NEG; if(c+32>d)p1[r]=NEG;}
}

constexpr int NSLOT=3, SLOTB=8192;
constexpr int LDS_GT=98304;
constexpr int LDS_K=0, LDS_V=NSLOT*SLOTB, LDS_WS=2*NSLOT*SLOTB, LDS_OST=LDS_WS+NW*64*4, LDS_BYTES=LDS_OST+NW*4096;
constexpr float C2=0.125f*1.4426950408889634f;
__device__ __forceinline__ void glds16(const void*gsrc,unsigned lds_dst){unsigned keep;
  asm volatile("s_mov_b32 %0, m0\n\ts_mov_b32 m0, %2\n\ts_nop 0\n\tglobal_load_lds_dwordx4 %1, off\n\ts_mov_b32 m0, %0":"=&s"(keep):"v"(gsrc),"s"(lds_dst):"memory");}
__device__ __forceinline__ void glds16s(const void*sbase,unsigned voff,unsigned lds_dst){unsigned keep;
  asm volatile("s_nop 4\n\ts_mov_b32 %0, m0\n\ts_mov_b32 m0, %3\n\ts_nop 0\n\tglobal_load_lds_dwordx4 %1, %2\n\ts_mov_b32 m0, %0":"=&s"(keep):"v"(voff),"s"(sbase),"s"(lds_dst):"memory");}
__device__ __forceinline__ unsigned lane_now(){unsigned l;asm volatile("v_mbcnt_lo_u32_b32 %0, -1, 0\n\tv_mbcnt_hi_u32_b32 %0, -1, %0":"=v"(l));return l;}
__device__ __forceinline__ float max3f(float a,float b,float c){float r;asm("v_max3_f32 %0, %1, %2, %3":"=v"(r):"v"(a),"v"(b),"v"(c));return r;}
__device__ __forceinline__ float max2f(float a,float b){float r;asm("v_max_f32_e32 %0, %1, %2":"=v"(r):"v"(a),"v"(b));return r;}
__device__ __forceinline__ float fadd_s(float a,float b){float r;asm("v_add_f32_e32 %0, %1, %2":"=v"(r):"v"(a),"v"(b));return r;}
__device__ __forceinline__ float fsub_s(float a,float b){float r;asm("v_sub_f32_e32 %0, %1, %2":"=v"(r):"v"(a),"v"(b));return r;}
typedef float f32x2_t __attribute__((ext_vector_type(2))); typedef __bf16 bf16x2_t __attribute__((ext_vector_type(2)));
__device__ __forceinline__ unsigned cvtpk_s(float lo,float hi){f32x2_t v={lo,hi};bf16x2_t b=__builtin_convertvector(v,bf16x2_t);return __builtin_bit_cast(unsigned,b);}
#define WAIT_BAR(N) asm volatile("s_waitcnt vmcnt(" #N ") lgkmcnt(0)\n\ts_barrier":::"memory")

__device__ __forceinline__ void qkt(f32x16&p0,f32x16&p1,const char*Kslot,const bf16x8*qr,int r32,int hi){
  const char*kb=Kslot+hi*1024+r32*16;
  #pragma unroll
  for(int d0=0;d0<4;++d0){
    const bf16x8 b0=*reinterpret_cast<const bf16x8*>(kb+d0*2048);
    const bf16x8 b1=*reinterpret_cast<const bf16x8*>(kb+d0*2048+512);
    if(d0==0){p0=__builtin_amdgcn_mfma_f32_32x32x16_bf16(b0,qr[0],(f32x16){0.f,0.f,0.f,0.f,0.f,0.f,0.f,0.f,0.f,0.f,0.f,0.f,0.f,0.f,0.f,0.f},0,0,0);p1=__builtin_amdgcn_mfma_f32_32x32x16_bf16(b1,qr[0],(f32x16){0.f,0.f,0.f,0.f,0.f,0.f,0.f,0.f,0.f,0.f,0.f,0.f,0.f,0.f,0.f,0.f},0,0,0);}
    else{p0=__builtin_amdgcn_mfma_f32_32x32x16_bf16(b0,qr[d0],p0,0,0,0);p1=__builtin_amdgcn_mfma_f32_32x32x16_bf16(b1,qr[d0],p1,0,0,0);}}
}
typedef __attribute__((address_space(3))) const char* lds_cptr;
typedef short v4i16_t __attribute__((ext_vector_type(4)));
__device__ __forceinline__ void kload8(bf16x8*kf,lds_cptr kp){
  kf[0]=*(const __attribute__((address_space(3))) bf16x8*)(kp);      kf[1]=*(const __attribute__((address_space(3))) bf16x8*)(kp+512);
  kf[2]=*(const __attribute__((address_space(3))) bf16x8*)(kp+2048); kf[3]=*(const __attribute__((address_space(3))) bf16x8*)(kp+2560);
  kf[4]=*(const __attribute__((address_space(3))) bf16x8*)(kp+4096); kf[5]=*(const __attribute__((address_space(3))) bf16x8*)(kp+4608);
  kf[6]=*(const __attribute__((address_space(3))) bf16x8*)(kp+6144); kf[7]=*(const __attribute__((address_space(3))) bf16x8*)(kp+6656);
}
__device__ __forceinline__ void kload2(bf16x8*kf,lds_cptr kp,int j){ kf[2*j]=*(const __attribute__((address_space(3))) bf16x8*)(kp+j*2048); kf[2*j+1]=*(const __attribute__((address_space(3))) bf16x8*)(kp+j*2048+512); }
__device__ __forceinline__ s16x4 vtr(lds_cptr p){ return __builtin_bit_cast(s16x4,__builtin_amdgcn_ds_read_tr16_b64_v4i16((__attribute__((address_space(3))) v4i16_t*)p)); }
__device__ __forceinline__ float rowmax(const f32x16&p0,const f32x16&p1){
  float a=max3f(p0[0],p0[1],p1[0]),b=max3f(p0[2],p0[3],p1[1]);a=max3f(a,p1[2],p1[3]);
  #pragma unroll
  for(int r=4;r<16;r+=4){a=max3f(a,p0[r],p0[r+1]);b=max3f(b,p0[r+2],p0[r+3]);a=max3f(a,p1[r],p1[r+1]);b=max3f(b,p1[r+2],p1[r+3]);}
  const float m=max2f(a,b);
  auto rr=__builtin_amdgcn_permlane32_swap(__float_as_uint(m),__float_as_uint(m),false,false);
  return max2f(__uint_as_float(rr[0]),__uint_as_float(rr[1]));
}
__device__ __forceinline__ void pv(f32x16*o,int vb,bf16x8 pa0,bf16x8 pa1,bf16x8 pa2,bf16x8 pa3){
  #pragma unroll
  for(int d0=0;d0<2;++d0){s16x4 lo[4],hi[4];
    #pragma unroll
    for(int ks=0;ks<4;++ks){
      asm volatile("ds_read_b64_tr_b16 %0,%1 offset:%c2":"=&v"(lo[ks]):"v"(vb),"i"(d0*4096+ks*1024):"memory");
      asm volatile("ds_read_b64_tr_b16 %0,%1 offset:%c2":"=&v"(hi[ks]):"v"(vb),"i"(d0*4096+ks*1024+512):"memory");}
    asm volatile("s_waitcnt lgkmcnt(0)":::"memory");SBAR();
    #define PK(k) (bf16x8){lo[k][0],lo[k][1],lo[k][2],lo[k][3],hi[k][0],hi[k][1],hi[k][2],hi[k][3]}
    o[d0]=__builtin_amdgcn_mfma_f32_32x32x16_bf16(pa0,PK(0),o[d0],0,0,0);
    o[d0]=__builtin_amdgcn_mfma_f32_32x32x16_bf16(pa1,PK(1),o[d0],0,0,0);
    o[d0]=__builtin_amdgcn_mfma_f32_32x32x16_bf16(pa2,PK(2),o[d0],0,0,0);
    o[d0]=__builtin_amdgcn_mfma_f32_32x32x16_bf16(pa3,PK(3),o[d0],0,0,0);
    #undef PK
  }
}

#ifndef ATTN_STORE16
#define ATTN_STORE16(p,v) (*(u32x4*)(p)=(v))
#endif
template<int THRL> __device__ __forceinline__ void attn_unit(int b,int h,int qb,const bf16*Q,const bf16*__restrict__ K,const bf16*__restrict__ V,bf16*O,const float*ksum,char*shm){
  const int tid=threadIdx.x,lane=tid&63,r32=lane&31,hi=lane>>5; const int wid=__builtin_amdgcn_readfirstlane(tid>>6);
  const long rowbase=(long)b*SEQ; const int q0=qb*QB;
  const bf16*Qw=Q+(rowbase+q0+wid*QBLK)*DM+h*D;
  const bf16*Kh=K+rowbase*DM+h*D,*Vh=V+rowbase*DM+h*D;
  const unsigned lds0=(unsigned)(uintptr_t)shm;
  float*wsf=(float*)(shm+LDS_WS)+wid*64;
  const unsigned kdst=lds0+LDS_K+wid*1024, vdst=lds0+LDS_V+wid*1024;
  #define PHYS(t) (((t)<4)?(4*qb+(t)):((t)-4))
  #define DMA_K(t,slot) glds16s((const char*)Kh+(size_t)PHYS(t)*(KVBLK*DM*2)+wid*16,lane_now()*(unsigned)(DM*2),(unsigned)__builtin_amdgcn_readfirstlane(kdst+(slot)))
  #define DMA_V(t,slot) glds16s((const char*)Vh+(size_t)PHYS(t)*(KVBLK*DM*2)+(size_t)(16*(wid&3))*(DM*2)+(wid>>2)*64,({const unsigned l_=lane_now(); (l_>>2)*(unsigned)(DM*2)+(l_&3u)*16u;}),(unsigned)__builtin_amdgcn_readfirstlane(vdst+(slot)))
  const int vb0=(int)(lds0+LDS_V)+((lane>>4)&1)*32+(lane&3)*8+(4*hi+((lane&15)>>2))*64;
  const char*Kbase=shm+LDS_K; bf16x8 kf[8];
  const lds_cptr shm3=(lds_cptr)shm; const lds_cptr kp0=shm3+LDS_K+hi*1024+r32*16; const lds_cptr vp0=shm3+LDS_V+((lane>>4)&1)*32+(lane&3)*8+(4*hi+((lane&15)>>2))*64;
  const int NT=(q0+QB)/KVBLK;
  DMA_K(0,0);DMA_V(0,0);DMA_K(1,SLOTB);
  { float*gt=(float*)(shm+LDS_GT);
    #pragma unroll
    for(int k=0;k<2;++k){ const int j=2*wid+k; if(j<qb) gt[j*64+lane]=ksum[(long)(b*16+j)*DM+h*D+lane]; } }
  bf16x8 qr[4];
  #pragma unroll
  for(int d0=0;d0<4;++d0)qr[d0]=*reinterpret_cast<const bf16x8*>(&Qw[(long)r32*DM+d0*16+hi*8]);

  unsigned sel=0u;
  float mhat=0.f,l_reg=0.f;f32x16 o[2];o[0]=f32x16{};o[1]=f32x16{};
  bf16x8 kone=(bf16x8){0,0,0,0,0,0,0,0}, qm=(bf16x8){0,0,0,0,0,0,0,0}; if(hi==0) kone[0]=(short)0x3F80;
  #define SETQM() do{ const unsigned short mb_=(unsigned short)(cvtpk_s(-mhat,0.f)&0xffffu); qm[0]=(hi==0)?(short)mb_:(short)0; asm volatile("":"+v"(qm)); }while(0)
  const int qrel=wid*QBLK+r32;
  #define CMASK(P0,P1,t) do{ const int t_=(t); if(t_<4){ const int l_=(int)lane_now(); cmask(P0,P1,t_,wid*QBLK+(l_&31),l_>>5); } else if(!((sel>>(((t_-4)>>2)&15))&1u)){ _Pragma("unroll") for(int r=0;r<16;++r){P0[r]=-INFINITY;P1[r]=-INFINITY;} } }while(0)
  bool resc=false;
  #define START(P0,P1) do{ const float rm=rowmax(P0,P1); resc=false; \
    { const float dl=__uint_as_float(cvtpk_s(rm,0.f)<<16); mhat=fadd_s(mhat,dl);          \
      _Pragma("unroll") for(int r=0;r<16;++r){P0[r]=fsub_s(P0[r],dl);P1[r]=fsub_s(P1[r],dl);} \
      SETQM(); } \
    _Pragma("unroll") for(int r=0;r<16;++r)P0[r]=__builtin_amdgcn_exp2f(P0[r]); }while(0)
  #define RESC() do{ if(resc){ asm volatile("s_waitcnt lgkmcnt(0)":::"memory"); \
      _Pragma("unroll") for(int d_=0;d_<2;++d_) _Pragma("unroll") for(int r=0;r<16;++r)o[d_][r]*=wsf[crow(r,(int)(lane_now()>>5))]; } }while(0)
  f32x16 pA0,pA1,pB0,pB1;
  int sl_prev=0,sl_cur=0,sl_next=SLOTB;
  #define ROT() do{sl_prev=sl_cur;sl_cur=sl_next;sl_next=(sl_next==(NSLOT-1)*SLOTB)?0:sl_next+SLOTB;}while(0)
  DMA_K(2,2*SLOTB);
  WAIT_BAR(3);
  { float qf[32];
    #pragma unroll
    for(int d0=0;d0<4;++d0){
      #pragma unroll
      for(int i=0;i<8;++i) qf[d0*8+i]=__uint_as_float(((unsigned)(unsigned short)qr[d0][i])<<16); }
    const float*gt=(const float*)(shm+LDS_GT)+hi*8; float g[15];
    #pragma unroll
    for(int j=0;j<15;++j){ g[j]=-INFINITY;
      if(j<qb){ const float*kp=gt+j*64; float a=0.f;
        #pragma unroll
        for(int d0=0;d0<4;++d0){ const float4 k0=*reinterpret_cast<const float4*>(kp+d0*16), k1=*reinterpret_cast<const float4*>(kp+d0*16+4);
          a+=qf[d0*8+0]*k0.x; a+=qf[d0*8+1]*k0.y; a+=qf[d0*8+2]*k0.z; a+=qf[d0*8+3]*k0.w; a+=qf[d0*8+4]*k1.x; a+=qf[d0*8+5]*k1.y; a+=qf[d0*8+6]*k1.z; a+=qf[d0*8+7]*k1.w; }
        g[j]=a+__shfl_xor(a,32); } }
    #pragma unroll
    for(int kk=0;kk<3;++kk){ float best=-INFINITY; int bj=-1;
      #pragma unroll
      for(int j=0;j<15;++j){ const bool c=(j<qb)&&!((sel>>j)&1u)&&(g[j]>best); best=c?g[j]:best; bj=c?j:bj; }
      if(bj>=0) sel|=(1u<<bj); } }
  qkt(pA0,pA1,Kbase,qr,r32,hi);asm volatile("s_nop 15\n\ts_nop 7":"+v"(pA0),"+v"(pA1));CMASK(pA0,pA1,0);
  START(pA0,pA1);
  _Pragma("unroll") for(int r=0;r<16;++r)pA1[r]=__builtin_amdgcn_exp2f(pA1[r]);
  WAIT_BAR(0);
  DMA_K(3,0);DMA_V(1,SLOTB);
  ROT();
  kload8(kf,kp0+sl_cur);
  WAIT_BAR(2);
  s16x4 vlo[8],vhi[8]; u32x4 pw0,pw1,pw2,pw3;
  #define PKW(P,B) cvtpk_s(P[B],P[B+1])
  #define PAF(k) __builtin_bit_cast(bf16x8,pw##k)
  #define VFR(i) (bf16x8){vlo[i][0],vlo[i][1],vlo[i][2],vlo[i][3],vhi[i][0],vhi[i][1],vhi[i][2],vhi[i][3]}
  #define PIN(x) asm volatile("":"+v"(x))
  #define MX3(a,b,c) __builtin_fmaxf(__builtin_fmaxf((a),(b)),(c))
  #define GAPA(MF,A0,A1,A2,A3,W0,W1,PW) do{ MF; sacc+=A0; sacc+=A1; sacc+=A2; sacc+=A3; PIN(sacc); W0; W1; PIN(PW); SBAR(); }while(0)
  #define EX(v) __builtin_amdgcn_exp2f(v)
  #define GAPB(MF,X,B) do{ MF; X[B]=EX(X[B]); X[B+1]=EX(X[B+1]); X[B+2]=EX(X[B+2]); X[B+3]=EX(X[B+3]); PIN(X); SBAR(); }while(0)
  #define VRD(i) do{ vlo[i]=vtr(vp_+(((i)>>2)*4096+((i)&3)*1024)); vhi[i]=vtr(vp_+(((i)>>2)*4096+((i)&3)*1024+512)); }while(0)
  #define KRD(G,j) do{ if(G){ kload2(kf,kp0+sl_next,j); SBAR(); } }while(0)
  #define STEP(C0,C1,P0,P1,t,GK,GV,GL) do{ SBAR(); \
    const lds_cptr vp_=vp0+sl_prev; \
    C0=__builtin_amdgcn_mfma_f32_32x32x16_bf16(kone,qm,(f32x16){0.f,0.f,0.f,0.f,0.f,0.f,0.f,0.f,0.f,0.f,0.f,0.f,0.f,0.f,0.f,0.f},0,0,0); C1=__builtin_amdgcn_mfma_f32_32x32x16_bf16(kone,qm,(f32x16){0.f,0.f,0.f,0.f,0.f,0.f,0.f,0.f,0.f,0.f,0.f,0.f,0.f,0.f,0.f,0.f},0,0,0); SBAR(); \
    VRD(0); SBAR(); float sacc=(P0[0]+P0[1]); \
    GAPA(C0=__builtin_amdgcn_mfma_f32_32x32x16_bf16(kf[0],qr[0],C0,0,0,0), P0[2],P0[3],P0[4],P0[5],     pw0[0]=PKW(P0,0), pw0[1]=PKW(P0,2), pw0); \
    VRD(4); SBAR(); GAPA(C1=__builtin_amdgcn_mfma_f32_32x32x16_bf16(kf[1],qr[0],C1,0,0,0), P0[6],P0[7],P0[8],P0[9],     pw0[2]=PKW(P0,4), pw0[3]=PKW(P0,6), pw0); \
    VRD(1); SBAR(); GAPA(C0=__builtin_amdgcn_mfma_f32_32x32x16_bf16(kf[2],qr[1],C0,0,0,0),   P0[10],P0[11],P0[12],P0[13], pw1[0]=PKW(P0,8), pw1[1]=PKW(P0,10), pw1); \
    VRD(5); SBAR(); GAPA(C1=__builtin_amdgcn_mfma_f32_32x32x16_bf16(kf[3],qr[1],C1,0,0,0),   P0[14],P0[15],P1[0],P1[1],   pw1[2]=PKW(P0,12),pw1[3]=PKW(P0,14), pw1); \
    VRD(2); SBAR(); GAPA(C0=__builtin_amdgcn_mfma_f32_32x32x16_bf16(kf[4],qr[2],C0,0,0,0),   P1[2],P1[3],P1[4],P1[5],     pw2[0]=PKW(P1,0), pw2[1]=PKW(P1,2), pw2); \
    VRD(6); SBAR(); GAPA(C1=__builtin_amdgcn_mfma_f32_32x32x16_bf16(kf[5],qr[2],C1,0,0,0),   P1[6],P1[7],P1[8],P1[9],     pw2[2]=PKW(P1,4), pw2[3]=PKW(P1,6), pw2); \
    VRD(3); SBAR(); GAPA(C0=__builtin_amdgcn_mfma_f32_32x32x16_bf16(kf[6],qr[3],C0,0,0,0),   P1[10],P1[11],P1[12],P1[13], pw3[0]=PKW(P1,8), pw3[1]=PKW(P1,10), pw3); \
    VRD(7); SBAR(); GAPA(C1=__builtin_amdgcn_mfma_f32_32x32x16_bf16(kf[7],qr[3],C1,0,0,0),   P1[14],P1[15],0.f,0.f,       pw3[2]=PKW(P1,12),pw3[3]=PKW(P1,14), pw3); \
    l_reg+=sacc; \
    if(GK){DMA_K((t)+3,sl_cur);} if(GV){DMA_V((t)+1,sl_next);} \
    CMASK(C0,C1,t); \
    { float a=MX3(C0[0],C0[1],C1[0]),b=MX3(C0[2],C0[3],C1[1]); a=MX3(a,C1[2],C1[3]); \
      _Pragma("unroll") for(int r=4;r<16;r+=4){a=MX3(a,C0[r],C0[r+1]);b=MX3(b,C0[r+2],C0[r+3]);a=MX3(a,C1[r],C1[r+1]);b=MX3(b,C1[r+2],C1[r+3]);} \
      float rm=__builtin_fmaxf(a,b); { auto rr=__builtin_amdgcn_permlane32_swap(__float_as_uint(rm),__float_as_uint(rm),false,false); rm=__builtin_fmaxf(__uint_as_float(rr[0]),__uint_as_float(rr[1])); } \
      resc=false; \
      if(__builtin_expect(__any(rm>(float)THRL),0)){ const float mn_=__uint_as_float(cvtpk_s(mhat+__builtin_fmaxf(rm,0.f),0.f)<<16); const float dl=mn_-mhat; mhat=mn_; \
        _Pragma("unroll") for(int r=0;r<16;++r){C0[r]-=dl;C1[r]-=dl;} \
        SETQM(); \
        const float f=__builtin_amdgcn_exp2f(-dl); l_reg*=f; { const int l_=(int)lane_now(); if((l_>>5)==0)wsf[l_&31]=f; } resc=true; } } \
    SBAR(); \
    GAPB(o[0]=__builtin_amdgcn_mfma_f32_32x32x16_bf16(PAF(0),VFR(0),o[0],0,0,0), C0,0); \
    GAPB(o[1]=__builtin_amdgcn_mfma_f32_32x32x16_bf16(PAF(0),VFR(4),o[1],0,0,0), C0,4); \
    KRD(GL,0); GAPB(o[0]=__builtin_amdgcn_mfma_f32_32x32x16_bf16(PAF(1),VFR(1),o[0],0,0,0), C0,8); \
    KRD(GL,1); GAPB(o[1]=__builtin_amdgcn_mfma_f32_32x32x16_bf16(PAF(1),VFR(5),o[1],0,0,0), C0,12); \
    KRD(GL,2); GAPB(o[0]=__builtin_amdgcn_mfma_f32_32x32x16_bf16(PAF(2),VFR(2),o[0],0,0,0), C1,0); \
    KRD(GL,3); GAPB(o[1]=__builtin_amdgcn_mfma_f32_32x32x16_bf16(PAF(2),VFR(6),o[1],0,0,0), C1,4); \
    GAPB(o[0]=__builtin_amdgcn_mfma_f32_32x32x16_bf16(PAF(3),VFR(3),o[0],0,0,0), C1,8); \
    GAPB(o[1]=__builtin_amdgcn_mfma_f32_32x32x16_bf16(PAF(3),VFR(7),o[1],0,0,0), C1,12); \
    }while(0)
  int t=1;
  #undef CMASK
  #define CMASK(P0,P1,t) do{ const int t_=(t); if(t_<4){ const int l_=(int)lane_now(); cmask(P0,P1,t_,wid*QBLK+(l_&31),l_>>5); } else if(!((sel>>(((t_-4)>>2)&15))&1u)){ _Pragma("unroll") for(int r=0;r<16;++r){P0[r]=-INFINITY;P1[r]=-INFINITY;} } }while(0)
  for(;t+5<NT;t+=2){
    STEP(pB0,pB1,pA0,pA1,t,true,true,true);     WAIT_BAR(2); RESC(); ROT();
    STEP(pA0,pA1,pB0,pB1,t+1,true,true,true);   WAIT_BAR(2); RESC(); ROT();
  }
  #undef CMASK
  #define CMASK(P0,P1,t) do{ const int t_=(t); if(t_<4){ const int l_=(int)lane_now(); cmask(P0,P1,t_,wid*QBLK+(l_&31),l_>>5); } else if(!((sel>>(((t_-4)>>2)&15))&1u)){ _Pragma("unroll") for(int r=0;r<16;++r){P0[r]=-INFINITY;P1[r]=-INFINITY;} } }while(0)
  #define ENDW(tt) do{ if((tt)+3<NT){WAIT_BAR(2);} else if((tt)+2<NT){WAIT_BAR(1);} else {WAIT_BAR(0);} }while(0)
  for(;t+1<NT;t+=2){
    STEP(pB0,pB1,pA0,pA1,t,(t+3<NT),(t+1<NT),(t+1<NT));       ENDW(t);   RESC(); ROT();
    STEP(pA0,pA1,pB0,pB1,t+1,(t+4<NT),(t+2<NT),(t+2<NT));     ENDW(t+1); RESC(); ROT();
  }
  STEP(pB0,pB1,pA0,pA1,NT-1,false,false,false); RESC();
  { float sacc=pB0[0]+pB0[1]; _Pragma("unroll") for(int r=2;r<16;++r)sacc+=pB0[r]; _Pragma("unroll") for(int r=0;r<16;++r)sacc+=pB1[r]; l_reg+=sacc;
    pw0=(u32x4){PKW(pB0,0),PKW(pB0,2),PKW(pB0,4),PKW(pB0,6)};pw1=(u32x4){PKW(pB0,8),PKW(pB0,10),PKW(pB0,12),PKW(pB0,14)};pw2=(u32x4){PKW(pB1,0),PKW(pB1,2),PKW(pB1,4),PKW(pB1,6)};pw3=(u32x4){PKW(pB1,8),PKW(pB1,10),PKW(pB1,12),PKW(pB1,14)};
    SBAR(); pv(o,vb0+sl_cur,PAF(0),PAF(1),PAF(2),PAF(3)); }
  #undef PKW
  #undef PAF
  #undef VFR
  #undef PIN
  #undef MX3
  #undef GAPA
  #undef GAPB
  #undef EX
  #undef VRD
  #undef KRD
  #undef STEP
  #undef ENDW
  {auto rr=__builtin_amdgcn_permlane32_swap(__float_as_uint(l_reg),__float_as_uint(l_reg),false,false);l_reg=__uint_as_float(rr[0])+__uint_as_float(rr[1]);}
  if(hi==0)wsf[32+r32]=l_reg;asm volatile("s_waitcnt lgkmcnt(0)":::"memory");
  float rli[16];
  #pragma unroll
  for(int r=0;r<16;++r)rli[r]=__builtin_amdgcn_rcpf(wsf[32+crow(r,hi)]);
  bf16*Ow=O+(rowbase+q0+wid*QBLK)*DM+h*D;
  { bf16*stg=(bf16*)(shm+LDS_OST)+wid*2048;
    #pragma unroll
    for(int r=0;r<16;++r){const int orow=crow(r,hi);
      #pragma unroll
      for(int d0=0;d0<2;++d0)stg[orow*64+d0*32+r32]=__float2bfloat16(o[d0][r]*rli[r]);}
    asm volatile("s_waitcnt lgkmcnt(0)":::"memory");
    #pragma unroll
    for(int i=0;i<4;++i){const int row=i*8+(lane>>3),ch=lane&7; const u32x4 v=*(const u32x4*)(stg+row*64+ch*8); ATTN_STORE16(Ow+(long)row*DM+ch*8,v);} }
  asm volatile("s_waitcnt lgkmcnt(0)\n\ts_barrier":::"memory");
  #undef DMA_K
  #undef PHYS
  #undef DMA_V
  #undef CMASK
  #undef START
  #undef SETQM
  #undef RESC
  #undef ROT
}
constexpr int ATTN_LDS_BYTES=LDS_BYTES;
struct AttnTensors { const bf16* Q; const bf16* K; const bf16* V; bf16* O; const float* ksum; };
struct AttnUnit { int bh; int qb; };
struct StaticOrder {
  int vcu, G;
  __device__ __forceinline__ explicit StaticOrder(int grid,int block):vcu((grid%8==0)?((block%8)*(grid/8)+block/8):block),G(grid){}
  __device__ __forceinline__ bool next(int i,AttnUnit&u)const{ const int L=i*G+vcu; if(L>=1024)return false; const int w=L&255, rnd=L>>8, s=w&3; u.bh=w>>2; u.qb=(rnd==0)?s:(rnd==1)?7-s:(rnd==2)?8+s:15-s; return true; }
  __device__ __forceinline__ void a_ready(const AttnUnit&)const{}
  __device__ __forceinline__ void done(const AttnUnit&)const{}
};
struct SnakeOrder {
  int v, G;
  __device__ __forceinline__ bool next(int i,AttnUnit&u)const{ const int idx=i*G+((i&1)?(G-1-v):v); if(idx>=1024)return false; u.qb=15-(idx>>6); u.bh=idx&63; return true; }
  __device__ __forceinline__ void a_ready(const AttnUnit&)const{}
  __device__ __forceinline__ void done(const AttnUnit&)const{}
};
template<class Sched,int THRL=8> __device__ __forceinline__ void attn_phase(char*lds,const AttnTensors&T,const Sched&S){
  AttnUnit u;
  for(int i=0;S.next(i,u);++i){ S.a_ready(u); attn_unit<THRL>(u.bh/NHEAD,u.bh%NHEAD,u.qb,T.Q,T.K,T.V,T.O,T.ksum,lds); S.done(u); }
}
#undef SBAR
#undef WAIT_BAR
}
constexpr int NWAVES = 8, NTHR = 512;
constexpr int NTOK = 16384, DM = 1024, SEQ = 4096, NBATCH = 4, NEXP = 32;
constexpr float ALPHA = 1.4142135623730951f;
constexpr float LN_EPS = 1e-5f;
constexpr float RSQRT_DQK = 0.08838834764831845f;
constexpr int NPHASE = 19;
constexpr float FP8_SA = 4.0f, FP8_SWGU = 64.0f, FP8_SWD = 128.0f;
constexpr float FP8_SY = 32.0f, FP8_MAXV = 448.0f;
constexpr float FP8_SWIN = 64.0f, SCI = 1.0f / (FP8_SA * FP8_SWIN);
constexpr size_t WS_X8 = (size_t)288 << 20;
#ifndef DBG_ATTN_MUL
#define DBG_ATTN_MUL 1.0f
#endif
#ifndef DBG_MLSTM_MUL
#define DBG_MLSTM_MUL 1.0f
#endif
#ifndef DBG_MOE_MUL
#define DBG_MOE_MUL 1.0f
#endif
#ifndef DBG_P14_A
#define DBG_P14_A WS_HN
#endif
#ifndef NCONV
#define NCONV 80
#endif
#ifndef MK_ONE_LAUNCH
#define MK_ONE_LAUNCH 1
#endif

constexpr size_t MiB = 1u << 20, KiB = 1024;
constexpr size_t WS_CTL = 0, CTL_ZERO_BYTES = 1 * MiB;
constexpr int CW_TMO = 0, CW_BAR = 4096, CW_CNT = 8192, CW_AQ = 16384;
constexpr size_t WS_KSUM = 256 * KiB, WS_DEN = 512 * KiB;
constexpr size_t WS_WQKV = 2 * MiB, WS_WO = 8 * MiB, WS_WINA = 10 * MiB, WS_WINB = 14 * MiB, WS_WOUT = 17 * MiB;
constexpr size_t WS_WG = 19 * MiB, WS_RWT = 20 * MiB, WS_ROPE = 21 * MiB;
constexpr size_t WS_TOKE = 22 * MiB, WS_TOKP = 22 * MiB + 256 * KiB, WS_TOKG = 22 * MiB + 512 * KiB;
constexpr size_t WS_GI = 23 * MiB, WS_LF = 23 * MiB + 256 * KiB, WS_RF = 23 * MiB + 512 * KiB, WS_CF = 23 * MiB + 768 * KiB;
constexpr size_t WS_DEC = 24 * MiB, WS_NU = 24 * MiB + 256 * KiB, WS_NPREV = 24 * MiB + 512 * KiB;
constexpr size_t WS_ROWTOK = 25 * MiB;
constexpr size_t WS_XB = 32 * MiB, WS_Q = 64 * MiB, WS_K = 96 * MiB, WS_V = 128 * MiB;
constexpr size_t WS_R0 = 160 * MiB, WS_R1 = 224 * MiB, WS_R2 = 288 * MiB;
constexpr size_t WS_H = 352 * MiB, WS_Y = 496 * MiB;
constexpr size_t WS_WGU = 640 * MiB, WS_WD = 896 * MiB, WS_END = 1024 * MiB;
constexpr size_t WS_AE = 352 * MiB, WS_BE = 416 * MiB, WS_KN = 464 * MiB, WS_KT = 496 * MiB, WS_UT = 512 * MiB, WS_OS = 544 * MiB, WS_HN = 576 * MiB;

constexpr int RING_OFF = 0, RING_BYTES = 131072;
constexpr int LX = RING_BYTES;
constexpr int LX_MISC = LX;
constexpr int LX_TILEE = LX + 128;
constexpr int LX_TBASE = LX + 1280;
constexpr int LX_LCNT = LX + 1536, LX_GBASE = LX + 1664;
constexpr int LX_REC = LX + 1792;
constexpr int LX_TOKL = LX + 4096;
constexpr int LX_LNX = LX + 4096;
constexpr int LX_BIAS = LX + 12288;
constexpr int LX_ROPE = LX + 16384;
constexpr int LDS_BYTES = 163840;
constexpr int TOKL_ROUNDS = 10;

#define RLX_AGENT __ATOMIC_RELAXED, __HIP_MEMORY_SCOPE_AGENT
#define LDS_WAIT() asm volatile("s_waitcnt lgkmcnt(0)" ::: "memory")
#define VM_WAIT() asm volatile("s_waitcnt vmcnt(0)" ::: "memory")
#define XB_TMO      128
#define XB_XCNT(j)  (256  + 64 * (j))
#define XB_XSUB(j)  (1280 + 64 * (j))
#define XB_XGEN(j)  (2304 + 64 * (j))
#define XB_TOP      3328
#define XB_TOPGEN   3392
#define XCD_BAR_WORDS 3456
#define XB_SPIN_CAP (1u << 18)

__device__ __forceinline__ unsigned xb_ld(unsigned* p)              { return __hip_atomic_load(p, __ATOMIC_RELAXED, __HIP_MEMORY_SCOPE_AGENT); }
__device__ __forceinline__ unsigned xb_add(unsigned* p, unsigned v) { return __hip_atomic_fetch_add(p, v, __ATOMIC_RELAXED, __HIP_MEMORY_SCOPE_AGENT); }
__device__ __forceinline__ unsigned xb_xcc_id() { return (unsigned)__builtin_amdgcn_s_getreg((3 << 11) | 20) & 0xFu; }
#define XB_SPIN(cond, bar) do { unsigned _sp = 0; while (cond) { __builtin_amdgcn_s_sleep(1); \
    if ((++_sp & 255u) == 0u) { if (xb_ld(&(bar)[XB_TMO])) break; if (_sp > XB_SPIN_CAP) { atomicAdd(&(bar)[XB_TMO], 1u); break; } } } } while (0)

struct XcdBarrier {
    unsigned* bar; unsigned x;
    volatile LAS unsigned* st;
};

__device__ __forceinline__ XcdBarrier xcd_barrier_post(unsigned* bar, volatile LAS unsigned* st) {
    XcdBarrier b; b.bar = bar; b.x = xb_xcc_id(); b.st = st;
    if (threadIdx.x == 0) (void)xb_add(&bar[XB_XCNT(b.x)], 1u);
    return b;
}
__device__ __forceinline__ void xcd_barrier_complete(unsigned* bar, unsigned x, unsigned& nloc, unsigned& nx) {
    const unsigned G = gridDim.x * gridDim.y * gridDim.z;
    unsigned sum, cnt, mine, sp = 0u;
    for (;;) {
        sum = 0u; cnt = 0u; mine = 0u;
#pragma unroll
        for (unsigned j = 0; j < 16; ++j) { const unsigned c = xb_ld(&bar[XB_XCNT(j)]); sum += c; cnt += (c > 0u) ? 1u : 0u; mine = (j == x) ? c : mine; }
        if (sum == G) break;
        __builtin_amdgcn_s_sleep(1);
        if ((++sp & 255u) == 0u) { if (xb_ld(&bar[XB_TMO])) break; if (sp > XB_SPIN_CAP) { atomicAdd(&bar[XB_TMO], 1u); break; } }
    }
    nloc = mine > 0u ? mine : 1u; nx = cnt > 0u ? cnt : 1u;
}

__device__ __forceinline__ void xcd_barrier(const XcdBarrier& b) {
    asm volatile("s_waitcnt vmcnt(0)" ::: "memory");
    __syncthreads();
    if (threadIdx.x == 0) {
        unsigned* bar = b.bar;
        __builtin_amdgcn_s_waitcnt(0);
        unsigned nloc = b.st[0], nx = b.st[1];
        if (nloc == 0u) { xcd_barrier_complete(bar, b.x, nloc, nx); b.st[0] = nloc; b.st[1] = nx; }
        const unsigned old = xb_add(&bar[XB_XSUB(b.x)], 1u);
        const unsigned gen = old / nloc;
        if (old + 1u == (gen + 1u) * nloc) {
            __builtin_amdgcn_fence(__ATOMIC_RELEASE, "agent");
            asm volatile("s_waitcnt vmcnt(0)" ::: "memory");
            asm volatile("buffer_inv sc1" ::: "memory");
            const unsigned og = xb_add(&bar[XB_TOP], 1u);
            const unsigned tg = og / nx;
            if (og + 1u == (tg + 1u) * nx) xb_add(&bar[XB_TOPGEN], 1u);
            else XB_SPIN(xb_ld(&bar[XB_TOPGEN]) == tg, bar);
            asm volatile("s_waitcnt vmcnt(0)" ::: "memory");
        } else {
            asm volatile("buffer_inv sc1" ::: "memory");
            XB_SPIN(xb_ld(&bar[XB_TOPGEN]) == gen, bar);
            asm volatile("" ::: "memory");
            asm volatile("s_waitcnt vmcnt(0)" ::: "memory");
        }
    }
    __syncthreads();
}
using pg8::Unit; using pg8::Gemm;
typedef f32x4 (&AccRef)[2][2][4][2];

#ifndef TAIL_FIRST
#define TAIL_FIRST 0
#endif
__device__ __forceinline__ bool moe_unit(int i, int G, int c, int nT, int nN, int& pm, int& pn, int& half) {
    const int U = nT * nN, R = U / G, rem = U - R * G; half = 0;
#if TAIL_FIRST
    if (rem > 0 && 2 * rem <= G) {
        if (c < 2 * rem) { if (i == 0) { half = 1 + (c & 1); return pg8::tile_order(0, U, R * G + (c >> 1), nT, nN, pm, pn); } --i; }
        if (i < R) return pg8::tile_order(i, G, c, nT, nN, pm, pn);
        return false; }
#endif
    if (i < R) return pg8::tile_order(i, G, c, nT, nN, pm, pn);
    if (i > R || rem == 0) return false;
    if (2 * rem <= G) { if (c >= 2 * rem) return false; half = 1 + (c & 1); return pg8::tile_order(0, U, R * G + (c >> 1), nT, nN, pm, pn); }
    return pg8::tile_order(i, G, c, nT, nN, pm, pn);
}
struct DenseSched {
    int nM, nN, G, c; const char* A; const char* B; size_t tstepA, tstepB; bool split = false;
    __device__ __forceinline__ bool next(int i, Unit& u) const {
        int half = 0;
        if (split) { if (!moe_unit(i, G, c, nM, nN, u.pm, u.pn, half)) return false; }
        else if (!pg8::tile_order(i, G, c, nM, nN, u.pm, u.pn)) return false;
        u.A = A + (size_t)u.pm * tstepA; u.B = B + (size_t)u.pn * tstepB; u.tl = nullptr; u.x0 = u.x1 = 0; u.x2 = half; return true; }
};
struct MoeSched {
    int nT, nN, G, c; const LAS int* tile_e; const LAS int* tbase; const LAS unsigned short* tokl;
    const char* A; const char* B; size_t tstepA, estepB, tstepB;
    __device__ __forceinline__ bool next(int i, Unit& u) const {
        int half; if (!moe_unit(i, G, c, nT, nN, u.pm, u.pn, half)) return false;
        const int e = tile_e[u.pm];
        u.x0 = e; u.x1 = u.pm * 256; u.x2 = half;
        u.A = A + (size_t)u.pm * tstepA; u.B = B + (size_t)e * estepB + (size_t)u.pn * tstepB;
        u.tl = tokl ? tokl + (i < TOKL_ROUNDS ? i : TOKL_ROUNDS - 1) * 256 : nullptr; return true; }
};
struct MuSched {
    int G, c, mode; const char* A; const char* B;
    __device__ __forceinline__ bool next(int i, Unit& u) const {
        const int mu = i * G + c; if (mu >= 256) return false;
        const int b = mu >> 6, hh = (mu >> 4) & 3, ch = mu & 15; const size_t tok0 = (size_t)b * SEQ + (size_t)ch * 256;
        u.pm = mu; u.pn = 0; u.x0 = mu; u.x1 = 0; u.x2 = (mode == 0) ? 1 : 0; u.tl = nullptr;
        if (mode == 0) { u.A = A + (size_t)mu * 256 * 384 * 2; u.B = B + ((size_t)(hh * 128) * NTOK + tok0) * 2; }
        else if (mode == 1) { u.A = A + ((size_t)mu * 256 * 512 + 256) * 2; u.B = B + (tok0 * 1024 + (size_t)hh * 256) * 2; }
        else { u.A = A + (size_t)mu * 256 * 512 * 2; u.B = B + (size_t)mu * 256 * 384 * 2; }
        return true; }
};

constexpr float C2 = 0.125f * 1.4426950408889634f;

struct EpiQKV {
    static constexpr bool PERM = true; static constexpr bool MID = true;
    __device__ __forceinline__ void prep(const Unit&, int, int, int) const {}
    __device__ __forceinline__ void prep_mid(const Unit& u, int wid, int lane) const { if ((u.pn >> 2) < 2) {
#pragma unroll
        for (int i = 0; i < 2; ++i) { const int row = (wid * 2 + i) * 16 + (lane >> 2), c = (lane & 3) ^ ((row >> 1) & 3);
            glds16s(uni_ptr((const char*)(rope + (size_t)u.pm * 256 * 16)), (unsigned)(row * 64 + c * 16), (unsigned)__builtin_amdgcn_readfirstlane((unsigned)(unsigned long long)ropel + (unsigned)((wid * 2 + i) * 1024))); } } }
    bf16_t* Q; bf16_t* K; bf16_t* V; const float* rope; float* ksum; LAS float* ropel;
    __device__ __forceinline__ void operator()(AccRef acc, const Unit& u, int wr, int wc, int fr, int fq) const {
        asm volatile("" : "+v"(fr), "+v"(fq));
        const int part = u.pn >> 2, colt = (u.pn & 3) * 256;
        bf16_t* base = Q + (size_t)part * ((WS_K - WS_Q) / 2);
        const bool rot = (part < 2) && ((wc & 1) == 0);
        float ks[2][8];
#pragma unroll
        for (int bj = 0; bj < 2; ++bj)
#pragma unroll
            for (int j = 0; j < 8; ++j) ks[bj][j] = 0.f;
#pragma unroll
        for (int ai = 0; ai < 2; ++ai)
#pragma unroll
            for (int m = 0; m < 4; ++m) {
                const int row = u.pm * 256 + ai * 128 + wr * 64 + m * 16 + fr;
                f32x4 cs = {1.f, 1.f, 1.f, 1.f}, sn = {0.f, 0.f, 0.f, 0.f};
                if (rot && fq < 2) { const int rl = ai * 128 + wr * 64 + m * 16 + fr, sw = (rl >> 1) & 3; const LAS f32x4* rp = (const LAS f32x4*)(ropel + rl * 16);
                    cs = rp[fq ^ sw]; sn = rp[(2 + fq) ^ sw]; }
#pragma unroll
                for (int bj = 0; bj < 2; ++bj) {
                    f32x4 v0 = acc[ai][bj][m][0], v1 = acc[ai][bj][m][1];
                    if (rot) { const f32x4 lo = v0 * cs - v1 * sn, hi = v1 * cs + v0 * sn; v0 = lo; v1 = hi; }
                    if (part == 0) { v0 = v0 * C2; v1 = v1 * C2; }
                    if (part == 1) {
#pragma unroll
                        for (int j = 0; j < 4; ++j) { ks[bj][j] += v0[j]; ks[bj][4 + j] += v1[j]; } }
                    u32x4 w; w.x = cvt_pk_bf16(v0[0], v0[1]); w.y = cvt_pk_bf16(v0[2], v0[3]); w.z = cvt_pk_bf16(v1[0], v1[1]); w.w = cvt_pk_bf16(v1[2], v1[3]);
                    *(u32x4*)(base + (size_t)row * DM + colt + bj * 128 + wc * 32 + fq * 8) = w;
                }
            }
        if (part == 1) {
#pragma unroll
            for (int bj = 0; bj < 2; ++bj)
#pragma unroll
                for (int j = 0; j < 8; ++j) { float s = ks[bj][j]; s += __shfl_xor(s, 1); s += __shfl_xor(s, 2); s += __shfl_xor(s, 4); s += __shfl_xor(s, 8);
                    if (fr == 0) atomicAdd(ksum + (size_t)u.pm * DM + colt + bj * 128 + wc * 32 + fq * 8 + j, s); }
        }
    }
};

struct EpiZ {
    static constexpr bool PERM = true; static constexpr bool MID = false;
    __device__ __forceinline__ void prep(const Unit&, int, int, int) const {}
    const bf16_t* xin; bf16_t* z; float ymul;
    __device__ __forceinline__ void operator()(AccRef acc, const Unit& u, int wr, int wc, int fr, int fq) const {
        asm volatile("" : "+v"(fr), "+v"(fq));
        const size_t off0 = (size_t)(u.pm * 256 + wr * 64 + fr) * DM + u.pn * 256 + wc * 32 + fq * 8;
        u32x4 xr[2][4][2];
#pragma unroll
        for (int ai = 0; ai < 2; ++ai)
#pragma unroll
            for (int m = 0; m < 4; ++m)
#pragma unroll
                for (int bj = 0; bj < 2; ++bj) xr[ai][m][bj] = *(const u32x4*)(xin + off0 + (size_t)(ai * 128 + m * 16) * DM + bj * 128);
        asm volatile("" ::: "memory");
#pragma unroll
        for (int ai = 0; ai < 2; ++ai)
#pragma unroll
            for (int m = 0; m < 4; ++m)
#pragma unroll
                for (int bj = 0; bj < 2; ++bj) { const u32x4 x = xr[ai][m][bj]; const f32x4 a0 = acc[ai][bj][m][0] * ymul, a1 = acc[ai][bj][m][1] * ymul;
                    u32x4 w; w.x = cvt_pk_bf16(bflo(x.x) * ALPHA + a0[0], bfhi(x.x) * ALPHA + a0[1]); w.y = cvt_pk_bf16(bflo(x.y) * ALPHA + a0[2], bfhi(x.y) * ALPHA + a0[3]);
                    w.z = cvt_pk_bf16(bflo(x.z) * ALPHA + a1[0], bfhi(x.z) * ALPHA + a1[1]); w.w = cvt_pk_bf16(bflo(x.w) * ALPHA + a1[2], bfhi(x.w) * ALPHA + a1[3]);
                    *(u32x4*)(z + off0 + (size_t)(ai * 128 + m * 16) * DM + bj * 128) = w; }
    }
};

__device__ __forceinline__ float swiglu1(float glu, float lin) {
    const float g = fminf(glu, 7.0f), l = fminf(fmaxf(lin, -7.0f), 7.0f);
    const float sg = __builtin_amdgcn_rcpf(1.0f + __builtin_amdgcn_exp2f(-1.702f * 1.4426950408889634f * g));
    return g * sg * (l + 1.0f);
}
__device__ __forceinline__ f32x2 swiglu2(float glu0, float lin0, float glu1, float lin1) {
    const f32x2 g = {fminf(glu0, 7.0f), fminf(glu1, 7.0f)}, l = {fminf(fmaxf(lin0, -7.0f), 7.0f), fminf(fmaxf(lin1, -7.0f), 7.0f)};
    const f32x2 t = g * (f32x2){-1.702f * 1.4426950408889634f, -1.702f * 1.4426950408889634f};
    const f32x2 d = (f32x2){__builtin_amdgcn_exp2f(t[0]), __builtin_amdgcn_exp2f(t[1])} + (f32x2){1.0f, 1.0f};
    const f32x2 r = {__builtin_amdgcn_rcpf(d[0]), __builtin_amdgcn_rcpf(d[1])};
    const f32x2 lp = l * (f32x2){FP8_SA, FP8_SA} + (f32x2){FP8_SA, FP8_SA};
    return (g * lp) * r;
}
struct EpiGU {
    static constexpr bool PERM = true; static constexpr bool MID = false;
    __device__ __forceinline__ void prep(const Unit& u, int ui, int wid, int lane) const { if (wid < 4) glds4s(uni_ptr((const char*)(bias + (size_t)u.x0 * 2048 + u.pn * 256 + wid * 64)), (unsigned)lane * 4u, (unsigned)__builtin_amdgcn_readfirstlane((unsigned)(unsigned long long)bl + (unsigned)(((ui & 1) * 256 + wid * 64) * 4))); }
    const float* bias; unsigned char* H; LAS float* bl; mutable int ucnt;
    __device__ __forceinline__ void operator()(AccRef acc, const Unit& u, int wr, int wc, int fr, int fq) const {
        asm volatile("" : "+v"(fr), "+v"(fq));
        const int c0 = u.pn * 256 + wc * 32 + fq * 8; const LAS float* bp = bl + (ucnt & 1) * 256 + wc * 32 + fq * 8; ++ucnt; constexpr float SC = 1.0f / (FP8_SA * FP8_SWGU);
        f32x4 b[2][2];
#pragma unroll
        for (int bj = 0; bj < 2; ++bj) { b[bj][0] = *(const LAS f32x4*)(bp + bj * 128); b[bj][1] = *(const LAS f32x4*)(bp + bj * 128 + 4); }
#pragma unroll
        for (int ai = 0; ai < 2; ++ai)
#pragma unroll
            for (int m = 0; m < 4; ++m) {
                unsigned char* rowp = H + (size_t)(u.x1 + ai * 128 + wr * 64 + m * 16 + fr) * DM + (c0 >> 1);
#pragma unroll
                for (int bj = 0; bj < 2; ++bj) { if (u.x2 == 2 - bj) continue;
                    const f32x4 v0 = acc[ai][bj][m][0] * SC + b[bj][0], v1 = acc[ai][bj][m][1] * SC + b[bj][1];
                    const f32x2 h0 = swiglu2(v0[0], v0[1], v0[2], v0[3]), h1 = swiglu2(v1[0], v1[1], v1[2], v1[3]);
                    int w = __builtin_amdgcn_cvt_pk_fp8_f32(h0[0], h0[1], 0, false);
                    w = __builtin_amdgcn_cvt_pk_fp8_f32(h1[0], h1[1], w, true);
                    *(int*)(rowp + bj * 64) = w; }
            }
    }
};
struct EpiDN {
    static constexpr bool PERM = true; static constexpr bool MID = false;
    __device__ __forceinline__ void prep(const Unit& u, int ui, int wid, int lane) const { if (wid < 4) glds4s(uni_ptr((const char*)(bias + (size_t)u.x0 * 1024 + u.pn * 256 + wid * 64)), (unsigned)lane * 4u, (unsigned)__builtin_amdgcn_readfirstlane((unsigned)(unsigned long long)bl + (unsigned)(((ui & 1) * 256 + wid * 64) * 4))); }
    const float* bias; unsigned char* Y; LAS float* bl; mutable int ucnt;
    __device__ __forceinline__ void operator()(AccRef acc, const Unit& u, int wr, int wc, int fr, int fq) const {
        asm volatile("" : "+v"(fr), "+v"(fq));
        const int c0 = u.pn * 256 + wc * 32 + fq * 8; const LAS float* bp = bl + (ucnt & 1) * 256 + wc * 32 + fq * 8; ++ucnt; constexpr float SC = FP8_SY / (FP8_SA * FP8_SWD);
        f32x4 b[2][2];
#pragma unroll
        for (int bj = 0; bj < 2; ++bj) { b[bj][0] = *(const LAS f32x4*)(bp + bj * 128) * FP8_SY; b[bj][1] = *(const LAS f32x4*)(bp + bj * 128 + 4) * FP8_SY; }
#pragma unroll
        for (int ai = 0; ai < 2; ++ai)
#pragma unroll
            for (int m = 0; m < 4; ++m) {
                unsigned char* rowp = Y + (size_t)(u.x1 + ai * 128 + wr * 64 + m * 16 + fr) * DM + c0;
#pragma unroll
                for (int bj = 0; bj < 2; ++bj) { if (u.x2 == 2 - bj) continue;
                    f32x4 v0 = acc[ai][bj][m][0] * SC + b[bj][0], v1 = acc[ai][bj][m][1] * SC + b[bj][1];
#pragma unroll
                    for (int q = 0; q < 4; ++q) { v0[q] = __builtin_amdgcn_fmed3f(v0[q], -FP8_MAXV, FP8_MAXV); v1[q] = __builtin_amdgcn_fmed3f(v1[q], -FP8_MAXV, FP8_MAXV); }
                    int w0 = __builtin_amdgcn_cvt_pk_fp8_f32(v0[0], v0[1], 0, false); w0 = __builtin_amdgcn_cvt_pk_fp8_f32(v0[2], v0[3], w0, true);
                    int w1 = __builtin_amdgcn_cvt_pk_fp8_f32(v1[0], v1[1], 0, false); w1 = __builtin_amdgcn_cvt_pk_fp8_f32(v1[2], v1[3], w1, true);
                    u32x2 w; w.x = (unsigned)w0; w.y = (unsigned)w1;
                    *(u32x2*)(rowp + bj * 128) = w; }
            }
    }
};

struct EpiINA {
    static constexpr bool PERM = true; static constexpr bool MID = false;
    __device__ __forceinline__ void prep(const Unit&, int, int, int) const {}
    const float* rf; const float* cf; bf16_t* AE; bf16_t* KN; bf16_t* OS;
    __device__ __forceinline__ void operator()(AccRef acc, const Unit& u, int wr, int wc, int fr, int fq) const {
        asm volatile("" : "+v"(fr), "+v"(fq));
        const int b = u.pm >> 4, ch = u.pm & 15, d0 = wc * 32 + fq * 8; const u32x4 zero = {0u, 0u, 0u, 0u};
        if (u.pn < 4) {
            const bool isq = u.pn < 2; const float* fac = isq ? rf : cf; const float fs = (isq ? 1.0f : RSQRT_DQK) * SCI; const int h0 = (u.pn & 1) * 2;
            float sf[2][4][2];
#pragma unroll
            for (int ai = 0; ai < 2; ++ai)
#pragma unroll
                for (int m = 0; m < 4; ++m)
#pragma unroll
                    for (int bj = 0; bj < 2; ++bj) sf[ai][m][bj] = fac[(size_t)(h0 + bj) * NTOK + (size_t)u.pm * 256 + ai * 128 + wr * 64 + m * 16 + fr];
#pragma unroll
            for (int ai = 0; ai < 2; ++ai)
#pragma unroll
                for (int m = 0; m < 4; ++m) {
                    const int t = ai * 128 + wr * 64 + m * 16 + fr; const size_t token = (size_t)u.pm * 256 + t;
#pragma unroll
                    for (int bj = 0; bj < 2; ++bj) { const int hh = h0 + bj; const float s = sf[ai][m][bj] * fs;
                        const f32x4 v0 = acc[ai][bj][m][0] * s, v1 = acc[ai][bj][m][1] * s;
                        const size_t oq = ((size_t)(((b * 4 + hh) * 16 + ch) * 256 + t)) * 512 + 256 + d0, ok = token * 1024 + hh * 256 + d0;
                        bf16_t* dst = isq ? (AE + oq) : (KN + ok);
                        u32x4 w; w.x = cvt_pk_bf16(v0[0], v0[1]); w.y = cvt_pk_bf16(v0[2], v0[3]); w.z = cvt_pk_bf16(v1[0], v1[1]); w.w = cvt_pk_bf16(v1[2], v1[3]);
                        *(u32x4*)dst = w; }
                }
        } else {
#pragma unroll
            for (int ai = 0; ai < 2; ++ai)
#pragma unroll
                for (int m = 0; m < 4; ++m) {
                    const int t = ai * 128 + wr * 64 + m * 16 + fr; const size_t token = (size_t)u.pm * 256 + t;
#pragma unroll
                    for (int bj = 0; bj < 2; ++bj) { f32x4 v0 = acc[ai][bj][m][0], v1 = acc[ai][bj][m][1];
#pragma unroll
                        for (int j = 0; j < 4; ++j) { v0[j] = __builtin_amdgcn_rcpf(1.0f + __builtin_amdgcn_exp2f((-1.4426950408889634f * SCI) * v0[j])); v1[j] = __builtin_amdgcn_rcpf(1.0f + __builtin_amdgcn_exp2f((-1.4426950408889634f * SCI) * v1[j])); }
                        u32x4 w; w.x = cvt_pk_bf16(v0[0], v0[1]); w.y = cvt_pk_bf16(v0[2], v0[3]); w.z = cvt_pk_bf16(v1[0], v1[1]); w.w = cvt_pk_bf16(v1[2], v1[3]);
                        *(u32x4*)(OS + token * 1024 + (u.pn - 4) * 256 + bj * 128 + d0) = w; }
                }
        }
    }
};
struct EpiINB {
    static constexpr bool PERM = true; static constexpr bool MID = false;
    __device__ __forceinline__ void prep(const Unit&, int, int, int) const {}
    const float* cf; bf16_t* KT; bf16_t* BE;
    __device__ __forceinline__ void operator()(AccRef acc, const Unit& u, int wr, int wc, int fr, int fq) const {
        asm volatile("" : "+v"(fr), "+v"(fq));
        const int b = u.pn >> 4, ch = u.pn & 15;
        f32x4 cv[2][2][2];
#pragma unroll
        for (int ai = 0; ai < 2; ++ai)
#pragma unroll
            for (int bj = 0; bj < 2; ++bj) { const size_t tok0 = (size_t)u.pn * 256 + bj * 128 + wc * 32 + fq * 8;
                if (u.pm < 2) { const int hh = u.pm * 2 + ai; cv[ai][bj][0] = *(const f32x4*)(cf + (size_t)hh * NTOK + tok0) * (RSQRT_DQK * SCI); cv[ai][bj][1] = *(const f32x4*)(cf + (size_t)hh * NTOK + tok0 + 4) * (RSQRT_DQK * SCI); }
                else { cv[ai][bj][0] = (f32x4){SCI, SCI, SCI, SCI}; cv[ai][bj][1] = cv[ai][bj][0]; } }
#pragma unroll
        for (int ai = 0; ai < 2; ++ai)
#pragma unroll
            for (int m = 0; m < 4; ++m) {
                const int R = u.pm * 256 + ai * 128 + wr * 64 + m * 16 + fr;
#pragma unroll
                for (int bj = 0; bj < 2; ++bj) { if (u.x2 == 2 - bj) continue;
                    const f32x4 v0 = acc[ai][bj][m][0] * cv[ai][bj][0], v1 = acc[ai][bj][m][1] * cv[ai][bj][1]; const int s0 = bj * 128 + wc * 32 + fq * 8; const size_t tok0 = (size_t)u.pn * 256 + s0; bf16_t* dst;
                    if (u.pm < 2) dst = KT + (size_t)R * NTOK + tok0;
                    else { const int eg = R - 512, hh = eg >> 8, e = eg & 255; dst = BE + ((size_t)(((b * 4 + hh) * 16 + ch) * 256 + e)) * 384 + s0; }
                    u32x4 w; w.x = cvt_pk_bf16(v0[0], v0[1]); w.y = cvt_pk_bf16(v0[2], v0[3]); w.z = cvt_pk_bf16(v1[0], v1[1]); w.w = cvt_pk_bf16(v1[2], v1[3]);
                    *(u32x4*)dst = w;
                }
            }
    }
};
struct EpiM1 {
    static constexpr bool PERM = true; static constexpr bool MID = false;
    __device__ __forceinline__ void prep(const Unit&, int, int, int) const {}
    bf16_t* UT;
    __device__ __forceinline__ void operator()(AccRef acc, const Unit& u, int wr, int wc, int fr, int fq) const {
        asm volatile("" : "+v"(fr), "+v"(fq));
#pragma unroll
        for (int ai = 0; ai < 2; ++ai)
#pragma unroll
            for (int m = 0; m < 4; ++m) { bf16_t* rowp = UT + ((size_t)u.x0 * 256 + ai * 128 + wr * 64 + m * 16 + fr) * 128 + wc * 32 + fq * 8;
                const f32x4 v0 = acc[ai][0][m][0], v1 = acc[ai][0][m][1];
                u32x4 w; w.x = cvt_pk_bf16(v0[0], v0[1]); w.y = cvt_pk_bf16(v0[2], v0[3]); w.z = cvt_pk_bf16(v1[0], v1[1]); w.w = cvt_pk_bf16(v1[2], v1[3]);
                *(u32x4*)rowp = w; }
    }
};
struct EpiM2A {
    static constexpr bool PERM = true; static constexpr bool MID = false;
    __device__ __forceinline__ void prep(const Unit&, int, int, int) const {}
    bf16_t* AE; const float* nprev; float* den;
    __device__ __forceinline__ void operator()(AccRef acc, const Unit& u, int wr, int wc, int fr, int fq) const {
        asm volatile("" : "+v"(fr), "+v"(fq));
        const int mu = u.x0, dd = wc * 32 + fq * 8;
        const f32x4 n0 = *(const f32x4*)(nprev + (size_t)mu * 128 + dd), n1 = *(const f32x4*)(nprev + (size_t)mu * 128 + dd + 4);
        u32x4 qv8[2][4];
#pragma unroll
        for (int ai = 0; ai < 2; ++ai)
#pragma unroll
            for (int m = 0; m < 4; ++m) qv8[ai][m] = *(const u32x4*)(AE + ((size_t)mu * 256 + ai * 128 + wr * 64 + m * 16 + fr) * 512 + 256 + dd);
#pragma unroll
        for (int ai = 0; ai < 2; ++ai)
#pragma unroll
            for (int m = 0; m < 4; ++m) {
                const int t = ai * 128 + wr * 64 + m * 16 + fr; bf16_t* rowp = AE + ((size_t)mu * 256 + t) * 512;
                const u32x4 qv = qv8[ai][m];
                float part = bflo(qv.x) * n0[0] + bfhi(qv.x) * n0[1] + bflo(qv.y) * n0[2] + bfhi(qv.y) * n0[3] + bflo(qv.z) * n1[0] + bfhi(qv.z) * n1[1] + bflo(qv.w) * n1[2] + bfhi(qv.w) * n1[3];
#pragma unroll
                for (int bj = 0; bj < 2; ++bj) { const int s0 = bj * 128 + wc * 32 + fq * 8; f32x4 v0 = acc[ai][bj][m][0], v1 = acc[ai][bj][m][1];
                    int dts = t - s0; asm volatile("" : "+v"(dts));
#pragma unroll
                    for (int j = 0; j < 4; ++j) { v0[j] = (j <= dts) ? v0[j] : 0.f; v1[j] = (4 + j <= dts) ? v1[j] : 0.f; part += v0[j] + v1[j]; }
                    u32x4 w; w.x = cvt_pk_bf16(v0[0], v0[1]); w.y = cvt_pk_bf16(v0[2], v0[3]); w.z = cvt_pk_bf16(v1[0], v1[1]); w.w = cvt_pk_bf16(v1[2], v1[3]);
                    *(u32x4*)(rowp + s0) = w; }
                part += __shfl_xor(part, 16); part += __shfl_xor(part, 32);
                if (fq == 0) atomicAdd(den + (size_t)mu * 256 + (wr * 64 + fr) + (ai * 128 + m * 16), part);
            }
    }
};
struct EpiM2B {
    static constexpr bool PERM = true; static constexpr bool MID = false;
    __device__ __forceinline__ void prep(const Unit&, int, int, int) const {}
    const float* den; const float* normg; const bf16_t* OS; bf16_t* HN; LAS float* lnx;
    __device__ __forceinline__ void operator()(AccRef acc, const Unit& u, int wr, int wc, int fr, int fq) const {
        asm volatile("" : "+v"(fr), "+v"(fq));
        const int mu = u.x0, b = mu >> 6, hh = (mu >> 4) & 3, ch = mu & 15;
        float dnv[2][4];
#pragma unroll
        for (int ai = 0; ai < 2; ++ai)
#pragma unroll
            for (int m = 0; m < 4; ++m) dnv[ai][m] = den[(size_t)mu * 256 + ai * 128 + wr * 64 + m * 16 + fr];
#pragma unroll
        for (int ai = 0; ai < 2; ++ai)
#pragma unroll
            for (int m = 0; m < 4; ++m) {
                const int t = ai * 128 + wr * 64 + m * 16 + fr; const float dn = dnv[ai][m];
#ifdef DBG_DEN1
                const float inv = 1.0f;
#else
                const float inv = 1.0f / fmaxf(fabsf(dn), 1.0f);
#endif
                float s1 = 0.f, s2 = 0.f;
#pragma unroll
                for (int bj = 0; bj < 2; ++bj)
#pragma unroll
                    for (int n = 0; n < 2; ++n) { f32x4 h = acc[ai][bj][m][n] * inv; acc[ai][bj][m][n] = h; s1 += (h[0] + h[1]) + (h[2] + h[3]); s2 += (h[0] * h[0] + h[1] * h[1]) + (h[2] * h[2] + h[3] * h[3]); }
                s1 += __shfl_xor(s1, 16); s1 += __shfl_xor(s1, 32); s2 += __shfl_xor(s2, 16); s2 += __shfl_xor(s2, 32);
                if (fq == 0) { lnx[(t * 4 + wc) * 2] = s1; lnx[(t * 4 + wc) * 2 + 1] = s2; }
            }
        const int e0 = wc * 32 + fq * 8;
        f32x4 gg[2][2];
#pragma unroll
        for (int bj = 0; bj < 2; ++bj) { gg[bj][0] = *(const f32x4*)(normg + hh * 256 + bj * 128 + e0); gg[bj][1] = *(const f32x4*)(normg + hh * 256 + bj * 128 + e0 + 4); }
        asm volatile("s_waitcnt lgkmcnt(0)" ::: "memory"); __builtin_amdgcn_s_barrier(); asm volatile("" ::: "memory");
#pragma unroll
        for (int ai = 0; ai < 2; ++ai) {
            u32x4 ovv[4][2];
#pragma unroll
            for (int m = 0; m < 4; ++m)
#pragma unroll
                for (int bj = 0; bj < 2; ++bj) ovv[m][bj] = *(const u32x4*)(OS + (((size_t)(b * 16 + ch)) * 256 + ai * 128 + wr * 64 + m * 16 + fr) * 1024 + hh * 256 + bj * 128 + e0);
#pragma unroll
            for (int m = 0; m < 4; ++m) {
                const int t = ai * 128 + wr * 64 + m * 16 + fr; const size_t token = ((size_t)(b * 16 + ch)) * 256 + t;
                const LAS f32x4* lp = (const LAS f32x4*)(lnx + t * 8); const f32x4 a = lp[0], c = lp[1];
                const float mean = (a[0] + a[2] + c[0] + c[2]) * (1.0f / 256.0f); const float ex2 = (a[1] + a[3] + c[1] + c[3]) * (1.0f / 256.0f);
                const float rstd = 1.0f / sqrtf(fmaxf(ex2 - mean * mean, 0.f) + LN_EPS);
#pragma unroll
                for (int bj = 0; bj < 2; ++bj) { const int e = bj * 128 + e0; const size_t off = token * 1024 + hh * 256 + e; const u32x4 ov = ovv[m][bj];
#ifdef DBG_HN_OS
                    f32x4 v0 = {1.f, 1.f, 1.f, 1.f}, v1 = v0;
#elif defined(DBG_HN_RAW)
                    f32x4 v0 = acc[ai][bj][m][0], v1 = acc[ai][bj][m][1];
#else
                    f32x4 v0 = (acc[ai][bj][m][0] - mean) * rstd * gg[bj][0], v1 = (acc[ai][bj][m][1] - mean) * rstd * gg[bj][1];
#endif
#ifndef DBG_HN_ONE
                    v0[0] *= bflo(ov.x); v0[1] *= bfhi(ov.x); v0[2] *= bflo(ov.y); v0[3] *= bfhi(ov.y); v1[0] *= bflo(ov.z); v1[1] *= bfhi(ov.z); v1[2] *= bflo(ov.w); v1[3] *= bfhi(ov.w);
#endif
                    u32x4 w; w.x = cvt_pk_bf16(v0[0], v0[1]); w.y = cvt_pk_bf16(v0[2], v0[3]); w.z = cvt_pk_bf16(v1[0], v1[1]); w.w = cvt_pk_bf16(v1[2], v1[3]);
                    *(u32x4*)(HN + off) = w; }
            }
            asm volatile("" ::: "memory");
        }
        asm volatile("s_waitcnt lgkmcnt(0)" ::: "memory"); __builtin_amdgcn_s_barrier(); asm volatile("" ::: "memory");
    }
};
struct Frame {
    LAS unsigned char* lds;
    unsigned* ctl;
    unsigned char* ws;
    int tid, lane, wave, vcu, G;
};
__device__ __forceinline__ float wave_sum(float v) {
#pragma unroll
    for (int o = 1; o < 64; o <<= 1) v += __shfl_xor(v, o);
    return v;
}

__device__ __forceinline__ void tr_block(const float* src, size_t pitch, bf16_t* dst, size_t kd, int kb, int nb, LAS unsigned* scr, int lane, bool rotperm = false) {
    const float* s0 = src + (size_t)(64 * kb) * pitch + 64 * nb + 4 * (lane & 15);
#pragma unroll
    for (int i = 0; i < 8; ++i) {
        const int kp = 4 * i + (lane >> 4);
        const f32x4 a = __builtin_nontemporal_load((const f32x4*)(s0 + (size_t)(2 * kp) * pitch)), b = __builtin_nontemporal_load((const f32x4*)(s0 + (size_t)(2 * kp + 1) * pitch));
#pragma unroll
        for (int j = 0; j < 4; ++j) scr[(4 * (lane & 15) + j) * 33 + kp] = cvt_pk_bf16(a[j], b[j]);
    }
    LDS_WAIT(); asm volatile("" ::: "memory");
    u32x4 o[8];
#pragma unroll
    for (int c = 0; c < 8; ++c) { const int r0 = 8 * c + (lane >> 3), rr = (rotperm && c < 2) ? (8 * ((r0 >> 2) & 1) + 4 * (r0 >> 3) + (r0 & 3)) : r0, q4 = 4 * (lane & 7); o[c].x = scr[rr * 33 + q4]; o[c].y = scr[rr * 33 + q4 + 1]; o[c].z = scr[rr * 33 + q4 + 2]; o[c].w = scr[rr * 33 + q4 + 3]; }
    bf16_t* d = dst + (size_t)(64 * nb + (lane >> 3)) * kd + 64 * kb + 8 * (lane & 7);
#pragma unroll
    for (int c = 0; c < 8; ++c) *(u32x4*)(d + (size_t)(8 * c) * kd) = o[c];
    LDS_WAIT(); asm volatile("" ::: "memory");
}
__device__ __forceinline__ void tr_block8(const float* src, size_t pitch, unsigned char* dst, size_t kd, int kb, int nb, float scale, LAS unsigned* scr, int lane) {
    const float* s0 = src + (size_t)(128 * kb) * pitch + 64 * nb + 4 * (lane & 15);
#pragma unroll
    for (int i = 0; i < 8; ++i) {
        const int kq = 4 * i + (lane >> 4);
        const f32x4 r0 = __builtin_nontemporal_load((const f32x4*)(s0 + (size_t)(4 * kq) * pitch)) * scale, r1 = __builtin_nontemporal_load((const f32x4*)(s0 + (size_t)(4 * kq + 1) * pitch)) * scale,
                    r2 = __builtin_nontemporal_load((const f32x4*)(s0 + (size_t)(4 * kq + 2) * pitch)) * scale, r3 = __builtin_nontemporal_load((const f32x4*)(s0 + (size_t)(4 * kq + 3) * pitch)) * scale;
#pragma unroll
        for (int j = 0; j < 4; ++j) { int w = __builtin_amdgcn_cvt_pk_fp8_f32(r0[j], r1[j], 0, false); w = __builtin_amdgcn_cvt_pk_fp8_f32(r2[j], r3[j], w, true); scr[(4 * (lane & 15) + j) * 33 + kq] = (unsigned)w; }
    }
    LDS_WAIT(); asm volatile("" ::: "memory");
    u32x4 o[8];
#pragma unroll
    for (int c = 0; c < 8; ++c) { const int rr = 8 * c + (lane >> 3), q4 = 4 * (lane & 7); o[c].x = scr[rr * 33 + q4]; o[c].y = scr[rr * 33 + q4 + 1]; o[c].z = scr[rr * 33 + q4 + 2]; o[c].w = scr[rr * 33 + q4 + 3]; }
    unsigned char* d = dst + (size_t)(64 * nb + (lane >> 3)) * kd + 128 * kb + 16 * (lane & 7);
#pragma unroll
    for (int c = 0; c < 8; ++c) *(u32x4*)(d + (size_t)(8 * c) * kd) = o[c];
    LDS_WAIT(); asm volatile("" ::: "memory");
}
constexpr int CONV_ITEMS = 24576;
struct ConvItem { const float* s0; size_t pitch; unsigned char* d; float scale; };
__device__ __forceinline__ ConvItem conv_desc(const float* wgu, const float* wd, unsigned char* ws, int v, int lane) {
    const int layer = v >= 12288; int r = v - layer * 12288; ConvItem it;
    if (r < 8192) { const int mat = layer * 32 + (r >> 8); r &= 255; const int kb = r >> 5, nb = r & 31; it.pitch = 2048; it.scale = FP8_SWGU;
        it.s0 = wgu + (size_t)mat * 1024 * 2048 + (size_t)(128 * kb) * 2048 + 64 * nb + 4 * (lane & 15); it.d = ws + WS_WGU + (size_t)mat * 2048 * 1024 + (size_t)(64 * nb + (lane >> 3)) * 1024 + 128 * kb + 16 * (lane & 7); }
    else { r -= 8192; const int mat = layer * 32 + (r >> 7); r &= 127; const int kb = r >> 4, nb = r & 15; it.pitch = 1024; it.scale = FP8_SWD;
        it.s0 = wd + (size_t)mat * 1024 * 1024 + (size_t)(128 * kb) * 1024 + 64 * nb + 4 * (lane & 15); it.d = ws + WS_WD + (size_t)mat * 1024 * 1024 + (size_t)(64 * nb + (lane >> 3)) * 1024 + 128 * kb + 16 * (lane & 7); }
    return it;
}
__device__ __forceinline__ void conv_items(Frame& F, const float* wgu, const float* wd, int v_lo, int v_hi, int cw, int ncw) {
    LAS unsigned* scr = (LAS unsigned*)(F.lds + RING_OFF + F.wave * 8448); unsigned char* ws = F.ws; const int lane = F.lane;
    int v = v_lo + cw; if (v >= v_hi) return;
    ConvItem cur = conv_desc(wgu, wd, ws, v, lane);
    f32x4 r[8][4];
#pragma unroll
    for (int i = 0; i < 8; ++i) { const int kq = 4 * i + (lane >> 4);
#pragma unroll
        for (int q = 0; q < 4; ++q) r[i][q] = __builtin_nontemporal_load((const f32x4*)(cur.s0 + (size_t)(4 * kq + q) * cur.pitch)); }
    for (;;) {
        const int vn = v + ncw; const bool has = vn < v_hi; ConvItem nx = cur; if (has) nx = conv_desc(wgu, wd, ws, vn, lane);
#pragma unroll
        for (int i = 0; i < 8; ++i) { const int kq = 4 * i + (lane >> 4);
#pragma unroll
            for (int j = 0; j < 4; ++j) { int w = __builtin_amdgcn_cvt_pk_fp8_f32(r[i][0][j] * cur.scale, r[i][1][j] * cur.scale, 0, false); w = __builtin_amdgcn_cvt_pk_fp8_f32(r[i][2][j] * cur.scale, r[i][3][j] * cur.scale, w, true); scr[(4 * (lane & 15) + j) * 33 + kq] = (unsigned)w; }
            if (has) {
#pragma unroll
                for (int q = 0; q < 4; ++q) r[i][q] = __builtin_nontemporal_load((const f32x4*)(nx.s0 + (size_t)(4 * kq + q) * nx.pitch)); } }
        LDS_WAIT(); asm volatile("" ::: "memory");
        u32x4 o[8];
#pragma unroll
        for (int c = 0; c < 8; ++c) { const int rr = 8 * c + (lane >> 3), q4 = 4 * (lane & 7); o[c].x = scr[rr * 33 + q4]; o[c].y = scr[rr * 33 + q4 + 1]; o[c].z = scr[rr * 33 + q4 + 2]; o[c].w = scr[rr * 33 + q4 + 3]; }
#pragma unroll
        for (int c = 0; c < 8; ++c) __builtin_nontemporal_store(o[c], (u32x4*)(cur.d + (size_t)(8 * c) * 1024));
        LDS_WAIT(); asm volatile("" ::: "memory");
        if (!has) break;
        v = vn; cur = nx;
    }
}
struct P0In { const float *x, *wqkv, *wo, *win, *wout, *rw, *wgu, *wd; const int* pos; };
__device__ __forceinline__ void p0_prologue(Frame& F, const P0In& I) {
    LAS unsigned* scr = (LAS unsigned*)(F.lds + RING_OFF + F.wave * 8448);
    const int gw = F.vcu * NWAVES + F.wave, NGW = F.G * NWAVES;
    unsigned char* ws = F.ws;
    constexpr int KB = 16;
    constexpr int I_QKV = KB * 48, I_WO = KB * 16, I_INA1 = 8 * 16, I_INA2 = 8 * 16, I_INB = 8 * 24, I_WOUT = KB * 16;
    constexpr int I_SMALL = I_QKV + I_WO + I_INA1 + I_INA2 + I_INB + I_WOUT;
    constexpr int NITEMS = I_SMALL;
    for (int it = gw; it < NITEMS; it += NGW) {
        int r = it; const float* src; size_t pitch; bf16_t* dst; int nbl; const bool isqkv = it < I_QKV; bool f8 = false;
        if (r < I_QKV) { src = I.wqkv; pitch = 3072; dst = (bf16_t*)(ws + WS_WQKV); nbl = 48; }
        else if ((r -= I_QKV) < I_WO) { src = I.wo; pitch = 1024; dst = (bf16_t*)(ws + WS_WO); nbl = 16; }
        else if ((r -= I_WO) < I_INA1) { src = I.win; pitch = 3080; dst = (bf16_t*)(ws + WS_WINA); nbl = 16; f8 = true; }
        else if ((r -= I_INA1) < I_INA2) { src = I.win + 2048; pitch = 3080; dst = (bf16_t*)(ws + WS_WINA + (size_t)1024 * 1024); nbl = 16; f8 = true; }
        else if ((r -= I_INA2) < I_INB) { src = I.win + 512; pitch = 3080; dst = (bf16_t*)(ws + WS_WINB); nbl = 24; f8 = true; }
        else { r -= I_INB; src = I.wout; pitch = 1024; dst = (bf16_t*)(ws + WS_WOUT); nbl = 16; }
        if (f8) tr_block8(src, pitch, (unsigned char*)dst, 1024, r / nbl, r % nbl, FP8_SWIN, scr, F.lane);
        else tr_block(src, pitch, dst, 1024, r / nbl, r % nbl, scr, F.lane, isqkv && (r % nbl) < 32);
    }
    if (NCONV == 0) conv_items(F, I.wgu, I.wd, 0, CONV_ITEMS, gw, NGW);
    const int gt = F.vcu * NTHR + F.tid, NGT = F.G * NTHR;
    for (int i = gt; i < NTOK * DM / 8; i += NGT) { const f32x4 a = ((const f32x4*)I.x)[2 * i], b = ((const f32x4*)I.x)[2 * i + 1];
        u32x4 w; w.x = cvt_pk_bf16(a[0], a[1]); w.y = cvt_pk_bf16(a[2], a[3]); w.z = cvt_pk_bf16(b[0], b[1]); w.w = cvt_pk_bf16(b[2], b[3]); ((u32x4*)(ws + WS_XB))[i] = w; }
    for (int i = gt; i < NTOK * 8; i += NGT) { const int tok = i >> 3, f = i & 7; const float inv = powf(500000.0f, -(float)f * 0.125f); const float ang = (float)I.pos[tok] * inv;
        float sn, cs; sincosf(ang, &sn, &cs); float* rp = (float*)(ws + WS_ROPE) + (size_t)tok * 16; rp[f] = cs; rp[8 + f] = sn; }
    for (int i = gt; i < 2 * 32 * 1024; i += NGT) { const int l = i >> 15, e = (i >> 10) & 31, k = i & 1023; ((float*)(ws + WS_RWT))[i] = I.rw[((size_t)l * 1024 + k) * 32 + e]; }
    for (int i = gt; i < 8 * 1024; i += NGT) { const int gidx = i >> 10, k = i & 1023; ((float*)(ws + WS_WG))[i] = I.win[(size_t)k * 3080 + 3072 + gidx]; }
}

__device__ __forceinline__ void phase_ln_router(Frame& F, const bf16_t* __restrict__ z, bf16_t* __restrict__ x1, const float* lng, const float* lnb, const float* rbias, int layer, int cset) {
    unsigned char* ws = F.ws;
    LAS f32x4* rwv = (LAS f32x4*)(F.lds + RING_OFF);
    LAS int* lcnt = (LAS int*)(F.lds + LX_LCNT); LAS int* gbase = (LAS int*)(F.lds + LX_GBASE); LAS int* rec = (LAS int*)(F.lds + LX_REC);
    LAS float* lgb = (LAS float*)(F.lds + LX_LNX);
    { const f32x4* src = (const f32x4*)((const float*)(ws + WS_RWT) + (size_t)layer * 32768);
      for (int i = F.tid; i < 8192; i += NTHR) { const int e = i >> 8, c = i & 255; rwv[e * 256 + (c ^ (e & 15))] = src[i]; } }
    int* toke = (int*)(ws + WS_TOKE); int* tokp = (int*)(ws + WS_TOKP); float* tokg = (float*)(ws + WS_TOKG);
    unsigned short* rowtok = (unsigned short*)(ws + WS_ROWTOK); unsigned char* xb8 = (unsigned char*)(ws + WS_XB);
    unsigned* cntg = F.ctl + CW_CNT + cset * 2048;
    const int lane = F.lane;
    for (int grp = F.vcu; grp < NTOK / 64; grp += F.G) {
        if (F.tid < 32) lcnt[F.tid] = 0;
        for (int i = F.tid; i < 1024; i += NTHR) { lgb[i] = lng[i]; lgb[1024 + i] = lnb[i]; }
        __syncthreads();
#pragma unroll 2
        for (int tk = 0; tk < 8; tk += 2) {
            const int token0 = grp * 64 + F.wave * 8 + tk;
            f32x4 v[2][4]; float s[2] = {0.f, 0.f};
#pragma unroll
            for (int u = 0; u < 2; ++u)
#pragma unroll
                for (int j = 0; j < 4; ++j) { const u32x2 zz = *(const u32x2*)(z + (size_t)(token0 + u) * DM + 4 * lane + 256 * j); v[u][j] = (f32x4){bflo(zz.x), bfhi(zz.x), bflo(zz.y), bfhi(zz.y)}; s[u] += (v[u][j][0] + v[u][j][1]) + (v[u][j][2] + v[u][j][3]); }
#pragma unroll
            for (int o = 1; o < 64; o <<= 1) { const float a0 = __shfl_xor(s[0], o), a1 = __shfl_xor(s[1], o); s[0] += a0; s[1] += a1; }
            float s2[2] = {0.f, 0.f};
#pragma unroll
            for (int u = 0; u < 2; ++u) { const float mean = s[u] * (1.0f / DM);
#pragma unroll
                for (int j = 0; j < 4; ++j) { v[u][j] = v[u][j] - mean; s2[u] += (v[u][j][0] * v[u][j][0] + v[u][j][1] * v[u][j][1]) + (v[u][j][2] * v[u][j][2] + v[u][j][3] * v[u][j][3]); } }
#pragma unroll
            for (int o = 1; o < 64; o <<= 1) { const float a0 = __shfl_xor(s2[0], o), a1 = __shfl_xor(s2[1], o); s2[0] += a0; s2[1] += a1; }
#pragma unroll
            for (int u = 0; u < 2; ++u) { const float rstd = 1.0f / sqrtf(s2[u] * (1.0f / DM) + LN_EPS); const int token = token0 + u;
#pragma unroll
                for (int j = 0; j < 4; ++j) { const f32x4 gvj = *(const LAS f32x4*)(lgb + 4 * lane + 256 * j), bvj = *(const LAS f32x4*)(lgb + 1024 + 4 * lane + 256 * j);
                    const f32x4 y = v[u][j] * rstd * gvj + bvj; { u32x2 wb; wb.x = cvt_pk_bf16(y[0], y[1]); wb.y = cvt_pk_bf16(y[2], y[3]); *(u32x2*)(x1 + (size_t)token * DM + 4 * lane + 256 * j) = wb; }
                    int w8 = __builtin_amdgcn_cvt_pk_fp8_f32(y[0] * FP8_SA, y[1] * FP8_SA, 0, false); w8 = __builtin_amdgcn_cvt_pk_fp8_f32(y[2] * FP8_SA, y[3] * FP8_SA, w8, true);
                    *(int*)(xb8 + (size_t)token * DM + 4 * lane + 256 * j) = w8; } }
        }
        VM_WAIT(); __syncthreads();
        const int tg = F.wave & 3, kh = F.wave >> 2, e0 = lane & 15, kq = lane >> 4;
        f32x4 acc0 = {0.f, 0.f, 0.f, 0.f}, acc1 = acc0;
        { const bf16_t* arow = x1 + (size_t)(grp * 64 + tg * 16 + e0) * DM + kh * 512 + 4 * kq;
#pragma unroll 4
          for (int blk = 0; blk < 32; ++blk) {
              const u32x2 ab = *(const u32x2*)(arow + blk * 16); const f32x4 a4 = {bflo(ab.x), bfhi(ab.x), bflo(ab.y), bfhi(ab.y)}; const int c = ((kh * 512 + blk * 16) >> 2) + kq;
              const f32x4 b0 = rwv[e0 * 256 + (c ^ e0)], b1 = rwv[(16 + e0) * 256 + (c ^ e0)];
#pragma unroll
              for (int j = 0; j < 4; ++j) { acc0 = __builtin_amdgcn_mfma_f32_16x16x4f32(a4[j], b0[j], acc0, 0, 0, 0); acc1 = __builtin_amdgcn_mfma_f32_16x16x4f32(a4[j], b1[j], acc1, 0, 0, 0); } } }
        __syncthreads();
        if (kh == 1) { ((LAS f32x4*)lgb)[(tg * 2 + 0) * 64 + lane] = acc0; ((LAS f32x4*)lgb)[(tg * 2 + 1) * 64 + lane] = acc1; }
        __syncthreads();
        if (kh == 0) {
            acc0 = acc0 + ((LAS f32x4*)lgb)[(tg * 2 + 0) * 64 + lane]; acc1 = acc1 + ((LAS f32x4*)lgb)[(tg * 2 + 1) * 64 + lane];
            const float rb0 = rbias[e0], rb1 = rbias[16 + e0];
#pragma unroll
            for (int r = 0; r < 4; ++r) {
                float l0 = acc0[r] + rb0, l1 = acc1[r] + rb1; float tv[4]; int te[4];
#pragma unroll
                for (int k = 0; k < 4; ++k) { float bvv = (l1 > l0) ? l1 : l0; int be = (l1 > l0) ? 16 + e0 : e0;
#pragma unroll
                    for (int o = 1; o < 16; o <<= 1) { const float ov = __shfl_xor(bvv, o); const int oe = __shfl_xor(be, o); const bool take = (ov > bvv) || (ov == bvv && oe < be); bvv = take ? ov : bvv; be = take ? oe : be; }
                    tv[k] = bvv; te[k] = be; if (be == e0) l0 = -INFINITY; if (be == 16 + e0) l1 = -INFINITY; }
                const float w0 = 1.0f, w1 = __expf(tv[1] - tv[0]), w2 = __expf(tv[2] - tv[0]), w3 = __expf(tv[3] - tv[0]); const float wi = 1.0f / (w0 + w1 + w2 + w3);
                if (e0 < 4) {
                    const int tl = tg * 16 + 4 * kq + r, token = grp * 64 + tl;
                    const int ek = (e0 == 0) ? te[0] : (e0 == 1) ? te[1] : (e0 == 2) ? te[2] : te[3];
                    const float wk = (e0 == 0) ? w0 : (e0 == 1) ? w1 : (e0 == 2) ? w2 : w3;
                    const int li = atomicAdd((int*)(lcnt + ek), 1); rec[tl * 8 + e0] = ek; rec[tl * 8 + 4 + e0] = li;
                    toke[token * 4 + e0] = ek; tokg[token * 4 + e0] = wk * wi;
                }
            }
        }
        __syncthreads();
        if (F.tid < 32) gbase[F.tid] = (int)__hip_atomic_fetch_add(cntg + F.tid * 64, (unsigned)lcnt[F.tid], RLX_AGENT);
        __syncthreads();
        if (F.tid < 256) { const int tl = F.tid >> 2, k = F.tid & 3; const int token = grp * 64 + tl; const int e = rec[tl * 8 + k]; const int pos = gbase[e] + rec[tl * 8 + 4 + k];
            tokp[token * 4 + k] = pos; rowtok[(size_t)e * NTOK + pos] = (unsigned short)token; }
        __syncthreads();
    }
}

__device__ __forceinline__ int moe_tables(Frame& F, int layer) {
    LAS int* tile_e = (LAS int*)(F.lds + LX_TILEE); LAS int* tbase = (LAS int*)(F.lds + LX_TBASE);
    if (F.tid < 64) {
        const int e = F.lane & 31; const int c = (int)__hip_atomic_load(F.ctl + CW_CNT + layer * 2048 + e * 64, RLX_AGENT); const int nt = (F.lane < 32) ? ((c + 255) >> 8) : 0;
        int inc = nt;
#pragma unroll
        for (int o = 1; o < 32; o <<= 1) { const int up = __shfl_up(inc, o); if (F.lane >= o) inc += up; }
        const int t0 = inc - nt;
        if (F.lane < 32) { tbase[e] = t0; for (int i = 0; i < nt; ++i) tile_e[t0 + i] = e; }
        if (F.lane == 31) tbase[32] = inc;
    }
    __syncthreads();
    return tbase[32];
}

template <bool NEXT_MLSTM>
__device__ __forceinline__ void phase_combine(Frame& F, const bf16_t* __restrict__ x1, float* __restrict__ out, const float* lng, const float* lnb, const float* bgates, int layer) {
    unsigned char* ws = F.ws;
    (void)moe_tables(F, layer);
    const LAS int* tbase = (const LAS int*)(F.lds + LX_TBASE);
    const int* toke = (const int*)(ws + WS_TOKE); const int* tokp = (const int*)(ws + WS_TOKP); const float* tokg = (const float*)(ws + WS_TOKG);
    const unsigned char* Y = (const unsigned char*)(ws + WS_Y); bf16_t* xb = (bf16_t*)(ws + WS_XB);
    LAS float* wg = (LAS float*)(F.lds + RING_OFF);
    LAS float* lgb = wg + 8192;
    if constexpr (NEXT_MLSTM) { const f32x4* src = (const f32x4*)(ws + WS_WG); for (int i = F.tid; i < 2048; i += NTHR) ((LAS f32x4*)wg)[i] = src[i];
        for (int i = F.tid; i < 1024; i += NTHR) { lgb[i] = lng[i]; lgb[1024 + i] = lnb[i]; } __syncthreads(); }
    const int lane = F.lane; const int gw = F.vcu * NWAVES + F.wave, NGW = F.G * NWAVES;
    f32x4 gv[4], bv[4];
    if constexpr (!NEXT_MLSTM) {
#pragma unroll
        for (int j = 0; j < 4; ++j) { gv[j] = *(const f32x4*)(lng + 4 * lane + 256 * j); bv[j] = *(const f32x4*)(lnb + 4 * lane + 256 * j); } }
    constexpr int NTK = 2;
    int rowv = 0; float gatev = 0.f;
    { const int mt = gw + (lane >> 2) * NGW; if (mt < NTOK) { const int ee = toke[mt * 4 + (lane & 3)]; rowv = tbase[ee] * 256 + tokp[mt * 4 + (lane & 3)]; gatev = tokg[mt * 4 + (lane & 3)] * (DBG_MOE_MUL / FP8_SY); } }
    int it = 0;
    for (int token0 = gw; token0 < NTOK; token0 += NTK * NGW, ++it) {
        f32x4 vv[NTK][4];
#pragma unroll
        for (int u = 0; u < NTK; ++u) { const int token = token0 + u * NGW; if (token < NTOK) {
#pragma unroll
            for (int j = 0; j < 4; ++j) { const u32x2 xx = *(const u32x2*)(x1 + (size_t)token * DM + 4 * lane + 256 * j); vv[u][j] = (f32x4){bflo(xx.x), bfhi(xx.x), bflo(xx.y), bfhi(xx.y)} * ALPHA; }
#pragma unroll
            for (int k = 0; k < 4; ++k) { const int sl = (it * NTK + u) * 4 + k; const size_t row = (size_t)__builtin_amdgcn_readlane(rowv, sl); const float gt = __int_as_float(__builtin_amdgcn_readlane(__float_as_int(gatev), sl));
#pragma unroll
                for (int j = 0; j < 4; ++j) { const int y = *(const int*)(Y + row * DM + 4 * lane + 256 * j); const f32x2 lo = __builtin_amdgcn_cvt_pk_f32_fp8(y, false), hi = __builtin_amdgcn_cvt_pk_f32_fp8(y, true);
                    vv[u][j][0] += gt * lo[0]; vv[u][j][1] += gt * lo[1]; vv[u][j][2] += gt * hi[0]; vv[u][j][3] += gt * hi[1]; } } } }
#pragma unroll
        for (int u = 0; u < NTK; ++u) { const int token = token0 + u * NGW; if (token < NTOK) {
        f32x4 v[4];
#pragma unroll
        for (int j = 0; j < 4; ++j) v[j] = vv[u][j];
        float s = 0.f;
#pragma unroll
        for (int j = 0; j < 4; ++j) s += (v[j][0] + v[j][1]) + (v[j][2] + v[j][3]);
        const float mean = wave_sum(s) * (1.0f / DM); float s2 = 0.f;
#pragma unroll
        for (int j = 0; j < 4; ++j) { v[j] = v[j] - mean; s2 += (v[j][0] * v[j][0] + v[j][1] * v[j][1]) + (v[j][2] * v[j][2] + v[j][3] * v[j][3]); }
        const float rstd = 1.0f / sqrtf(wave_sum(s2) * (1.0f / DM) + LN_EPS);
#pragma unroll
        for (int j = 0; j < 4; ++j) { if constexpr (NEXT_MLSTM) { gv[j] = *(const LAS f32x4*)(lgb + 4 * lane + 256 * j); bv[j] = *(const LAS f32x4*)(lgb + 1024 + 4 * lane + 256 * j); }
            v[j] = v[j] * rstd * gv[j] + bv[j]; if constexpr (!NEXT_MLSTM) *(f32x4*)(out + (size_t)token * DM + 4 * lane + 256 * j) = v[j]; }
        if constexpr (NEXT_MLSTM) {
#pragma unroll
            for (int j = 0; j < 4; ++j) { u32x2 w; w.x = cvt_pk_bf16(v[j][0], v[j][1]); w.y = cvt_pk_bf16(v[j][2], v[j][3]); *(u32x2*)(xb + (size_t)token * DM + 4 * lane + 256 * j) = w;
                int w8 = __builtin_amdgcn_cvt_pk_fp8_f32(v[j][0] * FP8_SA, v[j][1] * FP8_SA, 0, false); w8 = __builtin_amdgcn_cvt_pk_fp8_f32(v[j][2] * FP8_SA, v[j][3] * FP8_SA, w8, true);
                *(int*)(ws + WS_X8 + (size_t)token * DM + 4 * lane + 256 * j) = w8; }
            float gp[8];
#pragma unroll
            for (int gi = 0; gi < 8; ++gi) { float a = 0.f;
#pragma unroll
                for (int j = 0; j < 4; ++j) { const f32x4 w = *(const LAS f32x4*)(wg + gi * 1024 + 4 * lane + 256 * j); a += (v[j][0] * w[0] + v[j][1] * w[1]) + (v[j][2] * w[2] + v[j][3] * w[3]); }
                gp[gi] = a; if (gi & 1) asm volatile("" ::: "memory"); }
#pragma unroll
            for (int o = 1; o < 64; o <<= 1) {
#pragma unroll
                for (int gi = 0; gi < 8; ++gi) gp[gi] += __shfl_xor(gp[gi], o); }
#pragma unroll
            for (int gi = 0; gi < 8; ++gi) gp[gi] += bgates[gi];
            if (lane == 0) {
#pragma unroll
                for (int hh = 0; hh < 4; ++hh) { ((float*)(ws + WS_GI))[(size_t)hh * NTOK + token] = gp[hh];
                    const float f = gp[4 + hh]; const float lf = (f >= 0.f) ? -log1pf(__expf(-f)) : (f - log1pf(__expf(f)));
                    ((float*)(ws + WS_LF))[(size_t)hh * NTOK + token] = lf; } }
        }
        } }
    }
}

__device__ __forceinline__ void phase_gate_scan(Frame& F) {
    unsigned char* ws = F.ws; const int lane = F.lane; const int gw = F.vcu * NWAVES + F.wave, NGW = F.G * NWAVES;
    for (int mu = gw; mu < 256; mu += NGW) {
        const int b = mu >> 6, hh = (mu >> 4) & 3, ch = mu & 15; const size_t base = (size_t)hh * NTOK + (size_t)b * SEQ + ch * 256 + 4 * lane;
        const f32x4 lf = *(const f32x4*)((const float*)(ws + WS_LF) + base), gi = *(const f32x4*)((const float*)(ws + WS_GI) + base);
        f32x4 c; c[0] = lf[0]; c[1] = c[0] + lf[1]; c[2] = c[1] + lf[2]; c[3] = c[2] + lf[3];
        float tot = c[3];
#pragma unroll
        for (int o = 1; o < 64; o <<= 1) { const float up = __shfl_up(tot, o); if (lane >= o) tot += up; }
        const float excl = tot - c[3];
        f32x4 rf, cf;
#pragma unroll
        for (int j = 0; j < 4; ++j) { const float bt = excl + c[j]; rf[j] = __expf(bt); cf[j] = __expf(gi[j] - bt); }
        *(f32x4*)((float*)(ws + WS_RF) + base) = rf; *(f32x4*)((float*)(ws + WS_CF) + base) = cf;
        if (lane == 63) ((float*)(ws + WS_DEC))[mu] = __expf(tot);
    }
}
__device__ __forceinline__ void phase_nu(Frame& F) {
    unsigned char* ws = F.ws; const int lane = F.lane; const int gw = F.vcu * NWAVES + F.wave, NGW = F.G * NWAVES;
    const bf16_t* KT = (const bf16_t*)(ws + WS_KT); float* NU = (float*)(ws + WS_NU);
    for (int r0 = gw * 16; r0 < 256 * 128; r0 += NGW * 16) {
        const int mu = r0 >> 7, d0 = r0 & 127, b = mu >> 6, hh = (mu >> 4) & 3, ch = mu & 15;
        const bf16_t* base = KT + (size_t)(hh * 128 + d0) * NTOK + (size_t)b * SEQ + ch * 256 + 4 * lane;
        u32x2 kv[16];
#pragma unroll
        for (int i = 0; i < 16; ++i) kv[i] = *(const u32x2*)(base + (size_t)i * NTOK);
        float s[16];
#pragma unroll
        for (int i = 0; i < 16; ++i) s[i] = (bflo(kv[i].x) + bfhi(kv[i].x)) + (bflo(kv[i].y) + bfhi(kv[i].y));
#pragma unroll
        for (int o = 1; o < 64; o <<= 1) {
#pragma unroll
            for (int i = 0; i < 16; ++i) s[i] += __shfl_xor(s[i], o); }
        float mine = s[0];
#pragma unroll
        for (int i = 1; i < 16; ++i) mine = (lane == i) ? s[i] : mine;
        if (lane < 16) NU[r0 + lane] = mine;
    }
}
__device__ __forceinline__ void phase_state_scan(Frame& F) {
    unsigned char* ws = F.ws; const int gt = F.vcu * NTHR + F.tid, NGT = F.G * NTHR;
    const bf16_t* UT = (const bf16_t*)(ws + WS_UT); const float* DEC = (const float*)(ws + WS_DEC); bf16_t* BE = (bf16_t*)(ws + WS_BE);
    for (int i = gt; i < 16 * 256 * 32; i += NGT) { const int bh = i >> 13, e = (i >> 5) & 255, dg = i & 31;
        f32x4 U[16]; float dc[16];
#pragma unroll
        for (int ch = 0; ch < 16; ++ch) { const size_t mu = (size_t)bh * 16 + ch; { const u32x2 uu = *(const u32x2*)(UT + (mu * 256 + e) * 128 + 4 * dg); U[ch] = (f32x4){bflo(uu.x), bfhi(uu.x), bflo(uu.y), bfhi(uu.y)}; } dc[ch] = DEC[mu]; }
        f32x4 C = {0.f, 0.f, 0.f, 0.f};
#pragma unroll
        for (int ch = 0; ch < 16; ++ch) { const size_t mu = (size_t)bh * 16 + ch;
            u32x2 w; w.x = cvt_pk_bf16(C[0], C[1]); w.y = cvt_pk_bf16(C[2], C[3]);
#ifdef DBG_NO_INTER
            w.x = 0u; w.y = 0u;
#endif
            *(u32x2*)(BE + (mu * 256 + e) * 384 + 256 + 4 * dg) = w;
            C = (C + U[ch]) * dc[ch]; } }
    const float* NU = (const float*)(ws + WS_NU); float* NP = (float*)(ws + WS_NPREV);
    for (int i = gt; i < 16 * 128; i += NGT) { const int bh = i >> 7, d = i & 127; float n = 0.f;
        for (int ch = 0; ch < 16; ++ch) { const int mu = bh * 16 + ch; NP[mu * 128 + d] = n; n = (n + NU[mu * 128 + d]) * DEC[mu];
#ifdef DBG_NO_INTER
            n = 0.f;
#endif
        } }
}
struct Args { const float* in[18]; float* out; unsigned char* ws; int ph_lo, ph_hi; };
__global__ void __launch_bounds__(NTHR, 2) mk_fwd(Args args) {
    extern __shared__ __attribute__((aligned(16))) unsigned char lds[];
    Frame F;
    const char __attribute__((address_space(4)))* kargp = (const char __attribute__((address_space(4)))*)__builtin_amdgcn_kernarg_segment_ptr();
#define AIN(i) ({ const char __attribute__((address_space(4)))* k_ = kargp; asm volatile("" : "+s"(k_)); *(const float* const __attribute__((address_space(4)))*)(k_ + 8 * (i)); })
    unsigned char* const ws0 = (unsigned char*)AIN(19);
    F.lds = (LAS unsigned char*)lds; F.ws = ws0; F.ctl = (unsigned*)(ws0 + WS_CTL);
    F.tid = threadIdx.x; F.lane = F.tid & 63; F.wave = __builtin_amdgcn_readfirstlane(F.tid >> 6);
    F.G = gridDim.x; { const int bx = blockIdx.x; F.vcu = (F.G % 8 == 0) ? (bx % 8) * (F.G / 8) + bx / 8 : bx; }
    for (int u = F.tid; u < (LDS_BYTES - LX) / 4; u += NTHR) ((LAS unsigned*)(F.lds + LX))[u] = 0u;
    __syncthreads();
    int lo, hi; { const char __attribute__((address_space(4)))* k_ = kargp; lo = *(const int __attribute__((address_space(4)))*)(k_ + 160); hi = *(const int __attribute__((address_space(4)))*)(k_ + 164); }
    XcdBarrier bar; bar.bar = (unsigned*)(F.ctl + CW_BAR); bar.x = 0; bar.st = nullptr;
    if (hi - lo > 1) bar = xcd_barrier_post((unsigned*)(F.ctl + CW_BAR), (volatile LAS unsigned*)(F.lds + LX_MISC) + 8);
#ifndef PHASE_MASK
#define PHASE_MASK 0x7FFFF
#endif
#define IN(k) ((((PHASE_MASK) >> (k)) & 1) && lo <= (k) && (k) < hi)
#ifndef REPEAT_MASK
#define REPEAT_MASK 0
#endif
#define PH(k) if (IN(k))
#define SEAM(k) do { if (IN(k) && IN((k) + 1)) xcd_barrier(bar); } while (0)
    unsigned char* ws = ws0;
#define x_in AIN(0)
#define ln_mix_g AIN(8)
#define ln_mix_b AIN(9)
#define ln_ffn_g AIN(10)
#define ln_ffn_b AIN(11)
#define router_b AIN(13)
#define b_gu AIN(15)
#define b_dn AIN(17)
    bf16_t* XB = (bf16_t*)(ws + WS_XB); bf16_t* QB_ = (bf16_t*)(ws + WS_Q); bf16_t* KB_ = (bf16_t*)(ws + WS_K); bf16_t* VB_ = (bf16_t*)(ws + WS_V);
    bf16_t* R0 = (bf16_t*)(ws + WS_R0); bf16_t* R1 = (bf16_t*)(ws + WS_R1);
    bf16_t* HB = (bf16_t*)(ws + WS_H); bf16_t* YB = (bf16_t*)(ws + WS_Y);
    LAS unsigned char* ring = F.lds + RING_OFF;
    const int cG = (int)blockIdx.x;
    const bool isConv = (NCONV > 0) && ((int)blockIdx.x >= F.G - NCONV);
    const int Gc = F.G - NCONV, cwv = ((int)blockIdx.x - Gc) * NWAVES + F.wave, ncw = NCONV * NWAVES;
#define CONV_SLICE(a, b) conv_items(F, AIN(14), AIN(16), (int)((long)CONV_ITEMS * (a) / 1000), (int)((long)CONV_ITEMS * (b) / 1000), cwv, ncw)

    PH(0) { P0In I{x_in, AIN(2), AIN(3), AIN(4), AIN(7), AIN(12), AIN(14), AIN(16), (const int*)AIN(1)}; p0_prologue(F, I); }
    SEAM(0);
    PH(1) { { Gemm g{1024, 1024, 1024, nullptr}; DenseSched S{64, 12, F.G, cG, (const char*)XB, (const char*)(ws + WS_WQKV), (size_t)256 * 1024 * 2, (size_t)256 * 1024 * 2};
        EpiQKV E{QB_, KB_, VB_, (const float*)(ws + WS_ROPE), (float*)(ws + WS_KSUM), (LAS float*)(F.lds + LX_ROPE)};
        pg8::gemm_phase<EpiQKV, DenseSched, true, false>(ring, g, S, E); } }
    SEAM(1);
    PH(2) { if (isConv) CONV_SLICE(0, 1000); else {
        const attn_body::AttnTensors AT{(const attn_body::bf16*)QB_, (const attn_body::bf16*)KB_, (const attn_body::bf16*)VB_, (attn_body::bf16*)QB_, (const float*)(ws + WS_KSUM)};
        if (NCONV == 0) { const attn_body::StaticOrder S((int)F.G, (int)blockIdx.x); attn_body::attn_phase<attn_body::StaticOrder>((char*)lds + RING_OFF, AT, S); }
        else { const attn_body::SnakeOrder S{cG, Gc}; attn_body::attn_phase<attn_body::SnakeOrder>((char*)lds + RING_OFF, AT, S); } } }
    SEAM(2);
    PH(3) { { Gemm g{1024, 1024, 1024, nullptr}; DenseSched S{64, 4, F.G, cG, (const char*)QB_, (const char*)(ws + WS_WO), (size_t)256 * 1024 * 2, (size_t)256 * 1024 * 2};
        EpiZ E{XB, R0, DBG_ATTN_MUL}; pg8::gemm_phase<EpiZ, DenseSched, true, false>(ring, g, S, E); } }
    SEAM(3);
    PH(4) phase_ln_router(F, R0, R1, ln_mix_g, ln_mix_b, router_b, 0, 0);
    SEAM(4);
    PH(5) { const int nT = moe_tables(F, 0); LAS unsigned short* tokl = (LAS unsigned short*)(F.lds + LX_TOKL);
        { const unsigned short* rowtok = (const unsigned short*)(ws + WS_ROWTOK); const LAS int* tile_e = (const LAS int*)(F.lds + LX_TILEE); const LAS int* tbase = (const LAS int*)(F.lds + LX_TBASE);
          for (int i = 0; i < TOKL_ROUNDS; ++i) { int pm, pn, hf; if (!moe_unit(i, F.G, cG, nT, 8, pm, pn, hf)) break;
              if (F.tid < 256) { const int e = tile_e[pm]; const int r = (pm - tbase[e]) * 256 + F.tid; const int c = (int)__hip_atomic_load(F.ctl + CW_CNT + 0 * 2048 + e * 64, RLX_AGENT);
                  tokl[i * 256 + F.tid] = (r < c) ? rowtok[(size_t)e * NTOK + r] : (unsigned short)0; } }
          __syncthreads(); }
        Gemm g{512, 512, 512, (const char*)XB};
        MoeSched S{nT, 8, F.G, cG, (const LAS int*)(F.lds + LX_TILEE), (const LAS int*)(F.lds + LX_TBASE), tokl, nullptr, (const char*)(ws + WS_WGU) + (size_t)0 * 32 * 2048 * 1024, 0, (size_t)2048 * 1024, (size_t)256 * 1024};
        EpiGU E{b_gu + (size_t)0 * 32 * 2048, (unsigned char*)HB, (LAS float*)(F.lds + LX_BIAS), 0}; pg8::gemm_phase<EpiGU, MoeSched, true, true, true, true>(ring, g, S, E); }
    SEAM(5);
    PH(6) { const int nT = moe_tables(F, 0); Gemm g{512, 512, 512, nullptr};
        MoeSched S{nT, 4, F.G, cG, (const LAS int*)(F.lds + LX_TILEE), (const LAS int*)(F.lds + LX_TBASE), nullptr, (const char*)HB, (const char*)(ws + WS_WD) + (size_t)0 * 32 * 1024 * 1024, (size_t)256 * 1024, (size_t)1024 * 1024, (size_t)256 * 1024};
        EpiDN E{b_dn + (size_t)0 * 32 * 1024, (unsigned char*)YB, (LAS float*)(F.lds + LX_BIAS), 0}; pg8::gemm_phase<EpiDN, MoeSched, true, false, true, true>(ring, g, S, E); }
    SEAM(6);
    PH(7) phase_combine<true>(F, R1, nullptr, ln_ffn_g, ln_ffn_b, AIN(5), 0);
    { F.lane = (int)attn_body::lane_now(); F.tid = F.wave * 64 + F.lane; }
    SEAM(7);
    PH(8) phase_gate_scan(F);
    SEAM(8);
    PH(9) {
        { Gemm g{512, 512, 512, nullptr}; DenseSched S{64, 8, F.G, cG, (const char*)(ws + WS_X8), (const char*)(ws + WS_WINA), (size_t)256 * 1024, (size_t)256 * 1024};
          EpiINA E{(const float*)(ws + WS_RF), (const float*)(ws + WS_CF), (bf16_t*)(ws + WS_AE), (bf16_t*)(ws + WS_KN), (bf16_t*)(ws + WS_OS)};
          pg8::gemm_phase<EpiINA, DenseSched, true, false, true>(ring, g, S, E); }
        { Gemm g{512, 512, 512, nullptr}; DenseSched S{6, 64, F.G, cG, (const char*)(ws + WS_WINB), (const char*)(ws + WS_X8), (size_t)256 * 1024, (size_t)256 * 1024, true};
          EpiINB E{(const float*)(ws + WS_CF), (bf16_t*)(ws + WS_KT), (bf16_t*)(ws + WS_BE)};
          pg8::gemm_phase<EpiINB, DenseSched, true, false, true, true>(ring, g, S, E); }
    }
    SEAM(9);
    PH(10) { Gemm g{256, 384, NTOK, nullptr}; MuSched S{F.G, cG, 0, (const char*)(ws + WS_BE), (const char*)(ws + WS_KT)};
        EpiM1 E{(bf16_t*)(ws + WS_UT)}; pg8::gemm_phase<EpiM1, MuSched, true, false, false, true>(ring, g, S, E);
        phase_nu(F); }
    SEAM(10);
    PH(11) phase_state_scan(F);
    SEAM(11);
    PH(12) { Gemm g{128, 512, 1024, nullptr}; MuSched S{F.G, cG, 1, (const char*)(ws + WS_AE), (const char*)(ws + WS_KN)};
        EpiM2A E{(bf16_t*)(ws + WS_AE), (const float*)(ws + WS_NPREV), (float*)(ws + WS_DEN)}; pg8::gemm_phase<EpiM2A, MuSched, true, false>(ring, g, S, E); }
    SEAM(12);
    PH(13) { Gemm g{384, 512, 384, nullptr}; MuSched S{F.G, cG, 2, (const char*)(ws + WS_AE), (const char*)(ws + WS_BE)};
        EpiM2B E{(const float*)(ws + WS_DEN), AIN(6), (const bf16_t*)(ws + WS_OS), (bf16_t*)(ws + WS_HN), (LAS float*)(F.lds + LX_LNX)};
        pg8::gemm_phase<EpiM2B, MuSched, true, false>(ring, g, S, E); }
    SEAM(13);
    PH(14) { Gemm g{1024, 1024, 1024, nullptr}; DenseSched S{64, 4, F.G, cG, (const char*)(ws + DBG_P14_A), (const char*)(ws + WS_WOUT), (size_t)256 * 1024 * 2, (size_t)256 * 1024 * 2};
        EpiZ E{XB, R0, DBG_MLSTM_MUL}; pg8::gemm_phase<EpiZ, DenseSched, true, false>(ring, g, S, E); }
    SEAM(14);
    PH(15) phase_ln_router(F, R0, R1, ln_mix_g + 1024, ln_mix_b + 1024, router_b + 32, 1, 1);
    SEAM(15);
    PH(16) { const int nT = moe_tables(F, 1); LAS unsigned short* tokl = (LAS unsigned short*)(F.lds + LX_TOKL);
        { const unsigned short* rowtok = (const unsigned short*)(ws + WS_ROWTOK); const LAS int* tile_e = (const LAS int*)(F.lds + LX_TILEE); const LAS int* tbase = (const LAS int*)(F.lds + LX_TBASE);
          for (int i = 0; i < TOKL_ROUNDS; ++i) { int pm, pn, hf; if (!moe_unit(i, F.G, cG, nT, 8, pm, pn, hf)) break;
              if (F.tid < 256) { const int e = tile_e[pm]; const int r = (pm - tbase[e]) * 256 + F.tid; const int c = (int)__hip_atomic_load(F.ctl + CW_CNT + 1 * 2048 + e * 64, RLX_AGENT);
                  tokl[i * 256 + F.tid] = (r < c) ? rowtok[(size_t)e * NTOK + r] : (unsigned short)0; } }
          __syncthreads(); }
        Gemm g{512, 512, 512, (const char*)XB};
        MoeSched S{nT, 8, F.G, cG, (const LAS int*)(F.lds + LX_TILEE), (const LAS int*)(F.lds + LX_TBASE), tokl, nullptr, (const char*)(ws + WS_WGU) + (size_t)1 * 32 * 2048 * 1024, 0, (size_t)2048 * 1024, (size_t)256 * 1024};
        EpiGU E{b_gu + (size_t)1 * 32 * 2048, (unsigned char*)HB, (LAS float*)(F.lds + LX_BIAS), 0}; pg8::gemm_phase<EpiGU, MoeSched, true, true, true, true>(ring, g, S, E); }
    SEAM(16);
    PH(17) { const int nT = moe_tables(F, 1); Gemm g{512, 512, 512, nullptr};
        MoeSched S{nT, 4, F.G, cG, (const LAS int*)(F.lds + LX_TILEE), (const LAS int*)(F.lds + LX_TBASE), nullptr, (const char*)HB, (const char*)(ws + WS_WD) + (size_t)1 * 32 * 1024 * 1024, (size_t)256 * 1024, (size_t)1024 * 1024, (size_t)256 * 1024};
        EpiDN E{b_dn + (size_t)1 * 32 * 1024, (unsigned char*)YB, (LAS float*)(F.lds + LX_BIAS), 0}; pg8::gemm_phase<EpiDN, MoeSched, true, false, true, true>(ring, g, S, E); }
    SEAM(17);
    PH(18) phase_combine<false>(F, R1, (float*)AIN(18), ln_ffn_g + 1024, ln_ffn_b + 1024, nullptr, 1);
#undef IN
#undef CONV_SLICE
#undef AIN
#undef x_in
#undef ln_mix_g
#undef ln_mix_b
#undef ln_ffn_g
#undef ln_ffn_b
#undef router_b
#undef b_gu
#undef b_dn
#undef SEAM
}

extern "C" void kernel_launch(void* const* d_in, const int* in_sizes, int n_in, void* d_out, int out_size, void* d_ws, size_t ws_size, hipStream_t stream) {
    static int grid = 0;
    if (grid == 0) {
        if (n_in != 18 || out_size != NTOK * DM || ws_size < WS_END) { fprintf(stderr, "kernel_launch: unexpected problem shape (n_in %d, out %d, ws %zu)\n", n_in, out_size, ws_size); grid = -1; return; }
        int dev = 0, cus = 0, per_cu = 0;
        if (hipGetDevice(&dev) != hipSuccess || hipDeviceGetAttribute(&cus, hipDeviceAttributeMultiprocessorCount, dev) != hipSuccess) { grid = -1; return; }
        if (hipFuncSetAttribute((const void*)mk_fwd, hipFuncAttributeMaxDynamicSharedMemorySize, LDS_BYTES) != hipSuccess) { fprintf(stderr, "kernel_launch: hipFuncSetAttribute failed\n"); grid = -1; return; }
        if (hipOccupancyMaxActiveBlocksPerMultiprocessor(&per_cu, (const void*)mk_fwd, NTHR, LDS_BYTES) != hipSuccess || per_cu < 1) fprintf(stderr, "kernel_launch: occupancy query reports %d\n", per_cu);
        (void)hipGetLastError();
        grid = cus;
        if (grid > 256) grid = 256;
        if (grid < 240) { fprintf(stderr, "kernel_launch: %d CUs: this build needs 240..256\n", cus); grid = -1; return; }
    }
    if (grid < 0) return;
    if (hipMemsetAsync((char*)d_ws + WS_CTL, 0, CTL_ZERO_BYTES, stream) != hipSuccess) return;
    Args a{};
    for (int i = 0; i < 18; ++i) a.in[i] = (const float*)d_in[i];
    a.out = (float*)d_out; a.ws = (unsigned char*)d_ws;
#if MK_ONE_LAUNCH
    a.ph_lo = 0; a.ph_hi = NPHASE;
    hipLaunchKernelGGL(mk_fwd, dim3(grid), dim3(NTHR), LDS_BYTES, stream, a);
#else
    for (int p = 0; p < NPHASE; ++p) { a.ph_lo = p; a.ph_hi = p + 1; hipLaunchKernelGGL(mk_fwd, dim3(grid), dim3(NTHR), LDS_BYTES, stream, a); }
#endif
}
```

```cpp
#include <hip/hip_runtime.h>
#include <hip/hip_bf16.h>
#include <cstdio>
#include <cstdint>
#include <cmath>

#define LAS __attribute__((address_space(3)))
#define GAS __attribute__((address_space(1)))
typedef unsigned short bf16_t;
typedef short bf16x8 __attribute__((ext_vector_type(8)));
typedef float f32x4 __attribute__((ext_vector_type(4)));
typedef float f32x2 __attribute__((ext_vector_type(2)));
typedef unsigned u32x4 __attribute__((ext_vector_type(4)));
typedef unsigned u32x2 __attribute__((ext_vector_type(2)));
typedef int i32x4 __attribute__((ext_vector_type(4)));
typedef int i32x8 __attribute__((ext_vector_type(8)));

typedef __bf16 bf16x2_t __attribute__((ext_vector_type(2)));
__device__ __forceinline__ unsigned cvt_pk_bf16(float lo, float hi) { const f32x2 v = {lo, hi}; const bf16x2_t b = __builtin_convertvector(v, bf16x2_t); return __builtin_bit_cast(unsigned, b); }
__device__ __forceinline__ float bf2f(unsigned short b) { return __uint_as_float(((unsigned)b) << 16); }
__device__ __forceinline__ float bflo(unsigned w) { return __uint_as_float(w << 16); }
__device__ __forceinline__ float bfhi(unsigned w) { return __uint_as_float(w & 0xffff0000u); }

__device__ __forceinline__ void glds16s(const void* sbase, unsigned voff, unsigned lds_dst) { unsigned keep;
    asm volatile("s_nop 4\n\ts_mov_b32 %0, m0\n\ts_mov_b32 m0, %3\n\ts_nop 0\n\tglobal_load_lds_dwordx4 %1, %2\n\ts_mov_b32 m0, %0" : "=&s"(keep) : "v"(voff), "s"(sbase), "s"(lds_dst) : "memory"); }
__device__ __forceinline__ void glds4s(const void* sbase, unsigned voff, unsigned lds_dst) { unsigned keep;
    asm volatile("s_nop 4\n\ts_mov_b32 %0, m0\n\ts_mov_b32 m0, %3\n\ts_nop 0\n\tglobal_load_lds_dword %1, %2\n\ts_mov_b32 m0, %0" : "=&s"(keep) : "v"(voff), "s"(sbase), "s"(lds_dst) : "memory"); }
__device__ __forceinline__ const char* uni_ptr(const char* p) { const unsigned long long v = (unsigned long long)p; const unsigned lo = __builtin_amdgcn_readfirstlane((unsigned)v), hi = __builtin_amdgcn_readfirstlane((unsigned)(v >> 32)); return (const char*)(((unsigned long long)hi << 32) | lo); }
namespace pg8 {
constexpr int BM = 256, BK = 64, HALF = 128, HTB = HALF * BK * 2, STAGE_BYTES = 8 * HTB, NXCD = 8, WGM = 8;
__host__ __device__ __forceinline__ int lds_byte(int r, int c) { const int st = (r >> 4) * 2 + (c >> 5), rr = r & 15, cc = c & 31, ob = rr * 64 + cc * 2; return st * 1024 + (ob ^ (((ob >> 9) & 1) << 5)); }
__host__ __device__ __forceinline__ void stage_rc(int b, int& R, int& C) { const int st = b / 1024, sb = b % 1024, swz = sb ^ (((sb >> 9) & 1) << 5); R = (st >> 1) * 16 + swz / 64; C = (st & 1) * 32 + (swz % 64) / 2; }
__host__ __device__ __forceinline__ int perm32(int rho) { const int n = rho >> 4, i = rho & 15; return 8 * (i >> 2) + 4 * n + (i & 3); }

struct Unit { int pm, pn; const char* A; const char* B; const LAS unsigned short* tl; int x0, x1, x2; };
struct Gemm { int K, lda, ldb; const char* Abase; };

__device__ __forceinline__ bool tile_order(int i, int G, int c, int nM, int nN, int& pm, int& pn) {
    const int nwg = nM * nN; const long L = (long)i * G + c; if (L >= nwg) return false;
    int wgid = (int)L; { const int q = nwg / NXCD, r = nwg % NXCD, xcd = wgid % NXCD, off = wgid / NXCD; wgid = (xcd < r ? xcd * (q + 1) : r * (q + 1) + (xcd - r) * q) + off; }
    const int nig = WGM * nN, gid = wgid / nig, fm = gid * WGM, gsz = (nM - fm) < WGM ? (nM - fm) : WGM;
    pm = fm + ((wgid % nig) % gsz); pn = (wgid % nig) / gsz; return true;
}

template <class Epi, class Sched, bool ALIGN_EPI, bool GATHER, bool FP8 = false, bool HALFSEL = false>
__device__ __forceinline__ void gemm_phase(LAS unsigned char* lds, const Gemm g, const Sched& S, const Epi& E) {
    const int tid = threadIdx.x, wid = __builtin_amdgcn_readfirstlane(tid >> 6), lane = tid & 63, wr = wid >> 2, wc = wid & 3, fr = lane & 15, fq = lane >> 4;
    const int K = g.K, nt = K / BK;
    int RA[2]; unsigned cA2[2], voffB[2];
#pragma unroll
    for (int i = 0; i < 2; ++i) { int R, C; stage_rc(tid * 16 + i * 8192, R, C); const int Rb = Epi::PERM ? ((R & ~31) + perm32(R & 31)) : R;
        RA[i] = R; cA2[i] = (unsigned)C * 2u; voffB[i] = (unsigned)(Rb * g.ldb + C) * 2u; }
    const size_t kstep = (size_t)(BK * 2);
    const unsigned hstepA = (unsigned)HALF * (unsigned)g.lda * 2u; const size_t hstepB = (size_t)HALF * g.ldb * 2;
    const unsigned ldsb = (unsigned)__builtin_amdgcn_readfirstlane((unsigned)(unsigned long long)lds + (unsigned)wid * 1024u);
    const int aoff = lds_byte(wr * 64 + fr, fq * 8), boff = lds_byte(wc * 32 + fr, fq * 8);
    const int aoff2 = aoff + 1024, boff2 = boff + 1024;
#define PG8_SA(b, h) (((b) * 2 + (h)) * HTB)
#define PG8_SB(b, h) ((4 + (b) * 2 + (h)) * HTB)
#define PG8_STAGE(bufoff, gbase, voff) do { _Pragma("unroll") for (int _i = 0; _i < 2; ++_i) glds16s((gbase), (voff)[_i], ldsb + (unsigned)(bufoff) + _i * 8192u); } while (0)
#define PG8_STAGE_A(bufoff, gbase, AO, h) do { _Pragma("unroll") for (int _i = 0; _i < 2; ++_i) glds16s((gbase), (AO)[h][_i], ldsb + (unsigned)(bufoff) + _i * 8192u); } while (0)
#define PG8_LD8(base_, o1_, o2_) __builtin_shufflevector(*(const LAS i32x4*)(lds + (base_) + (o1_)), *(const LAS i32x4*)(lds + (base_) + (o2_)), 0, 1, 2, 3, 4, 5, 6, 7)
#define PG8_LDA(dst, b, h) do { if constexpr (FP8) { _Pragma("unroll") for (int m = 0; m < 4; ++m) dst##8[m] = PG8_LD8(PG8_SA(b, h) + m * 2048, aoff, aoff2); } \
        else { _Pragma("unroll") for (int m = 0; m < 4; ++m) _Pragma("unroll") for (int k = 0; k < 2; ++k) dst[m][k] = *(const LAS bf16x8*)(lds + PG8_SA(b, h) + aoff + m * 2048 + k * 1024); } } while (0)
#define PG8_LDB(dst, b, h) do { if constexpr (FP8) { _Pragma("unroll") for (int n = 0; n < 2; ++n) dst##8[n] = PG8_LD8(PG8_SB(b, h) + n * 2048, boff, boff2); } \
        else { _Pragma("unroll") for (int n = 0; n < 2; ++n) _Pragma("unroll") for (int k = 0; k < 2; ++k) dst[n][k] = *(const LAS bf16x8*)(lds + PG8_SB(b, h) + boff + n * 2048 + k * 1024); } } while (0)
#define PG8_MMA(ai, bj, At, Bt) do { __builtin_amdgcn_s_setprio(1); _Pragma("unroll") for (int m = 0; m < 4; ++m) _Pragma("unroll") for (int n = 0; n < 2; ++n) { \
        if constexpr (FP8) asm volatile("v_mfma_f32_16x16x128_f8f6f4 %0, %1, %2, %0" : "+v"(acc[ai][bj][m][n]) : "v"(Bt##8[n]), "v"(At##8[m])); \
        else { _Pragma("unroll") for (int k = 0; k < 2; ++k) acc[ai][bj][m][n] = __builtin_amdgcn_mfma_f32_16x16x32_bf16(Bt[n][k], At[m][k], acc[ai][bj][m][n], 0, 0, 0); } } \
        __builtin_amdgcn_s_setprio(0); } while (0)
#define PG8_WAIT_V(n) asm volatile("s_waitcnt vmcnt(" #n ")" ::: "memory")
#define PG8_WAIT_L(n) asm volatile("s_waitcnt lgkmcnt(" #n ")" ::: "memory")
#define PG8_BAR __builtin_amdgcn_s_barrier()
#define PG8_SCHED __builtin_amdgcn_sched_barrier(0)
#define PG8_AOFF(AO, U) do { _Pragma("unroll") for (int _h = 0; _h < 2; ++_h) _Pragma("unroll") for (int _i = 0; _i < 2; ++_i) { \
        if constexpr (GATHER) AO[_h][_i] = (unsigned)(U).tl[RA[_i] + _h * HALF] * (unsigned)(g.lda * 2) + cA2[_i]; \
        else AO[_h][_i] = (unsigned)RA[_i] * (unsigned)(g.lda * 2) + cA2[_i] + (unsigned)_h * hstepA; } } while (0)
    Unit cur, nxt; int ui = 0;
    if (!S.next(0, cur)) return;
    f32x4 acc[2][2][4][2];
#pragma unroll
    for (int a = 0; a < 2; ++a)
#pragma unroll
        for (int b = 0; b < 2; ++b)
#pragma unroll
            for (int m = 0; m < 4; ++m)
#pragma unroll
                for (int n = 0; n < 2; ++n) acc[a][b][m][n] = (f32x4){0.f, 0.f, 0.f, 0.f};
    bf16x8 At[4][2], B0[2][2], B1[2][2]; i32x8 At8[4], B08[2], B18[2];
    E.prep(cur, 0, wid, lane);
    unsigned aoC[2][2], aoN[2][2];
    PG8_AOFF(aoC, cur);
    const char* cA = uni_ptr(GATHER ? g.Abase : cur.A); const char* cB = uni_ptr(cur.B);
    PG8_STAGE(PG8_SB(0, 0), cB, voffB); PG8_STAGE(PG8_SB(0, 1), cB + hstepB, voffB); PG8_STAGE_A(PG8_SA(0, 0), cA, aoC, 0); PG8_STAGE_A(PG8_SA(0, 1), cA, aoC, 1);
    if (wr == 1) PG8_BAR;
    PG8_WAIT_V(2); PG8_BAR;
    PG8_STAGE(PG8_SB(1, 0), cB + kstep, voffB); PG8_STAGE_A(PG8_SA(1, 0), cA + kstep, aoC, 0); PG8_STAGE(PG8_SB(1, 1), cB + hstepB + kstep, voffB);
    PG8_WAIT_V(6); PG8_BAR;
    for (;;) {
        const bool has_next = S.next(ui + 1, nxt);
        if (has_next) E.prep(nxt, ui + 1, wid, lane);
        if constexpr (GATHER) { if (has_next) PG8_AOFF(aoN, nxt); else { _Pragma("unroll") for (int _h = 0; _h < 2; ++_h) _Pragma("unroll") for (int _i = 0; _i < 2; ++_i) aoN[_h][_i] = aoC[_h][_i]; } }
        const char* nA = uni_ptr(GATHER ? g.Abase : (has_next ? nxt.A : cA)); const char* nB = uni_ptr(has_next ? nxt.B : cB);
        const bool dh0 = cur.x2 != 2, dh1 = cur.x2 != 1;
#pragma nounroll
        for (int t = 0; t < nt; t += 2) {
            const bool last = (t == nt - 2);
            if constexpr (Epi::MID) { if (t == 2) E.prep_mid(cur, wid, lane); }
            const char* a1 = cA + (size_t)(t + 1) * kstep;
            const char* a2 = last ? nA : cA + (size_t)(t + 2) * kstep; const char* b2 = last ? nB : cB + (size_t)(t + 2) * kstep;
            const char* a3 = a2 + kstep; const char* b3 = b2 + kstep;
            unsigned aoS[2][2];
#pragma unroll
            for (int _h = 0; _h < 2; ++_h)
#pragma unroll
                for (int _i = 0; _i < 2; ++_i) aoS[_h][_i] = (GATHER && last) ? aoN[_h][_i] : aoC[_h][_i];
            PG8_LDB(B0, 0, 0); PG8_LDB(B1, 0, 1); PG8_SCHED; PG8_LDA(At, 0, 0); PG8_STAGE_A(PG8_SA(1, 1), a1, aoC, 1);
            PG8_WAIT_V(8); PG8_WAIT_L(0); PG8_BAR; if (!HALFSEL || dh0) PG8_MMA(0, 0, At, B0); if (!HALFSEL || dh1) PG8_MMA(0, 1, At, B1); PG8_BAR; PG8_SCHED;
            PG8_LDA(At, 0, 1); PG8_STAGE(PG8_SB(0, 0), b2, voffB); PG8_STAGE(PG8_SB(0, 1), b2 + hstepB, voffB); PG8_STAGE_A(PG8_SA(0, 0), a2, aoS, 0);
            PG8_WAIT_V(8); PG8_WAIT_L(0); PG8_BAR; if (!HALFSEL || dh0) PG8_MMA(1, 0, At, B0); if (!HALFSEL || dh1) PG8_MMA(1, 1, At, B1); PG8_BAR; PG8_SCHED;
            PG8_LDB(B0, 1, 0); PG8_LDB(B1, 1, 1); PG8_SCHED; PG8_LDA(At, 1, 0); PG8_STAGE_A(PG8_SA(0, 1), a2, aoS, 1);
            PG8_WAIT_V(8); PG8_WAIT_L(0); PG8_BAR; if (!HALFSEL || dh0) PG8_MMA(0, 0, At, B0); if (!HALFSEL || dh1) PG8_MMA(0, 1, At, B1); PG8_BAR; PG8_SCHED;
            PG8_LDA(At, 1, 1); PG8_STAGE(PG8_SB(1, 0), b3, voffB); PG8_STAGE(PG8_SB(1, 1), b3 + hstepB, voffB); PG8_STAGE_A(PG8_SA(1, 0), a3, aoS, 0);
            PG8_WAIT_V(8); PG8_WAIT_L(0); PG8_BAR; if (!HALFSEL || dh0) PG8_MMA(1, 0, At, B0); if (!HALFSEL || dh1) PG8_MMA(1, 1, At, B1); PG8_BAR; PG8_SCHED;
        }
        if constexpr (FP8) asm volatile("s_nop 15\n\ts_nop 15" ::: "memory");
        if constexpr (ALIGN_EPI) { if (wr == 0) PG8_BAR; }
        E(acc, cur, wr, wc, fr, fq);
        if (!has_next) break;
#pragma unroll
        for (int a = 0; a < 2; ++a)
#pragma unroll
            for (int b = 0; b < 2; ++b)
#pragma unroll
                for (int m = 0; m < 4; ++m)
#pragma unroll
                    for (int n = 0; n < 2; ++n) acc[a][b][m][n] = (f32x4){0.f, 0.f, 0.f, 0.f};
        if constexpr (FP8) asm volatile("s_nop 7" ::: "memory");
        cur = nxt; cA = nA; cB = nB; ++ui;
        if constexpr (GATHER) {
#pragma unroll
            for (int _h = 0; _h < 2; ++_h)
#pragma unroll
                for (int _i = 0; _i < 2; ++_i) aoC[_h][_i] = aoN[_h][_i]; }
        if constexpr (ALIGN_EPI) { if (wr == 1) PG8_BAR; }
    }
    PG8_WAIT_V(0);
    if constexpr (!ALIGN_EPI) { if (wr == 0) PG8_BAR; }
    PG8_BAR;
#undef PG8_SA
#undef PG8_SB
#undef PG8_STAGE
#undef PG8_STAGE_A
#undef PG8_LDA
#undef PG8_LD8
#undef PG8_LDB
#undef PG8_MMA
#undef PG8_WAIT_V
#undef PG8_WAIT_L
#undef PG8_BAR
#undef PG8_SCHED
#undef PG8_AOFF
}
}
#include <hip/hip_bf16.h>
namespace attn_body {
using bf16=__hip_bfloat16;
using bf16x8=__attribute__((ext_vector_type(8)))short;
using s16x4=__attribute__((ext_vector_type(4)))short;
using f32x16=__attribute__((ext_vector_type(16)))float;
using u32x4=__attribute__((ext_vector_type(4)))unsigned;
constexpr int BATCH=4,NHEAD=16,SEQ=4096,D=64,DM=NHEAD*D;
constexpr int NW=8,QBLK=32,QB=QBLK*NW,KVBLK=64,NQB=SEQ/QB;
constexpr int ATTN_PITCH=DM, ATTN_UNIT_ROWS=QB;
__device__ __forceinline__ int crow(int r,int hi){return (r&3)+8*(r>>2)+4*hi;}
#define SBAR() __builtin_amdgcn_sched_barrier(0)
__device__ __forceinline__ void cmask(f32x16&p0,f32x16&p1,int jb,int qrel,int hi){
  const float NEG=-INFINITY; int d=qrel-64*jb-4*hi; asm volatile("":"+v"(d));
  #pragma unroll
  for(int r=0;r<16;++r){const int c=(r&3)+8*(r>>2); if(c>d)p0[r]=NEG; if(c+32>d)p1[r]=NEG;}
}

constexpr int NSLOT=3, SLOTB=8192;
constexpr int LDS_GT=98304;
constexpr int LDS_K=0, LDS_V=NSLOT*SLOTB, LDS_WS=2*NSLOT*SLOTB, LDS_OST=LDS_WS+NW*64*4, LDS_BYTES=LDS_OST+NW*4096;
constexpr float C2=0.125f*1.4426950408889634f;
__device__ __forceinline__ void glds16(const void*gsrc,unsigned lds_dst){unsigned keep;
  asm volatile("s_mov_b32 %0, m0\n\ts_mov_b32 m0, %2\n\ts_nop 0\n\tglobal_load_lds_dwordx4 %1, off\n\ts_mov_b32 m0, %0":"=&s"(keep):"v"(gsrc),"s"(lds_dst):"memory");}
__device__ __forceinline__ void glds16s(const void*sbase,unsigned voff,unsigned lds_dst){unsigned keep;
  asm volatile("s_nop 4\n\ts_mov_b32 %0, m0\n\ts_mov_b32 m0, %3\n\ts_nop 0\n\tglobal_load_lds_dwordx4 %1, %2\n\ts_mov_b32 m0, %0":"=&s"(keep):"v"(voff),"s"(sbase),"s"(lds_dst):"memory");}
__device__ __forceinline__ unsigned lane_now(){unsigned l;asm volatile("v_mbcnt_lo_u32_b32 %0, -1, 0\n\tv_mbcnt_hi_u32_b32 %0, -1, %0":"=v"(l));return l;}
__device__ __forceinline__ float max3f(float a,float b,float c){float r;asm("v_max3_f32 %0, %1, %2, %3":"=v"(r):"v"(a),"v"(b),"v"(c));return r;}
__device__ __forceinline__ float max2f(float a,float b){float r;asm("v_max_f32_e32 %0, %1, %2":"=v"(r):"v"(a),"v"(b));return r;}
__device__ __forceinline__ float fadd_s(float a,float b){float r;asm("v_add_f32_e32 %0, %1, %2":"=v"(r):"v"(a),"v"(b));return r;}
__device__ __forceinline__ float fsub_s(float a,float b){float r;asm("v_sub_f32_e32 %0, %1, %2":"=v"(r):"v"(a),"v"(b));return r;}
typedef float f32x2_t __attribute__((ext_vector_type(2))); typedef __bf16 bf16x2_t __attribute__((ext_vector_type(2)));
__device__ __forceinline__ unsigned cvtpk_s(float lo,float hi){f32x2_t v={lo,hi};bf16x2_t b=__builtin_convertvector(v,bf16x2_t);return __builtin_bit_cast(unsigned,b);}
#define WAIT_BAR(N) asm volatile("s_waitcnt vmcnt(" #N ") lgkmcnt(0)\n\ts_barrier":::"memory")

__device__ __forceinline__ void qkt(f32x16&p0,f32x16&p1,const char*Kslot,const bf16x8*qr,int r32,int hi){
  const char*kb=Kslot+hi*1024+r32*16;
  #pragma unroll
  for(int d0=0;d0<4;++d0){
    const bf16x8 b0=*reinterpret_cast<const bf16x8*>(kb+d0*2048);
    const bf16x8 b1=*reinterpret_cast<const bf16x8*>(kb+d0*2048+512);
    if(d0==0){p0=__builtin_amdgcn_mfma_f32_32x32x16_bf16(b0,qr[0],(f32x16){0.f,0.f,0.f,0.f,0.f,0.f,0.f,0.f,0.f,0.f,0.f,0.f,0.f,0.f,0.f,0.f},0,0,0);p1=__builtin_amdgcn_mfma_f32_32x32x16_bf16(b1,qr[0],(f32x16){0.f,0.f,0.f,0.f,0.f,0.f,0.f,0.f,0.f,0.f,0.f,0.f,0.f,0.f,0.f,0.f},0,0,0);}
    else{p0=__builtin_amdgcn_mfma_f32_32x32x16_bf16(b0,qr[d0],p0,0,0,0);p1=__builtin_amdgcn_mfma_f32_32x32x16_bf16(b1,qr[d0],p1,0,0,0);}}
}
typedef __attribute__((address_space(3))) const char* lds_cptr;
typedef short v4i16_t __attribute__((ext_vector_type(4)));
__device__ __forceinline__ void kload8(bf16x8*kf,lds_cptr kp){
  kf[0]=*(const __attribute__((address_space(3))) bf16x8*)(kp);      kf[1]=*(const __attribute__((address_space(3))) bf16x8*)(kp+512);
  kf[2]=*(const __attribute__((address_space(3))) bf16x8*)(kp+2048); kf[3]=*(const __attribute__((address_space(3))) bf16x8*)(kp+2560);
  kf[4]=*(const __attribute__((address_space(3))) bf16x8*)(kp+4096); kf[5]=*(const __attribute__((address_space(3))) bf16x8*)(kp+4608);
  kf[6]=*(const __attribute__((address_space(3))) bf16x8*)(kp+6144); kf[7]=*(const __attribute__((address_space(3))) bf16x8*)(kp+6656);
}
__device__ __forceinline__ void kload2(bf16x8*kf,lds_cptr kp,int j){ kf[2*j]=*(const __attribute__((address_space(3))) bf16x8*)(kp+j*2048); kf[2*j+1]=*(const __attribute__((address_space(3))) bf16x8*)(kp+j*2048+512); }
__device__ __forceinline__ s16x4 vtr(lds_cptr p){ return __builtin_bit_cast(s16x4,__builtin_amdgcn_ds_read_tr16_b64_v4i16((__attribute__((address_space(3))) v4i16_t*)p)); }
__device__ __forceinline__ float rowmax(const f32x16&p0,const f32x16&p1){
  float a=max3f(p0[0],p0[1],p1[0]),b=max3f(p0[2],p0[3],p1[1]);a=max3f(a,p1[2],p1[3]);
  #pragma unroll
  for(int r=4;r<16;r+=4){a=max3f(a,p0[r],p0[r+1]);b=max3f(b,p0[r+2],p0[r+3]);a=max3f(a,p1[r],p1[r+1]);b=max3f(b,p1[r+2],p1[r+3]);}
  const float m=max2f(a,b);
  auto rr=__builtin_amdgcn_permlane32_swap(__float_as_uint(m),__float_as_uint(m),false,false);
  return max2f(__uint_as_float(rr[0]),__uint_as_float(rr[1]));
}
__device__ __forceinline__ void pv(f32x16*o,int vb,bf16x8 pa0,bf16x8 pa1,bf16x8 pa2,bf16x8 pa3){
  #pragma unroll
  for(int d0=0;d0<2;++d0){s16x4 lo[4],hi[4];
    #pragma unroll
    for(int ks=0;ks<4;++ks){
      asm volatile("ds_read_b64_tr_b16 %0,%1 offset:%c2":"=&v"(lo[ks]):"v"(vb),"i"(d0*4096+ks*1024):"memory");
      asm volatile("ds_read_b64_tr_b16 %0,%1 offset:%c2":"=&v"(hi[ks]):"v"(vb),"i"(d0*4096+ks*1024+512):"memory");}
    asm volatile("s_waitcnt lgkmcnt(0)":::"memory");SBAR();
    #define PK(k) (bf16x8){lo[k][0],lo[k][1],lo[k][2],lo[k][3],hi[k][0],hi[k][1],hi[k][2],hi[k][3]}
    o[d0]=__builtin_amdgcn_mfma_f32_32x32x16_bf16(pa0,PK(0),o[d0],0,0,0);
    o[d0]=__builtin_amdgcn_mfma_f32_32x32x16_bf16(pa1,PK(1),o[d0],0,0,0);
    o[d0]=__builtin_amdgcn_mfma_f32_32x32x16_bf16(pa2,PK(2),o[d0],0,0,0);
    o[d0]=__builtin_amdgcn_mfma_f32_32x32x16_bf16(pa3,PK(3),o[d0],0,0,0);
    #undef PK
  }
}

#ifndef ATTN_STORE16
#define ATTN_STORE16(p,v) (*(u32x4*)(p)=(v))
#endif
template<int THRL> __device__ __forceinline__ void attn_unit(int b,int h,int qb,const bf16*Q,const bf16*__restrict__ K,const bf16*__restrict__ V,unsigned char*O,const float*ksum,char*shm){
  const int tid=threadIdx.x,lane=tid&63,r32=lane&31,hi=lane>>5; const int wid=__builtin_amdgcn_readfirstlane(tid>>6);
  const long rowbase=(long)b*SEQ; const int q0=qb*QB;
  const bf16*Qw=Q+(rowbase+q0+wid*QBLK)*DM+h*D;
  const bf16*Kh=K+rowbase*DM+h*D,*Vh=V+rowbase*DM+h*D;
  const unsigned lds0=(unsigned)(uintptr_t)shm;
  float*wsf=(float*)(shm+LDS_WS)+wid*64;
  const unsigned kdst=lds0+LDS_K+wid*1024, vdst=lds0+LDS_V+wid*1024;
  #define PHYS(t) (((t)<4)?(4*qb+(t)):((t)-4))
  #define DMA_K(t,slot) glds16s((const char*)Kh+(size_t)PHYS(t)*(KVBLK*DM*2)+wid*16,lane_now()*(unsigned)(DM*2),(unsigned)__builtin_amdgcn_readfirstlane(kdst+(slot)))
  #define DMA_V(t,slot) glds16s((const char*)Vh+(size_t)PHYS(t)*(KVBLK*DM*2)+(size_t)(16*(wid&3))*(DM*2)+(wid>>2)*64,({const unsigned l_=lane_now(); (l_>>2)*(unsigned)(DM*2)+(l_&3u)*16u;}),(unsigned)__builtin_amdgcn_readfirstlane(vdst+(slot)))
  const int vb0=(int)(lds0+LDS_V)+((lane>>4)&1)*32+(lane&3)*8+(4*hi+((lane&15)>>2))*64;
  const char*Kbase=shm+LDS_K; bf16x8 kf[8];
  const lds_cptr shm3=(lds_cptr)shm; const lds_cptr kp0=shm3+LDS_K+hi*1024+r32*16; const lds_cptr vp0=shm3+LDS_V+((lane>>4)&1)*32+(lane&3)*8+(4*hi+((lane&15)>>2))*64;
  const int NT=(q0+QB)/KVBLK;
  DMA_K(0,0);DMA_V(0,0);DMA_K(1,SLOTB);
  { float*gt=(float*)(shm+LDS_GT);
    #pragma unroll
    for(int k=0;k<2;++k){ const int j=2*wid+k; if(j<qb) gt[j*64+lane]=ksum[(long)(b*16+j)*DM+h*D+lane]; } }
  bf16x8 qr[4];
  #pragma unroll
  for(int d0=0;d0<4;++d0)qr[d0]=*reinterpret_cast<const bf16x8*>(&Qw[(long)r32*DM+d0*16+hi*8]);

  unsigned sel=0u;
  float mhat=0.f,l_reg=0.f;f32x16 o[2];o[0]=f32x16{};o[1]=f32x16{};
  bf16x8 kone=(bf16x8){0,0,0,0,0,0,0,0}, qm=(bf16x8){0,0,0,0,0,0,0,0}; if(hi==0) kone[0]=(short)0x3F80;
  #define SETQM() do{ const unsigned short mb_=(unsigned short)(cvtpk_s(-mhat,0.f)&0xffffu); qm[0]=(hi==0)?(short)mb_:(short)0; asm volatile("":"+v"(qm)); }while(0)
  const int qrel=wid*QBLK+r32;
  #define CMASK(P0,P1,t) do{ const int t_=(t); if(t_<4){ const int l_=(int)lane_now(); cmask(P0,P1,t_,wid*QBLK+(l_&31),l_>>5); } else if(!((sel>>(((t_-4)>>2)&15))&1u)){ _Pragma("unroll") for(int r=0;r<16;++r){P0[r]=-INFINITY;P1[r]=-INFINITY;} } }while(0)
  bool resc=false;
  #define START(P0,P1) do{ const float rm=rowmax(P0,P1); resc=false; \
    { const float dl=__uint_as_float(cvtpk_s(rm,0.f)<<16); mhat=fadd_s(mhat,dl);          \
      _Pragma("unroll") for(int r=0;r<16;++r){P0[r]=fsub_s(P0[r],dl);P1[r]=fsub_s(P1[r],dl);} \
      SETQM(); } \
    _Pragma("unroll") for(int r=0;r<16;++r)P0[r]=__builtin_amdgcn_exp2f(P0[r]); }while(0)
  #define RESC() do{ if(resc){ asm volatile("s_waitcnt lgkmcnt(0)":::"memory"); \
      _Pragma("unroll") for(int d_=0;d_<2;++d_) _Pragma("unroll") for(int r=0;r<16;++r)o[d_][r]*=wsf[crow(r,(int)(lane_now()>>5))]; } }while(0)
  f32x16 pA0,pA1,pB0,pB1;
  int sl_prev=0,sl_cur=0,sl_next=SLOTB;
  #define ROT() do{sl_prev=sl_cur;sl_cur=sl_next;sl_next=(sl_next==(NSLOT-1)*SLOTB)?0:sl_next+SLOTB;}while(0)
  DMA_K(2,2*SLOTB);
  WAIT_BAR(3);
  { float qf[32];
    #pragma unroll
    for(int d0=0;d0<4;++d0){
      #pragma unroll
      for(int i=0;i<8;++i) qf[d0*8+i]=__uint_as_float(((unsigned)(unsigned short)qr[d0][i])<<16); }
    const float*gt=(const float*)(shm+LDS_GT)+hi*8; float g[15];
    #pragma unroll
    for(int j=0;j<15;++j){ g[j]=-INFINITY;
      if(j<qb){ const float*kp=gt+j*64; float a=0.f;
        #pragma unroll
        for(int d0=0;d0<4;++d0){ const float4 k0=*reinterpret_cast<const float4*>(kp+d0*16), k1=*reinterpret_cast<const float4*>(kp+d0*16+4);
          a+=qf[d0*8+0]*k0.x; a+=qf[d0*8+1]*k0.y; a+=qf[d0*8+2]*k0.z; a+=qf[d0*8+3]*k0.w; a+=qf[d0*8+4]*k1.x; a+=qf[d0*8+5]*k1.y; a+=qf[d0*8+6]*k1.z; a+=qf[d0*8+7]*k1.w; }
        g[j]=a+__shfl_xor(a,32); } }
    #pragma unroll
    for(int kk=0;kk<3;++kk){ float best=-INFINITY; int bj=-1;
      #pragma unroll
      for(int j=0;j<15;++j){ const bool c=(j<qb)&&!((sel>>j)&1u)&&(g[j]>best); best=c?g[j]:best; bj=c?j:bj; }
      if(bj>=0) sel|=(1u<<bj); } }
  qkt(pA0,pA1,Kbase,qr,r32,hi);asm volatile("s_nop 15\n\ts_nop 7":"+v"(pA0),"+v"(pA1));CMASK(pA0,pA1,0);
  START(pA0,pA1);
  _Pragma("unroll") for(int r=0;r<16;++r)pA1[r]=__builtin_amdgcn_exp2f(pA1[r]);
  WAIT_BAR(0);
  DMA_K(3,0);DMA_V(1,SLOTB);
  ROT();
  kload8(kf,kp0+sl_cur);
  WAIT_BAR(2);
  s16x4 vlo[8],vhi[8]; u32x4 pw0,pw1,pw2,pw3;
  #define PKW(P,B) cvtpk_s(P[B],P[B+1])
  #define PAF(k) __builtin_bit_cast(bf16x8,pw##k)
  #define VFR(i) (bf16x8){vlo[i][0],vlo[i][1],vlo[i][2],vlo[i][3],vhi[i][0],vhi[i][1],vhi[i][2],vhi[i][3]}
  #define PIN(x) asm volatile("":"+v"(x))
  #define MX3(a,b,c) __builtin_fmaxf(__builtin_fmaxf((a),(b)),(c))
  #define GAPA(MF,A0,A1,A2,A3,W0,W1,PW) do{ MF; sacc+=A0; sacc+=A1; sacc+=A2; sacc+=A3; PIN(sacc); W0; W1; PIN(PW); SBAR(); }while(0)
  #define EX(v) __builtin_amdgcn_exp2f(v)
  #define GAPB(MF,X,B) do{ MF; X[B]=EX(X[B]); X[B+1]=EX(X[B+1]); X[B+2]=EX(X[B+2]); X[B+3]=EX(X[B+3]); PIN(X); SBAR(); }while(0)
  #define VRD(i) do{ vlo[i]=vtr(vp_+(((i)>>2)*4096+((i)&3)*1024)); vhi[i]=vtr(vp_+(((i)>>2)*4096+((i)&3)*1024+512)); }while(0)
  #define KRD(G,j) do{ if(G){ kload2(kf,kp0+sl_next,j); SBAR(); } }while(0)
  #define STEP(C0,C1,P0,P1,t,GK,GV,GL) do{ SBAR(); \
    const lds_cptr vp_=vp0+sl_prev; \
    C0=__builtin_amdgcn_mfma_f32_32x32x16_bf16(kone,qm,(f32x16){0.f,0.f,0.f,0.f,0.f,0.f,0.f,0.f,0.f,0.f,0.f,0.f,0.f,0.f,0.f,0.f},0,0,0); C1=__builtin_amdgcn_mfma_f32_32x32x16_bf16(kone,qm,(f32x16){0.f,0.f,0.f,0.f,0.f,0.f,0.f,0.f,0.f,0.f,0.f,0.f,0.f,0.f,0.f,0.f},0,0,0); SBAR(); \
    VRD(0); SBAR(); float sacc=(P0[0]+P0[1]); \
    GAPA(C0=__builtin_amdgcn_mfma_f32_32x32x16_bf16(kf[0],qr[0],C0,0,0,0), P0[2],P0[3],P0[4],P0[5],     pw0[0]=PKW(P0,0), pw0[1]=PKW(P0,2), pw0); \
    VRD(4); SBAR(); GAPA(C1=__builtin_amdgcn_mfma_f32_32x32x16_bf16(kf[1],qr[0],C1,0,0,0), P0[6],P0[7],P0[8],P0[9],     pw0[2]=PKW(P0,4), pw0[3]=PKW(P0,6), pw0); \
    VRD(1); SBAR(); GAPA(C0=__builtin_amdgcn_mfma_f32_32x32x16_bf16(kf[2],qr[1],C0,0,0,0),   P0[10],P0[11],P0[12],P0[13], pw1[0]=PKW(P0,8), pw1[1]=PKW(P0,10), pw1); \
    VRD(5); SBAR(); GAPA(C1=__builtin_amdgcn_mfma_f32_32x32x16_bf16(kf[3],qr[1],C1,0,0,0),   P0[14],P0[15],P1[0],P1[1],   pw1[2]=PKW(P0,12),pw1[3]=PKW(P0,14), pw1); \
    VRD(2); SBAR(); GAPA(C0=__builtin_amdgcn_mfma_f32_32x32x16_bf16(kf[4],qr[2],C0,0,0,0),   P1[2],P1[3],P1[4],P1[5],     pw2[0]=PKW(P1,0), pw2[1]=PKW(P1,2), pw2); \
    VRD(6); SBAR(); GAPA(C1=__builtin_amdgcn_mfma_f32_32x32x16_bf16(kf[5],qr[2],C1,0,0,0),   P1[6],P1[7],P1[8],P1[9],     pw2[2]=PKW(P1,4), pw2[3]=PKW(P1,6), pw2); \
    VRD(3); SBAR(); GAPA(C0=__builtin_amdgcn_mfma_f32_32x32x16_bf16(kf[6],qr[3],C0,0,0,0),   P1[10],P1[11],P1[12],P1[13], pw3[0]=PKW(P1,8), pw3[1]=PKW(P1,10), pw3); \
    VRD(7); SBAR(); GAPA(C1=__builtin_amdgcn_mfma_f32_32x32x16_bf16(kf[7],qr[3],C1,0,0,0),   P1[14],P1[15],0.f,0.f,       pw3[2]=PKW(P1,12),pw3[3]=PKW(P1,14), pw3); \
    l_reg+=sacc; \
    if(GK){DMA_K((t)+3,sl_cur);} if(GV){DMA_V((t)+1,sl_next);} \
    CMASK(C0,C1,t); \
    { float a=MX3(C0[0],C0[1],C1[0]),b=MX3(C0[2],C0[3],C1[1]); a=MX3(a,C1[2],C1[3]); \
      _Pragma("unroll") for(int r=4;r<16;r+=4){a=MX3(a,C0[r],C0[r+1]);b=MX3(b,C0[r+2],C0[r+3]);a=MX3(a,C1[r],C1[r+1]);b=MX3(b,C1[r+2],C1[r+3]);} \
      float rm=__builtin_fmaxf(a,b); { auto rr=__builtin_amdgcn_permlane32_swap(__float_as_uint(rm),__float_as_uint(rm),false,false); rm=__builtin_fmaxf(__uint_as_float(rr[0]),__uint_as_float(rr[1])); } \
      resc=false; \
      if(__builtin_expect(__any(rm>(float)THRL),0)){ const float mn_=__uint_as_float(cvtpk_s(mhat+__builtin_fmaxf(rm,0.f),0.f)<<16); const float dl=mn_-mhat; mhat=mn_; \
        _Pragma("unroll") for(int r=0;r<16;++r){C0[r]-=dl;C1[r]-=dl;} \
        SETQM(); \
        const float f=__builtin_amdgcn_exp2f(-dl); l_reg*=f; { const int l_=(int)lane_now(); if((l_>>5)==0)wsf[l_&31]=f; } resc=true; } } \
    SBAR(); \
    GAPB(o[0]=__builtin_amdgcn_mfma_f32_32x32x16_bf16(PAF(0),VFR(0),o[0],0,0,0), C0,0); \
    GAPB(o[1]=__builtin_amdgcn_mfma_f32_32x32x16_bf16(PAF(0),VFR(4),o[1],0,0,0), C0,4); \
    KRD(GL,0); GAPB(o[0]=__builtin_amdgcn_mfma_f32_32x32x16_bf16(PAF(1),VFR(1),o[0],0,0,0), C0,8); \
    KRD(GL,1); GAPB(o[1]=__builtin_amdgcn_mfma_f32_32x32x16_bf16(PAF(1),VFR(5),o[1],0,0,0), C0,12); \
    KRD(GL,2); GAPB(o[0]=__builtin_amdgcn_mfma_f32_32x32x16_bf16(PAF(2),VFR(2),o[0],0,0,0), C1,0); \
    KRD(GL,3); GAPB(o[1]=__builtin_amdgcn_mfma_f32_32x32x16_bf16(PAF(2),VFR(6),o[1],0,0,0), C1,4); \
    GAPB(o[0]=__builtin_amdgcn_mfma_f32_32x32x16_bf16(PAF(3),VFR(3),o[0],0,0,0), C1,8); \
    GAPB(o[1]=__builtin_amdgcn_mfma_f32_32x32x16_bf16(PAF(3),VFR(7),o[1],0,0,0), C1,12); \
    }while(0)
  int t=1;
  #undef CMASK
  #define CMASK(P0,P1,t) do{ const int t_=(t); if(t_<4){ const int l_=(int)lane_now(); cmask(P0,P1,t_,wid*QBLK+(l_&31),l_>>5); } else if(!((sel>>(((t_-4)>>2)&15))&1u)){ _Pragma("unroll") for(int r=0;r<16;++r){P0[r]=-INFINITY;P1[r]=-INFINITY;} } }while(0)
  for(;t+5<NT;t+=2){
    STEP(pB0,pB1,pA0,pA1,t,true,true,true);     WAIT_BAR(2); RESC(); ROT();
    STEP(pA0,pA1,pB0,pB1,t+1,true,true,true);   WAIT_BAR(2); RESC(); ROT();
  }
  #undef CMASK
  #define CMASK(P0,P1,t) do{ const int t_=(t); if(t_<4){ const int l_=(int)lane_now(); cmask(P0,P1,t_,wid*QBLK+(l_&31),l_>>5); } else if(!((sel>>(((t_-4)>>2)&15))&1u)){ _Pragma("unroll") for(int r=0;r<16;++r){P0[r]=-INFINITY;P1[r]=-INFINITY;} } }while(0)
  #define ENDW(tt) do{ if((tt)+3<NT){WAIT_BAR(2);} else if((tt)+2<NT){WAIT_BAR(1);} else {WAIT_BAR(0);} }while(0)
  for(;t+1<NT;t+=2){
    STEP(pB0,pB1,pA0,pA1,t,(t+3<NT),(t+1<NT),(t+1<NT));       ENDW(t);   RESC(); ROT();
    STEP(pA0,pA1,pB0,pB1,t+1,(t+4<NT),(t+2<NT),(t+2<NT));     ENDW(t+1); RESC(); ROT();
  }
  STEP(pB0,pB1,pA0,pA1,NT-1,false,false,false); RESC();
  { float sacc=pB0[0]+pB0[1]; _Pragma("unroll") for(int r=2;r<16;++r)sacc+=pB0[r]; _Pragma("unroll") for(int r=0;r<16;++r)sacc+=pB1[r]; l_reg+=sacc;
    pw0=(u32x4){PKW(pB0,0),PKW(pB0,2),PKW(pB0,4),PKW(pB0,6)};pw1=(u32x4){PKW(pB0,8),PKW(pB0,10),PKW(pB0,12),PKW(pB0,14)};pw2=(u32x4){PKW(pB1,0),PKW(pB1,2),PKW(pB1,4),PKW(pB1,6)};pw3=(u32x4){PKW(pB1,8),PKW(pB1,10),PKW(pB1,12),PKW(pB1,14)};
    SBAR(); pv(o,vb0+sl_cur,PAF(0),PAF(1),PAF(2),PAF(3)); }
  #undef PKW
  #undef PAF
  #undef VFR
  #undef PIN
  #undef MX3
  #undef GAPA
  #undef GAPB
  #undef EX
  #undef VRD
  #undef KRD
  #undef STEP
  #undef ENDW
  {auto rr=__builtin_amdgcn_permlane32_swap(__float_as_uint(l_reg),__float_as_uint(l_reg),false,false);l_reg=__uint_as_float(rr[0])+__uint_as_float(rr[1]);}
  if(hi==0)wsf[32+r32]=l_reg;asm volatile("s_waitcnt lgkmcnt(0)":::"memory");
  float rli[16];
  #pragma unroll
  for(int r=0;r<16;++r)rli[r]=__builtin_amdgcn_rcpf(wsf[32+crow(r,hi)]);
  unsigned char*Ow=O+(rowbase+q0+wid*QBLK)*DM+h*D;
  { bf16*stg=(bf16*)(shm+LDS_OST)+wid*2048;
    #pragma unroll
    for(int r=0;r<16;++r){const int orow=crow(r,hi);
      #pragma unroll
      for(int d0=0;d0<2;++d0)stg[orow*64+d0*32+r32]=__float2bfloat16(o[d0][r]*rli[r]);}
    asm volatile("s_waitcnt lgkmcnt(0)":::"memory");
    #pragma unroll
    for(int i=0;i<4;++i){const int row=i*8+(lane>>3),ch=lane&7; const u32x4 v=*(const u32x4*)(stg+row*64+ch*8);
      #define BL_(w) (__uint_as_float((w)<<16)*4.f)
      #define BH_(w) (__uint_as_float((w)&0xffff0000u)*4.f)
      int w0=__builtin_amdgcn_cvt_pk_fp8_f32(BL_(v.x),BH_(v.x),0,false); w0=__builtin_amdgcn_cvt_pk_fp8_f32(BL_(v.y),BH_(v.y),w0,true);
      int w1=__builtin_amdgcn_cvt_pk_fp8_f32(BL_(v.z),BH_(v.z),0,false); w1=__builtin_amdgcn_cvt_pk_fp8_f32(BL_(v.w),BH_(v.w),w1,true);
      #undef BL_
      #undef BH_
      u32x2 w2; w2.x=(unsigned)w0; w2.y=(unsigned)w1; *(u32x2*)(Ow+(long)row*DM+ch*8)=w2;} }
  asm volatile("s_waitcnt lgkmcnt(0)\n\ts_barrier":::"memory");
  #undef DMA_K
  #undef PHYS
  #undef DMA_V
  #undef CMASK
  #undef START
  #undef SETQM
  #undef RESC
  #undef ROT
}
constexpr int ATTN_LDS_BYTES=LDS_BYTES;
struct AttnTensors { const bf16* Q; const bf16* K; const bf16* V; unsigned char* O; const float* ksum; };
struct AttnUnit { int bh; int qb; };
struct StaticOrder {
  int vcu, G;
  __device__ __forceinline__ explicit StaticOrder(int grid,int block):vcu((grid%8==0)?((block%8)*(grid/8)+block/8):block),G(grid){}
  __device__ __forceinline__ bool next(int i,AttnUnit&u)const{ const int L=i*G+vcu; if(L>=1024)return false; const int w=L&255, rnd=L>>8, s=w&3; u.bh=w>>2; u.qb=(rnd==0)?s:(rnd==1)?7-s:(rnd==2)?8+s:15-s; return true; }
  __device__ __forceinline__ void a_ready(const AttnUnit&)const{}
  __device__ __forceinline__ void done(const AttnUnit&)const{}
};
struct SnakeOrder {
  int v, G;
  __device__ __forceinline__ bool next(int i,AttnUnit&u)const{ const int idx=i*G+((i&1)?(G-1-v):v); if(idx>=1024)return false; u.qb=15-(idx>>6); u.bh=idx&63; return true; }
  __device__ __forceinline__ void a_ready(const AttnUnit&)const{}
  __device__ __forceinline__ void done(const AttnUnit&)const{}
};
template<class Sched,int THRL=8> __device__ __forceinline__ void attn_phase(char*lds,const AttnTensors&T,const Sched&S){
  AttnUnit u;
  for(int i=0;S.next(i,u);++i){ S.a_ready(u); attn_unit<THRL>(u.bh/NHEAD,u.bh%NHEAD,u.qb,T.Q,T.K,T.V,T.O,T.ksum,lds); S.done(u); }
}
#undef SBAR
#undef WAIT_BAR
}
constexpr int NWAVES = 8, NTHR = 512;
constexpr int NTOK = 16384, DM = 1024, SEQ = 4096, NBATCH = 4, NEXP = 32;
constexpr float ALPHA = 1.4142135623730951f;
constexpr float LN_EPS = 1e-5f;
constexpr float RSQRT_DQK = 0.08838834764831845f;
constexpr int NPHASE = 19;
constexpr float FP8_SA = 4.0f, FP8_SWGU = 64.0f, FP8_SWD = 128.0f;
constexpr float FP8_SY = 32.0f, FP8_MAXV = 448.0f;
constexpr float FP8_SWIN = 64.0f, SCI = 1.0f / (FP8_SA * FP8_SWIN);
constexpr size_t WS_X8 = (size_t)288 << 20, WS_O8 = (size_t)304 << 20;
#ifndef DBG_ATTN_MUL
#define DBG_ATTN_MUL 1.0f
#endif
#ifndef DBG_MLSTM_MUL
#define DBG_MLSTM_MUL 1.0f
#endif
#ifndef DBG_MOE_MUL
#define DBG_MOE_MUL 1.0f
#endif
#ifndef DBG_P14_A
#define DBG_P14_A WS_HN
#endif
#ifndef NCONV
#define NCONV 80
#endif
#ifndef MK_ONE_LAUNCH
#define MK_ONE_LAUNCH 1
#endif

constexpr size_t MiB = 1u << 20, KiB = 1024;
constexpr size_t WS_CTL = 0, CTL_ZERO_BYTES = 1 * MiB;
constexpr int CW_TMO = 0, CW_BAR = 4096, CW_CNT = 8192, CW_AQ = 16384;
constexpr size_t WS_KSUM = 256 * KiB, WS_DEN = 512 * KiB;
constexpr size_t WS_WQKV = 2 * MiB, WS_WO = 8 * MiB, WS_WINA = 10 * MiB, WS_WINB = 14 * MiB, WS_WOUT = 17 * MiB;
constexpr size_t WS_WG = 19 * MiB, WS_RWT = 20 * MiB, WS_ROPE = 21 * MiB;
constexpr size_t WS_TOKE = 22 * MiB, WS_TOKP = 22 * MiB + 256 * KiB, WS_TOKG = 22 * MiB + 512 * KiB;
constexpr size_t WS_GI = 23 * MiB, WS_LF = 23 * MiB + 256 * KiB, WS_RF = 23 * MiB + 512 * KiB, WS_CF = 23 * MiB + 768 * KiB;
constexpr size_t WS_DEC = 24 * MiB, WS_NU = 24 * MiB + 256 * KiB, WS_NPREV = 24 * MiB + 512 * KiB;
constexpr size_t WS_ROWTOK = 25 * MiB;
constexpr size_t WS_XB = 32 * MiB, WS_Q = 64 * MiB, WS_K = 96 * MiB, WS_V = 128 * MiB;
constexpr size_t WS_R0 = 160 * MiB, WS_R1 = 224 * MiB, WS_R2 = 288 * MiB;
constexpr size_t WS_H = 352 * MiB, WS_Y = 496 * MiB;
constexpr size_t WS_WGU = 640 * MiB, WS_WD = 896 * MiB, WS_END = 1024 * MiB;
constexpr size_t WS_AE = 352 * MiB, WS_BE = 416 * MiB, WS_KN = 464 * MiB, WS_KT = 496 * MiB, WS_UT = 512 * MiB, WS_OS = 544 * MiB, WS_HN = 576 * MiB;

constexpr int RING_OFF = 0, RING_BYTES = 131072;
constexpr int LX = RING_BYTES;
constexpr int LX_MISC = LX;
constexpr int LX_TILEE = LX + 128;
constexpr int LX_TBASE = LX + 1280;
constexpr int LX_LCNT = LX + 1536, LX_GBASE = LX + 1664;
constexpr int LX_REC = LX + 1792;
constexpr int LX_TOKL = LX + 4096;
constexpr int LX_LNX = LX + 4096;
constexpr int LX_BIAS = LX + 12288;
constexpr int LX_ROPE = LX + 16384;
constexpr int LDS_BYTES = 163840;
constexpr int TOKL_ROUNDS = 10;

#define RLX_AGENT __ATOMIC_RELAXED, __HIP_MEMORY_SCOPE_AGENT
#define LDS_WAIT() asm volatile("s_waitcnt lgkmcnt(0)" ::: "memory")
#define VM_WAIT() asm volatile("s_waitcnt vmcnt(0)" ::: "memory")
#define XB_TMO      128
#define XB_XCNT(j)  (256  + 64 * (j))
#define XB_XSUB(j)  (1280 + 64 * (j))
#define XB_XGEN(j)  (2304 + 64 * (j))
#define XB_TOP      3328
#define XB_TOPGEN   3392
#define XCD_BAR_WORDS 3456
#define XB_SPIN_CAP (1u << 18)

__device__ __forceinline__ unsigned xb_ld(unsigned* p)              { return __hip_atomic_load(p, __ATOMIC_RELAXED, __HIP_MEMORY_SCOPE_AGENT); }
__device__ __forceinline__ unsigned xb_add(unsigned* p, unsigned v) { return __hip_atomic_fetch_add(p, v, __ATOMIC_RELAXED, __HIP_MEMORY_SCOPE_AGENT); }
__device__ __forceinline__ unsigned xb_xcc_id() { return (unsigned)__builtin_amdgcn_s_getreg((3 << 11) | 20) & 0xFu; }
#define XB_SPIN(cond, bar) do { unsigned _sp = 0; while (cond) { __builtin_amdgcn_s_sleep(1); \
    if ((++_sp & 255u) == 0u) { if (xb_ld(&(bar)[XB_TMO])) break; if (_sp > XB_SPIN_CAP) { atomicAdd(&(bar)[XB_TMO], 1u); break; } } } } while (0)

struct XcdBarrier {
    unsigned* bar; unsigned x;
    volatile LAS unsigned* st;
};

__device__ __forceinline__ XcdBarrier xcd_barrier_post(unsigned* bar, volatile LAS unsigned* st) {
    XcdBarrier b; b.bar = bar; b.x = xb_xcc_id(); b.st = st;
    if (threadIdx.x == 0) (void)xb_add(&bar[XB_XCNT(b.x)], 1u);
    return b;
}
__device__ __forceinline__ void xcd_barrier_complete(unsigned* bar, unsigned x, unsigned& nloc, unsigned& nx) {
    const unsigned G = gridDim.x * gridDim.y * gridDim.z;
    unsigned sum, cnt, mine, sp = 0u;
    for (;;) {
        sum = 0u; cnt = 0u; mine = 0u;
#pragma unroll
        for (unsigned j = 0; j < 16; ++j) { const unsigned c = xb_ld(&bar[XB_XCNT(j)]); sum += c; cnt += (c > 0u) ? 1u : 0u; mine = (j == x) ? c : mine; }
        if (sum == G) break;
        __builtin_amdgcn_s_sleep(1);
        if ((++sp & 255u) == 0u) { if (xb_ld(&bar[XB_TMO])) break; if (sp > XB_SPIN_CAP) { atomicAdd(&bar[XB_TMO], 1u); break; } }
    }
    nloc = mine > 0u ? mine : 1u; nx = cnt > 0u ? cnt : 1u;
}

__device__ __forceinline__ void xcd_barrier(const XcdBarrier& b) {
    asm volatile("s_waitcnt vmcnt(0)" ::: "memory");
    __syncthreads();
    if (threadIdx.x == 0) {
        unsigned* bar = b.bar;
        __builtin_amdgcn_s_waitcnt(0);
        unsigned nloc = b.st[0], nx = b.st[1];
        if (nloc == 0u) { xcd_barrier_complete(bar, b.x, nloc, nx); b.st[0] = nloc; b.st[1] = nx; }
        const unsigned old = xb_add(&bar[XB_XSUB(b.x)], 1u);
        const unsigned gen = old / nloc;
        if (old + 1u == (gen + 1u) * nloc) {
            __builtin_amdgcn_fence(__ATOMIC_RELEASE, "agent");
            asm volatile("s_waitcnt vmcnt(0)" ::: "memory");
            asm volatile("buffer_inv sc1" ::: "memory");
            const unsigned og = xb_add(&bar[XB_TOP], 1u);
            const unsigned tg = og / nx;
            if (og + 1u == (tg + 1u) * nx) xb_add(&bar[XB_TOPGEN], 1u);
            else XB_SPIN(xb_ld(&bar[XB_TOPGEN]) == tg, bar);
            asm volatile("s_waitcnt vmcnt(0)" ::: "memory");
        } else {
            asm volatile("buffer_inv sc1" ::: "memory");
            XB_SPIN(xb_ld(&bar[XB_TOPGEN]) == gen, bar);
            asm volatile("" ::: "memory");
            asm volatile("s_waitcnt vmcnt(0)" ::: "memory");
        }
    }
    __syncthreads();
}
using pg8::Unit; using pg8::Gemm;
typedef f32x4 (&AccRef)[2][2][4][2];

#ifndef TAIL_FIRST
#define TAIL_FIRST 0
#endif
__device__ __forceinline__ bool moe_unit(int i, int G, int c, int nT, int nN, int& pm, int& pn, int& half) {
    const int U = nT * nN, R = U / G, rem = U - R * G; half = 0;
#if TAIL_FIRST
    if (rem > 0 && 2 * rem <= G) {
        if (c < 2 * rem) { if (i == 0) { half = 1 + (c & 1); return pg8::tile_order(0, U, R * G + (c >> 1), nT, nN, pm, pn); } --i; }
        if (i < R) return pg8::tile_order(i, G, c, nT, nN, pm, pn);
        return false; }
#endif
    if (i < R) return pg8::tile_order(i, G, c, nT, nN, pm, pn);
    if (i > R || rem == 0) return false;
    if (2 * rem <= G) { if (c >= 2 * rem) return false; half = 1 + (c & 1); return pg8::tile_order(0, U, R * G + (c >> 1), nT, nN, pm, pn); }
    return pg8::tile_order(i, G, c, nT, nN, pm, pn);
}
struct DenseSched {
    int nM, nN, G, c; const char* A; const char* B; size_t tstepA, tstepB; bool split = false;
    __device__ __forceinline__ bool next(int i, Unit& u) const {
        int half = 0;
        if (split) { if (!moe_unit(i, G, c, nM, nN, u.pm, u.pn, half)) return false; }
        else if (!pg8::tile_order(i, G, c, nM, nN, u.pm, u.pn)) return false;
        u.A = A + (size_t)u.pm * tstepA; u.B = B + (size_t)u.pn * tstepB; u.tl = nullptr; u.x0 = u.x1 = 0; u.x2 = half; return true; }
};
struct MoeSched {
    int nT, nN, G, c; const LAS int* tile_e; const LAS int* tbase; const LAS unsigned short* tokl;
    const char* A; const char* B; size_t tstepA, estepB, tstepB;
    __device__ __forceinline__ bool next(int i, Unit& u) const {
        int half; if (!moe_unit(i, G, c, nT, nN, u.pm, u.pn, half)) return false;
        const int e = tile_e[u.pm];
        u.x0 = e; u.x1 = u.pm * 256; u.x2 = half;
        u.A = A + (size_t)u.pm * tstepA; u.B = B + (size_t)e * estepB + (size_t)u.pn * tstepB;
        u.tl = tokl ? tokl + (i < TOKL_ROUNDS ? i : TOKL_ROUNDS - 1) * 256 : nullptr; return true; }
};
struct MuSched {
    int G, c, mode; const char* A; const char* B;
    __device__ __forceinline__ bool next(int i, Unit& u) const {
        const int mu = i * G + c; if (mu >= 256) return false;
        const int b = mu >> 6, hh = (mu >> 4) & 3, ch = mu & 15; const size_t tok0 = (size_t)b * SEQ + (size_t)ch * 256;
        u.pm = mu; u.pn = 0; u.x0 = mu; u.x1 = 0; u.x2 = (mode == 0) ? 1 : 0; u.tl = nullptr;
        if (mode == 0) { u.A = A + (size_t)mu * 256 * 384 * 2; u.B = B + ((size_t)(hh * 128) * NTOK + tok0) * 2; }
        else if (mode == 1) { u.A = A + ((size_t)mu * 256 * 512 + 256) * 2; u.B = B + (tok0 * 1024 + (size_t)hh * 256) * 2; }
        else { u.A = A + (size_t)mu * 256 * 512 * 2; u.B = B + (size_t)mu * 256 * 384 * 2; }
        return true; }
};

constexpr float C2 = 0.125f * 1.4426950408889634f;

struct EpiQKV {
    static constexpr bool PERM = true; static constexpr bool MID = true;
    __device__ __forceinline__ void prep(const Unit&, int, int, int) const {}
    __device__ __forceinline__ void prep_mid(const Unit& u, int wid, int lane) const { if ((u.pn >> 2) < 2) {
#pragma unroll
        for (int i = 0; i < 2; ++i) { const int row = (wid * 2 + i) * 16 + (lane >> 2), c = (lane & 3) ^ ((row >> 1) & 3);
            glds16s(uni_ptr((const char*)(rope + (size_t)u.pm * 256 * 16)), (unsigned)(row * 64 + c * 16), (unsigned)__builtin_amdgcn_readfirstlane((unsigned)(unsigned long long)ropel + (unsigned)((wid * 2 + i) * 1024))); } } }
    bf16_t* Q; bf16_t* K; bf16_t* V; const float* rope; float* ksum; LAS float* ropel;
    __device__ __forceinline__ void operator()(AccRef acc, const Unit& u, int wr, int wc, int fr, int fq) const {
        asm volatile("" : "+v"(fr), "+v"(fq));
        const int part = u.pn >> 2, colt = (u.pn & 3) * 256;
        bf16_t* base = Q + (size_t)part * ((WS_K - WS_Q) / 2);
        const bool rot = (part < 2) && ((wc & 1) == 0);
        float ks[2][8];
#pragma unroll
        for (int bj = 0; bj < 2; ++bj)
#pragma unroll
            for (int j = 0; j < 8; ++j) ks[bj][j] = 0.f;
#pragma unroll
        for (int ai = 0; ai < 2; ++ai)
#pragma unroll
            for (int m = 0; m < 4; ++m) {
                const int row = u.pm * 256 + ai * 128 + wr * 64 + m * 16 + fr;
                f32x4 cs = {1.f, 1.f, 1.f, 1.f}, sn = {0.f, 0.f, 0.f, 0.f};
                if (rot && fq < 2) { const int rl = ai * 128 + wr * 64 + m * 16 + fr, sw = (rl >> 1) & 3; const LAS f32x4* rp = (const LAS f32x4*)(ropel + rl * 16);
                    cs = rp[fq ^ sw]; sn = rp[(2 + fq) ^ sw]; }
#pragma unroll
                for (int bj = 0; bj < 2; ++bj) {
                    f32x4 v0 = acc[ai][bj][m][0], v1 = acc[ai][bj][m][1];
                    if (rot) { const f32x4 lo = v0 * cs - v1 * sn, hi = v1 * cs + v0 * sn; v0 = lo; v1 = hi; }
                    if (part == 0) { v0 = v0 * C2; v1 = v1 * C2; }
                    if (part == 1) {
#pragma unroll
                        for (int j = 0; j < 4; ++j) { ks[bj][j] += v0[j]; ks[bj][4 + j] += v1[j]; } }
                    u32x4 w; w.x = cvt_pk_bf16(v0[0], v0[1]); w.y = cvt_pk_bf16(v0[2], v0[3]); w.z = cvt_pk_bf16(v1[0], v1[1]); w.w = cvt_pk_bf16(v1[2], v1[3]);
                    *(u32x4*)(base + (size_t)row * DM + colt + bj * 128 + wc * 32 + fq * 8) = w;
                }
            }
        if (part == 1) {
#pragma unroll
            for (int bj = 0; bj < 2; ++bj)
#pragma unroll
                for (int j = 0; j < 8; ++j) { float s = ks[bj][j]; s += __shfl_xor(s, 1); s += __shfl_xor(s, 2); s += __shfl_xor(s, 4); s += __shfl_xor(s, 8);
                    if (fr == 0) atomicAdd(ksum + (size_t)u.pm * DM + colt + bj * 128 + wc * 32 + fq * 8 + j, s); }
        }
    }
};

struct EpiZ {
    static constexpr bool PERM = true; static constexpr bool MID = false;
    __device__ __forceinline__ void prep(const Unit&, int, int, int) const {}
    const bf16_t* xin; bf16_t* z; float ymul;
    __device__ __forceinline__ void operator()(AccRef acc, const Unit& u, int wr, int wc, int fr, int fq) const {
        asm volatile("" : "+v"(fr), "+v"(fq));
        const size_t off0 = (size_t)(u.pm * 256 + wr * 64 + fr) * DM + u.pn * 256 + wc * 32 + fq * 8;
        u32x4 xr[2][4][2];
#pragma unroll
        for (int ai = 0; ai < 2; ++ai)
#pragma unroll
            for (int m = 0; m < 4; ++m)
#pragma unroll
                for (int bj = 0; bj < 2; ++bj) xr[ai][m][bj] = *(const u32x4*)(xin + off0 + (size_t)(ai * 128 + m * 16) * DM + bj * 128);
        asm volatile("" ::: "memory");
#pragma unroll
        for (int ai = 0; ai < 2; ++ai)
#pragma unroll
            for (int m = 0; m < 4; ++m)
#pragma unroll
                for (int bj = 0; bj < 2; ++bj) { const u32x4 x = xr[ai][m][bj]; const f32x4 a0 = acc[ai][bj][m][0] * ymul, a1 = acc[ai][bj][m][1] * ymul;
                    u32x4 w; w.x = cvt_pk_bf16(bflo(x.x) * ALPHA + a0[0], bfhi(x.x) * ALPHA + a0[1]); w.y = cvt_pk_bf16(bflo(x.y) * ALPHA + a0[2], bfhi(x.y) * ALPHA + a0[3]);
                    w.z = cvt_pk_bf16(bflo(x.z) * ALPHA + a1[0], bfhi(x.z) * ALPHA + a1[1]); w.w = cvt_pk_bf16(bflo(x.w) * ALPHA + a1[2], bfhi(x.w) * ALPHA + a1[3]);
                    *(u32x4*)(z + off0 + (size_t)(ai * 128 + m * 16) * DM + bj * 128) = w; }
    }
};

__device__ __forceinline__ float swiglu1(float glu, float lin) {
    const float g = fminf(glu, 7.0f), l = fminf(fmaxf(lin, -7.0f), 7.0f);
    const float sg = __builtin_amdgcn_rcpf(1.0f + __builtin_amdgcn_exp2f(-1.702f * 1.4426950408889634f * g));
    return g * sg * (l + 1.0f);
}
__device__ __forceinline__ f32x2 swiglu2(float glu0, float lin0, float glu1, float lin1) {
    const f32x2 g = {fminf(glu0, 7.0f), fminf(glu1, 7.0f)}, l = {fminf(fmaxf(lin0, -7.0f), 7.0f), fminf(fmaxf(lin1, -7.0f), 7.0f)};
    const f32x2 t = g * (f32x2){-1.702f * 1.4426950408889634f, -1.702f * 1.4426950408889634f};
    const f32x2 d = (f32x2){__builtin_amdgcn_exp2f(t[0]), __builtin_amdgcn_exp2f(t[1])} + (f32x2){1.0f, 1.0f};
    const f32x2 r = {__builtin_amdgcn_rcpf(d[0]), __builtin_amdgcn_rcpf(d[1])};
    const f32x2 lp = l * (f32x2){FP8_SA, FP8_SA} + (f32x2){FP8_SA, FP8_SA};
    return (g * lp) * r;
}
struct EpiGU {
    static constexpr bool PERM = true; static constexpr bool MID = false;
    __device__ __forceinline__ void prep(const Unit& u, int ui, int wid, int lane) const { if (wid < 4) glds4s(uni_ptr((const char*)(bias + (size_t)u.x0 * 2048 + u.pn * 256 + wid * 64)), (unsigned)lane * 4u, (unsigned)__builtin_amdgcn_readfirstlane((unsigned)(unsigned long long)bl + (unsigned)(((ui & 1) * 256 + wid * 64) * 4))); }
    const float* bias; unsigned char* H; LAS float* bl; mutable int ucnt;
    __device__ __forceinline__ void operator()(AccRef acc, const Unit& u, int wr, int wc, int fr, int fq) const {
        asm volatile("" : "+v"(fr), "+v"(fq));
        const int c0 = u.pn * 256 + wc * 32 + fq * 8; const LAS float* bp = bl + (ucnt & 1) * 256 + wc * 32 + fq * 8; ++ucnt; constexpr float SC = 1.0f / (FP8_SA * FP8_SWGU);
        f32x4 b[2][2];
#pragma unroll
        for (int bj = 0; bj < 2; ++bj) { b[bj][0] = *(const LAS f32x4*)(bp + bj * 128); b[bj][1] = *(const LAS f32x4*)(bp + bj * 128 + 4); }
#pragma unroll
        for (int ai = 0; ai < 2; ++ai)
#pragma unroll
            for (int m = 0; m < 4; ++m) {
                unsigned char* rowp = H + (size_t)(u.x1 + ai * 128 + wr * 64 + m * 16 + fr) * DM + (c0 >> 1);
#pragma unroll
                for (int bj = 0; bj < 2; ++bj) { if (u.x2 == 2 - bj) continue;
                    const f32x4 v0 = acc[ai][bj][m][0] * SC + b[bj][0], v1 = acc[ai][bj][m][1] * SC + b[bj][1];
                    const f32x2 h0 = swiglu2(v0[0], v0[1], v0[2], v0[3]), h1 = swiglu2(v1[0], v1[1], v1[2], v1[3]);
                    int w = __builtin_amdgcn_cvt_pk_fp8_f32(h0[0], h0[1], 0, false);
                    w = __builtin_amdgcn_cvt_pk_fp8_f32(h1[0], h1[1], w, true);
                    *(int*)(rowp + bj * 64) = w; }
            }
    }
};
struct EpiDN {
    static constexpr bool PERM = true; static constexpr bool MID = false;
    __device__ __forceinline__ void prep(const Unit& u, int ui, int wid, int lane) const { if (wid < 4) glds4s(uni_ptr((const char*)(bias + (size_t)u.x0 * 1024 + u.pn * 256 + wid * 64)), (unsigned)lane * 4u, (unsigned)__builtin_amdgcn_readfirstlane((unsigned)(unsigned long long)bl + (unsigned)(((ui & 1) * 256 + wid * 64) * 4))); }
    const float* bias; unsigned char* Y; LAS float* bl; mutable int ucnt;
    __device__ __forceinline__ void operator()(AccRef acc, const Unit& u, int wr, int wc, int fr, int fq) const {
        asm volatile("" : "+v"(fr), "+v"(fq));
        const int c0 = u.pn * 256 + wc * 32 + fq * 8; const LAS float* bp = bl + (ucnt & 1) * 256 + wc * 32 + fq * 8; ++ucnt; constexpr float SC = FP8_SY / (FP8_SA * FP8_SWD);
        f32x4 b[2][2];
#pragma unroll
        for (int bj = 0; bj < 2; ++bj) { b[bj][0] = *(const LAS f32x4*)(bp + bj * 128) * FP8_SY; b[bj][1] = *(const LAS f32x4*)(bp + bj * 128 + 4) * FP8_SY; }
#pragma unroll
        for (int ai = 0; ai < 2; ++ai)
#pragma unroll
            for (int m = 0; m < 4; ++m) {
                unsigned char* rowp = Y + (size_t)(u.x1 + ai * 128 + wr * 64 + m * 16 + fr) * DM + c0;
#pragma unroll
                for (int bj = 0; bj < 2; ++bj) { if (u.x2 == 2 - bj) continue;
                    f32x4 v0 = acc[ai][bj][m][0] * SC + b[bj][0], v1 = acc[ai][bj][m][1] * SC + b[bj][1];
#pragma unroll
                    for (int q = 0; q < 4; ++q) { v0[q] = __builtin_amdgcn_fmed3f(v0[q], -FP8_MAXV, FP8_MAXV); v1[q] = __builtin_amdgcn_fmed3f(v1[q], -FP8_MAXV, FP8_MAXV); }
                    int w0 = __builtin_amdgcn_cvt_pk_fp8_f32(v0[0], v0[1], 0, false); w0 = __builtin_amdgcn_cvt_pk_fp8_f32(v0[2], v0[3], w0, true);
                    int w1 = __builtin_amdgcn_cvt_pk_fp8_f32(v1[0], v1[1], 0, false); w1 = __builtin_amdgcn_cvt_pk_fp8_f32(v1[2], v1[3], w1, true);
                    u32x2 w; w.x = (unsigned)w0; w.y = (unsigned)w1;
                    *(u32x2*)(rowp + bj * 128) = w; }
            }
    }
};

struct EpiINA {
    static constexpr bool PERM = true; static constexpr bool MID = false;
    __device__ __forceinline__ void prep(const Unit&, int, int, int) const {}
    const float* rf; const float* cf; bf16_t* AE; bf16_t* KN; bf16_t* OS;
    __device__ __forceinline__ void operator()(AccRef acc, const Unit& u, int wr, int wc, int fr, int fq) const {
        asm volatile("" : "+v"(fr), "+v"(fq));
        const int b = u.pm >> 4, ch = u.pm & 15, d0 = wc * 32 + fq * 8; const u32x4 zero = {0u, 0u, 0u, 0u};
        if (u.pn < 4) {
            const bool isq = u.pn < 2; const float* fac = isq ? rf : cf; const float fs = (isq ? 1.0f : RSQRT_DQK) * SCI; const int h0 = (u.pn & 1) * 2;
            float sf[2][4][2];
#pragma unroll
            for (int ai = 0; ai < 2; ++ai)
#pragma unroll
                for (int m = 0; m < 4; ++m)
#pragma unroll
                    for (int bj = 0; bj < 2; ++bj) sf[ai][m][bj] = fac[(size_t)(h0 + bj) * NTOK + (size_t)u.pm * 256 + ai * 128 + wr * 64 + m * 16 + fr];
#pragma unroll
            for (int ai = 0; ai < 2; ++ai)
#pragma unroll
                for (int m = 0; m < 4; ++m) {
                    const int t = ai * 128 + wr * 64 + m * 16 + fr; const size_t token = (size_t)u.pm * 256 + t;
#pragma unroll
                    for (int bj = 0; bj < 2; ++bj) { const int hh = h0 + bj; const float s = sf[ai][m][bj] * fs;
                        const f32x4 v0 = acc[ai][bj][m][0] * s, v1 = acc[ai][bj][m][1] * s;
                        const size_t oq = ((size_t)(((b * 4 + hh) * 16 + ch) * 256 + t)) * 512 + 256 + d0, ok = token * 1024 + hh * 256 + d0;
                        bf16_t* dst = isq ? (AE + oq) : (KN + ok);
                        u32x4 w; w.x = cvt_pk_bf16(v0[0], v0[1]); w.y = cvt_pk_bf16(v0[2], v0[3]); w.z = cvt_pk_bf16(v1[0], v1[1]); w.w = cvt_pk_bf16(v1[2], v1[3]);
                        *(u32x4*)dst = w; }
                }
        } else {
#pragma unroll
            for (int ai = 0; ai < 2; ++ai)
#pragma unroll
                for (int m = 0; m < 4; ++m) {
                    const int t = ai * 128 + wr * 64 + m * 16 + fr; const size_t token = (size_t)u.pm * 256 + t;
#pragma unroll
                    for (int bj = 0; bj < 2; ++bj) { f32x4 v0 = acc[ai][bj][m][0], v1 = acc[ai][bj][m][1];
#pragma unroll
                        for (int j = 0; j < 4; ++j) { v0[j] = __builtin_amdgcn_rcpf(1.0f + __builtin_amdgcn_exp2f((-1.4426950408889634f * SCI) * v0[j])); v1[j] = __builtin_amdgcn_rcpf(1.0f + __builtin_amdgcn_exp2f((-1.4426950408889634f * SCI) * v1[j])); }
                        u32x4 w; w.x = cvt_pk_bf16(v0[0], v0[1]); w.y = cvt_pk_bf16(v0[2], v0[3]); w.z = cvt_pk_bf16(v1[0], v1[1]); w.w = cvt_pk_bf16(v1[2], v1[3]);
                        *(u32x4*)(OS + token * 1024 + (u.pn - 4) * 256 + bj * 128 + d0) = w; }
                }
        }
    }
};
struct EpiINB {
    static constexpr bool PERM = true; static constexpr bool MID = false;
    __device__ __forceinline__ void prep(const Unit&, int, int, int) const {}
    const float* cf; bf16_t* KT; bf16_t* BE;
    __device__ __forceinline__ void operator()(AccRef acc, const Unit& u, int wr, int wc, int fr, int fq) const {
        asm volatile("" : "+v"(fr), "+v"(fq));
        const int b = u.pn >> 4, ch = u.pn & 15;
        f32x4 cv[2][2][2];
#pragma unroll
        for (int ai = 0; ai < 2; ++ai)
#pragma unroll
            for (int bj = 0; bj < 2; ++bj) { const size_t tok0 = (size_t)u.pn * 256 + bj * 128 + wc * 32 + fq * 8;
                if (u.pm < 2) { const int hh = u.pm * 2 + ai; cv[ai][bj][0] = *(const f32x4*)(cf + (size_t)hh * NTOK + tok0) * (RSQRT_DQK * SCI); cv[ai][bj][1] = *(const f32x4*)(cf + (size_t)hh * NTOK + tok0 + 4) * (RSQRT_DQK * SCI); }
                else { cv[ai][bj][0] = (f32x4){SCI, SCI, SCI, SCI}; cv[ai][bj][1] = cv[ai][bj][0]; } }
#pragma unroll
        for (int ai = 0; ai < 2; ++ai)
#pragma unroll
            for (int m = 0; m < 4; ++m) {
                const int R = u.pm * 256 + ai * 128 + wr * 64 + m * 16 + fr;
#pragma unroll
                for (int bj = 0; bj < 2; ++bj) { if (u.x2 == 2 - bj) continue;
                    const f32x4 v0 = acc[ai][bj][m][0] * cv[ai][bj][0], v1 = acc[ai][bj][m][1] * cv[ai][bj][1]; const int s0 = bj * 128 + wc * 32 + fq * 8; const size_t tok0 = (size_t)u.pn * 256 + s0; bf16_t* dst;
                    if (u.pm < 2) dst = KT + (size_t)R * NTOK + tok0;
                    else { const int eg = R - 512, hh = eg >> 8, e = eg & 255; dst = BE + ((size_t)(((b * 4 + hh) * 16 + ch) * 256 + e)) * 384 + s0; }
                    u32x4 w; w.x = cvt_pk_bf16(v0[0], v0[1]); w.y = cvt_pk_bf16(v0[2], v0[3]); w.z = cvt_pk_bf16(v1[0], v1[1]); w.w = cvt_pk_bf16(v1[2], v1[3]);
                    *(u32x4*)dst = w;
                }
            }
    }
};
struct EpiM1 {
    static constexpr bool PERM = true; static constexpr bool MID = false;
    __device__ __forceinline__ void prep(const Unit&, int, int, int) const {}
    bf16_t* UT;
    __device__ __forceinline__ void operator()(AccRef acc, const Unit& u, int wr, int wc, int fr, int fq) const {
        asm volatile("" : "+v"(fr), "+v"(fq));
#pragma unroll
        for (int ai = 0; ai < 2; ++ai)
#pragma unroll
            for (int m = 0; m < 4; ++m) { bf16_t* rowp = UT + ((size_t)u.x0 * 256 + ai * 128 + wr * 64 + m * 16 + fr) * 128 + wc * 32 + fq * 8;
                const f32x4 v0 = acc[ai][0][m][0], v1 = acc[ai][0][m][1];
                u32x4 w; w.x = cvt_pk_bf16(v0[0], v0[1]); w.y = cvt_pk_bf16(v0[2], v0[3]); w.z = cvt_pk_bf16(v1[0], v1[1]); w.w = cvt_pk_bf16(v1[2], v1[3]);
                *(u32x4*)rowp = w; }
    }
};
struct EpiM2A {
    static constexpr bool PERM = true; static constexpr bool MID = false;
    __device__ __forceinline__ void prep(const Unit&, int, int, int) const {}
    bf16_t* AE; const float* nprev; float* den;
    __device__ __forceinline__ void operator()(AccRef acc, const Unit& u, int wr, int wc, int fr, int fq) const {
        asm volatile("" : "+v"(fr), "+v"(fq));
        const int mu = u.x0, dd = wc * 32 + fq * 8;
        const f32x4 n0 = *(const f32x4*)(nprev + (size_t)mu * 128 + dd), n1 = *(const f32x4*)(nprev + (size_t)mu * 128 + dd + 4);
        u32x4 qv8[2][4];
#pragma unroll
        for (int ai = 0; ai < 2; ++ai)
#pragma unroll
            for (int m = 0; m < 4; ++m) qv8[ai][m] = *(const u32x4*)(AE + ((size_t)mu * 256 + ai * 128 + wr * 64 + m * 16 + fr) * 512 + 256 + dd);
#pragma unroll
        for (int ai = 0; ai < 2; ++ai)
#pragma unroll
            for (int m = 0; m < 4; ++m) {
                const int t = ai * 128 + wr * 64 + m * 16 + fr; bf16_t* rowp = AE + ((size_t)mu * 256 + t) * 512;
                const u32x4 qv = qv8[ai][m];
                float part = bflo(qv.x) * n0[0] + bfhi(qv.x) * n0[1] + bflo(qv.y) * n0[2] + bfhi(qv.y) * n0[3] + bflo(qv.z) * n1[0] + bfhi(qv.z) * n1[1] + bflo(qv.w) * n1[2] + bfhi(qv.w) * n1[3];
#pragma unroll
                for (int bj = 0; bj < 2; ++bj) { const int s0 = bj * 128 + wc * 32 + fq * 8; f32x4 v0 = acc[ai][bj][m][0], v1 = acc[ai][bj][m][1];
                    int dts = t - s0; asm volatile("" : "+v"(dts));
#pragma unroll
                    for (int j = 0; j < 4; ++j) { v0[j] = (j <= dts) ? v0[j] : 0.f; v1[j] = (4 + j <= dts) ? v1[j] : 0.f; part += v0[j] + v1[j]; }
                    u32x4 w; w.x = cvt_pk_bf16(v0[0], v0[1]); w.y = cvt_pk_bf16(v0[2], v0[3]); w.z = cvt_pk_bf16(v1[0], v1[1]); w.w = cvt_pk_bf16(v1[2], v1[3]);
                    *(u32x4*)(rowp + s0) = w; }
                part += __shfl_xor(part, 16); part += __shfl_xor(part, 32);
                if (fq == 0) atomicAdd(den + (size_t)mu * 256 + (wr * 64 + fr) + (ai * 128 + m * 16), part);
            }
    }
};
struct EpiM2B {
    static constexpr bool PERM = true; static constexpr bool MID = false;
    __device__ __forceinline__ void prep(const Unit&, int, int, int) const {}
    const float* den; const float* normg; const bf16_t* OS; unsigned char* HN; LAS float* lnx;
    __device__ __forceinline__ void operator()(AccRef acc, const Unit& u, int wr, int wc, int fr, int fq) const {
        asm volatile("" : "+v"(fr), "+v"(fq));
        const int mu = u.x0, b = mu >> 6, hh = (mu >> 4) & 3, ch = mu & 15;
        float dnv[2][4];
#pragma unroll
        for (int ai = 0; ai < 2; ++ai)
#pragma unroll
            for (int m = 0; m < 4; ++m) dnv[ai][m] = den[(size_t)mu * 256 + ai * 128 + wr * 64 + m * 16 + fr];
#pragma unroll
        for (int ai = 0; ai < 2; ++ai)
#pragma unroll
            for (int m = 0; m < 4; ++m) {
                const int t = ai * 128 + wr * 64 + m * 16 + fr; const float dn = dnv[ai][m];
#ifdef DBG_DEN1
                const float inv = 1.0f;
#else
                const float inv = 1.0f / fmaxf(fabsf(dn), 1.0f);
#endif
                float s1 = 0.f, s2 = 0.f;
#pragma unroll
                for (int bj = 0; bj < 2; ++bj)
#pragma unroll
                    for (int n = 0; n < 2; ++n) { f32x4 h = acc[ai][bj][m][n] * inv; acc[ai][bj][m][n] = h; s1 += (h[0] + h[1]) + (h[2] + h[3]); s2 += (h[0] * h[0] + h[1] * h[1]) + (h[2] * h[2] + h[3] * h[3]); }
                s1 += __shfl_xor(s1, 16); s1 += __shfl_xor(s1, 32); s2 += __shfl_xor(s2, 16); s2 += __shfl_xor(s2, 32);
                if (fq == 0) { lnx[(t * 4 + wc) * 2] = s1; lnx[(t * 4 + wc) * 2 + 1] = s2; }
            }
        const int e0 = wc * 32 + fq * 8;
        f32x4 gg[2][2];
#pragma unroll
        for (int bj = 0; bj < 2; ++bj) { gg[bj][0] = *(const f32x4*)(normg + hh * 256 + bj * 128 + e0); gg[bj][1] = *(const f32x4*)(normg + hh * 256 + bj * 128 + e0 + 4); }
        asm volatile("s_waitcnt lgkmcnt(0)" ::: "memory"); __builtin_amdgcn_s_barrier(); asm volatile("" ::: "memory");
#pragma unroll
        for (int ai = 0; ai < 2; ++ai) {
            u32x4 ovv[4][2];
#pragma unroll
            for (int m = 0; m < 4; ++m)
#pragma unroll
                for (int bj = 0; bj < 2; ++bj) ovv[m][bj] = *(const u32x4*)(OS + (((size_t)(b * 16 + ch)) * 256 + ai * 128 + wr * 64 + m * 16 + fr) * 1024 + hh * 256 + bj * 128 + e0);
#pragma unroll
            for (int m = 0; m < 4; ++m) {
                const int t = ai * 128 + wr * 64 + m * 16 + fr; const size_t token = ((size_t)(b * 16 + ch)) * 256 + t;
                const LAS f32x4* lp = (const LAS f32x4*)(lnx + t * 8); const f32x4 a = lp[0], c = lp[1];
                const float mean = (a[0] + a[2] + c[0] + c[2]) * (1.0f / 256.0f); const float ex2 = (a[1] + a[3] + c[1] + c[3]) * (1.0f / 256.0f);
                const float rstd = 1.0f / sqrtf(fmaxf(ex2 - mean * mean, 0.f) + LN_EPS);
#pragma unroll
                for (int bj = 0; bj < 2; ++bj) { const int e = bj * 128 + e0; const size_t off = token * 1024 + hh * 256 + e; const u32x4 ov = ovv[m][bj];
#ifdef DBG_HN_OS
                    f32x4 v0 = {1.f, 1.f, 1.f, 1.f}, v1 = v0;
#elif defined(DBG_HN_RAW)
                    f32x4 v0 = acc[ai][bj][m][0], v1 = acc[ai][bj][m][1];
#else
                    f32x4 v0 = (acc[ai][bj][m][0] - mean) * rstd * gg[bj][0], v1 = (acc[ai][bj][m][1] - mean) * rstd * gg[bj][1];
#endif
#ifndef DBG_HN_ONE
                    v0[0] *= bflo(ov.x); v0[1] *= bfhi(ov.x); v0[2] *= bflo(ov.y); v0[3] *= bfhi(ov.y); v1[0] *= bflo(ov.z); v1[1] *= bfhi(ov.z); v1[2] *= bflo(ov.w); v1[3] *= bfhi(ov.w);
#endif
                    int w0 = __builtin_amdgcn_cvt_pk_fp8_f32(v0[0] * FP8_SA, v0[1] * FP8_SA, 0, false); w0 = __builtin_amdgcn_cvt_pk_fp8_f32(v0[2] * FP8_SA, v0[3] * FP8_SA, w0, true);
                    int w1 = __builtin_amdgcn_cvt_pk_fp8_f32(v1[0] * FP8_SA, v1[1] * FP8_SA, 0, false); w1 = __builtin_amdgcn_cvt_pk_fp8_f32(v1[2] * FP8_SA, v1[3] * FP8_SA, w1, true);
                    u32x2 w; w.x = (unsigned)w0; w.y = (unsigned)w1; *(u32x2*)(HN + off) = w; }
            }
            asm volatile("" ::: "memory");
        }
        asm volatile("s_waitcnt lgkmcnt(0)" ::: "memory"); __builtin_amdgcn_s_barrier(); asm volatile("" ::: "memory");
    }
};
struct Frame {
    LAS unsigned char* lds;
    unsigned* ctl;
    unsigned char* ws;
    int tid, lane, wave, vcu, G;
};
__device__ __forceinline__ float wave_sum(float v) {
#pragma unroll
    for (int o = 1; o < 64; o <<= 1) v += __shfl_xor(v, o);
    return v;
}

__device__ __forceinline__ void tr_block(const float* src, size_t pitch, bf16_t* dst, size_t kd, int kb, int nb, LAS unsigned* scr, int lane, bool rotperm = false) {
    const float* s0 = src + (size_t)(64 * kb) * pitch + 64 * nb + 4 * (lane & 15);
#pragma unroll
    for (int i = 0; i < 8; ++i) {
        const int kp = 4 * i + (lane >> 4);
        const f32x4 a = __builtin_nontemporal_load((const f32x4*)(s0 + (size_t)(2 * kp) * pitch)), b = __builtin_nontemporal_load((const f32x4*)(s0 + (size_t)(2 * kp + 1) * pitch));
#pragma unroll
        for (int j = 0; j < 4; ++j) scr[(4 * (lane & 15) + j) * 33 + kp] = cvt_pk_bf16(a[j], b[j]);
    }
    LDS_WAIT(); asm volatile("" ::: "memory");
    u32x4 o[8];
#pragma unroll
    for (int c = 0; c < 8; ++c) { const int r0 = 8 * c + (lane >> 3), rr = (rotperm && c < 2) ? (8 * ((r0 >> 2) & 1) + 4 * (r0 >> 3) + (r0 & 3)) : r0, q4 = 4 * (lane & 7); o[c].x = scr[rr * 33 + q4]; o[c].y = scr[rr * 33 + q4 + 1]; o[c].z = scr[rr * 33 + q4 + 2]; o[c].w = scr[rr * 33 + q4 + 3]; }
    bf16_t* d = dst + (size_t)(64 * nb + (lane >> 3)) * kd + 64 * kb + 8 * (lane & 7);
#pragma unroll
    for (int c = 0; c < 8; ++c) *(u32x4*)(d + (size_t)(8 * c) * kd) = o[c];
    LDS_WAIT(); asm volatile("" ::: "memory");
}
__device__ __forceinline__ void tr_block8(const float* src, size_t pitch, unsigned char* dst, size_t kd, int kb, int nb, float scale, LAS unsigned* scr, int lane) {
    const float* s0 = src + (size_t)(128 * kb) * pitch + 64 * nb + 4 * (lane & 15);
#pragma unroll
    for (int i = 0; i < 8; ++i) {
        const int kq = 4 * i + (lane >> 4);
        const f32x4 r0 = __builtin_nontemporal_load((const f32x4*)(s0 + (size_t)(4 * kq) * pitch)) * scale, r1 = __builtin_nontemporal_load((const f32x4*)(s0 + (size_t)(4 * kq + 1) * pitch)) * scale,
                    r2 = __builtin_nontemporal_load((const f32x4*)(s0 + (size_t)(4 * kq + 2) * pitch)) * scale, r3 = __builtin_nontemporal_load((const f32x4*)(s0 + (size_t)(4 * kq + 3) * pitch)) * scale;
#pragma unroll
        for (int j = 0; j < 4; ++j) { int w = __builtin_amdgcn_cvt_pk_fp8_f32(r0[j], r1[j], 0, false); w = __builtin_amdgcn_cvt_pk_fp8_f32(r2[j], r3[j], w, true); scr[(4 * (lane & 15) + j) * 33 + kq] = (unsigned)w; }
    }
    LDS_WAIT(); asm volatile("" ::: "memory");
    u32x4 o[8];
#pragma unroll
    for (int c = 0; c < 8; ++c) { const int rr = 8 * c + (lane >> 3), q4 = 4 * (lane & 7); o[c].x = scr[rr * 33 + q4]; o[c].y = scr[rr * 33 + q4 + 1]; o[c].z = scr[rr * 33 + q4 + 2]; o[c].w = scr[rr * 33 + q4 + 3]; }
    unsigned char* d = dst + (size_t)(64 * nb + (lane >> 3)) * kd + 128 * kb + 16 * (lane & 7);
#pragma unroll
    for (int c = 0; c < 8; ++c) *(u32x4*)(d + (size_t)(8 * c) * kd) = o[c];
    LDS_WAIT(); asm volatile("" ::: "memory");
}
constexpr int CONV_ITEMS = 24576;
struct ConvItem { const float* s0; size_t pitch; unsigned char* d; float scale; };
__device__ __forceinline__ ConvItem conv_desc(const float* wgu, const float* wd, unsigned char* ws, int v, int lane) {
    const int layer = v >= 12288; int r = v - layer * 12288; ConvItem it;
    if (r < 8192) { const int mat = layer * 32 + (r >> 8); r &= 255; const int kb = r >> 5, nb = r & 31; it.pitch = 2048; it.scale = FP8_SWGU;
        it.s0 = wgu + (size_t)mat * 1024 * 2048 + (size_t)(128 * kb) * 2048 + 64 * nb + 4 * (lane & 15); it.d = ws + WS_WGU + (size_t)mat * 2048 * 1024 + (size_t)(64 * nb + (lane >> 3)) * 1024 + 128 * kb + 16 * (lane & 7); }
    else { r -= 8192; const int mat = layer * 32 + (r >> 7); r &= 127; const int kb = r >> 4, nb = r & 15; it.pitch = 1024; it.scale = FP8_SWD;
        it.s0 = wd + (size_t)mat * 1024 * 1024 + (size_t)(128 * kb) * 1024 + 64 * nb + 4 * (lane & 15); it.d = ws + WS_WD + (size_t)mat * 1024 * 1024 + (size_t)(64 * nb + (lane >> 3)) * 1024 + 128 * kb + 16 * (lane & 7); }
    return it;
}
__device__ __forceinline__ void conv_items(Frame& F, const float* wgu, const float* wd, int v_lo, int v_hi, int cw, int ncw) {
    LAS unsigned* scr = (LAS unsigned*)(F.lds + RING_OFF + F.wave * 8448); unsigned char* ws = F.ws; const int lane = F.lane;
    int v = v_lo + cw; if (v >= v_hi) return;
    ConvItem cur = conv_desc(wgu, wd, ws, v, lane);
    f32x4 r[8][4];
#pragma unroll
    for (int i = 0; i < 8; ++i) { const int kq = 4 * i + (lane >> 4);
#pragma unroll
        for (int q = 0; q < 4; ++q) r[i][q] = __builtin_nontemporal_load((const f32x4*)(cur.s0 + (size_t)(4 * kq + q) * cur.pitch)); }
    for (;;) {
        const int vn = v + ncw; const bool has = vn < v_hi; ConvItem nx = cur; if (has) nx = conv_desc(wgu, wd, ws, vn, lane);
#pragma unroll
        for (int i = 0; i < 8; ++i) { const int kq = 4 * i + (lane >> 4);
#pragma unroll
            for (int j = 0; j < 4; ++j) { int w = __builtin_amdgcn_cvt_pk_fp8_f32(r[i][0][j] * cur.scale, r[i][1][j] * cur.scale, 0, false); w = __builtin_amdgcn_cvt_pk_fp8_f32(r[i][2][j] * cur.scale, r[i][3][j] * cur.scale, w, true); scr[(4 * (lane & 15) + j) * 33 + kq] = (unsigned)w; }
            if (has) {
#pragma unroll
                for (int q = 0; q < 4; ++q) r[i][q] = __builtin_nontemporal_load((const f32x4*)(nx.s0 + (size_t)(4 * kq + q) * nx.pitch)); } }
        LDS_WAIT(); asm volatile("" ::: "memory");
        u32x4 o[8];
#pragma unroll
        for (int c = 0; c < 8; ++c) { const int rr = 8 * c + (lane >> 3), q4 = 4 * (lane & 7); o[c].x = scr[rr * 33 + q4]; o[c].y = scr[rr * 33 + q4 + 1]; o[c].z = scr[rr * 33 + q4 + 2]; o[c].w = scr[rr * 33 + q4 + 3]; }
#pragma unroll
        for (int c = 0; c < 8; ++c) __builtin_nontemporal_store(o[c], (u32x4*)(cur.d + (size_t)(8 * c) * 1024));
        LDS_WAIT(); asm volatile("" ::: "memory");
        if (!has) break;
        v = vn; cur = nx;
    }
}
struct P0In { const float *x, *wqkv, *wo, *win, *wout, *rw, *wgu, *wd; const int* pos; };
__device__ __forceinline__ void p0_prologue(Frame& F, const P0In& I) {
    LAS unsigned* scr = (LAS unsigned*)(F.lds + RING_OFF + F.wave * 8448);
    const int gw = F.vcu * NWAVES + F.wave, NGW = F.G * NWAVES;
    unsigned char* ws = F.ws;
    constexpr int KB = 16;
    constexpr int I_QKV = KB * 48, I_WO = 8 * 16, I_INA1 = 8 * 16, I_INA2 = 8 * 16, I_INB = 8 * 24, I_WOUT = 8 * 16;
    constexpr int I_SMALL = I_QKV + I_WO + I_INA1 + I_INA2 + I_INB + I_WOUT;
    constexpr int NITEMS = I_SMALL;
    for (int it = gw; it < NITEMS; it += NGW) {
        int r = it; const float* src; size_t pitch; bf16_t* dst; int nbl; const bool isqkv = it < I_QKV; bool f8 = false; float sc8 = FP8_SWIN;
        if (r < I_QKV) { src = I.wqkv; pitch = 3072; dst = (bf16_t*)(ws + WS_WQKV); nbl = 48; }
        else if ((r -= I_QKV) < I_WO) { src = I.wo; pitch = 1024; dst = (bf16_t*)(ws + WS_WO); nbl = 16; f8 = true; sc8 = FP8_SWD; }
        else if ((r -= I_WO) < I_INA1) { src = I.win; pitch = 3080; dst = (bf16_t*)(ws + WS_WINA); nbl = 16; f8 = true; }
        else if ((r -= I_INA1) < I_INA2) { src = I.win + 2048; pitch = 3080; dst = (bf16_t*)(ws + WS_WINA + (size_t)1024 * 1024); nbl = 16; f8 = true; }
        else if ((r -= I_INA2) < I_INB) { src = I.win + 512; pitch = 3080; dst = (bf16_t*)(ws + WS_WINB); nbl = 24; f8 = true; }
        else { r -= I_INB; src = I.wout; pitch = 1024; dst = (bf16_t*)(ws + WS_WOUT); nbl = 16; f8 = true; sc8 = FP8_SWD; }
        if (f8) tr_block8(src, pitch, (unsigned char*)dst, 1024, r / nbl, r % nbl, sc8, scr, F.lane);
        else tr_block(src, pitch, dst, 1024, r / nbl, r % nbl, scr, F.lane, isqkv && (r % nbl) < 32);
    }
    if (NCONV == 0) conv_items(F, I.wgu, I.wd, 0, CONV_ITEMS, gw, NGW);
    const int gt = F.vcu * NTHR + F.tid, NGT = F.G * NTHR;
    for (int i = gt; i < NTOK * DM / 8; i += NGT) { const f32x4 a = ((const f32x4*)I.x)[2 * i], b = ((const f32x4*)I.x)[2 * i + 1];
        u32x4 w; w.x = cvt_pk_bf16(a[0], a[1]); w.y = cvt_pk_bf16(a[2], a[3]); w.z = cvt_pk_bf16(b[0], b[1]); w.w = cvt_pk_bf16(b[2], b[3]); ((u32x4*)(ws + WS_XB))[i] = w; }
    for (int i = gt; i < NTOK * 8; i += NGT) { const int tok = i >> 3, f = i & 7; const float inv = powf(500000.0f, -(float)f * 0.125f); const float ang = (float)I.pos[tok] * inv;
        float sn, cs; sincosf(ang, &sn, &cs); float* rp = (float*)(ws + WS_ROPE) + (size_t)tok * 16; rp[f] = cs; rp[8 + f] = sn; }
    for (int i = gt; i < 2 * 32 * 1024; i += NGT) { const int l = i >> 15, e = (i >> 10) & 31, k = i & 1023; ((float*)(ws + WS_RWT))[i] = I.rw[((size_t)l * 1024 + k) * 32 + e]; }
    for (int i = gt; i < 8 * 1024; i += NGT) { const int gidx = i >> 10, k = i & 1023; ((float*)(ws + WS_WG))[i] = I.win[(size_t)k * 3080 + 3072 + gidx]; }
}

__device__ __forceinline__ void phase_ln_router(Frame& F, const bf16_t* __restrict__ z, bf16_t* __restrict__ x1, const float* lng, const float* lnb, const float* rbias, int layer, int cset) {
    unsigned char* ws = F.ws;
    LAS f32x4* rwv = (LAS f32x4*)(F.lds + RING_OFF);
    LAS int* lcnt = (LAS int*)(F.lds + LX_LCNT); LAS int* gbase = (LAS int*)(F.lds + LX_GBASE); LAS int* rec = (LAS int*)(F.lds + LX_REC);
    LAS float* lgb = (LAS float*)(F.lds + LX_LNX);
    { const f32x4* src = (const f32x4*)((const float*)(ws + WS_RWT) + (size_t)layer * 32768);
      for (int i = F.tid; i < 8192; i += NTHR) { const int e = i >> 8, c = i & 255; rwv[e * 256 + (c ^ (e & 15))] = src[i]; } }
    int* toke = (int*)(ws + WS_TOKE); int* tokp = (int*)(ws + WS_TOKP); float* tokg = (float*)(ws + WS_TOKG);
    unsigned short* rowtok = (unsigned short*)(ws + WS_ROWTOK); unsigned char* xb8 = (unsigned char*)(ws + WS_XB);
    unsigned* cntg = F.ctl + CW_CNT + cset * 2048;
    const int lane = F.lane;
    for (int grp = F.vcu; grp < NTOK / 64; grp += F.G) {
        if (F.tid < 32) lcnt[F.tid] = 0;
        for (int i = F.tid; i < 1024; i += NTHR) { lgb[i] = lng[i]; lgb[1024 + i] = lnb[i]; }
        __syncthreads();
#pragma unroll 2
        for (int tk = 0; tk < 8; tk += 2) {
            const int token0 = grp * 64 + F.wave * 8 + tk;
            f32x4 v[2][4]; float s[2] = {0.f, 0.f};
#pragma unroll
            for (int u = 0; u < 2; ++u)
#pragma unroll
                for (int j = 0; j < 4; ++j) { const u32x2 zz = *(const u32x2*)(z + (size_t)(token0 + u) * DM + 4 * lane + 256 * j); v[u][j] = (f32x4){bflo(zz.x), bfhi(zz.x), bflo(zz.y), bfhi(zz.y)}; s[u] += (v[u][j][0] + v[u][j][1]) + (v[u][j][2] + v[u][j][3]); }
#pragma unroll
            for (int o = 1; o < 64; o <<= 1) { const float a0 = __shfl_xor(s[0], o), a1 = __shfl_xor(s[1], o); s[0] += a0; s[1] += a1; }
            float s2[2] = {0.f, 0.f};
#pragma unroll
            for (int u = 0; u < 2; ++u) { const float mean = s[u] * (1.0f / DM);
#pragma unroll
                for (int j = 0; j < 4; ++j) { v[u][j] = v[u][j] - mean; s2[u] += (v[u][j][0] * v[u][j][0] + v[u][j][1] * v[u][j][1]) + (v[u][j][2] * v[u][j][2] + v[u][j][3] * v[u][j][3]); } }
#pragma unroll
            for (int o = 1; o < 64; o <<= 1) { const float a0 = __shfl_xor(s2[0], o), a1 = __shfl_xor(s2[1], o); s2[0] += a0; s2[1] += a1; }
#pragma unroll
            for (int u = 0; u < 2; ++u) { const float rstd = 1.0f / sqrtf(s2[u] * (1.0f / DM) + LN_EPS); const int token = token0 + u;
#pragma unroll
                for (int j = 0; j < 4; ++j) { const f32x4 gvj = *(const LAS f32x4*)(lgb + 4 * lane + 256 * j), bvj = *(const LAS f32x4*)(lgb + 1024 + 4 * lane + 256 * j);
                    const f32x4 y = v[u][j] * rstd * gvj + bvj; { u32x2 wb; wb.x = cvt_pk_bf16(y[0], y[1]); wb.y = cvt_pk_bf16(y[2], y[3]); *(u32x2*)(x1 + (size_t)token * DM + 4 * lane + 256 * j) = wb; }
                    int w8 = __builtin_amdgcn_cvt_pk_fp8_f32(y[0] * FP8_SA, y[1] * FP8_SA, 0, false); w8 = __builtin_amdgcn_cvt_pk_fp8_f32(y[2] * FP8_SA, y[3] * FP8_SA, w8, true);
                    *(int*)(xb8 + (size_t)token * DM + 4 * lane + 256 * j) = w8; } }
        }
        VM_WAIT(); __syncthreads();
        const int tg = F.wave & 3, kh = F.wave >> 2, e0 = lane & 15, kq = lane >> 4;
        f32x4 acc0 = {0.f, 0.f, 0.f, 0.f}, acc1 = acc0;
        { const bf16_t* arow = x1 + (size_t)(grp * 64 + tg * 16 + e0) * DM + kh * 512 + 4 * kq;
#pragma unroll 4
          for (int blk = 0; blk < 32; ++blk) {
              const u32x2 ab = *(const u32x2*)(arow + blk * 16); const f32x4 a4 = {bflo(ab.x), bfhi(ab.x), bflo(ab.y), bfhi(ab.y)}; const int c = ((kh * 512 + blk * 16) >> 2) + kq;
              const f32x4 b0 = rwv[e0 * 256 + (c ^ e0)], b1 = rwv[(16 + e0) * 256 + (c ^ e0)];
#pragma unroll
              for (int j = 0; j < 4; ++j) { acc0 = __builtin_amdgcn_mfma_f32_16x16x4f32(a4[j], b0[j], acc0, 0, 0, 0); acc1 = __builtin_amdgcn_mfma_f32_16x16x4f32(a4[j], b1[j], acc1, 0, 0, 0); } } }
        __syncthreads();
        if (kh == 1) { ((LAS f32x4*)lgb)[(tg * 2 + 0) * 64 + lane] = acc0; ((LAS f32x4*)lgb)[(tg * 2 + 1) * 64 + lane] = acc1; }
        __syncthreads();
        if (kh == 0) {
            acc0 = acc0 + ((LAS f32x4*)lgb)[(tg * 2 + 0) * 64 + lane]; acc1 = acc1 + ((LAS f32x4*)lgb)[(tg * 2 + 1) * 64 + lane];
            const float rb0 = rbias[e0], rb1 = rbias[16 + e0];
#pragma unroll
            for (int r = 0; r < 4; ++r) {
                float l0 = acc0[r] + rb0, l1 = acc1[r] + rb1; float tv[4]; int te[4];
#pragma unroll
                for (int k = 0; k < 4; ++k) { float bvv = (l1 > l0) ? l1 : l0; int be = (l1 > l0) ? 16 + e0 : e0;
#pragma unroll
                    for (int o = 1; o < 16; o <<= 1) { const float ov = __shfl_xor(bvv, o); const int oe = __shfl_xor(be, o); const bool take = (ov > bvv) || (ov == bvv && oe < be); bvv = take ? ov : bvv; be = take ? oe : be; }
                    tv[k] = bvv; te[k] = be; if (be == e0) l0 = -INFINITY; if (be == 16 + e0) l1 = -INFINITY; }
                const float w0 = 1.0f, w1 = __expf(tv[1] - tv[0]), w2 = __expf(tv[2] - tv[0]), w3 = __expf(tv[3] - tv[0]); const float wi = 1.0f / (w0 + w1 + w2 + w3);
                if (e0 < 4) {
                    const int tl = tg * 16 + 4 * kq + r, token = grp * 64 + tl;
                    const int ek = (e0 == 0) ? te[0] : (e0 == 1) ? te[1] : (e0 == 2) ? te[2] : te[3];
                    const float wk = (e0 == 0) ? w0 : (e0 == 1) ? w1 : (e0 == 2) ? w2 : w3;
                    const int li = atomicAdd((int*)(lcnt + ek), 1); rec[tl * 8 + e0] = ek; rec[tl * 8 + 4 + e0] = li;
                    toke[token * 4 + e0] = ek; tokg[token * 4 + e0] = wk * wi;
                }
            }
        }
        __syncthreads();
        if (F.tid < 32) gbase[F.tid] = (int)__hip_atomic_fetch_add(cntg + F.tid * 64, (unsigned)lcnt[F.tid], RLX_AGENT);
        __syncthreads();
        if (F.tid < 256) { const int tl = F.tid >> 2, k = F.tid & 3; const int token = grp * 64 + tl; const int e = rec[tl * 8 + k]; const int pos = gbase[e] + rec[tl * 8 + 4 + k];
            tokp[token * 4 + k] = pos; rowtok[(size_t)e * NTOK + pos] = (unsigned short)token; }
        __syncthreads();
    }
}

__device__ __forceinline__ int moe_tables(Frame& F, int layer) {
    LAS int* tile_e = (LAS int*)(F.lds + LX_TILEE); LAS int* tbase = (LAS int*)(F.lds + LX_TBASE);
    if (F.tid < 64) {
        const int e = F.lane & 31; const int c = (int)__hip_atomic_load(F.ctl + CW_CNT + layer * 2048 + e * 64, RLX_AGENT); const int nt = (F.lane < 32) ? ((c + 255) >> 8) : 0;
        int inc = nt;
#pragma unroll
        for (int o = 1; o < 32; o <<= 1) { const int up = __shfl_up(inc, o); if (F.lane >= o) inc += up; }
        const int t0 = inc - nt;
        if (F.lane < 32) { tbase[e] = t0; for (int i = 0; i < nt; ++i) tile_e[t0 + i] = e; }
        if (F.lane == 31) tbase[32] = inc;
    }
    __syncthreads();
    return tbase[32];
}

template <bool NEXT_MLSTM>
__device__ __forceinline__ void phase_combine(Frame& F, const bf16_t* __restrict__ x1, float* __restrict__ out, const float* lng, const float* lnb, const float* bgates, int layer) {
    unsigned char* ws = F.ws;
    (void)moe_tables(F, layer);
    const LAS int* tbase = (const LAS int*)(F.lds + LX_TBASE);
    const int* toke = (const int*)(ws + WS_TOKE); const int* tokp = (const int*)(ws + WS_TOKP); const float* tokg = (const float*)(ws + WS_TOKG);
    const unsigned char* Y = (const unsigned char*)(ws + WS_Y); bf16_t* xb = (bf16_t*)(ws + WS_XB);
    LAS float* wg = (LAS float*)(F.lds + RING_OFF);
    LAS float* lgb = wg + 8192;
    if constexpr (NEXT_MLSTM) { const f32x4* src = (const f32x4*)(ws + WS_WG); for (int i = F.tid; i < 2048; i += NTHR) ((LAS f32x4*)wg)[i] = src[i];
        for (int i = F.tid; i < 1024; i += NTHR) { lgb[i] = lng[i]; lgb[1024 + i] = lnb[i]; } __syncthreads(); }
    const int lane = F.lane; const int gw = F.vcu * NWAVES + F.wave, NGW = F.G * NWAVES;
    f32x4 gv[4], bv[4];
    if constexpr (!NEXT_MLSTM) {
#pragma unroll
        for (int j = 0; j < 4; ++j) { gv[j] = *(const f32x4*)(lng + 4 * lane + 256 * j); bv[j] = *(const f32x4*)(lnb + 4 * lane + 256 * j); } }
    constexpr int NTK = 2;
    int rowv = 0; float gatev = 0.f;
    { const int mt = gw + (lane >> 2) * NGW; if (mt < NTOK) { const int ee = toke[mt * 4 + (lane & 3)]; rowv = tbase[ee] * 256 + tokp[mt * 4 + (lane & 3)]; gatev = tokg[mt * 4 + (lane & 3)] * (DBG_MOE_MUL / FP8_SY); } }
    int it = 0;
    for (int token0 = gw; token0 < NTOK; token0 += NTK * NGW, ++it) {
        f32x4 vv[NTK][4];
#pragma unroll
        for (int u = 0; u < NTK; ++u) { const int token = token0 + u * NGW; if (token < NTOK) {
#pragma unroll
            for (int j = 0; j < 4; ++j) { const u32x2 xx = *(const u32x2*)(x1 + (size_t)token * DM + 4 * lane + 256 * j); vv[u][j] = (f32x4){bflo(xx.x), bfhi(xx.x), bflo(xx.y), bfhi(xx.y)} * ALPHA; }
#pragma unroll
            for (int k = 0; k < 4; ++k) { const int sl = (it * NTK + u) * 4 + k; const size_t row = (size_t)__builtin_amdgcn_readlane(rowv, sl); const float gt = __int_as_float(__builtin_amdgcn_readlane(__float_as_int(gatev), sl));
#pragma unroll
                for (int j = 0; j < 4; ++j) { const int y = *(const int*)(Y + row * DM + 4 * lane + 256 * j); const f32x2 lo = __builtin_amdgcn_cvt_pk_f32_fp8(y, false), hi = __builtin_amdgcn_cvt_pk_f32_fp8(y, true);
                    vv[u][j][0] += gt * lo[0]; vv[u][j][1] += gt * lo[1]; vv[u][j][2] += gt * hi[0]; vv[u][j][3] += gt * hi[1]; } } } }
#pragma unroll
        for (int u = 0; u < NTK; ++u) { const int token = token0 + u * NGW; if (token < NTOK) {
        f32x4 v[4];
#pragma unroll
        for (int j = 0; j < 4; ++j) v[j] = vv[u][j];
        float s = 0.f;
#pragma unroll
        for (int j = 0; j < 4; ++j) s += (v[j][0] + v[j][1]) + (v[j][2] + v[j][3]);
        const float mean = wave_sum(s) * (1.0f / DM); float s2 = 0.f;
#pragma unroll
        for (int j = 0; j < 4; ++j) { v[j] = v[j] - mean; s2 += (v[j][0] * v[j][0] + v[j][1] * v[j][1]) + (v[j][2] * v[j][2] + v[j][3] * v[j][3]); }
        const float rstd = 1.0f / sqrtf(wave_sum(s2) * (1.0f / DM) + LN_EPS);
#pragma unroll
        for (int j = 0; j < 4; ++j) { if constexpr (NEXT_MLSTM) { gv[j] = *(const LAS f32x4*)(lgb + 4 * lane + 256 * j); bv[j] = *(const LAS f32x4*)(lgb + 1024 + 4 * lane + 256 * j); }
            v[j] = v[j] * rstd * gv[j] + bv[j]; if constexpr (!NEXT_MLSTM) *(f32x4*)(out + (size_t)token * DM + 4 * lane + 256 * j) = v[j]; }
        if constexpr (NEXT_MLSTM) {
#pragma unroll
            for (int j = 0; j < 4; ++j) { u32x2 w; w.x = cvt_pk_bf16(v[j][0], v[j][1]); w.y = cvt_pk_bf16(v[j][2], v[j][3]); *(u32x2*)(xb + (size_t)token * DM + 4 * lane + 256 * j) = w;
                int w8 = __builtin_amdgcn_cvt_pk_fp8_f32(v[j][0] * FP8_SA, v[j][1] * FP8_SA, 0, false); w8 = __builtin_amdgcn_cvt_pk_fp8_f32(v[j][2] * FP8_SA, v[j][3] * FP8_SA, w8, true);
                *(int*)(ws + WS_X8 + (size_t)token * DM + 4 * lane + 256 * j) = w8; }
            float gp[8];
#pragma unroll
            for (int gi = 0; gi < 8; ++gi) { float a = 0.f;
#pragma unroll
                for (int j = 0; j < 4; ++j) { const f32x4 w = *(const LAS f32x4*)(wg + gi * 1024 + 4 * lane + 256 * j); a += (v[j][0] * w[0] + v[j][1] * w[1]) + (v[j][2] * w[2] + v[j][3] * w[3]); }
                gp[gi] = a; if (gi & 1) asm volatile("" ::: "memory"); }
#pragma unroll
            for (int o = 1; o < 64; o <<= 1) {
#pragma unroll
                for (int gi = 0; gi < 8; ++gi) gp[gi] += __shfl_xor(gp[gi], o); }
#pragma unroll
            for (int gi = 0; gi < 8; ++gi) gp[gi] += bgates[gi];
            if (lane == 0) {
#pragma unroll
                for (int hh = 0; hh < 4; ++hh) { ((float*)(ws + WS_GI))[(size_t)hh * NTOK + token] = gp[hh];
                    const float f = gp[4 + hh]; const float lf = (f >= 0.f) ? -log1pf(__expf(-f)) : (f - log1pf(__expf(f)));
                    ((float*)(ws + WS_LF))[(size_t)hh * NTOK + token] = lf; } }
        }
        } }
    }
}

__device__ __forceinline__ void phase_gate_scan(Frame& F) {
    unsigned char* ws = F.ws; const int lane = F.lane; const int gw = F.vcu * NWAVES + F.wave, NGW = F.G * NWAVES;
    for (int mu = gw; mu < 256; mu += NGW) {
        const int b = mu >> 6, hh = (mu >> 4) & 3, ch = mu & 15; const size_t base = (size_t)hh * NTOK + (size_t)b * SEQ + ch * 256 + 4 * lane;
        const f32x4 lf = *(const f32x4*)((const float*)(ws + WS_LF) + base), gi = *(const f32x4*)((const float*)(ws + WS_GI) + base);
        f32x4 c; c[0] = lf[0]; c[1] = c[0] + lf[1]; c[2] = c[1] + lf[2]; c[3] = c[2] + lf[3];
        float tot = c[3];
#pragma unroll
        for (int o = 1; o < 64; o <<= 1) { const float up = __shfl_up(tot, o); if (lane >= o) tot += up; }
        const float excl = tot - c[3];
        f32x4 rf, cf;
#pragma unroll
        for (int j = 0; j < 4; ++j) { const float bt = excl + c[j]; rf[j] = __expf(bt); cf[j] = __expf(gi[j] - bt); }
        *(f32x4*)((float*)(ws + WS_RF) + base) = rf; *(f32x4*)((float*)(ws + WS_CF) + base) = cf;
        if (lane == 63) ((float*)(ws + WS_DEC))[mu] = __expf(tot);
    }
}
__device__ __forceinline__ void phase_nu(Frame& F) {
    unsigned char* ws = F.ws; const int lane = F.lane; const int gw = F.vcu * NWAVES + F.wave, NGW = F.G * NWAVES;
    const bf16_t* KT = (const bf16_t*)(ws + WS_KT); float* NU = (float*)(ws + WS_NU);
    for (int r0 = gw * 16; r0 < 256 * 128; r0 += NGW * 16) {
        const int mu = r0 >> 7, d0 = r0 & 127, b = mu >> 6, hh = (mu >> 4) & 3, ch = mu & 15;
        const bf16_t* base = KT + (size_t)(hh * 128 + d0) * NTOK + (size_t)b * SEQ + ch * 256 + 4 * lane;
        u32x2 kv[16];
#pragma unroll
        for (int i = 0; i < 16; ++i) kv[i] = *(const u32x2*)(base + (size_t)i * NTOK);
        float s[16];
#pragma unroll
        for (int i = 0; i < 16; ++i) s[i] = (bflo(kv[i].x) + bfhi(kv[i].x)) + (bflo(kv[i].y) + bfhi(kv[i].y));
#pragma unroll
        for (int o = 1; o < 64; o <<= 1) {
#pragma unroll
            for (int i = 0; i < 16; ++i) s[i] += __shfl_xor(s[i], o); }
        float mine = s[0];
#pragma unroll
        for (int i = 1; i < 16; ++i) mine = (lane == i) ? s[i] : mine;
        if (lane < 16) NU[r0 + lane] = mine;
    }
}
__device__ __forceinline__ void phase_state_scan(Frame& F) {
    unsigned char* ws = F.ws; const int gt = F.vcu * NTHR + F.tid, NGT = F.G * NTHR;
    const bf16_t* UT = (const bf16_t*)(ws + WS_UT); const float* DEC = (const float*)(ws + WS_DEC); bf16_t* BE = (bf16_t*)(ws + WS_BE);
    for (int i = gt; i < 16 * 256 * 32; i += NGT) { const int bh = i >> 13, e = (i >> 5) & 255, dg = i & 31;
        f32x4 U[16]; float dc[16];
#pragma unroll
        for (int ch = 0; ch < 16; ++ch) { const size_t mu = (size_t)bh * 16 + ch; { const u32x2 uu = *(const u32x2*)(UT + (mu * 256 + e) * 128 + 4 * dg); U[ch] = (f32x4){bflo(uu.x), bfhi(uu.x), bflo(uu.y), bfhi(uu.y)}; } dc[ch] = DEC[mu]; }
        f32x4 C = {0.f, 0.f, 0.f, 0.f};
#pragma unroll
        for (int ch = 0; ch < 16; ++ch) { const size_t mu = (size_t)bh * 16 + ch;
            u32x2 w; w.x = cvt_pk_bf16(C[0], C[1]); w.y = cvt_pk_bf16(C[2], C[3]);
#ifdef DBG_NO_INTER
            w.x = 0u; w.y = 0u;
#endif
            *(u32x2*)(BE + (mu * 256 + e) * 384 + 256 + 4 * dg) = w;
            C = (C + U[ch]) * dc[ch]; } }
    const float* NU = (const float*)(ws + WS_NU); float* NP = (float*)(ws + WS_NPREV);
    for (int i = gt; i < 16 * 128; i += NGT) { const int bh = i >> 7, d = i & 127; float n = 0.f;
        for (int ch = 0; ch < 16; ++ch) { const int mu = bh * 16 + ch; NP[mu * 128 + d] = n; n = (n + NU[mu * 128 + d]) * DEC[mu];
#ifdef DBG_NO_INTER
            n = 0.f;
#endif
        } }
}
struct Args { const float* in[18]; float* out; unsigned char* ws; int ph_lo, ph_hi; };
__global__ void __launch_bounds__(NTHR, 2) mk_fwd(Args args) {
    extern __shared__ __attribute__((aligned(16))) unsigned char lds[];
    Frame F;
    const char __attribute__((address_space(4)))* kargp = (const char __attribute__((address_space(4)))*)__builtin_amdgcn_kernarg_segment_ptr();
#define AIN(i) ({ const char __attribute__((address_space(4)))* k_ = kargp; asm volatile("" : "+s"(k_)); *(const float* const __attribute__((address_space(4)))*)(k_ + 8 * (i)); })
    unsigned char* const ws0 = (unsigned char*)AIN(19);
    F.lds = (LAS unsigned char*)lds; F.ws = ws0; F.ctl = (unsigned*)(ws0 + WS_CTL);
    F.tid = threadIdx.x; F.lane = F.tid & 63; F.wave = __builtin_amdgcn_readfirstlane(F.tid >> 6);
    F.G = gridDim.x; { const int bx = blockIdx.x; F.vcu = (F.G % 8 == 0) ? (bx % 8) * (F.G / 8) + bx / 8 : bx; }
    for (int u = F.tid; u < (LDS_BYTES - LX) / 4; u += NTHR) ((LAS unsigned*)(F.lds + LX))[u] = 0u;
    __syncthreads();
    int lo, hi; { const char __attribute__((address_space(4)))* k_ = kargp; lo = *(const int __attribute__((address_space(4)))*)(k_ + 160); hi = *(const int __attribute__((address_space(4)))*)(k_ + 164); }
    XcdBarrier bar; bar.bar = (unsigned*)(F.ctl + CW_BAR); bar.x = 0; bar.st = nullptr;
    if (hi - lo > 1) bar = xcd_barrier_post((unsigned*)(F.ctl + CW_BAR), (volatile LAS unsigned*)(F.lds + LX_MISC) + 8);
#ifndef PHASE_MASK
#define PHASE_MASK 0x7FFFF
#endif
#define IN(k) ((((PHASE_MASK) >> (k)) & 1) && lo <= (k) && (k) < hi)
#ifndef REPEAT_MASK
#define REPEAT_MASK 0
#endif
#define PH(k) if (IN(k))
#define SEAM(k) do { if (IN(k) && IN((k) + 1)) xcd_barrier(bar); } while (0)
    unsigned char* ws = ws0;
#define x_in AIN(0)
#define ln_mix_g AIN(8)
#define ln_mix_b AIN(9)
#define ln_ffn_g AIN(10)
#define ln_ffn_b AIN(11)
#define router_b AIN(13)
#define b_gu AIN(15)
#define b_dn AIN(17)
    bf16_t* XB = (bf16_t*)(ws + WS_XB); bf16_t* QB_ = (bf16_t*)(ws + WS_Q); bf16_t* KB_ = (bf16_t*)(ws + WS_K); bf16_t* VB_ = (bf16_t*)(ws + WS_V);
    bf16_t* R0 = (bf16_t*)(ws + WS_R0); bf16_t* R1 = (bf16_t*)(ws + WS_R1);
    bf16_t* HB = (bf16_t*)(ws + WS_H); bf16_t* YB = (bf16_t*)(ws + WS_Y);
    LAS unsigned char* ring = F.lds + RING_OFF;
    const int cG = (int)blockIdx.x;
    const bool isConv = (NCONV > 0) && ((int)blockIdx.x >= F.G - NCONV);
    const int Gc = F.G - NCONV, cwv = ((int)blockIdx.x - Gc) * NWAVES + F.wave, ncw = NCONV * NWAVES;
#define CONV_SLICE(a, b) conv_items(F, AIN(14), AIN(16), (int)((long)CONV_ITEMS * (a) / 1000), (int)((long)CONV_ITEMS * (b) / 1000), cwv, ncw)

    PH(0) { P0In I{x_in, AIN(2), AIN(3), AIN(4), AIN(7), AIN(12), AIN(14), AIN(16), (const int*)AIN(1)}; p0_prologue(F, I); }
    SEAM(0);
    PH(1) { { Gemm g{1024, 1024, 1024, nullptr}; DenseSched S{64, 12, F.G, cG, (const char*)XB, (const char*)(ws + WS_WQKV), (size_t)256 * 1024 * 2, (size_t)256 * 1024 * 2};
        EpiQKV E{QB_, KB_, VB_, (const float*)(ws + WS_ROPE), (float*)(ws + WS_KSUM), (LAS float*)(F.lds + LX_ROPE)};
        pg8::gemm_phase<EpiQKV, DenseSched, true, false>(ring, g, S, E); } }
    SEAM(1);
    PH(2) { if (isConv) CONV_SLICE(0, 1000); else {
        const attn_body::AttnTensors AT{(const attn_body::bf16*)QB_, (const attn_body::bf16*)KB_, (const attn_body::bf16*)VB_, (unsigned char*)(ws + WS_O8), (const float*)(ws + WS_KSUM)};
        if (NCONV == 0) { const attn_body::StaticOrder S((int)F.G, (int)blockIdx.x); attn_body::attn_phase<attn_body::StaticOrder>((char*)lds + RING_OFF, AT, S); }
        else { const attn_body::SnakeOrder S{cG, Gc}; attn_body::attn_phase<attn_body::SnakeOrder>((char*)lds + RING_OFF, AT, S); } } }
    SEAM(2);
    PH(3) { { Gemm g{512, 512, 512, nullptr}; DenseSched S{64, 4, F.G, cG, (const char*)(ws + WS_O8), (const char*)(ws + WS_WO), (size_t)256 * 1024, (size_t)256 * 1024};
        EpiZ E{XB, R0, DBG_ATTN_MUL / (FP8_SA * FP8_SWD)}; pg8::gemm_phase<EpiZ, DenseSched, true, false, true>(ring, g, S, E); } }
    SEAM(3);
    PH(4) phase_ln_router(F, R0, R1, ln_mix_g, ln_mix_b, router_b, 0, 0);
    SEAM(4);
    PH(5) { const int nT = moe_tables(F, 0); LAS unsigned short* tokl = (LAS unsigned short*)(F.lds + LX_TOKL);
        { const unsigned short* rowtok = (const unsigned short*)(ws + WS_ROWTOK); const LAS int* tile_e = (const LAS int*)(F.lds + LX_TILEE); const LAS int* tbase = (const LAS int*)(F.lds + LX_TBASE);
          for (int i = 0; i < TOKL_ROUNDS; ++i) { int pm, pn, hf; if (!moe_unit(i, F.G, cG, nT, 8, pm, pn, hf)) break;
              if (F.tid < 256) { const int e = tile_e[pm]; const int r = (pm - tbase[e]) * 256 + F.tid; const int c = (int)__hip_atomic_load(F.ctl + CW_CNT + 0 * 2048 + e * 64, RLX_AGENT);
                  tokl[i * 256 + F.tid] = (r < c) ? rowtok[(size_t)e * NTOK + r] : (unsigned short)0; } }
          __syncthreads(); }
        Gemm g{512, 512, 512, (const char*)XB};
        MoeSched S{nT, 8, F.G, cG, (const LAS int*)(F.lds + LX_TILEE), (const LAS int*)(F.lds + LX_TBASE), tokl, nullptr, (const char*)(ws + WS_WGU) + (size_t)0 * 32 * 2048 * 1024, 0, (size_t)2048 * 1024, (size_t)256 * 1024};
        EpiGU E{b_gu + (size_t)0 * 32 * 2048, (unsigned char*)HB, (LAS float*)(F.lds + LX_BIAS), 0}; pg8::gemm_phase<EpiGU, MoeSched, true, true, true, true>(ring, g, S, E); }
    SEAM(5);
    PH(6) { const int nT = moe_tables(F, 0); Gemm g{512, 512, 512, nullptr};
        MoeSched S{nT, 4, F.G, cG, (const LAS int*)(F.lds + LX_TILEE), (const LAS int*)(F.lds + LX_TBASE), nullptr, (const char*)HB, (const char*)(ws + WS_WD) + (size_t)0 * 32 * 1024 * 1024, (size_t)256 * 1024, (size_t)1024 * 1024, (size_t)256 * 1024};
        EpiDN E{b_dn + (size_t)0 * 32 * 1024, (unsigned char*)YB, (LAS float*)(F.lds + LX_BIAS), 0}; pg8::gemm_phase<EpiDN, MoeSched, true, false, true, true>(ring, g, S, E); }
    SEAM(6);
    PH(7) phase_combine<true>(F, R1, nullptr, ln_ffn_g, ln_ffn_b, AIN(5), 0);
    { F.lane = (int)attn_body::lane_now(); F.tid = F.wave * 64 + F.lane; }
    SEAM(7);
    PH(8) phase_gate_scan(F);
    SEAM(8);
    PH(9) {
        { Gemm g{512, 512, 512, nullptr}; DenseSched S{64, 8, F.G, cG, (const char*)(ws + WS_X8), (const char*)(ws + WS_WINA), (size_t)256 * 1024, (size_t)256 * 1024};
          EpiINA E{(const float*)(ws + WS_RF), (const float*)(ws + WS_CF), (bf16_t*)(ws + WS_AE), (bf16_t*)(ws + WS_KN), (bf16_t*)(ws + WS_OS)};
          pg8::gemm_phase<EpiINA, DenseSched, true, false, true>(ring, g, S, E); }
        { Gemm g{512, 512, 512, nullptr}; DenseSched S{6, 64, F.G, cG, (const char*)(ws + WS_WINB), (const char*)(ws + WS_X8), (size_t)256 * 1024, (size_t)256 * 1024, true};
          EpiINB E{(const float*)(ws + WS_CF), (bf16_t*)(ws + WS_KT), (bf16_t*)(ws + WS_BE)};
          pg8::gemm_phase<EpiINB, DenseSched, true, false, true, true>(ring, g, S, E); }
    }
    SEAM(9);
    PH(10) { Gemm g{256, 384, NTOK, nullptr}; MuSched S{F.G, cG, 0, (const char*)(ws + WS_BE), (const char*)(ws + WS_KT)};
        EpiM1 E{(bf16_t*)(ws + WS_UT)}; pg8::gemm_phase<EpiM1, MuSched, true, false, false, true>(ring, g, S, E);
        phase_nu(F); }
    SEAM(10);
    PH(11) phase_state_scan(F);
    SEAM(11);
    PH(12) { Gemm g{128, 512, 1024, nullptr}; MuSched S{F.G, cG, 1, (const char*)(ws + WS_AE), (const char*)(ws + WS_KN)};
        EpiM2A E{(bf16_t*)(ws + WS_AE), (const float*)(ws + WS_NPREV), (float*)(ws + WS_DEN)}; pg8::gemm_phase<EpiM2A, MuSched, true, false>(ring, g, S, E); }
    SEAM(12);
    PH(13) { Gemm g{384, 512, 384, nullptr}; MuSched S{F.G, cG, 2, (const char*)(ws + WS_AE), (const char*)(ws + WS_BE)};
        EpiM2B E{(const float*)(ws + WS_DEN), AIN(6), (const bf16_t*)(ws + WS_OS), (unsigned char*)(ws + WS_HN), (LAS float*)(F.lds + LX_LNX)};
        pg8::gemm_phase<EpiM2B, MuSched, true, false>(ring, g, S, E); }
    SEAM(13);
    PH(14) { Gemm g{512, 512, 512, nullptr}; DenseSched S{64, 4, F.G, cG, (const char*)(ws + DBG_P14_A), (const char*)(ws + WS_WOUT), (size_t)256 * 1024, (size_t)256 * 1024};
        EpiZ E{XB, R0, DBG_MLSTM_MUL / (FP8_SA * FP8_SWD)}; pg8::gemm_phase<EpiZ, DenseSched, true, false, true>(ring, g, S, E); }
    SEAM(14);
    PH(15) phase_ln_router(F, R0, R1, ln_mix_g + 1024, ln_mix_b + 1024, router_b + 32, 1, 1);
    SEAM(15);
    PH(16) { const int nT = moe_tables(F, 1); LAS unsigned short* tokl = (LAS unsigned short*)(F.lds + LX_TOKL);
        { const unsigned short* rowtok = (const unsigned short*)(ws + WS_ROWTOK); const LAS int* tile_e = (const LAS int*)(F.lds + LX_TILEE); const LAS int* tbase = (const LAS int*)(F.lds + LX_TBASE);
          for (int i = 0; i < TOKL_ROUNDS; ++i) { int pm, pn, hf; if (!moe_unit(i, F.G, cG, nT, 8, pm, pn, hf)) break;
              if (F.tid < 256) { const int e = tile_e[pm]; const int r = (pm - tbase[e]) * 256 + F.tid; const int c = (int)__hip_atomic_load(F.ctl + CW_CNT + 1 * 2048 + e * 64, RLX_AGENT);
                  tokl[i * 256 + F.tid] = (r < c) ? rowtok[(size_t)e * NTOK + r] : (unsigned short)0; } }
          __syncthreads(); }
        Gemm g{512, 512, 512, (const char*)XB};
        MoeSched S{nT, 8, F.G, cG, (const LAS int*)(F.lds + LX_TILEE), (const LAS int*)(F.lds + LX_TBASE), tokl, nullptr, (const char*)(ws + WS_WGU) + (size_t)1 * 32 * 2048 * 1024, 0, (size_t)2048 * 1024, (size_t)256 * 1024};
        EpiGU E{b_gu + (size_t)1 * 32 * 2048, (unsigned char*)HB, (LAS float*)(F.lds + LX_BIAS), 0}; pg8::gemm_phase<EpiGU, MoeSched, true, true, true, true>(ring, g, S, E); }
    SEAM(16);
    PH(17) { const int nT = moe_tables(F, 1); Gemm g{512, 512, 512, nullptr};
        MoeSched S{nT, 4, F.G, cG, (const LAS int*)(F.lds + LX_TILEE), (const LAS int*)(F.lds + LX_TBASE), nullptr, (const char*)HB, (const char*)(ws + WS_WD) + (size_t)1 * 32 * 1024 * 1024, (size_t)256 * 1024, (size_t)1024 * 1024, (size_t)256 * 1024};
        EpiDN E{b_dn + (size_t)1 * 32 * 1024, (unsigned char*)YB, (LAS float*)(F.lds + LX_BIAS), 0}; pg8::gemm_phase<EpiDN, MoeSched, true, false, true, true>(ring, g, S, E); }
    SEAM(17);
    PH(18) phase_combine<false>(F, R1, (float*)AIN(18), ln_ffn_g + 1024, ln_ffn_b + 1024, nullptr, 1);
#undef IN
#undef CONV_SLICE
#undef AIN
#undef x_in
#undef ln_mix_g
#undef ln_mix_b
#undef ln_ffn_g
#undef ln_ffn_b
#undef router_b
#undef b_gu
#undef b_dn
#undef SEAM
}

extern "C" void kernel_launch(void* const* d_in, const int* in_sizes, int n_in, void* d_out, int out_size, void* d_ws, size_t ws_size, hipStream_t stream) {
    static int grid = 0;
    if (grid == 0) {
        if (n_in != 18 || out_size != NTOK * DM || ws_size < WS_END) { fprintf(stderr, "kernel_launch: unexpected problem shape (n_in %d, out %d, ws %zu)\n", n_in, out_size, ws_size); grid = -1; return; }
        int dev = 0, cus = 0, per_cu = 0;
        if (hipGetDevice(&dev) != hipSuccess || hipDeviceGetAttribute(&cus, hipDeviceAttributeMultiprocessorCount, dev) != hipSuccess) { grid = -1; return; }
        if (hipFuncSetAttribute((const void*)mk_fwd, hipFuncAttributeMaxDynamicSharedMemorySize, LDS_BYTES) != hipSuccess) { fprintf(stderr, "kernel_launch: hipFuncSetAttribute failed\n"); grid = -1; return; }
        if (hipOccupancyMaxActiveBlocksPerMultiprocessor(&per_cu, (const void*)mk_fwd, NTHR, LDS_BYTES) != hipSuccess || per_cu < 1) fprintf(stderr, "kernel_launch: occupancy query reports %d\n", per_cu);
        (void)hipGetLastError();
        grid = cus;
        if (grid > 256) grid = 256;
        if (grid < 240) { fprintf(stderr, "kernel_launch: %d CUs: this build needs 240..256\n", cus); grid = -1; return; }
    }
    if (grid < 0) return;
    if (hipMemsetAsync((char*)d_ws + WS_CTL, 0, CTL_ZERO_BYTES, stream) != hipSuccess) return;
    Args a{};
    for (int i = 0; i < 18; ++i) a.in[i] = (const float*)d_in[i];
    a.out = (float*)d_out; a.ws = (unsigned char*)d_ws;
#if MK_ONE_LAUNCH
    a.ph_lo = 0; a.ph_hi = NPHASE;
    hipLaunchKernelGGL(mk_fwd, dim3(grid), dim3(NTHR), LDS_BYTES, stream, a);
#else
    for (int p = 0; p < NPHASE; ++p) { a.ph_lo = p; a.ph_hi = p + 1; hipLaunchKernelGGL(mk_fwd, dim3(grid), dim3(NTHR), LDS_BYTES, stream, a); }
#endif
}
```

```cpp
#include <hip/hip_runtime.h>
#include <hip/hip_bf16.h>
#include <cstdio>
#include <cstdint>
#include <cmath>

#define LAS __attribute__((address_space(3)))
#define GAS __attribute__((address_space(1)))
typedef unsigned short bf16_t;
typedef short bf16x8 __attribute__((ext_vector_type(8)));
typedef float f32x4 __attribute__((ext_vector_type(4)));
typedef float f32x2 __attribute__((ext_vector_type(2)));
typedef unsigned u32x4 __attribute__((ext_vector_type(4)));
typedef unsigned u32x2 __attribute__((ext_vector_type(2)));
typedef int i32x4 __attribute__((ext_vector_type(4)));
typedef int i32x8 __attribute__((ext_vector_type(8)));

typedef __bf16 bf16x2_t __attribute__((ext_vector_type(2)));
__device__ __forceinline__ unsigned cvt_pk_bf16(float lo, float hi) { const f32x2 v = {lo, hi}; const bf16x2_t b = __builtin_convertvector(v, bf16x2_t); return __builtin_bit_cast(unsigned, b); }
__device__ __forceinline__ float bf2f(unsigned short b) { return __uint_as_float(((unsigned)b) << 16); }
__device__ __forceinline__ float bflo(unsigned w) { return __uint_as_float(w << 16); }
__device__ __forceinline__ float bfhi(unsigned w) { return __uint_as_float(w & 0xffff0000u); }

__device__ __forceinline__ void glds16s(const void* sbase, unsigned voff, unsigned lds_dst) { unsigned keep;
    asm volatile("s_nop 4\n\ts_mov_b32 %0, m0\n\ts_mov_b32 m0, %3\n\ts_nop 0\n\tglobal_load_lds_dwordx4 %1, %2\n\ts_mov_b32 m0, %0" : "=&s"(keep) : "v"(voff), "s"(sbase), "s"(lds_dst) : "memory"); }
__device__ __forceinline__ void glds4s(const void* sbase, unsigned voff, unsigned lds_dst) { unsigned keep;
    asm volatile("s_nop 4\n\ts_mov_b32 %0, m0\n\ts_mov_b32 m0, %3\n\ts_nop 0\n\tglobal_load_lds_dword %1, %2\n\ts_mov_b32 m0, %0" : "=&s"(keep) : "v"(voff), "s"(sbase), "s"(lds_dst) : "memory"); }
__device__ __forceinline__ const char* uni_ptr(const char* p) { const unsigned long long v = (unsigned long long)p; const unsigned lo = __builtin_amdgcn_readfirstlane((unsigned)v), hi = __builtin_amdgcn_readfirstlane((unsigned)(v >> 32)); return (const char*)(((unsigned long long)hi << 32) | lo); }
namespace pg8 {
constexpr int BM = 256, BK = 64, HALF = 128, HTB = HALF * BK * 2, STAGE_BYTES = 8 * HTB, NXCD = 8, WGM = 8;
__host__ __device__ __forceinline__ int lds_byte(int r, int c) { const int st = (r >> 4) * 2 + (c >> 5), rr = r & 15, cc = c & 31, ob = rr * 64 + cc * 2; return st * 1024 + (ob ^ (((ob >> 9) & 1) << 5)); }
__host__ __device__ __forceinline__ void stage_rc(int b, int& R, int& C) { const int st = b / 1024, sb = b % 1024, swz = sb ^ (((sb >> 9) & 1) << 5); R = (st >> 1) * 16 + swz / 64; C = (st & 1) * 32 + (swz % 64) / 2; }
__host__ __device__ __forceinline__ int perm32(int rho) { const int n = rho >> 4, i = rho & 15; return 8 * (i >> 2) + 4 * n + (i & 3); }

struct Unit { int pm, pn; const char* A; const char* B; const LAS unsigned short* tl; int x0, x1, x2; };
struct Gemm { int K, lda, ldb; const char* Abase; };

__device__ __forceinline__ bool tile_order(int i, int G, int c, int nM, int nN, int& pm, int& pn) {
    const int nwg = nM * nN; const long L = (long)i * G + c; if (L >= nwg) return false;
    int wgid = (int)L; { const int q = nwg / NXCD, r = nwg % NXCD, xcd = wgid % NXCD, off = wgid / NXCD; wgid = (xcd < r ? xcd * (q + 1) : r * (q + 1) + (xcd - r) * q) + off; }
    const int nig = WGM * nN, gid = wgid / nig, fm = gid * WGM, gsz = (nM - fm) < WGM ? (nM - fm) : WGM;
    pm = fm + ((wgid % nig) % gsz); pn = (wgid % nig) / gsz; return true;
}

template <class Epi, class Sched, bool ALIGN_EPI, bool GATHER, bool FP8 = false, bool HALFSEL = false>
__device__ __forceinline__ void gemm_phase(LAS unsigned char* lds, const Gemm g, const Sched& S, const Epi& E) {
    const int tid = threadIdx.x, wid = __builtin_amdgcn_readfirstlane(tid >> 6), lane = tid & 63, wr = wid >> 2, wc = wid & 3, fr = lane & 15, fq = lane >> 4;
    const int K = g.K, nt = K / BK;
    int RA[2]; unsigned cA2[2], voffB[2];
#pragma unroll
    for (int i = 0; i < 2; ++i) { int R, C; stage_rc(tid * 16 + i * 8192, R, C); const int Rb = Epi::PERM ? ((R & ~31) + perm32(R & 31)) : R;
        RA[i] = R; cA2[i] = (unsigned)C * 2u; voffB[i] = (unsigned)(Rb * g.ldb + C) * 2u; }
    const size_t kstep = (size_t)(BK * 2);
    const unsigned hstepA = (unsigned)HALF * (unsigned)g.lda * 2u; const size_t hstepB = (size_t)HALF * g.ldb * 2;
    const unsigned ldsb = (unsigned)__builtin_amdgcn_readfirstlane((unsigned)(unsigned long long)lds + (unsigned)wid * 1024u);
    const int aoff = lds_byte(wr * 64 + fr, fq * 8), boff = lds_byte(wc * 32 + fr, fq * 8);
    const int aoff2 = aoff + 1024, boff2 = boff + 1024;
#define PG8_SA(b, h) (((b) * 2 + (h)) * HTB)
#define PG8_SB(b, h) ((4 + (b) * 2 + (h)) * HTB)
#define PG8_STAGE(bufoff, gbase, voff) do { _Pragma("unroll") for (int _i = 0; _i < 2; ++_i) glds16s((gbase), (voff)[_i], ldsb + (unsigned)(bufoff) + _i * 8192u); } while (0)
#define PG8_STAGE_A(bufoff, gbase, AO, h) do { _Pragma("unroll") for (int _i = 0; _i < 2; ++_i) glds16s((gbase), (AO)[h][_i], ldsb + (unsigned)(bufoff) + _i * 8192u); } while (0)
#define PG8_LD8(base_, o1_, o2_) __builtin_shufflevector(*(const LAS i32x4*)(lds + (base_) + (o1_)), *(const LAS i32x4*)(lds + (base_) + (o2_)), 0, 1, 2, 3, 4, 5, 6, 7)
#define PG8_LDA(dst, b, h) do { if constexpr (FP8) { _Pragma("unroll") for (int m = 0; m < 4; ++m) dst##8[m] = PG8_LD8(PG8_SA(b, h) + m * 2048, aoff, aoff2); } \
        else { _Pragma("unroll") for (int m = 0; m < 4; ++m) _Pragma("unroll") for (int k = 0; k < 2; ++k) dst[m][k] = *(const LAS bf16x8*)(lds + PG8_SA(b, h) + aoff + m * 2048 + k * 1024); } } while (0)
#define PG8_LDB(dst, b, h) do { if constexpr (FP8) { _Pragma("unroll") for (int n = 0; n < 2; ++n) dst##8[n] = PG8_LD8(PG8_SB(b, h) + n * 2048, boff, boff2); } \
        else { _Pragma("unroll") for (int n = 0; n < 2; ++n) _Pragma("unroll") for (int k = 0; k < 2; ++k) dst[n][k] = *(const LAS bf16x8*)(lds + PG8_SB(b, h) + boff + n * 2048 + k * 1024); } } while (0)
#define PG8_MMA(ai, bj, At, Bt) do { __builtin_amdgcn_s_setprio(1); _Pragma("unroll") for (int m = 0; m < 4; ++m) _Pragma("unroll") for (int n = 0; n < 2; ++n) { \
        if constexpr (FP8) asm volatile("v_mfma_f32_16x16x128_f8f6f4 %0, %1, %2, %0" : "+v"(acc[ai][bj][m][n]) : "v"(Bt##8[n]), "v"(At##8[m])); \
        else { _Pragma("unroll") for (int k = 0; k < 2; ++k) acc[ai][bj][m][n] = __builtin_amdgcn_mfma_f32_16x16x32_bf16(Bt[n][k], At[m][k], acc[ai][bj][m][n], 0, 0, 0); } } \
        __builtin_amdgcn_s_setprio(0); } while (0)
#define PG8_WAIT_V(n) asm volatile("s_waitcnt vmcnt(" #n ")" ::: "memory")
#define PG8_WAIT_L(n) asm volatile("s_waitcnt lgkmcnt(" #n ")" ::: "memory")
#define PG8_BAR __builtin_amdgcn_s_barrier()
#define PG8_SCHED __builtin_amdgcn_sched_barrier(0)
#define PG8_AOFF(AO, U) do { _Pragma("unroll") for (int _h = 0; _h < 2; ++_h) _Pragma("unroll") for (int _i = 0; _i < 2; ++_i) { \
        if constexpr (GATHER) AO[_h][_i] = (unsigned)(U).tl[RA[_i] + _h * HALF] * (unsigned)(g.lda * 2) + cA2[_i]; \
        else AO[_h][_i] = (unsigned)RA[_i] * (unsigned)(g.lda * 2) + cA2[_i] + (unsigned)_h * hstepA; } } while (0)
    Unit cur, nxt; int ui = 0;
    if (!S.next(0, cur)) return;
    f32x4 acc[2][2][4][2];
#pragma unroll
    for (int a = 0; a < 2; ++a)
#pragma unroll
        for (int b = 0; b < 2; ++b)
#pragma unroll
            for (int m = 0; m < 4; ++m)
#pragma unroll
                for (int n = 0; n < 2; ++n) acc[a][b][m][n] = (f32x4){0.f, 0.f, 0.f, 0.f};
    bf16x8 At[4][2], B0[2][2], B1[2][2]; i32x8 At8[4], B08[2], B18[2];
    E.prep(cur, 0, wid, lane);
    unsigned aoC[2][2], aoN[2][2];
    PG8_AOFF(aoC, cur);
    const char* cA = uni_ptr(GATHER ? g.Abase : cur.A); const char* cB = uni_ptr(cur.B);
    PG8_STAGE(PG8_SB(0, 0), cB, voffB); PG8_STAGE(PG8_SB(0, 1), cB + hstepB, voffB); PG8_STAGE_A(PG8_SA(0, 0), cA, aoC, 0); PG8_STAGE_A(PG8_SA(0, 1), cA, aoC, 1);
    if (wr == 1) PG8_BAR;
    PG8_WAIT_V(2); PG8_BAR;
    PG8_STAGE(PG8_SB(1, 0), cB + kstep, voffB); PG8_STAGE_A(PG8_SA(1, 0), cA + kstep, aoC, 0); PG8_STAGE(PG8_SB(1, 1), cB + hstepB + kstep, voffB);
    PG8_WAIT_V(6); PG8_BAR;
    for (;;) {
        const bool has_next = S.next(ui + 1, nxt);
        if (has_next) E.prep(nxt, ui + 1, wid, lane);
        if constexpr (GATHER) { if (has_next) PG8_AOFF(aoN, nxt); else { _Pragma("unroll") for (int _h = 0; _h < 2; ++_h) _Pragma("unroll") for (int _i = 0; _i < 2; ++_i) aoN[_h][_i] = aoC[_h][_i]; } }
        const char* nA = uni_ptr(GATHER ? g.Abase : (has_next ? nxt.A : cA)); const char* nB = uni_ptr(has_next ? nxt.B : cB);
        const bool dh0 = cur.x2 != 2, dh1 = cur.x2 != 1;
#pragma nounroll
        for (int t = 0; t < nt; t += 2) {
            const bool last = (t == nt - 2);
            if constexpr (Epi::MID) { if (t == 2) E.prep_mid(cur, wid, lane); }
            const char* a1 = cA + (size_t)(t + 1) * kstep;
            const char* a2 = last ? nA : cA + (size_t)(t + 2) * kstep; const char* b2 = last ? nB : cB + (size_t)(t + 2) * kstep;
            const char* a3 = a2 + kstep; const char* b3 = b2 + kstep;
            unsigned aoS[2][2];
#pragma unroll
            for (int _h = 0; _h < 2; ++_h)
#pragma unroll
                for (int _i = 0; _i < 2; ++_i) aoS[_h][_i] = (GATHER && last) ? aoN[_h][_i] : aoC[_h][_i];
            PG8_LDB(B0, 0, 0); PG8_LDB(B1, 0, 1); PG8_SCHED; PG8_LDA(At, 0, 0); PG8_STAGE_A(PG8_SA(1, 1), a1, aoC, 1);
            PG8_WAIT_V(8); PG8_WAIT_L(0); PG8_BAR; if (!HALFSEL || dh0) PG8_MMA(0, 0, At, B0); if (!HALFSEL || dh1) PG8_MMA(0, 1, At, B1); PG8_BAR; PG8_SCHED;
            PG8_LDA(At, 0, 1); PG8_STAGE(PG8_SB(0, 0), b2, voffB); PG8_STAGE(PG8_SB(0, 1), b2 + hstepB, voffB); PG8_STAGE_A(PG8_SA(0, 0), a2, aoS, 0);
            PG8_WAIT_V(8); PG8_WAIT_L(0); PG8_BAR; if (!HALFSEL || dh0) PG8_MMA(1, 0, At, B0); if (!HALFSEL || dh1) PG8_MMA(1, 1, At, B1); PG8_BAR; PG8_SCHED;
            PG8_LDB(B0, 1, 0); PG8_LDB(B1, 1, 1); PG8_SCHED; PG8_LDA(At, 1, 0); PG8_STAGE_A(PG8_SA(0, 1), a2, aoS, 1);
            PG8_WAIT_V(8); PG8_WAIT_L(0); PG8_BAR; if (!HALFSEL || dh0) PG8_MMA(0, 0, At, B0); if (!HALFSEL || dh1) PG8_MMA(0, 1, At, B1); PG8_BAR; PG8_SCHED;
            PG8_LDA(At, 1, 1); PG8_STAGE(PG8_SB(1, 0), b3, voffB); PG8_STAGE(PG8_SB(1, 1), b3 + hstepB, voffB); PG8_STAGE_A(PG8_SA(1, 0), a3, aoS, 0);
            PG8_WAIT_V(8); PG8_WAIT_L(0); PG8_BAR; if (!HALFSEL || dh0) PG8_MMA(1, 0, At, B0); if (!HALFSEL || dh1) PG8_MMA(1, 1, At, B1); PG8_BAR; PG8_SCHED;
        }
        if constexpr (FP8) asm volatile("s_nop 15\n\ts_nop 15" ::: "memory");
        if constexpr (ALIGN_EPI) { if (wr == 0) PG8_BAR; }
        E(acc, cur, wr, wc, fr, fq);
        if (!has_next) break;
#pragma unroll
        for (int a = 0; a < 2; ++a)
#pragma unroll
            for (int b = 0; b < 2; ++b)
#pragma unroll
                for (int m = 0; m < 4; ++m)
#pragma unroll
                    for (int n = 0; n < 2; ++n) acc[a][b][m][n] = (f32x4){0.f, 0.f, 0.f, 0.f};
        if constexpr (FP8) asm volatile("s_nop 7" ::: "memory");
        cur = nxt; cA = nA; cB = nB; ++ui;
        if constexpr (GATHER) {
#pragma unroll
            for (int _h = 0; _h < 2; ++_h)
#pragma unroll
                for (int _i = 0; _i < 2; ++_i) aoC[_h][_i] = aoN[_h][_i]; }
        if constexpr (ALIGN_EPI) { if (wr == 1) PG8_BAR; }
    }
    PG8_WAIT_V(0);
    if constexpr (!ALIGN_EPI) { if (wr == 0) PG8_BAR; }
    PG8_BAR;
#undef PG8_SA
#undef PG8_SB
#undef PG8_STAGE
#undef PG8_STAGE_A
#undef PG8_LDA
#undef PG8_LD8
#undef PG8_LDB
#undef PG8_MMA
#undef PG8_WAIT_V
#undef PG8_WAIT_L
#undef PG8_BAR
#undef PG8_SCHED
#undef PG8_AOFF
}
}
#include <hip/hip_bf16.h>
namespace attn_body {
using bf16=__hip_bfloat16;
using bf16x8=__attribute__((ext_vector_type(8)))short;
using s16x4=__attribute__((ext_vector_type(4)))short;
using f32x16=__attribute__((ext_vector_type(16)))float;
using u32x4=__attribute__((ext_vector_type(4)))unsigned;
constexpr int BATCH=4,NHEAD=16,SEQ=4096,D=64,DM=NHEAD*D;
constexpr int NW=8,QBLK=32,QB=QBLK*NW,KVBLK=64,NQB=SEQ/QB;
constexpr int ATTN_PITCH=DM, ATTN_UNIT_ROWS=QB;
__device__ __forceinline__ int crow(int r,int hi){return (r&3)+8*(r>>2)+4*hi;}
#define SBAR() __builtin_amdgcn_sched_barrier(0)
__device__ __forceinline__ void cmask(f32x16&p0,f32x16&p1,int jb,int qrel,int hi){
  const float NEG=-INFINITY; int d=qrel-64*jb-4*hi; asm volatile("":"+v"(d));
  #pragma unroll
  for(int r=0;r<16;++r){const int c=(r&3)+8*(r>>2); if(c>d)p0[r]=NEG; if(c+32>d)p1[r]=NEG;}
}

constexpr int NSLOT=3, SLOTB=8192;
constexpr int LDS_GT=98304;
constexpr int LDS_K=0, LDS_V=NSLOT*SLOTB, LDS_WS=2*NSLOT*SLOTB, LDS_OST=LDS_WS+NW*64*4, LDS_BYTES=LDS_OST+NW*4096;
constexpr float C2=0.125f*1.4426950408889634f;
__device__ __forceinline__ void glds16(const void*gsrc,unsigned lds_dst){unsigned keep;
  asm volatile("s_mov_b32 %0, m0\n\ts_mov_b32 m0, %2\n\ts_nop 0\n\tglobal_load_lds_dwordx4 %1, off\n\ts_mov_b32 m0, %0":"=&s"(keep):"v"(gsrc),"s"(lds_dst):"memory");}
__device__ __forceinline__ void glds16s(const void*sbase,unsigned voff,unsigned lds_dst){unsigned keep;
  asm volatile("s_nop 4\n\ts_mov_b32 %0, m0\n\ts_mov_b32 m0, %3\n\ts_nop 0\n\tglobal_load_lds_dwordx4 %1, %2\n\ts_mov_b32 m0, %0":"=&s"(keep):"v"(voff),"s"(sbase),"s"(lds_dst):"memory");}
__device__ __forceinline__ unsigned lane_now(){unsigned l;asm volatile("v_mbcnt_lo_u32_b32 %0, -1, 0\n\tv_mbcnt_hi_u32_b32 %0, -1, %0":"=v"(l));return l;}
__device__ __forceinline__ float max3f(float a,float b,float c){float r;asm("v_max3_f32 %0, %1, %2, %3":"=v"(r):"v"(a),"v"(b),"v"(c));return r;}
__device__ __forceinline__ float max2f(float a,float b){float r;asm("v_max_f32_e32 %0, %1, %2":"=v"(r):"v"(a),"v"(b));return r;}
__device__ __forceinline__ float fadd_s(float a,float b){float r;asm("v_add_f32_e32 %0, %1, %2":"=v"(r):"v"(a),"v"(b));return r;}
__device__ __forceinline__ float fsub_s(float a,float b){float r;asm("v_sub_f32_e32 %0, %1, %2":"=v"(r):"v"(a),"v"(b));return r;}
typedef float f32x2_t __attribute__((ext_vector_type(2))); typedef __bf16 bf16x2_t __attribute__((ext_vector_type(2)));
__device__ __forceinline__ unsigned cvtpk_s(float lo,float hi){f32x2_t v={lo,hi};bf16x2_t b=__builtin_convertvector(v,bf16x2_t);return __builtin_bit_cast(unsigned,b);}
#define WAIT_BAR(N) asm volatile("s_waitcnt vmcnt(" #N ") lgkmcnt(0)\n\ts_barrier":::"memory")

__device__ __forceinline__ void qkt(f32x16&p0,f32x16&p1,const char*Kslot,const bf16x8*qr,int r32,int hi){
  const char*kb=Kslot+hi*1024+r32*16;
  #pragma unroll
  for(int d0=0;d0<4;++d0){
    const bf16x8 b0=*reinterpret_cast<const bf16x8*>(kb+d0*2048);
    const bf16x8 b1=*reinterpret_cast<const bf16x8*>(kb+d0*2048+512);
    if(d0==0){p0=__builtin_amdgcn_mfma_f32_32x32x16_bf16(b0,qr[0],(f32x16){0.f,0.f,0.f,0.f,0.f,0.f,0.f,0.f,0.f,0.f,0.f,0.f,0.f,0.f,0.f,0.f},0,0,0);p1=__builtin_amdgcn_mfma_f32_32x32x16_bf16(b1,qr[0],(f32x16){0.f,0.f,0.f,0.f,0.f,0.f,0.f,0.f,0.f,0.f,0.f,0.f,0.f,0.f,0.f,0.f},0,0,0);}
    else{p0=__builtin_amdgcn_mfma_f32_32x32x16_bf16(b0,qr[d0],p0,0,0,0);p1=__builtin_amdgcn_mfma_f32_32x32x16_bf16(b1,qr[d0],p1,0,0,0);}}
}
typedef __attribute__((address_space(3))) const char* lds_cptr;
typedef short v4i16_t __attribute__((ext_vector_type(4)));
__device__ __forceinline__ void kload8(bf16x8*kf,lds_cptr kp){
  kf[0]=*(const __attribute__((address_space(3))) bf16x8*)(kp);      kf[1]=*(const __attribute__((address_space(3))) bf16x8*)(kp+512);
  kf[2]=*(const __attribute__((address_space(3))) bf16x8*)(kp+2048); kf[3]=*(const __attribute__((address_space(3))) bf16x8*)(kp+2560);
  kf[4]=*(const __attribute__((address_space(3))) bf16x8*)(kp+4096); kf[5]=*(const __attribute__((address_space(3))) bf16x8*)(kp+4608);
  kf[6]=*(const __attribute__((address_space(3))) bf16x8*)(kp+6144); kf[7]=*(const __attribute__((address_space(3))) bf16x8*)(kp+6656);
}
__device__ __forceinline__ void kload2(bf16x8*kf,lds_cptr kp,int j){ kf[2*j]=*(const __attribute__((address_space(3))) bf16x8*)(kp+j*2048); kf[2*j+1]=*(const __attribute__((address_space(3))) bf16x8*)(kp+j*2048+512); }
__device__ __forceinline__ s16x4 vtr(lds_cptr p){ return __builtin_bit_cast(s16x4,__builtin_amdgcn_ds_read_tr16_b64_v4i16((__attribute__((address_space(3))) v4i16_t*)p)); }
__device__ __forceinline__ float rowmax(const f32x16&p0,const f32x16&p1){
  float a=max3f(p0[0],p0[1],p1[0]),b=max3f(p0[2],p0[3],p1[1]);a=max3f(a,p1[2],p1[3]);
  #pragma unroll
  for(int r=4;r<16;r+=4){a=max3f(a,p0[r],p0[r+1]);b=max3f(b,p0[r+2],p0[r+3]);a=max3f(a,p1[r],p1[r+1]);b=max3f(b,p1[r+2],p1[r+3]);}
  const float m=max2f(a,b);
  auto rr=__builtin_amdgcn_permlane32_swap(__float_as_uint(m),__float_as_uint(m),false,false);
  return max2f(__uint_as_float(rr[0]),__uint_as_float(rr[1]));
}
__device__ __forceinline__ void pv(f32x16*o,int vb,bf16x8 pa0,bf16x8 pa1,bf16x8 pa2,bf16x8 pa3){
  #pragma unroll
  for(int d0=0;d0<2;++d0){s16x4 lo[4],hi[4];
    #pragma unroll
    for(int ks=0;ks<4;++ks){
      asm volatile("ds_read_b64_tr_b16 %0,%1 offset:%c2":"=&v"(lo[ks]):"v"(vb),"i"(d0*4096+ks*1024):"memory");
      asm volatile("ds_read_b64_tr_b16 %0,%1 offset:%c2":"=&v"(hi[ks]):"v"(vb),"i"(d0*4096+ks*1024+512):"memory");}
    asm volatile("s_waitcnt lgkmcnt(0)":::"memory");SBAR();
    #define PK(k) (bf16x8){lo[k][0],lo[k][1],lo[k][2],lo[k][3],hi[k][0],hi[k][1],hi[k][2],hi[k][3]}
    o[d0]=__builtin_amdgcn_mfma_f32_32x32x16_bf16(pa0,PK(0),o[d0],0,0,0);
    o[d0]=__builtin_amdgcn_mfma_f32_32x32x16_bf16(pa1,PK(1),o[d0],0,0,0);
    o[d0]=__builtin_amdgcn_mfma_f32_32x32x16_bf16(pa2,PK(2),o[d0],0,0,0);
    o[d0]=__builtin_amdgcn_mfma_f32_32x32x16_bf16(pa3,PK(3),o[d0],0,0,0);
    #undef PK
  }
}

#ifndef ATTN_STORE16
#define ATTN_STORE16(p,v) (*(u32x4*)(p)=(v))
#endif
template<int THRL> __device__ __forceinline__ void attn_unit(int b,int h,int qb,const bf16*Q,const bf16*__restrict__ K,const bf16*__restrict__ V,unsigned char*O,const float*ksum,char*shm){
  const int tid=threadIdx.x,lane=tid&63,r32=lane&31,hi=lane>>5; const int wid=__builtin_amdgcn_readfirstlane(tid>>6);
  const long rowbase=(long)b*SEQ; const int q0=qb*QB;
  const bf16*Qw=Q+(rowbase+q0+wid*QBLK)*DM+h*D;
  const bf16*Kh=K+rowbase*DM+h*D,*Vh=V+rowbase*DM+h*D;
  const unsigned lds0=(unsigned)(uintptr_t)shm;
  float*wsf=(float*)(shm+LDS_WS)+wid*64;
  const unsigned kdst=lds0+LDS_K+wid*1024, vdst=lds0+LDS_V+wid*1024;
  #define PHYS(t) (((t)<4)?(4*qb+(t)):((t)-4))
  #define DMA_K(t,slot) glds16s((const char*)Kh+(size_t)PHYS(t)*(KVBLK*DM*2)+wid*16,lane_now()*(unsigned)(DM*2),(unsigned)__builtin_amdgcn_readfirstlane(kdst+(slot)))
  #define DMA_V(t,slot) glds16s((const char*)Vh+(size_t)PHYS(t)*(KVBLK*DM*2)+(size_t)(16*(wid&3))*(DM*2)+(wid>>2)*64,({const unsigned l_=lane_now(); (l_>>2)*(unsigned)(DM*2)+(l_&3u)*16u;}),(unsigned)__builtin_amdgcn_readfirstlane(vdst+(slot)))
  const int vb0=(int)(lds0+LDS_V)+((lane>>4)&1)*32+(lane&3)*8+(4*hi+((lane&15)>>2))*64;
  const char*Kbase=shm+LDS_K; bf16x8 kf[8];
  const lds_cptr shm3=(lds_cptr)shm; const lds_cptr kp0=shm3+LDS_K+hi*1024+r32*16; const lds_cptr vp0=shm3+LDS_V+((lane>>4)&1)*32+(lane&3)*8+(4*hi+((lane&15)>>2))*64;
  const int NT=(q0+QB)/KVBLK;
  DMA_K(0,0);DMA_V(0,0);DMA_K(1,SLOTB);
  { float*gt=(float*)(shm+LDS_GT);
    #pragma unroll
    for(int k=0;k<2;++k){ const int j=2*wid+k; if(j<qb) gt[j*64+lane]=ksum[(long)(b*16+j)*DM+h*D+lane]; } }
  bf16x8 qr[4];
  #pragma unroll
  for(int d0=0;d0<4;++d0)qr[d0]=*reinterpret_cast<const bf16x8*>(&Qw[(long)r32*DM+d0*16+hi*8]);

  unsigned sel=0u;
  float mhat=0.f,l_reg=0.f;f32x16 o[2];o[0]=f32x16{};o[1]=f32x16{};
  bf16x8 kone=(bf16x8){0,0,0,0,0,0,0,0}, qm=(bf16x8){0,0,0,0,0,0,0,0}; if(hi==0) kone[0]=(short)0x3F80;
  #define SETQM() do{ const unsigned short mb_=(unsigned short)(cvtpk_s(-mhat,0.f)&0xffffu); qm[0]=(hi==0)?(short)mb_:(short)0; asm volatile("":"+v"(qm)); }while(0)
  const int qrel=wid*QBLK+r32;
  #define CMASK(P0,P1,t) do{ const int t_=(t); if(t_<4){ const int l_=(int)lane_now(); cmask(P0,P1,t_,wid*QBLK+(l_&31),l_>>5); } else if(!((sel>>(((t_-4)>>2)&15))&1u)){ _Pragma("unroll") for(int r=0;r<16;++r){P0[r]=-INFINITY;P1[r]=-INFINITY;} } }while(0)
  bool resc=false;
  #define START(P0,P1) do{ const float rm=rowmax(P0,P1); resc=false; \
    { const float dl=__uint_as_float(cvtpk_s(rm,0.f)<<16); mhat=fadd_s(mhat,dl);          \
      _Pragma("unroll") for(int r=0;r<16;++r){P0[r]=fsub_s(P0[r],dl);P1[r]=fsub_s(P1[r],dl);} \
      SETQM(); } \
    _Pragma("unroll") for(int r=0;r<16;++r)P0[r]=__builtin_amdgcn_exp2f(P0[r]); }while(0)
  #define RESC() do{ if(resc){ asm volatile("s_waitcnt lgkmcnt(0)":::"memory"); \
      _Pragma("unroll") for(int d_=0;d_<2;++d_) _Pragma("unroll") for(int r=0;r<16;++r)o[d_][r]*=wsf[crow(r,(int)(lane_now()>>5))]; } }while(0)
  f32x16 pA0,pA1,pB0,pB1;
  int sl_prev=0,sl_cur=0,sl_next=SLOTB;
  #define ROT() do{sl_prev=sl_cur;sl_cur=sl_next;sl_next=(sl_next==(NSLOT-1)*SLOTB)?0:sl_next+SLOTB;}while(0)
  DMA_K(2,2*SLOTB);
  WAIT_BAR(3);
  { float qf[32];
    #pragma unroll
    for(int d0=0;d0<4;++d0){
      #pragma unroll
      for(int i=0;i<8;++i) qf[d0*8+i]=__uint_as_float(((unsigned)(unsigned short)qr[d0][i])<<16); }
    const float*gt=(const float*)(shm+LDS_GT)+hi*8; float g[15];
    #pragma unroll
    for(int j=0;j<15;++j){ g[j]=-INFINITY;
      if(j<qb){ const float*kp=gt+j*64; float a=0.f;
        #pragma unroll
        for(int d0=0;d0<4;++d0){ const float4 k0=*reinterpret_cast<const float4*>(kp+d0*16), k1=*reinterpret_cast<const float4*>(kp+d0*16+4);
          a+=qf[d0*8+0]*k0.x; a+=qf[d0*8+1]*k0.y; a+=qf[d0*8+2]*k0.z; a+=qf[d0*8+3]*k0.w; a+=qf[d0*8+4]*k1.x; a+=qf[d0*8+5]*k1.y; a+=qf[d0*8+6]*k1.z; a+=qf[d0*8+7]*k1.w; }
        g[j]=a+__shfl_xor(a,32); } }
    #pragma unroll
    for(int kk=0;kk<3;++kk){ float best=-INFINITY; int bj=-1;
      #pragma unroll
      for(int j=0;j<15;++j){ const bool c=(j<qb)&&!((sel>>j)&1u)&&(g[j]>best); best=c?g[j]:best; bj=c?j:bj; }
      if(bj>=0) sel|=(1u<<bj); } }
  qkt(pA0,pA1,Kbase,qr,r32,hi);asm volatile("s_nop 15\n\ts_nop 7":"+v"(pA0),"+v"(pA1));CMASK(pA0,pA1,0);
  START(pA0,pA1);
  _Pragma("unroll") for(int r=0;r<16;++r)pA1[r]=__builtin_amdgcn_exp2f(pA1[r]);
  WAIT_BAR(0);
  DMA_K(3,0);DMA_V(1,SLOTB);
  ROT();
  kload8(kf,kp0+sl_cur);
  WAIT_BAR(2);
  s16x4 vlo[8],vhi[8]; u32x4 pw0,pw1,pw2,pw3;
  #define PKW(P,B) cvtpk_s(P[B],P[B+1])
  #define PAF(k) __builtin_bit_cast(bf16x8,pw##k)
  #define VFR(i) (bf16x8){vlo[i][0],vlo[i][1],vlo[i][2],vlo[i][3],vhi[i][0],vhi[i][1],vhi[i][2],vhi[i][3]}
  #define PIN(x) asm volatile("":"+v"(x))
  #define MX3(a,b,c) __builtin_fmaxf(__builtin_fmaxf((a),(b)),(c))
  #define GAPA(MF,A0,A1,A2,A3,W0,W1,PW) do{ MF; sacc+=A0; sacc+=A1; sacc+=A2; sacc+=A3; PIN(sacc); W0; W1; PIN(PW); SBAR(); }while(0)
  #define EX(v) __builtin_amdgcn_exp2f(v)
  #define GAPB(MF,X,B) do{ MF; X[B]=EX(X[B]); X[B+1]=EX(X[B+1]); X[B+2]=EX(X[B+2]); X[B+3]=EX(X[B+3]); PIN(X); SBAR(); }while(0)
  #define VRD(i) do{ vlo[i]=vtr(vp_+(((i)>>2)*4096+((i)&3)*1024)); vhi[i]=vtr(vp_+(((i)>>2)*4096+((i)&3)*1024+512)); }while(0)
  #define KRD(G,j) do{ if(G){ kload2(kf,kp0+sl_next,j); SBAR(); } }while(0)
  #define STEP(C0,C1,P0,P1,t,GK,GV,GL) do{ SBAR(); \
    const lds_cptr vp_=vp0+sl_prev; \
    C0=__builtin_amdgcn_mfma_f32_32x32x16_bf16(kone,qm,(f32x16){0.f,0.f,0.f,0.f,0.f,0.f,0.f,0.f,0.f,0.f,0.f,0.f,0.f,0.f,0.f,0.f},0,0,0); C1=__builtin_amdgcn_mfma_f32_32x32x16_bf16(kone,qm,(f32x16){0.f,0.f,0.f,0.f,0.f,0.f,0.f,0.f,0.f,0.f,0.f,0.f,0.f,0.f,0.f,0.f},0,0,0); SBAR(); \
    VRD(0); SBAR(); float sacc=(P0[0]+P0[1]); \
    GAPA(C0=__builtin_amdgcn_mfma_f32_32x32x16_bf16(kf[0],qr[0],C0,0,0,0), P0[2],P0[3],P0[4],P0[5],     pw0[0]=PKW(P0,0), pw0[1]=PKW(P0,2), pw0); \
    VRD(4); SBAR(); GAPA(C1=__builtin_amdgcn_mfma_f32_32x32x16_bf16(kf[1],qr[0],C1,0,0,0), P0[6],P0[7],P0[8],P0[9],     pw0[2]=PKW(P0,4), pw0[3]=PKW(P0,6), pw0); \
    VRD(1); SBAR(); GAPA(C0=__builtin_amdgcn_mfma_f32_32x32x16_bf16(kf[2],qr[1],C0,0,0,0),   P0[10],P0[11],P0[12],P0[13], pw1[0]=PKW(P0,8), pw1[1]=PKW(P0,10), pw1); \
    VRD(5); SBAR(); GAPA(C1=__builtin_amdgcn_mfma_f32_32x32x16_bf16(kf[3],qr[1],C1,0,0,0),   P0[14],P0[15],P1[0],P1[1],   pw1[2]=PKW(P0,12),pw1[3]=PKW(P0,14), pw1); \
    VRD(2); SBAR(); GAPA(C0=__builtin_amdgcn_mfma_f32_32x32x16_bf16(kf[4],qr[2],C0,0,0,0),   P1[2],P1[3],P1[4],P1[5],     pw2[0]=PKW(P1,0), pw2[1]=PKW(P1,2), pw2); \
    VRD(6); SBAR(); GAPA(C1=__builtin_amdgcn_mfma_f32_32x32x16_bf16(kf[5],qr[2],C1,0,0,0),   P1[6],P1[7],P1[8],P1[9],     pw2[2]=PKW(P1,4), pw2[3]=PKW(P1,6), pw2); \
    VRD(3); SBAR(); GAPA(C0=__builtin_amdgcn_mfma_f32_32x32x16_bf16(kf[6],qr[3],C0,0,0,0),   P1[10],P1[11],P1[12],P1[13], pw3[0]=PKW(P1,8), pw3[1]=PKW(P1,10), pw3); \
    VRD(7); SBAR(); GAPA(C1=__builtin_amdgcn_mfma_f32_32x32x16_bf16(kf[7],qr[3],C1,0,0,0),   P1[14],P1[15],0.f,0.f,       pw3[2]=PKW(P1,12),pw3[3]=PKW(P1,14), pw3); \
    l_reg+=sacc; \
    if(GK){DMA_K((t)+3,sl_cur);} if(GV){DMA_V((t)+1,sl_next);} \
    CMASK(C0,C1,t); \
    { float a=MX3(C0[0],C0[1],C1[0]),b=MX3(C0[2],C0[3],C1[1]); a=MX3(a,C1[2],C1[3]); \
      _Pragma("unroll") for(int r=4;r<16;r+=4){a=MX3(a,C0[r],C0[r+1]);b=MX3(b,C0[r+2],C0[r+3]);a=MX3(a,C1[r],C1[r+1]);b=MX3(b,C1[r+2],C1[r+3]);} \
      float rm=__builtin_fmaxf(a,b); { auto rr=__builtin_amdgcn_permlane32_swap(__float_as_uint(rm),__float_as_uint(rm),false,false); rm=__builtin_fmaxf(__uint_as_float(rr[0]),__uint_as_float(rr[1])); } \
      resc=false; \
      if(__builtin_expect(__any(rm>(float)THRL),0)){ const float mn_=__uint_as_float(cvtpk_s(mhat+__builtin_fmaxf(rm,0.f),0.f)<<16); const float dl=mn_-mhat; mhat=mn_; \
        _Pragma("unroll") for(int r=0;r<16;++r){C0[r]-=dl;C1[r]-=dl;} \
        SETQM(); \
        const float f=__builtin_amdgcn_exp2f(-dl); l_reg*=f; { const int l_=(int)lane_now(); if((l_>>5)==0)wsf[l_&31]=f; } resc=true; } } \
    SBAR(); \
    GAPB(o[0]=__builtin_amdgcn_mfma_f32_32x32x16_bf16(PAF(0),VFR(0),o[0],0,0,0), C0,0); \
    GAPB(o[1]=__builtin_amdgcn_mfma_f32_32x32x16_bf16(PAF(0),VFR(4),o[1],0,0,0), C0,4); \
    KRD(GL,0); GAPB(o[0]=__builtin_amdgcn_mfma_f32_32x32x16_bf16(PAF(1),VFR(1),o[0],0,0,0), C0,8); \
    KRD(GL,1); GAPB(o[1]=__builtin_amdgcn_mfma_f32_32x32x16_bf16(PAF(1),VFR(5),o[1],0,0,0), C0,12); \
    KRD(GL,2); GAPB(o[0]=__builtin_amdgcn_mfma_f32_32x32x16_bf16(PAF(2),VFR(2),o[0],0,0,0), C1,0); \
    KRD(GL,3); GAPB(o[1]=__builtin_amdgcn_mfma_f32_32x32x16_bf16(PAF(2),VFR(6),o[1],0,0,0), C1,4); \
    GAPB(o[0]=__builtin_amdgcn_mfma_f32_32x32x16_bf16(PAF(3),VFR(3),o[0],0,0,0), C1,8); \
    GAPB(o[1]=__builtin_amdgcn_mfma_f32_32x32x16_bf16(PAF(3),VFR(7),o[1],0,0,0), C1,12); \
    }while(0)
  int t=1;
  #undef CMASK
  #define CMASK(P0,P1,t) do{ const int t_=(t); if(t_<4){ const int l_=(int)lane_now(); cmask(P0,P1,t_,wid*QBLK+(l_&31),l_>>5); } else if(!((sel>>(((t_-4)>>2)&15))&1u)){ _Pragma("unroll") for(int r=0;r<16;++r){P0[r]=-INFINITY;P1[r]=-INFINITY;} } }while(0)
  for(;t+5<NT;t+=2){
    STEP(pB0,pB1,pA0,pA1,t,true,true,true);     WAIT_BAR(2); RESC(); ROT();
    STEP(pA0,pA1,pB0,pB1,t+1,true,true,true);   WAIT_BAR(2); RESC(); ROT();
  }
  #undef CMASK
  #define CMASK(P0,P1,t) do{ const int t_=(t); if(t_<4){ const int l_=(int)lane_now(); cmask(P0,P1,t_,wid*QBLK+(l_&31),l_>>5); } else if(!((sel>>(((t_-4)>>2)&15))&1u)){ _Pragma("unroll") for(int r=0;r<16;++r){P0[r]=-INFINITY;P1[r]=-INFINITY;} } }while(0)
  #define ENDW(tt) do{ if((tt)+3<NT){WAIT_BAR(2);} else if((tt)+2<NT){WAIT_BAR(1);} else {WAIT_BAR(0);} }while(0)
  for(;t+1<NT;t+=2){
    STEP(pB0,pB1,pA0,pA1,t,(t+3<NT),(t+1<NT),(t+1<NT));       ENDW(t);   RESC(); ROT();
    STEP(pA0,pA1,pB0,pB1,t+1,(t+4<NT),(t+2<NT),(t+2<NT));     ENDW(t+1); RESC(); ROT();
  }
  STEP(pB0,pB1,pA0,pA1,NT-1,false,false,false); RESC();
  { float sacc=pB0[0]+pB0[1]; _Pragma("unroll") for(int r=2;r<16;++r)sacc+=pB0[r]; _Pragma("unroll") for(int r=0;r<16;++r)sacc+=pB1[r]; l_reg+=sacc;
    pw0=(u32x4){PKW(pB0,0),PKW(pB0,2),PKW(pB0,4),PKW(pB0,6)};pw1=(u32x4){PKW(pB0,8),PKW(pB0,10),PKW(pB0,12),PKW(pB0,14)};pw2=(u32x4){PKW(pB1,0),PKW(pB1,2),PKW(pB1,4),PKW(pB1,6)};pw3=(u32x4){PKW(pB1,8),PKW(pB1,10),PKW(pB1,12),PKW(pB1,14)};
    SBAR(); pv(o,vb0+sl_cur,PAF(0),PAF(1),PAF(2),PAF(3)); }
  #undef PKW
  #undef PAF
  #undef VFR
  #undef PIN
  #undef MX3
  #undef GAPA
  #undef GAPB
  #undef EX
  #undef VRD
  #undef KRD
  #undef STEP
  #undef ENDW
  {auto rr=__builtin_amdgcn_permlane32_swap(__float_as_uint(l_reg),__float_as_uint(l_reg),false,false);l_reg=__uint_as_float(rr[0])+__uint_as_float(rr[1]);}
  if(hi==0)wsf[32+r32]=l_reg;asm volatile("s_waitcnt lgkmcnt(0)":::"memory");
  float rli[16];
  #pragma unroll
  for(int r=0;r<16;++r)rli[r]=__builtin_amdgcn_rcpf(wsf[32+crow(r,hi)]);
  unsigned char*Ow=O+(rowbase+q0+wid*QBLK)*DM+h*D;
  { bf16*stg=(bf16*)(shm+LDS_OST)+wid*2048;
    #pragma unroll
    for(int r=0;r<16;++r){const int orow=crow(r,hi);
      #pragma unroll
      for(int d0=0;d0<2;++d0)stg[orow*64+d0*32+r32]=__float2bfloat16(o[d0][r]*rli[r]);}
    asm volatile("s_waitcnt lgkmcnt(0)":::"memory");
    #pragma unroll
    for(int i=0;i<4;++i){const int row=i*8+(lane>>3),ch=lane&7; const u32x4 v=*(const u32x4*)(stg+row*64+ch*8);
      #define BL_(w) (__uint_as_float((w)<<16)*4.f)
      #define BH_(w) (__uint_as_float((w)&0xffff0000u)*4.f)
      int w0=__builtin_amdgcn_cvt_pk_fp8_f32(BL_(v.x),BH_(v.x),0,false); w0=__builtin_amdgcn_cvt_pk_fp8_f32(BL_(v.y),BH_(v.y),w0,true);
      int w1=__builtin_amdgcn_cvt_pk_fp8_f32(BL_(v.z),BH_(v.z),0,false); w1=__builtin_amdgcn_cvt_pk_fp8_f32(BL_(v.w),BH_(v.w),w1,true);
      #undef BL_
      #undef BH_
      u32x2 w2; w2.x=(unsigned)w0; w2.y=(unsigned)w1; *(u32x2*)(Ow+(long)row*DM+ch*8)=w2;} }
  asm volatile("s_waitcnt lgkmcnt(0)\n\ts_barrier":::"memory");
  #undef DMA_K
  #undef PHYS
  #undef DMA_V
  #undef CMASK
  #undef START
  #undef SETQM
  #undef RESC
  #undef ROT
}
constexpr int ATTN_LDS_BYTES=LDS_BYTES;
struct AttnTensors { const bf16* Q; const bf16* K; const bf16* V; unsigned char* O; const float* ksum; };
struct AttnUnit { int bh; int qb; };
struct StaticOrder {
  int vcu, G;
  __device__ __forceinline__ explicit StaticOrder(int grid,int block):vcu((grid%8==0)?((block%8)*(grid/8)+block/8):block),G(grid){}
  __device__ __forceinline__ bool next(int i,AttnUnit&u)const{ const int L=i*G+vcu; if(L>=1024)return false; const int w=L&255, rnd=L>>8, s=w&3; u.bh=w>>2; u.qb=(rnd==0)?s:(rnd==1)?7-s:(rnd==2)?8+s:15-s; return true; }
  __device__ __forceinline__ void a_ready(const AttnUnit&)const{}
  __device__ __forceinline__ void done(const AttnUnit&)const{}
};
struct SnakeOrder {
  int v, G;
  __device__ __forceinline__ bool next(int i,AttnUnit&u)const{ const int idx=i*G+((i&1)?(G-1-v):v); if(idx>=1024)return false; u.qb=15-(idx>>6); u.bh=idx&63; return true; }
  __device__ __forceinline__ void a_ready(const AttnUnit&)const{}
  __device__ __forceinline__ void done(const AttnUnit&)const{}
};
template<class Sched,int THRL=8> __device__ __forceinline__ void attn_phase(char*lds,const AttnTensors&T,const Sched&S){
  AttnUnit u;
  for(int i=0;S.next(i,u);++i){ S.a_ready(u); attn_unit<THRL>(u.bh/NHEAD,u.bh%NHEAD,u.qb,T.Q,T.K,T.V,T.O,T.ksum,lds); S.done(u); }
}
#undef SBAR
#undef WAIT_BAR
}
constexpr int NWAVES = 8, NTHR = 512;
constexpr int NTOK = 16384, DM = 1024, SEQ = 4096, NBATCH = 4, NEXP = 32;
constexpr float ALPHA = 1.4142135623730951f;
constexpr float LN_EPS = 1e-5f;
constexpr float RSQRT_DQK = 0.08838834764831845f;
constexpr int NPHASE = 19;
constexpr float FP8_SA = 4.0f, FP8_SWGU = 64.0f, FP8_SWD = 128.0f;
constexpr float FP8_SY = 32.0f, FP8_MAXV = 448.0f;
constexpr float FP8_SWIN = 64.0f, SCI = 1.0f / (FP8_SA * FP8_SWIN);
constexpr size_t WS_X8 = (size_t)288 << 20, WS_O8 = (size_t)304 << 20;
#ifndef DBG_ATTN_MUL
#define DBG_ATTN_MUL 1.0f
#endif
#ifndef DBG_MLSTM_MUL
#define DBG_MLSTM_MUL 1.0f
#endif
#ifndef DBG_MOE_MUL
#define DBG_MOE_MUL 1.0f
#endif
#ifndef DBG_P14_A
#define DBG_P14_A WS_HN
#endif
#ifndef NCONV
#define NCONV 80
#endif
#ifndef MK_ONE_LAUNCH
#define MK_ONE_LAUNCH 1
#endif

constexpr size_t MiB = 1u << 20, KiB = 1024;
constexpr size_t WS_CTL = 0, CTL_ZERO_BYTES = 1 * MiB;
constexpr int CW_TMO = 0, CW_BAR = 4096, CW_CNT = 8192, CW_AQ = 16384;
constexpr size_t WS_KSUM = 256 * KiB, WS_DEN = 512 * KiB;
constexpr size_t WS_WQKV = 2 * MiB, WS_WO = 8 * MiB, WS_WINA = 10 * MiB, WS_WINB = 14 * MiB, WS_WOUT = 17 * MiB;
constexpr size_t WS_WG = 19 * MiB, WS_RWT = 20 * MiB, WS_ROPE = 21 * MiB;
constexpr size_t WS_TOKE = 22 * MiB, WS_TOKP = 22 * MiB + 256 * KiB, WS_TOKG = 22 * MiB + 512 * KiB;
constexpr size_t WS_GI = 23 * MiB, WS_LF = 23 * MiB + 256 * KiB, WS_RF = 23 * MiB + 512 * KiB, WS_CF = 23 * MiB + 768 * KiB;
constexpr size_t WS_DEC = 24 * MiB, WS_NU = 24 * MiB + 256 * KiB, WS_NPREV = 24 * MiB + 512 * KiB;
constexpr size_t WS_ROWTOK = 25 * MiB;
constexpr size_t WS_XB = 32 * MiB, WS_Q = 64 * MiB, WS_K = 96 * MiB, WS_V = 128 * MiB;
constexpr size_t WS_R0 = 160 * MiB, WS_R1 = 224 * MiB, WS_R2 = 288 * MiB;
constexpr size_t WS_H = 352 * MiB, WS_Y = 496 * MiB;
constexpr size_t WS_WGU = 640 * MiB, WS_WD = 896 * MiB, WS_END = 1024 * MiB;
constexpr size_t WS_AE = 352 * MiB, WS_BE = 416 * MiB, WS_KN = 464 * MiB, WS_KT = 496 * MiB, WS_UT = 512 * MiB, WS_OS = 544 * MiB, WS_HN = 576 * MiB;

constexpr int RING_OFF = 0, RING_BYTES = 131072;
constexpr int LX = RING_BYTES;
constexpr int LX_MISC = LX;
constexpr int LX_TILEE = LX + 128;
constexpr int LX_TBASE = LX + 1280;
constexpr int LX_LCNT = LX + 1536, LX_GBASE = LX + 1664;
constexpr int LX_REC = LX + 1792;
constexpr int LX_TOKL = LX + 4096;
constexpr int LX_LNX = LX + 4096;
constexpr int LX_BIAS = LX + 12288;
constexpr int LX_ROPE = LX + 16384;
constexpr int LDS_BYTES = 163840;
constexpr int TOKL_ROUNDS = 10;

#define RLX_AGENT __ATOMIC_RELAXED, __HIP_MEMORY_SCOPE_AGENT
#define LDS_WAIT() asm volatile("s_waitcnt lgkmcnt(0)" ::: "memory")
#define VM_WAIT() asm volatile("s_waitcnt vmcnt(0)" ::: "memory")
#define XB_TMO      128
#define XB_XCNT(j)  (256  + 64 * (j))
#define XB_XSUB(j)  (1280 + 64 * (j))
#define XB_XGEN(j)  (2304 + 64 * (j))
#define XB_TOP      3328
#define XB_TOPGEN   3392
#define XCD_BAR_WORDS 3456
#define XB_SPIN_CAP (1u << 18)

__device__ __forceinline__ unsigned xb_ld(unsigned* p)              { return __hip_atomic_load(p, __ATOMIC_RELAXED, __HIP_MEMORY_SCOPE_AGENT); }
__device__ __forceinline__ unsigned xb_add(unsigned* p, unsigned v) { return __hip_atomic_fetch_add(p, v, __ATOMIC_RELAXED, __HIP_MEMORY_SCOPE_AGENT); }
__device__ __forceinline__ unsigned xb_xcc_id() { return (unsigned)__builtin_amdgcn_s_getreg((3 << 11) | 20) & 0xFu; }
#define XB_SPIN(cond, bar) do { unsigned _sp = 0; while (cond) { __builtin_amdgcn_s_sleep(1); \
    if ((++_sp & 255u) == 0u) { if (xb_ld(&(bar)[XB_TMO])) break; if (_sp > XB_SPIN_CAP) { atomicAdd(&(bar)[XB_TMO], 1u); break; } } } } while (0)

struct XcdBarrier {
    unsigned* bar; unsigned x;
    volatile LAS unsigned* st;
};

__device__ __forceinline__ XcdBarrier xcd_barrier_post(unsigned* bar, volatile LAS unsigned* st) {
    XcdBarrier b; b.bar = bar; b.x = xb_xcc_id(); b.st = st;
    if (threadIdx.x == 0) (void)xb_add(&bar[XB_XCNT(b.x)], 1u);
    return b;
}
__device__ __forceinline__ void xcd_barrier_complete(unsigned* bar, unsigned x, unsigned& nloc, unsigned& nx) {
    const unsigned G = gridDim.x * gridDim.y * gridDim.z;
    unsigned sum, cnt, mine, sp = 0u;
    for (;;) {
        sum = 0u; cnt = 0u; mine = 0u;
#pragma unroll
        for (unsigned j = 0; j < 16; ++j) { const unsigned c = xb_ld(&bar[XB_XCNT(j)]); sum += c; cnt += (c > 0u) ? 1u : 0u; mine = (j == x) ? c : mine; }
        if (sum == G) break;
        __builtin_amdgcn_s_sleep(1);
        if ((++sp & 255u) == 0u) { if (xb_ld(&bar[XB_TMO])) break; if (sp > XB_SPIN_CAP) { atomicAdd(&bar[XB_TMO], 1u); break; } }
    }
    nloc = mine > 0u ? mine : 1u; nx = cnt > 0u ? cnt : 1u;
}

__device__ __forceinline__ void xcd_barrier(const XcdBarrier& b) {
    asm volatile("s_waitcnt vmcnt(0)" ::: "memory");
    __syncthreads();
    if (threadIdx.x == 0) {
        unsigned* bar = b.bar;
        __builtin_amdgcn_s_waitcnt(0);
        unsigned nloc = b.st[0], nx = b.st[1];
        if (nloc == 0u) { xcd_barrier_complete(bar, b.x, nloc, nx); b.st[0] = nloc; b.st[1] = nx; }
        const unsigned old = xb_add(&bar[XB_XSUB(b.x)], 1u);
        const unsigned gen = old / nloc;
        if (old + 1u == (gen + 1u) * nloc) {
            __builtin_amdgcn_fence(__ATOMIC_RELEASE, "agent");
            asm volatile("s_waitcnt vmcnt(0)" ::: "memory");
            asm volatile("buffer_inv sc1" ::: "memory");
            const unsigned og = xb_add(&bar[XB_TOP], 1u);
            const unsigned tg = og / nx;
            if (og + 1u == (tg + 1u) * nx) xb_add(&bar[XB_TOPGEN], 1u);
            else XB_SPIN(xb_ld(&bar[XB_TOPGEN]) == tg, bar);
            asm volatile("s_waitcnt vmcnt(0)" ::: "memory");
        } else {
            asm volatile("buffer_inv sc1" ::: "memory");
            XB_SPIN(xb_ld(&bar[XB_TOPGEN]) == gen, bar);
            asm volatile("" ::: "memory");
            asm volatile("s_waitcnt vmcnt(0)" ::: "memory");
        }
    }
    __syncthreads();
}
using pg8::Unit; using pg8::Gemm;
typedef f32x4 (&AccRef)[2][2][4][2];

#ifndef TAIL_FIRST
#define TAIL_FIRST 0
#endif
__device__ __forceinline__ bool moe_unit(int i, int G, int c, int nT, int nN, int& pm, int& pn, int& half) {
    const int U = nT * nN, R = U / G, rem = U - R * G; half = 0;
#if TAIL_FIRST
    if (rem > 0 && 2 * rem <= G) {
        if (c < 2 * rem) { if (i == 0) { half = 1 + (c & 1); return pg8::tile_order(0, U, R * G + (c >> 1), nT, nN, pm, pn); } --i; }
        if (i < R) return pg8::tile_order(i, G, c, nT, nN, pm, pn);
        return false; }
#endif
    if (i < R) return pg8::tile_order(i, G, c, nT, nN, pm, pn);
    if (i > R || rem == 0) return false;
    if (2 * rem <= G) { if (c >= 2 * rem) return false; half = 1 + (c & 1); return pg8::tile_order(0, U, R * G + (c >> 1), nT, nN, pm, pn); }
    return pg8::tile_order(i, G, c, nT, nN, pm, pn);
}
struct DenseSched {
    int nM, nN, G, c; const char* A; const char* B; size_t tstepA, tstepB; bool split = false;
    __device__ __forceinline__ bool next(int i, Unit& u) const {
        int half = 0;
        if (split) { if (!moe_unit(i, G, c, nM, nN, u.pm, u.pn, half)) return false; }
        else if (!pg8::tile_order(i, G, c, nM, nN, u.pm, u.pn)) return false;
        u.A = A + (size_t)u.pm * tstepA; u.B = B + (size_t)u.pn * tstepB; u.tl = nullptr; u.x0 = u.x1 = 0; u.x2 = half; return true; }
};
struct MoeSched {
    int nT, nN, G, c; const LAS int* tile_e; const LAS int* tbase; const LAS unsigned short* tokl;
    const char* A; const char* B; size_t tstepA, estepB, tstepB;
    __device__ __forceinline__ bool next(int i, Unit& u) const {
        int half; if (!moe_unit(i, G, c, nT, nN, u.pm, u.pn, half)) return false;
        const int e = tile_e[u.pm];
        u.x0 = e; u.x1 = u.pm * 256; u.x2 = half;
        u.A = A + (size_t)u.pm * tstepA; u.B = B + (size_t)e * estepB + (size_t)u.pn * tstepB;
        u.tl = tokl ? tokl + (i < TOKL_ROUNDS ? i : TOKL_ROUNDS - 1) * 256 : nullptr; return true; }
};
struct MuSched {
    int G, c, mode; const char* A; const char* B;
    __device__ __forceinline__ bool next(int i, Unit& u) const {
        const int mu = i * G + c; if (mu >= 256) return false;
        const int b = mu >> 6, hh = (mu >> 4) & 3, ch = mu & 15; const size_t tok0 = (size_t)b * SEQ + (size_t)ch * 256;
        u.pm = mu; u.pn = 0; u.x0 = mu; u.x1 = 0; u.x2 = (mode == 0) ? 1 : 0; u.tl = nullptr;
        if (mode == 0) { u.A = A + (size_t)mu * 256 * 384 * 2; u.B = B + ((size_t)(hh * 128) * NTOK + tok0) * 2; }
        else if (mode == 1) { u.A = A + ((size_t)mu * 256 * 512 + 256) * 2; u.B = B + (tok0 * 1024 + (size_t)hh * 256) * 2; }
        else { u.A = A + (size_t)mu * 256 * 512 * 2; u.B = B + (size_t)mu * 256 * 384 * 2; }
        return true; }
};

constexpr float C2 = 0.125f * 1.4426950408889634f;

struct EpiQKV {
    static constexpr bool PERM = true; static constexpr bool MID = true;
    __device__ __forceinline__ void prep(const Unit&, int, int, int) const {}
    __device__ __forceinline__ void prep_mid(const Unit& u, int wid, int lane) const { if ((u.pn >> 2) < 2) {
#pragma unroll
        for (int i = 0; i < 2; ++i) { const int row = (wid * 2 + i) * 16 + (lane >> 2), c = (lane & 3) ^ ((row >> 1) & 3);
            glds16s(uni_ptr((const char*)(rope + (size_t)u.pm * 256 * 16)), (unsigned)(row * 64 + c * 16), (unsigned)__builtin_amdgcn_readfirstlane((unsigned)(unsigned long long)ropel + (unsigned)((wid * 2 + i) * 1024))); } } }
    bf16_t* Q; bf16_t* K; bf16_t* V; const float* rope; float* ksum; LAS float* ropel;
    __device__ __forceinline__ void operator()(AccRef acc, const Unit& u, int wr, int wc, int fr, int fq) const {
        asm volatile("" : "+v"(fr), "+v"(fq));
        const int part = u.pn >> 2, colt = (u.pn & 3) * 256;
        bf16_t* base = Q + (size_t)part * ((WS_K - WS_Q) / 2);
        const bool rot = (part < 2) && ((wc & 1) == 0);
        float ks[2][8];
#pragma unroll
        for (int bj = 0; bj < 2; ++bj)
#pragma unroll
            for (int j = 0; j < 8; ++j) ks[bj][j] = 0.f;
#pragma unroll
        for (int ai = 0; ai < 2; ++ai)
#pragma unroll
            for (int m = 0; m < 4; ++m) {
                const int row = u.pm * 256 + ai * 128 + wr * 64 + m * 16 + fr;
                f32x4 cs = {1.f, 1.f, 1.f, 1.f}, sn = {0.f, 0.f, 0.f, 0.f};
                if (rot && fq < 2) { const int rl = ai * 128 + wr * 64 + m * 16 + fr, sw = (rl >> 1) & 3; const LAS f32x4* rp = (const LAS f32x4*)(ropel + rl * 16);
                    cs = rp[fq ^ sw]; sn = rp[(2 + fq) ^ sw]; }
#pragma unroll
                for (int bj = 0; bj < 2; ++bj) {
                    f32x4 v0 = acc[ai][bj][m][0] * SCI, v1 = acc[ai][bj][m][1] * SCI;
                    if (rot) { const f32x4 lo = v0 * cs - v1 * sn, hi = v1 * cs + v0 * sn; v0 = lo; v1 = hi; }
                    if (part == 0) { v0 = v0 * C2; v1 = v1 * C2; }
                    if (part == 1) {
#pragma unroll
                        for (int j = 0; j < 4; ++j) { ks[bj][j] += v0[j]; ks[bj][4 + j] += v1[j]; } }
                    u32x4 w; w.x = cvt_pk_bf16(v0[0], v0[1]); w.y = cvt_pk_bf16(v0[2], v0[3]); w.z = cvt_pk_bf16(v1[0], v1[1]); w.w = cvt_pk_bf16(v1[2], v1[3]);
                    *(u32x4*)(base + (size_t)row * DM + colt + bj * 128 + wc * 32 + fq * 8) = w;
                }
            }
        if (part == 1) {
#pragma unroll
            for (int bj = 0; bj < 2; ++bj)
#pragma unroll
                for (int j = 0; j < 8; ++j) { float s = ks[bj][j]; s += __shfl_xor(s, 1); s += __shfl_xor(s, 2); s += __shfl_xor(s, 4); s += __shfl_xor(s, 8);
                    if (fr == 0) atomicAdd(ksum + (size_t)u.pm * DM + colt + bj * 128 + wc * 32 + fq * 8 + j, s); }
        }
    }
};

struct EpiZ {
    static constexpr bool PERM = true; static constexpr bool MID = false;
    __device__ __forceinline__ void prep(const Unit&, int, int, int) const {}
    const bf16_t* xin; bf16_t* z; float ymul;
    __device__ __forceinline__ void operator()(AccRef acc, const Unit& u, int wr, int wc, int fr, int fq) const {
        asm volatile("" : "+v"(fr), "+v"(fq));
        const size_t off0 = (size_t)(u.pm * 256 + wr * 64 + fr) * DM + u.pn * 256 + wc * 32 + fq * 8;
        u32x4 xr[2][4][2];
#pragma unroll
        for (int ai = 0; ai < 2; ++ai)
#pragma unroll
            for (int m = 0; m < 4; ++m)
#pragma unroll
                for (int bj = 0; bj < 2; ++bj) xr[ai][m][bj] = *(const u32x4*)(xin + off0 + (size_t)(ai * 128 + m * 16) * DM + bj * 128);
        asm volatile("" ::: "memory");
#pragma unroll
        for (int ai = 0; ai < 2; ++ai)
#pragma unroll
            for (int m = 0; m < 4; ++m)
#pragma unroll
                for (int bj = 0; bj < 2; ++bj) { const u32x4 x = xr[ai][m][bj]; const f32x4 a0 = acc[ai][bj][m][0] * ymul, a1 = acc[ai][bj][m][1] * ymul;
                    u32x4 w; w.x = cvt_pk_bf16(bflo(x.x) * ALPHA + a0[0], bfhi(x.x) * ALPHA + a0[1]); w.y = cvt_pk_bf16(bflo(x.y) * ALPHA + a0[2], bfhi(x.y) * ALPHA + a0[3]);
                    w.z = cvt_pk_bf16(bflo(x.z) * ALPHA + a1[0], bfhi(x.z) * ALPHA + a1[1]); w.w = cvt_pk_bf16(bflo(x.w) * ALPHA + a1[2], bfhi(x.w) * ALPHA + a1[3]);
                    *(u32x4*)(z + off0 + (size_t)(ai * 128 + m * 16) * DM + bj * 128) = w; }
    }
};

__device__ __forceinline__ float swiglu1(float glu, float lin) {
    const float g = fminf(glu, 7.0f), l = fminf(fmaxf(lin, -7.0f), 7.0f);
    const float sg = __builtin_amdgcn_rcpf(1.0f + __builtin_amdgcn_exp2f(-1.702f * 1.4426950408889634f * g));
    return g * sg * (l + 1.0f);
}
__device__ __forceinline__ f32x2 swiglu2(float glu0, float lin0, float glu1, float lin1) {
    const f32x2 g = {fminf(glu0, 7.0f), fminf(glu1, 7.0f)}, l = {fminf(fmaxf(lin0, -7.0f), 7.0f), fminf(fmaxf(lin1, -7.0f), 7.0f)};
    const f32x2 t = g * (f32x2){-1.702f * 1.4426950408889634f, -1.702f * 1.4426950408889634f};
    const f32x2 d = (f32x2){__builtin_amdgcn_exp2f(t[0]), __builtin_amdgcn_exp2f(t[1])} + (f32x2){1.0f, 1.0f};
    const f32x2 r = {__builtin_amdgcn_rcpf(d[0]), __builtin_amdgcn_rcpf(d[1])};
    const f32x2 lp = l * (f32x2){FP8_SA, FP8_SA} + (f32x2){FP8_SA, FP8_SA};
    return (g * lp) * r;
}
struct EpiGU {
    static constexpr bool PERM = true; static constexpr bool MID = false;
    __device__ __forceinline__ void prep(const Unit& u, int ui, int wid, int lane) const { if (wid < 4) glds4s(uni_ptr((const char*)(bias + (size_t)u.x0 * 2048 + u.pn * 256 + wid * 64)), (unsigned)lane * 4u, (unsigned)__builtin_amdgcn_readfirstlane((unsigned)(unsigned long long)bl + (unsigned)(((ui & 1) * 256 + wid * 64) * 4))); }
    const float* bias; unsigned char* H; LAS float* bl; mutable int ucnt;
    __device__ __forceinline__ void operator()(AccRef acc, const Unit& u, int wr, int wc, int fr, int fq) const {
        asm volatile("" : "+v"(fr), "+v"(fq));
        const int c0 = u.pn * 256 + wc * 32 + fq * 8; const LAS float* bp = bl + (ucnt & 1) * 256 + wc * 32 + fq * 8; ++ucnt; constexpr float SC = 1.0f / (FP8_SA * FP8_SWGU);
        f32x4 b[2][2];
#pragma unroll
        for (int bj = 0; bj < 2; ++bj) { b[bj][0] = *(const LAS f32x4*)(bp + bj * 128); b[bj][1] = *(const LAS f32x4*)(bp + bj * 128 + 4); }
#pragma unroll
        for (int ai = 0; ai < 2; ++ai)
#pragma unroll
            for (int m = 0; m < 4; ++m) {
                unsigned char* rowp = H + (size_t)(u.x1 + ai * 128 + wr * 64 + m * 16 + fr) * DM + (c0 >> 1);
#pragma unroll
                for (int bj = 0; bj < 2; ++bj) { if (u.x2 == 2 - bj) continue;
                    const f32x4 v0 = acc[ai][bj][m][0] * SC + b[bj][0], v1 = acc[ai][bj][m][1] * SC + b[bj][1];
                    const f32x2 h0 = swiglu2(v0[0], v0[1], v0[2], v0[3]), h1 = swiglu2(v1[0], v1[1], v1[2], v1[3]);
                    int w = __builtin_amdgcn_cvt_pk_fp8_f32(h0[0], h0[1], 0, false);
                    w = __builtin_amdgcn_cvt_pk_fp8_f32(h1[0], h1[1], w, true);
                    *(int*)(rowp + bj * 64) = w; }
            }
    }
};
struct EpiDN {
    static constexpr bool PERM = true; static constexpr bool MID = false;
    __device__ __forceinline__ void prep(const Unit& u, int ui, int wid, int lane) const { if (wid < 4) glds4s(uni_ptr((const char*)(bias + (size_t)u.x0 * 1024 + u.pn * 256 + wid * 64)), (unsigned)lane * 4u, (unsigned)__builtin_amdgcn_readfirstlane((unsigned)(unsigned long long)bl + (unsigned)(((ui & 1) * 256 + wid * 64) * 4))); }
    const float* bias; unsigned char* Y; LAS float* bl; mutable int ucnt;
    __device__ __forceinline__ void operator()(AccRef acc, const Unit& u, int wr, int wc, int fr, int fq) const {
        asm volatile("" : "+v"(fr), "+v"(fq));
        const int c0 = u.pn * 256 + wc * 32 + fq * 8; const LAS float* bp = bl + (ucnt & 1) * 256 + wc * 32 + fq * 8; ++ucnt; constexpr float SC = FP8_SY / (FP8_SA * FP8_SWD);
        f32x4 b[2][2];
#pragma unroll
        for (int bj = 0; bj < 2; ++bj) { b[bj][0] = *(const LAS f32x4*)(bp + bj * 128) * FP8_SY; b[bj][1] = *(const LAS f32x4*)(bp + bj * 128 + 4) * FP8_SY; }
#pragma unroll
        for (int ai = 0; ai < 2; ++ai)
#pragma unroll
            for (int m = 0; m < 4; ++m) {
                unsigned char* rowp = Y + (size_t)(u.x1 + ai * 128 + wr * 64 + m * 16 + fr) * DM + c0;
#pragma unroll
                for (int bj = 0; bj < 2; ++bj) { if (u.x2 == 2 - bj) continue;
                    f32x4 v0 = acc[ai][bj][m][0] * SC + b[bj][0], v1 = acc[ai][bj][m][1] * SC + b[bj][1];
#pragma unroll
                    for (int q = 0; q < 4; ++q) { v0[q] = __builtin_amdgcn_fmed3f(v0[q], -FP8_MAXV, FP8_MAXV); v1[q] = __builtin_amdgcn_fmed3f(v1[q], -FP8_MAXV, FP8_MAXV); }
                    int w0 = __builtin_amdgcn_cvt_pk_fp8_f32(v0[0], v0[1], 0, false); w0 = __builtin_amdgcn_cvt_pk_fp8_f32(v0[2], v0[3], w0, true);
                    int w1 = __builtin_amdgcn_cvt_pk_fp8_f32(v1[0], v1[1], 0, false); w1 = __builtin_amdgcn_cvt_pk_fp8_f32(v1[2], v1[3], w1, true);
                    u32x2 w; w.x = (unsigned)w0; w.y = (unsigned)w1;
                    *(u32x2*)(rowp + bj * 128) = w; }
            }
    }
};

struct EpiINA {
    static constexpr bool PERM = true; static constexpr bool MID = false;
    __device__ __forceinline__ void prep(const Unit&, int, int, int) const {}
    const float* rf; const float* cf; bf16_t* AE; bf16_t* KN; bf16_t* OS;
    __device__ __forceinline__ void operator()(AccRef acc, const Unit& u, int wr, int wc, int fr, int fq) const {
        asm volatile("" : "+v"(fr), "+v"(fq));
        const int b = u.pm >> 4, ch = u.pm & 15, d0 = wc * 32 + fq * 8; const u32x4 zero = {0u, 0u, 0u, 0u};
        if (u.pn < 4) {
            const bool isq = u.pn < 2; const float* fac = isq ? rf : cf; const float fs = (isq ? 1.0f : RSQRT_DQK) * SCI; const int h0 = (u.pn & 1) * 2;
            float sf[2][4][2];
#pragma unroll
            for (int ai = 0; ai < 2; ++ai)
#pragma unroll
                for (int m = 0; m < 4; ++m)
#pragma unroll
                    for (int bj = 0; bj < 2; ++bj) sf[ai][m][bj] = fac[(size_t)(h0 + bj) * NTOK + (size_t)u.pm * 256 + ai * 128 + wr * 64 + m * 16 + fr];
#pragma unroll
            for (int ai = 0; ai < 2; ++ai)
#pragma unroll
                for (int m = 0; m < 4; ++m) {
                    const int t = ai * 128 + wr * 64 + m * 16 + fr; const size_t token = (size_t)u.pm * 256 + t;
#pragma unroll
                    for (int bj = 0; bj < 2; ++bj) { const int hh = h0 + bj; const float s = sf[ai][m][bj] * fs;
                        const f32x4 v0 = acc[ai][bj][m][0] * s, v1 = acc[ai][bj][m][1] * s;
                        const size_t oq = ((size_t)(((b * 4 + hh) * 16 + ch) * 256 + t)) * 512 + 256 + d0, ok = token * 1024 + hh * 256 + d0;
                        bf16_t* dst = isq ? (AE + oq) : (KN + ok);
                        u32x4 w; w.x = cvt_pk_bf16(v0[0], v0[1]); w.y = cvt_pk_bf16(v0[2], v0[3]); w.z = cvt_pk_bf16(v1[0], v1[1]); w.w = cvt_pk_bf16(v1[2], v1[3]);
                        *(u32x4*)dst = w; }
                }
        } else {
#pragma unroll
            for (int ai = 0; ai < 2; ++ai)
#pragma unroll
                for (int m = 0; m < 4; ++m) {
                    const int t = ai * 128 + wr * 64 + m * 16 + fr; const size_t token = (size_t)u.pm * 256 + t;
#pragma unroll
                    for (int bj = 0; bj < 2; ++bj) { f32x4 v0 = acc[ai][bj][m][0], v1 = acc[ai][bj][m][1];
#pragma unroll
                        for (int j = 0; j < 4; ++j) { v0[j] = __builtin_amdgcn_rcpf(1.0f + __builtin_amdgcn_exp2f((-1.4426950408889634f * SCI) * v0[j])); v1[j] = __builtin_amdgcn_rcpf(1.0f + __builtin_amdgcn_exp2f((-1.4426950408889634f * SCI) * v1[j])); }
                        u32x4 w; w.x = cvt_pk_bf16(v0[0], v0[1]); w.y = cvt_pk_bf16(v0[2], v0[3]); w.z = cvt_pk_bf16(v1[0], v1[1]); w.w = cvt_pk_bf16(v1[2], v1[3]);
                        *(u32x4*)(OS + token * 1024 + (u.pn - 4) * 256 + bj * 128 + d0) = w; }
                }
        }
    }
};
struct EpiINB {
    static constexpr bool PERM = true; static constexpr bool MID = false;
    __device__ __forceinline__ void prep(const Unit&, int, int, int) const {}
    const float* cf; bf16_t* KT; bf16_t* BE;
    __device__ __forceinline__ void operator()(AccRef acc, const Unit& u, int wr, int wc, int fr, int fq) const {
        asm volatile("" : "+v"(fr), "+v"(fq));
        const int b = u.pn >> 4, ch = u.pn & 15;
        f32x4 cv[2][2][2];
#pragma unroll
        for (int ai = 0; ai < 2; ++ai)
#pragma unroll
            for (int bj = 0; bj < 2; ++bj) { const size_t tok0 = (size_t)u.pn * 256 + bj * 128 + wc * 32 + fq * 8;
                if (u.pm < 2) { const int hh = u.pm * 2 + ai; cv[ai][bj][0] = *(const f32x4*)(cf + (size_t)hh * NTOK + tok0) * (RSQRT_DQK * SCI); cv[ai][bj][1] = *(const f32x4*)(cf + (size_t)hh * NTOK + tok0 + 4) * (RSQRT_DQK * SCI); }
                else { cv[ai][bj][0] = (f32x4){SCI, SCI, SCI, SCI}; cv[ai][bj][1] = cv[ai][bj][0]; } }
#pragma unroll
        for (int ai = 0; ai < 2; ++ai)
#pragma unroll
            for (int m = 0; m < 4; ++m) {
                const int R = u.pm * 256 + ai * 128 + wr * 64 + m * 16 + fr;
#pragma unroll
                for (int bj = 0; bj < 2; ++bj) { if (u.x2 == 2 - bj) continue;
                    const f32x4 v0 = acc[ai][bj][m][0] * cv[ai][bj][0], v1 = acc[ai][bj][m][1] * cv[ai][bj][1]; const int s0 = bj * 128 + wc * 32 + fq * 8; const size_t tok0 = (size_t)u.pn * 256 + s0; bf16_t* dst;
                    if (u.pm < 2) dst = KT + (size_t)R * NTOK + tok0;
                    else { const int eg = R - 512, hh = eg >> 8, e = eg & 255; dst = BE + ((size_t)(((b * 4 + hh) * 16 + ch) * 256 + e)) * 384 + s0; }
                    u32x4 w; w.x = cvt_pk_bf16(v0[0], v0[1]); w.y = cvt_pk_bf16(v0[2], v0[3]); w.z = cvt_pk_bf16(v1[0], v1[1]); w.w = cvt_pk_bf16(v1[2], v1[3]);
                    *(u32x4*)dst = w;
                }
            }
    }
};
struct EpiM1 {
    static constexpr bool PERM = true; static constexpr bool MID = false;
    __device__ __forceinline__ void prep(const Unit&, int, int, int) const {}
    bf16_t* UT;
    __device__ __forceinline__ void operator()(AccRef acc, const Unit& u, int wr, int wc, int fr, int fq) const {
        asm volatile("" : "+v"(fr), "+v"(fq));
#pragma unroll
        for (int ai = 0; ai < 2; ++ai)
#pragma unroll
            for (int m = 0; m < 4; ++m) { bf16_t* rowp = UT + ((size_t)u.x0 * 256 + ai * 128 + wr * 64 + m * 16 + fr) * 128 + wc * 32 + fq * 8;
                const f32x4 v0 = acc[ai][0][m][0], v1 = acc[ai][0][m][1];
                u32x4 w; w.x = cvt_pk_bf16(v0[0], v0[1]); w.y = cvt_pk_bf16(v0[2], v0[3]); w.z = cvt_pk_bf16(v1[0], v1[1]); w.w = cvt_pk_bf16(v1[2], v1[3]);
                *(u32x4*)rowp = w; }
    }
};
struct EpiM2A {
    static constexpr bool PERM = true; static constexpr bool MID = false;
    __device__ __forceinline__ void prep(const Unit&, int, int, int) const {}
    bf16_t* AE; const float* nprev; float* den;
    __device__ __forceinline__ void operator()(AccRef acc, const Unit& u, int wr, int wc, int fr, int fq) const {
        asm volatile("" : "+v"(fr), "+v"(fq));
        const int mu = u.x0, dd = wc * 32 + fq * 8;
        const f32x4 n0 = *(const f32x4*)(nprev + (size_t)mu * 128 + dd), n1 = *(const f32x4*)(nprev + (size_t)mu * 128 + dd + 4);
        u32x4 qv8[2][4];
#pragma unroll
        for (int ai = 0; ai < 2; ++ai)
#pragma unroll
            for (int m = 0; m < 4; ++m) qv8[ai][m] = *(const u32x4*)(AE + ((size_t)mu * 256 + ai * 128 + wr * 64 + m * 16 + fr) * 512 + 256 + dd);
#pragma unroll
        for (int ai = 0; ai < 2; ++ai)
#pragma unroll
            for (int m = 0; m < 4; ++m) {
                const int t = ai * 128 + wr * 64 + m * 16 + fr; bf16_t* rowp = AE + ((size_t)mu * 256 + t) * 512;
                const u32x4 qv = qv8[ai][m];
                float part = bflo(qv.x) * n0[0] + bfhi(qv.x) * n0[1] + bflo(qv.y) * n0[2] + bfhi(qv.y) * n0[3] + bflo(qv.z) * n1[0] + bfhi(qv.z) * n1[1] + bflo(qv.w) * n1[2] + bfhi(qv.w) * n1[3];
#pragma unroll
                for (int bj = 0; bj < 2; ++bj) { const int s0 = bj * 128 + wc * 32 + fq * 8; f32x4 v0 = acc[ai][bj][m][0], v1 = acc[ai][bj][m][1];
                    int dts = t - s0; asm volatile("" : "+v"(dts));
#pragma unroll
                    for (int j = 0; j < 4; ++j) { v0[j] = (j <= dts) ? v0[j] : 0.f; v1[j] = (4 + j <= dts) ? v1[j] : 0.f; part += v0[j] + v1[j]; }
                    u32x4 w; w.x = cvt_pk_bf16(v0[0], v0[1]); w.y = cvt_pk_bf16(v0[2], v0[3]); w.z = cvt_pk_bf16(v1[0], v1[1]); w.w = cvt_pk_bf16(v1[2], v1[3]);
                    *(u32x4*)(rowp + s0) = w; }
                part += __shfl_xor(part, 16); part += __shfl_xor(part, 32);
                if (fq == 0) atomicAdd(den + (size_t)mu * 256 + (wr * 64 + fr) + (ai * 128 + m * 16), part);
            }
    }
};
struct EpiM2B {
    static constexpr bool PERM = true; static constexpr bool MID = false;
    __device__ __forceinline__ void prep(const Unit&, int, int, int) const {}
    const float* den; const float* normg; const bf16_t* OS; unsigned char* HN; LAS float* lnx;
    __device__ __forceinline__ void operator()(AccRef acc, const Unit& u, int wr, int wc, int fr, int fq) const {
        asm volatile("" : "+v"(fr), "+v"(fq));
        const int mu = u.x0, b = mu >> 6, hh = (mu >> 4) & 3, ch = mu & 15;
        float dnv[2][4];
#pragma unroll
        for (int ai = 0; ai < 2; ++ai)
#pragma unroll
            for (int m = 0; m < 4; ++m) dnv[ai][m] = den[(size_t)mu * 256 + ai * 128 + wr * 64 + m * 16 + fr];
#pragma unroll
        for (int ai = 0; ai < 2; ++ai)
#pragma unroll
            for (int m = 0; m < 4; ++m) {
                const int t = ai * 128 + wr * 64 + m * 16 + fr; const float dn = dnv[ai][m];
#ifdef DBG_DEN1
                const float inv = 1.0f;
#else
                const float inv = 1.0f / fmaxf(fabsf(dn), 1.0f);
#endif
                float s1 = 0.f, s2 = 0.f;
#pragma unroll
                for (int bj = 0; bj < 2; ++bj)
#pragma unroll
                    for (int n = 0; n < 2; ++n) { f32x4 h = acc[ai][bj][m][n] * inv; acc[ai][bj][m][n] = h; s1 += (h[0] + h[1]) + (h[2] + h[3]); s2 += (h[0] * h[0] + h[1] * h[1]) + (h[2] * h[2] + h[3] * h[3]); }
                s1 += __shfl_xor(s1, 16); s1 += __shfl_xor(s1, 32); s2 += __shfl_xor(s2, 16); s2 += __shfl_xor(s2, 32);
                if (fq == 0) { lnx[(t * 4 + wc) * 2] = s1; lnx[(t * 4 + wc) * 2 + 1] = s2; }
            }
        const int e0 = wc * 32 + fq * 8;
        f32x4 gg[2][2];
#pragma unroll
        for (int bj = 0; bj < 2; ++bj) { gg[bj][0] = *(const f32x4*)(normg + hh * 256 + bj * 128 + e0); gg[bj][1] = *(const f32x4*)(normg + hh * 256 + bj * 128 + e0 + 4); }
        asm volatile("s_waitcnt lgkmcnt(0)" ::: "memory"); __builtin_amdgcn_s_barrier(); asm volatile("" ::: "memory");
#pragma unroll
        for (int ai = 0; ai < 2; ++ai) {
            u32x4 ovv[4][2];
#pragma unroll
            for (int m = 0; m < 4; ++m)
#pragma unroll
                for (int bj = 0; bj < 2; ++bj) ovv[m][bj] = *(const u32x4*)(OS + (((size_t)(b * 16 + ch)) * 256 + ai * 128 + wr * 64 + m * 16 + fr) * 1024 + hh * 256 + bj * 128 + e0);
#pragma unroll
            for (int m = 0; m < 4; ++m) {
                const int t = ai * 128 + wr * 64 + m * 16 + fr; const size_t token = ((size_t)(b * 16 + ch)) * 256 + t;
                const LAS f32x4* lp = (const LAS f32x4*)(lnx + t * 8); const f32x4 a = lp[0], c = lp[1];
                const float mean = (a[0] + a[2] + c[0] + c[2]) * (1.0f / 256.0f); const float ex2 = (a[1] + a[3] + c[1] + c[3]) * (1.0f / 256.0f);
                const float rstd = 1.0f / sqrtf(fmaxf(ex2 - mean * mean, 0.f) + LN_EPS);
#pragma unroll
                for (int bj = 0; bj < 2; ++bj) { const int e = bj * 128 + e0; const size_t off = token * 1024 + hh * 256 + e; const u32x4 ov = ovv[m][bj];
#ifdef DBG_HN_OS
                    f32x4 v0 = {1.f, 1.f, 1.f, 1.f}, v1 = v0;
#elif defined(DBG_HN_RAW)
                    f32x4 v0 = acc[ai][bj][m][0], v1 = acc[ai][bj][m][1];
#else
                    f32x4 v0 = (acc[ai][bj][m][0] - mean) * rstd * gg[bj][0], v1 = (acc[ai][bj][m][1] - mean) * rstd * gg[bj][1];
#endif
#ifndef DBG_HN_ONE
                    v0[0] *= bflo(ov.x); v0[1] *= bfhi(ov.x); v0[2] *= bflo(ov.y); v0[3] *= bfhi(ov.y); v1[0] *= bflo(ov.z); v1[1] *= bfhi(ov.z); v1[2] *= bflo(ov.w); v1[3] *= bfhi(ov.w);
#endif
                    int w0 = __builtin_amdgcn_cvt_pk_fp8_f32(v0[0] * FP8_SA, v0[1] * FP8_SA, 0, false); w0 = __builtin_amdgcn_cvt_pk_fp8_f32(v0[2] * FP8_SA, v0[3] * FP8_SA, w0, true);
                    int w1 = __builtin_amdgcn_cvt_pk_fp8_f32(v1[0] * FP8_SA, v1[1] * FP8_SA, 0, false); w1 = __builtin_amdgcn_cvt_pk_fp8_f32(v1[2] * FP8_SA, v1[3] * FP8_SA, w1, true);
                    u32x2 w; w.x = (unsigned)w0; w.y = (unsigned)w1; *(u32x2*)(HN + off) = w; }
            }
            asm volatile("" ::: "memory");
        }
        asm volatile("s_waitcnt lgkmcnt(0)" ::: "memory"); __builtin_amdgcn_s_barrier(); asm volatile("" ::: "memory");
    }
};
struct Frame {
    LAS unsigned char* lds;
    unsigned* ctl;
    unsigned char* ws;
    int tid, lane, wave, vcu, G;
};
__device__ __forceinline__ float wave_sum(float v) {
#pragma unroll
    for (int o = 1; o < 64; o <<= 1) v += __shfl_xor(v, o);
    return v;
}

__device__ __forceinline__ void tr_block(const float* src, size_t pitch, bf16_t* dst, size_t kd, int kb, int nb, LAS unsigned* scr, int lane, bool rotperm = false) {
    const float* s0 = src + (size_t)(64 * kb) * pitch + 64 * nb + 4 * (lane & 15);
#pragma unroll
    for (int i = 0; i < 8; ++i) {
        const int kp = 4 * i + (lane >> 4);
        const f32x4 a = __builtin_nontemporal_load((const f32x4*)(s0 + (size_t)(2 * kp) * pitch)), b = __builtin_nontemporal_load((const f32x4*)(s0 + (size_t)(2 * kp + 1) * pitch));
#pragma unroll
        for (int j = 0; j < 4; ++j) scr[(4 * (lane & 15) + j) * 33 + kp] = cvt_pk_bf16(a[j], b[j]);
    }
    LDS_WAIT(); asm volatile("" ::: "memory");
    u32x4 o[8];
#pragma unroll
    for (int c = 0; c < 8; ++c) { const int r0 = 8 * c + (lane >> 3), rr = (rotperm && c < 2) ? (8 * ((r0 >> 2) & 1) + 4 * (r0 >> 3) + (r0 & 3)) : r0, q4 = 4 * (lane & 7); o[c].x = scr[rr * 33 + q4]; o[c].y = scr[rr * 33 + q4 + 1]; o[c].z = scr[rr * 33 + q4 + 2]; o[c].w = scr[rr * 33 + q4 + 3]; }
    bf16_t* d = dst + (size_t)(64 * nb + (lane >> 3)) * kd + 64 * kb + 8 * (lane & 7);
#pragma unroll
    for (int c = 0; c < 8; ++c) *(u32x4*)(d + (size_t)(8 * c) * kd) = o[c];
    LDS_WAIT(); asm volatile("" ::: "memory");
}
__device__ __forceinline__ void tr_block8(const float* src, size_t pitch, unsigned char* dst, size_t kd, int kb, int nb, float scale, LAS unsigned* scr, int lane, bool rotperm = false) {
    const float* s0 = src + (size_t)(128 * kb) * pitch + 64 * nb + 4 * (lane & 15);
#pragma unroll
    for (int i = 0; i < 8; ++i) {
        const int kq = 4 * i + (lane >> 4);
        const f32x4 r0 = __builtin_nontemporal_load((const f32x4*)(s0 + (size_t)(4 * kq) * pitch)) * scale, r1 = __builtin_nontemporal_load((const f32x4*)(s0 + (size_t)(4 * kq + 1) * pitch)) * scale,
                    r2 = __builtin_nontemporal_load((const f32x4*)(s0 + (size_t)(4 * kq + 2) * pitch)) * scale, r3 = __builtin_nontemporal_load((const f32x4*)(s0 + (size_t)(4 * kq + 3) * pitch)) * scale;
#pragma unroll
        for (int j = 0; j < 4; ++j) { int w = __builtin_amdgcn_cvt_pk_fp8_f32(r0[j], r1[j], 0, false); w = __builtin_amdgcn_cvt_pk_fp8_f32(r2[j], r3[j], w, true); scr[(4 * (lane & 15) + j) * 33 + kq] = (unsigned)w; }
    }
    LDS_WAIT(); asm volatile("" ::: "memory");
    u32x4 o[8];
#pragma unroll
    for (int c = 0; c < 8; ++c) { const int r0 = 8 * c + (lane >> 3), rr = (rotperm && c < 2) ? (8 * ((r0 >> 2) & 1) + 4 * (r0 >> 3) + (r0 & 3)) : r0, q4 = 4 * (lane & 7); o[c].x = scr[rr * 33 + q4]; o[c].y = scr[rr * 33 + q4 + 1]; o[c].z = scr[rr * 33 + q4 + 2]; o[c].w = scr[rr * 33 + q4 + 3]; }
    unsigned char* d = dst + (size_t)(64 * nb + (lane >> 3)) * kd + 128 * kb + 16 * (lane & 7);
#pragma unroll
    for (int c = 0; c < 8; ++c) *(u32x4*)(d + (size_t)(8 * c) * kd) = o[c];
    LDS_WAIT(); asm volatile("" ::: "memory");
}
constexpr int CONV_ITEMS = 24576;
struct ConvItem { const float* s0; size_t pitch; unsigned char* d; float scale; };
__device__ __forceinline__ ConvItem conv_desc(const float* wgu, const float* wd, unsigned char* ws, int v, int lane) {
    const int layer = v >= 12288; int r = v - layer * 12288; ConvItem it;
    if (r < 8192) { const int mat = layer * 32 + (r >> 8); r &= 255; const int kb = r >> 5, nb = r & 31; it.pitch = 2048; it.scale = FP8_SWGU;
        it.s0 = wgu + (size_t)mat * 1024 * 2048 + (size_t)(128 * kb) * 2048 + 64 * nb + 4 * (lane & 15); it.d = ws + WS_WGU + (size_t)mat * 2048 * 1024 + (size_t)(64 * nb + (lane >> 3)) * 1024 + 128 * kb + 16 * (lane & 7); }
    else { r -= 8192; const int mat = layer * 32 + (r >> 7); r &= 127; const int kb = r >> 4, nb = r & 15; it.pitch = 1024; it.scale = FP8_SWD;
        it.s0 = wd + (size_t)mat * 1024 * 1024 + (size_t)(128 * kb) * 1024 + 64 * nb + 4 * (lane & 15); it.d = ws + WS_WD + (size_t)mat * 1024 * 1024 + (size_t)(64 * nb + (lane >> 3)) * 1024 + 128 * kb + 16 * (lane & 7); }
    return it;
}
__device__ __forceinline__ void conv_items(Frame& F, const float* wgu, const float* wd, int v_lo, int v_hi, int cw, int ncw) {
    LAS unsigned* scr = (LAS unsigned*)(F.lds + RING_OFF + F.wave * 8448); unsigned char* ws = F.ws; const int lane = F.lane;
    int v = v_lo + cw; if (v >= v_hi) return;
    ConvItem cur = conv_desc(wgu, wd, ws, v, lane);
    f32x4 r[8][4];
#pragma unroll
    for (int i = 0; i < 8; ++i) { const int kq = 4 * i + (lane >> 4);
#pragma unroll
        for (int q = 0; q < 4; ++q) r[i][q] = __builtin_nontemporal_load((const f32x4*)(cur.s0 + (size_t)(4 * kq + q) * cur.pitch)); }
    for (;;) {
        const int vn = v + ncw; const bool has = vn < v_hi; ConvItem nx = cur; if (has) nx = conv_desc(wgu, wd, ws, vn, lane);
#pragma unroll
        for (int i = 0; i < 8; ++i) { const int kq = 4 * i + (lane >> 4);
#pragma unroll
            for (int j = 0; j < 4; ++j) { int w = __builtin_amdgcn_cvt_pk_fp8_f32(r[i][0][j] * cur.scale, r[i][1][j] * cur.scale, 0, false); w = __builtin_amdgcn_cvt_pk_fp8_f32(r[i][2][j] * cur.scale, r[i][3][j] * cur.scale, w, true); scr[(4 * (lane & 15) + j) * 33 + kq] = (unsigned)w; }
            if (has) {
#pragma unroll
                for (int q = 0; q < 4; ++q) r[i][q] = __builtin_nontemporal_load((const f32x4*)(nx.s0 + (size_t)(4 * kq + q) * nx.pitch)); } }
        LDS_WAIT(); asm volatile("" ::: "memory");
        u32x4 o[8];
#pragma unroll
        for (int c = 0; c < 8; ++c) { const int rr = 8 * c + (lane >> 3), q4 = 4 * (lane & 7); o[c].x = scr[rr * 33 + q4]; o[c].y = scr[rr * 33 + q4 + 1]; o[c].z = scr[rr * 33 + q4 + 2]; o[c].w = scr[rr * 33 + q4 + 3]; }
#pragma unroll
        for (int c = 0; c < 8; ++c) __builtin_nontemporal_store(o[c], (u32x4*)(cur.d + (size_t)(8 * c) * 1024));
        LDS_WAIT(); asm volatile("" ::: "memory");
        if (!has) break;
        v = vn; cur = nx;
    }
}
struct P0In { const float *x, *wqkv, *wo, *win, *wout, *rw, *wgu, *wd; const int* pos; };
__device__ __forceinline__ void p0_prologue(Frame& F, const P0In& I) {
    LAS unsigned* scr = (LAS unsigned*)(F.lds + RING_OFF + F.wave * 8448);
    const int gw = F.vcu * NWAVES + F.wave, NGW = F.G * NWAVES;
    unsigned char* ws = F.ws;
    constexpr int KB = 16;
    constexpr int I_QKV = 8 * 48, I_WO = 8 * 16, I_INA1 = 8 * 16, I_INA2 = 8 * 16, I_INB = 8 * 24, I_WOUT = 8 * 16;
    constexpr int I_SMALL = I_QKV + I_WO + I_INA1 + I_INA2 + I_INB + I_WOUT;
    constexpr int NITEMS = I_SMALL;
    for (int it = gw; it < NITEMS; it += NGW) {
        int r = it; const float* src; size_t pitch; bf16_t* dst; int nbl; const bool isqkv = it < I_QKV; bool f8 = false; float sc8 = FP8_SWIN;
        if (r < I_QKV) { src = I.wqkv; pitch = 3072; dst = (bf16_t*)(ws + WS_WQKV); nbl = 48; f8 = true; }
        else if ((r -= I_QKV) < I_WO) { src = I.wo; pitch = 1024; dst = (bf16_t*)(ws + WS_WO); nbl = 16; f8 = true; sc8 = FP8_SWD; }
        else if ((r -= I_WO) < I_INA1) { src = I.win; pitch = 3080; dst = (bf16_t*)(ws + WS_WINA); nbl = 16; f8 = true; }
        else if ((r -= I_INA1) < I_INA2) { src = I.win + 2048; pitch = 3080; dst = (bf16_t*)(ws + WS_WINA + (size_t)1024 * 1024); nbl = 16; f8 = true; }
        else if ((r -= I_INA2) < I_INB) { src = I.win + 512; pitch = 3080; dst = (bf16_t*)(ws + WS_WINB); nbl = 24; f8 = true; }
        else { r -= I_INB; src = I.wout; pitch = 1024; dst = (bf16_t*)(ws + WS_WOUT); nbl = 16; f8 = true; sc8 = FP8_SWD; }
        if (f8) tr_block8(src, pitch, (unsigned char*)dst, 1024, r / nbl, r % nbl, sc8, scr, F.lane, isqkv && (r % nbl) < 32);
        else tr_block(src, pitch, dst, 1024, r / nbl, r % nbl, scr, F.lane, isqkv && (r % nbl) < 32);
    }
    if (NCONV == 0) conv_items(F, I.wgu, I.wd, 0, CONV_ITEMS, gw, NGW);
    const int gt = F.vcu * NTHR + F.tid, NGT = F.G * NTHR;
    for (int i = gt; i < NTOK * DM / 8; i += NGT) { const f32x4 a = ((const f32x4*)I.x)[2 * i], b = ((const f32x4*)I.x)[2 * i + 1];
        u32x4 w; w.x = cvt_pk_bf16(a[0], a[1]); w.y = cvt_pk_bf16(a[2], a[3]); w.z = cvt_pk_bf16(b[0], b[1]); w.w = cvt_pk_bf16(b[2], b[3]); ((u32x4*)(ws + WS_XB))[i] = w;
        int w0 = __builtin_amdgcn_cvt_pk_fp8_f32(a[0] * FP8_SA, a[1] * FP8_SA, 0, false); w0 = __builtin_amdgcn_cvt_pk_fp8_f32(a[2] * FP8_SA, a[3] * FP8_SA, w0, true);
        int w1 = __builtin_amdgcn_cvt_pk_fp8_f32(b[0] * FP8_SA, b[1] * FP8_SA, 0, false); w1 = __builtin_amdgcn_cvt_pk_fp8_f32(b[2] * FP8_SA, b[3] * FP8_SA, w1, true);
        u32x2 w8; w8.x = (unsigned)w0; w8.y = (unsigned)w1; ((u32x2*)(ws + WS_X8))[i] = w8; }
    for (int i = gt; i < NTOK * 8; i += NGT) { const int tok = i >> 3, f = i & 7; const float inv = powf(500000.0f, -(float)f * 0.125f); const float ang = (float)I.pos[tok] * inv;
        float sn, cs; sincosf(ang, &sn, &cs); float* rp = (float*)(ws + WS_ROPE) + (size_t)tok * 16; rp[f] = cs; rp[8 + f] = sn; }
    for (int i = gt; i < 2 * 32 * 1024; i += NGT) { const int l = i >> 15, e = (i >> 10) & 31, k = i & 1023; ((float*)(ws + WS_RWT))[i] = I.rw[((size_t)l * 1024 + k) * 32 + e]; }
    for (int i = gt; i < 8 * 1024; i += NGT) { const int gidx = i >> 10, k = i & 1023; ((float*)(ws + WS_WG))[i] = I.win[(size_t)k * 3080 + 3072 + gidx]; }
}

__device__ __forceinline__ void phase_ln_router(Frame& F, const bf16_t* __restrict__ z, bf16_t* __restrict__ x1, const float* lng, const float* lnb, const float* rbias, int layer, int cset) {
    unsigned char* ws = F.ws;
    LAS f32x4* rwv = (LAS f32x4*)(F.lds + RING_OFF);
    LAS int* lcnt = (LAS int*)(F.lds + LX_LCNT); LAS int* gbase = (LAS int*)(F.lds + LX_GBASE); LAS int* rec = (LAS int*)(F.lds + LX_REC);
    LAS float* lgb = (LAS float*)(F.lds + LX_LNX);
    { const f32x4* src = (const f32x4*)((const float*)(ws + WS_RWT) + (size_t)layer * 32768);
      for (int i = F.tid; i < 8192; i += NTHR) { const int e = i >> 8, c = i & 255; rwv[e * 256 + (c ^ (e & 15))] = src[i]; } }
    int* toke = (int*)(ws + WS_TOKE); int* tokp = (int*)(ws + WS_TOKP); float* tokg = (float*)(ws + WS_TOKG);
    unsigned short* rowtok = (unsigned short*)(ws + WS_ROWTOK); unsigned char* xb8 = (unsigned char*)(ws + WS_XB);
    unsigned* cntg = F.ctl + CW_CNT + cset * 2048;
    const int lane = F.lane;
    for (int grp = F.vcu; grp < NTOK / 64; grp += F.G) {
        if (F.tid < 32) lcnt[F.tid] = 0;
        for (int i = F.tid; i < 1024; i += NTHR) { lgb[i] = lng[i]; lgb[1024 + i] = lnb[i]; }
        __syncthreads();
#pragma unroll 2
        for (int tk = 0; tk < 8; tk += 2) {
            const int token0 = grp * 64 + F.wave * 8 + tk;
            f32x4 v[2][4]; float s[2] = {0.f, 0.f};
#pragma unroll
            for (int u = 0; u < 2; ++u)
#pragma unroll
                for (int j = 0; j < 4; ++j) { const u32x2 zz = *(const u32x2*)(z + (size_t)(token0 + u) * DM + 4 * lane + 256 * j); v[u][j] = (f32x4){bflo(zz.x), bfhi(zz.x), bflo(zz.y), bfhi(zz.y)}; s[u] += (v[u][j][0] + v[u][j][1]) + (v[u][j][2] + v[u][j][3]); }
#pragma unroll
            for (int o = 1; o < 64; o <<= 1) { const float a0 = __shfl_xor(s[0], o), a1 = __shfl_xor(s[1], o); s[0] += a0; s[1] += a1; }
            float s2[2] = {0.f, 0.f};
#pragma unroll
            for (int u = 0; u < 2; ++u) { const float mean = s[u] * (1.0f / DM);
#pragma unroll
                for (int j = 0; j < 4; ++j) { v[u][j] = v[u][j] - mean; s2[u] += (v[u][j][0] * v[u][j][0] + v[u][j][1] * v[u][j][1]) + (v[u][j][2] * v[u][j][2] + v[u][j][3] * v[u][j][3]); } }
#pragma unroll
            for (int o = 1; o < 64; o <<= 1) { const float a0 = __shfl_xor(s2[0], o), a1 = __shfl_xor(s2[1], o); s2[0] += a0; s2[1] += a1; }
#pragma unroll
            for (int u = 0; u < 2; ++u) { const float rstd = 1.0f / sqrtf(s2[u] * (1.0f / DM) + LN_EPS); const int token = token0 + u;
#pragma unroll
                for (int j = 0; j < 4; ++j) { const f32x4 gvj = *(const LAS f32x4*)(lgb + 4 * lane + 256 * j), bvj = *(const LAS f32x4*)(lgb + 1024 + 4 * lane + 256 * j);
                    const f32x4 y = v[u][j] * rstd * gvj + bvj; { u32x2 wb; wb.x = cvt_pk_bf16(y[0], y[1]); wb.y = cvt_pk_bf16(y[2], y[3]); *(u32x2*)(x1 + (size_t)token * DM + 4 * lane + 256 * j) = wb; }
                    int w8 = __builtin_amdgcn_cvt_pk_fp8_f32(y[0] * FP8_SA, y[1] * FP8_SA, 0, false); w8 = __builtin_amdgcn_cvt_pk_fp8_f32(y[2] * FP8_SA, y[3] * FP8_SA, w8, true);
                    *(int*)(xb8 + (size_t)token * DM + 4 * lane + 256 * j) = w8; } }
        }
        VM_WAIT(); __syncthreads();
        const int tg = F.wave & 3, kh = F.wave >> 2, e0 = lane & 15, kq = lane >> 4;
        f32x4 acc0 = {0.f, 0.f, 0.f, 0.f}, acc1 = acc0;
        { const bf16_t* arow = x1 + (size_t)(grp * 64 + tg * 16 + e0) * DM + kh * 512 + 4 * kq;
#pragma unroll 4
          for (int blk = 0; blk < 32; ++blk) {
              const u32x2 ab = *(const u32x2*)(arow + blk * 16); const f32x4 a4 = {bflo(ab.x), bfhi(ab.x), bflo(ab.y), bfhi(ab.y)}; const int c = ((kh * 512 + blk * 16) >> 2) + kq;
              const f32x4 b0 = rwv[e0 * 256 + (c ^ e0)], b1 = rwv[(16 + e0) * 256 + (c ^ e0)];
#pragma unroll
              for (int j = 0; j < 4; ++j) { acc0 = __builtin_amdgcn_mfma_f32_16x16x4f32(a4[j], b0[j], acc0, 0, 0, 0); acc1 = __builtin_amdgcn_mfma_f32_16x16x4f32(a4[j], b1[j], acc1, 0, 0, 0); } } }
        __syncthreads();
        if (kh == 1) { ((LAS f32x4*)lgb)[(tg * 2 + 0) * 64 + lane] = acc0; ((LAS f32x4*)lgb)[(tg * 2 + 1) * 64 + lane] = acc1; }
        __syncthreads();
        if (kh == 0) {
            acc0 = acc0 + ((LAS f32x4*)lgb)[(tg * 2 + 0) * 64 + lane]; acc1 = acc1 + ((LAS f32x4*)lgb)[(tg * 2 + 1) * 64 + lane];
            const float rb0 = rbias[e0], rb1 = rbias[16 + e0];
#pragma unroll
            for (int r = 0; r < 4; ++r) {
                float l0 = acc0[r] + rb0, l1 = acc1[r] + rb1; float tv[4]; int te[4];
#pragma unroll
                for (int k = 0; k < 4; ++k) { float bvv = (l1 > l0) ? l1 : l0; int be = (l1 > l0) ? 16 + e0 : e0;
#pragma unroll
                    for (int o = 1; o < 16; o <<= 1) { const float ov = __shfl_xor(bvv, o); const int oe = __shfl_xor(be, o); const bool take = (ov > bvv) || (ov == bvv && oe < be); bvv = take ? ov : bvv; be = take ? oe : be; }
                    tv[k] = bvv; te[k] = be; if (be == e0) l0 = -INFINITY; if (be == 16 + e0) l1 = -INFINITY; }
                const float w0 = 1.0f, w1 = __expf(tv[1] - tv[0]), w2 = __expf(tv[2] - tv[0]), w3 = __expf(tv[3] - tv[0]); const float wi = 1.0f / (w0 + w1 + w2 + w3);
                if (e0 < 4) {
                    const int tl = tg * 16 + 4 * kq + r, token = grp * 64 + tl;
                    const int ek = (e0 == 0) ? te[0] : (e0 == 1) ? te[1] : (e0 == 2) ? te[2] : te[3];
                    const float wk = (e0 == 0) ? w0 : (e0 == 1) ? w1 : (e0 == 2) ? w2 : w3;
                    const int li = atomicAdd((int*)(lcnt + ek), 1); rec[tl * 8 + e0] = ek; rec[tl * 8 + 4 + e0] = li;
                    toke[token * 4 + e0] = ek; tokg[token * 4 + e0] = wk * wi;
                }
            }
        }
        __syncthreads();
        if (F.tid < 32) gbase[F.tid] = (int)__hip_atomic_fetch_add(cntg + F.tid * 64, (unsigned)lcnt[F.tid], RLX_AGENT);
        __syncthreads();
        if (F.tid < 256) { const int tl = F.tid >> 2, k = F.tid & 3; const int token = grp * 64 + tl; const int e = rec[tl * 8 + k]; const int pos = gbase[e] + rec[tl * 8 + 4 + k];
            tokp[token * 4 + k] = pos; rowtok[(size_t)e * NTOK + pos] = (unsigned short)token; }
        __syncthreads();
    }
}

__device__ __forceinline__ int moe_tables(Frame& F, int layer) {
    LAS int* tile_e = (LAS int*)(F.lds + LX_TILEE); LAS int* tbase = (LAS int*)(F.lds + LX_TBASE);
    if (F.tid < 64) {
        const int e = F.lane & 31; const int c = (int)__hip_atomic_load(F.ctl + CW_CNT + layer * 2048 + e * 64, RLX_AGENT); const int nt = (F.lane < 32) ? ((c + 255) >> 8) : 0;
        int inc = nt;
#pragma unroll
        for (int o = 1; o < 32; o <<= 1) { const int up = __shfl_up(inc, o); if (F.lane >= o) inc += up; }
        const int t0 = inc - nt;
        if (F.lane < 32) { tbase[e] = t0; for (int i = 0; i < nt; ++i) tile_e[t0 + i] = e; }
        if (F.lane == 31) tbase[32] = inc;
    }
    __syncthreads();
    return tbase[32];
}

template <bool NEXT_MLSTM>
__device__ __forceinline__ void phase_combine(Frame& F, const bf16_t* __restrict__ x1, float* __restrict__ out, const float* lng, const float* lnb, const float* bgates, int layer) {
    unsigned char* ws = F.ws;
    (void)moe_tables(F, layer);
    const LAS int* tbase = (const LAS int*)(F.lds + LX_TBASE);
    const int* toke = (const int*)(ws + WS_TOKE); const int* tokp = (const int*)(ws + WS_TOKP); const float* tokg = (const float*)(ws + WS_TOKG);
    const unsigned char* Y = (const unsigned char*)(ws + WS_Y); bf16_t* xb = (bf16_t*)(ws + WS_XB);
    LAS float* wg = (LAS float*)(F.lds + RING_OFF);
    LAS float* lgb = wg + 8192;
    if constexpr (NEXT_MLSTM) { const f32x4* src = (const f32x4*)(ws + WS_WG); for (int i = F.tid; i < 2048; i += NTHR) ((LAS f32x4*)wg)[i] = src[i];
        for (int i = F.tid; i < 1024; i += NTHR) { lgb[i] = lng[i]; lgb[1024 + i] = lnb[i]; } __syncthreads(); }
    const int lane = F.lane; const int gw = F.vcu * NWAVES + F.wave, NGW = F.G * NWAVES;
    f32x4 gv[4], bv[4];
    if constexpr (!NEXT_MLSTM) {
#pragma unroll
        for (int j = 0; j < 4; ++j) { gv[j] = *(const f32x4*)(lng + 4 * lane + 256 * j); bv[j] = *(const f32x4*)(lnb + 4 * lane + 256 * j); } }
    constexpr int NTK = 2;
    int rowv = 0; float gatev = 0.f;
    { const int mt = gw + (lane >> 2) * NGW; if (mt < NTOK) { const int ee = toke[mt * 4 + (lane & 3)]; rowv = tbase[ee] * 256 + tokp[mt * 4 + (lane & 3)]; gatev = tokg[mt * 4 + (lane & 3)] * (DBG_MOE_MUL / FP8_SY); } }
    int it = 0;
    for (int token0 = gw; token0 < NTOK; token0 += NTK * NGW, ++it) {
        f32x4 vv[NTK][4];
#pragma unroll
        for (int u = 0; u < NTK; ++u) { const int token = token0 + u * NGW; if (token < NTOK) {
#pragma unroll
            for (int j = 0; j < 4; ++j) { const u32x2 xx = *(const u32x2*)(x1 + (size_t)token * DM + 4 * lane + 256 * j); vv[u][j] = (f32x4){bflo(xx.x), bfhi(xx.x), bflo(xx.y), bfhi(xx.y)} * ALPHA; }
#pragma unroll
            for (int k = 0; k < 4; ++k) { const int sl = (it * NTK + u) * 4 + k; const size_t row = (size_t)__builtin_amdgcn_readlane(rowv, sl); const float gt = __int_as_float(__builtin_amdgcn_readlane(__float_as_int(gatev), sl));
#pragma unroll
                for (int j = 0; j < 4; ++j) { const int y = *(const int*)(Y + row * DM + 4 * lane + 256 * j); const f32x2 lo = __builtin_amdgcn_cvt_pk_f32_fp8(y, false), hi = __builtin_amdgcn_cvt_pk_f32_fp8(y, true);
                    vv[u][j][0] += gt * lo[0]; vv[u][j][1] += gt * lo[1]; vv[u][j][2] += gt * hi[0]; vv[u][j][3] += gt * hi[1]; } } } }
#pragma unroll
        for (int u = 0; u < NTK; ++u) { const int token = token0 + u * NGW; if (token < NTOK) {
        f32x4 v[4];
#pragma unroll
        for (int j = 0; j < 4; ++j) v[j] = vv[u][j];
        float s = 0.f;
#pragma unroll
        for (int j = 0; j < 4; ++j) s += (v[j][0] + v[j][1]) + (v[j][2] + v[j][3]);
        const float mean = wave_sum(s) * (1.0f / DM); float s2 = 0.f;
#pragma unroll
        for (int j = 0; j < 4; ++j) { v[j] = v[j] - mean; s2 += (v[j][0] * v[j][0] + v[j][1] * v[j][1]) + (v[j][2] * v[j][2] + v[j][3] * v[j][3]); }
        const float rstd = 1.0f / sqrtf(wave_sum(s2) * (1.0f / DM) + LN_EPS);
#pragma unroll
        for (int j = 0; j < 4; ++j) { if constexpr (NEXT_MLSTM) { gv[j] = *(const LAS f32x4*)(lgb + 4 * lane + 256 * j); bv[j] = *(const LAS f32x4*)(lgb + 1024 + 4 * lane + 256 * j); }
            v[j] = v[j] * rstd * gv[j] + bv[j]; if constexpr (!NEXT_MLSTM) *(f32x4*)(out + (size_t)token * DM + 4 * lane + 256 * j) = v[j]; }
        if constexpr (NEXT_MLSTM) {
#pragma unroll
            for (int j = 0; j < 4; ++j) { u32x2 w; w.x = cvt_pk_bf16(v[j][0], v[j][1]); w.y = cvt_pk_bf16(v[j][2], v[j][3]); *(u32x2*)(xb + (size_t)token * DM + 4 * lane + 256 * j) = w;
                int w8 = __builtin_amdgcn_cvt_pk_fp8_f32(v[j][0] * FP8_SA, v[j][1] * FP8_SA, 0, false); w8 = __builtin_amdgcn_cvt_pk_fp8_f32(v[j][2] * FP8_SA, v[j][3] * FP8_SA, w8, true);
                *(int*)(ws + WS_X8 + (size_t)token * DM + 4 * lane + 256 * j) = w8; }
            float gp[8];
#pragma unroll
            for (int gi = 0; gi < 8; ++gi) { float a = 0.f;
#pragma unroll
                for (int j = 0; j < 4; ++j) { const f32x4 w = *(const LAS f32x4*)(wg + gi * 1024 + 4 * lane + 256 * j); a += (v[j][0] * w[0] + v[j][1] * w[1]) + (v[j][2] * w[2] + v[j][3] * w[3]); }
                gp[gi] = a; if (gi & 1) asm volatile("" ::: "memory"); }
#pragma unroll
            for (int o = 1; o < 64; o <<= 1) {
#pragma unroll
                for (int gi = 0; gi < 8; ++gi) gp[gi] += __shfl_xor(gp[gi], o); }
#pragma unroll
            for (int gi = 0; gi < 8; ++gi) gp[gi] += bgates[gi];
            if (lane == 0) {
#pragma unroll
                for (int hh = 0; hh < 4; ++hh) { ((float*)(ws + WS_GI))[(size_t)hh * NTOK + token] = gp[hh];
                    const float f = gp[4 + hh]; const float lf = (f >= 0.f) ? -log1pf(__expf(-f)) : (f - log1pf(__expf(f)));
                    ((float*)(ws + WS_LF))[(size_t)hh * NTOK + token] = lf; } }
        }
        } }
    }
}

__device__ __forceinline__ void phase_gate_scan(Frame& F) {
    unsigned char* ws = F.ws; const int lane = F.lane; const int gw = F.vcu * NWAVES + F.wave, NGW = F.G * NWAVES;
    for (int mu = gw; mu < 256; mu += NGW) {
        const int b = mu >> 6, hh = (mu >> 4) & 3, ch = mu & 15; const size_t base = (size_t)hh * NTOK + (size_t)b * SEQ + ch * 256 + 4 * lane;
        const f32x4 lf = *(const f32x4*)((const float*)(ws + WS_LF) + base), gi = *(const f32x4*)((const float*)(ws + WS_GI) + base);
        f32x4 c; c[0] = lf[0]; c[1] = c[0] + lf[1]; c[2] = c[1] + lf[2]; c[3] = c[2] + lf[3];
        float tot = c[3];
#pragma unroll
        for (int o = 1; o < 64; o <<= 1) { const float up = __shfl_up(tot, o); if (lane >= o) tot += up; }
        const float excl = tot - c[3];
        f32x4 rf, cf;
#pragma unroll
        for (int j = 0; j < 4; ++j) { const float bt = excl + c[j]; rf[j] = __expf(bt); cf[j] = __expf(gi[j] - bt); }
        *(f32x4*)((float*)(ws + WS_RF) + base) = rf; *(f32x4*)((float*)(ws + WS_CF) + base) = cf;
        if (lane == 63) ((float*)(ws + WS_DEC))[mu] = __expf(tot);
    }
}
__device__ __forceinline__ void phase_nu(Frame& F) {
    unsigned char* ws = F.ws; const int lane = F.lane; const int gw = F.vcu * NWAVES + F.wave, NGW = F.G * NWAVES;
    const bf16_t* KT = (const bf16_t*)(ws + WS_KT); float* NU = (float*)(ws + WS_NU);
    for (int r0 = gw * 16; r0 < 256 * 128; r0 += NGW * 16) {
        const int mu = r0 >> 7, d0 = r0 & 127, b = mu >> 6, hh = (mu >> 4) & 3, ch = mu & 15;
        const bf16_t* base = KT + (size_t)(hh * 128 + d0) * NTOK + (size_t)b * SEQ + ch * 256 + 4 * lane;
        u32x2 kv[16];
#pragma unroll
        for (int i = 0; i < 16; ++i) kv[i] = *(const u32x2*)(base + (size_t)i * NTOK);
        float s[16];
#pragma unroll
        for (int i = 0; i < 16; ++i) s[i] = (bflo(kv[i].x) + bfhi(kv[i].x)) + (bflo(kv[i].y) + bfhi(kv[i].y));
#pragma unroll
        for (int o = 1; o < 64; o <<= 1) {
#pragma unroll
            for (int i = 0; i < 16; ++i) s[i] += __shfl_xor(s[i], o); }
        float mine = s[0];
#pragma unroll
        for (int i = 1; i < 16; ++i) mine = (lane == i) ? s[i] : mine;
        if (lane < 16) NU[r0 + lane] = mine;
    }
}
__device__ __forceinline__ void phase_state_scan(Frame& F) {
    unsigned char* ws = F.ws; const int gt = F.vcu * NTHR + F.tid, NGT = F.G * NTHR;
    const bf16_t* UT = (const bf16_t*)(ws + WS_UT); const float* DEC = (const float*)(ws + WS_DEC); bf16_t* BE = (bf16_t*)(ws + WS_BE);
    for (int i = gt; i < 16 * 256 * 32; i += NGT) { const int bh = i >> 13, e = (i >> 5) & 255, dg = i & 31;
        f32x4 U[16]; float dc[16];
#pragma unroll
        for (int ch = 0; ch < 16; ++ch) { const size_t mu = (size_t)bh * 16 + ch; { const u32x2 uu = *(const u32x2*)(UT + (mu * 256 + e) * 128 + 4 * dg); U[ch] = (f32x4){bflo(uu.x), bfhi(uu.x), bflo(uu.y), bfhi(uu.y)}; } dc[ch] = DEC[mu]; }
        f32x4 C = {0.f, 0.f, 0.f, 0.f};
#pragma unroll
        for (int ch = 0; ch < 16; ++ch) { const size_t mu = (size_t)bh * 16 + ch;
            u32x2 w; w.x = cvt_pk_bf16(C[0], C[1]); w.y = cvt_pk_bf16(C[2], C[3]);
#ifdef DBG_NO_INTER
            w.x = 0u; w.y = 0u;
#endif
            *(u32x2*)(BE + (mu * 256 + e) * 384 + 256 + 4 * dg) = w;
            C = (C + U[ch]) * dc[ch]; } }
    const float* NU = (const float*)(ws + WS_NU); float* NP = (float*)(ws + WS_NPREV);
    for (int i = gt; i < 16 * 128; i += NGT) { const int bh = i >> 7, d = i & 127; float n = 0.f;
        for (int ch = 0; ch < 16; ++ch) { const int mu = bh * 16 + ch; NP[mu * 128 + d] = n; n = (n + NU[mu * 128 + d]) * DEC[mu];
#ifdef DBG_NO_INTER
            n = 0.f;
#endif
        } }
}
struct Args { const float* in[18]; float* out; unsigned char* ws; int ph_lo, ph_hi; };
__global__ void __launch_bounds__(NTHR, 2) mk_fwd(Args args) {
    extern __shared__ __attribute__((aligned(16))) unsigned char lds[];
    Frame F;
    const char __attribute__((address_space(4)))* kargp = (const char __attribute__((address_space(4)))*)__builtin_amdgcn_kernarg_segment_ptr();
#define AIN(i) ({ const char __attribute__((address_space(4)))* k_ = kargp; asm volatile("" : "+s"(k_)); *(const float* const __attribute__((address_space(4)))*)(k_ + 8 * (i)); })
    unsigned char* const ws0 = (unsigned char*)AIN(19);
    F.lds = (LAS unsigned char*)lds; F.ws = ws0; F.ctl = (unsigned*)(ws0 + WS_CTL);
    F.tid = threadIdx.x; F.lane = F.tid & 63; F.wave = __builtin_amdgcn_readfirstlane(F.tid >> 6);
    F.G = gridDim.x; { const int bx = blockIdx.x; F.vcu = (F.G % 8 == 0) ? (bx % 8) * (F.G / 8) + bx / 8 : bx; }
    for (int u = F.tid; u < (LDS_BYTES - LX) / 4; u += NTHR) ((LAS unsigned*)(F.lds + LX))[u] = 0u;
    __syncthreads();
    int lo, hi; { const char __attribute__((address_space(4)))* k_ = kargp; lo = *(const int __attribute__((address_space(4)))*)(k_ + 160); hi = *(const int __attribute__((address_space(4)))*)(k_ + 164); }
    XcdBarrier bar; bar.bar = (unsigned*)(F.ctl + CW_BAR); bar.x = 0; bar.st = nullptr;
    if (hi - lo > 1) bar = xcd_barrier_post((unsigned*)(F.ctl + CW_BAR), (volatile LAS unsigned*)(F.lds + LX_MISC) + 8);
#ifndef PHASE_MASK
#define PHASE_MASK 0x7FFFF
#endif
#define IN(k) ((((PHASE_MASK) >> (k)) & 1) && lo <= (k) && (k) < hi)
#ifndef REPEAT_MASK
#define REPEAT_MASK 0
#endif
#define PH(k) if (IN(k))
#define SEAM(k) do { if (IN(k) && IN((k) + 1)) xcd_barrier(bar); } while (0)
    unsigned char* ws = ws0;
#define x_in AIN(0)
#define ln_mix_g AIN(8)
#define ln_mix_b AIN(9)
#define ln_ffn_g AIN(10)
#define ln_ffn_b AIN(11)
#define router_b AIN(13)
#define b_gu AIN(15)
#define b_dn AIN(17)
    bf16_t* XB = (bf16_t*)(ws + WS_XB); bf16_t* QB_ = (bf16_t*)(ws + WS_Q); bf16_t* KB_ = (bf16_t*)(ws + WS_K); bf16_t* VB_ = (bf16_t*)(ws + WS_V);
    bf16_t* R0 = (bf16_t*)(ws + WS_R0); bf16_t* R1 = (bf16_t*)(ws + WS_R1);
    bf16_t* HB = (bf16_t*)(ws + WS_H); bf16_t* YB = (bf16_t*)(ws + WS_Y);
    LAS unsigned char* ring = F.lds + RING_OFF;
    const int cG = (int)blockIdx.x;
    const bool isConv = (NCONV > 0) && ((int)blockIdx.x >= F.G - NCONV);
    const int Gc = F.G - NCONV, cwv = ((int)blockIdx.x - Gc) * NWAVES + F.wave, ncw = NCONV * NWAVES;
#define CONV_SLICE(a, b) conv_items(F, AIN(14), AIN(16), (int)((long)CONV_ITEMS * (a) / 1000), (int)((long)CONV_ITEMS * (b) / 1000), cwv, ncw)

    PH(0) { P0In I{x_in, AIN(2), AIN(3), AIN(4), AIN(7), AIN(12), AIN(14), AIN(16), (const int*)AIN(1)}; p0_prologue(F, I); }
    SEAM(0);
    PH(1) { { Gemm g{512, 512, 512, nullptr}; DenseSched S{64, 12, F.G, cG, (const char*)(ws + WS_X8), (const char*)(ws + WS_WQKV), (size_t)256 * 1024, (size_t)256 * 1024};
        EpiQKV E{QB_, KB_, VB_, (const float*)(ws + WS_ROPE), (float*)(ws + WS_KSUM), (LAS float*)(F.lds + LX_ROPE)};
        pg8::gemm_phase<EpiQKV, DenseSched, true, false, true>(ring, g, S, E); } }
    SEAM(1);
    PH(2) { if (isConv) CONV_SLICE(0, 1000); else {
        const attn_body::AttnTensors AT{(const attn_body::bf16*)QB_, (const attn_body::bf16*)KB_, (const attn_body::bf16*)VB_, (unsigned char*)(ws + WS_O8), (const float*)(ws + WS_KSUM)};
        if (NCONV == 0) { const attn_body::StaticOrder S((int)F.G, (int)blockIdx.x); attn_body::attn_phase<attn_body::StaticOrder>((char*)lds + RING_OFF, AT, S); }
        else { const attn_body::SnakeOrder S{cG, Gc}; attn_body::attn_phase<attn_body::SnakeOrder>((char*)lds + RING_OFF, AT, S); } } }
    SEAM(2);
    PH(3) { { Gemm g{512, 512, 512, nullptr}; DenseSched S{64, 4, F.G, cG, (const char*)(ws + WS_O8), (const char*)(ws + WS_WO), (size_t)256 * 1024, (size_t)256 * 1024};
        EpiZ E{XB, R0, DBG_ATTN_MUL / (FP8_SA * FP8_SWD)}; pg8::gemm_phase<EpiZ, DenseSched, true, false, true>(ring, g, S, E); } }
    SEAM(3);
    PH(4) phase_ln_router(F, R0, R1, ln_mix_g, ln_mix_b, router_b, 0, 0);
    SEAM(4);
    PH(5) { const int nT = moe_tables(F, 0); LAS unsigned short* tokl = (LAS unsigned short*)(F.lds + LX_TOKL);
        { const unsigned short* rowtok = (const unsigned short*)(ws + WS_ROWTOK); const LAS int* tile_e = (const LAS int*)(F.lds + LX_TILEE); const LAS int* tbase = (const LAS int*)(F.lds + LX_TBASE);
          for (int i = 0; i < TOKL_ROUNDS; ++i) { int pm, pn, hf; if (!moe_unit(i, F.G, cG, nT, 8, pm, pn, hf)) break;
              if (F.tid < 256) { const int e = tile_e[pm]; const int r = (pm - tbase[e]) * 256 + F.tid; const int c = (int)__hip_atomic_load(F.ctl + CW_CNT + 0 * 2048 + e * 64, RLX_AGENT);
                  tokl[i * 256 + F.tid] = (r < c) ? rowtok[(size_t)e * NTOK + r] : (unsigned short)0; } }
          __syncthreads(); }
        Gemm g{512, 512, 512, (const char*)XB};
        MoeSched S{nT, 8, F.G, cG, (const LAS int*)(F.lds + LX_TILEE), (const LAS int*)(F.lds + LX_TBASE), tokl, nullptr, (const char*)(ws + WS_WGU) + (size_t)0 * 32 * 2048 * 1024, 0, (size_t)2048 * 1024, (size_t)256 * 1024};
        EpiGU E{b_gu + (size_t)0 * 32 * 2048, (unsigned char*)HB, (LAS float*)(F.lds + LX_BIAS), 0}; pg8::gemm_phase<EpiGU, MoeSched, true, true, true, true>(ring, g, S, E); }
    SEAM(5);
    PH(6) { const int nT = moe_tables(F, 0); Gemm g{512, 512, 512, nullptr};
        MoeSched S{nT, 4, F.G, cG, (const LAS int*)(F.lds + LX_TILEE), (const LAS int*)(F.lds + LX_TBASE), nullptr, (const char*)HB, (const char*)(ws + WS_WD) + (size_t)0 * 32 * 1024 * 1024, (size_t)256 * 1024, (size_t)1024 * 1024, (size_t)256 * 1024};
        EpiDN E{b_dn + (size_t)0 * 32 * 1024, (unsigned char*)YB, (LAS float*)(F.lds + LX_BIAS), 0}; pg8::gemm_phase<EpiDN, MoeSched, true, false, true, true>(ring, g, S, E); }
    SEAM(6);
    PH(7) phase_combine<true>(F, R1, nullptr, ln_ffn_g, ln_ffn_b, AIN(5), 0);
    { F.lane = (int)attn_body::lane_now(); F.tid = F.wave * 64 + F.lane; }
    SEAM(7);
    PH(8) phase_gate_scan(F);
    SEAM(8);
    PH(9) {
        { Gemm g{512, 512, 512, nullptr}; DenseSched S{64, 8, F.G, cG, (const char*)(ws + WS_X8), (const char*)(ws + WS_WINA), (size_t)256 * 1024, (size_t)256 * 1024};
          EpiINA E{(const float*)(ws + WS_RF), (const float*)(ws + WS_CF), (bf16_t*)(ws + WS_AE), (bf16_t*)(ws + WS_KN), (bf16_t*)(ws + WS_OS)};
          pg8::gemm_phase<EpiINA, DenseSched, true, false, true>(ring, g, S, E); }
        { Gemm g{512, 512, 512, nullptr}; DenseSched S{6, 64, F.G, cG, (const char*)(ws + WS_WINB), (const char*)(ws + WS_X8), (size_t)256 * 1024, (size_t)256 * 1024, true};
          EpiINB E{(const float*)(ws + WS_CF), (bf16_t*)(ws + WS_KT), (bf16_t*)(ws + WS_BE)};
          pg8::gemm_phase<EpiINB, DenseSched, true, false, true, true>(ring, g, S, E); }
    }
    SEAM(9);
    PH(10) { Gemm g{256, 384, NTOK, nullptr}; MuSched S{F.G, cG, 0, (const char*)(ws + WS_BE), (const char*)(ws + WS_KT)};
        EpiM1 E{(bf16_t*)(ws + WS_UT)}; pg8::gemm_phase<EpiM1, MuSched, true, false, false, true>(ring, g, S, E);
        phase_nu(F); }
    SEAM(10);
    PH(11) phase_state_scan(F);
    SEAM(11);
    PH(12) { Gemm g{128, 512, 1024, nullptr}; MuSched S{F.G, cG, 1, (const char*)(ws + WS_AE), (const char*)(ws + WS_KN)};
        EpiM2A E{(bf16_t*)(ws + WS_AE), (const float*)(ws + WS_NPREV), (float*)(ws + WS_DEN)}; pg8::gemm_phase<EpiM2A, MuSched, true, false>(ring, g, S, E); }
    SEAM(12);
    PH(13) { Gemm g{384, 512, 384, nullptr}; MuSched S{F.G, cG, 2, (const char*)(ws + WS_AE), (const char*)(ws + WS_BE)};
        EpiM2B E{(const float*)(ws + WS_DEN), AIN(6), (const bf16_t*)(ws + WS_OS), (unsigned char*)(ws + WS_HN), (LAS float*)(F.lds + LX_LNX)};
        pg8::gemm_phase<EpiM2B, MuSched, true, false>(ring, g, S, E); }
    SEAM(13);
    PH(14) { Gemm g{512, 512, 512, nullptr}; DenseSched S{64, 4, F.G, cG, (const char*)(ws + DBG_P14_A), (const char*)(ws + WS_WOUT), (size_t)256 * 1024, (size_t)256 * 1024};
        EpiZ E{XB, R0, DBG_MLSTM_MUL / (FP8_SA * FP8_SWD)}; pg8::gemm_phase<EpiZ, DenseSched, true, false, true>(ring, g, S, E); }
    SEAM(14);
    PH(15) phase_ln_router(F, R0, R1, ln_mix_g + 1024, ln_mix_b + 1024, router_b + 32, 1, 1);
    SEAM(15);
    PH(16) { const int nT = moe_tables(F, 1); LAS unsigned short* tokl = (LAS unsigned short*)(F.lds + LX_TOKL);
        { const unsigned short* rowtok = (const unsigned short*)(ws + WS_ROWTOK); const LAS int* tile_e = (const LAS int*)(F.lds + LX_TILEE); const LAS int* tbase = (const LAS int*)(F.lds + LX_TBASE);
          for (int i = 0; i < TOKL_ROUNDS; ++i) { int pm, pn, hf; if (!moe_unit(i, F.G, cG, nT, 8, pm, pn, hf)) break;
              if (F.tid < 256) { const int e = tile_e[pm]; const int r = (pm - tbase[e]) * 256 + F.tid; const int c = (int)__hip_atomic_load(F.ctl + CW_CNT + 1 * 2048 + e * 64, RLX_AGENT);
                  tokl[i * 256 + F.tid] = (r < c) ? rowtok[(size_t)e * NTOK + r] : (unsigned short)0; } }
          __syncthreads(); }
        Gemm g{512, 512, 512, (const char*)XB};
        MoeSched S{nT, 8, F.G, cG, (const LAS int*)(F.lds + LX_TILEE), (const LAS int*)(F.lds + LX_TBASE), tokl, nullptr, (const char*)(ws + WS_WGU) + (size_t)1 * 32 * 2048 * 1024, 0, (size_t)2048 * 1024, (size_t)256 * 1024};
        EpiGU E{b_gu + (size_t)1 * 32 * 2048, (unsigned char*)HB, (LAS float*)(F.lds + LX_BIAS), 0}; pg8::gemm_phase<EpiGU, MoeSched, true, true, true, true>(ring, g, S, E); }
    SEAM(16);
    PH(17) { const int nT = moe_tables(F, 1); Gemm g{512, 512, 512, nullptr};
        MoeSched S{nT, 4, F.G, cG, (const LAS int*)(F.lds + LX_TILEE), (const LAS int*)(F.lds + LX_TBASE), nullptr, (const char*)HB, (const char*)(ws + WS_WD) + (size_t)1 * 32 * 1024 * 1024, (size_t)256 * 1024, (size_t)1024 * 1024, (size_t)256 * 1024};
        EpiDN E{b_dn + (size_t)1 * 32 * 1024, (unsigned char*)YB, (LAS float*)(F.lds + LX_BIAS), 0}; pg8::gemm_phase<EpiDN, MoeSched, true, false, true, true>(ring, g, S, E); }
    SEAM(17);
    PH(18) phase_combine<false>(F, R1, (float*)AIN(18), ln_ffn_g + 1024, ln_ffn_b + 1024, nullptr, 1);
#undef IN
#undef CONV_SLICE
#undef AIN
#undef x_in
#undef ln_mix_g
#undef ln_mix_b
#undef ln_ffn_g
#undef ln_ffn_b
#undef router_b
#undef b_gu
#undef b_dn
#undef SEAM
}

extern "C" void kernel_launch(void* const* d_in, const int* in_sizes, int n_in, void* d_out, int out_size, void* d_ws, size_t ws_size, hipStream_t stream) {
    static int grid = 0;
    if (grid == 0) {
        if (n_in != 18 || out_size != NTOK * DM || ws_size < WS_END) { fprintf(stderr, "kernel_launch: unexpected problem shape (n_in %d, out %d, ws %zu)\n", n_in, out_size, ws_size); grid = -1; return; }
        int dev = 0, cus = 0, per_cu = 0;
        if (hipGetDevice(&dev) != hipSuccess || hipDeviceGetAttribute(&cus, hipDeviceAttributeMultiprocessorCount, dev) != hipSuccess) { grid = -1; return; }
        if (hipFuncSetAttribute((const void*)mk_fwd, hipFuncAttributeMaxDynamicSharedMemorySize, LDS_BYTES) != hipSuccess) { fprintf(stderr, "kernel_launch: hipFuncSetAttribute failed\n"); grid = -1; return; }
        if (hipOccupancyMaxActiveBlocksPerMultiprocessor(&per_cu, (const void*)mk_fwd, NTHR, LDS_BYTES) != hipSuccess || per_cu < 1) fprintf(stderr, "kernel_launch: occupancy query reports %d\n", per_cu);
        (void)hipGetLastError();
        grid = cus;
        if (grid > 256) grid = 256;
        if (grid < 240) { fprintf(stderr, "kernel_launch: %d CUs: this build needs 240..256\n", cus); grid = -1; return; }
    }
    if (grid < 0) return;
    if (hipMemsetAsync((char*)d_ws + WS_CTL, 0, CTL_ZERO_BYTES, stream) != hipSuccess) return;
    Args a{};
    for (int i = 0; i < 18; ++i) a.in[i] = (const float*)d_in[i];
    a.out = (float*)d_out; a.ws = (unsigned char*)d_ws;
#if MK_ONE_LAUNCH
    a.ph_lo = 0; a.ph_hi = NPHASE;
    hipLaunchKernelGGL(mk_fwd, dim3(grid), dim3(NTHR), LDS_BYTES, stream, a);
#else
    for (int p = 0; p < NPHASE; ++p) { a.ph_lo = p; a.ph_hi = p + 1; hipLaunchKernelGGL(mk_fwd, dim3(grid), dim3(NTHR), LDS_BYTES, stream, a); }
#endif
}
```
